# Optimizing an MI355X kernel written in HIP

```python
import jax
import jax.numpy as jnp
from jax import lax
import numpy as np

D_MODEL = 1024
BATCH = 2
SEQ = 16384
DEPTH = 4

GRID_W = 64
CTX_LEN = 256
N_MIXERS = 2
N_LAYERS_A = (DEPTH + N_MIXERS - 1) // N_MIXERS
N_LAYERS_B = DEPTH // N_MIXERS
N_MOD = 6
NORM_EPS = 1e-6
CHUNK = 128
GMLP_WIDTH = 2 * D_MODEL
GMLP_GROUP_CH = 128
GMLP_GROUPS = GMLP_WIDTH // GMLP_GROUP_CH
LN_EPS = 1e-5
RWKV_HEAD = 64
RWKV_HEADS = D_MODEL // RWKV_HEAD
DECAY_LORA = 64
AAA_LORA = 64
GATE_LORA = 160
GN_EPS = 64e-5
N_DIR = 2
N_GROUPS = 4
EXPERTS_PER_GROUP = 8
N_EXPERTS = N_GROUPS * EXPERTS_PER_GROUP
EXPERT_HIDDEN = 512
TOP_K = 2
MOE_BLOCK = 128

kernel_name = 'hybrid_gmlp_rwkv7_hmoe_dit'


def rmsnorm(x, g):
    xf = x.astype(jnp.float32)
    y = xf * lax.rsqrt(jnp.mean(xf * xf, axis=-1, keepdims=True) + NORM_EPS)
    return y.astype(x.dtype) * g


def layernorm(x, g, b, eps):
    xf = x.astype(jnp.float32)
    mu = jnp.mean(xf, axis=-1, keepdims=True)
    var = jnp.mean(jnp.square(xf - mu), axis=-1, keepdims=True)
    return ((xf - mu) * lax.rsqrt(var + eps)).astype(x.dtype) * g + b


def gmlp_mixer(h, w_in, b_in, ln_g, ln_b, w_s, b_s, w_out, b_out):
    bsz, n, _ = h.shape
    z = jax.nn.gelu(h @ w_in + b_in, approximate=False)
    u, v = jnp.split(z, 2, axis=-1)
    v = layernorm(v, ln_g, ln_b, LN_EPS)
    v = v.reshape(bsz, n // CHUNK, CHUNK, GMLP_GROUPS, GMLP_GROUP_CH)
    v = jnp.einsum('gpq,bcqgd->bcpgd', w_s, v) + b_s.T[:, :, None]
    return (u * v.reshape(bsz, n, GMLP_WIDTH)) @ w_out + b_out


def qshift_grid(h, rows):
    bsz, n, d = h.shape
    q = d // 4
    g = h.reshape(bsz, rows, GRID_W, d)
    left = jnp.pad(g[:, :, :-1, :q], ((0, 0), (0, 0), (1, 0), (0, 0)))
    right = jnp.pad(g[:, :, 1:, q:2 * q], ((0, 0), (0, 0), (0, 1), (0, 0)))
    up = jnp.pad(g[:, :-1, :, 2 * q:3 * q], ((0, 0), (1, 0), (0, 0), (0, 0)))
    down = jnp.pad(g[:, 1:, :, 3 * q:], ((0, 0), (0, 1), (0, 0), (0, 0)))
    return jnp.concatenate([left, right, up, down], axis=-1).reshape(bsz, n, d)


def bishift_1d(h):
    half = h.shape[-1] // 2
    prev = jnp.pad(h[:, :-1, :half], ((0, 0), (1, 0), (0, 0)))
    nxt = jnp.pad(h[:, 1:, half:], ((0, 0), (0, 1), (0, 0)))
    return jnp.concatenate([prev, nxt], axis=-1)


def _heads(z):
    return z.reshape(*z.shape[:-1], RWKV_HEADS, RWKV_HEAD)


def _both_dirs(z):
    return jnp.stack([z, z[:, ::-1]])


def _rev_dir1(z):
    return jnp.stack([z[0], z[1][:, ::-1]])


def _scan_layout(z):
    return jnp.moveaxis(_heads(z), 2, 0).astype(jnp.float32)


def rwkv_prepare(h, h_shift, mu, wr, wk, wv, w0, w1, w2, a0, a1, a2, k_k, k_a):
    xx = h_shift - h
    xr, xw, xk, xv, xa = [h + xx * mu[j] for j in range(5)]
    r = xr @ wr
    k = xk @ wk
    v = xv @ wv
    lw = jnp.einsum('zbtr,zrd->zbtd', jnp.tanh(jnp.einsum('btd,zdr->zbtr', xw, w1)), w2)
    w_log = -jax.nn.softplus(-(w0[:, None, None, :] + lw).astype(jnp.float32)) - 0.5
    decay = jnp.exp(-jnp.exp(w_log))
    la = jnp.einsum('zbtr,zrd->zbtd', jnp.einsum('btd,zdr->zbtr', xa, a1), a2)
    a = jax.nn.sigmoid((a0[:, None, None, :] + la).astype(jnp.float32))
    kk = _heads(k * k_k).astype(jnp.float32)
    kk = (kk * lax.rsqrt(jnp.sum(kk * kk, axis=-1, keepdims=True) + 1e-12)).reshape(k.shape)
    k_mod = k[None] * (1 + (a - 1) * k_a)
    scan_in = (_scan_layout(_both_dirs(r)), _scan_layout(_rev_dir1(decay)), _scan_layout(_rev_dir1(k_mod)),
               _scan_layout(_both_dirs(v)), _scan_layout(_both_dirs(-kk)), _scan_layout(_rev_dir1(kk[None] * a)))
    return scan_in, r, k_mod, v, xx


def _wkv_step(S, inp):
    r_t, w_t, k_t, v_t, a_t, b_t = inp
    sa = jnp.einsum('zbhvk,zbhk->zbhv', S, a_t)
    S = S * w_t[..., None, :] + sa[..., :, None] * b_t[..., None, :] + v_t[..., :, None] * k_t[..., None, :]
    return S, jnp.einsum('zbhvk,zbhk->zbhv', S, r_t)


def wkv_bidir(state0, scan_in):
    state, ys = lax.scan(_wkv_step, state0, scan_in)
    ys = jnp.moveaxis(ys, 0, 2)
    return state, ys[0] + ys[1][:, ::-1]


def rwkv_out(y, h, xx, r, k_mod, v, mu, ln_g, ln_b, r_k, g1, g2, wo):
    bsz, n, d = r.shape
    y = layernorm(y, ln_g.reshape(RWKV_HEADS, RWKV_HEAD), ln_b.reshape(RWKV_HEADS, RWKV_HEAD), GN_EPS)
    bonus = jnp.einsum('bthk,zbthk->bth', _heads(r) * r_k, _heads(k_mod))
    y = y.astype(r.dtype) + bonus[..., None] * _heads(v)
    xg = h + xx * mu[5]
    gate = jax.nn.sigmoid(xg @ g1) @ g2
    return (y.reshape(bsz, n, d) * gate) @ wo


def rwkv_mixer(hc, hl, rows, need_ctx_out, mu, wr, wk, wv, wo, w0, w1, w2, a0, a1, a2, g1, g2,
               k_k, k_a, r_k, ln_g, ln_b):
    proj = (mu, wr, wk, wv, w0, w1, w2, a0, a1, a2, k_k, k_a)
    scan_c, r_c, km_c, v_c, xx_c = rwkv_prepare(hc, bishift_1d(hc), *proj)
    scan_l, r_l, km_l, v_l, xx_l = rwkv_prepare(hl, qshift_grid(hl, rows), *proj)
    state0 = jnp.zeros((N_DIR, hc.shape[0], RWKV_HEADS, RWKV_HEAD, RWKV_HEAD), jnp.float32)
    state_c, y_c = wkv_bidir(state0, scan_c)
    _, y_l = wkv_bidir(state_c, scan_l)
    outp = (mu, ln_g, ln_b, r_k, g1, g2, wo)
    out_l = rwkv_out(y_l, hl, xx_l, r_l, km_l, v_l, *outp)
    out_c = rwkv_out(y_c, hc, xx_c, r_c, km_c, v_c, *outp) if need_ctx_out else None
    return out_c, out_l


def hier_moe(h, w_grp, b_grp, w_exp, b_exp, w_gate, w_up, w_down):
    n_tok, d = h.shape
    hf = h.astype(jnp.float32)
    grp_logits = hf @ w_grp.astype(jnp.float32) + b_grp.astype(jnp.float32)
    grp_prob = jax.nn.softmax(grp_logits, axis=-1)
    grp = jnp.argmax(grp_logits, axis=-1)
    p_grp = jnp.take_along_axis(grp_prob, grp[:, None], axis=-1)
    exp_logits = (hf @ w_exp.astype(jnp.float32) + b_exp.astype(jnp.float32)).reshape(n_tok, N_GROUPS, EXPERTS_PER_GROUP)
    exp_logits = jnp.take_along_axis(exp_logits, grp[:, None, None], axis=1)[:, 0]
    top_logit, top_idx = lax.top_k(exp_logits, TOP_K)
    weights = (p_grp * jax.nn.softmax(top_logit, axis=-1)).astype(h.dtype)
    expert_id = (grp[:, None] * EXPERTS_PER_GROUP + top_idx).reshape(-1)
    n_assign = n_tok * TOP_K
    order = jnp.argsort(expert_id)
    sorted_e = expert_id[order]
    token_of = order // TOP_K
    counts = jnp.bincount(expert_id, length=N_EXPERTS)
    padded = ((counts + MOE_BLOCK - 1) // MOE_BLOCK) * MOE_BLOCK
    pad_end = jnp.cumsum(padded)
    pad_start = pad_end - padded
    raw_start = jnp.cumsum(counts) - counts
    dest = pad_start[sorted_e] + (jnp.arange(n_assign) - raw_start[sorted_e])
    n_blocks = (n_assign + MOE_BLOCK - 1) // MOE_BLOCK + N_EXPERTS
    cap = n_blocks * MOE_BLOCK
    buf = jnp.zeros((cap, d), h.dtype).at[dest].set(h[token_of])
    block_expert = jnp.minimum(jnp.searchsorted(pad_end, jnp.arange(n_blocks) * MOE_BLOCK, side='right'),
                               N_EXPERTS - 1)

    def expert_block(args):
        xb, e = args
        return (jax.nn.silu(xb @ w_gate[e]) * (xb @ w_up[e])) @ w_down[e]

    out = lax.map(expert_block, (buf.reshape(n_blocks, MOE_BLOCK, d), block_expert)).reshape(cap, d)
    y = jnp.zeros((n_assign, d), h.dtype).at[order].set(out[dest]).reshape(n_tok, TOP_K, d)
    return jnp.einsum('tk,tkd->td', weights, y)


def setup_inputs(seed: int = 0) -> dict:
    key = jax.random.key(seed)
    keys = iter(jax.random.split(key, 48))
    f32 = jnp.float32

    def nrm(shape, scale):
        return scale * jax.random.normal(next(keys), shape, f32)

    def gain(shape):
        return 1.0 + nrm(shape, 0.1)

    def unif(shape, lo, hi):
        return jax.random.uniform(next(keys), shape, f32, lo, hi)

    D, W, F = D_MODEL, GMLP_WIDTH, EXPERT_HIDDEN
    NA, NB = N_LAYERS_A, N_LAYERS_B
    return {
        'x': nrm((BATCH, SEQ, D), 1.0),
        'c': nrm((BATCH, D), 1.0),
        'ctx': nrm((BATCH, CTX_LEN, D), 1.0),
        'c_ctx': nrm((D,), 1.0),
        'ada_w': nrm((DEPTH, D, N_MOD * D), 0.5 * D ** -0.5),
        'ada_b': nrm((DEPTH, N_MOD * D), 0.05),
        'norm1_g': gain((DEPTH, D)),
        'norm2_g': gain((DEPTH, D)),
        'final_g': gain((D,)),
        'ga_w_in': nrm((NA, D, 2 * W), D ** -0.5),
        'ga_b_in': nrm((NA, 2 * W), 0.02),
        'ga_ln_g': gain((NA, W)),
        'ga_ln_b': nrm((NA, W), 0.02),
        'ga_w_s': nrm((NA, GMLP_GROUPS, CHUNK, CHUNK), 0.5 * CHUNK ** -0.5),
        'ga_b_s': gain((NA, GMLP_GROUPS, CHUNK)),
        'ga_w_out': nrm((NA, W, D), W ** -0.5),
        'ga_b_out': nrm((NA, D), 0.02),
        'rw_mu': unif((NB, N_MOD, D), 0.0, 1.0),
        'rw_wr': nrm((NB, D, D), D ** -0.5),
        'rw_wk': nrm((NB, D, D), D ** -0.5),
        'rw_wv': nrm((NB, D, D), D ** -0.5),
        'rw_wo': nrm((NB, D, D), D ** -0.5),
        'rw_w0': unif((NB, N_DIR, D), -6.0, 0.0),
        'rw_w1': nrm((NB, N_DIR, D, DECAY_LORA), 0.5 * D ** -0.5),
        'rw_w2': nrm((NB, N_DIR, DECAY_LORA, D), 0.5 * DECAY_LORA ** -0.5),
        'rw_a0': nrm((NB, N_DIR, D), 0.5),
        'rw_a1': nrm((NB, N_DIR, D, AAA_LORA), 0.5 * D ** -0.5),
        'rw_a2': nrm((NB, N_DIR, AAA_LORA, D), 0.5 * AAA_LORA ** -0.5),
        'rw_g1': nrm((NB, D, GATE_LORA), D ** -0.5),
        'rw_g2': nrm((NB, GATE_LORA, D), GATE_LORA ** -0.5),
        'rw_k_k': 0.85 + nrm((NB, D), 0.05),
        'rw_k_a': gain((NB, D)),
        'rw_r_k': nrm((NB, RWKV_HEADS, RWKV_HEAD), 0.1),
        'rw_ln_g': gain((NB, D)),
        'rw_ln_b': nrm((NB, D), 0.02),
        'moe_w_grp': nrm((DEPTH, D, N_GROUPS), D ** -0.5),
        'moe_b_grp': nrm((DEPTH, N_GROUPS), 0.01),
        'moe_w_exp': nrm((DEPTH, D, N_EXPERTS), D ** -0.5),
        'moe_b_exp': nrm((DEPTH, N_EXPERTS), 0.01),
        'moe_w_gate': nrm((DEPTH, N_EXPERTS, D, F), D ** -0.5),
        'moe_w_up': nrm((DEPTH, N_EXPERTS, D, F), D ** -0.5),
        'moe_w_down': nrm((DEPTH, N_EXPERTS, F, D), F ** -0.5),
    }


def reference(x, c, ctx, c_ctx, ada_w, ada_b, norm1_g, norm2_g, final_g,
              ga_w_in, ga_b_in, ga_ln_g, ga_ln_b, ga_w_s, ga_b_s, ga_w_out, ga_b_out,
              rw_mu, rw_wr, rw_wk, rw_wv, rw_wo, rw_w0, rw_w1, rw_w2, rw_a0, rw_a1, rw_a2,
              rw_g1, rw_g2, rw_k_k, rw_k_a, rw_r_k, rw_ln_g, rw_ln_b,
              moe_w_grp, moe_b_grp, moe_w_exp, moe_b_exp, moe_w_gate, moe_w_up, moe_w_down):
    bsz, n, d = x.shape
    rows = n // GRID_W
    xc = ctx
    silu_c = jax.nn.silu(c)
    silu_cc = jax.nn.silu(c_ctx)
    for i in range(DEPTH):
        last = i == DEPTH - 1
        j = i // N_MIXERS
        mod_l = silu_c @ ada_w[i] + ada_b[i]
        mod_c = silu_cc @ ada_w[i] + ada_b[i]
        sh1, sc1, gt1, sh2, sc2, gt2 = jnp.split(mod_l[:, None, :], N_MOD, axis=-1)
        csh1, csc1, cgt1, csh2, csc2, cgt2 = jnp.split(mod_c, N_MOD, axis=-1)
        hl = rmsnorm(x, norm1_g[i]) * (1 + sc1) + sh1
        hc = rmsnorm(xc, norm1_g[i]) * (1 + csc1) + csh1
        if i % N_MIXERS == 0:
            gp = (ga_w_in[j], ga_b_in[j], ga_ln_g[j], ga_ln_b[j], ga_w_s[j], ga_b_s[j], ga_w_out[j], ga_b_out[j])
            yl = gmlp_mixer(hl, *gp)
            yc = None if last else gmlp_mixer(hc, *gp)
        else:
            yc, yl = rwkv_mixer(hc, hl, rows, not last, rw_mu[j], rw_wr[j], rw_wk[j], rw_wv[j], rw_wo[j],
                                rw_w0[j], rw_w1[j], rw_w2[j], rw_a0[j], rw_a1[j], rw_a2[j], rw_g1[j], rw_g2[j],
                                rw_k_k[j], rw_k_a[j], rw_r_k[j], rw_ln_g[j], rw_ln_b[j])
        x = x + gt1 * yl
        hl2 = rmsnorm(x, norm2_g[i]) * (1 + sc2) + sh2
        mp = (moe_w_grp[i], moe_b_grp[i], moe_w_exp[i], moe_b_exp[i], moe_w_gate[i], moe_w_up[i], moe_w_down[i])
        if last:
            x = x + gt2 * hier_moe(hl2.reshape(-1, d), *mp).reshape(x.shape)
        else:
            xc = xc + cgt1 * yc
            hc2 = rmsnorm(xc, norm2_g[i]) * (1 + csc2) + csh2
            out = hier_moe(jnp.concatenate([hl2.reshape(-1, d), hc2.reshape(-1, d)], axis=0), *mp)
            x = x + gt2 * out[:bsz * n].reshape(x.shape)
            xc = xc + cgt2 * out[bsz * n:].reshape(xc.shape)
    return rmsnorm(x, final_g)
```

```cpp
#include <hip/hip_runtime.h>
#include <cstdio>
#include <cstdint>

#define LAS __attribute__((address_space(3)))
typedef unsigned short bf16_t;
typedef short bf16x8 __attribute__((ext_vector_type(8)));
typedef float f32x4 __attribute__((ext_vector_type(4)));
typedef float f32x2 __attribute__((ext_vector_type(2)));
typedef unsigned u32x4 __attribute__((ext_vector_type(4)));
typedef unsigned u32x2 __attribute__((ext_vector_type(2)));

#ifndef MK_ONE_LAUNCH
#define MK_ONE_LAUNCH 0
#endif

constexpr int D = 1024, NBATCH = 2, SEQ = 16384, CTXL = 256, DEPTH = 4;
constexpr int TL = NBATCH * SEQ, TC = NBATCH * CTXL, T = TL + TC;
constexpr int GWID = 2048, NE = 32, EHID = 512, NH = 16, HD = 64;
constexpr int LISTCAP = T;
constexpr int MAXRT = (2 * T) / 256 + NE;
constexpr int NWAVES = 8, NTHR = 512;

constexpr size_t MiB = 1u << 20;
constexpr size_t WS_CTL = 0, CTL_BYTES = 1 * MiB;
constexpr size_t WS_MOD = 1 * MiB;
constexpr size_t WS_WIN = 2 * MiB, WS_WOUT = 18 * MiB, WS_WSP = 26 * MiB, WS_WR = 27 * MiB, WS_WK = 31 * MiB, WS_WV = 35 * MiB, WS_WO = 39 * MiB;
constexpr size_t WS_LW1 = 43 * MiB, WS_LA1 = 44 * MiB, WS_LG1 = 45 * MiB, WS_W2P = 46 * MiB, WS_A2P = 48 * MiB, WS_G2P = 50 * MiB;
constexpr size_t WS_WGU = 52 * MiB, WS_WD = 116 * MiB;
constexpr size_t WS_X = 148 * MiB;
constexpr size_t WS_LIST = 278 * MiB, WS_WGT = 283 * MiB;
constexpr size_t WS_HL = 284 * MiB;
constexpr size_t WS_BIG = 349 * MiB;
constexpr size_t SZB = 65 * MiB;
constexpr size_t WS_U = WS_BIG, WS_V = WS_BIG + 2 * SZB, WS_STAT = WS_BIG + 4 * SZB;
constexpr size_t WS_XR = WS_BIG, WS_XW = WS_BIG + SZB, WS_XK = WS_BIG + 2 * SZB, WS_XV = WS_BIG + 3 * SZB, WS_XA = WS_BIG + 4 * SZB, WS_XG = WS_BIG + 5 * SZB;
constexpr size_t WS_R = WS_BIG + 6 * SZB, WS_K = WS_BIG + 7 * SZB, WS_VV = WS_BIG + 8 * SZB;
constexpr size_t WS_TW = WS_BIG + 9 * SZB, WS_TA = WS_TW + 17 * MiB, WS_TG = WS_TA + 17 * MiB;
constexpr size_t WS_ELOG0 = WS_XR, WS_ELOG1 = WS_XW, WS_KM0 = WS_XK, WS_KM1 = WS_XV, WS_AS0 = WS_XA, WS_AS1 = WS_XG;
constexpr size_t WS_GATE = WS_HL, WS_YG = WS_AS0;
constexpr size_t WS_H = WS_BIG, WS_YB = WS_BIG + 73 * MiB;
constexpr size_t WS_END = WS_TG + 17 * MiB;
static_assert(WS_END <= 1000 * MiB, "workspace map");
constexpr int CW_BAR = 4096;
constexpr int CW_CNT = 16384;

__device__ __forceinline__ unsigned cvt_pk_bf16(float lo, float hi) { unsigned r; asm volatile("v_cvt_pk_bf16_f32 %0, %1, %2" : "=v"(r) : "v"(lo), "v"(hi)); return r; }
__device__ __forceinline__ float bf_lo(unsigned u) { return __uint_as_float(u << 16); }
__device__ __forceinline__ float bf_hi(unsigned u) { return __uint_as_float(u & 0xffff0000u); }
__device__ __forceinline__ float bf1(bf16_t b) { return __uint_as_float(((unsigned)b) << 16); }
__device__ __forceinline__ bf16_t f2bf(float f) { return (bf16_t)(cvt_pk_bf16(f, 0.f) & 0xffffu); }
__device__ __forceinline__ float wave_sum(float v) {
#pragma unroll
    for (int o = 1; o < 64; o <<= 1) v += __shfl_xor(v, o);
    return v;
}
__device__ __forceinline__ float sigmoidf_(float x) { return 1.0f / (1.0f + __expf(-x)); }
__device__ __forceinline__ float tanhf_(float x) { const float e = __expf(2.0f * x); return 1.0f - 2.0f / (e + 1.0f); }
__device__ __forceinline__ f32x2 gelu_pk(f32x2 v) {
    const f32x2 av = __builtin_elementwise_abs(v), d = av * 0.2316418882f + 1.0f;
    f32x2 t; t.x = __builtin_amdgcn_rcpf(d.x); t.y = __builtin_amdgcn_rcpf(d.y);
    f32x2 q = t * 0.5307027145f + (-0.7265760135f); q = q * t + 0.7107068705f; q = q * t + (-0.142248368f); q = q * t + 0.127414796f; q = q * t;
    const f32x2 s = (v * v) * (-0.72134752044f);
    f32x2 e; e.x = __builtin_amdgcn_exp2f(s.x); e.y = __builtin_amdgcn_exp2f(s.y);
    const f32x2 m = v * (q * e), r = v - m;
    f32x2 o; o.x = v.x < 0.f ? m.x : r.x; o.y = v.y < 0.f ? m.y : r.y; return o;
}

#define XB_TMO      128
#define XB_XCNT(j)  (256  + 64 * (j))
#define XB_XSUB(j)  (1280 + 64 * (j))
#define XB_XGEN(j)  (2304 + 64 * (j))
#define XB_TOP      3328
#define XB_TOPGEN   3392
#define XCD_BAR_WORDS 3456
#define XB_SPIN_CAP (1u << 18)
__device__ __forceinline__ unsigned xb_ld(unsigned* p)              { return __hip_atomic_load(p, __ATOMIC_RELAXED, __HIP_MEMORY_SCOPE_AGENT); }
__device__ __forceinline__ unsigned xb_add(unsigned* p, unsigned v) { return __hip_atomic_fetch_add(p, v, __ATOMIC_RELAXED, __HIP_MEMORY_SCOPE_AGENT); }
__device__ __forceinline__ unsigned xb_xcc_id() { return (unsigned)__builtin_amdgcn_s_getreg((3 << 11) | 20) & 0xFu; }
#define XB_SPIN(cond, bar) do { unsigned _sp = 0; while (cond) { __builtin_amdgcn_s_sleep(1); \
    if ((++_sp & 255u) == 0u) { if (xb_ld(&(bar)[XB_TMO])) break; if (_sp > XB_SPIN_CAP) { atomicAdd(&(bar)[XB_TMO], 1u); break; } } } } while (0)
struct XcdBarrier { unsigned* bar; unsigned x; volatile LAS unsigned* st; };
__device__ __forceinline__ XcdBarrier xcd_barrier_post(unsigned* bar, volatile LAS unsigned* st) {
    XcdBarrier b; b.bar = bar; b.x = xb_xcc_id(); b.st = st;
    if (threadIdx.x == 0) (void)xb_add(&bar[XB_XCNT(b.x)], 1u);
    return b;
}
__device__ __forceinline__ void xcd_barrier_complete(unsigned* bar, unsigned x, unsigned& nloc, unsigned& nx) {
    const unsigned G = gridDim.x * gridDim.y * gridDim.z;
    unsigned sum, cnt, mine, sp = 0u;
    for (;;) {
        sum = 0u; cnt = 0u; mine = 0u;
#pragma unroll
        for (unsigned j = 0; j < 16; ++j) { const unsigned c = xb_ld(&bar[XB_XCNT(j)]); sum += c; cnt += (c > 0u) ? 1u : 0u; mine = (j == x) ? c : mine; }
        if (sum == G) break;
        __builtin_amdgcn_s_sleep(1);
        if ((++sp & 255u) == 0u) { if (xb_ld(&bar[XB_TMO])) break; if (sp > XB_SPIN_CAP) { atomicAdd(&bar[XB_TMO], 1u); break; } }
    }
    nloc = mine > 0u ? mine : 1u; nx = cnt > 0u ? cnt : 1u;
}
__device__ __forceinline__ void xcd_barrier(const XcdBarrier& b) {
    asm volatile("s_waitcnt vmcnt(0)" ::: "memory");
    __syncthreads();
    if (threadIdx.x == 0) {
        unsigned* bar = b.bar;
        __builtin_amdgcn_s_waitcnt(0);
        unsigned nloc = b.st[0], nx = b.st[1];
        if (nloc == 0u) { xcd_barrier_complete(bar, b.x, nloc, nx); b.st[0] = nloc; b.st[1] = nx; }
        const unsigned old = xb_add(&bar[XB_XSUB(b.x)], 1u);
        const unsigned gen = old / nloc;
        if (old + 1u == (gen + 1u) * nloc) {
            __builtin_amdgcn_fence(__ATOMIC_RELEASE, "agent");
            asm volatile("s_waitcnt vmcnt(0)" ::: "memory");
            const unsigned og = xb_add(&bar[XB_TOP], 1u);
            const unsigned tg = og / nx;
            if (og + 1u == (tg + 1u) * nx) xb_add(&bar[XB_TOPGEN], 1u);
            else XB_SPIN(xb_ld(&bar[XB_TOPGEN]) == tg, bar);
            __builtin_amdgcn_fence(__ATOMIC_ACQUIRE, "agent");
            xb_add(&bar[XB_XGEN(b.x)], 1u);
            asm volatile("s_waitcnt vmcnt(0)" ::: "memory");
        } else {
            XB_SPIN(xb_ld(&bar[XB_XGEN(b.x)]) == gen, bar);
            __builtin_amdgcn_fence(__ATOMIC_ACQUIRE, "agent");
            asm volatile("s_waitcnt vmcnt(0)" ::: "memory");
        }
    }
    __syncthreads();
}

constexpr int LDS_MISC = 131072;
constexpr int LDS_DESC = LDS_MISC + 128;
constexpr int LDS_TAB = LDS_MISC + 512;
constexpr int LDS_BYTES = 147456;
namespace pg8 {
constexpr int BM = 256, BK = 64, HALF = 128, HTB = HALF * BK * 2, STAGE_BYTES = 8 * HTB, NXCD = 8, WGM = 8;
__host__ __device__ __forceinline__ int lds_byte(int r, int c) { const int st = (r >> 4) * 2 + (c >> 5), rr = r & 15, cc = c & 31, ob = rr * 64 + cc * 2; return st * 1024 + (ob ^ (((ob >> 9) & 1) << 5)); }
__host__ __device__ __forceinline__ void stage_rc(int b, int& R, int& C) { const int st = b / 1024, sb = b % 1024, swz = sb ^ (((sb >> 9) & 1) << 5); R = (st >> 1) * 16 + swz / 64; C = (st & 1) * 32 + (swz % 64) / 2; }
__host__ __device__ __forceinline__ int perm32(int rho) { const int n = rho >> 4, i = rho & 15; return 8 * (i >> 2) + 4 * n + (i & 3); }
__device__ __forceinline__ int xcd_remap(int L, int nwg) { const int q = nwg / NXCD, r = nwg % NXCD, xcd = L % NXCD, off = L / NXCD; return (xcd < r ? xcd * (q + 1) : r * (q + 1) + (xcd - r) * q) + off; }

struct Unit { int pm, pn, aux; };

template <class Epi, class Sched, bool GATHER, int K, int LDA, int LDB>
__device__ __forceinline__ void gemm_phase(LAS unsigned char* lds, const Sched& S, const Epi& E) {
    const int tid = threadIdx.x, wid = __builtin_amdgcn_readfirstlane(tid >> 6), lane = tid & 63, wr = wid >> 2, wc = wid & 3, fr = lane & 15, fq = lane >> 4;
    constexpr int nt = K / BK;
    unsigned voffA[2], voffB[2];
#pragma unroll
    for (int i = 0; i < 2; ++i) { int R, C; stage_rc(tid * 16 + i * 8192, R, C); const int Rb = Epi::PERM ? ((R & ~31) + perm32(R & 31)) : R;
        voffA[i] = (unsigned)(R * LDA + C) * 2u; voffB[i] = (unsigned)(Rb * LDB + C) * 2u; }
    constexpr size_t kstep = (size_t)(BK * 2);
    constexpr size_t hstepA = GATHER ? (size_t)0 : (size_t)HALF * LDA * 2, hstepB = (size_t)HALF * LDB * 2;
    const unsigned ldsw = (unsigned)wid * 1024u;
    const int aoff = lds_byte(wr * 64 + fr, fq * 8), boff = lds_byte(wc * 32 + fr, fq * 8);
    unsigned gA[2][2], gN[2][2];
#define PG8_SA(b, h) (((b) * 2 + (h)) * HTB)
#define PG8_SB(b, h) ((4 + (b) * 2 + (h)) * HTB)
#define PG8_STAGEB(bufoff, gbase) do { _Pragma("unroll") for (int _i = 0; _i < 2; ++_i) \
        __builtin_amdgcn_global_load_lds((const unsigned*)((const char*)(gbase) + voffB[_i]), (LAS unsigned*)(lds + (bufoff) + ldsw + _i * 8192), 16, 0, 0); } while (0)
#define PG8_STAGEA(bufoff, gbase, h, GV) do { _Pragma("unroll") for (int _i = 0; _i < 2; ++_i) \
        __builtin_amdgcn_global_load_lds((const unsigned*)((const char*)(gbase) + (GATHER ? GV[h][_i] : voffA[_i]) + (h) * hstepA), (LAS unsigned*)(lds + (bufoff) + ldsw + _i * 8192), 16, 0, 0); } while (0)
#define PG8_LDA(dst, b, h) do { _Pragma("unroll") for (int m = 0; m < 4; ++m) _Pragma("unroll") for (int k = 0; k < 2; ++k) dst[m][k] = *(const LAS bf16x8*)(lds + PG8_SA(b, h) + aoff + m * 2048 + k * 1024); } while (0)
#define PG8_LDB(dst, b, h) do { _Pragma("unroll") for (int n = 0; n < 2; ++n) _Pragma("unroll") for (int k = 0; k < 2; ++k) dst[n][k] = *(const LAS bf16x8*)(lds + PG8_SB(b, h) + boff + n * 2048 + k * 1024); } while (0)
#define PG8_MMA(ai, bj, At, Bt) do { __builtin_amdgcn_s_setprio(1); _Pragma("unroll") for (int m = 0; m < 4; ++m) _Pragma("unroll") for (int n = 0; n < 2; ++n) _Pragma("unroll") for (int k = 0; k < 2; ++k) \
        acc[ai][bj][m][n] = __builtin_amdgcn_mfma_f32_16x16x32_bf16(Bt[n][k], At[m][k], acc[ai][bj][m][n], 0, 0, 0); __builtin_amdgcn_s_setprio(0); } while (0)
#define PG8_WAIT_V(n) asm volatile("s_waitcnt vmcnt(" #n ")" ::: "memory")
#define PG8_WAIT_L(n) asm volatile("s_waitcnt lgkmcnt(" #n ")" ::: "memory")
#define PG8_BAR __builtin_amdgcn_s_barrier()
#define PG8_SCHED __builtin_amdgcn_sched_barrier(0)
    Unit cur, nxt; int ui = 0;
    if (!S.next(0, cur)) return;
    f32x4 acc[2][2][4][2];
#pragma unroll
    for (int a = 0; a < 2; ++a)
#pragma unroll
        for (int b = 0; b < 2; ++b)
#pragma unroll
            for (int m = 0; m < 4; ++m)
#pragma unroll
                for (int n = 0; n < 2; ++n) acc[a][b][m][n] = (f32x4){0.f, 0.f, 0.f, 0.f};
    bf16x8 At[4][2], B0[2][2], B1[2][2];
    const char* cA = S.aptr(cur); const char* cB = S.bptr(cur);
    if constexpr (GATHER) { S.gather(cur, tid, gA); }
    PG8_STAGEB(PG8_SB(0, 0), cB); PG8_STAGEB(PG8_SB(0, 1), cB + hstepB); PG8_STAGEA(PG8_SA(0, 0), cA, 0, gA); PG8_STAGEA(PG8_SA(0, 1), cA, 1, gA);
    if (wr == 1) PG8_BAR;
    PG8_WAIT_V(2); PG8_BAR;
    PG8_STAGEB(PG8_SB(1, 0), cB + kstep); PG8_STAGEA(PG8_SA(1, 0), cA + kstep, 0, gA); PG8_STAGEB(PG8_SB(1, 1), cB + hstepB + kstep);
    PG8_WAIT_V(6); PG8_BAR;
    for (;;) {
        const bool has_next = S.next(ui + 1, nxt);
        const char* nA = has_next ? S.aptr(nxt) : cA; const char* nB = has_next ? S.bptr(nxt) : cB;
        if constexpr (GATHER) { if (has_next) S.gather(nxt, tid, gN); else {
#pragma unroll
            for (int h = 0; h < 2; ++h)
#pragma unroll
                for (int i = 0; i < 2; ++i) gN[h][i] = gA[h][i]; } }
#pragma nounroll
        for (int t = 0; t < nt; t += 2) {
            const bool last = (t == nt - 2);
            const char* a1 = cA + (size_t)(t + 1) * kstep;
            const char* a2 = last ? nA : cA + (size_t)(t + 2) * kstep; const char* b2 = last ? nB : cB + (size_t)(t + 2) * kstep;
            const char* a3 = a2 + kstep; const char* b3 = b2 + kstep;
            unsigned g2[2][2];
            if constexpr (GATHER) {
#pragma unroll
                for (int h = 0; h < 2; ++h)
#pragma unroll
                    for (int i = 0; i < 2; ++i) g2[h][i] = last ? gN[h][i] : gA[h][i]; }
            PG8_LDB(B0, 0, 0); PG8_LDB(B1, 0, 1); PG8_SCHED; PG8_LDA(At, 0, 0); PG8_STAGEA(PG8_SA(1, 1), a1, 1, gA);
            PG8_WAIT_V(8); PG8_WAIT_L(0); PG8_BAR; PG8_MMA(0, 0, At, B0); PG8_MMA(0, 1, At, B1); PG8_BAR; PG8_SCHED;
            PG8_LDA(At, 0, 1); PG8_STAGEB(PG8_SB(0, 0), b2); PG8_STAGEB(PG8_SB(0, 1), b2 + hstepB); PG8_STAGEA(PG8_SA(0, 0), a2, 0, g2);
            PG8_WAIT_V(8); PG8_WAIT_L(0); PG8_BAR; PG8_MMA(1, 0, At, B0); PG8_MMA(1, 1, At, B1); PG8_BAR; PG8_SCHED;
            PG8_LDB(B0, 1, 0); PG8_LDB(B1, 1, 1); PG8_SCHED; PG8_LDA(At, 1, 0); PG8_STAGEA(PG8_SA(0, 1), a2, 1, g2);
            PG8_WAIT_V(8); PG8_WAIT_L(0); PG8_BAR; PG8_MMA(0, 0, At, B0); PG8_MMA(0, 1, At, B1); PG8_BAR; PG8_SCHED;
            PG8_LDA(At, 1, 1); PG8_STAGEB(PG8_SB(1, 0), b3); PG8_STAGEB(PG8_SB(1, 1), b3 + hstepB); PG8_STAGEA(PG8_SA(1, 0), a3, 0, g2);
            PG8_WAIT_V(8); PG8_WAIT_L(0); PG8_BAR; PG8_MMA(1, 0, At, B0); PG8_MMA(1, 1, At, B1); PG8_BAR; PG8_SCHED;
        }
        if (wr == 0) PG8_BAR;
        E(acc, cur, wr, wc, fr, fq);
        if (!has_next) break;
#pragma unroll
        for (int a = 0; a < 2; ++a)
#pragma unroll
            for (int b = 0; b < 2; ++b)
#pragma unroll
                for (int m = 0; m < 4; ++m)
#pragma unroll
                    for (int n = 0; n < 2; ++n) acc[a][b][m][n] = (f32x4){0.f, 0.f, 0.f, 0.f};
        cur = nxt; cA = nA; cB = nB; ++ui;
        if constexpr (GATHER) {
#pragma unroll
            for (int h = 0; h < 2; ++h)
#pragma unroll
                for (int i = 0; i < 2; ++i) gA[h][i] = gN[h][i]; }
        if (wr == 1) PG8_BAR;
    }
    PG8_WAIT_V(0);
    PG8_BAR;
#undef PG8_SA
#undef PG8_SB
#undef PG8_STAGEA
#undef PG8_STAGEB
#undef PG8_LDA
#undef PG8_LDB
#undef PG8_MMA
#undef PG8_WAIT_V
#undef PG8_WAIT_L
#undef PG8_BAR
#undef PG8_SCHED
}
}
using pg8::Unit;

__device__ __forceinline__ void set_desc(LAS unsigned char* lds, int g, const void* A, const void* B, const void* C, int nN, int ldc, int aux, const void* X1 = nullptr, const void* X2 = nullptr, const void* X3 = nullptr) {
    LAS int* d = (LAS int*)(lds + LDS_DESC) + g * 16;
    if (threadIdx.x == 0) { const unsigned long long a = (unsigned long long)A, b = (unsigned long long)B, c = (unsigned long long)C, x1 = (unsigned long long)X1, x2 = (unsigned long long)X2, x3 = (unsigned long long)X3;
        d[0] = (int)(unsigned)a; d[1] = (int)(unsigned)(a >> 32); d[2] = (int)(unsigned)b; d[3] = (int)(unsigned)(b >> 32); d[4] = (int)(unsigned)c; d[5] = (int)(unsigned)(c >> 32); d[6] = nN; d[7] = ldc; d[8] = aux;
        d[10] = (int)(unsigned)x1; d[11] = (int)(unsigned)(x1 >> 32); d[12] = (int)(unsigned)x2; d[13] = (int)(unsigned)(x2 >> 32); d[14] = (int)(unsigned)x3; d[15] = (int)(unsigned)(x3 >> 32); }
}
__device__ __forceinline__ int desc_i(LAS unsigned char* lds, int g, int f) { return __builtin_amdgcn_readfirstlane(((LAS const int*)(lds + LDS_DESC))[g * 16 + f]); }
__device__ __forceinline__ const char* desc_p(LAS unsigned char* lds, int g, int f) {
    const unsigned lo = (unsigned)desc_i(lds, g, f), hi = (unsigned)desc_i(lds, g, f + 1); return (const char*)(((unsigned long long)hi << 32) | lo); }
template <int LDA, int LDB>
struct SchedMulti {
    LAS unsigned char* lds; int nM, ntot, ng;
    __device__ __forceinline__ bool next(int i, Unit& u) const {
        const int nwg = nM * ntot; const long L = (long)i * gridDim.x + blockIdx.x; if (L >= nwg) return false;
        const int wgid = pg8::xcd_remap((int)L, nwg);
        const int nig = pg8::WGM * ntot, gid = wgid / nig, fm = gid * pg8::WGM, gsz = (nM - fm) < pg8::WGM ? (nM - fm) : pg8::WGM;
        u.pm = fm + ((wgid % nig) % gsz); int pv = (wgid % nig) / gsz; int g = 0;
        for (int j = 0; j + 1 < ng; ++j) { const int n = desc_i(lds, j, 6); if (pv < n) break; pv -= n; g = j + 1; }
        u.pn = pv; u.aux = g; return true;
    }
    __device__ __forceinline__ const char* aptr(const Unit& u) const { return desc_p(lds, u.aux, 0) + (size_t)u.pm * (512 * LDA); }
    __device__ __forceinline__ const char* bptr(const Unit& u) const { return desc_p(lds, u.aux, 2) + (size_t)u.pn * (512 * LDB); }
};
template <int LDA, int LDB, bool GATHERED>
struct SchedMoE {
    LAS unsigned char* lds; const char* Abase; const char* Bbase; const int* list;
    __device__ __forceinline__ bool next(int i, Unit& u) const {
        LAS const int* tab = (LAS const int*)(lds + LDS_TAB);
        const int nrt = __builtin_amdgcn_readfirstlane(tab[2 * MAXRT + 32]);
        const int nwg = nrt * 4; const long L = (long)i * gridDim.x + blockIdx.x; if (L >= nwg) return false;
        const int wgid = pg8::xcd_remap((int)L, nwg);
        u.pm = wgid >> 2; u.pn = wgid & 3; u.aux = __builtin_amdgcn_readfirstlane(tab[u.pm]); return true;
    }
    __device__ __forceinline__ const char* aptr(const Unit& u) const { return GATHERED ? Abase : Abase + (size_t)u.pm * (512 * LDA); }
    __device__ __forceinline__ const char* bptr(const Unit& u) const { return Bbase + (size_t)u.aux * ((size_t)D * LDB * 2) + (size_t)u.pn * (512 * LDB); }
    __device__ __forceinline__ void gather(const Unit& u, int tid, unsigned (&g)[2][2]) const {
        LAS const int* tab = (LAS const int*)(lds + LDS_TAB);
        const int j0 = __builtin_amdgcn_readfirstlane(tab[MAXRT + u.pm]), cn = __builtin_amdgcn_readfirstlane(tab[2 * MAXRT + u.aux]);
#pragma unroll
        for (int i = 0; i < 2; ++i) { int R, C; pg8::stage_rc(tid * 16 + i * 8192, R, C);
#pragma unroll
            for (int h = 0; h < 2; ++h) { const int slot = j0 + 128 * h + R; const int a = slot < cn ? list[(size_t)u.aux * LISTCAP + slot] : 0;
                g[h][i] = (unsigned)((a >> 1) * LDA + C) * 2u; } }
    }
};
__device__ __forceinline__ void moe_tables(LAS unsigned char* lds, const unsigned* cnt) {
    LAS int* tab = (LAS int*)(lds + LDS_TAB);
    __syncthreads();
    if (threadIdx.x == 0) {
        int rt = 0;
#pragma nounroll
        for (int e = 0; e < NE; ++e) { const int c = (int)__hip_atomic_load(cnt + e, __ATOMIC_RELAXED, __HIP_MEMORY_SCOPE_AGENT); tab[2 * MAXRT + e] = c;
            const int nt = (c + 255) >> 8;
#pragma nounroll
            for (int j = 0; j < nt; ++j) { tab[rt] = e; tab[MAXRT + rt] = j * 256; ++rt; } }
        tab[2 * MAXRT + 32] = rt;
    }
    __syncthreads();
}

#define EPI_FENCE() asm volatile("" ::: "memory")
struct EpiGelu {
    static constexpr bool PERM = true;
    LAS unsigned char* lds;
    __device__ __forceinline__ void operator()(const f32x4 (&acc)[2][2][4][2], const Unit& u, int wr, int wc, int fr, int fq) const {
        const bool isv = u.pn >= 8; bf16_t* base = (bf16_t*)desc_p(lds, 0, isv ? 10 : 4); const float* bias = (const float*)desc_p(lds, 0, 12); float* stat = (float*)desc_p(lds, 0, 14);
        const int col0 = (u.pn & 7) * 256 + wc * 32 + 8 * fq, bcol0 = u.pn * 256 + wc * 32 + 8 * fq, row0 = u.pm * 256 + wr * 64 + fr;
        f32x4 bv[2][2];
#pragma unroll
        for (int bj = 0; bj < 2; ++bj)
#pragma unroll
            for (int n = 0; n < 2; ++n) bv[bj][n] = *(const f32x4*)(bias + bcol0 + bj * 128 + 4 * n);
#pragma unroll
        for (int ai = 0; ai < 2; ++ai)
#pragma unroll
            for (int m = 0; m < 4; ++m) { const int row = row0 + ai * 128 + m * 16; bf16_t* rowp = base + (size_t)row * GWID + col0; float s = 0.f, q = 0.f;
#pragma unroll
                for (int bj = 0; bj < 2; ++bj) { const f32x4 v0 = acc[ai][bj][m][0] + bv[bj][0], v1 = acc[ai][bj][m][1] + bv[bj][1];
                    const f32x2 a = gelu_pk((f32x2){v0[0], v0[1]}), b = gelu_pk((f32x2){v0[2], v0[3]}), c = gelu_pk((f32x2){v1[0], v1[1]}), d = gelu_pk((f32x2){v1[2], v1[3]});
                    s += ((a.x + a.y) + (b.x + b.y)) + ((c.x + c.y) + (d.x + d.y));
                    q += ((a.x * a.x + a.y * a.y) + (b.x * b.x + b.y * b.y)) + ((c.x * c.x + c.y * c.y) + (d.x * d.x + d.y * d.y));
                    u32x4 w; w.x = cvt_pk_bf16(a.x, a.y); w.y = cvt_pk_bf16(b.x, b.y); w.z = cvt_pk_bf16(c.x, c.y); w.w = cvt_pk_bf16(d.x, d.y);
                    *(u32x4*)(rowp + bj * 128) = w; }
                if (isv) { s += __shfl_xor(s, 16); s += __shfl_xor(s, 32); q += __shfl_xor(q, 16); q += __shfl_xor(q, 32);
                    if (fq == 0) *(f32x2*)(stat + ((size_t)row * 32 + (u.pn - 8) * 4 + wc) * 2) = (f32x2){s, q}; } }
    }
};
struct EpiResid {
    static constexpr bool PERM = false;
    LAS unsigned char* lds;
    __device__ __forceinline__ void operator()(const f32x4 (&acc)[2][2][4][2], const Unit& u, int wr, int wc, int fr, int fq) const {
        const int mrow = u.pm < 64 ? 0 : (u.pm < 128 ? 1 : 2);
        const float* xin = u.pm < 128 ? (const float*)desc_p(lds, 0, 10) + (size_t)u.pm * 256 * D : (const float*)desc_p(lds, 0, 12) + (size_t)(u.pm - 128) * 256 * D;
        float* xout = (float*)desc_p(lds, 0, 4) + (size_t)u.pm * 256 * D; const float* bias = (const float*)desc_p(lds, 0, 14); const float* gate = (const float*)desc_p(lds, 1, 10);
        const int col0 = u.pn * 256 + wc * 32 + 4 * fq, rl0 = wr * 64 + fr;
#pragma unroll
        for (int bj = 0; bj < 2; ++bj)
#pragma unroll
            for (int n = 0; n < 2; ++n) { const f32x4 bv = bias ? *(const f32x4*)(bias + col0 + bj * 128 + n * 16) : (f32x4){0.f, 0.f, 0.f, 0.f};
                const f32x4 gv = *(const f32x4*)(gate + mrow * 6 * D + col0 + bj * 128 + n * 16);
#pragma unroll
                for (int ai = 0; ai < 2; ++ai) {
#pragma unroll
                    for (int m = 0; m < 4; ++m) { const size_t off = (size_t)(rl0 + ai * 128 + m * 16) * D + col0 + bj * 128 + n * 16;
                        const f32x4 xi = *(const f32x4*)(xin + off); *(f32x4*)(xout + off) = xi + gv * (acc[ai][bj][m][n] + bv); }
                    EPI_FENCE(); } }
    }
};
struct EpiAct {
    static constexpr bool PERM = true;
    LAS unsigned char* lds;
    __device__ __forceinline__ void operator()(const f32x4 (&acc)[2][2][4][2], const Unit& u, int wr, int wc, int fr, int fq) const {
        bf16_t* C = (bf16_t*)desc_p(lds, u.aux, 4); const int ldc = desc_i(lds, u.aux, 7), act = desc_i(lds, u.aux, 8);
        const int col0 = u.pn * 256 + wc * 32 + 8 * fq, row0 = u.pm * 256 + wr * 64 + fr;
#pragma unroll
        for (int ai = 0; ai < 2; ++ai)
#pragma unroll
            for (int m = 0; m < 4; ++m) { bf16_t* rowp = C + (size_t)(row0 + ai * 128 + m * 16) * ldc + col0;
#pragma unroll
                for (int bj = 0; bj < 2; ++bj) { f32x4 v0 = acc[ai][bj][m][0], v1 = acc[ai][bj][m][1];
                    if (act == 1) {
#pragma unroll
                        for (int j = 0; j < 4; ++j) { v0[j] = tanhf_(v0[j]); v1[j] = tanhf_(v1[j]); } }
                    else if (act == 2) {
#pragma unroll
                        for (int j = 0; j < 4; ++j) { v0[j] = sigmoidf_(v0[j]); v1[j] = sigmoidf_(v1[j]); } }
                    u32x4 w; w.x = cvt_pk_bf16(v0[0], v0[1]); w.y = cvt_pk_bf16(v0[2], v0[3]); w.z = cvt_pk_bf16(v1[0], v1[1]); w.w = cvt_pk_bf16(v1[2], v1[3]);
                    *(u32x4*)(rowp + bj * 128) = w; } }
    }
};
struct EpiLora2 {
    static constexpr bool PERM = true;
    LAS unsigned char* lds;
    __device__ __forceinline__ void operator()(const f32x4 (&acc)[2][2][4][2], const Unit& u, int wr, int wc, int fr, int fq) const {
        bf16_t* C = (bf16_t*)desc_p(lds, u.aux, 4);
        const int col0 = u.pn * 256 + wc * 32 + 8 * fq, row0 = u.pm * 256 + wr * 64 + fr;
        const float* pv = u.aux < 4 ? (const float*)desc_p(lds, u.aux, 10) : (const float*)desc_p(lds, 5, 10); bf16_t* C2 = (bf16_t*)desc_p(lds, u.aux, 12);
        const float* k_a = (const float*)desc_p(lds, 5, 10); const bf16_t* Kb = (const bf16_t*)desc_p(lds, 5, 12);
#pragma unroll
        for (int bj = 0; bj < 2; ++bj) { const f32x4 p0 = *(const f32x4*)(pv + col0 + bj * 128), p1 = *(const f32x4*)(pv + col0 + bj * 128 + 4);
            const f32x4 ka0 = *(const f32x4*)(k_a + col0 + bj * 128), ka1 = *(const f32x4*)(k_a + col0 + bj * 128 + 4);
#pragma unroll
            for (int ai = 0; ai < 2; ++ai)
#pragma unroll
                for (int m = 0; m < 4; ++m) { const size_t ro = (size_t)(row0 + ai * 128 + m * 16) * D + col0 + bj * 128;
                    f32x4 v0 = acc[ai][bj][m][0], v1 = acc[ai][bj][m][1];
                    if (u.aux < 2) {
#pragma unroll
                        for (int j = 0; j < 4; ++j) { const float x0 = -(p0[j] + v0[j]), x1 = -(p1[j] + v1[j]);
                            const float s0 = fmaxf(x0, 0.f) + __logf(1.0f + __expf(-fabsf(x0))), s1 = fmaxf(x1, 0.f) + __logf(1.0f + __expf(-fabsf(x1)));
                            v0[j] = -__expf(-s0 - 0.5f); v1[j] = -__expf(-s1 - 0.5f); }
                    } else if (u.aux < 4) {
                        const u32x4 kw = *(const u32x4*)(Kb + ro); f32x4 a0v, a1v;
#pragma unroll
                        for (int j = 0; j < 4; ++j) { a0v[j] = sigmoidf_(p0[j] + v0[j]); a1v[j] = sigmoidf_(p1[j] + v1[j]); }
                        v0[0] = bf_lo(kw.x) * (1.0f + (a0v[0] - 1.0f) * ka0[0]); v0[1] = bf_hi(kw.x) * (1.0f + (a0v[1] - 1.0f) * ka0[1]);
                        v0[2] = bf_lo(kw.y) * (1.0f + (a0v[2] - 1.0f) * ka0[2]); v0[3] = bf_hi(kw.y) * (1.0f + (a0v[3] - 1.0f) * ka0[3]);
                        v1[0] = bf_lo(kw.z) * (1.0f + (a1v[0] - 1.0f) * ka1[0]); v1[1] = bf_hi(kw.z) * (1.0f + (a1v[1] - 1.0f) * ka1[1]);
                        v1[2] = bf_lo(kw.w) * (1.0f + (a1v[2] - 1.0f) * ka1[2]); v1[3] = bf_hi(kw.w) * (1.0f + (a1v[3] - 1.0f) * ka1[3]);
                        u32x4 w2; w2.x = cvt_pk_bf16(a0v[0], a0v[1]); w2.y = cvt_pk_bf16(a0v[2], a0v[3]); w2.z = cvt_pk_bf16(a1v[0], a1v[1]); w2.w = cvt_pk_bf16(a1v[2], a1v[3]);
                        *(u32x4*)(C2 + ro) = w2;
                    }
                    u32x4 w; w.x = cvt_pk_bf16(v0[0], v0[1]); w.y = cvt_pk_bf16(v0[2], v0[3]); w.z = cvt_pk_bf16(v1[0], v1[1]); w.w = cvt_pk_bf16(v1[2], v1[3]);
                    *(u32x4*)(C + ro) = w; EPI_FENCE(); } }
    }
};
struct EpiSiluGate {
    static constexpr bool PERM = true;
    bf16_t* H;
    __device__ __forceinline__ void operator()(const f32x4 (&acc)[2][2][4][2], const Unit& u, int wr, int wc, int fr, int fq) const {
        const int col0 = u.pn * 128 + wc * 32 + 8 * fq, row0 = u.pm * 256 + wr * 64 + fr;
#pragma unroll
        for (int ai = 0; ai < 2; ++ai)
#pragma unroll
            for (int m = 0; m < 4; ++m) { f32x4 h0, h1;
#pragma unroll
                for (int j = 0; j < 4; ++j) { const float g0 = acc[ai][0][m][0][j], g1 = acc[ai][0][m][1][j]; h0[j] = g0 * sigmoidf_(g0) * acc[ai][1][m][0][j]; h1[j] = g1 * sigmoidf_(g1) * acc[ai][1][m][1][j]; }
                u32x4 w; w.x = cvt_pk_bf16(h0[0], h0[1]); w.y = cvt_pk_bf16(h0[2], h0[3]); w.z = cvt_pk_bf16(h1[0], h1[1]); w.w = cvt_pk_bf16(h1[2], h1[3]);
                *(u32x4*)(H + (size_t)(row0 + ai * 128 + m * 16) * EHID + col0) = w; }
    }
};
struct EpiScatter {
    static constexpr bool PERM = true;
    LAS unsigned char* lds; bf16_t* YB; const int* list;
    __device__ __forceinline__ void operator()(const f32x4 (&acc)[2][2][4][2], const Unit& u, int wr, int wc, int fr, int fq) const {
        LAS const int* tab = (LAS const int*)(lds + LDS_TAB);
        const int j0 = __builtin_amdgcn_readfirstlane(tab[MAXRT + u.pm]), cn = __builtin_amdgcn_readfirstlane(tab[2 * MAXRT + u.aux]);
        const int col0 = u.pn * 256 + wc * 32 + 8 * fq;
#pragma unroll
        for (int ai = 0; ai < 2; ++ai)
#pragma unroll
            for (int m = 0; m < 4; ++m) { const int slot = j0 + ai * 128 + wr * 64 + m * 16 + fr;
                if (slot < cn) { const int a = list[(size_t)u.aux * LISTCAP + slot]; bf16_t* rowp = YB + (size_t)a * D + col0;
#pragma unroll
                    for (int bj = 0; bj < 2; ++bj) { const f32x4 v0 = acc[ai][bj][m][0], v1 = acc[ai][bj][m][1];
                        u32x4 w; w.x = cvt_pk_bf16(v0[0], v0[1]); w.y = cvt_pk_bf16(v0[2], v0[3]); w.z = cvt_pk_bf16(v1[0], v1[1]); w.w = cvt_pk_bf16(v1[2], v1[3]);
                        *(u32x4*)(rowp + bj * 128) = w; } } }
    }
};

struct Params { const float* in[42]; float* out; unsigned char* ws; int ph_lo, ph_hi; };
enum { I_X = 0, I_C, I_CTX, I_CCTX, I_ADAW, I_ADAB, I_N1G, I_N2G, I_FG, I_GWIN, I_GBIN, I_GLNG, I_GLNB, I_GWS, I_GBS, I_GWOUT, I_GBOUT,
       I_MU, I_WR, I_WK, I_WV, I_WO, I_W0, I_W1, I_W2, I_A0, I_A1, I_A2, I_G1, I_G2, I_KK, I_KA, I_RK, I_LNG, I_LNB,
       I_MWGRP, I_MBGRP, I_MWEXP, I_MBEXP, I_MWG, I_MWU, I_MWD };
struct Frame { LAS unsigned char* lds; int tid, lane, wave, G, gw, NGW; };

__device__ __forceinline__ void tr_item(const float* W, int N, int kmax, bf16_t* WT, int ldk, int k0, int n0, int drow0, int dk0, LAS float* scr, int lane) {
#pragma unroll 8
    for (int i = 0; i < 32; ++i) { const int kk = 2 * i + (lane >> 5), k = k0 + kk; scr[kk * 33 + (lane & 31)] = k < kmax ? W[(size_t)k * N + n0 + (lane & 31)] : 0.f; }
    asm volatile("s_waitcnt lgkmcnt(0)" ::: "memory");
    const int c = lane & 7;
#pragma unroll
    for (int j = 0; j < 4; ++j) { const int n = (lane >> 3) + 8 * j; const LAS float* s = scr + (8 * c) * 33 + n;
        u32x4 o; o.x = cvt_pk_bf16(s[0 * 33], s[1 * 33]); o.y = cvt_pk_bf16(s[2 * 33], s[3 * 33]); o.z = cvt_pk_bf16(s[4 * 33], s[5 * 33]); o.w = cvt_pk_bf16(s[6 * 33], s[7 * 33]);
        *(u32x4*)(WT + (size_t)(drow0 + n) * ldk + dk0 + k0 + 8 * c) = o; }
    asm volatile("s_waitcnt lgkmcnt(0)" ::: "memory");
}
__device__ __forceinline__ void conv_T(const Frame& F, const float* W, int N, int kmax, int kpad, bf16_t* WT, int ldk, int drow0, int dk0, int ilv) {
    LAS float* scr = (LAS float*)(F.lds + F.wave * 8704);
    const int nnb = N / 32, nit = (kpad / 64) * nnb;
    for (int it = F.gw; it < nit; it += F.NGW) { const int kb = it / nnb, nb = it % nnb, n0 = nb * 32;
        const int dr = ilv == 0 ? n0 : (256 * (n0 >> 7) + (n0 & 127) + (ilv == 2 ? 128 : 0));
        tr_item(W, N, kmax, WT, ldk, kb * 64, n0, drow0 + dr, dk0, scr, F.lane); }
}
__device__ __forceinline__ void zero_fill(const Frame& F, bf16_t* p, size_t nbytes) {
    u32x4* q = (u32x4*)p; const size_t n = nbytes / 16;
    for (size_t i = (size_t)blockIdx.x * NTHR + F.tid; i < n; i += (size_t)F.G * NTHR) q[i] = (u32x4){0u, 0u, 0u, 0u};
}

__device__ __forceinline__ void prologue_phase(const Frame& F, const Params& P) {
    unsigned char* ws = P.ws;
    {   float* MOD = (float*)(ws + WS_MOD); LAS float* part = (LAS float*)F.lds;
        const float* c = P.in[I_C]; const float* cc = P.in[I_CCTX];
        for (int item = blockIdx.x; item < DEPTH * 96; item += F.G) {
            const int layer = item / 96, col = (item % 96) * 64 + F.lane; const float* w = P.in[I_ADAW] + (size_t)layer * D * 6 * D;
            float a0 = 0.f, a1 = 0.f, a2 = 0.f;
#pragma unroll 8
            for (int dd = 0; dd < 128; ++dd) { const int d = F.wave * 128 + dd; const float wv = w[(size_t)d * 6 * D + col];
                const float c0 = c[d], c1 = c[D + d], c2 = cc[d];
                a0 += c0 * sigmoidf_(c0) * wv; a1 += c1 * sigmoidf_(c1) * wv; a2 += c2 * sigmoidf_(c2) * wv; }
            part[(F.wave * 3 + 0) * 64 + F.lane] = a0; part[(F.wave * 3 + 1) * 64 + F.lane] = a1; part[(F.wave * 3 + 2) * 64 + F.lane] = a2;
            __syncthreads();
            if (F.wave < 3) { float s = 0.f;
#pragma unroll
                for (int w8 = 0; w8 < 8; ++w8) s += part[(w8 * 3 + F.wave) * 64 + F.lane];
                MOD[((size_t)layer * 3 + F.wave) * 6 * D + col] = s + P.in[I_ADAB][(size_t)layer * 6 * D + col]; }
            __syncthreads();
        }
    }
    for (int j = 0; j < 2; ++j) {
        conv_T(F, P.in[I_GWIN] + (size_t)j * D * 4096, 4096, D, D, (bf16_t*)(ws + WS_WIN) + (size_t)j * 4096 * D, D, 0, 0, 0);
        conv_T(F, P.in[I_GWOUT] + (size_t)j * GWID * D, D, GWID, GWID, (bf16_t*)(ws + WS_WOUT) + (size_t)j * D * GWID, GWID, 0, 0, 0);
        conv_T(F, P.in[I_WR] + (size_t)j * D * D, D, D, D, (bf16_t*)(ws + WS_WR) + (size_t)j * D * D, D, 0, 0, 0);
        conv_T(F, P.in[I_WK] + (size_t)j * D * D, D, D, D, (bf16_t*)(ws + WS_WK) + (size_t)j * D * D, D, 0, 0, 0);
        conv_T(F, P.in[I_WV] + (size_t)j * D * D, D, D, D, (bf16_t*)(ws + WS_WV) + (size_t)j * D * D, D, 0, 0, 0);
        conv_T(F, P.in[I_WO] + (size_t)j * D * D, D, D, D, (bf16_t*)(ws + WS_WO) + (size_t)j * D * D, D, 0, 0, 0);
        bf16_t* lw1 = (bf16_t*)(ws + WS_LW1) + (size_t)j * 256 * D; bf16_t* la1 = (bf16_t*)(ws + WS_LA1) + (size_t)j * 256 * D; bf16_t* lg1 = (bf16_t*)(ws + WS_LG1) + (size_t)j * 256 * D;
        for (int z = 0; z < 2; ++z) {
            conv_T(F, P.in[I_W1] + ((size_t)j * 2 + z) * D * 64, 64, D, D, lw1, D, z * 64, 0, 0);
            conv_T(F, P.in[I_A1] + ((size_t)j * 2 + z) * D * 64, 64, D, D, la1, D, z * 64, 0, 0);
            bf16_t* w2p = (bf16_t*)(ws + WS_W2P) + ((size_t)j * 2 + z) * D * 256; bf16_t* a2p = (bf16_t*)(ws + WS_A2P) + ((size_t)j * 2 + z) * D * 256;
            conv_T(F, P.in[I_W2] + ((size_t)j * 2 + z) * 64 * D, D, 64, 64, w2p, 256, 0, z * 64, 0);
            conv_T(F, P.in[I_A2] + ((size_t)j * 2 + z) * 64 * D, D, 64, 64, a2p, 256, 0, z * 64, 0);
            for (int idx = blockIdx.x * NTHR + F.tid; idx < D * 32; idx += F.G * NTHR) { const int n = idx >> 5, ch = idx & 31;
                if ((ch >> 3) != z) { *(u32x4*)(w2p + (size_t)n * 256 + ch * 8) = (u32x4){0u, 0u, 0u, 0u}; *(u32x4*)(a2p + (size_t)n * 256 + ch * 8) = (u32x4){0u, 0u, 0u, 0u}; } }
        }
        conv_T(F, P.in[I_G1] + (size_t)j * D * 160, 160, D, D, lg1, D, 0, 0, 0);
        zero_fill(F, lw1 + 128 * D, (size_t)128 * D * 2); zero_fill(F, la1 + 128 * D, (size_t)128 * D * 2); zero_fill(F, lg1 + 160 * D, (size_t)96 * D * 2);
        conv_T(F, P.in[I_G2] + (size_t)j * 160 * D, D, 160, 256, (bf16_t*)(ws + WS_G2P) + (size_t)j * D * 256, 256, 0, 0, 0);
    }
    {   const float* src = P.in[I_GWS]; bf16_t* dst = (bf16_t*)(ws + WS_WSP); const int n8 = 2 * 16 * 128 * 128 / 8;
        for (int i = blockIdx.x * NTHR + F.tid; i < n8; i += F.G * NTHR) { const f32x4 a = *(const f32x4*)(src + (size_t)i * 8), b = *(const f32x4*)(src + (size_t)i * 8 + 4);
            u32x4 o; o.x = cvt_pk_bf16(a[0], a[1]); o.y = cvt_pk_bf16(a[2], a[3]); o.z = cvt_pk_bf16(b[0], b[1]); o.w = cvt_pk_bf16(b[2], b[3]); *(u32x4*)(dst + (size_t)i * 8) = o; } }
}
__device__ __forceinline__ void moe_weights_phase(const Frame& F, const Params& P, int layer) {
    unsigned char* ws = P.ws;
    for (int e = 0; e < NE; ++e) {
        const size_t so = ((size_t)layer * NE + e) * (size_t)D * EHID;
        conv_T(F, P.in[I_MWG] + so, EHID, D, D, (bf16_t*)(ws + WS_WGU) + (size_t)e * D * D, D, 0, 0, 1);
        conv_T(F, P.in[I_MWU] + so, EHID, D, D, (bf16_t*)(ws + WS_WGU) + (size_t)e * D * D, D, 0, 0, 2);
        conv_T(F, P.in[I_MWD] + so, D, EHID, EHID, (bf16_t*)(ws + WS_WD) + (size_t)e * D * EHID, EHID, 0, 0, 0);
    }
}

__device__ __forceinline__ const float* xrow_ptr(const Params& P, int layer, int row) {
    if (layer == 0) return row < TL ? P.in[I_X] + (size_t)row * D : P.in[I_CTX] + (size_t)(row - TL) * D;
    return (const float*)(P.ws + WS_X) + (size_t)row * D;
}
__device__ __forceinline__ void load_combine(const Params& P, const Frame& F, int layer, int row, int m, bool combine, f32x4 (&v)[4]) {
    const float* xr = xrow_ptr(P, layer, row);
#pragma unroll
    for (int j = 0; j < 4; ++j) v[j] = *(const f32x4*)(xr + 4 * F.lane + 256 * j);
    if (combine) {
        const bf16_t* yb = (const bf16_t*)(P.ws + WS_YB); const float* wg = (const float*)(P.ws + WS_WGT);
        const float w0 = wg[2 * row], w1 = wg[2 * row + 1]; const float* g2 = (const float*)(P.ws + WS_MOD) + ((size_t)(layer - 1) * 3 + m) * 6 * D + 5 * D;
#pragma unroll
        for (int j = 0; j < 4; ++j) { const int col = 4 * F.lane + 256 * j; const u32x2 a = *(const u32x2*)(yb + (size_t)(2 * row) * D + col), b = *(const u32x2*)(yb + (size_t)(2 * row + 1) * D + col);
            const f32x4 g = *(const f32x4*)(g2 + col);
            v[j][0] += g[0] * (w0 * bf_lo(a.x) + w1 * bf_lo(b.x)); v[j][1] += g[1] * (w0 * bf_hi(a.x) + w1 * bf_hi(b.x));
            v[j][2] += g[2] * (w0 * bf_lo(a.y) + w1 * bf_lo(b.y)); v[j][3] += g[3] * (w0 * bf_hi(a.y) + w1 * bf_hi(b.y)); }
    }
}
__device__ __forceinline__ void norm1_phase(const Frame& F, const Params& P, int layer) {
    const bool combine = layer > 0; float* X = (float*)(P.ws + WS_X); bf16_t* HL = (bf16_t*)(P.ws + WS_HL);
    const float* g1 = P.in[I_N1G] + (size_t)layer * D;
    for (int row = F.gw; row < T; row += F.NGW) {
        const int m = row < TL ? (row >> 14) : 2; f32x4 v[4];
        load_combine(P, F, layer, row, m, combine, v);
        if (combine) {
#pragma unroll
            for (int j = 0; j < 4; ++j) *(f32x4*)(X + (size_t)row * D + 4 * F.lane + 256 * j) = v[j]; }
        float ss = 0.f;
#pragma unroll
        for (int j = 0; j < 4; ++j) ss += (v[j][0] * v[j][0] + v[j][1] * v[j][1]) + (v[j][2] * v[j][2] + v[j][3] * v[j][3]);
        const float rstd = rsqrtf(wave_sum(ss) * (1.0f / D) + 1e-6f);
        const float* mod = (const float*)(P.ws + WS_MOD) + ((size_t)layer * 3 + m) * 6 * D;
#pragma unroll
        for (int j = 0; j < 4; ++j) { const int col = 4 * F.lane + 256 * j; const f32x4 g = *(const f32x4*)(g1 + col), sh = *(const f32x4*)(mod + col), sc = *(const f32x4*)(mod + D + col);
            const f32x4 h = (v[j] * rstd) * g * (sc + 1.0f) + sh;
            u32x2 o; o.x = cvt_pk_bf16(h[0], h[1]); o.y = cvt_pk_bf16(h[2], h[3]); *(u32x2*)(HL + (size_t)row * D + col) = o; }
    }
}
__device__ __forceinline__ void final_phase(const Frame& F, const Params& P) {
    const float* fg = P.in[I_FG];
    for (int row = F.gw; row < TL; row += F.NGW) {
        const int m = row >> 14; f32x4 v[4];
        load_combine(P, F, DEPTH, row, m, true, v);
        float ss = 0.f;
#pragma unroll
        for (int j = 0; j < 4; ++j) ss += (v[j][0] * v[j][0] + v[j][1] * v[j][1]) + (v[j][2] * v[j][2] + v[j][3] * v[j][3]);
        const float rstd = rsqrtf(wave_sum(ss) * (1.0f / D) + 1e-6f);
#pragma unroll
        for (int j = 0; j < 4; ++j) { const int col = 4 * F.lane + 256 * j; *(f32x4*)(P.out + (size_t)row * D + col) = (v[j] * rstd) * *(const f32x4*)(fg + col); }
    }
}
__device__ __forceinline__ void route_phase(const Frame& F, const Params& P, int layer) {
    const int ntok = layer == DEPTH - 1 ? TL : T; bf16_t* HL2 = (bf16_t*)(P.ws + WS_HL);
    const float* g2n = P.in[I_N2G] + (size_t)layer * D; const float* wgrp = P.in[I_MWGRP] + (size_t)layer * D * 4; const float* wexp = P.in[I_MWEXP] + (size_t)layer * D * NE;
    const float* bgrp = P.in[I_MBGRP] + layer * 4; const float* bexp = P.in[I_MBEXP] + layer * NE;
    unsigned* cnt = (unsigned*)(P.ws + WS_CTL) + CW_CNT + layer * 64; int* list = (int*)(P.ws + WS_LIST); float* wgt = (float*)(P.ws + WS_WGT);
    LAS float* hs = (LAS float*)F.lds + F.wave * 2 * D;
    for (int pr = F.gw; pr < ntok / 2; pr += F.NGW) {
        f32x4 h[2][4];
#pragma unroll
        for (int r = 0; r < 2; ++r) { const int row = 2 * pr + r; const int m = row < TL ? (row >> 14) : 2; const float* xr = xrow_ptr(P, 1, row);
#pragma unroll
            for (int j = 0; j < 4; ++j) h[r][j] = *(const f32x4*)(xr + 4 * F.lane + 256 * j);
            float ss = 0.f;
#pragma unroll
            for (int j = 0; j < 4; ++j) ss += (h[r][j][0] * h[r][j][0] + h[r][j][1] * h[r][j][1]) + (h[r][j][2] * h[r][j][2] + h[r][j][3] * h[r][j][3]);
            const float rstd = rsqrtf(wave_sum(ss) * (1.0f / D) + 1e-6f);
            const float* mod = (const float*)(P.ws + WS_MOD) + ((size_t)layer * 3 + m) * 6 * D;
#pragma unroll
            for (int j = 0; j < 4; ++j) { const int col = 4 * F.lane + 256 * j; const f32x4 g = *(const f32x4*)(g2n + col), sh = *(const f32x4*)(mod + 3 * D + col), sc = *(const f32x4*)(mod + 4 * D + col);
                h[r][j] = (h[r][j] * rstd) * g * (sc + 1.0f) + sh;
                u32x2 o; o.x = cvt_pk_bf16(h[r][j][0], h[r][j][1]); o.y = cvt_pk_bf16(h[r][j][2], h[r][j][3]); *(u32x2*)(HL2 + (size_t)row * D + col) = o; } }
        float ag[2][4], ae[2][NE];
#pragma unroll
        for (int r = 0; r < 2; ++r) {
#pragma unroll
            for (int i = 0; i < 4; ++i) ag[r][i] = 0.f;
#pragma unroll
            for (int i = 0; i < NE; ++i) ae[r][i] = 0.f; }
#pragma unroll
        for (int r = 0; r < 2; ++r)
#pragma unroll
            for (int j = 0; j < 4; ++j) *(LAS f32x4*)(hs + r * D + 4 * F.lane + 256 * j) = h[r][j];
        asm volatile("s_waitcnt lgkmcnt(0)" ::: "memory");
        {   const float* gp = wgrp + (size_t)F.lane * 4; const float* wp = wexp + (size_t)F.lane * NE;
#pragma unroll 2
            for (int it = 0; it < 16; ++it) { const float h0 = hs[F.lane + 64 * it], h1 = hs[D + F.lane + 64 * it];
                const f32x4 wg = *(const f32x4*)gp;
#pragma unroll
                for (int i = 0; i < 4; ++i) { ag[0][i] += h0 * wg[i]; ag[1][i] += h1 * wg[i]; }
#pragma unroll
                for (int q = 0; q < 8; ++q) { const f32x4 we = *(const f32x4*)(wp + 4 * q);
#pragma unroll
                    for (int i = 0; i < 4; ++i) { ae[0][4 * q + i] += h0 * we[i]; ae[1][4 * q + i] += h1 * we[i]; } }
                gp += 64 * 4; wp += 64 * NE; }
        }
        asm volatile("s_waitcnt lgkmcnt(0)" ::: "memory");
#pragma unroll
        for (int r = 0; r < 2; ++r) {
#pragma unroll
            for (int i = 0; i < 4; ++i) ag[r][i] = wave_sum(ag[r][i]) + bgrp[i];
#pragma unroll
            for (int i = 0; i < NE; ++i) ae[r][i] = wave_sum(ae[r][i]) + bexp[i];
            int grp = 0; float mx = ag[r][0];
#pragma unroll
            for (int i = 1; i < 4; ++i) if (ag[r][i] > mx) { mx = ag[r][i]; grp = i; }
            float den = 0.f;
#pragma unroll
            for (int i = 0; i < 4; ++i) den += __expf(ag[r][i] - mx);
            const float pg = 1.0f / den;
            float el[8];
#pragma unroll
            for (int i = 0; i < 8; ++i) { el[i] = ae[r][i];
#pragma unroll
                for (int g = 1; g < 4; ++g) if (grp == g) el[i] = ae[r][8 * g + i]; }
            int i0 = 0; float t0 = el[0];
#pragma unroll
            for (int i = 1; i < 8; ++i) if (el[i] > t0) { t0 = el[i]; i0 = i; }
            int i1 = -1; float t1 = -3.0e38f;
#pragma unroll
            for (int i = 0; i < 8; ++i) if (i != i0 && el[i] > t1) { t1 = el[i]; i1 = i; }
            const float p0 = 1.0f / (1.0f + __expf(t1 - t0)), w0 = pg * p0, w1 = pg * (1.0f - p0);
            if (F.lane == 0) { const int row = 2 * pr + r; const int e0 = grp * 8 + i0, e1 = grp * 8 + i1;
                const unsigned s0 = atomicAdd(cnt + e0, 1u), s1 = atomicAdd(cnt + e1, 1u);
                list[(size_t)e0 * LISTCAP + s0] = 2 * row; list[(size_t)e1 * LISTCAP + s1] = 2 * row + 1; wgt[2 * row] = w0; wgt[2 * row + 1] = w1; }
        }
    }
    __syncthreads();
    moe_weights_phase(F, P, layer);
}

__device__ __forceinline__ void spatial_phase(const Frame& F, const Params& P, int j) {
    bf16_t* U = (bf16_t*)(P.ws + WS_U); const bf16_t* V = (const bf16_t*)(P.ws + WS_V); const float* stat = (const float*)(P.ws + WS_STAT);
    const bf16_t* WSP = (const bf16_t*)(P.ws + WS_WSP) + (size_t)j * 16 * 128 * 128;
    const float* lng = P.in[I_GLNG] + (size_t)j * GWID; const float* lnb = P.in[I_GLNB] + (size_t)j * GWID; const float* bs = P.in[I_GBS] + (size_t)j * 16 * 128;
    LAS bf16_t* Wt = (LAS bf16_t*)F.lds; LAS bf16_t* Vt = Wt + 128 * 136;
    LAS float* mu = (LAS float*)(F.lds + 2 * 128 * 136 * 2); LAS float* rs = mu + 128;
    const int l15 = F.lane & 15, l4 = F.lane >> 4;
    for (int item = blockIdx.x; item < (T / 128) * 16; item += F.G) {
        const int c = item >> 4, g = item & 15, t0 = c * 128;
        __syncthreads();
        if (F.tid < 128) { const int row = t0 + F.tid; float s = 0.f, q = 0.f;
#pragma unroll 8
            for (int i = 0; i < 32; ++i) { const f32x2 p = *(const f32x2*)(stat + ((size_t)row * 32 + i) * 2); s += p.x; q += p.y; }
            const float mean = s * (1.0f / GWID), var = q * (1.0f / GWID) - mean * mean; mu[F.tid] = mean; rs[F.tid] = rsqrtf(var + 1e-5f); }
#pragma unroll
        for (int i = 0; i < 4; ++i) { const int idx = F.tid + NTHR * i, p = idx >> 4, seg = idx & 15;
            *(LAS u32x4*)(Wt + p * 136 + seg * 8) = *(const u32x4*)(WSP + ((size_t)g * 128 + p) * 128 + seg * 8); }
        __syncthreads();
#pragma unroll
        for (int i = 0; i < 4; ++i) { const int idx = F.tid + NTHR * i, q = idx >> 4, seg = idx & 15, ch = g * 128 + seg * 8;
            const u32x4 raw = *(const u32x4*)(V + (size_t)(t0 + q) * GWID + ch); const unsigned rw[4] = {raw.x, raw.y, raw.z, raw.w};
            const float m_ = mu[q], r_ = rs[q];
#pragma unroll
            for (int e = 0; e < 8; ++e) { const float x = (e & 1) ? bf_hi(rw[e >> 1]) : bf_lo(rw[e >> 1]);
                Vt[(seg * 8 + e) * 136 + q] = f2bf((x - m_) * r_ * lng[ch + e] + lnb[ch + e]); } }
        __syncthreads();
        bf16x8 bw[4];
#pragma unroll
        for (int ks = 0; ks < 4; ++ks) bw[ks] = *(const LAS bf16x8*)(Wt + (16 * F.wave + l15) * 136 + ks * 32 + 8 * l4);
        const int p = 16 * F.wave + l15; const float bias = bs[g * 128 + p];
#pragma unroll
        for (int dt = 0; dt < 8; ++dt) { f32x4 acc = (f32x4){0.f, 0.f, 0.f, 0.f};
#pragma unroll
            for (int ks = 0; ks < 4; ++ks) { const bf16x8 a = *(const LAS bf16x8*)(Vt + (dt * 16 + l15) * 136 + ks * 32 + 8 * l4); acc = __builtin_amdgcn_mfma_f32_16x16x32_bf16(a, bw[ks], acc, 0, 0, 0); }
            bf16_t* up = U + (size_t)(t0 + p) * GWID + g * 128 + dt * 16 + 4 * l4; const u32x2 uu = *(const u32x2*)up;
            u32x2 o; o.x = cvt_pk_bf16(bf_lo(uu.x) * (acc[0] + bias), bf_hi(uu.x) * (acc[1] + bias)); o.y = cvt_pk_bf16(bf_lo(uu.y) * (acc[2] + bias), bf_hi(uu.y) * (acc[3] + bias));
            *(u32x2*)up = o; }
    }
}

__device__ __forceinline__ void mix_phase(const Frame& F, const Params& P, int j) {
    const bf16_t* HL = (const bf16_t*)(P.ws + WS_HL); const float* mu = P.in[I_MU] + (size_t)j * 6 * D;
    bf16_t* outs[6] = {(bf16_t*)(P.ws + WS_XR), (bf16_t*)(P.ws + WS_XW), (bf16_t*)(P.ws + WS_XK), (bf16_t*)(P.ws + WS_XV), (bf16_t*)(P.ws + WS_XA), (bf16_t*)(P.ws + WS_XG)};
    for (int row = F.gw; row < T; row += F.NGW) {
        bool ok[2]; int src[2]; const bool hi = F.lane >= 32;
        if (row < TL) { const int n = row & (SEQ - 1), gc = n & 63, gr = n >> 6;
            ok[0] = hi ? gc < 63 : gc > 0; src[0] = hi ? row + 1 : row - 1; ok[1] = hi ? gr < 255 : gr > 0; src[1] = hi ? row + 64 : row - 64; }
        else { const int n = (row - TL) & (CTXL - 1); ok[0] = n > 0; src[0] = row - 1; ok[1] = n < CTXL - 1; src[1] = row + 1; }
#pragma unroll
        for (int jj = 0; jj < 2; ++jj) { const int col = 512 * jj + 8 * F.lane;
            const u32x4 h8 = *(const u32x4*)(HL + (size_t)row * D + col); u32x4 s8 = (u32x4){0u, 0u, 0u, 0u};
            if (ok[jj]) s8 = *(const u32x4*)(HL + (size_t)src[jj] * D + col);
            const unsigned hw[4] = {h8.x, h8.y, h8.z, h8.w}, sw[4] = {s8.x, s8.y, s8.z, s8.w}; float h[8], xx[8];
#pragma unroll
            for (int e = 0; e < 8; ++e) { h[e] = (e & 1) ? bf_hi(hw[e >> 1]) : bf_lo(hw[e >> 1]); const float s = (e & 1) ? bf_hi(sw[e >> 1]) : bf_lo(sw[e >> 1]); xx[e] = s - h[e]; }
#pragma unroll
            for (int m = 0; m < 6; ++m) { const f32x4 ma = *(const f32x4*)(mu + (size_t)m * D + col), mb = *(const f32x4*)(mu + (size_t)m * D + col + 4);
                u32x4 o; o.x = cvt_pk_bf16(h[0] + xx[0] * ma[0], h[1] + xx[1] * ma[1]); o.y = cvt_pk_bf16(h[2] + xx[2] * ma[2], h[3] + xx[3] * ma[3]);
                o.z = cvt_pk_bf16(h[4] + xx[4] * mb[0], h[5] + xx[5] * mb[1]); o.w = cvt_pk_bf16(h[6] + xx[6] * mb[2], h[7] + xx[7] * mb[3]);
                *(u32x4*)(outs[m] + (size_t)row * D + col) = o; } }
    }
}

__device__ __forceinline__ int scan_row(int z, int b, int p) {
    if (p < CTXL) return TL + b * CTXL + (z ? CTXL - 1 - p : p);
    const int q = p - CTXL; return b * SEQ + (z ? SEQ - 1 - q : q);
}
__device__ __forceinline__ void scan_phase(const Frame& F, const Params& P, int j) {
    if (blockIdx.x >= 64 || F.wave != 0) return;
    const int s = blockIdx.x, z = s >> 5, b = (s >> 4) & 1, hh = s & 15, ch = hh * 64 + F.lane;
    const bf16_t* Rb = (const bf16_t*)(P.ws + WS_R); const bf16_t* Kb = (const bf16_t*)(P.ws + WS_K); const bf16_t* Vb = (const bf16_t*)(P.ws + WS_VV);
    bf16_t* EL = (bf16_t*)(P.ws + (z ? WS_ELOG1 : WS_ELOG0)); const bf16_t* KM = (const bf16_t*)(P.ws + (z ? WS_KM1 : WS_KM0)); const bf16_t* AS = (const bf16_t*)(P.ws + (z ? WS_AS1 : WS_AS0));
    const float kkw = P.in[I_KK][(size_t)j * D + ch];
    float S[64];
#pragma unroll
    for (int k = 0; k < 64; ++k) S[k] = 0.f;
    const int NSTEP = CTXL + SEQ;
    size_t o = (size_t)scan_row(z, b, 0) * D + ch;
    bf16_t nr = Rb[o], nk = Kb[o], nv = Vb[o], ne = EL[o], nm = KM[o], na = AS[o];
    for (int p = 0; p < NSTEP; ++p) {
        const size_t oc = o; const float r = bf1(nr), k = bf1(nk), v = bf1(nv), el = bf1(ne), km = bf1(nm), as = bf1(na);
        if (p + 1 < NSTEP) { o = (size_t)scan_row(z, b, p + 1) * D + ch; nr = Rb[o]; nk = Kb[o]; nv = Vb[o]; ne = EL[o]; nm = KM[o]; na = AS[o]; }
        const float kr = k * kkw; const float kk = kr * rsqrtf(wave_sum(kr * kr) + 1e-12f);
        const float w = __expf(el), av = -kk, bv = kk * as;
        float sa = 0.f;
#pragma unroll
        for (int q = 0; q < 64; ++q) sa += S[q] * __int_as_float(__builtin_amdgcn_readlane(__float_as_int(av), q));
        float y = 0.f;
#pragma unroll
        for (int q = 0; q < 64; ++q) {
            const float wq = __int_as_float(__builtin_amdgcn_readlane(__float_as_int(w), q)), bq = __int_as_float(__builtin_amdgcn_readlane(__float_as_int(bv), q));
            const float kq = __int_as_float(__builtin_amdgcn_readlane(__float_as_int(km), q)), rq = __int_as_float(__builtin_amdgcn_readlane(__float_as_int(r), q));
            S[q] = S[q] * wq + sa * bq + v * kq; y += S[q] * rq; }
        EL[oc] = f2bf(y);
    }
}

__device__ __forceinline__ void rwkv_out_phase(const Frame& F, const Params& P, int j) {
    const bf16_t* Y0 = (const bf16_t*)(P.ws + WS_ELOG0); const bf16_t* Y1 = (const bf16_t*)(P.ws + WS_ELOG1); const bf16_t* Rb = (const bf16_t*)(P.ws + WS_R); const bf16_t* Vb = (const bf16_t*)(P.ws + WS_VV);
    const bf16_t* KM0 = (const bf16_t*)(P.ws + WS_KM0); const bf16_t* KM1 = (const bf16_t*)(P.ws + WS_KM1); const bf16_t* GT = (const bf16_t*)(P.ws + WS_GATE); bf16_t* YG = (bf16_t*)(P.ws + WS_YG);
    const float* lng = P.in[I_LNG] + (size_t)j * D; const float* lnb = P.in[I_LNB] + (size_t)j * D; const float* rk = P.in[I_RK] + (size_t)j * D;
    for (int row = F.gw; row < T; row += F.NGW) {
        const size_t o = (size_t)row * D + 16 * F.lane; float y[16], r[16], km[16], v[16], g[16];
#pragma unroll
        for (int hx = 0; hx < 2; ++hx) { const u32x4 a = *(const u32x4*)(Y0 + o + 8 * hx), b = *(const u32x4*)(Y1 + o + 8 * hx), c = *(const u32x4*)(Rb + o + 8 * hx), d = *(const u32x4*)(KM0 + o + 8 * hx),
                e = *(const u32x4*)(KM1 + o + 8 * hx), f = *(const u32x4*)(Vb + o + 8 * hx), gg = *(const u32x4*)(GT + o + 8 * hx);
            const unsigned aw[4] = {a.x, a.y, a.z, a.w}, bw[4] = {b.x, b.y, b.z, b.w}, cw[4] = {c.x, c.y, c.z, c.w}, dw[4] = {d.x, d.y, d.z, d.w}, ew[4] = {e.x, e.y, e.z, e.w}, fw[4] = {f.x, f.y, f.z, f.w}, gw4[4] = {gg.x, gg.y, gg.z, gg.w};
#pragma unroll
            for (int i = 0; i < 8; ++i) { const int q = i >> 1; const bool od = i & 1;
                y[8 * hx + i] = (od ? bf_hi(aw[q]) : bf_lo(aw[q])) + (od ? bf_hi(bw[q]) : bf_lo(bw[q])); r[8 * hx + i] = od ? bf_hi(cw[q]) : bf_lo(cw[q]);
                km[8 * hx + i] = (od ? bf_hi(dw[q]) : bf_lo(dw[q])) + (od ? bf_hi(ew[q]) : bf_lo(ew[q])); v[8 * hx + i] = od ? bf_hi(fw[q]) : bf_lo(fw[q]); g[8 * hx + i] = od ? bf_hi(gw4[q]) : bf_lo(gw4[q]); } }
        float s = 0.f, bn = 0.f;
#pragma unroll
        for (int i = 0; i < 16; ++i) { s += y[i]; bn += r[i] * rk[16 * F.lane + i] * km[i]; }
        s += __shfl_xor(s, 1); s += __shfl_xor(s, 2); bn += __shfl_xor(bn, 1); bn += __shfl_xor(bn, 2);
        const float mean = s * (1.0f / 64.0f); float q = 0.f;
#pragma unroll
        for (int i = 0; i < 16; ++i) { const float d = y[i] - mean; q += d * d; }
        q += __shfl_xor(q, 1); q += __shfl_xor(q, 2);
        const float rstd = rsqrtf(q * (1.0f / 64.0f) + 64e-5f);
        float ov[16];
#pragma unroll
        for (int i = 0; i < 16; ++i) { const int cix = 16 * F.lane + i; ov[i] = (((y[i] - mean) * rstd) * lng[cix] + lnb[cix] + bn * v[i]) * g[i]; }
#pragma unroll
        for (int hx = 0; hx < 2; ++hx) { u32x4 w; w.x = cvt_pk_bf16(ov[8 * hx], ov[8 * hx + 1]); w.y = cvt_pk_bf16(ov[8 * hx + 2], ov[8 * hx + 3]); w.z = cvt_pk_bf16(ov[8 * hx + 4], ov[8 * hx + 5]); w.w = cvt_pk_bf16(ov[8 * hx + 6], ov[8 * hx + 7]);
            *(u32x4*)(YG + o + 8 * hx) = w; }
    }
}

__device__ __forceinline__ bool in_range(int lo, int hi, int k) { asm volatile("" : "+s"(lo), "+s"(hi)); return lo <= k && k < hi; }
constexpr int NPH = 36;
template <unsigned KMASK> __global__ void __launch_bounds__(NTHR, 2) mega(Params P) {
    extern __shared__ __attribute__((aligned(16))) unsigned char lds_raw[];
    Frame F; F.lds = (LAS unsigned char*)lds_raw; F.tid = threadIdx.x; F.lane = F.tid & 63; F.wave = __builtin_amdgcn_readfirstlane(F.tid >> 6);
    F.G = gridDim.x; F.gw = blockIdx.x * NWAVES + F.wave; F.NGW = F.G * NWAVES;
    LAS unsigned* misc = (LAS unsigned*)(F.lds + LDS_MISC);
    if (F.tid < 128) misc[F.tid] = 0u;
    __syncthreads();
    unsigned char* ws = P.ws; unsigned* ctl = (unsigned*)(ws + WS_CTL);
    const int lo = P.ph_lo, hi = P.ph_hi;
    XcdBarrier bar; bar.bar = ctl + CW_BAR; bar.x = 0; bar.st = (volatile LAS unsigned*)(misc + 8);
    if (hi - lo > 1) bar = xcd_barrier_post(ctl + CW_BAR, (volatile LAS unsigned*)(misc + 8));
#define IN(k) in_range(lo, hi, (k))
#define KIND(q) ((KMASK >> (q)) & 1u)
#define SEAM(k) do { if (IN(k) && IN((k) + 1)) xcd_barrier(bar); } while (0)

    if constexpr (KIND(0)) if (IN(0)) prologue_phase(F, P);
    SEAM(0);
    for (int lp = 0; lp < 2; ++lp) {
        const int pb = 1 + 17 * lp, la = 2 * lp, lb = 2 * lp + 1;
        if constexpr (KIND(1)) if (IN(pb + 0)) norm1_phase(F, P, la);
        SEAM(pb + 0);
        if constexpr (KIND(2)) if (IN(pb + 1)) {
            __syncthreads(); set_desc(F.lds, 0, ws + WS_HL, ws + WS_WIN + (size_t)lp * 4096 * D * 2, ws + WS_U, 16, 0, 0, ws + WS_V, P.in[I_GBIN] + (size_t)lp * 4096, ws + WS_STAT); __syncthreads();
            SchedMulti<D, D> S{F.lds, T / 256, 16, 1};
            EpiGelu E{F.lds};
            pg8::gemm_phase<EpiGelu, SchedMulti<D, D>, false, D, D, D>(F.lds, S, E);
        }
        SEAM(pb + 1);
        if constexpr (KIND(3)) if (IN(pb + 2)) spatial_phase(F, P, lp);
        SEAM(pb + 2);
        if constexpr (KIND(4)) if (IN(pb + 3)) {
            __syncthreads(); { float* X = (float*)(ws + WS_X);
              set_desc(F.lds, 0, ws + WS_U, ws + WS_WOUT + (size_t)lp * D * GWID * 2, X, 4, 0, 0, la == 0 ? P.in[I_X] : X, la == 0 ? P.in[I_CTX] : X + (size_t)TL * D, P.in[I_GBOUT] + (size_t)lp * D);
              set_desc(F.lds, 1, nullptr, nullptr, nullptr, 0, 0, 0, (const float*)(ws + WS_MOD) + (size_t)la * 3 * 6 * D + 2 * D); }
            __syncthreads();
            SchedMulti<GWID, GWID> S{F.lds, T / 256, 4, 1};
            EpiResid E{F.lds};
            pg8::gemm_phase<EpiResid, SchedMulti<GWID, GWID>, false, GWID, GWID, GWID>(F.lds, S, E);
        }
        SEAM(pb + 3);
        if constexpr (KIND(5)) if (IN(pb + 4)) route_phase(F, P, la);
        SEAM(pb + 4);
        if constexpr (KIND(6)) if (IN(pb + 5)) {
            moe_tables(F.lds, ctl + CW_CNT + la * 64);
            SchedMoE<D, D, true> S{F.lds, (const char*)(ws + WS_HL), (const char*)(ws + WS_WGU), (const int*)(ws + WS_LIST)};
            EpiSiluGate E{(bf16_t*)(ws + WS_H)};
            pg8::gemm_phase<EpiSiluGate, SchedMoE<D, D, true>, true, D, D, D>(F.lds, S, E);
        }
        SEAM(pb + 5);
        if constexpr (KIND(7)) if (IN(pb + 6)) {
            moe_tables(F.lds, ctl + CW_CNT + la * 64);
            SchedMoE<EHID, EHID, false> S{F.lds, (const char*)(ws + WS_H), (const char*)(ws + WS_WD), (const int*)(ws + WS_LIST)};
            EpiScatter E{F.lds, (bf16_t*)(ws + WS_YB), (const int*)(ws + WS_LIST)};
            pg8::gemm_phase<EpiScatter, SchedMoE<EHID, EHID, false>, false, EHID, EHID, EHID>(F.lds, S, E);
        }
        SEAM(pb + 6);
        if constexpr (KIND(1)) if (IN(pb + 7)) norm1_phase(F, P, lb);
        SEAM(pb + 7);
        if constexpr (KIND(8)) if (IN(pb + 8)) mix_phase(F, P, lp);
        SEAM(pb + 8);
        if constexpr (KIND(9)) if (IN(pb + 9)) {
            __syncthreads();
            set_desc(F.lds, 0, ws + WS_XR, ws + WS_WR + (size_t)lp * D * D * 2, ws + WS_R, 4, D, 0);
            set_desc(F.lds, 1, ws + WS_XK, ws + WS_WK + (size_t)lp * D * D * 2, ws + WS_K, 4, D, 0);
            set_desc(F.lds, 2, ws + WS_XV, ws + WS_WV + (size_t)lp * D * D * 2, ws + WS_VV, 4, D, 0);
            set_desc(F.lds, 3, ws + WS_XW, ws + WS_LW1 + (size_t)lp * 256 * D * 2, ws + WS_TW, 1, 256, 1);
            set_desc(F.lds, 4, ws + WS_XA, ws + WS_LA1 + (size_t)lp * 256 * D * 2, ws + WS_TA, 1, 256, 0);
            set_desc(F.lds, 5, ws + WS_XG, ws + WS_LG1 + (size_t)lp * 256 * D * 2, ws + WS_TG, 1, 256, 2);
            __syncthreads();
            SchedMulti<D, D> S{F.lds, T / 256, 15, 6};
            EpiAct E{F.lds};
            pg8::gemm_phase<EpiAct, SchedMulti<D, D>, false, D, D, D>(F.lds, S, E);
        }
        SEAM(pb + 9);
        if constexpr (KIND(10)) if (IN(pb + 10)) {
            __syncthreads();
            set_desc(F.lds, 0, ws + WS_TW, ws + WS_W2P + ((size_t)lp * 2 + 0) * D * 256 * 2, ws + WS_ELOG0, 4, D, 0, P.in[I_W0] + (size_t)lp * 2 * D, nullptr);
            set_desc(F.lds, 1, ws + WS_TW, ws + WS_W2P + ((size_t)lp * 2 + 1) * D * 256 * 2, ws + WS_ELOG1, 4, D, 1, P.in[I_W0] + (size_t)lp * 2 * D + D, nullptr);
            set_desc(F.lds, 2, ws + WS_TA, ws + WS_A2P + ((size_t)lp * 2 + 0) * D * 256 * 2, ws + WS_KM0, 4, D, 2, P.in[I_A0] + (size_t)lp * 2 * D, ws + WS_AS0);
            set_desc(F.lds, 3, ws + WS_TA, ws + WS_A2P + ((size_t)lp * 2 + 1) * D * 256 * 2, ws + WS_KM1, 4, D, 3, P.in[I_A0] + (size_t)lp * 2 * D + D, ws + WS_AS1);
            set_desc(F.lds, 4, ws + WS_TG, ws + WS_G2P + (size_t)lp * D * 256 * 2, ws + WS_GATE, 4, D, 4);
            set_desc(F.lds, 5, nullptr, nullptr, nullptr, 0, 0, 0, P.in[I_KA] + (size_t)lp * D, ws + WS_K);
            __syncthreads();
            SchedMulti<256, 256> S{F.lds, T / 256, 20, 5};
            EpiLora2 E{F.lds};
            pg8::gemm_phase<EpiLora2, SchedMulti<256, 256>, false, 256, 256, 256>(F.lds, S, E);
        }
        SEAM(pb + 10);
        if constexpr (KIND(11)) if (IN(pb + 11)) scan_phase(F, P, lp);
        SEAM(pb + 11);
        if constexpr (KIND(12)) if (IN(pb + 12)) rwkv_out_phase(F, P, lp);
        SEAM(pb + 12);
        if constexpr (KIND(4)) if (IN(pb + 13)) {
            __syncthreads(); { float* X = (float*)(ws + WS_X);
              set_desc(F.lds, 0, ws + WS_YG, ws + WS_WO + (size_t)lp * D * D * 2, X, 4, 0, 0, X, X + (size_t)TL * D, nullptr);
              set_desc(F.lds, 1, nullptr, nullptr, nullptr, 0, 0, 0, (const float*)(ws + WS_MOD) + (size_t)lb * 3 * 6 * D + 2 * D); }
            __syncthreads();
            SchedMulti<D, D> S{F.lds, T / 256, 4, 1};
            EpiResid E{F.lds};
            pg8::gemm_phase<EpiResid, SchedMulti<D, D>, false, D, D, D>(F.lds, S, E);
        }
        SEAM(pb + 13);
        if constexpr (KIND(5)) if (IN(pb + 14)) route_phase(F, P, lb);
        SEAM(pb + 14);
        if constexpr (KIND(6)) if (IN(pb + 15)) {
            moe_tables(F.lds, ctl + CW_CNT + lb * 64);
            SchedMoE<D, D, true> S{F.lds, (const char*)(ws + WS_HL), (const char*)(ws + WS_WGU), (const int*)(ws + WS_LIST)};
            EpiSiluGate E{(bf16_t*)(ws + WS_H)};
            pg8::gemm_phase<EpiSiluGate, SchedMoE<D, D, true>, true, D, D, D>(F.lds, S, E);
        }
        SEAM(pb + 15);
        if constexpr (KIND(7)) if (IN(pb + 16)) {
            moe_tables(F.lds, ctl + CW_CNT + lb * 64);
            SchedMoE<EHID, EHID, false> S{F.lds, (const char*)(ws + WS_H), (const char*)(ws + WS_WD), (const int*)(ws + WS_LIST)};
            EpiScatter E{F.lds, (bf16_t*)(ws + WS_YB), (const int*)(ws + WS_LIST)};
            pg8::gemm_phase<EpiScatter, SchedMoE<EHID, EHID, false>, false, EHID, EHID, EHID>(F.lds, S, E);
        }
        SEAM(pb + 16);
    }
    if constexpr (KIND(13)) if (IN(35)) final_phase(F, P);
#undef IN
#undef KIND
#undef SEAM
}

static int phase_kind(int ph) { if (ph == 0) return 0; if (ph == 35) return 13; static const int k17[17] = {1, 2, 3, 4, 5, 6, 7, 1, 8, 9, 10, 11, 12, 4, 5, 6, 7}; return k17[(ph - 1) % 17]; }
typedef void (*kern_t)(Params);
template <unsigned KM> static kern_t kern_of() { return mega<KM>; }
static kern_t kind_kernel(int kind) {
    switch (kind) { case 0: return kern_of<1u << 0>(); case 1: return kern_of<1u << 1>(); case 2: return kern_of<1u << 2>(); case 3: return kern_of<1u << 3>(); case 4: return kern_of<1u << 4>();
        case 5: return kern_of<1u << 5>(); case 6: return kern_of<1u << 6>(); case 7: return kern_of<1u << 7>(); case 8: return kern_of<1u << 8>(); case 9: return kern_of<1u << 9>();
        case 10: return kern_of<1u << 10>(); case 11: return kern_of<1u << 11>(); case 12: return kern_of<1u << 12>(); default: return kern_of<1u << 13>(); }
}
extern "C" void kernel_launch(void* const* d_in, const int* in_sizes, int n_in, void* d_out, int out_size, void* d_ws, size_t ws_size, hipStream_t stream) {
    static int grid = 0;
    if (grid == 0) {
        if (n_in != 42 || out_size != TL * D || ws_size < WS_END) { fprintf(stderr, "kernel_launch: unexpected problem (n_in %d, out %d, ws %zu < %zu)\n", n_in, out_size, ws_size, (size_t)WS_END); grid = -1; return; }
        int dev = 0, cus = 0;
        if (hipGetDevice(&dev) != hipSuccess || hipDeviceGetAttribute(&cus, hipDeviceAttributeMultiprocessorCount, dev) != hipSuccess) { grid = -1; return; }
#if MK_ONE_LAUNCH
        if (hipFuncSetAttribute((const void*)mega<0x3fffu>, hipFuncAttributeMaxDynamicSharedMemorySize, LDS_BYTES) != hipSuccess) { fprintf(stderr, "kernel_launch: hipFuncSetAttribute failed\n"); grid = -1; return; }
#else
        for (int k = 0; k < 14; ++k) if (hipFuncSetAttribute((const void*)kind_kernel(k), hipFuncAttributeMaxDynamicSharedMemorySize, LDS_BYTES) != hipSuccess) { fprintf(stderr, "kernel_launch: hipFuncSetAttribute failed\n"); grid = -1; return; }
#endif
        (void)hipGetLastError();
        grid = cus;
    }
    if (grid < 0) return;
    (void)hipMemsetAsync((char*)d_ws + WS_CTL, 0, CTL_BYTES, stream);
    Params p{};
    for (int i = 0; i < 42; ++i) p.in[i] = (const float*)d_in[i];
    p.out = (float*)d_out; p.ws = (unsigned char*)d_ws;
#if MK_ONE_LAUNCH
    p.ph_lo = 0; p.ph_hi = NPH;
    hipLaunchKernelGGL(mega<0x3fffu>, dim3(grid), dim3(NTHR), LDS_BYTES, stream, p);
#else
    for (int ph = 0; ph < NPH; ++ph) { p.ph_lo = ph; p.ph_hi = ph + 1; hipLaunchKernelGGL(kind_kernel(phase_kind(ph)), dim3(grid), dim3(NTHR), LDS_BYTES, stream, p); }
#endif
}
```

```cpp
#include <hip/hip_runtime.h>
#include <cstdio>
#include <cstdint>

#define LAS __attribute__((address_space(3)))
typedef unsigned short bf16_t;
typedef short bf16x8 __attribute__((ext_vector_type(8)));
typedef float f32x4 __attribute__((ext_vector_type(4)));
typedef float f32x2 __attribute__((ext_vector_type(2)));
typedef unsigned u32x4 __attribute__((ext_vector_type(4)));
typedef unsigned u32x2 __attribute__((ext_vector_type(2)));

#ifndef MK_ONE_LAUNCH
#define MK_ONE_LAUNCH 1
#endif

constexpr int D = 1024, NBATCH = 2, SEQ = 16384, CTXL = 256, DEPTH = 4;
constexpr int TL = NBATCH * SEQ, TC = NBATCH * CTXL, T = TL + TC;
constexpr int GWID = 2048, NE = 32, EHID = 512, NH = 16, HD = 64;
constexpr int LISTCAP = T;
constexpr int MAXRT = (2 * T) / 256 + NE;
constexpr int NWAVES = 8, NTHR = 512;

constexpr size_t MiB = 1u << 20;
constexpr size_t WS_CTL = 0, CTL_BYTES = 1 * MiB;
constexpr size_t WS_MOD = 1 * MiB;
constexpr size_t WS_WIN = 2 * MiB, WS_WOUT = 18 * MiB, WS_WSP = 26 * MiB, WS_WR = 27 * MiB, WS_WK = 31 * MiB, WS_WV = 35 * MiB, WS_WO = 39 * MiB;
constexpr size_t WS_LW1 = 43 * MiB, WS_LA1 = 44 * MiB, WS_LG1 = 45 * MiB, WS_W2P = 46 * MiB, WS_A2P = 48 * MiB, WS_G2P = 50 * MiB;
constexpr size_t WS_WGU = 52 * MiB, WS_WD = 116 * MiB;
constexpr size_t WS_X = 148 * MiB;
constexpr size_t WS_LIST = 278 * MiB, WS_WGT = 283 * MiB;
constexpr size_t WS_HL = 284 * MiB;
constexpr size_t WS_BIG = 349 * MiB;
constexpr size_t SZB = 65 * MiB;
constexpr size_t WS_U = WS_BIG, WS_V = WS_BIG + 2 * SZB, WS_STAT = WS_BIG + 4 * SZB;
constexpr size_t WS_XR = WS_BIG, WS_XW = WS_BIG + SZB, WS_XK = WS_BIG + 2 * SZB, WS_XV = WS_BIG + 3 * SZB, WS_XA = WS_BIG + 4 * SZB, WS_XG = WS_BIG + 5 * SZB;
constexpr size_t WS_R = WS_BIG + 6 * SZB, WS_K = WS_BIG + 7 * SZB, WS_VV = WS_BIG + 8 * SZB;
constexpr size_t WS_TW = WS_BIG + 9 * SZB, WS_TA = WS_TW + 17 * MiB, WS_TG = WS_TA + 17 * MiB;
constexpr size_t WS_ELOG0 = WS_XR, WS_ELOG1 = WS_XW, WS_KM0 = WS_XK, WS_KM1 = WS_XV, WS_AS0 = WS_XA, WS_AS1 = WS_XG;
constexpr size_t WS_GATE = WS_HL, WS_YG = WS_AS0;
constexpr size_t WS_H = WS_BIG, WS_YB = WS_BIG + 73 * MiB;
constexpr size_t WS_END = WS_TG + 17 * MiB;
static_assert(WS_END <= 1000 * MiB, "workspace map");
constexpr int CW_BAR = 4096;
constexpr int CW_CNT = 16384;

__device__ __forceinline__ unsigned cvt_pk_bf16(float lo, float hi) { unsigned r; asm volatile("v_cvt_pk_bf16_f32 %0, %1, %2" : "=v"(r) : "v"(lo), "v"(hi)); return r; }
__device__ __forceinline__ float bf_lo(unsigned u) { return __uint_as_float(u << 16); }
__device__ __forceinline__ float bf_hi(unsigned u) { return __uint_as_float(u & 0xffff0000u); }
__device__ __forceinline__ float bf1(bf16_t b) { return __uint_as_float(((unsigned)b) << 16); }
__device__ __forceinline__ bf16_t f2bf(float f) { return (bf16_t)(cvt_pk_bf16(f, 0.f) & 0xffffu); }
__device__ __forceinline__ float wave_sum(float v) {
#pragma unroll
    for (int o = 1; o < 64; o <<= 1) v += __shfl_xor(v, o);
    return v;
}
__device__ __forceinline__ float sigmoidf_(float x) { return 1.0f / (1.0f + __expf(-x)); }
__device__ __forceinline__ float tanhf_(float x) { const float e = __expf(2.0f * x); return 1.0f - 2.0f / (e + 1.0f); }
__device__ __forceinline__ f32x2 gelu_pk(f32x2 v) {
    const f32x2 av = __builtin_elementwise_abs(v), d = av * 0.2316418882f + 1.0f;
    f32x2 t; t.x = __builtin_amdgcn_rcpf(d.x); t.y = __builtin_amdgcn_rcpf(d.y);
    f32x2 q = t * 0.5307027145f + (-0.7265760135f); q = q * t + 0.7107068705f; q = q * t + (-0.142248368f); q = q * t + 0.127414796f; q = q * t;
    const f32x2 s = (v * v) * (-0.72134752044f);
    f32x2 e; e.x = __builtin_amdgcn_exp2f(s.x); e.y = __builtin_amdgcn_exp2f(s.y);
    const f32x2 m = v * (q * e), r = v - m;
    f32x2 o; o.x = v.x < 0.f ? m.x : r.x; o.y = v.y < 0.f ? m.y : r.y; return o;
}

#define XB_TMO      128
#define XB_XCNT(j)  (256  + 64 * (j))
#define XB_XSUB(j)  (1280 + 64 * (j))
#define XB_XGEN(j)  (2304 + 64 * (j))
#define XB_TOP      3328
#define XB_TOPGEN   3392
#define XCD_BAR_WORDS 3456
#define XB_SPIN_CAP (1u << 18)
__device__ __forceinline__ unsigned xb_ld(unsigned* p)              { return __hip_atomic_load(p, __ATOMIC_RELAXED, __HIP_MEMORY_SCOPE_AGENT); }
__device__ __forceinline__ unsigned xb_add(unsigned* p, unsigned v) { return __hip_atomic_fetch_add(p, v, __ATOMIC_RELAXED, __HIP_MEMORY_SCOPE_AGENT); }
__device__ __forceinline__ unsigned xb_xcc_id() { return (unsigned)__builtin_amdgcn_s_getreg((3 << 11) | 20) & 0xFu; }
#define XB_SPIN(cond, bar) do { unsigned _sp = 0; while (cond) { __builtin_amdgcn_s_sleep(1); \
    if ((++_sp & 255u) == 0u) { if (xb_ld(&(bar)[XB_TMO])) break; if (_sp > XB_SPIN_CAP) { atomicAdd(&(bar)[XB_TMO], 1u); break; } } } } while (0)
struct XcdBarrier { unsigned* bar; unsigned x; volatile LAS unsigned* st; };
__device__ __forceinline__ XcdBarrier xcd_barrier_post(unsigned* bar, volatile LAS unsigned* st) {
    XcdBarrier b; b.bar = bar; b.x = xb_xcc_id(); b.st = st;
    if (threadIdx.x == 0) (void)xb_add(&bar[XB_XCNT(b.x)], 1u);
    return b;
}
__device__ __forceinline__ void xcd_barrier_complete(unsigned* bar, unsigned x, unsigned& nloc, unsigned& nx) {
    const unsigned G = gridDim.x * gridDim.y * gridDim.z;
    unsigned sum, cnt, mine, sp = 0u;
    for (;;) {
        sum = 0u; cnt = 0u; mine = 0u;
#pragma unroll
        for (unsigned j = 0; j < 16; ++j) { const unsigned c = xb_ld(&bar[XB_XCNT(j)]); sum += c; cnt += (c > 0u) ? 1u : 0u; mine = (j == x) ? c : mine; }
        if (sum == G) break;
        __builtin_amdgcn_s_sleep(1);
        if ((++sp & 255u) == 0u) { if (xb_ld(&bar[XB_TMO])) break; if (sp > XB_SPIN_CAP) { atomicAdd(&bar[XB_TMO], 1u); break; } }
    }
    nloc = mine > 0u ? mine : 1u; nx = cnt > 0u ? cnt : 1u;
}
__device__ __forceinline__ void xcd_barrier(const XcdBarrier& b) {
    asm volatile("s_waitcnt vmcnt(0)" ::: "memory");
    __syncthreads();
    if (threadIdx.x == 0) {
        unsigned* bar = b.bar;
        __builtin_amdgcn_s_waitcnt(0);
        unsigned nloc = b.st[0], nx = b.st[1];
        if (nloc == 0u) { xcd_barrier_complete(bar, b.x, nloc, nx); b.st[0] = nloc; b.st[1] = nx; }
        const unsigned old = xb_add(&bar[XB_XSUB(b.x)], 1u);
        const unsigned gen = old / nloc;
        if (old + 1u == (gen + 1u) * nloc) {
            __builtin_amdgcn_fence(__ATOMIC_RELEASE, "agent");
            asm volatile("s_waitcnt vmcnt(0)" ::: "memory");
            const unsigned og = xb_add(&bar[XB_TOP], 1u);
            const unsigned tg = og / nx;
            if (og + 1u == (tg + 1u) * nx) xb_add(&bar[XB_TOPGEN], 1u);
            else XB_SPIN(xb_ld(&bar[XB_TOPGEN]) == tg, bar);
            __builtin_amdgcn_fence(__ATOMIC_ACQUIRE, "agent");
            xb_add(&bar[XB_XGEN(b.x)], 1u);
            asm volatile("s_waitcnt vmcnt(0)" ::: "memory");
        } else {
            XB_SPIN(xb_ld(&bar[XB_XGEN(b.x)]) == gen, bar);
            __builtin_amdgcn_fence(__ATOMIC_ACQUIRE, "agent");
            asm volatile("s_waitcnt vmcnt(0)" ::: "memory");
        }
    }
    __syncthreads();
}

constexpr int LDS_MISC = 131072;
constexpr int LDS_DESC = LDS_MISC + 128;
constexpr int LDS_TAB = LDS_MISC + 512;
constexpr int LDS_BYTES = 147456;
namespace pg8 {
constexpr int BM = 256, BK = 64, HALF = 128, HTB = HALF * BK * 2, STAGE_BYTES = 8 * HTB, NXCD = 8, WGM = 8;
__host__ __device__ __forceinline__ int lds_byte(int r, int c) { const int st = (r >> 4) * 2 + (c >> 5), rr = r & 15, cc = c & 31, ob = rr * 64 + cc * 2; return st * 1024 + (ob ^ (((ob >> 9) & 1) << 5)); }
__host__ __device__ __forceinline__ void stage_rc(int b, int& R, int& C) { const int st = b / 1024, sb = b % 1024, swz = sb ^ (((sb >> 9) & 1) << 5); R = (st >> 1) * 16 + swz / 64; C = (st & 1) * 32 + (swz % 64) / 2; }
__host__ __device__ __forceinline__ int perm32(int rho) { const int n = rho >> 4, i = rho & 15; return 8 * (i >> 2) + 4 * n + (i & 3); }
__device__ __forceinline__ int xcd_remap(int L, int nwg) { const int q = nwg / NXCD, r = nwg % NXCD, xcd = L % NXCD, off = L / NXCD; return (xcd < r ? xcd * (q + 1) : r * (q + 1) + (xcd - r) * q) + off; }

struct Unit { int pm, pn, aux; };

template <class Epi, class Sched, bool GATHER, int K, int LDA, int LDB>
__device__ __forceinline__ void gemm_phase(LAS unsigned char* lds, const Sched& S, const Epi& E) {
    int tid_ = threadIdx.x; asm volatile("" : "+v"(tid_));
    const int tid = tid_, wid = __builtin_amdgcn_readfirstlane(tid >> 6), lane = tid & 63, wr = wid >> 2, wc = wid & 3, fr = lane & 15, fq = lane >> 4;
    constexpr int nt = K / BK;
    unsigned voffA[2], voffB[2];
#pragma unroll
    for (int i = 0; i < 2; ++i) { int R, C; stage_rc(tid * 16 + i * 8192, R, C); const int Rb = Epi::PERM ? ((R & ~31) + perm32(R & 31)) : R;
        voffA[i] = (unsigned)(R * LDA + C) * 2u; voffB[i] = (unsigned)(Rb * LDB + C) * 2u; }
    constexpr size_t kstep = (size_t)(BK * 2);
    constexpr size_t hstepA = GATHER ? (size_t)0 : (size_t)HALF * LDA * 2, hstepB = (size_t)HALF * LDB * 2;
    const unsigned ldsw = (unsigned)wid * 1024u;
    const int aoff = lds_byte(wr * 64 + fr, fq * 8), boff = lds_byte(wc * 32 + fr, fq * 8);
    unsigned gA[2][2], gN[2][2];
#define PG8_SA(b, h) (((b) * 2 + (h)) * HTB)
#define PG8_SB(b, h) ((4 + (b) * 2 + (h)) * HTB)
#define PG8_STAGEB(bufoff, gbase) do { _Pragma("unroll") for (int _i = 0; _i < 2; ++_i) \
        __builtin_amdgcn_global_load_lds((const unsigned*)((const char*)(gbase) + voffB[_i]), (LAS unsigned*)(lds + (bufoff) + ldsw + _i * 8192), 16, 0, 0); } while (0)
#define PG8_STAGEA(bufoff, gbase, h, GV) do { _Pragma("unroll") for (int _i = 0; _i < 2; ++_i) \
        __builtin_amdgcn_global_load_lds((const unsigned*)((const char*)(gbase) + (GATHER ? GV[h][_i] : voffA[_i]) + (h) * hstepA), (LAS unsigned*)(lds + (bufoff) + ldsw + _i * 8192), 16, 0, 0); } while (0)
#define PG8_LDA(dst, b, h) do { _Pragma("unroll") for (int m = 0; m < 4; ++m) _Pragma("unroll") for (int k = 0; k < 2; ++k) dst[m][k] = *(const LAS bf16x8*)(lds + PG8_SA(b, h) + aoff + m * 2048 + k * 1024); } while (0)
#define PG8_LDB(dst, b, h) do { _Pragma("unroll") for (int n = 0; n < 2; ++n) _Pragma("unroll") for (int k = 0; k < 2; ++k) dst[n][k] = *(const LAS bf16x8*)(lds + PG8_SB(b, h) + boff + n * 2048 + k * 1024); } while (0)
#define PG8_MMA(ai, bj, At, Bt) do { __builtin_amdgcn_s_setprio(1); _Pragma("unroll") for (int m = 0; m < 4; ++m) _Pragma("unroll") for (int n = 0; n < 2; ++n) _Pragma("unroll") for (int k = 0; k < 2; ++k) \
        acc[ai][bj][m][n] = __builtin_amdgcn_mfma_f32_16x16x32_bf16(Bt[n][k], At[m][k], acc[ai][bj][m][n], 0, 0, 0); __builtin_amdgcn_s_setprio(0); } while (0)
#define PG8_WAIT_V(n) asm volatile("s_waitcnt vmcnt(" #n ")" ::: "memory")
#define PG8_WAIT_L(n) asm volatile("s_waitcnt lgkmcnt(" #n ")" ::: "memory")
#define PG8_BAR __builtin_amdgcn_s_barrier()
#define PG8_SCHED __builtin_amdgcn_sched_barrier(0)
    Unit cur, nxt; int ui = 0;
    if (!S.next(0, cur)) return;
    f32x4 acc[2][2][4][2];
#pragma unroll
    for (int a = 0; a < 2; ++a)
#pragma unroll
        for (int b = 0; b < 2; ++b)
#pragma unroll
            for (int m = 0; m < 4; ++m)
#pragma unroll
                for (int n = 0; n < 2; ++n) acc[a][b][m][n] = (f32x4){0.f, 0.f, 0.f, 0.f};
    bf16x8 At[4][2], B0[2][2], B1[2][2];
    const char* cA = S.aptr(cur); const char* cB = S.bptr(cur);
    if constexpr (GATHER) { S.gather(cur, tid, gA); }
    PG8_STAGEB(PG8_SB(0, 0), cB); PG8_STAGEB(PG8_SB(0, 1), cB + hstepB); PG8_STAGEA(PG8_SA(0, 0), cA, 0, gA); PG8_STAGEA(PG8_SA(0, 1), cA, 1, gA);
    if (wr == 1) PG8_BAR;
    PG8_WAIT_V(2); PG8_BAR;
    PG8_STAGEB(PG8_SB(1, 0), cB + kstep); PG8_STAGEA(PG8_SA(1, 0), cA + kstep, 0, gA); PG8_STAGEB(PG8_SB(1, 1), cB + hstepB + kstep);
    PG8_WAIT_V(6); PG8_BAR;
    for (;;) {
        const bool has_next = S.next(ui + 1, nxt);
        const char* nA = has_next ? S.aptr(nxt) : cA; const char* nB = has_next ? S.bptr(nxt) : cB;
        if constexpr (GATHER) { if (has_next) S.gather(nxt, tid, gN); else {
#pragma unroll
            for (int h = 0; h < 2; ++h)
#pragma unroll
                for (int i = 0; i < 2; ++i) gN[h][i] = gA[h][i]; } }
#pragma nounroll
        for (int t = 0; t < nt; t += 2) {
            const bool last = (t == nt - 2);
            const char* a1 = cA + (size_t)(t + 1) * kstep;
            const char* a2 = last ? nA : cA + (size_t)(t + 2) * kstep; const char* b2 = last ? nB : cB + (size_t)(t + 2) * kstep;
            const char* a3 = a2 + kstep; const char* b3 = b2 + kstep;
            unsigned g2[2][2];
            if constexpr (GATHER) {
#pragma unroll
                for (int h = 0; h < 2; ++h)
#pragma unroll
                    for (int i = 0; i < 2; ++i) g2[h][i] = last ? gN[h][i] : gA[h][i]; }
            PG8_LDB(B0, 0, 0); PG8_LDB(B1, 0, 1); PG8_SCHED; PG8_LDA(At, 0, 0); PG8_STAGEA(PG8_SA(1, 1), a1, 1, gA);
            PG8_WAIT_V(8); PG8_WAIT_L(0); PG8_BAR; PG8_MMA(0, 0, At, B0); PG8_MMA(0, 1, At, B1); PG8_BAR; PG8_SCHED;
            PG8_LDA(At, 0, 1); PG8_STAGEB(PG8_SB(0, 0), b2); PG8_STAGEB(PG8_SB(0, 1), b2 + hstepB); PG8_STAGEA(PG8_SA(0, 0), a2, 0, g2);
            PG8_WAIT_V(8); PG8_WAIT_L(0); PG8_BAR; PG8_MMA(1, 0, At, B0); PG8_MMA(1, 1, At, B1); PG8_BAR; PG8_SCHED;
            PG8_LDB(B0, 1, 0); PG8_LDB(B1, 1, 1); PG8_SCHED; PG8_LDA(At, 1, 0); PG8_STAGEA(PG8_SA(0, 1), a2, 1, g2);
            PG8_WAIT_V(8); PG8_WAIT_L(0); PG8_BAR; PG8_MMA(0, 0, At, B0); PG8_MMA(0, 1, At, B1); PG8_BAR; PG8_SCHED;
            PG8_LDA(At, 1, 1); PG8_STAGEB(PG8_SB(1, 0), b3); PG8_STAGEB(PG8_SB(1, 1), b3 + hstepB); PG8_STAGEA(PG8_SA(1, 0), a3, 0, g2);
            PG8_WAIT_V(8); PG8_WAIT_L(0); PG8_BAR; PG8_MMA(1, 0, At, B0); PG8_MMA(1, 1, At, B1); PG8_BAR; PG8_SCHED;
        }
        if (wr == 0) PG8_BAR;
        E(acc, cur, wr, wc, fr, fq);
        if (!has_next) break;
#pragma unroll
        for (int a = 0; a < 2; ++a)
#pragma unroll
            for (int b = 0; b < 2; ++b)
#pragma unroll
                for (int m = 0; m < 4; ++m)
#pragma unroll
                    for (int n = 0; n < 2; ++n) acc[a][b][m][n] = (f32x4){0.f, 0.f, 0.f, 0.f};
        cur = nxt; cA = nA; cB = nB; ++ui;
        if constexpr (GATHER) {
#pragma unroll
            for (int h = 0; h < 2; ++h)
#pragma unroll
                for (int i = 0; i < 2; ++i) gA[h][i] = gN[h][i]; }
        if (wr == 1) PG8_BAR;
    }
    PG8_WAIT_V(0);
    PG8_BAR;
#undef PG8_SA
#undef PG8_SB
#undef PG8_STAGEA
#undef PG8_STAGEB
#undef PG8_LDA
#undef PG8_LDB
#undef PG8_MMA
#undef PG8_WAIT_V
#undef PG8_WAIT_L
#undef PG8_BAR
#undef PG8_SCHED
}
}
using pg8::Unit;

__device__ __forceinline__ void set_desc(LAS unsigned char* lds, int g, const void* A, const void* B, const void* C, int nN, int ldc, int aux, const void* X1 = nullptr, const void* X2 = nullptr, const void* X3 = nullptr) {
    LAS int* d = (LAS int*)(lds + LDS_DESC) + g * 16;
    if (threadIdx.x == 0) { unsigned long long a = (unsigned long long)A, b = (unsigned long long)B, c = (unsigned long long)C, x1 = (unsigned long long)X1, x2 = (unsigned long long)X2, x3 = (unsigned long long)X3;
        asm volatile("" : "+s"(a), "+s"(b), "+s"(c), "+s"(x1), "+s"(x2), "+s"(x3), "+s"(nN), "+s"(ldc), "+s"(aux));
        d[0] = (int)(unsigned)a; d[1] = (int)(unsigned)(a >> 32); d[2] = (int)(unsigned)b; d[3] = (int)(unsigned)(b >> 32); d[4] = (int)(unsigned)c; d[5] = (int)(unsigned)(c >> 32); d[6] = nN; d[7] = ldc; d[8] = aux;
        d[10] = (int)(unsigned)x1; d[11] = (int)(unsigned)(x1 >> 32); d[12] = (int)(unsigned)x2; d[13] = (int)(unsigned)(x2 >> 32); d[14] = (int)(unsigned)x3; d[15] = (int)(unsigned)(x3 >> 32); }
}
__device__ __forceinline__ int desc_i(LAS unsigned char* lds, int g, int f) { return __builtin_amdgcn_readfirstlane(((LAS const int*)(lds + LDS_DESC))[g * 16 + f]); }
__device__ __forceinline__ const char* desc_p(LAS unsigned char* lds, int g, int f) {
    const unsigned lo = (unsigned)desc_i(lds, g, f), hi = (unsigned)desc_i(lds, g, f + 1); return (const char*)(((unsigned long long)hi << 32) | lo); }
template <int LDA, int LDB>
struct SchedMulti {
    LAS unsigned char* lds; int nM, ntot, ng;
    __device__ __forceinline__ bool next(int i, Unit& u) const {
        const int nwg = nM * ntot; const long L = (long)i * gridDim.x + blockIdx.x; if (L >= nwg) return false;
        const int wgid = pg8::xcd_remap((int)L, nwg);
        const int nig = pg8::WGM * ntot, gid = wgid / nig, fm = gid * pg8::WGM, gsz = (nM - fm) < pg8::WGM ? (nM - fm) : pg8::WGM;
        u.pm = fm + ((wgid % nig) % gsz); int pv = (wgid % nig) / gsz; int g = 0;
        for (int j = 0; j + 1 < ng; ++j) { const int n = desc_i(lds, j, 6); if (pv < n) break; pv -= n; g = j + 1; }
        u.pn = pv; u.aux = g; return true;
    }
    __device__ __forceinline__ const char* aptr(const Unit& u) const { return desc_p(lds, u.aux, 0) + (size_t)u.pm * (512 * LDA); }
    __device__ __forceinline__ const char* bptr(const Unit& u) const { return desc_p(lds, u.aux, 2) + (size_t)u.pn * (512 * LDB); }
};
template <int LDA, int LDB, bool GATHERED>
struct SchedMoE {
    LAS unsigned char* lds; const char* Abase; const char* Bbase; const int* list;
    __device__ __forceinline__ bool next(int i, Unit& u) const {
        LAS const int* tab = (LAS const int*)(lds + LDS_TAB);
        const int nrt = __builtin_amdgcn_readfirstlane(tab[2 * MAXRT + 32]);
        const int nwg = nrt * 4; const long L = (long)i * gridDim.x + blockIdx.x; if (L >= nwg) return false;
        const int wgid = pg8::xcd_remap((int)L, nwg);
        u.pm = wgid >> 2; u.pn = wgid & 3; u.aux = __builtin_amdgcn_readfirstlane(tab[u.pm]); return true;
    }
    __device__ __forceinline__ const char* aptr(const Unit& u) const { return GATHERED ? Abase : Abase + (size_t)u.pm * (512 * LDA); }
    __device__ __forceinline__ const char* bptr(const Unit& u) const { return Bbase + (size_t)u.aux * ((size_t)D * LDB * 2) + (size_t)u.pn * (512 * LDB); }
    __device__ __forceinline__ void gather(const Unit& u, int tid, unsigned (&g)[2][2]) const {
        LAS const int* tab = (LAS const int*)(lds + LDS_TAB);
        const int j0 = __builtin_amdgcn_readfirstlane(tab[MAXRT + u.pm]), cn = __builtin_amdgcn_readfirstlane(tab[2 * MAXRT + u.aux]);
#pragma unroll
        for (int i = 0; i < 2; ++i) { int R, C; pg8::stage_rc(tid * 16 + i * 8192, R, C);
#pragma unroll
            for (int h = 0; h < 2; ++h) { const int slot = j0 + 128 * h + R; const int a = slot < cn ? list[(size_t)u.aux * LISTCAP + slot] : 0;
                g[h][i] = (unsigned)((a >> 1) * LDA + C) * 2u; } }
    }
};
__device__ __forceinline__ void moe_tables(LAS unsigned char* lds, const unsigned* cnt) {
    LAS int* tab = (LAS int*)(lds + LDS_TAB);
    __syncthreads();
    if (threadIdx.x == 0) {
        int rt = 0;
#pragma nounroll
        for (int e = 0; e < NE; ++e) { const int c = (int)__hip_atomic_load(cnt + e, __ATOMIC_RELAXED, __HIP_MEMORY_SCOPE_AGENT); tab[2 * MAXRT + e] = c;
            const int nt = (c + 255) >> 8;
#pragma nounroll
            for (int j = 0; j < nt; ++j) { tab[rt] = e; tab[MAXRT + rt] = j * 256; ++rt; } }
        tab[2 * MAXRT + 32] = rt;
    }
    __syncthreads();
}

#define EPI_FENCE() asm volatile("" ::: "memory")
struct EpiGelu {
    static constexpr bool PERM = true;
    LAS unsigned char* lds;
    __device__ __forceinline__ void operator()(const f32x4 (&acc)[2][2][4][2], const Unit& u, int wr, int wc, int fr, int fq) const {
        const bool isv = u.pn >= 8; bf16_t* base = (bf16_t*)desc_p(lds, 0, isv ? 10 : 4); const float* bias = (const float*)desc_p(lds, 0, 12); float* stat = (float*)desc_p(lds, 0, 14);
        const int col0 = (u.pn & 7) * 256 + wc * 32 + 8 * fq, bcol0 = u.pn * 256 + wc * 32 + 8 * fq, row0 = u.pm * 256 + wr * 64 + fr;
        f32x4 bv[2][2];
#pragma unroll
        for (int bj = 0; bj < 2; ++bj)
#pragma unroll
            for (int n = 0; n < 2; ++n) bv[bj][n] = *(const f32x4*)(bias + bcol0 + bj * 128 + 4 * n);
#pragma unroll
        for (int ai = 0; ai < 2; ++ai)
#pragma unroll
            for (int m = 0; m < 4; ++m) { const int row = row0 + ai * 128 + m * 16; bf16_t* rowp = base + (size_t)row * GWID + col0; float s = 0.f, q = 0.f;
#pragma unroll
                for (int bj = 0; bj < 2; ++bj) { const f32x4 v0 = acc[ai][bj][m][0] + bv[bj][0], v1 = acc[ai][bj][m][1] + bv[bj][1];
                    const f32x2 a = gelu_pk((f32x2){v0[0], v0[1]}), b = gelu_pk((f32x2){v0[2], v0[3]}), c = gelu_pk((f32x2){v1[0], v1[1]}), d = gelu_pk((f32x2){v1[2], v1[3]});
                    s += ((a.x + a.y) + (b.x + b.y)) + ((c.x + c.y) + (d.x + d.y));
                    q += ((a.x * a.x + a.y * a.y) + (b.x * b.x + b.y * b.y)) + ((c.x * c.x + c.y * c.y) + (d.x * d.x + d.y * d.y));
                    u32x4 w; w.x = cvt_pk_bf16(a.x, a.y); w.y = cvt_pk_bf16(b.x, b.y); w.z = cvt_pk_bf16(c.x, c.y); w.w = cvt_pk_bf16(d.x, d.y);
                    *(u32x4*)(rowp + bj * 128) = w; }
                if (isv) { s += __shfl_xor(s, 16); s += __shfl_xor(s, 32); q += __shfl_xor(q, 16); q += __shfl_xor(q, 32);
                    if (fq == 0) *(f32x2*)(stat + ((size_t)row * 32 + (u.pn - 8) * 4 + wc) * 2) = (f32x2){s, q}; } }
    }
};
struct EpiResid {
    static constexpr bool PERM = false;
    LAS unsigned char* lds;
    __device__ __forceinline__ void operator()(const f32x4 (&acc)[2][2][4][2], const Unit& u, int wr, int wc, int fr, int fq) const {
        const int mrow = u.pm < 64 ? 0 : (u.pm < 128 ? 1 : 2);
        const float* xin = u.pm < 128 ? (const float*)desc_p(lds, 0, 10) + (size_t)u.pm * 256 * D : (const float*)desc_p(lds, 0, 12) + (size_t)(u.pm - 128) * 256 * D;
        float* xout = (float*)desc_p(lds, 0, 4) + (size_t)u.pm * 256 * D; const float* bias = (const float*)desc_p(lds, 0, 14); const float* gate = (const float*)desc_p(lds, 1, 10);
        const int col0 = u.pn * 256 + wc * 32 + 4 * fq, rl0 = wr * 64 + fr;
#pragma unroll
        for (int bj = 0; bj < 2; ++bj)
#pragma unroll
            for (int n = 0; n < 2; ++n) { const f32x4 bv = bias ? *(const f32x4*)(bias + col0 + bj * 128 + n * 16) : (f32x4){0.f, 0.f, 0.f, 0.f};
                const f32x4 gv = *(const f32x4*)(gate + mrow * 6 * D + col0 + bj * 128 + n * 16);
#pragma unroll
                for (int ai = 0; ai < 2; ++ai) {
#pragma unroll
                    for (int m = 0; m < 4; ++m) { const size_t off = (size_t)(rl0 + ai * 128 + m * 16) * D + col0 + bj * 128 + n * 16;
                        const f32x4 xi = *(const f32x4*)(xin + off); *(f32x4*)(xout + off) = xi + gv * (acc[ai][bj][m][n] + bv); }
                    EPI_FENCE(); } }
    }
};
struct EpiAct {
    static constexpr bool PERM = true;
    LAS unsigned char* lds;
    __device__ __forceinline__ void operator()(const f32x4 (&acc)[2][2][4][2], const Unit& u, int wr, int wc, int fr, int fq) const {
        bf16_t* C = (bf16_t*)desc_p(lds, u.aux, 4); const int ldc = desc_i(lds, u.aux, 7), act = desc_i(lds, u.aux, 8);
        const int col0 = u.pn * 256 + wc * 32 + 8 * fq, row0 = u.pm * 256 + wr * 64 + fr;
#pragma unroll
        for (int ai = 0; ai < 2; ++ai)
#pragma unroll
            for (int m = 0; m < 4; ++m) { bf16_t* rowp = C + (size_t)(row0 + ai * 128 + m * 16) * ldc + col0;
#pragma unroll
                for (int bj = 0; bj < 2; ++bj) { f32x4 v0 = acc[ai][bj][m][0], v1 = acc[ai][bj][m][1];
                    if (act == 1) {
#pragma unroll
                        for (int j = 0; j < 4; ++j) { v0[j] = tanhf_(v0[j]); v1[j] = tanhf_(v1[j]); } }
                    else if (act == 2) {
#pragma unroll
                        for (int j = 0; j < 4; ++j) { v0[j] = sigmoidf_(v0[j]); v1[j] = sigmoidf_(v1[j]); } }
                    u32x4 w; w.x = cvt_pk_bf16(v0[0], v0[1]); w.y = cvt_pk_bf16(v0[2], v0[3]); w.z = cvt_pk_bf16(v1[0], v1[1]); w.w = cvt_pk_bf16(v1[2], v1[3]);
                    *(u32x4*)(rowp + bj * 128) = w; } }
    }
};
struct EpiLora2 {
    static constexpr bool PERM = true;
    LAS unsigned char* lds;
    __device__ __forceinline__ void operator()(const f32x4 (&acc)[2][2][4][2], const Unit& u, int wr, int wc, int fr, int fq) const {
        bf16_t* C = (bf16_t*)desc_p(lds, u.aux, 4);
        const int col0 = u.pn * 256 + wc * 32 + 8 * fq, row0 = u.pm * 256 + wr * 64 + fr;
        const float* pv = u.aux < 4 ? (const float*)desc_p(lds, u.aux, 10) : (const float*)desc_p(lds, 5, 10); bf16_t* C2 = (bf16_t*)desc_p(lds, u.aux, 12);
        const float* k_a = (const float*)desc_p(lds, 5, 10); const bf16_t* Kb = (const bf16_t*)desc_p(lds, 5, 12);
#pragma unroll
        for (int bj = 0; bj < 2; ++bj) { const f32x4 p0 = *(const f32x4*)(pv + col0 + bj * 128), p1 = *(const f32x4*)(pv + col0 + bj * 128 + 4);
            const f32x4 ka0 = *(const f32x4*)(k_a + col0 + bj * 128), ka1 = *(const f32x4*)(k_a + col0 + bj * 128 + 4);
#pragma unroll
            for (int ai = 0; ai < 2; ++ai)
#pragma unroll
                for (int m = 0; m < 4; ++m) { const size_t ro = (size_t)(row0 + ai * 128 + m * 16) * D + col0 + bj * 128;
                    f32x4 v0 = acc[ai][bj][m][0], v1 = acc[ai][bj][m][1];
                    if (u.aux < 2) {
#pragma unroll
                        for (int j = 0; j < 4; ++j) { const float x0 = -(p0[j] + v0[j]), x1 = -(p1[j] + v1[j]);
                            const float s0 = fmaxf(x0, 0.f) + __logf(1.0f + __expf(-fabsf(x0))), s1 = fmaxf(x1, 0.f) + __logf(1.0f + __expf(-fabsf(x1)));
                            v0[j] = -__expf(-s0 - 0.5f); v1[j] = -__expf(-s1 - 0.5f); }
                    } else if (u.aux < 4) {
                        const u32x4 kw = *(const u32x4*)(Kb + ro); f32x4 a0v, a1v;
#pragma unroll
                        for (int j = 0; j < 4; ++j) { a0v[j] = sigmoidf_(p0[j] + v0[j]); a1v[j] = sigmoidf_(p1[j] + v1[j]); }
                        v0[0] = bf_lo(kw.x) * (1.0f + (a0v[0] - 1.0f) * ka0[0]); v0[1] = bf_hi(kw.x) * (1.0f + (a0v[1] - 1.0f) * ka0[1]);
                        v0[2] = bf_lo(kw.y) * (1.0f + (a0v[2] - 1.0f) * ka0[2]); v0[3] = bf_hi(kw.y) * (1.0f + (a0v[3] - 1.0f) * ka0[3]);
                        v1[0] = bf_lo(kw.z) * (1.0f + (a1v[0] - 1.0f) * ka1[0]); v1[1] = bf_hi(kw.z) * (1.0f + (a1v[1] - 1.0f) * ka1[1]);
                        v1[2] = bf_lo(kw.w) * (1.0f + (a1v[2] - 1.0f) * ka1[2]); v1[3] = bf_hi(kw.w) * (1.0f + (a1v[3] - 1.0f) * ka1[3]);
                        u32x4 w2; w2.x = cvt_pk_bf16(a0v[0], a0v[1]); w2.y = cvt_pk_bf16(a0v[2], a0v[3]); w2.z = cvt_pk_bf16(a1v[0], a1v[1]); w2.w = cvt_pk_bf16(a1v[2], a1v[3]);
                        *(u32x4*)(C2 + ro) = w2;
                    }
                    u32x4 w; w.x = cvt_pk_bf16(v0[0], v0[1]); w.y = cvt_pk_bf16(v0[2], v0[3]); w.z = cvt_pk_bf16(v1[0], v1[1]); w.w = cvt_pk_bf16(v1[2], v1[3]);
                    *(u32x4*)(C + ro) = w; EPI_FENCE(); } }
    }
};
struct EpiSiluGate {
    static constexpr bool PERM = true;
    bf16_t* H;
    __device__ __forceinline__ void operator()(const f32x4 (&acc)[2][2][4][2], const Unit& u, int wr, int wc, int fr, int fq) const {
        const int col0 = u.pn * 128 + wc * 32 + 8 * fq, row0 = u.pm * 256 + wr * 64 + fr;
#pragma unroll
        for (int ai = 0; ai < 2; ++ai)
#pragma unroll
            for (int m = 0; m < 4; ++m) { f32x4 h0, h1;
#pragma unroll
                for (int j = 0; j < 4; ++j) { const float g0 = acc[ai][0][m][0][j], g1 = acc[ai][0][m][1][j]; h0[j] = g0 * sigmoidf_(g0) * acc[ai][1][m][0][j]; h1[j] = g1 * sigmoidf_(g1) * acc[ai][1][m][1][j]; }
                u32x4 w; w.x = cvt_pk_bf16(h0[0], h0[1]); w.y = cvt_pk_bf16(h0[2], h0[3]); w.z = cvt_pk_bf16(h1[0], h1[1]); w.w = cvt_pk_bf16(h1[2], h1[3]);
                *(u32x4*)(H + (size_t)(row0 + ai * 128 + m * 16) * EHID + col0) = w; }
    }
};
struct EpiScatter {
    static constexpr bool PERM = true;
    LAS unsigned char* lds; bf16_t* YB; const int* list;
    __device__ __forceinline__ void operator()(const f32x4 (&acc)[2][2][4][2], const Unit& u, int wr, int wc, int fr, int fq) const {
        LAS const int* tab = (LAS const int*)(lds + LDS_TAB);
        const int j0 = __builtin_amdgcn_readfirstlane(tab[MAXRT + u.pm]), cn = __builtin_amdgcn_readfirstlane(tab[2 * MAXRT + u.aux]);
        const int col0 = u.pn * 256 + wc * 32 + 8 * fq;
#pragma unroll
        for (int ai = 0; ai < 2; ++ai)
#pragma unroll
            for (int m = 0; m < 4; ++m) { const int slot = j0 + ai * 128 + wr * 64 + m * 16 + fr;
                if (slot < cn) { const int a = list[(size_t)u.aux * LISTCAP + slot]; bf16_t* rowp = YB + (size_t)a * D + col0;
#pragma unroll
                    for (int bj = 0; bj < 2; ++bj) { const f32x4 v0 = acc[ai][bj][m][0], v1 = acc[ai][bj][m][1];
                        u32x4 w; w.x = cvt_pk_bf16(v0[0], v0[1]); w.y = cvt_pk_bf16(v0[2], v0[3]); w.z = cvt_pk_bf16(v1[0], v1[1]); w.w = cvt_pk_bf16(v1[2], v1[3]);
                        *(u32x4*)(rowp + bj * 128) = w; } } }
    }
};

struct Params { const float* in[42]; float* out; unsigned char* ws; int ph_lo, ph_hi; };
enum { I_X = 0, I_C, I_CTX, I_CCTX, I_ADAW, I_ADAB, I_N1G, I_N2G, I_FG, I_GWIN, I_GBIN, I_GLNG, I_GLNB, I_GWS, I_GBS, I_GWOUT, I_GBOUT,
       I_MU, I_WR, I_WK, I_WV, I_WO, I_W0, I_W1, I_W2, I_A0, I_A1, I_A2, I_G1, I_G2, I_KK, I_KA, I_RK, I_LNG, I_LNB,
       I_MWGRP, I_MBGRP, I_MWEXP, I_MBEXP, I_MWG, I_MWU, I_MWD };
struct Frame { LAS unsigned char* lds; int tid, lane, wave, G, gw, NGW; };
typedef const __attribute__((address_space(4))) Params* KP;

__device__ __forceinline__ void tr_item(const float* W, int N, int kmax, bf16_t* WT, int ldk, int k0, int n0, int drow0, int dk0, LAS float* scr, int lane) {
#pragma unroll 8
    for (int i = 0; i < 32; ++i) { const int kk = 2 * i + (lane >> 5), k = k0 + kk; scr[kk * 33 + (lane & 31)] = k < kmax ? W[(size_t)k * N + n0 + (lane & 31)] : 0.f; }
    asm volatile("s_waitcnt lgkmcnt(0)" ::: "memory");
    const int c = lane & 7;
#pragma unroll
    for (int j = 0; j < 4; ++j) { const int n = (lane >> 3) + 8 * j; const LAS float* s = scr + (8 * c) * 33 + n;
        u32x4 o; o.x = cvt_pk_bf16(s[0 * 33], s[1 * 33]); o.y = cvt_pk_bf16(s[2 * 33], s[3 * 33]); o.z = cvt_pk_bf16(s[4 * 33], s[5 * 33]); o.w = cvt_pk_bf16(s[6 * 33], s[7 * 33]);
        *(u32x4*)(WT + (size_t)(drow0 + n) * ldk + dk0 + k0 + 8 * c) = o; }
    asm volatile("s_waitcnt lgkmcnt(0)" ::: "memory");
}
__device__ __forceinline__ void conv_T(const Frame& F, const float* W, int N, int kmax, int kpad, bf16_t* WT, int ldk, int drow0, int dk0, int ilv) {
    LAS float* scr = (LAS float*)(F.lds + F.wave * 8704);
    const int nnb = N / 32, nit = (kpad / 64) * nnb;
    for (int it = F.gw; it < nit; it += F.NGW) { const int kb = it / nnb, nb = it % nnb, n0 = nb * 32;
        const int dr = ilv == 0 ? n0 : (256 * (n0 >> 7) + (n0 & 127) + (ilv == 2 ? 128 : 0));
        tr_item(W, N, kmax, WT, ldk, kb * 64, n0, drow0 + dr, dk0, scr, F.lane); }
}
__device__ __forceinline__ void zero_fill(const Frame& F, bf16_t* p, size_t nbytes) {
    u32x4* q = (u32x4*)p; const size_t n = nbytes / 16;
    for (size_t i = (size_t)blockIdx.x * NTHR + F.tid; i < n; i += (size_t)F.G * NTHR) q[i] = (u32x4){0u, 0u, 0u, 0u};
}

__device__ __forceinline__ void prologue_phase(const Frame& F, KP P) {
    unsigned char* ws = P->ws;
    {   float* MOD = (float*)(ws + WS_MOD); LAS float* part = (LAS float*)F.lds;
        const float* c = P->in[I_C]; const float* cc = P->in[I_CCTX];
        for (int item = blockIdx.x; item < DEPTH * 96; item += F.G) {
            const int layer = item / 96, col = (item % 96) * 64 + F.lane; const float* w = P->in[I_ADAW] + (size_t)layer * D * 6 * D;
            float a0 = 0.f, a1 = 0.f, a2 = 0.f;
#pragma unroll 8
            for (int dd = 0; dd < 128; ++dd) { const int d = F.wave * 128 + dd; const float wv = w[(size_t)d * 6 * D + col];
                const float c0 = c[d], c1 = c[D + d], c2 = cc[d];
                a0 += c0 * sigmoidf_(c0) * wv; a1 += c1 * sigmoidf_(c1) * wv; a2 += c2 * sigmoidf_(c2) * wv; }
            part[(F.wave * 3 + 0) * 64 + F.lane] = a0; part[(F.wave * 3 + 1) * 64 + F.lane] = a1; part[(F.wave * 3 + 2) * 64 + F.lane] = a2;
            __syncthreads();
            if (F.wave < 3) { float s = 0.f;
#pragma unroll
                for (int w8 = 0; w8 < 8; ++w8) s += part[(w8 * 3 + F.wave) * 64 + F.lane];
                MOD[((size_t)layer * 3 + F.wave) * 6 * D + col] = s + P->in[I_ADAB][(size_t)layer * 6 * D + col]; }
            __syncthreads();
        }
    }
    for (int j = 0; j < 2; ++j) {
        conv_T(F, P->in[I_GWIN] + (size_t)j * D * 4096, 4096, D, D, (bf16_t*)(ws + WS_WIN) + (size_t)j * 4096 * D, D, 0, 0, 0);
        conv_T(F, P->in[I_GWOUT] + (size_t)j * GWID * D, D, GWID, GWID, (bf16_t*)(ws + WS_WOUT) + (size_t)j * D * GWID, GWID, 0, 0, 0);
        conv_T(F, P->in[I_WR] + (size_t)j * D * D, D, D, D, (bf16_t*)(ws + WS_WR) + (size_t)j * D * D, D, 0, 0, 0);
        conv_T(F, P->in[I_WK] + (size_t)j * D * D, D, D, D, (bf16_t*)(ws + WS_WK) + (size_t)j * D * D, D, 0, 0, 0);
        conv_T(F, P->in[I_WV] + (size_t)j * D * D, D, D, D, (bf16_t*)(ws + WS_WV) + (size_t)j * D * D, D, 0, 0, 0);
        conv_T(F, P->in[I_WO] + (size_t)j * D * D, D, D, D, (bf16_t*)(ws + WS_WO) + (size_t)j * D * D, D, 0, 0, 0);
        bf16_t* lw1 = (bf16_t*)(ws + WS_LW1) + (size_t)j * 256 * D; bf16_t* la1 = (bf16_t*)(ws + WS_LA1) + (size_t)j * 256 * D; bf16_t* lg1 = (bf16_t*)(ws + WS_LG1) + (size_t)j * 256 * D;
        for (int z = 0; z < 2; ++z) {
            conv_T(F, P->in[I_W1] + ((size_t)j * 2 + z) * D * 64, 64, D, D, lw1, D, z * 64, 0, 0);
            conv_T(F, P->in[I_A1] + ((size_t)j * 2 + z) * D * 64, 64, D, D, la1, D, z * 64, 0, 0);
            bf16_t* w2p = (bf16_t*)(ws + WS_W2P) + ((size_t)j * 2 + z) * D * 256; bf16_t* a2p = (bf16_t*)(ws + WS_A2P) + ((size_t)j * 2 + z) * D * 256;
            conv_T(F, P->in[I_W2] + ((size_t)j * 2 + z) * 64 * D, D, 64, 64, w2p, 256, 0, z * 64, 0);
            conv_T(F, P->in[I_A2] + ((size_t)j * 2 + z) * 64 * D, D, 64, 64, a2p, 256, 0, z * 64, 0);
            for (int idx = blockIdx.x * NTHR + F.tid; idx < D * 32; idx += F.G * NTHR) { const int n = idx >> 5, ch = idx & 31;
                if ((ch >> 3) != z) { *(u32x4*)(w2p + (size_t)n * 256 + ch * 8) = (u32x4){0u, 0u, 0u, 0u}; *(u32x4*)(a2p + (size_t)n * 256 + ch * 8) = (u32x4){0u, 0u, 0u, 0u}; } }
        }
        conv_T(F, P->in[I_G1] + (size_t)j * D * 160, 160, D, D, lg1, D, 0, 0, 0);
        zero_fill(F, lw1 + 128 * D, (size_t)128 * D * 2); zero_fill(F, la1 + 128 * D, (size_t)128 * D * 2); zero_fill(F, lg1 + 160 * D, (size_t)96 * D * 2);
        conv_T(F, P->in[I_G2] + (size_t)j * 160 * D, D, 160, 256, (bf16_t*)(ws + WS_G2P) + (size_t)j * D * 256, 256, 0, 0, 0);
    }
    {   const float* src = P->in[I_GWS]; bf16_t* dst = (bf16_t*)(ws + WS_WSP); const int n8 = 2 * 16 * 128 * 128 / 8;
        for (int i = blockIdx.x * NTHR + F.tid; i < n8; i += F.G * NTHR) { const f32x4 a = *(const f32x4*)(src + (size_t)i * 8), b = *(const f32x4*)(src + (size_t)i * 8 + 4);
            u32x4 o; o.x = cvt_pk_bf16(a[0], a[1]); o.y = cvt_pk_bf16(a[2], a[3]); o.z = cvt_pk_bf16(b[0], b[1]); o.w = cvt_pk_bf16(b[2], b[3]); *(u32x4*)(dst + (size_t)i * 8) = o; } }
}
__device__ __forceinline__ void moe_weights_phase(const Frame& F, KP P, int layer) {
    unsigned char* ws = P->ws;
    for (int e = 0; e < NE; ++e) {
        const size_t so = ((size_t)layer * NE + e) * (size_t)D * EHID;
        conv_T(F, P->in[I_MWG] + so, EHID, D, D, (bf16_t*)(ws + WS_WGU) + (size_t)e * D * D, D, 0, 0, 1);
        conv_T(F, P->in[I_MWU] + so, EHID, D, D, (bf16_t*)(ws + WS_WGU) + (size_t)e * D * D, D, 0, 0, 2);
        conv_T(F, P->in[I_MWD] + so, D, EHID, EHID, (bf16_t*)(ws + WS_WD) + (size_t)e * D * EHID, EHID, 0, 0, 0);
    }
}

__device__ __forceinline__ const float* xrow_ptr(KP P, int layer, int row) {
    if (layer == 0) return row < TL ? P->in[I_X] + (size_t)row * D : P->in[I_CTX] + (size_t)(row - TL) * D;
    return (const float*)(P->ws + WS_X) + (size_t)row * D;
}
__device__ __forceinline__ void load_combine(KP P, const Frame& F, int layer, int row, int m, bool combine, f32x4 (&v)[4]) {
    const float* xr = xrow_ptr(P, layer, row);
#pragma unroll
    for (int j = 0; j < 4; ++j) v[j] = *(const f32x4*)(xr + 4 * F.lane + 256 * j);
    if (combine) {
        const bf16_t* yb = (const bf16_t*)(P->ws + WS_YB); const float* wg = (const float*)(P->ws + WS_WGT);
        const float w0 = wg[2 * row], w1 = wg[2 * row + 1]; const float* g2 = (const float*)(P->ws + WS_MOD) + ((size_t)(layer - 1) * 3 + m) * 6 * D + 5 * D;
#pragma unroll
        for (int j = 0; j < 4; ++j) { const int col = 4 * F.lane + 256 * j; const u32x2 a = *(const u32x2*)(yb + (size_t)(2 * row) * D + col), b = *(const u32x2*)(yb + (size_t)(2 * row + 1) * D + col);
            const f32x4 g = *(const f32x4*)(g2 + col);
            v[j][0] += g[0] * (w0 * bf_lo(a.x) + w1 * bf_lo(b.x)); v[j][1] += g[1] * (w0 * bf_hi(a.x) + w1 * bf_hi(b.x));
            v[j][2] += g[2] * (w0 * bf_lo(a.y) + w1 * bf_lo(b.y)); v[j][3] += g[3] * (w0 * bf_hi(a.y) + w1 * bf_hi(b.y)); }
    }
}
__device__ __forceinline__ void norm1_phase(const Frame& F, KP P, int layer) {
    const bool combine = layer > 0; float* X = (float*)(P->ws + WS_X); bf16_t* HL = (bf16_t*)(P->ws + WS_HL);
    const float* g1 = P->in[I_N1G] + (size_t)layer * D;
    for (int row = F.gw; row < T; row += F.NGW) {
        const int m = row < TL ? (row >> 14) : 2; f32x4 v[4];
        load_combine(P, F, layer, row, m, combine, v);
        if (combine) {
#pragma unroll
            for (int j = 0; j < 4; ++j) *(f32x4*)(X + (size_t)row * D + 4 * F.lane + 256 * j) = v[j]; }
        float ss = 0.f;
#pragma unroll
        for (int j = 0; j < 4; ++j) ss += (v[j][0] * v[j][0] + v[j][1] * v[j][1]) + (v[j][2] * v[j][2] + v[j][3] * v[j][3]);
        const float rstd = rsqrtf(wave_sum(ss) * (1.0f / D) + 1e-6f);
        const float* mod = (const float*)(P->ws + WS_MOD) + ((size_t)layer * 3 + m) * 6 * D;
#pragma unroll
        for (int j = 0; j < 4; ++j) { const int col = 4 * F.lane + 256 * j; const f32x4 g = *(const f32x4*)(g1 + col), sh = *(const f32x4*)(mod + col), sc = *(const f32x4*)(mod + D + col);
            const f32x4 h = (v[j] * rstd) * g * (sc + 1.0f) + sh;
            u32x2 o; o.x = cvt_pk_bf16(h[0], h[1]); o.y = cvt_pk_bf16(h[2], h[3]); *(u32x2*)(HL + (size_t)row * D + col) = o; }
    }
}
__device__ __forceinline__ void final_phase(const Frame& F, KP P) {
    const float* fg = P->in[I_FG];
    for (int row = F.gw; row < TL; row += F.NGW) {
        const int m = row >> 14; f32x4 v[4];
        load_combine(P, F, DEPTH, row, m, true, v);
        float ss = 0.f;
#pragma unroll
        for (int j = 0; j < 4; ++j) ss += (v[j][0] * v[j][0] + v[j][1] * v[j][1]) + (v[j][2] * v[j][2] + v[j][3] * v[j][3]);
        const float rstd = rsqrtf(wave_sum(ss) * (1.0f / D) + 1e-6f);
#pragma unroll
        for (int j = 0; j < 4; ++j) { const int col = 4 * F.lane + 256 * j; *(f32x4*)(P->out + (size_t)row * D + col) = (v[j] * rstd) * *(const f32x4*)(fg + col); }
    }
}
__device__ __forceinline__ void route_phase(const Frame& F, KP P, int layer) {
    const int ntok = layer == DEPTH - 1 ? TL : T; bf16_t* HL2 = (bf16_t*)(P->ws + WS_HL);
    const float* g2n = P->in[I_N2G] + (size_t)layer * D; const float* wgrp = P->in[I_MWGRP] + (size_t)layer * D * 4; const float* wexp = P->in[I_MWEXP] + (size_t)layer * D * NE;
    const float* bgrp = P->in[I_MBGRP] + layer * 4; const float* bexp = P->in[I_MBEXP] + layer * NE;
    unsigned* cnt = (unsigned*)(P->ws + WS_CTL) + CW_CNT + layer * 64; int* list = (int*)(P->ws + WS_LIST); float* wgt = (float*)(P->ws + WS_WGT);
    LAS float* hs = (LAS float*)F.lds + F.wave * 2 * D;
    for (int pr = F.gw; pr < ntok / 2; pr += F.NGW) {
        f32x4 h[2][4];
#pragma unroll
        for (int r = 0; r < 2; ++r) { const int row = 2 * pr + r; const int m = row < TL ? (row >> 14) : 2; const float* xr = xrow_ptr(P, 1, row);
#pragma unroll
            for (int j = 0; j < 4; ++j) h[r][j] = *(const f32x4*)(xr + 4 * F.lane + 256 * j);
            float ss = 0.f;
#pragma unroll
            for (int j = 0; j < 4; ++j) ss += (h[r][j][0] * h[r][j][0] + h[r][j][1] * h[r][j][1]) + (h[r][j][2] * h[r][j][2] + h[r][j][3] * h[r][j][3]);
            const float rstd = rsqrtf(wave_sum(ss) * (1.0f / D) + 1e-6f);
            const float* mod = (const float*)(P->ws + WS_MOD) + ((size_t)layer * 3 + m) * 6 * D;
#pragma unroll
            for (int j = 0; j < 4; ++j) { const int col = 4 * F.lane + 256 * j; const f32x4 g = *(const f32x4*)(g2n + col), sh = *(const f32x4*)(mod + 3 * D + col), sc = *(const f32x4*)(mod + 4 * D + col);
                h[r][j] = (h[r][j] * rstd) * g * (sc + 1.0f) + sh;
                u32x2 o; o.x = cvt_pk_bf16(h[r][j][0], h[r][j][1]); o.y = cvt_pk_bf16(h[r][j][2], h[r][j][3]); *(u32x2*)(HL2 + (size_t)row * D + col) = o; } }
        float ag[2][4], ae[2][NE];
#pragma unroll
        for (int r = 0; r < 2; ++r) {
#pragma unroll
            for (int i = 0; i < 4; ++i) ag[r][i] = 0.f;
#pragma unroll
            for (int i = 0; i < NE; ++i) ae[r][i] = 0.f; }
#pragma unroll
        for (int r = 0; r < 2; ++r)
#pragma unroll
            for (int j = 0; j < 4; ++j) *(LAS f32x4*)(hs + r * D + 4 * F.lane + 256 * j) = h[r][j];
        asm volatile("s_waitcnt lgkmcnt(0)" ::: "memory");
        {   const float* gp = wgrp + (size_t)F.lane * 4; const float* wp = wexp + (size_t)F.lane * NE;
#pragma unroll 2
            for (int it = 0; it < 16; ++it) { const float h0 = hs[F.lane + 64 * it], h1 = hs[D + F.lane + 64 * it];
                const f32x4 wg = *(const f32x4*)gp;
#pragma unroll
                for (int i = 0; i < 4; ++i) { ag[0][i] += h0 * wg[i]; ag[1][i] += h1 * wg[i]; }
#pragma unroll
                for (int q = 0; q < 8; ++q) { const f32x4 we = *(const f32x4*)(wp + 4 * q);
#pragma unroll
                    for (int i = 0; i < 4; ++i) { ae[0][4 * q + i] += h0 * we[i]; ae[1][4 * q + i] += h1 * we[i]; } }
                gp += 64 * 4; wp += 64 * NE; }
        }
        asm volatile("s_waitcnt lgkmcnt(0)" ::: "memory");
#pragma unroll
        for (int r = 0; r < 2; ++r) {
#pragma unroll
            for (int i = 0; i < 4; ++i) ag[r][i] = wave_sum(ag[r][i]) + bgrp[i];
#pragma unroll
            for (int i = 0; i < NE; ++i) ae[r][i] = wave_sum(ae[r][i]) + bexp[i];
            int grp = 0; float mx = ag[r][0];
#pragma unroll
            for (int i = 1; i < 4; ++i) if (ag[r][i] > mx) { mx = ag[r][i]; grp = i; }
            float den = 0.f;
#pragma unroll
            for (int i = 0; i < 4; ++i) den += __expf(ag[r][i] - mx);
            const float pg = 1.0f / den;
            float el[8];
#pragma unroll
            for (int i = 0; i < 8; ++i) { el[i] = ae[r][i];
#pragma unroll
                for (int g = 1; g < 4; ++g) if (grp == g) el[i] = ae[r][8 * g + i]; }
            int i0 = 0; float t0 = el[0];
#pragma unroll
            for (int i = 1; i < 8; ++i) if (el[i] > t0) { t0 = el[i]; i0 = i; }
            int i1 = -1; float t1 = -3.0e38f;
#pragma unroll
            for (int i = 0; i < 8; ++i) if (i != i0 && el[i] > t1) { t1 = el[i]; i1 = i; }
            const float p0 = 1.0f / (1.0f + __expf(t1 - t0)), w0 = pg * p0, w1 = pg * (1.0f - p0);
            if (F.lane == 0) { const int row = 2 * pr + r; const int e0 = grp * 8 + i0, e1 = grp * 8 + i1;
                const unsigned s0 = atomicAdd(cnt + e0, 1u), s1 = atomicAdd(cnt + e1, 1u);
                list[(size_t)e0 * LISTCAP + s0] = 2 * row; list[(size_t)e1 * LISTCAP + s1] = 2 * row + 1; wgt[2 * row] = w0; wgt[2 * row + 1] = w1; }
        }
    }
    __syncthreads();
    moe_weights_phase(F, P, layer);
}

__device__ __forceinline__ void spatial_phase(const Frame& F, KP P, int j) {
    bf16_t* U = (bf16_t*)(P->ws + WS_U); const bf16_t* V = (const bf16_t*)(P->ws + WS_V); const float* stat = (const float*)(P->ws + WS_STAT);
    const bf16_t* WSP = (const bf16_t*)(P->ws + WS_WSP) + (size_t)j * 16 * 128 * 128;
    const float* lng = P->in[I_GLNG] + (size_t)j * GWID; const float* lnb = P->in[I_GLNB] + (size_t)j * GWID; const float* bs = P->in[I_GBS] + (size_t)j * 16 * 128;
    LAS bf16_t* Wt = (LAS bf16_t*)F.lds; LAS bf16_t* Vt = Wt + 128 * 136;
    LAS float* mu = (LAS float*)(F.lds + 2 * 128 * 136 * 2); LAS float* rs = mu + 128;
    const int l15 = F.lane & 15, l4 = F.lane >> 4;
    for (int item = blockIdx.x; item < (T / 128) * 16; item += F.G) {
        const int c = item >> 4, g = item & 15, t0 = c * 128;
        __syncthreads();
        if (F.tid < 128) { const int row = t0 + F.tid; float s = 0.f, q = 0.f;
#pragma unroll 8
            for (int i = 0; i < 32; ++i) { const f32x2 p = *(const f32x2*)(stat + ((size_t)row * 32 + i) * 2); s += p.x; q += p.y; }
            const float mean = s * (1.0f / GWID), var = q * (1.0f / GWID) - mean * mean; mu[F.tid] = mean; rs[F.tid] = rsqrtf(var + 1e-5f); }
#pragma unroll
        for (int i = 0; i < 4; ++i) { const int idx = F.tid + NTHR * i, p = idx >> 4, seg = idx & 15;
            *(LAS u32x4*)(Wt + p * 136 + seg * 8) = *(const u32x4*)(WSP + ((size_t)g * 128 + p) * 128 + seg * 8); }
        __syncthreads();
#pragma unroll
        for (int i = 0; i < 4; ++i) { const int idx = F.tid + NTHR * i, q = idx >> 4, seg = idx & 15, ch = g * 128 + seg * 8;
            const u32x4 raw = *(const u32x4*)(V + (size_t)(t0 + q) * GWID + ch); const unsigned rw[4] = {raw.x, raw.y, raw.z, raw.w};
            const float m_ = mu[q], r_ = rs[q];
#pragma unroll
            for (int e = 0; e < 8; ++e) { const float x = (e & 1) ? bf_hi(rw[e >> 1]) : bf_lo(rw[e >> 1]);
                Vt[(seg * 8 + e) * 136 + q] = f2bf((x - m_) * r_ * lng[ch + e] + lnb[ch + e]); } }
        __syncthreads();
        bf16x8 bw[4];
#pragma unroll
        for (int ks = 0; ks < 4; ++ks) bw[ks] = *(const LAS bf16x8*)(Wt + (16 * F.wave + l15) * 136 + ks * 32 + 8 * l4);
        const int p = 16 * F.wave + l15; const float bias = bs[g * 128 + p];
#pragma unroll
        for (int dt = 0; dt < 8; ++dt) { f32x4 acc = (f32x4){0.f, 0.f, 0.f, 0.f};
#pragma unroll
            for (int ks = 0; ks < 4; ++ks) { const bf16x8 a = *(const LAS bf16x8*)(Vt + (dt * 16 + l15) * 136 + ks * 32 + 8 * l4); acc = __builtin_amdgcn_mfma_f32_16x16x32_bf16(a, bw[ks], acc, 0, 0, 0); }
            bf16_t* up = U + (size_t)(t0 + p) * GWID + g * 128 + dt * 16 + 4 * l4; const u32x2 uu = *(const u32x2*)up;
            u32x2 o; o.x = cvt_pk_bf16(bf_lo(uu.x) * (acc[0] + bias), bf_hi(uu.x) * (acc[1] + bias)); o.y = cvt_pk_bf16(bf_lo(uu.y) * (acc[2] + bias), bf_hi(uu.y) * (acc[3] + bias));
            *(u32x2*)up = o; }
    }
}

__device__ __forceinline__ void mix_phase(const Frame& F, KP P, int j) {
    const bf16_t* HL = (const bf16_t*)(P->ws + WS_HL); const float* mu = P->in[I_MU] + (size_t)j * 6 * D;
    bf16_t* outs[6] = {(bf16_t*)(P->ws + WS_XR), (bf16_t*)(P->ws + WS_XW), (bf16_t*)(P->ws + WS_XK), (bf16_t*)(P->ws + WS_XV), (bf16_t*)(P->ws + WS_XA), (bf16_t*)(P->ws + WS_XG)};
    for (int row = F.gw; row < T; row += F.NGW) {
        bool ok[2]; int src[2]; const bool hi = F.lane >= 32;
        if (row < TL) { const int n = row & (SEQ - 1), gc = n & 63, gr = n >> 6;
            ok[0] = hi ? gc < 63 : gc > 0; src[0] = hi ? row + 1 : row - 1; ok[1] = hi ? gr < 255 : gr > 0; src[1] = hi ? row + 64 : row - 64; }
        else { const int n = (row - TL) & (CTXL - 1); ok[0] = n > 0; src[0] = row - 1; ok[1] = n < CTXL - 1; src[1] = row + 1; }
#pragma unroll
        for (int jj = 0; jj < 2; ++jj) { const int col = 512 * jj + 8 * F.lane;
            const u32x4 h8 = *(const u32x4*)(HL + (size_t)row * D + col); u32x4 s8 = (u32x4){0u, 0u, 0u, 0u};
            if (ok[jj]) s8 = *(const u32x4*)(HL + (size_t)src[jj] * D + col);
            const unsigned hw[4] = {h8.x, h8.y, h8.z, h8.w}, sw[4] = {s8.x, s8.y, s8.z, s8.w}; float h[8], xx[8];
#pragma unroll
            for (int e = 0; e < 8; ++e) { h[e] = (e & 1) ? bf_hi(hw[e >> 1]) : bf_lo(hw[e >> 1]); const float s = (e & 1) ? bf_hi(sw[e >> 1]) : bf_lo(sw[e >> 1]); xx[e] = s - h[e]; }
#pragma unroll
            for (int m = 0; m < 6; ++m) { const f32x4 ma = *(const f32x4*)(mu + (size_t)m * D + col), mb = *(const f32x4*)(mu + (size_t)m * D + col + 4);
                u32x4 o; o.x = cvt_pk_bf16(h[0] + xx[0] * ma[0], h[1] + xx[1] * ma[1]); o.y = cvt_pk_bf16(h[2] + xx[2] * ma[2], h[3] + xx[3] * ma[3]);
                o.z = cvt_pk_bf16(h[4] + xx[4] * mb[0], h[5] + xx[5] * mb[1]); o.w = cvt_pk_bf16(h[6] + xx[6] * mb[2], h[7] + xx[7] * mb[3]);
                *(u32x4*)(outs[m] + (size_t)row * D + col) = o; } }
    }
}

__device__ __forceinline__ int scan_row(int z, int b, int p) {
    if (p < CTXL) return TL + b * CTXL + (z ? CTXL - 1 - p : p);
    const int q = p - CTXL; return b * SEQ + (z ? SEQ - 1 - q : q);
}
__device__ __forceinline__ void scan_phase(const Frame& F, KP P, int j) {
    if (blockIdx.x >= 64 || F.wave != 0) return;
    const int s = blockIdx.x, z = s >> 5, b = (s >> 4) & 1, hh = s & 15, ch = hh * 64 + F.lane;
    const bf16_t* Rb = (const bf16_t*)(P->ws + WS_R); const bf16_t* Kb = (const bf16_t*)(P->ws + WS_K); const bf16_t* Vb = (const bf16_t*)(P->ws + WS_VV);
    bf16_t* EL = (bf16_t*)(P->ws + (z ? WS_ELOG1 : WS_ELOG0)); const bf16_t* KM = (const bf16_t*)(P->ws + (z ? WS_KM1 : WS_KM0)); const bf16_t* AS = (const bf16_t*)(P->ws + (z ? WS_AS1 : WS_AS0));
    const float kkw = P->in[I_KK][(size_t)j * D + ch];
    float S[64];
#pragma unroll
    for (int k = 0; k < 64; ++k) S[k] = 0.f;
    const int NSTEP = CTXL + SEQ;
    size_t o = (size_t)scan_row(z, b, 0) * D + ch;
    bf16_t nr = Rb[o], nk = Kb[o], nv = Vb[o], ne = EL[o], nm = KM[o], na = AS[o];
    for (int p = 0; p < NSTEP; ++p) {
        const size_t oc = o; const float r = bf1(nr), k = bf1(nk), v = bf1(nv), el = bf1(ne), km = bf1(nm), as = bf1(na);
        if (p + 1 < NSTEP) { o = (size_t)scan_row(z, b, p + 1) * D + ch; nr = Rb[o]; nk = Kb[o]; nv = Vb[o]; ne = EL[o]; nm = KM[o]; na = AS[o]; }
        const float kr = k * kkw; const float kk = kr * rsqrtf(wave_sum(kr * kr) + 1e-12f);
        const float w = __expf(el), av = -kk, bv = kk * as;
        float sa = 0.f;
#pragma unroll
        for (int q = 0; q < 64; ++q) sa += S[q] * __int_as_float(__builtin_amdgcn_readlane(__float_as_int(av), q));
        float y = 0.f;
#pragma unroll
        for (int q = 0; q < 64; ++q) {
            const float wq = __int_as_float(__builtin_amdgcn_readlane(__float_as_int(w), q)), bq = __int_as_float(__builtin_amdgcn_readlane(__float_as_int(bv), q));
            const float kq = __int_as_float(__builtin_amdgcn_readlane(__float_as_int(km), q)), rq = __int_as_float(__builtin_amdgcn_readlane(__float_as_int(r), q));
            S[q] = S[q] * wq + sa * bq + v * kq; y += S[q] * rq; }
        EL[oc] = f2bf(y);
    }
}

__device__ __forceinline__ void rwkv_out_phase(const Frame& F, KP P, int j) {
    const bf16_t* Y0 = (const bf16_t*)(P->ws + WS_ELOG0); const bf16_t* Y1 = (const bf16_t*)(P->ws + WS_ELOG1); const bf16_t* Rb = (const bf16_t*)(P->ws + WS_R); const bf16_t* Vb = (const bf16_t*)(P->ws + WS_VV);
    const bf16_t* KM0 = (const bf16_t*)(P->ws + WS_KM0); const bf16_t* KM1 = (const bf16_t*)(P->ws + WS_KM1); const bf16_t* GT = (const bf16_t*)(P->ws + WS_GATE); bf16_t* YG = (bf16_t*)(P->ws + WS_YG);
    const float* lng = P->in[I_LNG] + (size_t)j * D; const float* lnb = P->in[I_LNB] + (size_t)j * D; const float* rk = P->in[I_RK] + (size_t)j * D;
    for (int row = F.gw; row < T; row += F.NGW) {
        const size_t o = (size_t)row * D + 16 * F.lane; float y[16], r[16], km[16], v[16], g[16];
#pragma unroll
        for (int hx = 0; hx < 2; ++hx) { const u32x4 a = *(const u32x4*)(Y0 + o + 8 * hx), b = *(const u32x4*)(Y1 + o + 8 * hx), c = *(const u32x4*)(Rb + o + 8 * hx), d = *(const u32x4*)(KM0 + o + 8 * hx),
                e = *(const u32x4*)(KM1 + o + 8 * hx), f = *(const u32x4*)(Vb + o + 8 * hx), gg = *(const u32x4*)(GT + o + 8 * hx);
            const unsigned aw[4] = {a.x, a.y, a.z, a.w}, bw[4] = {b.x, b.y, b.z, b.w}, cw[4] = {c.x, c.y, c.z, c.w}, dw[4] = {d.x, d.y, d.z, d.w}, ew[4] = {e.x, e.y, e.z, e.w}, fw[4] = {f.x, f.y, f.z, f.w}, gw4[4] = {gg.x, gg.y, gg.z, gg.w};
#pragma unroll
            for (int i = 0; i < 8; ++i) { const int q = i >> 1; const bool od = i & 1;
                y[8 * hx + i] = (od ? bf_hi(aw[q]) : bf_lo(aw[q])) + (od ? bf_hi(bw[q]) : bf_lo(bw[q])); r[8 * hx + i] = od ? bf_hi(cw[q]) : bf_lo(cw[q]);
                km[8 * hx + i] = (od ? bf_hi(dw[q]) : bf_lo(dw[q])) + (od ? bf_hi(ew[q]) : bf_lo(ew[q])); v[8 * hx + i] = od ? bf_hi(fw[q]) : bf_lo(fw[q]); g[8 * hx + i] = od ? bf_hi(gw4[q]) : bf_lo(gw4[q]); } }
        float s = 0.f, bn = 0.f;
#pragma unroll
        for (int i = 0; i < 16; ++i) { s += y[i]; bn += r[i] * rk[16 * F.lane + i] * km[i]; }
        s += __shfl_xor(s, 1); s += __shfl_xor(s, 2); bn += __shfl_xor(bn, 1); bn += __shfl_xor(bn, 2);
        const float mean = s * (1.0f / 64.0f); float q = 0.f;
#pragma unroll
        for (int i = 0; i < 16; ++i) { const float d = y[i] - mean; q += d * d; }
        q += __shfl_xor(q, 1); q += __shfl_xor(q, 2);
        const float rstd = rsqrtf(q * (1.0f / 64.0f) + 64e-5f);
        float ov[16];
#pragma unroll
        for (int i = 0; i < 16; ++i) { const int cix = 16 * F.lane + i; ov[i] = (((y[i] - mean) * rstd) * lng[cix] + lnb[cix] + bn * v[i]) * g[i]; }
#pragma unroll
        for (int hx = 0; hx < 2; ++hx) { u32x4 w; w.x = cvt_pk_bf16(ov[8 * hx], ov[8 * hx + 1]); w.y = cvt_pk_bf16(ov[8 * hx + 2], ov[8 * hx + 3]); w.z = cvt_pk_bf16(ov[8 * hx + 4], ov[8 * hx + 5]); w.w = cvt_pk_bf16(ov[8 * hx + 6], ov[8 * hx + 7]);
            *(u32x4*)(YG + o + 8 * hx) = w; }
    }
}

__device__ __forceinline__ bool in_range(int lo, int hi, int k) { asm volatile("" : "+s"(lo), "+s"(hi)); return lo <= k && k < hi; }
constexpr int NPH = 36;
template <unsigned KMASK> __global__ void __launch_bounds__(NTHR, 2) mega(Params Pv) {
    extern __shared__ __attribute__((aligned(16))) unsigned char lds_raw[];
    Frame F0; F0.lds = (LAS unsigned char*)lds_raw; F0.tid = threadIdx.x; F0.lane = F0.tid & 63; F0.wave = __builtin_amdgcn_readfirstlane(F0.tid >> 6);
    F0.G = gridDim.x; F0.gw = blockIdx.x * NWAVES + F0.wave; F0.NGW = F0.G * NWAVES;
    LAS unsigned* misc = (LAS unsigned*)(F0.lds + LDS_MISC);
    if (F0.tid < 128) misc[F0.tid] = 0u;
    __syncthreads();
    KP P0 = (KP)__builtin_amdgcn_kernarg_segment_ptr();
    constexpr bool ALL = (KMASK == 0x3fffu);
    const int lo = ALL ? 0 : P0->ph_lo, hi = ALL ? NPH : P0->ph_hi;
    XcdBarrier bar; bar.bar = (unsigned*)(P0->ws + WS_CTL) + CW_BAR; bar.x = 0; bar.st = (volatile LAS unsigned*)(misc + 8);
    if (ALL || hi - lo > 1) bar = xcd_barrier_post((unsigned*)(P0->ws + WS_CTL) + CW_BAR, (volatile LAS unsigned*)(misc + 8));
#define IN(k) (ALL || in_range(lo, hi, (k)))
#define KIND(q) ((KMASK >> (q)) & 1u)
#define SEAM(k) do { if (IN(k) && IN((k) + 1)) xcd_barrier(bar); } while (0)
#define PHASE_ENTRY KP P = P0; asm volatile("" : "+s"(P)); unsigned char* ws = P->ws; unsigned* ctl = (unsigned*)(ws + WS_CTL); (void)ctl; \
    Frame F = F0; { int t_ = F0.tid; asm volatile("" : "+v"(t_)); F.tid = t_; F.lane = t_ & 63; F.wave = __builtin_amdgcn_readfirstlane(t_ >> 6); F.gw = blockIdx.x * NWAVES + F.wave; }

    if constexpr (KIND(0)) if (IN(0)) { PHASE_ENTRY prologue_phase(F, P); }
    SEAM(0);
    for (int lp = 0; lp < 2; ++lp) {
        const int pb = 1 + 17 * lp, la = 2 * lp, lb = 2 * lp + 1;
        if constexpr (KIND(1)) if (IN(pb + 0)) { PHASE_ENTRY norm1_phase(F, P, la); }
        SEAM(pb + 0);
        if constexpr (KIND(2)) if (IN(pb + 1)) { PHASE_ENTRY
            __syncthreads(); set_desc(F.lds, 0, ws + WS_HL, ws + WS_WIN + (size_t)lp * 4096 * D * 2, ws + WS_U, 16, 0, 0, ws + WS_V, P->in[I_GBIN] + (size_t)lp * 4096, ws + WS_STAT); __syncthreads();
            SchedMulti<D, D> S{F.lds, T / 256, 16, 1};
            EpiGelu E{F.lds};
            pg8::gemm_phase<EpiGelu, SchedMulti<D, D>, false, D, D, D>(F.lds, S, E);
        }
        SEAM(pb + 1);
        if constexpr (KIND(3)) if (IN(pb + 2)) { PHASE_ENTRY spatial_phase(F, P, lp); }
        SEAM(pb + 2);
        if constexpr (KIND(4)) if (IN(pb + 3)) { PHASE_ENTRY
            __syncthreads(); { float* X = (float*)(ws + WS_X);
              set_desc(F.lds, 0, ws + WS_U, ws + WS_WOUT + (size_t)lp * D * GWID * 2, X, 4, 0, 0, la == 0 ? P->in[I_X] : X, la == 0 ? P->in[I_CTX] : X + (size_t)TL * D, P->in[I_GBOUT] + (size_t)lp * D);
              set_desc(F.lds, 1, nullptr, nullptr, nullptr, 0, 0, 0, (const float*)(ws + WS_MOD) + (size_t)la * 3 * 6 * D + 2 * D); }
            __syncthreads();
            SchedMulti<GWID, GWID> S{F.lds, T / 256, 4, 1};
            EpiResid E{F.lds};
            pg8::gemm_phase<EpiResid, SchedMulti<GWID, GWID>, false, GWID, GWID, GWID>(F.lds, S, E);
        }
        SEAM(pb + 3);
        if constexpr (KIND(5)) if (IN(pb + 4)) { PHASE_ENTRY route_phase(F, P, la); }
        SEAM(pb + 4);
        if constexpr (KIND(6)) if (IN(pb + 5)) { PHASE_ENTRY
            moe_tables(F.lds, ctl + CW_CNT + la * 64);
            SchedMoE<D, D, true> S{F.lds, (const char*)(ws + WS_HL), (const char*)(ws + WS_WGU), (const int*)(ws + WS_LIST)};
            EpiSiluGate E{(bf16_t*)(ws + WS_H)};
            pg8::gemm_phase<EpiSiluGate, SchedMoE<D, D, true>, true, D, D, D>(F.lds, S, E);
        }
        SEAM(pb + 5);
        if constexpr (KIND(7)) if (IN(pb + 6)) { PHASE_ENTRY
            moe_tables(F.lds, ctl + CW_CNT + la * 64);
            SchedMoE<EHID, EHID, false> S{F.lds, (const char*)(ws + WS_H), (const char*)(ws + WS_WD), (const int*)(ws + WS_LIST)};
            EpiScatter E{F.lds, (bf16_t*)(ws + WS_YB), (const int*)(ws + WS_LIST)};
            pg8::gemm_phase<EpiScatter, SchedMoE<EHID, EHID, false>, false, EHID, EHID, EHID>(F.lds, S, E);
        }
        SEAM(pb + 6);
        if constexpr (KIND(1)) if (IN(pb + 7)) { PHASE_ENTRY norm1_phase(F, P, lb); }
        SEAM(pb + 7);
        if constexpr (KIND(8)) if (IN(pb + 8)) { PHASE_ENTRY mix_phase(F, P, lp); }
        SEAM(pb + 8);
        if constexpr (KIND(9)) if (IN(pb + 9)) { PHASE_ENTRY
            __syncthreads();
            set_desc(F.lds, 0, ws + WS_XR, ws + WS_WR + (size_t)lp * D * D * 2, ws + WS_R, 4, D, 0);
            set_desc(F.lds, 1, ws + WS_XK, ws + WS_WK + (size_t)lp * D * D * 2, ws + WS_K, 4, D, 0);
            set_desc(F.lds, 2, ws + WS_XV, ws + WS_WV + (size_t)lp * D * D * 2, ws + WS_VV, 4, D, 0);
            set_desc(F.lds, 3, ws + WS_XW, ws + WS_LW1 + (size_t)lp * 256 * D * 2, ws + WS_TW, 1, 256, 1);
            set_desc(F.lds, 4, ws + WS_XA, ws + WS_LA1 + (size_t)lp * 256 * D * 2, ws + WS_TA, 1, 256, 0);
            set_desc(F.lds, 5, ws + WS_XG, ws + WS_LG1 + (size_t)lp * 256 * D * 2, ws + WS_TG, 1, 256, 2);
            __syncthreads();
            SchedMulti<D, D> S{F.lds, T / 256, 15, 6};
            EpiAct E{F.lds};
            pg8::gemm_phase<EpiAct, SchedMulti<D, D>, false, D, D, D>(F.lds, S, E);
        }
        SEAM(pb + 9);
        if constexpr (KIND(10)) if (IN(pb + 10)) { PHASE_ENTRY
            __syncthreads();
            set_desc(F.lds, 0, ws + WS_TW, ws + WS_W2P + ((size_t)lp * 2 + 0) * D * 256 * 2, ws + WS_ELOG0, 4, D, 0, P->in[I_W0] + (size_t)lp * 2 * D, nullptr);
            set_desc(F.lds, 1, ws + WS_TW, ws + WS_W2P + ((size_t)lp * 2 + 1) * D * 256 * 2, ws + WS_ELOG1, 4, D, 1, P->in[I_W0] + (size_t)lp * 2 * D + D, nullptr);
            set_desc(F.lds, 2, ws + WS_TA, ws + WS_A2P + ((size_t)lp * 2 + 0) * D * 256 * 2, ws + WS_KM0, 4, D, 2, P->in[I_A0] + (size_t)lp * 2 * D, ws + WS_AS0);
            set_desc(F.lds, 3, ws + WS_TA, ws + WS_A2P + ((size_t)lp * 2 + 1) * D * 256 * 2, ws + WS_KM1, 4, D, 3, P->in[I_A0] + (size_t)lp * 2 * D + D, ws + WS_AS1);
            set_desc(F.lds, 4, ws + WS_TG, ws + WS_G2P + (size_t)lp * D * 256 * 2, ws + WS_GATE, 4, D, 4);
            set_desc(F.lds, 5, nullptr, nullptr, nullptr, 0, 0, 0, P->in[I_KA] + (size_t)lp * D, ws + WS_K);
            __syncthreads();
            SchedMulti<256, 256> S{F.lds, T / 256, 20, 5};
            EpiLora2 E{F.lds};
            pg8::gemm_phase<EpiLora2, SchedMulti<256, 256>, false, 256, 256, 256>(F.lds, S, E);
        }
        SEAM(pb + 10);
        if constexpr (KIND(11)) if (IN(pb + 11)) { PHASE_ENTRY scan_phase(F, P, lp); }
        SEAM(pb + 11);
        if constexpr (KIND(12)) if (IN(pb + 12)) { PHASE_ENTRY rwkv_out_phase(F, P, lp); }
        SEAM(pb + 12);
        if constexpr (KIND(4)) if (IN(pb + 13)) { PHASE_ENTRY
            __syncthreads(); { float* X = (float*)(ws + WS_X);
              set_desc(F.lds, 0, ws + WS_YG, ws + WS_WO + (size_t)lp * D * D * 2, X, 4, 0, 0, X, X + (size_t)TL * D, nullptr);
              set_desc(F.lds, 1, nullptr, nullptr, nullptr, 0, 0, 0, (const float*)(ws + WS_MOD) + (size_t)lb * 3 * 6 * D + 2 * D); }
            __syncthreads();
            SchedMulti<D, D> S{F.lds, T / 256, 4, 1};
            EpiResid E{F.lds};
            pg8::gemm_phase<EpiResid, SchedMulti<D, D>, false, D, D, D>(F.lds, S, E);
        }
        SEAM(pb + 13);
        if constexpr (KIND(5)) if (IN(pb + 14)) { PHASE_ENTRY route_phase(F, P, lb); }
        SEAM(pb + 14);
        if constexpr (KIND(6)) if (IN(pb + 15)) { PHASE_ENTRY
            moe_tables(F.lds, ctl + CW_CNT + lb * 64);
            SchedMoE<D, D, true> S{F.lds, (const char*)(ws + WS_HL), (const char*)(ws + WS_WGU), (const int*)(ws + WS_LIST)};
            EpiSiluGate E{(bf16_t*)(ws + WS_H)};
            pg8::gemm_phase<EpiSiluGate, SchedMoE<D, D, true>, true, D, D, D>(F.lds, S, E);
        }
        SEAM(pb + 15);
        if constexpr (KIND(7)) if (IN(pb + 16)) { PHASE_ENTRY
            moe_tables(F.lds, ctl + CW_CNT + lb * 64);
            SchedMoE<EHID, EHID, false> S{F.lds, (const char*)(ws + WS_H), (const char*)(ws + WS_WD), (const int*)(ws + WS_LIST)};
            EpiScatter E{F.lds, (bf16_t*)(ws + WS_YB), (const int*)(ws + WS_LIST)};
            pg8::gemm_phase<EpiScatter, SchedMoE<EHID, EHID, false>, false, EHID, EHID, EHID>(F.lds, S, E);
        }
        SEAM(pb + 16);
    }
    if constexpr (KIND(13)) if (IN(35)) { PHASE_ENTRY final_phase(F, P); }
#undef IN
#undef KIND
#undef SEAM
#undef PHASE_ENTRY
}

#if !MK_ONE_LAUNCH
static int phase_kind(int ph) { if (ph == 0) return 0; if (ph == 35) return 13; static const int k17[17] = {1, 2, 3, 4, 5, 6, 7, 1, 8, 9, 10, 11, 12, 4, 5, 6, 7}; return k17[(ph - 1) % 17]; }
typedef void (*kern_t)(Params);
template <unsigned KM> static kern_t kern_of() { return mega<KM>; }
static kern_t kind_kernel(int kind) {
    switch (kind) { case 0: return kern_of<1u << 0>(); case 1: return kern_of<1u << 1>(); case 2: return kern_of<1u << 2>(); case 3: return kern_of<1u << 3>(); case 4: return kern_of<1u << 4>();
        case 5: return kern_of<1u << 5>(); case 6: return kern_of<1u << 6>(); case 7: return kern_of<1u << 7>(); case 8: return kern_of<1u << 8>(); case 9: return kern_of<1u << 9>();
        case 10: return kern_of<1u << 10>(); case 11: return kern_of<1u << 11>(); case 12: return kern_of<1u << 12>(); default: return kern_of<1u << 13>(); }
}
#endif
extern "C" void kernel_launch(void* const* d_in, const int* in_sizes, int n_in, void* d_out, int out_size, void* d_ws, size_t ws_size, hipStream_t stream) {
    static int grid = 0;
    if (grid == 0) {
        if (n_in != 42 || out_size != TL * D || ws_size < WS_END) { fprintf(stderr, "kernel_launch: unexpected problem (n_in %d, out %d, ws %zu < %zu)\n", n_in, out_size, ws_size, (size_t)WS_END); grid = -1; return; }
        int dev = 0, cus = 0;
        if (hipGetDevice(&dev) != hipSuccess || hipDeviceGetAttribute(&cus, hipDeviceAttributeMultiprocessorCount, dev) != hipSuccess) { grid = -1; return; }
#if MK_ONE_LAUNCH
        if (hipFuncSetAttribute((const void*)mega<0x3fffu>, hipFuncAttributeMaxDynamicSharedMemorySize, LDS_BYTES) != hipSuccess) { fprintf(stderr, "kernel_launch: hipFuncSetAttribute failed\n"); grid = -1; return; }
#else
        for (int k = 0; k < 14; ++k) if (hipFuncSetAttribute((const void*)kind_kernel(k), hipFuncAttributeMaxDynamicSharedMemorySize, LDS_BYTES) != hipSuccess) { fprintf(stderr, "kernel_launch: hipFuncSetAttribute failed\n"); grid = -1; return; }
#endif
        (void)hipGetLastError();
        grid = cus;
    }
    if (grid < 0) return;
    (void)hipMemsetAsync((char*)d_ws + WS_CTL, 0, CTL_BYTES, stream);
    Params p{};
    for (int i = 0; i < 42; ++i) p.in[i] = (const float*)d_in[i];
    p.out = (float*)d_out; p.ws = (unsigned char*)d_ws;
#if MK_ONE_LAUNCH
    p.ph_lo = 0; p.ph_hi = NPH;
    hipLaunchKernelGGL(mega<0x3fffu>, dim3(grid), dim3(NTHR), LDS_BYTES, stream, p);
#else
    for (int ph = 0; ph < NPH; ++ph) { p.ph_lo = ph; p.ph_hi = ph + 1; hipLaunchKernelGGL(kind_kernel(phase_kind(ph)), dim3(grid), dim3(NTHR), LDS_BYTES, stream, p); }
#endif
}
```

```cpp
#include <hip/hip_runtime.h>
#include <cstdio>
#include <cstdint>

#define LAS __attribute__((address_space(3)))
typedef unsigned short bf16_t;
typedef short bf16x8 __attribute__((ext_vector_type(8)));
typedef float f32x4 __attribute__((ext_vector_type(4)));
typedef float f32x2 __attribute__((ext_vector_type(2)));
typedef unsigned u32x4 __attribute__((ext_vector_type(4)));
typedef unsigned u32x2 __attribute__((ext_vector_type(2)));

#ifndef MK_ONE_LAUNCH
#define MK_ONE_LAUNCH 1
#endif

constexpr int D = 1024, NBATCH = 2, SEQ = 16384, CTXL = 256, DEPTH = 4;
constexpr int TL = NBATCH * SEQ, TC = NBATCH * CTXL, T = TL + TC;
constexpr int GWID = 2048, NE = 32, EHID = 512, NH = 16, HD = 64;
constexpr int LISTCAP = T;
constexpr int MAXRT = (2 * T) / 256 + NE;
constexpr int NWAVES = 8, NTHR = 512;

constexpr size_t MiB = 1u << 20;
constexpr size_t WS_CTL = 0, CTL_BYTES = 1 * MiB;
constexpr size_t WS_MOD = 1 * MiB;
constexpr size_t WS_WIN = 2 * MiB, WS_WOUT = 18 * MiB, WS_WSP = 26 * MiB, WS_WR = 27 * MiB, WS_WK = 31 * MiB, WS_WV = 35 * MiB, WS_WO = 39 * MiB;
constexpr size_t WS_LW1 = 43 * MiB, WS_LA1 = 44 * MiB, WS_LG1 = 45 * MiB, WS_W2P = 46 * MiB, WS_A2P = 48 * MiB, WS_G2P = 50 * MiB;
constexpr size_t WS_WGU = 52 * MiB, WS_WD = 116 * MiB;
constexpr size_t WS_X = 148 * MiB;
constexpr size_t WS_LIST = 278 * MiB, WS_WGT = 283 * MiB;
constexpr size_t WS_HL = 284 * MiB;
constexpr size_t WS_BIG = 349 * MiB;
constexpr size_t SZB = 65 * MiB;
constexpr size_t WS_U = WS_BIG, WS_V = WS_BIG + 2 * SZB, WS_STAT = WS_BIG + 4 * SZB;
constexpr size_t WS_XR = WS_BIG, WS_XW = WS_BIG + SZB, WS_XK = WS_BIG + 2 * SZB, WS_XV = WS_BIG + 3 * SZB, WS_XA = WS_BIG + 4 * SZB, WS_XG = WS_BIG + 5 * SZB;
constexpr size_t WS_R = WS_BIG + 6 * SZB, WS_K = WS_BIG + 7 * SZB, WS_VV = WS_BIG + 8 * SZB;
constexpr size_t WS_TW = WS_BIG + 9 * SZB, WS_TA = WS_TW + 17 * MiB, WS_TG = WS_TA + 17 * MiB;
constexpr size_t WS_ELOG0 = WS_XR, WS_ELOG1 = WS_XW, WS_KM0 = WS_XK, WS_KM1 = WS_XV, WS_AS0 = WS_XA, WS_AS1 = WS_XG;
constexpr size_t WS_GATE = WS_HL, WS_YG = WS_AS0;
constexpr size_t WS_H = WS_BIG, WS_YB = WS_BIG + 73 * MiB;
constexpr size_t WS_PQ = WS_TW;
constexpr size_t WS_SST = WS_WGU;
constexpr size_t WS_END = WS_PQ + 131 * MiB;
static_assert(WS_END <= 1080 * MiB, "workspace map");
constexpr int CW_BAR = 4096;
constexpr int CW_CNT = 16384;

typedef __bf16 bf16x2_t __attribute__((ext_vector_type(2)));
__device__ __forceinline__ unsigned cvt_pk_bf16(float lo, float hi) { const bf16x2_t v = __builtin_convertvector((f32x2){lo, hi}, bf16x2_t); return __builtin_bit_cast(unsigned, v); }
__device__ __forceinline__ float bf_lo(unsigned u) { return __uint_as_float(u << 16); }
__device__ __forceinline__ float bf_hi(unsigned u) { return __uint_as_float(u & 0xffff0000u); }
__device__ __forceinline__ float bf1(bf16_t b) { return __uint_as_float(((unsigned)b) << 16); }
__device__ __forceinline__ bf16_t f2bf(float f) { return (bf16_t)(cvt_pk_bf16(f, 0.f) & 0xffffu); }
__device__ __forceinline__ float wave_sum(float v) {
#pragma unroll
    for (int o = 1; o < 64; o <<= 1) v += __shfl_xor(v, o);
    return v;
}
__device__ __forceinline__ float sigmoidf_(float x) { return 1.0f / (1.0f + __expf(-x)); }
__device__ __forceinline__ float tanhf_(float x) { const float e = __expf(2.0f * x); return 1.0f - 2.0f / (e + 1.0f); }
__device__ __forceinline__ f32x2 gelu_pk(f32x2 v) {
    const f32x2 av = __builtin_elementwise_abs(v), d = av * 0.2316418882f + 1.0f;
    f32x2 t; t.x = __builtin_amdgcn_rcpf(d.x); t.y = __builtin_amdgcn_rcpf(d.y);
    f32x2 q = t * 0.5307027145f + (-0.7265760135f); q = q * t + 0.7107068705f; q = q * t + (-0.142248368f); q = q * t + 0.127414796f; q = q * t;
    const f32x2 s = (v * v) * (-0.72134752044f);
    f32x2 e; e.x = __builtin_amdgcn_exp2f(s.x); e.y = __builtin_amdgcn_exp2f(s.y);
    const f32x2 m = v * (q * e), r = v - m;
    f32x2 o; o.x = v.x < 0.f ? m.x : r.x; o.y = v.y < 0.f ? m.y : r.y; return o;
}

#define XB_TMO      128
#define XB_XCNT(j)  (256  + 64 * (j))
#define XB_XSUB(j)  (1280 + 64 * (j))
#define XB_XGEN(j)  (2304 + 64 * (j))
#define XB_TOP      3328
#define XB_TOPGEN   3392
#define XCD_BAR_WORDS 3456
#define XB_SPIN_CAP (1u << 18)
__device__ __forceinline__ unsigned xb_ld(unsigned* p)              { return __hip_atomic_load(p, __ATOMIC_RELAXED, __HIP_MEMORY_SCOPE_AGENT); }
__device__ __forceinline__ unsigned xb_add(unsigned* p, unsigned v) { return __hip_atomic_fetch_add(p, v, __ATOMIC_RELAXED, __HIP_MEMORY_SCOPE_AGENT); }
__device__ __forceinline__ unsigned xb_xcc_id() { return (unsigned)__builtin_amdgcn_s_getreg((3 << 11) | 20) & 0xFu; }
#define XB_SPIN(cond, bar) do { unsigned _sp = 0; while (cond) { __builtin_amdgcn_s_sleep(1); \
    if ((++_sp & 255u) == 0u) { if (xb_ld(&(bar)[XB_TMO])) break; if (_sp > XB_SPIN_CAP) { atomicAdd(&(bar)[XB_TMO], 1u); break; } } } } while (0)
struct XcdBarrier { unsigned* bar; unsigned x; volatile LAS unsigned* st; };
__device__ __forceinline__ XcdBarrier xcd_barrier_post(unsigned* bar, volatile LAS unsigned* st) {
    XcdBarrier b; b.bar = bar; b.x = xb_xcc_id(); b.st = st;
    if (threadIdx.x == 0) (void)xb_add(&bar[XB_XCNT(b.x)], 1u);
    return b;
}
__device__ __forceinline__ void xcd_barrier_complete(unsigned* bar, unsigned x, unsigned& nloc, unsigned& nx) {
    const unsigned G = gridDim.x * gridDim.y * gridDim.z;
    unsigned sum, cnt, mine, sp = 0u;
    for (;;) {
        sum = 0u; cnt = 0u; mine = 0u;
#pragma unroll
        for (unsigned j = 0; j < 16; ++j) { const unsigned c = xb_ld(&bar[XB_XCNT(j)]); sum += c; cnt += (c > 0u) ? 1u : 0u; mine = (j == x) ? c : mine; }
        if (sum == G) break;
        __builtin_amdgcn_s_sleep(1);
        if ((++sp & 255u) == 0u) { if (xb_ld(&bar[XB_TMO])) break; if (sp > XB_SPIN_CAP) { atomicAdd(&bar[XB_TMO], 1u); break; } }
    }
    nloc = mine > 0u ? mine : 1u; nx = cnt > 0u ? cnt : 1u;
}
__device__ __forceinline__ void xcd_barrier(const XcdBarrier& b) {
    asm volatile("s_waitcnt vmcnt(0)" ::: "memory");
    __syncthreads();
    if (threadIdx.x == 0) {
        unsigned* bar = b.bar;
        __builtin_amdgcn_s_waitcnt(0);
        unsigned nloc = b.st[0], nx = b.st[1];
        if (nloc == 0u) { xcd_barrier_complete(bar, b.x, nloc, nx); b.st[0] = nloc; b.st[1] = nx; }
        const unsigned old = xb_add(&bar[XB_XSUB(b.x)], 1u);
        const unsigned gen = old / nloc;
        if (old + 1u == (gen + 1u) * nloc) {
            __builtin_amdgcn_fence(__ATOMIC_RELEASE, "agent");
            asm volatile("s_waitcnt vmcnt(0)" ::: "memory");
            const unsigned og = xb_add(&bar[XB_TOP], 1u);
            const unsigned tg = og / nx;
            if (og + 1u == (tg + 1u) * nx) xb_add(&bar[XB_TOPGEN], 1u);
            else XB_SPIN(xb_ld(&bar[XB_TOPGEN]) == tg, bar);
            __builtin_amdgcn_fence(__ATOMIC_ACQUIRE, "agent");
            xb_add(&bar[XB_XGEN(b.x)], 1u);
            asm volatile("s_waitcnt vmcnt(0)" ::: "memory");
        } else {
            XB_SPIN(xb_ld(&bar[XB_XGEN(b.x)]) == gen, bar);
            __builtin_amdgcn_fence(__ATOMIC_ACQUIRE, "agent");
            asm volatile("s_waitcnt vmcnt(0)" ::: "memory");
        }
    }
    __syncthreads();
}

constexpr int LDS_MISC = 143360;
constexpr int LDS_DESC = LDS_MISC + 128;
constexpr int LDS_TAB = LDS_MISC + 512;
constexpr int LDS_BYTES = 147456;
namespace pg8 {
constexpr int BM = 256, BK = 64, HALF = 128, HTB = HALF * BK * 2, STAGE_BYTES = 8 * HTB, NXCD = 8, WGM = 8;
__host__ __device__ __forceinline__ int lds_byte(int r, int c) { const int st = (r >> 4) * 2 + (c >> 5), rr = r & 15, cc = c & 31, ob = rr * 64 + cc * 2; return st * 1024 + (ob ^ (((ob >> 9) & 1) << 5)); }
__host__ __device__ __forceinline__ void stage_rc(int b, int& R, int& C) { const int st = b / 1024, sb = b % 1024, swz = sb ^ (((sb >> 9) & 1) << 5); R = (st >> 1) * 16 + swz / 64; C = (st & 1) * 32 + (swz % 64) / 2; }
__host__ __device__ __forceinline__ int perm32(int rho) { const int n = rho >> 4, i = rho & 15; return 8 * (i >> 2) + 4 * n + (i & 3); }
__device__ __forceinline__ int xcd_remap(int L, int nwg) { const int q = nwg / NXCD, r = nwg % NXCD, xcd = L % NXCD, off = L / NXCD; return (xcd < r ? xcd * (q + 1) : r * (q + 1) + (xcd - r) * q) + off; }

struct Unit { int pm, pn, aux; };

template <class Epi, class Sched, bool GATHER, int K, int LDA, int LDB>
__device__ __forceinline__ void gemm_phase(LAS unsigned char* lds, const Sched& S, const Epi& E) {
    int tid_ = threadIdx.x; asm volatile("" : "+v"(tid_));
    const int tid = tid_, wid = __builtin_amdgcn_readfirstlane(tid >> 6), lane = tid & 63, wr = wid >> 2, wc = wid & 3, fr = lane & 15, fq = lane >> 4;
    constexpr int nt = K / BK;
    unsigned voffA[2], voffB[2];
#pragma unroll
    for (int i = 0; i < 2; ++i) { int R, C; stage_rc(tid * 16 + i * 8192, R, C); const int Rb = Epi::PERM ? ((R & ~31) + perm32(R & 31)) : R;
        voffA[i] = (unsigned)(R * LDA + C) * 2u; voffB[i] = (unsigned)(Rb * LDB + C) * 2u; }
    constexpr size_t kstep = (size_t)(BK * 2);
    constexpr size_t hstepA = GATHER ? (size_t)0 : (size_t)HALF * LDA * 2, hstepB = (size_t)HALF * LDB * 2;
    const unsigned ldsw = (unsigned)wid * 1024u;
    const int aoff = lds_byte(wr * 64 + fr, fq * 8), boff = lds_byte(wc * 32 + fr, fq * 8);
    unsigned gA[2][2], gN[2][2];
#define PG8_SA(b, h) (((b) * 2 + (h)) * HTB)
#define PG8_SB(b, h) ((4 + (b) * 2 + (h)) * HTB)
#define PG8_STAGEB(bufoff, gbase) do { _Pragma("unroll") for (int _i = 0; _i < 2; ++_i) \
        __builtin_amdgcn_global_load_lds((const unsigned*)((const char*)(gbase) + voffB[_i]), (LAS unsigned*)(lds + (bufoff) + ldsw + _i * 8192), 16, 0, 0); } while (0)
#define PG8_STAGEA(bufoff, gbase, h, GV) do { _Pragma("unroll") for (int _i = 0; _i < 2; ++_i) \
        __builtin_amdgcn_global_load_lds((const unsigned*)((const char*)(gbase) + (GATHER ? GV[h][_i] : voffA[_i]) + (h) * hstepA), (LAS unsigned*)(lds + (bufoff) + ldsw + _i * 8192), 16, 0, 0); } while (0)
#define PG8_LDA(dst, b, h) do { _Pragma("unroll") for (int m = 0; m < 4; ++m) _Pragma("unroll") for (int k = 0; k < 2; ++k) dst[m][k] = *(const LAS bf16x8*)(lds + PG8_SA(b, h) + aoff + m * 2048 + k * 1024); } while (0)
#define PG8_LDB(dst, b, h) do { _Pragma("unroll") for (int n = 0; n < 2; ++n) _Pragma("unroll") for (int k = 0; k < 2; ++k) dst[n][k] = *(const LAS bf16x8*)(lds + PG8_SB(b, h) + boff + n * 2048 + k * 1024); } while (0)
#define PG8_MMA(ai, bj, At, Bt) do { __builtin_amdgcn_s_setprio(1); _Pragma("unroll") for (int m = 0; m < 4; ++m) _Pragma("unroll") for (int n = 0; n < 2; ++n) _Pragma("unroll") for (int k = 0; k < 2; ++k) \
        acc[ai][bj][m][n] = __builtin_amdgcn_mfma_f32_16x16x32_bf16(Bt[n][k], At[m][k], acc[ai][bj][m][n], 0, 0, 0); __builtin_amdgcn_s_setprio(0); } while (0)
#define PG8_WAIT_V(n) asm volatile("s_waitcnt vmcnt(" #n ")" ::: "memory")
#define PG8_WAIT_L(n) asm volatile("s_waitcnt lgkmcnt(" #n ")" ::: "memory")
#define PG8_BAR __builtin_amdgcn_s_barrier()
#define PG8_SCHED __builtin_amdgcn_sched_barrier(0)
    Unit cur, nxt; int ui = 0;
    if (!S.next(0, cur)) return;
    f32x4 acc[2][2][4][2];
#pragma unroll
    for (int a = 0; a < 2; ++a)
#pragma unroll
        for (int b = 0; b < 2; ++b)
#pragma unroll
            for (int m = 0; m < 4; ++m)
#pragma unroll
                for (int n = 0; n < 2; ++n) acc[a][b][m][n] = (f32x4){0.f, 0.f, 0.f, 0.f};
    bf16x8 At[4][2], B0[2][2], B1[2][2];
    const char* cA = S.aptr(cur); const char* cB = S.bptr(cur);
    if constexpr (GATHER) { S.gather(cur, tid, gA); }
    PG8_STAGEB(PG8_SB(0, 0), cB); PG8_STAGEB(PG8_SB(0, 1), cB + hstepB); PG8_STAGEA(PG8_SA(0, 0), cA, 0, gA); PG8_STAGEA(PG8_SA(0, 1), cA, 1, gA);
    if (wr == 1) PG8_BAR;
    PG8_WAIT_V(2); PG8_BAR;
    PG8_STAGEB(PG8_SB(1, 0), cB + kstep); PG8_STAGEA(PG8_SA(1, 0), cA + kstep, 0, gA); PG8_STAGEB(PG8_SB(1, 1), cB + hstepB + kstep);
    PG8_WAIT_V(6); PG8_BAR;
    for (;;) {
        const bool has_next = S.next(ui + 1, nxt);
        const char* nA = has_next ? S.aptr(nxt) : cA; const char* nB = has_next ? S.bptr(nxt) : cB;
        if constexpr (GATHER) { if (has_next) S.gather(nxt, tid, gN); else {
#pragma unroll
            for (int h = 0; h < 2; ++h)
#pragma unroll
                for (int i = 0; i < 2; ++i) gN[h][i] = gA[h][i]; } }
#pragma nounroll
        for (int t = 0; t < nt; t += 2) {
            const bool last = (t == nt - 2);
            const char* a1 = cA + (size_t)(t + 1) * kstep;
            const char* a2 = last ? nA : cA + (size_t)(t + 2) * kstep; const char* b2 = last ? nB : cB + (size_t)(t + 2) * kstep;
            const char* a3 = a2 + kstep; const char* b3 = b2 + kstep;
            unsigned g2[2][2];
            if constexpr (GATHER) {
#pragma unroll
                for (int h = 0; h < 2; ++h)
#pragma unroll
                    for (int i = 0; i < 2; ++i) g2[h][i] = last ? gN[h][i] : gA[h][i]; }
            PG8_LDB(B0, 0, 0); PG8_LDB(B1, 0, 1); PG8_SCHED; PG8_LDA(At, 0, 0); PG8_STAGEA(PG8_SA(1, 1), a1, 1, gA);
            PG8_WAIT_V(8); PG8_WAIT_L(0); PG8_BAR; PG8_MMA(0, 0, At, B0); PG8_MMA(0, 1, At, B1); PG8_BAR; PG8_SCHED;
            PG8_LDA(At, 0, 1); PG8_STAGEB(PG8_SB(0, 0), b2); PG8_STAGEB(PG8_SB(0, 1), b2 + hstepB); PG8_STAGEA(PG8_SA(0, 0), a2, 0, g2);
            PG8_WAIT_V(8); PG8_WAIT_L(0); PG8_BAR; PG8_MMA(1, 0, At, B0); PG8_MMA(1, 1, At, B1); PG8_BAR; PG8_SCHED;
            PG8_LDB(B0, 1, 0); PG8_LDB(B1, 1, 1); PG8_SCHED; PG8_LDA(At, 1, 0); PG8_STAGEA(PG8_SA(0, 1), a2, 1, g2);
            PG8_WAIT_V(8); PG8_WAIT_L(0); PG8_BAR; PG8_MMA(0, 0, At, B0); PG8_MMA(0, 1, At, B1); PG8_BAR; PG8_SCHED;
            PG8_LDA(At, 1, 1); PG8_STAGEB(PG8_SB(1, 0), b3); PG8_STAGEB(PG8_SB(1, 1), b3 + hstepB); PG8_STAGEA(PG8_SA(1, 0), a3, 0, g2);
            PG8_WAIT_V(8); PG8_WAIT_L(0); PG8_BAR; PG8_MMA(1, 0, At, B0); PG8_MMA(1, 1, At, B1); PG8_BAR; PG8_SCHED;
        }
        if (wr == 0) PG8_BAR;
        E(acc, cur, wr, wc, fr, fq);
        if (!has_next) break;
#pragma unroll
        for (int a = 0; a < 2; ++a)
#pragma unroll
            for (int b = 0; b < 2; ++b)
#pragma unroll
                for (int m = 0; m < 4; ++m)
#pragma unroll
                    for (int n = 0; n < 2; ++n) acc[a][b][m][n] = (f32x4){0.f, 0.f, 0.f, 0.f};
        cur = nxt; cA = nA; cB = nB; ++ui;
        if constexpr (GATHER) {
#pragma unroll
            for (int h = 0; h < 2; ++h)
#pragma unroll
                for (int i = 0; i < 2; ++i) gA[h][i] = gN[h][i]; }
        if (wr == 1) PG8_BAR;
    }
    PG8_WAIT_V(0);
    PG8_BAR;
#undef PG8_SA
#undef PG8_SB
#undef PG8_STAGEA
#undef PG8_STAGEB
#undef PG8_LDA
#undef PG8_LDB
#undef PG8_MMA
#undef PG8_WAIT_V
#undef PG8_WAIT_L
#undef PG8_BAR
#undef PG8_SCHED
}
}
using pg8::Unit;

__device__ __forceinline__ void set_desc(LAS unsigned char* lds, int g, const void* A, const void* B, const void* C, int nN, int ldc, int aux, const void* X1 = nullptr, const void* X2 = nullptr, const void* X3 = nullptr) {
    LAS int* d = (LAS int*)(lds + LDS_DESC) + g * 16;
    if (threadIdx.x == 0) { unsigned long long a = (unsigned long long)A, b = (unsigned long long)B, c = (unsigned long long)C, x1 = (unsigned long long)X1, x2 = (unsigned long long)X2, x3 = (unsigned long long)X3;
        asm volatile("" : "+s"(a), "+s"(b), "+s"(c), "+s"(x1), "+s"(x2), "+s"(x3), "+s"(nN), "+s"(ldc), "+s"(aux));
        d[0] = (int)(unsigned)a; d[1] = (int)(unsigned)(a >> 32); d[2] = (int)(unsigned)b; d[3] = (int)(unsigned)(b >> 32); d[4] = (int)(unsigned)c; d[5] = (int)(unsigned)(c >> 32); d[6] = nN; d[7] = ldc; d[8] = aux;
        d[10] = (int)(unsigned)x1; d[11] = (int)(unsigned)(x1 >> 32); d[12] = (int)(unsigned)x2; d[13] = (int)(unsigned)(x2 >> 32); d[14] = (int)(unsigned)x3; d[15] = (int)(unsigned)(x3 >> 32); }
}
__device__ __forceinline__ int desc_i(LAS unsigned char* lds, int g, int f) { return __builtin_amdgcn_readfirstlane(((LAS const int*)(lds + LDS_DESC))[g * 16 + f]); }
__device__ __forceinline__ const char* desc_p(LAS unsigned char* lds, int g, int f) {
    const unsigned lo = (unsigned)desc_i(lds, g, f), hi = (unsigned)desc_i(lds, g, f + 1); return (const char*)(((unsigned long long)hi << 32) | lo); }
template <int LDA, int LDB>
struct SchedMulti {
    LAS unsigned char* lds; int nM, ntot, ng;
    __device__ __forceinline__ bool next(int i, Unit& u) const {
        const int nwg = nM * ntot; const long L = (long)i * gridDim.x + blockIdx.x; if (L >= nwg) return false;
        const int wgid = pg8::xcd_remap((int)L, nwg);
        const int nig = pg8::WGM * ntot, gid = wgid / nig, fm = gid * pg8::WGM, gsz = (nM - fm) < pg8::WGM ? (nM - fm) : pg8::WGM;
        u.pm = fm + ((wgid % nig) % gsz); int pv = (wgid % nig) / gsz; int g = 0;
        for (int j = 0; j + 1 < ng; ++j) { const int n = desc_i(lds, j, 6); if (pv < n) break; pv -= n; g = j + 1; }
        u.pn = pv; u.aux = g; return true;
    }
    __device__ __forceinline__ const char* aptr(const Unit& u) const { return desc_p(lds, u.aux, 0) + (size_t)u.pm * (512 * LDA); }
    __device__ __forceinline__ const char* bptr(const Unit& u) const { return desc_p(lds, u.aux, 2) + (size_t)u.pn * (512 * LDB); }
};
template <int LDA, int LDB, bool GATHERED>
struct SchedMoE {
    LAS unsigned char* lds; const char* Abase; const char* Bbase; const int* list;
    __device__ __forceinline__ bool next(int i, Unit& u) const {
        LAS const int* tab = (LAS const int*)(lds + LDS_TAB);
        const int nrt = __builtin_amdgcn_readfirstlane(tab[2 * MAXRT + 32]);
        const int nwg = nrt * 4; const long L = (long)i * gridDim.x + blockIdx.x; if (L >= nwg) return false;
        const int wgid = pg8::xcd_remap((int)L, nwg);
        u.pm = wgid >> 2; u.pn = wgid & 3; u.aux = __builtin_amdgcn_readfirstlane(tab[u.pm]); return true;
    }
    __device__ __forceinline__ const char* aptr(const Unit& u) const { return GATHERED ? Abase : Abase + (size_t)u.pm * (512 * LDA); }
    __device__ __forceinline__ const char* bptr(const Unit& u) const { return Bbase + (size_t)u.aux * ((size_t)D * LDB * 2) + (size_t)u.pn * (512 * LDB); }
    __device__ __forceinline__ void gather(const Unit& u, int tid, unsigned (&g)[2][2]) const {
        LAS const int* tab = (LAS const int*)(lds + LDS_TAB);
        const int j0 = __builtin_amdgcn_readfirstlane(tab[MAXRT + u.pm]), cn = __builtin_amdgcn_readfirstlane(tab[2 * MAXRT + u.aux]);
#pragma unroll
        for (int i = 0; i < 2; ++i) { int R, C; pg8::stage_rc(tid * 16 + i * 8192, R, C);
#pragma unroll
            for (int h = 0; h < 2; ++h) { const int slot = j0 + 128 * h + R; const int a = slot < cn ? list[(size_t)u.aux * LISTCAP + slot] : 0;
                g[h][i] = (unsigned)((a >> 1) * LDA + C) * 2u; } }
    }
};
__device__ __forceinline__ void moe_tables(LAS unsigned char* lds, const unsigned* cnt) {
    LAS int* tab = (LAS int*)(lds + LDS_TAB);
    __syncthreads();
    if (threadIdx.x == 0) {
        int rt = 0;
#pragma nounroll
        for (int e = 0; e < NE; ++e) { const int c = (int)__hip_atomic_load(cnt + e, __ATOMIC_RELAXED, __HIP_MEMORY_SCOPE_AGENT); tab[2 * MAXRT + e] = c;
            const int nt = (c + 255) >> 8;
#pragma nounroll
            for (int j = 0; j < nt; ++j) { tab[rt] = e; tab[MAXRT + rt] = j * 256; ++rt; } }
        tab[2 * MAXRT + 32] = rt;
    }
    __syncthreads();
}

#define EPI_FENCE() asm volatile("" ::: "memory")
struct EpiGelu {
    static constexpr bool PERM = true;
    LAS unsigned char* lds;
    __device__ __forceinline__ void operator()(const f32x4 (&acc)[2][2][4][2], const Unit& u, int wr, int wc, int fr, int fq) const {
        const bool isv = u.pn >= 8; bf16_t* base = (bf16_t*)desc_p(lds, 0, isv ? 10 : 4); const float* bias = (const float*)desc_p(lds, 0, 12); float* stat = (float*)desc_p(lds, 0, 14);
        const int col0 = (u.pn & 7) * 256 + wc * 32 + 8 * fq, bcol0 = u.pn * 256 + wc * 32 + 8 * fq, row0 = u.pm * 256 + wr * 64 + fr;
        f32x4 bv[2][2];
#pragma unroll
        for (int bj = 0; bj < 2; ++bj)
#pragma unroll
            for (int n = 0; n < 2; ++n) bv[bj][n] = *(const f32x4*)(bias + bcol0 + bj * 128 + 4 * n);
#pragma unroll
        for (int ai = 0; ai < 2; ++ai)
#pragma unroll
            for (int m = 0; m < 4; ++m) { const int row = row0 + ai * 128 + m * 16; bf16_t* rowp = base + (size_t)row * GWID + col0; float s = 0.f, q = 0.f;
#pragma unroll
                for (int bj = 0; bj < 2; ++bj) { const f32x4 v0 = acc[ai][bj][m][0] + bv[bj][0], v1 = acc[ai][bj][m][1] + bv[bj][1];
                    const f32x2 a = gelu_pk((f32x2){v0[0], v0[1]}), b = gelu_pk((f32x2){v0[2], v0[3]}), c = gelu_pk((f32x2){v1[0], v1[1]}), d = gelu_pk((f32x2){v1[2], v1[3]});
                    s += ((a.x + a.y) + (b.x + b.y)) + ((c.x + c.y) + (d.x + d.y));
                    q += ((a.x * a.x + a.y * a.y) + (b.x * b.x + b.y * b.y)) + ((c.x * c.x + c.y * c.y) + (d.x * d.x + d.y * d.y));
                    u32x4 w; w.x = cvt_pk_bf16(a.x, a.y); w.y = cvt_pk_bf16(b.x, b.y); w.z = cvt_pk_bf16(c.x, c.y); w.w = cvt_pk_bf16(d.x, d.y);
                    *(u32x4*)(rowp + bj * 128) = w; }
                if (isv) { s += __shfl_xor(s, 16); s += __shfl_xor(s, 32); q += __shfl_xor(q, 16); q += __shfl_xor(q, 32);
                    if (fq == 0) *(f32x2*)(stat + ((size_t)row * 32 + (u.pn - 8) * 4 + wc) * 2) = (f32x2){s, q}; } }
    }
};
struct EpiResid {
    static constexpr bool PERM = false;
    LAS unsigned char* lds;
    __device__ __forceinline__ void operator()(const f32x4 (&acc)[2][2][4][2], const Unit& u, int wr, int wc, int fr, int fq) const {
        const int mrow = u.pm < 64 ? 0 : (u.pm < 128 ? 1 : 2);
        const float* xin = u.pm < 128 ? (const float*)desc_p(lds, 0, 10) + (size_t)u.pm * 256 * D : (const float*)desc_p(lds, 0, 12) + (size_t)(u.pm - 128) * 256 * D;
        float* xout = (float*)desc_p(lds, 0, 4) + (size_t)u.pm * 256 * D; const float* bias = (const float*)desc_p(lds, 0, 14); const float* gate = (const float*)desc_p(lds, 1, 10);
        const int col0 = u.pn * 256 + wc * 32 + 4 * fq, rl0 = wr * 64 + fr;
#pragma unroll
        for (int bj = 0; bj < 2; ++bj)
#pragma unroll
            for (int n = 0; n < 2; ++n) { const f32x4 bv = bias ? *(const f32x4*)(bias + col0 + bj * 128 + n * 16) : (f32x4){0.f, 0.f, 0.f, 0.f};
                const f32x4 gv = *(const f32x4*)(gate + mrow * 6 * D + col0 + bj * 128 + n * 16);
#pragma unroll
                for (int ai = 0; ai < 2; ++ai) {
#pragma unroll
                    for (int m = 0; m < 4; ++m) { const size_t off = (size_t)(rl0 + ai * 128 + m * 16) * D + col0 + bj * 128 + n * 16;
                        const f32x4 xi = *(const f32x4*)(xin + off); *(f32x4*)(xout + off) = xi + gv * (acc[ai][bj][m][n] + bv); }
                    EPI_FENCE(); } }
    }
};
struct EpiAct {
    static constexpr bool PERM = true;
    LAS unsigned char* lds;
    __device__ __forceinline__ void operator()(const f32x4 (&acc)[2][2][4][2], const Unit& u, int wr, int wc, int fr, int fq) const {
        bf16_t* C = (bf16_t*)desc_p(lds, u.aux, 4); const int ldc = desc_i(lds, u.aux, 7), act = desc_i(lds, u.aux, 8);
        const int col0 = u.pn * 256 + wc * 32 + 8 * fq, row0 = u.pm * 256 + wr * 64 + fr;
#pragma unroll
        for (int ai = 0; ai < 2; ++ai)
#pragma unroll
            for (int m = 0; m < 4; ++m) { bf16_t* rowp = C + (size_t)(row0 + ai * 128 + m * 16) * ldc + col0;
#pragma unroll
                for (int bj = 0; bj < 2; ++bj) { f32x4 v0 = acc[ai][bj][m][0], v1 = acc[ai][bj][m][1];
                    if (act == 1) {
#pragma unroll
                        for (int j = 0; j < 4; ++j) { v0[j] = tanhf_(v0[j]); v1[j] = tanhf_(v1[j]); } }
                    else if (act == 2) {
#pragma unroll
                        for (int j = 0; j < 4; ++j) { v0[j] = sigmoidf_(v0[j]); v1[j] = sigmoidf_(v1[j]); } }
                    u32x4 w; w.x = cvt_pk_bf16(v0[0], v0[1]); w.y = cvt_pk_bf16(v0[2], v0[3]); w.z = cvt_pk_bf16(v1[0], v1[1]); w.w = cvt_pk_bf16(v1[2], v1[3]);
                    *(u32x4*)(rowp + bj * 128) = w; } }
    }
};
struct EpiLora2 {
    static constexpr bool PERM = true;
    LAS unsigned char* lds;
    __device__ __forceinline__ void operator()(const f32x4 (&acc)[2][2][4][2], const Unit& u, int wr, int wc, int fr, int fq) const {
        bf16_t* C = (bf16_t*)desc_p(lds, u.aux, 4);
        const int col0 = u.pn * 256 + wc * 32 + 8 * fq, row0 = u.pm * 256 + wr * 64 + fr;
        const float* pv = u.aux < 4 ? (const float*)desc_p(lds, u.aux, 10) : (const float*)desc_p(lds, 5, 10); bf16_t* C2 = (bf16_t*)desc_p(lds, u.aux, 12);
        const float* k_a = (const float*)desc_p(lds, 5, 10); const bf16_t* Kb = (const bf16_t*)desc_p(lds, 5, 12);
#pragma unroll
        for (int bj = 0; bj < 2; ++bj) { const f32x4 p0 = *(const f32x4*)(pv + col0 + bj * 128), p1 = *(const f32x4*)(pv + col0 + bj * 128 + 4);
            const f32x4 ka0 = *(const f32x4*)(k_a + col0 + bj * 128), ka1 = *(const f32x4*)(k_a + col0 + bj * 128 + 4);
#pragma unroll
            for (int ai = 0; ai < 2; ++ai)
#pragma unroll
                for (int m = 0; m < 4; ++m) { const size_t ro = (size_t)(row0 + ai * 128 + m * 16) * D + col0 + bj * 128;
                    f32x4 v0 = acc[ai][bj][m][0], v1 = acc[ai][bj][m][1];
                    if (u.aux < 2) {
#pragma unroll
                        for (int j = 0; j < 4; ++j) { const float x0 = -(p0[j] + v0[j]), x1 = -(p1[j] + v1[j]);
                            const float s0 = fmaxf(x0, 0.f) + __logf(1.0f + __expf(-fabsf(x0))), s1 = fmaxf(x1, 0.f) + __logf(1.0f + __expf(-fabsf(x1)));
                            v0[j] = -__expf(-s0 - 0.5f); v1[j] = -__expf(-s1 - 0.5f); }
                    } else if (u.aux < 4) {
                        const u32x4 kw = *(const u32x4*)(Kb + ro); f32x4 a0v, a1v;
#pragma unroll
                        for (int j = 0; j < 4; ++j) { a0v[j] = sigmoidf_(p0[j] + v0[j]); a1v[j] = sigmoidf_(p1[j] + v1[j]); }
                        v0[0] = bf_lo(kw.x) * (1.0f + (a0v[0] - 1.0f) * ka0[0]); v0[1] = bf_hi(kw.x) * (1.0f + (a0v[1] - 1.0f) * ka0[1]);
                        v0[2] = bf_lo(kw.y) * (1.0f + (a0v[2] - 1.0f) * ka0[2]); v0[3] = bf_hi(kw.y) * (1.0f + (a0v[3] - 1.0f) * ka0[3]);
                        v1[0] = bf_lo(kw.z) * (1.0f + (a1v[0] - 1.0f) * ka1[0]); v1[1] = bf_hi(kw.z) * (1.0f + (a1v[1] - 1.0f) * ka1[1]);
                        v1[2] = bf_lo(kw.w) * (1.0f + (a1v[2] - 1.0f) * ka1[2]); v1[3] = bf_hi(kw.w) * (1.0f + (a1v[3] - 1.0f) * ka1[3]);
                        u32x4 w2; w2.x = cvt_pk_bf16(a0v[0], a0v[1]); w2.y = cvt_pk_bf16(a0v[2], a0v[3]); w2.z = cvt_pk_bf16(a1v[0], a1v[1]); w2.w = cvt_pk_bf16(a1v[2], a1v[3]);
                        *(u32x4*)(C2 + ro) = w2;
                    }
                    u32x4 w; w.x = cvt_pk_bf16(v0[0], v0[1]); w.y = cvt_pk_bf16(v0[2], v0[3]); w.z = cvt_pk_bf16(v1[0], v1[1]); w.w = cvt_pk_bf16(v1[2], v1[3]);
                    *(u32x4*)(C + ro) = w; EPI_FENCE(); } }
    }
};
struct EpiSiluGate {
    static constexpr bool PERM = true;
    bf16_t* H;
    __device__ __forceinline__ void operator()(const f32x4 (&acc)[2][2][4][2], const Unit& u, int wr, int wc, int fr, int fq) const {
        const int col0 = u.pn * 128 + wc * 32 + 8 * fq, row0 = u.pm * 256 + wr * 64 + fr;
#pragma unroll
        for (int ai = 0; ai < 2; ++ai)
#pragma unroll
            for (int m = 0; m < 4; ++m) { f32x4 h0, h1;
#pragma unroll
                for (int j = 0; j < 4; ++j) { const float g0 = acc[ai][0][m][0][j], g1 = acc[ai][0][m][1][j]; h0[j] = g0 * sigmoidf_(g0) * acc[ai][1][m][0][j]; h1[j] = g1 * sigmoidf_(g1) * acc[ai][1][m][1][j]; }
                u32x4 w; w.x = cvt_pk_bf16(h0[0], h0[1]); w.y = cvt_pk_bf16(h0[2], h0[3]); w.z = cvt_pk_bf16(h1[0], h1[1]); w.w = cvt_pk_bf16(h1[2], h1[3]);
                *(u32x4*)(H + (size_t)(row0 + ai * 128 + m * 16) * EHID + col0) = w; }
    }
};
struct EpiScatter {
    static constexpr bool PERM = true;
    LAS unsigned char* lds; bf16_t* YB; const int* list;
    __device__ __forceinline__ void operator()(const f32x4 (&acc)[2][2][4][2], const Unit& u, int wr, int wc, int fr, int fq) const {
        LAS const int* tab = (LAS const int*)(lds + LDS_TAB);
        const int j0 = __builtin_amdgcn_readfirstlane(tab[MAXRT + u.pm]), cn = __builtin_amdgcn_readfirstlane(tab[2 * MAXRT + u.aux]);
        const int col0 = u.pn * 256 + wc * 32 + 8 * fq;
#pragma unroll
        for (int ai = 0; ai < 2; ++ai)
#pragma unroll
            for (int m = 0; m < 4; ++m) { const int slot = j0 + ai * 128 + wr * 64 + m * 16 + fr;
                if (slot < cn) { const int a = list[(size_t)u.aux * LISTCAP + slot]; bf16_t* rowp = YB + (size_t)a * D + col0;
#pragma unroll
                    for (int bj = 0; bj < 2; ++bj) { const f32x4 v0 = acc[ai][bj][m][0], v1 = acc[ai][bj][m][1];
                        u32x4 w; w.x = cvt_pk_bf16(v0[0], v0[1]); w.y = cvt_pk_bf16(v0[2], v0[3]); w.z = cvt_pk_bf16(v1[0], v1[1]); w.w = cvt_pk_bf16(v1[2], v1[3]);
                        *(u32x4*)(rowp + bj * 128) = w; } } }
    }
};

struct Params { const float* in[42]; float* out; unsigned char* ws; int ph_lo, ph_hi; };
enum { I_X = 0, I_C, I_CTX, I_CCTX, I_ADAW, I_ADAB, I_N1G, I_N2G, I_FG, I_GWIN, I_GBIN, I_GLNG, I_GLNB, I_GWS, I_GBS, I_GWOUT, I_GBOUT,
       I_MU, I_WR, I_WK, I_WV, I_WO, I_W0, I_W1, I_W2, I_A0, I_A1, I_A2, I_G1, I_G2, I_KK, I_KA, I_RK, I_LNG, I_LNB,
       I_MWGRP, I_MBGRP, I_MWEXP, I_MBEXP, I_MWG, I_MWU, I_MWD };
struct Frame { LAS unsigned char* lds; int tid, lane, wave, G, gw, NGW; };
typedef const __attribute__((address_space(4))) Params* KP;

__device__ __forceinline__ void tr_item(const float* W, int N, int kmax, bf16_t* WT, int ldk, int k0, int n0, int drow0, int dk0, LAS float* scr, int lane) {
#pragma unroll 8
    for (int i = 0; i < 32; ++i) { const int kk = 2 * i + (lane >> 5), k = k0 + kk; scr[kk * 33 + (lane & 31)] = k < kmax ? W[(size_t)k * N + n0 + (lane & 31)] : 0.f; }
    asm volatile("s_waitcnt lgkmcnt(0)" ::: "memory");
    const int c = lane & 7;
#pragma unroll
    for (int j = 0; j < 4; ++j) { const int n = (lane >> 3) + 8 * j; const LAS float* s = scr + (8 * c) * 33 + n;
        u32x4 o; o.x = cvt_pk_bf16(s[0 * 33], s[1 * 33]); o.y = cvt_pk_bf16(s[2 * 33], s[3 * 33]); o.z = cvt_pk_bf16(s[4 * 33], s[5 * 33]); o.w = cvt_pk_bf16(s[6 * 33], s[7 * 33]);
        *(u32x4*)(WT + (size_t)(drow0 + n) * ldk + dk0 + k0 + 8 * c) = o; }
    asm volatile("s_waitcnt lgkmcnt(0)" ::: "memory");
}
__device__ __forceinline__ void conv_T(const Frame& F, const float* W, int N, int kmax, int kpad, bf16_t* WT, int ldk, int drow0, int dk0, int ilv) {
    LAS float* scr = (LAS float*)(F.lds + F.wave * 8704);
    const int nnb = N / 32, nit = (kpad / 64) * nnb;
    for (int it = F.gw; it < nit; it += F.NGW) { const int kb = it / nnb, nb = it % nnb, n0 = nb * 32;
        const int dr = ilv == 0 ? n0 : (256 * (n0 >> 7) + (n0 & 127) + (ilv == 2 ? 128 : 0));
        tr_item(W, N, kmax, WT, ldk, kb * 64, n0, drow0 + dr, dk0, scr, F.lane); }
}
__device__ __forceinline__ void zero_fill(const Frame& F, bf16_t* p, size_t nbytes) {
    u32x4* q = (u32x4*)p; const size_t n = nbytes / 16;
    for (size_t i = (size_t)blockIdx.x * NTHR + F.tid; i < n; i += (size_t)F.G * NTHR) q[i] = (u32x4){0u, 0u, 0u, 0u};
}

__device__ __forceinline__ void prologue_phase(const Frame& F, KP P) {
    unsigned char* ws = P->ws;
    {   float* MOD = (float*)(ws + WS_MOD); LAS float* part = (LAS float*)F.lds;
        const float* c = P->in[I_C]; const float* cc = P->in[I_CCTX];
        for (int item = blockIdx.x; item < DEPTH * 96; item += F.G) {
            const int layer = item / 96, col = (item % 96) * 64 + F.lane; const float* w = P->in[I_ADAW] + (size_t)layer * D * 6 * D;
            float a0 = 0.f, a1 = 0.f, a2 = 0.f;
#pragma unroll 8
            for (int dd = 0; dd < 128; ++dd) { const int d = F.wave * 128 + dd; const float wv = w[(size_t)d * 6 * D + col];
                const float c0 = c[d], c1 = c[D + d], c2 = cc[d];
                a0 += c0 * sigmoidf_(c0) * wv; a1 += c1 * sigmoidf_(c1) * wv; a2 += c2 * sigmoidf_(c2) * wv; }
            part[(F.wave * 3 + 0) * 64 + F.lane] = a0; part[(F.wave * 3 + 1) * 64 + F.lane] = a1; part[(F.wave * 3 + 2) * 64 + F.lane] = a2;
            __syncthreads();
            if (F.wave < 3) { float s = 0.f;
#pragma unroll
                for (int w8 = 0; w8 < 8; ++w8) s += part[(w8 * 3 + F.wave) * 64 + F.lane];
                MOD[((size_t)layer * 3 + F.wave) * 6 * D + col] = s + P->in[I_ADAB][(size_t)layer * 6 * D + col]; }
            __syncthreads();
        }
    }
    for (int j = 0; j < 2; ++j) {
        conv_T(F, P->in[I_GWIN] + (size_t)j * D * 4096, 4096, D, D, (bf16_t*)(ws + WS_WIN) + (size_t)j * 4096 * D, D, 0, 0, 0);
        conv_T(F, P->in[I_GWOUT] + (size_t)j * GWID * D, D, GWID, GWID, (bf16_t*)(ws + WS_WOUT) + (size_t)j * D * GWID, GWID, 0, 0, 0);
        conv_T(F, P->in[I_WR] + (size_t)j * D * D, D, D, D, (bf16_t*)(ws + WS_WR) + (size_t)j * D * D, D, 0, 0, 0);
        conv_T(F, P->in[I_WK] + (size_t)j * D * D, D, D, D, (bf16_t*)(ws + WS_WK) + (size_t)j * D * D, D, 0, 0, 0);
        conv_T(F, P->in[I_WV] + (size_t)j * D * D, D, D, D, (bf16_t*)(ws + WS_WV) + (size_t)j * D * D, D, 0, 0, 0);
        conv_T(F, P->in[I_WO] + (size_t)j * D * D, D, D, D, (bf16_t*)(ws + WS_WO) + (size_t)j * D * D, D, 0, 0, 0);
        bf16_t* lw1 = (bf16_t*)(ws + WS_LW1) + (size_t)j * 256 * D; bf16_t* la1 = (bf16_t*)(ws + WS_LA1) + (size_t)j * 256 * D; bf16_t* lg1 = (bf16_t*)(ws + WS_LG1) + (size_t)j * 256 * D;
        for (int z = 0; z < 2; ++z) {
            conv_T(F, P->in[I_W1] + ((size_t)j * 2 + z) * D * 64, 64, D, D, lw1, D, z * 64, 0, 0);
            conv_T(F, P->in[I_A1] + ((size_t)j * 2 + z) * D * 64, 64, D, D, la1, D, z * 64, 0, 0);
            bf16_t* w2p = (bf16_t*)(ws + WS_W2P) + ((size_t)j * 2 + z) * D * 256; bf16_t* a2p = (bf16_t*)(ws + WS_A2P) + ((size_t)j * 2 + z) * D * 256;
            conv_T(F, P->in[I_W2] + ((size_t)j * 2 + z) * 64 * D, D, 64, 64, w2p, 256, 0, z * 64, 0);
            conv_T(F, P->in[I_A2] + ((size_t)j * 2 + z) * 64 * D, D, 64, 64, a2p, 256, 0, z * 64, 0);
            for (int idx = blockIdx.x * NTHR + F.tid; idx < D * 32; idx += F.G * NTHR) { const int n = idx >> 5, ch = idx & 31;
                if ((ch >> 3) != z) { *(u32x4*)(w2p + (size_t)n * 256 + ch * 8) = (u32x4){0u, 0u, 0u, 0u}; *(u32x4*)(a2p + (size_t)n * 256 + ch * 8) = (u32x4){0u, 0u, 0u, 0u}; } }
        }
        conv_T(F, P->in[I_G1] + (size_t)j * D * 160, 160, D, D, lg1, D, 0, 0, 0);
        zero_fill(F, lw1 + 128 * D, (size_t)128 * D * 2); zero_fill(F, la1 + 128 * D, (size_t)128 * D * 2); zero_fill(F, lg1 + 160 * D, (size_t)96 * D * 2);
        conv_T(F, P->in[I_G2] + (size_t)j * 160 * D, D, 160, 256, (bf16_t*)(ws + WS_G2P) + (size_t)j * D * 256, 256, 0, 0, 0);
    }
    {   const float* src = P->in[I_GWS]; bf16_t* dst = (bf16_t*)(ws + WS_WSP); const int n8 = 2 * 16 * 128 * 128 / 8;
        for (int i = blockIdx.x * NTHR + F.tid; i < n8; i += F.G * NTHR) { const f32x4 a = *(const f32x4*)(src + (size_t)i * 8), b = *(const f32x4*)(src + (size_t)i * 8 + 4);
            u32x4 o; o.x = cvt_pk_bf16(a[0], a[1]); o.y = cvt_pk_bf16(a[2], a[3]); o.z = cvt_pk_bf16(b[0], b[1]); o.w = cvt_pk_bf16(b[2], b[3]); *(u32x4*)(dst + (size_t)i * 8) = o; } }
}
__device__ __forceinline__ void moe_weights_phase(const Frame& F, KP P, int layer) {
    unsigned char* ws = P->ws;
    for (int e = 0; e < NE; ++e) {
        const size_t so = ((size_t)layer * NE + e) * (size_t)D * EHID;
        conv_T(F, P->in[I_MWG] + so, EHID, D, D, (bf16_t*)(ws + WS_WGU) + (size_t)e * D * D, D, 0, 0, 1);
        conv_T(F, P->in[I_MWU] + so, EHID, D, D, (bf16_t*)(ws + WS_WGU) + (size_t)e * D * D, D, 0, 0, 2);
        conv_T(F, P->in[I_MWD] + so, D, EHID, EHID, (bf16_t*)(ws + WS_WD) + (size_t)e * D * EHID, EHID, 0, 0, 0);
    }
}

__device__ __forceinline__ const float* xrow_ptr(KP P, int layer, int row) {
    if (layer == 0) return row < TL ? P->in[I_X] + (size_t)row * D : P->in[I_CTX] + (size_t)(row - TL) * D;
    return (const float*)(P->ws + WS_X) + (size_t)row * D;
}
__device__ __forceinline__ void load_combine(KP P, const Frame& F, int layer, int row, int m, bool combine, f32x4 (&v)[4]) {
    const float* xr = xrow_ptr(P, layer, row);
#pragma unroll
    for (int j = 0; j < 4; ++j) v[j] = *(const f32x4*)(xr + 4 * F.lane + 256 * j);
    if (combine) {
        const bf16_t* yb = (const bf16_t*)(P->ws + WS_YB); const float* wg = (const float*)(P->ws + WS_WGT);
        const float w0 = wg[2 * row], w1 = wg[2 * row + 1]; const float* g2 = (const float*)(P->ws + WS_MOD) + ((size_t)(layer - 1) * 3 + m) * 6 * D + 5 * D;
#pragma unroll
        for (int j = 0; j < 4; ++j) { const int col = 4 * F.lane + 256 * j; const u32x2 a = *(const u32x2*)(yb + (size_t)(2 * row) * D + col), b = *(const u32x2*)(yb + (size_t)(2 * row + 1) * D + col);
            const f32x4 g = *(const f32x4*)(g2 + col);
            v[j][0] += g[0] * (w0 * bf_lo(a.x) + w1 * bf_lo(b.x)); v[j][1] += g[1] * (w0 * bf_hi(a.x) + w1 * bf_hi(b.x));
            v[j][2] += g[2] * (w0 * bf_lo(a.y) + w1 * bf_lo(b.y)); v[j][3] += g[3] * (w0 * bf_hi(a.y) + w1 * bf_hi(b.y)); }
    }
}
__device__ __forceinline__ void norm1_phase(const Frame& F, KP P, int layer) {
    const bool combine = layer > 0; float* X = (float*)(P->ws + WS_X); bf16_t* HL = (bf16_t*)(P->ws + WS_HL);
    const float* g1 = P->in[I_N1G] + (size_t)layer * D;
    for (int row = F.gw; row < T; row += F.NGW) {
        const int m = row < TL ? (row >> 14) : 2; f32x4 v[4];
        load_combine(P, F, layer, row, m, combine, v);
        if (combine) {
#pragma unroll
            for (int j = 0; j < 4; ++j) *(f32x4*)(X + (size_t)row * D + 4 * F.lane + 256 * j) = v[j]; }
        float ss = 0.f;
#pragma unroll
        for (int j = 0; j < 4; ++j) ss += (v[j][0] * v[j][0] + v[j][1] * v[j][1]) + (v[j][2] * v[j][2] + v[j][3] * v[j][3]);
        const float rstd = rsqrtf(wave_sum(ss) * (1.0f / D) + 1e-6f);
        const float* mod = (const float*)(P->ws + WS_MOD) + ((size_t)layer * 3 + m) * 6 * D;
#pragma unroll
        for (int j = 0; j < 4; ++j) { const int col = 4 * F.lane + 256 * j; const f32x4 g = *(const f32x4*)(g1 + col), sh = *(const f32x4*)(mod + col), sc = *(const f32x4*)(mod + D + col);
            const f32x4 h = (v[j] * rstd) * g * (sc + 1.0f) + sh;
            u32x2 o; o.x = cvt_pk_bf16(h[0], h[1]); o.y = cvt_pk_bf16(h[2], h[3]); *(u32x2*)(HL + (size_t)row * D + col) = o; }
    }
}
__device__ __forceinline__ void final_phase(const Frame& F, KP P) {
    const float* fg = P->in[I_FG];
    for (int row = F.gw; row < TL; row += F.NGW) {
        const int m = row >> 14; f32x4 v[4];
        load_combine(P, F, DEPTH, row, m, true, v);
        float ss = 0.f;
#pragma unroll
        for (int j = 0; j < 4; ++j) ss += (v[j][0] * v[j][0] + v[j][1] * v[j][1]) + (v[j][2] * v[j][2] + v[j][3] * v[j][3]);
        const float rstd = rsqrtf(wave_sum(ss) * (1.0f / D) + 1e-6f);
#pragma unroll
        for (int j = 0; j < 4; ++j) { const int col = 4 * F.lane + 256 * j; *(f32x4*)(P->out + (size_t)row * D + col) = (v[j] * rstd) * *(const f32x4*)(fg + col); }
    }
}
__device__ __forceinline__ void route_phase(const Frame& F, KP P, int layer) {
    const int ntok = layer == DEPTH - 1 ? TL : T; bf16_t* HL2 = (bf16_t*)(P->ws + WS_HL);
    const float* g2n = P->in[I_N2G] + (size_t)layer * D; const float* wgrp = P->in[I_MWGRP] + (size_t)layer * D * 4; const float* wexp = P->in[I_MWEXP] + (size_t)layer * D * NE;
    const float* bgrp = P->in[I_MBGRP] + layer * 4; const float* bexp = P->in[I_MBEXP] + layer * NE;
    unsigned* cnt = (unsigned*)(P->ws + WS_CTL) + CW_CNT + layer * 64; int* list = (int*)(P->ws + WS_LIST); float* wgt = (float*)(P->ws + WS_WGT);
    LAS float* hs = (LAS float*)F.lds + F.wave * 2 * D;
    for (int pr = F.gw; pr < ntok / 2; pr += F.NGW) {
        f32x4 h[2][4];
#pragma unroll
        for (int r = 0; r < 2; ++r) { const int row = 2 * pr + r; const int m = row < TL ? (row >> 14) : 2; const float* xr = xrow_ptr(P, 1, row);
#pragma unroll
            for (int j = 0; j < 4; ++j) h[r][j] = *(const f32x4*)(xr + 4 * F.lane + 256 * j);
            float ss = 0.f;
#pragma unroll
            for (int j = 0; j < 4; ++j) ss += (h[r][j][0] * h[r][j][0] + h[r][j][1] * h[r][j][1]) + (h[r][j][2] * h[r][j][2] + h[r][j][3] * h[r][j][3]);
            const float rstd = rsqrtf(wave_sum(ss) * (1.0f / D) + 1e-6f);
            const float* mod = (const float*)(P->ws + WS_MOD) + ((size_t)layer * 3 + m) * 6 * D;
#pragma unroll
            for (int j = 0; j < 4; ++j) { const int col = 4 * F.lane + 256 * j; const f32x4 g = *(const f32x4*)(g2n + col), sh = *(const f32x4*)(mod + 3 * D + col), sc = *(const f32x4*)(mod + 4 * D + col);
                h[r][j] = (h[r][j] * rstd) * g * (sc + 1.0f) + sh;
                u32x2 o; o.x = cvt_pk_bf16(h[r][j][0], h[r][j][1]); o.y = cvt_pk_bf16(h[r][j][2], h[r][j][3]); *(u32x2*)(HL2 + (size_t)row * D + col) = o; } }
        float ag[2][4], ae[2][NE];
#pragma unroll
        for (int r = 0; r < 2; ++r) {
#pragma unroll
            for (int i = 0; i < 4; ++i) ag[r][i] = 0.f;
#pragma unroll
            for (int i = 0; i < NE; ++i) ae[r][i] = 0.f; }
#pragma unroll
        for (int r = 0; r < 2; ++r)
#pragma unroll
            for (int j = 0; j < 4; ++j) *(LAS f32x4*)(hs + r * D + 4 * F.lane + 256 * j) = h[r][j];
        asm volatile("s_waitcnt lgkmcnt(0)" ::: "memory");
        {   const float* gp = wgrp + (size_t)F.lane * 4; const float* wp = wexp + (size_t)F.lane * NE;
#pragma unroll 2
            for (int it = 0; it < 16; ++it) { const float h0 = hs[F.lane + 64 * it], h1 = hs[D + F.lane + 64 * it];
                const f32x4 wg = *(const f32x4*)gp;
#pragma unroll
                for (int i = 0; i < 4; ++i) { ag[0][i] += h0 * wg[i]; ag[1][i] += h1 * wg[i]; }
#pragma unroll
                for (int q = 0; q < 8; ++q) { const f32x4 we = *(const f32x4*)(wp + 4 * q);
#pragma unroll
                    for (int i = 0; i < 4; ++i) { ae[0][4 * q + i] += h0 * we[i]; ae[1][4 * q + i] += h1 * we[i]; } }
                gp += 64 * 4; wp += 64 * NE; }
        }
        asm volatile("s_waitcnt lgkmcnt(0)" ::: "memory");
#pragma unroll
        for (int r = 0; r < 2; ++r) {
#pragma unroll
            for (int i = 0; i < 4; ++i) ag[r][i] = wave_sum(ag[r][i]) + bgrp[i];
#pragma unroll
            for (int i = 0; i < NE; ++i) ae[r][i] = wave_sum(ae[r][i]) + bexp[i];
            int grp = 0; float mx = ag[r][0];
#pragma unroll
            for (int i = 1; i < 4; ++i) if (ag[r][i] > mx) { mx = ag[r][i]; grp = i; }
            float den = 0.f;
#pragma unroll
            for (int i = 0; i < 4; ++i) den += __expf(ag[r][i] - mx);
            const float pg = 1.0f / den;
            float el[8];
#pragma unroll
            for (int i = 0; i < 8; ++i) { el[i] = ae[r][i];
#pragma unroll
                for (int g = 1; g < 4; ++g) if (grp == g) el[i] = ae[r][8 * g + i]; }
            int i0 = 0; float t0 = el[0];
#pragma unroll
            for (int i = 1; i < 8; ++i) if (el[i] > t0) { t0 = el[i]; i0 = i; }
            int i1 = -1; float t1 = -3.0e38f;
#pragma unroll
            for (int i = 0; i < 8; ++i) if (i != i0 && el[i] > t1) { t1 = el[i]; i1 = i; }
            const float p0 = 1.0f / (1.0f + __expf(t1 - t0)), w0 = pg * p0, w1 = pg * (1.0f - p0);
            if (F.lane == 0) { const int row = 2 * pr + r; const int e0 = grp * 8 + i0, e1 = grp * 8 + i1;
                const unsigned s0 = atomicAdd(cnt + e0, 1u), s1 = atomicAdd(cnt + e1, 1u);
                list[(size_t)e0 * LISTCAP + s0] = 2 * row; list[(size_t)e1 * LISTCAP + s1] = 2 * row + 1; wgt[2 * row] = w0; wgt[2 * row + 1] = w1; }
        }
    }
    __syncthreads();
    moe_weights_phase(F, P, layer);
}

__device__ __forceinline__ void spatial_phase(const Frame& F, KP P, int j) {
    bf16_t* U = (bf16_t*)(P->ws + WS_U); const bf16_t* V = (const bf16_t*)(P->ws + WS_V); const float* stat = (const float*)(P->ws + WS_STAT);
    const bf16_t* WSP = (const bf16_t*)(P->ws + WS_WSP) + (size_t)j * 16 * 128 * 128;
    const float* lng = P->in[I_GLNG] + (size_t)j * GWID; const float* lnb = P->in[I_GLNB] + (size_t)j * GWID; const float* bs = P->in[I_GBS] + (size_t)j * 16 * 128;
    LAS bf16_t* Wt = (LAS bf16_t*)F.lds; LAS bf16_t* Vt = Wt + 128 * 136;
    LAS float* mu = (LAS float*)(F.lds + 2 * 128 * 136 * 2); LAS float* rs = mu + 128;
    const int l15 = F.lane & 15, l4 = F.lane >> 4;
    for (int item = blockIdx.x; item < (T / 128) * 16; item += F.G) {
        const int c = item >> 4, g = item & 15, t0 = c * 128;
        __syncthreads();
        if (F.tid < 128) { const int row = t0 + F.tid; float s = 0.f, q = 0.f;
#pragma unroll 8
            for (int i = 0; i < 32; ++i) { const f32x2 p = *(const f32x2*)(stat + ((size_t)row * 32 + i) * 2); s += p.x; q += p.y; }
            const float mean = s * (1.0f / GWID), var = q * (1.0f / GWID) - mean * mean; mu[F.tid] = mean; rs[F.tid] = rsqrtf(var + 1e-5f); }
#pragma unroll
        for (int i = 0; i < 4; ++i) { const int idx = F.tid + NTHR * i, p = idx >> 4, seg = idx & 15;
            *(LAS u32x4*)(Wt + p * 136 + seg * 8) = *(const u32x4*)(WSP + ((size_t)g * 128 + p) * 128 + seg * 8); }
        __syncthreads();
#pragma unroll
        for (int i = 0; i < 4; ++i) { const int idx = F.tid + NTHR * i, q = idx >> 4, seg = idx & 15, ch = g * 128 + seg * 8;
            const u32x4 raw = *(const u32x4*)(V + (size_t)(t0 + q) * GWID + ch); const unsigned rw[4] = {raw.x, raw.y, raw.z, raw.w};
            const float m_ = mu[q], r_ = rs[q];
#pragma unroll
            for (int e = 0; e < 8; ++e) { const float x = (e & 1) ? bf_hi(rw[e >> 1]) : bf_lo(rw[e >> 1]);
                Vt[(seg * 8 + e) * 136 + q] = f2bf((x - m_) * r_ * lng[ch + e] + lnb[ch + e]); } }
        __syncthreads();
        bf16x8 bw[4];
#pragma unroll
        for (int ks = 0; ks < 4; ++ks) bw[ks] = *(const LAS bf16x8*)(Wt + (16 * F.wave + l15) * 136 + ks * 32 + 8 * l4);
        const int p = 16 * F.wave + l15; const float bias = bs[g * 128 + p];
#pragma unroll
        for (int dt = 0; dt < 8; ++dt) { f32x4 acc = (f32x4){0.f, 0.f, 0.f, 0.f};
#pragma unroll
            for (int ks = 0; ks < 4; ++ks) { const bf16x8 a = *(const LAS bf16x8*)(Vt + (dt * 16 + l15) * 136 + ks * 32 + 8 * l4); acc = __builtin_amdgcn_mfma_f32_16x16x32_bf16(a, bw[ks], acc, 0, 0, 0); }
            bf16_t* up = U + (size_t)(t0 + p) * GWID + g * 128 + dt * 16 + 4 * l4; const u32x2 uu = *(const u32x2*)up;
            u32x2 o; o.x = cvt_pk_bf16(bf_lo(uu.x) * (acc[0] + bias), bf_hi(uu.x) * (acc[1] + bias)); o.y = cvt_pk_bf16(bf_lo(uu.y) * (acc[2] + bias), bf_hi(uu.y) * (acc[3] + bias));
            *(u32x2*)up = o; }
    }
}

__device__ __forceinline__ void mix_phase(const Frame& F, KP P, int j) {
    const bf16_t* HL = (const bf16_t*)(P->ws + WS_HL); const float* mu = P->in[I_MU] + (size_t)j * 6 * D;
    bf16_t* outs[6] = {(bf16_t*)(P->ws + WS_XR), (bf16_t*)(P->ws + WS_XW), (bf16_t*)(P->ws + WS_XK), (bf16_t*)(P->ws + WS_XV), (bf16_t*)(P->ws + WS_XA), (bf16_t*)(P->ws + WS_XG)};
    for (int row = F.gw; row < T; row += F.NGW) {
        bool ok[2]; int src[2]; const bool hi = F.lane >= 32;
        if (row < TL) { const int n = row & (SEQ - 1), gc = n & 63, gr = n >> 6;
            ok[0] = hi ? gc < 63 : gc > 0; src[0] = hi ? row + 1 : row - 1; ok[1] = hi ? gr < 255 : gr > 0; src[1] = hi ? row + 64 : row - 64; }
        else { const int n = (row - TL) & (CTXL - 1); ok[0] = n > 0; src[0] = row - 1; ok[1] = n < CTXL - 1; src[1] = row + 1; }
#pragma unroll
        for (int jj = 0; jj < 2; ++jj) { const int col = 512 * jj + 8 * F.lane;
            const u32x4 h8 = *(const u32x4*)(HL + (size_t)row * D + col); u32x4 s8 = (u32x4){0u, 0u, 0u, 0u};
            if (ok[jj]) s8 = *(const u32x4*)(HL + (size_t)src[jj] * D + col);
            const unsigned hw[4] = {h8.x, h8.y, h8.z, h8.w}, sw[4] = {s8.x, s8.y, s8.z, s8.w}; float h[8], xx[8];
#pragma unroll
            for (int e = 0; e < 8; ++e) { h[e] = (e & 1) ? bf_hi(hw[e >> 1]) : bf_lo(hw[e >> 1]); const float s = (e & 1) ? bf_hi(sw[e >> 1]) : bf_lo(sw[e >> 1]); xx[e] = s - h[e]; }
#pragma unroll
            for (int m = 0; m < 6; ++m) { const f32x4 ma = *(const f32x4*)(mu + (size_t)m * D + col), mb = *(const f32x4*)(mu + (size_t)m * D + col + 4);
                u32x4 o; o.x = cvt_pk_bf16(h[0] + xx[0] * ma[0], h[1] + xx[1] * ma[1]); o.y = cvt_pk_bf16(h[2] + xx[2] * ma[2], h[3] + xx[3] * ma[3]);
                o.z = cvt_pk_bf16(h[4] + xx[4] * mb[0], h[5] + xx[5] * mb[1]); o.w = cvt_pk_bf16(h[6] + xx[6] * mb[2], h[7] + xx[7] * mb[3]);
                *(u32x4*)(outs[m] + (size_t)row * D + col) = o; } }
    }
}

constexpr int NSC = 65, NSCAN = 64, TP = 72, TILE_B = 64 * TP * 2;
enum { T_AT = 0, T_RT, T_BT, T_KT, T_VM, T_NT, T_MT, T_NRT, T_MRT, T_APA, T_APB, T_TAA, T_TAB, T_PRB, T_QRB, T_NTILE };
constexpr int LDS_GL = T_NTILE * TILE_B, LDS_SEG = LDS_GL + 256;
static_assert(LDS_SEG + 2048 <= LDS_MISC, "scan LDS map");
typedef short v4s __attribute__((ext_vector_type(4)));
__device__ __forceinline__ int scan_row(int z, int b, int p) {
    if (p < CTXL) return TL + b * CTXL + (z ? CTXL - 1 - p : p);
    const int q = p - CTXL; return b * SEQ + (z ? SEQ - 1 - q : q);
}
__device__ __forceinline__ LAS bf16_t* stile(LAS unsigned char* lds, int n) { return (LAS bf16_t*)(lds + n * TILE_B); }
__device__ __forceinline__ bf16x8 row_frag(const LAS bf16_t* M, int r0, int k0, int lane) { return *(const LAS bf16x8*)(M + (r0 + (lane & 15)) * TP + k0 + 8 * (lane >> 4)); }
__device__ __forceinline__ bf16x8 tr_frag(const LAS bf16_t* M, int k0, int c0, int lane) {
    LAS bf16_t* p = (LAS bf16_t*)M + (k0 + 8 * (lane >> 4) + ((lane & 15) >> 2)) * TP + c0 + 4 * (lane & 3);
    const v4s lo = __builtin_amdgcn_ds_read_tr16_b64_v4i16((LAS v4s*)p), hi = __builtin_amdgcn_ds_read_tr16_b64_v4i16((LAS v4s*)(p + 4 * TP));
    return (bf16x8){lo[0], lo[1], lo[2], lo[3], hi[0], hi[1], hi[2], hi[3]};
}
template <bool XT, bool YT>
__device__ __forceinline__ void mm64(const LAS bf16_t* X, const LAS bf16_t* Y, f32x4 (&acc)[2], int wq, int wh, int lane) {
#pragma unroll
    for (int ks = 0; ks < 2; ++ks) {
        const bf16x8 b = XT ? tr_frag(X, 32 * ks, 16 * wq, lane) : row_frag(X, 16 * wq, 32 * ks, lane);
#pragma unroll
        for (int q = 0; q < 2; ++q) { const int i0 = 16 * (2 * wh + q);
            const bf16x8 a = YT ? row_frag(Y, i0, 32 * ks, lane) : tr_frag(Y, 32 * ks, i0, lane);
            acc[q] = __builtin_amdgcn_mfma_f32_16x16x32_bf16(a, b, acc[q], 0, 0, 0); }
    }
}
__device__ __forceinline__ void st_tile(LAS bf16_t* Z, const f32x4 (&acc)[2], int wq, int wh, int lane) {
#pragma unroll
    for (int q = 0; q < 2; ++q) { u32x2 o; o.x = cvt_pk_bf16(acc[q][0], acc[q][1]); o.y = cvt_pk_bf16(acc[q][2], acc[q][3]);
        *(LAS u32x2*)(Z + (16 * wq + (lane & 15)) * TP + 16 * (2 * wh + q) + 4 * (lane >> 4)) = o; }
}
__device__ __forceinline__ void ld_tile(const LAS bf16_t* Z, f32x4 (&acc)[2], int wq, int wh, int lane) {
#pragma unroll
    for (int q = 0; q < 2; ++q) { const u32x2 o = *(const LAS u32x2*)(Z + (16 * wq + (lane & 15)) * TP + 16 * (2 * wh + q) + 4 * (lane >> 4));
        acc[q] = (f32x4){bf_lo(o.x), bf_hi(o.x), bf_lo(o.y), bf_hi(o.y)}; }
}
struct ChunkRegs { u32x4 r, k, v, e, m, a; };
__device__ __forceinline__ void scan_load(KP P, const Frame& F, int item, int c4, ChunkRegs& R) {
    const int s = item & 63, sc = item >> 6, z = s >> 5, b = (s >> 4) & 1, hh = s & 15;
    const size_t o = (size_t)scan_row(z, b, sc * 256 + c4 * 64 + (F.tid >> 3)) * D + hh * 64 + (F.tid & 7) * 8;
    R.r = *(const u32x4*)((const bf16_t*)(P->ws + WS_R) + o); R.k = *(const u32x4*)((const bf16_t*)(P->ws + WS_K) + o); R.v = *(const u32x4*)((const bf16_t*)(P->ws + WS_VV) + o);
    R.e = *(const u32x4*)((const bf16_t*)(P->ws + (z ? WS_ELOG1 : WS_ELOG0)) + o); R.m = *(const u32x4*)((const bf16_t*)(P->ws + (z ? WS_KM1 : WS_KM0)) + o); R.a = *(const u32x4*)((const bf16_t*)(P->ws + (z ? WS_AS1 : WS_AS0)) + o);
}
__device__ __forceinline__ void unpack8(const u32x4& w, float (&f)[8]) { f[0] = bf_lo(w.x); f[1] = bf_hi(w.x); f[2] = bf_lo(w.y); f[3] = bf_hi(w.y); f[4] = bf_lo(w.z); f[5] = bf_hi(w.z); f[6] = bf_lo(w.w); f[7] = bf_hi(w.w); }
__device__ __forceinline__ u32x4 pack8(const float (&f)[8]) { u32x4 o; o.x = cvt_pk_bf16(f[0], f[1]); o.y = cvt_pk_bf16(f[2], f[3]); o.z = cvt_pk_bf16(f[4], f[5]); o.w = cvt_pk_bf16(f[6], f[7]); return o; }
__device__ __forceinline__ void scan_chunk_phase(const Frame& F, KP P, int j) {
    LAS unsigned char* lds = F.lds;
    LAS bf16_t* At = stile(lds, T_AT); LAS bf16_t* Rt = stile(lds, T_RT); LAS bf16_t* Bt = stile(lds, T_BT); LAS bf16_t* Kt = stile(lds, T_KT); LAS bf16_t* Vm = stile(lds, T_VM);
    LAS bf16_t* NT = stile(lds, T_NT); LAS bf16_t* MT = stile(lds, T_MT); LAS bf16_t* NrT = stile(lds, T_NRT); LAS bf16_t* MrT = stile(lds, T_MRT);
    LAS bf16_t* ApA = stile(lds, T_APA); LAS bf16_t* ApB = stile(lds, T_APB); LAS bf16_t* TaA = stile(lds, T_TAA); LAS bf16_t* TaB = stile(lds, T_TAB);
    LAS bf16_t* PrB = stile(lds, T_PRB); LAS bf16_t* QrB = stile(lds, T_QRB);
    LAS float* Efp = (LAS float*)(lds + T_APA * TILE_B); LAS float* gl = (LAS float*)(lds + LDS_GL); LAS float* seg = (LAS float*)(lds + LDS_SEG);
    const int lane = F.lane, wq = F.wave & 3, wh = F.wave >> 2, l15 = lane & 15, l4 = lane >> 4;
    const int pi = F.tid >> 3, kq = F.tid & 7;
    const int jrow = 16 * wq + l15;
    const int NITEM = NSCAN * NSC;
    int item = blockIdx.x; if (item >= NITEM) return;
    ChunkRegs cur, nxt; scan_load(P, F, item, 0, cur); nxt = cur;
    f32x4 Pr[2], Qr[2];
#pragma unroll
    for (int q = 0; q < 2; ++q) { Pr[q] = (f32x4){0.f, 0.f, 0.f, 0.f}; Qr[q] = (f32x4){0.f, 0.f, 0.f, 0.f}; }
    for (;;) {
        const int s = item & 63, sc = item >> 6, z = s >> 5, b = (s >> 4) & 1, hh = s & 15;
        const float* kkw = P->in[I_KK] + (size_t)j * D + hh * 64 + kq * 8;
        bf16_t* GE = (bf16_t*)(P->ws + (z ? WS_AS1 : WS_AS0)); bf16_t* YE = (bf16_t*)(P->ws + (z ? WS_ELOG1 : WS_ELOG0));
#pragma nounroll
        for (int c4 = 0; c4 < 4; ++c4) {
            float r8[8], k8[8], e8[8], m8[8], a8[8], kk8[8];
            unpack8(cur.r, r8); unpack8(cur.k, k8); unpack8(cur.e, e8); unpack8(cur.m, m8); unpack8(cur.a, a8);
            { const f32x4 w0 = *(const f32x4*)kkw, w1 = *(const f32x4*)(kkw + 4); float ss = 0.f;
#pragma unroll
              for (int e = 0; e < 8; ++e) { kk8[e] = k8[e] * (e < 4 ? w0[e & 3] : w1[e & 3]); ss += kk8[e] * kk8[e]; }
              ss += __shfl_xor(ss, 1); ss += __shfl_xor(ss, 2); ss += __shfl_xor(ss, 4);
              const float rn = rsqrtf(ss + 1e-12f);
#pragma unroll
              for (int e = 0; e < 8; ++e) kk8[e] *= rn; }
            *(LAS f32x4*)(Efp + pi * 64 + kq * 8) = (f32x4){e8[0], e8[1], e8[2], e8[3]}; *(LAS f32x4*)(Efp + pi * 64 + kq * 8 + 4) = (f32x4){e8[4], e8[5], e8[6], e8[7]};
            __syncthreads();
            if (c4 > 0) { st_tile(PrB, Pr, wq, wh, lane); st_tile(QrB, Qr, wq, wh, lane); }
            { const int kc = F.tid & 63, sg = F.tid >> 6; float run = 0.f;
#pragma unroll
              for (int ii = 0; ii < 8; ++ii) { run += Efp[(sg * 8 + ii) * 64 + kc]; Efp[(sg * 8 + ii) * 64 + kc] = run; }
              seg[sg * 64 + kc] = run; }
            __syncthreads();
            { const int kc = F.tid & 63, sg = F.tid >> 6; float off = 0.f;
              for (int s2 = 0; s2 < sg; ++s2) off += seg[s2 * 64 + kc];
#pragma unroll
              for (int ii = 0; ii < 8; ++ii) Efp[(sg * 8 + ii) * 64 + kc] += off; }
            __syncthreads();
            float cum[8];
            { const f32x4 c0 = *(const LAS f32x4*)(Efp + pi * 64 + kq * 8), c1 = *(const LAS f32x4*)(Efp + pi * 64 + kq * 8 + 4);
#pragma unroll
              for (int e = 0; e < 8; ++e) cum[e] = e < 4 ? c0[e & 3] : c1[e & 3]; }
            __syncthreads();
            { float o[8];
#pragma unroll
              for (int e = 0; e < 8; ++e) o[e] = -kk8[e] * __expf(cum[e] - e8[e]);
              *(LAS u32x4*)(At + pi * TP + kq * 8) = pack8(o);
#pragma unroll
              for (int e = 0; e < 8; ++e) o[e] = r8[e] * __expf(cum[e]);
              *(LAS u32x4*)(Rt + pi * TP + kq * 8) = pack8(o);
              float en[8];
#pragma unroll
              for (int e = 0; e < 8; ++e) { en[e] = __expf(-cum[e]); o[e] = kk8[e] * a8[e] * en[e]; }
              *(LAS u32x4*)(Bt + pi * TP + kq * 8) = pack8(o);
#pragma unroll
              for (int e = 0; e < 8; ++e) o[e] = m8[e] * en[e];
              *(LAS u32x4*)(Kt + pi * TP + kq * 8) = pack8(o);
              *(LAS u32x4*)(Vm + pi * TP + kq * 8) = cur.v;
              if (pi == 63) {
#pragma unroll
                  for (int e = 0; e < 8; ++e) gl[kq * 8 + e] = __expf(cum[e]); } }
            { const int nitem = c4 < 3 ? item : item + (int)gridDim.x, nc4 = c4 < 3 ? c4 + 1 : 0; if (nitem < NITEM) scan_load(P, F, nitem, nc4, nxt); }
            __syncthreads();
            {   f32x4 aN[2], aM[2], aNr[2], aMr[2];
#pragma unroll
                for (int q = 0; q < 2; ++q) { aN[q] = (f32x4){0.f, 0.f, 0.f, 0.f}; aM[q] = aN[q]; aNr[q] = aN[q]; aMr[q] = aN[q]; }
                mm64<false, true>(At, Bt, aN, wq, wh, lane); mm64<false, true>(At, Kt, aM, wq, wh, lane); mm64<false, true>(Rt, Bt, aNr, wq, wh, lane); mm64<false, true>(Rt, Kt, aMr, wq, wh, lane);
                f32x4 aT[2];
#pragma unroll
                for (int q = 0; q < 2; ++q)
#pragma unroll
                    for (int r = 0; r < 4; ++r) { const int i = 16 * (2 * wh + q) + 4 * l4 + r; const bool lt = i < jrow, le = i <= jrow;
                        aN[q][r] = lt ? aN[q][r] : 0.f; aM[q][r] = lt ? aM[q][r] : 0.f; aNr[q][r] = le ? aNr[q][r] : 0.f; aMr[q][r] = le ? aMr[q][r] : 0.f; aT[q][r] = aN[q][r] + (i == jrow ? 1.f : 0.f); }
                st_tile(NT, aN, wq, wh, lane); st_tile(MT, aM, wq, wh, lane); st_tile(NrT, aNr, wq, wh, lane); st_tile(MrT, aMr, wq, wh, lane); st_tile(TaA, aT, wq, wh, lane);
            }
            __syncthreads();
            {   f32x4 a2[2] = {(f32x4){0.f, 0.f, 0.f, 0.f}, (f32x4){0.f, 0.f, 0.f, 0.f}}; mm64<false, false>(NT, NT, a2, wq, wh, lane); st_tile(ApA, a2, wq, wh, lane); }
            __syncthreads();
#pragma nounroll
            for (int it = 0; it < 2; ++it) {
                {   f32x4 t[2]; ld_tile(TaA, t, wq, wh, lane); mm64<false, false>(TaA, ApA, t, wq, wh, lane); st_tile(TaB, t, wq, wh, lane);
                    f32x4 a2[2] = {(f32x4){0.f, 0.f, 0.f, 0.f}, (f32x4){0.f, 0.f, 0.f, 0.f}}; mm64<false, false>(ApA, ApA, a2, wq, wh, lane); st_tile(ApB, a2, wq, wh, lane); }
                __syncthreads();
                {   f32x4 t[2]; ld_tile(TaB, t, wq, wh, lane); mm64<false, false>(TaB, ApB, t, wq, wh, lane); st_tile(TaA, t, wq, wh, lane);
                    f32x4 a2[2] = {(f32x4){0.f, 0.f, 0.f, 0.f}, (f32x4){0.f, 0.f, 0.f, 0.f}}; mm64<false, false>(ApB, ApB, a2, wq, wh, lane); st_tile(ApA, a2, wq, wh, lane); }
                __syncthreads();
            }
            {   f32x4 t[2]; ld_tile(TaA, t, wq, wh, lane); mm64<false, false>(TaA, ApA, t, wq, wh, lane); st_tile(TaB, t, wq, wh, lane); }
            __syncthreads();
            {   f32x4 w[2] = {(f32x4){0.f, 0.f, 0.f, 0.f}, (f32x4){0.f, 0.f, 0.f, 0.f}}; mm64<true, true>(At, TaB, w, wq, wh, lane); st_tile(ApA, w, wq, wh, lane);
                f32x4 x[2] = {(f32x4){0.f, 0.f, 0.f, 0.f}, (f32x4){0.f, 0.f, 0.f, 0.f}}; mm64<true, true>(Vm, MT, x, wq, wh, lane); st_tile(ApB, x, wq, wh, lane); }
            __syncthreads();
            {   f32x4 u[2] = {(f32x4){0.f, 0.f, 0.f, 0.f}, (f32x4){0.f, 0.f, 0.f, 0.f}}; mm64<false, true>(ApB, TaB, u, wq, wh, lane); st_tile(TaA, u, wq, wh, lane); }
            __syncthreads();
            f32x4 aP[2], aQ[2], aG[2], aY[2];
#pragma unroll
            for (int q = 0; q < 2; ++q) { aP[q] = (f32x4){0.f, 0.f, 0.f, 0.f}; aQ[q] = aP[q]; aG[q] = aP[q]; aY[q] = aP[q]; }
            mm64<false, false>(ApA, Bt, aP, wq, wh, lane);
            mm64<false, false>(TaA, Bt, aQ, wq, wh, lane); mm64<true, false>(Vm, Kt, aQ, wq, wh, lane);
            mm64<false, true>(NrT, ApA, aG, wq, wh, lane);
            mm64<false, true>(NrT, TaA, aY, wq, wh, lane); mm64<false, false>(MrT, Vm, aY, wq, wh, lane);
#pragma unroll
            for (int q = 0; q < 2; ++q) { const int i0 = 16 * (2 * wh + q) + 4 * l4; const f32x4 g4 = *(const LAS f32x4*)(gl + i0);
                const u32x2 rr = *(const LAS u32x2*)(Rt + jrow * TP + i0);
#pragma unroll
                for (int r = 0; r < 4; ++r) { aP[q][r] = (aP[q][r] + (i0 + r == jrow ? 1.f : 0.f)) * g4[r]; aQ[q][r] *= g4[r]; }
                aG[q][0] += bf_lo(rr.x); aG[q][1] += bf_hi(rr.x); aG[q][2] += bf_lo(rr.y); aG[q][3] += bf_hi(rr.y); }
            const size_t orow = (size_t)scan_row(z, b, sc * 256 + c4 * 64 + jrow) * D + hh * 64;
            if (c4 == 0) {
#pragma unroll
                for (int q = 0; q < 2; ++q) { const int i0 = 16 * (2 * wh + q) + 4 * l4;
                    u32x2 o; o.x = cvt_pk_bf16(aG[q][0], aG[q][1]); o.y = cvt_pk_bf16(aG[q][2], aG[q][3]); *(u32x2*)(GE + orow + i0) = o;
                    u32x2 y; y.x = cvt_pk_bf16(aY[q][0], aY[q][1]); y.y = cvt_pk_bf16(aY[q][2], aY[q][3]); *(u32x2*)(YE + orow + i0) = y;
                    Pr[q] = aP[q]; Qr[q] = aQ[q]; }
            } else {
                st_tile(NT, aG, wq, wh, lane); st_tile(MT, aP, wq, wh, lane);
                __syncthreads();
                f32x4 ge[2] = {(f32x4){0.f, 0.f, 0.f, 0.f}, (f32x4){0.f, 0.f, 0.f, 0.f}};
                mm64<false, true>(NT, PrB, ge, wq, wh, lane); mm64<false, true>(NT, QrB, aY, wq, wh, lane);
                f32x4 pn[2] = {(f32x4){0.f, 0.f, 0.f, 0.f}, (f32x4){0.f, 0.f, 0.f, 0.f}};
                mm64<false, false>(PrB, MT, pn, wq, wh, lane); mm64<false, false>(QrB, MT, aQ, wq, wh, lane);
#pragma unroll
                for (int q = 0; q < 2; ++q) { const int i0 = 16 * (2 * wh + q) + 4 * l4;
                    u32x2 o; o.x = cvt_pk_bf16(ge[q][0], ge[q][1]); o.y = cvt_pk_bf16(ge[q][2], ge[q][3]); *(u32x2*)(GE + orow + i0) = o;
                    u32x2 y; y.x = cvt_pk_bf16(aY[q][0], aY[q][1]); y.y = cvt_pk_bf16(aY[q][2], aY[q][3]); *(u32x2*)(YE + orow + i0) = y;
                    Pr[q] = pn[q]; Qr[q] = aQ[q]; }
            }
            if (c4 == 3) { float* pq = (float*)(P->ws + WS_PQ) + ((size_t)(s * NSC + sc) * 2) * 4096;
#pragma unroll
                for (int q = 0; q < 2; ++q) { const int i0 = 16 * (2 * wh + q) + 4 * l4; *(f32x4*)(pq + jrow * 64 + i0) = Pr[q]; *(f32x4*)(pq + 4096 + jrow * 64 + i0) = Qr[q]; } }
            cur = nxt;
            __syncthreads();
        }
        item += gridDim.x; if (item >= NITEM) break;
    }
}
__device__ __forceinline__ void scan_carry_phase(const Frame& F, KP P) {
    if (F.wave != 0 || blockIdx.x >= 4 * NSCAN) return;
    const int s = blockIdx.x >> 2, vs = blockIdx.x & 3, lane = F.lane, l15 = lane & 15, l4 = lane >> 4;
    const float* pq = (const float*)(P->ws + WS_PQ) + (size_t)s * NSC * 2 * 4096; bf16_t* sst = (bf16_t*)(P->ws + WS_SST) + (size_t)s * NSC * 4096;
    f32x4 S[4];
#pragma unroll
    for (int t = 0; t < 4; ++t) S[t] = (f32x4){0.f, 0.f, 0.f, 0.f};
#pragma nounroll
    for (int sc = 0; sc < NSC; ++sc) {
#pragma unroll
        for (int t = 0; t < 4; ++t) { u32x2 o; o.x = cvt_pk_bf16(S[t][0], S[t][1]); o.y = cvt_pk_bf16(S[t][2], S[t][3]); *(u32x2*)(sst + (size_t)sc * 4096 + (16 * vs + l15) * 64 + 16 * t + 4 * l4) = o; }
        if (sc == NSC - 1) break;
        const float* Pm = pq + (size_t)sc * 2 * 4096; const float* Qm = Pm + 4096;
        f32x4 nw[4];
#pragma unroll
        for (int t2 = 0; t2 < 4; ++t2) nw[t2] = *(const f32x4*)(Qm + (16 * vs + l15) * 64 + 16 * t2 + 4 * l4);
#pragma unroll
        for (int t = 0; t < 4; ++t)
#pragma unroll
            for (int r = 0; r < 4; ++r) { const float* prow = Pm + (16 * t + 4 * l4 + r) * 64 + l15;
#pragma unroll
                for (int t2 = 0; t2 < 4; ++t2) nw[t2] = __builtin_amdgcn_mfma_f32_16x16x4f32(prow[16 * t2], S[t][r], nw[t2], 0, 0, 0); }
#pragma unroll
        for (int t = 0; t < 4; ++t) S[t] = nw[t];
    }
}
__device__ __forceinline__ void scan_fix_phase(const Frame& F, KP P) {
    const int lane = F.lane, l15 = lane & 15, l4 = lane >> 4;
    for (int item = F.gw; item < NSCAN * NSC; item += F.NGW) {
        const int s = item & 63, sc = item >> 6, z = s >> 5, b = (s >> 4) & 1, hh = s & 15;
        const bf16_t* sst = (const bf16_t*)(P->ws + WS_SST) + ((size_t)s * NSC + sc) * 4096;
        const bf16_t* GE = (const bf16_t*)(P->ws + (z ? WS_AS1 : WS_AS0)); bf16_t* YE = (bf16_t*)(P->ws + (z ? WS_ELOG1 : WS_ELOG0));
        bf16x8 sa[4][2];
#pragma unroll
        for (int vt = 0; vt < 4; ++vt)
#pragma unroll
            for (int ks = 0; ks < 2; ++ks) sa[vt][ks] = *(const bf16x8*)(sst + (16 * vt + l15) * 64 + 32 * ks + 8 * l4);
#pragma nounroll
        for (int tt = 0; tt < 16; ++tt) {
            const size_t orow = (size_t)scan_row(z, b, sc * 256 + tt * 16 + l15) * D + hh * 64;
            const bf16x8 g0 = *(const bf16x8*)(GE + orow + 8 * l4), g1 = *(const bf16x8*)(GE + orow + 32 + 8 * l4);
#pragma unroll
            for (int vt = 0; vt < 4; ++vt) { const u32x2 y0 = *(const u32x2*)(YE + orow + 16 * vt + 4 * l4);
                f32x4 acc = (f32x4){bf_lo(y0.x), bf_hi(y0.x), bf_lo(y0.y), bf_hi(y0.y)};
                acc = __builtin_amdgcn_mfma_f32_16x16x32_bf16(sa[vt][0], g0, acc, 0, 0, 0); acc = __builtin_amdgcn_mfma_f32_16x16x32_bf16(sa[vt][1], g1, acc, 0, 0, 0);
                u32x2 o; o.x = cvt_pk_bf16(acc[0], acc[1]); o.y = cvt_pk_bf16(acc[2], acc[3]); *(u32x2*)(YE + orow + 16 * vt + 4 * l4) = o; }
        }
    }
}

__device__ __forceinline__ void rwkv_out_phase(const Frame& F, KP P, int j) {
    const bf16_t* Y0 = (const bf16_t*)(P->ws + WS_ELOG0); const bf16_t* Y1 = (const bf16_t*)(P->ws + WS_ELOG1); const bf16_t* Rb = (const bf16_t*)(P->ws + WS_R); const bf16_t* Vb = (const bf16_t*)(P->ws + WS_VV);
    const bf16_t* KM0 = (const bf16_t*)(P->ws + WS_KM0); const bf16_t* KM1 = (const bf16_t*)(P->ws + WS_KM1); const bf16_t* GT = (const bf16_t*)(P->ws + WS_GATE); bf16_t* YG = (bf16_t*)(P->ws + WS_YG);
    const float* lng = P->in[I_LNG] + (size_t)j * D; const float* lnb = P->in[I_LNB] + (size_t)j * D; const float* rk = P->in[I_RK] + (size_t)j * D;
    for (int row = F.gw; row < T; row += F.NGW) {
        const size_t o = (size_t)row * D + 16 * F.lane; float y[16], r[16], km[16], v[16], g[16];
#pragma unroll
        for (int hx = 0; hx < 2; ++hx) { const u32x4 a = *(const u32x4*)(Y0 + o + 8 * hx), b = *(const u32x4*)(Y1 + o + 8 * hx), c = *(const u32x4*)(Rb + o + 8 * hx), d = *(const u32x4*)(KM0 + o + 8 * hx),
                e = *(const u32x4*)(KM1 + o + 8 * hx), f = *(const u32x4*)(Vb + o + 8 * hx), gg = *(const u32x4*)(GT + o + 8 * hx);
            const unsigned aw[4] = {a.x, a.y, a.z, a.w}, bw[4] = {b.x, b.y, b.z, b.w}, cw[4] = {c.x, c.y, c.z, c.w}, dw[4] = {d.x, d.y, d.z, d.w}, ew[4] = {e.x, e.y, e.z, e.w}, fw[4] = {f.x, f.y, f.z, f.w}, gw4[4] = {gg.x, gg.y, gg.z, gg.w};
#pragma unroll
            for (int i = 0; i < 8; ++i) { const int q = i >> 1; const bool od = i & 1;
                y[8 * hx + i] = (od ? bf_hi(aw[q]) : bf_lo(aw[q])) + (od ? bf_hi(bw[q]) : bf_lo(bw[q])); r[8 * hx + i] = od ? bf_hi(cw[q]) : bf_lo(cw[q]);
                km[8 * hx + i] = (od ? bf_hi(dw[q]) : bf_lo(dw[q])) + (od ? bf_hi(ew[q]) : bf_lo(ew[q])); v[8 * hx + i] = od ? bf_hi(fw[q]) : bf_lo(fw[q]); g[8 * hx + i] = od ? bf_hi(gw4[q]) : bf_lo(gw4[q]); } }
        float s = 0.f, bn = 0.f;
#pragma unroll
        for (int i = 0; i < 16; ++i) { s += y[i]; bn += r[i] * rk[16 * F.lane + i] * km[i]; }
        s += __shfl_xor(s, 1); s += __shfl_xor(s, 2); bn += __shfl_xor(bn, 1); bn += __shfl_xor(bn, 2);
        const float mean = s * (1.0f / 64.0f); float q = 0.f;
#pragma unroll
        for (int i = 0; i < 16; ++i) { const float d = y[i] - mean; q += d * d; }
        q += __shfl_xor(q, 1); q += __shfl_xor(q, 2);
        const float rstd = rsqrtf(q * (1.0f / 64.0f) + 64e-5f);
        float ov[16];
#pragma unroll
        for (int i = 0; i < 16; ++i) { const int cix = 16 * F.lane + i; ov[i] = (((y[i] - mean) * rstd) * lng[cix] + lnb[cix] + bn * v[i]) * g[i]; }
#pragma unroll
        for (int hx = 0; hx < 2; ++hx) { u32x4 w; w.x = cvt_pk_bf16(ov[8 * hx], ov[8 * hx + 1]); w.y = cvt_pk_bf16(ov[8 * hx + 2], ov[8 * hx + 3]); w.z = cvt_pk_bf16(ov[8 * hx + 4], ov[8 * hx + 5]); w.w = cvt_pk_bf16(ov[8 * hx + 6], ov[8 * hx + 7]);
            *(u32x4*)(YG + o + 8 * hx) = w; }
    }
}

__device__ __forceinline__ bool in_range(int lo, int hi, int k) { asm volatile("" : "+s"(lo), "+s"(hi)); return lo <= k && k < hi; }
constexpr int NPH = 40;
template <unsigned KMASK> __global__ void __launch_bounds__(NTHR, 2) mega(Params Pv) {
    extern __shared__ __attribute__((aligned(16))) unsigned char lds_raw[];
    Frame F0; F0.lds = (LAS unsigned char*)lds_raw; F0.tid = threadIdx.x; F0.lane = F0.tid & 63; F0.wave = __builtin_amdgcn_readfirstlane(F0.tid >> 6);
    F0.G = gridDim.x; F0.gw = blockIdx.x * NWAVES + F0.wave; F0.NGW = F0.G * NWAVES;
    LAS unsigned* misc = (LAS unsigned*)(F0.lds + LDS_MISC);
    if (F0.tid < 128) misc[F0.tid] = 0u;
    __syncthreads();
    KP P0 = (KP)__builtin_amdgcn_kernarg_segment_ptr();
    constexpr bool ALL = (KMASK == 0xffffu);
    const int lo = ALL ? 0 : P0->ph_lo, hi = ALL ? NPH : P0->ph_hi;
    XcdBarrier bar; bar.bar = (unsigned*)(P0->ws + WS_CTL) + CW_BAR; bar.x = 0; bar.st = (volatile LAS unsigned*)(misc + 8);
    if (ALL || hi - lo > 1) bar = xcd_barrier_post((unsigned*)(P0->ws + WS_CTL) + CW_BAR, (volatile LAS unsigned*)(misc + 8));
#define IN(k) (ALL || in_range(lo, hi, (k)))
#define KIND(q) ((KMASK >> (q)) & 1u)
#define SEAM(k) do { if (IN(k) && IN((k) + 1)) xcd_barrier(bar); } while (0)
#define PHASE_ENTRY KP P = P0; asm volatile("" : "+s"(P)); unsigned char* ws = P->ws; unsigned* ctl = (unsigned*)(ws + WS_CTL); (void)ctl; \
    Frame F = F0; { int t_ = F0.tid; asm volatile("" : "+v"(t_)); F.tid = t_; F.lane = t_ & 63; F.wave = __builtin_amdgcn_readfirstlane(t_ >> 6); F.gw = blockIdx.x * NWAVES + F.wave; }

    if constexpr (KIND(0)) if (IN(0)) { PHASE_ENTRY prologue_phase(F, P); }
    SEAM(0);
    for (int lp = 0; lp < 2; ++lp) {
        const int pb = 1 + 19 * lp, la = 2 * lp, lb = 2 * lp + 1;
        if constexpr (KIND(1)) if (IN(pb + 0)) { PHASE_ENTRY norm1_phase(F, P, la); }
        SEAM(pb + 0);
        if constexpr (KIND(2)) if (IN(pb + 1)) { PHASE_ENTRY
            __syncthreads(); set_desc(F.lds, 0, ws + WS_HL, ws + WS_WIN + (size_t)lp * 4096 * D * 2, ws + WS_U, 16, 0, 0, ws + WS_V, P->in[I_GBIN] + (size_t)lp * 4096, ws + WS_STAT); __syncthreads();
            SchedMulti<D, D> S{F.lds, T / 256, 16, 1};
            EpiGelu E{F.lds};
            pg8::gemm_phase<EpiGelu, SchedMulti<D, D>, false, D, D, D>(F.lds, S, E);
        }
        SEAM(pb + 1);
        if constexpr (KIND(3)) if (IN(pb + 2)) { PHASE_ENTRY spatial_phase(F, P, lp); }
        SEAM(pb + 2);
        if constexpr (KIND(4)) if (IN(pb + 3)) { PHASE_ENTRY
            __syncthreads(); { float* X = (float*)(ws + WS_X);
              set_desc(F.lds, 0, ws + WS_U, ws + WS_WOUT + (size_t)lp * D * GWID * 2, X, 4, 0, 0, la == 0 ? P->in[I_X] : X, la == 0 ? P->in[I_CTX] : X + (size_t)TL * D, P->in[I_GBOUT] + (size_t)lp * D);
              set_desc(F.lds, 1, nullptr, nullptr, nullptr, 0, 0, 0, (const float*)(ws + WS_MOD) + (size_t)la * 3 * 6 * D + 2 * D); }
            __syncthreads();
            SchedMulti<GWID, GWID> S{F.lds, T / 256, 4, 1};
            EpiResid E{F.lds};
            pg8::gemm_phase<EpiResid, SchedMulti<GWID, GWID>, false, GWID, GWID, GWID>(F.lds, S, E);
        }
        SEAM(pb + 3);
        if constexpr (KIND(5)) if (IN(pb + 4)) { PHASE_ENTRY route_phase(F, P, la); }
        SEAM(pb + 4);
        if constexpr (KIND(6)) if (IN(pb + 5)) { PHASE_ENTRY
            moe_tables(F.lds, ctl + CW_CNT + la * 64);
            SchedMoE<D, D, true> S{F.lds, (const char*)(ws + WS_HL), (const char*)(ws + WS_WGU), (const int*)(ws + WS_LIST)};
            EpiSiluGate E{(bf16_t*)(ws + WS_H)};
            pg8::gemm_phase<EpiSiluGate, SchedMoE<D, D, true>, true, D, D, D>(F.lds, S, E);
        }
        SEAM(pb + 5);
        if constexpr (KIND(7)) if (IN(pb + 6)) { PHASE_ENTRY
            moe_tables(F.lds, ctl + CW_CNT + la * 64);
            SchedMoE<EHID, EHID, false> S{F.lds, (const char*)(ws + WS_H), (const char*)(ws + WS_WD), (const int*)(ws + WS_LIST)};
            EpiScatter E{F.lds, (bf16_t*)(ws + WS_YB), (const int*)(ws + WS_LIST)};
            pg8::gemm_phase<EpiScatter, SchedMoE<EHID, EHID, false>, false, EHID, EHID, EHID>(F.lds, S, E);
        }
        SEAM(pb + 6);
        if constexpr (KIND(1)) if (IN(pb + 7)) { PHASE_ENTRY norm1_phase(F, P, lb); }
        SEAM(pb + 7);
        if constexpr (KIND(8)) if (IN(pb + 8)) { PHASE_ENTRY mix_phase(F, P, lp); }
        SEAM(pb + 8);
        if constexpr (KIND(9)) if (IN(pb + 9)) { PHASE_ENTRY
            __syncthreads();
            set_desc(F.lds, 0, ws + WS_XR, ws + WS_WR + (size_t)lp * D * D * 2, ws + WS_R, 4, D, 0);
            set_desc(F.lds, 1, ws + WS_XK, ws + WS_WK + (size_t)lp * D * D * 2, ws + WS_K, 4, D, 0);
            set_desc(F.lds, 2, ws + WS_XV, ws + WS_WV + (size_t)lp * D * D * 2, ws + WS_VV, 4, D, 0);
            set_desc(F.lds, 3, ws + WS_XW, ws + WS_LW1 + (size_t)lp * 256 * D * 2, ws + WS_TW, 1, 256, 1);
            set_desc(F.lds, 4, ws + WS_XA, ws + WS_LA1 + (size_t)lp * 256 * D * 2, ws + WS_TA, 1, 256, 0);
            set_desc(F.lds, 5, ws + WS_XG, ws + WS_LG1 + (size_t)lp * 256 * D * 2, ws + WS_TG, 1, 256, 2);
            __syncthreads();
            SchedMulti<D, D> S{F.lds, T / 256, 15, 6};
            EpiAct E{F.lds};
            pg8::gemm_phase<EpiAct, SchedMulti<D, D>, false, D, D, D>(F.lds, S, E);
        }
        SEAM(pb + 9);
        if constexpr (KIND(10)) if (IN(pb + 10)) { PHASE_ENTRY
            __syncthreads();
            set_desc(F.lds, 0, ws + WS_TW, ws + WS_W2P + ((size_t)lp * 2 + 0) * D * 256 * 2, ws + WS_ELOG0, 4, D, 0, P->in[I_W0] + (size_t)lp * 2 * D, nullptr);
            set_desc(F.lds, 1, ws + WS_TW, ws + WS_W2P + ((size_t)lp * 2 + 1) * D * 256 * 2, ws + WS_ELOG1, 4, D, 1, P->in[I_W0] + (size_t)lp * 2 * D + D, nullptr);
            set_desc(F.lds, 2, ws + WS_TA, ws + WS_A2P + ((size_t)lp * 2 + 0) * D * 256 * 2, ws + WS_KM0, 4, D, 2, P->in[I_A0] + (size_t)lp * 2 * D, ws + WS_AS0);
            set_desc(F.lds, 3, ws + WS_TA, ws + WS_A2P + ((size_t)lp * 2 + 1) * D * 256 * 2, ws + WS_KM1, 4, D, 3, P->in[I_A0] + (size_t)lp * 2 * D + D, ws + WS_AS1);
            set_desc(F.lds, 4, ws + WS_TG, ws + WS_G2P + (size_t)lp * D * 256 * 2, ws + WS_GATE, 4, D, 4);
            set_desc(F.lds, 5, nullptr, nullptr, nullptr, 0, 0, 0, P->in[I_KA] + (size_t)lp * D, ws + WS_K);
            __syncthreads();
            SchedMulti<256, 256> S{F.lds, T / 256, 20, 5};
            EpiLora2 E{F.lds};
            pg8::gemm_phase<EpiLora2, SchedMulti<256, 256>, false, 256, 256, 256>(F.lds, S, E);
        }
        SEAM(pb + 10);
        if constexpr (KIND(11)) if (IN(pb + 11)) { PHASE_ENTRY scan_chunk_phase(F, P, lp); }
        SEAM(pb + 11);
        if constexpr (KIND(14)) if (IN(pb + 12)) { PHASE_ENTRY scan_carry_phase(F, P); }
        SEAM(pb + 12);
        if constexpr (KIND(15)) if (IN(pb + 13)) { PHASE_ENTRY scan_fix_phase(F, P); }
        SEAM(pb + 13);
        if constexpr (KIND(12)) if (IN(pb + 14)) { PHASE_ENTRY rwkv_out_phase(F, P, lp); }
        SEAM(pb + 14);
        if constexpr (KIND(4)) if (IN(pb + 15)) { PHASE_ENTRY
            __syncthreads(); { float* X = (float*)(ws + WS_X);
              set_desc(F.lds, 0, ws + WS_YG, ws + WS_WO + (size_t)lp * D * D * 2, X, 4, 0, 0, X, X + (size_t)TL * D, nullptr);
              set_desc(F.lds, 1, nullptr, nullptr, nullptr, 0, 0, 0, (const float*)(ws + WS_MOD) + (size_t)lb * 3 * 6 * D + 2 * D); }
            __syncthreads();
            SchedMulti<D, D> S{F.lds, T / 256, 4, 1};
            EpiResid E{F.lds};
            pg8::gemm_phase<EpiResid, SchedMulti<D, D>, false, D, D, D>(F.lds, S, E);
        }
        SEAM(pb + 15);
        if constexpr (KIND(5)) if (IN(pb + 16)) { PHASE_ENTRY route_phase(F, P, lb); }
        SEAM(pb + 16);
        if constexpr (KIND(6)) if (IN(pb + 17)) { PHASE_ENTRY
            moe_tables(F.lds, ctl + CW_CNT + lb * 64);
            SchedMoE<D, D, true> S{F.lds, (const char*)(ws + WS_HL), (const char*)(ws + WS_WGU), (const int*)(ws + WS_LIST)};
            EpiSiluGate E{(bf16_t*)(ws + WS_H)};
            pg8::gemm_phase<EpiSiluGate, SchedMoE<D, D, true>, true, D, D, D>(F.lds, S, E);
        }
        SEAM(pb + 17);
        if constexpr (KIND(7)) if (IN(pb + 18)) { PHASE_ENTRY
            moe_tables(F.lds, ctl + CW_CNT + lb * 64);
            SchedMoE<EHID, EHID, false> S{F.lds, (const char*)(ws + WS_H), (const char*)(ws + WS_WD), (const int*)(ws + WS_LIST)};
            EpiScatter E{F.lds, (bf16_t*)(ws + WS_YB), (const int*)(ws + WS_LIST)};
            pg8::gemm_phase<EpiScatter, SchedMoE<EHID, EHID, false>, false, EHID, EHID, EHID>(F.lds, S, E);
        }
        SEAM(pb + 18);
    }
    if constexpr (KIND(13)) if (IN(39)) { PHASE_ENTRY final_phase(F, P); }
#undef IN
#undef KIND
#undef SEAM
#undef PHASE_ENTRY
}

#if !MK_ONE_LAUNCH
static int phase_kind(int ph) { if (ph == 0) return 0; if (ph == 39) return 13; static const int k19[19] = {1, 2, 3, 4, 5, 6, 7, 1, 8, 9, 10, 11, 14, 15, 12, 4, 5, 6, 7}; return k19[(ph - 1) % 19]; }
typedef void (*kern_t)(Params);
template <unsigned KM> static kern_t kern_of() { return mega<KM>; }
static kern_t kind_kernel(int kind) {
    switch (kind) { case 0: return kern_of<1u << 0>(); case 1: return kern_of<1u << 1>(); case 2: return kern_of<1u << 2>(); case 3: return kern_of<1u << 3>(); case 4: return kern_of<1u << 4>();
        case 5: return kern_of<1u << 5>(); case 6: return kern_of<1u << 6>(); case 7: return kern_of<1u << 7>(); case 8: return kern_of<1u << 8>(); case 9: return kern_of<1u << 9>();
        case 10: return kern_of<1u << 10>(); case 11: return kern_of<1u << 11>(); case 12: return kern_of<1u << 12>(); case 14: return kern_of<1u << 14>(); case 15: return kern_of<1u << 15>(); default: return kern_of<1u << 13>(); }
}
#endif
extern "C" void kernel_launch(void* const* d_in, const int* in_sizes, int n_in, void* d_out, int out_size, void* d_ws, size_t ws_size, hipStream_t stream) {
    static int grid = 0;
    if (grid == 0) {
        if (n_in != 42 || out_size != TL * D || ws_size < WS_END) { fprintf(stderr, "kernel_launch: unexpected problem (n_in %d, out %d, ws %zu < %zu)\n", n_in, out_size, ws_size, (size_t)WS_END); grid = -1; return; }
        int dev = 0, cus = 0;
        if (hipGetDevice(&dev) != hipSuccess || hipDeviceGetAttribute(&cus, hipDeviceAttributeMultiprocessorCount, dev) != hipSuccess) { grid = -1; return; }
#if MK_ONE_LAUNCH
        if (hipFuncSetAttribute((const void*)mega<0xffffu>, hipFuncAttributeMaxDynamicSharedMemorySize, LDS_BYTES) != hipSuccess) { fprintf(stderr, "kernel_launch: hipFuncSetAttribute failed\n"); grid = -1; return; }
#else
        for (int k = 0; k < 16; ++k) if (hipFuncSetAttribute((const void*)kind_kernel(k), hipFuncAttributeMaxDynamicSharedMemorySize, LDS_BYTES) != hipSuccess) { fprintf(stderr, "kernel_launch: hipFuncSetAttribute failed\n"); grid = -1; return; }
#endif
        (void)hipGetLastError();
        grid = cus;
    }
    if (grid < 0) return;
    (void)hipMemsetAsync((char*)d_ws + WS_CTL, 0, CTL_BYTES, stream);
    Params p{};
    for (int i = 0; i < 42; ++i) p.in[i] = (const float*)d_in[i];
    p.out = (float*)d_out; p.ws = (unsigned char*)d_ws;
#if MK_ONE_LAUNCH
    p.ph_lo = 0; p.ph_hi = NPH;
    hipLaunchKernelGGL(mega<0xffffu>, dim3(grid), dim3(NTHR), LDS_BYTES, stream, p);
#else
    for (int ph = 0; ph < NPH; ++ph) { p.ph_lo = ph; p.ph_hi = ph + 1; hipLaunchKernelGGL(kind_kernel(phase_kind(ph)), dim3(grid), dim3(NTHR), LDS_BYTES, stream, p); }
#endif
}
```

```cpp
#include <hip/hip_runtime.h>
#include <cstdio>
#include <cstdint>

#define LAS __attribute__((address_space(3)))
typedef unsigned short bf16_t;
typedef short bf16x8 __attribute__((ext_vector_type(8)));
typedef float f32x4 __attribute__((ext_vector_type(4)));
typedef float f32x2 __attribute__((ext_vector_type(2)));
typedef unsigned u32x4 __attribute__((ext_vector_type(4)));
typedef unsigned u32x2 __attribute__((ext_vector_type(2)));

#ifndef AMP_MASK
#define AMP_MASK 0u
#endif
#define AMP_F 4
#ifndef MK_ONE_LAUNCH
#define MK_ONE_LAUNCH 1
#endif

constexpr int D = 1024, NBATCH = 2, SEQ = 16384, CTXL = 256, DEPTH = 4;
constexpr int TL = NBATCH * SEQ, TC = NBATCH * CTXL, T = TL + TC;
constexpr int GWID = 2048, NE = 32, EHID = 512, NH = 16, HD = 64;
constexpr int LISTCAP = T;
constexpr int MAXRT = (2 * T) / 256 + NE;
constexpr int NWAVES = 8, NTHR = 512;

constexpr size_t MiB = 1u << 20;
constexpr size_t WS_CTL = 0, CTL_BYTES = 1 * MiB;
constexpr size_t WS_MOD = 1 * MiB;
constexpr size_t WS_WIN = 2 * MiB, WS_WOUT = 18 * MiB, WS_WSP = 26 * MiB, WS_WR = 27 * MiB, WS_WK = 31 * MiB, WS_WV = 35 * MiB, WS_WO = 39 * MiB;
constexpr size_t WS_LW1 = 43 * MiB, WS_LA1 = 44 * MiB, WS_LG1 = 45 * MiB, WS_W2P = 46 * MiB, WS_A2P = 48 * MiB, WS_G2P = 50 * MiB;
constexpr size_t WS_WRT = 52 * MiB;
constexpr size_t WS_WGU = 54 * MiB, WS_WD = 118 * MiB;
constexpr size_t WS_X = 150 * MiB;
constexpr size_t WS_LIST = 280 * MiB, WS_WGT = 285 * MiB;
constexpr size_t WS_HL = 286 * MiB;
constexpr size_t WS_BIG = 351 * MiB;
constexpr size_t SZB = 65 * MiB;
constexpr size_t WS_U = WS_BIG, WS_V = WS_BIG + 2 * SZB, WS_STAT = WS_BIG + 4 * SZB;
constexpr size_t WS_XR = WS_BIG, WS_XW = WS_BIG + SZB, WS_XK = WS_BIG + 2 * SZB, WS_XV = WS_BIG + 3 * SZB, WS_XA = WS_BIG + 4 * SZB, WS_XG = WS_BIG + 5 * SZB;
constexpr size_t WS_R = WS_BIG + 6 * SZB, WS_K = WS_BIG + 7 * SZB, WS_VV = WS_BIG + 8 * SZB;
constexpr size_t WS_TW = WS_BIG + 9 * SZB, WS_TA = WS_TW + 17 * MiB, WS_TG = WS_TA + 17 * MiB;
constexpr size_t WS_ELOG0 = WS_XR, WS_ELOG1 = WS_XW, WS_KM0 = WS_XK, WS_KM1 = WS_XV, WS_AS0 = WS_XA, WS_AS1 = WS_XG;
constexpr size_t WS_GATE = WS_HL, WS_YG = WS_AS0;
constexpr size_t WS_H = WS_BIG, WS_YB = WS_BIG + 73 * MiB, WS_LG = WS_BIG + 204 * MiB;
constexpr size_t WS_PQ = WS_TW;
constexpr size_t WS_SST = WS_WGU;
constexpr size_t WS_END = WS_PQ + 131 * MiB;
static_assert(WS_END <= 1080 * MiB, "workspace map");
constexpr int CW_BAR = 4096;
constexpr int CW_CNT = 16384;

typedef __bf16 bf16x2_t __attribute__((ext_vector_type(2)));
__device__ __forceinline__ unsigned cvt_pk_bf16(float lo, float hi) { const bf16x2_t v = __builtin_convertvector((f32x2){lo, hi}, bf16x2_t); return __builtin_bit_cast(unsigned, v); }
__device__ __forceinline__ float bf_lo(unsigned u) { return __uint_as_float(u << 16); }
__device__ __forceinline__ float bf_hi(unsigned u) { return __uint_as_float(u & 0xffff0000u); }
__device__ __forceinline__ float bf1(bf16_t b) { return __uint_as_float(((unsigned)b) << 16); }
__device__ __forceinline__ bf16_t f2bf(float f) { return (bf16_t)(cvt_pk_bf16(f, 0.f) & 0x3ffffu); }
__device__ __forceinline__ void unpack8(const u32x4& w, float (&f)[8]) { f[0] = bf_lo(w.x); f[1] = bf_hi(w.x); f[2] = bf_lo(w.y); f[3] = bf_hi(w.y); f[4] = bf_lo(w.z); f[5] = bf_hi(w.z); f[6] = bf_lo(w.w); f[7] = bf_hi(w.w); }
__device__ __forceinline__ u32x4 pack8(const float (&f)[8]) { u32x4 o; o.x = cvt_pk_bf16(f[0], f[1]); o.y = cvt_pk_bf16(f[2], f[3]); o.z = cvt_pk_bf16(f[4], f[5]); o.w = cvt_pk_bf16(f[6], f[7]); return o; }
__device__ __forceinline__ float wave_sum(float v) {
#pragma unroll
    for (int o = 1; o < 64; o <<= 1) v += __shfl_xor(v, o);
    return v;
}
__device__ __forceinline__ float sigmoidf_(float x) { return 1.0f / (1.0f + __expf(-x)); }
__device__ __forceinline__ float tanhf_(float x) { const float e = __expf(2.0f * x); return 1.0f - 2.0f / (e + 1.0f); }
__device__ __forceinline__ f32x2 gelu_pk(f32x2 v) {
    const f32x2 av = __builtin_elementwise_abs(v), d = av * 0.2316418882f + 1.0f;
    f32x2 t; t.x = __builtin_amdgcn_rcpf(d.x); t.y = __builtin_amdgcn_rcpf(d.y);
    f32x2 q = t * 0.5307027145f + (-0.7265760135f); q = q * t + 0.7107068705f; q = q * t + (-0.142248368f); q = q * t + 0.127414796f; q = q * t;
    const f32x2 s = (v * v) * (-0.72134752044f);
    f32x2 e; e.x = __builtin_amdgcn_exp2f(s.x); e.y = __builtin_amdgcn_exp2f(s.y);
    const f32x2 m = v * (q * e), r = v - m;
    f32x2 o; o.x = v.x < 0.f ? m.x : r.x; o.y = v.y < 0.f ? m.y : r.y; return o;
}

#define XB_TMO      128
#define XB_XCNT(j)  (256  + 64 * (j))
#define XB_XSUB(j)  (1280 + 64 * (j))
#define XB_XGEN(j)  (2304 + 64 * (j))
#define XB_TOP      3328
#define XB_TOPGEN   3392
#define XCD_BAR_WORDS 3456
#define XB_SPIN_CAP (1u << 18)
__device__ __forceinline__ unsigned xb_ld(unsigned* p)              { return __hip_atomic_load(p, __ATOMIC_RELAXED, __HIP_MEMORY_SCOPE_AGENT); }
__device__ __forceinline__ unsigned xb_add(unsigned* p, unsigned v) { return __hip_atomic_fetch_add(p, v, __ATOMIC_RELAXED, __HIP_MEMORY_SCOPE_AGENT); }
__device__ __forceinline__ unsigned xb_xcc_id() { return (unsigned)__builtin_amdgcn_s_getreg((3 << 11) | 20) & 0xFu; }
#define XB_SPIN(cond, bar) do { unsigned _sp = 0; while (cond) { __builtin_amdgcn_s_sleep(1); \
    if ((++_sp & 255u) == 0u) { if (xb_ld(&(bar)[XB_TMO])) break; if (_sp > XB_SPIN_CAP) { atomicAdd(&(bar)[XB_TMO], 1u); break; } } } } while (0)
struct XcdBarrier { unsigned* bar; unsigned x; volatile LAS unsigned* st; };
__device__ __forceinline__ XcdBarrier xcd_barrier_post(unsigned* bar, volatile LAS unsigned* st) {
    XcdBarrier b; b.bar = bar; b.x = xb_xcc_id(); b.st = st;
    if (threadIdx.x == 0) (void)xb_add(&bar[XB_XCNT(b.x)], 1u);
    return b;
}
__device__ __forceinline__ void xcd_barrier_complete(unsigned* bar, unsigned x, unsigned& nloc, unsigned& nx) {
    const unsigned G = gridDim.x * gridDim.y * gridDim.z;
    unsigned sum, cnt, mine, sp = 0u;
    for (;;) {
        sum = 0u; cnt = 0u; mine = 0u;
#pragma unroll
        for (unsigned j = 0; j < 16; ++j) { const unsigned c = xb_ld(&bar[XB_XCNT(j)]); sum += c; cnt += (c > 0u) ? 1u : 0u; mine = (j == x) ? c : mine; }
        if (sum == G) break;
        __builtin_amdgcn_s_sleep(1);
        if ((++sp & 255u) == 0u) { if (xb_ld(&bar[XB_TMO])) break; if (sp > XB_SPIN_CAP) { atomicAdd(&bar[XB_TMO], 1u); break; } }
    }
    nloc = mine > 0u ? mine : 1u; nx = cnt > 0u ? cnt : 1u;
}
__device__ __forceinline__ void xcd_barrier(const XcdBarrier& b) {
    asm volatile("s_waitcnt vmcnt(0)" ::: "memory");
    __syncthreads();
    if (threadIdx.x == 0) {
        unsigned* bar = b.bar;
        __builtin_amdgcn_s_waitcnt(0);
        unsigned nloc = b.st[0], nx = b.st[1];
        if (nloc == 0u) { xcd_barrier_complete(bar, b.x, nloc, nx); b.st[0] = nloc; b.st[1] = nx; }
        const unsigned old = xb_add(&bar[XB_XSUB(b.x)], 1u);
        const unsigned gen = old / nloc;
        if (old + 1u == (gen + 1u) * nloc) {
            __builtin_amdgcn_fence(__ATOMIC_RELEASE, "agent");
            asm volatile("s_waitcnt vmcnt(0)" ::: "memory");
            const unsigned og = xb_add(&bar[XB_TOP], 1u);
            const unsigned tg = og / nx;
            if (og + 1u == (tg + 1u) * nx) xb_add(&bar[XB_TOPGEN], 1u);
            else XB_SPIN(xb_ld(&bar[XB_TOPGEN]) == tg, bar);
            __builtin_amdgcn_fence(__ATOMIC_ACQUIRE, "agent");
            xb_add(&bar[XB_XGEN(b.x)], 1u);
            asm volatile("s_waitcnt vmcnt(0)" ::: "memory");
        } else {
            XB_SPIN(xb_ld(&bar[XB_XGEN(b.x)]) == gen, bar);
            __builtin_amdgcn_fence(__ATOMIC_ACQUIRE, "agent");
            asm volatile("s_waitcnt vmcnt(0)" ::: "memory");
        }
    }
    __syncthreads();
}

constexpr int LDS_MISC = 143360;
constexpr int LDS_DESC = LDS_MISC + 128;
constexpr int LDS_TAB = LDS_MISC + 512;
constexpr int LDS_BYTES = 147456;
namespace pg8 {
constexpr int BM = 256, BK = 64, HALF = 128, HTB = HALF * BK * 2, STAGE_BYTES = 8 * HTB, NXCD = 8, WGM = 8;
__host__ __device__ __forceinline__ int lds_byte(int r, int c) { const int st = (r >> 4) * 2 + (c >> 5), rr = r & 15, cc = c & 31, ob = rr * 64 + cc * 2; return st * 1024 + (ob ^ (((ob >> 9) & 1) << 5)); }
__host__ __device__ __forceinline__ void stage_rc(int b, int& R, int& C) { const int st = b / 1024, sb = b % 1024, swz = sb ^ (((sb >> 9) & 1) << 5); R = (st >> 1) * 16 + swz / 64; C = (st & 1) * 32 + (swz % 64) / 2; }
__host__ __device__ __forceinline__ int perm32(int rho) { const int n = rho >> 4, i = rho & 15; return 8 * (i >> 2) + 4 * n + (i & 3); }
__device__ __forceinline__ int xcd_remap(int L, int nwg) { const int q = nwg / NXCD, r = nwg % NXCD, xcd = L % NXCD, off = L / NXCD; return (xcd < r ? xcd * (q + 1) : r * (q + 1) + (xcd - r) * q) + off; }

struct Unit { int pm, pn, aux; };

template <class Epi, class Sched, bool GATHER, int K, int LDA, int LDB>
__device__ __forceinline__ void gemm_phase(LAS unsigned char* lds, const Sched& S, const Epi& E) {
    int tid_ = threadIdx.x; asm volatile("" : "+v"(tid_));
    const int tid = tid_, wid = __builtin_amdgcn_readfirstlane(tid >> 6), lane = tid & 63, wr = wid >> 2, wc = wid & 3, fr = lane & 15, fq = lane >> 4;
    constexpr int nt = K / BK;
    unsigned voffA[2], voffB[2];
#pragma unroll
    for (int i = 0; i < 2; ++i) { int R, C; stage_rc(tid * 16 + i * 8192, R, C); const int Rb = Epi::PERM ? ((R & ~31) + perm32(R & 31)) : R;
        voffA[i] = (unsigned)(R * LDA + C) * 2u; voffB[i] = (unsigned)(Rb * LDB + C) * 2u; }
    constexpr size_t kstep = (size_t)(BK * 2);
    constexpr size_t hstepA = GATHER ? (size_t)0 : (size_t)HALF * LDA * 2, hstepB = (size_t)HALF * LDB * 2;
    const unsigned ldsw = (unsigned)wid * 1024u;
    const int aoff = lds_byte(wr * 64 + fr, fq * 8), boff = lds_byte(wc * 32 + fr, fq * 8);
    unsigned gA[2][2], gN[2][2];
#define PG8_SA(b, h) (((b) * 2 + (h)) * HTB)
#define PG8_SB(b, h) ((4 + (b) * 2 + (h)) * HTB)
#define PG8_STAGEB(bufoff, gbase) do { _Pragma("unroll") for (int _i = 0; _i < 2; ++_i) \
        __builtin_amdgcn_global_load_lds((const unsigned*)((const char*)(gbase) + voffB[_i]), (LAS unsigned*)(lds + (bufoff) + ldsw + _i * 8192), 16, 0, 0); } while (0)
#define PG8_STAGEA(bufoff, gbase, h, GV) do { _Pragma("unroll") for (int _i = 0; _i < 2; ++_i) \
        __builtin_amdgcn_global_load_lds((const unsigned*)((const char*)(gbase) + (GATHER ? GV[h][_i] : voffA[_i]) + (h) * hstepA), (LAS unsigned*)(lds + (bufoff) + ldsw + _i * 8192), 16, 0, 0); } while (0)
#define PG8_LDA(dst, b, h) do { _Pragma("unroll") for (int m = 0; m < 4; ++m) _Pragma("unroll") for (int k = 0; k < 2; ++k) dst[m][k] = *(const LAS bf16x8*)(lds + PG8_SA(b, h) + aoff + m * 2048 + k * 1024); } while (0)
#define PG8_LDB(dst, b, h) do { _Pragma("unroll") for (int n = 0; n < 2; ++n) _Pragma("unroll") for (int k = 0; k < 2; ++k) dst[n][k] = *(const LAS bf16x8*)(lds + PG8_SB(b, h) + boff + n * 2048 + k * 1024); } while (0)
#define PG8_MMA(ai, bj, At, Bt) do { __builtin_amdgcn_s_setprio(1); _Pragma("unroll") for (int m = 0; m < 4; ++m) _Pragma("unroll") for (int n = 0; n < 2; ++n) _Pragma("unroll") for (int k = 0; k < 2; ++k) \
        acc[ai][bj][m][n] = __builtin_amdgcn_mfma_f32_16x16x32_bf16(Bt[n][k], At[m][k], acc[ai][bj][m][n], 0, 0, 0); __builtin_amdgcn_s_setprio(0); } while (0)
#define PG8_WAIT_V(n) asm volatile("s_waitcnt vmcnt(" #n ")" ::: "memory")
#define PG8_WAIT_L(n) asm volatile("s_waitcnt lgkmcnt(" #n ")" ::: "memory")
#define PG8_BAR __builtin_amdgcn_s_barrier()
#define PG8_SCHED __builtin_amdgcn_sched_barrier(0)
    Unit cur, nxt; int ui = 0;
    if (!S.next(0, cur)) return;
    f32x4 acc[2][2][4][2];
#pragma unroll
    for (int a = 0; a < 2; ++a)
#pragma unroll
        for (int b = 0; b < 2; ++b)
#pragma unroll
            for (int m = 0; m < 4; ++m)
#pragma unroll
                for (int n = 0; n < 2; ++n) acc[a][b][m][n] = (f32x4){0.f, 0.f, 0.f, 0.f};
    bf16x8 At[4][2], B0[2][2], B1[2][2];
    const char* cA = S.aptr(cur); const char* cB = S.bptr(cur);
    if constexpr (GATHER) { S.gather(cur, tid, gA); }
    PG8_STAGEB(PG8_SB(0, 0), cB); PG8_STAGEB(PG8_SB(0, 1), cB + hstepB); PG8_STAGEA(PG8_SA(0, 0), cA, 0, gA); PG8_STAGEA(PG8_SA(0, 1), cA, 1, gA);
    if (wr == 1) PG8_BAR;
    PG8_WAIT_V(2); PG8_BAR;
    PG8_STAGEB(PG8_SB(1, 0), cB + kstep); PG8_STAGEA(PG8_SA(1, 0), cA + kstep, 0, gA); PG8_STAGEB(PG8_SB(1, 1), cB + hstepB + kstep);
    PG8_WAIT_V(6); PG8_BAR;
    for (;;) {
        const bool has_next = S.next(ui + 1, nxt);
        const char* nA = has_next ? S.aptr(nxt) : cA; const char* nB = has_next ? S.bptr(nxt) : cB;
        if constexpr (GATHER) { if (has_next) S.gather(nxt, tid, gN); else {
#pragma unroll
            for (int h = 0; h < 2; ++h)
#pragma unroll
                for (int i = 0; i < 2; ++i) gN[h][i] = gA[h][i]; } }
#pragma nounroll
        for (int t = 0; t < nt; t += 2) {
            const bool last = (t == nt - 2);
            const char* a1 = cA + (size_t)(t + 1) * kstep;
            const char* a2 = last ? nA : cA + (size_t)(t + 2) * kstep; const char* b2 = last ? nB : cB + (size_t)(t + 2) * kstep;
            const char* a3 = a2 + kstep; const char* b3 = b2 + kstep;
            unsigned g2[2][2];
            if constexpr (GATHER) {
#pragma unroll
                for (int h = 0; h < 2; ++h)
#pragma unroll
                    for (int i = 0; i < 2; ++i) g2[h][i] = last ? gN[h][i] : gA[h][i]; }
            PG8_LDB(B0, 0, 0); PG8_LDB(B1, 0, 1); PG8_SCHED; PG8_LDA(At, 0, 0); PG8_STAGEA(PG8_SA(1, 1), a1, 1, gA);
            PG8_WAIT_V(8); PG8_WAIT_L(0); PG8_BAR; PG8_MMA(0, 0, At, B0); PG8_MMA(0, 1, At, B1); PG8_BAR; PG8_SCHED;
            PG8_LDA(At, 0, 1); PG8_STAGEB(PG8_SB(0, 0), b2); PG8_STAGEB(PG8_SB(0, 1), b2 + hstepB); PG8_STAGEA(PG8_SA(0, 0), a2, 0, g2);
            PG8_WAIT_V(8); PG8_WAIT_L(0); PG8_BAR; PG8_MMA(1, 0, At, B0); PG8_MMA(1, 1, At, B1); PG8_BAR; PG8_SCHED;
            PG8_LDB(B0, 1, 0); PG8_LDB(B1, 1, 1); PG8_SCHED; PG8_LDA(At, 1, 0); PG8_STAGEA(PG8_SA(0, 1), a2, 1, g2);
            PG8_WAIT_V(8); PG8_WAIT_L(0); PG8_BAR; PG8_MMA(0, 0, At, B0); PG8_MMA(0, 1, At, B1); PG8_BAR; PG8_SCHED;
            PG8_LDA(At, 1, 1); PG8_STAGEB(PG8_SB(1, 0), b3); PG8_STAGEB(PG8_SB(1, 1), b3 + hstepB); PG8_STAGEA(PG8_SA(1, 0), a3, 0, g2);
            PG8_WAIT_V(8); PG8_WAIT_L(0); PG8_BAR; PG8_MMA(1, 0, At, B0); PG8_MMA(1, 1, At, B1); PG8_BAR; PG8_SCHED;
        }
        if (wr == 0) PG8_BAR;
        E(acc, cur, wr, wc, fr, fq);
        if (!has_next) break;
#pragma unroll
        for (int a = 0; a < 2; ++a)
#pragma unroll
            for (int b = 0; b < 2; ++b)
#pragma unroll
                for (int m = 0; m < 4; ++m)
#pragma unroll
                    for (int n = 0; n < 2; ++n) acc[a][b][m][n] = (f32x4){0.f, 0.f, 0.f, 0.f};
        cur = nxt; cA = nA; cB = nB; ++ui;
        if constexpr (GATHER) {
#pragma unroll
            for (int h = 0; h < 2; ++h)
#pragma unroll
                for (int i = 0; i < 2; ++i) gA[h][i] = gN[h][i]; }
        if (wr == 1) PG8_BAR;
    }
    PG8_WAIT_V(0);
    PG8_BAR;
#undef PG8_SA
#undef PG8_SB
#undef PG8_STAGEA
#undef PG8_STAGEB
#undef PG8_LDA
#undef PG8_LDB
#undef PG8_MMA
#undef PG8_WAIT_V
#undef PG8_WAIT_L
#undef PG8_BAR
#undef PG8_SCHED
}
}
using pg8::Unit;

__device__ __forceinline__ void set_desc(LAS unsigned char* lds, int g, const void* A, const void* B, const void* C, int nN, int ldc, int aux, const void* X1 = nullptr, const void* X2 = nullptr, const void* X3 = nullptr) {
    LAS int* d = (LAS int*)(lds + LDS_DESC) + g * 16;
    if (threadIdx.x == 0) { unsigned long long a = (unsigned long long)A, b = (unsigned long long)B, c = (unsigned long long)C, x1 = (unsigned long long)X1, x2 = (unsigned long long)X2, x3 = (unsigned long long)X3;
        asm volatile("" : "+s"(a), "+s"(b), "+s"(c), "+s"(x1), "+s"(x2), "+s"(x3), "+s"(nN), "+s"(ldc), "+s"(aux));
        d[0] = (int)(unsigned)a; d[1] = (int)(unsigned)(a >> 32); d[2] = (int)(unsigned)b; d[3] = (int)(unsigned)(b >> 32); d[4] = (int)(unsigned)c; d[5] = (int)(unsigned)(c >> 32); d[6] = nN; d[7] = ldc; d[8] = aux;
        d[10] = (int)(unsigned)x1; d[11] = (int)(unsigned)(x1 >> 32); d[12] = (int)(unsigned)x2; d[13] = (int)(unsigned)(x2 >> 32); d[14] = (int)(unsigned)x3; d[15] = (int)(unsigned)(x3 >> 32); }
}
__device__ __forceinline__ int desc_i(LAS unsigned char* lds, int g, int f) { return __builtin_amdgcn_readfirstlane(((LAS const int*)(lds + LDS_DESC))[g * 16 + f]); }
__device__ __forceinline__ const char* desc_p(LAS unsigned char* lds, int g, int f) {
    const unsigned lo = (unsigned)desc_i(lds, g, f), hi = (unsigned)desc_i(lds, g, f + 1); return (const char*)(((unsigned long long)hi << 32) | lo); }
template <int LDA, int LDB>
struct SchedMulti {
    LAS unsigned char* lds; int nM, ntot, ng;
    __device__ __forceinline__ bool next(int i, Unit& u) const {
        const int nwg = nM * ntot; const long L = (long)i * gridDim.x + blockIdx.x; if (L >= nwg) return false;
        const int wgid = pg8::xcd_remap((int)L, nwg);
        const int nig = pg8::WGM * ntot, gid = wgid / nig, fm = gid * pg8::WGM, gsz = (nM - fm) < pg8::WGM ? (nM - fm) : pg8::WGM;
        u.pm = fm + ((wgid % nig) % gsz); int pv = (wgid % nig) / gsz; int g = 0;
        for (int j = 0; j + 1 < ng; ++j) { const int n = desc_i(lds, j, 6); if (pv < n) break; pv -= n; g = j + 1; }
        u.pn = pv; u.aux = g; return true;
    }
    __device__ __forceinline__ const char* aptr(const Unit& u) const { return desc_p(lds, u.aux, 0) + (size_t)u.pm * (512 * LDA); }
    __device__ __forceinline__ const char* bptr(const Unit& u) const { return desc_p(lds, u.aux, 2) + (size_t)u.pn * (512 * LDB); }
};
template <int LDA, int LDB, bool GATHERED>
struct SchedMoE {
    LAS unsigned char* lds; const char* Abase; const char* Bbase; const int* list;
    __device__ __forceinline__ bool next(int i, Unit& u) const {
        LAS const int* tab = (LAS const int*)(lds + LDS_TAB);
        const int nrt = __builtin_amdgcn_readfirstlane(tab[2 * MAXRT + 32]);
        const int nwg = nrt * 4; const long L = (long)i * gridDim.x + blockIdx.x; if (L >= nwg) return false;
        const int wgid = pg8::xcd_remap((int)L, nwg);
        u.pm = wgid >> 2; u.pn = wgid & 3; u.aux = __builtin_amdgcn_readfirstlane(tab[u.pm]); return true;
    }
    __device__ __forceinline__ const char* aptr(const Unit& u) const { return GATHERED ? Abase : Abase + (size_t)u.pm * (512 * LDA); }
    __device__ __forceinline__ const char* bptr(const Unit& u) const { return Bbase + (size_t)u.aux * ((size_t)D * LDB * 2) + (size_t)u.pn * (512 * LDB); }
    __device__ __forceinline__ void gather(const Unit& u, int tid, unsigned (&g)[2][2]) const {
        LAS const int* tab = (LAS const int*)(lds + LDS_TAB);
        const int j0 = __builtin_amdgcn_readfirstlane(tab[MAXRT + u.pm]), cn = __builtin_amdgcn_readfirstlane(tab[2 * MAXRT + u.aux]);
#pragma unroll
        for (int i = 0; i < 2; ++i) { int R, C; pg8::stage_rc(tid * 16 + i * 8192, R, C);
#pragma unroll
            for (int h = 0; h < 2; ++h) { const int slot = j0 + 128 * h + R; const int a = slot < cn ? list[(size_t)u.aux * LISTCAP + slot] : 0;
                g[h][i] = (unsigned)((a >> 1) * LDA + C) * 2u; } }
    }
};
__device__ __forceinline__ void moe_tables(LAS unsigned char* lds, const unsigned* cnt) {
    LAS int* tab = (LAS int*)(lds + LDS_TAB);
    __syncthreads();
    if (threadIdx.x == 0) {
        int rt = 0;
#pragma nounroll
        for (int e = 0; e < NE; ++e) { const int c = (int)__hip_atomic_load(cnt + e, __ATOMIC_RELAXED, __HIP_MEMORY_SCOPE_AGENT); tab[2 * MAXRT + e] = c;
            const int nt = (c + 255) >> 8;
#pragma nounroll
            for (int j = 0; j < nt; ++j) { tab[rt] = e; tab[MAXRT + rt] = j * 256; ++rt; } }
        tab[2 * MAXRT + 32] = rt;
    }
    __syncthreads();
}

#define EPI_FENCE() asm volatile("" ::: "memory")
struct EpiGelu {
    static constexpr bool PERM = true;
    LAS unsigned char* lds;
    __device__ __forceinline__ void operator()(const f32x4 (&acc)[2][2][4][2], const Unit& u, int wr, int wc, int fr, int fq) const {
        const bool isv = u.pn >= 8; bf16_t* base = (bf16_t*)desc_p(lds, 0, isv ? 10 : 4); const float* bias = (const float*)desc_p(lds, 0, 12); float* stat = (float*)desc_p(lds, 0, 14);
        const int col0 = (u.pn & 7) * 256 + wc * 32 + 8 * fq, bcol0 = u.pn * 256 + wc * 32 + 8 * fq, row0 = u.pm * 256 + wr * 64 + fr;
        f32x4 bv[2][2];
#pragma unroll
        for (int bj = 0; bj < 2; ++bj)
#pragma unroll
            for (int n = 0; n < 2; ++n) bv[bj][n] = *(const f32x4*)(bias + bcol0 + bj * 128 + 4 * n);
#pragma unroll
        for (int ai = 0; ai < 2; ++ai)
#pragma unroll
            for (int m = 0; m < 4; ++m) { const int row = row0 + ai * 128 + m * 16; bf16_t* rowp = base + (size_t)row * GWID + col0; float s = 0.f, q = 0.f;
#pragma unroll
                for (int bj = 0; bj < 2; ++bj) { const f32x4 v0 = acc[ai][bj][m][0] + bv[bj][0], v1 = acc[ai][bj][m][1] + bv[bj][1];
                    const f32x2 a = gelu_pk((f32x2){v0[0], v0[1]}), b = gelu_pk((f32x2){v0[2], v0[3]}), c = gelu_pk((f32x2){v1[0], v1[1]}), d = gelu_pk((f32x2){v1[2], v1[3]});
                    s += ((a.x + a.y) + (b.x + b.y)) + ((c.x + c.y) + (d.x + d.y));
                    q += ((a.x * a.x + a.y * a.y) + (b.x * b.x + b.y * b.y)) + ((c.x * c.x + c.y * c.y) + (d.x * d.x + d.y * d.y));
                    u32x4 w; w.x = cvt_pk_bf16(a.x, a.y); w.y = cvt_pk_bf16(b.x, b.y); w.z = cvt_pk_bf16(c.x, c.y); w.w = cvt_pk_bf16(d.x, d.y);
                    *(u32x4*)(rowp + bj * 128) = w; }
                if (isv) { s += __shfl_xor(s, 16); s += __shfl_xor(s, 32); q += __shfl_xor(q, 16); q += __shfl_xor(q, 32);
                    if (fq == 0) *(f32x2*)(stat + ((size_t)row * 32 + (u.pn - 8) * 4 + wc) * 2) = (f32x2){s, q}; } }
    }
};
struct EpiResid {
    static constexpr bool PERM = false;
    LAS unsigned char* lds;
    __device__ __forceinline__ void operator()(const f32x4 (&acc)[2][2][4][2], const Unit& u, int wr, int wc, int fr, int fq) const {
        const int mrow = u.pm < 64 ? 0 : (u.pm < 128 ? 1 : 2);
        const float* xin = u.pm < 128 ? (const float*)desc_p(lds, 0, 10) + (size_t)u.pm * 256 * D : (const float*)desc_p(lds, 0, 12) + (size_t)(u.pm - 128) * 256 * D;
        float* xout = (float*)desc_p(lds, 0, 4) + (size_t)u.pm * 256 * D; const float* bias = (const float*)desc_p(lds, 0, 14); const float* gate = (const float*)desc_p(lds, 1, 10);
        const int col0 = u.pn * 256 + wc * 32 + 4 * fq, rl0 = wr * 64 + fr;
#pragma unroll
        for (int bj = 0; bj < 2; ++bj)
#pragma unroll
            for (int n = 0; n < 2; ++n) { const f32x4 bv = bias ? *(const f32x4*)(bias + col0 + bj * 128 + n * 16) : (f32x4){0.f, 0.f, 0.f, 0.f};
                const f32x4 gv = *(const f32x4*)(gate + mrow * 6 * D + col0 + bj * 128 + n * 16);
#pragma unroll
                for (int ai = 0; ai < 2; ++ai) {
#pragma unroll
                    for (int m = 0; m < 4; ++m) { const size_t off = (size_t)(rl0 + ai * 128 + m * 16) * D + col0 + bj * 128 + n * 16;
                        const f32x4 xi = *(const f32x4*)(xin + off); *(f32x4*)(xout + off) = xi + gv * (acc[ai][bj][m][n] + bv); }
                    EPI_FENCE(); } }
    }
};
struct EpiAct {
    static constexpr bool PERM = true;
    LAS unsigned char* lds;
    __device__ __forceinline__ void operator()(const f32x4 (&acc)[2][2][4][2], const Unit& u, int wr, int wc, int fr, int fq) const {
        bf16_t* C = (bf16_t*)desc_p(lds, u.aux, 4); const int ldc = desc_i(lds, u.aux, 7), act = desc_i(lds, u.aux, 8);
        const int col0 = u.pn * 256 + wc * 32 + 8 * fq, row0 = u.pm * 256 + wr * 64 + fr;
#pragma unroll
        for (int ai = 0; ai < 2; ++ai)
#pragma unroll
            for (int m = 0; m < 4; ++m) { bf16_t* rowp = C + (size_t)(row0 + ai * 128 + m * 16) * ldc + col0;
#pragma unroll
                for (int bj = 0; bj < 2; ++bj) { f32x4 v0 = acc[ai][bj][m][0], v1 = acc[ai][bj][m][1];
                    if (act == 1) {
#pragma unroll
                        for (int j = 0; j < 4; ++j) { v0[j] = tanhf_(v0[j]); v1[j] = tanhf_(v1[j]); } }
                    else if (act == 2) {
#pragma unroll
                        for (int j = 0; j < 4; ++j) { v0[j] = sigmoidf_(v0[j]); v1[j] = sigmoidf_(v1[j]); } }
                    u32x4 w; w.x = cvt_pk_bf16(v0[0], v0[1]); w.y = cvt_pk_bf16(v0[2], v0[3]); w.z = cvt_pk_bf16(v1[0], v1[1]); w.w = cvt_pk_bf16(v1[2], v1[3]);
                    *(u32x4*)(rowp + bj * 128) = w; } }
    }
};
struct EpiLora2 {
    static constexpr bool PERM = true;
    LAS unsigned char* lds;
    __device__ __forceinline__ void operator()(const f32x4 (&acc)[2][2][4][2], const Unit& u, int wr, int wc, int fr, int fq) const {
        bf16_t* C = (bf16_t*)desc_p(lds, u.aux, 4);
        const int col0 = u.pn * 256 + wc * 32 + 8 * fq, row0 = u.pm * 256 + wr * 64 + fr;
        const float* pv = u.aux < 4 ? (const float*)desc_p(lds, u.aux, 10) : (const float*)desc_p(lds, 5, 10); bf16_t* C2 = (bf16_t*)desc_p(lds, u.aux, 12);
        const float* k_a = (const float*)desc_p(lds, 5, 10); const bf16_t* Kb = (const bf16_t*)desc_p(lds, 5, 12);
#pragma unroll
        for (int bj = 0; bj < 2; ++bj) { const f32x4 p0 = *(const f32x4*)(pv + col0 + bj * 128), p1 = *(const f32x4*)(pv + col0 + bj * 128 + 4);
            const f32x4 ka0 = *(const f32x4*)(k_a + col0 + bj * 128), ka1 = *(const f32x4*)(k_a + col0 + bj * 128 + 4);
#pragma unroll
            for (int ai = 0; ai < 2; ++ai)
#pragma unroll
                for (int m = 0; m < 4; ++m) { const size_t ro = (size_t)(row0 + ai * 128 + m * 16) * D + col0 + bj * 128;
                    f32x4 v0 = acc[ai][bj][m][0], v1 = acc[ai][bj][m][1];
                    if (u.aux < 2) {
#pragma unroll
                        for (int j = 0; j < 4; ++j) { const float x0 = -(p0[j] + v0[j]), x1 = -(p1[j] + v1[j]);
                            const float s0 = fmaxf(x0, 0.f) + __logf(1.0f + __expf(-fabsf(x0))), s1 = fmaxf(x1, 0.f) + __logf(1.0f + __expf(-fabsf(x1)));
                            v0[j] = -__expf(-s0 - 0.5f); v1[j] = -__expf(-s1 - 0.5f); }
                    } else if (u.aux < 4) {
                        const u32x4 kw = *(const u32x4*)(Kb + ro); f32x4 a0v, a1v;
#pragma unroll
                        for (int j = 0; j < 4; ++j) { a0v[j] = sigmoidf_(p0[j] + v0[j]); a1v[j] = sigmoidf_(p1[j] + v1[j]); }
                        v0[0] = bf_lo(kw.x) * (1.0f + (a0v[0] - 1.0f) * ka0[0]); v0[1] = bf_hi(kw.x) * (1.0f + (a0v[1] - 1.0f) * ka0[1]);
                        v0[2] = bf_lo(kw.y) * (1.0f + (a0v[2] - 1.0f) * ka0[2]); v0[3] = bf_hi(kw.y) * (1.0f + (a0v[3] - 1.0f) * ka0[3]);
                        v1[0] = bf_lo(kw.z) * (1.0f + (a1v[0] - 1.0f) * ka1[0]); v1[1] = bf_hi(kw.z) * (1.0f + (a1v[1] - 1.0f) * ka1[1]);
                        v1[2] = bf_lo(kw.w) * (1.0f + (a1v[2] - 1.0f) * ka1[2]); v1[3] = bf_hi(kw.w) * (1.0f + (a1v[3] - 1.0f) * ka1[3]);
                        u32x4 w2; w2.x = cvt_pk_bf16(a0v[0], a0v[1]); w2.y = cvt_pk_bf16(a0v[2], a0v[3]); w2.z = cvt_pk_bf16(a1v[0], a1v[1]); w2.w = cvt_pk_bf16(a1v[2], a1v[3]);
                        *(u32x4*)(C2 + ro) = w2;
                    }
                    u32x4 w; w.x = cvt_pk_bf16(v0[0], v0[1]); w.y = cvt_pk_bf16(v0[2], v0[3]); w.z = cvt_pk_bf16(v1[0], v1[1]); w.w = cvt_pk_bf16(v1[2], v1[3]);
                    *(u32x4*)(C + ro) = w; EPI_FENCE(); } }
    }
};
struct EpiLogits {
    static constexpr bool PERM = false;
    float* LG;
    __device__ __forceinline__ void operator()(const f32x4 (&acc)[2][2][4][2], const Unit& u, int wr, int wc, int fr, int fq) const {
        if (wc >= 2) return;
        const int col0 = wc * 32 + 4 * fq, row0 = u.pm * 256 + wr * 64 + fr;
#pragma unroll
        for (int ai = 0; ai < 2; ++ai)
#pragma unroll
            for (int m = 0; m < 4; ++m)
#pragma unroll
                for (int n = 0; n < 2; ++n) *(f32x4*)(LG + (size_t)(row0 + ai * 128 + m * 16) * 64 + col0 + n * 16) = acc[ai][0][m][n] + acc[ai][1][m][n];
    }
};
struct EpiSiluGate {
    static constexpr bool PERM = true;
    bf16_t* H;
    __device__ __forceinline__ void operator()(const f32x4 (&acc)[2][2][4][2], const Unit& u, int wr, int wc, int fr, int fq) const {
        const int col0 = u.pn * 128 + wc * 32 + 8 * fq, row0 = u.pm * 256 + wr * 64 + fr;
#pragma unroll
        for (int ai = 0; ai < 2; ++ai)
#pragma unroll
            for (int m = 0; m < 4; ++m) { f32x4 h0, h1;
#pragma unroll
                for (int j = 0; j < 4; ++j) { const float g0 = acc[ai][0][m][0][j], g1 = acc[ai][0][m][1][j]; h0[j] = g0 * sigmoidf_(g0) * acc[ai][1][m][0][j]; h1[j] = g1 * sigmoidf_(g1) * acc[ai][1][m][1][j]; }
                u32x4 w; w.x = cvt_pk_bf16(h0[0], h0[1]); w.y = cvt_pk_bf16(h0[2], h0[3]); w.z = cvt_pk_bf16(h1[0], h1[1]); w.w = cvt_pk_bf16(h1[2], h1[3]);
                *(u32x4*)(H + (size_t)(row0 + ai * 128 + m * 16) * EHID + col0) = w; }
    }
};
struct EpiScatter {
    static constexpr bool PERM = true;
    LAS unsigned char* lds; bf16_t* YB; const int* list;
    __device__ __forceinline__ void operator()(const f32x4 (&acc)[2][2][4][2], const Unit& u, int wr, int wc, int fr, int fq) const {
        LAS const int* tab = (LAS const int*)(lds + LDS_TAB);
        const int j0 = __builtin_amdgcn_readfirstlane(tab[MAXRT + u.pm]), cn = __builtin_amdgcn_readfirstlane(tab[2 * MAXRT + u.aux]);
        const int col0 = u.pn * 256 + wc * 32 + 8 * fq;
#pragma unroll
        for (int ai = 0; ai < 2; ++ai)
#pragma unroll
            for (int m = 0; m < 4; ++m) { const int slot = j0 + ai * 128 + wr * 64 + m * 16 + fr;
                if (slot < cn) { const int a = list[(size_t)u.aux * LISTCAP + slot]; bf16_t* rowp = YB + (size_t)a * D + col0;
#pragma unroll
                    for (int bj = 0; bj < 2; ++bj) { const f32x4 v0 = acc[ai][bj][m][0], v1 = acc[ai][bj][m][1];
                        u32x4 w; w.x = cvt_pk_bf16(v0[0], v0[1]); w.y = cvt_pk_bf16(v0[2], v0[3]); w.z = cvt_pk_bf16(v1[0], v1[1]); w.w = cvt_pk_bf16(v1[2], v1[3]);
                        *(u32x4*)(rowp + bj * 128) = w; } } }
    }
};

struct Params { const float* in[42]; float* out; unsigned char* ws; int ph_lo, ph_hi; };
enum { I_X = 0, I_C, I_CTX, I_CCTX, I_ADAW, I_ADAB, I_N1G, I_N2G, I_FG, I_GWIN, I_GBIN, I_GLNG, I_GLNB, I_GWS, I_GBS, I_GWOUT, I_GBOUT,
       I_MU, I_WR, I_WK, I_WV, I_WO, I_W0, I_W1, I_W2, I_A0, I_A1, I_A2, I_G1, I_G2, I_KK, I_KA, I_RK, I_LNG, I_LNB,
       I_MWGRP, I_MBGRP, I_MWEXP, I_MBEXP, I_MWG, I_MWU, I_MWD };
struct Frame { LAS unsigned char* lds; int tid, lane, wave, G, gw, NGW; };
typedef const __attribute__((address_space(4))) Params* KP;

__device__ __forceinline__ void tr_item(const float* W, int N, int kmax, bf16_t* WT, int ldk, int k0, int n0, int drow0, int dk0, LAS float* scr, int lane) {
#pragma unroll 8
    for (int i = 0; i < 32; ++i) { const int kk = 2 * i + (lane >> 5), k = k0 + kk; scr[kk * 33 + (lane & 31)] = k < kmax ? W[(size_t)k * N + n0 + (lane & 31)] : 0.f; }
    asm volatile("s_waitcnt lgkmcnt(0)" ::: "memory");
    const int c = lane & 7;
#pragma unroll
    for (int j = 0; j < 4; ++j) { const int n = (lane >> 3) + 8 * j; const LAS float* s = scr + (8 * c) * 33 + n;
        u32x4 o; o.x = cvt_pk_bf16(s[0 * 33], s[1 * 33]); o.y = cvt_pk_bf16(s[2 * 33], s[3 * 33]); o.z = cvt_pk_bf16(s[4 * 33], s[5 * 33]); o.w = cvt_pk_bf16(s[6 * 33], s[7 * 33]);
        *(u32x4*)(WT + (size_t)(drow0 + n) * ldk + dk0 + k0 + 8 * c) = o; }
    asm volatile("s_waitcnt lgkmcnt(0)" ::: "memory");
}
__device__ __forceinline__ void conv_T(const Frame& F, const float* W, int N, int kmax, int kpad, bf16_t* WT, int ldk, int drow0, int dk0, int ilv) {
    LAS float* scr = (LAS float*)(F.lds + F.wave * 8704);
    const int nnb = N / 32, nit = (kpad / 64) * nnb;
    for (int it = F.gw; it < nit; it += F.NGW) { const int kb = it / nnb, nb = it % nnb, n0 = nb * 32;
        const int dr = ilv == 0 ? n0 : (256 * (n0 >> 7) + (n0 & 127) + (ilv == 2 ? 128 : 0));
        tr_item(W, N, kmax, WT, ldk, kb * 64, n0, drow0 + dr, dk0, scr, F.lane); }
}
__device__ __forceinline__ void zero_fill(const Frame& F, bf16_t* p, size_t nbytes) {
    u32x4* q = (u32x4*)p; const size_t n = nbytes / 16;
    for (size_t i = (size_t)blockIdx.x * NTHR + F.tid; i < n; i += (size_t)F.G * NTHR) q[i] = (u32x4){0u, 0u, 0u, 0u};
}

__device__ __forceinline__ void prologue_phase(const Frame& F, KP P) {
    unsigned char* ws = P->ws;
    {   float* MOD = (float*)(ws + WS_MOD); LAS float* part = (LAS float*)F.lds;
        const float* c = P->in[I_C]; const float* cc = P->in[I_CCTX];
        for (int item = blockIdx.x; item < DEPTH * 96; item += F.G) {
            const int layer = item / 96, col = (item % 96) * 64 + F.lane; const float* w = P->in[I_ADAW] + (size_t)layer * D * 6 * D;
            float a0 = 0.f, a1 = 0.f, a2 = 0.f;
#pragma unroll 8
            for (int dd = 0; dd < 128; ++dd) { const int d = F.wave * 128 + dd; const float wv = w[(size_t)d * 6 * D + col];
                const float c0 = c[d], c1 = c[D + d], c2 = cc[d];
                a0 += c0 * sigmoidf_(c0) * wv; a1 += c1 * sigmoidf_(c1) * wv; a2 += c2 * sigmoidf_(c2) * wv; }
            part[(F.wave * 3 + 0) * 64 + F.lane] = a0; part[(F.wave * 3 + 1) * 64 + F.lane] = a1; part[(F.wave * 3 + 2) * 64 + F.lane] = a2;
            __syncthreads();
            if (F.wave < 3) { float s = 0.f;
#pragma unroll
                for (int w8 = 0; w8 < 8; ++w8) s += part[(w8 * 3 + F.wave) * 64 + F.lane];
                MOD[((size_t)layer * 3 + F.wave) * 6 * D + col] = s + P->in[I_ADAB][(size_t)layer * 6 * D + col]; }
            __syncthreads();
        }
    }
    for (int j = 0; j < 2; ++j) {
        conv_T(F, P->in[I_GWIN] + (size_t)j * D * 4096, 4096, D, D, (bf16_t*)(ws + WS_WIN) + (size_t)j * 4096 * D, D, 0, 0, 0);
        conv_T(F, P->in[I_GWOUT] + (size_t)j * GWID * D, D, GWID, GWID, (bf16_t*)(ws + WS_WOUT) + (size_t)j * D * GWID, GWID, 0, 0, 0);
        conv_T(F, P->in[I_WR] + (size_t)j * D * D, D, D, D, (bf16_t*)(ws + WS_WR) + (size_t)j * D * D, D, 0, 0, 0);
        conv_T(F, P->in[I_WK] + (size_t)j * D * D, D, D, D, (bf16_t*)(ws + WS_WK) + (size_t)j * D * D, D, 0, 0, 0);
        conv_T(F, P->in[I_WV] + (size_t)j * D * D, D, D, D, (bf16_t*)(ws + WS_WV) + (size_t)j * D * D, D, 0, 0, 0);
        conv_T(F, P->in[I_WO] + (size_t)j * D * D, D, D, D, (bf16_t*)(ws + WS_WO) + (size_t)j * D * D, D, 0, 0, 0);
        bf16_t* lw1 = (bf16_t*)(ws + WS_LW1) + (size_t)j * 256 * D; bf16_t* la1 = (bf16_t*)(ws + WS_LA1) + (size_t)j * 256 * D; bf16_t* lg1 = (bf16_t*)(ws + WS_LG1) + (size_t)j * 256 * D;
        for (int z = 0; z < 2; ++z) {
            conv_T(F, P->in[I_W1] + ((size_t)j * 2 + z) * D * 64, 64, D, D, lw1, D, z * 64, 0, 0);
            conv_T(F, P->in[I_A1] + ((size_t)j * 2 + z) * D * 64, 64, D, D, la1, D, z * 64, 0, 0);
            bf16_t* w2p = (bf16_t*)(ws + WS_W2P) + ((size_t)j * 2 + z) * D * 256; bf16_t* a2p = (bf16_t*)(ws + WS_A2P) + ((size_t)j * 2 + z) * D * 256;
            conv_T(F, P->in[I_W2] + ((size_t)j * 2 + z) * 64 * D, D, 64, 64, w2p, 256, 0, z * 64, 0);
            conv_T(F, P->in[I_A2] + ((size_t)j * 2 + z) * 64 * D, D, 64, 64, a2p, 256, 0, z * 64, 0);
            for (int idx = blockIdx.x * NTHR + F.tid; idx < D * 32; idx += F.G * NTHR) { const int n = idx >> 5, ch = idx & 31;
                if ((ch >> 3) != z) { *(u32x4*)(w2p + (size_t)n * 256 + ch * 8) = (u32x4){0u, 0u, 0u, 0u}; *(u32x4*)(a2p + (size_t)n * 256 + ch * 8) = (u32x4){0u, 0u, 0u, 0u}; } }
        }
        conv_T(F, P->in[I_G1] + (size_t)j * D * 160, 160, D, D, lg1, D, 0, 0, 0);
        zero_fill(F, lw1 + 128 * D, (size_t)128 * D * 2); zero_fill(F, la1 + 128 * D, (size_t)128 * D * 2); zero_fill(F, lg1 + 160 * D, (size_t)96 * D * 2);
        conv_T(F, P->in[I_G2] + (size_t)j * 160 * D, D, 160, 256, (bf16_t*)(ws + WS_G2P) + (size_t)j * D * 256, 256, 0, 0, 0);
    }
    {   bf16_t* wrt = (bf16_t*)(ws + WS_WRT);
        for (int idx = blockIdx.x * NTHR + F.tid; idx < DEPTH * 256 * (D / 8); idx += F.G * NTHR) { const int k0 = (idx & 127) * 8, n = (idx >> 7) & 255, layer = idx >> 15;
            const int nn = n & 127; const bool lo = n >= 128; float w[8];
#pragma unroll
            for (int e = 0; e < 8; ++e) { float x = 0.f;
                if (nn < 4) x = P->in[I_MWGRP][((size_t)layer * D + k0 + e) * 4 + nn]; else if (nn < 36) x = P->in[I_MWEXP][((size_t)layer * D + k0 + e) * NE + nn - 4];
                const float hi = bf_lo(cvt_pk_bf16(x, 0.f)); w[e] = lo ? x - hi : x; }
            *(u32x4*)(wrt + ((size_t)layer * 256 + n) * D + k0) = pack8(w); } }
    {   const float* src = P->in[I_GWS]; bf16_t* dst = (bf16_t*)(ws + WS_WSP); const int n8 = 2 * 16 * 128 * 128 / 8;
        for (int i = blockIdx.x * NTHR + F.tid; i < n8; i += F.G * NTHR) { const f32x4 a = *(const f32x4*)(src + (size_t)i * 8), b = *(const f32x4*)(src + (size_t)i * 8 + 4);
            u32x4 o; o.x = cvt_pk_bf16(a[0], a[1]); o.y = cvt_pk_bf16(a[2], a[3]); o.z = cvt_pk_bf16(b[0], b[1]); o.w = cvt_pk_bf16(b[2], b[3]); *(u32x4*)(dst + (size_t)i * 8) = o; } }
}
__device__ __forceinline__ void moe_weights_phase(const Frame& F, KP P, int layer) {
    unsigned char* ws = P->ws; LAS float* scr = (LAS float*)(F.lds + F.wave * 8704);
    for (int it = F.gw; it < NE * 768; it += F.NGW) {
        const int e = it / 768, r = it % 768, m = r >> 8, q = r & 255;
        const size_t so = ((size_t)layer * NE + e) * (size_t)D * EHID;
        if (m < 2) { const int kb = q >> 4, n0 = (q & 15) * 32;
            tr_item((m == 0 ? P->in[I_MWG] : P->in[I_MWU]) + so, EHID, D, (bf16_t*)(ws + WS_WGU) + (size_t)e * D * D, D, kb * 64, n0, 256 * (n0 >> 7) + (n0 & 127) + (m == 1 ? 128 : 0), 0, scr, F.lane); }
        else { const int kb = q >> 5, n0 = (q & 31) * 32;
            tr_item(P->in[I_MWD] + so, D, EHID, (bf16_t*)(ws + WS_WD) + (size_t)e * D * EHID, EHID, kb * 64, n0, n0, 0, scr, F.lane); }
    }
}

__device__ __forceinline__ const float* xrow_ptr(KP P, int layer, int row) {
    if (layer == 0) return row < TL ? P->in[I_X] + (size_t)row * D : P->in[I_CTX] + (size_t)(row - TL) * D;
    return (const float*)(P->ws + WS_X) + (size_t)row * D;
}
__device__ __forceinline__ void load_combine(KP P, const Frame& F, int layer, int row, int m, bool combine, f32x4 (&v)[4]) {
    const float* xr = xrow_ptr(P, layer, row);
#pragma unroll
    for (int j = 0; j < 4; ++j) v[j] = *(const f32x4*)(xr + 4 * F.lane + 256 * j);
    if (combine) {
        const bf16_t* yb = (const bf16_t*)(P->ws + WS_YB); const float* wg = (const float*)(P->ws + WS_WGT);
        const float w0 = wg[2 * row], w1 = wg[2 * row + 1]; const float* g2 = (const float*)(P->ws + WS_MOD) + ((size_t)(layer - 1) * 3 + m) * 6 * D + 5 * D;
#pragma unroll
        for (int j = 0; j < 4; ++j) { const int col = 4 * F.lane + 256 * j; const u32x2 a = *(const u32x2*)(yb + (size_t)(2 * row) * D + col), b = *(const u32x2*)(yb + (size_t)(2 * row + 1) * D + col);
            const f32x4 g = *(const f32x4*)(g2 + col);
            v[j][0] += g[0] * (w0 * bf_lo(a.x) + w1 * bf_lo(b.x)); v[j][1] += g[1] * (w0 * bf_hi(a.x) + w1 * bf_hi(b.x));
            v[j][2] += g[2] * (w0 * bf_lo(a.y) + w1 * bf_lo(b.y)); v[j][3] += g[3] * (w0 * bf_hi(a.y) + w1 * bf_hi(b.y)); }
    }
}
__device__ __forceinline__ void norm1_phase(const Frame& F, KP P, int layer) {
    const bool combine = layer > 0; float* X = (float*)(P->ws + WS_X); bf16_t* HL = (bf16_t*)(P->ws + WS_HL);
    const float* g1 = P->in[I_N1G] + (size_t)layer * D;
    for (int row = F.gw; row < T; row += F.NGW) {
        const int m = row < TL ? (row >> 14) : 2; f32x4 v[4];
        load_combine(P, F, layer, row, m, combine, v);
        if (combine) {
#pragma unroll
            for (int j = 0; j < 4; ++j) *(f32x4*)(X + (size_t)row * D + 4 * F.lane + 256 * j) = v[j]; }
        float ss = 0.f;
#pragma unroll
        for (int j = 0; j < 4; ++j) ss += (v[j][0] * v[j][0] + v[j][1] * v[j][1]) + (v[j][2] * v[j][2] + v[j][3] * v[j][3]);
        const float rstd = rsqrtf(wave_sum(ss) * (1.0f / D) + 1e-6f);
        const float* mod = (const float*)(P->ws + WS_MOD) + ((size_t)layer * 3 + m) * 6 * D;
#pragma unroll
        for (int j = 0; j < 4; ++j) { const int col = 4 * F.lane + 256 * j; const f32x4 g = *(const f32x4*)(g1 + col), sh = *(const f32x4*)(mod + col), sc = *(const f32x4*)(mod + D + col);
            const f32x4 h = (v[j] * rstd) * g * (sc + 1.0f) + sh;
            u32x2 o; o.x = cvt_pk_bf16(h[0], h[1]); o.y = cvt_pk_bf16(h[2], h[3]); *(u32x2*)(HL + (size_t)row * D + col) = o; }
    }
}
__device__ __forceinline__ void final_phase(const Frame& F, KP P) {
    const float* fg = P->in[I_FG];
    for (int row = F.gw; row < TL; row += F.NGW) {
        const int m = row >> 14; f32x4 v[4];
        load_combine(P, F, DEPTH, row, m, true, v);
        float ss = 0.f;
#pragma unroll
        for (int j = 0; j < 4; ++j) ss += (v[j][0] * v[j][0] + v[j][1] * v[j][1]) + (v[j][2] * v[j][2] + v[j][3] * v[j][3]);
        const float rstd = rsqrtf(wave_sum(ss) * (1.0f / D) + 1e-6f);
#pragma unroll
        for (int j = 0; j < 4; ++j) { const int col = 4 * F.lane + 256 * j; *(f32x4*)(P->out + (size_t)row * D + col) = (v[j] * rstd) * *(const f32x4*)(fg + col); }
    }
}
__device__ __forceinline__ void norm2_phase(const Frame& F, KP P, int layer) {
    const int ntok = layer == DEPTH - 1 ? TL : T; bf16_t* HL2 = (bf16_t*)(P->ws + WS_HL); const float* g2n = P->in[I_N2G] + (size_t)layer * D;
    for (int row = F.gw; row < ntok; row += F.NGW) {
        const int m = row < TL ? (row >> 14) : 2; const float* xr = xrow_ptr(P, 1, row); f32x4 v[4];
#pragma unroll
        for (int j = 0; j < 4; ++j) v[j] = *(const f32x4*)(xr + 4 * F.lane + 256 * j);
        float ss = 0.f;
#pragma unroll
        for (int j = 0; j < 4; ++j) ss += (v[j][0] * v[j][0] + v[j][1] * v[j][1]) + (v[j][2] * v[j][2] + v[j][3] * v[j][3]);
        const float rstd = rsqrtf(wave_sum(ss) * (1.0f / D) + 1e-6f);
        const float* mod = (const float*)(P->ws + WS_MOD) + ((size_t)layer * 3 + m) * 6 * D;
#pragma unroll
        for (int j = 0; j < 4; ++j) { const int col = 4 * F.lane + 256 * j; const f32x4 g = *(const f32x4*)(g2n + col), sh = *(const f32x4*)(mod + 3 * D + col), sc = *(const f32x4*)(mod + 4 * D + col);
            const f32x4 h = (v[j] * rstd) * g * (sc + 1.0f) + sh;
            u32x2 o; o.x = cvt_pk_bf16(h[0], h[1]); o.y = cvt_pk_bf16(h[2], h[3]); *(u32x2*)(HL2 + (size_t)row * D + col) = o; }
    }
    moe_weights_phase(F, P, layer);
}
__device__ __forceinline__ void route_phase(const Frame& F, KP P, int layer) {
    const int ntok = layer == DEPTH - 1 ? TL : T; const float* LG = (const float*)(P->ws + WS_LG);
    const float* bgrp = P->in[I_MBGRP] + layer * 4; const float* bexp = P->in[I_MBEXP] + layer * NE;
    unsigned* cnt = (unsigned*)(P->ws + WS_CTL) + CW_CNT + layer * 64; int* list = (int*)(P->ws + WS_LIST); float* wgt = (float*)(P->ws + WS_WGT);
    for (int row = blockIdx.x * NTHR + F.tid; row < ntok; row += F.G * NTHR) {
        const float* lg = LG + (size_t)row * 64; const f32x4 g4 = *(const f32x4*)lg;
        float ag[4];
#pragma unroll
        for (int i = 0; i < 4; ++i) ag[i] = g4[i] + bgrp[i];
        int grp = 0; float mx = ag[0];
#pragma unroll
        for (int i = 1; i < 4; ++i) if (ag[i] > mx) { mx = ag[i]; grp = i; }
        float den = 0.f;
#pragma unroll
        for (int i = 0; i < 4; ++i) den += __expf(ag[i] - mx);
        const float pg = 1.0f / den;
        const f32x4 e0v = *(const f32x4*)(lg + 4 + 8 * grp), e1v = *(const f32x4*)(lg + 8 + 8 * grp); const f32x4 b0v = *(const f32x4*)(bexp + 8 * grp), b1v = *(const f32x4*)(bexp + 8 * grp + 4);
        float el[8];
#pragma unroll
        for (int i = 0; i < 4; ++i) { el[i] = e0v[i] + b0v[i]; el[4 + i] = e1v[i] + b1v[i]; }
        int i0 = 0; float t0 = el[0];
#pragma unroll
        for (int i = 1; i < 8; ++i) if (el[i] > t0) { t0 = el[i]; i0 = i; }
        int i1 = -1; float t1 = -3.0e38f;
#pragma unroll
        for (int i = 0; i < 8; ++i) if (i != i0 && el[i] > t1) { t1 = el[i]; i1 = i; }
        const float p0 = 1.0f / (1.0f + __expf(t1 - t0)), w0 = pg * p0, w1 = pg * (1.0f - p0);
        const int e0 = grp * 8 + i0, e1 = grp * 8 + i1;
        const unsigned s0 = atomicAdd(cnt + e0, 1u), s1 = atomicAdd(cnt + e1, 1u);
        list[(size_t)e0 * LISTCAP + s0] = 2 * row; list[(size_t)e1 * LISTCAP + s1] = 2 * row + 1; wgt[2 * row] = w0; wgt[2 * row + 1] = w1;
    }
}
__device__ __forceinline__ void spatial_phase(const Frame& F, KP P, int j) {
    bf16_t* U = (bf16_t*)(P->ws + WS_U); const bf16_t* V = (const bf16_t*)(P->ws + WS_V); const float* stat = (const float*)(P->ws + WS_STAT);
    const bf16_t* WSP = (const bf16_t*)(P->ws + WS_WSP) + (size_t)j * 16 * 128 * 128;
    const float* lng = P->in[I_GLNG] + (size_t)j * GWID; const float* lnb = P->in[I_GLNB] + (size_t)j * GWID; const float* bs = P->in[I_GBS] + (size_t)j * 16 * 128;
    LAS bf16_t* Wt = (LAS bf16_t*)F.lds; LAS bf16_t* Vt = Wt + 128 * 136;
    LAS float* mu = (LAS float*)(F.lds + 2 * 128 * 136 * 2); LAS float* rs = mu + 128;
    const int l15 = F.lane & 15, l4 = F.lane >> 4;
    for (int item = blockIdx.x; item < (T / 128) * 16; item += F.G) {
        const int c = item >> 4, g = item & 15, t0 = c * 128;
        __syncthreads();
        if (F.tid < 128) { const int row = t0 + F.tid; float s = 0.f, q = 0.f;
#pragma unroll 8
            for (int i = 0; i < 32; ++i) { const f32x2 p = *(const f32x2*)(stat + ((size_t)row * 32 + i) * 2); s += p.x; q += p.y; }
            const float mean = s * (1.0f / GWID), var = q * (1.0f / GWID) - mean * mean; mu[F.tid] = mean; rs[F.tid] = rsqrtf(var + 1e-5f); }
#pragma unroll
        for (int i = 0; i < 4; ++i) { const int idx = F.tid + NTHR * i, p = idx >> 4, seg = idx & 15;
            *(LAS u32x4*)(Wt + p * 136 + seg * 8) = *(const u32x4*)(WSP + ((size_t)g * 128 + p) * 128 + seg * 8); }
        __syncthreads();
#pragma unroll
        for (int i = 0; i < 4; ++i) { const int idx = F.tid + NTHR * i, q = idx >> 4, seg = idx & 15, ch = g * 128 + seg * 8;
            const u32x4 raw = *(const u32x4*)(V + (size_t)(t0 + q) * GWID + ch); const unsigned rw[4] = {raw.x, raw.y, raw.z, raw.w};
            const float m_ = mu[q], r_ = rs[q];
#pragma unroll
            for (int e = 0; e < 8; ++e) { const float x = (e & 1) ? bf_hi(rw[e >> 1]) : bf_lo(rw[e >> 1]);
                Vt[(seg * 8 + e) * 136 + q] = f2bf((x - m_) * r_ * lng[ch + e] + lnb[ch + e]); } }
        __syncthreads();
        bf16x8 bw[4];
#pragma unroll
        for (int ks = 0; ks < 4; ++ks) bw[ks] = *(const LAS bf16x8*)(Wt + (16 * F.wave + l15) * 136 + ks * 32 + 8 * l4);
        const int p = 16 * F.wave + l15; const float bias = bs[g * 128 + p];
#pragma unroll
        for (int dt = 0; dt < 8; ++dt) { f32x4 acc = (f32x4){0.f, 0.f, 0.f, 0.f};
#pragma unroll
            for (int ks = 0; ks < 4; ++ks) { const bf16x8 a = *(const LAS bf16x8*)(Vt + (dt * 16 + l15) * 136 + ks * 32 + 8 * l4); acc = __builtin_amdgcn_mfma_f32_16x16x32_bf16(a, bw[ks], acc, 0, 0, 0); }
            bf16_t* up = U + (size_t)(t0 + p) * GWID + g * 128 + dt * 16 + 4 * l4; const u32x2 uu = *(const u32x2*)up;
            u32x2 o; o.x = cvt_pk_bf16(bf_lo(uu.x) * (acc[0] + bias), bf_hi(uu.x) * (acc[1] + bias)); o.y = cvt_pk_bf16(bf_lo(uu.y) * (acc[2] + bias), bf_hi(uu.y) * (acc[3] + bias));
            *(u32x2*)up = o; }
    }
}

__device__ __forceinline__ void mix_phase(const Frame& F, KP P, int j) {
    const bf16_t* HL = (const bf16_t*)(P->ws + WS_HL); const float* mu = P->in[I_MU] + (size_t)j * 6 * D;
    bf16_t* outs[6] = {(bf16_t*)(P->ws + WS_XR), (bf16_t*)(P->ws + WS_XW), (bf16_t*)(P->ws + WS_XK), (bf16_t*)(P->ws + WS_XV), (bf16_t*)(P->ws + WS_XA), (bf16_t*)(P->ws + WS_XG)};
    for (int row = F.gw; row < T; row += F.NGW) {
        bool ok[2]; int src[2]; const bool hi = F.lane >= 32;
        if (row < TL) { const int n = row & (SEQ - 1), gc = n & 63, gr = n >> 6;
            ok[0] = hi ? gc < 63 : gc > 0; src[0] = hi ? row + 1 : row - 1; ok[1] = hi ? gr < 255 : gr > 0; src[1] = hi ? row + 64 : row - 64; }
        else { const int n = (row - TL) & (CTXL - 1); ok[0] = n > 0; src[0] = row - 1; ok[1] = n < CTXL - 1; src[1] = row + 1; }
#pragma unroll
        for (int jj = 0; jj < 2; ++jj) { const int col = 512 * jj + 8 * F.lane;
            const u32x4 h8 = *(const u32x4*)(HL + (size_t)row * D + col); u32x4 s8 = (u32x4){0u, 0u, 0u, 0u};
            if (ok[jj]) s8 = *(const u32x4*)(HL + (size_t)src[jj] * D + col);
            const unsigned hw[4] = {h8.x, h8.y, h8.z, h8.w}, sw[4] = {s8.x, s8.y, s8.z, s8.w}; float h[8], xx[8];
#pragma unroll
            for (int e = 0; e < 8; ++e) { h[e] = (e & 1) ? bf_hi(hw[e >> 1]) : bf_lo(hw[e >> 1]); const float s = (e & 1) ? bf_hi(sw[e >> 1]) : bf_lo(sw[e >> 1]); xx[e] = s - h[e]; }
#pragma unroll
            for (int m = 0; m < 6; ++m) { const f32x4 ma = *(const f32x4*)(mu + (size_t)m * D + col), mb = *(const f32x4*)(mu + (size_t)m * D + col + 4);
                u32x4 o; o.x = cvt_pk_bf16(h[0] + xx[0] * ma[0], h[1] + xx[1] * ma[1]); o.y = cvt_pk_bf16(h[2] + xx[2] * ma[2], h[3] + xx[3] * ma[3]);
                o.z = cvt_pk_bf16(h[4] + xx[4] * mb[0], h[5] + xx[5] * mb[1]); o.w = cvt_pk_bf16(h[6] + xx[6] * mb[2], h[7] + xx[7] * mb[3]);
                *(u32x4*)(outs[m] + (size_t)row * D + col) = o; } }
    }
}

constexpr int NSC = 65, NSCAN = 64, TP = 72, TILE_B = 64 * TP * 2;
enum { T_AT = 0, T_RT, T_BT, T_KT, T_VM, T_NT, T_MT, T_NRT, T_MRT, T_APA, T_APB, T_TAA, T_TAB, T_PRB, T_QRB, T_NTILE };
constexpr int LDS_GL = T_NTILE * TILE_B, LDS_SEG = LDS_GL + 256;
static_assert(LDS_SEG + 2048 <= LDS_MISC, "scan LDS map");
typedef short v4s __attribute__((ext_vector_type(4)));
__device__ __forceinline__ int scan_row(int z, int b, int p) {
    if (p < CTXL) return TL + b * CTXL + (z ? CTXL - 1 - p : p);
    const int q = p - CTXL; return b * SEQ + (z ? SEQ - 1 - q : q);
}
__device__ __forceinline__ LAS bf16_t* stile(LAS unsigned char* lds, int n) { return (LAS bf16_t*)(lds + n * TILE_B); }
__device__ __forceinline__ bf16x8 row_frag(const LAS bf16_t* M, int r0, int k0, int lane) { return *(const LAS bf16x8*)(M + (r0 + (lane & 15)) * TP + k0 + 8 * (lane >> 4)); }
__device__ __forceinline__ bf16x8 tr_frag(const LAS bf16_t* M, int k0, int c0, int lane) {
    LAS bf16_t* p = (LAS bf16_t*)M + (k0 + 8 * (lane >> 4) + ((lane & 15) >> 2)) * TP + c0 + 4 * (lane & 3);
    const v4s lo = __builtin_amdgcn_ds_read_tr16_b64_v4i16((LAS v4s*)p), hi = __builtin_amdgcn_ds_read_tr16_b64_v4i16((LAS v4s*)(p + 4 * TP));
    return (bf16x8){lo[0], lo[1], lo[2], lo[3], hi[0], hi[1], hi[2], hi[3]};
}
template <bool XT, bool YT>
__device__ __forceinline__ void mm64(const LAS bf16_t* X, const LAS bf16_t* Y, f32x4 (&acc)[2], int wq, int wh, int lane) {
#pragma unroll
    for (int ks = 0; ks < 2; ++ks) {
        const bf16x8 b = XT ? tr_frag(X, 32 * ks, 16 * wq, lane) : row_frag(X, 16 * wq, 32 * ks, lane);
#pragma unroll
        for (int q = 0; q < 2; ++q) { const int i0 = 16 * (2 * wh + q);
            const bf16x8 a = YT ? row_frag(Y, i0, 32 * ks, lane) : tr_frag(Y, 32 * ks, i0, lane);
            acc[q] = __builtin_amdgcn_mfma_f32_16x16x32_bf16(a, b, acc[q], 0, 0, 0); }
    }
}
__device__ __forceinline__ void st_tile(LAS bf16_t* Z, const f32x4 (&acc)[2], int wq, int wh, int lane) {
#pragma unroll
    for (int q = 0; q < 2; ++q) { u32x2 o; o.x = cvt_pk_bf16(acc[q][0], acc[q][1]); o.y = cvt_pk_bf16(acc[q][2], acc[q][3]);
        *(LAS u32x2*)(Z + (16 * wq + (lane & 15)) * TP + 16 * (2 * wh + q) + 4 * (lane >> 4)) = o; }
}
__device__ __forceinline__ void ld_tile(const LAS bf16_t* Z, f32x4 (&acc)[2], int wq, int wh, int lane) {
#pragma unroll
    for (int q = 0; q < 2; ++q) { const u32x2 o = *(const LAS u32x2*)(Z + (16 * wq + (lane & 15)) * TP + 16 * (2 * wh + q) + 4 * (lane >> 4));
        acc[q] = (f32x4){bf_lo(o.x), bf_hi(o.x), bf_lo(o.y), bf_hi(o.y)}; }
}
struct ChunkRegs { u32x4 r, k, v, e, m, a; };
__device__ __forceinline__ void scan_load(KP P, const Frame& F, int item, int c4, ChunkRegs& R) {
    const int s = item & 63, sc = item >> 6, z = s >> 5, b = (s >> 4) & 1, hh = s & 15;
    const size_t o = (size_t)scan_row(z, b, sc * 256 + c4 * 64 + (F.tid >> 3)) * D + hh * 64 + (F.tid & 7) * 8;
    R.r = *(const u32x4*)((const bf16_t*)(P->ws + WS_R) + o); R.k = *(const u32x4*)((const bf16_t*)(P->ws + WS_K) + o); R.v = *(const u32x4*)((const bf16_t*)(P->ws + WS_VV) + o);
    R.e = *(const u32x4*)((const bf16_t*)(P->ws + (z ? WS_ELOG1 : WS_ELOG0)) + o); R.m = *(const u32x4*)((const bf16_t*)(P->ws + (z ? WS_KM1 : WS_KM0)) + o); R.a = *(const u32x4*)((const bf16_t*)(P->ws + (z ? WS_AS1 : WS_AS0)) + o);
}
__device__ __forceinline__ void scan_chunk_phase(const Frame& F, KP P, int j) {
    LAS unsigned char* lds = F.lds;
    LAS bf16_t* At = stile(lds, T_AT); LAS bf16_t* Rt = stile(lds, T_RT); LAS bf16_t* Bt = stile(lds, T_BT); LAS bf16_t* Kt = stile(lds, T_KT); LAS bf16_t* Vm = stile(lds, T_VM);
    LAS bf16_t* NT = stile(lds, T_NT); LAS bf16_t* MT = stile(lds, T_MT); LAS bf16_t* NrT = stile(lds, T_NRT); LAS bf16_t* MrT = stile(lds, T_MRT);
    LAS bf16_t* ApA = stile(lds, T_APA); LAS bf16_t* ApB = stile(lds, T_APB); LAS bf16_t* TaA = stile(lds, T_TAA); LAS bf16_t* TaB = stile(lds, T_TAB);
    LAS bf16_t* PrB = stile(lds, T_PRB); LAS bf16_t* QrB = stile(lds, T_QRB);
    LAS float* Efp = (LAS float*)(lds + T_APA * TILE_B); LAS float* gl = (LAS float*)(lds + LDS_GL); LAS float* seg = (LAS float*)(lds + LDS_SEG);
    const int lane = F.lane, wq = F.wave & 3, wh = F.wave >> 2, l15 = lane & 15, l4 = lane >> 4;
    const int pi = F.tid >> 3, kq = F.tid & 7;
    const int jrow = 16 * wq + l15;
    const int NITEM = NSCAN * NSC;
    int item = blockIdx.x; if (item >= NITEM) return;
    ChunkRegs cur, nxt; scan_load(P, F, item, 0, cur); nxt = cur;
    f32x4 Pr[2], Qr[2];
#pragma unroll
    for (int q = 0; q < 2; ++q) { Pr[q] = (f32x4){0.f, 0.f, 0.f, 0.f}; Qr[q] = (f32x4){0.f, 0.f, 0.f, 0.f}; }
    for (;;) {
        const int s = item & 63, sc = item >> 6, z = s >> 5, b = (s >> 4) & 1, hh = s & 15;
        const float* kkw = P->in[I_KK] + (size_t)j * D + hh * 64 + kq * 8;
        bf16_t* GE = (bf16_t*)(P->ws + (z ? WS_AS1 : WS_AS0)); bf16_t* YE = (bf16_t*)(P->ws + (z ? WS_ELOG1 : WS_ELOG0));
#pragma nounroll
        for (int c4 = 0; c4 < 4; ++c4) {
            float r8[8], k8[8], e8[8], m8[8], a8[8], kk8[8];
            unpack8(cur.r, r8); unpack8(cur.k, k8); unpack8(cur.e, e8); unpack8(cur.m, m8); unpack8(cur.a, a8);
            { const f32x4 w0 = *(const f32x4*)kkw, w1 = *(const f32x4*)(kkw + 4); float ss = 0.f;
#pragma unroll
              for (int e = 0; e < 8; ++e) { kk8[e] = k8[e] * (e < 4 ? w0[e & 3] : w1[e & 3]); ss += kk8[e] * kk8[e]; }
              ss += __shfl_xor(ss, 1); ss += __shfl_xor(ss, 2); ss += __shfl_xor(ss, 4);
              const float rn = rsqrtf(ss + 1e-12f);
#pragma unroll
              for (int e = 0; e < 8; ++e) kk8[e] *= rn; }
            *(LAS f32x4*)(Efp + pi * 64 + kq * 8) = (f32x4){e8[0], e8[1], e8[2], e8[3]}; *(LAS f32x4*)(Efp + pi * 64 + kq * 8 + 4) = (f32x4){e8[4], e8[5], e8[6], e8[7]};
            __syncthreads();
            if (c4 > 0) { st_tile(PrB, Pr, wq, wh, lane); st_tile(QrB, Qr, wq, wh, lane); }
            { const int kc = F.tid & 63, sg = F.tid >> 6; float run = 0.f;
#pragma unroll
              for (int ii = 0; ii < 8; ++ii) { run += Efp[(sg * 8 + ii) * 64 + kc]; Efp[(sg * 8 + ii) * 64 + kc] = run; }
              seg[sg * 64 + kc] = run; }
            __syncthreads();
            { const int kc = F.tid & 63, sg = F.tid >> 6; float off = 0.f;
              for (int s2 = 0; s2 < sg; ++s2) off += seg[s2 * 64 + kc];
#pragma unroll
              for (int ii = 0; ii < 8; ++ii) Efp[(sg * 8 + ii) * 64 + kc] += off; }
            __syncthreads();
            float cum[8];
            { const f32x4 c0 = *(const LAS f32x4*)(Efp + pi * 64 + kq * 8), c1 = *(const LAS f32x4*)(Efp + pi * 64 + kq * 8 + 4);
#pragma unroll
              for (int e = 0; e < 8; ++e) cum[e] = e < 4 ? c0[e & 3] : c1[e & 3]; }
            __syncthreads();
            { float o[8];
#pragma unroll
              for (int e = 0; e < 8; ++e) o[e] = -kk8[e] * __expf(cum[e] - e8[e]);
              *(LAS u32x4*)(At + pi * TP + kq * 8) = pack8(o);
#pragma unroll
              for (int e = 0; e < 8; ++e) o[e] = r8[e] * __expf(cum[e]);
              *(LAS u32x4*)(Rt + pi * TP + kq * 8) = pack8(o);
              float en[8];
#pragma unroll
              for (int e = 0; e < 8; ++e) { en[e] = __expf(-cum[e]); o[e] = kk8[e] * a8[e] * en[e]; }
              *(LAS u32x4*)(Bt + pi * TP + kq * 8) = pack8(o);
#pragma unroll
              for (int e = 0; e < 8; ++e) o[e] = m8[e] * en[e];
              *(LAS u32x4*)(Kt + pi * TP + kq * 8) = pack8(o);
              *(LAS u32x4*)(Vm + pi * TP + kq * 8) = cur.v;
              if (pi == 63) {
#pragma unroll
                  for (int e = 0; e < 8; ++e) gl[kq * 8 + e] = __expf(cum[e]); } }
            { const int nitem = c4 < 3 ? item : item + (int)gridDim.x, nc4 = c4 < 3 ? c4 + 1 : 0; if (nitem < NITEM) scan_load(P, F, nitem, nc4, nxt); }
            __syncthreads();
            {   f32x4 aN[2], aM[2], aNr[2], aMr[2];
#pragma unroll
                for (int q = 0; q < 2; ++q) { aN[q] = (f32x4){0.f, 0.f, 0.f, 0.f}; aM[q] = aN[q]; aNr[q] = aN[q]; aMr[q] = aN[q]; }
                mm64<false, true>(At, Bt, aN, wq, wh, lane); mm64<false, true>(At, Kt, aM, wq, wh, lane); mm64<false, true>(Rt, Bt, aNr, wq, wh, lane); mm64<false, true>(Rt, Kt, aMr, wq, wh, lane);
                f32x4 aT[2];
#pragma unroll
                for (int q = 0; q < 2; ++q)
#pragma unroll
                    for (int r = 0; r < 4; ++r) { const int i = 16 * (2 * wh + q) + 4 * l4 + r; const bool lt = i < jrow, le = i <= jrow;
                        aN[q][r] = lt ? aN[q][r] : 0.f; aM[q][r] = lt ? aM[q][r] : 0.f; aNr[q][r] = le ? aNr[q][r] : 0.f; aMr[q][r] = le ? aMr[q][r] : 0.f; aT[q][r] = aN[q][r] + (i == jrow ? 1.f : 0.f); }
                st_tile(NT, aN, wq, wh, lane); st_tile(MT, aM, wq, wh, lane); st_tile(NrT, aNr, wq, wh, lane); st_tile(MrT, aMr, wq, wh, lane); st_tile(TaA, aT, wq, wh, lane);
            }
            __syncthreads();
            {   f32x4 a2[2] = {(f32x4){0.f, 0.f, 0.f, 0.f}, (f32x4){0.f, 0.f, 0.f, 0.f}}; mm64<false, false>(NT, NT, a2, wq, wh, lane); st_tile(ApA, a2, wq, wh, lane); }
            __syncthreads();
#pragma nounroll
            for (int it = 0; it < 2; ++it) {
                {   f32x4 t[2]; ld_tile(TaA, t, wq, wh, lane); mm64<false, false>(TaA, ApA, t, wq, wh, lane); st_tile(TaB, t, wq, wh, lane);
                    f32x4 a2[2] = {(f32x4){0.f, 0.f, 0.f, 0.f}, (f32x4){0.f, 0.f, 0.f, 0.f}}; mm64<false, false>(ApA, ApA, a2, wq, wh, lane); st_tile(ApB, a2, wq, wh, lane); }
                __syncthreads();
                {   f32x4 t[2]; ld_tile(TaB, t, wq, wh, lane); mm64<false, false>(TaB, ApB, t, wq, wh, lane); st_tile(TaA, t, wq, wh, lane);
                    f32x4 a2[2] = {(f32x4){0.f, 0.f, 0.f, 0.f}, (f32x4){0.f, 0.f, 0.f, 0.f}}; mm64<false, false>(ApB, ApB, a2, wq, wh, lane); st_tile(ApA, a2, wq, wh, lane); }
                __syncthreads();
            }
            {   f32x4 t[2]; ld_tile(TaA, t, wq, wh, lane); mm64<false, false>(TaA, ApA, t, wq, wh, lane); st_tile(TaB, t, wq, wh, lane); }
            __syncthreads();
            {   f32x4 w[2] = {(f32x4){0.f, 0.f, 0.f, 0.f}, (f32x4){0.f, 0.f, 0.f, 0.f}}; mm64<true, true>(At, TaB, w, wq, wh, lane); st_tile(ApA, w, wq, wh, lane);
                f32x4 x[2] = {(f32x4){0.f, 0.f, 0.f, 0.f}, (f32x4){0.f, 0.f, 0.f, 0.f}}; mm64<true, true>(Vm, MT, x, wq, wh, lane); st_tile(ApB, x, wq, wh, lane); }
            __syncthreads();
            {   f32x4 u[2] = {(f32x4){0.f, 0.f, 0.f, 0.f}, (f32x4){0.f, 0.f, 0.f, 0.f}}; mm64<false, true>(ApB, TaB, u, wq, wh, lane); st_tile(TaA, u, wq, wh, lane); }
            __syncthreads();
            f32x4 aP[2], aQ[2], aG[2], aY[2];
#pragma unroll
            for (int q = 0; q < 2; ++q) { aP[q] = (f32x4){0.f, 0.f, 0.f, 0.f}; aQ[q] = aP[q]; aG[q] = aP[q]; aY[q] = aP[q]; }
            mm64<false, false>(ApA, Bt, aP, wq, wh, lane);
            mm64<false, false>(TaA, Bt, aQ, wq, wh, lane); mm64<true, false>(Vm, Kt, aQ, wq, wh, lane);
            mm64<false, true>(NrT, ApA, aG, wq, wh, lane);
            mm64<false, true>(NrT, TaA, aY, wq, wh, lane); mm64<false, false>(MrT, Vm, aY, wq, wh, lane);
#pragma unroll
            for (int q = 0; q < 2; ++q) { const int i0 = 16 * (2 * wh + q) + 4 * l4; const f32x4 g4 = *(const LAS f32x4*)(gl + i0);
                const u32x2 rr = *(const LAS u32x2*)(Rt + jrow * TP + i0);
#pragma unroll
                for (int r = 0; r < 4; ++r) { aP[q][r] = (aP[q][r] + (i0 + r == jrow ? 1.f : 0.f)) * g4[r]; aQ[q][r] *= g4[r]; }
                aG[q][0] += bf_lo(rr.x); aG[q][1] += bf_hi(rr.x); aG[q][2] += bf_lo(rr.y); aG[q][3] += bf_hi(rr.y); }
            const size_t orow = (size_t)scan_row(z, b, sc * 256 + c4 * 64 + jrow) * D + hh * 64;
            if (c4 == 0) {
#pragma unroll
                for (int q = 0; q < 2; ++q) { const int i0 = 16 * (2 * wh + q) + 4 * l4;
                    u32x2 o; o.x = cvt_pk_bf16(aG[q][0], aG[q][1]); o.y = cvt_pk_bf16(aG[q][2], aG[q][3]); *(u32x2*)(GE + orow + i0) = o;
                    u32x2 y; y.x = cvt_pk_bf16(aY[q][0], aY[q][1]); y.y = cvt_pk_bf16(aY[q][2], aY[q][3]); *(u32x2*)(YE + orow + i0) = y;
                    Pr[q] = aP[q]; Qr[q] = aQ[q]; }
            } else {
                st_tile(NT, aG, wq, wh, lane); st_tile(MT, aP, wq, wh, lane);
                __syncthreads();
                f32x4 ge[2] = {(f32x4){0.f, 0.f, 0.f, 0.f}, (f32x4){0.f, 0.f, 0.f, 0.f}};
                mm64<false, true>(NT, PrB, ge, wq, wh, lane); mm64<false, true>(NT, QrB, aY, wq, wh, lane);
                f32x4 pn[2] = {(f32x4){0.f, 0.f, 0.f, 0.f}, (f32x4){0.f, 0.f, 0.f, 0.f}};
                mm64<false, false>(PrB, MT, pn, wq, wh, lane); mm64<false, false>(QrB, MT, aQ, wq, wh, lane);
#pragma unroll
                for (int q = 0; q < 2; ++q) { const int i0 = 16 * (2 * wh + q) + 4 * l4;
                    u32x2 o; o.x = cvt_pk_bf16(ge[q][0], ge[q][1]); o.y = cvt_pk_bf16(ge[q][2], ge[q][3]); *(u32x2*)(GE + orow + i0) = o;
                    u32x2 y; y.x = cvt_pk_bf16(aY[q][0], aY[q][1]); y.y = cvt_pk_bf16(aY[q][2], aY[q][3]); *(u32x2*)(YE + orow + i0) = y;
                    Pr[q] = pn[q]; Qr[q] = aQ[q]; }
            }
            if (c4 == 3) { float* pq = (float*)(P->ws + WS_PQ) + ((size_t)(s * NSC + sc) * 2) * 4096;
#pragma unroll
                for (int q = 0; q < 2; ++q) { const int i0 = 16 * (2 * wh + q) + 4 * l4; *(f32x4*)(pq + jrow * 64 + i0) = Pr[q]; *(f32x4*)(pq + 4096 + jrow * 64 + i0) = Qr[q]; } }
            cur = nxt;
            __syncthreads();
        }
        item += gridDim.x; if (item >= NITEM) break;
    }
}
__device__ __forceinline__ void scan_carry_phase(const Frame& F, KP P) {
    if (F.wave != 0 || blockIdx.x >= 4 * NSCAN) return;
    const int s = blockIdx.x >> 2, vs = blockIdx.x & 3, lane = F.lane, l15 = lane & 15, l4 = lane >> 4, v = 16 * vs + l15;
    const float* pq = (const float*)(P->ws + WS_PQ) + (size_t)s * NSC * 2 * 4096; bf16_t* sst = (bf16_t*)(P->ws + WS_SST) + (size_t)s * NSC * 4096;
    f32x4 S[4], an[4][4], qn[4];
#pragma unroll
    for (int t = 0; t < 4; ++t) S[t] = (f32x4){0.f, 0.f, 0.f, 0.f};
#pragma unroll
    for (int t2i = 0; t2i < 4; ++t2i)
#pragma unroll
        for (int ri = 0; ri < 4; ++ri) an[t2i][ri] = *(const f32x4*)(pq + (16 * l4 + 4 * ri + t2i) * 64 + 4 * l15);
#pragma unroll
    for (int r = 0; r < 4; ++r) qn[r] = *(const f32x4*)(pq + 4096 + v * 64 + 16 * l4 + 4 * r);
#pragma nounroll
    for (int sc = 0; sc < NSC; ++sc) {
        {   float o[16];
#pragma unroll
            for (int r = 0; r < 4; ++r)
#pragma unroll
                for (int t2 = 0; t2 < 4; ++t2) o[4 * r + t2] = S[t2][r];
            u32x4 w0, w1; w0.x = cvt_pk_bf16(o[0], o[1]); w0.y = cvt_pk_bf16(o[2], o[3]); w0.z = cvt_pk_bf16(o[4], o[5]); w0.w = cvt_pk_bf16(o[6], o[7]);
            w1.x = cvt_pk_bf16(o[8], o[9]); w1.y = cvt_pk_bf16(o[10], o[11]); w1.z = cvt_pk_bf16(o[12], o[13]); w1.w = cvt_pk_bf16(o[14], o[15]);
            *(u32x4*)(sst + (size_t)sc * 4096 + v * 64 + 16 * l4) = w0; *(u32x4*)(sst + (size_t)sc * 4096 + v * 64 + 16 * l4 + 8) = w1; }
        if (sc == NSC - 1) break;
        f32x4 ac[4][4], nw[4];
#pragma unroll
        for (int t2i = 0; t2i < 4; ++t2i)
#pragma unroll
            for (int ri = 0; ri < 4; ++ri) ac[t2i][ri] = an[t2i][ri];
#pragma unroll
        for (int t2 = 0; t2 < 4; ++t2) nw[t2] = (f32x4){qn[0][t2], qn[1][t2], qn[2][t2], qn[3][t2]};
        if (sc + 1 < NSC - 1) { const float* Pm = pq + (size_t)(sc + 1) * 2 * 4096;
#pragma unroll
            for (int t2i = 0; t2i < 4; ++t2i)
#pragma unroll
                for (int ri = 0; ri < 4; ++ri) an[t2i][ri] = *(const f32x4*)(Pm + (16 * l4 + 4 * ri + t2i) * 64 + 4 * l15);
#pragma unroll
            for (int r = 0; r < 4; ++r) qn[r] = *(const f32x4*)(Pm + 4096 + v * 64 + 16 * l4 + 4 * r); }
#pragma unroll
        for (int t2i = 0; t2i < 4; ++t2i)
#pragma unroll
            for (int ri = 0; ri < 4; ++ri)
#pragma unroll
                for (int t2 = 0; t2 < 4; ++t2) nw[t2] = __builtin_amdgcn_mfma_f32_16x16x4f32(ac[t2i][ri][t2], S[t2i][ri], nw[t2], 0, 0, 0);
#pragma unroll
        for (int t = 0; t < 4; ++t) S[t] = nw[t];
    }
}
__device__ __forceinline__ void scan_fix_phase(const Frame& F, KP P) {
    const int lane = F.lane, l15 = lane & 15, l4 = lane >> 4;
    for (int item = F.gw; item < NSCAN * NSC; item += F.NGW) {
        const int s = item & 63, sc = item >> 6, z = s >> 5, b = (s >> 4) & 1, hh = s & 15;
        const bf16_t* sst = (const bf16_t*)(P->ws + WS_SST) + ((size_t)s * NSC + sc) * 4096;
        const bf16_t* GE = (const bf16_t*)(P->ws + (z ? WS_AS1 : WS_AS0)); bf16_t* YE = (bf16_t*)(P->ws + (z ? WS_ELOG1 : WS_ELOG0));
        bf16x8 sa[4][2];
#pragma unroll
        for (int vt = 0; vt < 4; ++vt)
#pragma unroll
            for (int ks = 0; ks < 2; ++ks) sa[vt][ks] = *(const bf16x8*)(sst + (16 * vt + l15) * 64 + 32 * ks + 8 * l4);
#pragma nounroll
        for (int tt = 0; tt < 16; ++tt) {
            const size_t orow = (size_t)scan_row(z, b, sc * 256 + tt * 16 + l15) * D + hh * 64;
            const bf16x8 g0 = *(const bf16x8*)(GE + orow + 8 * l4), g1 = *(const bf16x8*)(GE + orow + 32 + 8 * l4);
#pragma unroll
            for (int vt = 0; vt < 4; ++vt) { const u32x2 y0 = *(const u32x2*)(YE + orow + 16 * vt + 4 * l4);
                f32x4 acc = (f32x4){bf_lo(y0.x), bf_hi(y0.x), bf_lo(y0.y), bf_hi(y0.y)};
                acc = __builtin_amdgcn_mfma_f32_16x16x32_bf16(sa[vt][0], g0, acc, 0, 0, 0); acc = __builtin_amdgcn_mfma_f32_16x16x32_bf16(sa[vt][1], g1, acc, 0, 0, 0);
                u32x2 o; o.x = cvt_pk_bf16(acc[0], acc[1]); o.y = cvt_pk_bf16(acc[2], acc[3]); *(u32x2*)(YE + orow + 16 * vt + 4 * l4) = o; }
        }
    }
}

__device__ __forceinline__ void rwkv_out_phase(const Frame& F, KP P, int j) {
    const bf16_t* Y0 = (const bf16_t*)(P->ws + WS_ELOG0); const bf16_t* Y1 = (const bf16_t*)(P->ws + WS_ELOG1); const bf16_t* Rb = (const bf16_t*)(P->ws + WS_R); const bf16_t* Vb = (const bf16_t*)(P->ws + WS_VV);
    const bf16_t* KM0 = (const bf16_t*)(P->ws + WS_KM0); const bf16_t* KM1 = (const bf16_t*)(P->ws + WS_KM1); const bf16_t* GT = (const bf16_t*)(P->ws + WS_GATE); bf16_t* YG = (bf16_t*)(P->ws + WS_YG);
    const float* lng = P->in[I_LNG] + (size_t)j * D; const float* lnb = P->in[I_LNB] + (size_t)j * D; const float* rk = P->in[I_RK] + (size_t)j * D;
    for (int row = F.gw; row < T; row += F.NGW) {
        const size_t o = (size_t)row * D + 16 * F.lane; float y[16], r[16], km[16], v[16], g[16];
#pragma unroll
        for (int hx = 0; hx < 2; ++hx) { const u32x4 a = *(const u32x4*)(Y0 + o + 8 * hx), b = *(const u32x4*)(Y1 + o + 8 * hx), c = *(const u32x4*)(Rb + o + 8 * hx), d = *(const u32x4*)(KM0 + o + 8 * hx),
                e = *(const u32x4*)(KM1 + o + 8 * hx), f = *(const u32x4*)(Vb + o + 8 * hx), gg = *(const u32x4*)(GT + o + 8 * hx);
            const unsigned aw[4] = {a.x, a.y, a.z, a.w}, bw[4] = {b.x, b.y, b.z, b.w}, cw[4] = {c.x, c.y, c.z, c.w}, dw[4] = {d.x, d.y, d.z, d.w}, ew[4] = {e.x, e.y, e.z, e.w}, fw[4] = {f.x, f.y, f.z, f.w}, gw4[4] = {gg.x, gg.y, gg.z, gg.w};
#pragma unroll
            for (int i = 0; i < 8; ++i) { const int q = i >> 1; const bool od = i & 1;
                y[8 * hx + i] = (od ? bf_hi(aw[q]) : bf_lo(aw[q])) + (od ? bf_hi(bw[q]) : bf_lo(bw[q])); r[8 * hx + i] = od ? bf_hi(cw[q]) : bf_lo(cw[q]);
                km[8 * hx + i] = (od ? bf_hi(dw[q]) : bf_lo(dw[q])) + (od ? bf_hi(ew[q]) : bf_lo(ew[q])); v[8 * hx + i] = od ? bf_hi(fw[q]) : bf_lo(fw[q]); g[8 * hx + i] = od ? bf_hi(gw4[q]) : bf_lo(gw4[q]); } }
        float s = 0.f, bn = 0.f;
#pragma unroll
        for (int i = 0; i < 16; ++i) { s += y[i]; bn += r[i] * rk[16 * F.lane + i] * km[i]; }
        s += __shfl_xor(s, 1); s += __shfl_xor(s, 2); bn += __shfl_xor(bn, 1); bn += __shfl_xor(bn, 2);
        const float mean = s * (1.0f / 64.0f); float q = 0.f;
#pragma unroll
        for (int i = 0; i < 16; ++i) { const float d = y[i] - mean; q += d * d; }
        q += __shfl_xor(q, 1); q += __shfl_xor(q, 2);
        const float rstd = rsqrtf(q * (1.0f / 64.0f) + 64e-5f);
        float ov[16];
#pragma unroll
        for (int i = 0; i < 16; ++i) { const int cix = 16 * F.lane + i; ov[i] = (((y[i] - mean) * rstd) * lng[cix] + lnb[cix] + bn * v[i]) * g[i]; }
#pragma unroll
        for (int hx = 0; hx < 2; ++hx) { u32x4 w; w.x = cvt_pk_bf16(ov[8 * hx], ov[8 * hx + 1]); w.y = cvt_pk_bf16(ov[8 * hx + 2], ov[8 * hx + 3]); w.z = cvt_pk_bf16(ov[8 * hx + 4], ov[8 * hx + 5]); w.w = cvt_pk_bf16(ov[8 * hx + 6], ov[8 * hx + 7]);
            *(u32x4*)(YG + o + 8 * hx) = w; }
    }
}

__device__ __forceinline__ bool in_range(int lo, int hi, int k) { asm volatile("" : "+s"(lo), "+s"(hi)); return lo <= k && k < hi; }
constexpr int NPH = 48;
template <unsigned KMASK> __global__ void __launch_bounds__(NTHR, 2) mega(Params Pv) {
    extern __shared__ __attribute__((aligned(16))) unsigned char lds_raw[];
    Frame F0; F0.lds = (LAS unsigned char*)lds_raw; F0.tid = threadIdx.x; F0.lane = F0.tid & 63; F0.wave = __builtin_amdgcn_readfirstlane(F0.tid >> 6);
    F0.G = gridDim.x; F0.gw = blockIdx.x * NWAVES + F0.wave; F0.NGW = F0.G * NWAVES;
    LAS unsigned* misc = (LAS unsigned*)(F0.lds + LDS_MISC);
    if (F0.tid < 128) misc[F0.tid] = 0u;
    __syncthreads();
    KP P0 = (KP)__builtin_amdgcn_kernarg_segment_ptr();
    constexpr bool ALL = (KMASK == 0x3ffffu);
    const int lo = ALL ? 0 : P0->ph_lo, hi = ALL ? NPH : P0->ph_hi;
    XcdBarrier bar; bar.bar = (unsigned*)(P0->ws + WS_CTL) + CW_BAR; bar.x = 0; bar.st = (volatile LAS unsigned*)(misc + 8);
    if (ALL || hi - lo > 1) bar = xcd_barrier_post((unsigned*)(P0->ws + WS_CTL) + CW_BAR, (volatile LAS unsigned*)(misc + 8));
#define IN(k) (ALL || in_range(lo, hi, (k)))
#define KIND(q) ((KMASK >> (q)) & 1u)
#define SEAM(k) do { if (IN(k) && IN((k) + 1)) xcd_barrier(bar); } while (0)
#define AMP_T0 const unsigned long long amp_t0 = AMP_MASK ? __builtin_amdgcn_s_memrealtime() : 0ull;
#define AMP_END(kind) do { if (AMP_MASK & (1u << (kind))) { const unsigned long long t1_ = __builtin_amdgcn_s_memrealtime(), dl_ = t1_ + AMP_F * (t1_ - amp_t0); while (__builtin_amdgcn_s_memrealtime() < dl_) __builtin_amdgcn_s_sleep(8); } } while (0)
#define PHASE_ENTRY AMP_T0 KP P = P0; asm volatile("" : "+s"(P)); unsigned char* ws = P->ws; unsigned* ctl = (unsigned*)(ws + WS_CTL); (void)ctl; \
    Frame F = F0; { int t_ = F0.tid; asm volatile("" : "+v"(t_)); F.tid = t_; F.lane = t_ & 63; F.wave = __builtin_amdgcn_readfirstlane(t_ >> 6); F.gw = blockIdx.x * NWAVES + F.wave; }

    if constexpr (KIND(0)) if (IN(0)) { PHASE_ENTRY prologue_phase(F, P); AMP_END(0); }
    SEAM(0);
    for (int lp = 0; lp < 2; ++lp) {
        const int pb = 1 + 23 * lp, la = 2 * lp, lb = 2 * lp + 1;
        if constexpr (KIND(1)) if (IN(pb + 0)) { PHASE_ENTRY norm1_phase(F, P, la); AMP_END(1); }
        SEAM(pb + 0);
        if constexpr (KIND(2)) if (IN(pb + 1)) { PHASE_ENTRY
            __syncthreads(); set_desc(F.lds, 0, ws + WS_HL, ws + WS_WIN + (size_t)lp * 4096 * D * 2, ws + WS_U, 16, 0, 0, ws + WS_V, P->in[I_GBIN] + (size_t)lp * 4096, ws + WS_STAT); __syncthreads();
            SchedMulti<D, D> S{F.lds, T / 256, 16, 1};
            EpiGelu E{F.lds};
            pg8::gemm_phase<EpiGelu, SchedMulti<D, D>, false, D, D, D>(F.lds, S, E);
            AMP_END(2); }
        SEAM(pb + 1);
        if constexpr (KIND(3)) if (IN(pb + 2)) { PHASE_ENTRY spatial_phase(F, P, lp); AMP_END(3); }
        SEAM(pb + 2);
        if constexpr (KIND(4)) if (IN(pb + 3)) { PHASE_ENTRY
            __syncthreads();
            { float* X = (float*)(ws + WS_X);
              set_desc(F.lds, 0, ws + WS_U, ws + WS_WOUT + (size_t)lp * D * GWID * 2, X, 4, 0, 0, la == 0 ? P->in[I_X] : X, la == 0 ? P->in[I_CTX] : X + (size_t)TL * D, P->in[I_GBOUT] + (size_t)lp * D);
              set_desc(F.lds, 1, nullptr, nullptr, nullptr, 0, 0, 0, (const float*)(ws + WS_MOD) + (size_t)la * 3 * 6 * D + 2 * D); }
            __syncthreads();
            SchedMulti<GWID, GWID> S{F.lds, T / 256, 4, 1};
            EpiResid E{F.lds};
            pg8::gemm_phase<EpiResid, SchedMulti<GWID, GWID>, false, GWID, GWID, GWID>(F.lds, S, E);
            AMP_END(4); }
        SEAM(pb + 3);
        if constexpr (KIND(5)) if (IN(pb + 4)) { PHASE_ENTRY norm2_phase(F, P, la); AMP_END(5); }
        SEAM(pb + 4);
        if constexpr (KIND(16)) if (IN(pb + 5)) { PHASE_ENTRY
            __syncthreads(); set_desc(F.lds, 0, ws + WS_HL, ws + WS_WRT + (size_t)la * 256 * D * 2, nullptr, 1, 0, 0); __syncthreads();
            SchedMulti<D, D> S{F.lds, (la == DEPTH - 1 ? TL : T) / 256, 1, 1};
            EpiLogits E{(float*)(ws + WS_LG)};
            pg8::gemm_phase<EpiLogits, SchedMulti<D, D>, false, D, D, D>(F.lds, S, E);
            AMP_END(16); }
        SEAM(pb + 5);
        if constexpr (KIND(17)) if (IN(pb + 6)) { PHASE_ENTRY route_phase(F, P, la); AMP_END(17); }
        SEAM(pb + 6);
        if constexpr (KIND(6)) if (IN(pb + 7)) { PHASE_ENTRY
            moe_tables(F.lds, ctl + CW_CNT + la * 64);
            SchedMoE<D, D, true> S{F.lds, (const char*)(ws + WS_HL), (const char*)(ws + WS_WGU), (const int*)(ws + WS_LIST)};
            EpiSiluGate E{(bf16_t*)(ws + WS_H)};
            pg8::gemm_phase<EpiSiluGate, SchedMoE<D, D, true>, true, D, D, D>(F.lds, S, E);
            AMP_END(6); }
        SEAM(pb + 7);
        if constexpr (KIND(7)) if (IN(pb + 8)) { PHASE_ENTRY
            moe_tables(F.lds, ctl + CW_CNT + la * 64);
            SchedMoE<EHID, EHID, false> S{F.lds, (const char*)(ws + WS_H), (const char*)(ws + WS_WD), (const int*)(ws + WS_LIST)};
            EpiScatter E{F.lds, (bf16_t*)(ws + WS_YB), (const int*)(ws + WS_LIST)};
            pg8::gemm_phase<EpiScatter, SchedMoE<EHID, EHID, false>, false, EHID, EHID, EHID>(F.lds, S, E);
            AMP_END(7); }
        SEAM(pb + 8);
        if constexpr (KIND(1)) if (IN(pb + 9)) { PHASE_ENTRY norm1_phase(F, P, lb); AMP_END(1); }
        SEAM(pb + 9);
        if constexpr (KIND(8)) if (IN(pb + 10)) { PHASE_ENTRY mix_phase(F, P, lp); AMP_END(8); }
        SEAM(pb + 10);
        if constexpr (KIND(9)) if (IN(pb + 11)) { PHASE_ENTRY
            __syncthreads();
            set_desc(F.lds, 0, ws + WS_XR, ws + WS_WR + (size_t)lp * D * D * 2, ws + WS_R, 4, D, 0);
            set_desc(F.lds, 1, ws + WS_XK, ws + WS_WK + (size_t)lp * D * D * 2, ws + WS_K, 4, D, 0);
            set_desc(F.lds, 2, ws + WS_XV, ws + WS_WV + (size_t)lp * D * D * 2, ws + WS_VV, 4, D, 0);
            set_desc(F.lds, 3, ws + WS_XW, ws + WS_LW1 + (size_t)lp * 256 * D * 2, ws + WS_TW, 1, 256, 1);
            set_desc(F.lds, 4, ws + WS_XA, ws + WS_LA1 + (size_t)lp * 256 * D * 2, ws + WS_TA, 1, 256, 0);
            set_desc(F.lds, 5, ws + WS_XG, ws + WS_LG1 + (size_t)lp * 256 * D * 2, ws + WS_TG, 1, 256, 2);
            __syncthreads();
            SchedMulti<D, D> S{F.lds, T / 256, 15, 6};
            EpiAct E{F.lds};
            pg8::gemm_phase<EpiAct, SchedMulti<D, D>, false, D, D, D>(F.lds, S, E);
            AMP_END(9); }
        SEAM(pb + 11);
        if constexpr (KIND(10)) if (IN(pb + 12)) { PHASE_ENTRY
            __syncthreads();
            set_desc(F.lds, 0, ws + WS_TW, ws + WS_W2P + ((size_t)lp * 2 + 0) * D * 256 * 2, ws + WS_ELOG0, 4, D, 0, P->in[I_W0] + (size_t)lp * 2 * D, nullptr);
            set_desc(F.lds, 1, ws + WS_TW, ws + WS_W2P + ((size_t)lp * 2 + 1) * D * 256 * 2, ws + WS_ELOG1, 4, D, 1, P->in[I_W0] + (size_t)lp * 2 * D + D, nullptr);
            set_desc(F.lds, 2, ws + WS_TA, ws + WS_A2P + ((size_t)lp * 2 + 0) * D * 256 * 2, ws + WS_KM0, 4, D, 2, P->in[I_A0] + (size_t)lp * 2 * D, ws + WS_AS0);
            set_desc(F.lds, 3, ws + WS_TA, ws + WS_A2P + ((size_t)lp * 2 + 1) * D * 256 * 2, ws + WS_KM1, 4, D, 3, P->in[I_A0] + (size_t)lp * 2 * D + D, ws + WS_AS1);
            set_desc(F.lds, 4, ws + WS_TG, ws + WS_G2P + (size_t)lp * D * 256 * 2, ws + WS_GATE, 4, D, 4);
            set_desc(F.lds, 5, nullptr, nullptr, nullptr, 0, 0, 0, P->in[I_KA] + (size_t)lp * D, ws + WS_K);
            __syncthreads();
            SchedMulti<256, 256> S{F.lds, T / 256, 20, 5};
            EpiLora2 E{F.lds};
            pg8::gemm_phase<EpiLora2, SchedMulti<256, 256>, false, 256, 256, 256>(F.lds, S, E);
            AMP_END(10); }
        SEAM(pb + 12);
        if constexpr (KIND(11)) if (IN(pb + 13)) { PHASE_ENTRY scan_chunk_phase(F, P, lp); AMP_END(11); }
        SEAM(pb + 13);
        if constexpr (KIND(14)) if (IN(pb + 14)) { PHASE_ENTRY scan_carry_phase(F, P); AMP_END(14); }
        SEAM(pb + 14);
        if constexpr (KIND(15)) if (IN(pb + 15)) { PHASE_ENTRY scan_fix_phase(F, P); AMP_END(15); }
        SEAM(pb + 15);
        if constexpr (KIND(12)) if (IN(pb + 16)) { PHASE_ENTRY rwkv_out_phase(F, P, lp); AMP_END(12); }
        SEAM(pb + 16);
        if constexpr (KIND(4)) if (IN(pb + 17)) { PHASE_ENTRY
            __syncthreads();
            { float* X = (float*)(ws + WS_X);
              set_desc(F.lds, 0, ws + WS_YG, ws + WS_WO + (size_t)lp * D * D * 2, X, 4, 0, 0, X, X + (size_t)TL * D, nullptr);
              set_desc(F.lds, 1, nullptr, nullptr, nullptr, 0, 0, 0, (const float*)(ws + WS_MOD) + (size_t)lb * 3 * 6 * D + 2 * D); }
            __syncthreads();
            SchedMulti<D, D> S{F.lds, T / 256, 4, 1};
            EpiResid E{F.lds};
            pg8::gemm_phase<EpiResid, SchedMulti<D, D>, false, D, D, D>(F.lds, S, E);
            AMP_END(4); }
        SEAM(pb + 17);
        if constexpr (KIND(5)) if (IN(pb + 18)) { PHASE_ENTRY norm2_phase(F, P, lb); AMP_END(5); }
        SEAM(pb + 18);
        if constexpr (KIND(16)) if (IN(pb + 19)) { PHASE_ENTRY
            __syncthreads(); set_desc(F.lds, 0, ws + WS_HL, ws + WS_WRT + (size_t)lb * 256 * D * 2, nullptr, 1, 0, 0); __syncthreads();
            SchedMulti<D, D> S{F.lds, (lb == DEPTH - 1 ? TL : T) / 256, 1, 1};
            EpiLogits E{(float*)(ws + WS_LG)};
            pg8::gemm_phase<EpiLogits, SchedMulti<D, D>, false, D, D, D>(F.lds, S, E);
            AMP_END(16); }
        SEAM(pb + 19);
        if constexpr (KIND(17)) if (IN(pb + 20)) { PHASE_ENTRY route_phase(F, P, lb); AMP_END(17); }
        SEAM(pb + 20);
        if constexpr (KIND(6)) if (IN(pb + 21)) { PHASE_ENTRY
            moe_tables(F.lds, ctl + CW_CNT + lb * 64);
            SchedMoE<D, D, true> S{F.lds, (const char*)(ws + WS_HL), (const char*)(ws + WS_WGU), (const int*)(ws + WS_LIST)};
            EpiSiluGate E{(bf16_t*)(ws + WS_H)};
            pg8::gemm_phase<EpiSiluGate, SchedMoE<D, D, true>, true, D, D, D>(F.lds, S, E);
            AMP_END(6); }
        SEAM(pb + 21);
        if constexpr (KIND(7)) if (IN(pb + 22)) { PHASE_ENTRY
            moe_tables(F.lds, ctl + CW_CNT + lb * 64);
            SchedMoE<EHID, EHID, false> S{F.lds, (const char*)(ws + WS_H), (const char*)(ws + WS_WD), (const int*)(ws + WS_LIST)};
            EpiScatter E{F.lds, (bf16_t*)(ws + WS_YB), (const int*)(ws + WS_LIST)};
            pg8::gemm_phase<EpiScatter, SchedMoE<EHID, EHID, false>, false, EHID, EHID, EHID>(F.lds, S, E);
            AMP_END(7); }
        SEAM(pb + 22);
    }
    if constexpr (KIND(13)) if (IN(47)) { PHASE_ENTRY final_phase(F, P); AMP_END(13); }
#undef IN
#undef KIND
#undef SEAM
#undef PHASE_ENTRY
}

#if !MK_ONE_LAUNCH
static int phase_kind(int ph) { if (ph == 0) return 0; if (ph == 47) return 13; static const int k23[23] = {1, 2, 3, 4, 5, 16, 17, 6, 7, 1, 8, 9, 10, 11, 14, 15, 12, 4, 5, 16, 17, 6, 7}; return k23[(ph - 1) % 23]; }
typedef void (*kern_t)(Params);
template <unsigned KM> static kern_t kern_of() { return mega<KM>; }
static kern_t kind_kernel(int kind) {
    switch (kind) { case 0: return kern_of<1u << 0>(); case 1: return kern_of<1u << 1>(); case 2: return kern_of<1u << 2>(); case 3: return kern_of<1u << 3>(); case 4: return kern_of<1u << 4>();
        case 5: return kern_of<1u << 5>(); case 6: return kern_of<1u << 6>(); case 7: return kern_of<1u << 7>(); case 8: return kern_of<1u << 8>(); case 9: return kern_of<1u << 9>();
        case 10: return kern_of<1u << 10>(); case 11: return kern_of<1u << 11>(); case 12: return kern_of<1u << 12>(); case 14: return kern_of<1u << 14>(); case 15: return kern_of<1u << 15>(); case 16: return kern_of<1u << 16>(); case 17: return kern_of<1u << 17>(); default: return kern_of<1u << 13>(); }
}
#endif
extern "C" void kernel_launch(void* const* d_in, const int* in_sizes, int n_in, void* d_out, int out_size, void* d_ws, size_t ws_size, hipStream_t stream) {
    static int grid = 0;
    if (grid == 0) {
        if (n_in != 42 || out_size != TL * D || ws_size < WS_END) { fprintf(stderr, "kernel_launch: unexpected problem (n_in %d, out %d, ws %zu < %zu)\n", n_in, out_size, ws_size, (size_t)WS_END); grid = -1; return; }
        int dev = 0, cus = 0;
        if (hipGetDevice(&dev) != hipSuccess || hipDeviceGetAttribute(&cus, hipDeviceAttributeMultiprocessorCount, dev) != hipSuccess) { grid = -1; return; }
#if MK_ONE_LAUNCH
        if (hipFuncSetAttribute((const void*)mega<0x3ffffu>, hipFuncAttributeMaxDynamicSharedMemorySize, LDS_BYTES) != hipSuccess) { fprintf(stderr, "kernel_launch: hipFuncSetAttribute failed\n"); grid = -1; return; }
#else
        for (int k = 0; k < 18; ++k) if (hipFuncSetAttribute((const void*)kind_kernel(k), hipFuncAttributeMaxDynamicSharedMemorySize, LDS_BYTES) != hipSuccess) { fprintf(stderr, "kernel_launch: hipFuncSetAttribute failed\n"); grid = -1; return; }
#endif
        (void)hipGetLastError();
        grid = cus;
    }
    if (grid < 0) return;
    (void)hipMemsetAsync((char*)d_ws + WS_CTL, 0, CTL_BYTES, stream);
    Params p{};
    for (int i = 0; i < 42; ++i) p.in[i] = (const float*)d_in[i];
    p.out = (float*)d_out; p.ws = (unsigned char*)d_ws;
#if MK_ONE_LAUNCH
    p.ph_lo = 0; p.ph_hi = NPH;
    hipLaunchKernelGGL(mega<0x3ffffu>, dim3(grid), dim3(NTHR), LDS_BYTES, stream, p);
#else
    for (int ph = 0; ph < NPH; ++ph) { p.ph_lo = ph; p.ph_hi = ph + 1; hipLaunchKernelGGL(kind_kernel(phase_kind(ph)), dim3(grid), dim3(NTHR), LDS_BYTES, stream, p); }
#endif
}
```

```cpp
#include <hip/hip_runtime.h>
#include <cstdio>
#include <cstdint>

#define LAS __attribute__((address_space(3)))
typedef unsigned short bf16_t;
typedef short bf16x8 __attribute__((ext_vector_type(8)));
typedef float f32x4 __attribute__((ext_vector_type(4)));
typedef float f32x2 __attribute__((ext_vector_type(2)));
typedef unsigned u32x4 __attribute__((ext_vector_type(4)));
typedef unsigned u32x2 __attribute__((ext_vector_type(2)));

#ifndef AMP_MASK
#define AMP_MASK 0u
#endif
#define AMP_F 4
#ifndef MK_ONE_LAUNCH
#define MK_ONE_LAUNCH 1
#endif

constexpr int D = 1024, NBATCH = 2, SEQ = 16384, CTXL = 256, DEPTH = 4;
constexpr int TL = NBATCH * SEQ, TC = NBATCH * CTXL, T = TL + TC;
constexpr int GWID = 2048, NE = 32, EHID = 512, NH = 16, HD = 64;
constexpr int LISTCAP = T;
constexpr int MAXRT = (2 * T) / 256 + NE;
constexpr int NWAVES = 8, NTHR = 512;

constexpr size_t MiB = 1u << 20;
constexpr size_t WS_CTL = 0, CTL_BYTES = 1 * MiB;
constexpr size_t WS_MOD = 1 * MiB;
constexpr size_t WS_WIN = 2 * MiB, WS_WOUT = 18 * MiB, WS_WSP = 26 * MiB, WS_WR = 27 * MiB, WS_WK = 31 * MiB, WS_WV = 35 * MiB, WS_WO = 39 * MiB;
constexpr size_t WS_LW1 = 43 * MiB, WS_LA1 = 44 * MiB, WS_LG1 = 45 * MiB, WS_W2P = 46 * MiB, WS_A2P = 48 * MiB, WS_G2P = 50 * MiB;
constexpr size_t WS_WRT = 52 * MiB;
constexpr size_t WS_WGU = 54 * MiB, WS_WD = 118 * MiB;
constexpr size_t WS_X = 150 * MiB;
constexpr size_t WS_LIST = 280 * MiB, WS_WGT = 285 * MiB;
constexpr size_t WS_HL = 286 * MiB;
constexpr size_t WS_BIG = 351 * MiB;
constexpr size_t SZB = 65 * MiB;
constexpr size_t WS_U = WS_BIG, WS_V = WS_BIG + 2 * SZB, WS_STAT = WS_BIG + 4 * SZB;
constexpr size_t WS_XR = WS_BIG, WS_XW = WS_BIG + SZB, WS_XK = WS_BIG + 2 * SZB, WS_XV = WS_BIG + 3 * SZB, WS_XA = WS_BIG + 4 * SZB, WS_XG = WS_BIG + 5 * SZB;
constexpr size_t WS_R = WS_BIG + 6 * SZB, WS_K = WS_BIG + 7 * SZB, WS_VV = WS_BIG + 8 * SZB;
constexpr size_t WS_TW = WS_BIG + 9 * SZB, WS_TA = WS_TW + 17 * MiB, WS_TG = WS_TA + 17 * MiB;
constexpr size_t WS_ELOG0 = WS_XR, WS_ELOG1 = WS_XW, WS_KM0 = WS_XK, WS_KM1 = WS_XV, WS_AS0 = WS_XA, WS_AS1 = WS_XG;
constexpr size_t WS_GATE = WS_HL, WS_YG = WS_AS0;
constexpr size_t WS_H = WS_BIG, WS_YB = WS_BIG + 73 * MiB, WS_LG = WS_BIG + 204 * MiB;
constexpr size_t WS_PQ = WS_TW;
constexpr size_t WS_SST = WS_WGU;
constexpr size_t WS_END = WS_PQ + 131 * MiB;
static_assert(WS_END <= 1080 * MiB, "workspace map");
constexpr int CW_BAR = 4096;
constexpr int CW_CNT = 16384;

typedef __bf16 bf16x2_t __attribute__((ext_vector_type(2)));
__device__ __forceinline__ unsigned cvt_pk_bf16(float lo, float hi) { const bf16x2_t v = __builtin_convertvector((f32x2){lo, hi}, bf16x2_t); return __builtin_bit_cast(unsigned, v); }
__device__ __forceinline__ float bf_lo(unsigned u) { return __uint_as_float(u << 16); }
__device__ __forceinline__ float bf_hi(unsigned u) { return __uint_as_float(u & 0xffff0000u); }
__device__ __forceinline__ float bf1(bf16_t b) { return __uint_as_float(((unsigned)b) << 16); }
__device__ __forceinline__ bf16_t f2bf(float f) { return (bf16_t)(cvt_pk_bf16(f, 0.f) & 0x3ffffu); }
__device__ __forceinline__ void unpack8(const u32x4& w, float (&f)[8]) { f[0] = bf_lo(w.x); f[1] = bf_hi(w.x); f[2] = bf_lo(w.y); f[3] = bf_hi(w.y); f[4] = bf_lo(w.z); f[5] = bf_hi(w.z); f[6] = bf_lo(w.w); f[7] = bf_hi(w.w); }
__device__ __forceinline__ u32x4 pack8(const float (&f)[8]) { u32x4 o; o.x = cvt_pk_bf16(f[0], f[1]); o.y = cvt_pk_bf16(f[2], f[3]); o.z = cvt_pk_bf16(f[4], f[5]); o.w = cvt_pk_bf16(f[6], f[7]); return o; }
__device__ __forceinline__ float wave_sum(float v) {
#pragma unroll
    for (int o = 1; o < 64; o <<= 1) v += __shfl_xor(v, o);
    return v;
}
__device__ __forceinline__ float sigmoidf_(float x) { return 1.0f / (1.0f + __expf(-x)); }
__device__ __forceinline__ float tanhf_(float x) { const float e = __expf(2.0f * x); return 1.0f - 2.0f / (e + 1.0f); }
__device__ __forceinline__ f32x2 gelu_pk(f32x2 v) {
    const f32x2 av = __builtin_elementwise_abs(v), d = av * 0.2316418882f + 1.0f;
    f32x2 t; t.x = __builtin_amdgcn_rcpf(d.x); t.y = __builtin_amdgcn_rcpf(d.y);
    f32x2 q = t * 0.5307027145f + (-0.7265760135f); q = q * t + 0.7107068705f; q = q * t + (-0.142248368f); q = q * t + 0.127414796f; q = q * t;
    const f32x2 s = (v * v) * (-0.72134752044f);
    f32x2 e; e.x = __builtin_amdgcn_exp2f(s.x); e.y = __builtin_amdgcn_exp2f(s.y);
    const f32x2 m = v * (q * e), r = v - m;
    f32x2 o; o.x = v.x < 0.f ? m.x : r.x; o.y = v.y < 0.f ? m.y : r.y; return o;
}

#define XB_TMO      128
#define XB_XCNT(j)  (256  + 64 * (j))
#define XB_XSUB(j)  (1280 + 64 * (j))
#define XB_XGEN(j)  (2304 + 64 * (j))
#define XB_TOP      3328
#define XB_TOPGEN   3392
#define XCD_BAR_WORDS 3456
#define XB_SPIN_CAP (1u << 18)
__device__ __forceinline__ unsigned xb_ld(unsigned* p)              { return __hip_atomic_load(p, __ATOMIC_RELAXED, __HIP_MEMORY_SCOPE_AGENT); }
__device__ __forceinline__ unsigned xb_add(unsigned* p, unsigned v) { return __hip_atomic_fetch_add(p, v, __ATOMIC_RELAXED, __HIP_MEMORY_SCOPE_AGENT); }
__device__ __forceinline__ unsigned xb_xcc_id() { return (unsigned)__builtin_amdgcn_s_getreg((3 << 11) | 20) & 0xFu; }
#define XB_SPIN(cond, bar) do { unsigned _sp = 0; while (cond) { __builtin_amdgcn_s_sleep(1); \
    if ((++_sp & 255u) == 0u) { if (xb_ld(&(bar)[XB_TMO])) break; if (_sp > XB_SPIN_CAP) { atomicAdd(&(bar)[XB_TMO], 1u); break; } } } } while (0)
struct XcdBarrier { unsigned* bar; unsigned x; volatile LAS unsigned* st; };
__device__ __forceinline__ XcdBarrier xcd_barrier_post(unsigned* bar, volatile LAS unsigned* st) {
    XcdBarrier b; b.bar = bar; b.x = xb_xcc_id(); b.st = st;
    if (threadIdx.x == 0) (void)xb_add(&bar[XB_XCNT(b.x)], 1u);
    return b;
}
__device__ __forceinline__ void xcd_barrier_complete(unsigned* bar, unsigned x, unsigned& nloc, unsigned& nx) {
    const unsigned G = gridDim.x * gridDim.y * gridDim.z;
    unsigned sum, cnt, mine, sp = 0u;
    for (;;) {
        sum = 0u; cnt = 0u; mine = 0u;
#pragma unroll
        for (unsigned j = 0; j < 16; ++j) { const unsigned c = xb_ld(&bar[XB_XCNT(j)]); sum += c; cnt += (c > 0u) ? 1u : 0u; mine = (j == x) ? c : mine; }
        if (sum == G) break;
        __builtin_amdgcn_s_sleep(1);
        if ((++sp & 255u) == 0u) { if (xb_ld(&bar[XB_TMO])) break; if (sp > XB_SPIN_CAP) { atomicAdd(&bar[XB_TMO], 1u); break; } }
    }
    nloc = mine > 0u ? mine : 1u; nx = cnt > 0u ? cnt : 1u;
}
__device__ __forceinline__ void xcd_barrier(const XcdBarrier& b) {
    asm volatile("s_waitcnt vmcnt(0)" ::: "memory");
    __syncthreads();
    if (threadIdx.x == 0) {
        unsigned* bar = b.bar;
        __builtin_amdgcn_s_waitcnt(0);
        unsigned nloc = b.st[0], nx = b.st[1];
        if (nloc == 0u) { xcd_barrier_complete(bar, b.x, nloc, nx); b.st[0] = nloc; b.st[1] = nx; }
        const unsigned old = xb_add(&bar[XB_XSUB(b.x)], 1u);
        const unsigned gen = old / nloc;
        if (old + 1u == (gen + 1u) * nloc) {
            __builtin_amdgcn_fence(__ATOMIC_RELEASE, "agent");
            asm volatile("s_waitcnt vmcnt(0)" ::: "memory");
            const unsigned og = xb_add(&bar[XB_TOP], 1u);
            const unsigned tg = og / nx;
            if (og + 1u == (tg + 1u) * nx) xb_add(&bar[XB_TOPGEN], 1u);
            else XB_SPIN(xb_ld(&bar[XB_TOPGEN]) == tg, bar);
            __builtin_amdgcn_fence(__ATOMIC_ACQUIRE, "agent");
            xb_add(&bar[XB_XGEN(b.x)], 1u);
            asm volatile("s_waitcnt vmcnt(0)" ::: "memory");
        } else {
            XB_SPIN(xb_ld(&bar[XB_XGEN(b.x)]) == gen, bar);
            __builtin_amdgcn_fence(__ATOMIC_ACQUIRE, "agent");
            asm volatile("s_waitcnt vmcnt(0)" ::: "memory");
        }
    }
    __syncthreads();
}

constexpr int LDS_MISC = 143360;
constexpr int LDS_DESC = LDS_MISC + 128;
constexpr int LDS_TAB = LDS_MISC + 512;
constexpr int LDS_BYTES = 147456;
namespace pg8 {
constexpr int BM = 256, BK = 64, HALF = 128, HTB = HALF * BK * 2, STAGE_BYTES = 8 * HTB, NXCD = 8, WGM = 8;
__host__ __device__ __forceinline__ int lds_byte(int r, int c) { const int st = (r >> 4) * 2 + (c >> 5), rr = r & 15, cc = c & 31, ob = rr * 64 + cc * 2; return st * 1024 + (ob ^ (((ob >> 9) & 1) << 5)); }
__host__ __device__ __forceinline__ void stage_rc(int b, int& R, int& C) { const int st = b / 1024, sb = b % 1024, swz = sb ^ (((sb >> 9) & 1) << 5); R = (st >> 1) * 16 + swz / 64; C = (st & 1) * 32 + (swz % 64) / 2; }
__host__ __device__ __forceinline__ int perm32(int rho) { const int n = rho >> 4, i = rho & 15; return 8 * (i >> 2) + 4 * n + (i & 3); }
__device__ __forceinline__ int xcd_remap(int L, int nwg) { const int q = nwg / NXCD, r = nwg % NXCD, xcd = L % NXCD, off = L / NXCD; return (xcd < r ? xcd * (q + 1) : r * (q + 1) + (xcd - r) * q) + off; }

struct Unit { int pm, pn, aux; };

template <class Epi, class Sched, bool GATHER, int K, int LDA, int LDB>
__device__ __forceinline__ void gemm_phase(LAS unsigned char* lds, const Sched& S, const Epi& E) {
    int tid_ = threadIdx.x; asm volatile("" : "+v"(tid_));
    const int tid = tid_, wid = __builtin_amdgcn_readfirstlane(tid >> 6), lane = tid & 63, wr = wid >> 2, wc = wid & 3, fr = lane & 15, fq = lane >> 4;
    constexpr int nt = K / BK;
    unsigned voffA[2], voffB[2];
#pragma unroll
    for (int i = 0; i < 2; ++i) { int R, C; stage_rc(tid * 16 + i * 8192, R, C); const int Rb = Epi::PERM ? ((R & ~31) + perm32(R & 31)) : R;
        voffA[i] = (unsigned)(R * LDA + C) * 2u; voffB[i] = (unsigned)(Rb * LDB + C) * 2u; }
    constexpr size_t kstep = (size_t)(BK * 2);
    constexpr size_t hstepA = GATHER ? (size_t)0 : (size_t)HALF * LDA * 2, hstepB = (size_t)HALF * LDB * 2;
    const unsigned ldsw = (unsigned)wid * 1024u;
    const int aoff = lds_byte(wr * 64 + fr, fq * 8), boff = lds_byte(wc * 32 + fr, fq * 8);
    unsigned gA[2][2], gN[2][2];
#define PG8_SA(b, h) (((b) * 2 + (h)) * HTB)
#define PG8_SB(b, h) ((4 + (b) * 2 + (h)) * HTB)
#define PG8_STAGEB(bufoff, gbase) do { _Pragma("unroll") for (int _i = 0; _i < 2; ++_i) \
        __builtin_amdgcn_global_load_lds((const unsigned*)((const char*)(gbase) + voffB[_i]), (LAS unsigned*)(lds + (bufoff) + ldsw + _i * 8192), 16, 0, 0); } while (0)
#define PG8_STAGEA(bufoff, gbase, h, GV) do { _Pragma("unroll") for (int _i = 0; _i < 2; ++_i) \
        __builtin_amdgcn_global_load_lds((const unsigned*)((const char*)(gbase) + (GATHER ? GV[h][_i] : voffA[_i]) + (h) * hstepA), (LAS unsigned*)(lds + (bufoff) + ldsw + _i * 8192), 16, 0, 0); } while (0)
#define PG8_LDA(dst, b, h) do { _Pragma("unroll") for (int m = 0; m < 4; ++m) _Pragma("unroll") for (int k = 0; k < 2; ++k) dst[m][k] = *(const LAS bf16x8*)(lds + PG8_SA(b, h) + aoff + m * 2048 + k * 1024); } while (0)
#define PG8_LDB(dst, b, h) do { _Pragma("unroll") for (int n = 0; n < 2; ++n) _Pragma("unroll") for (int k = 0; k < 2; ++k) dst[n][k] = *(const LAS bf16x8*)(lds + PG8_SB(b, h) + boff + n * 2048 + k * 1024); } while (0)
#define PG8_MMA(ai, bj, At, Bt) do { __builtin_amdgcn_s_setprio(1); _Pragma("unroll") for (int m = 0; m < 4; ++m) _Pragma("unroll") for (int n = 0; n < 2; ++n) _Pragma("unroll") for (int k = 0; k < 2; ++k) \
        acc[ai][bj][m][n] = __builtin_amdgcn_mfma_f32_16x16x32_bf16(Bt[n][k], At[m][k], acc[ai][bj][m][n], 0, 0, 0); __builtin_amdgcn_s_setprio(0); } while (0)
#define PG8_WAIT_V(n) asm volatile("s_waitcnt vmcnt(" #n ")" ::: "memory")
#define PG8_WAIT_L(n) asm volatile("s_waitcnt lgkmcnt(" #n ")" ::: "memory")
#define PG8_BAR __builtin_amdgcn_s_barrier()
#define PG8_SCHED __builtin_amdgcn_sched_barrier(0)
    Unit cur, nxt; int ui = 0;
    if (!S.next(0, cur)) return;
    f32x4 acc[2][2][4][2];
#pragma unroll
    for (int a = 0; a < 2; ++a)
#pragma unroll
        for (int b = 0; b < 2; ++b)
#pragma unroll
            for (int m = 0; m < 4; ++m)
#pragma unroll
                for (int n = 0; n < 2; ++n) acc[a][b][m][n] = (f32x4){0.f, 0.f, 0.f, 0.f};
    bf16x8 At[4][2], B0[2][2], B1[2][2];
    const char* cA = S.aptr(cur); const char* cB = S.bptr(cur);
    if constexpr (GATHER) { S.gather(cur, tid, gA); }
    PG8_STAGEB(PG8_SB(0, 0), cB); PG8_STAGEB(PG8_SB(0, 1), cB + hstepB); PG8_STAGEA(PG8_SA(0, 0), cA, 0, gA); PG8_STAGEA(PG8_SA(0, 1), cA, 1, gA);
    if (wr == 1) PG8_BAR;
    PG8_WAIT_V(2); PG8_BAR;
    PG8_STAGEB(PG8_SB(1, 0), cB + kstep); PG8_STAGEA(PG8_SA(1, 0), cA + kstep, 0, gA); PG8_STAGEB(PG8_SB(1, 1), cB + hstepB + kstep);
    PG8_WAIT_V(6); PG8_BAR;
    for (;;) {
        const bool has_next = S.next(ui + 1, nxt);
        const char* nA = has_next ? S.aptr(nxt) : cA; const char* nB = has_next ? S.bptr(nxt) : cB;
        if constexpr (GATHER) { if (has_next) S.gather(nxt, tid, gN); else {
#pragma unroll
            for (int h = 0; h < 2; ++h)
#pragma unroll
                for (int i = 0; i < 2; ++i) gN[h][i] = gA[h][i]; } }
#pragma nounroll
        for (int t = 0; t < nt; t += 2) {
            const bool last = (t == nt - 2);
            const char* a1 = cA + (size_t)(t + 1) * kstep;
            const char* a2 = last ? nA : cA + (size_t)(t + 2) * kstep; const char* b2 = last ? nB : cB + (size_t)(t + 2) * kstep;
            const char* a3 = a2 + kstep; const char* b3 = b2 + kstep;
            unsigned g2[2][2];
            if constexpr (GATHER) {
#pragma unroll
                for (int h = 0; h < 2; ++h)
#pragma unroll
                    for (int i = 0; i < 2; ++i) g2[h][i] = last ? gN[h][i] : gA[h][i]; }
            PG8_LDB(B0, 0, 0); PG8_LDB(B1, 0, 1); PG8_SCHED; PG8_LDA(At, 0, 0); PG8_STAGEA(PG8_SA(1, 1), a1, 1, gA);
            PG8_WAIT_V(8); PG8_WAIT_L(0); PG8_BAR; PG8_MMA(0, 0, At, B0); PG8_MMA(0, 1, At, B1); PG8_BAR; PG8_SCHED;
            PG8_LDA(At, 0, 1); PG8_STAGEB(PG8_SB(0, 0), b2); PG8_STAGEB(PG8_SB(0, 1), b2 + hstepB); PG8_STAGEA(PG8_SA(0, 0), a2, 0, g2);
            PG8_WAIT_V(8); PG8_WAIT_L(0); PG8_BAR; PG8_MMA(1, 0, At, B0); PG8_MMA(1, 1, At, B1); PG8_BAR; PG8_SCHED;
            PG8_LDB(B0, 1, 0); PG8_LDB(B1, 1, 1); PG8_SCHED; PG8_LDA(At, 1, 0); PG8_STAGEA(PG8_SA(0, 1), a2, 1, g2);
            PG8_WAIT_V(8); PG8_WAIT_L(0); PG8_BAR; PG8_MMA(0, 0, At, B0); PG8_MMA(0, 1, At, B1); PG8_BAR; PG8_SCHED;
            PG8_LDA(At, 1, 1); PG8_STAGEB(PG8_SB(1, 0), b3); PG8_STAGEB(PG8_SB(1, 1), b3 + hstepB); PG8_STAGEA(PG8_SA(1, 0), a3, 0, g2);
            PG8_WAIT_V(8); PG8_WAIT_L(0); PG8_BAR; PG8_MMA(1, 0, At, B0); PG8_MMA(1, 1, At, B1); PG8_BAR; PG8_SCHED;
        }
        if (wr == 0) PG8_BAR;
        E(acc, cur, wr, wc, fr, fq);
        if (!has_next) break;
#pragma unroll
        for (int a = 0; a < 2; ++a)
#pragma unroll
            for (int b = 0; b < 2; ++b)
#pragma unroll
                for (int m = 0; m < 4; ++m)
#pragma unroll
                    for (int n = 0; n < 2; ++n) acc[a][b][m][n] = (f32x4){0.f, 0.f, 0.f, 0.f};
        cur = nxt; cA = nA; cB = nB; ++ui;
        if constexpr (GATHER) {
#pragma unroll
            for (int h = 0; h < 2; ++h)
#pragma unroll
                for (int i = 0; i < 2; ++i) gA[h][i] = gN[h][i]; }
        if (wr == 1) PG8_BAR;
    }
    PG8_WAIT_V(0);
    PG8_BAR;
#undef PG8_SA
#undef PG8_SB
#undef PG8_STAGEA
#undef PG8_STAGEB
#undef PG8_LDA
#undef PG8_LDB
#undef PG8_MMA
#undef PG8_WAIT_V
#undef PG8_WAIT_L
#undef PG8_BAR
#undef PG8_SCHED
}
}
using pg8::Unit;

__device__ __forceinline__ void set_desc(LAS unsigned char* lds, int g, const void* A, const void* B, const void* C, int nN, int ldc, int aux, const void* X1 = nullptr, const void* X2 = nullptr, const void* X3 = nullptr) {
    LAS int* d = (LAS int*)(lds + LDS_DESC) + g * 16;
    if (threadIdx.x == 0) { unsigned long long a = (unsigned long long)A, b = (unsigned long long)B, c = (unsigned long long)C, x1 = (unsigned long long)X1, x2 = (unsigned long long)X2, x3 = (unsigned long long)X3;
        asm volatile("" : "+s"(a), "+s"(b), "+s"(c), "+s"(x1), "+s"(x2), "+s"(x3), "+s"(nN), "+s"(ldc), "+s"(aux));
        d[0] = (int)(unsigned)a; d[1] = (int)(unsigned)(a >> 32); d[2] = (int)(unsigned)b; d[3] = (int)(unsigned)(b >> 32); d[4] = (int)(unsigned)c; d[5] = (int)(unsigned)(c >> 32); d[6] = nN; d[7] = ldc; d[8] = aux;
        d[10] = (int)(unsigned)x1; d[11] = (int)(unsigned)(x1 >> 32); d[12] = (int)(unsigned)x2; d[13] = (int)(unsigned)(x2 >> 32); d[14] = (int)(unsigned)x3; d[15] = (int)(unsigned)(x3 >> 32); }
}
__device__ __forceinline__ int desc_i(LAS unsigned char* lds, int g, int f) { return __builtin_amdgcn_readfirstlane(((LAS const int*)(lds + LDS_DESC))[g * 16 + f]); }
__device__ __forceinline__ const char* desc_p(LAS unsigned char* lds, int g, int f) {
    const unsigned lo = (unsigned)desc_i(lds, g, f), hi = (unsigned)desc_i(lds, g, f + 1); return (const char*)(((unsigned long long)hi << 32) | lo); }
template <int LDA, int LDB>
struct SchedMulti {
    LAS unsigned char* lds; int nM, ntot, ng;
    __device__ __forceinline__ bool next(int i, Unit& u) const {
        const int nwg = nM * ntot; const long L = (long)i * gridDim.x + blockIdx.x; if (L >= nwg) return false;
        const int wgid = pg8::xcd_remap((int)L, nwg);
        const int nig = pg8::WGM * ntot, gid = wgid / nig, fm = gid * pg8::WGM, gsz = (nM - fm) < pg8::WGM ? (nM - fm) : pg8::WGM;
        u.pm = fm + ((wgid % nig) % gsz); int pv = (wgid % nig) / gsz; int g = 0;
        for (int j = 0; j + 1 < ng; ++j) { const int n = desc_i(lds, j, 6); if (pv < n) break; pv -= n; g = j + 1; }
        u.pn = pv; u.aux = g; return true;
    }
    __device__ __forceinline__ const char* aptr(const Unit& u) const { return desc_p(lds, u.aux, 0) + (size_t)u.pm * (512 * LDA); }
    __device__ __forceinline__ const char* bptr(const Unit& u) const { return desc_p(lds, u.aux, 2) + (size_t)u.pn * (512 * LDB); }
};
template <int LDA, int LDB, bool GATHERED>
struct SchedMoE {
    LAS unsigned char* lds; const char* Abase; const char* Bbase; const int* list;
    __device__ __forceinline__ bool next(int i, Unit& u) const {
        LAS const int* tab = (LAS const int*)(lds + LDS_TAB);
        const int nrt = __builtin_amdgcn_readfirstlane(tab[2 * MAXRT + 32]);
        const int nwg = nrt * 4; const long L = (long)i * gridDim.x + blockIdx.x; if (L >= nwg) return false;
        const int wgid = pg8::xcd_remap((int)L, nwg);
        u.pm = wgid >> 2; u.pn = wgid & 3; u.aux = __builtin_amdgcn_readfirstlane(tab[u.pm]); return true;
    }
    __device__ __forceinline__ const char* aptr(const Unit& u) const { return GATHERED ? Abase : Abase + (size_t)u.pm * (512 * LDA); }
    __device__ __forceinline__ const char* bptr(const Unit& u) const { return Bbase + (size_t)u.aux * ((size_t)D * LDB * 2) + (size_t)u.pn * (512 * LDB); }
    __device__ __forceinline__ void gather(const Unit& u, int tid, unsigned (&g)[2][2]) const {
        LAS const int* tab = (LAS const int*)(lds + LDS_TAB);
        const int j0 = __builtin_amdgcn_readfirstlane(tab[MAXRT + u.pm]), cn = __builtin_amdgcn_readfirstlane(tab[2 * MAXRT + u.aux]);
#pragma unroll
        for (int i = 0; i < 2; ++i) { int R, C; pg8::stage_rc(tid * 16 + i * 8192, R, C);
#pragma unroll
            for (int h = 0; h < 2; ++h) { const int slot = j0 + 128 * h + R; const int a = slot < cn ? list[(size_t)u.aux * LISTCAP + slot] : 0;
                g[h][i] = (unsigned)((a >> 1) * LDA + C) * 2u; } }
    }
};
__device__ __forceinline__ void moe_tables(LAS unsigned char* lds, const unsigned* cnt) {
    LAS int* tab = (LAS int*)(lds + LDS_TAB);
    __syncthreads();
    if (threadIdx.x == 0) {
        int rt = 0;
#pragma nounroll
        for (int e = 0; e < NE; ++e) { const int c = (int)__hip_atomic_load(cnt + e, __ATOMIC_RELAXED, __HIP_MEMORY_SCOPE_AGENT); tab[2 * MAXRT + e] = c;
            const int nt = (c + 255) >> 8;
#pragma nounroll
            for (int j = 0; j < nt; ++j) { tab[rt] = e; tab[MAXRT + rt] = j * 256; ++rt; } }
        tab[2 * MAXRT + 32] = rt;
    }
    __syncthreads();
}

#define EPI_FENCE() asm volatile("" ::: "memory")
struct EpiGelu {
    static constexpr bool PERM = true;
    LAS unsigned char* lds;
    __device__ __forceinline__ void operator()(const f32x4 (&acc)[2][2][4][2], const Unit& u, int wr, int wc, int fr, int fq) const {
        const bool isv = u.pn >= 8; bf16_t* base = (bf16_t*)desc_p(lds, 0, isv ? 10 : 4); const float* bias = (const float*)desc_p(lds, 0, 12); float* stat = (float*)desc_p(lds, 0, 14);
        const int col0 = (u.pn & 7) * 256 + wc * 32 + 8 * fq, bcol0 = u.pn * 256 + wc * 32 + 8 * fq, row0 = u.pm * 256 + wr * 64 + fr;
        f32x4 bv[2][2];
#pragma unroll
        for (int bj = 0; bj < 2; ++bj)
#pragma unroll
            for (int n = 0; n < 2; ++n) bv[bj][n] = *(const f32x4*)(bias + bcol0 + bj * 128 + 4 * n);
#pragma unroll
        for (int ai = 0; ai < 2; ++ai)
#pragma unroll
            for (int m = 0; m < 4; ++m) { const int row = row0 + ai * 128 + m * 16; bf16_t* rowp = base + (size_t)row * GWID + col0; float s = 0.f, q = 0.f;
#pragma unroll
                for (int bj = 0; bj < 2; ++bj) { const f32x4 v0 = acc[ai][bj][m][0] + bv[bj][0], v1 = acc[ai][bj][m][1] + bv[bj][1];
                    const f32x2 a = gelu_pk((f32x2){v0[0], v0[1]}), b = gelu_pk((f32x2){v0[2], v0[3]}), c = gelu_pk((f32x2){v1[0], v1[1]}), d = gelu_pk((f32x2){v1[2], v1[3]});
                    s += ((a.x + a.y) + (b.x + b.y)) + ((c.x + c.y) + (d.x + d.y));
                    q += ((a.x * a.x + a.y * a.y) + (b.x * b.x + b.y * b.y)) + ((c.x * c.x + c.y * c.y) + (d.x * d.x + d.y * d.y));
                    u32x4 w; w.x = cvt_pk_bf16(a.x, a.y); w.y = cvt_pk_bf16(b.x, b.y); w.z = cvt_pk_bf16(c.x, c.y); w.w = cvt_pk_bf16(d.x, d.y);
                    *(u32x4*)(rowp + bj * 128) = w; }
                if (isv) { s += __shfl_xor(s, 16); s += __shfl_xor(s, 32); q += __shfl_xor(q, 16); q += __shfl_xor(q, 32);
                    if (fq == 0) *(f32x2*)(stat + ((size_t)row * 32 + (u.pn - 8) * 4 + wc) * 2) = (f32x2){s, q}; } }
    }
};
struct EpiResid {
    static constexpr bool PERM = false;
    LAS unsigned char* lds;
    __device__ __forceinline__ void operator()(const f32x4 (&acc)[2][2][4][2], const Unit& u, int wr, int wc, int fr, int fq) const {
        const int mrow = u.pm < 64 ? 0 : (u.pm < 128 ? 1 : 2);
        const float* xin = u.pm < 128 ? (const float*)desc_p(lds, 0, 10) + (size_t)u.pm * 256 * D : (const float*)desc_p(lds, 0, 12) + (size_t)(u.pm - 128) * 256 * D;
        float* xout = (float*)desc_p(lds, 0, 4) + (size_t)u.pm * 256 * D; const float* bias = (const float*)desc_p(lds, 0, 14); const float* gate = (const float*)desc_p(lds, 1, 10);
        const int col0 = u.pn * 256 + wc * 32 + 4 * fq, rl0 = wr * 64 + fr;
#pragma unroll
        for (int bj = 0; bj < 2; ++bj)
#pragma unroll
            for (int n = 0; n < 2; ++n) { const f32x4 bv = bias ? *(const f32x4*)(bias + col0 + bj * 128 + n * 16) : (f32x4){0.f, 0.f, 0.f, 0.f};
                const f32x4 gv = *(const f32x4*)(gate + mrow * 6 * D + col0 + bj * 128 + n * 16);
#pragma unroll
                for (int ai = 0; ai < 2; ++ai) {
#pragma unroll
                    for (int m = 0; m < 4; ++m) { const size_t off = (size_t)(rl0 + ai * 128 + m * 16) * D + col0 + bj * 128 + n * 16;
                        const f32x4 xi = *(const f32x4*)(xin + off); *(f32x4*)(xout + off) = xi + gv * (acc[ai][bj][m][n] + bv); }
                    EPI_FENCE(); } }
    }
};
struct EpiAct {
    static constexpr bool PERM = true;
    LAS unsigned char* lds;
    __device__ __forceinline__ void operator()(const f32x4 (&acc)[2][2][4][2], const Unit& u, int wr, int wc, int fr, int fq) const {
        bf16_t* C = (bf16_t*)desc_p(lds, u.aux, 4); const int ldc = desc_i(lds, u.aux, 7), act = desc_i(lds, u.aux, 8);
        const int col0 = u.pn * 256 + wc * 32 + 8 * fq, row0 = u.pm * 256 + wr * 64 + fr;
#pragma unroll
        for (int ai = 0; ai < 2; ++ai)
#pragma unroll
            for (int m = 0; m < 4; ++m) { bf16_t* rowp = C + (size_t)(row0 + ai * 128 + m * 16) * ldc + col0;
#pragma unroll
                for (int bj = 0; bj < 2; ++bj) { f32x4 v0 = acc[ai][bj][m][0], v1 = acc[ai][bj][m][1];
                    if (act == 1) {
#pragma unroll
                        for (int j = 0; j < 4; ++j) { v0[j] = tanhf_(v0[j]); v1[j] = tanhf_(v1[j]); } }
                    else if (act == 2) {
#pragma unroll
                        for (int j = 0; j < 4; ++j) { v0[j] = sigmoidf_(v0[j]); v1[j] = sigmoidf_(v1[j]); } }
                    u32x4 w; w.x = cvt_pk_bf16(v0[0], v0[1]); w.y = cvt_pk_bf16(v0[2], v0[3]); w.z = cvt_pk_bf16(v1[0], v1[1]); w.w = cvt_pk_bf16(v1[2], v1[3]);
                    *(u32x4*)(rowp + bj * 128) = w; } }
    }
};
struct EpiLora2 {
    static constexpr bool PERM = true;
    LAS unsigned char* lds;
    __device__ __forceinline__ void operator()(const f32x4 (&acc)[2][2][4][2], const Unit& u, int wr, int wc, int fr, int fq) const {
        bf16_t* C = (bf16_t*)desc_p(lds, u.aux, 4);
        const int col0 = u.pn * 256 + wc * 32 + 8 * fq, row0 = u.pm * 256 + wr * 64 + fr;
        const float* pv = u.aux < 4 ? (const float*)desc_p(lds, u.aux, 10) : (const float*)desc_p(lds, 5, 10); bf16_t* C2 = (bf16_t*)desc_p(lds, u.aux, 12);
        const float* k_a = (const float*)desc_p(lds, 5, 10); const bf16_t* Kb = (const bf16_t*)desc_p(lds, 5, 12);
#pragma unroll
        for (int bj = 0; bj < 2; ++bj) { const f32x4 p0 = *(const f32x4*)(pv + col0 + bj * 128), p1 = *(const f32x4*)(pv + col0 + bj * 128 + 4);
            const f32x4 ka0 = *(const f32x4*)(k_a + col0 + bj * 128), ka1 = *(const f32x4*)(k_a + col0 + bj * 128 + 4);
#pragma unroll
            for (int ai = 0; ai < 2; ++ai)
#pragma unroll
                for (int m = 0; m < 4; ++m) { const size_t ro = (size_t)(row0 + ai * 128 + m * 16) * D + col0 + bj * 128;
                    f32x4 v0 = acc[ai][bj][m][0], v1 = acc[ai][bj][m][1];
                    if (u.aux < 2) {
#pragma unroll
                        for (int j = 0; j < 4; ++j) { const float x0 = -(p0[j] + v0[j]), x1 = -(p1[j] + v1[j]);
                            const float s0 = fmaxf(x0, 0.f) + __logf(1.0f + __expf(-fabsf(x0))), s1 = fmaxf(x1, 0.f) + __logf(1.0f + __expf(-fabsf(x1)));
                            v0[j] = -__expf(-s0 - 0.5f); v1[j] = -__expf(-s1 - 0.5f); }
                    } else if (u.aux < 4) {
                        const u32x4 kw = *(const u32x4*)(Kb + ro); f32x4 a0v, a1v;
#pragma unroll
                        for (int j = 0; j < 4; ++j) { a0v[j] = sigmoidf_(p0[j] + v0[j]); a1v[j] = sigmoidf_(p1[j] + v1[j]); }
                        v0[0] = bf_lo(kw.x) * (1.0f + (a0v[0] - 1.0f) * ka0[0]); v0[1] = bf_hi(kw.x) * (1.0f + (a0v[1] - 1.0f) * ka0[1]);
                        v0[2] = bf_lo(kw.y) * (1.0f + (a0v[2] - 1.0f) * ka0[2]); v0[3] = bf_hi(kw.y) * (1.0f + (a0v[3] - 1.0f) * ka0[3]);
                        v1[0] = bf_lo(kw.z) * (1.0f + (a1v[0] - 1.0f) * ka1[0]); v1[1] = bf_hi(kw.z) * (1.0f + (a1v[1] - 1.0f) * ka1[1]);
                        v1[2] = bf_lo(kw.w) * (1.0f + (a1v[2] - 1.0f) * ka1[2]); v1[3] = bf_hi(kw.w) * (1.0f + (a1v[3] - 1.0f) * ka1[3]);
                        u32x4 w2; w2.x = cvt_pk_bf16(a0v[0], a0v[1]); w2.y = cvt_pk_bf16(a0v[2], a0v[3]); w2.z = cvt_pk_bf16(a1v[0], a1v[1]); w2.w = cvt_pk_bf16(a1v[2], a1v[3]);
                        *(u32x4*)(C2 + ro) = w2;
                    }
                    u32x4 w; w.x = cvt_pk_bf16(v0[0], v0[1]); w.y = cvt_pk_bf16(v0[2], v0[3]); w.z = cvt_pk_bf16(v1[0], v1[1]); w.w = cvt_pk_bf16(v1[2], v1[3]);
                    *(u32x4*)(C + ro) = w; EPI_FENCE(); } }
    }
};
struct EpiLogits {
    static constexpr bool PERM = false;
    float* LG;
    __device__ __forceinline__ void operator()(const f32x4 (&acc)[2][2][4][2], const Unit& u, int wr, int wc, int fr, int fq) const {
        if (wc >= 2) return;
        const int col0 = wc * 32 + 4 * fq, row0 = u.pm * 256 + wr * 64 + fr;
#pragma unroll
        for (int ai = 0; ai < 2; ++ai)
#pragma unroll
            for (int m = 0; m < 4; ++m)
#pragma unroll
                for (int n = 0; n < 2; ++n) *(f32x4*)(LG + (size_t)(row0 + ai * 128 + m * 16) * 64 + col0 + n * 16) = acc[ai][0][m][n] + acc[ai][1][m][n];
    }
};
struct EpiSiluGate {
    static constexpr bool PERM = true;
    bf16_t* H;
    __device__ __forceinline__ void operator()(const f32x4 (&acc)[2][2][4][2], const Unit& u, int wr, int wc, int fr, int fq) const {
        const int col0 = u.pn * 128 + wc * 32 + 8 * fq, row0 = u.pm * 256 + wr * 64 + fr;
#pragma unroll
        for (int ai = 0; ai < 2; ++ai)
#pragma unroll
            for (int m = 0; m < 4; ++m) { f32x4 h0, h1;
#pragma unroll
                for (int j = 0; j < 4; ++j) { const float g0 = acc[ai][0][m][0][j], g1 = acc[ai][0][m][1][j]; h0[j] = g0 * sigmoidf_(g0) * acc[ai][1][m][0][j]; h1[j] = g1 * sigmoidf_(g1) * acc[ai][1][m][1][j]; }
                u32x4 w; w.x = cvt_pk_bf16(h0[0], h0[1]); w.y = cvt_pk_bf16(h0[2], h0[3]); w.z = cvt_pk_bf16(h1[0], h1[1]); w.w = cvt_pk_bf16(h1[2], h1[3]);
                *(u32x4*)(H + (size_t)(row0 + ai * 128 + m * 16) * EHID + col0) = w; }
    }
};
struct EpiScatter {
    static constexpr bool PERM = true;
    LAS unsigned char* lds; bf16_t* YB; const int* list;
    __device__ __forceinline__ void operator()(const f32x4 (&acc)[2][2][4][2], const Unit& u, int wr, int wc, int fr, int fq) const {
        LAS const int* tab = (LAS const int*)(lds + LDS_TAB);
        const int j0 = __builtin_amdgcn_readfirstlane(tab[MAXRT + u.pm]), cn = __builtin_amdgcn_readfirstlane(tab[2 * MAXRT + u.aux]);
        const int col0 = u.pn * 256 + wc * 32 + 8 * fq;
#pragma unroll
        for (int ai = 0; ai < 2; ++ai)
#pragma unroll
            for (int m = 0; m < 4; ++m) { const int slot = j0 + ai * 128 + wr * 64 + m * 16 + fr;
                if (slot < cn) { const int a = list[(size_t)u.aux * LISTCAP + slot]; bf16_t* rowp = YB + (size_t)a * D + col0;
#pragma unroll
                    for (int bj = 0; bj < 2; ++bj) { const f32x4 v0 = acc[ai][bj][m][0], v1 = acc[ai][bj][m][1];
                        u32x4 w; w.x = cvt_pk_bf16(v0[0], v0[1]); w.y = cvt_pk_bf16(v0[2], v0[3]); w.z = cvt_pk_bf16(v1[0], v1[1]); w.w = cvt_pk_bf16(v1[2], v1[3]);
                        *(u32x4*)(rowp + bj * 128) = w; } } }
    }
};

struct Params { const float* in[42]; float* out; unsigned char* ws; int ph_lo, ph_hi; };
enum { I_X = 0, I_C, I_CTX, I_CCTX, I_ADAW, I_ADAB, I_N1G, I_N2G, I_FG, I_GWIN, I_GBIN, I_GLNG, I_GLNB, I_GWS, I_GBS, I_GWOUT, I_GBOUT,
       I_MU, I_WR, I_WK, I_WV, I_WO, I_W0, I_W1, I_W2, I_A0, I_A1, I_A2, I_G1, I_G2, I_KK, I_KA, I_RK, I_LNG, I_LNB,
       I_MWGRP, I_MBGRP, I_MWEXP, I_MBEXP, I_MWG, I_MWU, I_MWD };
struct Frame { LAS unsigned char* lds; int tid, lane, wave, G, gw, NGW; };
typedef const __attribute__((address_space(4))) Params* KP;

constexpr int TRP = 36, TR_SCR = 64 * TRP * 4;
__device__ __forceinline__ void tr_item(const float* W, int N, int kmax, bf16_t* WT, int ldk, int k0, int n0, int drow0, int dk0, LAS float* scr, int lane) {
    const int n4 = lane & 7, kr = lane >> 3; f32x4 v[8];
#pragma unroll
    for (int i = 0; i < 8; ++i) { const int k = k0 + 8 * i + kr; v[i] = k < kmax ? *(const f32x4*)(W + (size_t)k * N + n0 + 4 * n4) : (f32x4){0.f, 0.f, 0.f, 0.f}; }
#pragma unroll
    for (int i = 0; i < 8; ++i) *(LAS f32x4*)(scr + (8 * i + kr) * TRP + 4 * n4) = v[i];
    asm volatile("s_waitcnt lgkmcnt(0)" ::: "memory");
    const int c = lane & 7;
#pragma unroll
    for (int j = 0; j < 4; ++j) { const int n = (lane >> 3) + 8 * j; const LAS float* sp = scr + (8 * c) * TRP + n;
        u32x4 o; o.x = cvt_pk_bf16(sp[0 * TRP], sp[1 * TRP]); o.y = cvt_pk_bf16(sp[2 * TRP], sp[3 * TRP]); o.z = cvt_pk_bf16(sp[4 * TRP], sp[5 * TRP]); o.w = cvt_pk_bf16(sp[6 * TRP], sp[7 * TRP]);
        *(u32x4*)(WT + (size_t)(drow0 + n) * ldk + dk0 + k0 + 8 * c) = o; }
    asm volatile("s_waitcnt lgkmcnt(0)" ::: "memory");
}
constexpr int LDS_JOBS = 80 * 1024, MAXJOBS = 48;
__device__ __forceinline__ void add_job(LAS int* jobs, int& nj, int& nit, const float* src, int N, int kmax, int kpad, bf16_t* dst, int ldk, int drow0, int dk0) {
    LAS int* q = jobs + nj * 12; const unsigned long long a = (unsigned long long)src, d = (unsigned long long)dst;
    q[0] = (int)(unsigned)a; q[1] = (int)(unsigned)(a >> 32); q[2] = (int)(unsigned)d; q[3] = (int)(unsigned)(d >> 32); q[4] = N; q[5] = kmax; q[6] = kpad / 64; q[7] = ldk; q[8] = drow0; q[9] = dk0; q[10] = nit;
    nit += (kpad / 64) * (N / 32); ++nj;
}
__device__ __forceinline__ void zero_fill(const Frame& F, bf16_t* p, size_t nbytes) {
    u32x4* q = (u32x4*)p; const size_t n = nbytes / 16;
    for (size_t i = (size_t)blockIdx.x * NTHR + F.tid; i < n; i += (size_t)F.G * NTHR) q[i] = (u32x4){0u, 0u, 0u, 0u};
}

__device__ __forceinline__ void prologue_phase(const Frame& F, KP P) {
    unsigned char* ws = P->ws;
    {   float* MOD = (float*)(ws + WS_MOD); LAS float* part = (LAS float*)F.lds;
        const float* c = P->in[I_C]; const float* cc = P->in[I_CCTX];
        for (int item = blockIdx.x; item < DEPTH * 24; item += F.G) {
            const int layer = item / 24, col = (item % 24) * 256 + 4 * F.lane; const float* w = P->in[I_ADAW] + (size_t)layer * D * 6 * D + col;
            f32x4 a0 = (f32x4){0.f, 0.f, 0.f, 0.f}, a1 = a0, a2 = a0;
#pragma unroll 8
            for (int i = 0; i < 128; ++i) { const int d = F.wave + 8 * i; const f32x4 wv = *(const f32x4*)(w + (size_t)d * 6 * D);
                const float c0 = c[d], c1 = c[D + d], c2 = cc[d];
                a0 += wv * (c0 * sigmoidf_(c0)); a1 += wv * (c1 * sigmoidf_(c1)); a2 += wv * (c2 * sigmoidf_(c2)); }
            __syncthreads();
            *(LAS f32x4*)(part + (F.wave * 3 + 0) * 256 + 4 * F.lane) = a0; *(LAS f32x4*)(part + (F.wave * 3 + 1) * 256 + 4 * F.lane) = a1; *(LAS f32x4*)(part + (F.wave * 3 + 2) * 256 + 4 * F.lane) = a2;
            __syncthreads();
            if (F.wave < 3) { f32x4 sacc = (f32x4){0.f, 0.f, 0.f, 0.f};
#pragma unroll
                for (int w8 = 0; w8 < 8; ++w8) sacc += *(const LAS f32x4*)(part + (w8 * 3 + F.wave) * 256 + 4 * F.lane);
                *(f32x4*)(MOD + ((size_t)layer * 3 + F.wave) * 6 * D + col) = sacc + *(const f32x4*)(P->in[I_ADAB] + (size_t)layer * 6 * D + col); }
        }
    }
    LAS int* jobs = (LAS int*)(F.lds + LDS_JOBS); LAS int* jtot = jobs + MAXJOBS * 12;
    __syncthreads();
    if (F.tid == 0) { int nj = 0, nit = 0;
        for (int j = 0; j < 2; ++j) {
            add_job(jobs, nj, nit, P->in[I_GWIN] + (size_t)j * D * 4096, 4096, D, D, (bf16_t*)(ws + WS_WIN) + (size_t)j * 4096 * D, D, 0, 0);
            add_job(jobs, nj, nit, P->in[I_GWOUT] + (size_t)j * GWID * D, D, GWID, GWID, (bf16_t*)(ws + WS_WOUT) + (size_t)j * D * GWID, GWID, 0, 0);
            add_job(jobs, nj, nit, P->in[I_WR] + (size_t)j * D * D, D, D, D, (bf16_t*)(ws + WS_WR) + (size_t)j * D * D, D, 0, 0);
            add_job(jobs, nj, nit, P->in[I_WK] + (size_t)j * D * D, D, D, D, (bf16_t*)(ws + WS_WK) + (size_t)j * D * D, D, 0, 0);
            add_job(jobs, nj, nit, P->in[I_WV] + (size_t)j * D * D, D, D, D, (bf16_t*)(ws + WS_WV) + (size_t)j * D * D, D, 0, 0);
            add_job(jobs, nj, nit, P->in[I_WO] + (size_t)j * D * D, D, D, D, (bf16_t*)(ws + WS_WO) + (size_t)j * D * D, D, 0, 0);
            for (int z = 0; z < 2; ++z) {
                add_job(jobs, nj, nit, P->in[I_W1] + ((size_t)j * 2 + z) * D * 64, 64, D, D, (bf16_t*)(ws + WS_LW1) + (size_t)j * 256 * D, D, z * 64, 0);
                add_job(jobs, nj, nit, P->in[I_A1] + ((size_t)j * 2 + z) * D * 64, 64, D, D, (bf16_t*)(ws + WS_LA1) + (size_t)j * 256 * D, D, z * 64, 0);
                add_job(jobs, nj, nit, P->in[I_W2] + ((size_t)j * 2 + z) * 64 * D, D, 64, 64, (bf16_t*)(ws + WS_W2P) + ((size_t)j * 2 + z) * D * 256, 256, 0, z * 64);
                add_job(jobs, nj, nit, P->in[I_A2] + ((size_t)j * 2 + z) * 64 * D, D, 64, 64, (bf16_t*)(ws + WS_A2P) + ((size_t)j * 2 + z) * D * 256, 256, 0, z * 64); }
            add_job(jobs, nj, nit, P->in[I_G1] + (size_t)j * D * 160, 160, D, D, (bf16_t*)(ws + WS_LG1) + (size_t)j * 256 * D, D, 0, 0);
            add_job(jobs, nj, nit, P->in[I_G2] + (size_t)j * 160 * D, D, 160, 256, (bf16_t*)(ws + WS_G2P) + (size_t)j * D * 256, 256, 0, 0); }
        jtot[0] = nj; jtot[1] = nit; }
    __syncthreads();
    {   const int nj = jtot[0], nit = jtot[1]; LAS float* scr = (LAS float*)(F.lds + F.wave * TR_SCR);
        for (int it = F.gw; it < nit; it += F.NGW) {
            int jb = 0; for (int q = 1; q < nj; ++q) if (it >= jobs[q * 12 + 10]) jb = q;
            jb = __builtin_amdgcn_readfirstlane(jb); LAS const int* q = jobs + jb * 12;
            const float* src = (const float*)(((unsigned long long)(unsigned)q[1] << 32) | (unsigned)q[0]); bf16_t* dst = (bf16_t*)(((unsigned long long)(unsigned)q[3] << 32) | (unsigned)q[2]);
            const int N = q[4], nnb = N / 32, r = it - q[10], kb = r / nnb, nb = r % nnb;
            tr_item(src, N, q[5], dst, q[7], kb * 64, nb * 32, q[8] + nb * 32, q[9], scr, F.lane); }
    }
    for (int j = 0; j < 2; ++j) {
        bf16_t* lw1 = (bf16_t*)(ws + WS_LW1) + (size_t)j * 256 * D; bf16_t* la1 = (bf16_t*)(ws + WS_LA1) + (size_t)j * 256 * D; bf16_t* lg1 = (bf16_t*)(ws + WS_LG1) + (size_t)j * 256 * D;
        zero_fill(F, lw1 + 128 * D, (size_t)128 * D * 2); zero_fill(F, la1 + 128 * D, (size_t)128 * D * 2); zero_fill(F, lg1 + 160 * D, (size_t)96 * D * 2);
        for (int z = 0; z < 2; ++z) { bf16_t* w2p = (bf16_t*)(ws + WS_W2P) + ((size_t)j * 2 + z) * D * 256; bf16_t* a2p = (bf16_t*)(ws + WS_A2P) + ((size_t)j * 2 + z) * D * 256;
            for (int idx = blockIdx.x * NTHR + F.tid; idx < D * 32; idx += F.G * NTHR) { const int n = idx >> 5, ch = idx & 31;
                if ((ch >> 3) != z) { *(u32x4*)(w2p + (size_t)n * 256 + ch * 8) = (u32x4){0u, 0u, 0u, 0u}; *(u32x4*)(a2p + (size_t)n * 256 + ch * 8) = (u32x4){0u, 0u, 0u, 0u}; } } }
    }
    {   bf16_t* wrt = (bf16_t*)(ws + WS_WRT);
        for (int idx = blockIdx.x * NTHR + F.tid; idx < DEPTH * 256 * (D / 8); idx += F.G * NTHR) { const int k0 = (idx & 127) * 8, n = (idx >> 7) & 255, layer = idx >> 15;
            const int nn = n & 127; const bool lo = n >= 128; float w[8];
#pragma unroll
            for (int e = 0; e < 8; ++e) { float x = 0.f;
                if (nn < 4) x = P->in[I_MWGRP][((size_t)layer * D + k0 + e) * 4 + nn]; else if (nn < 36) x = P->in[I_MWEXP][((size_t)layer * D + k0 + e) * NE + nn - 4];
                const float hi = bf_lo(cvt_pk_bf16(x, 0.f)); w[e] = lo ? x - hi : x; }
            *(u32x4*)(wrt + ((size_t)layer * 256 + n) * D + k0) = pack8(w); } }
    {   const float* src = P->in[I_GWS]; bf16_t* dst = (bf16_t*)(ws + WS_WSP); const int n8 = 2 * 16 * 128 * 128 / 8;
        for (int i = blockIdx.x * NTHR + F.tid; i < n8; i += F.G * NTHR) { const f32x4 a = *(const f32x4*)(src + (size_t)i * 8), b = *(const f32x4*)(src + (size_t)i * 8 + 4);
            u32x4 o; o.x = cvt_pk_bf16(a[0], a[1]); o.y = cvt_pk_bf16(a[2], a[3]); o.z = cvt_pk_bf16(b[0], b[1]); o.w = cvt_pk_bf16(b[2], b[3]); *(u32x4*)(dst + (size_t)i * 8) = o; } }
}
__device__ __forceinline__ void moe_weights_phase(const Frame& F, KP P, int layer) {
    unsigned char* ws = P->ws; LAS float* scr = (LAS float*)(F.lds + F.wave * TR_SCR);
    for (int it = F.gw; it < NE * 768; it += F.NGW) {
        const int e = it / 768, r = it % 768, m = r >> 8, q = r & 255;
        const size_t so = ((size_t)layer * NE + e) * (size_t)D * EHID;
        if (m < 2) { const int kb = q >> 4, n0 = (q & 15) * 32;
            tr_item((m == 0 ? P->in[I_MWG] : P->in[I_MWU]) + so, EHID, D, (bf16_t*)(ws + WS_WGU) + (size_t)e * D * D, D, kb * 64, n0, 256 * (n0 >> 7) + (n0 & 127) + (m == 1 ? 128 : 0), 0, scr, F.lane); }
        else { const int kb = q >> 5, n0 = (q & 31) * 32;
            tr_item(P->in[I_MWD] + so, D, EHID, (bf16_t*)(ws + WS_WD) + (size_t)e * D * EHID, EHID, kb * 64, n0, n0, 0, scr, F.lane); }
    }
}

__device__ __forceinline__ const float* xrow_ptr(KP P, int layer, int row) {
    if (layer == 0) return row < TL ? P->in[I_X] + (size_t)row * D : P->in[I_CTX] + (size_t)(row - TL) * D;
    return (const float*)(P->ws + WS_X) + (size_t)row * D;
}
__device__ __forceinline__ void load_combine(KP P, const Frame& F, int layer, int row, int m, bool combine, f32x4 (&v)[4]) {
    const float* xr = xrow_ptr(P, layer, row);
#pragma unroll
    for (int j = 0; j < 4; ++j) v[j] = *(const f32x4*)(xr + 4 * F.lane + 256 * j);
    if (combine) {
        const bf16_t* yb = (const bf16_t*)(P->ws + WS_YB); const float* wg = (const float*)(P->ws + WS_WGT);
        const float w0 = wg[2 * row], w1 = wg[2 * row + 1]; const float* g2 = (const float*)(P->ws + WS_MOD) + ((size_t)(layer - 1) * 3 + m) * 6 * D + 5 * D;
#pragma unroll
        for (int j = 0; j < 4; ++j) { const int col = 4 * F.lane + 256 * j; const u32x2 a = *(const u32x2*)(yb + (size_t)(2 * row) * D + col), b = *(const u32x2*)(yb + (size_t)(2 * row + 1) * D + col);
            const f32x4 g = *(const f32x4*)(g2 + col);
            v[j][0] += g[0] * (w0 * bf_lo(a.x) + w1 * bf_lo(b.x)); v[j][1] += g[1] * (w0 * bf_hi(a.x) + w1 * bf_hi(b.x));
            v[j][2] += g[2] * (w0 * bf_lo(a.y) + w1 * bf_lo(b.y)); v[j][3] += g[3] * (w0 * bf_hi(a.y) + w1 * bf_hi(b.y)); }
    }
}
__device__ __forceinline__ void norm1_phase(const Frame& F, KP P, int layer) {
    const bool combine = layer > 0; float* X = (float*)(P->ws + WS_X); bf16_t* HL = (bf16_t*)(P->ws + WS_HL);
    const float* g1 = P->in[I_N1G] + (size_t)layer * D;
    for (int row = F.gw; row < T; row += F.NGW) {
        const int m = row < TL ? (row >> 14) : 2; f32x4 v[4];
        load_combine(P, F, layer, row, m, combine, v);
        if (combine) {
#pragma unroll
            for (int j = 0; j < 4; ++j) *(f32x4*)(X + (size_t)row * D + 4 * F.lane + 256 * j) = v[j]; }
        float ss = 0.f;
#pragma unroll
        for (int j = 0; j < 4; ++j) ss += (v[j][0] * v[j][0] + v[j][1] * v[j][1]) + (v[j][2] * v[j][2] + v[j][3] * v[j][3]);
        const float rstd = rsqrtf(wave_sum(ss) * (1.0f / D) + 1e-6f);
        const float* mod = (const float*)(P->ws + WS_MOD) + ((size_t)layer * 3 + m) * 6 * D;
#pragma unroll
        for (int j = 0; j < 4; ++j) { const int col = 4 * F.lane + 256 * j; const f32x4 g = *(const f32x4*)(g1 + col), sh = *(const f32x4*)(mod + col), sc = *(const f32x4*)(mod + D + col);
            const f32x4 h = (v[j] * rstd) * g * (sc + 1.0f) + sh;
            u32x2 o; o.x = cvt_pk_bf16(h[0], h[1]); o.y = cvt_pk_bf16(h[2], h[3]); *(u32x2*)(HL + (size_t)row * D + col) = o; }
    }
}
__device__ __forceinline__ void final_phase(const Frame& F, KP P) {
    const float* fg = P->in[I_FG];
    for (int row = F.gw; row < TL; row += F.NGW) {
        const int m = row >> 14; f32x4 v[4];
        load_combine(P, F, DEPTH, row, m, true, v);
        float ss = 0.f;
#pragma unroll
        for (int j = 0; j < 4; ++j) ss += (v[j][0] * v[j][0] + v[j][1] * v[j][1]) + (v[j][2] * v[j][2] + v[j][3] * v[j][3]);
        const float rstd = rsqrtf(wave_sum(ss) * (1.0f / D) + 1e-6f);
#pragma unroll
        for (int j = 0; j < 4; ++j) { const int col = 4 * F.lane + 256 * j; *(f32x4*)(P->out + (size_t)row * D + col) = (v[j] * rstd) * *(const f32x4*)(fg + col); }
    }
}
__device__ __forceinline__ void norm2_phase(const Frame& F, KP P, int layer) {
    const int ntok = layer == DEPTH - 1 ? TL : T; bf16_t* HL2 = (bf16_t*)(P->ws + WS_HL); const float* g2n = P->in[I_N2G] + (size_t)layer * D;
    for (int row = F.gw; row < ntok; row += F.NGW) {
        const int m = row < TL ? (row >> 14) : 2; const float* xr = xrow_ptr(P, 1, row); f32x4 v[4];
#pragma unroll
        for (int j = 0; j < 4; ++j) v[j] = *(const f32x4*)(xr + 4 * F.lane + 256 * j);
        float ss = 0.f;
#pragma unroll
        for (int j = 0; j < 4; ++j) ss += (v[j][0] * v[j][0] + v[j][1] * v[j][1]) + (v[j][2] * v[j][2] + v[j][3] * v[j][3]);
        const float rstd = rsqrtf(wave_sum(ss) * (1.0f / D) + 1e-6f);
        const float* mod = (const float*)(P->ws + WS_MOD) + ((size_t)layer * 3 + m) * 6 * D;
#pragma unroll
        for (int j = 0; j < 4; ++j) { const int col = 4 * F.lane + 256 * j; const f32x4 g = *(const f32x4*)(g2n + col), sh = *(const f32x4*)(mod + 3 * D + col), sc = *(const f32x4*)(mod + 4 * D + col);
            const f32x4 h = (v[j] * rstd) * g * (sc + 1.0f) + sh;
            u32x2 o; o.x = cvt_pk_bf16(h[0], h[1]); o.y = cvt_pk_bf16(h[2], h[3]); *(u32x2*)(HL2 + (size_t)row * D + col) = o; }
    }
    moe_weights_phase(F, P, layer);
}
__device__ __forceinline__ void route_phase(const Frame& F, KP P, int layer) {
    const int ntok = layer == DEPTH - 1 ? TL : T; const float* LG = (const float*)(P->ws + WS_LG);
    const float* bgrp = P->in[I_MBGRP] + layer * 4; const float* bexp = P->in[I_MBEXP] + layer * NE;
    unsigned* cnt = (unsigned*)(P->ws + WS_CTL) + CW_CNT + layer * 64; int* list = (int*)(P->ws + WS_LIST); float* wgt = (float*)(P->ws + WS_WGT);
    LAS unsigned* lcnt = (LAS unsigned*)F.lds; LAS unsigned* lbase = lcnt + 32;
    for (int r0 = blockIdx.x * NTHR; r0 < ntok; r0 += F.G * NTHR) {
        const int row = r0 + F.tid; const bool act = row < ntok;
        __syncthreads();
        if (F.tid < 32) lcnt[F.tid] = 0u;
        __syncthreads();
        int e0 = 0, e1 = 0; unsigned k0 = 0, k1 = 0;
        if (act) {
            const float* lg = LG + (size_t)row * 64; const f32x4 g4 = *(const f32x4*)lg;
            float ag[4];
#pragma unroll
            for (int i = 0; i < 4; ++i) ag[i] = g4[i] + bgrp[i];
            int grp = 0; float mx = ag[0];
#pragma unroll
            for (int i = 1; i < 4; ++i) if (ag[i] > mx) { mx = ag[i]; grp = i; }
            float den = 0.f;
#pragma unroll
            for (int i = 0; i < 4; ++i) den += __expf(ag[i] - mx);
            const float pg = 1.0f / den;
            const f32x4 e0v = *(const f32x4*)(lg + 4 + 8 * grp), e1v = *(const f32x4*)(lg + 8 + 8 * grp); const f32x4 b0v = *(const f32x4*)(bexp + 8 * grp), b1v = *(const f32x4*)(bexp + 8 * grp + 4);
            float el[8];
#pragma unroll
            for (int i = 0; i < 4; ++i) { el[i] = e0v[i] + b0v[i]; el[4 + i] = e1v[i] + b1v[i]; }
            int i0 = 0; float t0 = el[0];
#pragma unroll
            for (int i = 1; i < 8; ++i) if (el[i] > t0) { t0 = el[i]; i0 = i; }
            int i1 = -1; float t1 = -3.0e38f;
#pragma unroll
            for (int i = 0; i < 8; ++i) if (i != i0 && el[i] > t1) { t1 = el[i]; i1 = i; }
            const float p0 = 1.0f / (1.0f + __expf(t1 - t0));
            wgt[2 * row] = pg * p0; wgt[2 * row + 1] = pg * (1.0f - p0);
            e0 = grp * 8 + i0; e1 = grp * 8 + i1;
            k0 = atomicAdd((unsigned*)(lcnt + e0), 1u); k1 = atomicAdd((unsigned*)(lcnt + e1), 1u);
        }
        __syncthreads();
        if (F.tid < 32) { const unsigned c = lcnt[F.tid]; lbase[F.tid] = c ? atomicAdd(cnt + F.tid, c) : 0u; }
        __syncthreads();
        if (act) { list[(size_t)e0 * LISTCAP + lbase[e0] + k0] = 2 * row; list[(size_t)e1 * LISTCAP + lbase[e1] + k1] = 2 * row + 1; }
    }
}
__device__ __forceinline__ void spatial_phase(const Frame& F, KP P, int j) {
    bf16_t* U = (bf16_t*)(P->ws + WS_U); const bf16_t* V = (const bf16_t*)(P->ws + WS_V); const float* stat = (const float*)(P->ws + WS_STAT);
    const bf16_t* WSP = (const bf16_t*)(P->ws + WS_WSP) + (size_t)j * 16 * 128 * 128;
    const float* lng = P->in[I_GLNG] + (size_t)j * GWID; const float* lnb = P->in[I_GLNB] + (size_t)j * GWID; const float* bs = P->in[I_GBS] + (size_t)j * 16 * 128;
    LAS bf16_t* Wt = (LAS bf16_t*)F.lds; LAS bf16_t* Vt = Wt + 128 * 136;
    LAS float* mu = (LAS float*)(F.lds + 2 * 128 * 136 * 2); LAS float* rs = mu + 128;
    const int l15 = F.lane & 15, l4 = F.lane >> 4;
    for (int item = blockIdx.x; item < (T / 128) * 16; item += F.G) {
        const int c = item >> 4, g = item & 15, t0 = c * 128;
        __syncthreads();
        if (F.tid < 128) { const int row = t0 + F.tid; float s = 0.f, q = 0.f;
#pragma unroll 8
            for (int i = 0; i < 32; ++i) { const f32x2 p = *(const f32x2*)(stat + ((size_t)row * 32 + i) * 2); s += p.x; q += p.y; }
            const float mean = s * (1.0f / GWID), var = q * (1.0f / GWID) - mean * mean; mu[F.tid] = mean; rs[F.tid] = rsqrtf(var + 1e-5f); }
#pragma unroll
        for (int i = 0; i < 4; ++i) { const int idx = F.tid + NTHR * i, p = idx >> 4, seg = idx & 15;
            *(LAS u32x4*)(Wt + p * 136 + seg * 8) = *(const u32x4*)(WSP + ((size_t)g * 128 + p) * 128 + seg * 8); }
        __syncthreads();
#pragma unroll
        for (int i = 0; i < 4; ++i) { const int idx = F.tid + NTHR * i, q = idx >> 4, seg = idx & 15, ch = g * 128 + seg * 8;
            const u32x4 raw = *(const u32x4*)(V + (size_t)(t0 + q) * GWID + ch); const unsigned rw[4] = {raw.x, raw.y, raw.z, raw.w};
            const float m_ = mu[q], r_ = rs[q];
#pragma unroll
            for (int e = 0; e < 8; ++e) { const float x = (e & 1) ? bf_hi(rw[e >> 1]) : bf_lo(rw[e >> 1]);
                Vt[(seg * 8 + e) * 136 + q] = f2bf((x - m_) * r_ * lng[ch + e] + lnb[ch + e]); } }
        __syncthreads();
        bf16x8 bw[4];
#pragma unroll
        for (int ks = 0; ks < 4; ++ks) bw[ks] = *(const LAS bf16x8*)(Wt + (16 * F.wave + l15) * 136 + ks * 32 + 8 * l4);
        const int p = 16 * F.wave + l15; const float bias = bs[g * 128 + p];
#pragma unroll
        for (int dt = 0; dt < 8; ++dt) { f32x4 acc = (f32x4){0.f, 0.f, 0.f, 0.f};
#pragma unroll
            for (int ks = 0; ks < 4; ++ks) { const bf16x8 a = *(const LAS bf16x8*)(Vt + (dt * 16 + l15) * 136 + ks * 32 + 8 * l4); acc = __builtin_amdgcn_mfma_f32_16x16x32_bf16(a, bw[ks], acc, 0, 0, 0); }
            bf16_t* up = U + (size_t)(t0 + p) * GWID + g * 128 + dt * 16 + 4 * l4; const u32x2 uu = *(const u32x2*)up;
            u32x2 o; o.x = cvt_pk_bf16(bf_lo(uu.x) * (acc[0] + bias), bf_hi(uu.x) * (acc[1] + bias)); o.y = cvt_pk_bf16(bf_lo(uu.y) * (acc[2] + bias), bf_hi(uu.y) * (acc[3] + bias));
            *(u32x2*)up = o; }
    }
}

__device__ __forceinline__ void mix_phase(const Frame& F, KP P, int j) {
    const bf16_t* HL = (const bf16_t*)(P->ws + WS_HL); const float* mu = P->in[I_MU] + (size_t)j * 6 * D;
    bf16_t* outs[6] = {(bf16_t*)(P->ws + WS_XR), (bf16_t*)(P->ws + WS_XW), (bf16_t*)(P->ws + WS_XK), (bf16_t*)(P->ws + WS_XV), (bf16_t*)(P->ws + WS_XA), (bf16_t*)(P->ws + WS_XG)};
    for (int row = F.gw; row < T; row += F.NGW) {
        bool ok[2]; int src[2]; const bool hi = F.lane >= 32;
        if (row < TL) { const int n = row & (SEQ - 1), gc = n & 63, gr = n >> 6;
            ok[0] = hi ? gc < 63 : gc > 0; src[0] = hi ? row + 1 : row - 1; ok[1] = hi ? gr < 255 : gr > 0; src[1] = hi ? row + 64 : row - 64; }
        else { const int n = (row - TL) & (CTXL - 1); ok[0] = n > 0; src[0] = row - 1; ok[1] = n < CTXL - 1; src[1] = row + 1; }
#pragma unroll
        for (int jj = 0; jj < 2; ++jj) { const int col = 512 * jj + 8 * F.lane;
            const u32x4 h8 = *(const u32x4*)(HL + (size_t)row * D + col); u32x4 s8 = (u32x4){0u, 0u, 0u, 0u};
            if (ok[jj]) s8 = *(const u32x4*)(HL + (size_t)src[jj] * D + col);
            const unsigned hw[4] = {h8.x, h8.y, h8.z, h8.w}, sw[4] = {s8.x, s8.y, s8.z, s8.w}; float h[8], xx[8];
#pragma unroll
            for (int e = 0; e < 8; ++e) { h[e] = (e & 1) ? bf_hi(hw[e >> 1]) : bf_lo(hw[e >> 1]); const float s = (e & 1) ? bf_hi(sw[e >> 1]) : bf_lo(sw[e >> 1]); xx[e] = s - h[e]; }
#pragma unroll
            for (int m = 0; m < 6; ++m) { const f32x4 ma = *(const f32x4*)(mu + (size_t)m * D + col), mb = *(const f32x4*)(mu + (size_t)m * D + col + 4);
                u32x4 o; o.x = cvt_pk_bf16(h[0] + xx[0] * ma[0], h[1] + xx[1] * ma[1]); o.y = cvt_pk_bf16(h[2] + xx[2] * ma[2], h[3] + xx[3] * ma[3]);
                o.z = cvt_pk_bf16(h[4] + xx[4] * mb[0], h[5] + xx[5] * mb[1]); o.w = cvt_pk_bf16(h[6] + xx[6] * mb[2], h[7] + xx[7] * mb[3]);
                *(u32x4*)(outs[m] + (size_t)row * D + col) = o; } }
    }
}

constexpr int NSC = 65, NSCAN = 64, TP = 72, TILE_B = 64 * TP * 2;
enum { T_AT = 0, T_RT, T_BT, T_KT, T_VM, T_NT, T_MT, T_NRT, T_MRT, T_APA, T_APB, T_TAA, T_TAB, T_PRB, T_QRB, T_NTILE };
constexpr int LDS_GL = T_NTILE * TILE_B, LDS_SEG = LDS_GL + 256;
static_assert(LDS_SEG + 2048 <= LDS_MISC, "scan LDS map");
typedef short v4s __attribute__((ext_vector_type(4)));
__device__ __forceinline__ int scan_row(int z, int b, int p) {
    if (p < CTXL) return TL + b * CTXL + (z ? CTXL - 1 - p : p);
    const int q = p - CTXL; return b * SEQ + (z ? SEQ - 1 - q : q);
}
__device__ __forceinline__ LAS bf16_t* stile(LAS unsigned char* lds, int n) { return (LAS bf16_t*)(lds + n * TILE_B); }
__device__ __forceinline__ bf16x8 row_frag(const LAS bf16_t* M, int r0, int k0, int lane) { return *(const LAS bf16x8*)(M + (r0 + (lane & 15)) * TP + k0 + 8 * (lane >> 4)); }
__device__ __forceinline__ bf16x8 tr_frag(const LAS bf16_t* M, int k0, int c0, int lane) {
    LAS bf16_t* p = (LAS bf16_t*)M + (k0 + 8 * (lane >> 4) + ((lane & 15) >> 2)) * TP + c0 + 4 * (lane & 3);
    const v4s lo = __builtin_amdgcn_ds_read_tr16_b64_v4i16((LAS v4s*)p), hi = __builtin_amdgcn_ds_read_tr16_b64_v4i16((LAS v4s*)(p + 4 * TP));
    return (bf16x8){lo[0], lo[1], lo[2], lo[3], hi[0], hi[1], hi[2], hi[3]};
}
template <bool XT, bool YT>
__device__ __forceinline__ void mm64(const LAS bf16_t* X, const LAS bf16_t* Y, f32x4 (&acc)[2], int wq, int wh, int lane) {
#pragma unroll
    for (int ks = 0; ks < 2; ++ks) {
        const bf16x8 b = XT ? tr_frag(X, 32 * ks, 16 * wq, lane) : row_frag(X, 16 * wq, 32 * ks, lane);
#pragma unroll
        for (int q = 0; q < 2; ++q) { const int i0 = 16 * (2 * wh + q);
            const bf16x8 a = YT ? row_frag(Y, i0, 32 * ks, lane) : tr_frag(Y, 32 * ks, i0, lane);
            acc[q] = __builtin_amdgcn_mfma_f32_16x16x32_bf16(a, b, acc[q], 0, 0, 0); }
    }
}
__device__ __forceinline__ void st_tile(LAS bf16_t* Z, const f32x4 (&acc)[2], int wq, int wh, int lane) {
#pragma unroll
    for (int q = 0; q < 2; ++q) { u32x2 o; o.x = cvt_pk_bf16(acc[q][0], acc[q][1]); o.y = cvt_pk_bf16(acc[q][2], acc[q][3]);
        *(LAS u32x2*)(Z + (16 * wq + (lane & 15)) * TP + 16 * (2 * wh + q) + 4 * (lane >> 4)) = o; }
}
__device__ __forceinline__ void ld_tile(const LAS bf16_t* Z, f32x4 (&acc)[2], int wq, int wh, int lane) {
#pragma unroll
    for (int q = 0; q < 2; ++q) { const u32x2 o = *(const LAS u32x2*)(Z + (16 * wq + (lane & 15)) * TP + 16 * (2 * wh + q) + 4 * (lane >> 4));
        acc[q] = (f32x4){bf_lo(o.x), bf_hi(o.x), bf_lo(o.y), bf_hi(o.y)}; }
}
struct ChunkRegs { u32x4 r, k, v, e, m, a; };
__device__ __forceinline__ void scan_load(KP P, const Frame& F, int item, int c4, ChunkRegs& R) {
    const int s = item & 63, sc = item >> 6, z = s >> 5, b = (s >> 4) & 1, hh = s & 15;
    const size_t o = (size_t)scan_row(z, b, sc * 256 + c4 * 64 + (F.tid >> 3)) * D + hh * 64 + (F.tid & 7) * 8;
    R.r = *(const u32x4*)((const bf16_t*)(P->ws + WS_R) + o); R.k = *(const u32x4*)((const bf16_t*)(P->ws + WS_K) + o); R.v = *(const u32x4*)((const bf16_t*)(P->ws + WS_VV) + o);
    R.e = *(const u32x4*)((const bf16_t*)(P->ws + (z ? WS_ELOG1 : WS_ELOG0)) + o); R.m = *(const u32x4*)((const bf16_t*)(P->ws + (z ? WS_KM1 : WS_KM0)) + o); R.a = *(const u32x4*)((const bf16_t*)(P->ws + (z ? WS_AS1 : WS_AS0)) + o);
}
__device__ __forceinline__ void scan_chunk_phase(const Frame& F, KP P, int j) {
    LAS unsigned char* lds = F.lds;
    LAS bf16_t* At = stile(lds, T_AT); LAS bf16_t* Rt = stile(lds, T_RT); LAS bf16_t* Bt = stile(lds, T_BT); LAS bf16_t* Kt = stile(lds, T_KT); LAS bf16_t* Vm = stile(lds, T_VM);
    LAS bf16_t* NT = stile(lds, T_NT); LAS bf16_t* MT = stile(lds, T_MT); LAS bf16_t* NrT = stile(lds, T_NRT); LAS bf16_t* MrT = stile(lds, T_MRT);
    LAS bf16_t* ApA = stile(lds, T_APA); LAS bf16_t* ApB = stile(lds, T_APB); LAS bf16_t* TaA = stile(lds, T_TAA); LAS bf16_t* TaB = stile(lds, T_TAB);
    LAS bf16_t* PrB = stile(lds, T_PRB); LAS bf16_t* QrB = stile(lds, T_QRB);
    LAS float* Efp = (LAS float*)(lds + T_APA * TILE_B); LAS float* gl = (LAS float*)(lds + LDS_GL); LAS float* seg = (LAS float*)(lds + LDS_SEG);
    const int lane = F.lane, wq = F.wave & 3, wh = F.wave >> 2, l15 = lane & 15, l4 = lane >> 4;
    const int pi = F.tid >> 3, kq = F.tid & 7;
    const int jrow = 16 * wq + l15;
    const int NITEM = NSCAN * NSC;
    int item = blockIdx.x; if (item >= NITEM) return;
    ChunkRegs cur, nxt; scan_load(P, F, item, 0, cur); nxt = cur;
    f32x4 Pr[2], Qr[2];
#pragma unroll
    for (int q = 0; q < 2; ++q) { Pr[q] = (f32x4){0.f, 0.f, 0.f, 0.f}; Qr[q] = (f32x4){0.f, 0.f, 0.f, 0.f}; }
    for (;;) {
        const int s = item & 63, sc = item >> 6, z = s >> 5, b = (s >> 4) & 1, hh = s & 15;
        const float* kkw = P->in[I_KK] + (size_t)j * D + hh * 64 + kq * 8;
        bf16_t* GE = (bf16_t*)(P->ws + (z ? WS_AS1 : WS_AS0)); bf16_t* YE = (bf16_t*)(P->ws + (z ? WS_ELOG1 : WS_ELOG0));
#pragma nounroll
        for (int c4 = 0; c4 < 4; ++c4) {
            float r8[8], k8[8], e8[8], m8[8], a8[8], kk8[8];
            unpack8(cur.r, r8); unpack8(cur.k, k8); unpack8(cur.e, e8); unpack8(cur.m, m8); unpack8(cur.a, a8);
            { const f32x4 w0 = *(const f32x4*)kkw, w1 = *(const f32x4*)(kkw + 4); float ss = 0.f;
#pragma unroll
              for (int e = 0; e < 8; ++e) { kk8[e] = k8[e] * (e < 4 ? w0[e & 3] : w1[e & 3]); ss += kk8[e] * kk8[e]; }
              ss += __shfl_xor(ss, 1); ss += __shfl_xor(ss, 2); ss += __shfl_xor(ss, 4);
              const float rn = rsqrtf(ss + 1e-12f);
#pragma unroll
              for (int e = 0; e < 8; ++e) kk8[e] *= rn; }
            *(LAS f32x4*)(Efp + pi * 64 + kq * 8) = (f32x4){e8[0], e8[1], e8[2], e8[3]}; *(LAS f32x4*)(Efp + pi * 64 + kq * 8 + 4) = (f32x4){e8[4], e8[5], e8[6], e8[7]};
            __syncthreads();
            if (c4 > 0) { st_tile(PrB, Pr, wq, wh, lane); st_tile(QrB, Qr, wq, wh, lane); }
            { const int kc = F.tid & 63, sg = F.tid >> 6; float run = 0.f;
#pragma unroll
              for (int ii = 0; ii < 8; ++ii) { run += Efp[(sg * 8 + ii) * 64 + kc]; Efp[(sg * 8 + ii) * 64 + kc] = run; }
              seg[sg * 64 + kc] = run; }
            __syncthreads();
            { const int kc = F.tid & 63, sg = F.tid >> 6; float off = 0.f;
              for (int s2 = 0; s2 < sg; ++s2) off += seg[s2 * 64 + kc];
#pragma unroll
              for (int ii = 0; ii < 8; ++ii) Efp[(sg * 8 + ii) * 64 + kc] += off; }
            __syncthreads();
            float cum[8];
            { const f32x4 c0 = *(const LAS f32x4*)(Efp + pi * 64 + kq * 8), c1 = *(const LAS f32x4*)(Efp + pi * 64 + kq * 8 + 4);
#pragma unroll
              for (int e = 0; e < 8; ++e) cum[e] = e < 4 ? c0[e & 3] : c1[e & 3]; }
            __syncthreads();
            { float o[8];
#pragma unroll
              for (int e = 0; e < 8; ++e) o[e] = -kk8[e] * __expf(cum[e] - e8[e]);
              *(LAS u32x4*)(At + pi * TP + kq * 8) = pack8(o);
#pragma unroll
              for (int e = 0; e < 8; ++e) o[e] = r8[e] * __expf(cum[e]);
              *(LAS u32x4*)(Rt + pi * TP + kq * 8) = pack8(o);
              float en[8];
#pragma unroll
              for (int e = 0; e < 8; ++e) { en[e] = __expf(-cum[e]); o[e] = kk8[e] * a8[e] * en[e]; }
              *(LAS u32x4*)(Bt + pi * TP + kq * 8) = pack8(o);
#pragma unroll
              for (int e = 0; e < 8; ++e) o[e] = m8[e] * en[e];
              *(LAS u32x4*)(Kt + pi * TP + kq * 8) = pack8(o);
              *(LAS u32x4*)(Vm + pi * TP + kq * 8) = cur.v;
              if (pi == 63) {
#pragma unroll
                  for (int e = 0; e < 8; ++e) gl[kq * 8 + e] = __expf(cum[e]); } }
            { const int nitem = c4 < 3 ? item : item + (int)gridDim.x, nc4 = c4 < 3 ? c4 + 1 : 0; if (nitem < NITEM) scan_load(P, F, nitem, nc4, nxt); }
            __syncthreads();
            {   f32x4 aN[2], aM[2], aNr[2], aMr[2];
#pragma unroll
                for (int q = 0; q < 2; ++q) { aN[q] = (f32x4){0.f, 0.f, 0.f, 0.f}; aM[q] = aN[q]; aNr[q] = aN[q]; aMr[q] = aN[q]; }
                mm64<false, true>(At, Bt, aN, wq, wh, lane); mm64<false, true>(At, Kt, aM, wq, wh, lane); mm64<false, true>(Rt, Bt, aNr, wq, wh, lane); mm64<false, true>(Rt, Kt, aMr, wq, wh, lane);
                f32x4 aT[2];
#pragma unroll
                for (int q = 0; q < 2; ++q)
#pragma unroll
                    for (int r = 0; r < 4; ++r) { const int i = 16 * (2 * wh + q) + 4 * l4 + r; const bool lt = i < jrow, le = i <= jrow;
                        aN[q][r] = lt ? aN[q][r] : 0.f; aM[q][r] = lt ? aM[q][r] : 0.f; aNr[q][r] = le ? aNr[q][r] : 0.f; aMr[q][r] = le ? aMr[q][r] : 0.f; aT[q][r] = aN[q][r] + (i == jrow ? 1.f : 0.f); }
                st_tile(NT, aN, wq, wh, lane); st_tile(MT, aM, wq, wh, lane); st_tile(NrT, aNr, wq, wh, lane); st_tile(MrT, aMr, wq, wh, lane); st_tile(TaA, aT, wq, wh, lane);
            }
            __syncthreads();
            {   f32x4 a2[2] = {(f32x4){0.f, 0.f, 0.f, 0.f}, (f32x4){0.f, 0.f, 0.f, 0.f}}; mm64<false, false>(NT, NT, a2, wq, wh, lane); st_tile(ApA, a2, wq, wh, lane); }
            __syncthreads();
#pragma nounroll
            for (int it = 0; it < 2; ++it) {
                {   f32x4 t[2]; ld_tile(TaA, t, wq, wh, lane); mm64<false, false>(TaA, ApA, t, wq, wh, lane); st_tile(TaB, t, wq, wh, lane);
                    f32x4 a2[2] = {(f32x4){0.f, 0.f, 0.f, 0.f}, (f32x4){0.f, 0.f, 0.f, 0.f}}; mm64<false, false>(ApA, ApA, a2, wq, wh, lane); st_tile(ApB, a2, wq, wh, lane); }
                __syncthreads();
                {   f32x4 t[2]; ld_tile(TaB, t, wq, wh, lane); mm64<false, false>(TaB, ApB, t, wq, wh, lane); st_tile(TaA, t, wq, wh, lane);
                    f32x4 a2[2] = {(f32x4){0.f, 0.f, 0.f, 0.f}, (f32x4){0.f, 0.f, 0.f, 0.f}}; mm64<false, false>(ApB, ApB, a2, wq, wh, lane); st_tile(ApA, a2, wq, wh, lane); }
                __syncthreads();
            }
            {   f32x4 t[2]; ld_tile(TaA, t, wq, wh, lane); mm64<false, false>(TaA, ApA, t, wq, wh, lane); st_tile(TaB, t, wq, wh, lane); }
            __syncthreads();
            {   f32x4 w[2] = {(f32x4){0.f, 0.f, 0.f, 0.f}, (f32x4){0.f, 0.f, 0.f, 0.f}}; mm64<true, true>(At, TaB, w, wq, wh, lane); st_tile(ApA, w, wq, wh, lane);
                f32x4 x[2] = {(f32x4){0.f, 0.f, 0.f, 0.f}, (f32x4){0.f, 0.f, 0.f, 0.f}}; mm64<true, true>(Vm, MT, x, wq, wh, lane); st_tile(ApB, x, wq, wh, lane); }
            __syncthreads();
            {   f32x4 u[2] = {(f32x4){0.f, 0.f, 0.f, 0.f}, (f32x4){0.f, 0.f, 0.f, 0.f}}; mm64<false, true>(ApB, TaB, u, wq, wh, lane); st_tile(TaA, u, wq, wh, lane); }
            __syncthreads();
            f32x4 aP[2], aQ[2], aG[2], aY[2];
#pragma unroll
            for (int q = 0; q < 2; ++q) { aP[q] = (f32x4){0.f, 0.f, 0.f, 0.f}; aQ[q] = aP[q]; aG[q] = aP[q]; aY[q] = aP[q]; }
            mm64<false, false>(ApA, Bt, aP, wq, wh, lane);
            mm64<false, false>(TaA, Bt, aQ, wq, wh, lane); mm64<true, false>(Vm, Kt, aQ, wq, wh, lane);
            mm64<false, true>(NrT, ApA, aG, wq, wh, lane);
            mm64<false, true>(NrT, TaA, aY, wq, wh, lane); mm64<false, false>(MrT, Vm, aY, wq, wh, lane);
#pragma unroll
            for (int q = 0; q < 2; ++q) { const int i0 = 16 * (2 * wh + q) + 4 * l4; const f32x4 g4 = *(const LAS f32x4*)(gl + i0);
                const u32x2 rr = *(const LAS u32x2*)(Rt + jrow * TP + i0);
#pragma unroll
                for (int r = 0; r < 4; ++r) { aP[q][r] = (aP[q][r] + (i0 + r == jrow ? 1.f : 0.f)) * g4[r]; aQ[q][r] *= g4[r]; }
                aG[q][0] += bf_lo(rr.x); aG[q][1] += bf_hi(rr.x); aG[q][2] += bf_lo(rr.y); aG[q][3] += bf_hi(rr.y); }
            const size_t orow = (size_t)scan_row(z, b, sc * 256 + c4 * 64 + jrow) * D + hh * 64;
            if (c4 == 0) {
#pragma unroll
                for (int q = 0; q < 2; ++q) { const int i0 = 16 * (2 * wh + q) + 4 * l4;
                    u32x2 o; o.x = cvt_pk_bf16(aG[q][0], aG[q][1]); o.y = cvt_pk_bf16(aG[q][2], aG[q][3]); *(u32x2*)(GE + orow + i0) = o;
                    u32x2 y; y.x = cvt_pk_bf16(aY[q][0], aY[q][1]); y.y = cvt_pk_bf16(aY[q][2], aY[q][3]); *(u32x2*)(YE + orow + i0) = y;
                    Pr[q] = aP[q]; Qr[q] = aQ[q]; }
            } else {
                st_tile(NT, aG, wq, wh, lane); st_tile(MT, aP, wq, wh, lane);
                __syncthreads();
                f32x4 ge[2] = {(f32x4){0.f, 0.f, 0.f, 0.f}, (f32x4){0.f, 0.f, 0.f, 0.f}};
                mm64<false, true>(NT, PrB, ge, wq, wh, lane); mm64<false, true>(NT, QrB, aY, wq, wh, lane);
                f32x4 pn[2] = {(f32x4){0.f, 0.f, 0.f, 0.f}, (f32x4){0.f, 0.f, 0.f, 0.f}};
                mm64<false, false>(PrB, MT, pn, wq, wh, lane); mm64<false, false>(QrB, MT, aQ, wq, wh, lane);
#pragma unroll
                for (int q = 0; q < 2; ++q) { const int i0 = 16 * (2 * wh + q) + 4 * l4;
                    u32x2 o; o.x = cvt_pk_bf16(ge[q][0], ge[q][1]); o.y = cvt_pk_bf16(ge[q][2], ge[q][3]); *(u32x2*)(GE + orow + i0) = o;
                    u32x2 y; y.x = cvt_pk_bf16(aY[q][0], aY[q][1]); y.y = cvt_pk_bf16(aY[q][2], aY[q][3]); *(u32x2*)(YE + orow + i0) = y;
                    Pr[q] = pn[q]; Qr[q] = aQ[q]; }
            }
            if (c4 == 3) { float* pq = (float*)(P->ws + WS_PQ) + ((size_t)(s * NSC + sc) * 2) * 4096;
#pragma unroll
                for (int q = 0; q < 2; ++q) { const int i0 = 16 * (2 * wh + q) + 4 * l4; *(f32x4*)(pq + jrow * 64 + i0) = Pr[q]; *(f32x4*)(pq + 4096 + jrow * 64 + i0) = Qr[q]; } }
            cur = nxt;
            __syncthreads();
        }
        item += gridDim.x; if (item >= NITEM) break;
    }
}
__device__ __forceinline__ void scan_carry_phase(const Frame& F, KP P) {
    if (F.wave != 0 || blockIdx.x >= 4 * NSCAN) return;
    const int s = blockIdx.x >> 2, vs = blockIdx.x & 3, lane = F.lane, l15 = lane & 15, l4 = lane >> 4, v = 16 * vs + l15;
    const float* pq = (const float*)(P->ws + WS_PQ) + (size_t)s * NSC * 2 * 4096; bf16_t* sst = (bf16_t*)(P->ws + WS_SST) + (size_t)s * NSC * 4096;
    f32x4 S[4], an[4][4], qn[4];
#pragma unroll
    for (int t = 0; t < 4; ++t) S[t] = (f32x4){0.f, 0.f, 0.f, 0.f};
#pragma unroll
    for (int t2i = 0; t2i < 4; ++t2i)
#pragma unroll
        for (int ri = 0; ri < 4; ++ri) an[t2i][ri] = *(const f32x4*)(pq + (16 * l4 + 4 * ri + t2i) * 64 + 4 * l15);
#pragma unroll
    for (int r = 0; r < 4; ++r) qn[r] = *(const f32x4*)(pq + 4096 + v * 64 + 16 * l4 + 4 * r);
#pragma nounroll
    for (int sc = 0; sc < NSC; ++sc) {
        {   float o[16];
#pragma unroll
            for (int r = 0; r < 4; ++r)
#pragma unroll
                for (int t2 = 0; t2 < 4; ++t2) o[4 * r + t2] = S[t2][r];
            u32x4 w0, w1; w0.x = cvt_pk_bf16(o[0], o[1]); w0.y = cvt_pk_bf16(o[2], o[3]); w0.z = cvt_pk_bf16(o[4], o[5]); w0.w = cvt_pk_bf16(o[6], o[7]);
            w1.x = cvt_pk_bf16(o[8], o[9]); w1.y = cvt_pk_bf16(o[10], o[11]); w1.z = cvt_pk_bf16(o[12], o[13]); w1.w = cvt_pk_bf16(o[14], o[15]);
            *(u32x4*)(sst + (size_t)sc * 4096 + v * 64 + 16 * l4) = w0; *(u32x4*)(sst + (size_t)sc * 4096 + v * 64 + 16 * l4 + 8) = w1; }
        if (sc == NSC - 1) break;
        f32x4 ac[4][4], nw[4];
#pragma unroll
        for (int t2i = 0; t2i < 4; ++t2i)
#pragma unroll
            for (int ri = 0; ri < 4; ++ri) ac[t2i][ri] = an[t2i][ri];
#pragma unroll
        for (int t2 = 0; t2 < 4; ++t2) nw[t2] = (f32x4){qn[0][t2], qn[1][t2], qn[2][t2], qn[3][t2]};
        if (sc + 1 < NSC - 1) { const float* Pm = pq + (size_t)(sc + 1) * 2 * 4096;
#pragma unroll
            for (int t2i = 0; t2i < 4; ++t2i)
#pragma unroll
                for (int ri = 0; ri < 4; ++ri) an[t2i][ri] = *(const f32x4*)(Pm + (16 * l4 + 4 * ri + t2i) * 64 + 4 * l15);
#pragma unroll
            for (int r = 0; r < 4; ++r) qn[r] = *(const f32x4*)(Pm + 4096 + v * 64 + 16 * l4 + 4 * r); }
#pragma unroll
        for (int t2i = 0; t2i < 4; ++t2i)
#pragma unroll
            for (int ri = 0; ri < 4; ++ri)
#pragma unroll
                for (int t2 = 0; t2 < 4; ++t2) nw[t2] = __builtin_amdgcn_mfma_f32_16x16x4f32(ac[t2i][ri][t2], S[t2i][ri], nw[t2], 0, 0, 0);
#pragma unroll
        for (int t = 0; t < 4; ++t) S[t] = nw[t];
    }
}
__device__ __forceinline__ void scan_out_phase(const Frame& F, KP P, int j) {
    const int lane = F.lane, l15 = lane & 15, l4 = lane >> 4;
    const bf16_t* GE0 = (const bf16_t*)(P->ws + WS_AS0); const bf16_t* GE1 = (const bf16_t*)(P->ws + WS_AS1); const bf16_t* YE0 = (const bf16_t*)(P->ws + WS_ELOG0); const bf16_t* YE1 = (const bf16_t*)(P->ws + WS_ELOG1);
    const bf16_t* Rb = (const bf16_t*)(P->ws + WS_R); const bf16_t* Vb = (const bf16_t*)(P->ws + WS_VV); const bf16_t* KM0 = (const bf16_t*)(P->ws + WS_KM0); const bf16_t* KM1 = (const bf16_t*)(P->ws + WS_KM1);
    const bf16_t* GT = (const bf16_t*)(P->ws + WS_GATE); bf16_t* YG = (bf16_t*)(P->ws + WS_YG);
    for (int item = F.gw; item < NBATCH * NH * NSC * 4; item += F.NGW) {
        const int qtr = item & 3, bh = (item >> 2) & 31, blk = item >> 7, b = bh >> 4, hh = bh & 15;
        const int sc0 = blk, sc1 = blk == 0 ? 0 : NSC - blk;
        const bf16_t* s0 = (const bf16_t*)(P->ws + WS_SST) + ((size_t)(b * 16 + hh) * NSC + sc0) * 4096; const bf16_t* s1 = (const bf16_t*)(P->ws + WS_SST) + ((size_t)(32 + b * 16 + hh) * NSC + sc1) * 4096;
        bf16x8 sa0[4][2], sa1[4][2];
#pragma unroll
        for (int vt = 0; vt < 4; ++vt)
#pragma unroll
            for (int ks = 0; ks < 2; ++ks) { sa0[vt][ks] = *(const bf16x8*)(s0 + (16 * vt + l15) * 64 + 32 * ks + 8 * l4); sa1[vt][ks] = *(const bf16x8*)(s1 + (16 * vt + l15) * 64 + 32 * ks + 8 * l4); }
        f32x4 lg4[4], lb4[4], rk4[4];
#pragma unroll
        for (int vt = 0; vt < 4; ++vt) { const int c = hh * 64 + 16 * vt + 4 * l4; lg4[vt] = *(const f32x4*)(P->in[I_LNG] + (size_t)j * D + c); lb4[vt] = *(const f32x4*)(P->in[I_LNB] + (size_t)j * D + c); rk4[vt] = *(const f32x4*)(P->in[I_RK] + (size_t)j * D + c); }
#pragma nounroll
        for (int ti = 0; ti < 4; ++ti) {
            const int tok = (4 * qtr + ti) * 16 + l15; const int row = blk == 0 ? TL + b * CTXL + tok : b * SEQ + (blk - 1) * 256 + tok;
            const size_t o = (size_t)row * D + hh * 64;
            const bf16x8 g00 = *(const bf16x8*)(GE0 + o + 8 * l4), g01 = *(const bf16x8*)(GE0 + o + 32 + 8 * l4), g10 = *(const bf16x8*)(GE1 + o + 8 * l4), g11 = *(const bf16x8*)(GE1 + o + 32 + 8 * l4);
            u32x2 la[4], lc[4], lr[4], lm0[4], lm1[4], lv[4], lgt[4];
#pragma unroll
            for (int vt = 0; vt < 4; ++vt) { const size_t oc = o + 16 * vt + 4 * l4;
                la[vt] = *(const u32x2*)(YE0 + oc); lc[vt] = *(const u32x2*)(YE1 + oc); lr[vt] = *(const u32x2*)(Rb + oc); lm0[vt] = *(const u32x2*)(KM0 + oc); lm1[vt] = *(const u32x2*)(KM1 + oc); lv[vt] = *(const u32x2*)(Vb + oc); lgt[vt] = *(const u32x2*)(GT + oc); }
            __builtin_amdgcn_sched_barrier(0);
            f32x4 y[4]; float s = 0.f, bn = 0.f; f32x4 vv[4], gg[4];
#pragma unroll
            for (int vt = 0; vt < 4; ++vt) { const u32x2 a = la[vt], c = lc[vt], rr = lr[vt], m0 = lm0[vt], m1 = lm1[vt], v2 = lv[vt], g2 = lgt[vt];
                f32x4 acc = (f32x4){bf_lo(a.x) + bf_lo(c.x), bf_hi(a.x) + bf_hi(c.x), bf_lo(a.y) + bf_lo(c.y), bf_hi(a.y) + bf_hi(c.y)};
                acc = __builtin_amdgcn_mfma_f32_16x16x32_bf16(sa0[vt][0], g00, acc, 0, 0, 0); acc = __builtin_amdgcn_mfma_f32_16x16x32_bf16(sa0[vt][1], g01, acc, 0, 0, 0);
                acc = __builtin_amdgcn_mfma_f32_16x16x32_bf16(sa1[vt][0], g10, acc, 0, 0, 0); acc = __builtin_amdgcn_mfma_f32_16x16x32_bf16(sa1[vt][1], g11, acc, 0, 0, 0);
                y[vt] = acc; s += (acc[0] + acc[1]) + (acc[2] + acc[3]);
                const f32x4 r4 = (f32x4){bf_lo(rr.x), bf_hi(rr.x), bf_lo(rr.y), bf_hi(rr.y)}, k4 = (f32x4){bf_lo(m0.x) + bf_lo(m1.x), bf_hi(m0.x) + bf_hi(m1.x), bf_lo(m0.y) + bf_lo(m1.y), bf_hi(m0.y) + bf_hi(m1.y)};
                const f32x4 p4 = r4 * rk4[vt] * k4; bn += (p4[0] + p4[1]) + (p4[2] + p4[3]);
                vv[vt] = (f32x4){bf_lo(v2.x), bf_hi(v2.x), bf_lo(v2.y), bf_hi(v2.y)}; gg[vt] = (f32x4){bf_lo(g2.x), bf_hi(g2.x), bf_lo(g2.y), bf_hi(g2.y)}; }
            s += __shfl_xor(s, 16); s += __shfl_xor(s, 32); bn += __shfl_xor(bn, 16); bn += __shfl_xor(bn, 32);
            const float mean = s * (1.0f / 64.0f); float q = 0.f;
#pragma unroll
            for (int vt = 0; vt < 4; ++vt) { const f32x4 d = y[vt] - mean; q += (d[0] * d[0] + d[1] * d[1]) + (d[2] * d[2] + d[3] * d[3]); }
            q += __shfl_xor(q, 16); q += __shfl_xor(q, 32);
            const float rstd = rsqrtf(q * (1.0f / 64.0f) + 64e-5f);
#pragma unroll
            for (int vt = 0; vt < 4; ++vt) { const f32x4 ov = (((y[vt] - mean) * rstd) * lg4[vt] + lb4[vt] + vv[vt] * bn) * gg[vt];
                u32x2 w; w.x = cvt_pk_bf16(ov[0], ov[1]); w.y = cvt_pk_bf16(ov[2], ov[3]); *(u32x2*)(YG + o + 16 * vt + 4 * l4) = w; }
        }
    }
}
__device__ __forceinline__ bool in_range(int lo, int hi, int k) { asm volatile("" : "+s"(lo), "+s"(hi)); return lo <= k && k < hi; }
constexpr int NPH = 46;
template <unsigned KMASK> __global__ void __launch_bounds__(NTHR, 2) mega(Params Pv) {
    extern __shared__ __attribute__((aligned(16))) unsigned char lds_raw[];
    Frame F0; F0.lds = (LAS unsigned char*)lds_raw; F0.tid = threadIdx.x; F0.lane = F0.tid & 63; F0.wave = __builtin_amdgcn_readfirstlane(F0.tid >> 6);
    F0.G = gridDim.x; F0.gw = blockIdx.x * NWAVES + F0.wave; F0.NGW = F0.G * NWAVES;
    LAS unsigned* misc = (LAS unsigned*)(F0.lds + LDS_MISC);
    if (F0.tid < 128) misc[F0.tid] = 0u;
    __syncthreads();
    KP P0 = (KP)__builtin_amdgcn_kernarg_segment_ptr();
    constexpr bool ALL = (KMASK == 0x3ffffu);
    const int lo = ALL ? 0 : P0->ph_lo, hi = ALL ? NPH : P0->ph_hi;
    XcdBarrier bar; bar.bar = (unsigned*)(P0->ws + WS_CTL) + CW_BAR; bar.x = 0; bar.st = (volatile LAS unsigned*)(misc + 8);
    if (ALL || hi - lo > 1) bar = xcd_barrier_post((unsigned*)(P0->ws + WS_CTL) + CW_BAR, (volatile LAS unsigned*)(misc + 8));
#define IN(k) (ALL || in_range(lo, hi, (k)))
#define KIND(q) ((KMASK >> (q)) & 1u)
#define SEAM(k) do { if (IN(k) && IN((k) + 1)) xcd_barrier(bar); } while (0)
#define AMP_T0 const unsigned long long amp_t0 = AMP_MASK ? __builtin_amdgcn_s_memrealtime() : 0ull;
#define AMP_END(kind) do { if (AMP_MASK & (1u << (kind))) { const unsigned long long t1_ = __builtin_amdgcn_s_memrealtime(), dl_ = t1_ + AMP_F * (t1_ - amp_t0); while (__builtin_amdgcn_s_memrealtime() < dl_) __builtin_amdgcn_s_sleep(8); } } while (0)
#define PHASE_ENTRY AMP_T0 KP P = P0; asm volatile("" : "+s"(P)); unsigned char* ws = P->ws; unsigned* ctl = (unsigned*)(ws + WS_CTL); (void)ctl; \
    Frame F = F0; { int t_ = F0.tid; asm volatile("" : "+v"(t_)); F.tid = t_; F.lane = t_ & 63; F.wave = __builtin_amdgcn_readfirstlane(t_ >> 6); F.gw = blockIdx.x * NWAVES + F.wave; }

    if constexpr (KIND(0)) if (IN(0)) { PHASE_ENTRY prologue_phase(F, P); AMP_END(0); }
    SEAM(0);
    for (int lp = 0; lp < 2; ++lp) {
        const int pb = 1 + 22 * lp, la = 2 * lp, lb = 2 * lp + 1;
        if constexpr (KIND(1)) if (IN(pb + 0)) { PHASE_ENTRY norm1_phase(F, P, la); AMP_END(1); }
        SEAM(pb + 0);
        if constexpr (KIND(2)) if (IN(pb + 1)) { PHASE_ENTRY
            __syncthreads(); set_desc(F.lds, 0, ws + WS_HL, ws + WS_WIN + (size_t)lp * 4096 * D * 2, ws + WS_U, 16, 0, 0, ws + WS_V, P->in[I_GBIN] + (size_t)lp * 4096, ws + WS_STAT); __syncthreads();
            SchedMulti<D, D> S{F.lds, T / 256, 16, 1};
            EpiGelu E{F.lds};
            pg8::gemm_phase<EpiGelu, SchedMulti<D, D>, false, D, D, D>(F.lds, S, E);
            AMP_END(2); }
        SEAM(pb + 1);
        if constexpr (KIND(3)) if (IN(pb + 2)) { PHASE_ENTRY spatial_phase(F, P, lp); AMP_END(3); }
        SEAM(pb + 2);
        if constexpr (KIND(4)) if (IN(pb + 3)) { PHASE_ENTRY
            __syncthreads();
            { float* X = (float*)(ws + WS_X);
              set_desc(F.lds, 0, ws + WS_U, ws + WS_WOUT + (size_t)lp * D * GWID * 2, X, 4, 0, 0, la == 0 ? P->in[I_X] : X, la == 0 ? P->in[I_CTX] : X + (size_t)TL * D, P->in[I_GBOUT] + (size_t)lp * D);
              set_desc(F.lds, 1, nullptr, nullptr, nullptr, 0, 0, 0, (const float*)(ws + WS_MOD) + (size_t)la * 3 * 6 * D + 2 * D); }
            __syncthreads();
            SchedMulti<GWID, GWID> S{F.lds, T / 256, 4, 1};
            EpiResid E{F.lds};
            pg8::gemm_phase<EpiResid, SchedMulti<GWID, GWID>, false, GWID, GWID, GWID>(F.lds, S, E);
            AMP_END(4); }
        SEAM(pb + 3);
        if constexpr (KIND(5)) if (IN(pb + 4)) { PHASE_ENTRY norm2_phase(F, P, la); AMP_END(5); }
        SEAM(pb + 4);
        if constexpr (KIND(16)) if (IN(pb + 5)) { PHASE_ENTRY
            __syncthreads(); set_desc(F.lds, 0, ws + WS_HL, ws + WS_WRT + (size_t)la * 256 * D * 2, nullptr, 1, 0, 0); __syncthreads();
            SchedMulti<D, D> S{F.lds, (la == DEPTH - 1 ? TL : T) / 256, 1, 1};
            EpiLogits E{(float*)(ws + WS_LG)};
            pg8::gemm_phase<EpiLogits, SchedMulti<D, D>, false, D, D, D>(F.lds, S, E);
            AMP_END(16); }
        SEAM(pb + 5);
        if constexpr (KIND(17)) if (IN(pb + 6)) { PHASE_ENTRY route_phase(F, P, la); AMP_END(17); }
        SEAM(pb + 6);
        if constexpr (KIND(6)) if (IN(pb + 7)) { PHASE_ENTRY
            moe_tables(F.lds, ctl + CW_CNT + la * 64);
            SchedMoE<D, D, true> S{F.lds, (const char*)(ws + WS_HL), (const char*)(ws + WS_WGU), (const int*)(ws + WS_LIST)};
            EpiSiluGate E{(bf16_t*)(ws + WS_H)};
            pg8::gemm_phase<EpiSiluGate, SchedMoE<D, D, true>, true, D, D, D>(F.lds, S, E);
            AMP_END(6); }
        SEAM(pb + 7);
        if constexpr (KIND(7)) if (IN(pb + 8)) { PHASE_ENTRY
            moe_tables(F.lds, ctl + CW_CNT + la * 64);
            SchedMoE<EHID, EHID, false> S{F.lds, (const char*)(ws + WS_H), (const char*)(ws + WS_WD), (const int*)(ws + WS_LIST)};
            EpiScatter E{F.lds, (bf16_t*)(ws + WS_YB), (const int*)(ws + WS_LIST)};
            pg8::gemm_phase<EpiScatter, SchedMoE<EHID, EHID, false>, false, EHID, EHID, EHID>(F.lds, S, E);
            AMP_END(7); }
        SEAM(pb + 8);
        if constexpr (KIND(1)) if (IN(pb + 9)) { PHASE_ENTRY norm1_phase(F, P, lb); AMP_END(1); }
        SEAM(pb + 9);
        if constexpr (KIND(8)) if (IN(pb + 10)) { PHASE_ENTRY mix_phase(F, P, lp); AMP_END(8); }
        SEAM(pb + 10);
        if constexpr (KIND(9)) if (IN(pb + 11)) { PHASE_ENTRY
            __syncthreads();
            set_desc(F.lds, 0, ws + WS_XR, ws + WS_WR + (size_t)lp * D * D * 2, ws + WS_R, 4, D, 0);
            set_desc(F.lds, 1, ws + WS_XK, ws + WS_WK + (size_t)lp * D * D * 2, ws + WS_K, 4, D, 0);
            set_desc(F.lds, 2, ws + WS_XV, ws + WS_WV + (size_t)lp * D * D * 2, ws + WS_VV, 4, D, 0);
            set_desc(F.lds, 3, ws + WS_XW, ws + WS_LW1 + (size_t)lp * 256 * D * 2, ws + WS_TW, 1, 256, 1);
            set_desc(F.lds, 4, ws + WS_XA, ws + WS_LA1 + (size_t)lp * 256 * D * 2, ws + WS_TA, 1, 256, 0);
            set_desc(F.lds, 5, ws + WS_XG, ws + WS_LG1 + (size_t)lp * 256 * D * 2, ws + WS_TG, 1, 256, 2);
            __syncthreads();
            SchedMulti<D, D> S{F.lds, T / 256, 15, 6};
            EpiAct E{F.lds};
            pg8::gemm_phase<EpiAct, SchedMulti<D, D>, false, D, D, D>(F.lds, S, E);
            AMP_END(9); }
        SEAM(pb + 11);
        if constexpr (KIND(10)) if (IN(pb + 12)) { PHASE_ENTRY
            __syncthreads();
            set_desc(F.lds, 0, ws + WS_TW, ws + WS_W2P + ((size_t)lp * 2 + 0) * D * 256 * 2, ws + WS_ELOG0, 4, D, 0, P->in[I_W0] + (size_t)lp * 2 * D, nullptr);
            set_desc(F.lds, 1, ws + WS_TW, ws + WS_W2P + ((size_t)lp * 2 + 1) * D * 256 * 2, ws + WS_ELOG1, 4, D, 1, P->in[I_W0] + (size_t)lp * 2 * D + D, nullptr);
            set_desc(F.lds, 2, ws + WS_TA, ws + WS_A2P + ((size_t)lp * 2 + 0) * D * 256 * 2, ws + WS_KM0, 4, D, 2, P->in[I_A0] + (size_t)lp * 2 * D, ws + WS_AS0);
            set_desc(F.lds, 3, ws + WS_TA, ws + WS_A2P + ((size_t)lp * 2 + 1) * D * 256 * 2, ws + WS_KM1, 4, D, 3, P->in[I_A0] + (size_t)lp * 2 * D + D, ws + WS_AS1);
            set_desc(F.lds, 4, ws + WS_TG, ws + WS_G2P + (size_t)lp * D * 256 * 2, ws + WS_GATE, 4, D, 4);
            set_desc(F.lds, 5, nullptr, nullptr, nullptr, 0, 0, 0, P->in[I_KA] + (size_t)lp * D, ws + WS_K);
            __syncthreads();
            SchedMulti<256, 256> S{F.lds, T / 256, 20, 5};
            EpiLora2 E{F.lds};
            pg8::gemm_phase<EpiLora2, SchedMulti<256, 256>, false, 256, 256, 256>(F.lds, S, E);
            AMP_END(10); }
        SEAM(pb + 12);
        if constexpr (KIND(11)) if (IN(pb + 13)) { PHASE_ENTRY scan_chunk_phase(F, P, lp); AMP_END(11); }
        SEAM(pb + 13);
        if constexpr (KIND(14)) if (IN(pb + 14)) { PHASE_ENTRY scan_carry_phase(F, P); AMP_END(14); }
        SEAM(pb + 14);
        if constexpr (KIND(15)) if (IN(pb + 15)) { PHASE_ENTRY scan_out_phase(F, P, lp); AMP_END(15); }
        SEAM(pb + 15);
        if constexpr (KIND(4)) if (IN(pb + 16)) { PHASE_ENTRY
            __syncthreads();
            { float* X = (float*)(ws + WS_X);
              set_desc(F.lds, 0, ws + WS_YG, ws + WS_WO + (size_t)lp * D * D * 2, X, 4, 0, 0, X, X + (size_t)TL * D, nullptr);
              set_desc(F.lds, 1, nullptr, nullptr, nullptr, 0, 0, 0, (const float*)(ws + WS_MOD) + (size_t)lb * 3 * 6 * D + 2 * D); }
            __syncthreads();
            SchedMulti<D, D> S{F.lds, T / 256, 4, 1};
            EpiResid E{F.lds};
            pg8::gemm_phase<EpiResid, SchedMulti<D, D>, false, D, D, D>(F.lds, S, E);
            AMP_END(4); }
        SEAM(pb + 16);
        if constexpr (KIND(5)) if (IN(pb + 17)) { PHASE_ENTRY norm2_phase(F, P, lb); AMP_END(5); }
        SEAM(pb + 17);
        if constexpr (KIND(16)) if (IN(pb + 18)) { PHASE_ENTRY
            __syncthreads(); set_desc(F.lds, 0, ws + WS_HL, ws + WS_WRT + (size_t)lb * 256 * D * 2, nullptr, 1, 0, 0); __syncthreads();
            SchedMulti<D, D> S{F.lds, (lb == DEPTH - 1 ? TL : T) / 256, 1, 1};
            EpiLogits E{(float*)(ws + WS_LG)};
            pg8::gemm_phase<EpiLogits, SchedMulti<D, D>, false, D, D, D>(F.lds, S, E);
            AMP_END(16); }
        SEAM(pb + 18);
        if constexpr (KIND(17)) if (IN(pb + 19)) { PHASE_ENTRY route_phase(F, P, lb); AMP_END(17); }
        SEAM(pb + 19);
        if constexpr (KIND(6)) if (IN(pb + 20)) { PHASE_ENTRY
            moe_tables(F.lds, ctl + CW_CNT + lb * 64);
            SchedMoE<D, D, true> S{F.lds, (const char*)(ws + WS_HL), (const char*)(ws + WS_WGU), (const int*)(ws + WS_LIST)};
            EpiSiluGate E{(bf16_t*)(ws + WS_H)};
            pg8::gemm_phase<EpiSiluGate, SchedMoE<D, D, true>, true, D, D, D>(F.lds, S, E);
            AMP_END(6); }
        SEAM(pb + 20);
        if constexpr (KIND(7)) if (IN(pb + 21)) { PHASE_ENTRY
            moe_tables(F.lds, ctl + CW_CNT + lb * 64);
            SchedMoE<EHID, EHID, false> S{F.lds, (const char*)(ws + WS_H), (const char*)(ws + WS_WD), (const int*)(ws + WS_LIST)};
            EpiScatter E{F.lds, (bf16_t*)(ws + WS_YB), (const int*)(ws + WS_LIST)};
            pg8::gemm_phase<EpiScatter, SchedMoE<EHID, EHID, false>, false, EHID, EHID, EHID>(F.lds, S, E);
            AMP_END(7); }
        SEAM(pb + 21);
    }
    if constexpr (KIND(13)) if (IN(45)) { PHASE_ENTRY final_phase(F, P); AMP_END(13); }
#undef IN
#undef KIND
#undef SEAM
#undef PHASE_ENTRY
}

#if !MK_ONE_LAUNCH
static int phase_kind(int ph) { if (ph == 0) return 0; if (ph == 45) return 13; static const int k22[22] = {1, 2, 3, 4, 5, 16, 17, 6, 7, 1, 8, 9, 10, 11, 14, 15, 4, 5, 16, 17, 6, 7}; return k22[(ph - 1) % 22]; }
typedef void (*kern_t)(Params);
template <unsigned KM> static kern_t kern_of() { return mega<KM>; }
static kern_t kind_kernel(int kind) {
    switch (kind) { case 0: return kern_of<1u << 0>(); case 1: return kern_of<1u << 1>(); case 2: return kern_of<1u << 2>(); case 3: return kern_of<1u << 3>(); case 4: return kern_of<1u << 4>();
        case 5: return kern_of<1u << 5>(); case 6: return kern_of<1u << 6>(); case 7: return kern_of<1u << 7>(); case 8: return kern_of<1u << 8>(); case 9: return kern_of<1u << 9>();
        case 10: return kern_of<1u << 10>(); case 11: return kern_of<1u << 11>(); case 12: return kern_of<1u << 12>(); case 14: return kern_of<1u << 14>(); case 15: return kern_of<1u << 15>(); case 16: return kern_of<1u << 16>(); case 17: return kern_of<1u << 17>(); default: return kern_of<1u << 13>(); }
}
#endif
extern "C" void kernel_launch(void* const* d_in, const int* in_sizes, int n_in, void* d_out, int out_size, void* d_ws, size_t ws_size, hipStream_t stream) {
    static int grid = 0;
    if (grid == 0) {
        if (n_in != 42 || out_size != TL * D || ws_size < WS_END) { fprintf(stderr, "kernel_launch: unexpected problem (n_in %d, out %d, ws %zu < %zu)\n", n_in, out_size, ws_size, (size_t)WS_END); grid = -1; return; }
        int dev = 0, cus = 0;
        if (hipGetDevice(&dev) != hipSuccess || hipDeviceGetAttribute(&cus, hipDeviceAttributeMultiprocessorCount, dev) != hipSuccess) { grid = -1; return; }
#if MK_ONE_LAUNCH
        if (hipFuncSetAttribute((const void*)mega<0x3ffffu>, hipFuncAttributeMaxDynamicSharedMemorySize, LDS_BYTES) != hipSuccess) { fprintf(stderr, "kernel_launch: hipFuncSetAttribute failed\n"); grid = -1; return; }
#else
        for (int k = 0; k < 18; ++k) if (hipFuncSetAttribute((const void*)kind_kernel(k), hipFuncAttributeMaxDynamicSharedMemorySize, LDS_BYTES) != hipSuccess) { fprintf(stderr, "kernel_launch: hipFuncSetAttribute failed\n"); grid = -1; return; }
#endif
        (void)hipGetLastError();
        grid = cus;
    }
    if (grid < 0) return;
    (void)hipMemsetAsync((char*)d_ws + WS_CTL, 0, CTL_BYTES, stream);
    Params p{};
    for (int i = 0; i < 42; ++i) p.in[i] = (const float*)d_in[i];
    p.out = (float*)d_out; p.ws = (unsigned char*)d_ws;
#if MK_ONE_LAUNCH
    p.ph_lo = 0; p.ph_hi = NPH;
    hipLaunchKernelGGL(mega<0x3ffffu>, dim3(grid), dim3(NTHR), LDS_BYTES, stream, p);
#else
    for (int ph = 0; ph < NPH; ++ph) { p.ph_lo = ph; p.ph_hi = ph + 1; hipLaunchKernelGGL(kind_kernel(phase_kind(ph)), dim3(grid), dim3(NTHR), LDS_BYTES, stream, p); }
#endif
}
```

```cpp
#include <hip/hip_runtime.h>
#include <cstdio>
#include <cstdint>

#define LAS __attribute__((address_space(3)))
typedef unsigned short bf16_t;
typedef short bf16x8 __attribute__((ext_vector_type(8)));
typedef float f32x4 __attribute__((ext_vector_type(4)));
typedef float f32x2 __attribute__((ext_vector_type(2)));
typedef unsigned u32x4 __attribute__((ext_vector_type(4)));
typedef unsigned u32x2 __attribute__((ext_vector_type(2)));

#ifndef AMP_MASK
#define AMP_MASK 0u
#endif
#define AMP_F 4
#ifndef MK_ONE_LAUNCH
#define MK_ONE_LAUNCH 1
#endif

constexpr int D = 1024, NBATCH = 2, SEQ = 16384, CTXL = 256, DEPTH = 4;
constexpr int TL = NBATCH * SEQ, TC = NBATCH * CTXL, T = TL + TC;
constexpr int GWID = 2048, NE = 32, EHID = 512, NH = 16, HD = 64;
constexpr int LISTCAP = T;
constexpr int MAXRT = (2 * T) / 256 + NE;
constexpr int NWAVES = 8, NTHR = 512;

constexpr size_t MiB = 1u << 20;
constexpr size_t WS_CTL = 0, CTL_BYTES = 1 * MiB;
constexpr size_t WS_MOD = 1 * MiB;
constexpr size_t WS_WIN = 2 * MiB, WS_WOUT = 18 * MiB, WS_WSP = 26 * MiB, WS_WR = 27 * MiB, WS_WK = 31 * MiB, WS_WV = 35 * MiB, WS_WO = 39 * MiB;
constexpr size_t WS_LW1 = 43 * MiB, WS_LA1 = 44 * MiB, WS_LG1 = 45 * MiB, WS_W2P = 46 * MiB, WS_A2P = 48 * MiB, WS_G2P = 50 * MiB;
constexpr size_t WS_WRT = 52 * MiB;
constexpr size_t WS_WGU = 54 * MiB, WS_WD = 118 * MiB;
constexpr size_t WS_X = 150 * MiB;
constexpr size_t WS_LIST = 280 * MiB, WS_WGT = 285 * MiB;
constexpr size_t WS_HL = 286 * MiB;
constexpr size_t WS_BIG = 351 * MiB;
constexpr size_t SZB = 65 * MiB;
constexpr size_t WS_U = WS_BIG, WS_V = WS_BIG + 2 * SZB, WS_STAT = WS_BIG + 4 * SZB;
constexpr size_t WS_XR = WS_BIG, WS_XW = WS_BIG + SZB, WS_XK = WS_BIG + 2 * SZB, WS_XV = WS_BIG + 3 * SZB, WS_XA = WS_BIG + 4 * SZB, WS_XG = WS_BIG + 5 * SZB;
constexpr size_t WS_R = WS_BIG + 6 * SZB, WS_K = WS_BIG + 7 * SZB, WS_VV = WS_BIG + 8 * SZB;
constexpr size_t WS_TW = WS_BIG + 9 * SZB, WS_TA = WS_TW + 17 * MiB, WS_TG = WS_TA + 17 * MiB;
constexpr size_t WS_ELOG0 = WS_XR, WS_ELOG1 = WS_XW, WS_KM0 = WS_XK, WS_KM1 = WS_XV, WS_AS0 = WS_XA, WS_AS1 = WS_XG;
constexpr size_t WS_GATE = WS_HL, WS_YG = WS_AS0, WS_BON = WS_TG + 17 * MiB;
constexpr size_t WS_H = WS_BIG, WS_YB = WS_BIG + 73 * MiB, WS_LG = WS_BIG + 204 * MiB;
constexpr size_t WS_PQ = WS_KM0;
constexpr size_t WS_SST = WS_WGU;
constexpr size_t WS_END = WS_BON + 5 * MiB;
static_assert(WS_END <= 1080 * MiB, "workspace map");
constexpr int CW_BAR = 4096;
constexpr int CW_CNT = 16384;

typedef short v4s __attribute__((ext_vector_type(4)));
#define LDS_BARRIER() asm volatile("s_waitcnt lgkmcnt(0)\n\ts_barrier" ::: "memory")
typedef __bf16 bf16x2_t __attribute__((ext_vector_type(2)));
__device__ __forceinline__ unsigned cvt_pk_bf16(float lo, float hi) { const bf16x2_t v = __builtin_convertvector((f32x2){lo, hi}, bf16x2_t); return __builtin_bit_cast(unsigned, v); }
__device__ __forceinline__ float bf_lo(unsigned u) { return __uint_as_float(u << 16); }
__device__ __forceinline__ float bf_hi(unsigned u) { return __uint_as_float(u & 0xffff0000u); }
__device__ __forceinline__ float bf1(bf16_t b) { return __uint_as_float(((unsigned)b) << 16); }
__device__ __forceinline__ bf16_t f2bf(float f) { return (bf16_t)(cvt_pk_bf16(f, 0.f) & 0x3ffffu); }
__device__ __forceinline__ void unpack8(const u32x4& w, float (&f)[8]) { f[0] = bf_lo(w.x); f[1] = bf_hi(w.x); f[2] = bf_lo(w.y); f[3] = bf_hi(w.y); f[4] = bf_lo(w.z); f[5] = bf_hi(w.z); f[6] = bf_lo(w.w); f[7] = bf_hi(w.w); }
__device__ __forceinline__ u32x4 pack8(const float (&f)[8]) { u32x4 o; o.x = cvt_pk_bf16(f[0], f[1]); o.y = cvt_pk_bf16(f[2], f[3]); o.z = cvt_pk_bf16(f[4], f[5]); o.w = cvt_pk_bf16(f[6], f[7]); return o; }
__device__ __forceinline__ float wave_sum(float v) {
#pragma unroll
    for (int o = 1; o < 64; o <<= 1) v += __shfl_xor(v, o);
    return v;
}
__device__ __forceinline__ float sigmoidf_(float x) { return 1.0f / (1.0f + __expf(-x)); }
__device__ __forceinline__ float tanhf_(float x) { const float e = __expf(2.0f * x); return 1.0f - 2.0f / (e + 1.0f); }
__device__ __forceinline__ f32x2 gelu_pk(f32x2 v) {
    const f32x2 av = __builtin_elementwise_abs(v), d = av * 0.2316418882f + 1.0f;
    f32x2 t; t.x = __builtin_amdgcn_rcpf(d.x); t.y = __builtin_amdgcn_rcpf(d.y);
    f32x2 q = t * 0.5307027145f + (-0.7265760135f); q = q * t + 0.7107068705f; q = q * t + (-0.142248368f); q = q * t + 0.127414796f; q = q * t;
    const f32x2 s = (v * v) * (-0.72134752044f);
    f32x2 e; e.x = __builtin_amdgcn_exp2f(s.x); e.y = __builtin_amdgcn_exp2f(s.y);
    const f32x2 m = v * (q * e), r = v - m;
    f32x2 o; o.x = v.x < 0.f ? m.x : r.x; o.y = v.y < 0.f ? m.y : r.y; return o;
}

#define XB_TMO      128
#define XB_XCNT(j)  (256  + 64 * (j))
#define XB_XSUB(j)  (1280 + 64 * (j))
#define XB_XGEN(j)  (2304 + 64 * (j))
#define XB_TOP      3328
#define XB_TOPGEN   3392
#define XCD_BAR_WORDS 3456
#define XB_SPIN_CAP (1u << 18)
__device__ __forceinline__ unsigned xb_ld(unsigned* p)              { return __hip_atomic_load(p, __ATOMIC_RELAXED, __HIP_MEMORY_SCOPE_AGENT); }
__device__ __forceinline__ unsigned xb_add(unsigned* p, unsigned v) { return __hip_atomic_fetch_add(p, v, __ATOMIC_RELAXED, __HIP_MEMORY_SCOPE_AGENT); }
__device__ __forceinline__ unsigned xb_xcc_id() { return (unsigned)__builtin_amdgcn_s_getreg((3 << 11) | 20) & 0xFu; }
#define XB_SPIN(cond, bar) do { unsigned _sp = 0; while (cond) { __builtin_amdgcn_s_sleep(1); \
    if ((++_sp & 255u) == 0u) { if (xb_ld(&(bar)[XB_TMO])) break; if (_sp > XB_SPIN_CAP) { atomicAdd(&(bar)[XB_TMO], 1u); break; } } } } while (0)
struct XcdBarrier { unsigned* bar; unsigned x; volatile LAS unsigned* st; };
__device__ __forceinline__ XcdBarrier xcd_barrier_post(unsigned* bar, volatile LAS unsigned* st) {
    XcdBarrier b; b.bar = bar; b.x = xb_xcc_id(); b.st = st;
    if (threadIdx.x == 0) (void)xb_add(&bar[XB_XCNT(b.x)], 1u);
    return b;
}
__device__ __forceinline__ void xcd_barrier_complete(unsigned* bar, unsigned x, unsigned& nloc, unsigned& nx) {
    const unsigned G = gridDim.x * gridDim.y * gridDim.z;
    unsigned sum, cnt, mine, sp = 0u;
    for (;;) {
        sum = 0u; cnt = 0u; mine = 0u;
#pragma unroll
        for (unsigned j = 0; j < 16; ++j) { const unsigned c = xb_ld(&bar[XB_XCNT(j)]); sum += c; cnt += (c > 0u) ? 1u : 0u; mine = (j == x) ? c : mine; }
        if (sum == G) break;
        __builtin_amdgcn_s_sleep(1);
        if ((++sp & 255u) == 0u) { if (xb_ld(&bar[XB_TMO])) break; if (sp > XB_SPIN_CAP) { atomicAdd(&bar[XB_TMO], 1u); break; } }
    }
    nloc = mine > 0u ? mine : 1u; nx = cnt > 0u ? cnt : 1u;
}
__device__ __forceinline__ void xcd_barrier(const XcdBarrier& b) {
    asm volatile("s_waitcnt vmcnt(0)" ::: "memory");
    __syncthreads();
    if (threadIdx.x == 0) {
        unsigned* bar = b.bar;
        __builtin_amdgcn_s_waitcnt(0);
        unsigned nloc = b.st[0], nx = b.st[1];
        if (nloc == 0u) { xcd_barrier_complete(bar, b.x, nloc, nx); b.st[0] = nloc; b.st[1] = nx; }
        const unsigned old = xb_add(&bar[XB_XSUB(b.x)], 1u);
        const unsigned gen = old / nloc;
        if (old + 1u == (gen + 1u) * nloc) {
            __builtin_amdgcn_fence(__ATOMIC_RELEASE, "agent");
            asm volatile("s_waitcnt vmcnt(0)" ::: "memory");
            const unsigned og = xb_add(&bar[XB_TOP], 1u);
            const unsigned tg = og / nx;
            if (og + 1u == (tg + 1u) * nx) xb_add(&bar[XB_TOPGEN], 1u);
            else XB_SPIN(xb_ld(&bar[XB_TOPGEN]) == tg, bar);
            __builtin_amdgcn_fence(__ATOMIC_ACQUIRE, "agent");
            xb_add(&bar[XB_XGEN(b.x)], 1u);
            asm volatile("s_waitcnt vmcnt(0)" ::: "memory");
        } else {
            XB_SPIN(xb_ld(&bar[XB_XGEN(b.x)]) == gen, bar);
            __builtin_amdgcn_fence(__ATOMIC_ACQUIRE, "agent");
            asm volatile("s_waitcnt vmcnt(0)" ::: "memory");
        }
    }
    __syncthreads();
}

constexpr int LDS_MISC = 143360;
constexpr int LDS_DESC = LDS_MISC + 128;
constexpr int LDS_TAB = LDS_MISC + 512;
constexpr int LDS_BYTES = 147456;
namespace pg8 {
constexpr int BM = 256, BK = 64, HALF = 128, HTB = HALF * BK * 2, STAGE_BYTES = 8 * HTB, NXCD = 8, WGM = 8;
__host__ __device__ __forceinline__ int lds_byte(int r, int c) { const int st = (r >> 4) * 2 + (c >> 5), rr = r & 15, cc = c & 31, ob = rr * 64 + cc * 2; return st * 1024 + (ob ^ (((ob >> 9) & 1) << 5)); }
__host__ __device__ __forceinline__ void stage_rc(int b, int& R, int& C) { const int st = b / 1024, sb = b % 1024, swz = sb ^ (((sb >> 9) & 1) << 5); R = (st >> 1) * 16 + swz / 64; C = (st & 1) * 32 + (swz % 64) / 2; }
__host__ __device__ __forceinline__ int perm32(int rho) { const int n = rho >> 4, i = rho & 15; return 8 * (i >> 2) + 4 * n + (i & 3); }
__device__ __forceinline__ int xcd_remap(int L, int nwg) { const int q = nwg / NXCD, r = nwg % NXCD, xcd = L % NXCD, off = L / NXCD; return (xcd < r ? xcd * (q + 1) : r * (q + 1) + (xcd - r) * q) + off; }

struct Unit { int pm, pn, aux; };

template <class Epi, class Sched, bool GATHER, int K, int LDA, int LDB>
__device__ __forceinline__ void gemm_phase(LAS unsigned char* lds, const Sched& S, const Epi& E) {
    int tid_ = threadIdx.x; asm volatile("" : "+v"(tid_));
    const int tid = tid_, wid = __builtin_amdgcn_readfirstlane(tid >> 6), lane = tid & 63, wr = wid >> 2, wc = wid & 3, fr = lane & 15, fq = lane >> 4;
    constexpr int nt = K / BK;
    unsigned voffA[2], voffB[2];
#pragma unroll
    for (int i = 0; i < 2; ++i) { int R, C; stage_rc(tid * 16 + i * 8192, R, C); const int Rb = Epi::PERM ? ((R & ~31) + perm32(R & 31)) : R;
        voffA[i] = (unsigned)(R * LDA + C) * 2u; voffB[i] = (unsigned)(Rb * LDB + C) * 2u; }
    constexpr size_t kstep = (size_t)(BK * 2);
    constexpr size_t hstepA = GATHER ? (size_t)0 : (size_t)HALF * LDA * 2, hstepB = (size_t)HALF * LDB * 2;
    const unsigned ldsw = (unsigned)wid * 1024u;
    const int aoff = lds_byte(wr * 64 + fr, fq * 8), boff = lds_byte(wc * 32 + fr, fq * 8);
    unsigned gA[2][2], gN[2][2];
#define PG8_SA(b, h) (((b) * 2 + (h)) * HTB)
#define PG8_SB(b, h) ((4 + (b) * 2 + (h)) * HTB)
#define PG8_STAGEB(bufoff, gbase) do { _Pragma("unroll") for (int _i = 0; _i < 2; ++_i) \
        __builtin_amdgcn_global_load_lds((const unsigned*)((const char*)(gbase) + voffB[_i]), (LAS unsigned*)(lds + (bufoff) + ldsw + _i * 8192), 16, 0, 0); } while (0)
#define PG8_STAGEA(bufoff, gbase, h, GV) do { _Pragma("unroll") for (int _i = 0; _i < 2; ++_i) \
        __builtin_amdgcn_global_load_lds((const unsigned*)((const char*)(gbase) + (GATHER ? GV[h][_i] : voffA[_i]) + (h) * hstepA), (LAS unsigned*)(lds + (bufoff) + ldsw + _i * 8192), 16, 0, 0); } while (0)
#define PG8_LDA(dst, b, h) do { _Pragma("unroll") for (int m = 0; m < 4; ++m) _Pragma("unroll") for (int k = 0; k < 2; ++k) dst[m][k] = *(const LAS bf16x8*)(lds + PG8_SA(b, h) + aoff + m * 2048 + k * 1024); } while (0)
#define PG8_LDB(dst, b, h) do { _Pragma("unroll") for (int n = 0; n < 2; ++n) _Pragma("unroll") for (int k = 0; k < 2; ++k) dst[n][k] = *(const LAS bf16x8*)(lds + PG8_SB(b, h) + boff + n * 2048 + k * 1024); } while (0)
#define PG8_MMA(ai, bj, At, Bt) do { __builtin_amdgcn_s_setprio(1); _Pragma("unroll") for (int m = 0; m < 4; ++m) _Pragma("unroll") for (int n = 0; n < 2; ++n) _Pragma("unroll") for (int k = 0; k < 2; ++k) \
        acc[ai][bj][m][n] = __builtin_amdgcn_mfma_f32_16x16x32_bf16(Bt[n][k], At[m][k], acc[ai][bj][m][n], 0, 0, 0); __builtin_amdgcn_s_setprio(0); } while (0)
#define PG8_WAIT_V(n) asm volatile("s_waitcnt vmcnt(" #n ")" ::: "memory")
#define PG8_WAIT_L(n) asm volatile("s_waitcnt lgkmcnt(" #n ")" ::: "memory")
#define PG8_BAR __builtin_amdgcn_s_barrier()
#define PG8_SCHED __builtin_amdgcn_sched_barrier(0)
    Unit cur, nxt; int ui = 0;
    if (!S.next(0, cur)) return;
    f32x4 acc[2][2][4][2];
#pragma unroll
    for (int a = 0; a < 2; ++a)
#pragma unroll
        for (int b = 0; b < 2; ++b)
#pragma unroll
            for (int m = 0; m < 4; ++m)
#pragma unroll
                for (int n = 0; n < 2; ++n) acc[a][b][m][n] = (f32x4){0.f, 0.f, 0.f, 0.f};
    bf16x8 At[4][2], B0[2][2], B1[2][2];
    const char* cA = S.aptr(cur); const char* cB = S.bptr(cur);
    if constexpr (GATHER) { S.gather(cur, tid, gA); }
    PG8_STAGEB(PG8_SB(0, 0), cB); PG8_STAGEB(PG8_SB(0, 1), cB + hstepB); PG8_STAGEA(PG8_SA(0, 0), cA, 0, gA); PG8_STAGEA(PG8_SA(0, 1), cA, 1, gA);
    if (wr == 1) PG8_BAR;
    PG8_WAIT_V(2); PG8_BAR;
    PG8_STAGEB(PG8_SB(1, 0), cB + kstep); PG8_STAGEA(PG8_SA(1, 0), cA + kstep, 0, gA); PG8_STAGEB(PG8_SB(1, 1), cB + hstepB + kstep);
    PG8_WAIT_V(6); PG8_BAR;
    for (;;) {
        const bool has_next = S.next(ui + 1, nxt);
        const char* nA = has_next ? S.aptr(nxt) : cA; const char* nB = has_next ? S.bptr(nxt) : cB;
        if constexpr (GATHER) { if (has_next) S.gather(nxt, tid, gN); else {
#pragma unroll
            for (int h = 0; h < 2; ++h)
#pragma unroll
                for (int i = 0; i < 2; ++i) gN[h][i] = gA[h][i]; } }
#pragma nounroll
        for (int t = 0; t < nt; t += 2) {
            const bool last = (t == nt - 2);
            const char* a1 = cA + (size_t)(t + 1) * kstep;
            const char* a2 = last ? nA : cA + (size_t)(t + 2) * kstep; const char* b2 = last ? nB : cB + (size_t)(t + 2) * kstep;
            const char* a3 = a2 + kstep; const char* b3 = b2 + kstep;
            unsigned g2[2][2];
            if constexpr (GATHER) {
#pragma unroll
                for (int h = 0; h < 2; ++h)
#pragma unroll
                    for (int i = 0; i < 2; ++i) g2[h][i] = last ? gN[h][i] : gA[h][i]; }
            PG8_LDB(B0, 0, 0); PG8_LDB(B1, 0, 1); PG8_SCHED; PG8_LDA(At, 0, 0); PG8_STAGEA(PG8_SA(1, 1), a1, 1, gA);
            PG8_WAIT_V(8); PG8_WAIT_L(0); PG8_BAR; PG8_MMA(0, 0, At, B0); PG8_MMA(0, 1, At, B1); PG8_BAR; PG8_SCHED;
            PG8_LDA(At, 0, 1); PG8_STAGEB(PG8_SB(0, 0), b2); PG8_STAGEB(PG8_SB(0, 1), b2 + hstepB); PG8_STAGEA(PG8_SA(0, 0), a2, 0, g2);
            PG8_WAIT_V(8); PG8_WAIT_L(0); PG8_BAR; PG8_MMA(1, 0, At, B0); PG8_MMA(1, 1, At, B1); PG8_BAR; PG8_SCHED;
            PG8_LDB(B0, 1, 0); PG8_LDB(B1, 1, 1); PG8_SCHED; PG8_LDA(At, 1, 0); PG8_STAGEA(PG8_SA(0, 1), a2, 1, g2);
            PG8_WAIT_V(8); PG8_WAIT_L(0); PG8_BAR; PG8_MMA(0, 0, At, B0); PG8_MMA(0, 1, At, B1); PG8_BAR; PG8_SCHED;
            PG8_LDA(At, 1, 1); PG8_STAGEB(PG8_SB(1, 0), b3); PG8_STAGEB(PG8_SB(1, 1), b3 + hstepB); PG8_STAGEA(PG8_SA(1, 0), a3, 0, g2);
            PG8_WAIT_V(8); PG8_WAIT_L(0); PG8_BAR; PG8_MMA(1, 0, At, B0); PG8_MMA(1, 1, At, B1); PG8_BAR; PG8_SCHED;
        }
        if (wr == 0) PG8_BAR;
        E(acc, cur, wr, wc, fr, fq);
        if (!has_next) break;
#pragma unroll
        for (int a = 0; a < 2; ++a)
#pragma unroll
            for (int b = 0; b < 2; ++b)
#pragma unroll
                for (int m = 0; m < 4; ++m)
#pragma unroll
                    for (int n = 0; n < 2; ++n) acc[a][b][m][n] = (f32x4){0.f, 0.f, 0.f, 0.f};
        cur = nxt; cA = nA; cB = nB; ++ui;
        if constexpr (GATHER) {
#pragma unroll
            for (int h = 0; h < 2; ++h)
#pragma unroll
                for (int i = 0; i < 2; ++i) gA[h][i] = gN[h][i]; }
        if (wr == 1) PG8_BAR;
    }
    PG8_WAIT_V(0);
    PG8_BAR;
#undef PG8_SA
#undef PG8_SB
#undef PG8_STAGEA
#undef PG8_STAGEB
#undef PG8_LDA
#undef PG8_LDB
#undef PG8_MMA
#undef PG8_WAIT_V
#undef PG8_WAIT_L
#undef PG8_BAR
#undef PG8_SCHED
}
}
using pg8::Unit;

__device__ __forceinline__ void set_desc(LAS unsigned char* lds, int g, const void* A, const void* B, const void* C, int nN, int ldc, int aux, const void* X1 = nullptr, const void* X2 = nullptr, const void* X3 = nullptr) {
    LAS int* d = (LAS int*)(lds + LDS_DESC) + g * 16;
    if (threadIdx.x == 0) { unsigned long long a = (unsigned long long)A, b = (unsigned long long)B, c = (unsigned long long)C, x1 = (unsigned long long)X1, x2 = (unsigned long long)X2, x3 = (unsigned long long)X3;
        asm volatile("" : "+s"(a), "+s"(b), "+s"(c), "+s"(x1), "+s"(x2), "+s"(x3), "+s"(nN), "+s"(ldc), "+s"(aux));
        d[0] = (int)(unsigned)a; d[1] = (int)(unsigned)(a >> 32); d[2] = (int)(unsigned)b; d[3] = (int)(unsigned)(b >> 32); d[4] = (int)(unsigned)c; d[5] = (int)(unsigned)(c >> 32); d[6] = nN; d[7] = ldc; d[8] = aux;
        d[10] = (int)(unsigned)x1; d[11] = (int)(unsigned)(x1 >> 32); d[12] = (int)(unsigned)x2; d[13] = (int)(unsigned)(x2 >> 32); d[14] = (int)(unsigned)x3; d[15] = (int)(unsigned)(x3 >> 32); }
}
__device__ __forceinline__ int desc_i(LAS unsigned char* lds, int g, int f) { return __builtin_amdgcn_readfirstlane(((LAS const int*)(lds + LDS_DESC))[g * 16 + f]); }
__device__ __forceinline__ const char* desc_p(LAS unsigned char* lds, int g, int f) {
    const unsigned lo = (unsigned)desc_i(lds, g, f), hi = (unsigned)desc_i(lds, g, f + 1); return (const char*)(((unsigned long long)hi << 32) | lo); }
template <int LDA, int LDB>
struct SchedMulti {
    LAS unsigned char* lds; int nM, ntot, ng;
    __device__ __forceinline__ bool next(int i, Unit& u) const {
        const int nwg = nM * ntot; const long L = (long)i * gridDim.x + blockIdx.x; if (L >= nwg) return false;
        const int wgid = pg8::xcd_remap((int)L, nwg);
        const int nig = pg8::WGM * ntot, gid = wgid / nig, fm = gid * pg8::WGM, gsz = (nM - fm) < pg8::WGM ? (nM - fm) : pg8::WGM;
        u.pm = fm + ((wgid % nig) % gsz); int pv = (wgid % nig) / gsz; int g = 0;
        for (int j = 0; j + 1 < ng; ++j) { const int n = desc_i(lds, j, 6); if (pv < n) break; pv -= n; g = j + 1; }
        u.pn = pv; u.aux = g; return true;
    }
    __device__ __forceinline__ const char* aptr(const Unit& u) const { return desc_p(lds, u.aux, 0) + (size_t)u.pm * (512 * LDA); }
    __device__ __forceinline__ const char* bptr(const Unit& u) const { return desc_p(lds, u.aux, 2) + (size_t)u.pn * (512 * LDB); }
};
template <int LDA, int LDB, bool GATHERED>
struct SchedMoE {
    LAS unsigned char* lds; const char* Abase; const char* Bbase; const int* list;
    __device__ __forceinline__ bool next(int i, Unit& u) const {
        LAS const int* tab = (LAS const int*)(lds + LDS_TAB);
        const int nrt = __builtin_amdgcn_readfirstlane(tab[2 * MAXRT + 32]);
        const int nwg = nrt * 4; const long L = (long)i * gridDim.x + blockIdx.x; if (L >= nwg) return false;
        const int wgid = pg8::xcd_remap((int)L, nwg);
        u.pm = wgid >> 2; u.pn = wgid & 3; u.aux = __builtin_amdgcn_readfirstlane(tab[u.pm]); return true;
    }
    __device__ __forceinline__ const char* aptr(const Unit& u) const { return GATHERED ? Abase : Abase + (size_t)u.pm * (512 * LDA); }
    __device__ __forceinline__ const char* bptr(const Unit& u) const { return Bbase + (size_t)u.aux * ((size_t)D * LDB * 2) + (size_t)u.pn * (512 * LDB); }
    __device__ __forceinline__ void gather(const Unit& u, int tid, unsigned (&g)[2][2]) const {
        LAS const int* tab = (LAS const int*)(lds + LDS_TAB);
        const int j0 = __builtin_amdgcn_readfirstlane(tab[MAXRT + u.pm]), cn = __builtin_amdgcn_readfirstlane(tab[2 * MAXRT + u.aux]);
#pragma unroll
        for (int i = 0; i < 2; ++i) { int R, C; pg8::stage_rc(tid * 16 + i * 8192, R, C);
#pragma unroll
            for (int h = 0; h < 2; ++h) { const int slot = j0 + 128 * h + R; const int a = slot < cn ? list[(size_t)u.aux * LISTCAP + slot] : 0;
                g[h][i] = (unsigned)((a >> 1) * LDA + C) * 2u; } }
    }
};
__device__ __forceinline__ void moe_tables(LAS unsigned char* lds, const unsigned* cnt) {
    LAS int* tab = (LAS int*)(lds + LDS_TAB);
    __syncthreads();
    if (threadIdx.x == 0) {
        int rt = 0;
#pragma nounroll
        for (int e = 0; e < NE; ++e) { const int c = (int)__hip_atomic_load(cnt + e, __ATOMIC_RELAXED, __HIP_MEMORY_SCOPE_AGENT); tab[2 * MAXRT + e] = c;
            const int nt = (c + 255) >> 8;
#pragma nounroll
            for (int j = 0; j < nt; ++j) { tab[rt] = e; tab[MAXRT + rt] = j * 256; ++rt; } }
        tab[2 * MAXRT + 32] = rt;
    }
    __syncthreads();
}

#define EPI_FENCE() asm volatile("" ::: "memory")
struct EpiGelu {
    static constexpr bool PERM = true;
    LAS unsigned char* lds;
    __device__ __forceinline__ void operator()(const f32x4 (&acc)[2][2][4][2], const Unit& u, int wr, int wc, int fr, int fq) const {
        const bool isv = u.pn >= 8; bf16_t* base = (bf16_t*)desc_p(lds, 0, isv ? 10 : 4); const float* bias = (const float*)desc_p(lds, 0, 12); float* stat = (float*)desc_p(lds, 0, 14);
        const int col0 = (u.pn & 7) * 256 + wc * 32 + 8 * fq, bcol0 = u.pn * 256 + wc * 32 + 8 * fq, row0 = u.pm * 256 + wr * 64 + fr;
        f32x4 bv[2][2];
#pragma unroll
        for (int bj = 0; bj < 2; ++bj)
#pragma unroll
            for (int n = 0; n < 2; ++n) bv[bj][n] = *(const f32x4*)(bias + bcol0 + bj * 128 + 4 * n);
#pragma unroll
        for (int ai = 0; ai < 2; ++ai)
#pragma unroll
            for (int m = 0; m < 4; ++m) { const int row = row0 + ai * 128 + m * 16; bf16_t* rowp = base + (size_t)row * GWID + col0; float s = 0.f, q = 0.f;
#pragma unroll
                for (int bj = 0; bj < 2; ++bj) { const f32x4 v0 = acc[ai][bj][m][0] + bv[bj][0], v1 = acc[ai][bj][m][1] + bv[bj][1];
                    const f32x2 a = gelu_pk((f32x2){v0[0], v0[1]}), b = gelu_pk((f32x2){v0[2], v0[3]}), c = gelu_pk((f32x2){v1[0], v1[1]}), d = gelu_pk((f32x2){v1[2], v1[3]});
                    s += ((a.x + a.y) + (b.x + b.y)) + ((c.x + c.y) + (d.x + d.y));
                    q += ((a.x * a.x + a.y * a.y) + (b.x * b.x + b.y * b.y)) + ((c.x * c.x + c.y * c.y) + (d.x * d.x + d.y * d.y));
                    u32x4 w; w.x = cvt_pk_bf16(a.x, a.y); w.y = cvt_pk_bf16(b.x, b.y); w.z = cvt_pk_bf16(c.x, c.y); w.w = cvt_pk_bf16(d.x, d.y);
                    *(u32x4*)(rowp + bj * 128) = w; }
                if (isv) { s += __shfl_xor(s, 16); s += __shfl_xor(s, 32); q += __shfl_xor(q, 16); q += __shfl_xor(q, 32);
                    if (fq == 0) *(f32x2*)(stat + ((size_t)row * 32 + (u.pn - 8) * 4 + wc) * 2) = (f32x2){s, q}; } }
    }
};
struct EpiResid {
    static constexpr bool PERM = false;
    LAS unsigned char* lds;
    __device__ __forceinline__ void operator()(const f32x4 (&acc)[2][2][4][2], const Unit& u, int wr, int wc, int fr, int fq) const {
        const int mrow = u.pm < 64 ? 0 : (u.pm < 128 ? 1 : 2);
        const float* xin = u.pm < 128 ? (const float*)desc_p(lds, 0, 10) + (size_t)u.pm * 256 * D : (const float*)desc_p(lds, 0, 12) + (size_t)(u.pm - 128) * 256 * D;
        float* xout = (float*)desc_p(lds, 0, 4) + (size_t)u.pm * 256 * D; const float* bias = (const float*)desc_p(lds, 0, 14); const float* gate = (const float*)desc_p(lds, 1, 10);
        const int col0 = u.pn * 256 + wc * 32 + 4 * fq, rl0 = wr * 64 + fr;
#pragma unroll
        for (int bj = 0; bj < 2; ++bj)
#pragma unroll
            for (int n = 0; n < 2; ++n) { const f32x4 bv = bias ? *(const f32x4*)(bias + col0 + bj * 128 + n * 16) : (f32x4){0.f, 0.f, 0.f, 0.f};
                const f32x4 gv = *(const f32x4*)(gate + mrow * 6 * D + col0 + bj * 128 + n * 16);
#pragma unroll
                for (int ai = 0; ai < 2; ++ai) {
#pragma unroll
                    for (int m = 0; m < 4; ++m) { const size_t off = (size_t)(rl0 + ai * 128 + m * 16) * D + col0 + bj * 128 + n * 16;
                        const f32x4 xi = *(const f32x4*)(xin + off); *(f32x4*)(xout + off) = xi + gv * (acc[ai][bj][m][n] + bv); }
                    EPI_FENCE(); } }
    }
};
struct EpiAct {
    static constexpr bool PERM = true;
    LAS unsigned char* lds;
    __device__ __forceinline__ void operator()(const f32x4 (&acc)[2][2][4][2], const Unit& u, int wr, int wc, int fr, int fq) const {
        bf16_t* C = (bf16_t*)desc_p(lds, u.aux, 4); const int ldc = desc_i(lds, u.aux, 7), act = desc_i(lds, u.aux, 8);
        const int col0 = u.pn * 256 + wc * 32 + 8 * fq, row0 = u.pm * 256 + wr * 64 + fr;
#pragma unroll
        for (int ai = 0; ai < 2; ++ai)
#pragma unroll
            for (int m = 0; m < 4; ++m) { bf16_t* rowp = C + (size_t)(row0 + ai * 128 + m * 16) * ldc + col0;
#pragma unroll
                for (int bj = 0; bj < 2; ++bj) { f32x4 v0 = acc[ai][bj][m][0], v1 = acc[ai][bj][m][1];
                    if (act == 1) {
#pragma unroll
                        for (int j = 0; j < 4; ++j) { v0[j] = tanhf_(v0[j]); v1[j] = tanhf_(v1[j]); } }
                    else if (act == 2) {
#pragma unroll
                        for (int j = 0; j < 4; ++j) { v0[j] = sigmoidf_(v0[j]); v1[j] = sigmoidf_(v1[j]); } }
                    u32x4 w; w.x = cvt_pk_bf16(v0[0], v0[1]); w.y = cvt_pk_bf16(v0[2], v0[3]); w.z = cvt_pk_bf16(v1[0], v1[1]); w.w = cvt_pk_bf16(v1[2], v1[3]);
                    *(u32x4*)(rowp + bj * 128) = w; } }
    }
};
struct EpiLogits {
    static constexpr bool PERM = false;
    float* LG;
    __device__ __forceinline__ void operator()(const f32x4 (&acc)[2][2][4][2], const Unit& u, int wr, int wc, int fr, int fq) const {
        if (wc >= 2) return;
        const int col0 = wc * 32 + 4 * fq, row0 = u.pm * 256 + wr * 64 + fr;
#pragma unroll
        for (int ai = 0; ai < 2; ++ai)
#pragma unroll
            for (int m = 0; m < 4; ++m)
#pragma unroll
                for (int n = 0; n < 2; ++n) *(f32x4*)(LG + (size_t)(row0 + ai * 128 + m * 16) * 64 + col0 + n * 16) = acc[ai][0][m][n] + acc[ai][1][m][n];
    }
};
struct EpiSiluGate {
    static constexpr bool PERM = true;
    bf16_t* H;
    __device__ __forceinline__ void operator()(const f32x4 (&acc)[2][2][4][2], const Unit& u, int wr, int wc, int fr, int fq) const {
        const int col0 = u.pn * 128 + wc * 32 + 8 * fq, row0 = u.pm * 256 + wr * 64 + fr;
#pragma unroll
        for (int ai = 0; ai < 2; ++ai)
#pragma unroll
            for (int m = 0; m < 4; ++m) { f32x4 h0, h1;
#pragma unroll
                for (int j = 0; j < 4; ++j) { const float g0 = acc[ai][0][m][0][j], g1 = acc[ai][0][m][1][j]; h0[j] = g0 * sigmoidf_(g0) * acc[ai][1][m][0][j]; h1[j] = g1 * sigmoidf_(g1) * acc[ai][1][m][1][j]; }
                u32x4 w; w.x = cvt_pk_bf16(h0[0], h0[1]); w.y = cvt_pk_bf16(h0[2], h0[3]); w.z = cvt_pk_bf16(h1[0], h1[1]); w.w = cvt_pk_bf16(h1[2], h1[3]);
                *(u32x4*)(H + (size_t)(row0 + ai * 128 + m * 16) * EHID + col0) = w; }
    }
};
struct EpiScatter {
    static constexpr bool PERM = true;
    LAS unsigned char* lds; bf16_t* YB; const int* list;
    __device__ __forceinline__ void operator()(const f32x4 (&acc)[2][2][4][2], const Unit& u, int wr, int wc, int fr, int fq) const {
        LAS const int* tab = (LAS const int*)(lds + LDS_TAB);
        const int j0 = __builtin_amdgcn_readfirstlane(tab[MAXRT + u.pm]), cn = __builtin_amdgcn_readfirstlane(tab[2 * MAXRT + u.aux]);
        const int col0 = u.pn * 256 + wc * 32 + 8 * fq;
#pragma unroll
        for (int ai = 0; ai < 2; ++ai)
#pragma unroll
            for (int m = 0; m < 4; ++m) { const int slot = j0 + ai * 128 + wr * 64 + m * 16 + fr;
                if (slot < cn) { const int a = list[(size_t)u.aux * LISTCAP + slot]; bf16_t* rowp = YB + (size_t)a * D + col0;
#pragma unroll
                    for (int bj = 0; bj < 2; ++bj) { const f32x4 v0 = acc[ai][bj][m][0], v1 = acc[ai][bj][m][1];
                        u32x4 w; w.x = cvt_pk_bf16(v0[0], v0[1]); w.y = cvt_pk_bf16(v0[2], v0[3]); w.z = cvt_pk_bf16(v1[0], v1[1]); w.w = cvt_pk_bf16(v1[2], v1[3]);
                        *(u32x4*)(rowp + bj * 128) = w; } } }
    }
};

struct Params { const float* in[42]; float* out; unsigned char* ws; int ph_lo, ph_hi; };
enum { I_X = 0, I_C, I_CTX, I_CCTX, I_ADAW, I_ADAB, I_N1G, I_N2G, I_FG, I_GWIN, I_GBIN, I_GLNG, I_GLNB, I_GWS, I_GBS, I_GWOUT, I_GBOUT,
       I_MU, I_WR, I_WK, I_WV, I_WO, I_W0, I_W1, I_W2, I_A0, I_A1, I_A2, I_G1, I_G2, I_KK, I_KA, I_RK, I_LNG, I_LNB,
       I_MWGRP, I_MBGRP, I_MWEXP, I_MBEXP, I_MWG, I_MWU, I_MWD };
struct Frame { LAS unsigned char* lds; int tid, lane, wave, G, gw, NGW; };
typedef const __attribute__((address_space(4))) Params* KP;

constexpr int TRP = 36, TR_SCR = 64 * TRP * 4;
__device__ __forceinline__ void tr_item(const float* W, int N, int kmax, bf16_t* WT, int ldk, int k0, int n0, int drow0, int dk0, LAS float* scr, int lane) {
    const int n4 = lane & 7, kr = lane >> 3; f32x4 v[8];
#pragma unroll
    for (int i = 0; i < 8; ++i) { const int k = k0 + 8 * i + kr; v[i] = k < kmax ? *(const f32x4*)(W + (size_t)k * N + n0 + 4 * n4) : (f32x4){0.f, 0.f, 0.f, 0.f}; }
#pragma unroll
    for (int i = 0; i < 8; ++i) *(LAS f32x4*)(scr + (8 * i + kr) * TRP + 4 * n4) = v[i];
    asm volatile("s_waitcnt lgkmcnt(0)" ::: "memory");
    const int c = lane & 7;
#pragma unroll
    for (int j = 0; j < 4; ++j) { const int n = (lane >> 3) + 8 * j; const LAS float* sp = scr + (8 * c) * TRP + n;
        u32x4 o; o.x = cvt_pk_bf16(sp[0 * TRP], sp[1 * TRP]); o.y = cvt_pk_bf16(sp[2 * TRP], sp[3 * TRP]); o.z = cvt_pk_bf16(sp[4 * TRP], sp[5 * TRP]); o.w = cvt_pk_bf16(sp[6 * TRP], sp[7 * TRP]);
        *(u32x4*)(WT + (size_t)(drow0 + n) * ldk + dk0 + k0 + 8 * c) = o; }
    asm volatile("s_waitcnt lgkmcnt(0)" ::: "memory");
}
constexpr int LDS_JOBS = 80 * 1024, MAXJOBS = 48;
__device__ __forceinline__ void add_job(LAS int* jobs, int& nj, int& nit, const float* src, int N, int kmax, int kpad, bf16_t* dst, int ldk, int drow0, int dk0) {
    LAS int* q = jobs + nj * 12; const unsigned long long a = (unsigned long long)src, d = (unsigned long long)dst;
    q[0] = (int)(unsigned)a; q[1] = (int)(unsigned)(a >> 32); q[2] = (int)(unsigned)d; q[3] = (int)(unsigned)(d >> 32); q[4] = N; q[5] = kmax; q[6] = kpad / 64; q[7] = ldk; q[8] = drow0; q[9] = dk0; q[10] = nit;
    nit += (kpad / 64) * (N / 32); ++nj;
}
__device__ __forceinline__ void zero_fill(const Frame& F, bf16_t* p, size_t nbytes) {
    u32x4* q = (u32x4*)p; const size_t n = nbytes / 16;
    for (size_t i = (size_t)blockIdx.x * NTHR + F.tid; i < n; i += (size_t)F.G * NTHR) q[i] = (u32x4){0u, 0u, 0u, 0u};
}

__device__ __forceinline__ void prologue_phase(const Frame& F, KP P) {
    unsigned char* ws = P->ws;
    {   float* MOD = (float*)(ws + WS_MOD); LAS float* part = (LAS float*)F.lds;
        const float* c = P->in[I_C]; const float* cc = P->in[I_CCTX];
        for (int item = blockIdx.x; item < DEPTH * 24; item += F.G) {
            const int layer = item / 24, col = (item % 24) * 256 + 4 * F.lane; const float* w = P->in[I_ADAW] + (size_t)layer * D * 6 * D + col;
            f32x4 a0 = (f32x4){0.f, 0.f, 0.f, 0.f}, a1 = a0, a2 = a0;
#pragma unroll 8
            for (int i = 0; i < 128; ++i) { const int d = F.wave + 8 * i; const f32x4 wv = *(const f32x4*)(w + (size_t)d * 6 * D);
                const float c0 = c[d], c1 = c[D + d], c2 = cc[d];
                a0 += wv * (c0 * sigmoidf_(c0)); a1 += wv * (c1 * sigmoidf_(c1)); a2 += wv * (c2 * sigmoidf_(c2)); }
            __syncthreads();
            *(LAS f32x4*)(part + (F.wave * 3 + 0) * 256 + 4 * F.lane) = a0; *(LAS f32x4*)(part + (F.wave * 3 + 1) * 256 + 4 * F.lane) = a1; *(LAS f32x4*)(part + (F.wave * 3 + 2) * 256 + 4 * F.lane) = a2;
            __syncthreads();
            if (F.wave < 3) { f32x4 sacc = (f32x4){0.f, 0.f, 0.f, 0.f};
#pragma unroll
                for (int w8 = 0; w8 < 8; ++w8) sacc += *(const LAS f32x4*)(part + (w8 * 3 + F.wave) * 256 + 4 * F.lane);
                *(f32x4*)(MOD + ((size_t)layer * 3 + F.wave) * 6 * D + col) = sacc + *(const f32x4*)(P->in[I_ADAB] + (size_t)layer * 6 * D + col); }
        }
    }
    LAS int* jobs = (LAS int*)(F.lds + LDS_JOBS); LAS int* jtot = jobs + MAXJOBS * 12;
    __syncthreads();
    if (F.tid == 0) { int nj = 0, nit = 0;
        for (int j = 0; j < 2; ++j) {
            add_job(jobs, nj, nit, P->in[I_GWIN] + (size_t)j * D * 4096, 4096, D, D, (bf16_t*)(ws + WS_WIN) + (size_t)j * 4096 * D, D, 0, 0);
            add_job(jobs, nj, nit, P->in[I_GWOUT] + (size_t)j * GWID * D, D, GWID, GWID, (bf16_t*)(ws + WS_WOUT) + (size_t)j * D * GWID, GWID, 0, 0);
            add_job(jobs, nj, nit, P->in[I_WR] + (size_t)j * D * D, D, D, D, (bf16_t*)(ws + WS_WR) + (size_t)j * D * D, D, 0, 0);
            add_job(jobs, nj, nit, P->in[I_WK] + (size_t)j * D * D, D, D, D, (bf16_t*)(ws + WS_WK) + (size_t)j * D * D, D, 0, 0);
            add_job(jobs, nj, nit, P->in[I_WV] + (size_t)j * D * D, D, D, D, (bf16_t*)(ws + WS_WV) + (size_t)j * D * D, D, 0, 0);
            add_job(jobs, nj, nit, P->in[I_WO] + (size_t)j * D * D, D, D, D, (bf16_t*)(ws + WS_WO) + (size_t)j * D * D, D, 0, 0);
            for (int z = 0; z < 2; ++z) {
                add_job(jobs, nj, nit, P->in[I_W1] + ((size_t)j * 2 + z) * D * 64, 64, D, D, (bf16_t*)(ws + WS_LW1) + (size_t)j * 256 * D, D, z * 64, 0);
                add_job(jobs, nj, nit, P->in[I_A1] + ((size_t)j * 2 + z) * D * 64, 64, D, D, (bf16_t*)(ws + WS_LA1) + (size_t)j * 256 * D, D, z * 64, 0);
                add_job(jobs, nj, nit, P->in[I_W2] + ((size_t)j * 2 + z) * 64 * D, D, 64, 64, (bf16_t*)(ws + WS_W2P) + ((size_t)j * 2 + z) * D * 256, 256, 0, z * 64);
                add_job(jobs, nj, nit, P->in[I_A2] + ((size_t)j * 2 + z) * 64 * D, D, 64, 64, (bf16_t*)(ws + WS_A2P) + ((size_t)j * 2 + z) * D * 256, 256, 0, z * 64); }
            add_job(jobs, nj, nit, P->in[I_G1] + (size_t)j * D * 160, 160, D, D, (bf16_t*)(ws + WS_LG1) + (size_t)j * 256 * D, D, 0, 0);
            add_job(jobs, nj, nit, P->in[I_G2] + (size_t)j * 160 * D, D, 160, 256, (bf16_t*)(ws + WS_G2P) + (size_t)j * D * 256, 256, 0, 0); }
        jtot[0] = nj; jtot[1] = nit; }
    __syncthreads();
    {   const int nj = jtot[0], nit = jtot[1]; LAS float* scr = (LAS float*)(F.lds + F.wave * TR_SCR);
        for (int it = F.gw; it < nit; it += F.NGW) {
            int jb = 0; for (int q = 1; q < nj; ++q) if (it >= jobs[q * 12 + 10]) jb = q;
            jb = __builtin_amdgcn_readfirstlane(jb); LAS const int* q = jobs + jb * 12;
            const float* src = (const float*)(((unsigned long long)(unsigned)q[1] << 32) | (unsigned)q[0]); bf16_t* dst = (bf16_t*)(((unsigned long long)(unsigned)q[3] << 32) | (unsigned)q[2]);
            const int N = q[4], nnb = N / 32, r = it - q[10], kb = r / nnb, nb = r % nnb;
            tr_item(src, N, q[5], dst, q[7], kb * 64, nb * 32, q[8] + nb * 32, q[9], scr, F.lane); }
    }
    for (int j = 0; j < 2; ++j) {
        bf16_t* lw1 = (bf16_t*)(ws + WS_LW1) + (size_t)j * 256 * D; bf16_t* la1 = (bf16_t*)(ws + WS_LA1) + (size_t)j * 256 * D; bf16_t* lg1 = (bf16_t*)(ws + WS_LG1) + (size_t)j * 256 * D;
        zero_fill(F, lw1 + 128 * D, (size_t)128 * D * 2); zero_fill(F, la1 + 128 * D, (size_t)128 * D * 2); zero_fill(F, lg1 + 160 * D, (size_t)96 * D * 2);
        for (int z = 0; z < 2; ++z) { bf16_t* w2p = (bf16_t*)(ws + WS_W2P) + ((size_t)j * 2 + z) * D * 256; bf16_t* a2p = (bf16_t*)(ws + WS_A2P) + ((size_t)j * 2 + z) * D * 256;
            for (int idx = blockIdx.x * NTHR + F.tid; idx < D * 32; idx += F.G * NTHR) { const int n = idx >> 5, ch = idx & 31;
                if ((ch >> 3) != z) { *(u32x4*)(w2p + (size_t)n * 256 + ch * 8) = (u32x4){0u, 0u, 0u, 0u}; *(u32x4*)(a2p + (size_t)n * 256 + ch * 8) = (u32x4){0u, 0u, 0u, 0u}; } } }
    }
    {   bf16_t* wrt = (bf16_t*)(ws + WS_WRT);
        for (int idx = blockIdx.x * NTHR + F.tid; idx < DEPTH * 256 * (D / 8); idx += F.G * NTHR) { const int k0 = (idx & 127) * 8, n = (idx >> 7) & 255, layer = idx >> 15;
            const int nn = n & 127; const bool lo = n >= 128; float w[8];
#pragma unroll
            for (int e = 0; e < 8; ++e) { float x = 0.f;
                if (nn < 4) x = P->in[I_MWGRP][((size_t)layer * D + k0 + e) * 4 + nn]; else if (nn < 36) x = P->in[I_MWEXP][((size_t)layer * D + k0 + e) * NE + nn - 4];
                const float hi = bf_lo(cvt_pk_bf16(x, 0.f)); w[e] = lo ? x - hi : x; }
            *(u32x4*)(wrt + ((size_t)layer * 256 + n) * D + k0) = pack8(w); } }
    {   const float* src = P->in[I_GWS]; bf16_t* dst = (bf16_t*)(ws + WS_WSP); const int n8 = 2 * 16 * 128 * 128 / 8;
        for (int i = blockIdx.x * NTHR + F.tid; i < n8; i += F.G * NTHR) { const f32x4 a = *(const f32x4*)(src + (size_t)i * 8), b = *(const f32x4*)(src + (size_t)i * 8 + 4);
            u32x4 o; o.x = cvt_pk_bf16(a[0], a[1]); o.y = cvt_pk_bf16(a[2], a[3]); o.z = cvt_pk_bf16(b[0], b[1]); o.w = cvt_pk_bf16(b[2], b[3]); *(u32x4*)(dst + (size_t)i * 8) = o; } }
}
__device__ __forceinline__ void moe_weights_phase(const Frame& F, KP P, int layer) {
    unsigned char* ws = P->ws; LAS float* scr = (LAS float*)(F.lds + F.wave * TR_SCR);
    for (int it = F.gw; it < NE * 768; it += F.NGW) {
        const int e = it / 768, r = it % 768, m = r >> 8, q = r & 255;
        const size_t so = ((size_t)layer * NE + e) * (size_t)D * EHID;
        if (m < 2) { const int kb = q >> 4, n0 = (q & 15) * 32;
            tr_item((m == 0 ? P->in[I_MWG] : P->in[I_MWU]) + so, EHID, D, (bf16_t*)(ws + WS_WGU) + (size_t)e * D * D, D, kb * 64, n0, 256 * (n0 >> 7) + (n0 & 127) + (m == 1 ? 128 : 0), 0, scr, F.lane); }
        else { const int kb = q >> 5, n0 = (q & 31) * 32;
            tr_item(P->in[I_MWD] + so, D, EHID, (bf16_t*)(ws + WS_WD) + (size_t)e * D * EHID, EHID, kb * 64, n0, n0, 0, scr, F.lane); }
    }
}

__device__ __forceinline__ const float* xrow_ptr(KP P, int layer, int row) {
    if (layer == 0) return row < TL ? P->in[I_X] + (size_t)row * D : P->in[I_CTX] + (size_t)(row - TL) * D;
    return (const float*)(P->ws + WS_X) + (size_t)row * D;
}
__device__ __forceinline__ void load_combine(KP P, const Frame& F, int layer, int row, int m, bool combine, f32x4 (&v)[4]) {
    const float* xr = xrow_ptr(P, layer, row);
#pragma unroll
    for (int j = 0; j < 4; ++j) v[j] = *(const f32x4*)(xr + 4 * F.lane + 256 * j);
    if (combine) {
        const bf16_t* yb = (const bf16_t*)(P->ws + WS_YB); const float* wg = (const float*)(P->ws + WS_WGT);
        const float w0 = wg[2 * row], w1 = wg[2 * row + 1]; const float* g2 = (const float*)(P->ws + WS_MOD) + ((size_t)(layer - 1) * 3 + m) * 6 * D + 5 * D;
#pragma unroll
        for (int j = 0; j < 4; ++j) { const int col = 4 * F.lane + 256 * j; const u32x2 a = *(const u32x2*)(yb + (size_t)(2 * row) * D + col), b = *(const u32x2*)(yb + (size_t)(2 * row + 1) * D + col);
            const f32x4 g = *(const f32x4*)(g2 + col);
            v[j][0] += g[0] * (w0 * bf_lo(a.x) + w1 * bf_lo(b.x)); v[j][1] += g[1] * (w0 * bf_hi(a.x) + w1 * bf_hi(b.x));
            v[j][2] += g[2] * (w0 * bf_lo(a.y) + w1 * bf_lo(b.y)); v[j][3] += g[3] * (w0 * bf_hi(a.y) + w1 * bf_hi(b.y)); }
    }
}
__device__ __forceinline__ void norm1_phase(const Frame& F, KP P, int layer) {
    const bool combine = layer > 0; float* X = (float*)(P->ws + WS_X); bf16_t* HL = (bf16_t*)(P->ws + WS_HL);
    const float* g1 = P->in[I_N1G] + (size_t)layer * D;
    for (int row = F.gw; row < T; row += F.NGW) {
        const int m = row < TL ? (row >> 14) : 2; f32x4 v[4];
        load_combine(P, F, layer, row, m, combine, v);
        if (combine) {
#pragma unroll
            for (int j = 0; j < 4; ++j) *(f32x4*)(X + (size_t)row * D + 4 * F.lane + 256 * j) = v[j]; }
        float ss = 0.f;
#pragma unroll
        for (int j = 0; j < 4; ++j) ss += (v[j][0] * v[j][0] + v[j][1] * v[j][1]) + (v[j][2] * v[j][2] + v[j][3] * v[j][3]);
        const float rstd = rsqrtf(wave_sum(ss) * (1.0f / D) + 1e-6f);
        const float* mod = (const float*)(P->ws + WS_MOD) + ((size_t)layer * 3 + m) * 6 * D;
#pragma unroll
        for (int j = 0; j < 4; ++j) { const int col = 4 * F.lane + 256 * j; const f32x4 g = *(const f32x4*)(g1 + col), sh = *(const f32x4*)(mod + col), sc = *(const f32x4*)(mod + D + col);
            const f32x4 h = (v[j] * rstd) * g * (sc + 1.0f) + sh;
            u32x2 o; o.x = cvt_pk_bf16(h[0], h[1]); o.y = cvt_pk_bf16(h[2], h[3]); *(u32x2*)(HL + (size_t)row * D + col) = o; }
    }
}
__device__ __forceinline__ void final_phase(const Frame& F, KP P) {
    const float* fg = P->in[I_FG];
    for (int row = F.gw; row < TL; row += F.NGW) {
        const int m = row >> 14; f32x4 v[4];
        load_combine(P, F, DEPTH, row, m, true, v);
        float ss = 0.f;
#pragma unroll
        for (int j = 0; j < 4; ++j) ss += (v[j][0] * v[j][0] + v[j][1] * v[j][1]) + (v[j][2] * v[j][2] + v[j][3] * v[j][3]);
        const float rstd = rsqrtf(wave_sum(ss) * (1.0f / D) + 1e-6f);
#pragma unroll
        for (int j = 0; j < 4; ++j) { const int col = 4 * F.lane + 256 * j; *(f32x4*)(P->out + (size_t)row * D + col) = (v[j] * rstd) * *(const f32x4*)(fg + col); }
    }
}
__device__ __forceinline__ void norm2_phase(const Frame& F, KP P, int layer) {
    const int ntok = layer == DEPTH - 1 ? TL : T; bf16_t* HL2 = (bf16_t*)(P->ws + WS_HL); const float* g2n = P->in[I_N2G] + (size_t)layer * D;
    for (int row = F.gw; row < ntok; row += F.NGW) {
        const int m = row < TL ? (row >> 14) : 2; const float* xr = xrow_ptr(P, 1, row); f32x4 v[4];
#pragma unroll
        for (int j = 0; j < 4; ++j) v[j] = *(const f32x4*)(xr + 4 * F.lane + 256 * j);
        float ss = 0.f;
#pragma unroll
        for (int j = 0; j < 4; ++j) ss += (v[j][0] * v[j][0] + v[j][1] * v[j][1]) + (v[j][2] * v[j][2] + v[j][3] * v[j][3]);
        const float rstd = rsqrtf(wave_sum(ss) * (1.0f / D) + 1e-6f);
        const float* mod = (const float*)(P->ws + WS_MOD) + ((size_t)layer * 3 + m) * 6 * D;
#pragma unroll
        for (int j = 0; j < 4; ++j) { const int col = 4 * F.lane + 256 * j; const f32x4 g = *(const f32x4*)(g2n + col), sh = *(const f32x4*)(mod + 3 * D + col), sc = *(const f32x4*)(mod + 4 * D + col);
            const f32x4 h = (v[j] * rstd) * g * (sc + 1.0f) + sh;
            u32x2 o; o.x = cvt_pk_bf16(h[0], h[1]); o.y = cvt_pk_bf16(h[2], h[3]); *(u32x2*)(HL2 + (size_t)row * D + col) = o; }
    }
    moe_weights_phase(F, P, layer);
}
__device__ __forceinline__ void route_phase(const Frame& F, KP P, int layer) {
    const int ntok = layer == DEPTH - 1 ? TL : T; const float* LG = (const float*)(P->ws + WS_LG);
    const float* bgrp = P->in[I_MBGRP] + layer * 4; const float* bexp = P->in[I_MBEXP] + layer * NE;
    unsigned* cnt = (unsigned*)(P->ws + WS_CTL) + CW_CNT + layer * 64; int* list = (int*)(P->ws + WS_LIST); float* wgt = (float*)(P->ws + WS_WGT);
    LAS unsigned* lcnt = (LAS unsigned*)F.lds; LAS unsigned* lbase = lcnt + 32;
    for (int r0 = blockIdx.x * NTHR; r0 < ntok; r0 += F.G * NTHR) {
        const int row = r0 + F.tid; const bool act = row < ntok;
        __syncthreads();
        if (F.tid < 32) lcnt[F.tid] = 0u;
        __syncthreads();
        int e0 = 0, e1 = 0; unsigned k0 = 0, k1 = 0;
        if (act) {
            const float* lg = LG + (size_t)row * 64; const f32x4 g4 = *(const f32x4*)lg;
            float ag[4];
#pragma unroll
            for (int i = 0; i < 4; ++i) ag[i] = g4[i] + bgrp[i];
            int grp = 0; float mx = ag[0];
#pragma unroll
            for (int i = 1; i < 4; ++i) if (ag[i] > mx) { mx = ag[i]; grp = i; }
            float den = 0.f;
#pragma unroll
            for (int i = 0; i < 4; ++i) den += __expf(ag[i] - mx);
            const float pg = 1.0f / den;
            const f32x4 e0v = *(const f32x4*)(lg + 4 + 8 * grp), e1v = *(const f32x4*)(lg + 8 + 8 * grp); const f32x4 b0v = *(const f32x4*)(bexp + 8 * grp), b1v = *(const f32x4*)(bexp + 8 * grp + 4);
            float el[8];
#pragma unroll
            for (int i = 0; i < 4; ++i) { el[i] = e0v[i] + b0v[i]; el[4 + i] = e1v[i] + b1v[i]; }
            int i0 = 0; float t0 = el[0];
#pragma unroll
            for (int i = 1; i < 8; ++i) if (el[i] > t0) { t0 = el[i]; i0 = i; }
            int i1 = -1; float t1 = -3.0e38f;
#pragma unroll
            for (int i = 0; i < 8; ++i) if (i != i0 && el[i] > t1) { t1 = el[i]; i1 = i; }
            const float p0 = 1.0f / (1.0f + __expf(t1 - t0));
            wgt[2 * row] = pg * p0; wgt[2 * row + 1] = pg * (1.0f - p0);
            e0 = grp * 8 + i0; e1 = grp * 8 + i1;
            k0 = atomicAdd((unsigned*)(lcnt + e0), 1u); k1 = atomicAdd((unsigned*)(lcnt + e1), 1u);
        }
        __syncthreads();
        if (F.tid < 32) { const unsigned c = lcnt[F.tid]; lbase[F.tid] = c ? atomicAdd(cnt + F.tid, c) : 0u; }
        __syncthreads();
        if (act) { list[(size_t)e0 * LISTCAP + lbase[e0] + k0] = 2 * row; list[(size_t)e1 * LISTCAP + lbase[e1] + k1] = 2 * row + 1; }
    }
}
__device__ __forceinline__ bf16x8 tr_frag136(const LAS bf16_t* M, int k0, int c0, int lane) {
    LAS bf16_t* p = (LAS bf16_t*)M + (k0 + 8 * (lane >> 4) + ((lane & 15) >> 2)) * 136 + c0 + 4 * (lane & 3);
    const v4s lo = __builtin_amdgcn_ds_read_tr16_b64_v4i16((LAS v4s*)p), hi = __builtin_amdgcn_ds_read_tr16_b64_v4i16((LAS v4s*)(p + 4 * 136));
    return (bf16x8){lo[0], lo[1], lo[2], lo[3], hi[0], hi[1], hi[2], hi[3]};
}
__device__ __forceinline__ void spatial_phase(const Frame& F, KP P, int j) {
    bf16_t* U = (bf16_t*)(P->ws + WS_U); const bf16_t* V = (const bf16_t*)(P->ws + WS_V); const float* stat = (const float*)(P->ws + WS_STAT);
    const bf16_t* WSP = (const bf16_t*)(P->ws + WS_WSP) + (size_t)j * 16 * 128 * 128;
    const float* lng = P->in[I_GLNG] + (size_t)j * GWID; const float* lnb = P->in[I_GLNB] + (size_t)j * GWID; const float* bs = P->in[I_GBS] + (size_t)j * 16 * 128;
    LAS bf16_t* Wt = (LAS bf16_t*)F.lds; LAS bf16_t* Vn = Wt + 128 * 136;
    LAS float* mu = (LAS float*)(F.lds + 2 * 128 * 136 * 2); LAS float* rs = mu + 128;
    const int l15 = F.lane & 15, l4 = F.lane >> 4;
    for (int item = blockIdx.x; item < (T / 128) * 4; item += F.G) {
        const int c = item >> 2, gq = item & 3, t0 = c * 128;
        LDS_BARRIER();
        if (F.tid < 128) { const int row = t0 + F.tid; float s = 0.f, q = 0.f;
#pragma unroll 8
            for (int i = 0; i < 32; ++i) { const f32x2 p = *(const f32x2*)(stat + ((size_t)row * 32 + i) * 2); s += p.x; q += p.y; }
            const float mean = s * (1.0f / GWID), var = q * (1.0f / GWID) - mean * mean; mu[F.tid] = mean; rs[F.tid] = rsqrtf(var + 1e-5f); }
#pragma nounroll
        for (int gi = 0; gi < 4; ++gi) { const int g = gq * 4 + gi;
            u32x4 wv[4], vv[4];
#pragma unroll
            for (int i = 0; i < 4; ++i) { const int idx = F.tid + NTHR * i, r = idx >> 4, seg = idx & 15;
                wv[i] = *(const u32x4*)(WSP + ((size_t)g * 128 + r) * 128 + seg * 8); vv[i] = *(const u32x4*)(V + (size_t)(t0 + r) * GWID + g * 128 + seg * 8); }
            LDS_BARRIER();
#pragma unroll
            for (int i = 0; i < 4; ++i) { const int idx = F.tid + NTHR * i, r = idx >> 4, seg = idx & 15, ch = g * 128 + seg * 8;
                *(LAS u32x4*)(Wt + r * 136 + seg * 8) = wv[i];
                float x[8], o[8]; unpack8(vv[i], x); const float m_ = mu[r], r_ = rs[r];
                const f32x4 g0 = *(const f32x4*)(lng + ch), g1 = *(const f32x4*)(lng + ch + 4), b0 = *(const f32x4*)(lnb + ch), b1 = *(const f32x4*)(lnb + ch + 4);
#pragma unroll
                for (int e = 0; e < 8; ++e) o[e] = (x[e] - m_) * r_ * (e < 4 ? g0[e & 3] : g1[e & 3]) + (e < 4 ? b0[e & 3] : b1[e & 3]);
                *(LAS u32x4*)(Vn + r * 136 + seg * 8) = pack8(o); }
            LDS_BARRIER();
            bf16x8 bw[4];
#pragma unroll
            for (int ks = 0; ks < 4; ++ks) bw[ks] = *(const LAS bf16x8*)(Wt + (16 * F.wave + l15) * 136 + ks * 32 + 8 * l4);
            const int p = 16 * F.wave + l15; const float bias = bs[g * 128 + p];
            bf16_t* urow = U + (size_t)(t0 + p) * GWID + g * 128 + 4 * l4;
            u32x2 uu[8];
#pragma unroll
            for (int dt = 0; dt < 8; ++dt) uu[dt] = *(const u32x2*)(urow + dt * 16);
#pragma unroll
            for (int dt = 0; dt < 8; ++dt) { f32x4 acc = (f32x4){0.f, 0.f, 0.f, 0.f};
#pragma unroll
                for (int ks = 0; ks < 4; ++ks) { const bf16x8 a = tr_frag136(Vn, 32 * ks, 16 * dt, F.lane); acc = __builtin_amdgcn_mfma_f32_16x16x32_bf16(a, bw[ks], acc, 0, 0, 0); }
                u32x2 o; o.x = cvt_pk_bf16(bf_lo(uu[dt].x) * (acc[0] + bias), bf_hi(uu[dt].x) * (acc[1] + bias)); o.y = cvt_pk_bf16(bf_lo(uu[dt].y) * (acc[2] + bias), bf_hi(uu[dt].y) * (acc[3] + bias));
                *(u32x2*)(urow + dt * 16) = o; }
        }
    }
}

__device__ __forceinline__ void mix_phase(const Frame& F, KP P, int j) {
    const bf16_t* HL = (const bf16_t*)(P->ws + WS_HL); const float* mu = P->in[I_MU] + (size_t)j * 6 * D;
    bf16_t* outs[6] = {(bf16_t*)(P->ws + WS_XR), (bf16_t*)(P->ws + WS_XW), (bf16_t*)(P->ws + WS_XK), (bf16_t*)(P->ws + WS_XV), (bf16_t*)(P->ws + WS_XA), (bf16_t*)(P->ws + WS_XG)};
    for (int row = F.gw; row < T; row += F.NGW) {
        bool ok[2]; int src[2]; const bool hi = F.lane >= 32;
        if (row < TL) { const int n = row & (SEQ - 1), gc = n & 63, gr = n >> 6;
            ok[0] = hi ? gc < 63 : gc > 0; src[0] = hi ? row + 1 : row - 1; ok[1] = hi ? gr < 255 : gr > 0; src[1] = hi ? row + 64 : row - 64; }
        else { const int n = (row - TL) & (CTXL - 1); ok[0] = n > 0; src[0] = row - 1; ok[1] = n < CTXL - 1; src[1] = row + 1; }
#pragma unroll
        for (int jj = 0; jj < 2; ++jj) { const int col = 512 * jj + 8 * F.lane;
            const u32x4 h8 = *(const u32x4*)(HL + (size_t)row * D + col); u32x4 s8 = (u32x4){0u, 0u, 0u, 0u};
            if (ok[jj]) s8 = *(const u32x4*)(HL + (size_t)src[jj] * D + col);
            const unsigned hw[4] = {h8.x, h8.y, h8.z, h8.w}, sw[4] = {s8.x, s8.y, s8.z, s8.w}; float h[8], xx[8];
#pragma unroll
            for (int e = 0; e < 8; ++e) { h[e] = (e & 1) ? bf_hi(hw[e >> 1]) : bf_lo(hw[e >> 1]); const float s = (e & 1) ? bf_hi(sw[e >> 1]) : bf_lo(sw[e >> 1]); xx[e] = s - h[e]; }
#pragma unroll
            for (int m = 0; m < 6; ++m) { const f32x4 ma = *(const f32x4*)(mu + (size_t)m * D + col), mb = *(const f32x4*)(mu + (size_t)m * D + col + 4);
                u32x4 o; o.x = cvt_pk_bf16(h[0] + xx[0] * ma[0], h[1] + xx[1] * ma[1]); o.y = cvt_pk_bf16(h[2] + xx[2] * ma[2], h[3] + xx[3] * ma[3]);
                o.z = cvt_pk_bf16(h[4] + xx[4] * mb[0], h[5] + xx[5] * mb[1]); o.w = cvt_pk_bf16(h[6] + xx[6] * mb[2], h[7] + xx[7] * mb[3]);
                *(u32x4*)(outs[m] + (size_t)row * D + col) = o; } }
    }
}

constexpr int NSC = 65, NSCAN = 64, TP = 72, TILE_B = 64 * TP * 2;
enum { T_AT = 0, T_RT, T_BT, T_KT, T_VM, T_NT, T_MT, T_NRT, T_MRT, T_APA, T_APB, T_TAA, T_TAB, T_PRB, T_QRB, T_NTILE };
constexpr int LDS_GL = T_NTILE * TILE_B, LDS_SEG = LDS_GL + 256;
static_assert(LDS_SEG + 2048 <= LDS_MISC, "scan LDS map");
__device__ __forceinline__ int scan_row(int z, int b, int p) {
    if (p < CTXL) return TL + b * CTXL + (z ? CTXL - 1 - p : p);
    const int q = p - CTXL; return b * SEQ + (z ? SEQ - 1 - q : q);
}
__device__ __forceinline__ LAS bf16_t* stile(LAS unsigned char* lds, int n) { return (LAS bf16_t*)(lds + n * TILE_B); }
__device__ __forceinline__ bf16x8 row_frag(const LAS bf16_t* M, int r0, int k0, int lane) { return *(const LAS bf16x8*)(M + (r0 + (lane & 15)) * TP + k0 + 8 * (lane >> 4)); }
__device__ __forceinline__ bf16x8 tr_frag(const LAS bf16_t* M, int k0, int c0, int lane) {
    LAS bf16_t* p = (LAS bf16_t*)M + (k0 + 8 * (lane >> 4) + ((lane & 15) >> 2)) * TP + c0 + 4 * (lane & 3);
    const v4s lo = __builtin_amdgcn_ds_read_tr16_b64_v4i16((LAS v4s*)p), hi = __builtin_amdgcn_ds_read_tr16_b64_v4i16((LAS v4s*)(p + 4 * TP));
    return (bf16x8){lo[0], lo[1], lo[2], lo[3], hi[0], hi[1], hi[2], hi[3]};
}
template <bool XT, bool YT>
__device__ __forceinline__ void mm64(const LAS bf16_t* X, const LAS bf16_t* Y, f32x4 (&acc)[2], int wq, int wh, int lane) {
#pragma unroll
    for (int ks = 0; ks < 2; ++ks) {
        const bf16x8 b = XT ? tr_frag(X, 32 * ks, 16 * wq, lane) : row_frag(X, 16 * wq, 32 * ks, lane);
#pragma unroll
        for (int q = 0; q < 2; ++q) { const int i0 = 16 * (2 * wh + q);
            const bf16x8 a = YT ? row_frag(Y, i0, 32 * ks, lane) : tr_frag(Y, 32 * ks, i0, lane);
            acc[q] = __builtin_amdgcn_mfma_f32_16x16x32_bf16(a, b, acc[q], 0, 0, 0); }
    }
}
__device__ __forceinline__ void st_tile(LAS bf16_t* Z, const f32x4 (&acc)[2], int wq, int wh, int lane) {
#pragma unroll
    for (int q = 0; q < 2; ++q) { u32x2 o; o.x = cvt_pk_bf16(acc[q][0], acc[q][1]); o.y = cvt_pk_bf16(acc[q][2], acc[q][3]);
        *(LAS u32x2*)(Z + (16 * wq + (lane & 15)) * TP + 16 * (2 * wh + q) + 4 * (lane >> 4)) = o; }
}
__device__ __forceinline__ void ld_tile(const LAS bf16_t* Z, f32x4 (&acc)[2], int wq, int wh, int lane) {
#pragma unroll
    for (int q = 0; q < 2; ++q) { const u32x2 o = *(const LAS u32x2*)(Z + (16 * wq + (lane & 15)) * TP + 16 * (2 * wh + q) + 4 * (lane >> 4));
        acc[q] = (f32x4){bf_lo(o.x), bf_hi(o.x), bf_lo(o.y), bf_hi(o.y)}; }
}
struct ChunkRegs { u32x4 r, k, v, tw, ta; };
__device__ __forceinline__ void scan_load(KP P, const Frame& F, int item, int c4, ChunkRegs& R) {
    const int s = item & 63, sc = item >> 6, z = s >> 5, b = (s >> 4) & 1, hh = s & 15;
    const size_t row = (size_t)scan_row(z, b, sc * 256 + c4 * 64 + (F.tid >> 3)); const size_t o = row * D + hh * 64 + (F.tid & 7) * 8, o2 = row * 256 + z * 64 + (F.tid & 7) * 8;
    R.r = *(const u32x4*)((const bf16_t*)(P->ws + WS_R) + o); R.k = *(const u32x4*)((const bf16_t*)(P->ws + WS_K) + o); R.v = *(const u32x4*)((const bf16_t*)(P->ws + WS_VV) + o);
    R.tw = *(const u32x4*)((const bf16_t*)(P->ws + WS_TW) + o2); R.ta = *(const u32x4*)((const bf16_t*)(P->ws + WS_TA) + o2);
}
__device__ __forceinline__ void scan_chunk_phase(const Frame& F, KP P, int j) {
    LAS unsigned char* lds = F.lds;
    LAS bf16_t* At = stile(lds, T_AT); LAS bf16_t* Rt = stile(lds, T_RT); LAS bf16_t* Bt = stile(lds, T_BT); LAS bf16_t* Kt = stile(lds, T_KT); LAS bf16_t* Vm = stile(lds, T_VM);
    LAS bf16_t* NT = stile(lds, T_NT); LAS bf16_t* MT = stile(lds, T_MT); LAS bf16_t* NrT = stile(lds, T_NRT); LAS bf16_t* MrT = stile(lds, T_MRT);
    LAS bf16_t* ApA = stile(lds, T_APA); LAS bf16_t* ApB = stile(lds, T_APB); LAS bf16_t* TaA = stile(lds, T_TAA); LAS bf16_t* TaB = stile(lds, T_TAB);
    LAS bf16_t* PrB = stile(lds, T_PRB); LAS bf16_t* QrB = stile(lds, T_QRB);
    LAS float* gl = (LAS float*)(lds + LDS_GL); LAS float* seg = (LAS float*)(lds + LDS_SEG);
    const int lane = F.lane, wq = F.wave & 3, wh = F.wave >> 2, l15 = lane & 15, l4 = lane >> 4;
    const int pi = F.tid >> 3, kq = F.tid & 7;
    const int jrow = 16 * wq + l15;
    const int NITEM = NSCAN * NSC;
    int item = blockIdx.x; if (item >= NITEM) return;
    ChunkRegs cur, nxt; scan_load(P, F, item, 0, cur); nxt = cur;
    f32x4 Pr[2], Qr[2], aYp[2], aQp[2];
#pragma unroll
    for (int q = 0; q < 2; ++q) { Pr[q] = (f32x4){0.f, 0.f, 0.f, 0.f}; Qr[q] = Pr[q]; aYp[q] = Pr[q]; aQp[q] = Pr[q]; }
    bool pend = false; size_t orowp = 0; bf16_t* GEp = nullptr; bf16_t* YEp = nullptr; float* pqp = nullptr; bool lastp = false;
#define SCAN_STAGE_G() do { \
        f32x4 ge[2] = {(f32x4){0.f, 0.f, 0.f, 0.f}, (f32x4){0.f, 0.f, 0.f, 0.f}}; \
        mm64<false, true>(NT, PrB, ge, wq, wh, lane); mm64<false, true>(NT, QrB, aYp, wq, wh, lane); \
        f32x4 pn[2] = {(f32x4){0.f, 0.f, 0.f, 0.f}, (f32x4){0.f, 0.f, 0.f, 0.f}}; \
        mm64<false, false>(PrB, MT, pn, wq, wh, lane); mm64<false, false>(QrB, MT, aQp, wq, wh, lane); \
        _Pragma("unroll") for (int q = 0; q < 2; ++q) { const int i0 = 16 * (2 * wh + q) + 4 * l4; \
            u32x2 o; o.x = cvt_pk_bf16(ge[q][0], ge[q][1]); o.y = cvt_pk_bf16(ge[q][2], ge[q][3]); *(u32x2*)(GEp + orowp + i0) = o; \
            u32x2 y; y.x = cvt_pk_bf16(aYp[q][0], aYp[q][1]); y.y = cvt_pk_bf16(aYp[q][2], aYp[q][3]); *(u32x2*)(YEp + orowp + i0) = y; \
            Pr[q] = pn[q]; Qr[q] = aQp[q]; } \
        if (lastp) { _Pragma("unroll") for (int q = 0; q < 2; ++q) { const int i0 = 16 * (2 * wh + q) + 4 * l4; *(f32x4*)(pqp + jrow * 64 + i0) = Pr[q]; *(f32x4*)(pqp + 4096 + jrow * 64 + i0) = Qr[q]; } } \
    } while (0)
    for (;;) {
        const int s = item & 63, sc = item >> 6, z = s >> 5, b = (s >> 4) & 1, hh = s & 15;
        const float* kkw = P->in[I_KK] + (size_t)j * D + hh * 64 + kq * 8; const float* kap = P->in[I_KA] + (size_t)j * D + hh * 64 + kq * 8; const float* rkp = P->in[I_RK] + (size_t)j * D + hh * 64 + kq * 8;
        const float* w0p = P->in[I_W0] + ((size_t)j * 2 + z) * D + hh * 64; const float* a0p = P->in[I_A0] + ((size_t)j * 2 + z) * D + hh * 64;
        float* bon = (float*)(P->ws + WS_BON) + (size_t)z * T * 16;
        const u32x4 w2r = *(const u32x4*)((const bf16_t*)(P->ws + WS_W2P) + (((size_t)j * 2 + z) * D + hh * 64 + pi) * 256 + z * 64 + kq * 8);
        const u32x4 a2r = *(const u32x4*)((const bf16_t*)(P->ws + WS_A2P) + (((size_t)j * 2 + z) * D + hh * 64 + pi) * 256 + z * 64 + kq * 8);
        bf16_t* GE = (bf16_t*)(P->ws + (z ? WS_AS1 : WS_AS0)); bf16_t* YE = (bf16_t*)(P->ws + (z ? WS_ELOG1 : WS_ELOG0));
        float* pq = (float*)(P->ws + WS_PQ) + ((size_t)(s * NSC + sc) * 2) * 4096;
#pragma nounroll
        for (int c4 = 0; c4 < 4; ++c4) {
            *(LAS u32x4*)(ApA + pi * TP + kq * 8) = cur.tw; *(LAS u32x4*)(ApB + pi * TP + kq * 8) = cur.ta; *(LAS u32x4*)(NrT + pi * TP + kq * 8) = w2r; *(LAS u32x4*)(MrT + pi * TP + kq * 8) = a2r;
            LDS_BARRIER();
            {   f32x4 lw[2] = {(f32x4){0.f, 0.f, 0.f, 0.f}, (f32x4){0.f, 0.f, 0.f, 0.f}}, la[2] = {(f32x4){0.f, 0.f, 0.f, 0.f}, (f32x4){0.f, 0.f, 0.f, 0.f}};
                mm64<false, true>(ApA, NrT, lw, wq, wh, lane); mm64<false, true>(ApB, MrT, la, wq, wh, lane);
#pragma unroll
                for (int q = 0; q < 2; ++q) { const int i0 = 16 * (2 * wh + q) + 4 * l4; const f32x4 w04 = *(const f32x4*)(w0p + i0), a04 = *(const f32x4*)(a0p + i0);
#pragma unroll
                    for (int r = 0; r < 4; ++r) { const float xx = -(w04[r] + lw[q][r]); const float sp = fmaxf(xx, 0.f) + __logf(1.0f + __expf(-fabsf(xx))); lw[q][r] = -__expf(-sp - 0.5f); la[q][r] = sigmoidf_(a04[r] + la[q][r]); } }
                st_tile(TaA, lw, wq, wh, lane); st_tile(TaB, la, wq, wh, lane); }
            LDS_BARRIER();
            float r8[8], k8[8], e8[8], m8[8], a8[8], kk8[8], c8[8];
            { const u32x4 et = *(const LAS u32x4*)(TaA + pi * TP + kq * 8), at = *(const LAS u32x4*)(TaB + pi * TP + kq * 8); unpack8(cur.r, r8); unpack8(cur.k, k8); unpack8(et, e8); unpack8(at, a8); }
            {   const f32x4 ka0 = *(const f32x4*)(kap), ka1 = *(const f32x4*)(kap + 4), rk0 = *(const f32x4*)(rkp), rk1 = *(const f32x4*)(rkp + 4); float bp = 0.f;
#pragma unroll
                for (int e = 0; e < 8; ++e) { m8[e] = k8[e] * (1.0f + (a8[e] - 1.0f) * (e < 4 ? ka0[e & 3] : ka1[e & 3])); bp += r8[e] * (e < 4 ? rk0[e & 3] : rk1[e & 3]) * m8[e]; }
                bp += __shfl_xor(bp, 1); bp += __shfl_xor(bp, 2); bp += __shfl_xor(bp, 4);
                if (kq == 0) bon[(size_t)scan_row(z, b, sc * 256 + c4 * 64 + pi) * 16 + hh] = bp; }
            { const f32x4 w0 = *(const f32x4*)kkw, w1 = *(const f32x4*)(kkw + 4); float ss = 0.f;
#pragma unroll
              for (int e = 0; e < 8; ++e) { kk8[e] = k8[e] * (e < 4 ? w0[e & 3] : w1[e & 3]); ss += kk8[e] * kk8[e]; }
              ss += __shfl_xor(ss, 1); ss += __shfl_xor(ss, 2); ss += __shfl_xor(ss, 4);
              const float rn = rsqrtf(ss + 1e-12f);
#pragma unroll
              for (int e = 0; e < 8; ++e) { kk8[e] *= rn; c8[e] = e8[e]; } }
#pragma unroll
            for (int d = 8; d < 64; d <<= 1) {
#pragma unroll
                for (int e = 0; e < 8; ++e) { const float t = __shfl_up(c8[e], d); c8[e] += lane >= d ? t : 0.f; } }
            if (lane >= 56) { *(LAS f32x4*)(seg + F.wave * 64 + kq * 8) = (f32x4){c8[0], c8[1], c8[2], c8[3]}; *(LAS f32x4*)(seg + F.wave * 64 + kq * 8 + 4) = (f32x4){c8[4], c8[5], c8[6], c8[7]}; }
            if (pend) { SCAN_STAGE_G(); pend = false; }
            LDS_BARRIER();
            if (c4 > 0) { st_tile(PrB, Pr, wq, wh, lane); st_tile(QrB, Qr, wq, wh, lane); }
            { float cum[8];
#pragma unroll
              for (int e = 0; e < 8; ++e) cum[e] = c8[e];
              for (int w2 = 0; w2 < F.wave; ++w2) { const f32x4 o0 = *(const LAS f32x4*)(seg + w2 * 64 + kq * 8), o1 = *(const LAS f32x4*)(seg + w2 * 64 + kq * 8 + 4);
#pragma unroll
                  for (int e = 0; e < 8; ++e) cum[e] += e < 4 ? o0[e & 3] : o1[e & 3]; }
              float o[8];
#pragma unroll
              for (int e = 0; e < 8; ++e) o[e] = -kk8[e] * __expf(cum[e] - e8[e]);
              *(LAS u32x4*)(At + pi * TP + kq * 8) = pack8(o);
#pragma unroll
              for (int e = 0; e < 8; ++e) o[e] = r8[e] * __expf(cum[e]);
              *(LAS u32x4*)(Rt + pi * TP + kq * 8) = pack8(o);
              float en[8];
#pragma unroll
              for (int e = 0; e < 8; ++e) { en[e] = __expf(-cum[e]); o[e] = kk8[e] * a8[e] * en[e]; }
              *(LAS u32x4*)(Bt + pi * TP + kq * 8) = pack8(o);
#pragma unroll
              for (int e = 0; e < 8; ++e) o[e] = m8[e] * en[e];
              *(LAS u32x4*)(Kt + pi * TP + kq * 8) = pack8(o);
              *(LAS u32x4*)(Vm + pi * TP + kq * 8) = cur.v;
              if (pi == 63) {
#pragma unroll
                  for (int e = 0; e < 8; ++e) gl[kq * 8 + e] = __expf(cum[e]); } }
            { const int nitem = c4 < 3 ? item : item + (int)gridDim.x, nc4 = c4 < 3 ? c4 + 1 : 0; if (nitem < NITEM) scan_load(P, F, nitem, nc4, nxt); }
            LDS_BARRIER();
            {   f32x4 aN[2], aM[2], aNr[2], aMr[2];
#pragma unroll
                for (int q = 0; q < 2; ++q) { aN[q] = (f32x4){0.f, 0.f, 0.f, 0.f}; aM[q] = aN[q]; aNr[q] = aN[q]; aMr[q] = aN[q]; }
                mm64<false, true>(At, Bt, aN, wq, wh, lane); mm64<false, true>(At, Kt, aM, wq, wh, lane); mm64<false, true>(Rt, Bt, aNr, wq, wh, lane); mm64<false, true>(Rt, Kt, aMr, wq, wh, lane);
                f32x4 aT[2];
#pragma unroll
                for (int q = 0; q < 2; ++q)
#pragma unroll
                    for (int r = 0; r < 4; ++r) { const int i = 16 * (2 * wh + q) + 4 * l4 + r; const bool lt = i < jrow, le = i <= jrow;
                        aN[q][r] = lt ? aN[q][r] : 0.f; aM[q][r] = lt ? aM[q][r] : 0.f; aNr[q][r] = le ? aNr[q][r] : 0.f; aMr[q][r] = le ? aMr[q][r] : 0.f; aT[q][r] = aN[q][r] + (i == jrow ? 1.f : 0.f); }
                st_tile(NT, aN, wq, wh, lane); st_tile(MT, aM, wq, wh, lane); st_tile(NrT, aNr, wq, wh, lane); st_tile(MrT, aMr, wq, wh, lane); st_tile(TaA, aT, wq, wh, lane);
            }
            LDS_BARRIER();
            {   f32x4 a2[2] = {(f32x4){0.f, 0.f, 0.f, 0.f}, (f32x4){0.f, 0.f, 0.f, 0.f}}; mm64<false, false>(NT, NT, a2, wq, wh, lane); st_tile(ApA, a2, wq, wh, lane); }
            LDS_BARRIER();
#pragma nounroll
            for (int it = 0; it < 2; ++it) {
                {   f32x4 t[2]; ld_tile(TaA, t, wq, wh, lane); mm64<false, false>(TaA, ApA, t, wq, wh, lane); st_tile(TaB, t, wq, wh, lane);
                    f32x4 a2[2] = {(f32x4){0.f, 0.f, 0.f, 0.f}, (f32x4){0.f, 0.f, 0.f, 0.f}}; mm64<false, false>(ApA, ApA, a2, wq, wh, lane); st_tile(ApB, a2, wq, wh, lane);
                    if (it == 0) { f32x4 x[2] = {(f32x4){0.f, 0.f, 0.f, 0.f}, (f32x4){0.f, 0.f, 0.f, 0.f}}; mm64<true, true>(Vm, MT, x, wq, wh, lane); st_tile(NT, x, wq, wh, lane); } }
                LDS_BARRIER();
                {   f32x4 t[2]; ld_tile(TaB, t, wq, wh, lane); mm64<false, false>(TaB, ApB, t, wq, wh, lane); st_tile(TaA, t, wq, wh, lane);
                    f32x4 a2[2] = {(f32x4){0.f, 0.f, 0.f, 0.f}, (f32x4){0.f, 0.f, 0.f, 0.f}}; mm64<false, false>(ApB, ApB, a2, wq, wh, lane); st_tile(ApA, a2, wq, wh, lane); }
                LDS_BARRIER();
            }
            {   f32x4 t[2]; ld_tile(TaA, t, wq, wh, lane); mm64<false, false>(TaA, ApA, t, wq, wh, lane); st_tile(TaB, t, wq, wh, lane); }
            LDS_BARRIER();
            {   f32x4 w[2] = {(f32x4){0.f, 0.f, 0.f, 0.f}, (f32x4){0.f, 0.f, 0.f, 0.f}}; mm64<true, true>(At, TaB, w, wq, wh, lane); st_tile(ApA, w, wq, wh, lane);
                f32x4 u[2] = {(f32x4){0.f, 0.f, 0.f, 0.f}, (f32x4){0.f, 0.f, 0.f, 0.f}}; mm64<false, true>(NT, TaB, u, wq, wh, lane); st_tile(TaA, u, wq, wh, lane); }
            LDS_BARRIER();
            f32x4 aP[2], aQ[2], aG[2], aY[2];
#pragma unroll
            for (int q = 0; q < 2; ++q) { aP[q] = (f32x4){0.f, 0.f, 0.f, 0.f}; aQ[q] = aP[q]; aG[q] = aP[q]; aY[q] = aP[q]; }
            mm64<false, false>(ApA, Bt, aP, wq, wh, lane);
            mm64<false, false>(TaA, Bt, aQ, wq, wh, lane); mm64<true, false>(Vm, Kt, aQ, wq, wh, lane);
            mm64<false, true>(NrT, ApA, aG, wq, wh, lane);
            mm64<false, true>(NrT, TaA, aY, wq, wh, lane); mm64<false, false>(MrT, Vm, aY, wq, wh, lane);
#pragma unroll
            for (int q = 0; q < 2; ++q) { const int i0 = 16 * (2 * wh + q) + 4 * l4; const f32x4 g4 = *(const LAS f32x4*)(gl + i0);
                const u32x2 rr = *(const LAS u32x2*)(Rt + jrow * TP + i0);
#pragma unroll
                for (int r = 0; r < 4; ++r) { aP[q][r] = (aP[q][r] + (i0 + r == jrow ? 1.f : 0.f)) * g4[r]; aQ[q][r] *= g4[r]; }
                aG[q][0] += bf_lo(rr.x); aG[q][1] += bf_hi(rr.x); aG[q][2] += bf_lo(rr.y); aG[q][3] += bf_hi(rr.y); }
            const size_t orow = (size_t)scan_row(z, b, sc * 256 + c4 * 64 + jrow) * D + hh * 64;
            if (c4 == 0) {
#pragma unroll
                for (int q = 0; q < 2; ++q) { const int i0 = 16 * (2 * wh + q) + 4 * l4;
                    u32x2 o; o.x = cvt_pk_bf16(aG[q][0], aG[q][1]); o.y = cvt_pk_bf16(aG[q][2], aG[q][3]); *(u32x2*)(GE + orow + i0) = o;
                    u32x2 y; y.x = cvt_pk_bf16(aY[q][0], aY[q][1]); y.y = cvt_pk_bf16(aY[q][2], aY[q][3]); *(u32x2*)(YE + orow + i0) = y;
                    Pr[q] = aP[q]; Qr[q] = aQ[q]; }
            } else {
                st_tile(NT, aG, wq, wh, lane); st_tile(MT, aP, wq, wh, lane);
#pragma unroll
                for (int q = 0; q < 2; ++q) { aYp[q] = aY[q]; aQp[q] = aQ[q]; }
                pend = true; orowp = orow; GEp = GE; YEp = YE; pqp = pq; lastp = c4 == 3;
            }
            cur = nxt;
            LDS_BARRIER();
        }
        item += gridDim.x; if (item >= NITEM) break;
    }
    if (pend) { SCAN_STAGE_G(); }
#undef SCAN_STAGE_G
}
__device__ __forceinline__ void scan_carry_phase(const Frame& F, KP P) {
    if (blockIdx.x >= 4 * NSCAN) return;
    const int s = blockIdx.x >> 2, vs = blockIdx.x & 3, lane = F.lane, l15 = lane & 15, l4 = lane >> 4, v = 16 * vs + l15, T2 = F.wave;
    const float* pq = (const float*)(P->ws + WS_PQ) + (size_t)s * NSC * 2 * 4096; bf16_t* sst = (bf16_t*)(P->ws + WS_SST) + (size_t)s * NSC * 4096;
    LAS f32x4* exch = (LAS f32x4*)F.lds;
    f32x4 S[4]; float ap[4][16], qp[4][4];
#pragma unroll
    for (int t = 0; t < 4; ++t) S[t] = (f32x4){0.f, 0.f, 0.f, 0.f};
#define CARRY_LOAD(slot, step) do { const float* Pm_ = pq + (size_t)(step) * 2 * 4096; \
        _Pragma("unroll") for (int t2i = 0; t2i < 4; ++t2i) _Pragma("unroll") for (int ri = 0; ri < 4; ++ri) ap[slot][t2i * 4 + ri] = Pm_[(16 * l4 + 4 * ri + t2i) * 64 + 4 * l15 + T2]; \
        _Pragma("unroll") for (int r = 0; r < 4; ++r) qp[slot][r] = Pm_[4096 + v * 64 + 16 * l4 + 4 * r + T2]; } while (0)
#define CARRY_STORE(sc_) do { if (T2 == 0) { float o[16]; \
        _Pragma("unroll") for (int r = 0; r < 4; ++r) _Pragma("unroll") for (int t2 = 0; t2 < 4; ++t2) o[4 * r + t2] = S[t2][r]; \
        u32x4 w0, w1; w0.x = cvt_pk_bf16(o[0], o[1]); w0.y = cvt_pk_bf16(o[2], o[3]); w0.z = cvt_pk_bf16(o[4], o[5]); w0.w = cvt_pk_bf16(o[6], o[7]); \
        w1.x = cvt_pk_bf16(o[8], o[9]); w1.y = cvt_pk_bf16(o[10], o[11]); w1.z = cvt_pk_bf16(o[12], o[13]); w1.w = cvt_pk_bf16(o[14], o[15]); \
        *(u32x4*)(sst + (size_t)(sc_) * 4096 + v * 64 + 16 * l4) = w0; *(u32x4*)(sst + (size_t)(sc_) * 4096 + v * 64 + 16 * l4 + 8) = w1; } } while (0)
    if (T2 < 4) {
#pragma unroll
        for (int u = 0; u < 4; ++u) CARRY_LOAD(u, u);
    }
#pragma nounroll
    for (int sc0 = 0; sc0 < NSC - 1; sc0 += 4) {
#pragma unroll
        for (int u = 0; u < 4; ++u) { const int sc = sc0 + u;
            CARRY_STORE(sc);
            if (T2 < 4) {
                f32x4 nw = (f32x4){qp[u][0], qp[u][1], qp[u][2], qp[u][3]};
#pragma unroll
                for (int t2i = 0; t2i < 4; ++t2i)
#pragma unroll
                    for (int ri = 0; ri < 4; ++ri) nw = __builtin_amdgcn_mfma_f32_16x16x4f32(ap[u][t2i * 4 + ri], S[t2i][ri], nw, 0, 0, 0);
                if (sc + 4 < NSC - 1) CARRY_LOAD(u, sc + 4);
                exch[((u & 1) * 4 + T2) * 64 + lane] = nw;
            }
            LDS_BARRIER();
            if (T2 < 4) {
#pragma unroll
                for (int t = 0; t < 4; ++t) S[t] = exch[((u & 1) * 4 + t) * 64 + lane];
            }
        }
    }
    CARRY_STORE(NSC - 1);
#undef CARRY_LOAD
#undef CARRY_STORE
}
__device__ __forceinline__ void scan_out_phase(const Frame& F, KP P, int j) {
    const int lane = F.lane, l15 = lane & 15, l4 = lane >> 4;
    const bf16_t* GE0 = (const bf16_t*)(P->ws + WS_AS0); const bf16_t* GE1 = (const bf16_t*)(P->ws + WS_AS1); const bf16_t* YE0 = (const bf16_t*)(P->ws + WS_ELOG0); const bf16_t* YE1 = (const bf16_t*)(P->ws + WS_ELOG1);
    const bf16_t* Vb = (const bf16_t*)(P->ws + WS_VV); const float* BON = (const float*)(P->ws + WS_BON);
    const bf16_t* GT = (const bf16_t*)(P->ws + WS_GATE); bf16_t* YG = (bf16_t*)(P->ws + WS_YG);
    for (int item = F.gw; item < NBATCH * NH * NSC * 8; item += F.NGW) {
        const int hh = item & 15, oct = (item >> 4) & 7, b = (item >> 7) & 1, blk = item >> 8;
        const int sc0 = blk, sc1 = blk == 0 ? 0 : NSC - blk;
        const bf16_t* s0 = (const bf16_t*)(P->ws + WS_SST) + ((size_t)(b * 16 + hh) * NSC + sc0) * 4096; const bf16_t* s1 = (const bf16_t*)(P->ws + WS_SST) + ((size_t)(32 + b * 16 + hh) * NSC + sc1) * 4096;
        bf16x8 sa0[4][2], sa1[4][2];
#pragma unroll
        for (int vt = 0; vt < 4; ++vt) { const int v = 32 * (vt >> 1) + 8 * (l15 >> 2) + 4 * (vt & 1) + (l15 & 3);
#pragma unroll
            for (int ks = 0; ks < 2; ++ks) { sa0[vt][ks] = *(const bf16x8*)(s0 + v * 64 + 32 * ks + 8 * l4); sa1[vt][ks] = *(const bf16x8*)(s1 + v * 64 + 32 * ks + 8 * l4); } }
        f32x4 lg4[4], lb4[4];
#pragma unroll
        for (int q = 0; q < 4; ++q) { const int c = hh * 64 + 32 * (q >> 1) + 8 * l4 + 4 * (q & 1); lg4[q] = *(const f32x4*)(P->in[I_LNG] + (size_t)j * D + c); lb4[q] = *(const f32x4*)(P->in[I_LNB] + (size_t)j * D + c); }
#pragma nounroll
        for (int ti = 0; ti < 2; ++ti) {
            const int tok = (2 * oct + ti) * 16 + l15; const int row = blk == 0 ? TL + b * CTXL + tok : b * SEQ + (blk - 1) * 256 + tok;
            const size_t o = (size_t)row * D + hh * 64;
            const bf16x8 g00 = *(const bf16x8*)(GE0 + o + 8 * l4), g01 = *(const bf16x8*)(GE0 + o + 32 + 8 * l4), g10 = *(const bf16x8*)(GE1 + o + 8 * l4), g11 = *(const bf16x8*)(GE1 + o + 32 + 8 * l4);
            u32x4 la[2], lc[2], lv[2], lgt[2];
#pragma unroll
            for (int h2 = 0; h2 < 2; ++h2) { const size_t oc = o + 32 * h2 + 8 * l4;
                la[h2] = *(const u32x4*)(YE0 + oc); lc[h2] = *(const u32x4*)(YE1 + oc); lv[h2] = *(const u32x4*)(Vb + oc); lgt[h2] = *(const u32x4*)(GT + oc); }
            const float bn = BON[(size_t)row * 16 + hh] + BON[((size_t)T + row) * 16 + hh];
            __builtin_amdgcn_sched_barrier(0);
            f32x4 y[4]; float s = 0.f; f32x4 vv[4], gg[4];
#pragma unroll
            for (int vt = 0; vt < 4; ++vt) { const int h2 = vt >> 1, hf = vt & 1;
                const unsigned ax = hf ? la[h2].z : la[h2].x, ay = hf ? la[h2].w : la[h2].y, cx = hf ? lc[h2].z : lc[h2].x, cy = hf ? lc[h2].w : lc[h2].y;
                const unsigned vx = hf ? lv[h2].z : lv[h2].x, vy = hf ? lv[h2].w : lv[h2].y, gx = hf ? lgt[h2].z : lgt[h2].x, gy = hf ? lgt[h2].w : lgt[h2].y;
                f32x4 acc = (f32x4){bf_lo(ax) + bf_lo(cx), bf_hi(ax) + bf_hi(cx), bf_lo(ay) + bf_lo(cy), bf_hi(ay) + bf_hi(cy)};
                acc = __builtin_amdgcn_mfma_f32_16x16x32_bf16(sa0[vt][0], g00, acc, 0, 0, 0); acc = __builtin_amdgcn_mfma_f32_16x16x32_bf16(sa0[vt][1], g01, acc, 0, 0, 0);
                acc = __builtin_amdgcn_mfma_f32_16x16x32_bf16(sa1[vt][0], g10, acc, 0, 0, 0); acc = __builtin_amdgcn_mfma_f32_16x16x32_bf16(sa1[vt][1], g11, acc, 0, 0, 0);
                y[vt] = acc; s += (acc[0] + acc[1]) + (acc[2] + acc[3]);
                vv[vt] = (f32x4){bf_lo(vx), bf_hi(vx), bf_lo(vy), bf_hi(vy)}; gg[vt] = (f32x4){bf_lo(gx), bf_hi(gx), bf_lo(gy), bf_hi(gy)}; }
            s += __shfl_xor(s, 16); s += __shfl_xor(s, 32);
            const float mean = s * (1.0f / 64.0f); float q = 0.f;
#pragma unroll
            for (int vt = 0; vt < 4; ++vt) { const f32x4 d = y[vt] - mean; q += (d[0] * d[0] + d[1] * d[1]) + (d[2] * d[2] + d[3] * d[3]); }
            q += __shfl_xor(q, 16); q += __shfl_xor(q, 32);
            const float rstd = rsqrtf(q * (1.0f / 64.0f) + 64e-5f);
#pragma unroll
            for (int h2 = 0; h2 < 2; ++h2) { const f32x4 o0 = (((y[2 * h2] - mean) * rstd) * lg4[2 * h2] + lb4[2 * h2] + vv[2 * h2] * bn) * gg[2 * h2], o1 = (((y[2 * h2 + 1] - mean) * rstd) * lg4[2 * h2 + 1] + lb4[2 * h2 + 1] + vv[2 * h2 + 1] * bn) * gg[2 * h2 + 1];
                u32x4 w; w.x = cvt_pk_bf16(o0[0], o0[1]); w.y = cvt_pk_bf16(o0[2], o0[3]); w.z = cvt_pk_bf16(o1[0], o1[1]); w.w = cvt_pk_bf16(o1[2], o1[3]); *(u32x4*)(YG + o + 32 * h2 + 8 * l4) = w; }
        }
    }
}
__device__ __forceinline__ bool in_range(int lo, int hi, int k) { asm volatile("" : "+s"(lo), "+s"(hi)); return lo <= k && k < hi; }
constexpr int NPH = 46;
template <unsigned KMASK> __global__ void __launch_bounds__(NTHR, 2) mega(Params Pv) {
    extern __shared__ __attribute__((aligned(16))) unsigned char lds_raw[];
    Frame F0; F0.lds = (LAS unsigned char*)lds_raw; F0.tid = threadIdx.x; F0.lane = F0.tid & 63; F0.wave = __builtin_amdgcn_readfirstlane(F0.tid >> 6);
    F0.G = gridDim.x; F0.gw = blockIdx.x * NWAVES + F0.wave; F0.NGW = F0.G * NWAVES;
    LAS unsigned* misc = (LAS unsigned*)(F0.lds + LDS_MISC);
    if (F0.tid < 128) misc[F0.tid] = 0u;
    __syncthreads();
    KP P0 = (KP)__builtin_amdgcn_kernarg_segment_ptr();
    constexpr bool ALL = (KMASK == 0x3ffffu);
    const int lo = ALL ? 0 : P0->ph_lo, hi = ALL ? NPH : P0->ph_hi;
    XcdBarrier bar; bar.bar = (unsigned*)(P0->ws + WS_CTL) + CW_BAR; bar.x = 0; bar.st = (volatile LAS unsigned*)(misc + 8);
    if (ALL || hi - lo > 1) bar = xcd_barrier_post((unsigned*)(P0->ws + WS_CTL) + CW_BAR, (volatile LAS unsigned*)(misc + 8));
#define IN(k) (ALL || in_range(lo, hi, (k)))
#define KIND(q) ((KMASK >> (q)) & 1u)
#define SEAM(k) do { if (IN(k) && IN((k) + 1)) { XcdBarrier b2_ = bar; unsigned* bb_ = bar.bar; asm volatile("" : "+s"(bb_)); b2_.bar = bb_; xcd_barrier(b2_); } } while (0)
#define AMP_T0 const unsigned long long amp_t0 = AMP_MASK ? __builtin_amdgcn_s_memrealtime() : 0ull;
#define AMP_END(kind) do { if (AMP_MASK & (1u << (kind))) { const unsigned long long t1_ = __builtin_amdgcn_s_memrealtime(), dl_ = t1_ + AMP_F * (t1_ - amp_t0); while (__builtin_amdgcn_s_memrealtime() < dl_) __builtin_amdgcn_s_sleep(8); } } while (0)
#define PHASE_ENTRY AMP_T0 KP P = P0; asm volatile("" : "+s"(P)); unsigned char* ws = P->ws; unsigned* ctl = (unsigned*)(ws + WS_CTL); (void)ctl; \
    Frame F = F0; { int t_ = F0.tid; asm volatile("" : "+v"(t_)); F.tid = t_; F.lane = t_ & 63; F.wave = __builtin_amdgcn_readfirstlane(t_ >> 6); F.gw = blockIdx.x * NWAVES + F.wave; }

    if constexpr (KIND(0)) if (IN(0)) { PHASE_ENTRY prologue_phase(F, P); AMP_END(0); }
    SEAM(0);
    for (int lp = 0; lp < 2; ++lp) {
        const int pb = 1 + 22 * lp, la = 2 * lp, lb = 2 * lp + 1;
        if constexpr (KIND(1)) if (IN(pb + 0)) { PHASE_ENTRY norm1_phase(F, P, la); AMP_END(1); }
        SEAM(pb + 0);
        if constexpr (KIND(2)) if (IN(pb + 1)) { PHASE_ENTRY
            __syncthreads(); set_desc(F.lds, 0, ws + WS_HL, ws + WS_WIN + (size_t)lp * 4096 * D * 2, ws + WS_U, 16, 0, 0, ws + WS_V, P->in[I_GBIN] + (size_t)lp * 4096, ws + WS_STAT); __syncthreads();
            SchedMulti<D, D> S{F.lds, T / 256, 16, 1};
            EpiGelu E{F.lds};
            pg8::gemm_phase<EpiGelu, SchedMulti<D, D>, false, D, D, D>(F.lds, S, E);
            AMP_END(2); }
        SEAM(pb + 1);
        if constexpr (KIND(3)) if (IN(pb + 2)) { PHASE_ENTRY spatial_phase(F, P, lp); AMP_END(3); }
        SEAM(pb + 2);
        if constexpr (KIND(4)) if (IN(pb + 3)) { PHASE_ENTRY
            __syncthreads();
            { float* X = (float*)(ws + WS_X);
              set_desc(F.lds, 0, ws + WS_U, ws + WS_WOUT + (size_t)lp * D * GWID * 2, X, 4, 0, 0, la == 0 ? P->in[I_X] : X, la == 0 ? P->in[I_CTX] : X + (size_t)TL * D, P->in[I_GBOUT] + (size_t)lp * D);
              set_desc(F.lds, 1, nullptr, nullptr, nullptr, 0, 0, 0, (const float*)(ws + WS_MOD) + (size_t)la * 3 * 6 * D + 2 * D); }
            __syncthreads();
            SchedMulti<GWID, GWID> S{F.lds, T / 256, 4, 1};
            EpiResid E{F.lds};
            pg8::gemm_phase<EpiResid, SchedMulti<GWID, GWID>, false, GWID, GWID, GWID>(F.lds, S, E);
            AMP_END(4); }
        SEAM(pb + 3);
        if constexpr (KIND(5)) if (IN(pb + 4)) { PHASE_ENTRY norm2_phase(F, P, la); AMP_END(5); }
        SEAM(pb + 4);
        if constexpr (KIND(16)) if (IN(pb + 5)) { PHASE_ENTRY
            __syncthreads(); set_desc(F.lds, 0, ws + WS_HL, ws + WS_WRT + (size_t)la * 256 * D * 2, nullptr, 1, 0, 0); __syncthreads();
            SchedMulti<D, D> S{F.lds, (la == DEPTH - 1 ? TL : T) / 256, 1, 1};
            EpiLogits E{(float*)(ws + WS_LG)};
            pg8::gemm_phase<EpiLogits, SchedMulti<D, D>, false, D, D, D>(F.lds, S, E);
            AMP_END(16); }
        SEAM(pb + 5);
        if constexpr (KIND(17)) if (IN(pb + 6)) { PHASE_ENTRY route_phase(F, P, la); AMP_END(17); }
        SEAM(pb + 6);
        if constexpr (KIND(6)) if (IN(pb + 7)) { PHASE_ENTRY
            moe_tables(F.lds, ctl + CW_CNT + la * 64);
            SchedMoE<D, D, true> S{F.lds, (const char*)(ws + WS_HL), (const char*)(ws + WS_WGU), (const int*)(ws + WS_LIST)};
            EpiSiluGate E{(bf16_t*)(ws + WS_H)};
            pg8::gemm_phase<EpiSiluGate, SchedMoE<D, D, true>, true, D, D, D>(F.lds, S, E);
            AMP_END(6); }
        SEAM(pb + 7);
        if constexpr (KIND(7)) if (IN(pb + 8)) { PHASE_ENTRY
            moe_tables(F.lds, ctl + CW_CNT + la * 64);
            SchedMoE<EHID, EHID, false> S{F.lds, (const char*)(ws + WS_H), (const char*)(ws + WS_WD), (const int*)(ws + WS_LIST)};
            EpiScatter E{F.lds, (bf16_t*)(ws + WS_YB), (const int*)(ws + WS_LIST)};
            pg8::gemm_phase<EpiScatter, SchedMoE<EHID, EHID, false>, false, EHID, EHID, EHID>(F.lds, S, E);
            AMP_END(7); }
        SEAM(pb + 8);
        if constexpr (KIND(1)) if (IN(pb + 9)) { PHASE_ENTRY norm1_phase(F, P, lb); AMP_END(1); }
        SEAM(pb + 9);
        if constexpr (KIND(8)) if (IN(pb + 10)) { PHASE_ENTRY mix_phase(F, P, lp); AMP_END(8); }
        SEAM(pb + 10);
        if constexpr (KIND(9)) if (IN(pb + 11)) { PHASE_ENTRY
            __syncthreads();
            set_desc(F.lds, 0, ws + WS_XR, ws + WS_WR + (size_t)lp * D * D * 2, ws + WS_R, 4, D, 0);
            set_desc(F.lds, 1, ws + WS_XK, ws + WS_WK + (size_t)lp * D * D * 2, ws + WS_K, 4, D, 0);
            set_desc(F.lds, 2, ws + WS_XV, ws + WS_WV + (size_t)lp * D * D * 2, ws + WS_VV, 4, D, 0);
            set_desc(F.lds, 3, ws + WS_XW, ws + WS_LW1 + (size_t)lp * 256 * D * 2, ws + WS_TW, 1, 256, 1);
            set_desc(F.lds, 4, ws + WS_XA, ws + WS_LA1 + (size_t)lp * 256 * D * 2, ws + WS_TA, 1, 256, 0);
            set_desc(F.lds, 5, ws + WS_XG, ws + WS_LG1 + (size_t)lp * 256 * D * 2, ws + WS_TG, 1, 256, 2);
            __syncthreads();
            SchedMulti<D, D> S{F.lds, T / 256, 15, 6};
            EpiAct E{F.lds};
            pg8::gemm_phase<EpiAct, SchedMulti<D, D>, false, D, D, D>(F.lds, S, E);
            AMP_END(9); }
        SEAM(pb + 11);
        if constexpr (KIND(10)) if (IN(pb + 12)) { PHASE_ENTRY
            __syncthreads(); set_desc(F.lds, 0, ws + WS_TG, ws + WS_G2P + (size_t)lp * D * 256 * 2, ws + WS_GATE, 4, D, 0); __syncthreads();
            SchedMulti<256, 256> S{F.lds, T / 256, 4, 1};
            EpiAct E{F.lds};
            pg8::gemm_phase<EpiAct, SchedMulti<256, 256>, false, 256, 256, 256>(F.lds, S, E);
            AMP_END(10); }
        SEAM(pb + 12);
        if constexpr (KIND(11)) if (IN(pb + 13)) { PHASE_ENTRY scan_chunk_phase(F, P, lp); AMP_END(11); }
        SEAM(pb + 13);
        if constexpr (KIND(14)) if (IN(pb + 14)) { PHASE_ENTRY scan_carry_phase(F, P); AMP_END(14); }
        SEAM(pb + 14);
        if constexpr (KIND(15)) if (IN(pb + 15)) { PHASE_ENTRY scan_out_phase(F, P, lp); AMP_END(15); }
        SEAM(pb + 15);
        if constexpr (KIND(4)) if (IN(pb + 16)) { PHASE_ENTRY
            __syncthreads();
            { float* X = (float*)(ws + WS_X);
              set_desc(F.lds, 0, ws + WS_YG, ws + WS_WO + (size_t)lp * D * D * 2, X, 4, 0, 0, X, X + (size_t)TL * D, nullptr);
              set_desc(F.lds, 1, nullptr, nullptr, nullptr, 0, 0, 0, (const float*)(ws + WS_MOD) + (size_t)lb * 3 * 6 * D + 2 * D); }
            __syncthreads();
            SchedMulti<D, D> S{F.lds, T / 256, 4, 1};
            EpiResid E{F.lds};
            pg8::gemm_phase<EpiResid, SchedMulti<D, D>, false, D, D, D>(F.lds, S, E);
            AMP_END(4); }
        SEAM(pb + 16);
        if constexpr (KIND(5)) if (IN(pb + 17)) { PHASE_ENTRY norm2_phase(F, P, lb); AMP_END(5); }
        SEAM(pb + 17);
        if constexpr (KIND(16)) if (IN(pb + 18)) { PHASE_ENTRY
            __syncthreads(); set_desc(F.lds, 0, ws + WS_HL, ws + WS_WRT + (size_t)lb * 256 * D * 2, nullptr, 1, 0, 0); __syncthreads();
            SchedMulti<D, D> S{F.lds, (lb == DEPTH - 1 ? TL : T) / 256, 1, 1};
            EpiLogits E{(float*)(ws + WS_LG)};
            pg8::gemm_phase<EpiLogits, SchedMulti<D, D>, false, D, D, D>(F.lds, S, E);
            AMP_END(16); }
        SEAM(pb + 18);
        if constexpr (KIND(17)) if (IN(pb + 19)) { PHASE_ENTRY route_phase(F, P, lb); AMP_END(17); }
        SEAM(pb + 19);
        if constexpr (KIND(6)) if (IN(pb + 20)) { PHASE_ENTRY
            moe_tables(F.lds, ctl + CW_CNT + lb * 64);
            SchedMoE<D, D, true> S{F.lds, (const char*)(ws + WS_HL), (const char*)(ws + WS_WGU), (const int*)(ws + WS_LIST)};
            EpiSiluGate E{(bf16_t*)(ws + WS_H)};
            pg8::gemm_phase<EpiSiluGate, SchedMoE<D, D, true>, true, D, D, D>(F.lds, S, E);
            AMP_END(6); }
        SEAM(pb + 20);
        if constexpr (KIND(7)) if (IN(pb + 21)) { PHASE_ENTRY
            moe_tables(F.lds, ctl + CW_CNT + lb * 64);
            SchedMoE<EHID, EHID, false> S{F.lds, (const char*)(ws + WS_H), (const char*)(ws + WS_WD), (const int*)(ws + WS_LIST)};
            EpiScatter E{F.lds, (bf16_t*)(ws + WS_YB), (const int*)(ws + WS_LIST)};
            pg8::gemm_phase<EpiScatter, SchedMoE<EHID, EHID, false>, false, EHID, EHID, EHID>(F.lds, S, E);
            AMP_END(7); }
        SEAM(pb + 21);
    }
    if constexpr (KIND(13)) if (IN(45)) { PHASE_ENTRY final_phase(F, P); AMP_END(13); }
#undef IN
#undef KIND
#undef SEAM
#undef PHASE_ENTRY
}

#if !MK_ONE_LAUNCH
static int phase_kind(int ph) { if (ph == 0) return 0; if (ph == 45) return 13; static const int k22[22] = {1, 2, 3, 4, 5, 16, 17, 6, 7, 1, 8, 9, 10, 11, 14, 15, 4, 5, 16, 17, 6, 7}; return k22[(ph - 1) % 22]; }
typedef void (*kern_t)(Params);
template <unsigned KM> static kern_t kern_of() { return mega<KM>; }
static kern_t kind_kernel(int kind) {
    switch (kind) { case 0: return kern_of<1u << 0>(); case 1: return kern_of<1u << 1>(); case 2: return kern_of<1u << 2>(); case 3: return kern_of<1u << 3>(); case 4: return kern_of<1u << 4>();
        case 5: return kern_of<1u << 5>(); case 6: return kern_of<1u << 6>(); case 7: return kern_of<1u << 7>(); case 8: return kern_of<1u << 8>(); case 9: return kern_of<1u << 9>();
        case 10: return kern_of<1u << 10>(); case 11: return kern_of<1u << 11>(); case 12: return kern_of<1u << 12>(); case 14: return kern_of<1u << 14>(); case 15: return kern_of<1u << 15>(); case 16: return kern_of<1u << 16>(); case 17: return kern_of<1u << 17>(); default: return kern_of<1u << 13>(); }
}
#endif
extern "C" void kernel_launch(void* const* d_in, const int* in_sizes, int n_in, void* d_out, int out_size, void* d_ws, size_t ws_size, hipStream_t stream) {
    static int grid = 0;
    if (grid == 0) {
        if (n_in != 42 || out_size != TL * D || ws_size < WS_END) { fprintf(stderr, "kernel_launch: unexpected problem (n_in %d, out %d, ws %zu < %zu)\n", n_in, out_size, ws_size, (size_t)WS_END); grid = -1; return; }
        int dev = 0, cus = 0;
        if (hipGetDevice(&dev) != hipSuccess || hipDeviceGetAttribute(&cus, hipDeviceAttributeMultiprocessorCount, dev) != hipSuccess) { grid = -1; return; }
#if MK_ONE_LAUNCH
        if (hipFuncSetAttribute((const void*)mega<0x3ffffu>, hipFuncAttributeMaxDynamicSharedMemorySize, LDS_BYTES) != hipSuccess) { fprintf(stderr, "kernel_launch: hipFuncSetAttribute failed\n"); grid = -1; return; }
#else
        for (int k = 0; k < 18; ++k) if (hipFuncSetAttribute((const void*)kind_kernel(k), hipFuncAttributeMaxDynamicSharedMemorySize, LDS_BYTES) != hipSuccess) { fprintf(stderr, "kernel_launch: hipFuncSetAttribute failed\n"); grid = -1; return; }
#endif
        (void)hipGetLastError();
        grid = cus;
    }
    if (grid < 0) return;
    (void)hipMemsetAsync((char*)d_ws + WS_CTL, 0, CTL_BYTES, stream);
    Params p{};
    for (int i = 0; i < 42; ++i) p.in[i] = (const float*)d_in[i];
    p.out = (float*)d_out; p.ws = (unsigned char*)d_ws;
#if MK_ONE_LAUNCH
    p.ph_lo = 0; p.ph_hi = NPH;
    hipLaunchKernelGGL(mega<0x3ffffu>, dim3(grid), dim3(NTHR), LDS_BYTES, stream, p);
#else
    for (int ph = 0; ph < NPH; ++ph) { p.ph_lo = ph; p.ph_hi = ph + 1; hipLaunchKernelGGL(kind_kernel(phase_kind(ph)), dim3(grid), dim3(NTHR), LDS_BYTES, stream, p); }
#endif
}
```

```cpp
#include <hip/hip_runtime.h>
#include <cstdio>
#include <cstdint>

#define LAS __attribute__((address_space(3)))
typedef unsigned short bf16_t;
typedef short bf16x8 __attribute__((ext_vector_type(8)));
typedef float f32x4 __attribute__((ext_vector_type(4)));
typedef float f32x2 __attribute__((ext_vector_type(2)));
typedef unsigned u32x4 __attribute__((ext_vector_type(4)));
typedef unsigned u32x2 __attribute__((ext_vector_type(2)));

#ifndef AMP_MASK
#define AMP_MASK 0u
#endif
#define AMP_F 4
#ifndef MK_ONE_LAUNCH
#define MK_ONE_LAUNCH 1
#endif

constexpr int D = 1024, NBATCH = 2, SEQ = 16384, CTXL = 256, DEPTH = 4;
constexpr int TL = NBATCH * SEQ, TC = NBATCH * CTXL, T = TL + TC;
constexpr int GWID = 2048, NE = 32, EHID = 512, NH = 16, HD = 64;
constexpr int LISTCAP = T;
constexpr int MAXRT = (2 * T) / 256 + NE;
constexpr int NWAVES = 8, NTHR = 512;

constexpr size_t MiB = 1u << 20;
constexpr size_t WS_CTL = 0, CTL_BYTES = 1 * MiB;
constexpr size_t WS_MOD = 1 * MiB;
constexpr size_t WS_WIN = 2 * MiB, WS_WOUT = 18 * MiB, WS_WSP = 26 * MiB, WS_WR = 27 * MiB, WS_WK = 31 * MiB, WS_WV = 35 * MiB, WS_WO = 39 * MiB;
constexpr size_t WS_LW1 = 43 * MiB, WS_LA1 = 44 * MiB, WS_LG1 = 45 * MiB, WS_W2P = 46 * MiB, WS_A2P = 48 * MiB, WS_G2P = 50 * MiB;
constexpr size_t WS_WRT = 52 * MiB;
constexpr size_t WS_WGU = 54 * MiB, WS_WD = 118 * MiB;
constexpr size_t WS_X = 150 * MiB;
constexpr size_t WS_LIST = 280 * MiB, WS_WGT = 285 * MiB;
constexpr size_t WS_HL = 286 * MiB;
constexpr size_t WS_BIG = 351 * MiB;
constexpr size_t SZB = 65 * MiB;
constexpr size_t WS_U = WS_BIG, WS_V = WS_BIG + 2 * SZB, WS_STAT = WS_BIG + 4 * SZB;
constexpr size_t WS_XR = WS_BIG, WS_XW = WS_BIG + SZB, WS_XK = WS_BIG + 2 * SZB, WS_XV = WS_BIG + 3 * SZB, WS_XA = WS_BIG + 4 * SZB, WS_XG = WS_BIG + 5 * SZB;
constexpr size_t WS_R = WS_BIG + 6 * SZB, WS_K = WS_BIG + 7 * SZB, WS_VV = WS_BIG + 8 * SZB;
constexpr size_t WS_TW = WS_BIG + 9 * SZB, WS_TA = WS_TW + 17 * MiB, WS_TG = WS_TA + 17 * MiB;
constexpr size_t WS_ELOG0 = WS_XR, WS_ELOG1 = WS_XW, WS_KM0 = WS_XK, WS_KM1 = WS_XV, WS_AS0 = WS_XA, WS_AS1 = WS_XG;
constexpr size_t WS_GATE = WS_HL, WS_YG = WS_AS0, WS_BON = WS_TG + 17 * MiB;
constexpr size_t WS_H = WS_BIG, WS_YB = WS_BIG + 73 * MiB, WS_LG = WS_BIG + 204 * MiB;
constexpr size_t WS_PQ = WS_KM0;
constexpr size_t WS_SST = WS_WGU;
constexpr size_t WS_END = WS_BON + 5 * MiB;
static_assert(WS_END <= 1080 * MiB, "workspace map");
constexpr int CW_BAR = 4096;
constexpr int CW_CNT = 16384;

__device__ __forceinline__ int wave_sgpr_now(int w) { asm volatile("" : "+s"(w)); return w; }
__device__ __forceinline__ int lane_id_now() { int l; asm volatile("v_mbcnt_lo_u32_b32 %0, -1, 0\n\tv_mbcnt_hi_u32_b32 %0, -1, %0" : "=v"(l)); return l; }
typedef short v4s __attribute__((ext_vector_type(4)));
#define LDS_BARRIER() asm volatile("s_waitcnt lgkmcnt(0)\n\ts_barrier" ::: "memory")
typedef __bf16 bf16x2_t __attribute__((ext_vector_type(2)));
__device__ __forceinline__ unsigned cvt_pk_bf16(float lo, float hi) { const bf16x2_t v = __builtin_convertvector((f32x2){lo, hi}, bf16x2_t); return __builtin_bit_cast(unsigned, v); }
__device__ __forceinline__ float bf_lo(unsigned u) { return __uint_as_float(u << 16); }
__device__ __forceinline__ float bf_hi(unsigned u) { return __uint_as_float(u & 0xffff0000u); }
__device__ __forceinline__ float bf1(bf16_t b) { return __uint_as_float(((unsigned)b) << 16); }
__device__ __forceinline__ bf16_t f2bf(float f) { return (bf16_t)(cvt_pk_bf16(f, 0.f) & 0x3ffffu); }
__device__ __forceinline__ void unpack8(const u32x4& w, float (&f)[8]) { f[0] = bf_lo(w.x); f[1] = bf_hi(w.x); f[2] = bf_lo(w.y); f[3] = bf_hi(w.y); f[4] = bf_lo(w.z); f[5] = bf_hi(w.z); f[6] = bf_lo(w.w); f[7] = bf_hi(w.w); }
__device__ __forceinline__ u32x4 pack8(const float (&f)[8]) { u32x4 o; o.x = cvt_pk_bf16(f[0], f[1]); o.y = cvt_pk_bf16(f[2], f[3]); o.z = cvt_pk_bf16(f[4], f[5]); o.w = cvt_pk_bf16(f[6], f[7]); return o; }
__device__ __forceinline__ float shx(float v, int m, int lane) { return __int_as_float(__builtin_amdgcn_ds_bpermute((lane ^ m) << 2, __float_as_int(v))); }
__device__ __forceinline__ float shup(float v, int d, int lane) { return __int_as_float(__builtin_amdgcn_ds_bpermute((lane - d) << 2, __float_as_int(v))); }
__device__ __forceinline__ float wave_sum(float v, int lane) {
#pragma unroll
    for (int o = 1; o < 64; o <<= 1) v += shx(v, o, lane);
    return v;
}
__device__ __forceinline__ float sigmoidf_(float x) { return 1.0f / (1.0f + __expf(-x)); }
__device__ __forceinline__ float tanhf_(float x) { const float e = __expf(2.0f * x); return 1.0f - 2.0f / (e + 1.0f); }
__device__ __forceinline__ f32x2 gelu_pk(f32x2 v) {
    const f32x2 av = __builtin_elementwise_abs(v), d = av * 0.2316418882f + 1.0f;
    f32x2 t; t.x = __builtin_amdgcn_rcpf(d.x); t.y = __builtin_amdgcn_rcpf(d.y);
    f32x2 q = t * 0.5307027145f + (-0.7265760135f); q = q * t + 0.7107068705f; q = q * t + (-0.142248368f); q = q * t + 0.127414796f; q = q * t;
    const f32x2 s = (v * v) * (-0.72134752044f);
    f32x2 e; e.x = __builtin_amdgcn_exp2f(s.x); e.y = __builtin_amdgcn_exp2f(s.y);
    const f32x2 m = v * (q * e), r = v - m;
    f32x2 o; o.x = v.x < 0.f ? m.x : r.x; o.y = v.y < 0.f ? m.y : r.y; return o;
}

#define XB_TMO      128
#define XB_XCNT(j)  (256  + 64 * (j))
#define XB_XSUB(j)  (1280 + 64 * (j))
#define XB_XGEN(j)  (2304 + 64 * (j))
#define XB_TOP      3328
#define XB_TOPGEN   3392
#define XCD_BAR_WORDS 3456
#define XB_SPIN_CAP (1u << 18)
__device__ __forceinline__ unsigned xb_ld(unsigned* p)              { return __hip_atomic_load(p, __ATOMIC_RELAXED, __HIP_MEMORY_SCOPE_AGENT); }
__device__ __forceinline__ unsigned xb_add(unsigned* p, unsigned v) { return __hip_atomic_fetch_add(p, v, __ATOMIC_RELAXED, __HIP_MEMORY_SCOPE_AGENT); }
__device__ __forceinline__ unsigned xb_xcc_id() { return (unsigned)__builtin_amdgcn_s_getreg((3 << 11) | 20) & 0xFu; }
#define XB_SPIN(cond, bar) do { unsigned _sp = 0; while (cond) { __builtin_amdgcn_s_sleep(1); \
    if ((++_sp & 255u) == 0u) { if (xb_ld(&(bar)[XB_TMO])) break; if (_sp > XB_SPIN_CAP) { atomicAdd(&(bar)[XB_TMO], 1u); break; } } } } while (0)
struct XcdBarrier { unsigned* bar; unsigned x; volatile LAS unsigned* st; };
__device__ __forceinline__ XcdBarrier xcd_barrier_post(unsigned* bar, volatile LAS unsigned* st) {
    XcdBarrier b; b.bar = bar; b.x = xb_xcc_id(); b.st = st;
    if (threadIdx.x == 0) (void)xb_add(&bar[XB_XCNT(b.x)], 1u);
    return b;
}
__device__ __forceinline__ void xcd_barrier_complete(unsigned* bar, unsigned x, unsigned& nloc, unsigned& nx) {
    const unsigned G = gridDim.x * gridDim.y * gridDim.z;
    unsigned sum, cnt, mine, sp = 0u;
    for (;;) {
        sum = 0u; cnt = 0u; mine = 0u;
#pragma unroll
        for (unsigned j = 0; j < 16; ++j) { const unsigned c = xb_ld(&bar[XB_XCNT(j)]); sum += c; cnt += (c > 0u) ? 1u : 0u; mine = (j == x) ? c : mine; }
        if (sum == G) break;
        __builtin_amdgcn_s_sleep(1);
        if ((++sp & 255u) == 0u) { if (xb_ld(&bar[XB_TMO])) break; if (sp > XB_SPIN_CAP) { atomicAdd(&bar[XB_TMO], 1u); break; } }
    }
    nloc = mine > 0u ? mine : 1u; nx = cnt > 0u ? cnt : 1u;
}
template <bool FIRST> __device__ __forceinline__ void xcd_barrier(const XcdBarrier& b, const bool leader) {
    asm volatile("s_waitcnt vmcnt(0)" ::: "memory");
    __syncthreads();
    if (leader) {
        unsigned* bar = b.bar;
        __builtin_amdgcn_s_waitcnt(0);
        unsigned nloc = b.st[0], nx = b.st[1];
        if constexpr (FIRST) { if (nloc == 0u) { xcd_barrier_complete(bar, b.x, nloc, nx); b.st[0] = nloc; b.st[1] = nx; } }
        const unsigned old = xb_add(&bar[XB_XSUB(b.x)], 1u);
        const unsigned gen = old / nloc;
        if (old + 1u == (gen + 1u) * nloc) {
            __builtin_amdgcn_fence(__ATOMIC_RELEASE, "agent");
            asm volatile("s_waitcnt vmcnt(0)" ::: "memory");
            const unsigned og = xb_add(&bar[XB_TOP], 1u);
            const unsigned tg = og / nx;
            if (og + 1u == (tg + 1u) * nx) xb_add(&bar[XB_TOPGEN], 1u);
            else XB_SPIN(xb_ld(&bar[XB_TOPGEN]) == tg, bar);
            __builtin_amdgcn_fence(__ATOMIC_ACQUIRE, "agent");
            xb_add(&bar[XB_XGEN(b.x)], 1u);
            asm volatile("s_waitcnt vmcnt(0)" ::: "memory");
        } else {
            XB_SPIN(xb_ld(&bar[XB_XGEN(b.x)]) == gen, bar);
            __builtin_amdgcn_fence(__ATOMIC_ACQUIRE, "agent");
            asm volatile("s_waitcnt vmcnt(0)" ::: "memory");
        }
    }
    __syncthreads();
}

constexpr int LDS_MISC = 143360;
constexpr int LDS_DESC = LDS_MISC + 128;
constexpr int LDS_TAB = LDS_MISC + 512;
constexpr int LDS_BYTES = 147456;
namespace pg8 {
constexpr int BM = 256, BK = 64, HALF = 128, HTB = HALF * BK * 2, STAGE_BYTES = 8 * HTB, NXCD = 8, WGM = 8;
__host__ __device__ __forceinline__ int lds_byte(int r, int c) { const int st = (r >> 4) * 2 + (c >> 5), rr = r & 15, cc = c & 31, ob = rr * 64 + cc * 2; return st * 1024 + (ob ^ (((ob >> 9) & 1) << 5)); }
__host__ __device__ __forceinline__ void stage_rc(int b, int& R, int& C) { const int st = b / 1024, sb = b % 1024, swz = sb ^ (((sb >> 9) & 1) << 5); R = (st >> 1) * 16 + swz / 64; C = (st & 1) * 32 + (swz % 64) / 2; }
__host__ __device__ __forceinline__ int perm32(int rho) { const int n = rho >> 4, i = rho & 15; return 8 * (i >> 2) + 4 * n + (i & 3); }
__device__ __forceinline__ int xcd_remap(int L, int nwg) { const int q = nwg / NXCD, r = nwg % NXCD, xcd = L % NXCD, off = L / NXCD; return (xcd < r ? xcd * (q + 1) : r * (q + 1) + (xcd - r) * q) + off; }

struct Unit { int pm, pn, aux; };

template <class Epi, class Sched, bool GATHER, int K, int LDA, int LDB>
__device__ __forceinline__ void gemm_phase(LAS unsigned char* lds, const Sched& S, const Epi& E, const int tid_in) {
    int tid_ = tid_in; asm volatile("" : "+v"(tid_));
    const int tid = tid_, wid = __builtin_amdgcn_readfirstlane(tid >> 6), lane = tid & 63, wr = wid >> 2, wc = wid & 3, fr = lane & 15, fq = lane >> 4;
    constexpr int nt = K / BK;
    unsigned voffA[2], voffB[2];
#pragma unroll
    for (int i = 0; i < 2; ++i) { int R, C; stage_rc(tid * 16 + i * 8192, R, C); const int Rb = Epi::PERM ? ((R & ~31) + perm32(R & 31)) : R;
        voffA[i] = (unsigned)(R * LDA + C) * 2u; voffB[i] = (unsigned)(Rb * LDB + C) * 2u; }
    constexpr size_t kstep = (size_t)(BK * 2);
    constexpr size_t hstepA = GATHER ? (size_t)0 : (size_t)HALF * LDA * 2, hstepB = (size_t)HALF * LDB * 2;
    const unsigned ldsw = (unsigned)wid * 1024u;
    const int aoff = lds_byte(wr * 64 + fr, fq * 8), boff = lds_byte(wc * 32 + fr, fq * 8);
    unsigned gA[2][2], gN[2][2];
#define PG8_SA(b, h) (((b) * 2 + (h)) * HTB)
#define PG8_SB(b, h) ((4 + (b) * 2 + (h)) * HTB)
#define PG8_STAGEB(bufoff, gbase) do { _Pragma("unroll") for (int _i = 0; _i < 2; ++_i) \
        __builtin_amdgcn_global_load_lds((const unsigned*)((const char*)(gbase) + voffB[_i]), (LAS unsigned*)(lds + (bufoff) + ldsw + _i * 8192), 16, 0, 0); } while (0)
#define PG8_STAGEA(bufoff, gbase, h, GV) do { _Pragma("unroll") for (int _i = 0; _i < 2; ++_i) \
        __builtin_amdgcn_global_load_lds((const unsigned*)((const char*)(gbase) + (GATHER ? GV[h][_i] : voffA[_i]) + (h) * hstepA), (LAS unsigned*)(lds + (bufoff) + ldsw + _i * 8192), 16, 0, 0); } while (0)
#define PG8_LDA(dst, b, h) do { _Pragma("unroll") for (int m = 0; m < 4; ++m) _Pragma("unroll") for (int k = 0; k < 2; ++k) dst[m][k] = *(const LAS bf16x8*)(lds + PG8_SA(b, h) + aoff + m * 2048 + k * 1024); } while (0)
#define PG8_LDB(dst, b, h) do { _Pragma("unroll") for (int n = 0; n < 2; ++n) _Pragma("unroll") for (int k = 0; k < 2; ++k) dst[n][k] = *(const LAS bf16x8*)(lds + PG8_SB(b, h) + boff + n * 2048 + k * 1024); } while (0)
#define PG8_MMA(ai, bj, At, Bt) do { __builtin_amdgcn_s_setprio(1); _Pragma("unroll") for (int m = 0; m < 4; ++m) _Pragma("unroll") for (int n = 0; n < 2; ++n) _Pragma("unroll") for (int k = 0; k < 2; ++k) \
        acc[ai][bj][m][n] = __builtin_amdgcn_mfma_f32_16x16x32_bf16(Bt[n][k], At[m][k], acc[ai][bj][m][n], 0, 0, 0); __builtin_amdgcn_s_setprio(0); } while (0)
#define PG8_WAIT_V(n) asm volatile("s_waitcnt vmcnt(" #n ")" ::: "memory")
#define PG8_WAIT_L(n) asm volatile("s_waitcnt lgkmcnt(" #n ")" ::: "memory")
#define PG8_BAR __builtin_amdgcn_s_barrier()
#define PG8_SCHED __builtin_amdgcn_sched_barrier(0)
    Unit cur, nxt; int ui = 0;
    if (!S.next(0, cur)) return;
    f32x4 acc[2][2][4][2];
#pragma unroll
    for (int a = 0; a < 2; ++a)
#pragma unroll
        for (int b = 0; b < 2; ++b)
#pragma unroll
            for (int m = 0; m < 4; ++m)
#pragma unroll
                for (int n = 0; n < 2; ++n) acc[a][b][m][n] = (f32x4){0.f, 0.f, 0.f, 0.f};
    bf16x8 At[4][2], B0[2][2], B1[2][2];
    const char* cA = S.aptr(cur); const char* cB = S.bptr(cur);
    if constexpr (GATHER) { S.gather(cur, tid, gA); }
    PG8_STAGEB(PG8_SB(0, 0), cB); PG8_STAGEB(PG8_SB(0, 1), cB + hstepB); PG8_STAGEA(PG8_SA(0, 0), cA, 0, gA); PG8_STAGEA(PG8_SA(0, 1), cA, 1, gA);
    if (wr == 1) PG8_BAR;
    PG8_WAIT_V(2); PG8_BAR;
    PG8_STAGEB(PG8_SB(1, 0), cB + kstep); PG8_STAGEA(PG8_SA(1, 0), cA + kstep, 0, gA); PG8_STAGEB(PG8_SB(1, 1), cB + hstepB + kstep);
    PG8_WAIT_V(6); PG8_BAR;
    for (;;) {
        const bool has_next = S.next(ui + 1, nxt);
        const char* nA = has_next ? S.aptr(nxt) : cA; const char* nB = has_next ? S.bptr(nxt) : cB;
        if constexpr (GATHER) { if (has_next) S.gather(nxt, tid, gN); else {
#pragma unroll
            for (int h = 0; h < 2; ++h)
#pragma unroll
                for (int i = 0; i < 2; ++i) gN[h][i] = gA[h][i]; } }
#pragma nounroll
        for (int t = 0; t < nt; t += 2) {
            const bool last = (t == nt - 2);
            const char* a1 = cA + (size_t)(t + 1) * kstep;
            const char* a2 = last ? nA : cA + (size_t)(t + 2) * kstep; const char* b2 = last ? nB : cB + (size_t)(t + 2) * kstep;
            const char* a3 = a2 + kstep; const char* b3 = b2 + kstep;
            unsigned g2[2][2];
            if constexpr (GATHER) {
#pragma unroll
                for (int h = 0; h < 2; ++h)
#pragma unroll
                    for (int i = 0; i < 2; ++i) g2[h][i] = last ? gN[h][i] : gA[h][i]; }
            PG8_LDB(B0, 0, 0); PG8_LDB(B1, 0, 1); PG8_SCHED; PG8_LDA(At, 0, 0); PG8_STAGEA(PG8_SA(1, 1), a1, 1, gA);
            PG8_WAIT_V(8); PG8_WAIT_L(0); PG8_BAR; PG8_MMA(0, 0, At, B0); PG8_MMA(0, 1, At, B1); PG8_BAR; PG8_SCHED;
            PG8_LDA(At, 0, 1); PG8_STAGEB(PG8_SB(0, 0), b2); PG8_STAGEB(PG8_SB(0, 1), b2 + hstepB); PG8_STAGEA(PG8_SA(0, 0), a2, 0, g2);
            PG8_WAIT_V(8); PG8_WAIT_L(0); PG8_BAR; PG8_MMA(1, 0, At, B0); PG8_MMA(1, 1, At, B1); PG8_BAR; PG8_SCHED;
            PG8_LDB(B0, 1, 0); PG8_LDB(B1, 1, 1); PG8_SCHED; PG8_LDA(At, 1, 0); PG8_STAGEA(PG8_SA(0, 1), a2, 1, g2);
            PG8_WAIT_V(8); PG8_WAIT_L(0); PG8_BAR; PG8_MMA(0, 0, At, B0); PG8_MMA(0, 1, At, B1); PG8_BAR; PG8_SCHED;
            PG8_LDA(At, 1, 1); PG8_STAGEB(PG8_SB(1, 0), b3); PG8_STAGEB(PG8_SB(1, 1), b3 + hstepB); PG8_STAGEA(PG8_SA(1, 0), a3, 0, g2);
            PG8_WAIT_V(8); PG8_WAIT_L(0); PG8_BAR; PG8_MMA(1, 0, At, B0); PG8_MMA(1, 1, At, B1); PG8_BAR; PG8_SCHED;
        }
        if (wr == 0) PG8_BAR;
        E(acc, cur, wr, wc, fr, fq);
        if (!has_next) break;
#pragma unroll
        for (int a = 0; a < 2; ++a)
#pragma unroll
            for (int b = 0; b < 2; ++b)
#pragma unroll
                for (int m = 0; m < 4; ++m)
#pragma unroll
                    for (int n = 0; n < 2; ++n) acc[a][b][m][n] = (f32x4){0.f, 0.f, 0.f, 0.f};
        cur = nxt; cA = nA; cB = nB; ++ui;
        if constexpr (GATHER) {
#pragma unroll
            for (int h = 0; h < 2; ++h)
#pragma unroll
                for (int i = 0; i < 2; ++i) gA[h][i] = gN[h][i]; }
        if (wr == 1) PG8_BAR;
    }
    PG8_WAIT_V(0);
    PG8_BAR;
#undef PG8_SA
#undef PG8_SB
#undef PG8_STAGEA
#undef PG8_STAGEB
#undef PG8_LDA
#undef PG8_LDB
#undef PG8_MMA
#undef PG8_WAIT_V
#undef PG8_WAIT_L
#undef PG8_BAR
#undef PG8_SCHED
}
}
using pg8::Unit;

__device__ __forceinline__ void set_desc(LAS unsigned char* lds, int tid, int g, const void* A, const void* B, const void* C, int nN, int ldc, int aux, const void* X1 = nullptr, const void* X2 = nullptr, const void* X3 = nullptr) {
    LAS int* d = (LAS int*)(lds + LDS_DESC) + g * 16;
    if (tid == 0) { unsigned long long a = (unsigned long long)A, b = (unsigned long long)B, c = (unsigned long long)C, x1 = (unsigned long long)X1, x2 = (unsigned long long)X2, x3 = (unsigned long long)X3;
        asm volatile("" : "+s"(a), "+s"(b), "+s"(c), "+s"(x1), "+s"(x2), "+s"(x3), "+s"(nN), "+s"(ldc), "+s"(aux));
        d[0] = (int)(unsigned)a; d[1] = (int)(unsigned)(a >> 32); d[2] = (int)(unsigned)b; d[3] = (int)(unsigned)(b >> 32); d[4] = (int)(unsigned)c; d[5] = (int)(unsigned)(c >> 32); d[6] = nN; d[7] = ldc; d[8] = aux;
        d[10] = (int)(unsigned)x1; d[11] = (int)(unsigned)(x1 >> 32); d[12] = (int)(unsigned)x2; d[13] = (int)(unsigned)(x2 >> 32); d[14] = (int)(unsigned)x3; d[15] = (int)(unsigned)(x3 >> 32); }
}
__device__ __forceinline__ int desc_i(LAS unsigned char* lds, int g, int f) { return __builtin_amdgcn_readfirstlane(((LAS const int*)(lds + LDS_DESC))[g * 16 + f]); }
__device__ __forceinline__ const char* desc_p(LAS unsigned char* lds, int g, int f) {
    const unsigned lo = (unsigned)desc_i(lds, g, f), hi = (unsigned)desc_i(lds, g, f + 1); return (const char*)(((unsigned long long)hi << 32) | lo); }
template <int LDA, int LDB>
struct SchedMulti {
    LAS unsigned char* lds; int nM, ntot, ng;
    __device__ __forceinline__ bool next(int i, Unit& u) const {
        const int nwg = nM * ntot; const long L = (long)i * gridDim.x + blockIdx.x; if (L >= nwg) return false;
        const int wgid = pg8::xcd_remap((int)L, nwg);
        const int nig = pg8::WGM * ntot, gid = wgid / nig, fm = gid * pg8::WGM, gsz = (nM - fm) < pg8::WGM ? (nM - fm) : pg8::WGM;
        u.pm = fm + ((wgid % nig) % gsz); int pv = (wgid % nig) / gsz; int g = 0;
        for (int j = 0; j + 1 < ng; ++j) { const int n = desc_i(lds, j, 6); if (pv < n) break; pv -= n; g = j + 1; }
        u.pn = pv; u.aux = g; return true;
    }
    __device__ __forceinline__ const char* aptr(const Unit& u) const { return desc_p(lds, u.aux, 0) + (size_t)u.pm * (512 * LDA); }
    __device__ __forceinline__ const char* bptr(const Unit& u) const { return desc_p(lds, u.aux, 2) + (size_t)u.pn * (512 * LDB); }
};
template <int LDA, int LDB, bool GATHERED>
struct SchedMoE {
    LAS unsigned char* lds; const char* Abase; const char* Bbase; const int* list;
    __device__ __forceinline__ bool next(int i, Unit& u) const {
        LAS const int* tab = (LAS const int*)(lds + LDS_TAB);
        const int nrt = __builtin_amdgcn_readfirstlane(tab[2 * MAXRT + 32]);
        const int nwg = nrt * 4; const long L = (long)i * gridDim.x + blockIdx.x; if (L >= nwg) return false;
        const int wgid = pg8::xcd_remap((int)L, nwg);
        u.pm = wgid >> 2; u.pn = wgid & 3; u.aux = __builtin_amdgcn_readfirstlane(tab[u.pm]); return true;
    }
    __device__ __forceinline__ const char* aptr(const Unit& u) const { return GATHERED ? Abase : Abase + (size_t)u.pm * (512 * LDA); }
    __device__ __forceinline__ const char* bptr(const Unit& u) const { return Bbase + (size_t)u.aux * ((size_t)D * LDB * 2) + (size_t)u.pn * (512 * LDB); }
    __device__ __forceinline__ void gather(const Unit& u, int tid, unsigned (&g)[2][2]) const {
        LAS const int* tab = (LAS const int*)(lds + LDS_TAB);
        const int j0 = __builtin_amdgcn_readfirstlane(tab[MAXRT + u.pm]), cn = __builtin_amdgcn_readfirstlane(tab[2 * MAXRT + u.aux]);
#pragma unroll
        for (int i = 0; i < 2; ++i) { int R, C; pg8::stage_rc(tid * 16 + i * 8192, R, C);
#pragma unroll
            for (int h = 0; h < 2; ++h) { const int slot = j0 + 128 * h + R; const int a = slot < cn ? list[(size_t)u.aux * LISTCAP + slot] : 0;
                g[h][i] = (unsigned)((a >> 1) * LDA + C) * 2u; } }
    }
};
__device__ __forceinline__ void moe_tables(LAS unsigned char* lds, int tid, const unsigned* cnt) {
    LAS int* tab = (LAS int*)(lds + LDS_TAB);
    __syncthreads();
    if (tid == 0) {
        int rt = 0;
#pragma nounroll
        for (int e = 0; e < NE; ++e) { const int c = (int)__hip_atomic_load(cnt + e, __ATOMIC_RELAXED, __HIP_MEMORY_SCOPE_AGENT); tab[2 * MAXRT + e] = c;
            const int nt = (c + 255) >> 8;
#pragma nounroll
            for (int j = 0; j < nt; ++j) { tab[rt] = e; tab[MAXRT + rt] = j * 256; ++rt; } }
        tab[2 * MAXRT + 32] = rt;
    }
    __syncthreads();
}

#define EPI_FENCE() asm volatile("" ::: "memory")
struct EpiGelu {
    static constexpr bool PERM = true;
    LAS unsigned char* lds;
    __device__ __forceinline__ void operator()(const f32x4 (&acc)[2][2][4][2], const Unit& u, int wr, int wc, int fr, int fq) const {
        const bool isv = u.pn >= 8; bf16_t* base = (bf16_t*)desc_p(lds, 0, isv ? 10 : 4); const float* bias = (const float*)desc_p(lds, 0, 12); float* stat = (float*)desc_p(lds, 0, 14);
        const int col0 = (u.pn & 7) * 256 + wc * 32 + 8 * fq, bcol0 = u.pn * 256 + wc * 32 + 8 * fq, row0 = u.pm * 256 + wr * 64 + fr;
        f32x4 bv[2][2];
#pragma unroll
        for (int bj = 0; bj < 2; ++bj)
#pragma unroll
            for (int n = 0; n < 2; ++n) bv[bj][n] = *(const f32x4*)(bias + bcol0 + bj * 128 + 4 * n);
#pragma unroll
        for (int ai = 0; ai < 2; ++ai)
#pragma unroll
            for (int m = 0; m < 4; ++m) { const int row = row0 + ai * 128 + m * 16; bf16_t* rowp = base + (size_t)row * GWID + col0; float s = 0.f, q = 0.f;
#pragma unroll
                for (int bj = 0; bj < 2; ++bj) { const f32x4 v0 = acc[ai][bj][m][0] + bv[bj][0], v1 = acc[ai][bj][m][1] + bv[bj][1];
                    const f32x2 a = gelu_pk((f32x2){v0[0], v0[1]}), b = gelu_pk((f32x2){v0[2], v0[3]}), c = gelu_pk((f32x2){v1[0], v1[1]}), d = gelu_pk((f32x2){v1[2], v1[3]});
                    s += ((a.x + a.y) + (b.x + b.y)) + ((c.x + c.y) + (d.x + d.y));
                    q += ((a.x * a.x + a.y * a.y) + (b.x * b.x + b.y * b.y)) + ((c.x * c.x + c.y * c.y) + (d.x * d.x + d.y * d.y));
                    u32x4 w; w.x = cvt_pk_bf16(a.x, a.y); w.y = cvt_pk_bf16(b.x, b.y); w.z = cvt_pk_bf16(c.x, c.y); w.w = cvt_pk_bf16(d.x, d.y);
                    *(u32x4*)(rowp + bj * 128) = w; }
                if (isv) { const int ln_ = 16 * fq + fr; s += shx(s, 16, ln_); s += shx(s, 32, ln_); q += shx(q, 16, ln_); q += shx(q, 32, ln_);
                    if (fq == 0) *(f32x2*)(stat + ((size_t)row * 32 + (u.pn - 8) * 4 + wc) * 2) = (f32x2){s, q}; } }
    }
};
struct EpiResid {
    static constexpr bool PERM = false;
    LAS unsigned char* lds;
    __device__ __forceinline__ void operator()(const f32x4 (&acc)[2][2][4][2], const Unit& u, int wr, int wc, int fr, int fq) const {
        const int mrow = u.pm < 64 ? 0 : (u.pm < 128 ? 1 : 2);
        const float* xin = u.pm < 128 ? (const float*)desc_p(lds, 0, 10) + (size_t)u.pm * 256 * D : (const float*)desc_p(lds, 0, 12) + (size_t)(u.pm - 128) * 256 * D;
        float* xout = (float*)desc_p(lds, 0, 4) + (size_t)u.pm * 256 * D; const float* bias = (const float*)desc_p(lds, 0, 14); const float* gate = (const float*)desc_p(lds, 1, 10);
        const int col0 = u.pn * 256 + wc * 32 + 4 * fq, rl0 = wr * 64 + fr;
#pragma unroll
        for (int bj = 0; bj < 2; ++bj)
#pragma unroll
            for (int n = 0; n < 2; ++n) { const f32x4 bv = bias ? *(const f32x4*)(bias + col0 + bj * 128 + n * 16) : (f32x4){0.f, 0.f, 0.f, 0.f};
                const f32x4 gv = *(const f32x4*)(gate + mrow * 6 * D + col0 + bj * 128 + n * 16);
#pragma unroll
                for (int ai = 0; ai < 2; ++ai) {
#pragma unroll
                    for (int m = 0; m < 4; ++m) { const size_t off = (size_t)(rl0 + ai * 128 + m * 16) * D + col0 + bj * 128 + n * 16;
                        const f32x4 xi = *(const f32x4*)(xin + off); *(f32x4*)(xout + off) = xi + gv * (acc[ai][bj][m][n] + bv); }
                    EPI_FENCE(); } }
    }
};
struct EpiAct {
    static constexpr bool PERM = true;
    LAS unsigned char* lds;
    __device__ __forceinline__ void operator()(const f32x4 (&acc)[2][2][4][2], const Unit& u, int wr, int wc, int fr, int fq) const {
        bf16_t* C = (bf16_t*)desc_p(lds, u.aux, 4); const int ldc = desc_i(lds, u.aux, 7), act = desc_i(lds, u.aux, 8);
        const int col0 = u.pn * 256 + wc * 32 + 8 * fq, row0 = u.pm * 256 + wr * 64 + fr;
#pragma unroll
        for (int ai = 0; ai < 2; ++ai)
#pragma unroll
            for (int m = 0; m < 4; ++m) { bf16_t* rowp = C + (size_t)(row0 + ai * 128 + m * 16) * ldc + col0;
#pragma unroll
                for (int bj = 0; bj < 2; ++bj) { f32x4 v0 = acc[ai][bj][m][0], v1 = acc[ai][bj][m][1];
                    if (act == 1) {
#pragma unroll
                        for (int j = 0; j < 4; ++j) { v0[j] = tanhf_(v0[j]); v1[j] = tanhf_(v1[j]); } }
                    else if (act == 2) {
#pragma unroll
                        for (int j = 0; j < 4; ++j) { v0[j] = sigmoidf_(v0[j]); v1[j] = sigmoidf_(v1[j]); } }
                    u32x4 w; w.x = cvt_pk_bf16(v0[0], v0[1]); w.y = cvt_pk_bf16(v0[2], v0[3]); w.z = cvt_pk_bf16(v1[0], v1[1]); w.w = cvt_pk_bf16(v1[2], v1[3]);
                    *(u32x4*)(rowp + bj * 128) = w; } }
    }
};
struct EpiLogits {
    static constexpr bool PERM = false;
    float* LG;
    __device__ __forceinline__ void operator()(const f32x4 (&acc)[2][2][4][2], const Unit& u, int wr, int wc, int fr, int fq) const {
        if (wc >= 2) return;
        const int col0 = wc * 32 + 4 * fq, row0 = u.pm * 256 + wr * 64 + fr;
#pragma unroll
        for (int ai = 0; ai < 2; ++ai)
#pragma unroll
            for (int m = 0; m < 4; ++m)
#pragma unroll
                for (int n = 0; n < 2; ++n) *(f32x4*)(LG + (size_t)(row0 + ai * 128 + m * 16) * 64 + col0 + n * 16) = acc[ai][0][m][n] + acc[ai][1][m][n];
    }
};
struct EpiSiluGate {
    static constexpr bool PERM = true;
    bf16_t* H;
    __device__ __forceinline__ void operator()(const f32x4 (&acc)[2][2][4][2], const Unit& u, int wr, int wc, int fr, int fq) const {
        const int col0 = u.pn * 128 + wc * 32 + 8 * fq, row0 = u.pm * 256 + wr * 64 + fr;
#pragma unroll
        for (int ai = 0; ai < 2; ++ai)
#pragma unroll
            for (int m = 0; m < 4; ++m) { f32x4 h0, h1;
#pragma unroll
                for (int j = 0; j < 4; ++j) { const float g0 = acc[ai][0][m][0][j], g1 = acc[ai][0][m][1][j]; h0[j] = g0 * sigmoidf_(g0) * acc[ai][1][m][0][j]; h1[j] = g1 * sigmoidf_(g1) * acc[ai][1][m][1][j]; }
                u32x4 w; w.x = cvt_pk_bf16(h0[0], h0[1]); w.y = cvt_pk_bf16(h0[2], h0[3]); w.z = cvt_pk_bf16(h1[0], h1[1]); w.w = cvt_pk_bf16(h1[2], h1[3]);
                *(u32x4*)(H + (size_t)(row0 + ai * 128 + m * 16) * EHID + col0) = w; }
    }
};
struct EpiScatter {
    static constexpr bool PERM = true;
    LAS unsigned char* lds; bf16_t* YB; const int* list;
    __device__ __forceinline__ void operator()(const f32x4 (&acc)[2][2][4][2], const Unit& u, int wr, int wc, int fr, int fq) const {
        LAS const int* tab = (LAS const int*)(lds + LDS_TAB);
        const int j0 = __builtin_amdgcn_readfirstlane(tab[MAXRT + u.pm]), cn = __builtin_amdgcn_readfirstlane(tab[2 * MAXRT + u.aux]);
        const int col0 = u.pn * 256 + wc * 32 + 8 * fq;
#pragma unroll
        for (int ai = 0; ai < 2; ++ai)
#pragma unroll
            for (int m = 0; m < 4; ++m) { const int slot = j0 + ai * 128 + wr * 64 + m * 16 + fr;
                if (slot < cn) { const int a = list[(size_t)u.aux * LISTCAP + slot]; bf16_t* rowp = YB + (size_t)a * D + col0;
#pragma unroll
                    for (int bj = 0; bj < 2; ++bj) { const f32x4 v0 = acc[ai][bj][m][0], v1 = acc[ai][bj][m][1];
                        u32x4 w; w.x = cvt_pk_bf16(v0[0], v0[1]); w.y = cvt_pk_bf16(v0[2], v0[3]); w.z = cvt_pk_bf16(v1[0], v1[1]); w.w = cvt_pk_bf16(v1[2], v1[3]);
                        *(u32x4*)(rowp + bj * 128) = w; } } }
    }
};

struct Params { const float* in[42]; float* out; unsigned char* ws; int ph_lo, ph_hi; };
enum { I_X = 0, I_C, I_CTX, I_CCTX, I_ADAW, I_ADAB, I_N1G, I_N2G, I_FG, I_GWIN, I_GBIN, I_GLNG, I_GLNB, I_GWS, I_GBS, I_GWOUT, I_GBOUT,
       I_MU, I_WR, I_WK, I_WV, I_WO, I_W0, I_W1, I_W2, I_A0, I_A1, I_A2, I_G1, I_G2, I_KK, I_KA, I_RK, I_LNG, I_LNB,
       I_MWGRP, I_MBGRP, I_MWEXP, I_MBEXP, I_MWG, I_MWU, I_MWD };
struct Frame { LAS unsigned char* lds; int tid, lane, wave, G, gw, NGW; };
typedef const __attribute__((address_space(4))) Params* KP;

constexpr int TRP = 36, TR_SCR = 64 * TRP * 4;
__device__ __forceinline__ void tr_item(const float* W, int N, int kmax, bf16_t* WT, int ldk, int k0, int n0, int drow0, int dk0, LAS float* scr, int lane) {
    const int n4 = lane & 7, kr = lane >> 3; f32x4 v[8];
#pragma unroll
    for (int i = 0; i < 8; ++i) { const int k = k0 + 8 * i + kr; v[i] = k < kmax ? *(const f32x4*)(W + (size_t)k * N + n0 + 4 * n4) : (f32x4){0.f, 0.f, 0.f, 0.f}; }
#pragma unroll
    for (int i = 0; i < 8; ++i) *(LAS f32x4*)(scr + (8 * i + kr) * TRP + 4 * n4) = v[i];
    asm volatile("s_waitcnt lgkmcnt(0)" ::: "memory");
    const int c = lane & 7;
#pragma unroll
    for (int j = 0; j < 4; ++j) { const int n = (lane >> 3) + 8 * j; const LAS float* sp = scr + (8 * c) * TRP + n;
        u32x4 o; o.x = cvt_pk_bf16(sp[0 * TRP], sp[1 * TRP]); o.y = cvt_pk_bf16(sp[2 * TRP], sp[3 * TRP]); o.z = cvt_pk_bf16(sp[4 * TRP], sp[5 * TRP]); o.w = cvt_pk_bf16(sp[6 * TRP], sp[7 * TRP]);
        *(u32x4*)(WT + (size_t)(drow0 + n) * ldk + dk0 + k0 + 8 * c) = o; }
    asm volatile("s_waitcnt lgkmcnt(0)" ::: "memory");
}
constexpr int LDS_JOBS = 80 * 1024, MAXJOBS = 48;
__device__ __forceinline__ void add_job(LAS int* jobs, int& nj, int& nit, const float* src, int N, int kmax, int kpad, bf16_t* dst, int ldk, int drow0, int dk0) {
    LAS int* q = jobs + nj * 12; const unsigned long long a = (unsigned long long)src, d = (unsigned long long)dst;
    q[0] = (int)(unsigned)a; q[1] = (int)(unsigned)(a >> 32); q[2] = (int)(unsigned)d; q[3] = (int)(unsigned)(d >> 32); q[4] = N; q[5] = kmax; q[6] = kpad / 64; q[7] = ldk; q[8] = drow0; q[9] = dk0; q[10] = nit;
    nit += (kpad / 64) * (N / 32); ++nj;
}
__device__ __forceinline__ void zero_fill(const Frame& F, bf16_t* p, size_t nbytes) {
    u32x4* q = (u32x4*)p; const size_t n = nbytes / 16;
    for (size_t i = (size_t)blockIdx.x * NTHR + F.tid; i < n; i += (size_t)F.G * NTHR) q[i] = (u32x4){0u, 0u, 0u, 0u};
}

__device__ __forceinline__ void prologue_phase(const Frame& F, KP P) {
    unsigned char* ws = P->ws;
    {   float* MOD = (float*)(ws + WS_MOD); LAS float* part = (LAS float*)F.lds;
        const float* c = P->in[I_C]; const float* cc = P->in[I_CCTX];
        for (int item = blockIdx.x; item < DEPTH * 24; item += F.G) {
            const int layer = item / 24, col = (item % 24) * 256 + 4 * F.lane; const float* w = P->in[I_ADAW] + (size_t)layer * D * 6 * D + col;
            f32x4 a0 = (f32x4){0.f, 0.f, 0.f, 0.f}, a1 = a0, a2 = a0;
#pragma unroll 8
            for (int i = 0; i < 128; ++i) { const int d = F.wave + 8 * i; const f32x4 wv = *(const f32x4*)(w + (size_t)d * 6 * D);
                const float c0 = c[d], c1 = c[D + d], c2 = cc[d];
                a0 += wv * (c0 * sigmoidf_(c0)); a1 += wv * (c1 * sigmoidf_(c1)); a2 += wv * (c2 * sigmoidf_(c2)); }
            __syncthreads();
            *(LAS f32x4*)(part + (F.wave * 3 + 0) * 256 + 4 * F.lane) = a0; *(LAS f32x4*)(part + (F.wave * 3 + 1) * 256 + 4 * F.lane) = a1; *(LAS f32x4*)(part + (F.wave * 3 + 2) * 256 + 4 * F.lane) = a2;
            __syncthreads();
            if (F.wave < 3) { f32x4 sacc = (f32x4){0.f, 0.f, 0.f, 0.f};
#pragma unroll
                for (int w8 = 0; w8 < 8; ++w8) sacc += *(const LAS f32x4*)(part + (w8 * 3 + F.wave) * 256 + 4 * F.lane);
                *(f32x4*)(MOD + ((size_t)layer * 3 + F.wave) * 6 * D + col) = sacc + *(const f32x4*)(P->in[I_ADAB] + (size_t)layer * 6 * D + col); }
        }
    }
    LAS int* jobs = (LAS int*)(F.lds + LDS_JOBS); LAS int* jtot = jobs + MAXJOBS * 12;
    __syncthreads();
    if (F.tid == 0) { int nj = 0, nit = 0;
        for (int j = 0; j < 2; ++j) {
            add_job(jobs, nj, nit, P->in[I_GWIN] + (size_t)j * D * 4096, 4096, D, D, (bf16_t*)(ws + WS_WIN) + (size_t)j * 4096 * D, D, 0, 0);
            add_job(jobs, nj, nit, P->in[I_GWOUT] + (size_t)j * GWID * D, D, GWID, GWID, (bf16_t*)(ws + WS_WOUT) + (size_t)j * D * GWID, GWID, 0, 0);
            add_job(jobs, nj, nit, P->in[I_WR] + (size_t)j * D * D, D, D, D, (bf16_t*)(ws + WS_WR) + (size_t)j * D * D, D, 0, 0);
            add_job(jobs, nj, nit, P->in[I_WK] + (size_t)j * D * D, D, D, D, (bf16_t*)(ws + WS_WK) + (size_t)j * D * D, D, 0, 0);
            add_job(jobs, nj, nit, P->in[I_WV] + (size_t)j * D * D, D, D, D, (bf16_t*)(ws + WS_WV) + (size_t)j * D * D, D, 0, 0);
            add_job(jobs, nj, nit, P->in[I_WO] + (size_t)j * D * D, D, D, D, (bf16_t*)(ws + WS_WO) + (size_t)j * D * D, D, 0, 0);
            for (int z = 0; z < 2; ++z) {
                add_job(jobs, nj, nit, P->in[I_W1] + ((size_t)j * 2 + z) * D * 64, 64, D, D, (bf16_t*)(ws + WS_LW1) + (size_t)j * 256 * D, D, z * 64, 0);
                add_job(jobs, nj, nit, P->in[I_A1] + ((size_t)j * 2 + z) * D * 64, 64, D, D, (bf16_t*)(ws + WS_LA1) + (size_t)j * 256 * D, D, z * 64, 0);
                add_job(jobs, nj, nit, P->in[I_W2] + ((size_t)j * 2 + z) * 64 * D, D, 64, 64, (bf16_t*)(ws + WS_W2P) + ((size_t)j * 2 + z) * D * 256, 256, 0, z * 64);
                add_job(jobs, nj, nit, P->in[I_A2] + ((size_t)j * 2 + z) * 64 * D, D, 64, 64, (bf16_t*)(ws + WS_A2P) + ((size_t)j * 2 + z) * D * 256, 256, 0, z * 64); }
            add_job(jobs, nj, nit, P->in[I_G1] + (size_t)j * D * 160, 160, D, D, (bf16_t*)(ws + WS_LG1) + (size_t)j * 256 * D, D, 0, 0);
            add_job(jobs, nj, nit, P->in[I_G2] + (size_t)j * 160 * D, D, 160, 256, (bf16_t*)(ws + WS_G2P) + (size_t)j * D * 256, 256, 0, 0); }
        jtot[0] = nj; jtot[1] = nit; }
    __syncthreads();
    {   const int nj = jtot[0], nit = jtot[1]; LAS float* scr = (LAS float*)(F.lds + F.wave * TR_SCR);
        for (int it = F.gw; it < nit; it += F.NGW) {
            int jb = 0; for (int q = 1; q < nj; ++q) if (it >= jobs[q * 12 + 10]) jb = q;
            jb = __builtin_amdgcn_readfirstlane(jb); LAS const int* q = jobs + jb * 12;
            const float* src = (const float*)(((unsigned long long)(unsigned)q[1] << 32) | (unsigned)q[0]); bf16_t* dst = (bf16_t*)(((unsigned long long)(unsigned)q[3] << 32) | (unsigned)q[2]);
            const int N = q[4], nnb = N / 32, r = it - q[10], kb = r / nnb, nb = r % nnb;
            tr_item(src, N, q[5], dst, q[7], kb * 64, nb * 32, q[8] + nb * 32, q[9], scr, F.lane); }
    }
    for (int j = 0; j < 2; ++j) {
        bf16_t* lw1 = (bf16_t*)(ws + WS_LW1) + (size_t)j * 256 * D; bf16_t* la1 = (bf16_t*)(ws + WS_LA1) + (size_t)j * 256 * D; bf16_t* lg1 = (bf16_t*)(ws + WS_LG1) + (size_t)j * 256 * D;
        zero_fill(F, lw1 + 128 * D, (size_t)128 * D * 2); zero_fill(F, la1 + 128 * D, (size_t)128 * D * 2); zero_fill(F, lg1 + 160 * D, (size_t)96 * D * 2);
        for (int z = 0; z < 2; ++z) { bf16_t* w2p = (bf16_t*)(ws + WS_W2P) + ((size_t)j * 2 + z) * D * 256; bf16_t* a2p = (bf16_t*)(ws + WS_A2P) + ((size_t)j * 2 + z) * D * 256;
            for (int idx = blockIdx.x * NTHR + F.tid; idx < D * 32; idx += F.G * NTHR) { const int n = idx >> 5, ch = idx & 31;
                if ((ch >> 3) != z) { *(u32x4*)(w2p + (size_t)n * 256 + ch * 8) = (u32x4){0u, 0u, 0u, 0u}; *(u32x4*)(a2p + (size_t)n * 256 + ch * 8) = (u32x4){0u, 0u, 0u, 0u}; } } }
    }
    {   bf16_t* wrt = (bf16_t*)(ws + WS_WRT);
        for (int idx = blockIdx.x * NTHR + F.tid; idx < DEPTH * 256 * (D / 8); idx += F.G * NTHR) { const int k0 = (idx & 127) * 8, n = (idx >> 7) & 255, layer = idx >> 15;
            const int nn = n & 127; const bool lo = n >= 128; float w[8];
#pragma unroll
            for (int e = 0; e < 8; ++e) { float x = 0.f;
                if (nn < 4) x = P->in[I_MWGRP][((size_t)layer * D + k0 + e) * 4 + nn]; else if (nn < 36) x = P->in[I_MWEXP][((size_t)layer * D + k0 + e) * NE + nn - 4];
                const float hi = bf_lo(cvt_pk_bf16(x, 0.f)); w[e] = lo ? x - hi : x; }
            *(u32x4*)(wrt + ((size_t)layer * 256 + n) * D + k0) = pack8(w); } }
    {   const float* src = P->in[I_GWS]; bf16_t* dst = (bf16_t*)(ws + WS_WSP); const int n8 = 2 * 16 * 128 * 128 / 8;
        for (int i = blockIdx.x * NTHR + F.tid; i < n8; i += F.G * NTHR) { const f32x4 a = *(const f32x4*)(src + (size_t)i * 8), b = *(const f32x4*)(src + (size_t)i * 8 + 4);
            u32x4 o; o.x = cvt_pk_bf16(a[0], a[1]); o.y = cvt_pk_bf16(a[2], a[3]); o.z = cvt_pk_bf16(b[0], b[1]); o.w = cvt_pk_bf16(b[2], b[3]); *(u32x4*)(dst + (size_t)i * 8) = o; } }
}
__device__ __forceinline__ void moe_weights_phase(const Frame& F, KP P, int layer) {
    unsigned char* ws = P->ws; LAS float* scr = (LAS float*)(F.lds + F.wave * TR_SCR);
    for (int it = F.gw; it < NE * 768; it += F.NGW) {
        const int e = it / 768, r = it % 768, m = r >> 8, q = r & 255;
        const size_t so = ((size_t)layer * NE + e) * (size_t)D * EHID;
        if (m < 2) { const int kb = q >> 4, n0 = (q & 15) * 32;
            tr_item((m == 0 ? P->in[I_MWG] : P->in[I_MWU]) + so, EHID, D, (bf16_t*)(ws + WS_WGU) + (size_t)e * D * D, D, kb * 64, n0, 256 * (n0 >> 7) + (n0 & 127) + (m == 1 ? 128 : 0), 0, scr, F.lane); }
        else { const int kb = q >> 5, n0 = (q & 31) * 32;
            tr_item(P->in[I_MWD] + so, D, EHID, (bf16_t*)(ws + WS_WD) + (size_t)e * D * EHID, EHID, kb * 64, n0, n0, 0, scr, F.lane); }
    }
}

__device__ __forceinline__ const float* xrow_ptr(KP P, int layer, int row) {
    if (layer == 0) return row < TL ? P->in[I_X] + (size_t)row * D : P->in[I_CTX] + (size_t)(row - TL) * D;
    return (const float*)(P->ws + WS_X) + (size_t)row * D;
}
__device__ __forceinline__ void load_combine(KP P, const Frame& F, int layer, int row, int m, bool combine, f32x4 (&v)[4]) {
    const float* xr = xrow_ptr(P, layer, row);
#pragma unroll
    for (int j = 0; j < 4; ++j) v[j] = *(const f32x4*)(xr + 4 * F.lane + 256 * j);
    if (combine) {
        const bf16_t* yb = (const bf16_t*)(P->ws + WS_YB); const float* wg = (const float*)(P->ws + WS_WGT);
        const float w0 = wg[2 * row], w1 = wg[2 * row + 1]; const float* g2 = (const float*)(P->ws + WS_MOD) + ((size_t)(layer - 1) * 3 + m) * 6 * D + 5 * D;
#pragma unroll
        for (int j = 0; j < 4; ++j) { const int col = 4 * F.lane + 256 * j; const u32x2 a = *(const u32x2*)(yb + (size_t)(2 * row) * D + col), b = *(const u32x2*)(yb + (size_t)(2 * row + 1) * D + col);
            const f32x4 g = *(const f32x4*)(g2 + col);
            v[j][0] += g[0] * (w0 * bf_lo(a.x) + w1 * bf_lo(b.x)); v[j][1] += g[1] * (w0 * bf_hi(a.x) + w1 * bf_hi(b.x));
            v[j][2] += g[2] * (w0 * bf_lo(a.y) + w1 * bf_lo(b.y)); v[j][3] += g[3] * (w0 * bf_hi(a.y) + w1 * bf_hi(b.y)); }
    }
}
__device__ __forceinline__ void norm1_phase(const Frame& F, KP P, int layer) {
    const bool combine = layer > 0; float* X = (float*)(P->ws + WS_X); bf16_t* HL = (bf16_t*)(P->ws + WS_HL);
    const float* g1 = P->in[I_N1G] + (size_t)layer * D;
    for (int row = F.gw; row < T; row += F.NGW) {
        const int m = row < TL ? (row >> 14) : 2; f32x4 v[4];
        load_combine(P, F, layer, row, m, combine, v);
        if (combine) {
#pragma unroll
            for (int j = 0; j < 4; ++j) *(f32x4*)(X + (size_t)row * D + 4 * F.lane + 256 * j) = v[j]; }
        float ss = 0.f;
#pragma unroll
        for (int j = 0; j < 4; ++j) ss += (v[j][0] * v[j][0] + v[j][1] * v[j][1]) + (v[j][2] * v[j][2] + v[j][3] * v[j][3]);
        const float rstd = rsqrtf(wave_sum(ss, F.lane) * (1.0f / D) + 1e-6f);
        const float* mod = (const float*)(P->ws + WS_MOD) + ((size_t)layer * 3 + m) * 6 * D;
#pragma unroll
        for (int j = 0; j < 4; ++j) { const int col = 4 * F.lane + 256 * j; const f32x4 g = *(const f32x4*)(g1 + col), sh = *(const f32x4*)(mod + col), sc = *(const f32x4*)(mod + D + col);
            const f32x4 h = (v[j] * rstd) * g * (sc + 1.0f) + sh;
            u32x2 o; o.x = cvt_pk_bf16(h[0], h[1]); o.y = cvt_pk_bf16(h[2], h[3]); *(u32x2*)(HL + (size_t)row * D + col) = o; }
    }
}
__device__ __forceinline__ void final_phase(const Frame& F, KP P) {
    const float* fg = P->in[I_FG];
    for (int row = F.gw; row < TL; row += F.NGW) {
        const int m = row >> 14; f32x4 v[4];
        load_combine(P, F, DEPTH, row, m, true, v);
        float ss = 0.f;
#pragma unroll
        for (int j = 0; j < 4; ++j) ss += (v[j][0] * v[j][0] + v[j][1] * v[j][1]) + (v[j][2] * v[j][2] + v[j][3] * v[j][3]);
        const float rstd = rsqrtf(wave_sum(ss, F.lane) * (1.0f / D) + 1e-6f);
#pragma unroll
        for (int j = 0; j < 4; ++j) { const int col = 4 * F.lane + 256 * j; *(f32x4*)(P->out + (size_t)row * D + col) = (v[j] * rstd) * *(const f32x4*)(fg + col); }
    }
}
__device__ __forceinline__ void norm2_phase(const Frame& F, KP P, int layer) {
    const int ntok = layer == DEPTH - 1 ? TL : T; bf16_t* HL2 = (bf16_t*)(P->ws + WS_HL); const float* g2n = P->in[I_N2G] + (size_t)layer * D;
    for (int row = F.gw; row < ntok; row += F.NGW) {
        const int m = row < TL ? (row >> 14) : 2; const float* xr = xrow_ptr(P, 1, row); f32x4 v[4];
#pragma unroll
        for (int j = 0; j < 4; ++j) v[j] = *(const f32x4*)(xr + 4 * F.lane + 256 * j);
        float ss = 0.f;
#pragma unroll
        for (int j = 0; j < 4; ++j) ss += (v[j][0] * v[j][0] + v[j][1] * v[j][1]) + (v[j][2] * v[j][2] + v[j][3] * v[j][3]);
        const float rstd = rsqrtf(wave_sum(ss, F.lane) * (1.0f / D) + 1e-6f);
        const float* mod = (const float*)(P->ws + WS_MOD) + ((size_t)layer * 3 + m) * 6 * D;
#pragma unroll
        for (int j = 0; j < 4; ++j) { const int col = 4 * F.lane + 256 * j; const f32x4 g = *(const f32x4*)(g2n + col), sh = *(const f32x4*)(mod + 3 * D + col), sc = *(const f32x4*)(mod + 4 * D + col);
            const f32x4 h = (v[j] * rstd) * g * (sc + 1.0f) + sh;
            u32x2 o; o.x = cvt_pk_bf16(h[0], h[1]); o.y = cvt_pk_bf16(h[2], h[3]); *(u32x2*)(HL2 + (size_t)row * D + col) = o; }
    }
    moe_weights_phase(F, P, layer);
}
__device__ __forceinline__ void route_phase(const Frame& F, KP P, int layer) {
    const int ntok = layer == DEPTH - 1 ? TL : T; const float* LG = (const float*)(P->ws + WS_LG);
    const float* bgrp = P->in[I_MBGRP] + layer * 4; const float* bexp = P->in[I_MBEXP] + layer * NE;
    unsigned* cnt = (unsigned*)(P->ws + WS_CTL) + CW_CNT + layer * 64; int* list = (int*)(P->ws + WS_LIST); float* wgt = (float*)(P->ws + WS_WGT);
    LAS unsigned* lcnt = (LAS unsigned*)F.lds; LAS unsigned* lbase = lcnt + 32;
    for (int r0 = blockIdx.x * NTHR; r0 < ntok; r0 += F.G * NTHR) {
        const int row = r0 + F.tid; const bool act = row < ntok;
        __syncthreads();
        if (F.tid < 32) lcnt[F.tid] = 0u;
        __syncthreads();
        int e0 = 0, e1 = 0; unsigned k0 = 0, k1 = 0;
        if (act) {
            const float* lg = LG + (size_t)row * 64; const f32x4 g4 = *(const f32x4*)lg;
            float ag[4];
#pragma unroll
            for (int i = 0; i < 4; ++i) ag[i] = g4[i] + bgrp[i];
            int grp = 0; float mx = ag[0];
#pragma unroll
            for (int i = 1; i < 4; ++i) if (ag[i] > mx) { mx = ag[i]; grp = i; }
            float den = 0.f;
#pragma unroll
            for (int i = 0; i < 4; ++i) den += __expf(ag[i] - mx);
            const float pg = 1.0f / den;
            const f32x4 e0v = *(const f32x4*)(lg + 4 + 8 * grp), e1v = *(const f32x4*)(lg + 8 + 8 * grp); const f32x4 b0v = *(const f32x4*)(bexp + 8 * grp), b1v = *(const f32x4*)(bexp + 8 * grp + 4);
            float el[8];
#pragma unroll
            for (int i = 0; i < 4; ++i) { el[i] = e0v[i] + b0v[i]; el[4 + i] = e1v[i] + b1v[i]; }
            int i0 = 0; float t0 = el[0];
#pragma unroll
            for (int i = 1; i < 8; ++i) if (el[i] > t0) { t0 = el[i]; i0 = i; }
            int i1 = -1; float t1 = -3.0e38f;
#pragma unroll
            for (int i = 0; i < 8; ++i) if (i != i0 && el[i] > t1) { t1 = el[i]; i1 = i; }
            const float p0 = 1.0f / (1.0f + __expf(t1 - t0));
            wgt[2 * row] = pg * p0; wgt[2 * row + 1] = pg * (1.0f - p0);
            e0 = grp * 8 + i0; e1 = grp * 8 + i1;
            k0 = atomicAdd((unsigned*)(lcnt + e0), 1u); k1 = atomicAdd((unsigned*)(lcnt + e1), 1u);
        }
        __syncthreads();
        if (F.tid < 32) { const unsigned c = lcnt[F.tid]; lbase[F.tid] = c ? atomicAdd(cnt + F.tid, c) : 0u; }
        __syncthreads();
        if (act) { list[(size_t)e0 * LISTCAP + lbase[e0] + k0] = 2 * row; list[(size_t)e1 * LISTCAP + lbase[e1] + k1] = 2 * row + 1; }
    }
}
__device__ __forceinline__ bf16x8 tr_frag136(const LAS bf16_t* M, int k0, int c0, int lane) {
    LAS bf16_t* p = (LAS bf16_t*)M + (k0 + 8 * (lane >> 4) + ((lane & 15) >> 2)) * 136 + c0 + 4 * (lane & 3);
    const v4s lo = __builtin_amdgcn_ds_read_tr16_b64_v4i16((LAS v4s*)p), hi = __builtin_amdgcn_ds_read_tr16_b64_v4i16((LAS v4s*)(p + 4 * 136));
    return (bf16x8){lo[0], lo[1], lo[2], lo[3], hi[0], hi[1], hi[2], hi[3]};
}
__device__ __forceinline__ void spatial_phase(const Frame& F, KP P, int j) {
    bf16_t* U = (bf16_t*)(P->ws + WS_U); const bf16_t* V = (const bf16_t*)(P->ws + WS_V); const float* stat = (const float*)(P->ws + WS_STAT);
    const bf16_t* WSP = (const bf16_t*)(P->ws + WS_WSP) + (size_t)j * 16 * 128 * 128;
    const float* lng = P->in[I_GLNG] + (size_t)j * GWID; const float* lnb = P->in[I_GLNB] + (size_t)j * GWID; const float* bs = P->in[I_GBS] + (size_t)j * 16 * 128;
    LAS bf16_t* Wt = (LAS bf16_t*)F.lds; LAS bf16_t* Vn = Wt + 128 * 136;
    LAS float* mu = (LAS float*)(F.lds + 2 * 128 * 136 * 2); LAS float* rs = mu + 128;
    const int l15 = F.lane & 15, l4 = F.lane >> 4;
    for (int item = blockIdx.x; item < (T / 128) * 4; item += F.G) {
        const int c = item >> 2, gq = item & 3, t0 = c * 128;
        LDS_BARRIER();
        if (F.tid < 128) { const int row = t0 + F.tid; float s = 0.f, q = 0.f;
#pragma unroll 8
            for (int i = 0; i < 32; ++i) { const f32x2 p = *(const f32x2*)(stat + ((size_t)row * 32 + i) * 2); s += p.x; q += p.y; }
            const float mean = s * (1.0f / GWID), var = q * (1.0f / GWID) - mean * mean; mu[F.tid] = mean; rs[F.tid] = rsqrtf(var + 1e-5f); }
#pragma nounroll
        for (int gi = 0; gi < 4; ++gi) { const int g = gq * 4 + gi;
            u32x4 wv[4], vv[4];
#pragma unroll
            for (int i = 0; i < 4; ++i) { const int idx = F.tid + NTHR * i, r = idx >> 4, seg = idx & 15;
                wv[i] = *(const u32x4*)(WSP + ((size_t)g * 128 + r) * 128 + seg * 8); vv[i] = *(const u32x4*)(V + (size_t)(t0 + r) * GWID + g * 128 + seg * 8); }
            LDS_BARRIER();
#pragma unroll
            for (int i = 0; i < 4; ++i) { const int idx = F.tid + NTHR * i, r = idx >> 4, seg = idx & 15, ch = g * 128 + seg * 8;
                *(LAS u32x4*)(Wt + r * 136 + seg * 8) = wv[i];
                float x[8], o[8]; unpack8(vv[i], x); const float m_ = mu[r], r_ = rs[r];
                const f32x4 g0 = *(const f32x4*)(lng + ch), g1 = *(const f32x4*)(lng + ch + 4), b0 = *(const f32x4*)(lnb + ch), b1 = *(const f32x4*)(lnb + ch + 4);
#pragma unroll
                for (int e = 0; e < 8; ++e) o[e] = (x[e] - m_) * r_ * (e < 4 ? g0[e & 3] : g1[e & 3]) + (e < 4 ? b0[e & 3] : b1[e & 3]);
                *(LAS u32x4*)(Vn + r * 136 + seg * 8) = pack8(o); }
            LDS_BARRIER();
            bf16x8 bw[4];
#pragma unroll
            for (int ks = 0; ks < 4; ++ks) bw[ks] = *(const LAS bf16x8*)(Wt + (16 * F.wave + l15) * 136 + ks * 32 + 8 * l4);
            const int p = 16 * F.wave + l15; const float bias = bs[g * 128 + p];
            bf16_t* urow = U + (size_t)(t0 + p) * GWID + g * 128 + 4 * l4;
            u32x2 uu[8];
#pragma unroll
            for (int dt = 0; dt < 8; ++dt) uu[dt] = *(const u32x2*)(urow + dt * 16);
#pragma unroll
            for (int dt = 0; dt < 8; ++dt) { f32x4 acc = (f32x4){0.f, 0.f, 0.f, 0.f};
#pragma unroll
                for (int ks = 0; ks < 4; ++ks) { const bf16x8 a = tr_frag136(Vn, 32 * ks, 16 * dt, F.lane); acc = __builtin_amdgcn_mfma_f32_16x16x32_bf16(a, bw[ks], acc, 0, 0, 0); }
                u32x2 o; o.x = cvt_pk_bf16(bf_lo(uu[dt].x) * (acc[0] + bias), bf_hi(uu[dt].x) * (acc[1] + bias)); o.y = cvt_pk_bf16(bf_lo(uu[dt].y) * (acc[2] + bias), bf_hi(uu[dt].y) * (acc[3] + bias));
                *(u32x2*)(urow + dt * 16) = o; }
        }
    }
}

__device__ __forceinline__ void mix_phase(const Frame& F, KP P, int j) {
    const bf16_t* HL = (const bf16_t*)(P->ws + WS_HL); const float* mu = P->in[I_MU] + (size_t)j * 6 * D;
    bf16_t* outs[6] = {(bf16_t*)(P->ws + WS_XR), (bf16_t*)(P->ws + WS_XW), (bf16_t*)(P->ws + WS_XK), (bf16_t*)(P->ws + WS_XV), (bf16_t*)(P->ws + WS_XA), (bf16_t*)(P->ws + WS_XG)};
    for (int row = F.gw; row < T; row += F.NGW) {
        bool ok[2]; int src[2]; const bool hi = F.lane >= 32;
        if (row < TL) { const int n = row & (SEQ - 1), gc = n & 63, gr = n >> 6;
            ok[0] = hi ? gc < 63 : gc > 0; src[0] = hi ? row + 1 : row - 1; ok[1] = hi ? gr < 255 : gr > 0; src[1] = hi ? row + 64 : row - 64; }
        else { const int n = (row - TL) & (CTXL - 1); ok[0] = n > 0; src[0] = row - 1; ok[1] = n < CTXL - 1; src[1] = row + 1; }
#pragma unroll
        for (int jj = 0; jj < 2; ++jj) { const int col = 512 * jj + 8 * F.lane;
            const u32x4 h8 = *(const u32x4*)(HL + (size_t)row * D + col); u32x4 s8 = (u32x4){0u, 0u, 0u, 0u};
            if (ok[jj]) s8 = *(const u32x4*)(HL + (size_t)src[jj] * D + col);
            const unsigned hw[4] = {h8.x, h8.y, h8.z, h8.w}, sw[4] = {s8.x, s8.y, s8.z, s8.w}; float h[8], xx[8];
#pragma unroll
            for (int e = 0; e < 8; ++e) { h[e] = (e & 1) ? bf_hi(hw[e >> 1]) : bf_lo(hw[e >> 1]); const float s = (e & 1) ? bf_hi(sw[e >> 1]) : bf_lo(sw[e >> 1]); xx[e] = s - h[e]; }
#pragma unroll
            for (int m = 0; m < 6; ++m) { const f32x4 ma = *(const f32x4*)(mu + (size_t)m * D + col), mb = *(const f32x4*)(mu + (size_t)m * D + col + 4);
                u32x4 o; o.x = cvt_pk_bf16(h[0] + xx[0] * ma[0], h[1] + xx[1] * ma[1]); o.y = cvt_pk_bf16(h[2] + xx[2] * ma[2], h[3] + xx[3] * ma[3]);
                o.z = cvt_pk_bf16(h[4] + xx[4] * mb[0], h[5] + xx[5] * mb[1]); o.w = cvt_pk_bf16(h[6] + xx[6] * mb[2], h[7] + xx[7] * mb[3]);
                *(u32x4*)(outs[m] + (size_t)row * D + col) = o; } }
    }
}

constexpr int NSC = 65, NSCAN = 64, TP = 72, TILE_B = 64 * TP * 2;
enum { T_AT = 0, T_RT, T_BT, T_KT, T_VM, T_NT, T_MT, T_NRT, T_MRT, T_APA, T_APB, T_TAA, T_TAB, T_PRB, T_QRB, T_NTILE };
constexpr int LDS_GL = T_NTILE * TILE_B, LDS_SEG = LDS_GL + 256;
static_assert(LDS_SEG + 2048 <= LDS_MISC, "scan LDS map");
__device__ __forceinline__ int scan_row(int z, int b, int p) {
    if (p < CTXL) return TL + b * CTXL + (z ? CTXL - 1 - p : p);
    const int q = p - CTXL; return b * SEQ + (z ? SEQ - 1 - q : q);
}
__device__ __forceinline__ LAS bf16_t* stile(LAS unsigned char* lds, int n) { return (LAS bf16_t*)(lds + n * TILE_B); }
__device__ __forceinline__ bf16x8 row_frag(const LAS bf16_t* M, int r0, int k0, int lane) { return *(const LAS bf16x8*)(M + (r0 + (lane & 15)) * TP + k0 + 8 * (lane >> 4)); }
__device__ __forceinline__ bf16x8 tr_frag(const LAS bf16_t* M, int k0, int c0, int lane) {
    LAS bf16_t* p = (LAS bf16_t*)M + (k0 + 8 * (lane >> 4) + ((lane & 15) >> 2)) * TP + c0 + 4 * (lane & 3);
    const v4s lo = __builtin_amdgcn_ds_read_tr16_b64_v4i16((LAS v4s*)p), hi = __builtin_amdgcn_ds_read_tr16_b64_v4i16((LAS v4s*)(p + 4 * TP));
    return (bf16x8){lo[0], lo[1], lo[2], lo[3], hi[0], hi[1], hi[2], hi[3]};
}
template <bool XT, bool YT>
__device__ __forceinline__ void mm64(const LAS bf16_t* X, const LAS bf16_t* Y, f32x4 (&acc)[2], int wq, int wh, int lane) {
#pragma unroll
    for (int ks = 0; ks < 2; ++ks) {
        const bf16x8 b = XT ? tr_frag(X, 32 * ks, 16 * wq, lane) : row_frag(X, 16 * wq, 32 * ks, lane);
#pragma unroll
        for (int q = 0; q < 2; ++q) { const int i0 = 16 * (2 * wh + q);
            const bf16x8 a = YT ? row_frag(Y, i0, 32 * ks, lane) : tr_frag(Y, 32 * ks, i0, lane);
            acc[q] = __builtin_amdgcn_mfma_f32_16x16x32_bf16(a, b, acc[q], 0, 0, 0); }
    }
}
__device__ __forceinline__ void st_tile(LAS bf16_t* Z, const f32x4 (&acc)[2], int wq, int wh, int lane) {
#pragma unroll
    for (int q = 0; q < 2; ++q) { u32x2 o; o.x = cvt_pk_bf16(acc[q][0], acc[q][1]); o.y = cvt_pk_bf16(acc[q][2], acc[q][3]);
        *(LAS u32x2*)(Z + (16 * wq + (lane & 15)) * TP + 16 * (2 * wh + q) + 4 * (lane >> 4)) = o; }
}
__device__ __forceinline__ void ld_tile(const LAS bf16_t* Z, f32x4 (&acc)[2], int wq, int wh, int lane) {
#pragma unroll
    for (int q = 0; q < 2; ++q) { const u32x2 o = *(const LAS u32x2*)(Z + (16 * wq + (lane & 15)) * TP + 16 * (2 * wh + q) + 4 * (lane >> 4));
        acc[q] = (f32x4){bf_lo(o.x), bf_hi(o.x), bf_lo(o.y), bf_hi(o.y)}; }
}
__device__ __forceinline__ f32x4 prod16(const LAS bf16_t* X, int xr, int xc, const LAS bf16_t* Y, int yr, int yc, f32x4 acc, int lane) {
    bf16x8 b = *(const LAS bf16x8*)(X + (xr + (lane & 15)) * TP + xc + 8 * (lane >> 4)); bf16x8 a = tr_frag(Y, yr, yc, lane);
    if ((lane >> 4) >= 2) { b = (bf16x8){0, 0, 0, 0, 0, 0, 0, 0}; a = (bf16x8){0, 0, 0, 0, 0, 0, 0, 0}; }
    return __builtin_amdgcn_mfma_f32_16x16x32_bf16(a, b, acc, 0, 0, 0);
}
__device__ __forceinline__ void st16(LAS bf16_t* Z, int zr, int zc, f32x4 acc, int lane) { u32x2 o; o.x = cvt_pk_bf16(acc[0], acc[1]); o.y = cvt_pk_bf16(acc[2], acc[3]); *(LAS u32x2*)(Z + (zr + (lane & 15)) * TP + zc + 4 * (lane >> 4)) = o; }
__device__ __forceinline__ f32x4 ld16(const LAS bf16_t* Z, int zr, int zc, int lane) { const u32x2 o = *(const LAS u32x2*)(Z + (zr + (lane & 15)) * TP + zc + 4 * (lane >> 4)); return (f32x4){bf_lo(o.x), bf_hi(o.x), bf_lo(o.y), bf_hi(o.y)}; }
struct ChunkRegs { u32x4 r, k, v, tw, ta; };
__device__ __forceinline__ void scan_load(KP P, const Frame& F, int item, int c4, ChunkRegs& R) {
    const int s = item & 63, sc = item >> 6, z = s >> 5, b = (s >> 4) & 1, hh = s & 15;
    const size_t row = (size_t)scan_row(z, b, sc * 256 + c4 * 64 + (F.tid >> 3)); const size_t o = row * D + hh * 64 + (F.tid & 7) * 8, o2 = row * 256 + z * 64 + (F.tid & 7) * 8;
    R.r = *(const u32x4*)((const bf16_t*)(P->ws + WS_R) + o); R.k = *(const u32x4*)((const bf16_t*)(P->ws + WS_K) + o); R.v = *(const u32x4*)((const bf16_t*)(P->ws + WS_VV) + o);
    R.tw = *(const u32x4*)((const bf16_t*)(P->ws + WS_TW) + o2); R.ta = *(const u32x4*)((const bf16_t*)(P->ws + WS_TA) + o2);
}
__device__ __forceinline__ void scan_chunk_phase(const Frame& F, KP P, int j) {
    LAS unsigned char* lds = F.lds;
    LAS bf16_t* At = stile(lds, T_AT); LAS bf16_t* Rt = stile(lds, T_RT); LAS bf16_t* Bt = stile(lds, T_BT); LAS bf16_t* Kt = stile(lds, T_KT); LAS bf16_t* Vm = stile(lds, T_VM);
    LAS bf16_t* NT = stile(lds, T_NT); LAS bf16_t* MT = stile(lds, T_MT); LAS bf16_t* NrT = stile(lds, T_NRT); LAS bf16_t* MrT = stile(lds, T_MRT);
    LAS bf16_t* ApA = stile(lds, T_APA); LAS bf16_t* ApB = stile(lds, T_APB); LAS bf16_t* TaA = stile(lds, T_TAA); LAS bf16_t* TaB = stile(lds, T_TAB);
    LAS bf16_t* PrB = stile(lds, T_PRB); LAS bf16_t* QrB = stile(lds, T_QRB);
    LAS float* gl = (LAS float*)(lds + LDS_GL); LAS float* seg = (LAS float*)(lds + LDS_SEG);
    const int lane = F.lane, wq = F.wave & 3, wh = F.wave >> 2, l15 = lane & 15, l4 = lane >> 4;
    const int pi = F.tid >> 3, kq = F.tid & 7;
    const int jrow = 16 * wq + l15;
    const int NITEM = NSCAN * NSC;
    int item = blockIdx.x; if (item >= NITEM) return;
    ChunkRegs cur, nxt; scan_load(P, F, item, 0, cur); nxt = cur;
    f32x4 Pr[2], Qr[2], aYp[2], aQp[2];
#pragma unroll
    for (int q = 0; q < 2; ++q) { Pr[q] = (f32x4){0.f, 0.f, 0.f, 0.f}; Qr[q] = Pr[q]; aYp[q] = Pr[q]; aQp[q] = Pr[q]; }
    bool pend = false; size_t orowp = 0; bf16_t* GEp = nullptr; bf16_t* YEp = nullptr; float* pqp = nullptr; bool lastp = false;
#define SCAN_STAGE_G() do { \
        f32x4 ge[2] = {(f32x4){0.f, 0.f, 0.f, 0.f}, (f32x4){0.f, 0.f, 0.f, 0.f}}; \
        mm64<false, true>(NT, PrB, ge, wq, wh, lane); mm64<false, true>(NT, QrB, aYp, wq, wh, lane); \
        f32x4 pn[2] = {(f32x4){0.f, 0.f, 0.f, 0.f}, (f32x4){0.f, 0.f, 0.f, 0.f}}; \
        mm64<false, false>(PrB, MT, pn, wq, wh, lane); mm64<false, false>(QrB, MT, aQp, wq, wh, lane); \
        _Pragma("unroll") for (int q = 0; q < 2; ++q) { const int i0 = 16 * (2 * wh + q) + 4 * l4; \
            u32x2 o; o.x = cvt_pk_bf16(ge[q][0], ge[q][1]); o.y = cvt_pk_bf16(ge[q][2], ge[q][3]); *(u32x2*)(GEp + orowp + i0) = o; \
            u32x2 y; y.x = cvt_pk_bf16(aYp[q][0], aYp[q][1]); y.y = cvt_pk_bf16(aYp[q][2], aYp[q][3]); *(u32x2*)(YEp + orowp + i0) = y; \
            Pr[q] = pn[q]; Qr[q] = aQp[q]; } \
        if (lastp) { _Pragma("unroll") for (int q = 0; q < 2; ++q) { const int i0 = 16 * (2 * wh + q) + 4 * l4; *(f32x4*)(pqp + jrow * 64 + i0) = Pr[q]; *(f32x4*)(pqp + 4096 + jrow * 64 + i0) = Qr[q]; } } \
    } while (0)
    for (;;) {
        const int s = item & 63, sc = item >> 6, z = s >> 5, b = (s >> 4) & 1, hh = s & 15;
        const float* kkw = P->in[I_KK] + (size_t)j * D + hh * 64 + kq * 8; const float* kap = P->in[I_KA] + (size_t)j * D + hh * 64 + kq * 8; const float* rkp = P->in[I_RK] + (size_t)j * D + hh * 64 + kq * 8;
        const float* w0p = P->in[I_W0] + ((size_t)j * 2 + z) * D + hh * 64; const float* a0p = P->in[I_A0] + ((size_t)j * 2 + z) * D + hh * 64;
        float* bon = (float*)(P->ws + WS_BON) + (size_t)z * T * 16;
        const u32x4 w2r = *(const u32x4*)((const bf16_t*)(P->ws + WS_W2P) + (((size_t)j * 2 + z) * D + hh * 64 + pi) * 256 + z * 64 + kq * 8);
        const u32x4 a2r = *(const u32x4*)((const bf16_t*)(P->ws + WS_A2P) + (((size_t)j * 2 + z) * D + hh * 64 + pi) * 256 + z * 64 + kq * 8);
        bf16_t* GE = (bf16_t*)(P->ws + (z ? WS_AS1 : WS_AS0)); bf16_t* YE = (bf16_t*)(P->ws + (z ? WS_ELOG1 : WS_ELOG0));
        float* pq = (float*)(P->ws + WS_PQ) + ((size_t)(s * NSC + sc) * 2) * 4096;
#pragma nounroll
        for (int c4 = 0; c4 < 4; ++c4) {
            *(LAS u32x4*)(ApA + pi * TP + kq * 8) = cur.tw; *(LAS u32x4*)(ApB + pi * TP + kq * 8) = cur.ta; *(LAS u32x4*)(NrT + pi * TP + kq * 8) = w2r; *(LAS u32x4*)(MrT + pi * TP + kq * 8) = a2r;
            LDS_BARRIER();
            {   f32x4 lw[2] = {(f32x4){0.f, 0.f, 0.f, 0.f}, (f32x4){0.f, 0.f, 0.f, 0.f}}, la[2] = {(f32x4){0.f, 0.f, 0.f, 0.f}, (f32x4){0.f, 0.f, 0.f, 0.f}};
                mm64<false, true>(ApA, NrT, lw, wq, wh, lane); mm64<false, true>(ApB, MrT, la, wq, wh, lane);
#pragma unroll
                for (int q = 0; q < 2; ++q) { const int i0 = 16 * (2 * wh + q) + 4 * l4; const f32x4 w04 = *(const f32x4*)(w0p + i0), a04 = *(const f32x4*)(a0p + i0);
#pragma unroll
                    for (int r = 0; r < 4; ++r) { const float xx = -(w04[r] + lw[q][r]); const float sp = fmaxf(xx, 0.f) + __logf(1.0f + __expf(-fabsf(xx))); lw[q][r] = -__expf(-sp - 0.5f); la[q][r] = sigmoidf_(a04[r] + la[q][r]); } }
                st_tile(TaA, lw, wq, wh, lane); st_tile(TaB, la, wq, wh, lane); }
            LDS_BARRIER();
            float r8[8], k8[8], e8[8], m8[8], a8[8], kk8[8], c8[8];
            { const u32x4 et = *(const LAS u32x4*)(TaA + pi * TP + kq * 8), at = *(const LAS u32x4*)(TaB + pi * TP + kq * 8); unpack8(cur.r, r8); unpack8(cur.k, k8); unpack8(et, e8); unpack8(at, a8); }
            {   const f32x4 ka0 = *(const f32x4*)(kap), ka1 = *(const f32x4*)(kap + 4), rk0 = *(const f32x4*)(rkp), rk1 = *(const f32x4*)(rkp + 4); float bp = 0.f;
#pragma unroll
                for (int e = 0; e < 8; ++e) { m8[e] = k8[e] * (1.0f + (a8[e] - 1.0f) * (e < 4 ? ka0[e & 3] : ka1[e & 3])); bp += r8[e] * (e < 4 ? rk0[e & 3] : rk1[e & 3]) * m8[e]; }
                bp += shx(bp, 1, lane); bp += shx(bp, 2, lane); bp += shx(bp, 4, lane);
                if (kq == 0) bon[(size_t)scan_row(z, b, sc * 256 + c4 * 64 + pi) * 16 + hh] = bp; }
            { const f32x4 w0 = *(const f32x4*)kkw, w1 = *(const f32x4*)(kkw + 4); float ss = 0.f;
#pragma unroll
              for (int e = 0; e < 8; ++e) { kk8[e] = k8[e] * (e < 4 ? w0[e & 3] : w1[e & 3]); ss += kk8[e] * kk8[e]; }
              ss += shx(ss, 1, lane); ss += shx(ss, 2, lane); ss += shx(ss, 4, lane);
              const float rn = rsqrtf(ss + 1e-12f);
#pragma unroll
              for (int e = 0; e < 8; ++e) { kk8[e] *= rn; c8[e] = e8[e]; } }
#pragma unroll
            for (int d = 8; d < 64; d <<= 1) {
#pragma unroll
                for (int e = 0; e < 8; ++e) { const float t = shup(c8[e], d, lane); c8[e] += lane >= d ? t : 0.f; } }
            if (lane >= 56) { *(LAS f32x4*)(seg + F.wave * 64 + kq * 8) = (f32x4){c8[0], c8[1], c8[2], c8[3]}; *(LAS f32x4*)(seg + F.wave * 64 + kq * 8 + 4) = (f32x4){c8[4], c8[5], c8[6], c8[7]}; }
            if (pend) { SCAN_STAGE_G(); pend = false; }
            LDS_BARRIER();
            if (c4 > 0) { st_tile(PrB, Pr, wq, wh, lane); st_tile(QrB, Qr, wq, wh, lane); }
            { float cum[8];
#pragma unroll
              for (int e = 0; e < 8; ++e) cum[e] = c8[e];
              for (int w2 = 0; w2 < F.wave; ++w2) { const f32x4 o0 = *(const LAS f32x4*)(seg + w2 * 64 + kq * 8), o1 = *(const LAS f32x4*)(seg + w2 * 64 + kq * 8 + 4);
#pragma unroll
                  for (int e = 0; e < 8; ++e) cum[e] += e < 4 ? o0[e & 3] : o1[e & 3]; }
              float o[8];
#pragma unroll
              for (int e = 0; e < 8; ++e) o[e] = -kk8[e] * __expf(cum[e] - e8[e]);
              *(LAS u32x4*)(At + pi * TP + kq * 8) = pack8(o);
#pragma unroll
              for (int e = 0; e < 8; ++e) o[e] = r8[e] * __expf(cum[e]);
              *(LAS u32x4*)(Rt + pi * TP + kq * 8) = pack8(o);
              float en[8];
#pragma unroll
              for (int e = 0; e < 8; ++e) { en[e] = __expf(-cum[e]); o[e] = kk8[e] * a8[e] * en[e]; }
              *(LAS u32x4*)(Bt + pi * TP + kq * 8) = pack8(o);
#pragma unroll
              for (int e = 0; e < 8; ++e) o[e] = m8[e] * en[e];
              *(LAS u32x4*)(Kt + pi * TP + kq * 8) = pack8(o);
              *(LAS u32x4*)(Vm + pi * TP + kq * 8) = cur.v;
              if (pi == 63) {
#pragma unroll
                  for (int e = 0; e < 8; ++e) gl[kq * 8 + e] = __expf(cum[e]); } }
            { const int nitem = c4 < 3 ? item : item + (int)gridDim.x, nc4 = c4 < 3 ? c4 + 1 : 0; if (nitem < NITEM) scan_load(P, F, nitem, nc4, nxt); }
            LDS_BARRIER();
            {   f32x4 aN[2], aM[2], aNr[2], aMr[2];
#pragma unroll
                for (int q = 0; q < 2; ++q) { aN[q] = (f32x4){0.f, 0.f, 0.f, 0.f}; aM[q] = aN[q]; aNr[q] = aN[q]; aMr[q] = aN[q]; }
                mm64<false, true>(At, Bt, aN, wq, wh, lane); mm64<false, true>(At, Kt, aM, wq, wh, lane); mm64<false, true>(Rt, Bt, aNr, wq, wh, lane); mm64<false, true>(Rt, Kt, aMr, wq, wh, lane);
                f32x4 aT[2];
#pragma unroll
                for (int q = 0; q < 2; ++q)
#pragma unroll
                    for (int r = 0; r < 4; ++r) { const int i = 16 * (2 * wh + q) + 4 * l4 + r; const bool lt = i < jrow, le = i <= jrow;
                        aN[q][r] = lt ? aN[q][r] : 0.f; aM[q][r] = lt ? aM[q][r] : 0.f; aNr[q][r] = le ? aNr[q][r] : 0.f; aMr[q][r] = le ? aMr[q][r] : 0.f; aT[q][r] = aN[q][r] + (i == jrow ? 1.f : 0.f); }
                st_tile(NT, aN, wq, wh, lane); st_tile(MT, aM, wq, wh, lane); st_tile(NrT, aNr, wq, wh, lane); st_tile(MrT, aMr, wq, wh, lane); st_tile(TaA, aT, wq, wh, lane);
            }
            LDS_BARRIER();
            if (F.wave < 4) { const int o = 16 * F.wave, oc = 16 * ((F.wave + 1) & 3);
                f32x4 p = prod16(NT, o, o, NT, o, o, (f32x4){0.f, 0.f, 0.f, 0.f}, lane); st16(ApA, o, o, p, lane);
                f32x4 t = prod16(TaA, o, o, ApA, o, o, ld16(TaA, o, o, lane), lane); p = prod16(ApA, o, o, ApA, o, o, (f32x4){0.f, 0.f, 0.f, 0.f}, lane);
                st16(TaB, o, o, t, lane); st16(ApA, o, oc, p, lane);
                t = prod16(TaB, o, o, ApA, o, oc, ld16(TaB, o, o, lane), lane); p = prod16(ApA, o, oc, ApA, o, oc, (f32x4){0.f, 0.f, 0.f, 0.f}, lane);
                st16(TaA, o, o, t, lane); st16(ApA, o, o, p, lane);
                t = prod16(TaA, o, o, ApA, o, o, ld16(TaA, o, o, lane), lane); st16(TaB, o, o, t, lane);
#pragma unroll
                for (int jj = 1; jj < 4; ++jj) if (jj > F.wave) { u32x2 zz; asm volatile("v_mov_b32 %0, 0\n\tv_mov_b32 %1, 0" : "=v"(zz.x), "=v"(zz.y)); *(LAS u32x2*)(TaB + (o + l15) * TP + 16 * jj + 4 * l4) = zz; }
            } else { const int wq2 = F.wave - 4;
#pragma unroll
                for (int wh2 = 0; wh2 < 2; ++wh2) { f32x4 x[2] = {(f32x4){0.f, 0.f, 0.f, 0.f}, (f32x4){0.f, 0.f, 0.f, 0.f}}; mm64<true, true>(Vm, MT, x, wq2, wh2, lane); st_tile(ApB, x, wq2, wh2, lane); } }
            LDS_BARRIER();
            if (F.wave < 3) { const int jj = F.wave;
#pragma unroll
                for (int i = 1; i < 4; ++i) if (i > jj) { f32x4 e = (f32x4){0.f, 0.f, 0.f, 0.f};
#pragma unroll
                    for (int m = 0; m < 3; ++m) if (m >= jj && m < i) e = prod16(NT, 16 * i, 16 * m, TaB, 16 * m, 16 * jj, e, lane);
                    st16(ApA, 16 * i, 16 * jj, e, lane);
                    st16(TaB, 16 * i, 16 * jj, prod16(TaB, 16 * i, 16 * i, ApA, 16 * i, 16 * jj, (f32x4){0.f, 0.f, 0.f, 0.f}, lane), lane); } }
            LDS_BARRIER();
            {   f32x4 w[2] = {(f32x4){0.f, 0.f, 0.f, 0.f}, (f32x4){0.f, 0.f, 0.f, 0.f}}; mm64<true, true>(At, TaB, w, wq, wh, lane); st_tile(ApA, w, wq, wh, lane);
                f32x4 u[2] = {(f32x4){0.f, 0.f, 0.f, 0.f}, (f32x4){0.f, 0.f, 0.f, 0.f}}; mm64<false, true>(ApB, TaB, u, wq, wh, lane); st_tile(TaA, u, wq, wh, lane); }
            LDS_BARRIER();
            f32x4 aP[2], aQ[2], aG[2], aY[2];
#pragma unroll
            for (int q = 0; q < 2; ++q) { aP[q] = (f32x4){0.f, 0.f, 0.f, 0.f}; aQ[q] = aP[q]; aG[q] = aP[q]; aY[q] = aP[q]; }
            mm64<false, false>(ApA, Bt, aP, wq, wh, lane);
            mm64<false, false>(TaA, Bt, aQ, wq, wh, lane); mm64<true, false>(Vm, Kt, aQ, wq, wh, lane);
            mm64<false, true>(NrT, ApA, aG, wq, wh, lane);
            mm64<false, true>(NrT, TaA, aY, wq, wh, lane); mm64<false, false>(MrT, Vm, aY, wq, wh, lane);
#pragma unroll
            for (int q = 0; q < 2; ++q) { const int i0 = 16 * (2 * wh + q) + 4 * l4; const f32x4 g4 = *(const LAS f32x4*)(gl + i0);
                const u32x2 rr = *(const LAS u32x2*)(Rt + jrow * TP + i0);
#pragma unroll
                for (int r = 0; r < 4; ++r) { aP[q][r] = (aP[q][r] + (i0 + r == jrow ? 1.f : 0.f)) * g4[r]; aQ[q][r] *= g4[r]; }
                aG[q][0] += bf_lo(rr.x); aG[q][1] += bf_hi(rr.x); aG[q][2] += bf_lo(rr.y); aG[q][3] += bf_hi(rr.y); }
            const size_t orow = (size_t)scan_row(z, b, sc * 256 + c4 * 64 + jrow) * D + hh * 64;
            if (c4 == 0) {
#pragma unroll
                for (int q = 0; q < 2; ++q) { const int i0 = 16 * (2 * wh + q) + 4 * l4;
                    u32x2 o; o.x = cvt_pk_bf16(aG[q][0], aG[q][1]); o.y = cvt_pk_bf16(aG[q][2], aG[q][3]); *(u32x2*)(GE + orow + i0) = o;
                    u32x2 y; y.x = cvt_pk_bf16(aY[q][0], aY[q][1]); y.y = cvt_pk_bf16(aY[q][2], aY[q][3]); *(u32x2*)(YE + orow + i0) = y;
                    Pr[q] = aP[q]; Qr[q] = aQ[q]; }
            } else {
                st_tile(NT, aG, wq, wh, lane); st_tile(MT, aP, wq, wh, lane);
#pragma unroll
                for (int q = 0; q < 2; ++q) { aYp[q] = aY[q]; aQp[q] = aQ[q]; }
                pend = true; orowp = orow; GEp = GE; YEp = YE; pqp = pq; lastp = c4 == 3;
            }
            cur = nxt;
            LDS_BARRIER();
        }
        item += gridDim.x; if (item >= NITEM) break;
    }
    if (pend) { SCAN_STAGE_G(); }
#undef SCAN_STAGE_G
}
__device__ __forceinline__ void scan_carry_phase(const Frame& F, KP P) {
    if (blockIdx.x >= 4 * NSCAN) return;
    const int s = blockIdx.x >> 2, vs = blockIdx.x & 3, lane = F.lane, l15 = lane & 15, l4 = lane >> 4, v = 16 * vs + l15, T2 = F.wave;
    const float* pq = (const float*)(P->ws + WS_PQ) + (size_t)s * NSC * 2 * 4096; bf16_t* sst = (bf16_t*)(P->ws + WS_SST) + (size_t)s * NSC * 4096;
    LAS f32x4* exch = (LAS f32x4*)F.lds;
    f32x4 S[4]; float ap[4][16], qp[4][4];
#pragma unroll
    for (int t = 0; t < 4; ++t) S[t] = (f32x4){0.f, 0.f, 0.f, 0.f};
#define CARRY_LOAD(slot, step) do { const float* Pm_ = pq + (size_t)(step) * 2 * 4096; \
        _Pragma("unroll") for (int t2i = 0; t2i < 4; ++t2i) _Pragma("unroll") for (int ri = 0; ri < 4; ++ri) ap[slot][t2i * 4 + ri] = Pm_[(16 * l4 + 4 * ri + t2i) * 64 + 4 * l15 + T2]; \
        _Pragma("unroll") for (int r = 0; r < 4; ++r) qp[slot][r] = Pm_[4096 + v * 64 + 16 * l4 + 4 * r + T2]; } while (0)
#define CARRY_STORE(sc_) do { if (T2 == 0) { float o[16]; \
        _Pragma("unroll") for (int r = 0; r < 4; ++r) _Pragma("unroll") for (int t2 = 0; t2 < 4; ++t2) o[4 * r + t2] = S[t2][r]; \
        u32x4 w0, w1; w0.x = cvt_pk_bf16(o[0], o[1]); w0.y = cvt_pk_bf16(o[2], o[3]); w0.z = cvt_pk_bf16(o[4], o[5]); w0.w = cvt_pk_bf16(o[6], o[7]); \
        w1.x = cvt_pk_bf16(o[8], o[9]); w1.y = cvt_pk_bf16(o[10], o[11]); w1.z = cvt_pk_bf16(o[12], o[13]); w1.w = cvt_pk_bf16(o[14], o[15]); \
        *(u32x4*)(sst + (size_t)(sc_) * 4096 + v * 64 + 16 * l4) = w0; *(u32x4*)(sst + (size_t)(sc_) * 4096 + v * 64 + 16 * l4 + 8) = w1; } } while (0)
    if (T2 < 4) {
#pragma unroll
        for (int u = 0; u < 4; ++u) CARRY_LOAD(u, u);
    }
#pragma nounroll
    for (int sc0 = 0; sc0 < NSC - 1; sc0 += 4) {
#pragma unroll
        for (int u = 0; u < 4; ++u) { const int sc = sc0 + u;
            CARRY_STORE(sc);
            if (T2 < 4) {
                f32x4 nw = (f32x4){qp[u][0], qp[u][1], qp[u][2], qp[u][3]};
#pragma unroll
                for (int t2i = 0; t2i < 4; ++t2i)
#pragma unroll
                    for (int ri = 0; ri < 4; ++ri) nw = __builtin_amdgcn_mfma_f32_16x16x4f32(ap[u][t2i * 4 + ri], S[t2i][ri], nw, 0, 0, 0);
                if (sc + 4 < NSC - 1) CARRY_LOAD(u, sc + 4);
                exch[((u & 1) * 4 + T2) * 64 + lane] = nw;
            }
            LDS_BARRIER();
            if (T2 < 4) {
#pragma unroll
                for (int t = 0; t < 4; ++t) S[t] = exch[((u & 1) * 4 + t) * 64 + lane];
            }
        }
    }
    CARRY_STORE(NSC - 1);
#undef CARRY_LOAD
#undef CARRY_STORE
}
__device__ __forceinline__ void scan_out_phase(const Frame& F, KP P, int j) {
    const int lane = F.lane, l15 = lane & 15, l4 = lane >> 4;
    const bf16_t* GE0 = (const bf16_t*)(P->ws + WS_AS0); const bf16_t* GE1 = (const bf16_t*)(P->ws + WS_AS1); const bf16_t* YE0 = (const bf16_t*)(P->ws + WS_ELOG0); const bf16_t* YE1 = (const bf16_t*)(P->ws + WS_ELOG1);
    const bf16_t* Vb = (const bf16_t*)(P->ws + WS_VV); const float* BON = (const float*)(P->ws + WS_BON);
    const bf16_t* GT = (const bf16_t*)(P->ws + WS_GATE); bf16_t* YG = (bf16_t*)(P->ws + WS_YG);
    for (int item = F.gw; item < NBATCH * NH * NSC * 8; item += F.NGW) {
        const int hh = item & 15, oct = (item >> 4) & 7, b = (item >> 7) & 1, blk = item >> 8;
        const int sc0 = blk, sc1 = blk == 0 ? 0 : NSC - blk;
        const bf16_t* s0 = (const bf16_t*)(P->ws + WS_SST) + ((size_t)(b * 16 + hh) * NSC + sc0) * 4096; const bf16_t* s1 = (const bf16_t*)(P->ws + WS_SST) + ((size_t)(32 + b * 16 + hh) * NSC + sc1) * 4096;
        bf16x8 sa0[4][2], sa1[4][2];
#pragma unroll
        for (int vt = 0; vt < 4; ++vt) { const int v = 32 * (vt >> 1) + 8 * (l15 >> 2) + 4 * (vt & 1) + (l15 & 3);
#pragma unroll
            for (int ks = 0; ks < 2; ++ks) { sa0[vt][ks] = *(const bf16x8*)(s0 + v * 64 + 32 * ks + 8 * l4); sa1[vt][ks] = *(const bf16x8*)(s1 + v * 64 + 32 * ks + 8 * l4); } }
        f32x4 lg4[4], lb4[4];
#pragma unroll
        for (int q = 0; q < 4; ++q) { const int c = hh * 64 + 32 * (q >> 1) + 8 * l4 + 4 * (q & 1); lg4[q] = *(const f32x4*)(P->in[I_LNG] + (size_t)j * D + c); lb4[q] = *(const f32x4*)(P->in[I_LNB] + (size_t)j * D + c); }
#pragma nounroll
        for (int ti = 0; ti < 2; ++ti) {
            const int tok = (2 * oct + ti) * 16 + l15; const int row = blk == 0 ? TL + b * CTXL + tok : b * SEQ + (blk - 1) * 256 + tok;
            const size_t o = (size_t)row * D + hh * 64;
            const bf16x8 g00 = *(const bf16x8*)(GE0 + o + 8 * l4), g01 = *(const bf16x8*)(GE0 + o + 32 + 8 * l4), g10 = *(const bf16x8*)(GE1 + o + 8 * l4), g11 = *(const bf16x8*)(GE1 + o + 32 + 8 * l4);
            u32x4 la[2], lc[2], lv[2], lgt[2];
#pragma unroll
            for (int h2 = 0; h2 < 2; ++h2) { const size_t oc = o + 32 * h2 + 8 * l4;
                la[h2] = *(const u32x4*)(YE0 + oc); lc[h2] = *(const u32x4*)(YE1 + oc); lv[h2] = *(const u32x4*)(Vb + oc); lgt[h2] = *(const u32x4*)(GT + oc); }
            const float bn = BON[(size_t)row * 16 + hh] + BON[((size_t)T + row) * 16 + hh];
            __builtin_amdgcn_sched_barrier(0);
            f32x4 y[4]; float s = 0.f; f32x4 vv[4], gg[4];
#pragma unroll
            for (int vt = 0; vt < 4; ++vt) { const int h2 = vt >> 1, hf = vt & 1;
                const unsigned ax = hf ? la[h2].z : la[h2].x, ay = hf ? la[h2].w : la[h2].y, cx = hf ? lc[h2].z : lc[h2].x, cy = hf ? lc[h2].w : lc[h2].y;
                const unsigned vx = hf ? lv[h2].z : lv[h2].x, vy = hf ? lv[h2].w : lv[h2].y, gx = hf ? lgt[h2].z : lgt[h2].x, gy = hf ? lgt[h2].w : lgt[h2].y;
                f32x4 acc = (f32x4){bf_lo(ax) + bf_lo(cx), bf_hi(ax) + bf_hi(cx), bf_lo(ay) + bf_lo(cy), bf_hi(ay) + bf_hi(cy)};
                acc = __builtin_amdgcn_mfma_f32_16x16x32_bf16(sa0[vt][0], g00, acc, 0, 0, 0); acc = __builtin_amdgcn_mfma_f32_16x16x32_bf16(sa0[vt][1], g01, acc, 0, 0, 0);
                acc = __builtin_amdgcn_mfma_f32_16x16x32_bf16(sa1[vt][0], g10, acc, 0, 0, 0); acc = __builtin_amdgcn_mfma_f32_16x16x32_bf16(sa1[vt][1], g11, acc, 0, 0, 0);
                y[vt] = acc; s += (acc[0] + acc[1]) + (acc[2] + acc[3]);
                vv[vt] = (f32x4){bf_lo(vx), bf_hi(vx), bf_lo(vy), bf_hi(vy)}; gg[vt] = (f32x4){bf_lo(gx), bf_hi(gx), bf_lo(gy), bf_hi(gy)}; }
            s += shx(s, 16, lane); s += shx(s, 32, lane);
            const float mean = s * (1.0f / 64.0f); float q = 0.f;
#pragma unroll
            for (int vt = 0; vt < 4; ++vt) { const f32x4 d = y[vt] - mean; q += (d[0] * d[0] + d[1] * d[1]) + (d[2] * d[2] + d[3] * d[3]); }
            q += shx(q, 16, lane); q += shx(q, 32, lane);
            const float rstd = rsqrtf(q * (1.0f / 64.0f) + 64e-5f);
#pragma unroll
            for (int h2 = 0; h2 < 2; ++h2) { const f32x4 o0 = (((y[2 * h2] - mean) * rstd) * lg4[2 * h2] + lb4[2 * h2] + vv[2 * h2] * bn) * gg[2 * h2], o1 = (((y[2 * h2 + 1] - mean) * rstd) * lg4[2 * h2 + 1] + lb4[2 * h2 + 1] + vv[2 * h2 + 1] * bn) * gg[2 * h2 + 1];
                u32x4 w; w.x = cvt_pk_bf16(o0[0], o0[1]); w.y = cvt_pk_bf16(o0[2], o0[3]); w.z = cvt_pk_bf16(o1[0], o1[1]); w.w = cvt_pk_bf16(o1[2], o1[3]); *(u32x4*)(YG + o + 32 * h2 + 8 * l4) = w; }
        }
    }
}
__device__ __forceinline__ bool in_range(int lo, int hi, int k) { asm volatile("" : "+s"(lo), "+s"(hi)); return lo <= k && k < hi; }
constexpr int NPH = 46;
template <unsigned KMASK> __global__ void __launch_bounds__(NTHR, 2) mega(Params Pv) {
    extern __shared__ __attribute__((aligned(16))) unsigned char lds_raw[];
    Frame F0; F0.lds = (LAS unsigned char*)lds_raw; F0.tid = threadIdx.x; F0.lane = F0.tid & 63; F0.wave = __builtin_amdgcn_readfirstlane(F0.tid >> 6);
    F0.G = gridDim.x; F0.gw = blockIdx.x * NWAVES + F0.wave; F0.NGW = F0.G * NWAVES;
    LAS unsigned* misc = (LAS unsigned*)(F0.lds + LDS_MISC);
    if (F0.tid < 128) misc[F0.tid] = 0u;
    __syncthreads();
    KP P0 = (KP)__builtin_amdgcn_kernarg_segment_ptr();
    constexpr bool ALL = (KMASK == 0x3ffffu);
    const int lo = ALL ? 0 : P0->ph_lo, hi = ALL ? NPH : P0->ph_hi;
    XcdBarrier bar; bar.bar = (unsigned*)(P0->ws + WS_CTL) + CW_BAR; bar.x = 0; bar.st = (volatile LAS unsigned*)(misc + 8);
    if (ALL || hi - lo > 1) bar = xcd_barrier_post((unsigned*)(P0->ws + WS_CTL) + CW_BAR, (volatile LAS unsigned*)(misc + 8));
#define IN(k) (ALL || in_range(lo, hi, (k)))
#define KIND(q) ((KMASK >> (q)) & 1u)
#define BAR_LEADER (wave_sgpr_now(F0.wave) == 0 && lane_id_now() == 0)
#define SEAM(k) do { if (IN(k) && IN((k) + 1)) { XcdBarrier b2_ = bar; unsigned* bb_ = bar.bar; unsigned bx_ = bar.x; asm volatile("" : "+s"(bb_), "+s"(bx_)); b2_.bar = bb_; b2_.x = bx_; xcd_barrier<false>(b2_, BAR_LEADER); } } while (0)
#define AMP_T0 const unsigned long long amp_t0 = AMP_MASK ? __builtin_amdgcn_s_memrealtime() : 0ull;
#define AMP_END(kind) do { if (AMP_MASK & (1u << (kind))) { const unsigned long long t1_ = __builtin_amdgcn_s_memrealtime(), dl_ = t1_ + AMP_F * (t1_ - amp_t0); while (__builtin_amdgcn_s_memrealtime() < dl_) __builtin_amdgcn_s_sleep(8); } } while (0)
#define PHASE_ENTRY AMP_T0 KP P = P0; asm volatile("" : "+s"(P)); unsigned char* ws = P->ws; unsigned* ctl = (unsigned*)(ws + WS_CTL); (void)ctl; \
    Frame F = F0; { int l_ = lane_id_now(), w_ = F0.wave; asm volatile("" : "+s"(w_)); F.lane = l_; F.wave = w_; F.tid = w_ * 64 + l_; F.gw = blockIdx.x * NWAVES + w_; }

    if constexpr (KIND(0)) if (IN(0)) { PHASE_ENTRY prologue_phase(F, P); AMP_END(0); }
    if (IN(0) && IN(1)) { XcdBarrier b2_ = bar; unsigned* bb_ = bar.bar; unsigned bx_ = bar.x; asm volatile("" : "+s"(bb_), "+s"(bx_)); b2_.bar = bb_; b2_.x = bx_; xcd_barrier<true>(b2_, BAR_LEADER); }
    for (int lp = 0; lp < 2; ++lp) {
        const int pb = 1 + 22 * lp, la = 2 * lp, lb = 2 * lp + 1;
        if constexpr (KIND(1)) if (IN(pb + 0)) { PHASE_ENTRY norm1_phase(F, P, la); AMP_END(1); }
        SEAM(pb + 0);
        if constexpr (KIND(2)) if (IN(pb + 1)) { PHASE_ENTRY
            __syncthreads(); set_desc(F.lds, F.tid, 0, ws + WS_HL, ws + WS_WIN + (size_t)lp * 4096 * D * 2, ws + WS_U, 16, 0, 0, ws + WS_V, P->in[I_GBIN] + (size_t)lp * 4096, ws + WS_STAT); __syncthreads();
            SchedMulti<D, D> S{F.lds, T / 256, 16, 1};
            EpiGelu E{F.lds};
            pg8::gemm_phase<EpiGelu, SchedMulti<D, D>, false, D, D, D>(F.lds, S, E, F.tid);
            AMP_END(2); }
        SEAM(pb + 1);
        if constexpr (KIND(3)) if (IN(pb + 2)) { PHASE_ENTRY spatial_phase(F, P, lp); AMP_END(3); }
        SEAM(pb + 2);
        if constexpr (KIND(4)) if (IN(pb + 3)) { PHASE_ENTRY
            __syncthreads();
            { float* X = (float*)(ws + WS_X);
              set_desc(F.lds, F.tid, 0, ws + WS_U, ws + WS_WOUT + (size_t)lp * D * GWID * 2, X, 4, 0, 0, la == 0 ? P->in[I_X] : X, la == 0 ? P->in[I_CTX] : X + (size_t)TL * D, P->in[I_GBOUT] + (size_t)lp * D);
              set_desc(F.lds, F.tid, 1, nullptr, nullptr, nullptr, 0, 0, 0, (const float*)(ws + WS_MOD) + (size_t)la * 3 * 6 * D + 2 * D); }
            __syncthreads();
            SchedMulti<GWID, GWID> S{F.lds, T / 256, 4, 1};
            EpiResid E{F.lds};
            pg8::gemm_phase<EpiResid, SchedMulti<GWID, GWID>, false, GWID, GWID, GWID>(F.lds, S, E, F.tid);
            AMP_END(4); }
        SEAM(pb + 3);
        if constexpr (KIND(5)) if (IN(pb + 4)) { PHASE_ENTRY norm2_phase(F, P, la); AMP_END(5); }
        SEAM(pb + 4);
        if constexpr (KIND(16)) if (IN(pb + 5)) { PHASE_ENTRY
            __syncthreads(); set_desc(F.lds, F.tid, 0, ws + WS_HL, ws + WS_WRT + (size_t)la * 256 * D * 2, nullptr, 1, 0, 0); __syncthreads();
            SchedMulti<D, D> S{F.lds, (la == DEPTH - 1 ? TL : T) / 256, 1, 1};
            EpiLogits E{(float*)(ws + WS_LG)};
            pg8::gemm_phase<EpiLogits, SchedMulti<D, D>, false, D, D, D>(F.lds, S, E, F.tid);
            AMP_END(16); }
        SEAM(pb + 5);
        if constexpr (KIND(17)) if (IN(pb + 6)) { PHASE_ENTRY route_phase(F, P, la); AMP_END(17); }
        SEAM(pb + 6);
        if constexpr (KIND(6)) if (IN(pb + 7)) { PHASE_ENTRY
            moe_tables(F.lds, F.tid, ctl + CW_CNT + la * 64);
            SchedMoE<D, D, true> S{F.lds, (const char*)(ws + WS_HL), (const char*)(ws + WS_WGU), (const int*)(ws + WS_LIST)};
            EpiSiluGate E{(bf16_t*)(ws + WS_H)};
            pg8::gemm_phase<EpiSiluGate, SchedMoE<D, D, true>, true, D, D, D>(F.lds, S, E, F.tid);
            AMP_END(6); }
        SEAM(pb + 7);
        if constexpr (KIND(7)) if (IN(pb + 8)) { PHASE_ENTRY
            moe_tables(F.lds, F.tid, ctl + CW_CNT + la * 64);
            SchedMoE<EHID, EHID, false> S{F.lds, (const char*)(ws + WS_H), (const char*)(ws + WS_WD), (const int*)(ws + WS_LIST)};
            EpiScatter E{F.lds, (bf16_t*)(ws + WS_YB), (const int*)(ws + WS_LIST)};
            pg8::gemm_phase<EpiScatter, SchedMoE<EHID, EHID, false>, false, EHID, EHID, EHID>(F.lds, S, E, F.tid);
            AMP_END(7); }
        SEAM(pb + 8);
        if constexpr (KIND(1)) if (IN(pb + 9)) { PHASE_ENTRY norm1_phase(F, P, lb); AMP_END(1); }
        SEAM(pb + 9);
        if constexpr (KIND(8)) if (IN(pb + 10)) { PHASE_ENTRY mix_phase(F, P, lp); AMP_END(8); }
        SEAM(pb + 10);
        if constexpr (KIND(9)) if (IN(pb + 11)) { PHASE_ENTRY
            __syncthreads();
            set_desc(F.lds, F.tid, 0, ws + WS_XR, ws + WS_WR + (size_t)lp * D * D * 2, ws + WS_R, 4, D, 0);
            set_desc(F.lds, F.tid, 1, ws + WS_XK, ws + WS_WK + (size_t)lp * D * D * 2, ws + WS_K, 4, D, 0);
            set_desc(F.lds, F.tid, 2, ws + WS_XV, ws + WS_WV + (size_t)lp * D * D * 2, ws + WS_VV, 4, D, 0);
            set_desc(F.lds, F.tid, 3, ws + WS_XW, ws + WS_LW1 + (size_t)lp * 256 * D * 2, ws + WS_TW, 1, 256, 1);
            set_desc(F.lds, F.tid, 4, ws + WS_XA, ws + WS_LA1 + (size_t)lp * 256 * D * 2, ws + WS_TA, 1, 256, 0);
            set_desc(F.lds, F.tid, 5, ws + WS_XG, ws + WS_LG1 + (size_t)lp * 256 * D * 2, ws + WS_TG, 1, 256, 2);
            __syncthreads();
            SchedMulti<D, D> S{F.lds, T / 256, 15, 6};
            EpiAct E{F.lds};
            pg8::gemm_phase<EpiAct, SchedMulti<D, D>, false, D, D, D>(F.lds, S, E, F.tid);
            AMP_END(9); }
        SEAM(pb + 11);
        if constexpr (KIND(10)) if (IN(pb + 12)) { PHASE_ENTRY
            __syncthreads(); set_desc(F.lds, F.tid, 0, ws + WS_TG, ws + WS_G2P + (size_t)lp * D * 256 * 2, ws + WS_GATE, 4, D, 0); __syncthreads();
            SchedMulti<256, 256> S{F.lds, T / 256, 4, 1};
            EpiAct E{F.lds};
            pg8::gemm_phase<EpiAct, SchedMulti<256, 256>, false, 256, 256, 256>(F.lds, S, E, F.tid);
            AMP_END(10); }
        SEAM(pb + 12);
        if constexpr (KIND(11)) if (IN(pb + 13)) { PHASE_ENTRY scan_chunk_phase(F, P, lp); AMP_END(11); }
        SEAM(pb + 13);
        if constexpr (KIND(14)) if (IN(pb + 14)) { PHASE_ENTRY scan_carry_phase(F, P); AMP_END(14); }
        SEAM(pb + 14);
        if constexpr (KIND(15)) if (IN(pb + 15)) { PHASE_ENTRY scan_out_phase(F, P, lp); AMP_END(15); }
        SEAM(pb + 15);
        if constexpr (KIND(4)) if (IN(pb + 16)) { PHASE_ENTRY
            __syncthreads();
            { float* X = (float*)(ws + WS_X);
              set_desc(F.lds, F.tid, 0, ws + WS_YG, ws + WS_WO + (size_t)lp * D * D * 2, X, 4, 0, 0, X, X + (size_t)TL * D, nullptr);
              set_desc(F.lds, F.tid, 1, nullptr, nullptr, nullptr, 0, 0, 0, (const float*)(ws + WS_MOD) + (size_t)lb * 3 * 6 * D + 2 * D); }
            __syncthreads();
            SchedMulti<D, D> S{F.lds, T / 256, 4, 1};
            EpiResid E{F.lds};
            pg8::gemm_phase<EpiResid, SchedMulti<D, D>, false, D, D, D>(F.lds, S, E, F.tid);
            AMP_END(4); }
        SEAM(pb + 16);
        if constexpr (KIND(5)) if (IN(pb + 17)) { PHASE_ENTRY norm2_phase(F, P, lb); AMP_END(5); }
        SEAM(pb + 17);
        if constexpr (KIND(16)) if (IN(pb + 18)) { PHASE_ENTRY
            __syncthreads(); set_desc(F.lds, F.tid, 0, ws + WS_HL, ws + WS_WRT + (size_t)lb * 256 * D * 2, nullptr, 1, 0, 0); __syncthreads();
            SchedMulti<D, D> S{F.lds, (lb == DEPTH - 1 ? TL : T) / 256, 1, 1};
            EpiLogits E{(float*)(ws + WS_LG)};
            pg8::gemm_phase<EpiLogits, SchedMulti<D, D>, false, D, D, D>(F.lds, S, E, F.tid);
            AMP_END(16); }
        SEAM(pb + 18);
        if constexpr (KIND(17)) if (IN(pb + 19)) { PHASE_ENTRY route_phase(F, P, lb); AMP_END(17); }
        SEAM(pb + 19);
        if constexpr (KIND(6)) if (IN(pb + 20)) { PHASE_ENTRY
            moe_tables(F.lds, F.tid, ctl + CW_CNT + lb * 64);
            SchedMoE<D, D, true> S{F.lds, (const char*)(ws + WS_HL), (const char*)(ws + WS_WGU), (const int*)(ws + WS_LIST)};
            EpiSiluGate E{(bf16_t*)(ws + WS_H)};
            pg8::gemm_phase<EpiSiluGate, SchedMoE<D, D, true>, true, D, D, D>(F.lds, S, E, F.tid);
            AMP_END(6); }
        SEAM(pb + 20);
        if constexpr (KIND(7)) if (IN(pb + 21)) { PHASE_ENTRY
            moe_tables(F.lds, F.tid, ctl + CW_CNT + lb * 64);
            SchedMoE<EHID, EHID, false> S{F.lds, (const char*)(ws + WS_H), (const char*)(ws + WS_WD), (const int*)(ws + WS_LIST)};
            EpiScatter E{F.lds, (bf16_t*)(ws + WS_YB), (const int*)(ws + WS_LIST)};
            pg8::gemm_phase<EpiScatter, SchedMoE<EHID, EHID, false>, false, EHID, EHID, EHID>(F.lds, S, E, F.tid);
            AMP_END(7); }
        SEAM(pb + 21);
    }
    if constexpr (KIND(13)) if (IN(45)) { PHASE_ENTRY final_phase(F, P); AMP_END(13); }
#undef IN
#undef KIND
#undef SEAM
#undef PHASE_ENTRY
}

#if !MK_ONE_LAUNCH
static int phase_kind(int ph) { if (ph == 0) return 0; if (ph == 45) return 13; static const int k22[22] = {1, 2, 3, 4, 5, 16, 17, 6, 7, 1, 8, 9, 10, 11, 14, 15, 4, 5, 16, 17, 6, 7}; return k22[(ph - 1) % 22]; }
typedef void (*kern_t)(Params);
template <unsigned KM> static kern_t kern_of() { return mega<KM>; }
static kern_t kind_kernel(int kind) {
    switch (kind) { case 0: return kern_of<1u << 0>(); case 1: return kern_of<1u << 1>(); case 2: return kern_of<1u << 2>(); case 3: return kern_of<1u << 3>(); case 4: return kern_of<1u << 4>();
        case 5: return kern_of<1u << 5>(); case 6: return kern_of<1u << 6>(); case 7: return kern_of<1u << 7>(); case 8: return kern_of<1u << 8>(); case 9: return kern_of<1u << 9>();
        case 10: return kern_of<1u << 10>(); case 11: return kern_of<1u << 11>(); case 12: return kern_of<1u << 12>(); case 14: return kern_of<1u << 14>(); case 15: return kern_of<1u << 15>(); case 16: return kern_of<1u << 16>(); case 17: return kern_of<1u << 17>(); default: return kern_of<1u << 13>(); }
}
#endif
extern "C" void kernel_launch(void* const* d_in, const int* in_sizes, int n_in, void* d_out, int out_size, void* d_ws, size_t ws_size, hipStream_t stream) {
    static int grid = 0;
    if (grid == 0) {
        if (n_in != 42 || out_size != TL * D || ws_size < WS_END) { fprintf(stderr, "kernel_launch: unexpected problem (n_in %d, out %d, ws %zu < %zu)\n", n_in, out_size, ws_size, (size_t)WS_END); grid = -1; return; }
        int dev = 0, cus = 0;
        if (hipGetDevice(&dev) != hipSuccess || hipDeviceGetAttribute(&cus, hipDeviceAttributeMultiprocessorCount, dev) != hipSuccess) { grid = -1; return; }
#if MK_ONE_LAUNCH
        if (hipFuncSetAttribute((const void*)mega<0x3ffffu>, hipFuncAttributeMaxDynamicSharedMemorySize, LDS_BYTES) != hipSuccess) { fprintf(stderr, "kernel_launch: hipFuncSetAttribute failed\n"); grid = -1; return; }
#else
        for (int k = 0; k < 18; ++k) if (hipFuncSetAttribute((const void*)kind_kernel(k), hipFuncAttributeMaxDynamicSharedMemorySize, LDS_BYTES) != hipSuccess) { fprintf(stderr, "kernel_launch: hipFuncSetAttribute failed\n"); grid = -1; return; }
#endif
        (void)hipGetLastError();
        grid = cus;
    }
    if (grid < 0) return;
    (void)hipMemsetAsync((char*)d_ws + WS_CTL, 0, CTL_BYTES, stream);
    Params p{};
    for (int i = 0; i < 42; ++i) p.in[i] = (const float*)d_in[i];
    p.out = (float*)d_out; p.ws = (unsigned char*)d_ws;
#if MK_ONE_LAUNCH
    p.ph_lo = 0; p.ph_hi = NPH;
    hipLaunchKernelGGL(mega<0x3ffffu>, dim3(grid), dim3(NTHR), LDS_BYTES, stream, p);
#else
    for (int ph = 0; ph < NPH; ++ph) { p.ph_lo = ph; p.ph_hi = ph + 1; hipLaunchKernelGGL(kind_kernel(phase_kind(ph)), dim3(grid), dim3(NTHR), LDS_BYTES, stream, p); }
#endif
}
```

```cpp
#include <hip/hip_runtime.h>
#include <cstdio>
#include <cstdint>

#define LAS __attribute__((address_space(3)))
typedef unsigned short bf16_t;
typedef short bf16x8 __attribute__((ext_vector_type(8)));
typedef float f32x4 __attribute__((ext_vector_type(4)));
typedef float f32x2 __attribute__((ext_vector_type(2)));
typedef unsigned u32x4 __attribute__((ext_vector_type(4)));
typedef unsigned u32x2 __attribute__((ext_vector_type(2)));

#ifndef CH_AMP
#define CH_AMP -1
#endif
#define CH_STAMP(i) do { if (CH_AMP >= 0) ch_t[i] = __builtin_amdgcn_s_memrealtime(); } while (0)
#ifndef AMP_MASK
#define AMP_MASK 0u
#endif
#define AMP_F 4
#ifndef MK_ONE_LAUNCH
#define MK_ONE_LAUNCH 1
#endif

constexpr int D = 1024, NBATCH = 2, SEQ = 16384, CTXL = 256, DEPTH = 4;
constexpr int TL = NBATCH * SEQ, TC = NBATCH * CTXL, T = TL + TC;
constexpr int GWID = 2048, NE = 32, EHID = 512, NH = 16, HD = 64;
constexpr int LISTCAP = T;
constexpr int MAXRT = (2 * T) / 256 + NE;
constexpr int NWAVES = 8, NTHR = 512;

constexpr size_t MiB = 1u << 20;
constexpr size_t WS_CTL = 0, CTL_BYTES = 1 * MiB;
constexpr size_t WS_MOD = 1 * MiB;
constexpr size_t WS_WIN = 2 * MiB, WS_WOUT = 18 * MiB, WS_WSP = 26 * MiB, WS_WR = 27 * MiB, WS_WK = 31 * MiB, WS_WV = 35 * MiB, WS_WO = 39 * MiB;
constexpr size_t WS_LW1 = 43 * MiB, WS_LA1 = 44 * MiB, WS_LG1 = 45 * MiB, WS_W2P = 46 * MiB, WS_A2P = 48 * MiB, WS_G2P = 50 * MiB;
constexpr size_t WS_WRT = 52 * MiB;
constexpr size_t WS_WGU = 54 * MiB, WS_WD = 118 * MiB;
constexpr size_t WS_X = 150 * MiB;
constexpr size_t WS_LIST = 280 * MiB, WS_WGT = 285 * MiB;
constexpr size_t WS_HL = 286 * MiB;
constexpr size_t WS_BIG = 351 * MiB;
constexpr size_t SZB = 65 * MiB;
constexpr size_t WS_U = WS_BIG, WS_V = WS_BIG + 2 * SZB, WS_STAT = WS_BIG + 4 * SZB;
constexpr size_t WS_XR = WS_BIG, WS_XW = WS_BIG + SZB, WS_XK = WS_BIG + 2 * SZB, WS_XV = WS_BIG + 3 * SZB, WS_XA = WS_BIG + 4 * SZB, WS_XG = WS_BIG + 5 * SZB;
constexpr size_t WS_R = WS_BIG + 6 * SZB, WS_K = WS_BIG + 7 * SZB, WS_VV = WS_BIG + 8 * SZB;
constexpr size_t WS_TW = WS_BIG + 9 * SZB, WS_TA = WS_TW + 17 * MiB, WS_TG = WS_TA + 17 * MiB;
constexpr size_t WS_ELOG0 = WS_XR, WS_ELOG1 = WS_XW, WS_KM0 = WS_XK, WS_KM1 = WS_XV, WS_AS0 = WS_XA, WS_AS1 = WS_XG;
constexpr size_t WS_GATE = WS_HL, WS_YG = WS_AS0, WS_BON = WS_TG + 17 * MiB;
constexpr size_t WS_H = WS_BIG, WS_YB = WS_BIG + 73 * MiB, WS_LG = WS_BIG + 204 * MiB;
constexpr size_t WS_PQ = WS_KM0;
constexpr size_t WS_SST = WS_WGU;
constexpr size_t WS_END = WS_BON + 5 * MiB;
static_assert(WS_END <= 1080 * MiB, "workspace map");
constexpr int CW_BAR = 4096;
constexpr int CW_CNT = 16384;

__device__ __forceinline__ int wave_sgpr_now(int w) { asm volatile("" : "+s"(w)); return w; }
__device__ __forceinline__ int lane_id_now() { int l; asm volatile("v_mbcnt_lo_u32_b32 %0, -1, 0\n\tv_mbcnt_hi_u32_b32 %0, -1, %0" : "=v"(l)); return l; }
typedef short v4s __attribute__((ext_vector_type(4)));
#define LDS_BARRIER() asm volatile("s_waitcnt lgkmcnt(0)\n\ts_barrier" ::: "memory")
typedef __bf16 bf16x2_t __attribute__((ext_vector_type(2)));
__device__ __forceinline__ unsigned cvt_pk_bf16(float lo, float hi) { const bf16x2_t v = __builtin_convertvector((f32x2){lo, hi}, bf16x2_t); return __builtin_bit_cast(unsigned, v); }
__device__ __forceinline__ float bf_lo(unsigned u) { return __uint_as_float(u << 16); }
__device__ __forceinline__ float bf_hi(unsigned u) { return __uint_as_float(u & 0xffff0000u); }
__device__ __forceinline__ float bf1(bf16_t b) { return __uint_as_float(((unsigned)b) << 16); }
__device__ __forceinline__ bf16_t f2bf(float f) { return (bf16_t)(cvt_pk_bf16(f, 0.f) & 0x3ffffu); }
__device__ __forceinline__ void unpack8(const u32x4& w, float (&f)[8]) { f[0] = bf_lo(w.x); f[1] = bf_hi(w.x); f[2] = bf_lo(w.y); f[3] = bf_hi(w.y); f[4] = bf_lo(w.z); f[5] = bf_hi(w.z); f[6] = bf_lo(w.w); f[7] = bf_hi(w.w); }
__device__ __forceinline__ u32x4 pack8(const float (&f)[8]) { u32x4 o; o.x = cvt_pk_bf16(f[0], f[1]); o.y = cvt_pk_bf16(f[2], f[3]); o.z = cvt_pk_bf16(f[4], f[5]); o.w = cvt_pk_bf16(f[6], f[7]); return o; }
__device__ __forceinline__ float shx(float v, int m, int lane) { return __int_as_float(__builtin_amdgcn_ds_bpermute((lane ^ m) << 2, __float_as_int(v))); }
__device__ __forceinline__ float shup(float v, int d, int lane) { return __int_as_float(__builtin_amdgcn_ds_bpermute((lane - d) << 2, __float_as_int(v))); }
__device__ __forceinline__ float wave_sum(float v, int lane) {
#pragma unroll
    for (int o = 1; o < 64; o <<= 1) v += shx(v, o, lane);
    return v;
}
__device__ __forceinline__ float sigmoidf_(float x) { return 1.0f / (1.0f + __expf(-x)); }
__device__ __forceinline__ float tanhf_(float x) { const float e = __expf(2.0f * x); return 1.0f - 2.0f / (e + 1.0f); }
__device__ __forceinline__ f32x2 gelu_pk(f32x2 v) {
    const f32x2 av = __builtin_elementwise_abs(v), d = av * 0.2316418882f + 1.0f;
    f32x2 t; t.x = __builtin_amdgcn_rcpf(d.x); t.y = __builtin_amdgcn_rcpf(d.y);
    f32x2 q = t * 0.5307027145f + (-0.7265760135f); q = q * t + 0.7107068705f; q = q * t + (-0.142248368f); q = q * t + 0.127414796f; q = q * t;
    const f32x2 s = (v * v) * (-0.72134752044f);
    f32x2 e; e.x = __builtin_amdgcn_exp2f(s.x); e.y = __builtin_amdgcn_exp2f(s.y);
    const f32x2 m = v * (q * e), r = v - m;
    f32x2 o; o.x = v.x < 0.f ? m.x : r.x; o.y = v.y < 0.f ? m.y : r.y; return o;
}

#define XB_TMO      128
#define XB_XCNT(j)  (256  + 64 * (j))
#define XB_XSUB(j)  (1280 + 64 * (j))
#define XB_XGEN(j)  (2304 + 64 * (j))
#define XB_TOP      3328
#define XB_TOPGEN   3392
#define XCD_BAR_WORDS 3456
#define XB_SPIN_CAP (1u << 18)
__device__ __forceinline__ unsigned xb_ld(unsigned* p)              { return __hip_atomic_load(p, __ATOMIC_RELAXED, __HIP_MEMORY_SCOPE_AGENT); }
__device__ __forceinline__ unsigned xb_add(unsigned* p, unsigned v) { return __hip_atomic_fetch_add(p, v, __ATOMIC_RELAXED, __HIP_MEMORY_SCOPE_AGENT); }
__device__ __forceinline__ unsigned xb_xcc_id() { return (unsigned)__builtin_amdgcn_s_getreg((3 << 11) | 20) & 0xFu; }
#define XB_SPIN(cond, bar) do { unsigned _sp = 0; while (cond) { __builtin_amdgcn_s_sleep(1); \
    if ((++_sp & 255u) == 0u) { if (xb_ld(&(bar)[XB_TMO])) break; if (_sp > XB_SPIN_CAP) { atomicAdd(&(bar)[XB_TMO], 1u); break; } } } } while (0)
struct XcdBarrier { unsigned* bar; unsigned x; volatile LAS unsigned* st; };
__device__ __forceinline__ XcdBarrier xcd_barrier_post(unsigned* bar, volatile LAS unsigned* st) {
    XcdBarrier b; b.bar = bar; b.x = xb_xcc_id(); b.st = st;
    if (threadIdx.x == 0) (void)xb_add(&bar[XB_XCNT(b.x)], 1u);
    return b;
}
__device__ __forceinline__ void xcd_barrier_complete(unsigned* bar, unsigned x, unsigned& nloc, unsigned& nx) {
    const unsigned G = gridDim.x * gridDim.y * gridDim.z;
    unsigned sum, cnt, mine, sp = 0u;
    for (;;) {
        sum = 0u; cnt = 0u; mine = 0u;
#pragma unroll
        for (unsigned j = 0; j < 16; ++j) { const unsigned c = xb_ld(&bar[XB_XCNT(j)]); sum += c; cnt += (c > 0u) ? 1u : 0u; mine = (j == x) ? c : mine; }
        if (sum == G) break;
        __builtin_amdgcn_s_sleep(1);
        if ((++sp & 255u) == 0u) { if (xb_ld(&bar[XB_TMO])) break; if (sp > XB_SPIN_CAP) { atomicAdd(&bar[XB_TMO], 1u); break; } }
    }
    nloc = mine > 0u ? mine : 1u; nx = cnt > 0u ? cnt : 1u;
}
template <bool FIRST> __device__ __forceinline__ void xcd_barrier(const XcdBarrier& b, const bool leader) {
    asm volatile("s_waitcnt vmcnt(0)" ::: "memory");
    __syncthreads();
    if (leader) {
        unsigned* bar = b.bar;
        __builtin_amdgcn_s_waitcnt(0);
        unsigned nloc = b.st[0], nx = b.st[1];
        if constexpr (FIRST) { if (nloc == 0u) { xcd_barrier_complete(bar, b.x, nloc, nx); b.st[0] = nloc; b.st[1] = nx; } }
        const unsigned old = xb_add(&bar[XB_XSUB(b.x)], 1u);
        const unsigned gen = old / nloc;
        if (old + 1u == (gen + 1u) * nloc) {
            __builtin_amdgcn_fence(__ATOMIC_RELEASE, "agent");
            asm volatile("s_waitcnt vmcnt(0)" ::: "memory");
            const unsigned og = xb_add(&bar[XB_TOP], 1u);
            const unsigned tg = og / nx;
            if (og + 1u == (tg + 1u) * nx) xb_add(&bar[XB_TOPGEN], 1u);
            else XB_SPIN(xb_ld(&bar[XB_TOPGEN]) == tg, bar);
            __builtin_amdgcn_fence(__ATOMIC_ACQUIRE, "agent");
            xb_add(&bar[XB_XGEN(b.x)], 1u);
            asm volatile("s_waitcnt vmcnt(0)" ::: "memory");
        } else {
            XB_SPIN(xb_ld(&bar[XB_XGEN(b.x)]) == gen, bar);
            __builtin_amdgcn_fence(__ATOMIC_ACQUIRE, "agent");
            asm volatile("s_waitcnt vmcnt(0)" ::: "memory");
        }
    }
    __syncthreads();
}

constexpr int LDS_MISC = 143360;
constexpr int LDS_DESC = LDS_MISC + 128;
constexpr int LDS_TAB = LDS_MISC + 512;
constexpr int LDS_BYTES = 147456;
namespace pg8 {
constexpr int BM = 256, BK = 64, HALF = 128, HTB = HALF * BK * 2, STAGE_BYTES = 8 * HTB, NXCD = 8, WGM = 8;
__host__ __device__ __forceinline__ int lds_byte(int r, int c) { const int st = (r >> 4) * 2 + (c >> 5), rr = r & 15, cc = c & 31, ob = rr * 64 + cc * 2; return st * 1024 + (ob ^ (((ob >> 9) & 1) << 5)); }
__host__ __device__ __forceinline__ void stage_rc(int b, int& R, int& C) { const int st = b / 1024, sb = b % 1024, swz = sb ^ (((sb >> 9) & 1) << 5); R = (st >> 1) * 16 + swz / 64; C = (st & 1) * 32 + (swz % 64) / 2; }
__host__ __device__ __forceinline__ int perm32(int rho) { const int n = rho >> 4, i = rho & 15; return 8 * (i >> 2) + 4 * n + (i & 3); }
__device__ __forceinline__ int xcd_remap(int L, int nwg) { const int q = nwg / NXCD, r = nwg % NXCD, xcd = L % NXCD, off = L / NXCD; return (xcd < r ? xcd * (q + 1) : r * (q + 1) + (xcd - r) * q) + off; }

struct Unit { int pm, pn, aux; };

template <class Epi, class Sched, bool GATHER, int K, int LDA, int LDB>
__device__ __forceinline__ void gemm_phase(LAS unsigned char* lds, const Sched& S, const Epi& E, const int tid_in) {
    int tid_ = tid_in; asm volatile("" : "+v"(tid_));
    const int tid = tid_, wid = __builtin_amdgcn_readfirstlane(tid >> 6), lane = tid & 63, wr = wid >> 2, wc = wid & 3, fr = lane & 15, fq = lane >> 4;
    constexpr int nt = K / BK;
    unsigned voffA[2], voffB[2];
#pragma unroll
    for (int i = 0; i < 2; ++i) { int R, C; stage_rc(tid * 16 + i * 8192, R, C); const int Rb = Epi::PERM ? ((R & ~31) + perm32(R & 31)) : R;
        voffA[i] = (unsigned)(R * LDA + C) * 2u; voffB[i] = (unsigned)(Rb * LDB + C) * 2u; }
    constexpr size_t kstep = (size_t)(BK * 2);
    constexpr size_t hstepA = GATHER ? (size_t)0 : (size_t)HALF * LDA * 2, hstepB = (size_t)HALF * LDB * 2;
    const unsigned ldsw = (unsigned)wid * 1024u;
    const int aoff = lds_byte(wr * 64 + fr, fq * 8), boff = lds_byte(wc * 32 + fr, fq * 8);
    unsigned gA[2][2], gN[2][2];
#define PG8_SA(b, h) (((b) * 2 + (h)) * HTB)
#define PG8_SB(b, h) ((4 + (b) * 2 + (h)) * HTB)
#define PG8_STAGEB(bufoff, gbase) do { _Pragma("unroll") for (int _i = 0; _i < 2; ++_i) \
        __builtin_amdgcn_global_load_lds((const unsigned*)((const char*)(gbase) + voffB[_i]), (LAS unsigned*)(lds + (bufoff) + ldsw + _i * 8192), 16, 0, 0); } while (0)
#define PG8_STAGEA(bufoff, gbase, h, GV) do { _Pragma("unroll") for (int _i = 0; _i < 2; ++_i) \
        __builtin_amdgcn_global_load_lds((const unsigned*)((const char*)(gbase) + (GATHER ? GV[h][_i] : voffA[_i]) + (h) * hstepA), (LAS unsigned*)(lds + (bufoff) + ldsw + _i * 8192), 16, 0, 0); } while (0)
#define PG8_LDA(dst, b, h) do { _Pragma("unroll") for (int m = 0; m < 4; ++m) _Pragma("unroll") for (int k = 0; k < 2; ++k) dst[m][k] = *(const LAS bf16x8*)(lds + PG8_SA(b, h) + aoff + m * 2048 + k * 1024); } while (0)
#define PG8_LDB(dst, b, h) do { _Pragma("unroll") for (int n = 0; n < 2; ++n) _Pragma("unroll") for (int k = 0; k < 2; ++k) dst[n][k] = *(const LAS bf16x8*)(lds + PG8_SB(b, h) + boff + n * 2048 + k * 1024); } while (0)
#define PG8_MMA(ai, bj, At, Bt) do { __builtin_amdgcn_s_setprio(1); _Pragma("unroll") for (int m = 0; m < 4; ++m) _Pragma("unroll") for (int n = 0; n < 2; ++n) _Pragma("unroll") for (int k = 0; k < 2; ++k) \
        acc[ai][bj][m][n] = __builtin_amdgcn_mfma_f32_16x16x32_bf16(Bt[n][k], At[m][k], acc[ai][bj][m][n], 0, 0, 0); __builtin_amdgcn_s_setprio(0); } while (0)
#define PG8_WAIT_V(n) asm volatile("s_waitcnt vmcnt(" #n ")" ::: "memory")
#define PG8_WAIT_L(n) asm volatile("s_waitcnt lgkmcnt(" #n ")" ::: "memory")
#define PG8_BAR __builtin_amdgcn_s_barrier()
#define PG8_SCHED __builtin_amdgcn_sched_barrier(0)
    Unit cur, nxt; int ui = 0;
    if (!S.next(0, cur)) return;
    f32x4 acc[2][2][4][2];
#pragma unroll
    for (int a = 0; a < 2; ++a)
#pragma unroll
        for (int b = 0; b < 2; ++b)
#pragma unroll
            for (int m = 0; m < 4; ++m)
#pragma unroll
                for (int n = 0; n < 2; ++n) acc[a][b][m][n] = (f32x4){0.f, 0.f, 0.f, 0.f};
    bf16x8 At[4][2], B0[2][2], B1[2][2];
    const char* cA = S.aptr(cur); const char* cB = S.bptr(cur);
    if constexpr (GATHER) { S.gather(cur, tid, gA); }
    PG8_STAGEB(PG8_SB(0, 0), cB); PG8_STAGEB(PG8_SB(0, 1), cB + hstepB); PG8_STAGEA(PG8_SA(0, 0), cA, 0, gA); PG8_STAGEA(PG8_SA(0, 1), cA, 1, gA);
    if (wr == 1) PG8_BAR;
    PG8_WAIT_V(2); PG8_BAR;
    PG8_STAGEB(PG8_SB(1, 0), cB + kstep); PG8_STAGEA(PG8_SA(1, 0), cA + kstep, 0, gA); PG8_STAGEB(PG8_SB(1, 1), cB + hstepB + kstep);
    PG8_WAIT_V(6); PG8_BAR;
    for (;;) {
        const bool has_next = S.next(ui + 1, nxt);
        const char* nA = has_next ? S.aptr(nxt) : cA; const char* nB = has_next ? S.bptr(nxt) : cB;
        if constexpr (GATHER) { if (has_next) S.gather(nxt, tid, gN); else {
#pragma unroll
            for (int h = 0; h < 2; ++h)
#pragma unroll
                for (int i = 0; i < 2; ++i) gN[h][i] = gA[h][i]; } }
#pragma nounroll
        for (int t = 0; t < nt; t += 2) {
            const bool last = (t == nt - 2);
            const char* a1 = cA + (size_t)(t + 1) * kstep;
            const char* a2 = last ? nA : cA + (size_t)(t + 2) * kstep; const char* b2 = last ? nB : cB + (size_t)(t + 2) * kstep;
            const char* a3 = a2 + kstep; const char* b3 = b2 + kstep;
            unsigned g2[2][2];
            if constexpr (GATHER) {
#pragma unroll
                for (int h = 0; h < 2; ++h)
#pragma unroll
                    for (int i = 0; i < 2; ++i) g2[h][i] = last ? gN[h][i] : gA[h][i]; }
            PG8_LDB(B0, 0, 0); PG8_LDB(B1, 0, 1); PG8_SCHED; PG8_LDA(At, 0, 0); PG8_STAGEA(PG8_SA(1, 1), a1, 1, gA);
            PG8_WAIT_V(8); PG8_WAIT_L(0); PG8_BAR; PG8_MMA(0, 0, At, B0); PG8_MMA(0, 1, At, B1); PG8_BAR; PG8_SCHED;
            PG8_LDA(At, 0, 1); PG8_STAGEB(PG8_SB(0, 0), b2); PG8_STAGEB(PG8_SB(0, 1), b2 + hstepB); PG8_STAGEA(PG8_SA(0, 0), a2, 0, g2);
            PG8_WAIT_V(8); PG8_WAIT_L(0); PG8_BAR; PG8_MMA(1, 0, At, B0); PG8_MMA(1, 1, At, B1); PG8_BAR; PG8_SCHED;
            PG8_LDB(B0, 1, 0); PG8_LDB(B1, 1, 1); PG8_SCHED; PG8_LDA(At, 1, 0); PG8_STAGEA(PG8_SA(0, 1), a2, 1, g2);
            PG8_WAIT_V(8); PG8_WAIT_L(0); PG8_BAR; PG8_MMA(0, 0, At, B0); PG8_MMA(0, 1, At, B1); PG8_BAR; PG8_SCHED;
            PG8_LDA(At, 1, 1); PG8_STAGEB(PG8_SB(1, 0), b3); PG8_STAGEB(PG8_SB(1, 1), b3 + hstepB); PG8_STAGEA(PG8_SA(1, 0), a3, 0, g2);
            PG8_WAIT_V(8); PG8_WAIT_L(0); PG8_BAR; PG8_MMA(1, 0, At, B0); PG8_MMA(1, 1, At, B1); PG8_BAR; PG8_SCHED;
        }
        if (wr == 0) PG8_BAR;
        E(acc, cur, wr, wc, fr, fq);
        if (!has_next) break;
#pragma unroll
        for (int a = 0; a < 2; ++a)
#pragma unroll
            for (int b = 0; b < 2; ++b)
#pragma unroll
                for (int m = 0; m < 4; ++m)
#pragma unroll
                    for (int n = 0; n < 2; ++n) acc[a][b][m][n] = (f32x4){0.f, 0.f, 0.f, 0.f};
        cur = nxt; cA = nA; cB = nB; ++ui;
        if constexpr (GATHER) {
#pragma unroll
            for (int h = 0; h < 2; ++h)
#pragma unroll
                for (int i = 0; i < 2; ++i) gA[h][i] = gN[h][i]; }
        if (wr == 1) PG8_BAR;
    }
    PG8_WAIT_V(0);
    PG8_BAR;
#undef PG8_SA
#undef PG8_SB
#undef PG8_STAGEA
#undef PG8_STAGEB
#undef PG8_LDA
#undef PG8_LDB
#undef PG8_MMA
#undef PG8_WAIT_V
#undef PG8_WAIT_L
#undef PG8_BAR
#undef PG8_SCHED
}
}
using pg8::Unit;

__device__ __forceinline__ void set_desc(LAS unsigned char* lds, int tid, int g, const void* A, const void* B, const void* C, int nN, int ldc, int aux, const void* X1 = nullptr, const void* X2 = nullptr, const void* X3 = nullptr) {
    LAS int* d = (LAS int*)(lds + LDS_DESC) + g * 16;
    if (tid == 0) { unsigned long long a = (unsigned long long)A, b = (unsigned long long)B, c = (unsigned long long)C, x1 = (unsigned long long)X1, x2 = (unsigned long long)X2, x3 = (unsigned long long)X3;
        asm volatile("" : "+s"(a), "+s"(b), "+s"(c), "+s"(x1), "+s"(x2), "+s"(x3), "+s"(nN), "+s"(ldc), "+s"(aux));
        d[0] = (int)(unsigned)a; d[1] = (int)(unsigned)(a >> 32); d[2] = (int)(unsigned)b; d[3] = (int)(unsigned)(b >> 32); d[4] = (int)(unsigned)c; d[5] = (int)(unsigned)(c >> 32); d[6] = nN; d[7] = ldc; d[8] = aux;
        d[10] = (int)(unsigned)x1; d[11] = (int)(unsigned)(x1 >> 32); d[12] = (int)(unsigned)x2; d[13] = (int)(unsigned)(x2 >> 32); d[14] = (int)(unsigned)x3; d[15] = (int)(unsigned)(x3 >> 32); }
}
__device__ __forceinline__ int desc_i(LAS unsigned char* lds, int g, int f) { return __builtin_amdgcn_readfirstlane(((LAS const int*)(lds + LDS_DESC))[g * 16 + f]); }
__device__ __forceinline__ const char* desc_p(LAS unsigned char* lds, int g, int f) {
    const unsigned lo = (unsigned)desc_i(lds, g, f), hi = (unsigned)desc_i(lds, g, f + 1); return (const char*)(((unsigned long long)hi << 32) | lo); }
template <int LDA, int LDB>
struct SchedMulti {
    LAS unsigned char* lds; int nM, ntot, ng;
    __device__ __forceinline__ bool next(int i, Unit& u) const {
        const int nwg = nM * ntot; const long L = (long)i * gridDim.x + blockIdx.x; if (L >= nwg) return false;
        const int wgid = pg8::xcd_remap((int)L, nwg);
        const int nig = pg8::WGM * ntot, gid = wgid / nig, fm = gid * pg8::WGM, gsz = (nM - fm) < pg8::WGM ? (nM - fm) : pg8::WGM;
        u.pm = fm + ((wgid % nig) % gsz); int pv = (wgid % nig) / gsz; int g = 0;
        for (int j = 0; j + 1 < ng; ++j) { const int n = desc_i(lds, j, 6); if (pv < n) break; pv -= n; g = j + 1; }
        u.pn = pv; u.aux = g; return true;
    }
    __device__ __forceinline__ const char* aptr(const Unit& u) const { return desc_p(lds, u.aux, 0) + (size_t)u.pm * (512 * LDA); }
    __device__ __forceinline__ const char* bptr(const Unit& u) const { return desc_p(lds, u.aux, 2) + (size_t)u.pn * (512 * LDB); }
};
template <int LDA, int LDB, bool GATHERED>
struct SchedMoE {
    LAS unsigned char* lds; const char* Abase; const char* Bbase; const int* list;
    __device__ __forceinline__ bool next(int i, Unit& u) const {
        LAS const int* tab = (LAS const int*)(lds + LDS_TAB);
        const int nrt = __builtin_amdgcn_readfirstlane(tab[2 * MAXRT + 32]);
        const int nwg = nrt * 4; const long L = (long)i * gridDim.x + blockIdx.x; if (L >= nwg) return false;
        const int wgid = pg8::xcd_remap((int)L, nwg);
        u.pm = wgid >> 2; u.pn = wgid & 3; u.aux = __builtin_amdgcn_readfirstlane(tab[u.pm]); return true;
    }
    __device__ __forceinline__ const char* aptr(const Unit& u) const { return GATHERED ? Abase : Abase + (size_t)u.pm * (512 * LDA); }
    __device__ __forceinline__ const char* bptr(const Unit& u) const { return Bbase + (size_t)u.aux * ((size_t)D * LDB * 2) + (size_t)u.pn * (512 * LDB); }
    __device__ __forceinline__ void gather(const Unit& u, int tid, unsigned (&g)[2][2]) const {
        LAS const int* tab = (LAS const int*)(lds + LDS_TAB);
        const int j0 = __builtin_amdgcn_readfirstlane(tab[MAXRT + u.pm]), cn = __builtin_amdgcn_readfirstlane(tab[2 * MAXRT + u.aux]);
#pragma unroll
        for (int i = 0; i < 2; ++i) { int R, C; pg8::stage_rc(tid * 16 + i * 8192, R, C);
#pragma unroll
            for (int h = 0; h < 2; ++h) { const int slot = j0 + 128 * h + R; const int a = slot < cn ? list[(size_t)u.aux * LISTCAP + slot] : 0;
                g[h][i] = (unsigned)((a >> 1) * LDA + C) * 2u; } }
    }
};
__device__ __forceinline__ void moe_tables(LAS unsigned char* lds, int tid, const unsigned* cnt) {
    LAS int* tab = (LAS int*)(lds + LDS_TAB);
    __syncthreads();
    if (tid == 0) {
        int rt = 0;
#pragma nounroll
        for (int e = 0; e < NE; ++e) { const int c = (int)__hip_atomic_load(cnt + e, __ATOMIC_RELAXED, __HIP_MEMORY_SCOPE_AGENT); tab[2 * MAXRT + e] = c;
            const int nt = (c + 255) >> 8;
#pragma nounroll
            for (int j = 0; j < nt; ++j) { tab[rt] = e; tab[MAXRT + rt] = j * 256; ++rt; } }
        tab[2 * MAXRT + 32] = rt;
    }
    __syncthreads();
}

#define EPI_FENCE() asm volatile("" ::: "memory")
struct EpiGelu {
    static constexpr bool PERM = true;
    LAS unsigned char* lds;
    __device__ __forceinline__ void operator()(const f32x4 (&acc)[2][2][4][2], const Unit& u, int wr, int wc, int fr, int fq) const {
        const bool isv = u.pn >= 8; bf16_t* base = (bf16_t*)desc_p(lds, 0, isv ? 10 : 4); const float* bias = (const float*)desc_p(lds, 0, 12); float* stat = (float*)desc_p(lds, 0, 14);
        const int col0 = (u.pn & 7) * 256 + wc * 32 + 8 * fq, bcol0 = u.pn * 256 + wc * 32 + 8 * fq, row0 = u.pm * 256 + wr * 64 + fr;
        f32x4 bv[2][2];
#pragma unroll
        for (int bj = 0; bj < 2; ++bj)
#pragma unroll
            for (int n = 0; n < 2; ++n) bv[bj][n] = *(const f32x4*)(bias + bcol0 + bj * 128 + 4 * n);
#pragma unroll
        for (int ai = 0; ai < 2; ++ai)
#pragma unroll
            for (int m = 0; m < 4; ++m) { const int row = row0 + ai * 128 + m * 16; bf16_t* rowp = base + (size_t)row * GWID + col0; float s = 0.f, q = 0.f;
#pragma unroll
                for (int bj = 0; bj < 2; ++bj) { const f32x4 v0 = acc[ai][bj][m][0] + bv[bj][0], v1 = acc[ai][bj][m][1] + bv[bj][1];
                    const f32x2 a = gelu_pk((f32x2){v0[0], v0[1]}), b = gelu_pk((f32x2){v0[2], v0[3]}), c = gelu_pk((f32x2){v1[0], v1[1]}), d = gelu_pk((f32x2){v1[2], v1[3]});
                    s += ((a.x + a.y) + (b.x + b.y)) + ((c.x + c.y) + (d.x + d.y));
                    q += ((a.x * a.x + a.y * a.y) + (b.x * b.x + b.y * b.y)) + ((c.x * c.x + c.y * c.y) + (d.x * d.x + d.y * d.y));
                    u32x4 w; w.x = cvt_pk_bf16(a.x, a.y); w.y = cvt_pk_bf16(b.x, b.y); w.z = cvt_pk_bf16(c.x, c.y); w.w = cvt_pk_bf16(d.x, d.y);
                    *(u32x4*)(rowp + bj * 128) = w; }
                if (isv) { const int ln_ = 16 * fq + fr; s += shx(s, 16, ln_); s += shx(s, 32, ln_); q += shx(q, 16, ln_); q += shx(q, 32, ln_);
                    if (fq == 0) *(f32x2*)(stat + ((size_t)row * 32 + (u.pn - 8) * 4 + wc) * 2) = (f32x2){s, q}; } }
    }
};
struct EpiResid {
    static constexpr bool PERM = false;
    LAS unsigned char* lds;
    __device__ __forceinline__ void operator()(const f32x4 (&acc)[2][2][4][2], const Unit& u, int wr, int wc, int fr, int fq) const {
        const int mrow = u.pm < 64 ? 0 : (u.pm < 128 ? 1 : 2);
        const float* xin = u.pm < 128 ? (const float*)desc_p(lds, 0, 10) + (size_t)u.pm * 256 * D : (const float*)desc_p(lds, 0, 12) + (size_t)(u.pm - 128) * 256 * D;
        float* xout = (float*)desc_p(lds, 0, 4) + (size_t)u.pm * 256 * D; const float* bias = (const float*)desc_p(lds, 0, 14); const float* gate = (const float*)desc_p(lds, 1, 10);
        const int col0 = u.pn * 256 + wc * 32 + 4 * fq, rl0 = wr * 64 + fr;
#pragma unroll
        for (int bj = 0; bj < 2; ++bj)
#pragma unroll
            for (int n = 0; n < 2; ++n) { const f32x4 bv = bias ? *(const f32x4*)(bias + col0 + bj * 128 + n * 16) : (f32x4){0.f, 0.f, 0.f, 0.f};
                const f32x4 gv = *(const f32x4*)(gate + mrow * 6 * D + col0 + bj * 128 + n * 16);
#pragma unroll
                for (int ai = 0; ai < 2; ++ai) {
#pragma unroll
                    for (int m = 0; m < 4; ++m) { const size_t off = (size_t)(rl0 + ai * 128 + m * 16) * D + col0 + bj * 128 + n * 16;
                        const f32x4 xi = *(const f32x4*)(xin + off); *(f32x4*)(xout + off) = xi + gv * (acc[ai][bj][m][n] + bv); }
                    EPI_FENCE(); } }
    }
};
struct EpiAct {
    static constexpr bool PERM = true;
    LAS unsigned char* lds;
    __device__ __forceinline__ void operator()(const f32x4 (&acc)[2][2][4][2], const Unit& u, int wr, int wc, int fr, int fq) const {
        bf16_t* C = (bf16_t*)desc_p(lds, u.aux, 4); const int ldc = desc_i(lds, u.aux, 7), act = desc_i(lds, u.aux, 8);
        const int col0 = u.pn * 256 + wc * 32 + 8 * fq, row0 = u.pm * 256 + wr * 64 + fr;
#pragma unroll
        for (int ai = 0; ai < 2; ++ai)
#pragma unroll
            for (int m = 0; m < 4; ++m) { bf16_t* rowp = C + (size_t)(row0 + ai * 128 + m * 16) * ldc + col0;
#pragma unroll
                for (int bj = 0; bj < 2; ++bj) { f32x4 v0 = acc[ai][bj][m][0], v1 = acc[ai][bj][m][1];
                    if (act == 1) {
#pragma unroll
                        for (int j = 0; j < 4; ++j) { v0[j] = tanhf_(v0[j]); v1[j] = tanhf_(v1[j]); } }
                    else if (act == 2) {
#pragma unroll
                        for (int j = 0; j < 4; ++j) { v0[j] = sigmoidf_(v0[j]); v1[j] = sigmoidf_(v1[j]); } }
                    u32x4 w; w.x = cvt_pk_bf16(v0[0], v0[1]); w.y = cvt_pk_bf16(v0[2], v0[3]); w.z = cvt_pk_bf16(v1[0], v1[1]); w.w = cvt_pk_bf16(v1[2], v1[3]);
                    *(u32x4*)(rowp + bj * 128) = w; } }
    }
};
struct EpiLogits {
    static constexpr bool PERM = false;
    float* LG;
    __device__ __forceinline__ void operator()(const f32x4 (&acc)[2][2][4][2], const Unit& u, int wr, int wc, int fr, int fq) const {
        if (wc >= 2) return;
        const int col0 = wc * 32 + 4 * fq, row0 = u.pm * 256 + wr * 64 + fr;
#pragma unroll
        for (int ai = 0; ai < 2; ++ai)
#pragma unroll
            for (int m = 0; m < 4; ++m)
#pragma unroll
                for (int n = 0; n < 2; ++n) *(f32x4*)(LG + (size_t)(row0 + ai * 128 + m * 16) * 64 + col0 + n * 16) = acc[ai][0][m][n] + acc[ai][1][m][n];
    }
};
struct EpiSiluGate {
    static constexpr bool PERM = true;
    bf16_t* H;
    __device__ __forceinline__ void operator()(const f32x4 (&acc)[2][2][4][2], const Unit& u, int wr, int wc, int fr, int fq) const {
        const int col0 = u.pn * 128 + wc * 32 + 8 * fq, row0 = u.pm * 256 + wr * 64 + fr;
#pragma unroll
        for (int ai = 0; ai < 2; ++ai)
#pragma unroll
            for (int m = 0; m < 4; ++m) { f32x4 h0, h1;
#pragma unroll
                for (int j = 0; j < 4; ++j) { const float g0 = acc[ai][0][m][0][j], g1 = acc[ai][0][m][1][j]; h0[j] = g0 * sigmoidf_(g0) * acc[ai][1][m][0][j]; h1[j] = g1 * sigmoidf_(g1) * acc[ai][1][m][1][j]; }
                u32x4 w; w.x = cvt_pk_bf16(h0[0], h0[1]); w.y = cvt_pk_bf16(h0[2], h0[3]); w.z = cvt_pk_bf16(h1[0], h1[1]); w.w = cvt_pk_bf16(h1[2], h1[3]);
                *(u32x4*)(H + (size_t)(row0 + ai * 128 + m * 16) * EHID + col0) = w; }
    }
};
struct EpiScatter {
    static constexpr bool PERM = true;
    LAS unsigned char* lds; bf16_t* YB; const int* list;
    __device__ __forceinline__ void operator()(const f32x4 (&acc)[2][2][4][2], const Unit& u, int wr, int wc, int fr, int fq) const {
        LAS const int* tab = (LAS const int*)(lds + LDS_TAB);
        const int j0 = __builtin_amdgcn_readfirstlane(tab[MAXRT + u.pm]), cn = __builtin_amdgcn_readfirstlane(tab[2 * MAXRT + u.aux]);
        const int col0 = u.pn * 256 + wc * 32 + 8 * fq;
#pragma unroll
        for (int ai = 0; ai < 2; ++ai)
#pragma unroll
            for (int m = 0; m < 4; ++m) { const int slot = j0 + ai * 128 + wr * 64 + m * 16 + fr;
                if (slot < cn) { const int a = list[(size_t)u.aux * LISTCAP + slot]; bf16_t* rowp = YB + (size_t)a * D + col0;
#pragma unroll
                    for (int bj = 0; bj < 2; ++bj) { const f32x4 v0 = acc[ai][bj][m][0], v1 = acc[ai][bj][m][1];
                        u32x4 w; w.x = cvt_pk_bf16(v0[0], v0[1]); w.y = cvt_pk_bf16(v0[2], v0[3]); w.z = cvt_pk_bf16(v1[0], v1[1]); w.w = cvt_pk_bf16(v1[2], v1[3]);
                        *(u32x4*)(rowp + bj * 128) = w; } } }
    }
};

struct Params { const float* in[42]; float* out; unsigned char* ws; int ph_lo, ph_hi; };
enum { I_X = 0, I_C, I_CTX, I_CCTX, I_ADAW, I_ADAB, I_N1G, I_N2G, I_FG, I_GWIN, I_GBIN, I_GLNG, I_GLNB, I_GWS, I_GBS, I_GWOUT, I_GBOUT,
       I_MU, I_WR, I_WK, I_WV, I_WO, I_W0, I_W1, I_W2, I_A0, I_A1, I_A2, I_G1, I_G2, I_KK, I_KA, I_RK, I_LNG, I_LNB,
       I_MWGRP, I_MBGRP, I_MWEXP, I_MBEXP, I_MWG, I_MWU, I_MWD };
struct Frame { LAS unsigned char* lds; int tid, lane, wave, G, gw, NGW; };
typedef const __attribute__((address_space(4))) Params* KP;

constexpr int TRP = 36, TR_SCR = 64 * TRP * 4;
__device__ __forceinline__ void tr_item(const float* W, int N, int kmax, bf16_t* WT, int ldk, int k0, int n0, int drow0, int dk0, LAS float* scr, int lane) {
    const int n4 = lane & 7, kr = lane >> 3; f32x4 v[8];
#pragma unroll
    for (int i = 0; i < 8; ++i) { const int k = k0 + 8 * i + kr; v[i] = k < kmax ? *(const f32x4*)(W + (size_t)k * N + n0 + 4 * n4) : (f32x4){0.f, 0.f, 0.f, 0.f}; }
#pragma unroll
    for (int i = 0; i < 8; ++i) *(LAS f32x4*)(scr + (8 * i + kr) * TRP + 4 * n4) = v[i];
    asm volatile("s_waitcnt lgkmcnt(0)" ::: "memory");
    const int c = lane & 7;
#pragma unroll
    for (int j = 0; j < 4; ++j) { const int n = (lane >> 3) + 8 * j; const LAS float* sp = scr + (8 * c) * TRP + n;
        u32x4 o; o.x = cvt_pk_bf16(sp[0 * TRP], sp[1 * TRP]); o.y = cvt_pk_bf16(sp[2 * TRP], sp[3 * TRP]); o.z = cvt_pk_bf16(sp[4 * TRP], sp[5 * TRP]); o.w = cvt_pk_bf16(sp[6 * TRP], sp[7 * TRP]);
        *(u32x4*)(WT + (size_t)(drow0 + n) * ldk + dk0 + k0 + 8 * c) = o; }
    asm volatile("s_waitcnt lgkmcnt(0)" ::: "memory");
}
constexpr int LDS_JOBS = 80 * 1024, MAXJOBS = 48;
__device__ __forceinline__ void add_job(LAS int* jobs, int& nj, int& nit, const float* src, int N, int kmax, int kpad, bf16_t* dst, int ldk, int drow0, int dk0) {
    LAS int* q = jobs + nj * 12; const unsigned long long a = (unsigned long long)src, d = (unsigned long long)dst;
    q[0] = (int)(unsigned)a; q[1] = (int)(unsigned)(a >> 32); q[2] = (int)(unsigned)d; q[3] = (int)(unsigned)(d >> 32); q[4] = N; q[5] = kmax; q[6] = kpad / 64; q[7] = ldk; q[8] = drow0; q[9] = dk0; q[10] = nit;
    nit += (kpad / 64) * (N / 32); ++nj;
}
__device__ __forceinline__ void zero_fill(const Frame& F, bf16_t* p, size_t nbytes) {
    u32x4* q = (u32x4*)p; const size_t n = nbytes / 16;
    for (size_t i = (size_t)blockIdx.x * NTHR + F.tid; i < n; i += (size_t)F.G * NTHR) q[i] = (u32x4){0u, 0u, 0u, 0u};
}

__device__ __forceinline__ void prologue_phase(const Frame& F, KP P) {
    unsigned char* ws = P->ws;
    {   float* MOD = (float*)(ws + WS_MOD); LAS float* part = (LAS float*)F.lds;
        const float* c = P->in[I_C]; const float* cc = P->in[I_CCTX];
        for (int item = blockIdx.x; item < DEPTH * 24; item += F.G) {
            const int layer = item / 24, col = (item % 24) * 256 + 4 * F.lane; const float* w = P->in[I_ADAW] + (size_t)layer * D * 6 * D + col;
            f32x4 a0 = (f32x4){0.f, 0.f, 0.f, 0.f}, a1 = a0, a2 = a0;
#pragma unroll 8
            for (int i = 0; i < 128; ++i) { const int d = F.wave + 8 * i; const f32x4 wv = *(const f32x4*)(w + (size_t)d * 6 * D);
                const float c0 = c[d], c1 = c[D + d], c2 = cc[d];
                a0 += wv * (c0 * sigmoidf_(c0)); a1 += wv * (c1 * sigmoidf_(c1)); a2 += wv * (c2 * sigmoidf_(c2)); }
            __syncthreads();
            *(LAS f32x4*)(part + (F.wave * 3 + 0) * 256 + 4 * F.lane) = a0; *(LAS f32x4*)(part + (F.wave * 3 + 1) * 256 + 4 * F.lane) = a1; *(LAS f32x4*)(part + (F.wave * 3 + 2) * 256 + 4 * F.lane) = a2;
            __syncthreads();
            if (F.wave < 3) { f32x4 sacc = (f32x4){0.f, 0.f, 0.f, 0.f};
#pragma unroll
                for (int w8 = 0; w8 < 8; ++w8) sacc += *(const LAS f32x4*)(part + (w8 * 3 + F.wave) * 256 + 4 * F.lane);
                *(f32x4*)(MOD + ((size_t)layer * 3 + F.wave) * 6 * D + col) = sacc + *(const f32x4*)(P->in[I_ADAB] + (size_t)layer * 6 * D + col); }
        }
    }
    LAS int* jobs = (LAS int*)(F.lds + LDS_JOBS); LAS int* jtot = jobs + MAXJOBS * 12;
    __syncthreads();
    if (F.tid == 0) { int nj = 0, nit = 0;
        for (int j = 0; j < 2; ++j) {
            add_job(jobs, nj, nit, P->in[I_GWIN] + (size_t)j * D * 4096, 4096, D, D, (bf16_t*)(ws + WS_WIN) + (size_t)j * 4096 * D, D, 0, 0);
            add_job(jobs, nj, nit, P->in[I_GWOUT] + (size_t)j * GWID * D, D, GWID, GWID, (bf16_t*)(ws + WS_WOUT) + (size_t)j * D * GWID, GWID, 0, 0);
            add_job(jobs, nj, nit, P->in[I_WR] + (size_t)j * D * D, D, D, D, (bf16_t*)(ws + WS_WR) + (size_t)j * D * D, D, 0, 0);
            add_job(jobs, nj, nit, P->in[I_WK] + (size_t)j * D * D, D, D, D, (bf16_t*)(ws + WS_WK) + (size_t)j * D * D, D, 0, 0);
            add_job(jobs, nj, nit, P->in[I_WV] + (size_t)j * D * D, D, D, D, (bf16_t*)(ws + WS_WV) + (size_t)j * D * D, D, 0, 0);
            add_job(jobs, nj, nit, P->in[I_WO] + (size_t)j * D * D, D, D, D, (bf16_t*)(ws + WS_WO) + (size_t)j * D * D, D, 0, 0);
            for (int z = 0; z < 2; ++z) {
                add_job(jobs, nj, nit, P->in[I_W1] + ((size_t)j * 2 + z) * D * 64, 64, D, D, (bf16_t*)(ws + WS_LW1) + (size_t)j * 256 * D, D, z * 64, 0);
                add_job(jobs, nj, nit, P->in[I_A1] + ((size_t)j * 2 + z) * D * 64, 64, D, D, (bf16_t*)(ws + WS_LA1) + (size_t)j * 256 * D, D, z * 64, 0);
                add_job(jobs, nj, nit, P->in[I_W2] + ((size_t)j * 2 + z) * 64 * D, D, 64, 64, (bf16_t*)(ws + WS_W2P) + ((size_t)j * 2 + z) * D * 256, 256, 0, z * 64);
                add_job(jobs, nj, nit, P->in[I_A2] + ((size_t)j * 2 + z) * 64 * D, D, 64, 64, (bf16_t*)(ws + WS_A2P) + ((size_t)j * 2 + z) * D * 256, 256, 0, z * 64); }
            add_job(jobs, nj, nit, P->in[I_G1] + (size_t)j * D * 160, 160, D, D, (bf16_t*)(ws + WS_LG1) + (size_t)j * 256 * D, D, 0, 0);
            add_job(jobs, nj, nit, P->in[I_G2] + (size_t)j * 160 * D, D, 160, 256, (bf16_t*)(ws + WS_G2P) + (size_t)j * D * 256, 256, 0, 0); }
        jtot[0] = nj; jtot[1] = nit; }
    __syncthreads();
    {   const int nj = jtot[0], nit = jtot[1]; LAS float* scr = (LAS float*)(F.lds + F.wave * TR_SCR);
        for (int it = F.gw; it < nit; it += F.NGW) {
            int jb = 0; for (int q = 1; q < nj; ++q) if (it >= jobs[q * 12 + 10]) jb = q;
            jb = __builtin_amdgcn_readfirstlane(jb); LAS const int* q = jobs + jb * 12;
            const float* src = (const float*)(((unsigned long long)(unsigned)q[1] << 32) | (unsigned)q[0]); bf16_t* dst = (bf16_t*)(((unsigned long long)(unsigned)q[3] << 32) | (unsigned)q[2]);
            const int N = q[4], nnb = N / 32, r = it - q[10], kb = r / nnb, nb = r % nnb;
            tr_item(src, N, q[5], dst, q[7], kb * 64, nb * 32, q[8] + nb * 32, q[9], scr, F.lane); }
    }
    for (int j = 0; j < 2; ++j) {
        bf16_t* lw1 = (bf16_t*)(ws + WS_LW1) + (size_t)j * 256 * D; bf16_t* la1 = (bf16_t*)(ws + WS_LA1) + (size_t)j * 256 * D; bf16_t* lg1 = (bf16_t*)(ws + WS_LG1) + (size_t)j * 256 * D;
        zero_fill(F, lw1 + 128 * D, (size_t)128 * D * 2); zero_fill(F, la1 + 128 * D, (size_t)128 * D * 2); zero_fill(F, lg1 + 160 * D, (size_t)96 * D * 2);
        for (int z = 0; z < 2; ++z) { bf16_t* w2p = (bf16_t*)(ws + WS_W2P) + ((size_t)j * 2 + z) * D * 256; bf16_t* a2p = (bf16_t*)(ws + WS_A2P) + ((size_t)j * 2 + z) * D * 256;
            for (int idx = blockIdx.x * NTHR + F.tid; idx < D * 32; idx += F.G * NTHR) { const int n = idx >> 5, ch = idx & 31;
                if ((ch >> 3) != z) { *(u32x4*)(w2p + (size_t)n * 256 + ch * 8) = (u32x4){0u, 0u, 0u, 0u}; *(u32x4*)(a2p + (size_t)n * 256 + ch * 8) = (u32x4){0u, 0u, 0u, 0u}; } } }
    }
    {   bf16_t* wrt = (bf16_t*)(ws + WS_WRT);
        for (int idx = blockIdx.x * NTHR + F.tid; idx < DEPTH * 256 * (D / 8); idx += F.G * NTHR) { const int k0 = (idx & 127) * 8, n = (idx >> 7) & 255, layer = idx >> 15;
            const int nn = n & 127; const bool lo = n >= 128; float w[8];
#pragma unroll
            for (int e = 0; e < 8; ++e) { float x = 0.f;
                if (nn < 4) x = P->in[I_MWGRP][((size_t)layer * D + k0 + e) * 4 + nn]; else if (nn < 36) x = P->in[I_MWEXP][((size_t)layer * D + k0 + e) * NE + nn - 4];
                const float hi = bf_lo(cvt_pk_bf16(x, 0.f)); w[e] = lo ? x - hi : x; }
            *(u32x4*)(wrt + ((size_t)layer * 256 + n) * D + k0) = pack8(w); } }
    {   const float* src = P->in[I_GWS]; bf16_t* dst = (bf16_t*)(ws + WS_WSP); const int n8 = 2 * 16 * 128 * 128 / 8;
        for (int i = blockIdx.x * NTHR + F.tid; i < n8; i += F.G * NTHR) { const f32x4 a = *(const f32x4*)(src + (size_t)i * 8), b = *(const f32x4*)(src + (size_t)i * 8 + 4);
            u32x4 o; o.x = cvt_pk_bf16(a[0], a[1]); o.y = cvt_pk_bf16(a[2], a[3]); o.z = cvt_pk_bf16(b[0], b[1]); o.w = cvt_pk_bf16(b[2], b[3]); *(u32x4*)(dst + (size_t)i * 8) = o; } }
}
__device__ __forceinline__ void moe_weights_phase(const Frame& F, KP P, int layer) {
    unsigned char* ws = P->ws; LAS float* scr = (LAS float*)(F.lds + F.wave * TR_SCR);
    for (int it = F.gw; it < NE * 768; it += F.NGW) {
        const int e = it / 768, r = it % 768, m = r >> 8, q = r & 255;
        const size_t so = ((size_t)layer * NE + e) * (size_t)D * EHID;
        if (m < 2) { const int kb = q >> 4, n0 = (q & 15) * 32;
            tr_item((m == 0 ? P->in[I_MWG] : P->in[I_MWU]) + so, EHID, D, (bf16_t*)(ws + WS_WGU) + (size_t)e * D * D, D, kb * 64, n0, 256 * (n0 >> 7) + (n0 & 127) + (m == 1 ? 128 : 0), 0, scr, F.lane); }
        else { const int kb = q >> 5, n0 = (q & 31) * 32;
            tr_item(P->in[I_MWD] + so, D, EHID, (bf16_t*)(ws + WS_WD) + (size_t)e * D * EHID, EHID, kb * 64, n0, n0, 0, scr, F.lane); }
    }
}

__device__ __forceinline__ const float* xrow_ptr(KP P, int layer, int row) {
    if (layer == 0) return row < TL ? P->in[I_X] + (size_t)row * D : P->in[I_CTX] + (size_t)(row - TL) * D;
    return (const float*)(P->ws + WS_X) + (size_t)row * D;
}
__device__ __forceinline__ void load_combine(KP P, const Frame& F, int layer, int row, int m, bool combine, f32x4 (&v)[4]) {
    const float* xr = xrow_ptr(P, layer, row);
#pragma unroll
    for (int j = 0; j < 4; ++j) v[j] = *(const f32x4*)(xr + 4 * F.lane + 256 * j);
    if (combine) {
        const bf16_t* yb = (const bf16_t*)(P->ws + WS_YB); const float* wg = (const float*)(P->ws + WS_WGT);
        const float w0 = wg[2 * row], w1 = wg[2 * row + 1]; const float* g2 = (const float*)(P->ws + WS_MOD) + ((size_t)(layer - 1) * 3 + m) * 6 * D + 5 * D;
#pragma unroll
        for (int j = 0; j < 4; ++j) { const int col = 4 * F.lane + 256 * j; const u32x2 a = *(const u32x2*)(yb + (size_t)(2 * row) * D + col), b = *(const u32x2*)(yb + (size_t)(2 * row + 1) * D + col);
            const f32x4 g = *(const f32x4*)(g2 + col);
            v[j][0] += g[0] * (w0 * bf_lo(a.x) + w1 * bf_lo(b.x)); v[j][1] += g[1] * (w0 * bf_hi(a.x) + w1 * bf_hi(b.x));
            v[j][2] += g[2] * (w0 * bf_lo(a.y) + w1 * bf_lo(b.y)); v[j][3] += g[3] * (w0 * bf_hi(a.y) + w1 * bf_hi(b.y)); }
    }
}
__device__ __forceinline__ void norm1_phase(const Frame& F, KP P, int layer) {
    const bool combine = layer > 0; float* X = (float*)(P->ws + WS_X); bf16_t* HL = (bf16_t*)(P->ws + WS_HL);
    const float* g1 = P->in[I_N1G] + (size_t)layer * D;
    for (int row = F.gw; row < T; row += F.NGW) {
        const int m = row < TL ? (row >> 14) : 2; f32x4 v[4];
        load_combine(P, F, layer, row, m, combine, v);
        if (combine) {
#pragma unroll
            for (int j = 0; j < 4; ++j) *(f32x4*)(X + (size_t)row * D + 4 * F.lane + 256 * j) = v[j]; }
        float ss = 0.f;
#pragma unroll
        for (int j = 0; j < 4; ++j) ss += (v[j][0] * v[j][0] + v[j][1] * v[j][1]) + (v[j][2] * v[j][2] + v[j][3] * v[j][3]);
        const float rstd = rsqrtf(wave_sum(ss, F.lane) * (1.0f / D) + 1e-6f);
        const float* mod = (const float*)(P->ws + WS_MOD) + ((size_t)layer * 3 + m) * 6 * D;
#pragma unroll
        for (int j = 0; j < 4; ++j) { const int col = 4 * F.lane + 256 * j; const f32x4 g = *(const f32x4*)(g1 + col), sh = *(const f32x4*)(mod + col), sc = *(const f32x4*)(mod + D + col);
            const f32x4 h = (v[j] * rstd) * g * (sc + 1.0f) + sh;
            u32x2 o; o.x = cvt_pk_bf16(h[0], h[1]); o.y = cvt_pk_bf16(h[2], h[3]); *(u32x2*)(HL + (size_t)row * D + col) = o; }
    }
}
__device__ __forceinline__ void final_phase(const Frame& F, KP P) {
    const float* fg = P->in[I_FG];
    for (int row = F.gw; row < TL; row += F.NGW) {
        const int m = row >> 14; f32x4 v[4];
        load_combine(P, F, DEPTH, row, m, true, v);
        float ss = 0.f;
#pragma unroll
        for (int j = 0; j < 4; ++j) ss += (v[j][0] * v[j][0] + v[j][1] * v[j][1]) + (v[j][2] * v[j][2] + v[j][3] * v[j][3]);
        const float rstd = rsqrtf(wave_sum(ss, F.lane) * (1.0f / D) + 1e-6f);
#pragma unroll
        for (int j = 0; j < 4; ++j) { const int col = 4 * F.lane + 256 * j; *(f32x4*)(P->out + (size_t)row * D + col) = (v[j] * rstd) * *(const f32x4*)(fg + col); }
    }
}
__device__ __forceinline__ void norm2_phase(const Frame& F, KP P, int layer) {
    const int ntok = layer == DEPTH - 1 ? TL : T; bf16_t* HL2 = (bf16_t*)(P->ws + WS_HL); const float* g2n = P->in[I_N2G] + (size_t)layer * D;
    for (int row = F.gw; row < ntok; row += F.NGW) {
        const int m = row < TL ? (row >> 14) : 2; const float* xr = xrow_ptr(P, 1, row); f32x4 v[4];
#pragma unroll
        for (int j = 0; j < 4; ++j) v[j] = *(const f32x4*)(xr + 4 * F.lane + 256 * j);
        float ss = 0.f;
#pragma unroll
        for (int j = 0; j < 4; ++j) ss += (v[j][0] * v[j][0] + v[j][1] * v[j][1]) + (v[j][2] * v[j][2] + v[j][3] * v[j][3]);
        const float rstd = rsqrtf(wave_sum(ss, F.lane) * (1.0f / D) + 1e-6f);
        const float* mod = (const float*)(P->ws + WS_MOD) + ((size_t)layer * 3 + m) * 6 * D;
#pragma unroll
        for (int j = 0; j < 4; ++j) { const int col = 4 * F.lane + 256 * j; const f32x4 g = *(const f32x4*)(g2n + col), sh = *(const f32x4*)(mod + 3 * D + col), sc = *(const f32x4*)(mod + 4 * D + col);
            const f32x4 h = (v[j] * rstd) * g * (sc + 1.0f) + sh;
            u32x2 o; o.x = cvt_pk_bf16(h[0], h[1]); o.y = cvt_pk_bf16(h[2], h[3]); *(u32x2*)(HL2 + (size_t)row * D + col) = o; }
    }
    moe_weights_phase(F, P, layer);
}
__device__ __forceinline__ void route_phase(const Frame& F, KP P, int layer) {
    const int ntok = layer == DEPTH - 1 ? TL : T; const float* LG = (const float*)(P->ws + WS_LG);
    const float* bgrp = P->in[I_MBGRP] + layer * 4; const float* bexp = P->in[I_MBEXP] + layer * NE;
    unsigned* cnt = (unsigned*)(P->ws + WS_CTL) + CW_CNT + layer * 64; int* list = (int*)(P->ws + WS_LIST); float* wgt = (float*)(P->ws + WS_WGT);
    LAS unsigned* lcnt = (LAS unsigned*)F.lds; LAS unsigned* lbase = lcnt + 32;
    for (int r0 = blockIdx.x * NTHR; r0 < ntok; r0 += F.G * NTHR) {
        const int row = r0 + F.tid; const bool act = row < ntok;
        __syncthreads();
        if (F.tid < 32) lcnt[F.tid] = 0u;
        __syncthreads();
        int e0 = 0, e1 = 0; unsigned k0 = 0, k1 = 0;
        if (act) {
            const float* lg = LG + (size_t)row * 64; const f32x4 g4 = *(const f32x4*)lg;
            float ag[4];
#pragma unroll
            for (int i = 0; i < 4; ++i) ag[i] = g4[i] + bgrp[i];
            int grp = 0; float mx = ag[0];
#pragma unroll
            for (int i = 1; i < 4; ++i) if (ag[i] > mx) { mx = ag[i]; grp = i; }
            float den = 0.f;
#pragma unroll
            for (int i = 0; i < 4; ++i) den += __expf(ag[i] - mx);
            const float pg = 1.0f / den;
            const f32x4 e0v = *(const f32x4*)(lg + 4 + 8 * grp), e1v = *(const f32x4*)(lg + 8 + 8 * grp); const f32x4 b0v = *(const f32x4*)(bexp + 8 * grp), b1v = *(const f32x4*)(bexp + 8 * grp + 4);
            float el[8];
#pragma unroll
            for (int i = 0; i < 4; ++i) { el[i] = e0v[i] + b0v[i]; el[4 + i] = e1v[i] + b1v[i]; }
            int i0 = 0; float t0 = el[0];
#pragma unroll
            for (int i = 1; i < 8; ++i) if (el[i] > t0) { t0 = el[i]; i0 = i; }
            int i1 = -1; float t1 = -3.0e38f;
#pragma unroll
            for (int i = 0; i < 8; ++i) if (i != i0 && el[i] > t1) { t1 = el[i]; i1 = i; }
            const float p0 = 1.0f / (1.0f + __expf(t1 - t0));
            wgt[2 * row] = pg * p0; wgt[2 * row + 1] = pg * (1.0f - p0);
            e0 = grp * 8 + i0; e1 = grp * 8 + i1;
            k0 = atomicAdd((unsigned*)(lcnt + e0), 1u); k1 = atomicAdd((unsigned*)(lcnt + e1), 1u);
        }
        __syncthreads();
        if (F.tid < 32) { const unsigned c = lcnt[F.tid]; lbase[F.tid] = c ? atomicAdd(cnt + F.tid, c) : 0u; }
        __syncthreads();
        if (act) { list[(size_t)e0 * LISTCAP + lbase[e0] + k0] = 2 * row; list[(size_t)e1 * LISTCAP + lbase[e1] + k1] = 2 * row + 1; }
    }
}
__device__ __forceinline__ bf16x8 tr_frag136(const LAS bf16_t* M, int k0, int c0, int lane) {
    LAS bf16_t* p = (LAS bf16_t*)M + (k0 + 8 * (lane >> 4) + ((lane & 15) >> 2)) * 136 + c0 + 4 * (lane & 3);
    const v4s lo = __builtin_amdgcn_ds_read_tr16_b64_v4i16((LAS v4s*)p), hi = __builtin_amdgcn_ds_read_tr16_b64_v4i16((LAS v4s*)(p + 4 * 136));
    return (bf16x8){lo[0], lo[1], lo[2], lo[3], hi[0], hi[1], hi[2], hi[3]};
}
__device__ __forceinline__ void spatial_phase(const Frame& F, KP P, int j) {
    bf16_t* U = (bf16_t*)(P->ws + WS_U); const bf16_t* V = (const bf16_t*)(P->ws + WS_V); const float* stat = (const float*)(P->ws + WS_STAT);
    const bf16_t* WSP = (const bf16_t*)(P->ws + WS_WSP) + (size_t)j * 16 * 128 * 128;
    const float* lng = P->in[I_GLNG] + (size_t)j * GWID; const float* lnb = P->in[I_GLNB] + (size_t)j * GWID; const float* bs = P->in[I_GBS] + (size_t)j * 16 * 128;
    LAS bf16_t* Wt = (LAS bf16_t*)F.lds; LAS bf16_t* Vn = Wt + 128 * 136;
    LAS float* mu = (LAS float*)(F.lds + 2 * 128 * 136 * 2); LAS float* rs = mu + 128;
    const int l15 = F.lane & 15, l4 = F.lane >> 4;
    for (int item = blockIdx.x; item < (T / 128) * 4; item += F.G) {
        const int c = item >> 2, gq = item & 3, t0 = c * 128;
        LDS_BARRIER();
        if (F.tid < 128) { const int row = t0 + F.tid; float s = 0.f, q = 0.f;
#pragma unroll 8
            for (int i = 0; i < 32; ++i) { const f32x2 p = *(const f32x2*)(stat + ((size_t)row * 32 + i) * 2); s += p.x; q += p.y; }
            const float mean = s * (1.0f / GWID), var = q * (1.0f / GWID) - mean * mean; mu[F.tid] = mean; rs[F.tid] = rsqrtf(var + 1e-5f); }
#pragma nounroll
        for (int gi = 0; gi < 4; ++gi) { const int g = gq * 4 + gi;
            u32x4 wv[4], vv[4];
#pragma unroll
            for (int i = 0; i < 4; ++i) { const int idx = F.tid + NTHR * i, r = idx >> 4, seg = idx & 15;
                wv[i] = *(const u32x4*)(WSP + ((size_t)g * 128 + r) * 128 + seg * 8); vv[i] = *(const u32x4*)(V + (size_t)(t0 + r) * GWID + g * 128 + seg * 8); }
            LDS_BARRIER();
#pragma unroll
            for (int i = 0; i < 4; ++i) { const int idx = F.tid + NTHR * i, r = idx >> 4, seg = idx & 15, ch = g * 128 + seg * 8;
                *(LAS u32x4*)(Wt + r * 136 + seg * 8) = wv[i];
                float x[8], o[8]; unpack8(vv[i], x); const float m_ = mu[r], r_ = rs[r];
                const f32x4 g0 = *(const f32x4*)(lng + ch), g1 = *(const f32x4*)(lng + ch + 4), b0 = *(const f32x4*)(lnb + ch), b1 = *(const f32x4*)(lnb + ch + 4);
#pragma unroll
                for (int e = 0; e < 8; ++e) o[e] = (x[e] - m_) * r_ * (e < 4 ? g0[e & 3] : g1[e & 3]) + (e < 4 ? b0[e & 3] : b1[e & 3]);
                *(LAS u32x4*)(Vn + r * 136 + seg * 8) = pack8(o); }
            LDS_BARRIER();
            bf16x8 bw[4];
#pragma unroll
            for (int ks = 0; ks < 4; ++ks) bw[ks] = *(const LAS bf16x8*)(Wt + (16 * F.wave + l15) * 136 + ks * 32 + 8 * l4);
            const int p = 16 * F.wave + l15; const float bias = bs[g * 128 + p];
            bf16_t* urow = U + (size_t)(t0 + p) * GWID + g * 128 + 4 * l4;
            u32x2 uu[8];
#pragma unroll
            for (int dt = 0; dt < 8; ++dt) uu[dt] = *(const u32x2*)(urow + dt * 16);
#pragma unroll
            for (int dt = 0; dt < 8; ++dt) { f32x4 acc = (f32x4){0.f, 0.f, 0.f, 0.f};
#pragma unroll
                for (int ks = 0; ks < 4; ++ks) { const bf16x8 a = tr_frag136(Vn, 32 * ks, 16 * dt, F.lane); acc = __builtin_amdgcn_mfma_f32_16x16x32_bf16(a, bw[ks], acc, 0, 0, 0); }
                u32x2 o; o.x = cvt_pk_bf16(bf_lo(uu[dt].x) * (acc[0] + bias), bf_hi(uu[dt].x) * (acc[1] + bias)); o.y = cvt_pk_bf16(bf_lo(uu[dt].y) * (acc[2] + bias), bf_hi(uu[dt].y) * (acc[3] + bias));
                *(u32x2*)(urow + dt * 16) = o; }
        }
    }
}

__device__ __forceinline__ void mix_phase(const Frame& F, KP P, int j) {
    const bf16_t* HL = (const bf16_t*)(P->ws + WS_HL); const float* mu = P->in[I_MU] + (size_t)j * 6 * D;
    bf16_t* outs[6] = {(bf16_t*)(P->ws + WS_XR), (bf16_t*)(P->ws + WS_XW), (bf16_t*)(P->ws + WS_XK), (bf16_t*)(P->ws + WS_XV), (bf16_t*)(P->ws + WS_XA), (bf16_t*)(P->ws + WS_XG)};
    for (int row = F.gw; row < T; row += F.NGW) {
        bool ok[2]; int src[2]; const bool hi = F.lane >= 32;
        if (row < TL) { const int n = row & (SEQ - 1), gc = n & 63, gr = n >> 6;
            ok[0] = hi ? gc < 63 : gc > 0; src[0] = hi ? row + 1 : row - 1; ok[1] = hi ? gr < 255 : gr > 0; src[1] = hi ? row + 64 : row - 64; }
        else { const int n = (row - TL) & (CTXL - 1); ok[0] = n > 0; src[0] = row - 1; ok[1] = n < CTXL - 1; src[1] = row + 1; }
#pragma unroll
        for (int jj = 0; jj < 2; ++jj) { const int col = 512 * jj + 8 * F.lane;
            const u32x4 h8 = *(const u32x4*)(HL + (size_t)row * D + col); u32x4 s8 = (u32x4){0u, 0u, 0u, 0u};
            if (ok[jj]) s8 = *(const u32x4*)(HL + (size_t)src[jj] * D + col);
            const unsigned hw[4] = {h8.x, h8.y, h8.z, h8.w}, sw[4] = {s8.x, s8.y, s8.z, s8.w}; float h[8], xx[8];
#pragma unroll
            for (int e = 0; e < 8; ++e) { h[e] = (e & 1) ? bf_hi(hw[e >> 1]) : bf_lo(hw[e >> 1]); const float s = (e & 1) ? bf_hi(sw[e >> 1]) : bf_lo(sw[e >> 1]); xx[e] = s - h[e]; }
#pragma unroll
            for (int m = 0; m < 6; ++m) { const f32x4 ma = *(const f32x4*)(mu + (size_t)m * D + col), mb = *(const f32x4*)(mu + (size_t)m * D + col + 4);
                u32x4 o; o.x = cvt_pk_bf16(h[0] + xx[0] * ma[0], h[1] + xx[1] * ma[1]); o.y = cvt_pk_bf16(h[2] + xx[2] * ma[2], h[3] + xx[3] * ma[3]);
                o.z = cvt_pk_bf16(h[4] + xx[4] * mb[0], h[5] + xx[5] * mb[1]); o.w = cvt_pk_bf16(h[6] + xx[6] * mb[2], h[7] + xx[7] * mb[3]);
                *(u32x4*)(outs[m] + (size_t)row * D + col) = o; } }
    }
}

constexpr int NSC = 65, NSCAN = 64, TP = 72, TILE_B = 64 * TP * 2;
enum { T_AT = 0, T_RT, T_BT, T_KT, T_VM, T_NT, T_MT, T_NRT, T_MRT, T_APA, T_APB, T_TAA, T_TAB, T_PRB, T_QRB, T_NTILE };
constexpr int LDS_GL = T_NTILE * TILE_B, LDS_SEG = LDS_GL + 256;
static_assert(LDS_SEG + 2048 <= LDS_MISC, "scan LDS map");
__device__ __forceinline__ int scan_row(int z, int b, int p) {
    if (p < CTXL) return TL + b * CTXL + (z ? CTXL - 1 - p : p);
    const int q = p - CTXL; return b * SEQ + (z ? SEQ - 1 - q : q);
}
__device__ __forceinline__ LAS bf16_t* stile(LAS unsigned char* lds, int n) { return (LAS bf16_t*)(lds + n * TILE_B); }
__device__ __forceinline__ bf16x8 row_frag(const LAS bf16_t* M, int r0, int k0, int lane) { return *(const LAS bf16x8*)(M + (r0 + (lane & 15)) * TP + k0 + 8 * (lane >> 4)); }
__device__ __forceinline__ bf16x8 tr_frag(const LAS bf16_t* M, int k0, int c0, int lane) {
    LAS bf16_t* p = (LAS bf16_t*)M + (k0 + 8 * (lane >> 4) + ((lane & 15) >> 2)) * TP + c0 + 4 * (lane & 3);
    const v4s lo = __builtin_amdgcn_ds_read_tr16_b64_v4i16((LAS v4s*)p), hi = __builtin_amdgcn_ds_read_tr16_b64_v4i16((LAS v4s*)(p + 4 * TP));
    return (bf16x8){lo[0], lo[1], lo[2], lo[3], hi[0], hi[1], hi[2], hi[3]};
}
template <bool XT, bool YT>
__device__ __forceinline__ void mm64(const LAS bf16_t* X, const LAS bf16_t* Y, f32x4 (&acc)[2], int wq, int wh, int lane) {
#pragma unroll
    for (int ks = 0; ks < 2; ++ks) {
        const bf16x8 b = XT ? tr_frag(X, 32 * ks, 16 * wq, lane) : row_frag(X, 16 * wq, 32 * ks, lane);
#pragma unroll
        for (int q = 0; q < 2; ++q) { const int i0 = 16 * (2 * wh + q);
            const bf16x8 a = YT ? row_frag(Y, i0, 32 * ks, lane) : tr_frag(Y, 32 * ks, i0, lane);
            acc[q] = __builtin_amdgcn_mfma_f32_16x16x32_bf16(a, b, acc[q], 0, 0, 0); }
    }
}
__device__ __forceinline__ void st_tile(LAS bf16_t* Z, const f32x4 (&acc)[2], int wq, int wh, int lane) {
#pragma unroll
    for (int q = 0; q < 2; ++q) { u32x2 o; o.x = cvt_pk_bf16(acc[q][0], acc[q][1]); o.y = cvt_pk_bf16(acc[q][2], acc[q][3]);
        *(LAS u32x2*)(Z + (16 * wq + (lane & 15)) * TP + 16 * (2 * wh + q) + 4 * (lane >> 4)) = o; }
}
__device__ __forceinline__ void ld_tile(const LAS bf16_t* Z, f32x4 (&acc)[2], int wq, int wh, int lane) {
#pragma unroll
    for (int q = 0; q < 2; ++q) { const u32x2 o = *(const LAS u32x2*)(Z + (16 * wq + (lane & 15)) * TP + 16 * (2 * wh + q) + 4 * (lane >> 4));
        acc[q] = (f32x4){bf_lo(o.x), bf_hi(o.x), bf_lo(o.y), bf_hi(o.y)}; }
}
__device__ __forceinline__ f32x4 prod16(const LAS bf16_t* X, int xr, int xc, const LAS bf16_t* Y, int yr, int yc, f32x4 acc, int lane) {
    bf16x8 b = *(const LAS bf16x8*)(X + (xr + (lane & 15)) * TP + xc + 8 * (lane >> 4)); bf16x8 a = tr_frag(Y, yr, yc, lane);
    if ((lane >> 4) >= 2) { b = (bf16x8){0, 0, 0, 0, 0, 0, 0, 0}; a = (bf16x8){0, 0, 0, 0, 0, 0, 0, 0}; }
    return __builtin_amdgcn_mfma_f32_16x16x32_bf16(a, b, acc, 0, 0, 0);
}
__device__ __forceinline__ void st16(LAS bf16_t* Z, int zr, int zc, f32x4 acc, int lane) { u32x2 o; o.x = cvt_pk_bf16(acc[0], acc[1]); o.y = cvt_pk_bf16(acc[2], acc[3]); *(LAS u32x2*)(Z + (zr + (lane & 15)) * TP + zc + 4 * (lane >> 4)) = o; }
__device__ __forceinline__ f32x4 ld16(const LAS bf16_t* Z, int zr, int zc, int lane) { const u32x2 o = *(const LAS u32x2*)(Z + (zr + (lane & 15)) * TP + zc + 4 * (lane >> 4)); return (f32x4){bf_lo(o.x), bf_hi(o.x), bf_lo(o.y), bf_hi(o.y)}; }
struct ChunkRegs { u32x4 r, k, v, tw, ta; };
__device__ __forceinline__ void scan_load(KP P, const Frame& F, int item, int c4, ChunkRegs& R) {
    const int s = item & 63, sc = item >> 6, z = s >> 5, b = (s >> 4) & 1, hh = s & 15;
    const size_t row = (size_t)scan_row(z, b, sc * 256 + c4 * 64 + (F.tid >> 3)); const size_t o = row * D + hh * 64 + (F.tid & 7) * 8, o2 = row * 256 + z * 64 + (F.tid & 7) * 8;
    R.r = *(const u32x4*)((const bf16_t*)(P->ws + WS_R) + o); R.k = *(const u32x4*)((const bf16_t*)(P->ws + WS_K) + o); R.v = *(const u32x4*)((const bf16_t*)(P->ws + WS_VV) + o);
    R.tw = *(const u32x4*)((const bf16_t*)(P->ws + WS_TW) + o2); R.ta = *(const u32x4*)((const bf16_t*)(P->ws + WS_TA) + o2);
}
__device__ __forceinline__ void scan_chunk_phase(const Frame& F, KP P, int j) {
    LAS unsigned char* lds = F.lds;
    LAS bf16_t* At = stile(lds, T_AT); LAS bf16_t* Rt = stile(lds, T_RT); LAS bf16_t* Bt = stile(lds, T_BT); LAS bf16_t* Kt = stile(lds, T_KT); LAS bf16_t* Vm = stile(lds, T_VM);
    LAS bf16_t* NT = stile(lds, T_NT); LAS bf16_t* MT = stile(lds, T_MT); LAS bf16_t* NrT = stile(lds, T_NRT); LAS bf16_t* MrT = stile(lds, T_MRT);
    LAS bf16_t* ApA = stile(lds, T_APA); LAS bf16_t* ApB = stile(lds, T_APB); LAS bf16_t* TaA = stile(lds, T_TAA); LAS bf16_t* TaB = stile(lds, T_TAB);
    LAS bf16_t* PrB = stile(lds, T_PRB); LAS bf16_t* QrB = stile(lds, T_QRB);
    LAS float* gl = (LAS float*)(lds + LDS_GL); LAS float* seg = (LAS float*)(lds + LDS_SEG);
    const int lane = F.lane, wq = F.wave & 3, wh = F.wave >> 2, l15 = lane & 15, l4 = lane >> 4;
    const int pi = F.tid >> 3, kq = F.tid & 7;
    const int jrow = 16 * wq + l15;
    const int NITEM = NSCAN * NSC;
    int item = blockIdx.x; if (item >= NITEM) return;
    ChunkRegs cur, nxt; scan_load(P, F, item, 0, cur); nxt = cur;
    f32x4 Pr[2], Qr[2], aYp[2], aQp[2];
#pragma unroll
    for (int q = 0; q < 2; ++q) { Pr[q] = (f32x4){0.f, 0.f, 0.f, 0.f}; Qr[q] = Pr[q]; aYp[q] = Pr[q]; aQp[q] = Pr[q]; }
    bool pend = false; size_t orowp = 0; bf16_t* GEp = nullptr; bf16_t* YEp = nullptr; float* pqp = nullptr; bool lastp = false;
#define SCAN_STAGE_G() do { \
        f32x4 ge[2] = {(f32x4){0.f, 0.f, 0.f, 0.f}, (f32x4){0.f, 0.f, 0.f, 0.f}}; \
        mm64<false, true>(NT, PrB, ge, wq, wh, lane); mm64<false, true>(NT, QrB, aYp, wq, wh, lane); \
        f32x4 pn[2] = {(f32x4){0.f, 0.f, 0.f, 0.f}, (f32x4){0.f, 0.f, 0.f, 0.f}}; \
        mm64<false, false>(PrB, MT, pn, wq, wh, lane); mm64<false, false>(QrB, MT, aQp, wq, wh, lane); \
        _Pragma("unroll") for (int q = 0; q < 2; ++q) { const int i0 = 16 * (2 * wh + q) + 4 * l4; \
            u32x2 o; o.x = cvt_pk_bf16(ge[q][0], ge[q][1]); o.y = cvt_pk_bf16(ge[q][2], ge[q][3]); *(u32x2*)(GEp + orowp + i0) = o; \
            u32x2 y; y.x = cvt_pk_bf16(aYp[q][0], aYp[q][1]); y.y = cvt_pk_bf16(aYp[q][2], aYp[q][3]); *(u32x2*)(YEp + orowp + i0) = y; \
            Pr[q] = pn[q]; Qr[q] = aQp[q]; } \
        if (lastp) { _Pragma("unroll") for (int q = 0; q < 2; ++q) { const int i0 = 16 * (2 * wh + q) + 4 * l4; *(f32x4*)(pqp + jrow * 64 + i0) = Pr[q]; *(f32x4*)(pqp + 4096 + jrow * 64 + i0) = Qr[q]; } } \
    } while (0)
    for (;;) {
        const int s = item & 63, sc = item >> 6, z = s >> 5, b = (s >> 4) & 1, hh = s & 15;
        const float* kkw = P->in[I_KK] + (size_t)j * D + hh * 64 + kq * 8; const float* kap = P->in[I_KA] + (size_t)j * D + hh * 64 + kq * 8; const float* rkp = P->in[I_RK] + (size_t)j * D + hh * 64 + kq * 8;
        const float* w0p = P->in[I_W0] + ((size_t)j * 2 + z) * D + hh * 64; const float* a0p = P->in[I_A0] + ((size_t)j * 2 + z) * D + hh * 64;
        float* bon = (float*)(P->ws + WS_BON) + (size_t)z * T * 16;
        const u32x4 w2r = *(const u32x4*)((const bf16_t*)(P->ws + WS_W2P) + (((size_t)j * 2 + z) * D + hh * 64 + pi) * 256 + z * 64 + kq * 8);
        const u32x4 a2r = *(const u32x4*)((const bf16_t*)(P->ws + WS_A2P) + (((size_t)j * 2 + z) * D + hh * 64 + pi) * 256 + z * 64 + kq * 8);
        bf16_t* GE = (bf16_t*)(P->ws + (z ? WS_AS1 : WS_AS0)); bf16_t* YE = (bf16_t*)(P->ws + (z ? WS_ELOG1 : WS_ELOG0));
        float* pq = (float*)(P->ws + WS_PQ) + ((size_t)(s * NSC + sc) * 2) * 4096;
#pragma nounroll
        for (int c4 = 0; c4 < 4; ++c4) {
            unsigned long long ch_t[12]; ch_t[11] = CH_AMP >= 0 ? __builtin_amdgcn_s_memrealtime() : 0ull;
            *(LAS u32x4*)(ApA + pi * TP + kq * 8) = cur.tw; *(LAS u32x4*)(ApB + pi * TP + kq * 8) = cur.ta; *(LAS u32x4*)(NrT + pi * TP + kq * 8) = w2r; *(LAS u32x4*)(MrT + pi * TP + kq * 8) = a2r;
            LDS_BARRIER(); CH_STAMP(0);
            {   f32x4 lw[2] = {(f32x4){0.f, 0.f, 0.f, 0.f}, (f32x4){0.f, 0.f, 0.f, 0.f}}, la[2] = {(f32x4){0.f, 0.f, 0.f, 0.f}, (f32x4){0.f, 0.f, 0.f, 0.f}};
                mm64<false, true>(ApA, NrT, lw, wq, wh, lane); mm64<false, true>(ApB, MrT, la, wq, wh, lane);
#pragma unroll
                for (int q = 0; q < 2; ++q) { const int i0 = 16 * (2 * wh + q) + 4 * l4; const f32x4 w04 = *(const f32x4*)(w0p + i0), a04 = *(const f32x4*)(a0p + i0);
#pragma unroll
                    for (int r = 0; r < 4; ++r) { lw[q][r] = -0.60653065971f * sigmoidf_(w04[r] + lw[q][r]); la[q][r] = sigmoidf_(a04[r] + la[q][r]); } }
                st_tile(TaA, lw, wq, wh, lane); st_tile(TaB, la, wq, wh, lane); }
            LDS_BARRIER(); CH_STAMP(1);
            float r8[8], k8[8], e8[8], m8[8], a8[8], kk8[8], c8[8];
            { const u32x4 et = *(const LAS u32x4*)(TaA + pi * TP + kq * 8), at = *(const LAS u32x4*)(TaB + pi * TP + kq * 8); unpack8(cur.r, r8); unpack8(cur.k, k8); unpack8(et, e8); unpack8(at, a8); }
            {   const f32x4 ka0 = *(const f32x4*)(kap), ka1 = *(const f32x4*)(kap + 4), rk0 = *(const f32x4*)(rkp), rk1 = *(const f32x4*)(rkp + 4); float bp = 0.f;
#pragma unroll
                for (int e = 0; e < 8; ++e) { m8[e] = k8[e] * (1.0f + (a8[e] - 1.0f) * (e < 4 ? ka0[e & 3] : ka1[e & 3])); bp += r8[e] * (e < 4 ? rk0[e & 3] : rk1[e & 3]) * m8[e]; }
                bp += shx(bp, 1, lane); bp += shx(bp, 2, lane); bp += shx(bp, 4, lane);
                if (kq == 0) bon[(size_t)scan_row(z, b, sc * 256 + c4 * 64 + pi) * 16 + hh] = bp; }
            { const f32x4 w0 = *(const f32x4*)kkw, w1 = *(const f32x4*)(kkw + 4); float ss = 0.f;
#pragma unroll
              for (int e = 0; e < 8; ++e) { kk8[e] = k8[e] * (e < 4 ? w0[e & 3] : w1[e & 3]); ss += kk8[e] * kk8[e]; }
              ss += shx(ss, 1, lane); ss += shx(ss, 2, lane); ss += shx(ss, 4, lane);
              const float rn = rsqrtf(ss + 1e-12f);
#pragma unroll
              for (int e = 0; e < 8; ++e) { kk8[e] *= rn; c8[e] = e8[e]; } }
#pragma unroll
            for (int d = 8; d < 64; d <<= 1) {
#pragma unroll
                for (int e = 0; e < 8; ++e) { const float t = shup(c8[e], d, lane); c8[e] += lane >= d ? t : 0.f; } }
            if (lane >= 56) { *(LAS f32x4*)(seg + F.wave * 64 + kq * 8) = (f32x4){c8[0], c8[1], c8[2], c8[3]}; *(LAS f32x4*)(seg + F.wave * 64 + kq * 8 + 4) = (f32x4){c8[4], c8[5], c8[6], c8[7]}; }
            if (pend) { SCAN_STAGE_G(); pend = false; }
            LDS_BARRIER(); CH_STAMP(2);
            if (c4 > 0) { st_tile(PrB, Pr, wq, wh, lane); st_tile(QrB, Qr, wq, wh, lane); }
            { float cum[8];
#pragma unroll
              for (int e = 0; e < 8; ++e) cum[e] = c8[e];
              for (int w2 = 0; w2 < F.wave; ++w2) { const f32x4 o0 = *(const LAS f32x4*)(seg + w2 * 64 + kq * 8), o1 = *(const LAS f32x4*)(seg + w2 * 64 + kq * 8 + 4);
#pragma unroll
                  for (int e = 0; e < 8; ++e) cum[e] += e < 4 ? o0[e & 3] : o1[e & 3]; }
              float o[8];
#pragma unroll
              for (int e = 0; e < 8; ++e) o[e] = -kk8[e] * __expf(cum[e] - e8[e]);
              *(LAS u32x4*)(At + pi * TP + kq * 8) = pack8(o);
#pragma unroll
              for (int e = 0; e < 8; ++e) o[e] = r8[e] * __expf(cum[e]);
              *(LAS u32x4*)(Rt + pi * TP + kq * 8) = pack8(o);
              float en[8];
#pragma unroll
              for (int e = 0; e < 8; ++e) { en[e] = __expf(-cum[e]); o[e] = kk8[e] * a8[e] * en[e]; }
              *(LAS u32x4*)(Bt + pi * TP + kq * 8) = pack8(o);
#pragma unroll
              for (int e = 0; e < 8; ++e) o[e] = m8[e] * en[e];
              *(LAS u32x4*)(Kt + pi * TP + kq * 8) = pack8(o);
              *(LAS u32x4*)(Vm + pi * TP + kq * 8) = cur.v;
              if (pi == 63) {
#pragma unroll
                  for (int e = 0; e < 8; ++e) gl[kq * 8 + e] = __expf(cum[e]); } }
            { const int nitem = c4 < 3 ? item : item + (int)gridDim.x, nc4 = c4 < 3 ? c4 + 1 : 0; if (nitem < NITEM) scan_load(P, F, nitem, nc4, nxt); }
            LDS_BARRIER(); CH_STAMP(3);
            {   f32x4 aN[2], aM[2], aNr[2], aMr[2];
#pragma unroll
                for (int q = 0; q < 2; ++q) { aN[q] = (f32x4){0.f, 0.f, 0.f, 0.f}; aM[q] = aN[q]; aNr[q] = aN[q]; aMr[q] = aN[q]; }
                mm64<false, true>(At, Bt, aN, wq, wh, lane); mm64<false, true>(At, Kt, aM, wq, wh, lane); mm64<false, true>(Rt, Bt, aNr, wq, wh, lane); mm64<false, true>(Rt, Kt, aMr, wq, wh, lane);
                f32x4 aT[2];
#pragma unroll
                for (int q = 0; q < 2; ++q)
#pragma unroll
                    for (int r = 0; r < 4; ++r) { const int i = 16 * (2 * wh + q) + 4 * l4 + r; const bool lt = i < jrow, le = i <= jrow;
                        aN[q][r] = lt ? aN[q][r] : 0.f; aM[q][r] = lt ? aM[q][r] : 0.f; aNr[q][r] = le ? aNr[q][r] : 0.f; aMr[q][r] = le ? aMr[q][r] : 0.f; aT[q][r] = aN[q][r] + (i == jrow ? 1.f : 0.f); }
                st_tile(NT, aN, wq, wh, lane); st_tile(MT, aM, wq, wh, lane); st_tile(NrT, aNr, wq, wh, lane); st_tile(MrT, aMr, wq, wh, lane); st_tile(TaA, aT, wq, wh, lane);
            }
            LDS_BARRIER(); CH_STAMP(4);
            if (F.wave < 4) { const int o = 16 * F.wave, oc = 16 * ((F.wave + 1) & 3);
                f32x4 p = prod16(NT, o, o, NT, o, o, (f32x4){0.f, 0.f, 0.f, 0.f}, lane); st16(ApA, o, o, p, lane);
                f32x4 t = prod16(TaA, o, o, ApA, o, o, ld16(TaA, o, o, lane), lane); p = prod16(ApA, o, o, ApA, o, o, (f32x4){0.f, 0.f, 0.f, 0.f}, lane);
                st16(TaB, o, o, t, lane); st16(ApA, o, oc, p, lane);
                t = prod16(TaB, o, o, ApA, o, oc, ld16(TaB, o, o, lane), lane); p = prod16(ApA, o, oc, ApA, o, oc, (f32x4){0.f, 0.f, 0.f, 0.f}, lane);
                st16(TaA, o, o, t, lane); st16(ApA, o, o, p, lane);
                t = prod16(TaA, o, o, ApA, o, o, ld16(TaA, o, o, lane), lane); st16(TaB, o, o, t, lane);
#pragma unroll
                for (int jj = 1; jj < 4; ++jj) if (jj > F.wave) { u32x2 zz; asm volatile("v_mov_b32 %0, 0\n\tv_mov_b32 %1, 0" : "=v"(zz.x), "=v"(zz.y)); *(LAS u32x2*)(TaB + (o + l15) * TP + 16 * jj + 4 * l4) = zz; }
            } else { const int wq2 = F.wave - 4;
#pragma unroll
                for (int wh2 = 0; wh2 < 2; ++wh2) { f32x4 x[2] = {(f32x4){0.f, 0.f, 0.f, 0.f}, (f32x4){0.f, 0.f, 0.f, 0.f}}; mm64<true, true>(Vm, MT, x, wq2, wh2, lane); st_tile(ApB, x, wq2, wh2, lane); } }
            LDS_BARRIER(); CH_STAMP(5);
            if (F.wave < 3) { const int jj = F.wave;
#pragma unroll
                for (int i = 1; i < 4; ++i) if (i > jj) { f32x4 e = (f32x4){0.f, 0.f, 0.f, 0.f};
#pragma unroll
                    for (int m = 0; m < 3; ++m) if (m >= jj && m < i) e = prod16(NT, 16 * i, 16 * m, TaB, 16 * m, 16 * jj, e, lane);
                    st16(ApA, 16 * i, 16 * jj, e, lane);
                    st16(TaB, 16 * i, 16 * jj, prod16(TaB, 16 * i, 16 * i, ApA, 16 * i, 16 * jj, (f32x4){0.f, 0.f, 0.f, 0.f}, lane), lane); } }
            LDS_BARRIER(); CH_STAMP(6);
            {   f32x4 w[2] = {(f32x4){0.f, 0.f, 0.f, 0.f}, (f32x4){0.f, 0.f, 0.f, 0.f}}; mm64<true, true>(At, TaB, w, wq, wh, lane); st_tile(ApA, w, wq, wh, lane);
                f32x4 u[2] = {(f32x4){0.f, 0.f, 0.f, 0.f}, (f32x4){0.f, 0.f, 0.f, 0.f}}; mm64<false, true>(ApB, TaB, u, wq, wh, lane); st_tile(TaA, u, wq, wh, lane); }
            LDS_BARRIER(); CH_STAMP(7);
            f32x4 aP[2], aQ[2], aG[2], aY[2];
#pragma unroll
            for (int q = 0; q < 2; ++q) { aP[q] = (f32x4){0.f, 0.f, 0.f, 0.f}; aQ[q] = aP[q]; aG[q] = aP[q]; aY[q] = aP[q]; }
            mm64<false, false>(ApA, Bt, aP, wq, wh, lane);
            mm64<false, false>(TaA, Bt, aQ, wq, wh, lane); mm64<true, false>(Vm, Kt, aQ, wq, wh, lane);
            mm64<false, true>(NrT, ApA, aG, wq, wh, lane);
            mm64<false, true>(NrT, TaA, aY, wq, wh, lane); mm64<false, false>(MrT, Vm, aY, wq, wh, lane);
#pragma unroll
            for (int q = 0; q < 2; ++q) { const int i0 = 16 * (2 * wh + q) + 4 * l4; const f32x4 g4 = *(const LAS f32x4*)(gl + i0);
                const u32x2 rr = *(const LAS u32x2*)(Rt + jrow * TP + i0);
#pragma unroll
                for (int r = 0; r < 4; ++r) { aP[q][r] = (aP[q][r] + (i0 + r == jrow ? 1.f : 0.f)) * g4[r]; aQ[q][r] *= g4[r]; }
                aG[q][0] += bf_lo(rr.x); aG[q][1] += bf_hi(rr.x); aG[q][2] += bf_lo(rr.y); aG[q][3] += bf_hi(rr.y); }
            const size_t orow = (size_t)scan_row(z, b, sc * 256 + c4 * 64 + jrow) * D + hh * 64;
            if (c4 == 0) {
#pragma unroll
                for (int q = 0; q < 2; ++q) { const int i0 = 16 * (2 * wh + q) + 4 * l4;
                    u32x2 o; o.x = cvt_pk_bf16(aG[q][0], aG[q][1]); o.y = cvt_pk_bf16(aG[q][2], aG[q][3]); *(u32x2*)(GE + orow + i0) = o;
                    u32x2 y; y.x = cvt_pk_bf16(aY[q][0], aY[q][1]); y.y = cvt_pk_bf16(aY[q][2], aY[q][3]); *(u32x2*)(YE + orow + i0) = y;
                    Pr[q] = aP[q]; Qr[q] = aQ[q]; }
            } else {
                st_tile(NT, aG, wq, wh, lane); st_tile(MT, aP, wq, wh, lane);
#pragma unroll
                for (int q = 0; q < 2; ++q) { aYp[q] = aY[q]; aQp[q] = aQ[q]; }
                pend = true; orowp = orow; GEp = GE; YEp = YE; pqp = pq; lastp = c4 == 3;
            }
            cur = nxt;
            if (CH_AMP >= 0) { const unsigned long long d_ = CH_AMP == 0 ? ch_t[0] - ch_t[11] : ch_t[CH_AMP] - ch_t[CH_AMP - 1]; const unsigned long long dl_ = __builtin_amdgcn_s_memrealtime() + 4 * d_; while (__builtin_amdgcn_s_memrealtime() < dl_) __builtin_amdgcn_s_sleep(4); }
            LDS_BARRIER(); CH_STAMP(8);
        }
        item += gridDim.x; if (item >= NITEM) break;
    }
    if (pend) { SCAN_STAGE_G(); }
#undef SCAN_STAGE_G
}
__device__ __forceinline__ void scan_carry_phase(const Frame& F, KP P) {
    if (blockIdx.x >= 4 * NSCAN) return;
    const int s = blockIdx.x >> 2, vs = blockIdx.x & 3, lane = F.lane, l15 = lane & 15, l4 = lane >> 4, v = 16 * vs + l15, T2 = F.wave;
    const float* pq = (const float*)(P->ws + WS_PQ) + (size_t)s * NSC * 2 * 4096; bf16_t* sst = (bf16_t*)(P->ws + WS_SST) + (size_t)s * NSC * 4096;
    LAS f32x4* exch = (LAS f32x4*)F.lds;
    f32x4 S[4]; float ap[4][16], qp[4][4];
#pragma unroll
    for (int t = 0; t < 4; ++t) S[t] = (f32x4){0.f, 0.f, 0.f, 0.f};
#define CARRY_LOAD(slot, step) do { const float* Pm_ = pq + (size_t)(step) * 2 * 4096; \
        _Pragma("unroll") for (int t2i = 0; t2i < 4; ++t2i) _Pragma("unroll") for (int ri = 0; ri < 4; ++ri) ap[slot][t2i * 4 + ri] = Pm_[(16 * l4 + 4 * ri + t2i) * 64 + 4 * l15 + T2]; \
        _Pragma("unroll") for (int r = 0; r < 4; ++r) qp[slot][r] = Pm_[4096 + v * 64 + 16 * l4 + 4 * r + T2]; } while (0)
#define CARRY_STORE(sc_) do { if (T2 == 0) { float o[16]; \
        _Pragma("unroll") for (int r = 0; r < 4; ++r) _Pragma("unroll") for (int t2 = 0; t2 < 4; ++t2) o[4 * r + t2] = S[t2][r]; \
        u32x4 w0, w1; w0.x = cvt_pk_bf16(o[0], o[1]); w0.y = cvt_pk_bf16(o[2], o[3]); w0.z = cvt_pk_bf16(o[4], o[5]); w0.w = cvt_pk_bf16(o[6], o[7]); \
        w1.x = cvt_pk_bf16(o[8], o[9]); w1.y = cvt_pk_bf16(o[10], o[11]); w1.z = cvt_pk_bf16(o[12], o[13]); w1.w = cvt_pk_bf16(o[14], o[15]); \
        *(u32x4*)(sst + (size_t)(sc_) * 4096 + v * 64 + 16 * l4) = w0; *(u32x4*)(sst + (size_t)(sc_) * 4096 + v * 64 + 16 * l4 + 8) = w1; } } while (0)
    if (T2 < 4) {
#pragma unroll
        for (int u = 0; u < 4; ++u) CARRY_LOAD(u, u);
    }
#pragma nounroll
    for (int sc0 = 0; sc0 < NSC - 1; sc0 += 4) {
#pragma unroll
        for (int u = 0; u < 4; ++u) { const int sc = sc0 + u;
            CARRY_STORE(sc);
            if (T2 < 4) {
                f32x4 nw = (f32x4){qp[u][0], qp[u][1], qp[u][2], qp[u][3]};
#pragma unroll
                for (int t2i = 0; t2i < 4; ++t2i)
#pragma unroll
                    for (int ri = 0; ri < 4; ++ri) nw = __builtin_amdgcn_mfma_f32_16x16x4f32(ap[u][t2i * 4 + ri], S[t2i][ri], nw, 0, 0, 0);
                if (sc + 4 < NSC - 1) CARRY_LOAD(u, sc + 4);
                exch[((u & 1) * 4 + T2) * 64 + lane] = nw;
            }
            LDS_BARRIER();
            if (T2 < 4) {
#pragma unroll
                for (int t = 0; t < 4; ++t) S[t] = exch[((u & 1) * 4 + t) * 64 + lane];
            }
        }
    }
    CARRY_STORE(NSC - 1);
#undef CARRY_LOAD
#undef CARRY_STORE
}
__device__ __forceinline__ void scan_out_phase(const Frame& F, KP P, int j) {
    const int lane = F.lane, l15 = lane & 15, l4 = lane >> 4;
    const bf16_t* GE0 = (const bf16_t*)(P->ws + WS_AS0); const bf16_t* GE1 = (const bf16_t*)(P->ws + WS_AS1); const bf16_t* YE0 = (const bf16_t*)(P->ws + WS_ELOG0); const bf16_t* YE1 = (const bf16_t*)(P->ws + WS_ELOG1);
    const bf16_t* Vb = (const bf16_t*)(P->ws + WS_VV); const float* BON = (const float*)(P->ws + WS_BON);
    const bf16_t* GT = (const bf16_t*)(P->ws + WS_GATE); bf16_t* YG = (bf16_t*)(P->ws + WS_YG);
    for (int item = F.gw; item < NBATCH * NH * NSC * 8; item += F.NGW) {
        const int hh = item & 15, oct = (item >> 4) & 7, b = (item >> 7) & 1, blk = item >> 8;
        const int sc0 = blk, sc1 = blk == 0 ? 0 : NSC - blk;
        const bf16_t* s0 = (const bf16_t*)(P->ws + WS_SST) + ((size_t)(b * 16 + hh) * NSC + sc0) * 4096; const bf16_t* s1 = (const bf16_t*)(P->ws + WS_SST) + ((size_t)(32 + b * 16 + hh) * NSC + sc1) * 4096;
        bf16x8 sa0[4][2], sa1[4][2];
#pragma unroll
        for (int vt = 0; vt < 4; ++vt) { const int v = 32 * (vt >> 1) + 8 * (l15 >> 2) + 4 * (vt & 1) + (l15 & 3);
#pragma unroll
            for (int ks = 0; ks < 2; ++ks) { sa0[vt][ks] = *(const bf16x8*)(s0 + v * 64 + 32 * ks + 8 * l4); sa1[vt][ks] = *(const bf16x8*)(s1 + v * 64 + 32 * ks + 8 * l4); } }
        f32x4 lg4[4], lb4[4];
#pragma unroll
        for (int q = 0; q < 4; ++q) { const int c = hh * 64 + 32 * (q >> 1) + 8 * l4 + 4 * (q & 1); lg4[q] = *(const f32x4*)(P->in[I_LNG] + (size_t)j * D + c); lb4[q] = *(const f32x4*)(P->in[I_LNB] + (size_t)j * D + c); }
#pragma nounroll
        for (int ti = 0; ti < 2; ++ti) {
            const int tok = (2 * oct + ti) * 16 + l15; const int row = blk == 0 ? TL + b * CTXL + tok : b * SEQ + (blk - 1) * 256 + tok;
            const size_t o = (size_t)row * D + hh * 64;
            const bf16x8 g00 = *(const bf16x8*)(GE0 + o + 8 * l4), g01 = *(const bf16x8*)(GE0 + o + 32 + 8 * l4), g10 = *(const bf16x8*)(GE1 + o + 8 * l4), g11 = *(const bf16x8*)(GE1 + o + 32 + 8 * l4);
            u32x4 la[2], lc[2], lv[2], lgt[2];
#pragma unroll
            for (int h2 = 0; h2 < 2; ++h2) { const size_t oc = o + 32 * h2 + 8 * l4;
                la[h2] = *(const u32x4*)(YE0 + oc); lc[h2] = *(const u32x4*)(YE1 + oc); lv[h2] = *(const u32x4*)(Vb + oc); lgt[h2] = *(const u32x4*)(GT + oc); }
            const float bn = BON[(size_t)row * 16 + hh] + BON[((size_t)T + row) * 16 + hh];
            __builtin_amdgcn_sched_barrier(0);
            f32x4 y[4]; float s = 0.f; f32x4 vv[4], gg[4];
#pragma unroll
            for (int vt = 0; vt < 4; ++vt) { const int h2 = vt >> 1, hf = vt & 1;
                const unsigned ax = hf ? la[h2].z : la[h2].x, ay = hf ? la[h2].w : la[h2].y, cx = hf ? lc[h2].z : lc[h2].x, cy = hf ? lc[h2].w : lc[h2].y;
                const unsigned vx = hf ? lv[h2].z : lv[h2].x, vy = hf ? lv[h2].w : lv[h2].y, gx = hf ? lgt[h2].z : lgt[h2].x, gy = hf ? lgt[h2].w : lgt[h2].y;
                f32x4 acc = (f32x4){bf_lo(ax) + bf_lo(cx), bf_hi(ax) + bf_hi(cx), bf_lo(ay) + bf_lo(cy), bf_hi(ay) + bf_hi(cy)};
                acc = __builtin_amdgcn_mfma_f32_16x16x32_bf16(sa0[vt][0], g00, acc, 0, 0, 0); acc = __builtin_amdgcn_mfma_f32_16x16x32_bf16(sa0[vt][1], g01, acc, 0, 0, 0);
                acc = __builtin_amdgcn_mfma_f32_16x16x32_bf16(sa1[vt][0], g10, acc, 0, 0, 0); acc = __builtin_amdgcn_mfma_f32_16x16x32_bf16(sa1[vt][1], g11, acc, 0, 0, 0);
                y[vt] = acc; s += (acc[0] + acc[1]) + (acc[2] + acc[3]);
                vv[vt] = (f32x4){bf_lo(vx), bf_hi(vx), bf_lo(vy), bf_hi(vy)}; gg[vt] = (f32x4){bf_lo(gx), bf_hi(gx), bf_lo(gy), bf_hi(gy)}; }
            s += shx(s, 16, lane); s += shx(s, 32, lane);
            const float mean = s * (1.0f / 64.0f); float q = 0.f;
#pragma unroll
            for (int vt = 0; vt < 4; ++vt) { const f32x4 d = y[vt] - mean; q += (d[0] * d[0] + d[1] * d[1]) + (d[2] * d[2] + d[3] * d[3]); }
            q += shx(q, 16, lane); q += shx(q, 32, lane);
            const float rstd = rsqrtf(q * (1.0f / 64.0f) + 64e-5f);
#pragma unroll
            for (int h2 = 0; h2 < 2; ++h2) { const f32x4 o0 = (((y[2 * h2] - mean) * rstd) * lg4[2 * h2] + lb4[2 * h2] + vv[2 * h2] * bn) * gg[2 * h2], o1 = (((y[2 * h2 + 1] - mean) * rstd) * lg4[2 * h2 + 1] + lb4[2 * h2 + 1] + vv[2 * h2 + 1] * bn) * gg[2 * h2 + 1];
                u32x4 w; w.x = cvt_pk_bf16(o0[0], o0[1]); w.y = cvt_pk_bf16(o0[2], o0[3]); w.z = cvt_pk_bf16(o1[0], o1[1]); w.w = cvt_pk_bf16(o1[2], o1[3]); *(u32x4*)(YG + o + 32 * h2 + 8 * l4) = w; }
        }
    }
}
__device__ __forceinline__ bool in_range(int lo, int hi, int k) { asm volatile("" : "+s"(lo), "+s"(hi)); return lo <= k && k < hi; }
constexpr int NPH = 46;
template <unsigned KMASK> __global__ void __launch_bounds__(NTHR, 2) mega(Params Pv) {
    extern __shared__ __attribute__((aligned(16))) unsigned char lds_raw[];
    Frame F0; F0.lds = (LAS unsigned char*)lds_raw; F0.tid = threadIdx.x; F0.lane = F0.tid & 63; F0.wave = __builtin_amdgcn_readfirstlane(F0.tid >> 6);
    F0.G = gridDim.x; F0.gw = blockIdx.x * NWAVES + F0.wave; F0.NGW = F0.G * NWAVES;
    LAS unsigned* misc = (LAS unsigned*)(F0.lds + LDS_MISC);
    if (F0.tid < 128) misc[F0.tid] = 0u;
    __syncthreads();
    KP P0 = (KP)__builtin_amdgcn_kernarg_segment_ptr();
    constexpr bool ALL = (KMASK == 0x3ffffu);
    const int lo = ALL ? 0 : P0->ph_lo, hi = ALL ? NPH : P0->ph_hi;
    XcdBarrier bar; bar.bar = (unsigned*)(P0->ws + WS_CTL) + CW_BAR; bar.x = 0; bar.st = (volatile LAS unsigned*)(misc + 8);
    if (ALL || hi - lo > 1) bar = xcd_barrier_post((unsigned*)(P0->ws + WS_CTL) + CW_BAR, (volatile LAS unsigned*)(misc + 8));
#define IN(k) (ALL || in_range(lo, hi, (k)))
#define KIND(q) ((KMASK >> (q)) & 1u)
#define BAR_LEADER (wave_sgpr_now(F0.wave) == 0 && lane_id_now() == 0)
#define SEAM(k) do { if (IN(k) && IN((k) + 1)) { XcdBarrier b2_ = bar; unsigned* bb_ = bar.bar; unsigned bx_ = bar.x; asm volatile("" : "+s"(bb_), "+s"(bx_)); b2_.bar = bb_; b2_.x = bx_; xcd_barrier<false>(b2_, BAR_LEADER); } } while (0)
#define AMP_T0 const unsigned long long amp_t0 = AMP_MASK ? __builtin_amdgcn_s_memrealtime() : 0ull;
#define AMP_END(kind) do { if (AMP_MASK & (1u << (kind))) { const unsigned long long t1_ = __builtin_amdgcn_s_memrealtime(), dl_ = t1_ + AMP_F * (t1_ - amp_t0); while (__builtin_amdgcn_s_memrealtime() < dl_) __builtin_amdgcn_s_sleep(8); } } while (0)
#define PHASE_ENTRY AMP_T0 KP P = P0; asm volatile("" : "+s"(P)); unsigned char* ws = P->ws; unsigned* ctl = (unsigned*)(ws + WS_CTL); (void)ctl; \
    Frame F = F0; { int l_ = lane_id_now(), w_ = F0.wave; asm volatile("" : "+s"(w_)); F.lane = l_; F.wave = w_; F.tid = w_ * 64 + l_; F.gw = blockIdx.x * NWAVES + w_; }

    if constexpr (KIND(0)) if (IN(0)) { PHASE_ENTRY prologue_phase(F, P); AMP_END(0); }
    if (IN(0) && IN(1)) { XcdBarrier b2_ = bar; unsigned* bb_ = bar.bar; unsigned bx_ = bar.x; asm volatile("" : "+s"(bb_), "+s"(bx_)); b2_.bar = bb_; b2_.x = bx_; xcd_barrier<true>(b2_, BAR_LEADER); }
    for (int lp = 0; lp < 2; ++lp) {
        const int pb = 1 + 22 * lp, la = 2 * lp, lb = 2 * lp + 1;
        if constexpr (KIND(1)) if (IN(pb + 0)) { PHASE_ENTRY norm1_phase(F, P, la); AMP_END(1); }
        SEAM(pb + 0);
        if constexpr (KIND(2)) if (IN(pb + 1)) { PHASE_ENTRY
            __syncthreads(); set_desc(F.lds, F.tid, 0, ws + WS_HL, ws + WS_WIN + (size_t)lp * 4096 * D * 2, ws + WS_U, 16, 0, 0, ws + WS_V, P->in[I_GBIN] + (size_t)lp * 4096, ws + WS_STAT); __syncthreads();
            SchedMulti<D, D> S{F.lds, T / 256, 16, 1};
            EpiGelu E{F.lds};
            pg8::gemm_phase<EpiGelu, SchedMulti<D, D>, false, D, D, D>(F.lds, S, E, F.tid);
            AMP_END(2); }
        SEAM(pb + 1);
        if constexpr (KIND(3)) if (IN(pb + 2)) { PHASE_ENTRY spatial_phase(F, P, lp); AMP_END(3); }
        SEAM(pb + 2);
        if constexpr (KIND(4)) if (IN(pb + 3)) { PHASE_ENTRY
            __syncthreads();
            { float* X = (float*)(ws + WS_X);
              set_desc(F.lds, F.tid, 0, ws + WS_U, ws + WS_WOUT + (size_t)lp * D * GWID * 2, X, 4, 0, 0, la == 0 ? P->in[I_X] : X, la == 0 ? P->in[I_CTX] : X + (size_t)TL * D, P->in[I_GBOUT] + (size_t)lp * D);
              set_desc(F.lds, F.tid, 1, nullptr, nullptr, nullptr, 0, 0, 0, (const float*)(ws + WS_MOD) + (size_t)la * 3 * 6 * D + 2 * D); }
            __syncthreads();
            SchedMulti<GWID, GWID> S{F.lds, T / 256, 4, 1};
            EpiResid E{F.lds};
            pg8::gemm_phase<EpiResid, SchedMulti<GWID, GWID>, false, GWID, GWID, GWID>(F.lds, S, E, F.tid);
            AMP_END(4); }
        SEAM(pb + 3);
        if constexpr (KIND(5)) if (IN(pb + 4)) { PHASE_ENTRY norm2_phase(F, P, la); AMP_END(5); }
        SEAM(pb + 4);
        if constexpr (KIND(16)) if (IN(pb + 5)) { PHASE_ENTRY
            __syncthreads(); set_desc(F.lds, F.tid, 0, ws + WS_HL, ws + WS_WRT + (size_t)la * 256 * D * 2, nullptr, 1, 0, 0); __syncthreads();
            SchedMulti<D, D> S{F.lds, (la == DEPTH - 1 ? TL : T) / 256, 1, 1};
            EpiLogits E{(float*)(ws + WS_LG)};
            pg8::gemm_phase<EpiLogits, SchedMulti<D, D>, false, D, D, D>(F.lds, S, E, F.tid);
            AMP_END(16); }
        SEAM(pb + 5);
        if constexpr (KIND(17)) if (IN(pb + 6)) { PHASE_ENTRY route_phase(F, P, la); AMP_END(17); }
        SEAM(pb + 6);
        if constexpr (KIND(6)) if (IN(pb + 7)) { PHASE_ENTRY
            moe_tables(F.lds, F.tid, ctl + CW_CNT + la * 64);
            SchedMoE<D, D, true> S{F.lds, (const char*)(ws + WS_HL), (const char*)(ws + WS_WGU), (const int*)(ws + WS_LIST)};
            EpiSiluGate E{(bf16_t*)(ws + WS_H)};
            pg8::gemm_phase<EpiSiluGate, SchedMoE<D, D, true>, true, D, D, D>(F.lds, S, E, F.tid);
            AMP_END(6); }
        SEAM(pb + 7);
        if constexpr (KIND(7)) if (IN(pb + 8)) { PHASE_ENTRY
            moe_tables(F.lds, F.tid, ctl + CW_CNT + la * 64);
            SchedMoE<EHID, EHID, false> S{F.lds, (const char*)(ws + WS_H), (const char*)(ws + WS_WD), (const int*)(ws + WS_LIST)};
            EpiScatter E{F.lds, (bf16_t*)(ws + WS_YB), (const int*)(ws + WS_LIST)};
            pg8::gemm_phase<EpiScatter, SchedMoE<EHID, EHID, false>, false, EHID, EHID, EHID>(F.lds, S, E, F.tid);
            AMP_END(7); }
        SEAM(pb + 8);
        if constexpr (KIND(1)) if (IN(pb + 9)) { PHASE_ENTRY norm1_phase(F, P, lb); AMP_END(1); }
        SEAM(pb + 9);
        if constexpr (KIND(8)) if (IN(pb + 10)) { PHASE_ENTRY mix_phase(F, P, lp); AMP_END(8); }
        SEAM(pb + 10);
        if constexpr (KIND(9)) if (IN(pb + 11)) { PHASE_ENTRY
            __syncthreads();
            set_desc(F.lds, F.tid, 0, ws + WS_XR, ws + WS_WR + (size_t)lp * D * D * 2, ws + WS_R, 4, D, 0);
            set_desc(F.lds, F.tid, 1, ws + WS_XK, ws + WS_WK + (size_t)lp * D * D * 2, ws + WS_K, 4, D, 0);
            set_desc(F.lds, F.tid, 2, ws + WS_XV, ws + WS_WV + (size_t)lp * D * D * 2, ws + WS_VV, 4, D, 0);
            set_desc(F.lds, F.tid, 3, ws + WS_XW, ws + WS_LW1 + (size_t)lp * 256 * D * 2, ws + WS_TW, 1, 256, 1);
            set_desc(F.lds, F.tid, 4, ws + WS_XA, ws + WS_LA1 + (size_t)lp * 256 * D * 2, ws + WS_TA, 1, 256, 0);
            set_desc(F.lds, F.tid, 5, ws + WS_XG, ws + WS_LG1 + (size_t)lp * 256 * D * 2, ws + WS_TG, 1, 256, 2);
            __syncthreads();
            SchedMulti<D, D> S{F.lds, T / 256, 15, 6};
            EpiAct E{F.lds};
            pg8::gemm_phase<EpiAct, SchedMulti<D, D>, false, D, D, D>(F.lds, S, E, F.tid);
            AMP_END(9); }
        SEAM(pb + 11);
        if constexpr (KIND(10)) if (IN(pb + 12)) { PHASE_ENTRY
            __syncthreads(); set_desc(F.lds, F.tid, 0, ws + WS_TG, ws + WS_G2P + (size_t)lp * D * 256 * 2, ws + WS_GATE, 4, D, 0); __syncthreads();
            SchedMulti<256, 256> S{F.lds, T / 256, 4, 1};
            EpiAct E{F.lds};
            pg8::gemm_phase<EpiAct, SchedMulti<256, 256>, false, 256, 256, 256>(F.lds, S, E, F.tid);
            AMP_END(10); }
        SEAM(pb + 12);
        if constexpr (KIND(11)) if (IN(pb + 13)) { PHASE_ENTRY scan_chunk_phase(F, P, lp); AMP_END(11); }
        SEAM(pb + 13);
        if constexpr (KIND(14)) if (IN(pb + 14)) { PHASE_ENTRY scan_carry_phase(F, P); AMP_END(14); }
        SEAM(pb + 14);
        if constexpr (KIND(15)) if (IN(pb + 15)) { PHASE_ENTRY scan_out_phase(F, P, lp); AMP_END(15); }
        SEAM(pb + 15);
        if constexpr (KIND(4)) if (IN(pb + 16)) { PHASE_ENTRY
            __syncthreads();
            { float* X = (float*)(ws + WS_X);
              set_desc(F.lds, F.tid, 0, ws + WS_YG, ws + WS_WO + (size_t)lp * D * D * 2, X, 4, 0, 0, X, X + (size_t)TL * D, nullptr);
              set_desc(F.lds, F.tid, 1, nullptr, nullptr, nullptr, 0, 0, 0, (const float*)(ws + WS_MOD) + (size_t)lb * 3 * 6 * D + 2 * D); }
            __syncthreads();
            SchedMulti<D, D> S{F.lds, T / 256, 4, 1};
            EpiResid E{F.lds};
            pg8::gemm_phase<EpiResid, SchedMulti<D, D>, false, D, D, D>(F.lds, S, E, F.tid);
            AMP_END(4); }
        SEAM(pb + 16);
        if constexpr (KIND(5)) if (IN(pb + 17)) { PHASE_ENTRY norm2_phase(F, P, lb); AMP_END(5); }
        SEAM(pb + 17);
        if constexpr (KIND(16)) if (IN(pb + 18)) { PHASE_ENTRY
            __syncthreads(); set_desc(F.lds, F.tid, 0, ws + WS_HL, ws + WS_WRT + (size_t)lb * 256 * D * 2, nullptr, 1, 0, 0); __syncthreads();
            SchedMulti<D, D> S{F.lds, (lb == DEPTH - 1 ? TL : T) / 256, 1, 1};
            EpiLogits E{(float*)(ws + WS_LG)};
            pg8::gemm_phase<EpiLogits, SchedMulti<D, D>, false, D, D, D>(F.lds, S, E, F.tid);
            AMP_END(16); }
        SEAM(pb + 18);
        if constexpr (KIND(17)) if (IN(pb + 19)) { PHASE_ENTRY route_phase(F, P, lb); AMP_END(17); }
        SEAM(pb + 19);
        if constexpr (KIND(6)) if (IN(pb + 20)) { PHASE_ENTRY
            moe_tables(F.lds, F.tid, ctl + CW_CNT + lb * 64);
            SchedMoE<D, D, true> S{F.lds, (const char*)(ws + WS_HL), (const char*)(ws + WS_WGU), (const int*)(ws + WS_LIST)};
            EpiSiluGate E{(bf16_t*)(ws + WS_H)};
            pg8::gemm_phase<EpiSiluGate, SchedMoE<D, D, true>, true, D, D, D>(F.lds, S, E, F.tid);
            AMP_END(6); }
        SEAM(pb + 20);
        if constexpr (KIND(7)) if (IN(pb + 21)) { PHASE_ENTRY
            moe_tables(F.lds, F.tid, ctl + CW_CNT + lb * 64);
            SchedMoE<EHID, EHID, false> S{F.lds, (const char*)(ws + WS_H), (const char*)(ws + WS_WD), (const int*)(ws + WS_LIST)};
            EpiScatter E{F.lds, (bf16_t*)(ws + WS_YB), (const int*)(ws + WS_LIST)};
            pg8::gemm_phase<EpiScatter, SchedMoE<EHID, EHID, false>, false, EHID, EHID, EHID>(F.lds, S, E, F.tid);
            AMP_END(7); }
        SEAM(pb + 21);
    }
    if constexpr (KIND(13)) if (IN(45)) { PHASE_ENTRY final_phase(F, P); AMP_END(13); }
#undef IN
#undef KIND
#undef SEAM
#undef PHASE_ENTRY
}

#if !MK_ONE_LAUNCH
static int phase_kind(int ph) { if (ph == 0) return 0; if (ph == 45) return 13; static const int k22[22] = {1, 2, 3, 4, 5, 16, 17, 6, 7, 1, 8, 9, 10, 11, 14, 15, 4, 5, 16, 17, 6, 7}; return k22[(ph - 1) % 22]; }
typedef void (*kern_t)(Params);
template <unsigned KM> static kern_t kern_of() { return mega<KM>; }
static kern_t kind_kernel(int kind) {
    switch (kind) { case 0: return kern_of<1u << 0>(); case 1: return kern_of<1u << 1>(); case 2: return kern_of<1u << 2>(); case 3: return kern_of<1u << 3>(); case 4: return kern_of<1u << 4>();
        case 5: return kern_of<1u << 5>(); case 6: return kern_of<1u << 6>(); case 7: return kern_of<1u << 7>(); case 8: return kern_of<1u << 8>(); case 9: return kern_of<1u << 9>();
        case 10: return kern_of<1u << 10>(); case 11: return kern_of<1u << 11>(); case 12: return kern_of<1u << 12>(); case 14: return kern_of<1u << 14>(); case 15: return kern_of<1u << 15>(); case 16: return kern_of<1u << 16>(); case 17: return kern_of<1u << 17>(); default: return kern_of<1u << 13>(); }
}
#endif
extern "C" void kernel_launch(void* const* d_in, const int* in_sizes, int n_in, void* d_out, int out_size, void* d_ws, size_t ws_size, hipStream_t stream) {
    static int grid = 0;
    if (grid == 0) {
        if (n_in != 42 || out_size != TL * D || ws_size < WS_END) { fprintf(stderr, "kernel_launch: unexpected problem (n_in %d, out %d, ws %zu < %zu)\n", n_in, out_size, ws_size, (size_t)WS_END); grid = -1; return; }
        int dev = 0, cus = 0;
        if (hipGetDevice(&dev) != hipSuccess || hipDeviceGetAttribute(&cus, hipDeviceAttributeMultiprocessorCount, dev) != hipSuccess) { grid = -1; return; }
#if MK_ONE_LAUNCH
        if (hipFuncSetAttribute((const void*)mega<0x3ffffu>, hipFuncAttributeMaxDynamicSharedMemorySize, LDS_BYTES) != hipSuccess) { fprintf(stderr, "kernel_launch: hipFuncSetAttribute failed\n"); grid = -1; return; }
#else
        for (int k = 0; k < 18; ++k) if (hipFuncSetAttribute((const void*)kind_kernel(k), hipFuncAttributeMaxDynamicSharedMemorySize, LDS_BYTES) != hipSuccess) { fprintf(stderr, "kernel_launch: hipFuncSetAttribute failed\n"); grid = -1; return; }
#endif
        (void)hipGetLastError();
        grid = cus;
    }
    if (grid < 0) return;
    (void)hipMemsetAsync((char*)d_ws + WS_CTL, 0, CTL_BYTES, stream);
    Params p{};
    for (int i = 0; i < 42; ++i) p.in[i] = (const float*)d_in[i];
    p.out = (float*)d_out; p.ws = (unsigned char*)d_ws;
#if MK_ONE_LAUNCH
    p.ph_lo = 0; p.ph_hi = NPH;
    hipLaunchKernelGGL(mega<0x3ffffu>, dim3(grid), dim3(NTHR), LDS_BYTES, stream, p);
#else
    for (int ph = 0; ph < NPH; ++ph) { p.ph_lo = ph; p.ph_hi = ph + 1; hipLaunchKernelGGL(kind_kernel(phase_kind(ph)), dim3(grid), dim3(NTHR), LDS_BYTES, stream, p); }
#endif
}
```

```cpp
#include <hip/hip_runtime.h>
#include <cstdio>
#include <cstdint>

#define LAS __attribute__((address_space(3)))
typedef unsigned short bf16_t;
typedef short bf16x8 __attribute__((ext_vector_type(8)));
typedef float f32x4 __attribute__((ext_vector_type(4)));
typedef float f32x2 __attribute__((ext_vector_type(2)));
typedef unsigned u32x4 __attribute__((ext_vector_type(4)));
typedef unsigned u32x2 __attribute__((ext_vector_type(2)));

#ifndef CH_AMP
#define CH_AMP -1
#endif
#define CH_STAMP(i) do { if (CH_AMP >= 0) ch_t[i] = __builtin_amdgcn_s_memrealtime(); } while (0)
#ifndef AMP_MASK
#define AMP_MASK 0u
#endif
#define AMP_F 4
#ifndef MK_ONE_LAUNCH
#define MK_ONE_LAUNCH 1
#endif

constexpr int D = 1024, NBATCH = 2, SEQ = 16384, CTXL = 256, DEPTH = 4;
constexpr int TL = NBATCH * SEQ, TC = NBATCH * CTXL, T = TL + TC;
constexpr int GWID = 2048, NE = 32, EHID = 512, NH = 16, HD = 64;
constexpr int LISTCAP = T;
constexpr int MAXRT = (2 * T) / 256 + NE;
constexpr int NWAVES = 8, NTHR = 512;

constexpr size_t MiB = 1u << 20;
constexpr size_t WS_CTL = 0, CTL_BYTES = 1 * MiB;
constexpr size_t WS_MOD = 1 * MiB;
constexpr size_t WS_WIN = 2 * MiB, WS_WOUT = 18 * MiB, WS_WSP = 26 * MiB, WS_WR = 27 * MiB, WS_WK = 31 * MiB, WS_WV = 35 * MiB, WS_WO = 39 * MiB;
constexpr size_t WS_LW1 = 43 * MiB, WS_LA1 = 44 * MiB, WS_LG1 = 45 * MiB, WS_W2P = 46 * MiB, WS_A2P = 48 * MiB, WS_G2P = 50 * MiB;
constexpr size_t WS_WRT = 52 * MiB;
constexpr size_t WS_WGU = 54 * MiB, WS_WD = 118 * MiB;
constexpr size_t WS_X = 150 * MiB;
constexpr size_t WS_LIST = 280 * MiB, WS_WGT = 285 * MiB;
constexpr size_t WS_HL = 286 * MiB;
constexpr size_t WS_BIG = 351 * MiB;
constexpr size_t SZB = 65 * MiB;
constexpr size_t WS_U = WS_BIG, WS_V = WS_BIG + 2 * SZB, WS_STAT = WS_BIG + 4 * SZB;
constexpr size_t WS_XR = WS_BIG, WS_XW = WS_BIG + SZB, WS_XK = WS_BIG + 2 * SZB, WS_XV = WS_BIG + 3 * SZB, WS_XA = WS_BIG + 4 * SZB, WS_XG = WS_BIG + 5 * SZB;
constexpr size_t WS_R = WS_BIG + 6 * SZB, WS_K = WS_BIG + 7 * SZB, WS_VV = WS_BIG + 8 * SZB;
constexpr size_t WS_TW = WS_BIG + 9 * SZB, WS_TA = WS_TW + 17 * MiB, WS_TG = WS_TA + 17 * MiB;
constexpr size_t WS_ELOG0 = WS_XR, WS_ELOG1 = WS_XW, WS_KM0 = WS_XK, WS_KM1 = WS_XV, WS_AS0 = WS_XA, WS_AS1 = WS_XG;
constexpr size_t WS_GATE = WS_HL, WS_YG = WS_AS0, WS_BON = WS_TG + 17 * MiB;
constexpr size_t WS_H = WS_BIG, WS_YB = WS_BIG + 73 * MiB, WS_LG = WS_BIG + 204 * MiB;
constexpr size_t WS_PQ = WS_KM0;
constexpr size_t WS_SST = WS_WGU;
constexpr size_t WS_END = WS_BON + 5 * MiB;
static_assert(WS_END <= 1080 * MiB, "workspace map");
constexpr int CW_BAR = 4096;
constexpr int CW_CNT = 16384;

__device__ __forceinline__ int wave_sgpr_now(int w) { asm volatile("" : "+s"(w)); return w; }
__device__ __forceinline__ int lane_id_now() { int l; asm volatile("v_mbcnt_lo_u32_b32 %0, -1, 0\n\tv_mbcnt_hi_u32_b32 %0, -1, %0" : "=v"(l)); return l; }
typedef short v4s __attribute__((ext_vector_type(4)));
#define LDS_BARRIER() asm volatile("s_waitcnt lgkmcnt(0)\n\ts_barrier" ::: "memory")
typedef __bf16 bf16x2_t __attribute__((ext_vector_type(2)));
__device__ __forceinline__ unsigned cvt_pk_bf16(float lo, float hi) { const bf16x2_t v = __builtin_convertvector((f32x2){lo, hi}, bf16x2_t); return __builtin_bit_cast(unsigned, v); }
__device__ __forceinline__ float bf_lo(unsigned u) { return __uint_as_float(u << 16); }
__device__ __forceinline__ float bf_hi(unsigned u) { return __uint_as_float(u & 0xffff0000u); }
__device__ __forceinline__ float bf1(bf16_t b) { return __uint_as_float(((unsigned)b) << 16); }
__device__ __forceinline__ bf16_t f2bf(float f) { return (bf16_t)(cvt_pk_bf16(f, 0.f) & 0x3ffffu); }
__device__ __forceinline__ void unpack8(const u32x4& w, float (&f)[8]) { f[0] = bf_lo(w.x); f[1] = bf_hi(w.x); f[2] = bf_lo(w.y); f[3] = bf_hi(w.y); f[4] = bf_lo(w.z); f[5] = bf_hi(w.z); f[6] = bf_lo(w.w); f[7] = bf_hi(w.w); }
__device__ __forceinline__ u32x4 pack8(const float (&f)[8]) { u32x4 o; o.x = cvt_pk_bf16(f[0], f[1]); o.y = cvt_pk_bf16(f[2], f[3]); o.z = cvt_pk_bf16(f[4], f[5]); o.w = cvt_pk_bf16(f[6], f[7]); return o; }
__device__ __forceinline__ float shx(float v, int m, int lane) { return __int_as_float(__builtin_amdgcn_ds_bpermute((lane ^ m) << 2, __float_as_int(v))); }
__device__ __forceinline__ float shup(float v, int d, int lane) { return __int_as_float(__builtin_amdgcn_ds_bpermute((lane - d) << 2, __float_as_int(v))); }
__device__ __forceinline__ float wave_sum(float v, int lane) {
#pragma unroll
    for (int o = 1; o < 64; o <<= 1) v += shx(v, o, lane);
    return v;
}
__device__ __forceinline__ float sigmoidf_(float x) { return 1.0f / (1.0f + __expf(-x)); }
__device__ __forceinline__ float tanhf_(float x) { const float e = __expf(2.0f * x); return 1.0f - 2.0f / (e + 1.0f); }
__device__ __forceinline__ f32x2 gelu_pk(f32x2 v) {
    const f32x2 av = __builtin_elementwise_abs(v), d = av * 0.2316418882f + 1.0f;
    f32x2 t; t.x = __builtin_amdgcn_rcpf(d.x); t.y = __builtin_amdgcn_rcpf(d.y);
    f32x2 q = t * 0.5307027145f + (-0.7265760135f); q = q * t + 0.7107068705f; q = q * t + (-0.142248368f); q = q * t + 0.127414796f; q = q * t;
    const f32x2 s = (v * v) * (-0.72134752044f);
    f32x2 e; e.x = __builtin_amdgcn_exp2f(s.x); e.y = __builtin_amdgcn_exp2f(s.y);
    const f32x2 m = v * (q * e), r = v - m;
    f32x2 o; o.x = v.x < 0.f ? m.x : r.x; o.y = v.y < 0.f ? m.y : r.y; return o;
}

#define XB_TMO      128
#define XB_XCNT(j)  (256  + 64 * (j))
#define XB_XSUB(j)  (1280 + 64 * (j))
#define XB_XGEN(j)  (2304 + 64 * (j))
#define XB_TOP      3328
#define XB_TOPGEN   3392
#define XCD_BAR_WORDS 3456
#define XB_SPIN_CAP (1u << 18)
__device__ __forceinline__ unsigned xb_ld(unsigned* p)              { return __hip_atomic_load(p, __ATOMIC_RELAXED, __HIP_MEMORY_SCOPE_AGENT); }
__device__ __forceinline__ unsigned xb_add(unsigned* p, unsigned v) { return __hip_atomic_fetch_add(p, v, __ATOMIC_RELAXED, __HIP_MEMORY_SCOPE_AGENT); }
__device__ __forceinline__ unsigned xb_xcc_id() { return (unsigned)__builtin_amdgcn_s_getreg((3 << 11) | 20) & 0xFu; }
#define XB_SPIN(cond, bar) do { unsigned _sp = 0; while (cond) { __builtin_amdgcn_s_sleep(1); \
    if ((++_sp & 255u) == 0u) { if (xb_ld(&(bar)[XB_TMO])) break; if (_sp > XB_SPIN_CAP) { atomicAdd(&(bar)[XB_TMO], 1u); break; } } } } while (0)
struct XcdBarrier { unsigned* bar; unsigned x; volatile LAS unsigned* st; };
__device__ __forceinline__ XcdBarrier xcd_barrier_post(unsigned* bar, volatile LAS unsigned* st) {
    XcdBarrier b; b.bar = bar; b.x = xb_xcc_id(); b.st = st;
    if (threadIdx.x == 0) (void)xb_add(&bar[XB_XCNT(b.x)], 1u);
    return b;
}
__device__ __forceinline__ void xcd_barrier_complete(unsigned* bar, unsigned x, unsigned& nloc, unsigned& nx) {
    const unsigned G = gridDim.x * gridDim.y * gridDim.z;
    unsigned sum, cnt, mine, sp = 0u;
    for (;;) {
        sum = 0u; cnt = 0u; mine = 0u;
#pragma unroll
        for (unsigned j = 0; j < 16; ++j) { const unsigned c = xb_ld(&bar[XB_XCNT(j)]); sum += c; cnt += (c > 0u) ? 1u : 0u; mine = (j == x) ? c : mine; }
        if (sum == G) break;
        __builtin_amdgcn_s_sleep(1);
        if ((++sp & 255u) == 0u) { if (xb_ld(&bar[XB_TMO])) break; if (sp > XB_SPIN_CAP) { atomicAdd(&bar[XB_TMO], 1u); break; } }
    }
    nloc = mine > 0u ? mine : 1u; nx = cnt > 0u ? cnt : 1u;
}
template <bool FIRST> __device__ __forceinline__ void xcd_barrier(const XcdBarrier& b, const bool leader) {
    asm volatile("s_waitcnt vmcnt(0)" ::: "memory");
    __syncthreads();
    if (leader) {
        unsigned* bar = b.bar;
        __builtin_amdgcn_s_waitcnt(0);
        unsigned nloc = b.st[0], nx = b.st[1];
        if constexpr (FIRST) { if (nloc == 0u) { xcd_barrier_complete(bar, b.x, nloc, nx); b.st[0] = nloc; b.st[1] = nx; } }
        const unsigned old = xb_add(&bar[XB_XSUB(b.x)], 1u);
        const unsigned gen = old / nloc;
        if (old + 1u == (gen + 1u) * nloc) {
            __builtin_amdgcn_fence(__ATOMIC_RELEASE, "agent");
            asm volatile("s_waitcnt vmcnt(0)" ::: "memory");
            const unsigned og = xb_add(&bar[XB_TOP], 1u);
            const unsigned tg = og / nx;
            if (og + 1u == (tg + 1u) * nx) xb_add(&bar[XB_TOPGEN], 1u);
            else XB_SPIN(xb_ld(&bar[XB_TOPGEN]) == tg, bar);
            __builtin_amdgcn_fence(__ATOMIC_ACQUIRE, "agent");
            xb_add(&bar[XB_XGEN(b.x)], 1u);
            asm volatile("s_waitcnt vmcnt(0)" ::: "memory");
        } else {
            XB_SPIN(xb_ld(&bar[XB_XGEN(b.x)]) == gen, bar);
            __builtin_amdgcn_fence(__ATOMIC_ACQUIRE, "agent");
            asm volatile("s_waitcnt vmcnt(0)" ::: "memory");
        }
    }
    __syncthreads();
}

constexpr int LDS_MISC = 143360;
constexpr int LDS_DESC = LDS_MISC + 128;
constexpr int LDS_TAB = LDS_MISC + 512;
constexpr int LDS_BYTES = 147456;
namespace pg8 {
constexpr int BM = 256, BK = 64, HALF = 128, HTB = HALF * BK * 2, STAGE_BYTES = 8 * HTB, NXCD = 8, WGM = 8;
__host__ __device__ __forceinline__ int lds_byte(int r, int c) { const int st = (r >> 4) * 2 + (c >> 5), rr = r & 15, cc = c & 31, ob = rr * 64 + cc * 2; return st * 1024 + (ob ^ (((ob >> 9) & 1) << 5)); }
__host__ __device__ __forceinline__ void stage_rc(int b, int& R, int& C) { const int st = b / 1024, sb = b % 1024, swz = sb ^ (((sb >> 9) & 1) << 5); R = (st >> 1) * 16 + swz / 64; C = (st & 1) * 32 + (swz % 64) / 2; }
__host__ __device__ __forceinline__ int perm32(int rho) { const int n = rho >> 4, i = rho & 15; return 8 * (i >> 2) + 4 * n + (i & 3); }
__device__ __forceinline__ int xcd_remap(int L, int nwg) { const int q = nwg / NXCD, r = nwg % NXCD, xcd = L % NXCD, off = L / NXCD; return (xcd < r ? xcd * (q + 1) : r * (q + 1) + (xcd - r) * q) + off; }

struct Unit { int pm, pn, aux; };

template <class Epi, class Sched, bool GATHER, int K, int LDA, int LDB>
__device__ __forceinline__ void gemm_phase(LAS unsigned char* lds, const Sched& S, const Epi& E, const int tid_in) {
    int tid_ = tid_in; asm volatile("" : "+v"(tid_));
    const int tid = tid_, wid = __builtin_amdgcn_readfirstlane(tid >> 6), lane = tid & 63, wr = wid >> 2, wc = wid & 3, fr = lane & 15, fq = lane >> 4;
    constexpr int nt = K / BK;
    unsigned voffA[2], voffB[2];
#pragma unroll
    for (int i = 0; i < 2; ++i) { int R, C; stage_rc(tid * 16 + i * 8192, R, C); const int Rb = Epi::PERM ? ((R & ~31) + perm32(R & 31)) : R;
        voffA[i] = (unsigned)(R * LDA + C) * 2u; voffB[i] = (unsigned)(Rb * LDB + C) * 2u; }
    constexpr size_t kstep = (size_t)(BK * 2);
    constexpr size_t hstepA = GATHER ? (size_t)0 : (size_t)HALF * LDA * 2, hstepB = (size_t)HALF * LDB * 2;
    const unsigned ldsw = (unsigned)wid * 1024u;
    const int aoff = lds_byte(wr * 64 + fr, fq * 8), boff = lds_byte(wc * 32 + fr, fq * 8);
    unsigned gA[2][2], gN[2][2];
#define PG8_SA(b, h) (((b) * 2 + (h)) * HTB)
#define PG8_SB(b, h) ((4 + (b) * 2 + (h)) * HTB)
#define PG8_STAGEB(bufoff, gbase) do { _Pragma("unroll") for (int _i = 0; _i < 2; ++_i) \
        __builtin_amdgcn_global_load_lds((const unsigned*)((const char*)(gbase) + voffB[_i]), (LAS unsigned*)(lds + (bufoff) + ldsw + _i * 8192), 16, 0, 0); } while (0)
#define PG8_STAGEA(bufoff, gbase, h, GV) do { _Pragma("unroll") for (int _i = 0; _i < 2; ++_i) \
        __builtin_amdgcn_global_load_lds((const unsigned*)((const char*)(gbase) + (GATHER ? GV[h][_i] : voffA[_i]) + (h) * hstepA), (LAS unsigned*)(lds + (bufoff) + ldsw + _i * 8192), 16, 0, 0); } while (0)
#define PG8_LDA(dst, b, h) do { _Pragma("unroll") for (int m = 0; m < 4; ++m) _Pragma("unroll") for (int k = 0; k < 2; ++k) dst[m][k] = *(const LAS bf16x8*)(lds + PG8_SA(b, h) + aoff + m * 2048 + k * 1024); } while (0)
#define PG8_LDB(dst, b, h) do { _Pragma("unroll") for (int n = 0; n < 2; ++n) _Pragma("unroll") for (int k = 0; k < 2; ++k) dst[n][k] = *(const LAS bf16x8*)(lds + PG8_SB(b, h) + boff + n * 2048 + k * 1024); } while (0)
#define PG8_MMA(ai, bj, At, Bt) do { __builtin_amdgcn_s_setprio(1); _Pragma("unroll") for (int m = 0; m < 4; ++m) _Pragma("unroll") for (int n = 0; n < 2; ++n) _Pragma("unroll") for (int k = 0; k < 2; ++k) \
        acc[ai][bj][m][n] = __builtin_amdgcn_mfma_f32_16x16x32_bf16(Bt[n][k], At[m][k], acc[ai][bj][m][n], 0, 0, 0); __builtin_amdgcn_s_setprio(0); } while (0)
#define PG8_WAIT_V(n) asm volatile("s_waitcnt vmcnt(" #n ")" ::: "memory")
#define PG8_WAIT_L(n) asm volatile("s_waitcnt lgkmcnt(" #n ")" ::: "memory")
#define PG8_BAR __builtin_amdgcn_s_barrier()
#define PG8_SCHED __builtin_amdgcn_sched_barrier(0)
    Unit cur, nxt; int ui = 0;
    if (!S.next(0, cur)) return;
    f32x4 acc[2][2][4][2];
#pragma unroll
    for (int a = 0; a < 2; ++a)
#pragma unroll
        for (int b = 0; b < 2; ++b)
#pragma unroll
            for (int m = 0; m < 4; ++m)
#pragma unroll
                for (int n = 0; n < 2; ++n) acc[a][b][m][n] = (f32x4){0.f, 0.f, 0.f, 0.f};
    bf16x8 At[4][2], B0[2][2], B1[2][2];
    const char* cA = S.aptr(cur); const char* cB = S.bptr(cur);
    if constexpr (GATHER) { S.gather(cur, tid, gA); }
    PG8_STAGEB(PG8_SB(0, 0), cB); PG8_STAGEB(PG8_SB(0, 1), cB + hstepB); PG8_STAGEA(PG8_SA(0, 0), cA, 0, gA); PG8_STAGEA(PG8_SA(0, 1), cA, 1, gA);
    if (wr == 1) PG8_BAR;
    PG8_WAIT_V(2); PG8_BAR;
    PG8_STAGEB(PG8_SB(1, 0), cB + kstep); PG8_STAGEA(PG8_SA(1, 0), cA + kstep, 0, gA); PG8_STAGEB(PG8_SB(1, 1), cB + hstepB + kstep);
    PG8_WAIT_V(6); PG8_BAR;
    for (;;) {
        const bool has_next = S.next(ui + 1, nxt);
        const char* nA = has_next ? S.aptr(nxt) : cA; const char* nB = has_next ? S.bptr(nxt) : cB;
        if constexpr (GATHER) { if (has_next) S.gather(nxt, tid, gN); else {
#pragma unroll
            for (int h = 0; h < 2; ++h)
#pragma unroll
                for (int i = 0; i < 2; ++i) gN[h][i] = gA[h][i]; } }
#pragma nounroll
        for (int t = 0; t < nt; t += 2) {
            const bool last = (t == nt - 2);
            const char* a1 = cA + (size_t)(t + 1) * kstep;
            const char* a2 = last ? nA : cA + (size_t)(t + 2) * kstep; const char* b2 = last ? nB : cB + (size_t)(t + 2) * kstep;
            const char* a3 = a2 + kstep; const char* b3 = b2 + kstep;
            unsigned g2[2][2];
            if constexpr (GATHER) {
#pragma unroll
                for (int h = 0; h < 2; ++h)
#pragma unroll
                    for (int i = 0; i < 2; ++i) g2[h][i] = last ? gN[h][i] : gA[h][i]; }
            PG8_LDB(B0, 0, 0); PG8_LDB(B1, 0, 1); PG8_SCHED; PG8_LDA(At, 0, 0); PG8_STAGEA(PG8_SA(1, 1), a1, 1, gA);
            PG8_WAIT_V(8); PG8_WAIT_L(0); PG8_BAR; PG8_MMA(0, 0, At, B0); PG8_MMA(0, 1, At, B1); PG8_BAR; PG8_SCHED;
            PG8_LDA(At, 0, 1); PG8_STAGEB(PG8_SB(0, 0), b2); PG8_STAGEB(PG8_SB(0, 1), b2 + hstepB); PG8_STAGEA(PG8_SA(0, 0), a2, 0, g2);
            PG8_WAIT_V(8); PG8_WAIT_L(0); PG8_BAR; PG8_MMA(1, 0, At, B0); PG8_MMA(1, 1, At, B1); PG8_BAR; PG8_SCHED;
            PG8_LDB(B0, 1, 0); PG8_LDB(B1, 1, 1); PG8_SCHED; PG8_LDA(At, 1, 0); PG8_STAGEA(PG8_SA(0, 1), a2, 1, g2);
            PG8_WAIT_V(8); PG8_WAIT_L(0); PG8_BAR; PG8_MMA(0, 0, At, B0); PG8_MMA(0, 1, At, B1); PG8_BAR; PG8_SCHED;
            PG8_LDA(At, 1, 1); PG8_STAGEB(PG8_SB(1, 0), b3); PG8_STAGEB(PG8_SB(1, 1), b3 + hstepB); PG8_STAGEA(PG8_SA(1, 0), a3, 0, g2);
            PG8_WAIT_V(8); PG8_WAIT_L(0); PG8_BAR; PG8_MMA(1, 0, At, B0); PG8_MMA(1, 1, At, B1); PG8_BAR; PG8_SCHED;
        }
        if (wr == 0) PG8_BAR;
        E(acc, cur, wr, wc, fr, fq);
        if (!has_next) break;
#pragma unroll
        for (int a = 0; a < 2; ++a)
#pragma unroll
            for (int b = 0; b < 2; ++b)
#pragma unroll
                for (int m = 0; m < 4; ++m)
#pragma unroll
                    for (int n = 0; n < 2; ++n) acc[a][b][m][n] = (f32x4){0.f, 0.f, 0.f, 0.f};
        cur = nxt; cA = nA; cB = nB; ++ui;
        if constexpr (GATHER) {
#pragma unroll
            for (int h = 0; h < 2; ++h)
#pragma unroll
                for (int i = 0; i < 2; ++i) gA[h][i] = gN[h][i]; }
        if (wr == 1) PG8_BAR;
    }
    PG8_WAIT_V(0);
    PG8_BAR;
#undef PG8_SA
#undef PG8_SB
#undef PG8_STAGEA
#undef PG8_STAGEB
#undef PG8_LDA
#undef PG8_LDB
#undef PG8_MMA
#undef PG8_WAIT_V
#undef PG8_WAIT_L
#undef PG8_BAR
#undef PG8_SCHED
}
}
using pg8::Unit;

__device__ __forceinline__ void set_desc(LAS unsigned char* lds, int tid, int g, const void* A, const void* B, const void* C, int nN, int ldc, int aux, const void* X1 = nullptr, const void* X2 = nullptr, const void* X3 = nullptr) {
    LAS int* d = (LAS int*)(lds + LDS_DESC) + g * 16;
    if (tid == 0) { unsigned long long a = (unsigned long long)A, b = (unsigned long long)B, c = (unsigned long long)C, x1 = (unsigned long long)X1, x2 = (unsigned long long)X2, x3 = (unsigned long long)X3;
        asm volatile("" : "+s"(a), "+s"(b), "+s"(c), "+s"(x1), "+s"(x2), "+s"(x3), "+s"(nN), "+s"(ldc), "+s"(aux));
        d[0] = (int)(unsigned)a; d[1] = (int)(unsigned)(a >> 32); d[2] = (int)(unsigned)b; d[3] = (int)(unsigned)(b >> 32); d[4] = (int)(unsigned)c; d[5] = (int)(unsigned)(c >> 32); d[6] = nN; d[7] = ldc; d[8] = aux;
        d[10] = (int)(unsigned)x1; d[11] = (int)(unsigned)(x1 >> 32); d[12] = (int)(unsigned)x2; d[13] = (int)(unsigned)(x2 >> 32); d[14] = (int)(unsigned)x3; d[15] = (int)(unsigned)(x3 >> 32); }
}
__device__ __forceinline__ int desc_i(LAS unsigned char* lds, int g, int f) { return __builtin_amdgcn_readfirstlane(((LAS const int*)(lds + LDS_DESC))[g * 16 + f]); }
__device__ __forceinline__ const char* desc_p(LAS unsigned char* lds, int g, int f) {
    const unsigned lo = (unsigned)desc_i(lds, g, f), hi = (unsigned)desc_i(lds, g, f + 1); return (const char*)(((unsigned long long)hi << 32) | lo); }
template <int LDA, int LDB>
struct SchedMulti {
    LAS unsigned char* lds; int nM, ntot, ng;
    __device__ __forceinline__ bool next(int i, Unit& u) const {
        const int nwg = nM * ntot; const long L = (long)i * gridDim.x + blockIdx.x; if (L >= nwg) return false;
        const int wgid = pg8::xcd_remap((int)L, nwg);
        const int nig = pg8::WGM * ntot, gid = wgid / nig, fm = gid * pg8::WGM, gsz = (nM - fm) < pg8::WGM ? (nM - fm) : pg8::WGM;
        u.pm = fm + ((wgid % nig) % gsz); int pv = (wgid % nig) / gsz; int g = 0;
        for (int j = 0; j + 1 < ng; ++j) { const int n = desc_i(lds, j, 6); if (pv < n) break; pv -= n; g = j + 1; }
        u.pn = pv; u.aux = g; return true;
    }
    __device__ __forceinline__ const char* aptr(const Unit& u) const { return desc_p(lds, u.aux, 0) + (size_t)u.pm * (512 * LDA); }
    __device__ __forceinline__ const char* bptr(const Unit& u) const { return desc_p(lds, u.aux, 2) + (size_t)u.pn * (512 * LDB); }
};
template <int LDA, int LDB, bool GATHERED>
struct SchedMoE {
    LAS unsigned char* lds; const char* Abase; const char* Bbase; const int* list;
    __device__ __forceinline__ bool next(int i, Unit& u) const {
        LAS const int* tab = (LAS const int*)(lds + LDS_TAB);
        const int nrt = __builtin_amdgcn_readfirstlane(tab[2 * MAXRT + 32]);
        const int nwg = nrt * 4; const long L = (long)i * gridDim.x + blockIdx.x; if (L >= nwg) return false;
        const int wgid = pg8::xcd_remap((int)L, nwg);
        u.pm = wgid >> 2; u.pn = wgid & 3; u.aux = __builtin_amdgcn_readfirstlane(tab[u.pm]); return true;
    }
    __device__ __forceinline__ const char* aptr(const Unit& u) const { return GATHERED ? Abase : Abase + (size_t)u.pm * (512 * LDA); }
    __device__ __forceinline__ const char* bptr(const Unit& u) const { return Bbase + (size_t)u.aux * ((size_t)D * LDB * 2) + (size_t)u.pn * (512 * LDB); }
    __device__ __forceinline__ void gather(const Unit& u, int tid, unsigned (&g)[2][2]) const {
        LAS const int* tab = (LAS const int*)(lds + LDS_TAB);
        const int j0 = __builtin_amdgcn_readfirstlane(tab[MAXRT + u.pm]), cn = __builtin_amdgcn_readfirstlane(tab[2 * MAXRT + u.aux]);
#pragma unroll
        for (int i = 0; i < 2; ++i) { int R, C; pg8::stage_rc(tid * 16 + i * 8192, R, C);
#pragma unroll
            for (int h = 0; h < 2; ++h) { const int slot = j0 + 128 * h + R; const int a = slot < cn ? list[(size_t)u.aux * LISTCAP + slot] : 0;
                g[h][i] = (unsigned)((a >> 1) * LDA + C) * 2u; } }
    }
};
__device__ __forceinline__ void moe_tables(LAS unsigned char* lds, int tid, const unsigned* cnt) {
    LAS int* tab = (LAS int*)(lds + LDS_TAB);
    __syncthreads();
    if (tid == 0) {
        int rt = 0;
#pragma nounroll
        for (int e = 0; e < NE; ++e) { const int c = (int)__hip_atomic_load(cnt + e, __ATOMIC_RELAXED, __HIP_MEMORY_SCOPE_AGENT); tab[2 * MAXRT + e] = c;
            const int nt = (c + 255) >> 8;
#pragma nounroll
            for (int j = 0; j < nt; ++j) { tab[rt] = e; tab[MAXRT + rt] = j * 256; ++rt; } }
        tab[2 * MAXRT + 32] = rt;
    }
    __syncthreads();
}

#define EPI_FENCE() asm volatile("" ::: "memory")
struct EpiGelu {
    static constexpr bool PERM = true;
    LAS unsigned char* lds;
    __device__ __forceinline__ void operator()(const f32x4 (&acc)[2][2][4][2], const Unit& u, int wr, int wc, int fr, int fq) const {
        const bool isv = u.pn >= 8; bf16_t* base = (bf16_t*)desc_p(lds, 0, isv ? 10 : 4); const float* bias = (const float*)desc_p(lds, 0, 12); float* stat = (float*)desc_p(lds, 0, 14);
        const int col0 = (u.pn & 7) * 256 + wc * 32 + 8 * fq, bcol0 = u.pn * 256 + wc * 32 + 8 * fq, row0 = u.pm * 256 + wr * 64 + fr;
        f32x4 bv[2][2];
#pragma unroll
        for (int bj = 0; bj < 2; ++bj)
#pragma unroll
            for (int n = 0; n < 2; ++n) bv[bj][n] = *(const f32x4*)(bias + bcol0 + bj * 128 + 4 * n);
#pragma unroll
        for (int ai = 0; ai < 2; ++ai)
#pragma unroll
            for (int m = 0; m < 4; ++m) { const int row = row0 + ai * 128 + m * 16; bf16_t* rowp = base + (size_t)row * GWID + col0; float s = 0.f, q = 0.f;
#pragma unroll
                for (int bj = 0; bj < 2; ++bj) { const f32x4 v0 = acc[ai][bj][m][0] + bv[bj][0], v1 = acc[ai][bj][m][1] + bv[bj][1];
                    const f32x2 a = gelu_pk((f32x2){v0[0], v0[1]}), b = gelu_pk((f32x2){v0[2], v0[3]}), c = gelu_pk((f32x2){v1[0], v1[1]}), d = gelu_pk((f32x2){v1[2], v1[3]});
                    s += ((a.x + a.y) + (b.x + b.y)) + ((c.x + c.y) + (d.x + d.y));
                    q += ((a.x * a.x + a.y * a.y) + (b.x * b.x + b.y * b.y)) + ((c.x * c.x + c.y * c.y) + (d.x * d.x + d.y * d.y));
                    u32x4 w; w.x = cvt_pk_bf16(a.x, a.y); w.y = cvt_pk_bf16(b.x, b.y); w.z = cvt_pk_bf16(c.x, c.y); w.w = cvt_pk_bf16(d.x, d.y);
                    *(u32x4*)(rowp + bj * 128) = w; }
                if (isv) { const int ln_ = 16 * fq + fr; s += shx(s, 16, ln_); s += shx(s, 32, ln_); q += shx(q, 16, ln_); q += shx(q, 32, ln_);
                    if (fq == 0) *(f32x2*)(stat + ((size_t)row * 32 + (u.pn - 8) * 4 + wc) * 2) = (f32x2){s, q}; } }
    }
};
struct EpiResid {
    static constexpr bool PERM = true;
    LAS unsigned char* lds;
    __device__ __forceinline__ void operator()(const f32x4 (&acc)[2][2][4][2], const Unit& u, int wr, int wc, int fr, int fq) const {
        const int mrow = u.pm < 64 ? 0 : (u.pm < 128 ? 1 : 2);
        bf16_t* x = (bf16_t*)desc_p(lds, 0, 4) + (size_t)(u.pm * 256 + wr * 64 + fr) * D + u.pn * 256 + wc * 32 + 8 * fq;
        const float* bias = (const float*)desc_p(lds, 0, 14); const float* gate = (const float*)desc_p(lds, 1, 10) + mrow * 6 * D + u.pn * 256 + wc * 32 + 8 * fq;
        if (bias) bias += u.pn * 256 + wc * 32 + 8 * fq;
#pragma unroll
        for (int bj = 0; bj < 2; ++bj) {
#pragma unroll
            for (int n = 0; n < 2; ++n) { const int c = bj * 128 + 4 * n;
                const f32x4 b0 = bias ? *(const f32x4*)(bias + c) : (f32x4){0.f, 0.f, 0.f, 0.f};
                const f32x4 g0 = *(const f32x4*)(gate + c);
#pragma unroll
                for (int ai = 0; ai < 2; ++ai) {
#pragma unroll
                    for (int m = 0; m < 4; ++m) { bf16_t* p = x + (size_t)(ai * 128 + m * 16) * D + c;
                        const u32x2 w = *(const u32x2*)p; const f32x4 x0 = (f32x4){bf_lo(w.x), bf_hi(w.x), bf_lo(w.y), bf_hi(w.y)};
                        const f32x4 o0 = x0 + g0 * (acc[ai][bj][m][n] + b0);
                        u32x2 w2; w2.x = cvt_pk_bf16(o0[0], o0[1]); w2.y = cvt_pk_bf16(o0[2], o0[3]);
                        *(u32x2*)p = w2; }
                    EPI_FENCE(); } } }
    }
};
struct EpiAct {
    static constexpr bool PERM = true;
    LAS unsigned char* lds;
    __device__ __forceinline__ void operator()(const f32x4 (&acc)[2][2][4][2], const Unit& u, int wr, int wc, int fr, int fq) const {
        bf16_t* C = (bf16_t*)desc_p(lds, u.aux, 4); const int ldc = desc_i(lds, u.aux, 7), act = desc_i(lds, u.aux, 8);
        const int col0 = u.pn * 256 + wc * 32 + 8 * fq, row0 = u.pm * 256 + wr * 64 + fr;
#pragma unroll
        for (int ai = 0; ai < 2; ++ai)
#pragma unroll
            for (int m = 0; m < 4; ++m) { bf16_t* rowp = C + (size_t)(row0 + ai * 128 + m * 16) * ldc + col0;
#pragma unroll
                for (int bj = 0; bj < 2; ++bj) { f32x4 v0 = acc[ai][bj][m][0], v1 = acc[ai][bj][m][1];
                    if (act == 1) {
#pragma unroll
                        for (int j = 0; j < 4; ++j) { v0[j] = tanhf_(v0[j]); v1[j] = tanhf_(v1[j]); } }
                    else if (act == 2) {
#pragma unroll
                        for (int j = 0; j < 4; ++j) { v0[j] = sigmoidf_(v0[j]); v1[j] = sigmoidf_(v1[j]); } }
                    u32x4 w; w.x = cvt_pk_bf16(v0[0], v0[1]); w.y = cvt_pk_bf16(v0[2], v0[3]); w.z = cvt_pk_bf16(v1[0], v1[1]); w.w = cvt_pk_bf16(v1[2], v1[3]);
                    *(u32x4*)(rowp + bj * 128) = w; } }
    }
};
struct EpiLogits {
    static constexpr bool PERM = false;
    float* LG;
    __device__ __forceinline__ void operator()(const f32x4 (&acc)[2][2][4][2], const Unit& u, int wr, int wc, int fr, int fq) const {
        if (wc >= 2) return;
        const int col0 = wc * 32 + 4 * fq, row0 = u.pm * 256 + wr * 64 + fr;
#pragma unroll
        for (int ai = 0; ai < 2; ++ai)
#pragma unroll
            for (int m = 0; m < 4; ++m)
#pragma unroll
                for (int n = 0; n < 2; ++n) *(f32x4*)(LG + (size_t)(row0 + ai * 128 + m * 16) * 64 + col0 + n * 16) = acc[ai][0][m][n] + acc[ai][1][m][n];
    }
};
struct EpiSiluGate {
    static constexpr bool PERM = true;
    bf16_t* H;
    __device__ __forceinline__ void operator()(const f32x4 (&acc)[2][2][4][2], const Unit& u, int wr, int wc, int fr, int fq) const {
        const int col0 = u.pn * 128 + wc * 32 + 8 * fq, row0 = u.pm * 256 + wr * 64 + fr;
#pragma unroll
        for (int ai = 0; ai < 2; ++ai)
#pragma unroll
            for (int m = 0; m < 4; ++m) { f32x4 h0, h1;
#pragma unroll
                for (int j = 0; j < 4; ++j) { const float g0 = acc[ai][0][m][0][j], g1 = acc[ai][0][m][1][j]; h0[j] = g0 * sigmoidf_(g0) * acc[ai][1][m][0][j]; h1[j] = g1 * sigmoidf_(g1) * acc[ai][1][m][1][j]; }
                u32x4 w; w.x = cvt_pk_bf16(h0[0], h0[1]); w.y = cvt_pk_bf16(h0[2], h0[3]); w.z = cvt_pk_bf16(h1[0], h1[1]); w.w = cvt_pk_bf16(h1[2], h1[3]);
                *(u32x4*)(H + (size_t)(row0 + ai * 128 + m * 16) * EHID + col0) = w; }
    }
};
struct EpiScatter {
    static constexpr bool PERM = true;
    LAS unsigned char* lds; bf16_t* YB; const int* list;
    __device__ __forceinline__ void operator()(const f32x4 (&acc)[2][2][4][2], const Unit& u, int wr, int wc, int fr, int fq) const {
        LAS const int* tab = (LAS const int*)(lds + LDS_TAB);
        const int j0 = __builtin_amdgcn_readfirstlane(tab[MAXRT + u.pm]), cn = __builtin_amdgcn_readfirstlane(tab[2 * MAXRT + u.aux]);
        const int col0 = u.pn * 256 + wc * 32 + 8 * fq;
#pragma unroll
        for (int ai = 0; ai < 2; ++ai)
#pragma unroll
            for (int m = 0; m < 4; ++m) { const int slot = j0 + ai * 128 + wr * 64 + m * 16 + fr;
                if (slot < cn) { const int a = list[(size_t)u.aux * LISTCAP + slot]; bf16_t* rowp = YB + (size_t)a * D + col0;
#pragma unroll
                    for (int bj = 0; bj < 2; ++bj) { const f32x4 v0 = acc[ai][bj][m][0], v1 = acc[ai][bj][m][1];
                        u32x4 w; w.x = cvt_pk_bf16(v0[0], v0[1]); w.y = cvt_pk_bf16(v0[2], v0[3]); w.z = cvt_pk_bf16(v1[0], v1[1]); w.w = cvt_pk_bf16(v1[2], v1[3]);
                        *(u32x4*)(rowp + bj * 128) = w; } } }
    }
};

struct Params { const float* in[42]; float* out; unsigned char* ws; int ph_lo, ph_hi; };
enum { I_X = 0, I_C, I_CTX, I_CCTX, I_ADAW, I_ADAB, I_N1G, I_N2G, I_FG, I_GWIN, I_GBIN, I_GLNG, I_GLNB, I_GWS, I_GBS, I_GWOUT, I_GBOUT,
       I_MU, I_WR, I_WK, I_WV, I_WO, I_W0, I_W1, I_W2, I_A0, I_A1, I_A2, I_G1, I_G2, I_KK, I_KA, I_RK, I_LNG, I_LNB,
       I_MWGRP, I_MBGRP, I_MWEXP, I_MBEXP, I_MWG, I_MWU, I_MWD };
struct Frame { LAS unsigned char* lds; int tid, lane, wave, G, gw, NGW; };
typedef const __attribute__((address_space(4))) Params* KP;

constexpr int TRP = 36, TR_SCR = 64 * TRP * 4;
__device__ __forceinline__ void tr_item(const float* W, int N, int kmax, bf16_t* WT, int ldk, int k0, int n0, int drow0, int dk0, LAS float* scr, int lane) {
    const int n4 = lane & 7, kr = lane >> 3; f32x4 v[8];
#pragma unroll
    for (int i = 0; i < 8; ++i) { const int k = k0 + 8 * i + kr; v[i] = k < kmax ? *(const f32x4*)(W + (size_t)k * N + n0 + 4 * n4) : (f32x4){0.f, 0.f, 0.f, 0.f}; }
#pragma unroll
    for (int i = 0; i < 8; ++i) *(LAS f32x4*)(scr + (8 * i + kr) * TRP + 4 * n4) = v[i];
    asm volatile("s_waitcnt lgkmcnt(0)" ::: "memory");
    const int c = lane & 7;
#pragma unroll
    for (int j = 0; j < 4; ++j) { const int n = (lane >> 3) + 8 * j; const LAS float* sp = scr + (8 * c) * TRP + n;
        u32x4 o; o.x = cvt_pk_bf16(sp[0 * TRP], sp[1 * TRP]); o.y = cvt_pk_bf16(sp[2 * TRP], sp[3 * TRP]); o.z = cvt_pk_bf16(sp[4 * TRP], sp[5 * TRP]); o.w = cvt_pk_bf16(sp[6 * TRP], sp[7 * TRP]);
        *(u32x4*)(WT + (size_t)(drow0 + n) * ldk + dk0 + k0 + 8 * c) = o; }
    asm volatile("s_waitcnt lgkmcnt(0)" ::: "memory");
}
constexpr int LDS_JOBS = 80 * 1024, MAXJOBS = 48;
__device__ __forceinline__ void add_job(LAS int* jobs, int& nj, int& nit, const float* src, int N, int kmax, int kpad, bf16_t* dst, int ldk, int drow0, int dk0) {
    LAS int* q = jobs + nj * 12; const unsigned long long a = (unsigned long long)src, d = (unsigned long long)dst;
    q[0] = (int)(unsigned)a; q[1] = (int)(unsigned)(a >> 32); q[2] = (int)(unsigned)d; q[3] = (int)(unsigned)(d >> 32); q[4] = N; q[5] = kmax; q[6] = kpad / 64; q[7] = ldk; q[8] = drow0; q[9] = dk0; q[10] = nit;
    nit += (kpad / 64) * (N / 32); ++nj;
}
__device__ __forceinline__ void zero_fill(const Frame& F, bf16_t* p, size_t nbytes) {
    u32x4* q = (u32x4*)p; const size_t n = nbytes / 16;
    for (size_t i = (size_t)blockIdx.x * NTHR + F.tid; i < n; i += (size_t)F.G * NTHR) q[i] = (u32x4){0u, 0u, 0u, 0u};
}

__device__ __forceinline__ void prologue_phase(const Frame& F, KP P) {
    unsigned char* ws = P->ws;
    {   float* MOD = (float*)(ws + WS_MOD); LAS float* part = (LAS float*)F.lds;
        const float* c = P->in[I_C]; const float* cc = P->in[I_CCTX];
        for (int item = blockIdx.x; item < DEPTH * 24; item += F.G) {
            const int layer = item / 24, col = (item % 24) * 256 + 4 * F.lane; const float* w = P->in[I_ADAW] + (size_t)layer * D * 6 * D + col;
            f32x4 a0 = (f32x4){0.f, 0.f, 0.f, 0.f}, a1 = a0, a2 = a0;
#pragma unroll 8
            for (int i = 0; i < 128; ++i) { const int d = F.wave + 8 * i; const f32x4 wv = *(const f32x4*)(w + (size_t)d * 6 * D);
                const float c0 = c[d], c1 = c[D + d], c2 = cc[d];
                a0 += wv * (c0 * sigmoidf_(c0)); a1 += wv * (c1 * sigmoidf_(c1)); a2 += wv * (c2 * sigmoidf_(c2)); }
            __syncthreads();
            *(LAS f32x4*)(part + (F.wave * 3 + 0) * 256 + 4 * F.lane) = a0; *(LAS f32x4*)(part + (F.wave * 3 + 1) * 256 + 4 * F.lane) = a1; *(LAS f32x4*)(part + (F.wave * 3 + 2) * 256 + 4 * F.lane) = a2;
            __syncthreads();
            if (F.wave < 3) { f32x4 sacc = (f32x4){0.f, 0.f, 0.f, 0.f};
#pragma unroll
                for (int w8 = 0; w8 < 8; ++w8) sacc += *(const LAS f32x4*)(part + (w8 * 3 + F.wave) * 256 + 4 * F.lane);
                *(f32x4*)(MOD + ((size_t)layer * 3 + F.wave) * 6 * D + col) = sacc + *(const f32x4*)(P->in[I_ADAB] + (size_t)layer * 6 * D + col); }
        }
    }
    LAS int* jobs = (LAS int*)(F.lds + LDS_JOBS); LAS int* jtot = jobs + MAXJOBS * 12;
    __syncthreads();
    if (F.tid == 0) { int nj = 0, nit = 0;
        for (int j = 0; j < 2; ++j) {
            add_job(jobs, nj, nit, P->in[I_GWIN] + (size_t)j * D * 4096, 4096, D, D, (bf16_t*)(ws + WS_WIN) + (size_t)j * 4096 * D, D, 0, 0);
            add_job(jobs, nj, nit, P->in[I_GWOUT] + (size_t)j * GWID * D, D, GWID, GWID, (bf16_t*)(ws + WS_WOUT) + (size_t)j * D * GWID, GWID, 0, 0);
            add_job(jobs, nj, nit, P->in[I_WR] + (size_t)j * D * D, D, D, D, (bf16_t*)(ws + WS_WR) + (size_t)j * D * D, D, 0, 0);
            add_job(jobs, nj, nit, P->in[I_WK] + (size_t)j * D * D, D, D, D, (bf16_t*)(ws + WS_WK) + (size_t)j * D * D, D, 0, 0);
            add_job(jobs, nj, nit, P->in[I_WV] + (size_t)j * D * D, D, D, D, (bf16_t*)(ws + WS_WV) + (size_t)j * D * D, D, 0, 0);
            add_job(jobs, nj, nit, P->in[I_WO] + (size_t)j * D * D, D, D, D, (bf16_t*)(ws + WS_WO) + (size_t)j * D * D, D, 0, 0);
            for (int z = 0; z < 2; ++z) {
                add_job(jobs, nj, nit, P->in[I_W1] + ((size_t)j * 2 + z) * D * 64, 64, D, D, (bf16_t*)(ws + WS_LW1) + (size_t)j * 256 * D, D, z * 64, 0);
                add_job(jobs, nj, nit, P->in[I_A1] + ((size_t)j * 2 + z) * D * 64, 64, D, D, (bf16_t*)(ws + WS_LA1) + (size_t)j * 256 * D, D, z * 64, 0);
                add_job(jobs, nj, nit, P->in[I_W2] + ((size_t)j * 2 + z) * 64 * D, D, 64, 64, (bf16_t*)(ws + WS_W2P) + ((size_t)j * 2 + z) * D * 256, 256, 0, z * 64);
                add_job(jobs, nj, nit, P->in[I_A2] + ((size_t)j * 2 + z) * 64 * D, D, 64, 64, (bf16_t*)(ws + WS_A2P) + ((size_t)j * 2 + z) * D * 256, 256, 0, z * 64); }
            add_job(jobs, nj, nit, P->in[I_G1] + (size_t)j * D * 160, 160, D, D, (bf16_t*)(ws + WS_LG1) + (size_t)j * 256 * D, D, 0, 0);
            add_job(jobs, nj, nit, P->in[I_G2] + (size_t)j * 160 * D, D, 160, 256, (bf16_t*)(ws + WS_G2P) + (size_t)j * D * 256, 256, 0, 0); }
        jtot[0] = nj; jtot[1] = nit; }
    __syncthreads();
    {   const int nj = jtot[0], nit = jtot[1]; LAS float* scr = (LAS float*)(F.lds + F.wave * TR_SCR);
        for (int it = F.gw; it < nit; it += F.NGW) {
            int jb = 0; for (int q = 1; q < nj; ++q) if (it >= jobs[q * 12 + 10]) jb = q;
            jb = __builtin_amdgcn_readfirstlane(jb); LAS const int* q = jobs + jb * 12;
            const float* src = (const float*)(((unsigned long long)(unsigned)q[1] << 32) | (unsigned)q[0]); bf16_t* dst = (bf16_t*)(((unsigned long long)(unsigned)q[3] << 32) | (unsigned)q[2]);
            const int N = q[4], nnb = N / 32, r = it - q[10], kb = r / nnb, nb = r % nnb;
            tr_item(src, N, q[5], dst, q[7], kb * 64, nb * 32, q[8] + nb * 32, q[9], scr, F.lane); }
    }
    for (int j = 0; j < 2; ++j) {
        bf16_t* lw1 = (bf16_t*)(ws + WS_LW1) + (size_t)j * 256 * D; bf16_t* la1 = (bf16_t*)(ws + WS_LA1) + (size_t)j * 256 * D; bf16_t* lg1 = (bf16_t*)(ws + WS_LG1) + (size_t)j * 256 * D;
        zero_fill(F, lw1 + 128 * D, (size_t)128 * D * 2); zero_fill(F, la1 + 128 * D, (size_t)128 * D * 2); zero_fill(F, lg1 + 160 * D, (size_t)96 * D * 2);
        for (int z = 0; z < 2; ++z) { bf16_t* w2p = (bf16_t*)(ws + WS_W2P) + ((size_t)j * 2 + z) * D * 256; bf16_t* a2p = (bf16_t*)(ws + WS_A2P) + ((size_t)j * 2 + z) * D * 256;
            for (int idx = blockIdx.x * NTHR + F.tid; idx < D * 32; idx += F.G * NTHR) { const int n = idx >> 5, ch = idx & 31;
                if ((ch >> 3) != z) { *(u32x4*)(w2p + (size_t)n * 256 + ch * 8) = (u32x4){0u, 0u, 0u, 0u}; *(u32x4*)(a2p + (size_t)n * 256 + ch * 8) = (u32x4){0u, 0u, 0u, 0u}; } } }
    }
    {   bf16_t* wrt = (bf16_t*)(ws + WS_WRT);
        for (int idx = blockIdx.x * NTHR + F.tid; idx < DEPTH * 256 * (D / 8); idx += F.G * NTHR) { const int k0 = (idx & 127) * 8, n = (idx >> 7) & 255, layer = idx >> 15;
            const int nn = n & 127; const bool lo = n >= 128; float w[8];
#pragma unroll
            for (int e = 0; e < 8; ++e) { float x = 0.f;
                if (nn < 4) x = P->in[I_MWGRP][((size_t)layer * D + k0 + e) * 4 + nn]; else if (nn < 36) x = P->in[I_MWEXP][((size_t)layer * D + k0 + e) * NE + nn - 4];
                const float hi = bf_lo(cvt_pk_bf16(x, 0.f)); w[e] = lo ? x - hi : x; }
            *(u32x4*)(wrt + ((size_t)layer * 256 + n) * D + k0) = pack8(w); } }
    {   const float* src = P->in[I_GWS]; bf16_t* dst = (bf16_t*)(ws + WS_WSP); const int n8 = 2 * 16 * 128 * 128 / 8;
        for (int i = blockIdx.x * NTHR + F.tid; i < n8; i += F.G * NTHR) { const f32x4 a = *(const f32x4*)(src + (size_t)i * 8), b = *(const f32x4*)(src + (size_t)i * 8 + 4);
            u32x4 o; o.x = cvt_pk_bf16(a[0], a[1]); o.y = cvt_pk_bf16(a[2], a[3]); o.z = cvt_pk_bf16(b[0], b[1]); o.w = cvt_pk_bf16(b[2], b[3]); *(u32x4*)(dst + (size_t)i * 8) = o; } }
}
__device__ __forceinline__ void moe_weights_phase(const Frame& F, KP P, int layer) {
    unsigned char* ws = P->ws; LAS float* scr = (LAS float*)(F.lds + F.wave * TR_SCR);
    for (int it = F.gw; it < NE * 768; it += F.NGW) {
        const int e = it / 768, r = it % 768, m = r >> 8, q = r & 255;
        const size_t so = ((size_t)layer * NE + e) * (size_t)D * EHID;
        if (m < 2) { const int kb = q >> 4, n0 = (q & 15) * 32;
            tr_item((m == 0 ? P->in[I_MWG] : P->in[I_MWU]) + so, EHID, D, (bf16_t*)(ws + WS_WGU) + (size_t)e * D * D, D, kb * 64, n0, 256 * (n0 >> 7) + (n0 & 127) + (m == 1 ? 128 : 0), 0, scr, F.lane); }
        else { const int kb = q >> 5, n0 = (q & 31) * 32;
            tr_item(P->in[I_MWD] + so, D, EHID, (bf16_t*)(ws + WS_WD) + (size_t)e * D * EHID, EHID, kb * 64, n0, n0, 0, scr, F.lane); }
    }
}

__device__ __forceinline__ void load_xrow(KP P, const Frame& F, int layer, int row, f32x4 (&v)[4]) {
    if (layer == 0) { const float* xr = row < TL ? P->in[I_X] + (size_t)row * D : P->in[I_CTX] + (size_t)(row - TL) * D;
#pragma unroll
        for (int j = 0; j < 4; ++j) v[j] = *(const f32x4*)(xr + 4 * F.lane + 256 * j); }
    else { const bf16_t* xr = (const bf16_t*)(P->ws + WS_X) + (size_t)row * D;
#pragma unroll
        for (int j = 0; j < 4; ++j) { const u32x2 w = *(const u32x2*)(xr + 4 * F.lane + 256 * j); v[j] = (f32x4){bf_lo(w.x), bf_hi(w.x), bf_lo(w.y), bf_hi(w.y)}; } }
}
__device__ __forceinline__ void load_combine(KP P, const Frame& F, int layer, int row, int m, bool combine, f32x4 (&v)[4]) {
    load_xrow(P, F, layer, row, v);
    if (combine) {
        const bf16_t* yb = (const bf16_t*)(P->ws + WS_YB); const float* wg = (const float*)(P->ws + WS_WGT);
        const float w0 = wg[2 * row], w1 = wg[2 * row + 1]; const float* g2 = (const float*)(P->ws + WS_MOD) + ((size_t)(layer - 1) * 3 + m) * 6 * D + 5 * D;
#pragma unroll
        for (int j = 0; j < 4; ++j) { const int col = 4 * F.lane + 256 * j; const u32x2 a = *(const u32x2*)(yb + (size_t)(2 * row) * D + col), b = *(const u32x2*)(yb + (size_t)(2 * row + 1) * D + col);
            const f32x4 g = *(const f32x4*)(g2 + col);
            v[j][0] += g[0] * (w0 * bf_lo(a.x) + w1 * bf_lo(b.x)); v[j][1] += g[1] * (w0 * bf_hi(a.x) + w1 * bf_hi(b.x));
            v[j][2] += g[2] * (w0 * bf_lo(a.y) + w1 * bf_lo(b.y)); v[j][3] += g[3] * (w0 * bf_hi(a.y) + w1 * bf_hi(b.y)); }
    }
}
__device__ __forceinline__ void norm1_phase(const Frame& F, KP P, int layer) {
    const bool combine = layer > 0; bf16_t* X = (bf16_t*)(P->ws + WS_X); bf16_t* HL = (bf16_t*)(P->ws + WS_HL);
    const float* g1 = P->in[I_N1G] + (size_t)layer * D;
    for (int row = F.gw; row < T; row += F.NGW) {
        const int m = row < TL ? (row >> 14) : 2; f32x4 v[4];
        load_combine(P, F, layer, row, m, combine, v);
        {
#pragma unroll
            for (int j = 0; j < 4; ++j) { u32x2 o; o.x = cvt_pk_bf16(v[j][0], v[j][1]); o.y = cvt_pk_bf16(v[j][2], v[j][3]); *(u32x2*)(X + (size_t)row * D + 4 * F.lane + 256 * j) = o;
                v[j] = (f32x4){bf_lo(o.x), bf_hi(o.x), bf_lo(o.y), bf_hi(o.y)}; } }
        float ss = 0.f;
#pragma unroll
        for (int j = 0; j < 4; ++j) ss += (v[j][0] * v[j][0] + v[j][1] * v[j][1]) + (v[j][2] * v[j][2] + v[j][3] * v[j][3]);
        const float rstd = rsqrtf(wave_sum(ss, F.lane) * (1.0f / D) + 1e-6f);
        const float* mod = (const float*)(P->ws + WS_MOD) + ((size_t)layer * 3 + m) * 6 * D;
#pragma unroll
        for (int j = 0; j < 4; ++j) { const int col = 4 * F.lane + 256 * j; const f32x4 g = *(const f32x4*)(g1 + col), sh = *(const f32x4*)(mod + col), sc = *(const f32x4*)(mod + D + col);
            const f32x4 h = (v[j] * rstd) * g * (sc + 1.0f) + sh;
            u32x2 o; o.x = cvt_pk_bf16(h[0], h[1]); o.y = cvt_pk_bf16(h[2], h[3]); *(u32x2*)(HL + (size_t)row * D + col) = o; }
    }
}
__device__ __forceinline__ void final_phase(const Frame& F, KP P) {
    const float* fg = P->in[I_FG];
    for (int row = F.gw; row < TL; row += F.NGW) {
        const int m = row >> 14; f32x4 v[4];
        load_combine(P, F, DEPTH, row, m, true, v);
        float ss = 0.f;
#pragma unroll
        for (int j = 0; j < 4; ++j) ss += (v[j][0] * v[j][0] + v[j][1] * v[j][1]) + (v[j][2] * v[j][2] + v[j][3] * v[j][3]);
        const float rstd = rsqrtf(wave_sum(ss, F.lane) * (1.0f / D) + 1e-6f);
#pragma unroll
        for (int j = 0; j < 4; ++j) { const int col = 4 * F.lane + 256 * j; *(f32x4*)(P->out + (size_t)row * D + col) = (v[j] * rstd) * *(const f32x4*)(fg + col); }
    }
}
__device__ __forceinline__ void norm2_phase(const Frame& F, KP P, int layer) {
    const int ntok = layer == DEPTH - 1 ? TL : T; bf16_t* HL2 = (bf16_t*)(P->ws + WS_HL); const float* g2n = P->in[I_N2G] + (size_t)layer * D;
    for (int row = F.gw; row < ntok; row += F.NGW) {
        const int m = row < TL ? (row >> 14) : 2; f32x4 v[4]; load_xrow(P, F, 1, row, v);
        float ss = 0.f;
#pragma unroll
        for (int j = 0; j < 4; ++j) ss += (v[j][0] * v[j][0] + v[j][1] * v[j][1]) + (v[j][2] * v[j][2] + v[j][3] * v[j][3]);
        const float rstd = rsqrtf(wave_sum(ss, F.lane) * (1.0f / D) + 1e-6f);
        const float* mod = (const float*)(P->ws + WS_MOD) + ((size_t)layer * 3 + m) * 6 * D;
#pragma unroll
        for (int j = 0; j < 4; ++j) { const int col = 4 * F.lane + 256 * j; const f32x4 g = *(const f32x4*)(g2n + col), sh = *(const f32x4*)(mod + 3 * D + col), sc = *(const f32x4*)(mod + 4 * D + col);
            const f32x4 h = (v[j] * rstd) * g * (sc + 1.0f) + sh;
            u32x2 o; o.x = cvt_pk_bf16(h[0], h[1]); o.y = cvt_pk_bf16(h[2], h[3]); *(u32x2*)(HL2 + (size_t)row * D + col) = o; }
    }
    moe_weights_phase(F, P, layer);
}
__device__ __forceinline__ void route_phase(const Frame& F, KP P, int layer) {
    const int ntok = layer == DEPTH - 1 ? TL : T; const float* LG = (const float*)(P->ws + WS_LG);
    const float* bgrp = P->in[I_MBGRP] + layer * 4; const float* bexp = P->in[I_MBEXP] + layer * NE;
    unsigned* cnt = (unsigned*)(P->ws + WS_CTL) + CW_CNT + layer * 64; int* list = (int*)(P->ws + WS_LIST); float* wgt = (float*)(P->ws + WS_WGT);
    LAS unsigned* lcnt = (LAS unsigned*)F.lds; LAS unsigned* lbase = lcnt + 32;
    for (int r0 = blockIdx.x * NTHR; r0 < ntok; r0 += F.G * NTHR) {
        const int row = r0 + F.tid; const bool act = row < ntok;
        __syncthreads();
        if (F.tid < 32) lcnt[F.tid] = 0u;
        __syncthreads();
        int e0 = 0, e1 = 0; unsigned k0 = 0, k1 = 0;
        if (act) {
            const float* lg = LG + (size_t)row * 64; const f32x4 g4 = *(const f32x4*)lg;
            float ag[4];
#pragma unroll
            for (int i = 0; i < 4; ++i) ag[i] = g4[i] + bgrp[i];
            int grp = 0; float mx = ag[0];
#pragma unroll
            for (int i = 1; i < 4; ++i) if (ag[i] > mx) { mx = ag[i]; grp = i; }
            float den = 0.f;
#pragma unroll
            for (int i = 0; i < 4; ++i) den += __expf(ag[i] - mx);
            const float pg = 1.0f / den;
            const f32x4 e0v = *(const f32x4*)(lg + 4 + 8 * grp), e1v = *(const f32x4*)(lg + 8 + 8 * grp); const f32x4 b0v = *(const f32x4*)(bexp + 8 * grp), b1v = *(const f32x4*)(bexp + 8 * grp + 4);
            float el[8];
#pragma unroll
            for (int i = 0; i < 4; ++i) { el[i] = e0v[i] + b0v[i]; el[4 + i] = e1v[i] + b1v[i]; }
            int i0 = 0; float t0 = el[0];
#pragma unroll
            for (int i = 1; i < 8; ++i) if (el[i] > t0) { t0 = el[i]; i0 = i; }
            int i1 = -1; float t1 = -3.0e38f;
#pragma unroll
            for (int i = 0; i < 8; ++i) if (i != i0 && el[i] > t1) { t1 = el[i]; i1 = i; }
            const float p0 = 1.0f / (1.0f + __expf(t1 - t0));
            wgt[2 * row] = pg * p0; wgt[2 * row + 1] = pg * (1.0f - p0);
            e0 = grp * 8 + i0; e1 = grp * 8 + i1;
            k0 = atomicAdd((unsigned*)(lcnt + e0), 1u); k1 = atomicAdd((unsigned*)(lcnt + e1), 1u);
        }
        __syncthreads();
        if (F.tid < 32) { const unsigned c = lcnt[F.tid]; lbase[F.tid] = c ? atomicAdd(cnt + F.tid, c) : 0u; }
        __syncthreads();
        if (act) { list[(size_t)e0 * LISTCAP + lbase[e0] + k0] = 2 * row; list[(size_t)e1 * LISTCAP + lbase[e1] + k1] = 2 * row + 1; }
    }
}
__device__ __forceinline__ bf16x8 tr_frag136(const LAS bf16_t* M, int k0, int c0, int lane) {
    LAS bf16_t* p = (LAS bf16_t*)M + (k0 + 8 * (lane >> 4) + ((lane & 15) >> 2)) * 136 + c0 + 4 * (lane & 3);
    const v4s lo = __builtin_amdgcn_ds_read_tr16_b64_v4i16((LAS v4s*)p), hi = __builtin_amdgcn_ds_read_tr16_b64_v4i16((LAS v4s*)(p + 4 * 136));
    return (bf16x8){lo[0], lo[1], lo[2], lo[3], hi[0], hi[1], hi[2], hi[3]};
}
__device__ __forceinline__ void spatial_phase(const Frame& F, KP P, int j) {
    bf16_t* U = (bf16_t*)(P->ws + WS_U); const bf16_t* V = (const bf16_t*)(P->ws + WS_V); const float* stat = (const float*)(P->ws + WS_STAT);
    const bf16_t* WSP = (const bf16_t*)(P->ws + WS_WSP) + (size_t)j * 16 * 128 * 128;
    const float* lng = P->in[I_GLNG] + (size_t)j * GWID; const float* lnb = P->in[I_GLNB] + (size_t)j * GWID; const float* bs = P->in[I_GBS] + (size_t)j * 16 * 128;
    LAS bf16_t* Wt = (LAS bf16_t*)F.lds; LAS bf16_t* Vn = Wt + 128 * 136;
    LAS float* mu = (LAS float*)(F.lds + 2 * 128 * 136 * 2); LAS float* rs = mu + 128;
    const int l15 = F.lane & 15, l4 = F.lane >> 4;
    for (int item = blockIdx.x; item < (T / 128) * 4; item += F.G) {
        const int c = item >> 2, gq = item & 3, t0 = c * 128;
        LDS_BARRIER();
        if (F.tid < 128) { const int row = t0 + F.tid; float s = 0.f, q = 0.f;
#pragma unroll 8
            for (int i = 0; i < 32; ++i) { const f32x2 p = *(const f32x2*)(stat + ((size_t)row * 32 + i) * 2); s += p.x; q += p.y; }
            const float mean = s * (1.0f / GWID), var = q * (1.0f / GWID) - mean * mean; mu[F.tid] = mean; rs[F.tid] = rsqrtf(var + 1e-5f); }
#pragma nounroll
        for (int gi = 0; gi < 4; ++gi) { const int g = gq * 4 + gi;
            u32x4 wv[4], vv[4];
#pragma unroll
            for (int i = 0; i < 4; ++i) { const int idx = F.tid + NTHR * i, r = idx >> 4, seg = idx & 15;
                wv[i] = *(const u32x4*)(WSP + ((size_t)g * 128 + r) * 128 + seg * 8); vv[i] = *(const u32x4*)(V + (size_t)(t0 + r) * GWID + g * 128 + seg * 8); }
            LDS_BARRIER();
#pragma unroll
            for (int i = 0; i < 4; ++i) { const int idx = F.tid + NTHR * i, r = idx >> 4, seg = idx & 15, ch = g * 128 + seg * 8;
                *(LAS u32x4*)(Wt + r * 136 + seg * 8) = wv[i];
                float x[8], o[8]; unpack8(vv[i], x); const float m_ = mu[r], r_ = rs[r];
                const f32x4 g0 = *(const f32x4*)(lng + ch), g1 = *(const f32x4*)(lng + ch + 4), b0 = *(const f32x4*)(lnb + ch), b1 = *(const f32x4*)(lnb + ch + 4);
#pragma unroll
                for (int e = 0; e < 8; ++e) o[e] = (x[e] - m_) * r_ * (e < 4 ? g0[e & 3] : g1[e & 3]) + (e < 4 ? b0[e & 3] : b1[e & 3]);
                *(LAS u32x4*)(Vn + r * 136 + seg * 8) = pack8(o); }
            LDS_BARRIER();
            bf16x8 bw[4];
#pragma unroll
            for (int ks = 0; ks < 4; ++ks) bw[ks] = *(const LAS bf16x8*)(Wt + (16 * F.wave + l15) * 136 + ks * 32 + 8 * l4);
            const int p = 16 * F.wave + l15; const float bias = bs[g * 128 + p];
            bf16_t* urow = U + (size_t)(t0 + p) * GWID + g * 128 + 4 * l4;
            u32x2 uu[8];
#pragma unroll
            for (int dt = 0; dt < 8; ++dt) uu[dt] = *(const u32x2*)(urow + dt * 16);
#pragma unroll
            for (int dt = 0; dt < 8; ++dt) { f32x4 acc = (f32x4){0.f, 0.f, 0.f, 0.f};
#pragma unroll
                for (int ks = 0; ks < 4; ++ks) { const bf16x8 a = tr_frag136(Vn, 32 * ks, 16 * dt, F.lane); acc = __builtin_amdgcn_mfma_f32_16x16x32_bf16(a, bw[ks], acc, 0, 0, 0); }
                u32x2 o; o.x = cvt_pk_bf16(bf_lo(uu[dt].x) * (acc[0] + bias), bf_hi(uu[dt].x) * (acc[1] + bias)); o.y = cvt_pk_bf16(bf_lo(uu[dt].y) * (acc[2] + bias), bf_hi(uu[dt].y) * (acc[3] + bias));
                *(u32x2*)(urow + dt * 16) = o; }
        }
    }
}

__device__ __forceinline__ void mix_phase(const Frame& F, KP P, int j) {
    const bf16_t* HL = (const bf16_t*)(P->ws + WS_HL); const float* mu = P->in[I_MU] + (size_t)j * 6 * D;
    bf16_t* outs[6] = {(bf16_t*)(P->ws + WS_XR), (bf16_t*)(P->ws + WS_XW), (bf16_t*)(P->ws + WS_XK), (bf16_t*)(P->ws + WS_XV), (bf16_t*)(P->ws + WS_XA), (bf16_t*)(P->ws + WS_XG)};
    for (int row = F.gw; row < T; row += F.NGW) {
        bool ok[2]; int src[2]; const bool hi = F.lane >= 32;
        if (row < TL) { const int n = row & (SEQ - 1), gc = n & 63, gr = n >> 6;
            ok[0] = hi ? gc < 63 : gc > 0; src[0] = hi ? row + 1 : row - 1; ok[1] = hi ? gr < 255 : gr > 0; src[1] = hi ? row + 64 : row - 64; }
        else { const int n = (row - TL) & (CTXL - 1); ok[0] = n > 0; src[0] = row - 1; ok[1] = n < CTXL - 1; src[1] = row + 1; }
#pragma unroll
        for (int jj = 0; jj < 2; ++jj) { const int col = 512 * jj + 8 * F.lane;
            const u32x4 h8 = *(const u32x4*)(HL + (size_t)row * D + col); u32x4 s8 = (u32x4){0u, 0u, 0u, 0u};
            if (ok[jj]) s8 = *(const u32x4*)(HL + (size_t)src[jj] * D + col);
            const unsigned hw[4] = {h8.x, h8.y, h8.z, h8.w}, sw[4] = {s8.x, s8.y, s8.z, s8.w}; float h[8], xx[8];
#pragma unroll
            for (int e = 0; e < 8; ++e) { h[e] = (e & 1) ? bf_hi(hw[e >> 1]) : bf_lo(hw[e >> 1]); const float s = (e & 1) ? bf_hi(sw[e >> 1]) : bf_lo(sw[e >> 1]); xx[e] = s - h[e]; }
#pragma unroll
            for (int m = 0; m < 6; ++m) { const f32x4 ma = *(const f32x4*)(mu + (size_t)m * D + col), mb = *(const f32x4*)(mu + (size_t)m * D + col + 4);
                u32x4 o; o.x = cvt_pk_bf16(h[0] + xx[0] * ma[0], h[1] + xx[1] * ma[1]); o.y = cvt_pk_bf16(h[2] + xx[2] * ma[2], h[3] + xx[3] * ma[3]);
                o.z = cvt_pk_bf16(h[4] + xx[4] * mb[0], h[5] + xx[5] * mb[1]); o.w = cvt_pk_bf16(h[6] + xx[6] * mb[2], h[7] + xx[7] * mb[3]);
                *(u32x4*)(outs[m] + (size_t)row * D + col) = o; } }
    }
}

constexpr int NSC = 65, NSCAN = 64, TP = 72, TILE_B = 64 * TP * 2;
enum { T_AT = 0, T_RT, T_BT, T_KT, T_VM, T_NT, T_MT, T_NRT, T_MRT, T_APA, T_APB, T_TAA, T_TAB, T_PRB, T_QRB, T_NTILE };
constexpr int LDS_GL = T_NTILE * TILE_B, LDS_SEG = LDS_GL + 256;
static_assert(LDS_SEG + 2048 <= LDS_MISC, "scan LDS map");
__device__ __forceinline__ int scan_row(int z, int b, int p) {
    if (p < CTXL) return TL + b * CTXL + (z ? CTXL - 1 - p : p);
    const int q = p - CTXL; return b * SEQ + (z ? SEQ - 1 - q : q);
}
__device__ __forceinline__ LAS bf16_t* stile(LAS unsigned char* lds, int n) { return (LAS bf16_t*)(lds + n * TILE_B); }
__device__ __forceinline__ bf16x8 row_frag(const LAS bf16_t* M, int r0, int k0, int lane) { return *(const LAS bf16x8*)(M + (r0 + (lane & 15)) * TP + k0 + 8 * (lane >> 4)); }
__device__ __forceinline__ bf16x8 tr_frag(const LAS bf16_t* M, int k0, int c0, int lane) {
    LAS bf16_t* p = (LAS bf16_t*)M + (k0 + 8 * (lane >> 4) + ((lane & 15) >> 2)) * TP + c0 + 4 * (lane & 3);
    const v4s lo = __builtin_amdgcn_ds_read_tr16_b64_v4i16((LAS v4s*)p), hi = __builtin_amdgcn_ds_read_tr16_b64_v4i16((LAS v4s*)(p + 4 * TP));
    return (bf16x8){lo[0], lo[1], lo[2], lo[3], hi[0], hi[1], hi[2], hi[3]};
}
template <bool XT, bool YT>
__device__ __forceinline__ void mm64(const LAS bf16_t* X, const LAS bf16_t* Y, f32x4 (&acc)[2], int wq, int wh, int lane) {
#pragma unroll
    for (int ks = 0; ks < 2; ++ks) {
        const bf16x8 b = XT ? tr_frag(X, 32 * ks, 16 * wq, lane) : row_frag(X, 16 * wq, 32 * ks, lane);
#pragma unroll
        for (int q = 0; q < 2; ++q) { const int i0 = 16 * (2 * wh + q);
            const bf16x8 a = YT ? row_frag(Y, i0, 32 * ks, lane) : tr_frag(Y, 32 * ks, i0, lane);
            acc[q] = __builtin_amdgcn_mfma_f32_16x16x32_bf16(a, b, acc[q], 0, 0, 0); }
    }
}
__device__ __forceinline__ void st_tile(LAS bf16_t* Z, const f32x4 (&acc)[2], int wq, int wh, int lane) {
#pragma unroll
    for (int q = 0; q < 2; ++q) { u32x2 o; o.x = cvt_pk_bf16(acc[q][0], acc[q][1]); o.y = cvt_pk_bf16(acc[q][2], acc[q][3]);
        *(LAS u32x2*)(Z + (16 * wq + (lane & 15)) * TP + 16 * (2 * wh + q) + 4 * (lane >> 4)) = o; }
}
__device__ __forceinline__ void ld_tile(const LAS bf16_t* Z, f32x4 (&acc)[2], int wq, int wh, int lane) {
#pragma unroll
    for (int q = 0; q < 2; ++q) { const u32x2 o = *(const LAS u32x2*)(Z + (16 * wq + (lane & 15)) * TP + 16 * (2 * wh + q) + 4 * (lane >> 4));
        acc[q] = (f32x4){bf_lo(o.x), bf_hi(o.x), bf_lo(o.y), bf_hi(o.y)}; }
}
__device__ __forceinline__ f32x4 prod16(const LAS bf16_t* X, int xr, int xc, const LAS bf16_t* Y, int yr, int yc, f32x4 acc, int lane) {
    bf16x8 b = *(const LAS bf16x8*)(X + (xr + (lane & 15)) * TP + xc + 8 * (lane >> 4)); bf16x8 a = tr_frag(Y, yr, yc, lane);
    if ((lane >> 4) >= 2) { b = (bf16x8){0, 0, 0, 0, 0, 0, 0, 0}; a = (bf16x8){0, 0, 0, 0, 0, 0, 0, 0}; }
    return __builtin_amdgcn_mfma_f32_16x16x32_bf16(a, b, acc, 0, 0, 0);
}
__device__ __forceinline__ void st16(LAS bf16_t* Z, int zr, int zc, f32x4 acc, int lane) { u32x2 o; o.x = cvt_pk_bf16(acc[0], acc[1]); o.y = cvt_pk_bf16(acc[2], acc[3]); *(LAS u32x2*)(Z + (zr + (lane & 15)) * TP + zc + 4 * (lane >> 4)) = o; }
__device__ __forceinline__ f32x4 ld16(const LAS bf16_t* Z, int zr, int zc, int lane) { const u32x2 o = *(const LAS u32x2*)(Z + (zr + (lane & 15)) * TP + zc + 4 * (lane >> 4)); return (f32x4){bf_lo(o.x), bf_hi(o.x), bf_lo(o.y), bf_hi(o.y)}; }
struct ChunkRegs { u32x4 r, k, v, tw, ta; };
__device__ __forceinline__ void scan_load(KP P, const Frame& F, int item, int c4, ChunkRegs& R) {
    const int s = item & 63, sc = item >> 6, z = s >> 5, b = (s >> 4) & 1, hh = s & 15;
    const size_t row = (size_t)scan_row(z, b, sc * 256 + c4 * 64 + (F.tid >> 3)); const size_t o = row * D + hh * 64 + (F.tid & 7) * 8, o2 = row * 256 + z * 64 + (F.tid & 7) * 8;
    R.r = *(const u32x4*)((const bf16_t*)(P->ws + WS_R) + o); R.k = *(const u32x4*)((const bf16_t*)(P->ws + WS_K) + o); R.v = *(const u32x4*)((const bf16_t*)(P->ws + WS_VV) + o);
    R.tw = *(const u32x4*)((const bf16_t*)(P->ws + WS_TW) + o2); R.ta = *(const u32x4*)((const bf16_t*)(P->ws + WS_TA) + o2);
}
__device__ __forceinline__ void scan_chunk_phase(const Frame& F, KP P, int j) {
    LAS unsigned char* lds = F.lds;
    LAS bf16_t* At = stile(lds, T_AT); LAS bf16_t* Rt = stile(lds, T_RT); LAS bf16_t* Bt = stile(lds, T_BT); LAS bf16_t* Kt = stile(lds, T_KT); LAS bf16_t* Vm = stile(lds, T_VM);
    LAS bf16_t* NT = stile(lds, T_NT); LAS bf16_t* MT = stile(lds, T_MT); LAS bf16_t* NrT = stile(lds, T_NRT); LAS bf16_t* MrT = stile(lds, T_MRT);
    LAS bf16_t* ApA = stile(lds, T_APA); LAS bf16_t* ApB = stile(lds, T_APB); LAS bf16_t* TaA = stile(lds, T_TAA); LAS bf16_t* TaB = stile(lds, T_TAB);
    LAS bf16_t* PrB = stile(lds, T_PRB); LAS bf16_t* QrB = stile(lds, T_QRB);
    LAS float* gl = (LAS float*)(lds + LDS_GL); LAS float* seg = (LAS float*)(lds + LDS_SEG);
    const int lane = F.lane, wq = F.wave & 3, wh = F.wave >> 2, l15 = lane & 15, l4 = lane >> 4;
    const int pi = F.tid >> 3, kq = F.tid & 7;
    const int jrow = 16 * wq + l15;
    const int NITEM = NSCAN * NSC;
    int item = blockIdx.x; if (item >= NITEM) return;
    ChunkRegs cur, nxt; scan_load(P, F, item, 0, cur); nxt = cur;
    f32x4 Pr[2], Qr[2], aYp[2], aQp[2];
#pragma unroll
    for (int q = 0; q < 2; ++q) { Pr[q] = (f32x4){0.f, 0.f, 0.f, 0.f}; Qr[q] = Pr[q]; aYp[q] = Pr[q]; aQp[q] = Pr[q]; }
    bool pend = false; size_t orowp = 0; bf16_t* GEp = nullptr; bf16_t* YEp = nullptr; float* pqp = nullptr; bool lastp = false;
#define SCAN_STAGE_G() do { \
        f32x4 ge[2] = {(f32x4){0.f, 0.f, 0.f, 0.f}, (f32x4){0.f, 0.f, 0.f, 0.f}}; \
        mm64<false, true>(NT, PrB, ge, wq, wh, lane); mm64<false, true>(NT, QrB, aYp, wq, wh, lane); \
        f32x4 pn[2] = {(f32x4){0.f, 0.f, 0.f, 0.f}, (f32x4){0.f, 0.f, 0.f, 0.f}}; \
        mm64<false, false>(PrB, MT, pn, wq, wh, lane); mm64<false, false>(QrB, MT, aQp, wq, wh, lane); \
        _Pragma("unroll") for (int q = 0; q < 2; ++q) { const int i0 = 16 * (2 * wh + q) + 4 * l4; \
            u32x2 o; o.x = cvt_pk_bf16(ge[q][0], ge[q][1]); o.y = cvt_pk_bf16(ge[q][2], ge[q][3]); *(u32x2*)(GEp + orowp + i0) = o; \
            u32x2 y; y.x = cvt_pk_bf16(aYp[q][0], aYp[q][1]); y.y = cvt_pk_bf16(aYp[q][2], aYp[q][3]); *(u32x2*)(YEp + orowp + i0) = y; \
            Pr[q] = pn[q]; Qr[q] = aQp[q]; } \
        if (lastp) { _Pragma("unroll") for (int q = 0; q < 2; ++q) { const int i0 = 16 * (2 * wh + q) + 4 * l4; *(f32x4*)(pqp + jrow * 64 + i0) = Pr[q]; *(f32x4*)(pqp + 4096 + jrow * 64 + i0) = Qr[q]; } } \
    } while (0)
    for (;;) {
        const int s = item & 63, sc = item >> 6, z = s >> 5, b = (s >> 4) & 1, hh = s & 15;
        const float* kkw = P->in[I_KK] + (size_t)j * D + hh * 64 + kq * 8; const float* kap = P->in[I_KA] + (size_t)j * D + hh * 64 + kq * 8; const float* rkp = P->in[I_RK] + (size_t)j * D + hh * 64 + kq * 8;
        const float* w0p = P->in[I_W0] + ((size_t)j * 2 + z) * D + hh * 64; const float* a0p = P->in[I_A0] + ((size_t)j * 2 + z) * D + hh * 64;
        float* bon = (float*)(P->ws + WS_BON) + (size_t)z * T * 16;
        const u32x4 w2r = *(const u32x4*)((const bf16_t*)(P->ws + WS_W2P) + (((size_t)j * 2 + z) * D + hh * 64 + pi) * 256 + z * 64 + kq * 8);
        const u32x4 a2r = *(const u32x4*)((const bf16_t*)(P->ws + WS_A2P) + (((size_t)j * 2 + z) * D + hh * 64 + pi) * 256 + z * 64 + kq * 8);
        bf16_t* GE = (bf16_t*)(P->ws + (z ? WS_AS1 : WS_AS0)); bf16_t* YE = (bf16_t*)(P->ws + (z ? WS_ELOG1 : WS_ELOG0));
        float* pq = (float*)(P->ws + WS_PQ) + ((size_t)(s * NSC + sc) * 2) * 4096;
#pragma nounroll
        for (int c4 = 0; c4 < 4; ++c4) {
            unsigned long long ch_t[12]; ch_t[11] = CH_AMP >= 0 ? __builtin_amdgcn_s_memrealtime() : 0ull;
            *(LAS u32x4*)(ApA + pi * TP + kq * 8) = cur.tw; *(LAS u32x4*)(ApB + pi * TP + kq * 8) = cur.ta; *(LAS u32x4*)(NrT + pi * TP + kq * 8) = w2r; *(LAS u32x4*)(MrT + pi * TP + kq * 8) = a2r;
            LDS_BARRIER(); CH_STAMP(0);
            {   f32x4 lw[2] = {(f32x4){0.f, 0.f, 0.f, 0.f}, (f32x4){0.f, 0.f, 0.f, 0.f}}, la[2] = {(f32x4){0.f, 0.f, 0.f, 0.f}, (f32x4){0.f, 0.f, 0.f, 0.f}};
                mm64<false, true>(ApA, NrT, lw, wq, wh, lane); mm64<false, true>(ApB, MrT, la, wq, wh, lane);
#pragma unroll
                for (int q = 0; q < 2; ++q) { const int i0 = 16 * (2 * wh + q) + 4 * l4; const f32x4 w04 = *(const f32x4*)(w0p + i0), a04 = *(const f32x4*)(a0p + i0);
#pragma unroll
                    for (int r = 0; r < 4; ++r) { lw[q][r] = -0.60653065971f * sigmoidf_(w04[r] + lw[q][r]); la[q][r] = sigmoidf_(a04[r] + la[q][r]); } }
                st_tile(TaA, lw, wq, wh, lane); st_tile(TaB, la, wq, wh, lane); }
            LDS_BARRIER(); CH_STAMP(1);
            float r8[8], k8[8], e8[8], m8[8], a8[8], kk8[8], c8[8];
            { const u32x4 et = *(const LAS u32x4*)(TaA + pi * TP + kq * 8), at = *(const LAS u32x4*)(TaB + pi * TP + kq * 8); unpack8(cur.r, r8); unpack8(cur.k, k8); unpack8(et, e8); unpack8(at, a8); }
            {   const f32x4 ka0 = *(const f32x4*)(kap), ka1 = *(const f32x4*)(kap + 4), rk0 = *(const f32x4*)(rkp), rk1 = *(const f32x4*)(rkp + 4); float bp = 0.f;
#pragma unroll
                for (int e = 0; e < 8; ++e) { m8[e] = k8[e] * (1.0f + (a8[e] - 1.0f) * (e < 4 ? ka0[e & 3] : ka1[e & 3])); bp += r8[e] * (e < 4 ? rk0[e & 3] : rk1[e & 3]) * m8[e]; }
                bp += shx(bp, 1, lane); bp += shx(bp, 2, lane); bp += shx(bp, 4, lane);
                if (kq == 0) bon[(size_t)scan_row(z, b, sc * 256 + c4 * 64 + pi) * 16 + hh] = bp; }
            { const f32x4 w0 = *(const f32x4*)kkw, w1 = *(const f32x4*)(kkw + 4); float ss = 0.f;
#pragma unroll
              for (int e = 0; e < 8; ++e) { kk8[e] = k8[e] * (e < 4 ? w0[e & 3] : w1[e & 3]); ss += kk8[e] * kk8[e]; }
              ss += shx(ss, 1, lane); ss += shx(ss, 2, lane); ss += shx(ss, 4, lane);
              const float rn = rsqrtf(ss + 1e-12f);
#pragma unroll
              for (int e = 0; e < 8; ++e) { kk8[e] *= rn; c8[e] = e8[e]; } }
#pragma unroll
            for (int d = 8; d < 64; d <<= 1) {
#pragma unroll
                for (int e = 0; e < 8; ++e) { const float t = shup(c8[e], d, lane); c8[e] += lane >= d ? t : 0.f; } }
            if (lane >= 56) { *(LAS f32x4*)(seg + F.wave * 64 + kq * 8) = (f32x4){c8[0], c8[1], c8[2], c8[3]}; *(LAS f32x4*)(seg + F.wave * 64 + kq * 8 + 4) = (f32x4){c8[4], c8[5], c8[6], c8[7]}; }
            if (pend) { SCAN_STAGE_G(); pend = false; }
            LDS_BARRIER(); CH_STAMP(2);
            if (c4 > 0) { st_tile(PrB, Pr, wq, wh, lane); st_tile(QrB, Qr, wq, wh, lane); }
            { float cum[8];
#pragma unroll
              for (int e = 0; e < 8; ++e) cum[e] = c8[e];
              for (int w2 = 0; w2 < F.wave; ++w2) { const f32x4 o0 = *(const LAS f32x4*)(seg + w2 * 64 + kq * 8), o1 = *(const LAS f32x4*)(seg + w2 * 64 + kq * 8 + 4);
#pragma unroll
                  for (int e = 0; e < 8; ++e) cum[e] += e < 4 ? o0[e & 3] : o1[e & 3]; }
              float o[8];
#pragma unroll
              for (int e = 0; e < 8; ++e) o[e] = -kk8[e] * __expf(cum[e] - e8[e]);
              *(LAS u32x4*)(At + pi * TP + kq * 8) = pack8(o);
#pragma unroll
              for (int e = 0; e < 8; ++e) o[e] = r8[e] * __expf(cum[e]);
              *(LAS u32x4*)(Rt + pi * TP + kq * 8) = pack8(o);
              float en[8];
#pragma unroll
              for (int e = 0; e < 8; ++e) { en[e] = __expf(-cum[e]); o[e] = kk8[e] * a8[e] * en[e]; }
              *(LAS u32x4*)(Bt + pi * TP + kq * 8) = pack8(o);
#pragma unroll
              for (int e = 0; e < 8; ++e) o[e] = m8[e] * en[e];
              *(LAS u32x4*)(Kt + pi * TP + kq * 8) = pack8(o);
              *(LAS u32x4*)(Vm + pi * TP + kq * 8) = cur.v;
              if (pi == 63) {
#pragma unroll
                  for (int e = 0; e < 8; ++e) gl[kq * 8 + e] = __expf(cum[e]); } }
            { const int nitem = c4 < 3 ? item : item + (int)gridDim.x, nc4 = c4 < 3 ? c4 + 1 : 0; if (nitem < NITEM) scan_load(P, F, nitem, nc4, nxt); }
            LDS_BARRIER(); CH_STAMP(3);
            {   f32x4 aN[2], aM[2], aNr[2], aMr[2];
#pragma unroll
                for (int q = 0; q < 2; ++q) { aN[q] = (f32x4){0.f, 0.f, 0.f, 0.f}; aM[q] = aN[q]; aNr[q] = aN[q]; aMr[q] = aN[q]; }
                mm64<false, true>(At, Bt, aN, wq, wh, lane); mm64<false, true>(At, Kt, aM, wq, wh, lane); mm64<false, true>(Rt, Bt, aNr, wq, wh, lane); mm64<false, true>(Rt, Kt, aMr, wq, wh, lane);
                f32x4 aT[2];
#pragma unroll
                for (int q = 0; q < 2; ++q)
#pragma unroll
                    for (int r = 0; r < 4; ++r) { const int i = 16 * (2 * wh + q) + 4 * l4 + r; const bool lt = i < jrow, le = i <= jrow;
                        aN[q][r] = lt ? aN[q][r] : 0.f; aM[q][r] = lt ? aM[q][r] : 0.f; aNr[q][r] = le ? aNr[q][r] : 0.f; aMr[q][r] = le ? aMr[q][r] : 0.f; aT[q][r] = aN[q][r] + (i == jrow ? 1.f : 0.f); }
                st_tile(NT, aN, wq, wh, lane); st_tile(MT, aM, wq, wh, lane); st_tile(NrT, aNr, wq, wh, lane); st_tile(MrT, aMr, wq, wh, lane); st_tile(TaA, aT, wq, wh, lane);
            }
            LDS_BARRIER(); CH_STAMP(4);
            if (F.wave < 4) { const int o = 16 * F.wave, oc = 16 * ((F.wave + 1) & 3);
                f32x4 p = prod16(NT, o, o, NT, o, o, (f32x4){0.f, 0.f, 0.f, 0.f}, lane); st16(ApA, o, o, p, lane);
                f32x4 t = prod16(TaA, o, o, ApA, o, o, ld16(TaA, o, o, lane), lane); p = prod16(ApA, o, o, ApA, o, o, (f32x4){0.f, 0.f, 0.f, 0.f}, lane);
                st16(TaB, o, o, t, lane); st16(ApA, o, oc, p, lane);
                t = prod16(TaB, o, o, ApA, o, oc, ld16(TaB, o, o, lane), lane); p = prod16(ApA, o, oc, ApA, o, oc, (f32x4){0.f, 0.f, 0.f, 0.f}, lane);
                st16(TaA, o, o, t, lane); st16(ApA, o, o, p, lane);
                t = prod16(TaA, o, o, ApA, o, o, ld16(TaA, o, o, lane), lane); st16(TaB, o, o, t, lane);
#pragma unroll
                for (int jj = 1; jj < 4; ++jj) if (jj > F.wave) { u32x2 zz; asm volatile("v_mov_b32 %0, 0\n\tv_mov_b32 %1, 0" : "=v"(zz.x), "=v"(zz.y)); *(LAS u32x2*)(TaB + (o + l15) * TP + 16 * jj + 4 * l4) = zz; }
            } else { const int wq2 = F.wave - 4;
#pragma unroll
                for (int wh2 = 0; wh2 < 2; ++wh2) { f32x4 x[2] = {(f32x4){0.f, 0.f, 0.f, 0.f}, (f32x4){0.f, 0.f, 0.f, 0.f}}; mm64<true, true>(Vm, MT, x, wq2, wh2, lane); st_tile(ApB, x, wq2, wh2, lane); } }
            LDS_BARRIER(); CH_STAMP(5);
            if (F.wave < 3) { const int jj = F.wave;
#pragma unroll
                for (int i = 1; i < 4; ++i) if (i > jj) { f32x4 e = (f32x4){0.f, 0.f, 0.f, 0.f};
#pragma unroll
                    for (int m = 0; m < 3; ++m) if (m >= jj && m < i) e = prod16(NT, 16 * i, 16 * m, TaB, 16 * m, 16 * jj, e, lane);
                    st16(ApA, 16 * i, 16 * jj, e, lane);
                    st16(TaB, 16 * i, 16 * jj, prod16(TaB, 16 * i, 16 * i, ApA, 16 * i, 16 * jj, (f32x4){0.f, 0.f, 0.f, 0.f}, lane), lane); } }
            LDS_BARRIER(); CH_STAMP(6);
            {   f32x4 w[2] = {(f32x4){0.f, 0.f, 0.f, 0.f}, (f32x4){0.f, 0.f, 0.f, 0.f}}; mm64<true, true>(At, TaB, w, wq, wh, lane); st_tile(ApA, w, wq, wh, lane);
                f32x4 u[2] = {(f32x4){0.f, 0.f, 0.f, 0.f}, (f32x4){0.f, 0.f, 0.f, 0.f}}; mm64<false, true>(ApB, TaB, u, wq, wh, lane); st_tile(TaA, u, wq, wh, lane); }
            LDS_BARRIER(); CH_STAMP(7);
            f32x4 aP[2], aQ[2], aG[2], aY[2];
#pragma unroll
            for (int q = 0; q < 2; ++q) { aP[q] = (f32x4){0.f, 0.f, 0.f, 0.f}; aQ[q] = aP[q]; aG[q] = aP[q]; aY[q] = aP[q]; }
            mm64<false, false>(ApA, Bt, aP, wq, wh, lane);
            mm64<false, false>(TaA, Bt, aQ, wq, wh, lane); mm64<true, false>(Vm, Kt, aQ, wq, wh, lane);
            mm64<false, true>(NrT, ApA, aG, wq, wh, lane);
            mm64<false, true>(NrT, TaA, aY, wq, wh, lane); mm64<false, false>(MrT, Vm, aY, wq, wh, lane);
#pragma unroll
            for (int q = 0; q < 2; ++q) { const int i0 = 16 * (2 * wh + q) + 4 * l4; const f32x4 g4 = *(const LAS f32x4*)(gl + i0);
                const u32x2 rr = *(const LAS u32x2*)(Rt + jrow * TP + i0);
#pragma unroll
                for (int r = 0; r < 4; ++r) { aP[q][r] = (aP[q][r] + (i0 + r == jrow ? 1.f : 0.f)) * g4[r]; aQ[q][r] *= g4[r]; }
                aG[q][0] += bf_lo(rr.x); aG[q][1] += bf_hi(rr.x); aG[q][2] += bf_lo(rr.y); aG[q][3] += bf_hi(rr.y); }
            const size_t orow = (size_t)scan_row(z, b, sc * 256 + c4 * 64 + jrow) * D + hh * 64;
            if (c4 == 0) {
#pragma unroll
                for (int q = 0; q < 2; ++q) { const int i0 = 16 * (2 * wh + q) + 4 * l4;
                    u32x2 o; o.x = cvt_pk_bf16(aG[q][0], aG[q][1]); o.y = cvt_pk_bf16(aG[q][2], aG[q][3]); *(u32x2*)(GE + orow + i0) = o;
                    u32x2 y; y.x = cvt_pk_bf16(aY[q][0], aY[q][1]); y.y = cvt_pk_bf16(aY[q][2], aY[q][3]); *(u32x2*)(YE + orow + i0) = y;
                    Pr[q] = aP[q]; Qr[q] = aQ[q]; }
            } else {
                st_tile(NT, aG, wq, wh, lane); st_tile(MT, aP, wq, wh, lane);
#pragma unroll
                for (int q = 0; q < 2; ++q) { aYp[q] = aY[q]; aQp[q] = aQ[q]; }
                pend = true; orowp = orow; GEp = GE; YEp = YE; pqp = pq; lastp = c4 == 3;
            }
            cur = nxt;
            if (CH_AMP >= 0) { const unsigned long long d_ = CH_AMP == 0 ? ch_t[0] - ch_t[11] : ch_t[CH_AMP] - ch_t[CH_AMP - 1]; const unsigned long long dl_ = __builtin_amdgcn_s_memrealtime() + 4 * d_; while (__builtin_amdgcn_s_memrealtime() < dl_) __builtin_amdgcn_s_sleep(4); }
            LDS_BARRIER(); CH_STAMP(8);
        }
        item += gridDim.x; if (item >= NITEM) break;
    }
    if (pend) { SCAN_STAGE_G(); }
#undef SCAN_STAGE_G
}
__device__ __forceinline__ void scan_carry_phase(const Frame& F, KP P) {
    if (blockIdx.x >= 4 * NSCAN) return;
    const int s = blockIdx.x >> 2, vs = blockIdx.x & 3, lane = F.lane, l15 = lane & 15, l4 = lane >> 4, v = 16 * vs + l15, T2 = F.wave;
    const float* pq = (const float*)(P->ws + WS_PQ) + (size_t)s * NSC * 2 * 4096; bf16_t* sst = (bf16_t*)(P->ws + WS_SST) + (size_t)s * NSC * 4096;
    LAS f32x4* exch = (LAS f32x4*)F.lds;
    f32x4 S[4]; float ap[4][16], qp[4][4];
#pragma unroll
    for (int t = 0; t < 4; ++t) S[t] = (f32x4){0.f, 0.f, 0.f, 0.f};
#define CARRY_LOAD(slot, step) do { const float* Pm_ = pq + (size_t)(step) * 2 * 4096; \
        _Pragma("unroll") for (int t2i = 0; t2i < 4; ++t2i) _Pragma("unroll") for (int ri = 0; ri < 4; ++ri) ap[slot][t2i * 4 + ri] = Pm_[(16 * l4 + 4 * ri + t2i) * 64 + 4 * l15 + T2]; \
        _Pragma("unroll") for (int r = 0; r < 4; ++r) qp[slot][r] = Pm_[4096 + v * 64 + 16 * l4 + 4 * r + T2]; } while (0)
#define CARRY_STORE(sc_) do { if (T2 == 0) { float o[16]; \
        _Pragma("unroll") for (int r = 0; r < 4; ++r) _Pragma("unroll") for (int t2 = 0; t2 < 4; ++t2) o[4 * r + t2] = S[t2][r]; \
        u32x4 w0, w1; w0.x = cvt_pk_bf16(o[0], o[1]); w0.y = cvt_pk_bf16(o[2], o[3]); w0.z = cvt_pk_bf16(o[4], o[5]); w0.w = cvt_pk_bf16(o[6], o[7]); \
        w1.x = cvt_pk_bf16(o[8], o[9]); w1.y = cvt_pk_bf16(o[10], o[11]); w1.z = cvt_pk_bf16(o[12], o[13]); w1.w = cvt_pk_bf16(o[14], o[15]); \
        *(u32x4*)(sst + (size_t)(sc_) * 4096 + v * 64 + 16 * l4) = w0; *(u32x4*)(sst + (size_t)(sc_) * 4096 + v * 64 + 16 * l4 + 8) = w1; } } while (0)
    if (T2 < 4) {
#pragma unroll
        for (int u = 0; u < 4; ++u) CARRY_LOAD(u, u);
    }
#pragma nounroll
    for (int sc0 = 0; sc0 < NSC - 1; sc0 += 4) {
#pragma unroll
        for (int u = 0; u < 4; ++u) { const int sc = sc0 + u;
            CARRY_STORE(sc);
            if (T2 < 4) {
                f32x4 nw = (f32x4){qp[u][0], qp[u][1], qp[u][2], qp[u][3]};
#pragma unroll
                for (int t2i = 0; t2i < 4; ++t2i)
#pragma unroll
                    for (int ri = 0; ri < 4; ++ri) nw = __builtin_amdgcn_mfma_f32_16x16x4f32(ap[u][t2i * 4 + ri], S[t2i][ri], nw, 0, 0, 0);
                if (sc + 4 < NSC - 1) CARRY_LOAD(u, sc + 4);
                exch[((u & 1) * 4 + T2) * 64 + lane] = nw;
            }
            LDS_BARRIER();
            if (T2 < 4) {
#pragma unroll
                for (int t = 0; t < 4; ++t) S[t] = exch[((u & 1) * 4 + t) * 64 + lane];
            }
        }
    }
    CARRY_STORE(NSC - 1);
#undef CARRY_LOAD
#undef CARRY_STORE
}
__device__ __forceinline__ void scan_out_phase(const Frame& F, KP P, int j) {
    const int lane = F.lane, l15 = lane & 15, l4 = lane >> 4;
    const bf16_t* GE0 = (const bf16_t*)(P->ws + WS_AS0); const bf16_t* GE1 = (const bf16_t*)(P->ws + WS_AS1); const bf16_t* YE0 = (const bf16_t*)(P->ws + WS_ELOG0); const bf16_t* YE1 = (const bf16_t*)(P->ws + WS_ELOG1);
    const bf16_t* Vb = (const bf16_t*)(P->ws + WS_VV); const float* BON = (const float*)(P->ws + WS_BON);
    const bf16_t* GT = (const bf16_t*)(P->ws + WS_GATE); bf16_t* YG = (bf16_t*)(P->ws + WS_YG);
    for (int item = F.gw; item < NBATCH * NH * NSC * 8; item += F.NGW) {
        const int hh = item & 15, oct = (item >> 4) & 7, b = (item >> 7) & 1, blk = item >> 8;
        const int sc0 = blk, sc1 = blk == 0 ? 0 : NSC - blk;
        const bf16_t* s0 = (const bf16_t*)(P->ws + WS_SST) + ((size_t)(b * 16 + hh) * NSC + sc0) * 4096; const bf16_t* s1 = (const bf16_t*)(P->ws + WS_SST) + ((size_t)(32 + b * 16 + hh) * NSC + sc1) * 4096;
        bf16x8 sa0[4][2], sa1[4][2];
#pragma unroll
        for (int vt = 0; vt < 4; ++vt) { const int v = 32 * (vt >> 1) + 8 * (l15 >> 2) + 4 * (vt & 1) + (l15 & 3);
#pragma unroll
            for (int ks = 0; ks < 2; ++ks) { sa0[vt][ks] = *(const bf16x8*)(s0 + v * 64 + 32 * ks + 8 * l4); sa1[vt][ks] = *(const bf16x8*)(s1 + v * 64 + 32 * ks + 8 * l4); } }
        f32x4 lg4[4], lb4[4];
#pragma unroll
        for (int q = 0; q < 4; ++q) { const int c = hh * 64 + 32 * (q >> 1) + 8 * l4 + 4 * (q & 1); lg4[q] = *(const f32x4*)(P->in[I_LNG] + (size_t)j * D + c); lb4[q] = *(const f32x4*)(P->in[I_LNB] + (size_t)j * D + c); }
#pragma nounroll
        for (int ti = 0; ti < 2; ++ti) {
            const int tok = (2 * oct + ti) * 16 + l15; const int row = blk == 0 ? TL + b * CTXL + tok : b * SEQ + (blk - 1) * 256 + tok;
            const size_t o = (size_t)row * D + hh * 64;
            const bf16x8 g00 = *(const bf16x8*)(GE0 + o + 8 * l4), g01 = *(const bf16x8*)(GE0 + o + 32 + 8 * l4), g10 = *(const bf16x8*)(GE1 + o + 8 * l4), g11 = *(const bf16x8*)(GE1 + o + 32 + 8 * l4);
            u32x4 la[2], lc[2], lv[2], lgt[2];
#pragma unroll
            for (int h2 = 0; h2 < 2; ++h2) { const size_t oc = o + 32 * h2 + 8 * l4;
                la[h2] = *(const u32x4*)(YE0 + oc); lc[h2] = *(const u32x4*)(YE1 + oc); lv[h2] = *(const u32x4*)(Vb + oc); lgt[h2] = *(const u32x4*)(GT + oc); }
            const float bn = BON[(size_t)row * 16 + hh] + BON[((size_t)T + row) * 16 + hh];
            __builtin_amdgcn_sched_barrier(0);
            f32x4 y[4]; float s = 0.f; f32x4 vv[4], gg[4];
#pragma unroll
            for (int vt = 0; vt < 4; ++vt) { const int h2 = vt >> 1, hf = vt & 1;
                const unsigned ax = hf ? la[h2].z : la[h2].x, ay = hf ? la[h2].w : la[h2].y, cx = hf ? lc[h2].z : lc[h2].x, cy = hf ? lc[h2].w : lc[h2].y;
                const unsigned vx = hf ? lv[h2].z : lv[h2].x, vy = hf ? lv[h2].w : lv[h2].y, gx = hf ? lgt[h2].z : lgt[h2].x, gy = hf ? lgt[h2].w : lgt[h2].y;
                f32x4 acc = (f32x4){bf_lo(ax) + bf_lo(cx), bf_hi(ax) + bf_hi(cx), bf_lo(ay) + bf_lo(cy), bf_hi(ay) + bf_hi(cy)};
                acc = __builtin_amdgcn_mfma_f32_16x16x32_bf16(sa0[vt][0], g00, acc, 0, 0, 0); acc = __builtin_amdgcn_mfma_f32_16x16x32_bf16(sa0[vt][1], g01, acc, 0, 0, 0);
                acc = __builtin_amdgcn_mfma_f32_16x16x32_bf16(sa1[vt][0], g10, acc, 0, 0, 0); acc = __builtin_amdgcn_mfma_f32_16x16x32_bf16(sa1[vt][1], g11, acc, 0, 0, 0);
                y[vt] = acc; s += (acc[0] + acc[1]) + (acc[2] + acc[3]);
                vv[vt] = (f32x4){bf_lo(vx), bf_hi(vx), bf_lo(vy), bf_hi(vy)}; gg[vt] = (f32x4){bf_lo(gx), bf_hi(gx), bf_lo(gy), bf_hi(gy)}; }
            s += shx(s, 16, lane); s += shx(s, 32, lane);
            const float mean = s * (1.0f / 64.0f); float q = 0.f;
#pragma unroll
            for (int vt = 0; vt < 4; ++vt) { const f32x4 d = y[vt] - mean; q += (d[0] * d[0] + d[1] * d[1]) + (d[2] * d[2] + d[3] * d[3]); }
            q += shx(q, 16, lane); q += shx(q, 32, lane);
            const float rstd = rsqrtf(q * (1.0f / 64.0f) + 64e-5f);
#pragma unroll
            for (int h2 = 0; h2 < 2; ++h2) { const f32x4 o0 = (((y[2 * h2] - mean) * rstd) * lg4[2 * h2] + lb4[2 * h2] + vv[2 * h2] * bn) * gg[2 * h2], o1 = (((y[2 * h2 + 1] - mean) * rstd) * lg4[2 * h2 + 1] + lb4[2 * h2 + 1] + vv[2 * h2 + 1] * bn) * gg[2 * h2 + 1];
                u32x4 w; w.x = cvt_pk_bf16(o0[0], o0[1]); w.y = cvt_pk_bf16(o0[2], o0[3]); w.z = cvt_pk_bf16(o1[0], o1[1]); w.w = cvt_pk_bf16(o1[2], o1[3]); *(u32x4*)(YG + o + 32 * h2 + 8 * l4) = w; }
        }
    }
}
__device__ __forceinline__ bool in_range(int lo, int hi, int k) { asm volatile("" : "+s"(lo), "+s"(hi)); return lo <= k && k < hi; }
constexpr int NPH = 46;
template <unsigned KMASK> __global__ void __launch_bounds__(NTHR, 2) mega(Params Pv) {
    extern __shared__ __attribute__((aligned(16))) unsigned char lds_raw[];
    Frame F0; F0.lds = (LAS unsigned char*)lds_raw; F0.tid = threadIdx.x; F0.lane = F0.tid & 63; F0.wave = __builtin_amdgcn_readfirstlane(F0.tid >> 6);
    F0.G = gridDim.x; F0.gw = blockIdx.x * NWAVES + F0.wave; F0.NGW = F0.G * NWAVES;
    LAS unsigned* misc = (LAS unsigned*)(F0.lds + LDS_MISC);
    if (F0.tid < 128) misc[F0.tid] = 0u;
    __syncthreads();
    KP P0 = (KP)__builtin_amdgcn_kernarg_segment_ptr();
    constexpr bool ALL = (KMASK == 0x3ffffu);
    const int lo = ALL ? 0 : P0->ph_lo, hi = ALL ? NPH : P0->ph_hi;
    XcdBarrier bar; bar.bar = (unsigned*)(P0->ws + WS_CTL) + CW_BAR; bar.x = 0; bar.st = (volatile LAS unsigned*)(misc + 8);
    if (ALL || hi - lo > 1) bar = xcd_barrier_post((unsigned*)(P0->ws + WS_CTL) + CW_BAR, (volatile LAS unsigned*)(misc + 8));
#define IN(k) (ALL || in_range(lo, hi, (k)))
#define KIND(q) ((KMASK >> (q)) & 1u)
#define BAR_LEADER (wave_sgpr_now(F0.wave) == 0 && lane_id_now() == 0)
#define SEAM(k) do { if (IN(k) && IN((k) + 1)) { XcdBarrier b2_ = bar; unsigned* bb_ = bar.bar; unsigned bx_ = bar.x; asm volatile("" : "+s"(bb_), "+s"(bx_)); b2_.bar = bb_; b2_.x = bx_; xcd_barrier<false>(b2_, BAR_LEADER); } } while (0)
#define AMP_T0 const unsigned long long amp_t0 = AMP_MASK ? __builtin_amdgcn_s_memrealtime() : 0ull;
#define AMP_END(kind) do { if (AMP_MASK & (1u << (kind))) { const unsigned long long t1_ = __builtin_amdgcn_s_memrealtime(), dl_ = t1_ + AMP_F * (t1_ - amp_t0); while (__builtin_amdgcn_s_memrealtime() < dl_) __builtin_amdgcn_s_sleep(8); } } while (0)
#define PHASE_ENTRY AMP_T0 KP P = P0; asm volatile("" : "+s"(P)); unsigned char* ws = P->ws; unsigned* ctl = (unsigned*)(ws + WS_CTL); (void)ctl; \
    Frame F = F0; { int l_ = lane_id_now(), w_ = F0.wave; asm volatile("" : "+s"(w_)); F.lane = l_; F.wave = w_; F.tid = w_ * 64 + l_; F.gw = blockIdx.x * NWAVES + w_; }

    if constexpr (KIND(0)) if (IN(0)) { PHASE_ENTRY prologue_phase(F, P); AMP_END(0); }
    if (IN(0) && IN(1)) { XcdBarrier b2_ = bar; unsigned* bb_ = bar.bar; unsigned bx_ = bar.x; asm volatile("" : "+s"(bb_), "+s"(bx_)); b2_.bar = bb_; b2_.x = bx_; xcd_barrier<true>(b2_, BAR_LEADER); }
    for (int lp = 0; lp < 2; ++lp) {
        const int pb = 1 + 22 * lp, la = 2 * lp, lb = 2 * lp + 1;
        if constexpr (KIND(1)) if (IN(pb + 0)) { PHASE_ENTRY norm1_phase(F, P, la); AMP_END(1); }
        SEAM(pb + 0);
        if constexpr (KIND(2)) if (IN(pb + 1)) { PHASE_ENTRY
            __syncthreads(); set_desc(F.lds, F.tid, 0, ws + WS_HL, ws + WS_WIN + (size_t)lp * 4096 * D * 2, ws + WS_U, 16, 0, 0, ws + WS_V, P->in[I_GBIN] + (size_t)lp * 4096, ws + WS_STAT); __syncthreads();
            SchedMulti<D, D> S{F.lds, T / 256, 16, 1};
            EpiGelu E{F.lds};
            pg8::gemm_phase<EpiGelu, SchedMulti<D, D>, false, D, D, D>(F.lds, S, E, F.tid);
            AMP_END(2); }
        SEAM(pb + 1);
        if constexpr (KIND(3)) if (IN(pb + 2)) { PHASE_ENTRY spatial_phase(F, P, lp); AMP_END(3); }
        SEAM(pb + 2);
        if constexpr (KIND(4)) if (IN(pb + 3)) { PHASE_ENTRY
            __syncthreads();
            { bf16_t* X = (bf16_t*)(ws + WS_X);
              set_desc(F.lds, F.tid, 0, ws + WS_U, ws + WS_WOUT + (size_t)lp * D * GWID * 2, X, 4, 0, 0, X, X + (size_t)TL * D, P->in[I_GBOUT] + (size_t)lp * D);
              set_desc(F.lds, F.tid, 1, nullptr, nullptr, nullptr, 0, 0, 0, (const float*)(ws + WS_MOD) + (size_t)la * 3 * 6 * D + 2 * D); }
            __syncthreads();
            SchedMulti<GWID, GWID> S{F.lds, T / 256, 4, 1};
            EpiResid E{F.lds};
            pg8::gemm_phase<EpiResid, SchedMulti<GWID, GWID>, false, GWID, GWID, GWID>(F.lds, S, E, F.tid);
            AMP_END(4); }
        SEAM(pb + 3);
        if constexpr (KIND(5)) if (IN(pb + 4)) { PHASE_ENTRY norm2_phase(F, P, la); AMP_END(5); }
        SEAM(pb + 4);
        if constexpr (KIND(16)) if (IN(pb + 5)) { PHASE_ENTRY
            __syncthreads(); set_desc(F.lds, F.tid, 0, ws + WS_HL, ws + WS_WRT + (size_t)la * 256 * D * 2, nullptr, 1, 0, 0); __syncthreads();
            SchedMulti<D, D> S{F.lds, (la == DEPTH - 1 ? TL : T) / 256, 1, 1};
            EpiLogits E{(float*)(ws + WS_LG)};
            pg8::gemm_phase<EpiLogits, SchedMulti<D, D>, false, D, D, D>(F.lds, S, E, F.tid);
            AMP_END(16); }
        SEAM(pb + 5);
        if constexpr (KIND(17)) if (IN(pb + 6)) { PHASE_ENTRY route_phase(F, P, la); AMP_END(17); }
        SEAM(pb + 6);
        if constexpr (KIND(6)) if (IN(pb + 7)) { PHASE_ENTRY
            moe_tables(F.lds, F.tid, ctl + CW_CNT + la * 64);
            SchedMoE<D, D, true> S{F.lds, (const char*)(ws + WS_HL), (const char*)(ws + WS_WGU), (const int*)(ws + WS_LIST)};
            EpiSiluGate E{(bf16_t*)(ws + WS_H)};
            pg8::gemm_phase<EpiSiluGate, SchedMoE<D, D, true>, true, D, D, D>(F.lds, S, E, F.tid);
            AMP_END(6); }
        SEAM(pb + 7);
        if constexpr (KIND(7)) if (IN(pb + 8)) { PHASE_ENTRY
            moe_tables(F.lds, F.tid, ctl + CW_CNT + la * 64);
            SchedMoE<EHID, EHID, false> S{F.lds, (const char*)(ws + WS_H), (const char*)(ws + WS_WD), (const int*)(ws + WS_LIST)};
            EpiScatter E{F.lds, (bf16_t*)(ws + WS_YB), (const int*)(ws + WS_LIST)};
            pg8::gemm_phase<EpiScatter, SchedMoE<EHID, EHID, false>, false, EHID, EHID, EHID>(F.lds, S, E, F.tid);
            AMP_END(7); }
        SEAM(pb + 8);
        if constexpr (KIND(1)) if (IN(pb + 9)) { PHASE_ENTRY norm1_phase(F, P, lb); AMP_END(1); }
        SEAM(pb + 9);
        if constexpr (KIND(8)) if (IN(pb + 10)) { PHASE_ENTRY mix_phase(F, P, lp); AMP_END(8); }
        SEAM(pb + 10);
        if constexpr (KIND(9)) if (IN(pb + 11)) { PHASE_ENTRY
            __syncthreads();
            set_desc(F.lds, F.tid, 0, ws + WS_XR, ws + WS_WR + (size_t)lp * D * D * 2, ws + WS_R, 4, D, 0);
            set_desc(F.lds, F.tid, 1, ws + WS_XK, ws + WS_WK + (size_t)lp * D * D * 2, ws + WS_K, 4, D, 0);
            set_desc(F.lds, F.tid, 2, ws + WS_XV, ws + WS_WV + (size_t)lp * D * D * 2, ws + WS_VV, 4, D, 0);
            set_desc(F.lds, F.tid, 3, ws + WS_XW, ws + WS_LW1 + (size_t)lp * 256 * D * 2, ws + WS_TW, 1, 256, 1);
            set_desc(F.lds, F.tid, 4, ws + WS_XA, ws + WS_LA1 + (size_t)lp * 256 * D * 2, ws + WS_TA, 1, 256, 0);
            set_desc(F.lds, F.tid, 5, ws + WS_XG, ws + WS_LG1 + (size_t)lp * 256 * D * 2, ws + WS_TG, 1, 256, 2);
            __syncthreads();
            SchedMulti<D, D> S{F.lds, T / 256, 15, 6};
            EpiAct E{F.lds};
            pg8::gemm_phase<EpiAct, SchedMulti<D, D>, false, D, D, D>(F.lds, S, E, F.tid);
            AMP_END(9); }
        SEAM(pb + 11);
        if constexpr (KIND(10)) if (IN(pb + 12)) { PHASE_ENTRY
            __syncthreads(); set_desc(F.lds, F.tid, 0, ws + WS_TG, ws + WS_G2P + (size_t)lp * D * 256 * 2, ws + WS_GATE, 4, D, 0); __syncthreads();
            SchedMulti<256, 256> S{F.lds, T / 256, 4, 1};
            EpiAct E{F.lds};
            pg8::gemm_phase<EpiAct, SchedMulti<256, 256>, false, 256, 256, 256>(F.lds, S, E, F.tid);
            AMP_END(10); }
        SEAM(pb + 12);
        if constexpr (KIND(11)) if (IN(pb + 13)) { PHASE_ENTRY scan_chunk_phase(F, P, lp); AMP_END(11); }
        SEAM(pb + 13);
        if constexpr (KIND(14)) if (IN(pb + 14)) { PHASE_ENTRY scan_carry_phase(F, P); AMP_END(14); }
        SEAM(pb + 14);
        if constexpr (KIND(15)) if (IN(pb + 15)) { PHASE_ENTRY scan_out_phase(F, P, lp); AMP_END(15); }
        SEAM(pb + 15);
        if constexpr (KIND(4)) if (IN(pb + 16)) { PHASE_ENTRY
            __syncthreads();
            { bf16_t* X = (bf16_t*)(ws + WS_X);
              set_desc(F.lds, F.tid, 0, ws + WS_YG, ws + WS_WO + (size_t)lp * D * D * 2, X, 4, 0, 0, X, X + (size_t)TL * D, nullptr);
              set_desc(F.lds, F.tid, 1, nullptr, nullptr, nullptr, 0, 0, 0, (const float*)(ws + WS_MOD) + (size_t)lb * 3 * 6 * D + 2 * D); }
            __syncthreads();
            SchedMulti<D, D> S{F.lds, T / 256, 4, 1};
            EpiResid E{F.lds};
            pg8::gemm_phase<EpiResid, SchedMulti<D, D>, false, D, D, D>(F.lds, S, E, F.tid);
            AMP_END(4); }
        SEAM(pb + 16);
        if constexpr (KIND(5)) if (IN(pb + 17)) { PHASE_ENTRY norm2_phase(F, P, lb); AMP_END(5); }
        SEAM(pb + 17);
        if constexpr (KIND(16)) if (IN(pb + 18)) { PHASE_ENTRY
            __syncthreads(); set_desc(F.lds, F.tid, 0, ws + WS_HL, ws + WS_WRT + (size_t)lb * 256 * D * 2, nullptr, 1, 0, 0); __syncthreads();
            SchedMulti<D, D> S{F.lds, (lb == DEPTH - 1 ? TL : T) / 256, 1, 1};
            EpiLogits E{(float*)(ws + WS_LG)};
            pg8::gemm_phase<EpiLogits, SchedMulti<D, D>, false, D, D, D>(F.lds, S, E, F.tid);
            AMP_END(16); }
        SEAM(pb + 18);
        if constexpr (KIND(17)) if (IN(pb + 19)) { PHASE_ENTRY route_phase(F, P, lb); AMP_END(17); }
        SEAM(pb + 19);
        if constexpr (KIND(6)) if (IN(pb + 20)) { PHASE_ENTRY
            moe_tables(F.lds, F.tid, ctl + CW_CNT + lb * 64);
            SchedMoE<D, D, true> S{F.lds, (const char*)(ws + WS_HL), (const char*)(ws + WS_WGU), (const int*)(ws + WS_LIST)};
            EpiSiluGate E{(bf16_t*)(ws + WS_H)};
            pg8::gemm_phase<EpiSiluGate, SchedMoE<D, D, true>, true, D, D, D>(F.lds, S, E, F.tid);
            AMP_END(6); }
        SEAM(pb + 20);
        if constexpr (KIND(7)) if (IN(pb + 21)) { PHASE_ENTRY
            moe_tables(F.lds, F.tid, ctl + CW_CNT + lb * 64);
            SchedMoE<EHID, EHID, false> S{F.lds, (const char*)(ws + WS_H), (const char*)(ws + WS_WD), (const int*)(ws + WS_LIST)};
            EpiScatter E{F.lds, (bf16_t*)(ws + WS_YB), (const int*)(ws + WS_LIST)};
            pg8::gemm_phase<EpiScatter, SchedMoE<EHID, EHID, false>, false, EHID, EHID, EHID>(F.lds, S, E, F.tid);
            AMP_END(7); }
        SEAM(pb + 21);
    }
    if constexpr (KIND(13)) if (IN(45)) { PHASE_ENTRY final_phase(F, P); AMP_END(13); }
#undef IN
#undef KIND
#undef SEAM
#undef PHASE_ENTRY
}

#if !MK_ONE_LAUNCH
static int phase_kind(int ph) { if (ph == 0) return 0; if (ph == 45) return 13; static const int k22[22] = {1, 2, 3, 4, 5, 16, 17, 6, 7, 1, 8, 9, 10, 11, 14, 15, 4, 5, 16, 17, 6, 7}; return k22[(ph - 1) % 22]; }
typedef void (*kern_t)(Params);
template <unsigned KM> static kern_t kern_of() { return mega<KM>; }
static kern_t kind_kernel(int kind) {
    switch (kind) { case 0: return kern_of<1u << 0>(); case 1: return kern_of<1u << 1>(); case 2: return kern_of<1u << 2>(); case 3: return kern_of<1u << 3>(); case 4: return kern_of<1u << 4>();
        case 5: return kern_of<1u << 5>(); case 6: return kern_of<1u << 6>(); case 7: return kern_of<1u << 7>(); case 8: return kern_of<1u << 8>(); case 9: return kern_of<1u << 9>();
        case 10: return kern_of<1u << 10>(); case 11: return kern_of<1u << 11>(); case 12: return kern_of<1u << 12>(); case 14: return kern_of<1u << 14>(); case 15: return kern_of<1u << 15>(); case 16: return kern_of<1u << 16>(); case 17: return kern_of<1u << 17>(); default: return kern_of<1u << 13>(); }
}
#endif
extern "C" void kernel_launch(void* const* d_in, const int* in_sizes, int n_in, void* d_out, int out_size, void* d_ws, size_t ws_size, hipStream_t stream) {
    static int grid = 0;
    if (grid == 0) {
        if (n_in != 42 || out_size != TL * D || ws_size < WS_END) { fprintf(stderr, "kernel_launch: unexpected problem (n_in %d, out %d, ws %zu < %zu)\n", n_in, out_size, ws_size, (size_t)WS_END); grid = -1; return; }
        int dev = 0, cus = 0;
        if (hipGetDevice(&dev) != hipSuccess || hipDeviceGetAttribute(&cus, hipDeviceAttributeMultiprocessorCount, dev) != hipSuccess) { grid = -1; return; }
#if MK_ONE_LAUNCH
        if (hipFuncSetAttribute((const void*)mega<0x3ffffu>, hipFuncAttributeMaxDynamicSharedMemorySize, LDS_BYTES) != hipSuccess) { fprintf(stderr, "kernel_launch: hipFuncSetAttribute failed\n"); grid = -1; return; }
#else
        for (int k = 0; k < 18; ++k) if (hipFuncSetAttribute((const void*)kind_kernel(k), hipFuncAttributeMaxDynamicSharedMemorySize, LDS_BYTES) != hipSuccess) { fprintf(stderr, "kernel_launch: hipFuncSetAttribute failed\n"); grid = -1; return; }
#endif
        (void)hipGetLastError();
        grid = cus;
    }
    if (grid < 0) return;
    (void)hipMemsetAsync((char*)d_ws + WS_CTL, 0, CTL_BYTES, stream);
    Params p{};
    for (int i = 0; i < 42; ++i) p.in[i] = (const float*)d_in[i];
    p.out = (float*)d_out; p.ws = (unsigned char*)d_ws;
#if MK_ONE_LAUNCH
    p.ph_lo = 0; p.ph_hi = NPH;
    hipLaunchKernelGGL(mega<0x3ffffu>, dim3(grid), dim3(NTHR), LDS_BYTES, stream, p);
#else
    for (int ph = 0; ph < NPH; ++ph) { p.ph_lo = ph; p.ph_hi = ph + 1; hipLaunchKernelGGL(kind_kernel(phase_kind(ph)), dim3(grid), dim3(NTHR), LDS_BYTES, stream, p); }
#endif
}
```

```cpp
#include <hip/hip_runtime.h>
#include <cstdio>
#include <cstdint>

#define LAS __attribute__((address_space(3)))
typedef unsigned short bf16_t;
typedef short bf16x8 __attribute__((ext_vector_type(8)));
typedef float f32x4 __attribute__((ext_vector_type(4)));
typedef float f32x2 __attribute__((ext_vector_type(2)));
typedef unsigned u32x4 __attribute__((ext_vector_type(4)));
typedef unsigned u32x2 __attribute__((ext_vector_type(2)));

#ifndef CH_AMP
#define CH_AMP -1
#endif
#define CH_STAMP(i) do { if (CH_AMP >= 0) ch_t[i] = __builtin_amdgcn_s_memrealtime(); } while (0)
#ifndef AMP_MASK
#define AMP_MASK 0u
#endif
#define AMP_F 4
#ifndef MK_ONE_LAUNCH
#define MK_ONE_LAUNCH 1
#endif

constexpr int D = 1024, NBATCH = 2, SEQ = 16384, CTXL = 256, DEPTH = 4;
constexpr int TL = NBATCH * SEQ, TC = NBATCH * CTXL, T = TL + TC;
constexpr int GWID = 2048, NE = 32, EHID = 512, NH = 16, HD = 64;
constexpr int LISTCAP = T;
constexpr int MAXRT = (2 * T) / 256 + NE;
constexpr int NWAVES = 8, NTHR = 512;

constexpr size_t MiB = 1u << 20;
constexpr size_t WS_CTL = 0, CTL_BYTES = 1 * MiB;
constexpr size_t WS_MOD = 1 * MiB;
constexpr size_t WS_WIN = 2 * MiB, WS_WOUT = 18 * MiB, WS_WSP = 26 * MiB, WS_WR = 27 * MiB, WS_WK = 31 * MiB, WS_WV = 35 * MiB, WS_WO = 39 * MiB;
constexpr size_t WS_LW1 = 43 * MiB, WS_LA1 = 44 * MiB, WS_LG1 = 45 * MiB, WS_W2P = 46 * MiB, WS_A2P = 48 * MiB, WS_G2P = 50 * MiB;
constexpr size_t WS_WRT = 52 * MiB;
constexpr size_t WS_WGU = 54 * MiB, WS_WD = 118 * MiB;
constexpr size_t WS_X = 150 * MiB;
constexpr size_t WS_LIST = 280 * MiB, WS_WGT = 285 * MiB;
constexpr size_t WS_HL = 286 * MiB;
constexpr size_t WS_BIG = 351 * MiB;
constexpr size_t SZB = 65 * MiB;
constexpr size_t WS_U = WS_BIG, WS_V = WS_BIG + 2 * SZB, WS_STAT = WS_BIG + 4 * SZB;
constexpr size_t WS_XR = WS_BIG, WS_XW = WS_BIG + SZB, WS_XK = WS_BIG + 2 * SZB, WS_XV = WS_BIG + 3 * SZB, WS_XA = WS_BIG + 4 * SZB, WS_XG = WS_BIG + 5 * SZB;
constexpr size_t WS_R = WS_BIG + 6 * SZB, WS_K = WS_BIG + 7 * SZB, WS_VV = WS_BIG + 8 * SZB;
constexpr size_t WS_TW = WS_BIG + 9 * SZB, WS_TA = WS_TW + 17 * MiB, WS_TG = WS_TA + 17 * MiB;
constexpr size_t WS_ELOG0 = WS_XR, WS_ELOG1 = WS_XW, WS_KM0 = WS_XK, WS_KM1 = WS_XV, WS_AS0 = WS_XA, WS_AS1 = WS_XG;
constexpr size_t WS_GATE = WS_HL, WS_YG = WS_AS0, WS_BON = WS_TG + 17 * MiB;
constexpr size_t WS_H = WS_BIG, WS_YB = WS_BIG + 73 * MiB, WS_LG = WS_BIG + 204 * MiB;
constexpr size_t WS_PQ = WS_KM0;
constexpr size_t WS_SST = WS_WGU;
constexpr size_t WS_END = WS_BON + 5 * MiB;
static_assert(WS_END <= 1080 * MiB, "workspace map");
constexpr int CW_BAR = 4096;
constexpr int CW_CNT = 16384;

__device__ __forceinline__ int wave_sgpr_now(int w) { asm volatile("" : "+s"(w)); return w; }
__device__ __forceinline__ int lane_id_now() { int l; asm volatile("v_mbcnt_lo_u32_b32 %0, -1, 0\n\tv_mbcnt_hi_u32_b32 %0, -1, %0" : "=v"(l)); return l; }
typedef short v4s __attribute__((ext_vector_type(4)));
#define LDS_BARRIER() asm volatile("s_waitcnt lgkmcnt(0)\n\ts_barrier" ::: "memory")
typedef __bf16 bf16x2_t __attribute__((ext_vector_type(2)));
__device__ __forceinline__ unsigned cvt_pk_bf16(float lo, float hi) { const bf16x2_t v = __builtin_convertvector((f32x2){lo, hi}, bf16x2_t); return __builtin_bit_cast(unsigned, v); }
__device__ __forceinline__ float bf_lo(unsigned u) { return __uint_as_float(u << 16); }
__device__ __forceinline__ float bf_hi(unsigned u) { return __uint_as_float(u & 0xffff0000u); }
__device__ __forceinline__ float bf1(bf16_t b) { return __uint_as_float(((unsigned)b) << 16); }
__device__ __forceinline__ bf16_t f2bf(float f) { return (bf16_t)(cvt_pk_bf16(f, 0.f) & 0x3ffffu); }
__device__ __forceinline__ void unpack8(const u32x4& w, float (&f)[8]) { f[0] = bf_lo(w.x); f[1] = bf_hi(w.x); f[2] = bf_lo(w.y); f[3] = bf_hi(w.y); f[4] = bf_lo(w.z); f[5] = bf_hi(w.z); f[6] = bf_lo(w.w); f[7] = bf_hi(w.w); }
__device__ __forceinline__ u32x4 pack8(const float (&f)[8]) { u32x4 o; o.x = cvt_pk_bf16(f[0], f[1]); o.y = cvt_pk_bf16(f[2], f[3]); o.z = cvt_pk_bf16(f[4], f[5]); o.w = cvt_pk_bf16(f[6], f[7]); return o; }
__device__ __forceinline__ float shx(float v, int m, int lane) { return __int_as_float(__builtin_amdgcn_ds_bpermute((lane ^ m) << 2, __float_as_int(v))); }
__device__ __forceinline__ float shup(float v, int d, int lane) { return __int_as_float(__builtin_amdgcn_ds_bpermute((lane - d) << 2, __float_as_int(v))); }
__device__ __forceinline__ float wave_sum(float v, int lane) {
#pragma unroll
    for (int o = 1; o < 64; o <<= 1) v += shx(v, o, lane);
    return v;
}
__device__ __forceinline__ float sigmoidf_(float x) { return 1.0f / (1.0f + __expf(-x)); }
__device__ __forceinline__ float tanhf_(float x) { const float e = __expf(2.0f * x); return 1.0f - 2.0f / (e + 1.0f); }
__device__ __forceinline__ f32x2 gelu_pk(f32x2 v) {
    const f32x2 av = __builtin_elementwise_abs(v), d = av * 0.2316418882f + 1.0f;
    f32x2 t; t.x = __builtin_amdgcn_rcpf(d.x); t.y = __builtin_amdgcn_rcpf(d.y);
    f32x2 q = t * 0.5307027145f + (-0.7265760135f); q = q * t + 0.7107068705f; q = q * t + (-0.142248368f); q = q * t + 0.127414796f; q = q * t;
    const f32x2 s = (v * v) * (-0.72134752044f);
    f32x2 e; e.x = __builtin_amdgcn_exp2f(s.x); e.y = __builtin_amdgcn_exp2f(s.y);
    const f32x2 m = v * (q * e), r = v - m;
    f32x2 o; o.x = v.x < 0.f ? m.x : r.x; o.y = v.y < 0.f ? m.y : r.y; return o;
}

#define XB_TMO      128
#define XB_XCNT(j)  (256  + 64 * (j))
#define XB_XSUB(j)  (1280 + 64 * (j))
#define XB_XGEN(j)  (2304 + 64 * (j))
#define XB_TOP      3328
#define XB_TOPGEN   3392
#define XCD_BAR_WORDS 3456
#define XB_SPIN_CAP (1u << 18)
__device__ __forceinline__ unsigned xb_ld(unsigned* p)              { return __hip_atomic_load(p, __ATOMIC_RELAXED, __HIP_MEMORY_SCOPE_AGENT); }
__device__ __forceinline__ unsigned xb_add(unsigned* p, unsigned v) { return __hip_atomic_fetch_add(p, v, __ATOMIC_RELAXED, __HIP_MEMORY_SCOPE_AGENT); }
__device__ __forceinline__ unsigned xb_xcc_id() { return (unsigned)__builtin_amdgcn_s_getreg((3 << 11) | 20) & 0xFu; }
#define XB_SPIN(cond, bar) do { unsigned _sp = 0; while (cond) { __builtin_amdgcn_s_sleep(1); \
    if ((++_sp & 255u) == 0u) { if (xb_ld(&(bar)[XB_TMO])) break; if (_sp > XB_SPIN_CAP) { atomicAdd(&(bar)[XB_TMO], 1u); break; } } } } while (0)
struct XcdBarrier { unsigned* bar; unsigned x; volatile LAS unsigned* st; };
__device__ __forceinline__ XcdBarrier xcd_barrier_post(unsigned* bar, volatile LAS unsigned* st) {
    XcdBarrier b; b.bar = bar; b.x = xb_xcc_id(); b.st = st;
    if (threadIdx.x == 0) (void)xb_add(&bar[XB_XCNT(b.x)], 1u);
    return b;
}
__device__ __forceinline__ void xcd_barrier_complete(unsigned* bar, unsigned x, unsigned& nloc, unsigned& nx) {
    const unsigned G = gridDim.x * gridDim.y * gridDim.z;
    unsigned sum, cnt, mine, sp = 0u;
    for (;;) {
        sum = 0u; cnt = 0u; mine = 0u;
#pragma unroll
        for (unsigned j = 0; j < 16; ++j) { const unsigned c = xb_ld(&bar[XB_XCNT(j)]); sum += c; cnt += (c > 0u) ? 1u : 0u; mine = (j == x) ? c : mine; }
        if (sum == G) break;
        __builtin_amdgcn_s_sleep(1);
        if ((++sp & 255u) == 0u) { if (xb_ld(&bar[XB_TMO])) break; if (sp > XB_SPIN_CAP) { atomicAdd(&bar[XB_TMO], 1u); break; } }
    }
    nloc = mine > 0u ? mine : 1u; nx = cnt > 0u ? cnt : 1u;
}
template <bool FIRST> __device__ __forceinline__ void xcd_barrier(const XcdBarrier& b, const bool leader) {
    asm volatile("s_waitcnt vmcnt(0)" ::: "memory");
    __syncthreads();
    if (leader) {
        unsigned* bar = b.bar;
        __builtin_amdgcn_s_waitcnt(0);
        unsigned nloc = b.st[0], nx = b.st[1];
        if constexpr (FIRST) { if (nloc == 0u) { xcd_barrier_complete(bar, b.x, nloc, nx); b.st[0] = nloc; b.st[1] = nx; } }
        const unsigned old = xb_add(&bar[XB_XSUB(b.x)], 1u);
        const unsigned gen = old / nloc;
        if (old + 1u == (gen + 1u) * nloc) {
            __builtin_amdgcn_fence(__ATOMIC_RELEASE, "agent");
            asm volatile("s_waitcnt vmcnt(0)" ::: "memory");
            const unsigned og = xb_add(&bar[XB_TOP], 1u);
            const unsigned tg = og / nx;
            if (og + 1u == (tg + 1u) * nx) xb_add(&bar[XB_TOPGEN], 1u);
            else XB_SPIN(xb_ld(&bar[XB_TOPGEN]) == tg, bar);
            __builtin_amdgcn_fence(__ATOMIC_ACQUIRE, "agent");
            xb_add(&bar[XB_XGEN(b.x)], 1u);
            asm volatile("s_waitcnt vmcnt(0)" ::: "memory");
        } else {
            XB_SPIN(xb_ld(&bar[XB_XGEN(b.x)]) == gen, bar);
            __builtin_amdgcn_fence(__ATOMIC_ACQUIRE, "agent");
            asm volatile("s_waitcnt vmcnt(0)" ::: "memory");
        }
    }
    __syncthreads();
}

constexpr int LDS_MISC = 143360;
constexpr int LDS_DESC = LDS_MISC + 128;
constexpr int LDS_TAB = LDS_MISC + 512;
constexpr int LDS_BYTES = 147456;
namespace pg8 {
constexpr int BM = 256, BK = 64, HALF = 128, HTB = HALF * BK * 2, STAGE_BYTES = 8 * HTB, NXCD = 8, WGM = 8;
__host__ __device__ __forceinline__ int lds_byte(int r, int c) { const int st = (r >> 4) * 2 + (c >> 5), rr = r & 15, cc = c & 31, ob = rr * 64 + cc * 2; return st * 1024 + (ob ^ (((ob >> 9) & 1) << 5)); }
__host__ __device__ __forceinline__ void stage_rc(int b, int& R, int& C) { const int st = b / 1024, sb = b % 1024, swz = sb ^ (((sb >> 9) & 1) << 5); R = (st >> 1) * 16 + swz / 64; C = (st & 1) * 32 + (swz % 64) / 2; }
__host__ __device__ __forceinline__ int perm32(int rho) { const int n = rho >> 4, i = rho & 15; return 8 * (i >> 2) + 4 * n + (i & 3); }
__device__ __forceinline__ int xcd_remap(int L, int nwg) { const int q = nwg / NXCD, r = nwg % NXCD, xcd = L % NXCD, off = L / NXCD; return (xcd < r ? xcd * (q + 1) : r * (q + 1) + (xcd - r) * q) + off; }

struct Unit { int pm, pn, aux; };

template <class Epi, class Sched, bool GATHER, int K, int LDA, int LDB>
__device__ __forceinline__ void gemm_phase(LAS unsigned char* lds, const Sched& S, const Epi& E, const int tid_in) {
    int tid_ = tid_in; asm volatile("" : "+v"(tid_));
    const int tid = tid_, wid = __builtin_amdgcn_readfirstlane(tid >> 6), lane = tid & 63, wr = wid >> 2, wc = wid & 3, fr = lane & 15, fq = lane >> 4;
    constexpr int nt = K / BK;
    unsigned voffA[2], voffB[2];
#pragma unroll
    for (int i = 0; i < 2; ++i) { int R, C; stage_rc(tid * 16 + i * 8192, R, C); const int Rb = Epi::PERM ? ((R & ~31) + perm32(R & 31)) : R;
        voffA[i] = (unsigned)(R * LDA + C) * 2u; voffB[i] = (unsigned)(Rb * LDB + C) * 2u; }
    constexpr size_t kstep = (size_t)(BK * 2);
    constexpr size_t hstepA = GATHER ? (size_t)0 : (size_t)HALF * LDA * 2, hstepB = (size_t)HALF * LDB * 2;
    const unsigned ldsw = (unsigned)wid * 1024u;
    const int aoff = lds_byte(wr * 64 + fr, fq * 8), boff = lds_byte(wc * 32 + fr, fq * 8);
    unsigned gA[2][2], gN[2][2];
#define PG8_SA(b, h) (((b) * 2 + (h)) * HTB)
#define PG8_SB(b, h) ((4 + (b) * 2 + (h)) * HTB)
#define PG8_STAGEB(bufoff, gbase) do { _Pragma("unroll") for (int _i = 0; _i < 2; ++_i) \
        __builtin_amdgcn_global_load_lds((const unsigned*)((const char*)(gbase) + voffB[_i]), (LAS unsigned*)(lds + (bufoff) + ldsw + _i * 8192), 16, 0, 0); } while (0)
#define PG8_STAGEA(bufoff, gbase, h, GV) do { _Pragma("unroll") for (int _i = 0; _i < 2; ++_i) \
        __builtin_amdgcn_global_load_lds((const unsigned*)((const char*)(gbase) + (GATHER ? GV[h][_i] : voffA[_i]) + (h) * hstepA), (LAS unsigned*)(lds + (bufoff) + ldsw + _i * 8192), 16, 0, 0); } while (0)
#define PG8_LDA(dst, b, h) do { _Pragma("unroll") for (int m = 0; m < 4; ++m) _Pragma("unroll") for (int k = 0; k < 2; ++k) dst[m][k] = *(const LAS bf16x8*)(lds + PG8_SA(b, h) + aoff + m * 2048 + k * 1024); } while (0)
#define PG8_LDB(dst, b, h) do { _Pragma("unroll") for (int n = 0; n < 2; ++n) _Pragma("unroll") for (int k = 0; k < 2; ++k) dst[n][k] = *(const LAS bf16x8*)(lds + PG8_SB(b, h) + boff + n * 2048 + k * 1024); } while (0)
#define PG8_MMA(ai, bj, At, Bt) do { __builtin_amdgcn_s_setprio(1); _Pragma("unroll") for (int m = 0; m < 4; ++m) _Pragma("unroll") for (int n = 0; n < 2; ++n) _Pragma("unroll") for (int k = 0; k < 2; ++k) \
        acc[ai][bj][m][n] = __builtin_amdgcn_mfma_f32_16x16x32_bf16(Bt[n][k], At[m][k], acc[ai][bj][m][n], 0, 0, 0); __builtin_amdgcn_s_setprio(0); } while (0)
#define PG8_WAIT_V(n) asm volatile("s_waitcnt vmcnt(" #n ")" ::: "memory")
#define PG8_WAIT_L(n) asm volatile("s_waitcnt lgkmcnt(" #n ")" ::: "memory")
#define PG8_BAR __builtin_amdgcn_s_barrier()
#define PG8_SCHED __builtin_amdgcn_sched_barrier(0)
    Unit cur, nxt; int ui = 0;
    if (!S.next(0, cur)) return;
    f32x4 acc[2][2][4][2];
#pragma unroll
    for (int a = 0; a < 2; ++a)
#pragma unroll
        for (int b = 0; b < 2; ++b)
#pragma unroll
            for (int m = 0; m < 4; ++m)
#pragma unroll
                for (int n = 0; n < 2; ++n) acc[a][b][m][n] = (f32x4){0.f, 0.f, 0.f, 0.f};
    bf16x8 At[4][2], B0[2][2], B1[2][2];
    const char* cA = S.aptr(cur); const char* cB = S.bptr(cur);
    if constexpr (GATHER) { S.gather(cur, tid, gA); }
    PG8_STAGEB(PG8_SB(0, 0), cB); PG8_STAGEB(PG8_SB(0, 1), cB + hstepB); PG8_STAGEA(PG8_SA(0, 0), cA, 0, gA); PG8_STAGEA(PG8_SA(0, 1), cA, 1, gA);
    if (wr == 1) PG8_BAR;
    PG8_WAIT_V(2); PG8_BAR;
    PG8_STAGEB(PG8_SB(1, 0), cB + kstep); PG8_STAGEA(PG8_SA(1, 0), cA + kstep, 0, gA); PG8_STAGEB(PG8_SB(1, 1), cB + hstepB + kstep);
    PG8_WAIT_V(6); PG8_BAR;
    for (;;) {
        const bool has_next = S.next(ui + 1, nxt);
        const char* nA = has_next ? S.aptr(nxt) : cA; const char* nB = has_next ? S.bptr(nxt) : cB;
        if constexpr (GATHER) { if (has_next) S.gather(nxt, tid, gN); else {
#pragma unroll
            for (int h = 0; h < 2; ++h)
#pragma unroll
                for (int i = 0; i < 2; ++i) gN[h][i] = gA[h][i]; } }
#pragma nounroll
        for (int t = 0; t < nt; t += 2) {
            const bool last = (t == nt - 2);
            const char* a1 = cA + (size_t)(t + 1) * kstep;
            const char* a2 = last ? nA : cA + (size_t)(t + 2) * kstep; const char* b2 = last ? nB : cB + (size_t)(t + 2) * kstep;
            const char* a3 = a2 + kstep; const char* b3 = b2 + kstep;
            unsigned g2[2][2];
            if constexpr (GATHER) {
#pragma unroll
                for (int h = 0; h < 2; ++h)
#pragma unroll
                    for (int i = 0; i < 2; ++i) g2[h][i] = last ? gN[h][i] : gA[h][i]; }
            PG8_LDB(B0, 0, 0); PG8_LDB(B1, 0, 1); PG8_SCHED; PG8_LDA(At, 0, 0); PG8_STAGEA(PG8_SA(1, 1), a1, 1, gA);
            PG8_WAIT_V(8); PG8_WAIT_L(0); PG8_BAR; PG8_MMA(0, 0, At, B0); PG8_MMA(0, 1, At, B1); PG8_BAR; PG8_SCHED;
            PG8_LDA(At, 0, 1); PG8_STAGEB(PG8_SB(0, 0), b2); PG8_STAGEB(PG8_SB(0, 1), b2 + hstepB); PG8_STAGEA(PG8_SA(0, 0), a2, 0, g2);
            PG8_WAIT_V(8); PG8_WAIT_L(0); PG8_BAR; PG8_MMA(1, 0, At, B0); PG8_MMA(1, 1, At, B1); PG8_BAR; PG8_SCHED;
            PG8_LDB(B0, 1, 0); PG8_LDB(B1, 1, 1); PG8_SCHED; PG8_LDA(At, 1, 0); PG8_STAGEA(PG8_SA(0, 1), a2, 1, g2);
            PG8_WAIT_V(8); PG8_WAIT_L(0); PG8_BAR; PG8_MMA(0, 0, At, B0); PG8_MMA(0, 1, At, B1); PG8_BAR; PG8_SCHED;
            PG8_LDA(At, 1, 1); PG8_STAGEB(PG8_SB(1, 0), b3); PG8_STAGEB(PG8_SB(1, 1), b3 + hstepB); PG8_STAGEA(PG8_SA(1, 0), a3, 0, g2);
            PG8_WAIT_V(8); PG8_WAIT_L(0); PG8_BAR; PG8_MMA(1, 0, At, B0); PG8_MMA(1, 1, At, B1); PG8_BAR; PG8_SCHED;
        }
        if (wr == 0) PG8_BAR;
        E(acc, cur, wr, wc, fr, fq);
        if (!has_next) break;
#pragma unroll
        for (int a = 0; a < 2; ++a)
#pragma unroll
            for (int b = 0; b < 2; ++b)
#pragma unroll
                for (int m = 0; m < 4; ++m)
#pragma unroll
                    for (int n = 0; n < 2; ++n) acc[a][b][m][n] = (f32x4){0.f, 0.f, 0.f, 0.f};
        cur = nxt; cA = nA; cB = nB; ++ui;
        if constexpr (GATHER) {
#pragma unroll
            for (int h = 0; h < 2; ++h)
#pragma unroll
                for (int i = 0; i < 2; ++i) gA[h][i] = gN[h][i]; }
        if (wr == 1) PG8_BAR;
    }
    PG8_WAIT_V(0);
    PG8_BAR;
#undef PG8_SA
#undef PG8_SB
#undef PG8_STAGEA
#undef PG8_STAGEB
#undef PG8_LDA
#undef PG8_LDB
#undef PG8_MMA
#undef PG8_WAIT_V
#undef PG8_WAIT_L
#undef PG8_BAR
#undef PG8_SCHED
}
}
using pg8::Unit;

__device__ __forceinline__ void set_desc(LAS unsigned char* lds, int tid, int g, const void* A, const void* B, const void* C, int nN, int ldc, int aux, const void* X1 = nullptr, const void* X2 = nullptr, const void* X3 = nullptr) {
    LAS int* d = (LAS int*)(lds + LDS_DESC) + g * 16;
    if (tid == 0) { unsigned long long a = (unsigned long long)A, b = (unsigned long long)B, c = (unsigned long long)C, x1 = (unsigned long long)X1, x2 = (unsigned long long)X2, x3 = (unsigned long long)X3;
        asm volatile("" : "+s"(a), "+s"(b), "+s"(c), "+s"(x1), "+s"(x2), "+s"(x3), "+s"(nN), "+s"(ldc), "+s"(aux));
        d[0] = (int)(unsigned)a; d[1] = (int)(unsigned)(a >> 32); d[2] = (int)(unsigned)b; d[3] = (int)(unsigned)(b >> 32); d[4] = (int)(unsigned)c; d[5] = (int)(unsigned)(c >> 32); d[6] = nN; d[7] = ldc; d[8] = aux;
        d[10] = (int)(unsigned)x1; d[11] = (int)(unsigned)(x1 >> 32); d[12] = (int)(unsigned)x2; d[13] = (int)(unsigned)(x2 >> 32); d[14] = (int)(unsigned)x3; d[15] = (int)(unsigned)(x3 >> 32); }
}
__device__ __forceinline__ int desc_i(LAS unsigned char* lds, int g, int f) { return __builtin_amdgcn_readfirstlane(((LAS const int*)(lds + LDS_DESC))[g * 16 + f]); }
__device__ __forceinline__ const char* desc_p(LAS unsigned char* lds, int g, int f) {
    const unsigned lo = (unsigned)desc_i(lds, g, f), hi = (unsigned)desc_i(lds, g, f + 1); return (const char*)(((unsigned long long)hi << 32) | lo); }
template <int LDA, int LDB>
struct SchedMulti {
    LAS unsigned char* lds; int nM, ntot, ng;
    __device__ __forceinline__ bool next(int i, Unit& u) const {
        const int nwg = nM * ntot; const long L = (long)i * gridDim.x + blockIdx.x; if (L >= nwg) return false;
        const int wgid = pg8::xcd_remap((int)L, nwg);
        const int nig = pg8::WGM * ntot, gid = wgid / nig, fm = gid * pg8::WGM, gsz = (nM - fm) < pg8::WGM ? (nM - fm) : pg8::WGM;
        u.pm = fm + ((wgid % nig) % gsz); int pv = (wgid % nig) / gsz; int g = 0;
        for (int j = 0; j + 1 < ng; ++j) { const int n = desc_i(lds, j, 6); if (pv < n) break; pv -= n; g = j + 1; }
        u.pn = pv; u.aux = g; return true;
    }
    __device__ __forceinline__ const char* aptr(const Unit& u) const { return desc_p(lds, u.aux, 0) + (size_t)u.pm * (512 * LDA); }
    __device__ __forceinline__ const char* bptr(const Unit& u) const { return desc_p(lds, u.aux, 2) + (size_t)u.pn * (512 * LDB); }
};
template <int LDA, int LDB, bool GATHERED>
struct SchedMoE {
    LAS unsigned char* lds; const char* Abase; const char* Bbase; const int* list;
    __device__ __forceinline__ bool next(int i, Unit& u) const {
        LAS const int* tab = (LAS const int*)(lds + LDS_TAB);
        const int nrt = __builtin_amdgcn_readfirstlane(tab[2 * MAXRT + 32]);
        const int nwg = nrt * 4; const long L = (long)i * gridDim.x + blockIdx.x; if (L >= nwg) return false;
        const int wgid = pg8::xcd_remap((int)L, nwg);
        u.pm = wgid >> 2; u.pn = wgid & 3; u.aux = __builtin_amdgcn_readfirstlane(tab[u.pm]); return true;
    }
    __device__ __forceinline__ const char* aptr(const Unit& u) const { return GATHERED ? Abase : Abase + (size_t)u.pm * (512 * LDA); }
    __device__ __forceinline__ const char* bptr(const Unit& u) const { return Bbase + (size_t)u.aux * ((size_t)D * LDB * 2) + (size_t)u.pn * (512 * LDB); }
    __device__ __forceinline__ void gather(const Unit& u, int tid, unsigned (&g)[2][2]) const {
        LAS const int* tab = (LAS const int*)(lds + LDS_TAB);
        const int j0 = __builtin_amdgcn_readfirstlane(tab[MAXRT + u.pm]), cn = __builtin_amdgcn_readfirstlane(tab[2 * MAXRT + u.aux]);
#pragma unroll
        for (int i = 0; i < 2; ++i) { int R, C; pg8::stage_rc(tid * 16 + i * 8192, R, C);
#pragma unroll
            for (int h = 0; h < 2; ++h) { const int slot = j0 + 128 * h + R; const int a = slot < cn ? list[(size_t)u.aux * LISTCAP + slot] : 0;
                g[h][i] = (unsigned)((a >> 1) * LDA + C) * 2u; } }
    }
};
__device__ __forceinline__ void moe_tables(LAS unsigned char* lds, int tid, const unsigned* cnt) {
    LAS int* tab = (LAS int*)(lds + LDS_TAB);
    __syncthreads();
    if (tid == 0) {
        int rt = 0;
#pragma nounroll
        for (int e = 0; e < NE; ++e) { const int c = (int)__hip_atomic_load(cnt + e, __ATOMIC_RELAXED, __HIP_MEMORY_SCOPE_AGENT); tab[2 * MAXRT + e] = c;
            const int nt = (c + 255) >> 8;
#pragma nounroll
            for (int j = 0; j < nt; ++j) { tab[rt] = e; tab[MAXRT + rt] = j * 256; ++rt; } }
        tab[2 * MAXRT + 32] = rt;
    }
    __syncthreads();
}

#define EPI_FENCE() asm volatile("" ::: "memory")
struct EpiGelu {
    static constexpr bool PERM = true;
    LAS unsigned char* lds;
    __device__ __forceinline__ void operator()(const f32x4 (&acc)[2][2][4][2], const Unit& u, int wr, int wc, int fr, int fq) const {
        const bool isv = u.pn >= 8; bf16_t* base = (bf16_t*)desc_p(lds, 0, isv ? 10 : 4); const float* bias = (const float*)desc_p(lds, 0, 12); float* stat = (float*)desc_p(lds, 0, 14);
        const int col0 = (u.pn & 7) * 256 + wc * 32 + 8 * fq, bcol0 = u.pn * 256 + wc * 32 + 8 * fq, row0 = u.pm * 256 + wr * 64 + fr;
        f32x4 bv[2][2];
#pragma unroll
        for (int bj = 0; bj < 2; ++bj)
#pragma unroll
            for (int n = 0; n < 2; ++n) bv[bj][n] = *(const f32x4*)(bias + bcol0 + bj * 128 + 4 * n);
#pragma unroll
        for (int ai = 0; ai < 2; ++ai)
#pragma unroll
            for (int m = 0; m < 4; ++m) { const int row = row0 + ai * 128 + m * 16; bf16_t* rowp = base + (size_t)row * GWID + col0; float s = 0.f, q = 0.f;
#pragma unroll
                for (int bj = 0; bj < 2; ++bj) { const f32x4 v0 = acc[ai][bj][m][0] + bv[bj][0], v1 = acc[ai][bj][m][1] + bv[bj][1];
                    const f32x2 a = gelu_pk((f32x2){v0[0], v0[1]}), b = gelu_pk((f32x2){v0[2], v0[3]}), c = gelu_pk((f32x2){v1[0], v1[1]}), d = gelu_pk((f32x2){v1[2], v1[3]});
                    s += ((a.x + a.y) + (b.x + b.y)) + ((c.x + c.y) + (d.x + d.y));
                    q += ((a.x * a.x + a.y * a.y) + (b.x * b.x + b.y * b.y)) + ((c.x * c.x + c.y * c.y) + (d.x * d.x + d.y * d.y));
                    u32x4 w; w.x = cvt_pk_bf16(a.x, a.y); w.y = cvt_pk_bf16(b.x, b.y); w.z = cvt_pk_bf16(c.x, c.y); w.w = cvt_pk_bf16(d.x, d.y);
                    *(u32x4*)(rowp + bj * 128) = w; }
                if (isv) { const int ln_ = 16 * fq + fr; s += shx(s, 16, ln_); s += shx(s, 32, ln_); q += shx(q, 16, ln_); q += shx(q, 32, ln_);
                    if (fq == 0) *(f32x2*)(stat + ((size_t)row * 32 + (u.pn - 8) * 4 + wc) * 2) = (f32x2){s, q}; } }
    }
};
struct EpiResid {
    static constexpr bool PERM = true;
    LAS unsigned char* lds;
    __device__ __forceinline__ void operator()(const f32x4 (&acc)[2][2][4][2], const Unit& u, int wr, int wc, int fr, int fq) const {
        const int mrow = u.pm < 64 ? 0 : (u.pm < 128 ? 1 : 2);
        bf16_t* x = (bf16_t*)desc_p(lds, 0, 4) + (size_t)(u.pm * 256 + wr * 64 + fr) * D + u.pn * 256 + wc * 32 + 8 * fq;
        const float* bias = (const float*)desc_p(lds, 0, 14); const float* gate = (const float*)desc_p(lds, 1, 10) + mrow * 6 * D + u.pn * 256 + wc * 32 + 8 * fq;
        if (bias) bias += u.pn * 256 + wc * 32 + 8 * fq;
#pragma unroll
        for (int bj = 0; bj < 2; ++bj) {
#pragma unroll
            for (int n = 0; n < 2; ++n) { const int c = bj * 128 + 4 * n;
                const f32x4 b0 = bias ? *(const f32x4*)(bias + c) : (f32x4){0.f, 0.f, 0.f, 0.f};
                const f32x4 g0 = *(const f32x4*)(gate + c);
#pragma unroll
                for (int ai = 0; ai < 2; ++ai) {
#pragma unroll
                    for (int m = 0; m < 4; ++m) { bf16_t* p = x + (size_t)(ai * 128 + m * 16) * D + c;
                        const u32x2 w = *(const u32x2*)p; const f32x4 x0 = (f32x4){bf_lo(w.x), bf_hi(w.x), bf_lo(w.y), bf_hi(w.y)};
                        const f32x4 o0 = x0 + g0 * (acc[ai][bj][m][n] + b0);
                        u32x2 w2; w2.x = cvt_pk_bf16(o0[0], o0[1]); w2.y = cvt_pk_bf16(o0[2], o0[3]);
                        *(u32x2*)p = w2; }
                    EPI_FENCE(); } } }
    }
};
template <int K>
__device__ __forceinline__ void tail_resid(LAS unsigned char* lds, int wave) {
    const int lane = lane_id_now(), fr = lane & 15, q = lane >> 4, tid = wave * 64 + lane;
    constexpr int KW = K / 8, RP = 68;
    LAS float* red = (LAS float*)lds;
    const bf16_t* A = (const bf16_t*)desc_p(lds, 0, 0) + (size_t)TL * K; const bf16_t* W = (const bf16_t*)desc_p(lds, 0, 2);
    bf16_t* X = (bf16_t*)desc_p(lds, 0, 4) + (size_t)TL * D; const float* bias = (const float*)desc_p(lds, 0, 14); const float* gate = (const float*)desc_p(lds, 1, 10) + 2 * 6 * D;
    for (int item = blockIdx.x; item < 256; item += gridDim.x) {
        const int r0 = (item >> 4) * 16, c0 = (item & 15) * 64;
        const bf16_t* ap = A + (size_t)(r0 + fr) * K + wave * KW + 16 * q;
        const bf16_t* bp = W + (size_t)(c0 + fr) * K + wave * KW + 16 * q;
        f32x4 acc[4];
#pragma unroll
        for (int n = 0; n < 4; ++n) acc[n] = (f32x4){0.f, 0.f, 0.f, 0.f};
#pragma unroll
        for (int kb = 0; kb < KW / 64; ++kb) {
            const bf16x8 a0 = *(const bf16x8*)(ap + kb * 64), a1 = *(const bf16x8*)(ap + kb * 64 + 8);
#pragma unroll
            for (int n = 0; n < 4; ++n) { const bf16x8 b0 = *(const bf16x8*)(bp + (size_t)n * 16 * K + kb * 64), b1 = *(const bf16x8*)(bp + (size_t)n * 16 * K + kb * 64 + 8);
                acc[n] = __builtin_amdgcn_mfma_f32_16x16x32_bf16(a0, b0, acc[n], 0, 0, 0); acc[n] = __builtin_amdgcn_mfma_f32_16x16x32_bf16(a1, b1, acc[n], 0, 0, 0); }
        }
#pragma unroll
        for (int n = 0; n < 4; ++n)
#pragma unroll
            for (int r = 0; r < 4; ++r) red[(wave * 16 + 4 * q + r) * RP + n * 16 + fr] = acc[n][r];
        __syncthreads();
        { const int row = tid >> 5, c2 = 2 * (tid & 31); float s0 = 0.f, s1 = 0.f;
#pragma unroll
          for (int w = 0; w < 8; ++w) { const f32x2 v = *(LAS const f32x2*)(red + (w * 16 + row) * RP + c2); s0 += v.x; s1 += v.y; }
          const int col = c0 + c2; bf16_t* p = X + (size_t)(r0 + row) * D + col; const unsigned xw = *(const unsigned*)p;
          const float b0 = bias ? bias[col] : 0.f, b1 = bias ? bias[col + 1] : 0.f;
          *(unsigned*)p = cvt_pk_bf16(bf_lo(xw) + gate[col] * (s0 + b0), bf_hi(xw) + gate[col + 1] * (s1 + b1)); }
        __syncthreads();
    }
}
struct EpiAct {
    static constexpr bool PERM = true;
    LAS unsigned char* lds;
    __device__ __forceinline__ void operator()(const f32x4 (&acc)[2][2][4][2], const Unit& u, int wr, int wc, int fr, int fq) const {
        bf16_t* C = (bf16_t*)desc_p(lds, u.aux, 4); const int ldc = desc_i(lds, u.aux, 7), act = desc_i(lds, u.aux, 8);
        const int col0 = u.pn * 256 + wc * 32 + 8 * fq, row0 = u.pm * 256 + wr * 64 + fr;
#pragma unroll
        for (int ai = 0; ai < 2; ++ai)
#pragma unroll
            for (int m = 0; m < 4; ++m) { bf16_t* rowp = C + (size_t)(row0 + ai * 128 + m * 16) * ldc + col0;
#pragma unroll
                for (int bj = 0; bj < 2; ++bj) { f32x4 v0 = acc[ai][bj][m][0], v1 = acc[ai][bj][m][1];
                    if (act == 1) {
#pragma unroll
                        for (int j = 0; j < 4; ++j) { v0[j] = tanhf_(v0[j]); v1[j] = tanhf_(v1[j]); } }
                    else if (act == 2) {
#pragma unroll
                        for (int j = 0; j < 4; ++j) { v0[j] = sigmoidf_(v0[j]); v1[j] = sigmoidf_(v1[j]); } }
                    u32x4 w; w.x = cvt_pk_bf16(v0[0], v0[1]); w.y = cvt_pk_bf16(v0[2], v0[3]); w.z = cvt_pk_bf16(v1[0], v1[1]); w.w = cvt_pk_bf16(v1[2], v1[3]);
                    *(u32x4*)(rowp + bj * 128) = w; } }
    }
};
struct EpiLogits {
    static constexpr bool PERM = false;
    float* LG;
    __device__ __forceinline__ void operator()(const f32x4 (&acc)[2][2][4][2], const Unit& u, int wr, int wc, int fr, int fq) const {
        if (wc >= 2) return;
        const int col0 = wc * 32 + 4 * fq, row0 = u.pm * 256 + wr * 64 + fr;
#pragma unroll
        for (int ai = 0; ai < 2; ++ai)
#pragma unroll
            for (int m = 0; m < 4; ++m)
#pragma unroll
                for (int n = 0; n < 2; ++n) *(f32x4*)(LG + (size_t)(row0 + ai * 128 + m * 16) * 64 + col0 + n * 16) = acc[ai][0][m][n] + acc[ai][1][m][n];
    }
};
struct EpiSiluGate {
    static constexpr bool PERM = true;
    bf16_t* H;
    __device__ __forceinline__ void operator()(const f32x4 (&acc)[2][2][4][2], const Unit& u, int wr, int wc, int fr, int fq) const {
        const int col0 = u.pn * 128 + wc * 32 + 8 * fq, row0 = u.pm * 256 + wr * 64 + fr;
#pragma unroll
        for (int ai = 0; ai < 2; ++ai)
#pragma unroll
            for (int m = 0; m < 4; ++m) { f32x4 h0, h1;
#pragma unroll
                for (int j = 0; j < 4; ++j) { const float g0 = acc[ai][0][m][0][j], g1 = acc[ai][0][m][1][j]; h0[j] = g0 * sigmoidf_(g0) * acc[ai][1][m][0][j]; h1[j] = g1 * sigmoidf_(g1) * acc[ai][1][m][1][j]; }
                u32x4 w; w.x = cvt_pk_bf16(h0[0], h0[1]); w.y = cvt_pk_bf16(h0[2], h0[3]); w.z = cvt_pk_bf16(h1[0], h1[1]); w.w = cvt_pk_bf16(h1[2], h1[3]);
                *(u32x4*)(H + (size_t)(row0 + ai * 128 + m * 16) * EHID + col0) = w; }
    }
};
struct EpiScatter {
    static constexpr bool PERM = true;
    LAS unsigned char* lds; bf16_t* YB; const int* list;
    __device__ __forceinline__ void operator()(const f32x4 (&acc)[2][2][4][2], const Unit& u, int wr, int wc, int fr, int fq) const {
        LAS const int* tab = (LAS const int*)(lds + LDS_TAB);
        const int j0 = __builtin_amdgcn_readfirstlane(tab[MAXRT + u.pm]), cn = __builtin_amdgcn_readfirstlane(tab[2 * MAXRT + u.aux]);
        const int col0 = u.pn * 256 + wc * 32 + 8 * fq;
#pragma unroll
        for (int ai = 0; ai < 2; ++ai)
#pragma unroll
            for (int m = 0; m < 4; ++m) { const int slot = j0 + ai * 128 + wr * 64 + m * 16 + fr;
                if (slot < cn) { const int a = list[(size_t)u.aux * LISTCAP + slot]; bf16_t* rowp = YB + (size_t)a * D + col0;
#pragma unroll
                    for (int bj = 0; bj < 2; ++bj) { const f32x4 v0 = acc[ai][bj][m][0], v1 = acc[ai][bj][m][1];
                        u32x4 w; w.x = cvt_pk_bf16(v0[0], v0[1]); w.y = cvt_pk_bf16(v0[2], v0[3]); w.z = cvt_pk_bf16(v1[0], v1[1]); w.w = cvt_pk_bf16(v1[2], v1[3]);
                        *(u32x4*)(rowp + bj * 128) = w; } } }
    }
};

struct Params { const float* in[42]; float* out; unsigned char* ws; int ph_lo, ph_hi; };
enum { I_X = 0, I_C, I_CTX, I_CCTX, I_ADAW, I_ADAB, I_N1G, I_N2G, I_FG, I_GWIN, I_GBIN, I_GLNG, I_GLNB, I_GWS, I_GBS, I_GWOUT, I_GBOUT,
       I_MU, I_WR, I_WK, I_WV, I_WO, I_W0, I_W1, I_W2, I_A0, I_A1, I_A2, I_G1, I_G2, I_KK, I_KA, I_RK, I_LNG, I_LNB,
       I_MWGRP, I_MBGRP, I_MWEXP, I_MBEXP, I_MWG, I_MWU, I_MWD };
struct Frame { LAS unsigned char* lds; int tid, lane, wave, G, gw, NGW; };
typedef const __attribute__((address_space(4))) Params* KP;

constexpr int TRP = 36, TR_SCR = 64 * TRP * 4;
__device__ __forceinline__ void tr_item(const float* W, int N, int kmax, bf16_t* WT, int ldk, int k0, int n0, int drow0, int dk0, LAS float* scr, int lane) {
    const int n4 = lane & 7, kr = lane >> 3; f32x4 v[8];
#pragma unroll
    for (int i = 0; i < 8; ++i) { const int k = k0 + 8 * i + kr; v[i] = k < kmax ? *(const f32x4*)(W + (size_t)k * N + n0 + 4 * n4) : (f32x4){0.f, 0.f, 0.f, 0.f}; }
#pragma unroll
    for (int i = 0; i < 8; ++i) *(LAS f32x4*)(scr + (8 * i + kr) * TRP + 4 * n4) = v[i];
    asm volatile("s_waitcnt lgkmcnt(0)" ::: "memory");
    const int c = lane & 7;
#pragma unroll
    for (int j = 0; j < 4; ++j) { const int n = (lane >> 3) + 8 * j; const LAS float* sp = scr + (8 * c) * TRP + n;
        u32x4 o; o.x = cvt_pk_bf16(sp[0 * TRP], sp[1 * TRP]); o.y = cvt_pk_bf16(sp[2 * TRP], sp[3 * TRP]); o.z = cvt_pk_bf16(sp[4 * TRP], sp[5 * TRP]); o.w = cvt_pk_bf16(sp[6 * TRP], sp[7 * TRP]);
        *(u32x4*)(WT + (size_t)(drow0 + n) * ldk + dk0 + k0 + 8 * c) = o; }
    asm volatile("s_waitcnt lgkmcnt(0)" ::: "memory");
}
constexpr int LDS_JOBS = 80 * 1024, MAXJOBS = 48;
__device__ __forceinline__ void add_job(LAS int* jobs, int& nj, int& nit, const float* src, int N, int kmax, int kpad, bf16_t* dst, int ldk, int drow0, int dk0) {
    LAS int* q = jobs + nj * 12; const unsigned long long a = (unsigned long long)src, d = (unsigned long long)dst;
    q[0] = (int)(unsigned)a; q[1] = (int)(unsigned)(a >> 32); q[2] = (int)(unsigned)d; q[3] = (int)(unsigned)(d >> 32); q[4] = N; q[5] = kmax; q[6] = kpad / 64; q[7] = ldk; q[8] = drow0; q[9] = dk0; q[10] = nit;
    nit += (kpad / 64) * (N / 32); ++nj;
}
__device__ __forceinline__ void zero_fill(const Frame& F, bf16_t* p, size_t nbytes) {
    u32x4* q = (u32x4*)p; const size_t n = nbytes / 16;
    for (size_t i = (size_t)blockIdx.x * NTHR + F.tid; i < n; i += (size_t)F.G * NTHR) q[i] = (u32x4){0u, 0u, 0u, 0u};
}

__device__ __forceinline__ void prologue_phase(const Frame& F, KP P) {
    unsigned char* ws = P->ws;
    {   float* MOD = (float*)(ws + WS_MOD); LAS float* part = (LAS float*)F.lds;
        const float* c = P->in[I_C]; const float* cc = P->in[I_CCTX];
        for (int item = blockIdx.x; item < DEPTH * 24; item += F.G) {
            const int layer = item / 24, col = (item % 24) * 256 + 4 * F.lane; const float* w = P->in[I_ADAW] + (size_t)layer * D * 6 * D + col;
            f32x4 a0 = (f32x4){0.f, 0.f, 0.f, 0.f}, a1 = a0, a2 = a0;
#pragma unroll 8
            for (int i = 0; i < 128; ++i) { const int d = F.wave + 8 * i; const f32x4 wv = *(const f32x4*)(w + (size_t)d * 6 * D);
                const float c0 = c[d], c1 = c[D + d], c2 = cc[d];
                a0 += wv * (c0 * sigmoidf_(c0)); a1 += wv * (c1 * sigmoidf_(c1)); a2 += wv * (c2 * sigmoidf_(c2)); }
            __syncthreads();
            *(LAS f32x4*)(part + (F.wave * 3 + 0) * 256 + 4 * F.lane) = a0; *(LAS f32x4*)(part + (F.wave * 3 + 1) * 256 + 4 * F.lane) = a1; *(LAS f32x4*)(part + (F.wave * 3 + 2) * 256 + 4 * F.lane) = a2;
            __syncthreads();
            if (F.wave < 3) { f32x4 sacc = (f32x4){0.f, 0.f, 0.f, 0.f};
#pragma unroll
                for (int w8 = 0; w8 < 8; ++w8) sacc += *(const LAS f32x4*)(part + (w8 * 3 + F.wave) * 256 + 4 * F.lane);
                *(f32x4*)(MOD + ((size_t)layer * 3 + F.wave) * 6 * D + col) = sacc + *(const f32x4*)(P->in[I_ADAB] + (size_t)layer * 6 * D + col); }
        }
    }
    LAS int* jobs = (LAS int*)(F.lds + LDS_JOBS); LAS int* jtot = jobs + MAXJOBS * 12;
    __syncthreads();
    if (F.tid == 0) { int nj = 0, nit = 0;
        for (int j = 0; j < 2; ++j) {
            add_job(jobs, nj, nit, P->in[I_GWIN] + (size_t)j * D * 4096, 4096, D, D, (bf16_t*)(ws + WS_WIN) + (size_t)j * 4096 * D, D, 0, 0);
            add_job(jobs, nj, nit, P->in[I_GWOUT] + (size_t)j * GWID * D, D, GWID, GWID, (bf16_t*)(ws + WS_WOUT) + (size_t)j * D * GWID, GWID, 0, 0);
            add_job(jobs, nj, nit, P->in[I_WR] + (size_t)j * D * D, D, D, D, (bf16_t*)(ws + WS_WR) + (size_t)j * D * D, D, 0, 0);
            add_job(jobs, nj, nit, P->in[I_WK] + (size_t)j * D * D, D, D, D, (bf16_t*)(ws + WS_WK) + (size_t)j * D * D, D, 0, 0);
            add_job(jobs, nj, nit, P->in[I_WV] + (size_t)j * D * D, D, D, D, (bf16_t*)(ws + WS_WV) + (size_t)j * D * D, D, 0, 0);
            add_job(jobs, nj, nit, P->in[I_WO] + (size_t)j * D * D, D, D, D, (bf16_t*)(ws + WS_WO) + (size_t)j * D * D, D, 0, 0);
            for (int z = 0; z < 2; ++z) {
                add_job(jobs, nj, nit, P->in[I_W1] + ((size_t)j * 2 + z) * D * 64, 64, D, D, (bf16_t*)(ws + WS_LW1) + (size_t)j * 256 * D, D, z * 64, 0);
                add_job(jobs, nj, nit, P->in[I_A1] + ((size_t)j * 2 + z) * D * 64, 64, D, D, (bf16_t*)(ws + WS_LA1) + (size_t)j * 256 * D, D, z * 64, 0);
                add_job(jobs, nj, nit, P->in[I_W2] + ((size_t)j * 2 + z) * 64 * D, D, 64, 64, (bf16_t*)(ws + WS_W2P) + ((size_t)j * 2 + z) * D * 256, 256, 0, z * 64);
                add_job(jobs, nj, nit, P->in[I_A2] + ((size_t)j * 2 + z) * 64 * D, D, 64, 64, (bf16_t*)(ws + WS_A2P) + ((size_t)j * 2 + z) * D * 256, 256, 0, z * 64); }
            add_job(jobs, nj, nit, P->in[I_G1] + (size_t)j * D * 160, 160, D, D, (bf16_t*)(ws + WS_LG1) + (size_t)j * 256 * D, D, 0, 0);
            add_job(jobs, nj, nit, P->in[I_G2] + (size_t)j * 160 * D, D, 160, 256, (bf16_t*)(ws + WS_G2P) + (size_t)j * D * 256, 256, 0, 0); }
        jtot[0] = nj; jtot[1] = nit; }
    __syncthreads();
    {   const int nj = jtot[0], nit = jtot[1]; LAS float* scr = (LAS float*)(F.lds + F.wave * TR_SCR);
        for (int it = F.gw; it < nit; it += F.NGW) {
            int jb = 0; for (int q = 1; q < nj; ++q) if (it >= jobs[q * 12 + 10]) jb = q;
            jb = __builtin_amdgcn_readfirstlane(jb); LAS const int* q = jobs + jb * 12;
            const float* src = (const float*)(((unsigned long long)(unsigned)q[1] << 32) | (unsigned)q[0]); bf16_t* dst = (bf16_t*)(((unsigned long long)(unsigned)q[3] << 32) | (unsigned)q[2]);
            const int N = q[4], nnb = N / 32, r = it - q[10], kb = r / nnb, nb = r % nnb;
            tr_item(src, N, q[5], dst, q[7], kb * 64, nb * 32, q[8] + nb * 32, q[9], scr, F.lane); }
    }
    for (int j = 0; j < 2; ++j) {
        bf16_t* lw1 = (bf16_t*)(ws + WS_LW1) + (size_t)j * 256 * D; bf16_t* la1 = (bf16_t*)(ws + WS_LA1) + (size_t)j * 256 * D; bf16_t* lg1 = (bf16_t*)(ws + WS_LG1) + (size_t)j * 256 * D;
        zero_fill(F, lw1 + 128 * D, (size_t)128 * D * 2); zero_fill(F, la1 + 128 * D, (size_t)128 * D * 2); zero_fill(F, lg1 + 160 * D, (size_t)96 * D * 2);
        for (int z = 0; z < 2; ++z) { bf16_t* w2p = (bf16_t*)(ws + WS_W2P) + ((size_t)j * 2 + z) * D * 256; bf16_t* a2p = (bf16_t*)(ws + WS_A2P) + ((size_t)j * 2 + z) * D * 256;
            for (int idx = blockIdx.x * NTHR + F.tid; idx < D * 32; idx += F.G * NTHR) { const int n = idx >> 5, ch = idx & 31;
                if ((ch >> 3) != z) { *(u32x4*)(w2p + (size_t)n * 256 + ch * 8) = (u32x4){0u, 0u, 0u, 0u}; *(u32x4*)(a2p + (size_t)n * 256 + ch * 8) = (u32x4){0u, 0u, 0u, 0u}; } } }
    }
    {   bf16_t* wrt = (bf16_t*)(ws + WS_WRT);
        for (int idx = blockIdx.x * NTHR + F.tid; idx < DEPTH * 256 * (D / 8); idx += F.G * NTHR) { const int k0 = (idx & 127) * 8, n = (idx >> 7) & 255, layer = idx >> 15;
            const int nn = n & 127; const bool lo = n >= 128; float w[8];
#pragma unroll
            for (int e = 0; e < 8; ++e) { float x = 0.f;
                if (nn < 4) x = P->in[I_MWGRP][((size_t)layer * D + k0 + e) * 4 + nn]; else if (nn < 36) x = P->in[I_MWEXP][((size_t)layer * D + k0 + e) * NE + nn - 4];
                const float hi = bf_lo(cvt_pk_bf16(x, 0.f)); w[e] = lo ? x - hi : x; }
            *(u32x4*)(wrt + ((size_t)layer * 256 + n) * D + k0) = pack8(w); } }
    {   const float* src = P->in[I_GWS]; bf16_t* dst = (bf16_t*)(ws + WS_WSP); const int n8 = 2 * 16 * 128 * 128 / 8;
        for (int i = blockIdx.x * NTHR + F.tid; i < n8; i += F.G * NTHR) { const f32x4 a = *(const f32x4*)(src + (size_t)i * 8), b = *(const f32x4*)(src + (size_t)i * 8 + 4);
            u32x4 o; o.x = cvt_pk_bf16(a[0], a[1]); o.y = cvt_pk_bf16(a[2], a[3]); o.z = cvt_pk_bf16(b[0], b[1]); o.w = cvt_pk_bf16(b[2], b[3]); *(u32x4*)(dst + (size_t)i * 8) = o; } }
}
__device__ __forceinline__ void moe_weights_phase(const Frame& F, KP P, int layer) {
    unsigned char* ws = P->ws; LAS float* scr = (LAS float*)(F.lds + F.wave * TR_SCR);
    for (int it = F.gw; it < NE * 768; it += F.NGW) {
        const int e = it / 768, r = it % 768, m = r >> 8, q = r & 255;
        const size_t so = ((size_t)layer * NE + e) * (size_t)D * EHID;
        if (m < 2) { const int kb = q >> 4, n0 = (q & 15) * 32;
            tr_item((m == 0 ? P->in[I_MWG] : P->in[I_MWU]) + so, EHID, D, (bf16_t*)(ws + WS_WGU) + (size_t)e * D * D, D, kb * 64, n0, 256 * (n0 >> 7) + (n0 & 127) + (m == 1 ? 128 : 0), 0, scr, F.lane); }
        else { const int kb = q >> 5, n0 = (q & 31) * 32;
            tr_item(P->in[I_MWD] + so, D, EHID, (bf16_t*)(ws + WS_WD) + (size_t)e * D * EHID, EHID, kb * 64, n0, n0, 0, scr, F.lane); }
    }
}

__device__ __forceinline__ void load_xrow(KP P, const Frame& F, int layer, int row, f32x4 (&v)[4]) {
    if (layer == 0) { const float* xr = row < TL ? P->in[I_X] + (size_t)row * D : P->in[I_CTX] + (size_t)(row - TL) * D;
#pragma unroll
        for (int j = 0; j < 4; ++j) v[j] = *(const f32x4*)(xr + 4 * F.lane + 256 * j); }
    else { const bf16_t* xr = (const bf16_t*)(P->ws + WS_X) + (size_t)row * D;
#pragma unroll
        for (int j = 0; j < 4; ++j) { const u32x2 w = *(const u32x2*)(xr + 4 * F.lane + 256 * j); v[j] = (f32x4){bf_lo(w.x), bf_hi(w.x), bf_lo(w.y), bf_hi(w.y)}; } }
}
__device__ __forceinline__ void load_combine(KP P, const Frame& F, int layer, int row, int m, bool combine, f32x4 (&v)[4]) {
    load_xrow(P, F, layer, row, v);
    if (combine) {
        const bf16_t* yb = (const bf16_t*)(P->ws + WS_YB); const float* wg = (const float*)(P->ws + WS_WGT);
        const float w0 = wg[2 * row], w1 = wg[2 * row + 1]; const float* g2 = (const float*)(P->ws + WS_MOD) + ((size_t)(layer - 1) * 3 + m) * 6 * D + 5 * D;
#pragma unroll
        for (int j = 0; j < 4; ++j) { const int col = 4 * F.lane + 256 * j; const u32x2 a = *(const u32x2*)(yb + (size_t)(2 * row) * D + col), b = *(const u32x2*)(yb + (size_t)(2 * row + 1) * D + col);
            const f32x4 g = *(const f32x4*)(g2 + col);
            v[j][0] += g[0] * (w0 * bf_lo(a.x) + w1 * bf_lo(b.x)); v[j][1] += g[1] * (w0 * bf_hi(a.x) + w1 * bf_hi(b.x));
            v[j][2] += g[2] * (w0 * bf_lo(a.y) + w1 * bf_lo(b.y)); v[j][3] += g[3] * (w0 * bf_hi(a.y) + w1 * bf_hi(b.y)); }
    }
}
__device__ __forceinline__ void norm1_phase(const Frame& F, KP P, int layer) {
    const bool combine = layer > 0; bf16_t* X = (bf16_t*)(P->ws + WS_X); bf16_t* HL = (bf16_t*)(P->ws + WS_HL);
    const float* g1 = P->in[I_N1G] + (size_t)layer * D;
    for (int row = F.gw; row < T; row += F.NGW) {
        const int m = row < TL ? (row >> 14) : 2; f32x4 v[4];
        load_combine(P, F, layer, row, m, combine, v);
        {
#pragma unroll
            for (int j = 0; j < 4; ++j) { u32x2 o; o.x = cvt_pk_bf16(v[j][0], v[j][1]); o.y = cvt_pk_bf16(v[j][2], v[j][3]); *(u32x2*)(X + (size_t)row * D + 4 * F.lane + 256 * j) = o;
                v[j] = (f32x4){bf_lo(o.x), bf_hi(o.x), bf_lo(o.y), bf_hi(o.y)}; } }
        float ss = 0.f;
#pragma unroll
        for (int j = 0; j < 4; ++j) ss += (v[j][0] * v[j][0] + v[j][1] * v[j][1]) + (v[j][2] * v[j][2] + v[j][3] * v[j][3]);
        const float rstd = rsqrtf(wave_sum(ss, F.lane) * (1.0f / D) + 1e-6f);
        const float* mod = (const float*)(P->ws + WS_MOD) + ((size_t)layer * 3 + m) * 6 * D;
#pragma unroll
        for (int j = 0; j < 4; ++j) { const int col = 4 * F.lane + 256 * j; const f32x4 g = *(const f32x4*)(g1 + col), sh = *(const f32x4*)(mod + col), sc = *(const f32x4*)(mod + D + col);
            const f32x4 h = (v[j] * rstd) * g * (sc + 1.0f) + sh;
            u32x2 o; o.x = cvt_pk_bf16(h[0], h[1]); o.y = cvt_pk_bf16(h[2], h[3]); *(u32x2*)(HL + (size_t)row * D + col) = o; }
    }
}
__device__ __forceinline__ void final_phase(const Frame& F, KP P) {
    const float* fg = P->in[I_FG];
    for (int row = F.gw; row < TL; row += F.NGW) {
        const int m = row >> 14; f32x4 v[4];
        load_combine(P, F, DEPTH, row, m, true, v);
        float ss = 0.f;
#pragma unroll
        for (int j = 0; j < 4; ++j) ss += (v[j][0] * v[j][0] + v[j][1] * v[j][1]) + (v[j][2] * v[j][2] + v[j][3] * v[j][3]);
        const float rstd = rsqrtf(wave_sum(ss, F.lane) * (1.0f / D) + 1e-6f);
#pragma unroll
        for (int j = 0; j < 4; ++j) { const int col = 4 * F.lane + 256 * j; *(f32x4*)(P->out + (size_t)row * D + col) = (v[j] * rstd) * *(const f32x4*)(fg + col); }
    }
}
__device__ __forceinline__ void norm2_phase(const Frame& F, KP P, int layer) {
    const int ntok = layer == DEPTH - 1 ? TL : T; bf16_t* HL2 = (bf16_t*)(P->ws + WS_HL); const float* g2n = P->in[I_N2G] + (size_t)layer * D;
    for (int row = F.gw; row < ntok; row += F.NGW) {
        const int m = row < TL ? (row >> 14) : 2; f32x4 v[4]; load_xrow(P, F, 1, row, v);
        float ss = 0.f;
#pragma unroll
        for (int j = 0; j < 4; ++j) ss += (v[j][0] * v[j][0] + v[j][1] * v[j][1]) + (v[j][2] * v[j][2] + v[j][3] * v[j][3]);
        const float rstd = rsqrtf(wave_sum(ss, F.lane) * (1.0f / D) + 1e-6f);
        const float* mod = (const float*)(P->ws + WS_MOD) + ((size_t)layer * 3 + m) * 6 * D;
#pragma unroll
        for (int j = 0; j < 4; ++j) { const int col = 4 * F.lane + 256 * j; const f32x4 g = *(const f32x4*)(g2n + col), sh = *(const f32x4*)(mod + 3 * D + col), sc = *(const f32x4*)(mod + 4 * D + col);
            const f32x4 h = (v[j] * rstd) * g * (sc + 1.0f) + sh;
            u32x2 o; o.x = cvt_pk_bf16(h[0], h[1]); o.y = cvt_pk_bf16(h[2], h[3]); *(u32x2*)(HL2 + (size_t)row * D + col) = o; }
    }
    moe_weights_phase(F, P, layer);
}
__device__ __forceinline__ void route_phase(const Frame& F, KP P, int layer) {
    const int ntok = layer == DEPTH - 1 ? TL : T; const float* LG = (const float*)(P->ws + WS_LG);
    const float* bgrp = P->in[I_MBGRP] + layer * 4; const float* bexp = P->in[I_MBEXP] + layer * NE;
    unsigned* cnt = (unsigned*)(P->ws + WS_CTL) + CW_CNT + layer * 64; int* list = (int*)(P->ws + WS_LIST); float* wgt = (float*)(P->ws + WS_WGT);
    LAS unsigned* lcnt = (LAS unsigned*)F.lds; LAS unsigned* lbase = lcnt + 32;
    for (int r0 = blockIdx.x * NTHR; r0 < ntok; r0 += F.G * NTHR) {
        const int row = r0 + F.tid; const bool act = row < ntok;
        __syncthreads();
        if (F.tid < 32) lcnt[F.tid] = 0u;
        __syncthreads();
        int e0 = 0, e1 = 0; unsigned k0 = 0, k1 = 0;
        if (act) {
            const float* lg = LG + (size_t)row * 64; const f32x4 g4 = *(const f32x4*)lg;
            float ag[4];
#pragma unroll
            for (int i = 0; i < 4; ++i) ag[i] = g4[i] + bgrp[i];
            int grp = 0; float mx = ag[0];
#pragma unroll
            for (int i = 1; i < 4; ++i) if (ag[i] > mx) { mx = ag[i]; grp = i; }
            float den = 0.f;
#pragma unroll
            for (int i = 0; i < 4; ++i) den += __expf(ag[i] - mx);
            const float pg = 1.0f / den;
            const f32x4 e0v = *(const f32x4*)(lg + 4 + 8 * grp), e1v = *(const f32x4*)(lg + 8 + 8 * grp); const f32x4 b0v = *(const f32x4*)(bexp + 8 * grp), b1v = *(const f32x4*)(bexp + 8 * grp + 4);
            float el[8];
#pragma unroll
            for (int i = 0; i < 4; ++i) { el[i] = e0v[i] + b0v[i]; el[4 + i] = e1v[i] + b1v[i]; }
            int i0 = 0; float t0 = el[0];
#pragma unroll
            for (int i = 1; i < 8; ++i) if (el[i] > t0) { t0 = el[i]; i0 = i; }
            int i1 = -1; float t1 = -3.0e38f;
#pragma unroll
            for (int i = 0; i < 8; ++i) if (i != i0 && el[i] > t1) { t1 = el[i]; i1 = i; }
            const float p0 = 1.0f / (1.0f + __expf(t1 - t0));
            wgt[2 * row] = pg * p0; wgt[2 * row + 1] = pg * (1.0f - p0);
            e0 = grp * 8 + i0; e1 = grp * 8 + i1;
            k0 = atomicAdd((unsigned*)(lcnt + e0), 1u); k1 = atomicAdd((unsigned*)(lcnt + e1), 1u);
        }
        __syncthreads();
        if (F.tid < 32) { const unsigned c = lcnt[F.tid]; lbase[F.tid] = c ? atomicAdd(cnt + F.tid, c) : 0u; }
        __syncthreads();
        if (act) { list[(size_t)e0 * LISTCAP + lbase[e0] + k0] = 2 * row; list[(size_t)e1 * LISTCAP + lbase[e1] + k1] = 2 * row + 1; }
    }
}
__device__ __forceinline__ bf16x8 tr_frag136(const LAS bf16_t* M, int k0, int c0, int lane) {
    LAS bf16_t* p = (LAS bf16_t*)M + (k0 + 8 * (lane >> 4) + ((lane & 15) >> 2)) * 136 + c0 + 4 * (lane & 3);
    const v4s lo = __builtin_amdgcn_ds_read_tr16_b64_v4i16((LAS v4s*)p), hi = __builtin_amdgcn_ds_read_tr16_b64_v4i16((LAS v4s*)(p + 4 * 136));
    return (bf16x8){lo[0], lo[1], lo[2], lo[3], hi[0], hi[1], hi[2], hi[3]};
}
__device__ __forceinline__ void spatial_phase(const Frame& F, KP P, int j) {
    bf16_t* U = (bf16_t*)(P->ws + WS_U); const bf16_t* V = (const bf16_t*)(P->ws + WS_V); const float* stat = (const float*)(P->ws + WS_STAT);
    const bf16_t* WSP = (const bf16_t*)(P->ws + WS_WSP) + (size_t)j * 16 * 128 * 128;
    const float* lng = P->in[I_GLNG] + (size_t)j * GWID; const float* lnb = P->in[I_GLNB] + (size_t)j * GWID; const float* bs = P->in[I_GBS] + (size_t)j * 16 * 128;
    LAS bf16_t* Wt = (LAS bf16_t*)F.lds; LAS bf16_t* Vn = Wt + 128 * 136;
    LAS float* mu = (LAS float*)(F.lds + 2 * 128 * 136 * 2); LAS float* rs = mu + 128;
    const int l15 = F.lane & 15, l4 = F.lane >> 4;
    for (int item = blockIdx.x; item < (T / 128) * 4; item += F.G) {
        const int c = item >> 2, gq = item & 3, t0 = c * 128;
        LDS_BARRIER();
        if (F.tid < 128) { const int row = t0 + F.tid; float s = 0.f, q = 0.f;
#pragma unroll 8
            for (int i = 0; i < 32; ++i) { const f32x2 p = *(const f32x2*)(stat + ((size_t)row * 32 + i) * 2); s += p.x; q += p.y; }
            const float mean = s * (1.0f / GWID), var = q * (1.0f / GWID) - mean * mean; mu[F.tid] = mean; rs[F.tid] = rsqrtf(var + 1e-5f); }
#pragma nounroll
        for (int gi = 0; gi < 4; ++gi) { const int g = gq * 4 + gi;
            u32x4 wv[4], vv[4];
#pragma unroll
            for (int i = 0; i < 4; ++i) { const int idx = F.tid + NTHR * i, r = idx >> 4, seg = idx & 15;
                wv[i] = *(const u32x4*)(WSP + ((size_t)g * 128 + r) * 128 + seg * 8); vv[i] = *(const u32x4*)(V + (size_t)(t0 + r) * GWID + g * 128 + seg * 8); }
            LDS_BARRIER();
#pragma unroll
            for (int i = 0; i < 4; ++i) { const int idx = F.tid + NTHR * i, r = idx >> 4, seg = idx & 15, ch = g * 128 + seg * 8;
                *(LAS u32x4*)(Wt + r * 136 + seg * 8) = wv[i];
                float x[8], o[8]; unpack8(vv[i], x); const float m_ = mu[r], r_ = rs[r];
                const f32x4 g0 = *(const f32x4*)(lng + ch), g1 = *(const f32x4*)(lng + ch + 4), b0 = *(const f32x4*)(lnb + ch), b1 = *(const f32x4*)(lnb + ch + 4);
#pragma unroll
                for (int e = 0; e < 8; ++e) o[e] = (x[e] - m_) * r_ * (e < 4 ? g0[e & 3] : g1[e & 3]) + (e < 4 ? b0[e & 3] : b1[e & 3]);
                *(LAS u32x4*)(Vn + r * 136 + seg * 8) = pack8(o); }
            LDS_BARRIER();
            bf16x8 bw[4];
#pragma unroll
            for (int ks = 0; ks < 4; ++ks) bw[ks] = *(const LAS bf16x8*)(Wt + (16 * F.wave + l15) * 136 + ks * 32 + 8 * l4);
            const int p = 16 * F.wave + l15; const float bias = bs[g * 128 + p];
            bf16_t* urow = U + (size_t)(t0 + p) * GWID + g * 128 + 4 * l4;
            u32x2 uu[8];
#pragma unroll
            for (int dt = 0; dt < 8; ++dt) uu[dt] = *(const u32x2*)(urow + dt * 16);
#pragma unroll
            for (int dt = 0; dt < 8; ++dt) { f32x4 acc = (f32x4){0.f, 0.f, 0.f, 0.f};
#pragma unroll
                for (int ks = 0; ks < 4; ++ks) { const bf16x8 a = tr_frag136(Vn, 32 * ks, 16 * dt, F.lane); acc = __builtin_amdgcn_mfma_f32_16x16x32_bf16(a, bw[ks], acc, 0, 0, 0); }
                u32x2 o; o.x = cvt_pk_bf16(bf_lo(uu[dt].x) * (acc[0] + bias), bf_hi(uu[dt].x) * (acc[1] + bias)); o.y = cvt_pk_bf16(bf_lo(uu[dt].y) * (acc[2] + bias), bf_hi(uu[dt].y) * (acc[3] + bias));
                *(u32x2*)(urow + dt * 16) = o; }
        }
    }
}

__device__ __forceinline__ void mix_phase(const Frame& F, KP P, int j) {
    const bf16_t* HL = (const bf16_t*)(P->ws + WS_HL); const float* mu = P->in[I_MU] + (size_t)j * 6 * D;
    bf16_t* outs[6] = {(bf16_t*)(P->ws + WS_XR), (bf16_t*)(P->ws + WS_XW), (bf16_t*)(P->ws + WS_XK), (bf16_t*)(P->ws + WS_XV), (bf16_t*)(P->ws + WS_XA), (bf16_t*)(P->ws + WS_XG)};
    for (int row = F.gw; row < T; row += F.NGW) {
        bool ok[2]; int src[2]; const bool hi = F.lane >= 32;
        if (row < TL) { const int n = row & (SEQ - 1), gc = n & 63, gr = n >> 6;
            ok[0] = hi ? gc < 63 : gc > 0; src[0] = hi ? row + 1 : row - 1; ok[1] = hi ? gr < 255 : gr > 0; src[1] = hi ? row + 64 : row - 64; }
        else { const int n = (row - TL) & (CTXL - 1); ok[0] = n > 0; src[0] = row - 1; ok[1] = n < CTXL - 1; src[1] = row + 1; }
#pragma unroll
        for (int jj = 0; jj < 2; ++jj) { const int col = 512 * jj + 8 * F.lane;
            const u32x4 h8 = *(const u32x4*)(HL + (size_t)row * D + col); u32x4 s8 = (u32x4){0u, 0u, 0u, 0u};
            if (ok[jj]) s8 = *(const u32x4*)(HL + (size_t)src[jj] * D + col);
            const unsigned hw[4] = {h8.x, h8.y, h8.z, h8.w}, sw[4] = {s8.x, s8.y, s8.z, s8.w}; float h[8], xx[8];
#pragma unroll
            for (int e = 0; e < 8; ++e) { h[e] = (e & 1) ? bf_hi(hw[e >> 1]) : bf_lo(hw[e >> 1]); const float s = (e & 1) ? bf_hi(sw[e >> 1]) : bf_lo(sw[e >> 1]); xx[e] = s - h[e]; }
#pragma unroll
            for (int m = 0; m < 6; ++m) { const f32x4 ma = *(const f32x4*)(mu + (size_t)m * D + col), mb = *(const f32x4*)(mu + (size_t)m * D + col + 4);
                u32x4 o; o.x = cvt_pk_bf16(h[0] + xx[0] * ma[0], h[1] + xx[1] * ma[1]); o.y = cvt_pk_bf16(h[2] + xx[2] * ma[2], h[3] + xx[3] * ma[3]);
                o.z = cvt_pk_bf16(h[4] + xx[4] * mb[0], h[5] + xx[5] * mb[1]); o.w = cvt_pk_bf16(h[6] + xx[6] * mb[2], h[7] + xx[7] * mb[3]);
                *(u32x4*)(outs[m] + (size_t)row * D + col) = o; } }
    }
}

constexpr int NSC = 65, NSCAN = 64, TP = 72, TILE_B = 64 * TP * 2;
enum { T_AT = 0, T_RT, T_BT, T_KT, T_VM, T_NT, T_MT, T_NRT, T_MRT, T_APA, T_APB, T_TAA, T_TAB, T_PRB, T_QRB, T_NTILE };
constexpr int LDS_GL = T_NTILE * TILE_B, LDS_SEG = LDS_GL + 256;
static_assert(LDS_SEG + 2048 <= LDS_MISC, "scan LDS map");
__device__ __forceinline__ int scan_row(int z, int b, int p) {
    if (p < CTXL) return TL + b * CTXL + (z ? CTXL - 1 - p : p);
    const int q = p - CTXL; return b * SEQ + (z ? SEQ - 1 - q : q);
}
__device__ __forceinline__ LAS bf16_t* stile(LAS unsigned char* lds, int n) { return (LAS bf16_t*)(lds + n * TILE_B); }
__device__ __forceinline__ bf16x8 row_frag(const LAS bf16_t* M, int r0, int k0, int lane) { return *(const LAS bf16x8*)(M + (r0 + (lane & 15)) * TP + k0 + 8 * (lane >> 4)); }
__device__ __forceinline__ bf16x8 tr_frag(const LAS bf16_t* M, int k0, int c0, int lane) {
    LAS bf16_t* p = (LAS bf16_t*)M + (k0 + 8 * (lane >> 4) + ((lane & 15) >> 2)) * TP + c0 + 4 * (lane & 3);
    const v4s lo = __builtin_amdgcn_ds_read_tr16_b64_v4i16((LAS v4s*)p), hi = __builtin_amdgcn_ds_read_tr16_b64_v4i16((LAS v4s*)(p + 4 * TP));
    return (bf16x8){lo[0], lo[1], lo[2], lo[3], hi[0], hi[1], hi[2], hi[3]};
}
template <bool XT, bool YT>
__device__ __forceinline__ void mm64(const LAS bf16_t* X, const LAS bf16_t* Y, f32x4 (&acc)[2], int wq, int wh, int lane) {
#pragma unroll
    for (int ks = 0; ks < 2; ++ks) {
        const bf16x8 b = XT ? tr_frag(X, 32 * ks, 16 * wq, lane) : row_frag(X, 16 * wq, 32 * ks, lane);
#pragma unroll
        for (int q = 0; q < 2; ++q) { const int i0 = 16 * (2 * wh + q);
            const bf16x8 a = YT ? row_frag(Y, i0, 32 * ks, lane) : tr_frag(Y, 32 * ks, i0, lane);
            acc[q] = __builtin_amdgcn_mfma_f32_16x16x32_bf16(a, b, acc[q], 0, 0, 0); }
    }
}
__device__ __forceinline__ void st_tile(LAS bf16_t* Z, const f32x4 (&acc)[2], int wq, int wh, int lane) {
#pragma unroll
    for (int q = 0; q < 2; ++q) { u32x2 o; o.x = cvt_pk_bf16(acc[q][0], acc[q][1]); o.y = cvt_pk_bf16(acc[q][2], acc[q][3]);
        *(LAS u32x2*)(Z + (16 * wq + (lane & 15)) * TP + 16 * (2 * wh + q) + 4 * (lane >> 4)) = o; }
}
__device__ __forceinline__ void ld_tile(const LAS bf16_t* Z, f32x4 (&acc)[2], int wq, int wh, int lane) {
#pragma unroll
    for (int q = 0; q < 2; ++q) { const u32x2 o = *(const LAS u32x2*)(Z + (16 * wq + (lane & 15)) * TP + 16 * (2 * wh + q) + 4 * (lane >> 4));
        acc[q] = (f32x4){bf_lo(o.x), bf_hi(o.x), bf_lo(o.y), bf_hi(o.y)}; }
}
__device__ __forceinline__ f32x4 prod16(const LAS bf16_t* X, int xr, int xc, const LAS bf16_t* Y, int yr, int yc, f32x4 acc, int lane) {
    bf16x8 b = *(const LAS bf16x8*)(X + (xr + (lane & 15)) * TP + xc + 8 * (lane >> 4)); bf16x8 a = tr_frag(Y, yr, yc, lane);
    if ((lane >> 4) >= 2) { b = (bf16x8){0, 0, 0, 0, 0, 0, 0, 0}; a = (bf16x8){0, 0, 0, 0, 0, 0, 0, 0}; }
    return __builtin_amdgcn_mfma_f32_16x16x32_bf16(a, b, acc, 0, 0, 0);
}
__device__ __forceinline__ void st16(LAS bf16_t* Z, int zr, int zc, f32x4 acc, int lane) { u32x2 o; o.x = cvt_pk_bf16(acc[0], acc[1]); o.y = cvt_pk_bf16(acc[2], acc[3]); *(LAS u32x2*)(Z + (zr + (lane & 15)) * TP + zc + 4 * (lane >> 4)) = o; }
__device__ __forceinline__ f32x4 ld16(const LAS bf16_t* Z, int zr, int zc, int lane) { const u32x2 o = *(const LAS u32x2*)(Z + (zr + (lane & 15)) * TP + zc + 4 * (lane >> 4)); return (f32x4){bf_lo(o.x), bf_hi(o.x), bf_lo(o.y), bf_hi(o.y)}; }
struct ChunkRegs { u32x4 r, k, v, tw, ta; };
__device__ __forceinline__ void scan_load(KP P, const Frame& F, int item, int c4, ChunkRegs& R) {
    const int s = item & 63, sc = item >> 6, z = s >> 5, b = (s >> 4) & 1, hh = s & 15;
    const size_t row = (size_t)scan_row(z, b, sc * 256 + c4 * 64 + (F.tid >> 3)); const size_t o = row * D + hh * 64 + (F.tid & 7) * 8, o2 = row * 256 + z * 64 + (F.tid & 7) * 8;
    R.r = *(const u32x4*)((const bf16_t*)(P->ws + WS_R) + o); R.k = *(const u32x4*)((const bf16_t*)(P->ws + WS_K) + o); R.v = *(const u32x4*)((const bf16_t*)(P->ws + WS_VV) + o);
    R.tw = *(const u32x4*)((const bf16_t*)(P->ws + WS_TW) + o2); R.ta = *(const u32x4*)((const bf16_t*)(P->ws + WS_TA) + o2);
}
__device__ __forceinline__ void scan_chunk_phase(const Frame& F, KP P, int j) {
    LAS unsigned char* lds = F.lds;
    LAS bf16_t* At = stile(lds, T_AT); LAS bf16_t* Rt = stile(lds, T_RT); LAS bf16_t* Bt = stile(lds, T_BT); LAS bf16_t* Kt = stile(lds, T_KT); LAS bf16_t* Vm = stile(lds, T_VM);
    LAS bf16_t* NT = stile(lds, T_NT); LAS bf16_t* MT = stile(lds, T_MT); LAS bf16_t* NrT = stile(lds, T_NRT); LAS bf16_t* MrT = stile(lds, T_MRT);
    LAS bf16_t* ApA = stile(lds, T_APA); LAS bf16_t* ApB = stile(lds, T_APB); LAS bf16_t* TaA = stile(lds, T_TAA); LAS bf16_t* TaB = stile(lds, T_TAB);
    LAS bf16_t* PrB = stile(lds, T_PRB); LAS bf16_t* QrB = stile(lds, T_QRB);
    LAS float* gl = (LAS float*)(lds + LDS_GL); LAS float* seg = (LAS float*)(lds + LDS_SEG);
    const int lane = F.lane, wq = F.wave & 3, wh = F.wave >> 2, l15 = lane & 15, l4 = lane >> 4;
    const int pi = F.tid >> 3, kq = F.tid & 7;
    const int jrow = 16 * wq + l15;
    const int NITEM = NSCAN * NSC;
    int item = blockIdx.x; if (item >= NITEM) return;
    ChunkRegs cur, nxt; scan_load(P, F, item, 0, cur); nxt = cur;
    f32x4 Pr[2], Qr[2], aYp[2], aQp[2];
#pragma unroll
    for (int q = 0; q < 2; ++q) { Pr[q] = (f32x4){0.f, 0.f, 0.f, 0.f}; Qr[q] = Pr[q]; aYp[q] = Pr[q]; aQp[q] = Pr[q]; }
    bool pend = false; size_t orowp = 0; bf16_t* GEp = nullptr; bf16_t* YEp = nullptr; float* pqp = nullptr; bool lastp = false;
#define SCAN_STAGE_G() do { \
        f32x4 ge[2] = {(f32x4){0.f, 0.f, 0.f, 0.f}, (f32x4){0.f, 0.f, 0.f, 0.f}}; \
        mm64<false, true>(NT, PrB, ge, wq, wh, lane); mm64<false, true>(NT, QrB, aYp, wq, wh, lane); \
        f32x4 pn[2] = {(f32x4){0.f, 0.f, 0.f, 0.f}, (f32x4){0.f, 0.f, 0.f, 0.f}}; \
        mm64<false, false>(PrB, MT, pn, wq, wh, lane); mm64<false, false>(QrB, MT, aQp, wq, wh, lane); \
        _Pragma("unroll") for (int q = 0; q < 2; ++q) { const int i0 = 16 * (2 * wh + q) + 4 * l4; \
            u32x2 o; o.x = cvt_pk_bf16(ge[q][0], ge[q][1]); o.y = cvt_pk_bf16(ge[q][2], ge[q][3]); *(u32x2*)(GEp + orowp + i0) = o; \
            u32x2 y; y.x = cvt_pk_bf16(aYp[q][0], aYp[q][1]); y.y = cvt_pk_bf16(aYp[q][2], aYp[q][3]); *(u32x2*)(YEp + orowp + i0) = y; \
            Pr[q] = pn[q]; Qr[q] = aQp[q]; } \
        if (lastp) { _Pragma("unroll") for (int q = 0; q < 2; ++q) { const int i0 = 16 * (2 * wh + q) + 4 * l4; *(f32x4*)(pqp + jrow * 64 + i0) = Pr[q]; *(f32x4*)(pqp + 4096 + jrow * 64 + i0) = Qr[q]; } } \
    } while (0)
    for (;;) {
        const int s = item & 63, sc = item >> 6, z = s >> 5, b = (s >> 4) & 1, hh = s & 15;
        const float* kkw = P->in[I_KK] + (size_t)j * D + hh * 64 + kq * 8; const float* kap = P->in[I_KA] + (size_t)j * D + hh * 64 + kq * 8; const float* rkp = P->in[I_RK] + (size_t)j * D + hh * 64 + kq * 8;
        const float* w0p = P->in[I_W0] + ((size_t)j * 2 + z) * D + hh * 64; const float* a0p = P->in[I_A0] + ((size_t)j * 2 + z) * D + hh * 64;
        float* bon = (float*)(P->ws + WS_BON) + (size_t)z * T * 16;
        const u32x4 w2r = *(const u32x4*)((const bf16_t*)(P->ws + WS_W2P) + (((size_t)j * 2 + z) * D + hh * 64 + pi) * 256 + z * 64 + kq * 8);
        const u32x4 a2r = *(const u32x4*)((const bf16_t*)(P->ws + WS_A2P) + (((size_t)j * 2 + z) * D + hh * 64 + pi) * 256 + z * 64 + kq * 8);
        bf16_t* GE = (bf16_t*)(P->ws + (z ? WS_AS1 : WS_AS0)); bf16_t* YE = (bf16_t*)(P->ws + (z ? WS_ELOG1 : WS_ELOG0));
        float* pq = (float*)(P->ws + WS_PQ) + ((size_t)(s * NSC + sc) * 2) * 4096;
#pragma nounroll
        for (int c4 = 0; c4 < 4; ++c4) {
            unsigned long long ch_t[12]; ch_t[11] = CH_AMP >= 0 ? __builtin_amdgcn_s_memrealtime() : 0ull;
            *(LAS u32x4*)(ApA + pi * TP + kq * 8) = cur.tw; *(LAS u32x4*)(ApB + pi * TP + kq * 8) = cur.ta; *(LAS u32x4*)(NrT + pi * TP + kq * 8) = w2r; *(LAS u32x4*)(MrT + pi * TP + kq * 8) = a2r;
            LDS_BARRIER(); CH_STAMP(0);
            {   f32x4 lw[2] = {(f32x4){0.f, 0.f, 0.f, 0.f}, (f32x4){0.f, 0.f, 0.f, 0.f}}, la[2] = {(f32x4){0.f, 0.f, 0.f, 0.f}, (f32x4){0.f, 0.f, 0.f, 0.f}};
                mm64<false, true>(ApA, NrT, lw, wq, wh, lane); mm64<false, true>(ApB, MrT, la, wq, wh, lane);
#pragma unroll
                for (int q = 0; q < 2; ++q) { const int i0 = 16 * (2 * wh + q) + 4 * l4; const f32x4 w04 = *(const f32x4*)(w0p + i0), a04 = *(const f32x4*)(a0p + i0);
#pragma unroll
                    for (int r = 0; r < 4; ++r) { lw[q][r] = -0.60653065971f * sigmoidf_(w04[r] + lw[q][r]); la[q][r] = sigmoidf_(a04[r] + la[q][r]); } }
                st_tile(TaA, lw, wq, wh, lane); st_tile(TaB, la, wq, wh, lane); }
            LDS_BARRIER(); CH_STAMP(1);
            float r8[8], k8[8], e8[8], m8[8], a8[8], kk8[8], c8[8];
            { const u32x4 et = *(const LAS u32x4*)(TaA + pi * TP + kq * 8), at = *(const LAS u32x4*)(TaB + pi * TP + kq * 8); unpack8(cur.r, r8); unpack8(cur.k, k8); unpack8(et, e8); unpack8(at, a8); }
            {   const f32x4 ka0 = *(const f32x4*)(kap), ka1 = *(const f32x4*)(kap + 4), rk0 = *(const f32x4*)(rkp), rk1 = *(const f32x4*)(rkp + 4); float bp = 0.f;
#pragma unroll
                for (int e = 0; e < 8; ++e) { m8[e] = k8[e] * (1.0f + (a8[e] - 1.0f) * (e < 4 ? ka0[e & 3] : ka1[e & 3])); bp += r8[e] * (e < 4 ? rk0[e & 3] : rk1[e & 3]) * m8[e]; }
                bp += shx(bp, 1, lane); bp += shx(bp, 2, lane); bp += shx(bp, 4, lane);
                if (kq == 0) bon[(size_t)scan_row(z, b, sc * 256 + c4 * 64 + pi) * 16 + hh] = bp; }
            { const f32x4 w0 = *(const f32x4*)kkw, w1 = *(const f32x4*)(kkw + 4); float ss = 0.f;
#pragma unroll
              for (int e = 0; e < 8; ++e) { kk8[e] = k8[e] * (e < 4 ? w0[e & 3] : w1[e & 3]); ss += kk8[e] * kk8[e]; }
              ss += shx(ss, 1, lane); ss += shx(ss, 2, lane); ss += shx(ss, 4, lane);
              const float rn = rsqrtf(ss + 1e-12f);
#pragma unroll
              for (int e = 0; e < 8; ++e) { kk8[e] *= rn; c8[e] = e8[e]; } }
#pragma unroll
            for (int d = 8; d < 64; d <<= 1) {
#pragma unroll
                for (int e = 0; e < 8; ++e) { const float t = shup(c8[e], d, lane); c8[e] += lane >= d ? t : 0.f; } }
            if (lane >= 56) { *(LAS f32x4*)(seg + F.wave * 64 + kq * 8) = (f32x4){c8[0], c8[1], c8[2], c8[3]}; *(LAS f32x4*)(seg + F.wave * 64 + kq * 8 + 4) = (f32x4){c8[4], c8[5], c8[6], c8[7]}; }
            if (pend) { SCAN_STAGE_G(); pend = false; }
            LDS_BARRIER(); CH_STAMP(2);
            if (c4 > 0) { st_tile(PrB, Pr, wq, wh, lane); st_tile(QrB, Qr, wq, wh, lane); }
            { float cum[8];
#pragma unroll
              for (int e = 0; e < 8; ++e) cum[e] = c8[e];
              for (int w2 = 0; w2 < F.wave; ++w2) { const f32x4 o0 = *(const LAS f32x4*)(seg + w2 * 64 + kq * 8), o1 = *(const LAS f32x4*)(seg + w2 * 64 + kq * 8 + 4);
#pragma unroll
                  for (int e = 0; e < 8; ++e) cum[e] += e < 4 ? o0[e & 3] : o1[e & 3]; }
              float o[8];
#pragma unroll
              for (int e = 0; e < 8; ++e) o[e] = -kk8[e] * __expf(cum[e] - e8[e]);
              *(LAS u32x4*)(At + pi * TP + kq * 8) = pack8(o);
#pragma unroll
              for (int e = 0; e < 8; ++e) o[e] = r8[e] * __expf(cum[e]);
              *(LAS u32x4*)(Rt + pi * TP + kq * 8) = pack8(o);
              float en[8];
#pragma unroll
              for (int e = 0; e < 8; ++e) { en[e] = __expf(-cum[e]); o[e] = kk8[e] * a8[e] * en[e]; }
              *(LAS u32x4*)(Bt + pi * TP + kq * 8) = pack8(o);
#pragma unroll
              for (int e = 0; e < 8; ++e) o[e] = m8[e] * en[e];
              *(LAS u32x4*)(Kt + pi * TP + kq * 8) = pack8(o);
              *(LAS u32x4*)(Vm + pi * TP + kq * 8) = cur.v;
              if (pi == 63) {
#pragma unroll
                  for (int e = 0; e < 8; ++e) gl[kq * 8 + e] = __expf(cum[e]); } }
            { const int nitem = c4 < 3 ? item : item + (int)gridDim.x, nc4 = c4 < 3 ? c4 + 1 : 0; if (nitem < NITEM) scan_load(P, F, nitem, nc4, nxt); }
            LDS_BARRIER(); CH_STAMP(3);
            {   f32x4 aN[2], aM[2], aNr[2], aMr[2];
#pragma unroll
                for (int q = 0; q < 2; ++q) { aN[q] = (f32x4){0.f, 0.f, 0.f, 0.f}; aM[q] = aN[q]; aNr[q] = aN[q]; aMr[q] = aN[q]; }
                mm64<false, true>(At, Bt, aN, wq, wh, lane); mm64<false, true>(At, Kt, aM, wq, wh, lane); mm64<false, true>(Rt, Bt, aNr, wq, wh, lane); mm64<false, true>(Rt, Kt, aMr, wq, wh, lane);
                f32x4 aT[2];
#pragma unroll
                for (int q = 0; q < 2; ++q)
#pragma unroll
                    for (int r = 0; r < 4; ++r) { const int i = 16 * (2 * wh + q) + 4 * l4 + r; const bool lt = i < jrow, le = i <= jrow;
                        aN[q][r] = lt ? aN[q][r] : 0.f; aM[q][r] = lt ? aM[q][r] : 0.f; aNr[q][r] = le ? aNr[q][r] : 0.f; aMr[q][r] = le ? aMr[q][r] : 0.f; aT[q][r] = aN[q][r] + (i == jrow ? 1.f : 0.f); }
                st_tile(NT, aN, wq, wh, lane); st_tile(MT, aM, wq, wh, lane); st_tile(NrT, aNr, wq, wh, lane); st_tile(MrT, aMr, wq, wh, lane); st_tile(TaA, aT, wq, wh, lane);
            }
            LDS_BARRIER(); CH_STAMP(4);
            if (F.wave < 4) { const int o = 16 * F.wave, oc = 16 * ((F.wave + 1) & 3);
                f32x4 p = prod16(NT, o, o, NT, o, o, (f32x4){0.f, 0.f, 0.f, 0.f}, lane); st16(ApA, o, o, p, lane);
                f32x4 t = prod16(TaA, o, o, ApA, o, o, ld16(TaA, o, o, lane), lane); p = prod16(ApA, o, o, ApA, o, o, (f32x4){0.f, 0.f, 0.f, 0.f}, lane);
                st16(TaB, o, o, t, lane); st16(ApA, o, oc, p, lane);
                t = prod16(TaB, o, o, ApA, o, oc, ld16(TaB, o, o, lane), lane); p = prod16(ApA, o, oc, ApA, o, oc, (f32x4){0.f, 0.f, 0.f, 0.f}, lane);
                st16(TaA, o, o, t, lane); st16(ApA, o, o, p, lane);
                t = prod16(TaA, o, o, ApA, o, o, ld16(TaA, o, o, lane), lane); st16(TaB, o, o, t, lane);
#pragma unroll
                for (int jj = 1; jj < 4; ++jj) if (jj > F.wave) { u32x2 zz; asm volatile("v_mov_b32 %0, 0\n\tv_mov_b32 %1, 0" : "=v"(zz.x), "=v"(zz.y)); *(LAS u32x2*)(TaB + (o + l15) * TP + 16 * jj + 4 * l4) = zz; }
            } else { const int wq2 = F.wave - 4;
#pragma unroll
                for (int wh2 = 0; wh2 < 2; ++wh2) { f32x4 x[2] = {(f32x4){0.f, 0.f, 0.f, 0.f}, (f32x4){0.f, 0.f, 0.f, 0.f}}; mm64<true, true>(Vm, MT, x, wq2, wh2, lane); st_tile(ApB, x, wq2, wh2, lane); } }
            LDS_BARRIER(); CH_STAMP(5);
            if (F.wave < 3) { const int jj = F.wave;
#pragma unroll
                for (int i = 1; i < 4; ++i) if (i > jj) { f32x4 e = (f32x4){0.f, 0.f, 0.f, 0.f};
#pragma unroll
                    for (int m = 0; m < 3; ++m) if (m >= jj && m < i) e = prod16(NT, 16 * i, 16 * m, TaB, 16 * m, 16 * jj, e, lane);
                    st16(ApA, 16 * i, 16 * jj, e, lane);
                    st16(TaB, 16 * i, 16 * jj, prod16(TaB, 16 * i, 16 * i, ApA, 16 * i, 16 * jj, (f32x4){0.f, 0.f, 0.f, 0.f}, lane), lane); } }
            LDS_BARRIER(); CH_STAMP(6);
            {   f32x4 w[2] = {(f32x4){0.f, 0.f, 0.f, 0.f}, (f32x4){0.f, 0.f, 0.f, 0.f}}; mm64<true, true>(At, TaB, w, wq, wh, lane); st_tile(ApA, w, wq, wh, lane);
                f32x4 u[2] = {(f32x4){0.f, 0.f, 0.f, 0.f}, (f32x4){0.f, 0.f, 0.f, 0.f}}; mm64<false, true>(ApB, TaB, u, wq, wh, lane); st_tile(TaA, u, wq, wh, lane); }
            LDS_BARRIER(); CH_STAMP(7);
            f32x4 aP[2], aQ[2], aG[2], aY[2];
#pragma unroll
            for (int q = 0; q < 2; ++q) { aP[q] = (f32x4){0.f, 0.f, 0.f, 0.f}; aQ[q] = aP[q]; aG[q] = aP[q]; aY[q] = aP[q]; }
            mm64<false, false>(ApA, Bt, aP, wq, wh, lane);
            mm64<false, false>(TaA, Bt, aQ, wq, wh, lane); mm64<true, false>(Vm, Kt, aQ, wq, wh, lane);
            mm64<false, true>(NrT, ApA, aG, wq, wh, lane);
            mm64<false, true>(NrT, TaA, aY, wq, wh, lane); mm64<false, false>(MrT, Vm, aY, wq, wh, lane);
#pragma unroll
            for (int q = 0; q < 2; ++q) { const int i0 = 16 * (2 * wh + q) + 4 * l4; const f32x4 g4 = *(const LAS f32x4*)(gl + i0);
                const u32x2 rr = *(const LAS u32x2*)(Rt + jrow * TP + i0);
#pragma unroll
                for (int r = 0; r < 4; ++r) { aP[q][r] = (aP[q][r] + (i0 + r == jrow ? 1.f : 0.f)) * g4[r]; aQ[q][r] *= g4[r]; }
                aG[q][0] += bf_lo(rr.x); aG[q][1] += bf_hi(rr.x); aG[q][2] += bf_lo(rr.y); aG[q][3] += bf_hi(rr.y); }
            const size_t orow = (size_t)scan_row(z, b, sc * 256 + c4 * 64 + jrow) * D + hh * 64;
            if (c4 == 0) {
#pragma unroll
                for (int q = 0; q < 2; ++q) { const int i0 = 16 * (2 * wh + q) + 4 * l4;
                    u32x2 o; o.x = cvt_pk_bf16(aG[q][0], aG[q][1]); o.y = cvt_pk_bf16(aG[q][2], aG[q][3]); *(u32x2*)(GE + orow + i0) = o;
                    u32x2 y; y.x = cvt_pk_bf16(aY[q][0], aY[q][1]); y.y = cvt_pk_bf16(aY[q][2], aY[q][3]); *(u32x2*)(YE + orow + i0) = y;
                    Pr[q] = aP[q]; Qr[q] = aQ[q]; }
            } else {
                st_tile(NT, aG, wq, wh, lane); st_tile(MT, aP, wq, wh, lane);
#pragma unroll
                for (int q = 0; q < 2; ++q) { aYp[q] = aY[q]; aQp[q] = aQ[q]; }
                pend = true; orowp = orow; GEp = GE; YEp = YE; pqp = pq; lastp = c4 == 3;
            }
            cur = nxt;
            if (CH_AMP >= 0) { const unsigned long long d_ = CH_AMP == 0 ? ch_t[0] - ch_t[11] : ch_t[CH_AMP] - ch_t[CH_AMP - 1]; const unsigned long long dl_ = __builtin_amdgcn_s_memrealtime() + 4 * d_; while (__builtin_amdgcn_s_memrealtime() < dl_) __builtin_amdgcn_s_sleep(4); }
            LDS_BARRIER(); CH_STAMP(8);
        }
        item += gridDim.x; if (item >= NITEM) break;
    }
    if (pend) { SCAN_STAGE_G(); }
#undef SCAN_STAGE_G
}
__device__ __forceinline__ void scan_carry_phase(const Frame& F, KP P) {
    if (blockIdx.x >= 4 * NSCAN) return;
    const int s = blockIdx.x >> 2, vs = blockIdx.x & 3, lane = F.lane, l15 = lane & 15, l4 = lane >> 4, v = 16 * vs + l15, T2 = F.wave;
    const float* pq = (const float*)(P->ws + WS_PQ) + (size_t)s * NSC * 2 * 4096; bf16_t* sst = (bf16_t*)(P->ws + WS_SST) + (size_t)s * NSC * 4096;
    LAS f32x4* exch = (LAS f32x4*)F.lds;
    f32x4 S[4]; float ap[4][16], qp[4][4];
#pragma unroll
    for (int t = 0; t < 4; ++t) S[t] = (f32x4){0.f, 0.f, 0.f, 0.f};
#define CARRY_LOAD(slot, step) do { const float* Pm_ = pq + (size_t)(step) * 2 * 4096; \
        _Pragma("unroll") for (int t2i = 0; t2i < 4; ++t2i) _Pragma("unroll") for (int ri = 0; ri < 4; ++ri) ap[slot][t2i * 4 + ri] = Pm_[(16 * l4 + 4 * ri + t2i) * 64 + 4 * l15 + T2]; \
        _Pragma("unroll") for (int r = 0; r < 4; ++r) qp[slot][r] = Pm_[4096 + v * 64 + 16 * l4 + 4 * r + T2]; } while (0)
#define CARRY_STORE(sc_) do { if (T2 == 0) { float o[16]; \
        _Pragma("unroll") for (int r = 0; r < 4; ++r) _Pragma("unroll") for (int t2 = 0; t2 < 4; ++t2) o[4 * r + t2] = S[t2][r]; \
        u32x4 w0, w1; w0.x = cvt_pk_bf16(o[0], o[1]); w0.y = cvt_pk_bf16(o[2], o[3]); w0.z = cvt_pk_bf16(o[4], o[5]); w0.w = cvt_pk_bf16(o[6], o[7]); \
        w1.x = cvt_pk_bf16(o[8], o[9]); w1.y = cvt_pk_bf16(o[10], o[11]); w1.z = cvt_pk_bf16(o[12], o[13]); w1.w = cvt_pk_bf16(o[14], o[15]); \
        *(u32x4*)(sst + (size_t)(sc_) * 4096 + v * 64 + 16 * l4) = w0; *(u32x4*)(sst + (size_t)(sc_) * 4096 + v * 64 + 16 * l4 + 8) = w1; } } while (0)
    if (T2 < 4) {
#pragma unroll
        for (int u = 0; u < 4; ++u) CARRY_LOAD(u, u);
    }
#pragma nounroll
    for (int sc0 = 0; sc0 < NSC - 1; sc0 += 4) {
#pragma unroll
        for (int u = 0; u < 4; ++u) { const int sc = sc0 + u;
            CARRY_STORE(sc);
            if (T2 < 4) {
                f32x4 nw = (f32x4){qp[u][0], qp[u][1], qp[u][2], qp[u][3]};
#pragma unroll
                for (int t2i = 0; t2i < 4; ++t2i)
#pragma unroll
                    for (int ri = 0; ri < 4; ++ri) nw = __builtin_amdgcn_mfma_f32_16x16x4f32(ap[u][t2i * 4 + ri], S[t2i][ri], nw, 0, 0, 0);
                if (sc + 4 < NSC - 1) CARRY_LOAD(u, sc + 4);
                exch[((u & 1) * 4 + T2) * 64 + lane] = nw;
            }
            LDS_BARRIER();
            if (T2 < 4) {
#pragma unroll
                for (int t = 0; t < 4; ++t) S[t] = exch[((u & 1) * 4 + t) * 64 + lane];
            }
        }
    }
    CARRY_STORE(NSC - 1);
#undef CARRY_LOAD
#undef CARRY_STORE
}
__device__ __forceinline__ void scan_out_phase(const Frame& F, KP P, int j) {
    const int lane = F.lane, l15 = lane & 15, l4 = lane >> 4;
    const bf16_t* GE0 = (const bf16_t*)(P->ws + WS_AS0); const bf16_t* GE1 = (const bf16_t*)(P->ws + WS_AS1); const bf16_t* YE0 = (const bf16_t*)(P->ws + WS_ELOG0); const bf16_t* YE1 = (const bf16_t*)(P->ws + WS_ELOG1);
    const bf16_t* Vb = (const bf16_t*)(P->ws + WS_VV); const float* BON = (const float*)(P->ws + WS_BON);
    const bf16_t* GT = (const bf16_t*)(P->ws + WS_GATE); bf16_t* YG = (bf16_t*)(P->ws + WS_YG);
    for (int item = F.gw; item < NBATCH * NH * NSC * 8; item += F.NGW) {
        const int hh = item & 15, oct = (item >> 4) & 7, b = (item >> 7) & 1, blk = item >> 8;
        const int sc0 = blk, sc1 = blk == 0 ? 0 : NSC - blk;
        const bf16_t* s0 = (const bf16_t*)(P->ws + WS_SST) + ((size_t)(b * 16 + hh) * NSC + sc0) * 4096; const bf16_t* s1 = (const bf16_t*)(P->ws + WS_SST) + ((size_t)(32 + b * 16 + hh) * NSC + sc1) * 4096;
        bf16x8 sa0[4][2], sa1[4][2];
#pragma unroll
        for (int vt = 0; vt < 4; ++vt) { const int v = 32 * (vt >> 1) + 8 * (l15 >> 2) + 4 * (vt & 1) + (l15 & 3);
#pragma unroll
            for (int ks = 0; ks < 2; ++ks) { sa0[vt][ks] = *(const bf16x8*)(s0 + v * 64 + 32 * ks + 8 * l4); sa1[vt][ks] = *(const bf16x8*)(s1 + v * 64 + 32 * ks + 8 * l4); } }
        f32x4 lg4[4], lb4[4];
#pragma unroll
        for (int q = 0; q < 4; ++q) { const int c = hh * 64 + 32 * (q >> 1) + 8 * l4 + 4 * (q & 1); lg4[q] = *(const f32x4*)(P->in[I_LNG] + (size_t)j * D + c); lb4[q] = *(const f32x4*)(P->in[I_LNB] + (size_t)j * D + c); }
#pragma nounroll
        for (int ti = 0; ti < 2; ++ti) {
            const int tok = (2 * oct + ti) * 16 + l15; const int row = blk == 0 ? TL + b * CTXL + tok : b * SEQ + (blk - 1) * 256 + tok;
            const size_t o = (size_t)row * D + hh * 64;
            const bf16x8 g00 = *(const bf16x8*)(GE0 + o + 8 * l4), g01 = *(const bf16x8*)(GE0 + o + 32 + 8 * l4), g10 = *(const bf16x8*)(GE1 + o + 8 * l4), g11 = *(const bf16x8*)(GE1 + o + 32 + 8 * l4);
            u32x4 la[2], lc[2], lv[2], lgt[2];
#pragma unroll
            for (int h2 = 0; h2 < 2; ++h2) { const size_t oc = o + 32 * h2 + 8 * l4;
                la[h2] = *(const u32x4*)(YE0 + oc); lc[h2] = *(const u32x4*)(YE1 + oc); lv[h2] = *(const u32x4*)(Vb + oc); lgt[h2] = *(const u32x4*)(GT + oc); }
            const float bn = BON[(size_t)row * 16 + hh] + BON[((size_t)T + row) * 16 + hh];
            __builtin_amdgcn_sched_barrier(0);
            f32x4 y[4]; float s = 0.f; f32x4 vv[4], gg[4];
#pragma unroll
            for (int vt = 0; vt < 4; ++vt) { const int h2 = vt >> 1, hf = vt & 1;
                const unsigned ax = hf ? la[h2].z : la[h2].x, ay = hf ? la[h2].w : la[h2].y, cx = hf ? lc[h2].z : lc[h2].x, cy = hf ? lc[h2].w : lc[h2].y;
                const unsigned vx = hf ? lv[h2].z : lv[h2].x, vy = hf ? lv[h2].w : lv[h2].y, gx = hf ? lgt[h2].z : lgt[h2].x, gy = hf ? lgt[h2].w : lgt[h2].y;
                f32x4 acc = (f32x4){bf_lo(ax) + bf_lo(cx), bf_hi(ax) + bf_hi(cx), bf_lo(ay) + bf_lo(cy), bf_hi(ay) + bf_hi(cy)};
                acc = __builtin_amdgcn_mfma_f32_16x16x32_bf16(sa0[vt][0], g00, acc, 0, 0, 0); acc = __builtin_amdgcn_mfma_f32_16x16x32_bf16(sa0[vt][1], g01, acc, 0, 0, 0);
                acc = __builtin_amdgcn_mfma_f32_16x16x32_bf16(sa1[vt][0], g10, acc, 0, 0, 0); acc = __builtin_amdgcn_mfma_f32_16x16x32_bf16(sa1[vt][1], g11, acc, 0, 0, 0);
                y[vt] = acc; s += (acc[0] + acc[1]) + (acc[2] + acc[3]);
                vv[vt] = (f32x4){bf_lo(vx), bf_hi(vx), bf_lo(vy), bf_hi(vy)}; gg[vt] = (f32x4){bf_lo(gx), bf_hi(gx), bf_lo(gy), bf_hi(gy)}; }
            s += shx(s, 16, lane); s += shx(s, 32, lane);
            const float mean = s * (1.0f / 64.0f); float q = 0.f;
#pragma unroll
            for (int vt = 0; vt < 4; ++vt) { const f32x4 d = y[vt] - mean; q += (d[0] * d[0] + d[1] * d[1]) + (d[2] * d[2] + d[3] * d[3]); }
            q += shx(q, 16, lane); q += shx(q, 32, lane);
            const float rstd = rsqrtf(q * (1.0f / 64.0f) + 64e-5f);
#pragma unroll
            for (int h2 = 0; h2 < 2; ++h2) { const f32x4 o0 = (((y[2 * h2] - mean) * rstd) * lg4[2 * h2] + lb4[2 * h2] + vv[2 * h2] * bn) * gg[2 * h2], o1 = (((y[2 * h2 + 1] - mean) * rstd) * lg4[2 * h2 + 1] + lb4[2 * h2 + 1] + vv[2 * h2 + 1] * bn) * gg[2 * h2 + 1];
                u32x4 w; w.x = cvt_pk_bf16(o0[0], o0[1]); w.y = cvt_pk_bf16(o0[2], o0[3]); w.z = cvt_pk_bf16(o1[0], o1[1]); w.w = cvt_pk_bf16(o1[2], o1[3]); *(u32x4*)(YG + o + 32 * h2 + 8 * l4) = w; }
        }
    }
}
__device__ __forceinline__ bool in_range(int lo, int hi, int k) { asm volatile("" : "+s"(lo), "+s"(hi)); return lo <= k && k < hi; }
constexpr int NPH = 46;
template <unsigned KMASK> __global__ void __launch_bounds__(NTHR, 2) mega(Params Pv) {
    extern __shared__ __attribute__((aligned(16))) unsigned char lds_raw[];
    Frame F0; F0.lds = (LAS unsigned char*)lds_raw; F0.tid = threadIdx.x; F0.lane = F0.tid & 63; F0.wave = __builtin_amdgcn_readfirstlane(F0.tid >> 6);
    F0.G = gridDim.x; F0.gw = blockIdx.x * NWAVES + F0.wave; F0.NGW = F0.G * NWAVES;
    LAS unsigned* misc = (LAS unsigned*)(F0.lds + LDS_MISC);
    if (F0.tid < 128) misc[F0.tid] = 0u;
    __syncthreads();
    KP P0 = (KP)__builtin_amdgcn_kernarg_segment_ptr();
    constexpr bool ALL = (KMASK == 0x3ffffu);
    const int lo = ALL ? 0 : P0->ph_lo, hi = ALL ? NPH : P0->ph_hi;
    XcdBarrier bar; bar.bar = (unsigned*)(P0->ws + WS_CTL) + CW_BAR; bar.x = 0; bar.st = (volatile LAS unsigned*)(misc + 8);
    if (ALL || hi - lo > 1) bar = xcd_barrier_post((unsigned*)(P0->ws + WS_CTL) + CW_BAR, (volatile LAS unsigned*)(misc + 8));
#define IN(k) (ALL || in_range(lo, hi, (k)))
#define KIND(q) ((KMASK >> (q)) & 1u)
#define BAR_LEADER (wave_sgpr_now(F0.wave) == 0 && lane_id_now() == 0)
#define SEAM(k) do { if (IN(k) && IN((k) + 1)) { XcdBarrier b2_ = bar; unsigned* bb_ = bar.bar; unsigned bx_ = bar.x; asm volatile("" : "+s"(bb_), "+s"(bx_)); b2_.bar = bb_; b2_.x = bx_; xcd_barrier<false>(b2_, BAR_LEADER); } } while (0)
#define AMP_T0 const unsigned long long amp_t0 = AMP_MASK ? __builtin_amdgcn_s_memrealtime() : 0ull;
#define AMP_END(kind) do { if (AMP_MASK & (1u << (kind))) { const unsigned long long t1_ = __builtin_amdgcn_s_memrealtime(), dl_ = t1_ + AMP_F * (t1_ - amp_t0); while (__builtin_amdgcn_s_memrealtime() < dl_) __builtin_amdgcn_s_sleep(8); } } while (0)
#define PHASE_ENTRY AMP_T0 KP P = P0; asm volatile("" : "+s"(P)); unsigned char* ws = P->ws; unsigned* ctl = (unsigned*)(ws + WS_CTL); (void)ctl; \
    Frame F = F0; { int l_ = lane_id_now(), w_ = F0.wave; asm volatile("" : "+s"(w_)); F.lane = l_; F.wave = w_; F.tid = w_ * 64 + l_; F.gw = blockIdx.x * NWAVES + w_; }

    if constexpr (KIND(0)) if (IN(0)) { PHASE_ENTRY prologue_phase(F, P); AMP_END(0); }
    if (IN(0) && IN(1)) { XcdBarrier b2_ = bar; unsigned* bb_ = bar.bar; unsigned bx_ = bar.x; asm volatile("" : "+s"(bb_), "+s"(bx_)); b2_.bar = bb_; b2_.x = bx_; xcd_barrier<true>(b2_, BAR_LEADER); }
    for (int lp = 0; lp < 2; ++lp) {
        const int pb = 1 + 22 * lp, la = 2 * lp, lb = 2 * lp + 1;
        if constexpr (KIND(1)) if (IN(pb + 0)) { PHASE_ENTRY norm1_phase(F, P, la); AMP_END(1); }
        SEAM(pb + 0);
        if constexpr (KIND(2)) if (IN(pb + 1)) { PHASE_ENTRY
            __syncthreads(); set_desc(F.lds, F.tid, 0, ws + WS_HL, ws + WS_WIN + (size_t)lp * 4096 * D * 2, ws + WS_U, 16, 0, 0, ws + WS_V, P->in[I_GBIN] + (size_t)lp * 4096, ws + WS_STAT); __syncthreads();
            SchedMulti<D, D> S{F.lds, T / 256, 16, 1};
            EpiGelu E{F.lds};
            pg8::gemm_phase<EpiGelu, SchedMulti<D, D>, false, D, D, D>(F.lds, S, E, F.tid);
            AMP_END(2); }
        SEAM(pb + 1);
        if constexpr (KIND(3)) if (IN(pb + 2)) { PHASE_ENTRY spatial_phase(F, P, lp); AMP_END(3); }
        SEAM(pb + 2);
        if constexpr (KIND(4)) if (IN(pb + 3)) { PHASE_ENTRY
            __syncthreads();
            { bf16_t* X = (bf16_t*)(ws + WS_X);
              set_desc(F.lds, F.tid, 0, ws + WS_U, ws + WS_WOUT + (size_t)lp * D * GWID * 2, X, 4, 0, 0, X, X + (size_t)TL * D, P->in[I_GBOUT] + (size_t)lp * D);
              set_desc(F.lds, F.tid, 1, nullptr, nullptr, nullptr, 0, 0, 0, (const float*)(ws + WS_MOD) + (size_t)la * 3 * 6 * D + 2 * D); }
            __syncthreads();
            SchedMulti<GWID, GWID> S{F.lds, TL / 256, 4, 1};
            EpiResid E{F.lds};
            pg8::gemm_phase<EpiResid, SchedMulti<GWID, GWID>, false, GWID, GWID, GWID>(F.lds, S, E, F.tid);
            __syncthreads(); { int w_ = F0.wave; asm volatile("" : "+s"(w_)); tail_resid<GWID>(F0.lds, w_); }
            AMP_END(4); }
        SEAM(pb + 3);
        if constexpr (KIND(5)) if (IN(pb + 4)) { PHASE_ENTRY norm2_phase(F, P, la); AMP_END(5); }
        SEAM(pb + 4);
        if constexpr (KIND(16)) if (IN(pb + 5)) { PHASE_ENTRY
            __syncthreads(); set_desc(F.lds, F.tid, 0, ws + WS_HL, ws + WS_WRT + (size_t)la * 256 * D * 2, nullptr, 1, 0, 0); __syncthreads();
            SchedMulti<D, D> S{F.lds, (la == DEPTH - 1 ? TL : T) / 256, 1, 1};
            EpiLogits E{(float*)(ws + WS_LG)};
            pg8::gemm_phase<EpiLogits, SchedMulti<D, D>, false, D, D, D>(F.lds, S, E, F.tid);
            AMP_END(16); }
        SEAM(pb + 5);
        if constexpr (KIND(17)) if (IN(pb + 6)) { PHASE_ENTRY route_phase(F, P, la); AMP_END(17); }
        SEAM(pb + 6);
        if constexpr (KIND(6)) if (IN(pb + 7)) { PHASE_ENTRY
            moe_tables(F.lds, F.tid, ctl + CW_CNT + la * 64);
            SchedMoE<D, D, true> S{F.lds, (const char*)(ws + WS_HL), (const char*)(ws + WS_WGU), (const int*)(ws + WS_LIST)};
            EpiSiluGate E{(bf16_t*)(ws + WS_H)};
            pg8::gemm_phase<EpiSiluGate, SchedMoE<D, D, true>, true, D, D, D>(F.lds, S, E, F.tid);
            AMP_END(6); }
        SEAM(pb + 7);
        if constexpr (KIND(7)) if (IN(pb + 8)) { PHASE_ENTRY
            moe_tables(F.lds, F.tid, ctl + CW_CNT + la * 64);
            SchedMoE<EHID, EHID, false> S{F.lds, (const char*)(ws + WS_H), (const char*)(ws + WS_WD), (const int*)(ws + WS_LIST)};
            EpiScatter E{F.lds, (bf16_t*)(ws + WS_YB), (const int*)(ws + WS_LIST)};
            pg8::gemm_phase<EpiScatter, SchedMoE<EHID, EHID, false>, false, EHID, EHID, EHID>(F.lds, S, E, F.tid);
            AMP_END(7); }
        SEAM(pb + 8);
        if constexpr (KIND(1)) if (IN(pb + 9)) { PHASE_ENTRY norm1_phase(F, P, lb); AMP_END(1); }
        SEAM(pb + 9);
        if constexpr (KIND(8)) if (IN(pb + 10)) { PHASE_ENTRY mix_phase(F, P, lp); AMP_END(8); }
        SEAM(pb + 10);
        if constexpr (KIND(9)) if (IN(pb + 11)) { PHASE_ENTRY
            __syncthreads();
            set_desc(F.lds, F.tid, 0, ws + WS_XR, ws + WS_WR + (size_t)lp * D * D * 2, ws + WS_R, 4, D, 0);
            set_desc(F.lds, F.tid, 1, ws + WS_XK, ws + WS_WK + (size_t)lp * D * D * 2, ws + WS_K, 4, D, 0);
            set_desc(F.lds, F.tid, 2, ws + WS_XV, ws + WS_WV + (size_t)lp * D * D * 2, ws + WS_VV, 4, D, 0);
            set_desc(F.lds, F.tid, 3, ws + WS_XW, ws + WS_LW1 + (size_t)lp * 256 * D * 2, ws + WS_TW, 1, 256, 1);
            set_desc(F.lds, F.tid, 4, ws + WS_XA, ws + WS_LA1 + (size_t)lp * 256 * D * 2, ws + WS_TA, 1, 256, 0);
            set_desc(F.lds, F.tid, 5, ws + WS_XG, ws + WS_LG1 + (size_t)lp * 256 * D * 2, ws + WS_TG, 1, 256, 2);
            __syncthreads();
            SchedMulti<D, D> S{F.lds, T / 256, 15, 6};
            EpiAct E{F.lds};
            pg8::gemm_phase<EpiAct, SchedMulti<D, D>, false, D, D, D>(F.lds, S, E, F.tid);
            AMP_END(9); }
        SEAM(pb + 11);
        if constexpr (KIND(10)) if (IN(pb + 12)) { PHASE_ENTRY
            __syncthreads(); set_desc(F.lds, F.tid, 0, ws + WS_TG, ws + WS_G2P + (size_t)lp * D * 256 * 2, ws + WS_GATE, 4, D, 0); __syncthreads();
            SchedMulti<256, 256> S{F.lds, T / 256, 4, 1};
            EpiAct E{F.lds};
            pg8::gemm_phase<EpiAct, SchedMulti<256, 256>, false, 256, 256, 256>(F.lds, S, E, F.tid);
            AMP_END(10); }
        SEAM(pb + 12);
        if constexpr (KIND(11)) if (IN(pb + 13)) { PHASE_ENTRY scan_chunk_phase(F, P, lp); AMP_END(11); }
        SEAM(pb + 13);
        if constexpr (KIND(14)) if (IN(pb + 14)) { PHASE_ENTRY scan_carry_phase(F, P); AMP_END(14); }
        SEAM(pb + 14);
        if constexpr (KIND(15)) if (IN(pb + 15)) { PHASE_ENTRY scan_out_phase(F, P, lp); AMP_END(15); }
        SEAM(pb + 15);
        if constexpr (KIND(4)) if (IN(pb + 16)) { PHASE_ENTRY
            __syncthreads();
            { bf16_t* X = (bf16_t*)(ws + WS_X);
              set_desc(F.lds, F.tid, 0, ws + WS_YG, ws + WS_WO + (size_t)lp * D * D * 2, X, 4, 0, 0, X, X + (size_t)TL * D, nullptr);
              set_desc(F.lds, F.tid, 1, nullptr, nullptr, nullptr, 0, 0, 0, (const float*)(ws + WS_MOD) + (size_t)lb * 3 * 6 * D + 2 * D); }
            __syncthreads();
            SchedMulti<D, D> S{F.lds, TL / 256, 4, 1};
            EpiResid E{F.lds};
            pg8::gemm_phase<EpiResid, SchedMulti<D, D>, false, D, D, D>(F.lds, S, E, F.tid);
            __syncthreads(); { int w_ = F0.wave; asm volatile("" : "+s"(w_)); tail_resid<D>(F0.lds, w_); }
            AMP_END(4); }
        SEAM(pb + 16);
        if constexpr (KIND(5)) if (IN(pb + 17)) { PHASE_ENTRY norm2_phase(F, P, lb); AMP_END(5); }
        SEAM(pb + 17);
        if constexpr (KIND(16)) if (IN(pb + 18)) { PHASE_ENTRY
            __syncthreads(); set_desc(F.lds, F.tid, 0, ws + WS_HL, ws + WS_WRT + (size_t)lb * 256 * D * 2, nullptr, 1, 0, 0); __syncthreads();
            SchedMulti<D, D> S{F.lds, (lb == DEPTH - 1 ? TL : T) / 256, 1, 1};
            EpiLogits E{(float*)(ws + WS_LG)};
            pg8::gemm_phase<EpiLogits, SchedMulti<D, D>, false, D, D, D>(F.lds, S, E, F.tid);
            AMP_END(16); }
        SEAM(pb + 18);
        if constexpr (KIND(17)) if (IN(pb + 19)) { PHASE_ENTRY route_phase(F, P, lb); AMP_END(17); }
        SEAM(pb + 19);
        if constexpr (KIND(6)) if (IN(pb + 20)) { PHASE_ENTRY
            moe_tables(F.lds, F.tid, ctl + CW_CNT + lb * 64);
            SchedMoE<D, D, true> S{F.lds, (const char*)(ws + WS_HL), (const char*)(ws + WS_WGU), (const int*)(ws + WS_LIST)};
            EpiSiluGate E{(bf16_t*)(ws + WS_H)};
            pg8::gemm_phase<EpiSiluGate, SchedMoE<D, D, true>, true, D, D, D>(F.lds, S, E, F.tid);
            AMP_END(6); }
        SEAM(pb + 20);
        if constexpr (KIND(7)) if (IN(pb + 21)) { PHASE_ENTRY
            moe_tables(F.lds, F.tid, ctl + CW_CNT + lb * 64);
            SchedMoE<EHID, EHID, false> S{F.lds, (const char*)(ws + WS_H), (const char*)(ws + WS_WD), (const int*)(ws + WS_LIST)};
            EpiScatter E{F.lds, (bf16_t*)(ws + WS_YB), (const int*)(ws + WS_LIST)};
            pg8::gemm_phase<EpiScatter, SchedMoE<EHID, EHID, false>, false, EHID, EHID, EHID>(F.lds, S, E, F.tid);
            AMP_END(7); }
        SEAM(pb + 21);
    }
    if constexpr (KIND(13)) if (IN(45)) { PHASE_ENTRY final_phase(F, P); AMP_END(13); }
#undef IN
#undef KIND
#undef SEAM
#undef PHASE_ENTRY
}

#if !MK_ONE_LAUNCH
static int phase_kind(int ph) { if (ph == 0) return 0; if (ph == 45) return 13; static const int k22[22] = {1, 2, 3, 4, 5, 16, 17, 6, 7, 1, 8, 9, 10, 11, 14, 15, 4, 5, 16, 17, 6, 7}; return k22[(ph - 1) % 22]; }
typedef void (*kern_t)(Params);
template <unsigned KM> static kern_t kern_of() { return mega<KM>; }
static kern_t kind_kernel(int kind) {
    switch (kind) { case 0: return kern_of<1u << 0>(); case 1: return kern_of<1u << 1>(); case 2: return kern_of<1u << 2>(); case 3: return kern_of<1u << 3>(); case 4: return kern_of<1u << 4>();
        case 5: return kern_of<1u << 5>(); case 6: return kern_of<1u << 6>(); case 7: return kern_of<1u << 7>(); case 8: return kern_of<1u << 8>(); case 9: return kern_of<1u << 9>();
        case 10: return kern_of<1u << 10>(); case 11: return kern_of<1u << 11>(); case 12: return kern_of<1u << 12>(); case 14: return kern_of<1u << 14>(); case 15: return kern_of<1u << 15>(); case 16: return kern_of<1u << 16>(); case 17: return kern_of<1u << 17>(); default: return kern_of<1u << 13>(); }
}
#endif
extern "C" void kernel_launch(void* const* d_in, const int* in_sizes, int n_in, void* d_out, int out_size, void* d_ws, size_t ws_size, hipStream_t stream) {
    static int grid = 0;
    if (grid == 0) {
        if (n_in != 42 || out_size != TL * D || ws_size < WS_END) { fprintf(stderr, "kernel_launch: unexpected problem (n_in %d, out %d, ws %zu < %zu)\n", n_in, out_size, ws_size, (size_t)WS_END); grid = -1; return; }
        int dev = 0, cus = 0;
        if (hipGetDevice(&dev) != hipSuccess || hipDeviceGetAttribute(&cus, hipDeviceAttributeMultiprocessorCount, dev) != hipSuccess) { grid = -1; return; }
#if MK_ONE_LAUNCH
        if (hipFuncSetAttribute((const void*)mega<0x3ffffu>, hipFuncAttributeMaxDynamicSharedMemorySize, LDS_BYTES) != hipSuccess) { fprintf(stderr, "kernel_launch: hipFuncSetAttribute failed\n"); grid = -1; return; }
#else
        for (int k = 0; k < 18; ++k) if (hipFuncSetAttribute((const void*)kind_kernel(k), hipFuncAttributeMaxDynamicSharedMemorySize, LDS_BYTES) != hipSuccess) { fprintf(stderr, "kernel_launch: hipFuncSetAttribute failed\n"); grid = -1; return; }
#endif
        (void)hipGetLastError();
        grid = cus;
    }
    if (grid < 0) return;
    (void)hipMemsetAsync((char*)d_ws + WS_CTL, 0, CTL_BYTES, stream);
    Params p{};
    for (int i = 0; i < 42; ++i) p.in[i] = (const float*)d_in[i];
    p.out = (float*)d_out; p.ws = (unsigned char*)d_ws;
#if MK_ONE_LAUNCH
    p.ph_lo = 0; p.ph_hi = NPH;
    hipLaunchKernelGGL(mega<0x3ffffu>, dim3(grid), dim3(NTHR), LDS_BYTES, stream, p);
#else
    for (int ph = 0; ph < NPH; ++ph) { p.ph_lo = ph; p.ph_hi = ph + 1; hipLaunchKernelGGL(kind_kernel(phase_kind(ph)), dim3(grid), dim3(NTHR), LDS_BYTES, stream, p); }
#endif
}
```

```cpp
#include <hip/hip_runtime.h>
#include <cstdio>
#include <cstdint>

#define LAS __attribute__((address_space(3)))
typedef unsigned short bf16_t;
typedef short bf16x8 __attribute__((ext_vector_type(8)));
typedef float f32x4 __attribute__((ext_vector_type(4)));
typedef float f32x2 __attribute__((ext_vector_type(2)));
typedef unsigned u32x4 __attribute__((ext_vector_type(4)));
typedef unsigned u32x2 __attribute__((ext_vector_type(2)));

#ifndef CH_AMP
#define CH_AMP -1
#endif
#define CH_STAMP(i) do { if (CH_AMP >= 0) ch_t[i] = __builtin_amdgcn_s_memrealtime(); } while (0)
#ifndef AMP_MASK
#define AMP_MASK 0u
#endif
#define AMP_F 4
#ifndef MK_ONE_LAUNCH
#define MK_ONE_LAUNCH 1
#endif

constexpr int D = 1024, NBATCH = 2, SEQ = 16384, CTXL = 256, DEPTH = 4;
constexpr int TL = NBATCH * SEQ, TC = NBATCH * CTXL, T = TL + TC;
constexpr int GWID = 2048, NE = 32, EHID = 512, NH = 16, HD = 64;
constexpr int LISTCAP = T;
constexpr int MAXRT = (2 * T) / 256 + NE;
constexpr int NWAVES = 8, NTHR = 512;

constexpr size_t MiB = 1u << 20;
constexpr size_t WS_CTL = 0, CTL_BYTES = 1 * MiB;
constexpr size_t WS_MOD = 1 * MiB;
constexpr size_t WS_WIN = 2 * MiB, WS_WOUT = 18 * MiB, WS_WSP = 26 * MiB, WS_WR = 27 * MiB, WS_WK = 31 * MiB, WS_WV = 35 * MiB, WS_WO = 39 * MiB;
constexpr size_t WS_LW1 = 43 * MiB, WS_LA1 = 44 * MiB, WS_LG1 = 45 * MiB, WS_W2P = 46 * MiB, WS_A2P = 48 * MiB, WS_G2P = 50 * MiB;
constexpr size_t WS_WRT = 52 * MiB;
constexpr size_t WS_WGU = 54 * MiB, WS_WD = 118 * MiB;
constexpr size_t WS_X = 150 * MiB;
constexpr size_t WS_LIST = 280 * MiB, WS_WGT = 285 * MiB;
constexpr size_t WS_HL = 286 * MiB;
constexpr size_t WS_BIG = 351 * MiB;
constexpr size_t SZB = 65 * MiB;
constexpr size_t WS_U = WS_BIG, WS_V = WS_BIG + 2 * SZB, WS_STAT = WS_BIG + 4 * SZB;
constexpr size_t WS_XR = WS_BIG, WS_XW = WS_BIG + SZB, WS_XK = WS_BIG + 2 * SZB, WS_XV = WS_BIG + 3 * SZB, WS_XA = WS_BIG + 4 * SZB, WS_XG = WS_BIG + 5 * SZB;
constexpr size_t WS_R = WS_BIG + 6 * SZB, WS_K = WS_BIG + 7 * SZB, WS_VV = WS_BIG + 8 * SZB;
constexpr size_t WS_TW = WS_BIG + 9 * SZB, WS_TA = WS_TW + 17 * MiB, WS_TG = WS_TA + 17 * MiB;
constexpr size_t WS_ELOG0 = WS_XR, WS_ELOG1 = WS_XW, WS_KM0 = WS_XK, WS_KM1 = WS_XV, WS_AS0 = WS_XA, WS_AS1 = WS_XG;
constexpr size_t WS_GATE = WS_HL, WS_YG = WS_AS0, WS_BON = WS_TG + 17 * MiB;
constexpr size_t WS_H = WS_BIG, WS_YB = WS_BIG + 73 * MiB, WS_LG = WS_BIG + 204 * MiB;
constexpr size_t WS_PQ = WS_KM0;
constexpr size_t WS_SST = WS_WGU;
constexpr size_t WS_END = WS_BON + 5 * MiB;
static_assert(WS_END <= 1080 * MiB, "workspace map");
constexpr int CW_BAR = 4096;
constexpr int CW_CNT = 16384;

__device__ __forceinline__ int wave_sgpr_now(int w) { asm volatile("" : "+s"(w)); return w; }
__device__ __forceinline__ int lane_id_now() { int l; asm volatile("v_mbcnt_lo_u32_b32 %0, -1, 0\n\tv_mbcnt_hi_u32_b32 %0, -1, %0" : "=v"(l)); return l; }
typedef short v4s __attribute__((ext_vector_type(4)));
#define LDS_BARRIER() asm volatile("s_waitcnt lgkmcnt(0)\n\ts_barrier" ::: "memory")
typedef __bf16 bf16x2_t __attribute__((ext_vector_type(2)));
__device__ __forceinline__ unsigned cvt_pk_bf16(float lo, float hi) { const bf16x2_t v = __builtin_convertvector((f32x2){lo, hi}, bf16x2_t); return __builtin_bit_cast(unsigned, v); }
__device__ __forceinline__ float bf_lo(unsigned u) { return __uint_as_float(u << 16); }
__device__ __forceinline__ float bf_hi(unsigned u) { return __uint_as_float(u & 0xffff0000u); }
__device__ __forceinline__ float bf1(bf16_t b) { return __uint_as_float(((unsigned)b) << 16); }
__device__ __forceinline__ bf16_t f2bf(float f) { return (bf16_t)(cvt_pk_bf16(f, 0.f) & 0x3ffffu); }
__device__ __forceinline__ void unpack8(const u32x4& w, float (&f)[8]) { f[0] = bf_lo(w.x); f[1] = bf_hi(w.x); f[2] = bf_lo(w.y); f[3] = bf_hi(w.y); f[4] = bf_lo(w.z); f[5] = bf_hi(w.z); f[6] = bf_lo(w.w); f[7] = bf_hi(w.w); }
__device__ __forceinline__ u32x4 pack8(const float (&f)[8]) { u32x4 o; o.x = cvt_pk_bf16(f[0], f[1]); o.y = cvt_pk_bf16(f[2], f[3]); o.z = cvt_pk_bf16(f[4], f[5]); o.w = cvt_pk_bf16(f[6], f[7]); return o; }
__device__ __forceinline__ float shx(float v, int m, int lane) { return __int_as_float(__builtin_amdgcn_ds_bpermute((lane ^ m) << 2, __float_as_int(v))); }
__device__ __forceinline__ float shup(float v, int d, int lane) { return __int_as_float(__builtin_amdgcn_ds_bpermute((lane - d) << 2, __float_as_int(v))); }
__device__ __forceinline__ float wave_sum(float v, int lane) {
#pragma unroll
    for (int o = 1; o < 64; o <<= 1) v += shx(v, o, lane);
    return v;
}
__device__ __forceinline__ float sigmoidf_(float x) { return 1.0f / (1.0f + __expf(-x)); }
__device__ __forceinline__ float tanhf_(float x) { const float e = __expf(2.0f * x); return 1.0f - 2.0f / (e + 1.0f); }
__device__ __forceinline__ f32x2 gelu_pk(f32x2 v) {
    const f32x2 av = __builtin_elementwise_abs(v), d = av * 0.2316418882f + 1.0f;
    f32x2 t; t.x = __builtin_amdgcn_rcpf(d.x); t.y = __builtin_amdgcn_rcpf(d.y);
    f32x2 q = t * 0.5307027145f + (-0.7265760135f); q = q * t + 0.7107068705f; q = q * t + (-0.142248368f); q = q * t + 0.127414796f; q = q * t;
    const f32x2 s = (v * v) * (-0.72134752044f);
    f32x2 e; e.x = __builtin_amdgcn_exp2f(s.x); e.y = __builtin_amdgcn_exp2f(s.y);
    const f32x2 m = v * (q * e), r = v - m;
    f32x2 o; o.x = v.x < 0.f ? m.x : r.x; o.y = v.y < 0.f ? m.y : r.y; return o;
}

#define XB_TMO      128
#define XB_XCNT(j)  (256  + 64 * (j))
#define XB_XSUB(j)  (1280 + 64 * (j))
#define XB_XGEN(j)  (2304 + 64 * (j))
#define XB_TOP      3328
#define XB_TOPGEN   3392
#define XCD_BAR_WORDS 3456
#define XB_SPIN_CAP (1u << 18)
__device__ __forceinline__ unsigned xb_ld(unsigned* p)              { return __hip_atomic_load(p, __ATOMIC_RELAXED, __HIP_MEMORY_SCOPE_AGENT); }
__device__ __forceinline__ unsigned xb_add(unsigned* p, unsigned v) { return __hip_atomic_fetch_add(p, v, __ATOMIC_RELAXED, __HIP_MEMORY_SCOPE_AGENT); }
__device__ __forceinline__ unsigned xb_xcc_id() { return (unsigned)__builtin_amdgcn_s_getreg((3 << 11) | 20) & 0xFu; }
#define XB_SPIN(cond, bar) do { unsigned _sp = 0; while (cond) { __builtin_amdgcn_s_sleep(1); \
    if ((++_sp & 255u) == 0u) { if (xb_ld(&(bar)[XB_TMO])) break; if (_sp > XB_SPIN_CAP) { atomicAdd(&(bar)[XB_TMO], 1u); break; } } } } while (0)
struct XcdBarrier { unsigned* bar; unsigned x; volatile LAS unsigned* st; };
__device__ __forceinline__ XcdBarrier xcd_barrier_post(unsigned* bar, volatile LAS unsigned* st) {
    XcdBarrier b; b.bar = bar; b.x = xb_xcc_id(); b.st = st;
    if (threadIdx.x == 0) (void)xb_add(&bar[XB_XCNT(b.x)], 1u);
    return b;
}
__device__ __forceinline__ void xcd_barrier_complete(unsigned* bar, unsigned x, unsigned& nloc, unsigned& nx) {
    const unsigned G = gridDim.x * gridDim.y * gridDim.z;
    unsigned sum, cnt, mine, sp = 0u;
    for (;;) {
        sum = 0u; cnt = 0u; mine = 0u;
#pragma unroll
        for (unsigned j = 0; j < 16; ++j) { const unsigned c = xb_ld(&bar[XB_XCNT(j)]); sum += c; cnt += (c > 0u) ? 1u : 0u; mine = (j == x) ? c : mine; }
        if (sum == G) break;
        __builtin_amdgcn_s_sleep(1);
        if ((++sp & 255u) == 0u) { if (xb_ld(&bar[XB_TMO])) break; if (sp > XB_SPIN_CAP) { atomicAdd(&bar[XB_TMO], 1u); break; } }
    }
    nloc = mine > 0u ? mine : 1u; nx = cnt > 0u ? cnt : 1u;
}
template <bool FIRST> __device__ __forceinline__ void xcd_barrier(const XcdBarrier& b, const bool leader) {
    asm volatile("s_waitcnt vmcnt(0)" ::: "memory");
    __syncthreads();
    if (leader) {
        unsigned* bar = b.bar;
        __builtin_amdgcn_s_waitcnt(0);
        unsigned nloc = b.st[0], nx = b.st[1];
        if constexpr (FIRST) { if (nloc == 0u) { xcd_barrier_complete(bar, b.x, nloc, nx); b.st[0] = nloc; b.st[1] = nx; } }
        const unsigned old = xb_add(&bar[XB_XSUB(b.x)], 1u);
        const unsigned gen = old / nloc;
        if (old + 1u == (gen + 1u) * nloc) {
            __builtin_amdgcn_fence(__ATOMIC_RELEASE, "agent");
            asm volatile("s_waitcnt vmcnt(0)" ::: "memory");
            const unsigned og = xb_add(&bar[XB_TOP], 1u);
            const unsigned tg = og / nx;
            if (og + 1u == (tg + 1u) * nx) xb_add(&bar[XB_TOPGEN], 1u);
            else XB_SPIN(xb_ld(&bar[XB_TOPGEN]) == tg, bar);
            __builtin_amdgcn_fence(__ATOMIC_ACQUIRE, "agent");
            xb_add(&bar[XB_XGEN(b.x)], 1u);
            asm volatile("s_waitcnt vmcnt(0)" ::: "memory");
        } else {
            XB_SPIN(xb_ld(&bar[XB_XGEN(b.x)]) == gen, bar);
            __builtin_amdgcn_fence(__ATOMIC_ACQUIRE, "agent");
            asm volatile("s_waitcnt vmcnt(0)" ::: "memory");
        }
    }
    __syncthreads();
}

constexpr int LDS_MISC = 143360;
constexpr int LDS_DESC = LDS_MISC + 128;
constexpr int LDS_TAB = LDS_MISC + 512;
constexpr int LDS_BYTES = 147456;
namespace pg8 {
constexpr int BM = 256, BK = 64, HALF = 128, HTB = HALF * BK * 2, STAGE_BYTES = 8 * HTB, NXCD = 8, WGM = 8;
__host__ __device__ __forceinline__ int lds_byte(int r, int c) { const int st = (r >> 4) * 2 + (c >> 5), rr = r & 15, cc = c & 31, ob = rr * 64 + cc * 2; return st * 1024 + (ob ^ (((ob >> 9) & 1) << 5)); }
__host__ __device__ __forceinline__ void stage_rc(int b, int& R, int& C) { const int st = b / 1024, sb = b % 1024, swz = sb ^ (((sb >> 9) & 1) << 5); R = (st >> 1) * 16 + swz / 64; C = (st & 1) * 32 + (swz % 64) / 2; }
__host__ __device__ __forceinline__ int perm32(int rho) { const int n = rho >> 4, i = rho & 15; return 8 * (i >> 2) + 4 * n + (i & 3); }
__device__ __forceinline__ int xcd_remap(int L, int nwg) { const int q = nwg / NXCD, r = nwg % NXCD, xcd = L % NXCD, off = L / NXCD; return (xcd < r ? xcd * (q + 1) : r * (q + 1) + (xcd - r) * q) + off; }

struct Unit { int pm, pn, aux; };

template <class Epi, class Sched, bool GATHER, int K, int LDA, int LDB>
__device__ __forceinline__ void gemm_phase(LAS unsigned char* lds, const Sched& S, const Epi& E, const int tid_in) {
    int tid_ = tid_in; asm volatile("" : "+v"(tid_));
    const int tid = tid_, wid = __builtin_amdgcn_readfirstlane(tid >> 6), lane = tid & 63, wr = wid >> 2, wc = wid & 3, fr = lane & 15, fq = lane >> 4;
    constexpr int nt = K / BK;
    unsigned voffA[2], voffB[2];
#pragma unroll
    for (int i = 0; i < 2; ++i) { int R, C; stage_rc(tid * 16 + i * 8192, R, C); const int Rb = Epi::PERM ? ((R & ~31) + perm32(R & 31)) : R;
        voffA[i] = (unsigned)(R * LDA + C) * 2u; voffB[i] = (unsigned)(Rb * LDB + C) * 2u; }
    constexpr size_t kstep = (size_t)(BK * 2);
    constexpr size_t hstepA = GATHER ? (size_t)0 : (size_t)HALF * LDA * 2, hstepB = (size_t)HALF * LDB * 2;
    const unsigned ldsw = (unsigned)wid * 1024u;
    const int aoff = lds_byte(wr * 64 + fr, fq * 8), boff = lds_byte(wc * 32 + fr, fq * 8);
    unsigned gA[2][2], gN[2][2];
#define PG8_SA(b, h) (((b) * 2 + (h)) * HTB)
#define PG8_SB(b, h) ((4 + (b) * 2 + (h)) * HTB)
#define PG8_STAGEB(bufoff, gbase) do { _Pragma("unroll") for (int _i = 0; _i < 2; ++_i) \
        __builtin_amdgcn_global_load_lds((const unsigned*)((const char*)(gbase) + voffB[_i]), (LAS unsigned*)(lds + (bufoff) + ldsw + _i * 8192), 16, 0, 0); } while (0)
#define PG8_STAGEA(bufoff, gbase, h, GV) do { _Pragma("unroll") for (int _i = 0; _i < 2; ++_i) \
        __builtin_amdgcn_global_load_lds((const unsigned*)((const char*)(gbase) + (GATHER ? GV[h][_i] : voffA[_i]) + (h) * hstepA), (LAS unsigned*)(lds + (bufoff) + ldsw + _i * 8192), 16, 0, 0); } while (0)
#define PG8_LDA(dst, b, h) do { _Pragma("unroll") for (int m = 0; m < 4; ++m) _Pragma("unroll") for (int k = 0; k < 2; ++k) dst[m][k] = *(const LAS bf16x8*)(lds + PG8_SA(b, h) + aoff + m * 2048 + k * 1024); } while (0)
#define PG8_LDB(dst, b, h) do { _Pragma("unroll") for (int n = 0; n < 2; ++n) _Pragma("unroll") for (int k = 0; k < 2; ++k) dst[n][k] = *(const LAS bf16x8*)(lds + PG8_SB(b, h) + boff + n * 2048 + k * 1024); } while (0)
#define PG8_MMA(ai, bj, At, Bt) do { __builtin_amdgcn_s_setprio(1); _Pragma("unroll") for (int m = 0; m < 4; ++m) _Pragma("unroll") for (int n = 0; n < 2; ++n) _Pragma("unroll") for (int k = 0; k < 2; ++k) \
        acc[ai][bj][m][n] = __builtin_amdgcn_mfma_f32_16x16x32_bf16(Bt[n][k], At[m][k], acc[ai][bj][m][n], 0, 0, 0); __builtin_amdgcn_s_setprio(0); } while (0)
#define PG8_WAIT_V(n) asm volatile("s_waitcnt vmcnt(" #n ")" ::: "memory")
#define PG8_WAIT_L(n) asm volatile("s_waitcnt lgkmcnt(" #n ")" ::: "memory")
#define PG8_BAR __builtin_amdgcn_s_barrier()
#define PG8_SCHED __builtin_amdgcn_sched_barrier(0)
    Unit cur, nxt; int ui = 0;
    if (!S.next(0, cur)) return;
    f32x4 acc[2][2][4][2];
#pragma unroll
    for (int a = 0; a < 2; ++a)
#pragma unroll
        for (int b = 0; b < 2; ++b)
#pragma unroll
            for (int m = 0; m < 4; ++m)
#pragma unroll
                for (int n = 0; n < 2; ++n) acc[a][b][m][n] = (f32x4){0.f, 0.f, 0.f, 0.f};
    bf16x8 At[4][2], B0[2][2], B1[2][2];
    const char* cA = S.aptr(cur); const char* cB = S.bptr(cur);
    if constexpr (GATHER) { S.gather(cur, tid, gA); }
    PG8_STAGEB(PG8_SB(0, 0), cB); PG8_STAGEB(PG8_SB(0, 1), cB + hstepB); PG8_STAGEA(PG8_SA(0, 0), cA, 0, gA); PG8_STAGEA(PG8_SA(0, 1), cA, 1, gA);
    if (wr == 1) PG8_BAR;
    PG8_WAIT_V(2); PG8_BAR;
    PG8_STAGEB(PG8_SB(1, 0), cB + kstep); PG8_STAGEA(PG8_SA(1, 0), cA + kstep, 0, gA); PG8_STAGEB(PG8_SB(1, 1), cB + hstepB + kstep);
    PG8_WAIT_V(6); PG8_BAR;
    for (;;) {
        const bool has_next = S.next(ui + 1, nxt);
        const char* nA = has_next ? S.aptr(nxt) : cA; const char* nB = has_next ? S.bptr(nxt) : cB;
        if constexpr (GATHER) { if (has_next) S.gather(nxt, tid, gN); else {
#pragma unroll
            for (int h = 0; h < 2; ++h)
#pragma unroll
                for (int i = 0; i < 2; ++i) gN[h][i] = gA[h][i]; } }
#pragma nounroll
        for (int t = 0; t < nt; t += 2) {
            const bool last = (t == nt - 2);
            const char* a1 = cA + (size_t)(t + 1) * kstep;
            const char* a2 = last ? nA : cA + (size_t)(t + 2) * kstep; const char* b2 = last ? nB : cB + (size_t)(t + 2) * kstep;
            const char* a3 = a2 + kstep; const char* b3 = b2 + kstep;
            unsigned g2[2][2];
            if constexpr (GATHER) {
#pragma unroll
                for (int h = 0; h < 2; ++h)
#pragma unroll
                    for (int i = 0; i < 2; ++i) g2[h][i] = last ? gN[h][i] : gA[h][i]; }
            PG8_LDB(B0, 0, 0); PG8_LDB(B1, 0, 1); PG8_SCHED; PG8_LDA(At, 0, 0); PG8_STAGEA(PG8_SA(1, 1), a1, 1, gA);
            PG8_WAIT_V(8); PG8_WAIT_L(0); PG8_BAR; PG8_MMA(0, 0, At, B0); PG8_MMA(0, 1, At, B1); PG8_BAR; PG8_SCHED;
            PG8_LDA(At, 0, 1); PG8_STAGEB(PG8_SB(0, 0), b2); PG8_STAGEB(PG8_SB(0, 1), b2 + hstepB); PG8_STAGEA(PG8_SA(0, 0), a2, 0, g2);
            PG8_WAIT_V(8); PG8_WAIT_L(0); PG8_BAR; PG8_MMA(1, 0, At, B0); PG8_MMA(1, 1, At, B1); PG8_BAR; PG8_SCHED;
            PG8_LDB(B0, 1, 0); PG8_LDB(B1, 1, 1); PG8_SCHED; PG8_LDA(At, 1, 0); PG8_STAGEA(PG8_SA(0, 1), a2, 1, g2);
            PG8_WAIT_V(8); PG8_WAIT_L(0); PG8_BAR; PG8_MMA(0, 0, At, B0); PG8_MMA(0, 1, At, B1); PG8_BAR; PG8_SCHED;
            PG8_LDA(At, 1, 1); PG8_STAGEB(PG8_SB(1, 0), b3); PG8_STAGEB(PG8_SB(1, 1), b3 + hstepB); PG8_STAGEA(PG8_SA(1, 0), a3, 0, g2);
            PG8_WAIT_V(8); PG8_WAIT_L(0); PG8_BAR; PG8_MMA(1, 0, At, B0); PG8_MMA(1, 1, At, B1); PG8_BAR; PG8_SCHED;
        }
        if (wr == 0) PG8_BAR;
        E(acc, cur, wr, wc, fr, fq);
        if (!has_next) break;
#pragma unroll
        for (int a = 0; a < 2; ++a)
#pragma unroll
            for (int b = 0; b < 2; ++b)
#pragma unroll
                for (int m = 0; m < 4; ++m)
#pragma unroll
                    for (int n = 0; n < 2; ++n) acc[a][b][m][n] = (f32x4){0.f, 0.f, 0.f, 0.f};
        cur = nxt; cA = nA; cB = nB; ++ui;
        if constexpr (GATHER) {
#pragma unroll
            for (int h = 0; h < 2; ++h)
#pragma unroll
                for (int i = 0; i < 2; ++i) gA[h][i] = gN[h][i]; }
        if (wr == 1) PG8_BAR;
    }
    PG8_WAIT_V(0);
    PG8_BAR;
#undef PG8_SA
#undef PG8_SB
#undef PG8_STAGEA
#undef PG8_STAGEB
#undef PG8_LDA
#undef PG8_LDB
#undef PG8_MMA
#undef PG8_WAIT_V
#undef PG8_WAIT_L
#undef PG8_BAR
#undef PG8_SCHED
}
}
using pg8::Unit;

__device__ __forceinline__ void set_desc(LAS unsigned char* lds, int tid, int g, const void* A, const void* B, const void* C, int nN, int ldc, int aux, const void* X1 = nullptr, const void* X2 = nullptr, const void* X3 = nullptr) {
    LAS int* d = (LAS int*)(lds + LDS_DESC) + g * 16;
    if (tid == 0) { unsigned long long a = (unsigned long long)A, b = (unsigned long long)B, c = (unsigned long long)C, x1 = (unsigned long long)X1, x2 = (unsigned long long)X2, x3 = (unsigned long long)X3;
        asm volatile("" : "+s"(a), "+s"(b), "+s"(c), "+s"(x1), "+s"(x2), "+s"(x3), "+s"(nN), "+s"(ldc), "+s"(aux));
        d[0] = (int)(unsigned)a; d[1] = (int)(unsigned)(a >> 32); d[2] = (int)(unsigned)b; d[3] = (int)(unsigned)(b >> 32); d[4] = (int)(unsigned)c; d[5] = (int)(unsigned)(c >> 32); d[6] = nN; d[7] = ldc; d[8] = aux;
        d[10] = (int)(unsigned)x1; d[11] = (int)(unsigned)(x1 >> 32); d[12] = (int)(unsigned)x2; d[13] = (int)(unsigned)(x2 >> 32); d[14] = (int)(unsigned)x3; d[15] = (int)(unsigned)(x3 >> 32); }
}
__device__ __forceinline__ int desc_i(LAS unsigned char* lds, int g, int f) { return __builtin_amdgcn_readfirstlane(((LAS const int*)(lds + LDS_DESC))[g * 16 + f]); }
__device__ __forceinline__ const char* desc_p(LAS unsigned char* lds, int g, int f) {
    const unsigned lo = (unsigned)desc_i(lds, g, f), hi = (unsigned)desc_i(lds, g, f + 1); return (const char*)(((unsigned long long)hi << 32) | lo); }
template <int LDA, int LDB>
struct SchedMulti {
    LAS unsigned char* lds; int nM, ntot, ng;
    __device__ __forceinline__ bool next(int i, Unit& u) const {
        const int nwg = nM * ntot; const long L = (long)i * gridDim.x + blockIdx.x; if (L >= nwg) return false;
        const int wgid = pg8::xcd_remap((int)L, nwg);
        const int nig = pg8::WGM * ntot, gid = wgid / nig, fm = gid * pg8::WGM, gsz = (nM - fm) < pg8::WGM ? (nM - fm) : pg8::WGM;
        u.pm = fm + ((wgid % nig) % gsz); int pv = (wgid % nig) / gsz; int g = 0;
        for (int j = 0; j + 1 < ng; ++j) { const int n = desc_i(lds, j, 6); if (pv < n) break; pv -= n; g = j + 1; }
        u.pn = pv; u.aux = g; return true;
    }
    __device__ __forceinline__ const char* aptr(const Unit& u) const { return desc_p(lds, u.aux, 0) + (size_t)u.pm * (512 * LDA); }
    __device__ __forceinline__ const char* bptr(const Unit& u) const { return desc_p(lds, u.aux, 2) + (size_t)u.pn * (512 * LDB); }
};
template <int LDA, int LDB, bool GATHERED>
struct SchedMoE {
    LAS unsigned char* lds; const char* Abase; const char* Bbase; const int* list;
    __device__ __forceinline__ bool next(int i, Unit& u) const {
        LAS const int* tab = (LAS const int*)(lds + LDS_TAB);
        const int nrt = __builtin_amdgcn_readfirstlane(tab[2 * MAXRT + 32]);
        const int nwg = nrt * 4; const long L = (long)i * gridDim.x + blockIdx.x; if (L >= nwg) return false;
        const int wgid = pg8::xcd_remap((int)L, nwg);
        u.pm = wgid >> 2; u.pn = wgid & 3; u.aux = __builtin_amdgcn_readfirstlane(tab[u.pm]); return true;
    }
    __device__ __forceinline__ const char* aptr(const Unit& u) const { return GATHERED ? Abase : Abase + (size_t)u.pm * (512 * LDA); }
    __device__ __forceinline__ const char* bptr(const Unit& u) const { return Bbase + (size_t)u.aux * ((size_t)D * LDB * 2) + (size_t)u.pn * (512 * LDB); }
    __device__ __forceinline__ void gather(const Unit& u, int tid, unsigned (&g)[2][2]) const {
        LAS const int* tab = (LAS const int*)(lds + LDS_TAB);
        const int j0 = __builtin_amdgcn_readfirstlane(tab[MAXRT + u.pm]), cn = __builtin_amdgcn_readfirstlane(tab[2 * MAXRT + u.aux]);
#pragma unroll
        for (int i = 0; i < 2; ++i) { int R, C; pg8::stage_rc(tid * 16 + i * 8192, R, C);
#pragma unroll
            for (int h = 0; h < 2; ++h) { const int slot = j0 + 128 * h + R; const int a = slot < cn ? list[(size_t)u.aux * LISTCAP + slot] : 0;
                g[h][i] = (unsigned)((a >> 1) * LDA + C) * 2u; } }
    }
};
__device__ __forceinline__ void moe_tables(LAS unsigned char* lds, int tid, const unsigned* cnt) {
    LAS int* tab = (LAS int*)(lds + LDS_TAB);
    __syncthreads();
    if (tid == 0) {
        int rt = 0;
#pragma nounroll
        for (int e = 0; e < NE; ++e) { const int c = (int)__hip_atomic_load(cnt + e, __ATOMIC_RELAXED, __HIP_MEMORY_SCOPE_AGENT); tab[2 * MAXRT + e] = c;
            const int nt = (c + 255) >> 8;
#pragma nounroll
            for (int j = 0; j < nt; ++j) { tab[rt] = e; tab[MAXRT + rt] = j * 256; ++rt; } }
        tab[2 * MAXRT + 32] = rt;
    }
    __syncthreads();
}

#define EPI_FENCE() asm volatile("" ::: "memory")
struct EpiGelu {
    static constexpr bool PERM = true;
    LAS unsigned char* lds;
    __device__ __forceinline__ void operator()(const f32x4 (&acc)[2][2][4][2], const Unit& u, int wr, int wc, int fr, int fq) const {
        const bool isv = u.pn >= 8; bf16_t* base = (bf16_t*)desc_p(lds, 0, isv ? 10 : 4); const float* bias = (const float*)desc_p(lds, 0, 12); float* stat = (float*)desc_p(lds, 0, 14);
        const int col0 = (u.pn & 7) * 256 + wc * 32 + 8 * fq, bcol0 = u.pn * 256 + wc * 32 + 8 * fq, row0 = u.pm * 256 + wr * 64 + fr;
        f32x4 bv[2][2];
#pragma unroll
        for (int bj = 0; bj < 2; ++bj)
#pragma unroll
            for (int n = 0; n < 2; ++n) bv[bj][n] = *(const f32x4*)(bias + bcol0 + bj * 128 + 4 * n);
#pragma unroll
        for (int ai = 0; ai < 2; ++ai)
#pragma unroll
            for (int m = 0; m < 4; ++m) { const int row = row0 + ai * 128 + m * 16; bf16_t* rowp = base + (size_t)row * GWID + col0; float s = 0.f, q = 0.f;
#pragma unroll
                for (int bj = 0; bj < 2; ++bj) { const f32x4 v0 = acc[ai][bj][m][0] + bv[bj][0], v1 = acc[ai][bj][m][1] + bv[bj][1];
                    const f32x2 a = gelu_pk((f32x2){v0[0], v0[1]}), b = gelu_pk((f32x2){v0[2], v0[3]}), c = gelu_pk((f32x2){v1[0], v1[1]}), d = gelu_pk((f32x2){v1[2], v1[3]});
                    s += ((a.x + a.y) + (b.x + b.y)) + ((c.x + c.y) + (d.x + d.y));
                    q += ((a.x * a.x + a.y * a.y) + (b.x * b.x + b.y * b.y)) + ((c.x * c.x + c.y * c.y) + (d.x * d.x + d.y * d.y));
                    u32x4 w; w.x = cvt_pk_bf16(a.x, a.y); w.y = cvt_pk_bf16(b.x, b.y); w.z = cvt_pk_bf16(c.x, c.y); w.w = cvt_pk_bf16(d.x, d.y);
                    *(u32x4*)(rowp + bj * 128) = w; }
                if (isv) { const int ln_ = 16 * fq + fr; s += shx(s, 16, ln_); s += shx(s, 32, ln_); q += shx(q, 16, ln_); q += shx(q, 32, ln_);
                    if (fq == 0) *(f32x2*)(stat + ((size_t)row * 32 + (u.pn - 8) * 4 + wc) * 2) = (f32x2){s, q}; } }
    }
};
struct EpiResid {
    static constexpr bool PERM = true;
    LAS unsigned char* lds;
    __device__ __forceinline__ void operator()(const f32x4 (&acc)[2][2][4][2], const Unit& u, int wr, int wc, int fr, int fq) const {
        const int mrow = u.pm < 64 ? 0 : (u.pm < 128 ? 1 : 2);
        bf16_t* x = (bf16_t*)desc_p(lds, 0, 4) + (size_t)(u.pm * 256 + wr * 64 + fr) * D + u.pn * 256 + wc * 32 + 8 * fq;
        const float* bias = (const float*)desc_p(lds, 0, 14); const float* gate = (const float*)desc_p(lds, 1, 10) + mrow * 6 * D + u.pn * 256 + wc * 32 + 8 * fq;
        if (bias) bias += u.pn * 256 + wc * 32 + 8 * fq;
#pragma unroll
        for (int bj = 0; bj < 2; ++bj) {
#pragma unroll
            for (int n = 0; n < 2; ++n) { const int c = bj * 128 + 4 * n;
                const f32x4 b0 = bias ? *(const f32x4*)(bias + c) : (f32x4){0.f, 0.f, 0.f, 0.f};
                const f32x4 g0 = *(const f32x4*)(gate + c);
#pragma unroll
                for (int ai = 0; ai < 2; ++ai) {
#pragma unroll
                    for (int m = 0; m < 4; ++m) { bf16_t* p = x + (size_t)(ai * 128 + m * 16) * D + c;
                        const u32x2 w = *(const u32x2*)p; const f32x4 x0 = (f32x4){bf_lo(w.x), bf_hi(w.x), bf_lo(w.y), bf_hi(w.y)};
                        const f32x4 o0 = x0 + g0 * (acc[ai][bj][m][n] + b0);
                        u32x2 w2; w2.x = cvt_pk_bf16(o0[0], o0[1]); w2.y = cvt_pk_bf16(o0[2], o0[3]);
                        *(u32x2*)p = w2; }
                    EPI_FENCE(); } } }
    }
};
template <int K>
__device__ __forceinline__ void tail_resid(LAS unsigned char* lds, int wave) {
    const int lane = lane_id_now(), fr = lane & 15, q = lane >> 4, tid = wave * 64 + lane;
    constexpr int KW = K / 8, RP = 68;
    LAS float* red = (LAS float*)lds;
    const bf16_t* A = (const bf16_t*)desc_p(lds, 0, 0) + (size_t)TL * K; const bf16_t* W = (const bf16_t*)desc_p(lds, 0, 2);
    bf16_t* X = (bf16_t*)desc_p(lds, 0, 4) + (size_t)TL * D; const float* bias = (const float*)desc_p(lds, 0, 14); const float* gate = (const float*)desc_p(lds, 1, 10) + 2 * 6 * D;
    for (int item = blockIdx.x; item < 256; item += gridDim.x) {
        const int r0 = (item >> 4) * 16, c0 = (item & 15) * 64;
        const bf16_t* ap = A + (size_t)(r0 + fr) * K + wave * KW + 16 * q;
        const bf16_t* bp = W + (size_t)(c0 + fr) * K + wave * KW + 16 * q;
        f32x4 acc[4];
#pragma unroll
        for (int n = 0; n < 4; ++n) acc[n] = (f32x4){0.f, 0.f, 0.f, 0.f};
#pragma unroll
        for (int kb = 0; kb < KW / 64; ++kb) {
            const bf16x8 a0 = *(const bf16x8*)(ap + kb * 64), a1 = *(const bf16x8*)(ap + kb * 64 + 8);
#pragma unroll
            for (int n = 0; n < 4; ++n) { const bf16x8 b0 = *(const bf16x8*)(bp + (size_t)n * 16 * K + kb * 64), b1 = *(const bf16x8*)(bp + (size_t)n * 16 * K + kb * 64 + 8);
                acc[n] = __builtin_amdgcn_mfma_f32_16x16x32_bf16(a0, b0, acc[n], 0, 0, 0); acc[n] = __builtin_amdgcn_mfma_f32_16x16x32_bf16(a1, b1, acc[n], 0, 0, 0); }
        }
#pragma unroll
        for (int n = 0; n < 4; ++n)
#pragma unroll
            for (int r = 0; r < 4; ++r) red[(wave * 16 + 4 * q + r) * RP + n * 16 + fr] = acc[n][r];
        __syncthreads();
        { const int row = tid >> 5, c2 = 2 * (tid & 31); float s0 = 0.f, s1 = 0.f;
#pragma unroll
          for (int w = 0; w < 8; ++w) { const f32x2 v = *(LAS const f32x2*)(red + (w * 16 + row) * RP + c2); s0 += v.x; s1 += v.y; }
          const int col = c0 + c2; bf16_t* p = X + (size_t)(r0 + row) * D + col; const unsigned xw = *(const unsigned*)p;
          const float b0 = bias ? bias[col] : 0.f, b1 = bias ? bias[col + 1] : 0.f;
          *(unsigned*)p = cvt_pk_bf16(bf_lo(xw) + gate[col] * (s0 + b0), bf_hi(xw) + gate[col + 1] * (s1 + b1)); }
        __syncthreads();
    }
}
__device__ __forceinline__ void tail_gelu(LAS unsigned char* lds, int wave) {
    const int lane = lane_id_now(), fr = lane & 15, q = lane >> 4, tid = wave * 64 + lane;
    constexpr int K = D, KW = K / 8, RP = 260;
    LAS float* red = (LAS float*)lds;
    const bf16_t* A = (const bf16_t*)desc_p(lds, 0, 0) + (size_t)TL * K; const bf16_t* W = (const bf16_t*)desc_p(lds, 0, 2);
    const float* bias = (const float*)desc_p(lds, 0, 12); float* stat = (float*)desc_p(lds, 0, 14);
    for (int item = blockIdx.x; item < 256; item += gridDim.x) {
        const int r0 = (item >> 4) * 16, c0 = (item & 15) * 256;
        const bf16_t* ap = A + (size_t)(r0 + fr) * K + wave * KW + 16 * q;
        const bf16_t* bp = W + (size_t)(c0 + fr) * K + wave * KW + 16 * q;
        const bf16x8 a0 = *(const bf16x8*)(ap), a1 = *(const bf16x8*)(ap + 8), a2 = *(const bf16x8*)(ap + 64), a3 = *(const bf16x8*)(ap + 72);
#pragma unroll 1
        for (int ng = 0; ng < 4; ++ng) {
            f32x4 acc[4];
#pragma unroll
            for (int n = 0; n < 4; ++n) { const bf16_t* b = bp + (size_t)(ng * 4 + n) * 16 * K;
                const bf16x8 b0 = *(const bf16x8*)(b), b1 = *(const bf16x8*)(b + 8), b2 = *(const bf16x8*)(b + 64), b3 = *(const bf16x8*)(b + 72);
                f32x4 c = (f32x4){0.f, 0.f, 0.f, 0.f};
                c = __builtin_amdgcn_mfma_f32_16x16x32_bf16(a0, b0, c, 0, 0, 0); c = __builtin_amdgcn_mfma_f32_16x16x32_bf16(a1, b1, c, 0, 0, 0);
                c = __builtin_amdgcn_mfma_f32_16x16x32_bf16(a2, b2, c, 0, 0, 0); c = __builtin_amdgcn_mfma_f32_16x16x32_bf16(a3, b3, c, 0, 0, 0); acc[n] = c; }
#pragma unroll
            for (int n = 0; n < 4; ++n)
#pragma unroll
                for (int r = 0; r < 4; ++r) red[(wave * 16 + 4 * q + r) * RP + (ng * 4 + n) * 16 + fr] = acc[n][r];
        }
        __syncthreads();
        { const int row = tid >> 5, c8 = 8 * (tid & 31); f32x4 s0 = (f32x4){0.f, 0.f, 0.f, 0.f}, s1 = s0;
#pragma unroll
          for (int w = 0; w < 8; ++w) { s0 += *(LAS const f32x4*)(red + (w * 16 + row) * RP + c8); s1 += *(LAS const f32x4*)(red + (w * 16 + row) * RP + c8 + 4); }
          const int col = c0 + c8; const bool isv = col >= GWID; bf16_t* base = (bf16_t*)desc_p(lds, 0, isv ? 10 : 4);
          s0 += *(const f32x4*)(bias + col); s1 += *(const f32x4*)(bias + col + 4);
          const f32x2 a = gelu_pk((f32x2){s0[0], s0[1]}), b = gelu_pk((f32x2){s0[2], s0[3]}), c = gelu_pk((f32x2){s1[0], s1[1]}), d = gelu_pk((f32x2){s1[2], s1[3]});
          u32x4 w; w.x = cvt_pk_bf16(a.x, a.y); w.y = cvt_pk_bf16(b.x, b.y); w.z = cvt_pk_bf16(c.x, c.y); w.w = cvt_pk_bf16(d.x, d.y);
          *(u32x4*)(base + (size_t)(TL + r0 + row) * GWID + (col & (GWID - 1))) = w;
          if (isv) { float s = ((a.x + a.y) + (b.x + b.y)) + ((c.x + c.y) + (d.x + d.y)), qq = ((a.x * a.x + a.y * a.y) + (b.x * b.x + b.y * b.y)) + ((c.x * c.x + c.y * c.y) + (d.x * d.x + d.y * d.y));
              s += shx(s, 1, lane); s += shx(s, 2, lane); s += shx(s, 4, lane); qq += shx(qq, 1, lane); qq += shx(qq, 2, lane); qq += shx(qq, 4, lane);
              if ((lane & 7) == 0) *(f32x2*)(stat + ((size_t)(TL + r0 + row) * 32 + ((col - GWID) >> 6)) * 2) = (f32x2){s, qq}; } }
        __syncthreads();
    }
}
struct EpiAct {
    static constexpr bool PERM = true;
    LAS unsigned char* lds;
    __device__ __forceinline__ void operator()(const f32x4 (&acc)[2][2][4][2], const Unit& u, int wr, int wc, int fr, int fq) const {
        bf16_t* C = (bf16_t*)desc_p(lds, u.aux, 4); const int ldc = desc_i(lds, u.aux, 7), act = desc_i(lds, u.aux, 8);
        const int col0 = u.pn * 256 + wc * 32 + 8 * fq, row0 = u.pm * 256 + wr * 64 + fr;
#pragma unroll
        for (int ai = 0; ai < 2; ++ai)
#pragma unroll
            for (int m = 0; m < 4; ++m) { bf16_t* rowp = C + (size_t)(row0 + ai * 128 + m * 16) * ldc + col0;
#pragma unroll
                for (int bj = 0; bj < 2; ++bj) { f32x4 v0 = acc[ai][bj][m][0], v1 = acc[ai][bj][m][1];
                    if (act == 1) {
#pragma unroll
                        for (int j = 0; j < 4; ++j) { v0[j] = tanhf_(v0[j]); v1[j] = tanhf_(v1[j]); } }
                    else if (act == 2) {
#pragma unroll
                        for (int j = 0; j < 4; ++j) { v0[j] = sigmoidf_(v0[j]); v1[j] = sigmoidf_(v1[j]); } }
                    u32x4 w; w.x = cvt_pk_bf16(v0[0], v0[1]); w.y = cvt_pk_bf16(v0[2], v0[3]); w.z = cvt_pk_bf16(v1[0], v1[1]); w.w = cvt_pk_bf16(v1[2], v1[3]);
                    *(u32x4*)(rowp + bj * 128) = w; } }
    }
};
struct EpiLogits {
    static constexpr bool PERM = false;
    float* LG;
    __device__ __forceinline__ void operator()(const f32x4 (&acc)[2][2][4][2], const Unit& u, int wr, int wc, int fr, int fq) const {
        if (wc >= 2) return;
        const int col0 = wc * 32 + 4 * fq, row0 = u.pm * 256 + wr * 64 + fr;
#pragma unroll
        for (int ai = 0; ai < 2; ++ai)
#pragma unroll
            for (int m = 0; m < 4; ++m)
#pragma unroll
                for (int n = 0; n < 2; ++n) *(f32x4*)(LG + (size_t)(row0 + ai * 128 + m * 16) * 64 + col0 + n * 16) = acc[ai][0][m][n] + acc[ai][1][m][n];
    }
};
struct EpiSiluGate {
    static constexpr bool PERM = true;
    bf16_t* H;
    __device__ __forceinline__ void operator()(const f32x4 (&acc)[2][2][4][2], const Unit& u, int wr, int wc, int fr, int fq) const {
        const int col0 = u.pn * 128 + wc * 32 + 8 * fq, row0 = u.pm * 256 + wr * 64 + fr;
#pragma unroll
        for (int ai = 0; ai < 2; ++ai)
#pragma unroll
            for (int m = 0; m < 4; ++m) { f32x4 h0, h1;
#pragma unroll
                for (int j = 0; j < 4; ++j) { const float g0 = acc[ai][0][m][0][j], g1 = acc[ai][0][m][1][j]; h0[j] = g0 * sigmoidf_(g0) * acc[ai][1][m][0][j]; h1[j] = g1 * sigmoidf_(g1) * acc[ai][1][m][1][j]; }
                u32x4 w; w.x = cvt_pk_bf16(h0[0], h0[1]); w.y = cvt_pk_bf16(h0[2], h0[3]); w.z = cvt_pk_bf16(h1[0], h1[1]); w.w = cvt_pk_bf16(h1[2], h1[3]);
                *(u32x4*)(H + (size_t)(row0 + ai * 128 + m * 16) * EHID + col0) = w; }
    }
};
struct EpiScatter {
    static constexpr bool PERM = true;
    LAS unsigned char* lds; bf16_t* YB; const int* list;
    __device__ __forceinline__ void operator()(const f32x4 (&acc)[2][2][4][2], const Unit& u, int wr, int wc, int fr, int fq) const {
        LAS const int* tab = (LAS const int*)(lds + LDS_TAB);
        const int j0 = __builtin_amdgcn_readfirstlane(tab[MAXRT + u.pm]), cn = __builtin_amdgcn_readfirstlane(tab[2 * MAXRT + u.aux]);
        const int col0 = u.pn * 256 + wc * 32 + 8 * fq;
#pragma unroll
        for (int ai = 0; ai < 2; ++ai)
#pragma unroll
            for (int m = 0; m < 4; ++m) { const int slot = j0 + ai * 128 + wr * 64 + m * 16 + fr;
                if (slot < cn) { const int a = list[(size_t)u.aux * LISTCAP + slot]; bf16_t* rowp = YB + (size_t)a * D + col0;
#pragma unroll
                    for (int bj = 0; bj < 2; ++bj) { const f32x4 v0 = acc[ai][bj][m][0], v1 = acc[ai][bj][m][1];
                        u32x4 w; w.x = cvt_pk_bf16(v0[0], v0[1]); w.y = cvt_pk_bf16(v0[2], v0[3]); w.z = cvt_pk_bf16(v1[0], v1[1]); w.w = cvt_pk_bf16(v1[2], v1[3]);
                        *(u32x4*)(rowp + bj * 128) = w; } } }
    }
};

struct Params { const float* in[42]; float* out; unsigned char* ws; int ph_lo, ph_hi; };
enum { I_X = 0, I_C, I_CTX, I_CCTX, I_ADAW, I_ADAB, I_N1G, I_N2G, I_FG, I_GWIN, I_GBIN, I_GLNG, I_GLNB, I_GWS, I_GBS, I_GWOUT, I_GBOUT,
       I_MU, I_WR, I_WK, I_WV, I_WO, I_W0, I_W1, I_W2, I_A0, I_A1, I_A2, I_G1, I_G2, I_KK, I_KA, I_RK, I_LNG, I_LNB,
       I_MWGRP, I_MBGRP, I_MWEXP, I_MBEXP, I_MWG, I_MWU, I_MWD };
struct Frame { LAS unsigned char* lds; int tid, lane, wave, G, gw, NGW; };
typedef const __attribute__((address_space(4))) Params* KP;

constexpr int TRP = 36, TR_SCR = 64 * TRP * 4;
__device__ __forceinline__ void tr_item(const float* W, int N, int kmax, bf16_t* WT, int ldk, int k0, int n0, int drow0, int dk0, LAS float* scr, int lane) {
    const int n4 = lane & 7, kr = lane >> 3; f32x4 v[8];
#pragma unroll
    for (int i = 0; i < 8; ++i) { const int k = k0 + 8 * i + kr; v[i] = k < kmax ? *(const f32x4*)(W + (size_t)k * N + n0 + 4 * n4) : (f32x4){0.f, 0.f, 0.f, 0.f}; }
#pragma unroll
    for (int i = 0; i < 8; ++i) *(LAS f32x4*)(scr + (8 * i + kr) * TRP + 4 * n4) = v[i];
    asm volatile("s_waitcnt lgkmcnt(0)" ::: "memory");
    const int c = lane & 7;
#pragma unroll
    for (int j = 0; j < 4; ++j) { const int n = (lane >> 3) + 8 * j; const LAS float* sp = scr + (8 * c) * TRP + n;
        u32x4 o; o.x = cvt_pk_bf16(sp[0 * TRP], sp[1 * TRP]); o.y = cvt_pk_bf16(sp[2 * TRP], sp[3 * TRP]); o.z = cvt_pk_bf16(sp[4 * TRP], sp[5 * TRP]); o.w = cvt_pk_bf16(sp[6 * TRP], sp[7 * TRP]);
        *(u32x4*)(WT + (size_t)(drow0 + n) * ldk + dk0 + k0 + 8 * c) = o; }
    asm volatile("s_waitcnt lgkmcnt(0)" ::: "memory");
}
constexpr int LDS_JOBS = 80 * 1024, MAXJOBS = 48;
__device__ __forceinline__ void add_job(LAS int* jobs, int& nj, int& nit, const float* src, int N, int kmax, int kpad, bf16_t* dst, int ldk, int drow0, int dk0) {
    LAS int* q = jobs + nj * 12; const unsigned long long a = (unsigned long long)src, d = (unsigned long long)dst;
    q[0] = (int)(unsigned)a; q[1] = (int)(unsigned)(a >> 32); q[2] = (int)(unsigned)d; q[3] = (int)(unsigned)(d >> 32); q[4] = N; q[5] = kmax; q[6] = kpad / 64; q[7] = ldk; q[8] = drow0; q[9] = dk0; q[10] = nit;
    nit += (kpad / 64) * (N / 32); ++nj;
}
__device__ __forceinline__ void zero_fill(const Frame& F, bf16_t* p, size_t nbytes) {
    u32x4* q = (u32x4*)p; const size_t n = nbytes / 16;
    for (size_t i = (size_t)blockIdx.x * NTHR + F.tid; i < n; i += (size_t)F.G * NTHR) q[i] = (u32x4){0u, 0u, 0u, 0u};
}

__device__ __forceinline__ void prologue_phase(const Frame& F, KP P) {
    unsigned char* ws = P->ws;
    {   float* MOD = (float*)(ws + WS_MOD); LAS float* part = (LAS float*)F.lds;
        const float* c = P->in[I_C]; const float* cc = P->in[I_CCTX];
        for (int item = blockIdx.x; item < DEPTH * 24; item += F.G) {
            const int layer = item / 24, col = (item % 24) * 256 + 4 * F.lane; const float* w = P->in[I_ADAW] + (size_t)layer * D * 6 * D + col;
            f32x4 a0 = (f32x4){0.f, 0.f, 0.f, 0.f}, a1 = a0, a2 = a0;
#pragma unroll 8
            for (int i = 0; i < 128; ++i) { const int d = F.wave + 8 * i; const f32x4 wv = *(const f32x4*)(w + (size_t)d * 6 * D);
                const float c0 = c[d], c1 = c[D + d], c2 = cc[d];
                a0 += wv * (c0 * sigmoidf_(c0)); a1 += wv * (c1 * sigmoidf_(c1)); a2 += wv * (c2 * sigmoidf_(c2)); }
            __syncthreads();
            *(LAS f32x4*)(part + (F.wave * 3 + 0) * 256 + 4 * F.lane) = a0; *(LAS f32x4*)(part + (F.wave * 3 + 1) * 256 + 4 * F.lane) = a1; *(LAS f32x4*)(part + (F.wave * 3 + 2) * 256 + 4 * F.lane) = a2;
            __syncthreads();
            if (F.wave < 3) { f32x4 sacc = (f32x4){0.f, 0.f, 0.f, 0.f};
#pragma unroll
                for (int w8 = 0; w8 < 8; ++w8) sacc += *(const LAS f32x4*)(part + (w8 * 3 + F.wave) * 256 + 4 * F.lane);
                *(f32x4*)(MOD + ((size_t)layer * 3 + F.wave) * 6 * D + col) = sacc + *(const f32x4*)(P->in[I_ADAB] + (size_t)layer * 6 * D + col); }
        }
    }
    LAS int* jobs = (LAS int*)(F.lds + LDS_JOBS); LAS int* jtot = jobs + MAXJOBS * 12;
    __syncthreads();
    if (F.tid == 0) { int nj = 0, nit = 0;
        for (int j = 0; j < 2; ++j) {
            add_job(jobs, nj, nit, P->in[I_GWIN] + (size_t)j * D * 4096, 4096, D, D, (bf16_t*)(ws + WS_WIN) + (size_t)j * 4096 * D, D, 0, 0);
            add_job(jobs, nj, nit, P->in[I_GWOUT] + (size_t)j * GWID * D, D, GWID, GWID, (bf16_t*)(ws + WS_WOUT) + (size_t)j * D * GWID, GWID, 0, 0);
            add_job(jobs, nj, nit, P->in[I_WR] + (size_t)j * D * D, D, D, D, (bf16_t*)(ws + WS_WR) + (size_t)j * D * D, D, 0, 0);
            add_job(jobs, nj, nit, P->in[I_WK] + (size_t)j * D * D, D, D, D, (bf16_t*)(ws + WS_WK) + (size_t)j * D * D, D, 0, 0);
            add_job(jobs, nj, nit, P->in[I_WV] + (size_t)j * D * D, D, D, D, (bf16_t*)(ws + WS_WV) + (size_t)j * D * D, D, 0, 0);
            add_job(jobs, nj, nit, P->in[I_WO] + (size_t)j * D * D, D, D, D, (bf16_t*)(ws + WS_WO) + (size_t)j * D * D, D, 0, 0);
            for (int z = 0; z < 2; ++z) {
                add_job(jobs, nj, nit, P->in[I_W1] + ((size_t)j * 2 + z) * D * 64, 64, D, D, (bf16_t*)(ws + WS_LW1) + (size_t)j * 256 * D, D, z * 64, 0);
                add_job(jobs, nj, nit, P->in[I_A1] + ((size_t)j * 2 + z) * D * 64, 64, D, D, (bf16_t*)(ws + WS_LA1) + (size_t)j * 256 * D, D, z * 64, 0);
                add_job(jobs, nj, nit, P->in[I_W2] + ((size_t)j * 2 + z) * 64 * D, D, 64, 64, (bf16_t*)(ws + WS_W2P) + ((size_t)j * 2 + z) * D * 256, 256, 0, z * 64);
                add_job(jobs, nj, nit, P->in[I_A2] + ((size_t)j * 2 + z) * 64 * D, D, 64, 64, (bf16_t*)(ws + WS_A2P) + ((size_t)j * 2 + z) * D * 256, 256, 0, z * 64); }
            add_job(jobs, nj, nit, P->in[I_G1] + (size_t)j * D * 160, 160, D, D, (bf16_t*)(ws + WS_LG1) + (size_t)j * 256 * D, D, 0, 0);
            add_job(jobs, nj, nit, P->in[I_G2] + (size_t)j * 160 * D, D, 160, 256, (bf16_t*)(ws + WS_G2P) + (size_t)j * D * 256, 256, 0, 0); }
        jtot[0] = nj; jtot[1] = nit; }
    __syncthreads();
    {   const int nj = jtot[0], nit = jtot[1]; LAS float* scr = (LAS float*)(F.lds + F.wave * TR_SCR);
        for (int it = F.gw; it < nit; it += F.NGW) {
            int jb = 0; for (int q = 1; q < nj; ++q) if (it >= jobs[q * 12 + 10]) jb = q;
            jb = __builtin_amdgcn_readfirstlane(jb); LAS const int* q = jobs + jb * 12;
            const float* src = (const float*)(((unsigned long long)(unsigned)q[1] << 32) | (unsigned)q[0]); bf16_t* dst = (bf16_t*)(((unsigned long long)(unsigned)q[3] << 32) | (unsigned)q[2]);
            const int N = q[4], nnb = N / 32, r = it - q[10], kb = r / nnb, nb = r % nnb;
            tr_item(src, N, q[5], dst, q[7], kb * 64, nb * 32, q[8] + nb * 32, q[9], scr, F.lane); }
    }
    for (int j = 0; j < 2; ++j) {
        bf16_t* lw1 = (bf16_t*)(ws + WS_LW1) + (size_t)j * 256 * D; bf16_t* la1 = (bf16_t*)(ws + WS_LA1) + (size_t)j * 256 * D; bf16_t* lg1 = (bf16_t*)(ws + WS_LG1) + (size_t)j * 256 * D;
        zero_fill(F, lw1 + 128 * D, (size_t)128 * D * 2); zero_fill(F, la1 + 128 * D, (size_t)128 * D * 2); zero_fill(F, lg1 + 160 * D, (size_t)96 * D * 2);
        for (int z = 0; z < 2; ++z) { bf16_t* w2p = (bf16_t*)(ws + WS_W2P) + ((size_t)j * 2 + z) * D * 256; bf16_t* a2p = (bf16_t*)(ws + WS_A2P) + ((size_t)j * 2 + z) * D * 256;
            for (int idx = blockIdx.x * NTHR + F.tid; idx < D * 32; idx += F.G * NTHR) { const int n = idx >> 5, ch = idx & 31;
                if ((ch >> 3) != z) { *(u32x4*)(w2p + (size_t)n * 256 + ch * 8) = (u32x4){0u, 0u, 0u, 0u}; *(u32x4*)(a2p + (size_t)n * 256 + ch * 8) = (u32x4){0u, 0u, 0u, 0u}; } } }
    }
    {   bf16_t* wrt = (bf16_t*)(ws + WS_WRT);
        for (int idx = blockIdx.x * NTHR + F.tid; idx < DEPTH * 256 * (D / 8); idx += F.G * NTHR) { const int k0 = (idx & 127) * 8, n = (idx >> 7) & 255, layer = idx >> 15;
            const int nn = n & 127; const bool lo = n >= 128; float w[8];
#pragma unroll
            for (int e = 0; e < 8; ++e) { float x = 0.f;
                if (nn < 4) x = P->in[I_MWGRP][((size_t)layer * D + k0 + e) * 4 + nn]; else if (nn < 36) x = P->in[I_MWEXP][((size_t)layer * D + k0 + e) * NE + nn - 4];
                const float hi = bf_lo(cvt_pk_bf16(x, 0.f)); w[e] = lo ? x - hi : x; }
            *(u32x4*)(wrt + ((size_t)layer * 256 + n) * D + k0) = pack8(w); } }
    {   const float* src = P->in[I_GWS]; bf16_t* dst = (bf16_t*)(ws + WS_WSP); const int n8 = 2 * 16 * 128 * 128 / 8;
        for (int i = blockIdx.x * NTHR + F.tid; i < n8; i += F.G * NTHR) { const f32x4 a = *(const f32x4*)(src + (size_t)i * 8), b = *(const f32x4*)(src + (size_t)i * 8 + 4);
            u32x4 o; o.x = cvt_pk_bf16(a[0], a[1]); o.y = cvt_pk_bf16(a[2], a[3]); o.z = cvt_pk_bf16(b[0], b[1]); o.w = cvt_pk_bf16(b[2], b[3]); *(u32x4*)(dst + (size_t)i * 8) = o; } }
}
__device__ __forceinline__ void moe_weights_phase(const Frame& F, KP P, int layer) {
    unsigned char* ws = P->ws; LAS float* scr = (LAS float*)(F.lds + F.wave * TR_SCR);
    for (int it = F.gw; it < NE * 768; it += F.NGW) {
        const int e = it / 768, r = it % 768, m = r >> 8, q = r & 255;
        const size_t so = ((size_t)layer * NE + e) * (size_t)D * EHID;
        if (m < 2) { const int kb = q >> 4, n0 = (q & 15) * 32;
            tr_item((m == 0 ? P->in[I_MWG] : P->in[I_MWU]) + so, EHID, D, (bf16_t*)(ws + WS_WGU) + (size_t)e * D * D, D, kb * 64, n0, 256 * (n0 >> 7) + (n0 & 127) + (m == 1 ? 128 : 0), 0, scr, F.lane); }
        else { const int kb = q >> 5, n0 = (q & 31) * 32;
            tr_item(P->in[I_MWD] + so, D, EHID, (bf16_t*)(ws + WS_WD) + (size_t)e * D * EHID, EHID, kb * 64, n0, n0, 0, scr, F.lane); }
    }
}

__device__ __forceinline__ void load_xrow(KP P, const Frame& F, int layer, int row, f32x4 (&v)[4]) {
    if (layer == 0) { const float* xr = row < TL ? P->in[I_X] + (size_t)row * D : P->in[I_CTX] + (size_t)(row - TL) * D;
#pragma unroll
        for (int j = 0; j < 4; ++j) v[j] = *(const f32x4*)(xr + 4 * F.lane + 256 * j); }
    else { const bf16_t* xr = (const bf16_t*)(P->ws + WS_X) + (size_t)row * D;
#pragma unroll
        for (int j = 0; j < 4; ++j) { const u32x2 w = *(const u32x2*)(xr + 4 * F.lane + 256 * j); v[j] = (f32x4){bf_lo(w.x), bf_hi(w.x), bf_lo(w.y), bf_hi(w.y)}; } }
}
__device__ __forceinline__ void load_combine(KP P, const Frame& F, int layer, int row, int m, bool combine, f32x4 (&v)[4]) {
    load_xrow(P, F, layer, row, v);
    if (combine) {
        const bf16_t* yb = (const bf16_t*)(P->ws + WS_YB); const float* wg = (const float*)(P->ws + WS_WGT);
        const float w0 = wg[2 * row], w1 = wg[2 * row + 1]; const float* g2 = (const float*)(P->ws + WS_MOD) + ((size_t)(layer - 1) * 3 + m) * 6 * D + 5 * D;
#pragma unroll
        for (int j = 0; j < 4; ++j) { const int col = 4 * F.lane + 256 * j; const u32x2 a = *(const u32x2*)(yb + (size_t)(2 * row) * D + col), b = *(const u32x2*)(yb + (size_t)(2 * row + 1) * D + col);
            const f32x4 g = *(const f32x4*)(g2 + col);
            v[j][0] += g[0] * (w0 * bf_lo(a.x) + w1 * bf_lo(b.x)); v[j][1] += g[1] * (w0 * bf_hi(a.x) + w1 * bf_hi(b.x));
            v[j][2] += g[2] * (w0 * bf_lo(a.y) + w1 * bf_lo(b.y)); v[j][3] += g[3] * (w0 * bf_hi(a.y) + w1 * bf_hi(b.y)); }
    }
}
__device__ __forceinline__ void norm1_phase(const Frame& F, KP P, int layer) {
    const bool combine = layer > 0; bf16_t* X = (bf16_t*)(P->ws + WS_X); bf16_t* HL = (bf16_t*)(P->ws + WS_HL);
    const float* g1 = P->in[I_N1G] + (size_t)layer * D;
    for (int row = F.gw; row < T; row += F.NGW) {
        const int m = row < TL ? (row >> 14) : 2; f32x4 v[4];
        load_combine(P, F, layer, row, m, combine, v);
        {
#pragma unroll
            for (int j = 0; j < 4; ++j) { u32x2 o; o.x = cvt_pk_bf16(v[j][0], v[j][1]); o.y = cvt_pk_bf16(v[j][2], v[j][3]); *(u32x2*)(X + (size_t)row * D + 4 * F.lane + 256 * j) = o;
                v[j] = (f32x4){bf_lo(o.x), bf_hi(o.x), bf_lo(o.y), bf_hi(o.y)}; } }
        float ss = 0.f;
#pragma unroll
        for (int j = 0; j < 4; ++j) ss += (v[j][0] * v[j][0] + v[j][1] * v[j][1]) + (v[j][2] * v[j][2] + v[j][3] * v[j][3]);
        const float rstd = rsqrtf(wave_sum(ss, F.lane) * (1.0f / D) + 1e-6f);
        const float* mod = (const float*)(P->ws + WS_MOD) + ((size_t)layer * 3 + m) * 6 * D;
#pragma unroll
        for (int j = 0; j < 4; ++j) { const int col = 4 * F.lane + 256 * j; const f32x4 g = *(const f32x4*)(g1 + col), sh = *(const f32x4*)(mod + col), sc = *(const f32x4*)(mod + D + col);
            const f32x4 h = (v[j] * rstd) * g * (sc + 1.0f) + sh;
            u32x2 o; o.x = cvt_pk_bf16(h[0], h[1]); o.y = cvt_pk_bf16(h[2], h[3]); *(u32x2*)(HL + (size_t)row * D + col) = o; }
    }
}
__device__ __forceinline__ void final_phase(const Frame& F, KP P) {
    const float* fg = P->in[I_FG];
    for (int row = F.gw; row < TL; row += F.NGW) {
        const int m = row >> 14; f32x4 v[4];
        load_combine(P, F, DEPTH, row, m, true, v);
        float ss = 0.f;
#pragma unroll
        for (int j = 0; j < 4; ++j) ss += (v[j][0] * v[j][0] + v[j][1] * v[j][1]) + (v[j][2] * v[j][2] + v[j][3] * v[j][3]);
        const float rstd = rsqrtf(wave_sum(ss, F.lane) * (1.0f / D) + 1e-6f);
#pragma unroll
        for (int j = 0; j < 4; ++j) { const int col = 4 * F.lane + 256 * j; *(f32x4*)(P->out + (size_t)row * D + col) = (v[j] * rstd) * *(const f32x4*)(fg + col); }
    }
}
__device__ __forceinline__ void norm2_phase(const Frame& F, KP P, int layer) {
    const int ntok = layer == DEPTH - 1 ? TL : T; bf16_t* HL2 = (bf16_t*)(P->ws + WS_HL); const float* g2n = P->in[I_N2G] + (size_t)layer * D;
    for (int row = F.gw; row < ntok; row += F.NGW) {
        const int m = row < TL ? (row >> 14) : 2; f32x4 v[4]; load_xrow(P, F, 1, row, v);
        float ss = 0.f;
#pragma unroll
        for (int j = 0; j < 4; ++j) ss += (v[j][0] * v[j][0] + v[j][1] * v[j][1]) + (v[j][2] * v[j][2] + v[j][3] * v[j][3]);
        const float rstd = rsqrtf(wave_sum(ss, F.lane) * (1.0f / D) + 1e-6f);
        const float* mod = (const float*)(P->ws + WS_MOD) + ((size_t)layer * 3 + m) * 6 * D;
#pragma unroll
        for (int j = 0; j < 4; ++j) { const int col = 4 * F.lane + 256 * j; const f32x4 g = *(const f32x4*)(g2n + col), sh = *(const f32x4*)(mod + 3 * D + col), sc = *(const f32x4*)(mod + 4 * D + col);
            const f32x4 h = (v[j] * rstd) * g * (sc + 1.0f) + sh;
            u32x2 o; o.x = cvt_pk_bf16(h[0], h[1]); o.y = cvt_pk_bf16(h[2], h[3]); *(u32x2*)(HL2 + (size_t)row * D + col) = o; }
    }
    moe_weights_phase(F, P, layer);
}
__device__ __forceinline__ void route_phase(const Frame& F, KP P, int layer) {
    const int ntok = layer == DEPTH - 1 ? TL : T; const float* LG = (const float*)(P->ws + WS_LG);
    const float* bgrp = P->in[I_MBGRP] + layer * 4; const float* bexp = P->in[I_MBEXP] + layer * NE;
    unsigned* cnt = (unsigned*)(P->ws + WS_CTL) + CW_CNT + layer * 64; int* list = (int*)(P->ws + WS_LIST); float* wgt = (float*)(P->ws + WS_WGT);
    LAS unsigned* lcnt = (LAS unsigned*)F.lds; LAS unsigned* lbase = lcnt + 32;
    for (int r0 = blockIdx.x * NTHR; r0 < ntok; r0 += F.G * NTHR) {
        const int row = r0 + F.tid; const bool act = row < ntok;
        __syncthreads();
        if (F.tid < 32) lcnt[F.tid] = 0u;
        __syncthreads();
        int e0 = 0, e1 = 0; unsigned k0 = 0, k1 = 0;
        if (act) {
            const float* lg = LG + (size_t)row * 64; const f32x4 g4 = *(const f32x4*)lg;
            float ag[4];
#pragma unroll
            for (int i = 0; i < 4; ++i) ag[i] = g4[i] + bgrp[i];
            int grp = 0; float mx = ag[0];
#pragma unroll
            for (int i = 1; i < 4; ++i) if (ag[i] > mx) { mx = ag[i]; grp = i; }
            float den = 0.f;
#pragma unroll
            for (int i = 0; i < 4; ++i) den += __expf(ag[i] - mx);
            const float pg = 1.0f / den;
            const f32x4 e0v = *(const f32x4*)(lg + 4 + 8 * grp), e1v = *(const f32x4*)(lg + 8 + 8 * grp); const f32x4 b0v = *(const f32x4*)(bexp + 8 * grp), b1v = *(const f32x4*)(bexp + 8 * grp + 4);
            float el[8];
#pragma unroll
            for (int i = 0; i < 4; ++i) { el[i] = e0v[i] + b0v[i]; el[4 + i] = e1v[i] + b1v[i]; }
            int i0 = 0; float t0 = el[0];
#pragma unroll
            for (int i = 1; i < 8; ++i) if (el[i] > t0) { t0 = el[i]; i0 = i; }
            int i1 = -1; float t1 = -3.0e38f;
#pragma unroll
            for (int i = 0; i < 8; ++i) if (i != i0 && el[i] > t1) { t1 = el[i]; i1 = i; }
            const float p0 = 1.0f / (1.0f + __expf(t1 - t0));
            wgt[2 * row] = pg * p0; wgt[2 * row + 1] = pg * (1.0f - p0);
            e0 = grp * 8 + i0; e1 = grp * 8 + i1;
            k0 = atomicAdd((unsigned*)(lcnt + e0), 1u); k1 = atomicAdd((unsigned*)(lcnt + e1), 1u);
        }
        __syncthreads();
        if (F.tid < 32) { const unsigned c = lcnt[F.tid]; lbase[F.tid] = c ? atomicAdd(cnt + F.tid, c) : 0u; }
        __syncthreads();
        if (act) { list[(size_t)e0 * LISTCAP + lbase[e0] + k0] = 2 * row; list[(size_t)e1 * LISTCAP + lbase[e1] + k1] = 2 * row + 1; }
    }
}
__device__ __forceinline__ bf16x8 tr_frag136(const LAS bf16_t* M, int k0, int c0, int lane) {
    LAS bf16_t* p = (LAS bf16_t*)M + (k0 + 8 * (lane >> 4) + ((lane & 15) >> 2)) * 136 + c0 + 4 * (lane & 3);
    const v4s lo = __builtin_amdgcn_ds_read_tr16_b64_v4i16((LAS v4s*)p), hi = __builtin_amdgcn_ds_read_tr16_b64_v4i16((LAS v4s*)(p + 4 * 136));
    return (bf16x8){lo[0], lo[1], lo[2], lo[3], hi[0], hi[1], hi[2], hi[3]};
}
__device__ __forceinline__ void spatial_phase(const Frame& F, KP P, int j) {
    bf16_t* U = (bf16_t*)(P->ws + WS_U); const bf16_t* V = (const bf16_t*)(P->ws + WS_V); const float* stat = (const float*)(P->ws + WS_STAT);
    const bf16_t* WSP = (const bf16_t*)(P->ws + WS_WSP) + (size_t)j * 16 * 128 * 128;
    const float* lng = P->in[I_GLNG] + (size_t)j * GWID; const float* lnb = P->in[I_GLNB] + (size_t)j * GWID; const float* bs = P->in[I_GBS] + (size_t)j * 16 * 128;
    LAS bf16_t* Wt = (LAS bf16_t*)F.lds; LAS bf16_t* Vn = Wt + 128 * 136;
    LAS float* mu = (LAS float*)(F.lds + 2 * 128 * 136 * 2); LAS float* rs = mu + 128;
    const int l15 = F.lane & 15, l4 = F.lane >> 4;
    for (int item = blockIdx.x; item < (T / 128) * 4; item += F.G) {
        const int c = item >> 2, gq = item & 3, t0 = c * 128;
        LDS_BARRIER();
        if (F.tid < 128) { const int row = t0 + F.tid; float s = 0.f, q = 0.f;
#pragma unroll 8
            for (int i = 0; i < 32; ++i) { const f32x2 p = *(const f32x2*)(stat + ((size_t)row * 32 + i) * 2); s += p.x; q += p.y; }
            const float mean = s * (1.0f / GWID), var = q * (1.0f / GWID) - mean * mean; mu[F.tid] = mean; rs[F.tid] = rsqrtf(var + 1e-5f); }
#pragma nounroll
        for (int gi = 0; gi < 4; ++gi) { const int g = gq * 4 + gi;
            u32x4 wv[4], vv[4];
#pragma unroll
            for (int i = 0; i < 4; ++i) { const int idx = F.tid + NTHR * i, r = idx >> 4, seg = idx & 15;
                wv[i] = *(const u32x4*)(WSP + ((size_t)g * 128 + r) * 128 + seg * 8); vv[i] = *(const u32x4*)(V + (size_t)(t0 + r) * GWID + g * 128 + seg * 8); }
            LDS_BARRIER();
#pragma unroll
            for (int i = 0; i < 4; ++i) { const int idx = F.tid + NTHR * i, r = idx >> 4, seg = idx & 15, ch = g * 128 + seg * 8;
                *(LAS u32x4*)(Wt + r * 136 + seg * 8) = wv[i];
                float x[8], o[8]; unpack8(vv[i], x); const float m_ = mu[r], r_ = rs[r];
                const f32x4 g0 = *(const f32x4*)(lng + ch), g1 = *(const f32x4*)(lng + ch + 4), b0 = *(const f32x4*)(lnb + ch), b1 = *(const f32x4*)(lnb + ch + 4);
#pragma unroll
                for (int e = 0; e < 8; ++e) o[e] = (x[e] - m_) * r_ * (e < 4 ? g0[e & 3] : g1[e & 3]) + (e < 4 ? b0[e & 3] : b1[e & 3]);
                *(LAS u32x4*)(Vn + r * 136 + seg * 8) = pack8(o); }
            LDS_BARRIER();
            bf16x8 bw[4];
#pragma unroll
            for (int ks = 0; ks < 4; ++ks) bw[ks] = *(const LAS bf16x8*)(Wt + (16 * F.wave + l15) * 136 + ks * 32 + 8 * l4);
            const int p = 16 * F.wave + l15; const float bias = bs[g * 128 + p];
            bf16_t* urow = U + (size_t)(t0 + p) * GWID + g * 128 + 4 * l4;
            u32x2 uu[8];
#pragma unroll
            for (int dt = 0; dt < 8; ++dt) uu[dt] = *(const u32x2*)(urow + dt * 16);
#pragma unroll
            for (int dt = 0; dt < 8; ++dt) { f32x4 acc = (f32x4){0.f, 0.f, 0.f, 0.f};
#pragma unroll
                for (int ks = 0; ks < 4; ++ks) { const bf16x8 a = tr_frag136(Vn, 32 * ks, 16 * dt, F.lane); acc = __builtin_amdgcn_mfma_f32_16x16x32_bf16(a, bw[ks], acc, 0, 0, 0); }
                u32x2 o; o.x = cvt_pk_bf16(bf_lo(uu[dt].x) * (acc[0] + bias), bf_hi(uu[dt].x) * (acc[1] + bias)); o.y = cvt_pk_bf16(bf_lo(uu[dt].y) * (acc[2] + bias), bf_hi(uu[dt].y) * (acc[3] + bias));
                *(u32x2*)(urow + dt * 16) = o; }
        }
    }
}

__device__ __forceinline__ void mix_phase(const Frame& F, KP P, int j) {
    const bf16_t* HL = (const bf16_t*)(P->ws + WS_HL); const float* mu = P->in[I_MU] + (size_t)j * 6 * D;
    bf16_t* outs[6] = {(bf16_t*)(P->ws + WS_XR), (bf16_t*)(P->ws + WS_XW), (bf16_t*)(P->ws + WS_XK), (bf16_t*)(P->ws + WS_XV), (bf16_t*)(P->ws + WS_XA), (bf16_t*)(P->ws + WS_XG)};
    for (int row = F.gw; row < T; row += F.NGW) {
        bool ok[2]; int src[2]; const bool hi = F.lane >= 32;
        if (row < TL) { const int n = row & (SEQ - 1), gc = n & 63, gr = n >> 6;
            ok[0] = hi ? gc < 63 : gc > 0; src[0] = hi ? row + 1 : row - 1; ok[1] = hi ? gr < 255 : gr > 0; src[1] = hi ? row + 64 : row - 64; }
        else { const int n = (row - TL) & (CTXL - 1); ok[0] = n > 0; src[0] = row - 1; ok[1] = n < CTXL - 1; src[1] = row + 1; }
#pragma unroll
        for (int jj = 0; jj < 2; ++jj) { const int col = 512 * jj + 8 * F.lane;
            const u32x4 h8 = *(const u32x4*)(HL + (size_t)row * D + col); u32x4 s8 = (u32x4){0u, 0u, 0u, 0u};
            if (ok[jj]) s8 = *(const u32x4*)(HL + (size_t)src[jj] * D + col);
            const unsigned hw[4] = {h8.x, h8.y, h8.z, h8.w}, sw[4] = {s8.x, s8.y, s8.z, s8.w}; float h[8], xx[8];
#pragma unroll
            for (int e = 0; e < 8; ++e) { h[e] = (e & 1) ? bf_hi(hw[e >> 1]) : bf_lo(hw[e >> 1]); const float s = (e & 1) ? bf_hi(sw[e >> 1]) : bf_lo(sw[e >> 1]); xx[e] = s - h[e]; }
#pragma unroll
            for (int m = 0; m < 6; ++m) { const f32x4 ma = *(const f32x4*)(mu + (size_t)m * D + col), mb = *(const f32x4*)(mu + (size_t)m * D + col + 4);
                u32x4 o; o.x = cvt_pk_bf16(h[0] + xx[0] * ma[0], h[1] + xx[1] * ma[1]); o.y = cvt_pk_bf16(h[2] + xx[2] * ma[2], h[3] + xx[3] * ma[3]);
                o.z = cvt_pk_bf16(h[4] + xx[4] * mb[0], h[5] + xx[5] * mb[1]); o.w = cvt_pk_bf16(h[6] + xx[6] * mb[2], h[7] + xx[7] * mb[3]);
                *(u32x4*)(outs[m] + (size_t)row * D + col) = o; } }
    }
}

constexpr int NSC = 65, NSCAN = 64, TP = 72, TILE_B = 64 * TP * 2;
enum { T_AT = 0, T_RT, T_BT, T_KT, T_VM, T_NT, T_MT, T_NRT, T_MRT, T_APA, T_APB, T_TAA, T_TAB, T_PRB, T_QRB, T_NTILE };
constexpr int LDS_GL = T_NTILE * TILE_B, LDS_SEG = LDS_GL + 256;
static_assert(LDS_SEG + 2048 <= LDS_MISC, "scan LDS map");
__device__ __forceinline__ int scan_row(int z, int b, int p) {
    if (p < CTXL) return TL + b * CTXL + (z ? CTXL - 1 - p : p);
    const int q = p - CTXL; return b * SEQ + (z ? SEQ - 1 - q : q);
}
__device__ __forceinline__ LAS bf16_t* stile(LAS unsigned char* lds, int n) { return (LAS bf16_t*)(lds + n * TILE_B); }
__device__ __forceinline__ bf16x8 row_frag(const LAS bf16_t* M, int r0, int k0, int lane) { return *(const LAS bf16x8*)(M + (r0 + (lane & 15)) * TP + k0 + 8 * (lane >> 4)); }
__device__ __forceinline__ bf16x8 tr_frag(const LAS bf16_t* M, int k0, int c0, int lane) {
    LAS bf16_t* p = (LAS bf16_t*)M + (k0 + 8 * (lane >> 4) + ((lane & 15) >> 2)) * TP + c0 + 4 * (lane & 3);
    const v4s lo = __builtin_amdgcn_ds_read_tr16_b64_v4i16((LAS v4s*)p), hi = __builtin_amdgcn_ds_read_tr16_b64_v4i16((LAS v4s*)(p + 4 * TP));
    return (bf16x8){lo[0], lo[1], lo[2], lo[3], hi[0], hi[1], hi[2], hi[3]};
}
template <bool XT, bool YT>
__device__ __forceinline__ void mm64(const LAS bf16_t* X, const LAS bf16_t* Y, f32x4 (&acc)[2], int wq, int wh, int lane) {
#pragma unroll
    for (int ks = 0; ks < 2; ++ks) {
        const bf16x8 b = XT ? tr_frag(X, 32 * ks, 16 * wq, lane) : row_frag(X, 16 * wq, 32 * ks, lane);
#pragma unroll
        for (int q = 0; q < 2; ++q) { const int i0 = 16 * (2 * wh + q);
            const bf16x8 a = YT ? row_frag(Y, i0, 32 * ks, lane) : tr_frag(Y, 32 * ks, i0, lane);
            acc[q] = __builtin_amdgcn_mfma_f32_16x16x32_bf16(a, b, acc[q], 0, 0, 0); }
    }
}
__device__ __forceinline__ void st_tile(LAS bf16_t* Z, const f32x4 (&acc)[2], int wq, int wh, int lane) {
#pragma unroll
    for (int q = 0; q < 2; ++q) { u32x2 o; o.x = cvt_pk_bf16(acc[q][0], acc[q][1]); o.y = cvt_pk_bf16(acc[q][2], acc[q][3]);
        *(LAS u32x2*)(Z + (16 * wq + (lane & 15)) * TP + 16 * (2 * wh + q) + 4 * (lane >> 4)) = o; }
}
__device__ __forceinline__ void ld_tile(const LAS bf16_t* Z, f32x4 (&acc)[2], int wq, int wh, int lane) {
#pragma unroll
    for (int q = 0; q < 2; ++q) { const u32x2 o = *(const LAS u32x2*)(Z + (16 * wq + (lane & 15)) * TP + 16 * (2 * wh + q) + 4 * (lane >> 4));
        acc[q] = (f32x4){bf_lo(o.x), bf_hi(o.x), bf_lo(o.y), bf_hi(o.y)}; }
}
__device__ __forceinline__ f32x4 prod16(const LAS bf16_t* X, int xr, int xc, const LAS bf16_t* Y, int yr, int yc, f32x4 acc, int lane) {
    bf16x8 b = *(const LAS bf16x8*)(X + (xr + (lane & 15)) * TP + xc + 8 * (lane >> 4)); bf16x8 a = tr_frag(Y, yr, yc, lane);
    if ((lane >> 4) >= 2) { b = (bf16x8){0, 0, 0, 0, 0, 0, 0, 0}; a = (bf16x8){0, 0, 0, 0, 0, 0, 0, 0}; }
    return __builtin_amdgcn_mfma_f32_16x16x32_bf16(a, b, acc, 0, 0, 0);
}
__device__ __forceinline__ void st16(LAS bf16_t* Z, int zr, int zc, f32x4 acc, int lane) { u32x2 o; o.x = cvt_pk_bf16(acc[0], acc[1]); o.y = cvt_pk_bf16(acc[2], acc[3]); *(LAS u32x2*)(Z + (zr + (lane & 15)) * TP + zc + 4 * (lane >> 4)) = o; }
__device__ __forceinline__ f32x4 ld16(const LAS bf16_t* Z, int zr, int zc, int lane) { const u32x2 o = *(const LAS u32x2*)(Z + (zr + (lane & 15)) * TP + zc + 4 * (lane >> 4)); return (f32x4){bf_lo(o.x), bf_hi(o.x), bf_lo(o.y), bf_hi(o.y)}; }
struct ChunkRegs { u32x4 r, k, v, tw, ta; };
__device__ __forceinline__ void scan_load(KP P, const Frame& F, int item, int c4, ChunkRegs& R) {
    const int s = item & 63, sc = item >> 6, z = s >> 5, b = (s >> 4) & 1, hh = s & 15;
    const size_t row = (size_t)scan_row(z, b, sc * 256 + c4 * 64 + (F.tid >> 3)); const size_t o = row * D + hh * 64 + (F.tid & 7) * 8, o2 = row * 256 + z * 64 + (F.tid & 7) * 8;
    R.r = *(const u32x4*)((const bf16_t*)(P->ws + WS_R) + o); R.k = *(const u32x4*)((const bf16_t*)(P->ws + WS_K) + o); R.v = *(const u32x4*)((const bf16_t*)(P->ws + WS_VV) + o);
    R.tw = *(const u32x4*)((const bf16_t*)(P->ws + WS_TW) + o2); R.ta = *(const u32x4*)((const bf16_t*)(P->ws + WS_TA) + o2);
}
__device__ __forceinline__ void scan_chunk_phase(const Frame& F, KP P, int j) {
    LAS unsigned char* lds = F.lds;
    LAS bf16_t* At = stile(lds, T_AT); LAS bf16_t* Rt = stile(lds, T_RT); LAS bf16_t* Bt = stile(lds, T_BT); LAS bf16_t* Kt = stile(lds, T_KT); LAS bf16_t* Vm = stile(lds, T_VM);
    LAS bf16_t* NT = stile(lds, T_NT); LAS bf16_t* MT = stile(lds, T_MT); LAS bf16_t* NrT = stile(lds, T_NRT); LAS bf16_t* MrT = stile(lds, T_MRT);
    LAS bf16_t* ApA = stile(lds, T_APA); LAS bf16_t* ApB = stile(lds, T_APB); LAS bf16_t* TaA = stile(lds, T_TAA); LAS bf16_t* TaB = stile(lds, T_TAB);
    LAS bf16_t* PrB = stile(lds, T_PRB); LAS bf16_t* QrB = stile(lds, T_QRB);
    LAS float* gl = (LAS float*)(lds + LDS_GL); LAS float* seg = (LAS float*)(lds + LDS_SEG);
    const int lane = F.lane, wq = F.wave & 3, wh = F.wave >> 2, l15 = lane & 15, l4 = lane >> 4;
    const int pi = F.tid >> 3, kq = F.tid & 7;
    const int jrow = 16 * wq + l15;
    const int NITEM = NSCAN * NSC;
    int item = blockIdx.x; if (item >= NITEM) return;
    ChunkRegs cur, nxt; scan_load(P, F, item, 0, cur); nxt = cur;
    f32x4 Pr[2], Qr[2], aYp[2], aQp[2];
#pragma unroll
    for (int q = 0; q < 2; ++q) { Pr[q] = (f32x4){0.f, 0.f, 0.f, 0.f}; Qr[q] = Pr[q]; aYp[q] = Pr[q]; aQp[q] = Pr[q]; }
    bool pend = false; size_t orowp = 0; bf16_t* GEp = nullptr; bf16_t* YEp = nullptr; float* pqp = nullptr; bool lastp = false;
#define SCAN_STAGE_G() do { \
        f32x4 ge[2] = {(f32x4){0.f, 0.f, 0.f, 0.f}, (f32x4){0.f, 0.f, 0.f, 0.f}}; \
        mm64<false, true>(NT, PrB, ge, wq, wh, lane); mm64<false, true>(NT, QrB, aYp, wq, wh, lane); \
        f32x4 pn[2] = {(f32x4){0.f, 0.f, 0.f, 0.f}, (f32x4){0.f, 0.f, 0.f, 0.f}}; \
        mm64<false, false>(PrB, MT, pn, wq, wh, lane); mm64<false, false>(QrB, MT, aQp, wq, wh, lane); \
        _Pragma("unroll") for (int q = 0; q < 2; ++q) { const int i0 = 16 * (2 * wh + q) + 4 * l4; \
            u32x2 o; o.x = cvt_pk_bf16(ge[q][0], ge[q][1]); o.y = cvt_pk_bf16(ge[q][2], ge[q][3]); *(u32x2*)(GEp + orowp + i0) = o; \
            u32x2 y; y.x = cvt_pk_bf16(aYp[q][0], aYp[q][1]); y.y = cvt_pk_bf16(aYp[q][2], aYp[q][3]); *(u32x2*)(YEp + orowp + i0) = y; \
            Pr[q] = pn[q]; Qr[q] = aQp[q]; } \
        if (lastp) { _Pragma("unroll") for (int q = 0; q < 2; ++q) { const int i0 = 16 * (2 * wh + q) + 4 * l4; *(f32x4*)(pqp + jrow * 64 + i0) = Pr[q]; *(f32x4*)(pqp + 4096 + jrow * 64 + i0) = Qr[q]; } } \
    } while (0)
    for (;;) {
        const int s = item & 63, sc = item >> 6, z = s >> 5, b = (s >> 4) & 1, hh = s & 15;
        const float* kkw = P->in[I_KK] + (size_t)j * D + hh * 64 + kq * 8; const float* kap = P->in[I_KA] + (size_t)j * D + hh * 64 + kq * 8; const float* rkp = P->in[I_RK] + (size_t)j * D + hh * 64 + kq * 8;
        const float* w0p = P->in[I_W0] + ((size_t)j * 2 + z) * D + hh * 64; const float* a0p = P->in[I_A0] + ((size_t)j * 2 + z) * D + hh * 64;
        float* bon = (float*)(P->ws + WS_BON) + (size_t)z * T * 16;
        const u32x4 w2r = *(const u32x4*)((const bf16_t*)(P->ws + WS_W2P) + (((size_t)j * 2 + z) * D + hh * 64 + pi) * 256 + z * 64 + kq * 8);
        const u32x4 a2r = *(const u32x4*)((const bf16_t*)(P->ws + WS_A2P) + (((size_t)j * 2 + z) * D + hh * 64 + pi) * 256 + z * 64 + kq * 8);
        bf16_t* GE = (bf16_t*)(P->ws + (z ? WS_AS1 : WS_AS0)); bf16_t* YE = (bf16_t*)(P->ws + (z ? WS_ELOG1 : WS_ELOG0));
        float* pq = (float*)(P->ws + WS_PQ) + ((size_t)(s * NSC + sc) * 2) * 4096;
#pragma nounroll
        for (int c4 = 0; c4 < 4; ++c4) {
            unsigned long long ch_t[12]; ch_t[11] = CH_AMP >= 0 ? __builtin_amdgcn_s_memrealtime() : 0ull;
            *(LAS u32x4*)(ApA + pi * TP + kq * 8) = cur.tw; *(LAS u32x4*)(ApB + pi * TP + kq * 8) = cur.ta; *(LAS u32x4*)(NrT + pi * TP + kq * 8) = w2r; *(LAS u32x4*)(MrT + pi * TP + kq * 8) = a2r;
            LDS_BARRIER(); CH_STAMP(0);
            {   f32x4 lw[2] = {(f32x4){0.f, 0.f, 0.f, 0.f}, (f32x4){0.f, 0.f, 0.f, 0.f}}, la[2] = {(f32x4){0.f, 0.f, 0.f, 0.f}, (f32x4){0.f, 0.f, 0.f, 0.f}};
                mm64<false, true>(ApA, NrT, lw, wq, wh, lane); mm64<false, true>(ApB, MrT, la, wq, wh, lane);
#pragma unroll
                for (int q = 0; q < 2; ++q) { const int i0 = 16 * (2 * wh + q) + 4 * l4; const f32x4 w04 = *(const f32x4*)(w0p + i0), a04 = *(const f32x4*)(a0p + i0);
#pragma unroll
                    for (int r = 0; r < 4; ++r) { lw[q][r] = -0.60653065971f * sigmoidf_(w04[r] + lw[q][r]); la[q][r] = sigmoidf_(a04[r] + la[q][r]); } }
                st_tile(TaA, lw, wq, wh, lane); st_tile(TaB, la, wq, wh, lane); }
            LDS_BARRIER(); CH_STAMP(1);
            float r8[8], k8[8], e8[8], m8[8], a8[8], kk8[8], c8[8];
            { const u32x4 et = *(const LAS u32x4*)(TaA + pi * TP + kq * 8), at = *(const LAS u32x4*)(TaB + pi * TP + kq * 8); unpack8(cur.r, r8); unpack8(cur.k, k8); unpack8(et, e8); unpack8(at, a8); }
            {   const f32x4 ka0 = *(const f32x4*)(kap), ka1 = *(const f32x4*)(kap + 4), rk0 = *(const f32x4*)(rkp), rk1 = *(const f32x4*)(rkp + 4); float bp = 0.f;
#pragma unroll
                for (int e = 0; e < 8; ++e) { m8[e] = k8[e] * (1.0f + (a8[e] - 1.0f) * (e < 4 ? ka0[e & 3] : ka1[e & 3])); bp += r8[e] * (e < 4 ? rk0[e & 3] : rk1[e & 3]) * m8[e]; }
                bp += shx(bp, 1, lane); bp += shx(bp, 2, lane); bp += shx(bp, 4, lane);
                if (kq == 0) bon[(size_t)scan_row(z, b, sc * 256 + c4 * 64 + pi) * 16 + hh] = bp; }
            { const f32x4 w0 = *(const f32x4*)kkw, w1 = *(const f32x4*)(kkw + 4); float ss = 0.f;
#pragma unroll
              for (int e = 0; e < 8; ++e) { kk8[e] = k8[e] * (e < 4 ? w0[e & 3] : w1[e & 3]); ss += kk8[e] * kk8[e]; }
              ss += shx(ss, 1, lane); ss += shx(ss, 2, lane); ss += shx(ss, 4, lane);
              const float rn = rsqrtf(ss + 1e-12f);
#pragma unroll
              for (int e = 0; e < 8; ++e) { kk8[e] *= rn; c8[e] = e8[e]; } }
#pragma unroll
            for (int d = 8; d < 64; d <<= 1) {
#pragma unroll
                for (int e = 0; e < 8; ++e) { const float t = shup(c8[e], d, lane); c8[e] += lane >= d ? t : 0.f; } }
            if (lane >= 56) { *(LAS f32x4*)(seg + F.wave * 64 + kq * 8) = (f32x4){c8[0], c8[1], c8[2], c8[3]}; *(LAS f32x4*)(seg + F.wave * 64 + kq * 8 + 4) = (f32x4){c8[4], c8[5], c8[6], c8[7]}; }
            if (pend) { SCAN_STAGE_G(); pend = false; }
            LDS_BARRIER(); CH_STAMP(2);
            if (c4 > 0) { st_tile(PrB, Pr, wq, wh, lane); st_tile(QrB, Qr, wq, wh, lane); }
            { float cum[8];
#pragma unroll
              for (int e = 0; e < 8; ++e) cum[e] = c8[e];
              for (int w2 = 0; w2 < F.wave; ++w2) { const f32x4 o0 = *(const LAS f32x4*)(seg + w2 * 64 + kq * 8), o1 = *(const LAS f32x4*)(seg + w2 * 64 + kq * 8 + 4);
#pragma unroll
                  for (int e = 0; e < 8; ++e) cum[e] += e < 4 ? o0[e & 3] : o1[e & 3]; }
              float o[8];
#pragma unroll
              for (int e = 0; e < 8; ++e) o[e] = -kk8[e] * __expf(cum[e] - e8[e]);
              *(LAS u32x4*)(At + pi * TP + kq * 8) = pack8(o);
#pragma unroll
              for (int e = 0; e < 8; ++e) o[e] = r8[e] * __expf(cum[e]);
              *(LAS u32x4*)(Rt + pi * TP + kq * 8) = pack8(o);
              float en[8];
#pragma unroll
              for (int e = 0; e < 8; ++e) { en[e] = __expf(-cum[e]); o[e] = kk8[e] * a8[e] * en[e]; }
              *(LAS u32x4*)(Bt + pi * TP + kq * 8) = pack8(o);
#pragma unroll
              for (int e = 0; e < 8; ++e) o[e] = m8[e] * en[e];
              *(LAS u32x4*)(Kt + pi * TP + kq * 8) = pack8(o);
              *(LAS u32x4*)(Vm + pi * TP + kq * 8) = cur.v;
              if (pi == 63) {
#pragma unroll
                  for (int e = 0; e < 8; ++e) gl[kq * 8 + e] = __expf(cum[e]); } }
            { const int nitem = c4 < 3 ? item : item + (int)gridDim.x, nc4 = c4 < 3 ? c4 + 1 : 0; if (nitem < NITEM) scan_load(P, F, nitem, nc4, nxt); }
            LDS_BARRIER(); CH_STAMP(3);
            {   f32x4 aN[2], aM[2], aNr[2], aMr[2];
#pragma unroll
                for (int q = 0; q < 2; ++q) { aN[q] = (f32x4){0.f, 0.f, 0.f, 0.f}; aM[q] = aN[q]; aNr[q] = aN[q]; aMr[q] = aN[q]; }
                mm64<false, true>(At, Bt, aN, wq, wh, lane); mm64<false, true>(At, Kt, aM, wq, wh, lane); mm64<false, true>(Rt, Bt, aNr, wq, wh, lane); mm64<false, true>(Rt, Kt, aMr, wq, wh, lane);
                f32x4 aT[2];
#pragma unroll
                for (int q = 0; q < 2; ++q)
#pragma unroll
                    for (int r = 0; r < 4; ++r) { const int i = 16 * (2 * wh + q) + 4 * l4 + r; const bool lt = i < jrow, le = i <= jrow;
                        aN[q][r] = lt ? aN[q][r] : 0.f; aM[q][r] = lt ? aM[q][r] : 0.f; aNr[q][r] = le ? aNr[q][r] : 0.f; aMr[q][r] = le ? aMr[q][r] : 0.f; aT[q][r] = aN[q][r] + (i == jrow ? 1.f : 0.f); }
                st_tile(NT, aN, wq, wh, lane); st_tile(MT, aM, wq, wh, lane); st_tile(NrT, aNr, wq, wh, lane); st_tile(MrT, aMr, wq, wh, lane); st_tile(TaA, aT, wq, wh, lane);
            }
            LDS_BARRIER(); CH_STAMP(4);
            if (F.wave < 4) { const int o = 16 * F.wave, oc = 16 * ((F.wave + 1) & 3);
                f32x4 p = prod16(NT, o, o, NT, o, o, (f32x4){0.f, 0.f, 0.f, 0.f}, lane); st16(ApA, o, o, p, lane);
                f32x4 t = prod16(TaA, o, o, ApA, o, o, ld16(TaA, o, o, lane), lane); p = prod16(ApA, o, o, ApA, o, o, (f32x4){0.f, 0.f, 0.f, 0.f}, lane);
                st16(TaB, o, o, t, lane); st16(ApA, o, oc, p, lane);
                t = prod16(TaB, o, o, ApA, o, oc, ld16(TaB, o, o, lane), lane); p = prod16(ApA, o, oc, ApA, o, oc, (f32x4){0.f, 0.f, 0.f, 0.f}, lane);
                st16(TaA, o, o, t, lane); st16(ApA, o, o, p, lane);
                t = prod16(TaA, o, o, ApA, o, o, ld16(TaA, o, o, lane), lane); st16(TaB, o, o, t, lane);
#pragma unroll
                for (int jj = 1; jj < 4; ++jj) if (jj > F.wave) { u32x2 zz; asm volatile("v_mov_b32 %0, 0\n\tv_mov_b32 %1, 0" : "=v"(zz.x), "=v"(zz.y)); *(LAS u32x2*)(TaB + (o + l15) * TP + 16 * jj + 4 * l4) = zz; }
            } else { const int wq2 = F.wave - 4;
#pragma unroll
                for (int wh2 = 0; wh2 < 2; ++wh2) { f32x4 x[2] = {(f32x4){0.f, 0.f, 0.f, 0.f}, (f32x4){0.f, 0.f, 0.f, 0.f}}; mm64<true, true>(Vm, MT, x, wq2, wh2, lane); st_tile(ApB, x, wq2, wh2, lane); } }
            LDS_BARRIER(); CH_STAMP(5);
            if (F.wave < 3) { const int jj = F.wave;
#pragma unroll
                for (int i = 1; i < 4; ++i) if (i > jj) { f32x4 e = (f32x4){0.f, 0.f, 0.f, 0.f};
#pragma unroll
                    for (int m = 0; m < 3; ++m) if (m >= jj && m < i) e = prod16(NT, 16 * i, 16 * m, TaB, 16 * m, 16 * jj, e, lane);
                    st16(ApA, 16 * i, 16 * jj, e, lane);
                    st16(TaB, 16 * i, 16 * jj, prod16(TaB, 16 * i, 16 * i, ApA, 16 * i, 16 * jj, (f32x4){0.f, 0.f, 0.f, 0.f}, lane), lane); } }
            LDS_BARRIER(); CH_STAMP(6);
            {   f32x4 w[2] = {(f32x4){0.f, 0.f, 0.f, 0.f}, (f32x4){0.f, 0.f, 0.f, 0.f}}; mm64<true, true>(At, TaB, w, wq, wh, lane); st_tile(ApA, w, wq, wh, lane);
                f32x4 u[2] = {(f32x4){0.f, 0.f, 0.f, 0.f}, (f32x4){0.f, 0.f, 0.f, 0.f}}; mm64<false, true>(ApB, TaB, u, wq, wh, lane); st_tile(TaA, u, wq, wh, lane); }
            LDS_BARRIER(); CH_STAMP(7);
            f32x4 aP[2], aQ[2], aG[2], aY[2];
#pragma unroll
            for (int q = 0; q < 2; ++q) { aP[q] = (f32x4){0.f, 0.f, 0.f, 0.f}; aQ[q] = aP[q]; aG[q] = aP[q]; aY[q] = aP[q]; }
            mm64<false, false>(ApA, Bt, aP, wq, wh, lane);
            mm64<false, false>(TaA, Bt, aQ, wq, wh, lane); mm64<true, false>(Vm, Kt, aQ, wq, wh, lane);
            mm64<false, true>(NrT, ApA, aG, wq, wh, lane);
            mm64<false, true>(NrT, TaA, aY, wq, wh, lane); mm64<false, false>(MrT, Vm, aY, wq, wh, lane);
#pragma unroll
            for (int q = 0; q < 2; ++q) { const int i0 = 16 * (2 * wh + q) + 4 * l4; const f32x4 g4 = *(const LAS f32x4*)(gl + i0);
                const u32x2 rr = *(const LAS u32x2*)(Rt + jrow * TP + i0);
#pragma unroll
                for (int r = 0; r < 4; ++r) { aP[q][r] = (aP[q][r] + (i0 + r == jrow ? 1.f : 0.f)) * g4[r]; aQ[q][r] *= g4[r]; }
                aG[q][0] += bf_lo(rr.x); aG[q][1] += bf_hi(rr.x); aG[q][2] += bf_lo(rr.y); aG[q][3] += bf_hi(rr.y); }
            const size_t orow = (size_t)scan_row(z, b, sc * 256 + c4 * 64 + jrow) * D + hh * 64;
            if (c4 == 0) {
#pragma unroll
                for (int q = 0; q < 2; ++q) { const int i0 = 16 * (2 * wh + q) + 4 * l4;
                    u32x2 o; o.x = cvt_pk_bf16(aG[q][0], aG[q][1]); o.y = cvt_pk_bf16(aG[q][2], aG[q][3]); *(u32x2*)(GE + orow + i0) = o;
                    u32x2 y; y.x = cvt_pk_bf16(aY[q][0], aY[q][1]); y.y = cvt_pk_bf16(aY[q][2], aY[q][3]); *(u32x2*)(YE + orow + i0) = y;
                    Pr[q] = aP[q]; Qr[q] = aQ[q]; }
            } else {
                st_tile(NT, aG, wq, wh, lane); st_tile(MT, aP, wq, wh, lane);
#pragma unroll
                for (int q = 0; q < 2; ++q) { aYp[q] = aY[q]; aQp[q] = aQ[q]; }
                pend = true; orowp = orow; GEp = GE; YEp = YE; pqp = pq; lastp = c4 == 3;
            }
            cur = nxt;
            if (CH_AMP >= 0) { const unsigned long long d_ = CH_AMP == 0 ? ch_t[0] - ch_t[11] : ch_t[CH_AMP] - ch_t[CH_AMP - 1]; const unsigned long long dl_ = __builtin_amdgcn_s_memrealtime() + 4 * d_; while (__builtin_amdgcn_s_memrealtime() < dl_) __builtin_amdgcn_s_sleep(4); }
            LDS_BARRIER(); CH_STAMP(8);
        }
        item += gridDim.x; if (item >= NITEM) break;
    }
    if (pend) { SCAN_STAGE_G(); }
#undef SCAN_STAGE_G
}
__device__ __forceinline__ void scan_carry_phase(const Frame& F, KP P) {
    if (blockIdx.x >= 4 * NSCAN) return;
    const int s = blockIdx.x >> 2, vs = blockIdx.x & 3, lane = F.lane, l15 = lane & 15, l4 = lane >> 4, v = 16 * vs + l15, T2 = F.wave;
    const float* pq = (const float*)(P->ws + WS_PQ) + (size_t)s * NSC * 2 * 4096; bf16_t* sst = (bf16_t*)(P->ws + WS_SST) + (size_t)s * NSC * 4096;
    LAS f32x4* exch = (LAS f32x4*)F.lds;
    f32x4 S[4]; float ap[4][16], qp[4][4];
#pragma unroll
    for (int t = 0; t < 4; ++t) S[t] = (f32x4){0.f, 0.f, 0.f, 0.f};
#define CARRY_LOAD(slot, step) do { const float* Pm_ = pq + (size_t)(step) * 2 * 4096; \
        _Pragma("unroll") for (int t2i = 0; t2i < 4; ++t2i) _Pragma("unroll") for (int ri = 0; ri < 4; ++ri) ap[slot][t2i * 4 + ri] = Pm_[(16 * l4 + 4 * ri + t2i) * 64 + 4 * l15 + T2]; \
        _Pragma("unroll") for (int r = 0; r < 4; ++r) qp[slot][r] = Pm_[4096 + v * 64 + 16 * l4 + 4 * r + T2]; } while (0)
#define CARRY_STORE(sc_) do { if (T2 == 0) { float o[16]; \
        _Pragma("unroll") for (int r = 0; r < 4; ++r) _Pragma("unroll") for (int t2 = 0; t2 < 4; ++t2) o[4 * r + t2] = S[t2][r]; \
        u32x4 w0, w1; w0.x = cvt_pk_bf16(o[0], o[1]); w0.y = cvt_pk_bf16(o[2], o[3]); w0.z = cvt_pk_bf16(o[4], o[5]); w0.w = cvt_pk_bf16(o[6], o[7]); \
        w1.x = cvt_pk_bf16(o[8], o[9]); w1.y = cvt_pk_bf16(o[10], o[11]); w1.z = cvt_pk_bf16(o[12], o[13]); w1.w = cvt_pk_bf16(o[14], o[15]); \
        *(u32x4*)(sst + (size_t)(sc_) * 4096 + v * 64 + 16 * l4) = w0; *(u32x4*)(sst + (size_t)(sc_) * 4096 + v * 64 + 16 * l4 + 8) = w1; } } while (0)
    if (T2 < 4) {
#pragma unroll
        for (int u = 0; u < 4; ++u) CARRY_LOAD(u, u);
    }
#pragma nounroll
    for (int sc0 = 0; sc0 < NSC - 1; sc0 += 4) {
#pragma unroll
        for (int u = 0; u < 4; ++u) { const int sc = sc0 + u;
            CARRY_STORE(sc);
            if (T2 < 4) {
                f32x4 nw = (f32x4){qp[u][0], qp[u][1], qp[u][2], qp[u][3]};
#pragma unroll
                for (int t2i = 0; t2i < 4; ++t2i)
#pragma unroll
                    for (int ri = 0; ri < 4; ++ri) nw = __builtin_amdgcn_mfma_f32_16x16x4f32(ap[u][t2i * 4 + ri], S[t2i][ri], nw, 0, 0, 0);
                if (sc + 4 < NSC - 1) CARRY_LOAD(u, sc + 4);
                exch[((u & 1) * 4 + T2) * 64 + lane] = nw;
            }
            LDS_BARRIER();
            if (T2 < 4) {
#pragma unroll
                for (int t = 0; t < 4; ++t) S[t] = exch[((u & 1) * 4 + t) * 64 + lane];
            }
        }
    }
    CARRY_STORE(NSC - 1);
#undef CARRY_LOAD
#undef CARRY_STORE
}
__device__ __forceinline__ void scan_out_phase(const Frame& F, KP P, int j) {
    const int lane = F.lane, l15 = lane & 15, l4 = lane >> 4;
    const bf16_t* GE0 = (const bf16_t*)(P->ws + WS_AS0); const bf16_t* GE1 = (const bf16_t*)(P->ws + WS_AS1); const bf16_t* YE0 = (const bf16_t*)(P->ws + WS_ELOG0); const bf16_t* YE1 = (const bf16_t*)(P->ws + WS_ELOG1);
    const bf16_t* Vb = (const bf16_t*)(P->ws + WS_VV); const float* BON = (const float*)(P->ws + WS_BON);
    const bf16_t* GT = (const bf16_t*)(P->ws + WS_GATE); bf16_t* YG = (bf16_t*)(P->ws + WS_YG);
    for (int item = F.gw; item < NBATCH * NH * NSC * 8; item += F.NGW) {
        const int hh = item & 15, oct = (item >> 4) & 7, b = (item >> 7) & 1, blk = item >> 8;
        const int sc0 = blk, sc1 = blk == 0 ? 0 : NSC - blk;
        const bf16_t* s0 = (const bf16_t*)(P->ws + WS_SST) + ((size_t)(b * 16 + hh) * NSC + sc0) * 4096; const bf16_t* s1 = (const bf16_t*)(P->ws + WS_SST) + ((size_t)(32 + b * 16 + hh) * NSC + sc1) * 4096;
        bf16x8 sa0[4][2], sa1[4][2];
#pragma unroll
        for (int vt = 0; vt < 4; ++vt) { const int v = 32 * (vt >> 1) + 8 * (l15 >> 2) + 4 * (vt & 1) + (l15 & 3);
#pragma unroll
            for (int ks = 0; ks < 2; ++ks) { sa0[vt][ks] = *(const bf16x8*)(s0 + v * 64 + 32 * ks + 8 * l4); sa1[vt][ks] = *(const bf16x8*)(s1 + v * 64 + 32 * ks + 8 * l4); } }
        f32x4 lg4[4], lb4[4];
#pragma unroll
        for (int q = 0; q < 4; ++q) { const int c = hh * 64 + 32 * (q >> 1) + 8 * l4 + 4 * (q & 1); lg4[q] = *(const f32x4*)(P->in[I_LNG] + (size_t)j * D + c); lb4[q] = *(const f32x4*)(P->in[I_LNB] + (size_t)j * D + c); }
#pragma nounroll
        for (int ti = 0; ti < 2; ++ti) {
            const int tok = (2 * oct + ti) * 16 + l15; const int row = blk == 0 ? TL + b * CTXL + tok : b * SEQ + (blk - 1) * 256 + tok;
            const size_t o = (size_t)row * D + hh * 64;
            const bf16x8 g00 = *(const bf16x8*)(GE0 + o + 8 * l4), g01 = *(const bf16x8*)(GE0 + o + 32 + 8 * l4), g10 = *(const bf16x8*)(GE1 + o + 8 * l4), g11 = *(const bf16x8*)(GE1 + o + 32 + 8 * l4);
            u32x4 la[2], lc[2], lv[2], lgt[2];
#pragma unroll
            for (int h2 = 0; h2 < 2; ++h2) { const size_t oc = o + 32 * h2 + 8 * l4;
                la[h2] = *(const u32x4*)(YE0 + oc); lc[h2] = *(const u32x4*)(YE1 + oc); lv[h2] = *(const u32x4*)(Vb + oc); lgt[h2] = *(const u32x4*)(GT + oc); }
            const float bn = BON[(size_t)row * 16 + hh] + BON[((size_t)T + row) * 16 + hh];
            __builtin_amdgcn_sched_barrier(0);
            f32x4 y[4]; float s = 0.f; f32x4 vv[4], gg[4];
#pragma unroll
            for (int vt = 0; vt < 4; ++vt) { const int h2 = vt >> 1, hf = vt & 1;
                const unsigned ax = hf ? la[h2].z : la[h2].x, ay = hf ? la[h2].w : la[h2].y, cx = hf ? lc[h2].z : lc[h2].x, cy = hf ? lc[h2].w : lc[h2].y;
                const unsigned vx = hf ? lv[h2].z : lv[h2].x, vy = hf ? lv[h2].w : lv[h2].y, gx = hf ? lgt[h2].z : lgt[h2].x, gy = hf ? lgt[h2].w : lgt[h2].y;
                f32x4 acc = (f32x4){bf_lo(ax) + bf_lo(cx), bf_hi(ax) + bf_hi(cx), bf_lo(ay) + bf_lo(cy), bf_hi(ay) + bf_hi(cy)};
                acc = __builtin_amdgcn_mfma_f32_16x16x32_bf16(sa0[vt][0], g00, acc, 0, 0, 0); acc = __builtin_amdgcn_mfma_f32_16x16x32_bf16(sa0[vt][1], g01, acc, 0, 0, 0);
                acc = __builtin_amdgcn_mfma_f32_16x16x32_bf16(sa1[vt][0], g10, acc, 0, 0, 0); acc = __builtin_amdgcn_mfma_f32_16x16x32_bf16(sa1[vt][1], g11, acc, 0, 0, 0);
                y[vt] = acc; s += (acc[0] + acc[1]) + (acc[2] + acc[3]);
                vv[vt] = (f32x4){bf_lo(vx), bf_hi(vx), bf_lo(vy), bf_hi(vy)}; gg[vt] = (f32x4){bf_lo(gx), bf_hi(gx), bf_lo(gy), bf_hi(gy)}; }
            s += shx(s, 16, lane); s += shx(s, 32, lane);
            const float mean = s * (1.0f / 64.0f); float q = 0.f;
#pragma unroll
            for (int vt = 0; vt < 4; ++vt) { const f32x4 d = y[vt] - mean; q += (d[0] * d[0] + d[1] * d[1]) + (d[2] * d[2] + d[3] * d[3]); }
            q += shx(q, 16, lane); q += shx(q, 32, lane);
            const float rstd = rsqrtf(q * (1.0f / 64.0f) + 64e-5f);
#pragma unroll
            for (int h2 = 0; h2 < 2; ++h2) { const f32x4 o0 = (((y[2 * h2] - mean) * rstd) * lg4[2 * h2] + lb4[2 * h2] + vv[2 * h2] * bn) * gg[2 * h2], o1 = (((y[2 * h2 + 1] - mean) * rstd) * lg4[2 * h2 + 1] + lb4[2 * h2 + 1] + vv[2 * h2 + 1] * bn) * gg[2 * h2 + 1];
                u32x4 w; w.x = cvt_pk_bf16(o0[0], o0[1]); w.y = cvt_pk_bf16(o0[2], o0[3]); w.z = cvt_pk_bf16(o1[0], o1[1]); w.w = cvt_pk_bf16(o1[2], o1[3]); *(u32x4*)(YG + o + 32 * h2 + 8 * l4) = w; }
        }
    }
}
__device__ __forceinline__ bool in_range(int lo, int hi, int k) { asm volatile("" : "+s"(lo), "+s"(hi)); return lo <= k && k < hi; }
constexpr int NPH = 46;
template <unsigned KMASK> __global__ void __launch_bounds__(NTHR, 2) mega(Params Pv) {
    extern __shared__ __attribute__((aligned(16))) unsigned char lds_raw[];
    Frame F0; F0.lds = (LAS unsigned char*)lds_raw; F0.tid = threadIdx.x; F0.lane = F0.tid & 63; F0.wave = __builtin_amdgcn_readfirstlane(F0.tid >> 6);
    F0.G = gridDim.x; F0.gw = blockIdx.x * NWAVES + F0.wave; F0.NGW = F0.G * NWAVES;
    LAS unsigned* misc = (LAS unsigned*)(F0.lds + LDS_MISC);
    if (F0.tid < 128) misc[F0.tid] = 0u;
    __syncthreads();
    KP P0 = (KP)__builtin_amdgcn_kernarg_segment_ptr();
    constexpr bool ALL = (KMASK == 0x3ffffu);
    const int lo = ALL ? 0 : P0->ph_lo, hi = ALL ? NPH : P0->ph_hi;
    XcdBarrier bar; bar.bar = (unsigned*)(P0->ws + WS_CTL) + CW_BAR; bar.x = 0; bar.st = (volatile LAS unsigned*)(misc + 8);
    if (ALL || hi - lo > 1) bar = xcd_barrier_post((unsigned*)(P0->ws + WS_CTL) + CW_BAR, (volatile LAS unsigned*)(misc + 8));
#define IN(k) (ALL || in_range(lo, hi, (k)))
#define KIND(q) ((KMASK >> (q)) & 1u)
#define BAR_LEADER (wave_sgpr_now(F0.wave) == 0 && lane_id_now() == 0)
#define SEAM(k) do { if (IN(k) && IN((k) + 1)) { XcdBarrier b2_ = bar; unsigned* bb_ = bar.bar; unsigned bx_ = bar.x; asm volatile("" : "+s"(bb_), "+s"(bx_)); b2_.bar = bb_; b2_.x = bx_; xcd_barrier<false>(b2_, BAR_LEADER); } } while (0)
#define AMP_T0 const unsigned long long amp_t0 = AMP_MASK ? __builtin_amdgcn_s_memrealtime() : 0ull;
#define AMP_END(kind) do { if (AMP_MASK & (1u << (kind))) { const unsigned long long t1_ = __builtin_amdgcn_s_memrealtime(), dl_ = t1_ + AMP_F * (t1_ - amp_t0); while (__builtin_amdgcn_s_memrealtime() < dl_) __builtin_amdgcn_s_sleep(8); } } while (0)
#define PHASE_ENTRY AMP_T0 KP P = P0; asm volatile("" : "+s"(P)); unsigned char* ws = P->ws; unsigned* ctl = (unsigned*)(ws + WS_CTL); (void)ctl; \
    Frame F = F0; { int l_ = lane_id_now(), w_ = F0.wave; asm volatile("" : "+s"(w_)); F.lane = l_; F.wave = w_; F.tid = w_ * 64 + l_; F.gw = blockIdx.x * NWAVES + w_; }

    if constexpr (KIND(0)) if (IN(0)) { PHASE_ENTRY prologue_phase(F, P); AMP_END(0); }
    if (IN(0) && IN(1)) { XcdBarrier b2_ = bar; unsigned* bb_ = bar.bar; unsigned bx_ = bar.x; asm volatile("" : "+s"(bb_), "+s"(bx_)); b2_.bar = bb_; b2_.x = bx_; xcd_barrier<true>(b2_, BAR_LEADER); }
    for (int lp = 0; lp < 2; ++lp) {
        const int pb = 1 + 22 * lp, la = 2 * lp, lb = 2 * lp + 1;
        if constexpr (KIND(1)) if (IN(pb + 0)) { PHASE_ENTRY norm1_phase(F, P, la); AMP_END(1); }
        SEAM(pb + 0);
        if constexpr (KIND(2)) if (IN(pb + 1)) { PHASE_ENTRY
            __syncthreads(); set_desc(F.lds, F.tid, 0, ws + WS_HL, ws + WS_WIN + (size_t)lp * 4096 * D * 2, ws + WS_U, 16, 0, 0, ws + WS_V, P->in[I_GBIN] + (size_t)lp * 4096, ws + WS_STAT); __syncthreads();
            SchedMulti<D, D> S{F.lds, TL / 256, 16, 1};
            EpiGelu E{F.lds};
            pg8::gemm_phase<EpiGelu, SchedMulti<D, D>, false, D, D, D>(F.lds, S, E, F.tid);
            __syncthreads(); { int w_ = F0.wave; asm volatile("" : "+s"(w_)); tail_gelu(F0.lds, w_); }
            AMP_END(2); }
        SEAM(pb + 1);
        if constexpr (KIND(3)) if (IN(pb + 2)) { PHASE_ENTRY spatial_phase(F, P, lp); AMP_END(3); }
        SEAM(pb + 2);
        if constexpr (KIND(4)) if (IN(pb + 3)) { PHASE_ENTRY
            __syncthreads();
            { bf16_t* X = (bf16_t*)(ws + WS_X);
              set_desc(F.lds, F.tid, 0, ws + WS_U, ws + WS_WOUT + (size_t)lp * D * GWID * 2, X, 4, 0, 0, X, X + (size_t)TL * D, P->in[I_GBOUT] + (size_t)lp * D);
              set_desc(F.lds, F.tid, 1, nullptr, nullptr, nullptr, 0, 0, 0, (const float*)(ws + WS_MOD) + (size_t)la * 3 * 6 * D + 2 * D); }
            __syncthreads();
            SchedMulti<GWID, GWID> S{F.lds, TL / 256, 4, 1};
            EpiResid E{F.lds};
            pg8::gemm_phase<EpiResid, SchedMulti<GWID, GWID>, false, GWID, GWID, GWID>(F.lds, S, E, F.tid);
            __syncthreads(); { int w_ = F0.wave; asm volatile("" : "+s"(w_)); tail_resid<GWID>(F0.lds, w_); }
            AMP_END(4); }
        SEAM(pb + 3);
        if constexpr (KIND(5)) if (IN(pb + 4)) { PHASE_ENTRY norm2_phase(F, P, la); AMP_END(5); }
        SEAM(pb + 4);
        if constexpr (KIND(16)) if (IN(pb + 5)) { PHASE_ENTRY
            __syncthreads(); set_desc(F.lds, F.tid, 0, ws + WS_HL, ws + WS_WRT + (size_t)la * 256 * D * 2, nullptr, 1, 0, 0); __syncthreads();
            SchedMulti<D, D> S{F.lds, (la == DEPTH - 1 ? TL : T) / 256, 1, 1};
            EpiLogits E{(float*)(ws + WS_LG)};
            pg8::gemm_phase<EpiLogits, SchedMulti<D, D>, false, D, D, D>(F.lds, S, E, F.tid);
            AMP_END(16); }
        SEAM(pb + 5);
        if constexpr (KIND(17)) if (IN(pb + 6)) { PHASE_ENTRY route_phase(F, P, la); AMP_END(17); }
        SEAM(pb + 6);
        if constexpr (KIND(6)) if (IN(pb + 7)) { PHASE_ENTRY
            moe_tables(F.lds, F.tid, ctl + CW_CNT + la * 64);
            SchedMoE<D, D, true> S{F.lds, (const char*)(ws + WS_HL), (const char*)(ws + WS_WGU), (const int*)(ws + WS_LIST)};
            EpiSiluGate E{(bf16_t*)(ws + WS_H)};
            pg8::gemm_phase<EpiSiluGate, SchedMoE<D, D, true>, true, D, D, D>(F.lds, S, E, F.tid);
            AMP_END(6); }
        SEAM(pb + 7);
        if constexpr (KIND(7)) if (IN(pb + 8)) { PHASE_ENTRY
            moe_tables(F.lds, F.tid, ctl + CW_CNT + la * 64);
            SchedMoE<EHID, EHID, false> S{F.lds, (const char*)(ws + WS_H), (const char*)(ws + WS_WD), (const int*)(ws + WS_LIST)};
            EpiScatter E{F.lds, (bf16_t*)(ws + WS_YB), (const int*)(ws + WS_LIST)};
            pg8::gemm_phase<EpiScatter, SchedMoE<EHID, EHID, false>, false, EHID, EHID, EHID>(F.lds, S, E, F.tid);
            AMP_END(7); }
        SEAM(pb + 8);
        if constexpr (KIND(1)) if (IN(pb + 9)) { PHASE_ENTRY norm1_phase(F, P, lb); AMP_END(1); }
        SEAM(pb + 9);
        if constexpr (KIND(8)) if (IN(pb + 10)) { PHASE_ENTRY mix_phase(F, P, lp); AMP_END(8); }
        SEAM(pb + 10);
        if constexpr (KIND(9)) if (IN(pb + 11)) { PHASE_ENTRY
            __syncthreads();
            set_desc(F.lds, F.tid, 0, ws + WS_XR, ws + WS_WR + (size_t)lp * D * D * 2, ws + WS_R, 4, D, 0);
            set_desc(F.lds, F.tid, 1, ws + WS_XK, ws + WS_WK + (size_t)lp * D * D * 2, ws + WS_K, 4, D, 0);
            set_desc(F.lds, F.tid, 2, ws + WS_XV, ws + WS_WV + (size_t)lp * D * D * 2, ws + WS_VV, 4, D, 0);
            set_desc(F.lds, F.tid, 3, ws + WS_XW, ws + WS_LW1 + (size_t)lp * 256 * D * 2, ws + WS_TW, 1, 256, 1);
            set_desc(F.lds, F.tid, 4, ws + WS_XA, ws + WS_LA1 + (size_t)lp * 256 * D * 2, ws + WS_TA, 1, 256, 0);
            set_desc(F.lds, F.tid, 5, ws + WS_XG, ws + WS_LG1 + (size_t)lp * 256 * D * 2, ws + WS_TG, 1, 256, 2);
            __syncthreads();
            SchedMulti<D, D> S{F.lds, T / 256, 15, 6};
            EpiAct E{F.lds};
            pg8::gemm_phase<EpiAct, SchedMulti<D, D>, false, D, D, D>(F.lds, S, E, F.tid);
            AMP_END(9); }
        SEAM(pb + 11);
        if constexpr (KIND(10)) if (IN(pb + 12)) { PHASE_ENTRY
            __syncthreads(); set_desc(F.lds, F.tid, 0, ws + WS_TG, ws + WS_G2P + (size_t)lp * D * 256 * 2, ws + WS_GATE, 4, D, 0); __syncthreads();
            SchedMulti<256, 256> S{F.lds, T / 256, 4, 1};
            EpiAct E{F.lds};
            pg8::gemm_phase<EpiAct, SchedMulti<256, 256>, false, 256, 256, 256>(F.lds, S, E, F.tid);
            AMP_END(10); }
        SEAM(pb + 12);
        if constexpr (KIND(11)) if (IN(pb + 13)) { PHASE_ENTRY scan_chunk_phase(F, P, lp); AMP_END(11); }
        SEAM(pb + 13);
        if constexpr (KIND(14)) if (IN(pb + 14)) { PHASE_ENTRY scan_carry_phase(F, P); AMP_END(14); }
        SEAM(pb + 14);
        if constexpr (KIND(15)) if (IN(pb + 15)) { PHASE_ENTRY scan_out_phase(F, P, lp); AMP_END(15); }
        SEAM(pb + 15);
        if constexpr (KIND(4)) if (IN(pb + 16)) { PHASE_ENTRY
            __syncthreads();
            { bf16_t* X = (bf16_t*)(ws + WS_X);
              set_desc(F.lds, F.tid, 0, ws + WS_YG, ws + WS_WO + (size_t)lp * D * D * 2, X, 4, 0, 0, X, X + (size_t)TL * D, nullptr);
              set_desc(F.lds, F.tid, 1, nullptr, nullptr, nullptr, 0, 0, 0, (const float*)(ws + WS_MOD) + (size_t)lb * 3 * 6 * D + 2 * D); }
            __syncthreads();
            SchedMulti<D, D> S{F.lds, TL / 256, 4, 1};
            EpiResid E{F.lds};
            pg8::gemm_phase<EpiResid, SchedMulti<D, D>, false, D, D, D>(F.lds, S, E, F.tid);
            __syncthreads(); { int w_ = F0.wave; asm volatile("" : "+s"(w_)); tail_resid<D>(F0.lds, w_); }
            AMP_END(4); }
        SEAM(pb + 16);
        if constexpr (KIND(5)) if (IN(pb + 17)) { PHASE_ENTRY norm2_phase(F, P, lb); AMP_END(5); }
        SEAM(pb + 17);
        if constexpr (KIND(16)) if (IN(pb + 18)) { PHASE_ENTRY
            __syncthreads(); set_desc(F.lds, F.tid, 0, ws + WS_HL, ws + WS_WRT + (size_t)lb * 256 * D * 2, nullptr, 1, 0, 0); __syncthreads();
            SchedMulti<D, D> S{F.lds, (lb == DEPTH - 1 ? TL : T) / 256, 1, 1};
            EpiLogits E{(float*)(ws + WS_LG)};
            pg8::gemm_phase<EpiLogits, SchedMulti<D, D>, false, D, D, D>(F.lds, S, E, F.tid);
            AMP_END(16); }
        SEAM(pb + 18);
        if constexpr (KIND(17)) if (IN(pb + 19)) { PHASE_ENTRY route_phase(F, P, lb); AMP_END(17); }
        SEAM(pb + 19);
        if constexpr (KIND(6)) if (IN(pb + 20)) { PHASE_ENTRY
            moe_tables(F.lds, F.tid, ctl + CW_CNT + lb * 64);
            SchedMoE<D, D, true> S{F.lds, (const char*)(ws + WS_HL), (const char*)(ws + WS_WGU), (const int*)(ws + WS_LIST)};
            EpiSiluGate E{(bf16_t*)(ws + WS_H)};
            pg8::gemm_phase<EpiSiluGate, SchedMoE<D, D, true>, true, D, D, D>(F.lds, S, E, F.tid);
            AMP_END(6); }
        SEAM(pb + 20);
        if constexpr (KIND(7)) if (IN(pb + 21)) { PHASE_ENTRY
            moe_tables(F.lds, F.tid, ctl + CW_CNT + lb * 64);
            SchedMoE<EHID, EHID, false> S{F.lds, (const char*)(ws + WS_H), (const char*)(ws + WS_WD), (const int*)(ws + WS_LIST)};
            EpiScatter E{F.lds, (bf16_t*)(ws + WS_YB), (const int*)(ws + WS_LIST)};
            pg8::gemm_phase<EpiScatter, SchedMoE<EHID, EHID, false>, false, EHID, EHID, EHID>(F.lds, S, E, F.tid);
            AMP_END(7); }
        SEAM(pb + 21);
    }
    if constexpr (KIND(13)) if (IN(45)) { PHASE_ENTRY final_phase(F, P); AMP_END(13); }
#undef IN
#undef KIND
#undef SEAM
#undef PHASE_ENTRY
}

#if !MK_ONE_LAUNCH
static int phase_kind(int ph) { if (ph == 0) return 0; if (ph == 45) return 13; static const int k22[22] = {1, 2, 3, 4, 5, 16, 17, 6, 7, 1, 8, 9, 10, 11, 14, 15, 4, 5, 16, 17, 6, 7}; return k22[(ph - 1) % 22]; }
typedef void (*kern_t)(Params);
template <unsigned KM> static kern_t kern_of() { return mega<KM>; }
static kern_t kind_kernel(int kind) {
    switch (kind) { case 0: return kern_of<1u << 0>(); case 1: return kern_of<1u << 1>(); case 2: return kern_of<1u << 2>(); case 3: return kern_of<1u << 3>(); case 4: return kern_of<1u << 4>();
        case 5: return kern_of<1u << 5>(); case 6: return kern_of<1u << 6>(); case 7: return kern_of<1u << 7>(); case 8: return kern_of<1u << 8>(); case 9: return kern_of<1u << 9>();
        case 10: return kern_of<1u << 10>(); case 11: return kern_of<1u << 11>(); case 12: return kern_of<1u << 12>(); case 14: return kern_of<1u << 14>(); case 15: return kern_of<1u << 15>(); case 16: return kern_of<1u << 16>(); case 17: return kern_of<1u << 17>(); default: return kern_of<1u << 13>(); }
}
#endif
extern "C" void kernel_launch(void* const* d_in, const int* in_sizes, int n_in, void* d_out, int out_size, void* d_ws, size_t ws_size, hipStream_t stream) {
    static int grid = 0;
    if (grid == 0) {
        if (n_in != 42 || out_size != TL * D || ws_size < WS_END) { fprintf(stderr, "kernel_launch: unexpected problem (n_in %d, out %d, ws %zu < %zu)\n", n_in, out_size, ws_size, (size_t)WS_END); grid = -1; return; }
        int dev = 0, cus = 0;
        if (hipGetDevice(&dev) != hipSuccess || hipDeviceGetAttribute(&cus, hipDeviceAttributeMultiprocessorCount, dev) != hipSuccess) { grid = -1; return; }
#if MK_ONE_LAUNCH
        if (hipFuncSetAttribute((const void*)mega<0x3ffffu>, hipFuncAttributeMaxDynamicSharedMemorySize, LDS_BYTES) != hipSuccess) { fprintf(stderr, "kernel_launch: hipFuncSetAttribute failed\n"); grid = -1; return; }
#else
        for (int k = 0; k < 18; ++k) if (hipFuncSetAttribute((const void*)kind_kernel(k), hipFuncAttributeMaxDynamicSharedMemorySize, LDS_BYTES) != hipSuccess) { fprintf(stderr, "kernel_launch: hipFuncSetAttribute failed\n"); grid = -1; return; }
#endif
        (void)hipGetLastError();
        grid = cus;
    }
    if (grid < 0) return;
    (void)hipMemsetAsync((char*)d_ws + WS_CTL, 0, CTL_BYTES, stream);
    Params p{};
    for (int i = 0; i < 42; ++i) p.in[i] = (const float*)d_in[i];
    p.out = (float*)d_out; p.ws = (unsigned char*)d_ws;
#if MK_ONE_LAUNCH
    p.ph_lo = 0; p.ph_hi = NPH;
    hipLaunchKernelGGL(mega<0x3ffffu>, dim3(grid), dim3(NTHR), LDS_BYTES, stream, p);
#else
    for (int ph = 0; ph < NPH; ++ph) { p.ph_lo = ph; p.ph_hi = ph + 1; hipLaunchKernelGGL(kind_kernel(phase_kind(ph)), dim3(grid), dim3(NTHR), LDS_BYTES, stream, p); }
#endif
}
```

```cpp
#include <hip/hip_runtime.h>
#include <cstdio>
#include <cstdint>

#define LAS __attribute__((address_space(3)))
typedef unsigned short bf16_t;
typedef short bf16x8 __attribute__((ext_vector_type(8)));
typedef float f32x4 __attribute__((ext_vector_type(4)));
typedef float f32x2 __attribute__((ext_vector_type(2)));
typedef unsigned u32x4 __attribute__((ext_vector_type(4)));
typedef unsigned u32x2 __attribute__((ext_vector_type(2)));

#ifndef CH_AMP
#define CH_AMP -1
#endif
#define CH_STAMP(i) do { if (CH_AMP >= 0) ch_t[i] = __builtin_amdgcn_s_memrealtime(); } while (0)
#ifndef AMP_MASK
#define AMP_MASK 0u
#endif
#define AMP_F 4
#ifndef MK_ONE_LAUNCH
#define MK_ONE_LAUNCH 1
#endif

constexpr int D = 1024, NBATCH = 2, SEQ = 16384, CTXL = 256, DEPTH = 4;
constexpr int TL = NBATCH * SEQ, TC = NBATCH * CTXL, T = TL + TC;
constexpr int GWID = 2048, NE = 32, EHID = 512, NH = 16, HD = 64;
constexpr int LISTCAP = T;
constexpr int MAXRT = (2 * T) / 256 + NE;
constexpr int NWAVES = 8, NTHR = 512;

constexpr size_t MiB = 1u << 20;
constexpr size_t WS_CTL = 0, CTL_BYTES = 1 * MiB;
constexpr size_t WS_MOD = 1 * MiB;
constexpr size_t WS_WIN = 2 * MiB, WS_WOUT = 18 * MiB, WS_WSP = 26 * MiB, WS_WR = 27 * MiB, WS_WK = 31 * MiB, WS_WV = 35 * MiB, WS_WO = 39 * MiB;
constexpr size_t WS_LW1 = 43 * MiB, WS_LA1 = 44 * MiB, WS_LG1 = 45 * MiB, WS_W2P = 46 * MiB, WS_A2P = 48 * MiB, WS_G2P = 50 * MiB;
constexpr size_t WS_WRT = 52 * MiB;
constexpr size_t WS_WGU = 54 * MiB, WS_WD = 118 * MiB;
constexpr size_t WS_X = 150 * MiB;
constexpr size_t WS_LIST = 280 * MiB, WS_WGT = 285 * MiB;
constexpr size_t WS_HL = 286 * MiB;
constexpr size_t WS_BIG = 351 * MiB;
constexpr size_t SZB = 65 * MiB;
constexpr size_t WS_U = WS_BIG, WS_V = WS_BIG + 2 * SZB, WS_STAT = WS_BIG + 4 * SZB;
constexpr size_t WS_XR = WS_BIG, WS_XW = WS_BIG + SZB, WS_XK = WS_BIG + 2 * SZB, WS_XV = WS_BIG + 3 * SZB, WS_XA = WS_BIG + 4 * SZB, WS_XG = WS_BIG + 5 * SZB;
constexpr size_t WS_R = WS_BIG + 6 * SZB, WS_K = WS_BIG + 7 * SZB, WS_VV = WS_BIG + 8 * SZB;
constexpr size_t WS_TW = WS_BIG + 9 * SZB, WS_TA = WS_TW + 17 * MiB, WS_TG = WS_TA + 17 * MiB;
constexpr size_t WS_ELOG0 = WS_XR, WS_ELOG1 = WS_XW, WS_KM0 = WS_XK, WS_KM1 = WS_XV, WS_AS0 = WS_XA, WS_AS1 = WS_XG;
constexpr size_t WS_GATE = WS_HL, WS_YG = WS_AS0, WS_BON = WS_TG + 17 * MiB;
constexpr size_t WS_H = WS_BIG, WS_YB = WS_BIG + 73 * MiB, WS_LG = WS_BIG + 204 * MiB;
constexpr size_t WS_PQ = WS_KM0;
constexpr size_t WS_SST = 215 * MiB;
constexpr size_t WS_END = WS_BON + 5 * MiB;
static_assert(WS_END <= 1080 * MiB, "workspace map");
constexpr int CW_BAR = 4096;
constexpr int CW_CNT = 16384;

__device__ __forceinline__ int wave_sgpr_now(int w) { asm volatile("" : "+s"(w)); return w; }
__device__ __forceinline__ int lane_id_now() { int l; asm volatile("v_mbcnt_lo_u32_b32 %0, -1, 0\n\tv_mbcnt_hi_u32_b32 %0, -1, %0" : "=v"(l)); return l; }
typedef short v4s __attribute__((ext_vector_type(4)));
#define LDS_BARRIER() asm volatile("s_waitcnt lgkmcnt(0)\n\ts_barrier" ::: "memory")
typedef __bf16 bf16x2_t __attribute__((ext_vector_type(2)));
__device__ __forceinline__ unsigned cvt_pk_bf16(float lo, float hi) { const bf16x2_t v = __builtin_convertvector((f32x2){lo, hi}, bf16x2_t); return __builtin_bit_cast(unsigned, v); }
__device__ __forceinline__ float bf_lo(unsigned u) { return __uint_as_float(u << 16); }
__device__ __forceinline__ float bf_hi(unsigned u) { return __uint_as_float(u & 0xffff0000u); }
__device__ __forceinline__ float bf1(bf16_t b) { return __uint_as_float(((unsigned)b) << 16); }
__device__ __forceinline__ bf16_t f2bf(float f) { return (bf16_t)(cvt_pk_bf16(f, 0.f) & 0x3ffffu); }
__device__ __forceinline__ void unpack8(const u32x4& w, float (&f)[8]) { f[0] = bf_lo(w.x); f[1] = bf_hi(w.x); f[2] = bf_lo(w.y); f[3] = bf_hi(w.y); f[4] = bf_lo(w.z); f[5] = bf_hi(w.z); f[6] = bf_lo(w.w); f[7] = bf_hi(w.w); }
__device__ __forceinline__ u32x4 pack8(const float (&f)[8]) { u32x4 o; o.x = cvt_pk_bf16(f[0], f[1]); o.y = cvt_pk_bf16(f[2], f[3]); o.z = cvt_pk_bf16(f[4], f[5]); o.w = cvt_pk_bf16(f[6], f[7]); return o; }
__device__ __forceinline__ float shx(float v, int m, int lane) { return __int_as_float(__builtin_amdgcn_ds_bpermute((lane ^ m) << 2, __float_as_int(v))); }
__device__ __forceinline__ float shup(float v, int d, int lane) { return __int_as_float(__builtin_amdgcn_ds_bpermute((lane - d) << 2, __float_as_int(v))); }
__device__ __forceinline__ float wave_sum(float v, int lane) {
#pragma unroll
    for (int o = 1; o < 64; o <<= 1) v += shx(v, o, lane);
    return v;
}
__device__ __forceinline__ float sigmoidf_(float x) { return 1.0f / (1.0f + __expf(-x)); }
__device__ __forceinline__ float tanhf_(float x) { const float e = __expf(2.0f * x); return 1.0f - 2.0f / (e + 1.0f); }
__device__ __forceinline__ f32x2 gelu_pk(f32x2 v) {
    const f32x2 av = __builtin_elementwise_abs(v), d = av * 0.2316418882f + 1.0f;
    f32x2 t; t.x = __builtin_amdgcn_rcpf(d.x); t.y = __builtin_amdgcn_rcpf(d.y);
    f32x2 q = t * 0.5307027145f + (-0.7265760135f); q = q * t + 0.7107068705f; q = q * t + (-0.142248368f); q = q * t + 0.127414796f; q = q * t;
    const f32x2 s = (v * v) * (-0.72134752044f);
    f32x2 e; e.x = __builtin_amdgcn_exp2f(s.x); e.y = __builtin_amdgcn_exp2f(s.y);
    const f32x2 m = v * (q * e), r = v - m;
    f32x2 o; o.x = v.x < 0.f ? m.x : r.x; o.y = v.y < 0.f ? m.y : r.y; return o;
}

#define XB_TMO      128
#define XB_XCNT(j)  (256  + 64 * (j))
#define XB_XSUB(j)  (1280 + 64 * (j))
#define XB_XGEN(j)  (2304 + 64 * (j))
#define XB_TOP      3328
#define XB_TOPGEN   3392
#define XCD_BAR_WORDS 3456
#define XB_SPIN_CAP (1u << 18)
__device__ __forceinline__ unsigned xb_ld(unsigned* p)              { return __hip_atomic_load(p, __ATOMIC_RELAXED, __HIP_MEMORY_SCOPE_AGENT); }
__device__ __forceinline__ unsigned xb_add(unsigned* p, unsigned v) { return __hip_atomic_fetch_add(p, v, __ATOMIC_RELAXED, __HIP_MEMORY_SCOPE_AGENT); }
__device__ __forceinline__ unsigned xb_xcc_id() { return (unsigned)__builtin_amdgcn_s_getreg((3 << 11) | 20) & 0xFu; }
#define XB_SPIN(cond, bar) do { unsigned _sp = 0; while (cond) { __builtin_amdgcn_s_sleep(1); \
    if ((++_sp & 255u) == 0u) { if (xb_ld(&(bar)[XB_TMO])) break; if (_sp > XB_SPIN_CAP) { atomicAdd(&(bar)[XB_TMO], 1u); break; } } } } while (0)
struct XcdBarrier { unsigned* bar; unsigned x; volatile LAS unsigned* st; };
__device__ __forceinline__ XcdBarrier xcd_barrier_post(unsigned* bar, volatile LAS unsigned* st) {
    XcdBarrier b; b.bar = bar; b.x = xb_xcc_id(); b.st = st;
    if (threadIdx.x == 0) (void)xb_add(&bar[XB_XCNT(b.x)], 1u);
    return b;
}
__device__ __forceinline__ void xcd_barrier_complete(unsigned* bar, unsigned x, unsigned& nloc, unsigned& nx) {
    const unsigned G = gridDim.x * gridDim.y * gridDim.z;
    unsigned sum, cnt, mine, sp = 0u;
    for (;;) {
        sum = 0u; cnt = 0u; mine = 0u;
#pragma unroll
        for (unsigned j = 0; j < 16; ++j) { const unsigned c = xb_ld(&bar[XB_XCNT(j)]); sum += c; cnt += (c > 0u) ? 1u : 0u; mine = (j == x) ? c : mine; }
        if (sum == G) break;
        __builtin_amdgcn_s_sleep(1);
        if ((++sp & 255u) == 0u) { if (xb_ld(&bar[XB_TMO])) break; if (sp > XB_SPIN_CAP) { atomicAdd(&bar[XB_TMO], 1u); break; } }
    }
    nloc = mine > 0u ? mine : 1u; nx = cnt > 0u ? cnt : 1u;
}
template <bool FIRST> __device__ __forceinline__ void xcd_barrier(const XcdBarrier& b, const bool leader) {
    asm volatile("s_waitcnt vmcnt(0)" ::: "memory");
    __syncthreads();
    if (leader) {
        unsigned* bar = b.bar;
        __builtin_amdgcn_s_waitcnt(0);
        unsigned nloc = b.st[0], nx = b.st[1];
        if constexpr (FIRST) { if (nloc == 0u) { xcd_barrier_complete(bar, b.x, nloc, nx); b.st[0] = nloc; b.st[1] = nx; } }
        const unsigned old = xb_add(&bar[XB_XSUB(b.x)], 1u);
        const unsigned gen = old / nloc;
        if (old + 1u == (gen + 1u) * nloc) {
            __builtin_amdgcn_fence(__ATOMIC_RELEASE, "agent");
            asm volatile("s_waitcnt vmcnt(0)" ::: "memory");
            const unsigned og = xb_add(&bar[XB_TOP], 1u);
            const unsigned tg = og / nx;
            if (og + 1u == (tg + 1u) * nx) xb_add(&bar[XB_TOPGEN], 1u);
            else XB_SPIN(xb_ld(&bar[XB_TOPGEN]) == tg, bar);
            __builtin_amdgcn_fence(__ATOMIC_ACQUIRE, "agent");
            xb_add(&bar[XB_XGEN(b.x)], 1u);
            asm volatile("s_waitcnt vmcnt(0)" ::: "memory");
        } else {
            XB_SPIN(xb_ld(&bar[XB_XGEN(b.x)]) == gen, bar);
            __builtin_amdgcn_fence(__ATOMIC_ACQUIRE, "agent");
            asm volatile("s_waitcnt vmcnt(0)" ::: "memory");
        }
    }
    __syncthreads();
}

constexpr int LDS_MISC = 143360;
constexpr int LDS_DESC = LDS_MISC + 128;
constexpr int LDS_TAB = LDS_MISC + 512;
constexpr int LDS_BYTES = 147456;
namespace pg8 {
constexpr int BM = 256, BK = 64, HALF = 128, HTB = HALF * BK * 2, STAGE_BYTES = 8 * HTB, NXCD = 8, WGM = 8;
__host__ __device__ __forceinline__ int lds_byte(int r, int c) { const int st = (r >> 4) * 2 + (c >> 5), rr = r & 15, cc = c & 31, ob = rr * 64 + cc * 2; return st * 1024 + (ob ^ (((ob >> 9) & 1) << 5)); }
__host__ __device__ __forceinline__ void stage_rc(int b, int& R, int& C) { const int st = b / 1024, sb = b % 1024, swz = sb ^ (((sb >> 9) & 1) << 5); R = (st >> 1) * 16 + swz / 64; C = (st & 1) * 32 + (swz % 64) / 2; }
__host__ __device__ __forceinline__ int perm32(int rho) { const int n = rho >> 4, i = rho & 15; return 8 * (i >> 2) + 4 * n + (i & 3); }
__device__ __forceinline__ int xcd_remap(int L, int nwg) { const int q = nwg / NXCD, r = nwg % NXCD, xcd = L % NXCD, off = L / NXCD; return (xcd < r ? xcd * (q + 1) : r * (q + 1) + (xcd - r) * q) + off; }

struct Unit { int pm, pn, aux; };

template <class Epi, class Sched, bool GATHER, int K, int LDA, int LDB>
__device__ __forceinline__ void gemm_phase(LAS unsigned char* lds, const Sched& S, const Epi& E, const int tid_in) {
    int tid_ = tid_in; asm volatile("" : "+v"(tid_));
    const int tid = tid_, wid = __builtin_amdgcn_readfirstlane(tid >> 6), lane = tid & 63, wr = wid >> 2, wc = wid & 3, fr = lane & 15, fq = lane >> 4;
    constexpr int nt = K / BK;
    unsigned voffA[2], voffB[2];
#pragma unroll
    for (int i = 0; i < 2; ++i) { int R, C; stage_rc(tid * 16 + i * 8192, R, C); const int Rb = Epi::PERM ? ((R & ~31) + perm32(R & 31)) : R;
        voffA[i] = (unsigned)(R * LDA + C) * 2u; voffB[i] = (unsigned)(Rb * LDB + C) * 2u; }
    constexpr size_t kstep = (size_t)(BK * 2);
    constexpr size_t hstepA = GATHER ? (size_t)0 : (size_t)HALF * LDA * 2, hstepB = (size_t)HALF * LDB * 2;
    const unsigned ldsw = (unsigned)wid * 1024u;
    const int aoff = lds_byte(wr * 64 + fr, fq * 8), boff = lds_byte(wc * 32 + fr, fq * 8);
    unsigned gA[2][2], gN[2][2];
#define PG8_SA(b, h) (((b) * 2 + (h)) * HTB)
#define PG8_SB(b, h) ((4 + (b) * 2 + (h)) * HTB)
#define PG8_STAGEB(bufoff, gbase) do { _Pragma("unroll") for (int _i = 0; _i < 2; ++_i) \
        __builtin_amdgcn_global_load_lds((const unsigned*)((const char*)(gbase) + voffB[_i]), (LAS unsigned*)(lds + (bufoff) + ldsw + _i * 8192), 16, 0, 0); } while (0)
#define PG8_STAGEA(bufoff, gbase, h, GV) do { _Pragma("unroll") for (int _i = 0; _i < 2; ++_i) \
        __builtin_amdgcn_global_load_lds((const unsigned*)((const char*)(gbase) + (GATHER ? GV[h][_i] : voffA[_i]) + (h) * hstepA), (LAS unsigned*)(lds + (bufoff) + ldsw + _i * 8192), 16, 0, 0); } while (0)
#define PG8_LDA(dst, b, h) do { _Pragma("unroll") for (int m = 0; m < 4; ++m) _Pragma("unroll") for (int k = 0; k < 2; ++k) dst[m][k] = *(const LAS bf16x8*)(lds + PG8_SA(b, h) + aoff + m * 2048 + k * 1024); } while (0)
#define PG8_LDB(dst, b, h) do { _Pragma("unroll") for (int n = 0; n < 2; ++n) _Pragma("unroll") for (int k = 0; k < 2; ++k) dst[n][k] = *(const LAS bf16x8*)(lds + PG8_SB(b, h) + boff + n * 2048 + k * 1024); } while (0)
#define PG8_MMA(ai, bj, At, Bt) do { __builtin_amdgcn_s_setprio(1); _Pragma("unroll") for (int m = 0; m < 4; ++m) _Pragma("unroll") for (int n = 0; n < 2; ++n) _Pragma("unroll") for (int k = 0; k < 2; ++k) \
        acc[ai][bj][m][n] = __builtin_amdgcn_mfma_f32_16x16x32_bf16(Bt[n][k], At[m][k], acc[ai][bj][m][n], 0, 0, 0); __builtin_amdgcn_s_setprio(0); } while (0)
#define PG8_WAIT_V(n) asm volatile("s_waitcnt vmcnt(" #n ")" ::: "memory")
#define PG8_WAIT_L(n) asm volatile("s_waitcnt lgkmcnt(" #n ")" ::: "memory")
#define PG8_BAR __builtin_amdgcn_s_barrier()
#define PG8_SCHED __builtin_amdgcn_sched_barrier(0)
    Unit cur, nxt; int ui = 0;
    if (!S.next(0, cur)) return;
    f32x4 acc[2][2][4][2];
#pragma unroll
    for (int a = 0; a < 2; ++a)
#pragma unroll
        for (int b = 0; b < 2; ++b)
#pragma unroll
            for (int m = 0; m < 4; ++m)
#pragma unroll
                for (int n = 0; n < 2; ++n) acc[a][b][m][n] = (f32x4){0.f, 0.f, 0.f, 0.f};
    bf16x8 At[4][2], B0[2][2], B1[2][2];
    const char* cA = S.aptr(cur); const char* cB = S.bptr(cur);
    if constexpr (GATHER) { S.gather(cur, tid, gA); }
    PG8_STAGEB(PG8_SB(0, 0), cB); PG8_STAGEB(PG8_SB(0, 1), cB + hstepB); PG8_STAGEA(PG8_SA(0, 0), cA, 0, gA); PG8_STAGEA(PG8_SA(0, 1), cA, 1, gA);
    if (wr == 1) PG8_BAR;
    PG8_WAIT_V(2); PG8_BAR;
    PG8_STAGEB(PG8_SB(1, 0), cB + kstep); PG8_STAGEA(PG8_SA(1, 0), cA + kstep, 0, gA); PG8_STAGEB(PG8_SB(1, 1), cB + hstepB + kstep);
    PG8_WAIT_V(6); PG8_BAR;
    for (;;) {
        const bool has_next = S.next(ui + 1, nxt);
        const char* nA = has_next ? S.aptr(nxt) : cA; const char* nB = has_next ? S.bptr(nxt) : cB;
        if constexpr (GATHER) { if (has_next) S.gather(nxt, tid, gN); else {
#pragma unroll
            for (int h = 0; h < 2; ++h)
#pragma unroll
                for (int i = 0; i < 2; ++i) gN[h][i] = gA[h][i]; } }
#pragma nounroll
        for (int t = 0; t < nt; t += 2) {
            const bool last = (t == nt - 2);
            const char* a1 = cA + (size_t)(t + 1) * kstep;
            const char* a2 = last ? nA : cA + (size_t)(t + 2) * kstep; const char* b2 = last ? nB : cB + (size_t)(t + 2) * kstep;
            const char* a3 = a2 + kstep; const char* b3 = b2 + kstep;
            unsigned g2[2][2];
            if constexpr (GATHER) {
#pragma unroll
                for (int h = 0; h < 2; ++h)
#pragma unroll
                    for (int i = 0; i < 2; ++i) g2[h][i] = last ? gN[h][i] : gA[h][i]; }
            PG8_LDB(B0, 0, 0); PG8_LDB(B1, 0, 1); PG8_SCHED; PG8_LDA(At, 0, 0); PG8_STAGEA(PG8_SA(1, 1), a1, 1, gA);
            PG8_WAIT_V(8); PG8_WAIT_L(0); PG8_BAR; PG8_MMA(0, 0, At, B0); PG8_MMA(0, 1, At, B1); PG8_BAR; PG8_SCHED;
            PG8_LDA(At, 0, 1); PG8_STAGEB(PG8_SB(0, 0), b2); PG8_STAGEB(PG8_SB(0, 1), b2 + hstepB); PG8_STAGEA(PG8_SA(0, 0), a2, 0, g2);
            PG8_WAIT_V(8); PG8_WAIT_L(0); PG8_BAR; PG8_MMA(1, 0, At, B0); PG8_MMA(1, 1, At, B1); PG8_BAR; PG8_SCHED;
            PG8_LDB(B0, 1, 0); PG8_LDB(B1, 1, 1); PG8_SCHED; PG8_LDA(At, 1, 0); PG8_STAGEA(PG8_SA(0, 1), a2, 1, g2);
            PG8_WAIT_V(8); PG8_WAIT_L(0); PG8_BAR; PG8_MMA(0, 0, At, B0); PG8_MMA(0, 1, At, B1); PG8_BAR; PG8_SCHED;
            PG8_LDA(At, 1, 1); PG8_STAGEB(PG8_SB(1, 0), b3); PG8_STAGEB(PG8_SB(1, 1), b3 + hstepB); PG8_STAGEA(PG8_SA(1, 0), a3, 0, g2);
            PG8_WAIT_V(8); PG8_WAIT_L(0); PG8_BAR; PG8_MMA(1, 0, At, B0); PG8_MMA(1, 1, At, B1); PG8_BAR; PG8_SCHED;
        }
        if (wr == 0) PG8_BAR;
        E(acc, cur, wr, wc, fr, fq);
        if (!has_next) break;
#pragma unroll
        for (int a = 0; a < 2; ++a)
#pragma unroll
            for (int b = 0; b < 2; ++b)
#pragma unroll
                for (int m = 0; m < 4; ++m)
#pragma unroll
                    for (int n = 0; n < 2; ++n) acc[a][b][m][n] = (f32x4){0.f, 0.f, 0.f, 0.f};
        cur = nxt; cA = nA; cB = nB; ++ui;
        if constexpr (GATHER) {
#pragma unroll
            for (int h = 0; h < 2; ++h)
#pragma unroll
                for (int i = 0; i < 2; ++i) gA[h][i] = gN[h][i]; }
        if (wr == 1) PG8_BAR;
    }
    PG8_WAIT_V(0);
    PG8_BAR;
#undef PG8_SA
#undef PG8_SB
#undef PG8_STAGEA
#undef PG8_STAGEB
#undef PG8_LDA
#undef PG8_LDB
#undef PG8_MMA
#undef PG8_WAIT_V
#undef PG8_WAIT_L
#undef PG8_BAR
#undef PG8_SCHED
}
}
using pg8::Unit;

__device__ __forceinline__ void set_desc(LAS unsigned char* lds, int tid, int g, const void* A, const void* B, const void* C, int nN, int ldc, int aux, const void* X1 = nullptr, const void* X2 = nullptr, const void* X3 = nullptr) {
    LAS int* d = (LAS int*)(lds + LDS_DESC) + g * 16;
    if (tid == 0) { unsigned long long a = (unsigned long long)A, b = (unsigned long long)B, c = (unsigned long long)C, x1 = (unsigned long long)X1, x2 = (unsigned long long)X2, x3 = (unsigned long long)X3;
        asm volatile("" : "+s"(a), "+s"(b), "+s"(c), "+s"(x1), "+s"(x2), "+s"(x3), "+s"(nN), "+s"(ldc), "+s"(aux));
        d[0] = (int)(unsigned)a; d[1] = (int)(unsigned)(a >> 32); d[2] = (int)(unsigned)b; d[3] = (int)(unsigned)(b >> 32); d[4] = (int)(unsigned)c; d[5] = (int)(unsigned)(c >> 32); d[6] = nN; d[7] = ldc; d[8] = aux;
        d[10] = (int)(unsigned)x1; d[11] = (int)(unsigned)(x1 >> 32); d[12] = (int)(unsigned)x2; d[13] = (int)(unsigned)(x2 >> 32); d[14] = (int)(unsigned)x3; d[15] = (int)(unsigned)(x3 >> 32); }
}
__device__ __forceinline__ int desc_i(LAS unsigned char* lds, int g, int f) { return __builtin_amdgcn_readfirstlane(((LAS const int*)(lds + LDS_DESC))[g * 16 + f]); }
__device__ __forceinline__ const char* desc_p(LAS unsigned char* lds, int g, int f) {
    const unsigned lo = (unsigned)desc_i(lds, g, f), hi = (unsigned)desc_i(lds, g, f + 1); return (const char*)(((unsigned long long)hi << 32) | lo); }
template <int LDA, int LDB>
struct SchedMulti {
    LAS unsigned char* lds; int nM, ntot, ng;
    __device__ __forceinline__ bool next(int i, Unit& u) const {
        const int nwg = nM * ntot; const long L = (long)i * gridDim.x + blockIdx.x; if (L >= nwg) return false;
        const int wgid = pg8::xcd_remap((int)L, nwg);
        const int nig = pg8::WGM * ntot, gid = wgid / nig, fm = gid * pg8::WGM, gsz = (nM - fm) < pg8::WGM ? (nM - fm) : pg8::WGM;
        u.pm = fm + ((wgid % nig) % gsz); int pv = (wgid % nig) / gsz; int g = 0;
        for (int j = 0; j + 1 < ng; ++j) { const int n = desc_i(lds, j, 6); if (pv < n) break; pv -= n; g = j + 1; }
        u.pn = pv; u.aux = g; return true;
    }
    __device__ __forceinline__ const char* aptr(const Unit& u) const { return desc_p(lds, u.aux, 0) + (size_t)u.pm * (512 * LDA); }
    __device__ __forceinline__ const char* bptr(const Unit& u) const { return desc_p(lds, u.aux, 2) + (size_t)u.pn * (512 * LDB); }
};
template <int LDA, int LDB, bool GATHERED>
struct SchedMoE {
    LAS unsigned char* lds; const char* Abase; const char* Bbase; const int* list;
    __device__ __forceinline__ bool next(int i, Unit& u) const {
        LAS const int* tab = (LAS const int*)(lds + LDS_TAB);
        const int nrt = __builtin_amdgcn_readfirstlane(tab[2 * MAXRT + 32]);
        const int nwg = nrt * 4; const long L = (long)i * gridDim.x + blockIdx.x; if (L >= nwg) return false;
        const int wgid = pg8::xcd_remap((int)L, nwg);
        u.pm = wgid >> 2; u.pn = wgid & 3; u.aux = __builtin_amdgcn_readfirstlane(tab[u.pm]); return true;
    }
    __device__ __forceinline__ const char* aptr(const Unit& u) const { return GATHERED ? Abase : Abase + (size_t)u.pm * (512 * LDA); }
    __device__ __forceinline__ const char* bptr(const Unit& u) const { return Bbase + (size_t)u.aux * ((size_t)D * LDB * 2) + (size_t)u.pn * (512 * LDB); }
    __device__ __forceinline__ void gather(const Unit& u, int tid, unsigned (&g)[2][2]) const {
        LAS const int* tab = (LAS const int*)(lds + LDS_TAB);
        const int j0 = __builtin_amdgcn_readfirstlane(tab[MAXRT + u.pm]), cn = __builtin_amdgcn_readfirstlane(tab[2 * MAXRT + u.aux]);
#pragma unroll
        for (int i = 0; i < 2; ++i) { int R, C; pg8::stage_rc(tid * 16 + i * 8192, R, C);
#pragma unroll
            for (int h = 0; h < 2; ++h) { const int slot = j0 + 128 * h + R; const int a = slot < cn ? list[(size_t)u.aux * LISTCAP + slot] : 0;
                g[h][i] = (unsigned)((a >> 1) * LDA + C) * 2u; } }
    }
};
__device__ __forceinline__ void moe_tables(LAS unsigned char* lds, int tid, const unsigned* cnt) {
    LAS int* tab = (LAS int*)(lds + LDS_TAB);
    __syncthreads();
    if (tid == 0) {
        int rt = 0;
#pragma nounroll
        for (int e = 0; e < NE; ++e) { const int c = (int)__hip_atomic_load(cnt + e, __ATOMIC_RELAXED, __HIP_MEMORY_SCOPE_AGENT); tab[2 * MAXRT + e] = c;
            const int nt = (c + 255) >> 8;
#pragma nounroll
            for (int j = 0; j < nt; ++j) { tab[rt] = e; tab[MAXRT + rt] = j * 256; ++rt; } }
        tab[2 * MAXRT + 32] = rt;
    }
    __syncthreads();
}

#define EPI_FENCE() asm volatile("" ::: "memory")
struct EpiGelu {
    static constexpr bool PERM = true;
    LAS unsigned char* lds;
    __device__ __forceinline__ void operator()(const f32x4 (&acc)[2][2][4][2], const Unit& u, int wr, int wc, int fr, int fq) const {
        const bool isv = u.pn >= 8; bf16_t* base = (bf16_t*)desc_p(lds, 0, isv ? 10 : 4); const float* bias = (const float*)desc_p(lds, 0, 12); float* stat = (float*)desc_p(lds, 0, 14);
        const int col0 = (u.pn & 7) * 256 + wc * 32 + 8 * fq, bcol0 = u.pn * 256 + wc * 32 + 8 * fq, row0 = u.pm * 256 + wr * 64 + fr;
        f32x4 bv[2][2];
#pragma unroll
        for (int bj = 0; bj < 2; ++bj)
#pragma unroll
            for (int n = 0; n < 2; ++n) bv[bj][n] = *(const f32x4*)(bias + bcol0 + bj * 128 + 4 * n);
#pragma unroll
        for (int ai = 0; ai < 2; ++ai)
#pragma unroll
            for (int m = 0; m < 4; ++m) { const int row = row0 + ai * 128 + m * 16; bf16_t* rowp = base + (size_t)row * GWID + col0; float s = 0.f, q = 0.f;
#pragma unroll
                for (int bj = 0; bj < 2; ++bj) { const f32x4 v0 = acc[ai][bj][m][0] + bv[bj][0], v1 = acc[ai][bj][m][1] + bv[bj][1];
                    const f32x2 a = gelu_pk((f32x2){v0[0], v0[1]}), b = gelu_pk((f32x2){v0[2], v0[3]}), c = gelu_pk((f32x2){v1[0], v1[1]}), d = gelu_pk((f32x2){v1[2], v1[3]});
                    s += ((a.x + a.y) + (b.x + b.y)) + ((c.x + c.y) + (d.x + d.y));
                    q += ((a.x * a.x + a.y * a.y) + (b.x * b.x + b.y * b.y)) + ((c.x * c.x + c.y * c.y) + (d.x * d.x + d.y * d.y));
                    u32x4 w; w.x = cvt_pk_bf16(a.x, a.y); w.y = cvt_pk_bf16(b.x, b.y); w.z = cvt_pk_bf16(c.x, c.y); w.w = cvt_pk_bf16(d.x, d.y);
                    *(u32x4*)(rowp + bj * 128) = w; }
                if (isv) { const int ln_ = 16 * fq + fr; s += shx(s, 16, ln_); s += shx(s, 32, ln_); q += shx(q, 16, ln_); q += shx(q, 32, ln_);
                    if (fq == 0) *(f32x2*)(stat + ((size_t)row * 32 + (u.pn - 8) * 4 + wc) * 2) = (f32x2){s, q}; } }
    }
};
struct EpiResid {
    static constexpr bool PERM = true;
    LAS unsigned char* lds;
    __device__ __forceinline__ void operator()(const f32x4 (&acc)[2][2][4][2], const Unit& u, int wr, int wc, int fr, int fq) const {
        const int mrow = u.pm < 64 ? 0 : (u.pm < 128 ? 1 : 2);
        bf16_t* x = (bf16_t*)desc_p(lds, 0, 4) + (size_t)(u.pm * 256 + wr * 64 + fr) * D + u.pn * 256 + wc * 32 + 8 * fq;
        const float* bias = (const float*)desc_p(lds, 0, 14); const float* gate = (const float*)desc_p(lds, 1, 10) + mrow * 6 * D + u.pn * 256 + wc * 32 + 8 * fq;
        if (bias) bias += u.pn * 256 + wc * 32 + 8 * fq;
#pragma unroll
        for (int bj = 0; bj < 2; ++bj) {
#pragma unroll
            for (int n = 0; n < 2; ++n) { const int c = bj * 128 + 4 * n;
                const f32x4 b0 = bias ? *(const f32x4*)(bias + c) : (f32x4){0.f, 0.f, 0.f, 0.f};
                const f32x4 g0 = *(const f32x4*)(gate + c);
#pragma unroll
                for (int ai = 0; ai < 2; ++ai) {
#pragma unroll
                    for (int m = 0; m < 4; ++m) { bf16_t* p = x + (size_t)(ai * 128 + m * 16) * D + c;
                        const u32x2 w = *(const u32x2*)p; const f32x4 x0 = (f32x4){bf_lo(w.x), bf_hi(w.x), bf_lo(w.y), bf_hi(w.y)};
                        const f32x4 o0 = x0 + g0 * (acc[ai][bj][m][n] + b0);
                        u32x2 w2; w2.x = cvt_pk_bf16(o0[0], o0[1]); w2.y = cvt_pk_bf16(o0[2], o0[3]);
                        *(u32x2*)p = w2; }
                    EPI_FENCE(); } } }
    }
};
template <int K>
__device__ __forceinline__ void tail_resid(LAS unsigned char* lds, int wave) {
    const int lane = lane_id_now(), fr = lane & 15, q = lane >> 4, tid = wave * 64 + lane;
    constexpr int KW = K / 8, RP = 68;
    LAS float* red = (LAS float*)lds;
    const bf16_t* A = (const bf16_t*)desc_p(lds, 0, 0) + (size_t)TL * K; const bf16_t* W = (const bf16_t*)desc_p(lds, 0, 2);
    bf16_t* X = (bf16_t*)desc_p(lds, 0, 4) + (size_t)TL * D; const float* bias = (const float*)desc_p(lds, 0, 14); const float* gate = (const float*)desc_p(lds, 1, 10) + 2 * 6 * D;
    for (int item = blockIdx.x; item < TC / 16 * 16; item += gridDim.x) {
        const int r0 = (item >> 4) * 16, c0 = (item & 15) * 64;
        const bf16_t* ap = A + (size_t)(r0 + fr) * K + wave * KW + 16 * q;
        const bf16_t* bp = W + (size_t)(c0 + fr) * K + wave * KW + 16 * q;
        f32x4 acc[4];
#pragma unroll
        for (int n = 0; n < 4; ++n) acc[n] = (f32x4){0.f, 0.f, 0.f, 0.f};
#pragma unroll
        for (int kb = 0; kb < KW / 64; ++kb) {
            const bf16x8 a0 = *(const bf16x8*)(ap + kb * 64), a1 = *(const bf16x8*)(ap + kb * 64 + 8);
#pragma unroll
            for (int n = 0; n < 4; ++n) { const bf16x8 b0 = *(const bf16x8*)(bp + (size_t)n * 16 * K + kb * 64), b1 = *(const bf16x8*)(bp + (size_t)n * 16 * K + kb * 64 + 8);
                acc[n] = __builtin_amdgcn_mfma_f32_16x16x32_bf16(a0, b0, acc[n], 0, 0, 0); acc[n] = __builtin_amdgcn_mfma_f32_16x16x32_bf16(a1, b1, acc[n], 0, 0, 0); }
        }
#pragma unroll
        for (int n = 0; n < 4; ++n)
#pragma unroll
            for (int r = 0; r < 4; ++r) red[(wave * 16 + 4 * q + r) * RP + n * 16 + fr] = acc[n][r];
        __syncthreads();
        { const int row = tid >> 5, c2 = 2 * (tid & 31); float s0 = 0.f, s1 = 0.f;
#pragma unroll
          for (int w = 0; w < 8; ++w) { const f32x2 v = *(LAS const f32x2*)(red + (w * 16 + row) * RP + c2); s0 += v.x; s1 += v.y; }
          const int col = c0 + c2; bf16_t* p = X + (size_t)(r0 + row) * D + col; const unsigned xw = *(const unsigned*)p;
          const float b0 = bias ? bias[col] : 0.f, b1 = bias ? bias[col + 1] : 0.f;
          *(unsigned*)p = cvt_pk_bf16(bf_lo(xw) + gate[col] * (s0 + b0), bf_hi(xw) + gate[col + 1] * (s1 + b1)); }
        __syncthreads();
    }
}
__device__ __forceinline__ void tail_gelu(LAS unsigned char* lds, int wave) {
    const int lane = lane_id_now(), fr = lane & 15, q = lane >> 4, tid = wave * 64 + lane;
    constexpr int K = D, KW = K / 8, RP = 260;
    LAS float* red = (LAS float*)lds;
    const bf16_t* A = (const bf16_t*)desc_p(lds, 0, 0) + (size_t)TL * K; const bf16_t* W = (const bf16_t*)desc_p(lds, 0, 2);
    const float* bias = (const float*)desc_p(lds, 0, 12); float* stat = (float*)desc_p(lds, 0, 14);
    for (int item = blockIdx.x; item < TC / 16 * 16; item += gridDim.x) {
        const int r0 = (item >> 4) * 16, c0 = (item & 15) * 256;
        const bf16_t* ap = A + (size_t)(r0 + fr) * K + wave * KW + 16 * q;
        const bf16_t* bp = W + (size_t)(c0 + fr) * K + wave * KW + 16 * q;
        const bf16x8 a0 = *(const bf16x8*)(ap), a1 = *(const bf16x8*)(ap + 8), a2 = *(const bf16x8*)(ap + 64), a3 = *(const bf16x8*)(ap + 72);
#pragma unroll 1
        for (int ng = 0; ng < 4; ++ng) {
            f32x4 acc[4];
#pragma unroll
            for (int n = 0; n < 4; ++n) { const bf16_t* b = bp + (size_t)(ng * 4 + n) * 16 * K;
                const bf16x8 b0 = *(const bf16x8*)(b), b1 = *(const bf16x8*)(b + 8), b2 = *(const bf16x8*)(b + 64), b3 = *(const bf16x8*)(b + 72);
                f32x4 c = (f32x4){0.f, 0.f, 0.f, 0.f};
                c = __builtin_amdgcn_mfma_f32_16x16x32_bf16(a0, b0, c, 0, 0, 0); c = __builtin_amdgcn_mfma_f32_16x16x32_bf16(a1, b1, c, 0, 0, 0);
                c = __builtin_amdgcn_mfma_f32_16x16x32_bf16(a2, b2, c, 0, 0, 0); c = __builtin_amdgcn_mfma_f32_16x16x32_bf16(a3, b3, c, 0, 0, 0); acc[n] = c; }
#pragma unroll
            for (int n = 0; n < 4; ++n)
#pragma unroll
                for (int r = 0; r < 4; ++r) red[(wave * 16 + 4 * q + r) * RP + (ng * 4 + n) * 16 + fr] = acc[n][r];
        }
        __syncthreads();
        { const int row = tid >> 5, c8 = 8 * (tid & 31); f32x4 s0 = (f32x4){0.f, 0.f, 0.f, 0.f}, s1 = s0;
#pragma unroll
          for (int w = 0; w < 8; ++w) { s0 += *(LAS const f32x4*)(red + (w * 16 + row) * RP + c8); s1 += *(LAS const f32x4*)(red + (w * 16 + row) * RP + c8 + 4); }
          const int col = c0 + c8; const bool isv = col >= GWID; bf16_t* base = (bf16_t*)desc_p(lds, 0, isv ? 10 : 4);
          s0 += *(const f32x4*)(bias + col); s1 += *(const f32x4*)(bias + col + 4);
          const f32x2 a = gelu_pk((f32x2){s0[0], s0[1]}), b = gelu_pk((f32x2){s0[2], s0[3]}), c = gelu_pk((f32x2){s1[0], s1[1]}), d = gelu_pk((f32x2){s1[2], s1[3]});
          u32x4 w; w.x = cvt_pk_bf16(a.x, a.y); w.y = cvt_pk_bf16(b.x, b.y); w.z = cvt_pk_bf16(c.x, c.y); w.w = cvt_pk_bf16(d.x, d.y);
          *(u32x4*)(base + (size_t)(TL + r0 + row) * GWID + (col & (GWID - 1))) = w;
          if (isv) { float s = ((a.x + a.y) + (b.x + b.y)) + ((c.x + c.y) + (d.x + d.y)), qq = ((a.x * a.x + a.y * a.y) + (b.x * b.x + b.y * b.y)) + ((c.x * c.x + c.y * c.y) + (d.x * d.x + d.y * d.y));
              s += shx(s, 1, lane); s += shx(s, 2, lane); s += shx(s, 4, lane); qq += shx(qq, 1, lane); qq += shx(qq, 2, lane); qq += shx(qq, 4, lane);
              if ((lane & 7) == 0) *(f32x2*)(stat + ((size_t)(TL + r0 + row) * 32 + ((col - GWID) >> 6)) * 2) = (f32x2){s, qq}; } }
        __syncthreads();
    }
}
struct EpiAct {
    static constexpr bool PERM = true;
    LAS unsigned char* lds;
    __device__ __forceinline__ void operator()(const f32x4 (&acc)[2][2][4][2], const Unit& u, int wr, int wc, int fr, int fq) const {
        bf16_t* C = (bf16_t*)desc_p(lds, u.aux, 4); const int ldc = desc_i(lds, u.aux, 7), act = desc_i(lds, u.aux, 8);
        const int col0 = u.pn * 256 + wc * 32 + 8 * fq, row0 = u.pm * 256 + wr * 64 + fr;
#pragma unroll
        for (int ai = 0; ai < 2; ++ai)
#pragma unroll
            for (int m = 0; m < 4; ++m) { bf16_t* rowp = C + (size_t)(row0 + ai * 128 + m * 16) * ldc + col0;
#pragma unroll
                for (int bj = 0; bj < 2; ++bj) { f32x4 v0 = acc[ai][bj][m][0], v1 = acc[ai][bj][m][1];
                    if (act == 1) {
#pragma unroll
                        for (int j = 0; j < 4; ++j) { v0[j] = tanhf_(v0[j]); v1[j] = tanhf_(v1[j]); } }
                    else if (act == 2) {
#pragma unroll
                        for (int j = 0; j < 4; ++j) { v0[j] = sigmoidf_(v0[j]); v1[j] = sigmoidf_(v1[j]); } }
                    u32x4 w; w.x = cvt_pk_bf16(v0[0], v0[1]); w.y = cvt_pk_bf16(v0[2], v0[3]); w.z = cvt_pk_bf16(v1[0], v1[1]); w.w = cvt_pk_bf16(v1[2], v1[3]);
                    *(u32x4*)(rowp + bj * 128) = w; } }
    }
};
struct EpiLogits {
    static constexpr bool PERM = false;
    float* LG;
    __device__ __forceinline__ void operator()(const f32x4 (&acc)[2][2][4][2], const Unit& u, int wr, int wc, int fr, int fq) const {
        if (wc >= 2) return;
        const int col0 = wc * 32 + 4 * fq, row0 = u.pm * 256 + wr * 64 + fr;
#pragma unroll
        for (int ai = 0; ai < 2; ++ai)
#pragma unroll
            for (int m = 0; m < 4; ++m)
#pragma unroll
                for (int n = 0; n < 2; ++n) *(f32x4*)(LG + (size_t)(row0 + ai * 128 + m * 16) * 64 + col0 + n * 16) = acc[ai][0][m][n] + acc[ai][1][m][n];
    }
};
struct EpiSiluGate {
    static constexpr bool PERM = true;
    bf16_t* H;
    __device__ __forceinline__ void operator()(const f32x4 (&acc)[2][2][4][2], const Unit& u, int wr, int wc, int fr, int fq) const {
        const int col0 = u.pn * 128 + wc * 32 + 8 * fq, row0 = u.pm * 256 + wr * 64 + fr;
#pragma unroll
        for (int ai = 0; ai < 2; ++ai)
#pragma unroll
            for (int m = 0; m < 4; ++m) { f32x4 h0, h1;
#pragma unroll
                for (int j = 0; j < 4; ++j) { const float g0 = acc[ai][0][m][0][j], g1 = acc[ai][0][m][1][j]; h0[j] = g0 * sigmoidf_(g0) * acc[ai][1][m][0][j]; h1[j] = g1 * sigmoidf_(g1) * acc[ai][1][m][1][j]; }
                u32x4 w; w.x = cvt_pk_bf16(h0[0], h0[1]); w.y = cvt_pk_bf16(h0[2], h0[3]); w.z = cvt_pk_bf16(h1[0], h1[1]); w.w = cvt_pk_bf16(h1[2], h1[3]);
                *(u32x4*)(H + (size_t)(row0 + ai * 128 + m * 16) * EHID + col0) = w; }
    }
};
struct EpiScatter {
    static constexpr bool PERM = true;
    LAS unsigned char* lds; bf16_t* YB; const int* list;
    __device__ __forceinline__ void operator()(const f32x4 (&acc)[2][2][4][2], const Unit& u, int wr, int wc, int fr, int fq) const {
        LAS const int* tab = (LAS const int*)(lds + LDS_TAB);
        const int j0 = __builtin_amdgcn_readfirstlane(tab[MAXRT + u.pm]), cn = __builtin_amdgcn_readfirstlane(tab[2 * MAXRT + u.aux]);
        const int col0 = u.pn * 256 + wc * 32 + 8 * fq;
#pragma unroll
        for (int ai = 0; ai < 2; ++ai)
#pragma unroll
            for (int m = 0; m < 4; ++m) { const int slot = j0 + ai * 128 + wr * 64 + m * 16 + fr;
                if (slot < cn) { const int a = list[(size_t)u.aux * LISTCAP + slot]; bf16_t* rowp = YB + (size_t)a * D + col0;
#pragma unroll
                    for (int bj = 0; bj < 2; ++bj) { const f32x4 v0 = acc[ai][bj][m][0], v1 = acc[ai][bj][m][1];
                        u32x4 w; w.x = cvt_pk_bf16(v0[0], v0[1]); w.y = cvt_pk_bf16(v0[2], v0[3]); w.z = cvt_pk_bf16(v1[0], v1[1]); w.w = cvt_pk_bf16(v1[2], v1[3]);
                        *(u32x4*)(rowp + bj * 128) = w; } } }
    }
};

struct Params { const float* in[42]; float* out; unsigned char* ws; int ph_lo, ph_hi; };
enum { I_X = 0, I_C, I_CTX, I_CCTX, I_ADAW, I_ADAB, I_N1G, I_N2G, I_FG, I_GWIN, I_GBIN, I_GLNG, I_GLNB, I_GWS, I_GBS, I_GWOUT, I_GBOUT,
       I_MU, I_WR, I_WK, I_WV, I_WO, I_W0, I_W1, I_W2, I_A0, I_A1, I_A2, I_G1, I_G2, I_KK, I_KA, I_RK, I_LNG, I_LNB,
       I_MWGRP, I_MBGRP, I_MWEXP, I_MBEXP, I_MWG, I_MWU, I_MWD };
struct Frame { LAS unsigned char* lds; int tid, lane, wave, G, gw, NGW; };
typedef const __attribute__((address_space(4))) Params* KP;

constexpr int TRP = 36, TR_SCR = 64 * TRP * 4;
__device__ __forceinline__ void tr_item(const float* W, int N, int kmax, bf16_t* WT, int ldk, int k0, int n0, int drow0, int dk0, LAS float* scr, int lane) {
    const int n4 = lane & 7, kr = lane >> 3; f32x4 v[8];
#pragma unroll
    for (int i = 0; i < 8; ++i) { const int k = k0 + 8 * i + kr; v[i] = k < kmax ? *(const f32x4*)(W + (size_t)k * N + n0 + 4 * n4) : (f32x4){0.f, 0.f, 0.f, 0.f}; }
#pragma unroll
    for (int i = 0; i < 8; ++i) *(LAS f32x4*)(scr + (8 * i + kr) * TRP + 4 * n4) = v[i];
    asm volatile("s_waitcnt lgkmcnt(0)" ::: "memory");
    const int c = lane & 7;
#pragma unroll
    for (int j = 0; j < 4; ++j) { const int n = (lane >> 3) + 8 * j; const LAS float* sp = scr + (8 * c) * TRP + n;
        u32x4 o; o.x = cvt_pk_bf16(sp[0 * TRP], sp[1 * TRP]); o.y = cvt_pk_bf16(sp[2 * TRP], sp[3 * TRP]); o.z = cvt_pk_bf16(sp[4 * TRP], sp[5 * TRP]); o.w = cvt_pk_bf16(sp[6 * TRP], sp[7 * TRP]);
        *(u32x4*)(WT + (size_t)(drow0 + n) * ldk + dk0 + k0 + 8 * c) = o; }
    asm volatile("s_waitcnt lgkmcnt(0)" ::: "memory");
}
constexpr int LDS_JOBS = 80 * 1024, MAXJOBS = 48;
__device__ __forceinline__ void add_job(LAS int* jobs, int& nj, int& nit, const float* src, int N, int kmax, int kpad, bf16_t* dst, int ldk, int drow0, int dk0) {
    LAS int* q = jobs + nj * 12; const unsigned long long a = (unsigned long long)src, d = (unsigned long long)dst;
    q[0] = (int)(unsigned)a; q[1] = (int)(unsigned)(a >> 32); q[2] = (int)(unsigned)d; q[3] = (int)(unsigned)(d >> 32); q[4] = N; q[5] = kmax; q[6] = kpad / 64; q[7] = ldk; q[8] = drow0; q[9] = dk0; q[10] = nit;
    nit += (kpad / 64) * (N / 32); ++nj;
}
__device__ __forceinline__ void zero_fill(const Frame& F, bf16_t* p, size_t nbytes) {
    u32x4* q = (u32x4*)p; const size_t n = nbytes / 16;
    for (size_t i = (size_t)blockIdx.x * NTHR + F.tid; i < n; i += (size_t)F.G * NTHR) q[i] = (u32x4){0u, 0u, 0u, 0u};
}

__device__ __forceinline__ void prologue_phase(const Frame& F, KP P) {
    unsigned char* ws = P->ws;
    {   float* MOD = (float*)(ws + WS_MOD); LAS float* part = (LAS float*)F.lds;
        const float* c = P->in[I_C]; const float* cc = P->in[I_CCTX];
        for (int item = blockIdx.x; item < DEPTH * 24; item += F.G) {
            const int layer = item / 24, col = (item % 24) * 256 + 4 * F.lane; const float* w = P->in[I_ADAW] + (size_t)layer * D * 6 * D + col;
            f32x4 a0 = (f32x4){0.f, 0.f, 0.f, 0.f}, a1 = a0, a2 = a0;
#pragma unroll 8
            for (int i = 0; i < 128; ++i) { const int d = F.wave + 8 * i; const f32x4 wv = *(const f32x4*)(w + (size_t)d * 6 * D);
                const float c0 = c[d], c1 = c[D + d], c2 = cc[d];
                a0 += wv * (c0 * sigmoidf_(c0)); a1 += wv * (c1 * sigmoidf_(c1)); a2 += wv * (c2 * sigmoidf_(c2)); }
            __syncthreads();
            *(LAS f32x4*)(part + (F.wave * 3 + 0) * 256 + 4 * F.lane) = a0; *(LAS f32x4*)(part + (F.wave * 3 + 1) * 256 + 4 * F.lane) = a1; *(LAS f32x4*)(part + (F.wave * 3 + 2) * 256 + 4 * F.lane) = a2;
            __syncthreads();
            if (F.wave < 3) { f32x4 sacc = (f32x4){0.f, 0.f, 0.f, 0.f};
#pragma unroll
                for (int w8 = 0; w8 < 8; ++w8) sacc += *(const LAS f32x4*)(part + (w8 * 3 + F.wave) * 256 + 4 * F.lane);
                *(f32x4*)(MOD + ((size_t)layer * 3 + F.wave) * 6 * D + col) = sacc + *(const f32x4*)(P->in[I_ADAB] + (size_t)layer * 6 * D + col); }
        }
    }
    LAS int* jobs = (LAS int*)(F.lds + LDS_JOBS); LAS int* jtot = jobs + MAXJOBS * 12;
    __syncthreads();
    if (F.tid == 0) { int nj = 0, nit = 0;
        for (int j = 0; j < 2; ++j) {
            add_job(jobs, nj, nit, P->in[I_GWIN] + (size_t)j * D * 4096, 4096, D, D, (bf16_t*)(ws + WS_WIN) + (size_t)j * 4096 * D, D, 0, 0);
            add_job(jobs, nj, nit, P->in[I_GWOUT] + (size_t)j * GWID * D, D, GWID, GWID, (bf16_t*)(ws + WS_WOUT) + (size_t)j * D * GWID, GWID, 0, 0);
            add_job(jobs, nj, nit, P->in[I_WR] + (size_t)j * D * D, D, D, D, (bf16_t*)(ws + WS_WR) + (size_t)j * D * D, D, 0, 0);
            add_job(jobs, nj, nit, P->in[I_WK] + (size_t)j * D * D, D, D, D, (bf16_t*)(ws + WS_WK) + (size_t)j * D * D, D, 0, 0);
            add_job(jobs, nj, nit, P->in[I_WV] + (size_t)j * D * D, D, D, D, (bf16_t*)(ws + WS_WV) + (size_t)j * D * D, D, 0, 0);
            add_job(jobs, nj, nit, P->in[I_WO] + (size_t)j * D * D, D, D, D, (bf16_t*)(ws + WS_WO) + (size_t)j * D * D, D, 0, 0);
            for (int z = 0; z < 2; ++z) {
                add_job(jobs, nj, nit, P->in[I_W1] + ((size_t)j * 2 + z) * D * 64, 64, D, D, (bf16_t*)(ws + WS_LW1) + (size_t)j * 256 * D, D, z * 64, 0);
                add_job(jobs, nj, nit, P->in[I_A1] + ((size_t)j * 2 + z) * D * 64, 64, D, D, (bf16_t*)(ws + WS_LA1) + (size_t)j * 256 * D, D, z * 64, 0);
                add_job(jobs, nj, nit, P->in[I_W2] + ((size_t)j * 2 + z) * 64 * D, D, 64, 64, (bf16_t*)(ws + WS_W2P) + ((size_t)j * 2 + z) * D * 256, 256, 0, z * 64);
                add_job(jobs, nj, nit, P->in[I_A2] + ((size_t)j * 2 + z) * 64 * D, D, 64, 64, (bf16_t*)(ws + WS_A2P) + ((size_t)j * 2 + z) * D * 256, 256, 0, z * 64); }
            add_job(jobs, nj, nit, P->in[I_G1] + (size_t)j * D * 160, 160, D, D, (bf16_t*)(ws + WS_LG1) + (size_t)j * 256 * D, D, 0, 0);
            add_job(jobs, nj, nit, P->in[I_G2] + (size_t)j * 160 * D, D, 160, 256, (bf16_t*)(ws + WS_G2P) + (size_t)j * D * 256, 256, 0, 0); }
        jtot[0] = nj; jtot[1] = nit; }
    __syncthreads();
    {   const int nj = jtot[0], nit = jtot[1]; LAS float* scr = (LAS float*)(F.lds + F.wave * TR_SCR);
        for (int it = F.gw; it < nit; it += F.NGW) {
            int jb = 0; for (int q = 1; q < nj; ++q) if (it >= jobs[q * 12 + 10]) jb = q;
            jb = __builtin_amdgcn_readfirstlane(jb); LAS const int* q = jobs + jb * 12;
            const float* src = (const float*)(((unsigned long long)(unsigned)q[1] << 32) | (unsigned)q[0]); bf16_t* dst = (bf16_t*)(((unsigned long long)(unsigned)q[3] << 32) | (unsigned)q[2]);
            const int N = q[4], nnb = N / 32, r = it - q[10], kb = r / nnb, nb = r % nnb;
            tr_item(src, N, q[5], dst, q[7], kb * 64, nb * 32, q[8] + nb * 32, q[9], scr, F.lane); }
    }
    for (int j = 0; j < 2; ++j) {
        bf16_t* lw1 = (bf16_t*)(ws + WS_LW1) + (size_t)j * 256 * D; bf16_t* la1 = (bf16_t*)(ws + WS_LA1) + (size_t)j * 256 * D; bf16_t* lg1 = (bf16_t*)(ws + WS_LG1) + (size_t)j * 256 * D;
        zero_fill(F, lw1 + 128 * D, (size_t)128 * D * 2); zero_fill(F, la1 + 128 * D, (size_t)128 * D * 2); zero_fill(F, lg1 + 160 * D, (size_t)96 * D * 2);
        for (int z = 0; z < 2; ++z) { bf16_t* w2p = (bf16_t*)(ws + WS_W2P) + ((size_t)j * 2 + z) * D * 256; bf16_t* a2p = (bf16_t*)(ws + WS_A2P) + ((size_t)j * 2 + z) * D * 256;
            for (int idx = blockIdx.x * NTHR + F.tid; idx < D * 32; idx += F.G * NTHR) { const int n = idx >> 5, ch = idx & 31;
                if ((ch >> 3) != z) { *(u32x4*)(w2p + (size_t)n * 256 + ch * 8) = (u32x4){0u, 0u, 0u, 0u}; *(u32x4*)(a2p + (size_t)n * 256 + ch * 8) = (u32x4){0u, 0u, 0u, 0u}; } } }
    }
    {   bf16_t* wrt = (bf16_t*)(ws + WS_WRT);
        for (int idx = blockIdx.x * NTHR + F.tid; idx < DEPTH * 256 * (D / 8); idx += F.G * NTHR) { const int k0 = (idx & 127) * 8, n = (idx >> 7) & 255, layer = idx >> 15;
            const int nn = n & 127; const bool lo = n >= 128; float w[8];
#pragma unroll
            for (int e = 0; e < 8; ++e) { float x = 0.f;
                if (nn < 4) x = P->in[I_MWGRP][((size_t)layer * D + k0 + e) * 4 + nn]; else if (nn < 36) x = P->in[I_MWEXP][((size_t)layer * D + k0 + e) * NE + nn - 4];
                const float hi = bf_lo(cvt_pk_bf16(x, 0.f)); w[e] = lo ? x - hi : x; }
            *(u32x4*)(wrt + ((size_t)layer * 256 + n) * D + k0) = pack8(w); } }
    {   const float* src = P->in[I_GWS]; bf16_t* dst = (bf16_t*)(ws + WS_WSP); const int n8 = 2 * 16 * 128 * 128 / 8;
        for (int i = blockIdx.x * NTHR + F.tid; i < n8; i += F.G * NTHR) { const f32x4 a = *(const f32x4*)(src + (size_t)i * 8), b = *(const f32x4*)(src + (size_t)i * 8 + 4);
            u32x4 o; o.x = cvt_pk_bf16(a[0], a[1]); o.y = cvt_pk_bf16(a[2], a[3]); o.z = cvt_pk_bf16(b[0], b[1]); o.w = cvt_pk_bf16(b[2], b[3]); *(u32x4*)(dst + (size_t)i * 8) = o; } }
}
struct MoeItem { const float* src; bf16_t* dst; int N, kmax, ldk, k0, n0, drow0; };
__device__ __forceinline__ MoeItem moe_item(KP P, unsigned char* ws, int layer, int it) {
    const int e = it / 768, r = it % 768, m = r >> 8, q = r & 255; const size_t so = ((size_t)layer * NE + e) * (size_t)D * EHID; MoeItem I;
    if (m < 2) { const int kb = q >> 4, n0 = (q & 15) * 32;
        I.src = (m == 0 ? P->in[I_MWG] : P->in[I_MWU]) + so; I.N = EHID; I.kmax = D; I.dst = (bf16_t*)(ws + WS_WGU) + (size_t)e * D * D; I.ldk = D; I.k0 = kb * 64; I.n0 = n0; I.drow0 = 256 * (n0 >> 7) + (n0 & 127) + (m == 1 ? 128 : 0); }
    else { const int kb = q >> 5, n0 = (q & 31) * 32;
        I.src = P->in[I_MWD] + so; I.N = D; I.kmax = EHID; I.dst = (bf16_t*)(ws + WS_WD) + (size_t)e * D * EHID; I.ldk = EHID; I.k0 = kb * 64; I.n0 = n0; I.drow0 = n0; }
    return I;
}
__device__ __forceinline__ void tr_load(const MoeItem& I, int lane, f32x4 (&v)[8]) {
    const int n4 = lane & 7, kr = lane >> 3;
#pragma unroll
    for (int i = 0; i < 8; ++i) v[i] = *(const f32x4*)(I.src + (size_t)(I.k0 + 8 * i + kr) * I.N + I.n0 + 4 * n4);
}
__device__ __forceinline__ void tr_store(const MoeItem& I, int lane, const f32x4 (&v)[8], LAS float* scr) {
    const int n4 = lane & 7, kr = lane >> 3;
#pragma unroll
    for (int i = 0; i < 8; ++i) *(LAS f32x4*)(scr + (8 * i + kr) * TRP + 4 * n4) = v[i];
    asm volatile("s_waitcnt lgkmcnt(0)" ::: "memory");
    const int c = lane & 7;
#pragma unroll
    for (int j = 0; j < 4; ++j) { const int n = (lane >> 3) + 8 * j; const LAS float* sp = scr + (8 * c) * TRP + n;
        u32x4 o; o.x = cvt_pk_bf16(sp[0 * TRP], sp[1 * TRP]); o.y = cvt_pk_bf16(sp[2 * TRP], sp[3 * TRP]); o.z = cvt_pk_bf16(sp[4 * TRP], sp[5 * TRP]); o.w = cvt_pk_bf16(sp[6 * TRP], sp[7 * TRP]);
        *(u32x4*)(I.dst + (size_t)(I.drow0 + n) * I.ldk + I.k0 + 8 * c) = o; }
    asm volatile("s_waitcnt lgkmcnt(0)" ::: "memory");
}
constexpr int MOE_ITEMS = NE * 768, MOE_SPLIT = 14336, MOE_RKV = 6144;
__device__ __forceinline__ void moe_weights_phase(const Frame& F, KP P, int layer, int vgw, int vngw, int it0, int it1) {
    unsigned char* ws = P->ws; LAS float* scr = (LAS float*)(F.lds + F.wave * TR_SCR);
    int it = it0 + vgw; f32x4 v[8], vn[8];
    if (it < it1) { const MoeItem I = moe_item(P, ws, layer, it); tr_load(I, F.lane, v); }
#pragma nounroll
    while (it < it1) { const int nx = it + vngw;
        if (nx < it1) { const MoeItem In = moe_item(P, ws, layer, nx); tr_load(In, F.lane, vn); }
        { const MoeItem I = moe_item(P, ws, layer, it); tr_store(I, F.lane, v, scr); }
#pragma unroll
        for (int i = 0; i < 8; ++i) v[i] = vn[i];
        it = nx; }
}

__device__ __forceinline__ void load_xrow(KP P, const Frame& F, int layer, int row, f32x4 (&v)[4]) {
    if (layer == 0) { const float* xr = row < TL ? P->in[I_X] + (size_t)row * D : P->in[I_CTX] + (size_t)(row - TL) * D;
#pragma unroll
        for (int j = 0; j < 4; ++j) v[j] = *(const f32x4*)(xr + 4 * F.lane + 256 * j); }
    else { const bf16_t* xr = (const bf16_t*)(P->ws + WS_X) + (size_t)row * D;
#pragma unroll
        for (int j = 0; j < 4; ++j) { const u32x2 w = *(const u32x2*)(xr + 4 * F.lane + 256 * j); v[j] = (f32x4){bf_lo(w.x), bf_hi(w.x), bf_lo(w.y), bf_hi(w.y)}; } }
}
__device__ __forceinline__ void load_combine(KP P, const Frame& F, int layer, int row, int m, bool combine, f32x4 (&v)[4]) {
    load_xrow(P, F, layer, row, v);
    if (combine) {
        const bf16_t* yb = (const bf16_t*)(P->ws + WS_YB); const float* wg = (const float*)(P->ws + WS_WGT);
        const float w0 = wg[2 * row], w1 = wg[2 * row + 1]; const float* g2 = (const float*)(P->ws + WS_MOD) + ((size_t)(layer - 1) * 3 + m) * 6 * D + 5 * D;
#pragma unroll
        for (int j = 0; j < 4; ++j) { const int col = 4 * F.lane + 256 * j; const u32x2 a = *(const u32x2*)(yb + (size_t)(2 * row) * D + col), b = *(const u32x2*)(yb + (size_t)(2 * row + 1) * D + col);
            const f32x4 g = *(const f32x4*)(g2 + col);
            v[j][0] += g[0] * (w0 * bf_lo(a.x) + w1 * bf_lo(b.x)); v[j][1] += g[1] * (w0 * bf_hi(a.x) + w1 * bf_hi(b.x));
            v[j][2] += g[2] * (w0 * bf_lo(a.y) + w1 * bf_lo(b.y)); v[j][3] += g[3] * (w0 * bf_hi(a.y) + w1 * bf_hi(b.y)); }
    }
}
__device__ __forceinline__ void norm1_phase(const Frame& F, KP P, int layer) {
    const bool combine = layer > 0; bf16_t* X = (bf16_t*)(P->ws + WS_X); bf16_t* HL = (bf16_t*)(P->ws + WS_HL);
    const float* g1 = P->in[I_N1G] + (size_t)layer * D;
    for (int row = F.gw; row < T; row += F.NGW) {
        const int m = row < TL ? (row >> 14) : 2; f32x4 v[4];
        load_combine(P, F, layer, row, m, combine, v);
        {
#pragma unroll
            for (int j = 0; j < 4; ++j) { u32x2 o; o.x = cvt_pk_bf16(v[j][0], v[j][1]); o.y = cvt_pk_bf16(v[j][2], v[j][3]); *(u32x2*)(X + (size_t)row * D + 4 * F.lane + 256 * j) = o;
                v[j] = (f32x4){bf_lo(o.x), bf_hi(o.x), bf_lo(o.y), bf_hi(o.y)}; } }
        float ss = 0.f;
#pragma unroll
        for (int j = 0; j < 4; ++j) ss += (v[j][0] * v[j][0] + v[j][1] * v[j][1]) + (v[j][2] * v[j][2] + v[j][3] * v[j][3]);
        const float rstd = rsqrtf(wave_sum(ss, F.lane) * (1.0f / D) + 1e-6f);
        const float* mod = (const float*)(P->ws + WS_MOD) + ((size_t)layer * 3 + m) * 6 * D;
#pragma unroll
        for (int j = 0; j < 4; ++j) { const int col = 4 * F.lane + 256 * j; const f32x4 g = *(const f32x4*)(g1 + col), sh = *(const f32x4*)(mod + col), sc = *(const f32x4*)(mod + D + col);
            const f32x4 h = (v[j] * rstd) * g * (sc + 1.0f) + sh;
            u32x2 o; o.x = cvt_pk_bf16(h[0], h[1]); o.y = cvt_pk_bf16(h[2], h[3]); *(u32x2*)(HL + (size_t)row * D + col) = o; }
    }
}
__device__ __forceinline__ void final_phase(const Frame& F, KP P) {
    const float* fg = P->in[I_FG];
    for (int row = F.gw; row < TL; row += F.NGW) {
        const int m = row >> 14; f32x4 v[4];
        load_combine(P, F, DEPTH, row, m, true, v);
        float ss = 0.f;
#pragma unroll
        for (int j = 0; j < 4; ++j) ss += (v[j][0] * v[j][0] + v[j][1] * v[j][1]) + (v[j][2] * v[j][2] + v[j][3] * v[j][3]);
        const float rstd = rsqrtf(wave_sum(ss, F.lane) * (1.0f / D) + 1e-6f);
#pragma unroll
        for (int j = 0; j < 4; ++j) { const int col = 4 * F.lane + 256 * j; *(f32x4*)(P->out + (size_t)row * D + col) = (v[j] * rstd) * *(const f32x4*)(fg + col); }
    }
}
__device__ __forceinline__ void norm2_phase(const Frame& F, KP P, int layer) {
    const int ntok = layer == DEPTH - 1 ? TL : T; bf16_t* HL2 = (bf16_t*)(P->ws + WS_HL); const float* g2n = P->in[I_N2G] + (size_t)layer * D;
    for (int row = F.gw; row < ntok; row += F.NGW) {
        const int m = row < TL ? (row >> 14) : 2; f32x4 v[4]; load_xrow(P, F, 1, row, v);
        float ss = 0.f;
#pragma unroll
        for (int j = 0; j < 4; ++j) ss += (v[j][0] * v[j][0] + v[j][1] * v[j][1]) + (v[j][2] * v[j][2] + v[j][3] * v[j][3]);
        const float rstd = rsqrtf(wave_sum(ss, F.lane) * (1.0f / D) + 1e-6f);
        const float* mod = (const float*)(P->ws + WS_MOD) + ((size_t)layer * 3 + m) * 6 * D;
#pragma unroll
        for (int j = 0; j < 4; ++j) { const int col = 4 * F.lane + 256 * j; const f32x4 g = *(const f32x4*)(g2n + col), sh = *(const f32x4*)(mod + 3 * D + col), sc = *(const f32x4*)(mod + 4 * D + col);
            const f32x4 h = (v[j] * rstd) * g * (sc + 1.0f) + sh;
            u32x2 o; o.x = cvt_pk_bf16(h[0], h[1]); o.y = cvt_pk_bf16(h[2], h[3]); *(u32x2*)(HL2 + (size_t)row * D + col) = o; }
    }
    if (!(layer & 1)) moe_weights_phase(F, P, layer, F.gw, F.NGW, 0, MOE_SPLIT);
}
__device__ __forceinline__ void route_phase(const Frame& F, KP P, int layer) {
    const int ntok = layer == DEPTH - 1 ? TL : T; const float* LG = (const float*)(P->ws + WS_LG);
    const float* bgrp = P->in[I_MBGRP] + layer * 4; const float* bexp = P->in[I_MBEXP] + layer * NE;
    unsigned* cnt = (unsigned*)(P->ws + WS_CTL) + CW_CNT + layer * 64; int* list = (int*)(P->ws + WS_LIST); float* wgt = (float*)(P->ws + WS_WGT);
    LAS unsigned* lcnt = (LAS unsigned*)F.lds; LAS unsigned* lbase = lcnt + 32;
    for (int r0 = blockIdx.x * NTHR; r0 < ntok; r0 += F.G * NTHR) {
        const int row = r0 + F.tid; const bool act = row < ntok;
        __syncthreads();
        if (F.tid < 32) lcnt[F.tid] = 0u;
        __syncthreads();
        int e0 = 0, e1 = 0; unsigned k0 = 0, k1 = 0;
        if (act) {
            const float* lg = LG + (size_t)row * 64; const f32x4 g4 = *(const f32x4*)lg;
            float ag[4];
#pragma unroll
            for (int i = 0; i < 4; ++i) ag[i] = g4[i] + bgrp[i];
            int grp = 0; float mx = ag[0];
#pragma unroll
            for (int i = 1; i < 4; ++i) if (ag[i] > mx) { mx = ag[i]; grp = i; }
            float den = 0.f;
#pragma unroll
            for (int i = 0; i < 4; ++i) den += __expf(ag[i] - mx);
            const float pg = 1.0f / den;
            const f32x4 e0v = *(const f32x4*)(lg + 4 + 8 * grp), e1v = *(const f32x4*)(lg + 8 + 8 * grp); const f32x4 b0v = *(const f32x4*)(bexp + 8 * grp), b1v = *(const f32x4*)(bexp + 8 * grp + 4);
            float el[8];
#pragma unroll
            for (int i = 0; i < 4; ++i) { el[i] = e0v[i] + b0v[i]; el[4 + i] = e1v[i] + b1v[i]; }
            int i0 = 0; float t0 = el[0];
#pragma unroll
            for (int i = 1; i < 8; ++i) if (el[i] > t0) { t0 = el[i]; i0 = i; }
            int i1 = -1; float t1 = -3.0e38f;
#pragma unroll
            for (int i = 0; i < 8; ++i) if (i != i0 && el[i] > t1) { t1 = el[i]; i1 = i; }
            const float p0 = 1.0f / (1.0f + __expf(t1 - t0));
            wgt[2 * row] = pg * p0; wgt[2 * row + 1] = pg * (1.0f - p0);
            e0 = grp * 8 + i0; e1 = grp * 8 + i1;
            k0 = atomicAdd((unsigned*)(lcnt + e0), 1u); k1 = atomicAdd((unsigned*)(lcnt + e1), 1u);
        }
        __syncthreads();
        if (F.tid < 32) { const unsigned c = lcnt[F.tid]; lbase[F.tid] = c ? atomicAdd(cnt + F.tid, c) : 0u; }
        __syncthreads();
        if (act) { list[(size_t)e0 * LISTCAP + lbase[e0] + k0] = 2 * row; list[(size_t)e1 * LISTCAP + lbase[e1] + k1] = 2 * row + 1; }
    }
}
__device__ __forceinline__ bf16x8 tr_frag136(const LAS bf16_t* M, int k0, int c0, int lane) {
    LAS bf16_t* p = (LAS bf16_t*)M + (k0 + 8 * (lane >> 4) + ((lane & 15) >> 2)) * 136 + c0 + 4 * (lane & 3);
    const v4s lo = __builtin_amdgcn_ds_read_tr16_b64_v4i16((LAS v4s*)p), hi = __builtin_amdgcn_ds_read_tr16_b64_v4i16((LAS v4s*)(p + 4 * 136));
    return (bf16x8){lo[0], lo[1], lo[2], lo[3], hi[0], hi[1], hi[2], hi[3]};
}
__device__ __forceinline__ bf16x8 tr_frag136p(const LAS bf16_t* M, int k0, int dt, int lane) {
    LAS bf16_t* p = (LAS bf16_t*)M + (k0 + 8 * (lane >> 4) + ((lane & 15) >> 2)) * 136 + 32 * (dt >> 1) + 8 * (lane & 3) + 4 * (dt & 1);
    const v4s lo = __builtin_amdgcn_ds_read_tr16_b64_v4i16((LAS v4s*)p), hi = __builtin_amdgcn_ds_read_tr16_b64_v4i16((LAS v4s*)(p + 4 * 136));
    return (bf16x8){lo[0], lo[1], lo[2], lo[3], hi[0], hi[1], hi[2], hi[3]};
}
__device__ __forceinline__ void spatial_phase(const Frame& F, KP P, int j) {
    bf16_t* U = (bf16_t*)(P->ws + WS_U); const bf16_t* V = (const bf16_t*)(P->ws + WS_V); const float* stat = (const float*)(P->ws + WS_STAT);
    const bf16_t* WSP = (const bf16_t*)(P->ws + WS_WSP) + (size_t)j * 16 * 128 * 128;
    const float* lng = P->in[I_GLNG] + (size_t)j * GWID; const float* lnb = P->in[I_GLNB] + (size_t)j * GWID; const float* bs = P->in[I_GBS] + (size_t)j * 16 * 128;
    LAS bf16_t* Wt = (LAS bf16_t*)F.lds; LAS bf16_t* Vn = Wt + 128 * 136;
    LAS float* mu = (LAS float*)(F.lds + 2 * 128 * 136 * 2); LAS float* rs = mu + 128;
    const int l15 = F.lane & 15, l4 = F.lane >> 4;
    constexpr int NUNIT = (T / 128) * 16;
    const int u0 = (int)((long)blockIdx.x * NUNIT / F.G), u1 = (int)((long)(blockIdx.x + 1) * NUNIT / F.G);
#define SP_LOAD(W_, V_, U_, t0_, g_) do { \
        _Pragma("unroll") for (int i = 0; i < 4; ++i) { const int idx = F.tid + NTHR * i, r = idx >> 4, seg = idx & 15; \
            W_[i] = *(const u32x4*)(WSP + ((size_t)(g_) * 128 + r) * 128 + seg * 8); V_[i] = *(const u32x4*)(V + (size_t)((t0_) + r) * GWID + (g_) * 128 + seg * 8); } \
        { const bf16_t* ur_ = U + (size_t)((t0_) + 16 * F.wave + l15) * GWID + (g_) * 128 + 8 * l4; \
          _Pragma("unroll") for (int e = 0; e < 4; ++e) U_[e] = *(const u32x4*)(ur_ + e * 32); } } while (0)
    u32x4 wv[4], vv[4], uu[4];
    if (u0 < u1) SP_LOAD(wv, vv, uu, (u0 >> 4) * 128, u0 & 15);
    int cprev = -1;
#pragma nounroll
    for (int u = u0; u < u1; ++u) { const int c = u >> 4, g = u & 15, t0 = c * 128;
        if (c != cprev) { cprev = c;
            if (F.tid < 128) { const int row = t0 + F.tid; float s = 0.f, q = 0.f;
#pragma unroll 8
                for (int i = 0; i < 32; ++i) { const f32x2 p = *(const f32x2*)(stat + ((size_t)row * 32 + i) * 2); s += p.x; q += p.y; }
                const float mean = s * (1.0f / GWID), var = q * (1.0f / GWID) - mean * mean; mu[F.tid] = mean; rs[F.tid] = rsqrtf(var + 1e-5f); } }
        LDS_BARRIER();
#pragma unroll
        for (int i = 0; i < 4; ++i) { const int idx = F.tid + NTHR * i, r = idx >> 4, seg = idx & 15, ch = g * 128 + seg * 8;
            *(LAS u32x4*)(Wt + r * 136 + seg * 8) = wv[i];
            float x[8], o[8]; unpack8(vv[i], x); const float m_ = mu[r], r_ = rs[r];
            const f32x4 g0 = *(const f32x4*)(lng + ch), g1 = *(const f32x4*)(lng + ch + 4), b0 = *(const f32x4*)(lnb + ch), b1 = *(const f32x4*)(lnb + ch + 4);
#pragma unroll
            for (int e = 0; e < 8; ++e) o[e] = (x[e] - m_) * r_ * (e < 4 ? g0[e & 3] : g1[e & 3]) + (e < 4 ? b0[e & 3] : b1[e & 3]);
            *(LAS u32x4*)(Vn + r * 136 + seg * 8) = pack8(o); }
        u32x4 wn[4], vn[4], un[4];
        if (u + 1 < u1) SP_LOAD(wn, vn, un, ((u + 1) >> 4) * 128, (u + 1) & 15);
        LDS_BARRIER();
        bf16x8 bw[4];
#pragma unroll
        for (int ks = 0; ks < 4; ++ks) bw[ks] = *(const LAS bf16x8*)(Wt + (16 * F.wave + l15) * 136 + ks * 32 + 8 * l4);
        const int p = 16 * F.wave + l15; const float bias = bs[g * 128 + p];
        bf16_t* urow = U + (size_t)(t0 + p) * GWID + g * 128 + 8 * l4;
#pragma unroll
        for (int e = 0; e < 4; ++e) { f32x4 a0 = (f32x4){0.f, 0.f, 0.f, 0.f}, a1 = a0;
#pragma unroll
            for (int ks = 0; ks < 4; ++ks) { const bf16x8 f0 = tr_frag136p(Vn, 32 * ks, 2 * e, F.lane), f1 = tr_frag136p(Vn, 32 * ks, 2 * e + 1, F.lane);
                a0 = __builtin_amdgcn_mfma_f32_16x16x32_bf16(f0, bw[ks], a0, 0, 0, 0); a1 = __builtin_amdgcn_mfma_f32_16x16x32_bf16(f1, bw[ks], a1, 0, 0, 0); }
            u32x4 o; o.x = cvt_pk_bf16(bf_lo(uu[e].x) * (a0[0] + bias), bf_hi(uu[e].x) * (a0[1] + bias)); o.y = cvt_pk_bf16(bf_lo(uu[e].y) * (a0[2] + bias), bf_hi(uu[e].y) * (a0[3] + bias));
            o.z = cvt_pk_bf16(bf_lo(uu[e].z) * (a1[0] + bias), bf_hi(uu[e].z) * (a1[1] + bias)); o.w = cvt_pk_bf16(bf_lo(uu[e].w) * (a1[2] + bias), bf_hi(uu[e].w) * (a1[3] + bias));
            *(u32x4*)(urow + e * 32) = o; }
        if (u + 1 < u1) {
#pragma unroll
            for (int i = 0; i < 4; ++i) { wv[i] = wn[i]; vv[i] = vn[i]; uu[i] = un[i]; } }
    }
#undef SP_LOAD
}

__device__ __forceinline__ void mix_phase(const Frame& F, KP P, int j) {
    const bf16_t* HL = (const bf16_t*)(P->ws + WS_HL); const float* mu = P->in[I_MU] + (size_t)j * 6 * D;
    bf16_t* outs[6] = {(bf16_t*)(P->ws + WS_XR), (bf16_t*)(P->ws + WS_XW), (bf16_t*)(P->ws + WS_XK), (bf16_t*)(P->ws + WS_XV), (bf16_t*)(P->ws + WS_XA), (bf16_t*)(P->ws + WS_XG)};
    for (int row = F.gw; row < T; row += F.NGW) {
        bool ok[2]; int src[2]; const bool hi = F.lane >= 32;
        if (row < TL) { const int n = row & (SEQ - 1), gc = n & 63, gr = n >> 6;
            ok[0] = hi ? gc < 63 : gc > 0; src[0] = hi ? row + 1 : row - 1; ok[1] = hi ? gr < 255 : gr > 0; src[1] = hi ? row + 64 : row - 64; }
        else { const int n = (row - TL) & (CTXL - 1); ok[0] = n > 0; src[0] = row - 1; ok[1] = n < CTXL - 1; src[1] = row + 1; }
#pragma unroll
        for (int jj = 0; jj < 2; ++jj) { const int col = 512 * jj + 8 * F.lane;
            const u32x4 h8 = *(const u32x4*)(HL + (size_t)row * D + col); u32x4 s8 = (u32x4){0u, 0u, 0u, 0u};
            if (ok[jj]) s8 = *(const u32x4*)(HL + (size_t)src[jj] * D + col);
            const unsigned hw[4] = {h8.x, h8.y, h8.z, h8.w}, sw[4] = {s8.x, s8.y, s8.z, s8.w}; float h[8], xx[8];
#pragma unroll
            for (int e = 0; e < 8; ++e) { h[e] = (e & 1) ? bf_hi(hw[e >> 1]) : bf_lo(hw[e >> 1]); const float s = (e & 1) ? bf_hi(sw[e >> 1]) : bf_lo(sw[e >> 1]); xx[e] = s - h[e]; }
#pragma unroll
            for (int m = 0; m < 6; ++m) { const f32x4 ma = *(const f32x4*)(mu + (size_t)m * D + col), mb = *(const f32x4*)(mu + (size_t)m * D + col + 4);
                u32x4 o; o.x = cvt_pk_bf16(h[0] + xx[0] * ma[0], h[1] + xx[1] * ma[1]); o.y = cvt_pk_bf16(h[2] + xx[2] * ma[2], h[3] + xx[3] * ma[3]);
                o.z = cvt_pk_bf16(h[4] + xx[4] * mb[0], h[5] + xx[5] * mb[1]); o.w = cvt_pk_bf16(h[6] + xx[6] * mb[2], h[7] + xx[7] * mb[3]);
                *(u32x4*)(outs[m] + (size_t)row * D + col) = o; } }
    }
}

constexpr int NCH = 5, SCP = NCH * 64, NSC = (SEQ + CTXL) / SCP, NSCAN = 64, TP = 72, TILE_B = 64 * TP * 2;
static_assert(NSC * SCP == SEQ + CTXL, "super-chunks");
enum { T_AT = 0, T_RT, T_BT, T_KT, T_VM, T_NT, T_MT, T_NRT, T_MRT, T_APA, T_APB, T_TAA, T_TAB, T_PRB, T_QRB, T_NTILE };
constexpr int LDS_GL = T_NTILE * TILE_B, LDS_SEG = LDS_GL + 256;
static_assert(LDS_SEG + 2048 <= LDS_MISC, "scan LDS map");
__device__ __forceinline__ int scan_row(int z, int b, int p) {
    if (p < CTXL) return TL + b * CTXL + (z ? CTXL - 1 - p : p);
    const int q = p - CTXL; return b * SEQ + (z ? SEQ - 1 - q : q);
}
__device__ __forceinline__ LAS bf16_t* stile(LAS unsigned char* lds, int n) { return (LAS bf16_t*)(lds + n * TILE_B); }
__device__ __forceinline__ bf16x8 row_frag(const LAS bf16_t* M, int r0, int k0, int lane) { return *(const LAS bf16x8*)(M + (r0 + (lane & 15)) * TP + k0 + 8 * (lane >> 4)); }
__device__ __forceinline__ bf16x8 tr_frag(const LAS bf16_t* M, int k0, int c0, int lane) {
    LAS bf16_t* p = (LAS bf16_t*)M + (k0 + 8 * (lane >> 4) + ((lane & 15) >> 2)) * TP + c0 + 4 * (lane & 3);
    const v4s lo = __builtin_amdgcn_ds_read_tr16_b64_v4i16((LAS v4s*)p), hi = __builtin_amdgcn_ds_read_tr16_b64_v4i16((LAS v4s*)(p + 4 * TP));
    return (bf16x8){lo[0], lo[1], lo[2], lo[3], hi[0], hi[1], hi[2], hi[3]};
}
template <bool XT, bool YT>
__device__ __forceinline__ void mm64(const LAS bf16_t* X, const LAS bf16_t* Y, f32x4 (&acc)[2], int wq, int wh, int lane) {
#pragma unroll
    for (int ks = 0; ks < 2; ++ks) {
        const bf16x8 b = XT ? tr_frag(X, 32 * ks, 16 * wq, lane) : row_frag(X, 16 * wq, 32 * ks, lane);
#pragma unroll
        for (int q = 0; q < 2; ++q) { const int i0 = 16 * (2 * wh + q);
            const bf16x8 a = YT ? row_frag(Y, i0, 32 * ks, lane) : tr_frag(Y, 32 * ks, i0, lane);
            acc[q] = __builtin_amdgcn_mfma_f32_16x16x32_bf16(a, b, acc[q], 0, 0, 0); }
    }
}
__device__ __forceinline__ void st_tile(LAS bf16_t* Z, const f32x4 (&acc)[2], int wq, int wh, int lane) {
#pragma unroll
    for (int q = 0; q < 2; ++q) { u32x2 o; o.x = cvt_pk_bf16(acc[q][0], acc[q][1]); o.y = cvt_pk_bf16(acc[q][2], acc[q][3]);
        *(LAS u32x2*)(Z + (16 * wq + (lane & 15)) * TP + 16 * (2 * wh + q) + 4 * (lane >> 4)) = o; }
}
__device__ __forceinline__ void ld_tile(const LAS bf16_t* Z, f32x4 (&acc)[2], int wq, int wh, int lane) {
#pragma unroll
    for (int q = 0; q < 2; ++q) { const u32x2 o = *(const LAS u32x2*)(Z + (16 * wq + (lane & 15)) * TP + 16 * (2 * wh + q) + 4 * (lane >> 4));
        acc[q] = (f32x4){bf_lo(o.x), bf_hi(o.x), bf_lo(o.y), bf_hi(o.y)}; }
}
__device__ __forceinline__ f32x4 prod16(const LAS bf16_t* X, int xr, int xc, const LAS bf16_t* Y, int yr, int yc, f32x4 acc, int lane) {
    bf16x8 b = *(const LAS bf16x8*)(X + (xr + (lane & 15)) * TP + xc + 8 * (lane >> 4)); bf16x8 a = tr_frag(Y, yr, yc, lane);
    if ((lane >> 4) >= 2) { b = (bf16x8){0, 0, 0, 0, 0, 0, 0, 0}; a = (bf16x8){0, 0, 0, 0, 0, 0, 0, 0}; }
    return __builtin_amdgcn_mfma_f32_16x16x32_bf16(a, b, acc, 0, 0, 0);
}
__device__ __forceinline__ void st16(LAS bf16_t* Z, int zr, int zc, f32x4 acc, int lane) { u32x2 o; o.x = cvt_pk_bf16(acc[0], acc[1]); o.y = cvt_pk_bf16(acc[2], acc[3]); *(LAS u32x2*)(Z + (zr + (lane & 15)) * TP + zc + 4 * (lane >> 4)) = o; }
__device__ __forceinline__ f32x4 ld16(const LAS bf16_t* Z, int zr, int zc, int lane) { const u32x2 o = *(const LAS u32x2*)(Z + (zr + (lane & 15)) * TP + zc + 4 * (lane >> 4)); return (f32x4){bf_lo(o.x), bf_hi(o.x), bf_lo(o.y), bf_hi(o.y)}; }
struct ChunkRegs { u32x4 r, k, v, tw, ta; };
__device__ __forceinline__ void scan_load(KP P, const Frame& F, int item, int c4, ChunkRegs& R) {
    const int s = item & 63, sc = item >> 6, z = s >> 5, b = (s >> 4) & 1, hh = s & 15;
    const size_t row = (size_t)scan_row(z, b, sc * SCP + c4 * 64 + (F.tid >> 3)); const size_t o = row * D + hh * 64 + (F.tid & 7) * 8, o2 = row * 256 + z * 64 + (F.tid & 7) * 8;
    R.r = *(const u32x4*)((const bf16_t*)(P->ws + WS_R) + o); R.k = *(const u32x4*)((const bf16_t*)(P->ws + WS_K) + o); R.v = *(const u32x4*)((const bf16_t*)(P->ws + WS_VV) + o);
    R.tw = *(const u32x4*)((const bf16_t*)(P->ws + WS_TW) + o2); R.ta = *(const u32x4*)((const bf16_t*)(P->ws + WS_TA) + o2);
}
__device__ __forceinline__ void scan_chunk_phase(const Frame& F, KP P, int j) {
    LAS unsigned char* lds = F.lds;
    LAS bf16_t* At = stile(lds, T_AT); LAS bf16_t* Rt = stile(lds, T_RT); LAS bf16_t* Bt = stile(lds, T_BT); LAS bf16_t* Kt = stile(lds, T_KT); LAS bf16_t* Vm = stile(lds, T_VM);
    LAS bf16_t* NT = stile(lds, T_NT); LAS bf16_t* MT = stile(lds, T_MT); LAS bf16_t* NrT = stile(lds, T_NRT); LAS bf16_t* MrT = stile(lds, T_MRT);
    LAS bf16_t* ApA = stile(lds, T_APA); LAS bf16_t* ApB = stile(lds, T_APB); LAS bf16_t* TaA = stile(lds, T_TAA); LAS bf16_t* TaB = stile(lds, T_TAB);
    LAS bf16_t* PrB = stile(lds, T_PRB); LAS bf16_t* QrB = stile(lds, T_QRB);
    LAS float* gl = (LAS float*)(lds + LDS_GL); LAS float* seg = (LAS float*)(lds + LDS_SEG);
    const int lane = F.lane, wq = F.wave & 3, wh = F.wave >> 2, l15 = lane & 15, l4 = lane >> 4;
    const int pi = F.tid >> 3, kq = F.tid & 7;
    const int jrow = 16 * wq + l15;
    const int NITEM = NSCAN * NSC;
    int item = blockIdx.x; if (item >= NITEM) return;
    ChunkRegs cur, nxt; scan_load(P, F, item, 0, cur); nxt = cur;
    f32x4 Pr[2], Qr[2], aYp[2], aQp[2];
#pragma unroll
    for (int q = 0; q < 2; ++q) { Pr[q] = (f32x4){0.f, 0.f, 0.f, 0.f}; Qr[q] = Pr[q]; aYp[q] = Pr[q]; aQp[q] = Pr[q]; }
    bool pend = false; size_t orowp = 0; bf16_t* GEp = nullptr; bf16_t* YEp = nullptr; float* pqp = nullptr; bool lastp = false;
#define SCAN_STAGE_G() do { \
        f32x4 ge[2] = {(f32x4){0.f, 0.f, 0.f, 0.f}, (f32x4){0.f, 0.f, 0.f, 0.f}}; \
        mm64<false, true>(NT, PrB, ge, wq, wh, lane); mm64<false, true>(NT, QrB, aYp, wq, wh, lane); \
        f32x4 pn[2] = {(f32x4){0.f, 0.f, 0.f, 0.f}, (f32x4){0.f, 0.f, 0.f, 0.f}}; \
        mm64<false, false>(PrB, MT, pn, wq, wh, lane); mm64<false, false>(QrB, MT, aQp, wq, wh, lane); \
        _Pragma("unroll") for (int q = 0; q < 2; ++q) { const int i0 = 16 * (2 * wh + q) + 4 * l4; \
            u32x2 o; o.x = cvt_pk_bf16(ge[q][0], ge[q][1]); o.y = cvt_pk_bf16(ge[q][2], ge[q][3]); *(u32x2*)(GEp + orowp + i0) = o; \
            u32x2 y; y.x = cvt_pk_bf16(aYp[q][0], aYp[q][1]); y.y = cvt_pk_bf16(aYp[q][2], aYp[q][3]); *(u32x2*)(YEp + orowp + i0) = y; \
            Pr[q] = pn[q]; Qr[q] = aQp[q]; } \
        if (lastp) { const int ln_ = lane_id_now(), l15_ = ln_ & 15, l4_ = ln_ >> 4;   \
            float* pP_ = pqp + ((l15_ & 3) * 4 + (l15_ >> 2)) * 64 + wq * 16 + 8 * wh + l4_; float* pQ_ = pqp + 4096 + (wq * 16 + l4_) * 64 + 32 * wh + l15_; \
            _Pragma("unroll") for (int q = 0; q < 2; ++q)   \
            _Pragma("unroll") for (int r = 0; r < 4; ++r) { pP_[r * 1024 + 4 * q] = Pr[q][r]; pQ_[r * 256 + 16 * q] = Qr[q][r]; } } \
    } while (0)
    for (;;) {
        const int s = item & 63, sc = item >> 6, z = s >> 5, b = (s >> 4) & 1, hh = s & 15;
        const float* kkw = P->in[I_KK] + (size_t)j * D + hh * 64 + kq * 8; const float* kap = P->in[I_KA] + (size_t)j * D + hh * 64 + kq * 8; const float* rkp = P->in[I_RK] + (size_t)j * D + hh * 64 + kq * 8;
        const float* w0p = P->in[I_W0] + ((size_t)j * 2 + z) * D + hh * 64; const float* a0p = P->in[I_A0] + ((size_t)j * 2 + z) * D + hh * 64;
        float* bon = (float*)(P->ws + WS_BON) + (size_t)z * T * 16;
        const u32x4 w2r = *(const u32x4*)((const bf16_t*)(P->ws + WS_W2P) + (((size_t)j * 2 + z) * D + hh * 64 + pi) * 256 + z * 64 + kq * 8);
        const u32x4 a2r = *(const u32x4*)((const bf16_t*)(P->ws + WS_A2P) + (((size_t)j * 2 + z) * D + hh * 64 + pi) * 256 + z * 64 + kq * 8);
        bf16_t* GE = (bf16_t*)(P->ws + (z ? WS_AS1 : WS_AS0)); bf16_t* YE = (bf16_t*)(P->ws + (z ? WS_ELOG1 : WS_ELOG0));
        float* pq = (float*)(P->ws + WS_PQ) + ((size_t)(s * NSC + sc) * 2) * 4096;
#pragma nounroll
        for (int c4 = 0; c4 < NCH; ++c4) {
            unsigned long long ch_t[12]; ch_t[11] = CH_AMP >= 0 ? __builtin_amdgcn_s_memrealtime() : 0ull;
            *(LAS u32x4*)(ApA + pi * TP + kq * 8) = cur.tw; *(LAS u32x4*)(ApB + pi * TP + kq * 8) = cur.ta; *(LAS u32x4*)(NrT + pi * TP + kq * 8) = w2r; *(LAS u32x4*)(MrT + pi * TP + kq * 8) = a2r;
            LDS_BARRIER(); CH_STAMP(0);
            {   f32x4 lw[2] = {(f32x4){0.f, 0.f, 0.f, 0.f}, (f32x4){0.f, 0.f, 0.f, 0.f}}, la[2] = {(f32x4){0.f, 0.f, 0.f, 0.f}, (f32x4){0.f, 0.f, 0.f, 0.f}};
                mm64<false, true>(ApA, NrT, lw, wq, wh, lane); mm64<false, true>(ApB, MrT, la, wq, wh, lane);
#pragma unroll
                for (int q = 0; q < 2; ++q) { const int i0 = 16 * (2 * wh + q) + 4 * l4; const f32x4 w04 = *(const f32x4*)(w0p + i0), a04 = *(const f32x4*)(a0p + i0);
#pragma unroll
                    for (int r = 0; r < 4; ++r) { lw[q][r] = -0.60653065971f * sigmoidf_(w04[r] + lw[q][r]); la[q][r] = sigmoidf_(a04[r] + la[q][r]); } }
                st_tile(TaA, lw, wq, wh, lane); st_tile(TaB, la, wq, wh, lane); }
            LDS_BARRIER(); CH_STAMP(1);
            float r8[8], k8[8], e8[8], m8[8], a8[8], kk8[8], c8[8];
            { const u32x4 et = *(const LAS u32x4*)(TaA + pi * TP + kq * 8), at = *(const LAS u32x4*)(TaB + pi * TP + kq * 8); unpack8(cur.r, r8); unpack8(cur.k, k8); unpack8(et, e8); unpack8(at, a8); }
            {   const f32x4 ka0 = *(const f32x4*)(kap), ka1 = *(const f32x4*)(kap + 4), rk0 = *(const f32x4*)(rkp), rk1 = *(const f32x4*)(rkp + 4); float bp = 0.f;
#pragma unroll
                for (int e = 0; e < 8; ++e) { m8[e] = k8[e] * (1.0f + (a8[e] - 1.0f) * (e < 4 ? ka0[e & 3] : ka1[e & 3])); bp += r8[e] * (e < 4 ? rk0[e & 3] : rk1[e & 3]) * m8[e]; }
                bp += shx(bp, 1, lane); bp += shx(bp, 2, lane); bp += shx(bp, 4, lane);
                if (kq == 0) bon[(size_t)scan_row(z, b, sc * SCP + c4 * 64 + pi) * 16 + hh] = bp; }
            { const f32x4 w0 = *(const f32x4*)kkw, w1 = *(const f32x4*)(kkw + 4); float ss = 0.f;
#pragma unroll
              for (int e = 0; e < 8; ++e) { kk8[e] = k8[e] * (e < 4 ? w0[e & 3] : w1[e & 3]); ss += kk8[e] * kk8[e]; }
              ss += shx(ss, 1, lane); ss += shx(ss, 2, lane); ss += shx(ss, 4, lane);
              const float rn = rsqrtf(ss + 1e-12f);
#pragma unroll
              for (int e = 0; e < 8; ++e) { kk8[e] *= rn; c8[e] = e8[e]; } }
#pragma unroll
            for (int d = 8; d < 64; d <<= 1) {
#pragma unroll
                for (int e = 0; e < 8; ++e) { const float t = shup(c8[e], d, lane); c8[e] += lane >= d ? t : 0.f; } }
            if (lane >= 56) { *(LAS f32x4*)(seg + F.wave * 64 + kq * 8) = (f32x4){c8[0], c8[1], c8[2], c8[3]}; *(LAS f32x4*)(seg + F.wave * 64 + kq * 8 + 4) = (f32x4){c8[4], c8[5], c8[6], c8[7]}; }
            if (pend) { SCAN_STAGE_G(); pend = false; }
            LDS_BARRIER(); CH_STAMP(2);
            if (c4 > 0) { st_tile(PrB, Pr, wq, wh, lane); st_tile(QrB, Qr, wq, wh, lane); }
            { float cum[8];
#pragma unroll
              for (int e = 0; e < 8; ++e) cum[e] = c8[e];
              for (int w2 = 0; w2 < F.wave; ++w2) { const f32x4 o0 = *(const LAS f32x4*)(seg + w2 * 64 + kq * 8), o1 = *(const LAS f32x4*)(seg + w2 * 64 + kq * 8 + 4);
#pragma unroll
                  for (int e = 0; e < 8; ++e) cum[e] += e < 4 ? o0[e & 3] : o1[e & 3]; }
              float o[8];
#pragma unroll
              for (int e = 0; e < 8; ++e) o[e] = -kk8[e] * __expf(cum[e] - e8[e]);
              *(LAS u32x4*)(At + pi * TP + kq * 8) = pack8(o);
#pragma unroll
              for (int e = 0; e < 8; ++e) o[e] = r8[e] * __expf(cum[e]);
              *(LAS u32x4*)(Rt + pi * TP + kq * 8) = pack8(o);
              float en[8];
#pragma unroll
              for (int e = 0; e < 8; ++e) { en[e] = __expf(-cum[e]); o[e] = kk8[e] * a8[e] * en[e]; }
              *(LAS u32x4*)(Bt + pi * TP + kq * 8) = pack8(o);
#pragma unroll
              for (int e = 0; e < 8; ++e) o[e] = m8[e] * en[e];
              *(LAS u32x4*)(Kt + pi * TP + kq * 8) = pack8(o);
              *(LAS u32x4*)(Vm + pi * TP + kq * 8) = cur.v;
              if (pi == 63) {
#pragma unroll
                  for (int e = 0; e < 8; ++e) gl[kq * 8 + e] = __expf(cum[e]); } }
            { const int nitem = c4 < NCH - 1 ? item : item + (int)gridDim.x, nc4 = c4 < NCH - 1 ? c4 + 1 : 0; if (nitem < NITEM) scan_load(P, F, nitem, nc4, nxt); }
            LDS_BARRIER(); CH_STAMP(3);
            {   f32x4 aN[2], aM[2], aNr[2], aMr[2];
#pragma unroll
                for (int q = 0; q < 2; ++q) { aN[q] = (f32x4){0.f, 0.f, 0.f, 0.f}; aM[q] = aN[q]; aNr[q] = aN[q]; aMr[q] = aN[q]; }
                mm64<false, true>(At, Bt, aN, wq, wh, lane); mm64<false, true>(At, Kt, aM, wq, wh, lane); mm64<false, true>(Rt, Bt, aNr, wq, wh, lane); mm64<false, true>(Rt, Kt, aMr, wq, wh, lane);
                f32x4 aT[2];
#pragma unroll
                for (int q = 0; q < 2; ++q)
#pragma unroll
                    for (int r = 0; r < 4; ++r) { const int i = 16 * (2 * wh + q) + 4 * l4 + r; const bool lt = i < jrow, le = i <= jrow;
                        aN[q][r] = lt ? aN[q][r] : 0.f; aM[q][r] = lt ? aM[q][r] : 0.f; aNr[q][r] = le ? aNr[q][r] : 0.f; aMr[q][r] = le ? aMr[q][r] : 0.f; aT[q][r] = aN[q][r] + (i == jrow ? 1.f : 0.f); }
                st_tile(NT, aN, wq, wh, lane); st_tile(MT, aM, wq, wh, lane); st_tile(NrT, aNr, wq, wh, lane); st_tile(MrT, aMr, wq, wh, lane); st_tile(TaA, aT, wq, wh, lane);
            }
            LDS_BARRIER(); CH_STAMP(4);
            if (F.wave < 4) { const int o = 16 * F.wave, oc = 16 * ((F.wave + 1) & 3);
                f32x4 p = prod16(NT, o, o, NT, o, o, (f32x4){0.f, 0.f, 0.f, 0.f}, lane); st16(ApA, o, o, p, lane);
                f32x4 t = prod16(TaA, o, o, ApA, o, o, ld16(TaA, o, o, lane), lane); p = prod16(ApA, o, o, ApA, o, o, (f32x4){0.f, 0.f, 0.f, 0.f}, lane);
                st16(TaB, o, o, t, lane); st16(ApA, o, oc, p, lane);
                t = prod16(TaB, o, o, ApA, o, oc, ld16(TaB, o, o, lane), lane); p = prod16(ApA, o, oc, ApA, o, oc, (f32x4){0.f, 0.f, 0.f, 0.f}, lane);
                st16(TaA, o, o, t, lane); st16(ApA, o, o, p, lane);
                t = prod16(TaA, o, o, ApA, o, o, ld16(TaA, o, o, lane), lane); st16(TaB, o, o, t, lane);
#pragma unroll
                for (int jj = 1; jj < 4; ++jj) if (jj > F.wave) { u32x2 zz; asm volatile("v_mov_b32 %0, 0\n\tv_mov_b32 %1, 0" : "=v"(zz.x), "=v"(zz.y)); *(LAS u32x2*)(TaB + (o + l15) * TP + 16 * jj + 4 * l4) = zz; }
            } else { const int wq2 = F.wave - 4;
#pragma unroll
                for (int wh2 = 0; wh2 < 2; ++wh2) { f32x4 x[2] = {(f32x4){0.f, 0.f, 0.f, 0.f}, (f32x4){0.f, 0.f, 0.f, 0.f}}; mm64<true, true>(Vm, MT, x, wq2, wh2, lane); st_tile(ApB, x, wq2, wh2, lane); } }
            LDS_BARRIER(); CH_STAMP(5);
            if (F.wave < 3) { const int jj = F.wave;
#pragma unroll
                for (int i = 1; i < 4; ++i) if (i > jj) { f32x4 e = (f32x4){0.f, 0.f, 0.f, 0.f};
#pragma unroll
                    for (int m = 0; m < 3; ++m) if (m >= jj && m < i) e = prod16(NT, 16 * i, 16 * m, TaB, 16 * m, 16 * jj, e, lane);
                    st16(ApA, 16 * i, 16 * jj, e, lane);
                    st16(TaB, 16 * i, 16 * jj, prod16(TaB, 16 * i, 16 * i, ApA, 16 * i, 16 * jj, (f32x4){0.f, 0.f, 0.f, 0.f}, lane), lane); } }
            LDS_BARRIER(); CH_STAMP(6);
            {   f32x4 w[2] = {(f32x4){0.f, 0.f, 0.f, 0.f}, (f32x4){0.f, 0.f, 0.f, 0.f}}; mm64<true, true>(At, TaB, w, wq, wh, lane); st_tile(ApA, w, wq, wh, lane);
                f32x4 u[2] = {(f32x4){0.f, 0.f, 0.f, 0.f}, (f32x4){0.f, 0.f, 0.f, 0.f}}; mm64<false, true>(ApB, TaB, u, wq, wh, lane); st_tile(TaA, u, wq, wh, lane); }
            LDS_BARRIER(); CH_STAMP(7);
            f32x4 aP[2], aQ[2], aG[2], aY[2];
#pragma unroll
            for (int q = 0; q < 2; ++q) { aP[q] = (f32x4){0.f, 0.f, 0.f, 0.f}; aQ[q] = aP[q]; aG[q] = aP[q]; aY[q] = aP[q]; }
            mm64<false, false>(ApA, Bt, aP, wq, wh, lane);
            mm64<false, false>(TaA, Bt, aQ, wq, wh, lane); mm64<true, false>(Vm, Kt, aQ, wq, wh, lane);
            mm64<false, true>(NrT, ApA, aG, wq, wh, lane);
            mm64<false, true>(NrT, TaA, aY, wq, wh, lane); mm64<false, false>(MrT, Vm, aY, wq, wh, lane);
#pragma unroll
            for (int q = 0; q < 2; ++q) { const int i0 = 16 * (2 * wh + q) + 4 * l4; const f32x4 g4 = *(const LAS f32x4*)(gl + i0);
                const u32x2 rr = *(const LAS u32x2*)(Rt + jrow * TP + i0);
#pragma unroll
                for (int r = 0; r < 4; ++r) { aP[q][r] = (aP[q][r] + (i0 + r == jrow ? 1.f : 0.f)) * g4[r]; aQ[q][r] *= g4[r]; }
                aG[q][0] += bf_lo(rr.x); aG[q][1] += bf_hi(rr.x); aG[q][2] += bf_lo(rr.y); aG[q][3] += bf_hi(rr.y); }
            const size_t orow = (size_t)scan_row(z, b, sc * SCP + c4 * 64 + jrow) * D + hh * 64;
            if (c4 == 0) {
#pragma unroll
                for (int q = 0; q < 2; ++q) { const int i0 = 16 * (2 * wh + q) + 4 * l4;
                    u32x2 o; o.x = cvt_pk_bf16(aG[q][0], aG[q][1]); o.y = cvt_pk_bf16(aG[q][2], aG[q][3]); *(u32x2*)(GE + orow + i0) = o;
                    u32x2 y; y.x = cvt_pk_bf16(aY[q][0], aY[q][1]); y.y = cvt_pk_bf16(aY[q][2], aY[q][3]); *(u32x2*)(YE + orow + i0) = y;
                    Pr[q] = aP[q]; Qr[q] = aQ[q]; }
            } else {
                st_tile(NT, aG, wq, wh, lane); st_tile(MT, aP, wq, wh, lane);
#pragma unroll
                for (int q = 0; q < 2; ++q) { aYp[q] = aY[q]; aQp[q] = aQ[q]; }
                pend = true; orowp = orow; GEp = GE; YEp = YE; pqp = pq; lastp = c4 == NCH - 1;
            }
            cur = nxt;
            if (CH_AMP >= 0) { const unsigned long long d_ = CH_AMP == 0 ? ch_t[0] - ch_t[11] : ch_t[CH_AMP] - ch_t[CH_AMP - 1]; const unsigned long long dl_ = __builtin_amdgcn_s_memrealtime() + 4 * d_; while (__builtin_amdgcn_s_memrealtime() < dl_) __builtin_amdgcn_s_sleep(4); }
            LDS_BARRIER(); CH_STAMP(8);
        }
        item += gridDim.x; if (item >= NITEM) break;
    }
    if (pend) { SCAN_STAGE_G(); }
#undef SCAN_STAGE_G
}
__device__ __forceinline__ void scan_carry_phase(const Frame& F, KP P, int layer) {
    LAS unsigned* cbar = (LAS unsigned*)(F.lds + 8192);
    if (F.tid == 0) *cbar = 0u;
    __syncthreads();
    if (F.wave >= 4) { moe_weights_phase(F, P, layer, blockIdx.x * 4 + (F.wave - 4), gridDim.x * 4, ((T / 256) * 15) % (int)gridDim.x ? MOE_RKV : 0, MOE_SPLIT); return; }
    if (blockIdx.x >= 4 * NSCAN) return;
    unsigned ctarget = 0u;
    const int s = blockIdx.x >> 2, vs = blockIdx.x & 3, lane = F.lane, l15 = lane & 15, l4 = lane >> 4, v = 16 * vs + l15, T2 = F.wave;
    const float* pq = (const float*)(P->ws + WS_PQ) + (size_t)s * NSC * 2 * 4096; bf16_t* sst = (bf16_t*)(P->ws + WS_SST) + (size_t)s * NSC * 4096;
    LAS f32x4* exch = (LAS f32x4*)F.lds;
    f32x4 S[4]; float ap[4][16], qp[4][4];
#pragma unroll
    for (int t = 0; t < 4; ++t) S[t] = (f32x4){0.f, 0.f, 0.f, 0.f};
#define CARRY_LOAD(slot, step) do { const float* Pm_ = pq + (size_t)(step) * 2 * 4096; \
        _Pragma("unroll") for (int t2i = 0; t2i < 4; ++t2i) _Pragma("unroll") for (int ri = 0; ri < 4; ++ri) ap[slot][t2i * 4 + ri] = Pm_[(T2 * 16 + t2i * 4 + ri) * 64 + lane];   \
        _Pragma("unroll") for (int r = 0; r < 4; ++r) qp[slot][r] = Pm_[4096 + ((vs * 4 + T2) * 4 + r) * 64 + lane];   } while (0)
#define CARRY_STORE(sc_) do { if (T2 == 0) { float o[16]; \
        _Pragma("unroll") for (int r = 0; r < 4; ++r) _Pragma("unroll") for (int t2 = 0; t2 < 4; ++t2) o[4 * r + t2] = S[t2][r]; \
        u32x4 w0, w1; w0.x = cvt_pk_bf16(o[0], o[1]); w0.y = cvt_pk_bf16(o[2], o[3]); w0.z = cvt_pk_bf16(o[4], o[5]); w0.w = cvt_pk_bf16(o[6], o[7]); \
        w1.x = cvt_pk_bf16(o[8], o[9]); w1.y = cvt_pk_bf16(o[10], o[11]); w1.z = cvt_pk_bf16(o[12], o[13]); w1.w = cvt_pk_bf16(o[14], o[15]); \
        *(u32x4*)(sst + (size_t)(sc_) * 4096 + v * 64 + 16 * l4) = w0; *(u32x4*)(sst + (size_t)(sc_) * 4096 + v * 64 + 16 * l4 + 8) = w1; } } while (0)
    if (T2 < 4) {
#pragma unroll
        for (int u = 0; u < 4; ++u) CARRY_LOAD(u, u);
    }
#pragma nounroll
    for (int sc0 = 0; sc0 < NSC - 1; sc0 += 4) {
#pragma unroll
        for (int u = 0; u < 4; ++u) { const int sc = sc0 + u; if (sc >= NSC - 1) break;
            CARRY_STORE(sc);
            if (T2 < 4) {
                f32x4 nw = (f32x4){qp[u][0], qp[u][1], qp[u][2], qp[u][3]};
#pragma unroll
                for (int t2i = 0; t2i < 4; ++t2i)
#pragma unroll
                    for (int ri = 0; ri < 4; ++ri) nw = __builtin_amdgcn_mfma_f32_16x16x4f32(ap[u][t2i * 4 + ri], S[t2i][ri], nw, 0, 0, 0);
                if (sc + 4 < NSC - 1) CARRY_LOAD(u, sc + 4);
                exch[((u & 1) * 4 + T2) * 64 + lane] = nw;
            }
            { asm volatile("s_waitcnt lgkmcnt(0)" ::: "memory"); if (lane == 0) __hip_atomic_fetch_add(cbar, 1u, __ATOMIC_RELAXED, __HIP_MEMORY_SCOPE_WORKGROUP); ctarget += 4u;
              for (int spin = 0; spin < (1 << 22); ++spin) { const unsigned c = __hip_atomic_load(cbar, __ATOMIC_RELAXED, __HIP_MEMORY_SCOPE_WORKGROUP); if ((int)(c - ctarget) >= 0) break; }
              asm volatile("" ::: "memory"); }
            if (T2 < 4) {
#pragma unroll
                for (int t = 0; t < 4; ++t) S[t] = exch[((u & 1) * 4 + t) * 64 + lane];
            }
        }
    }
    CARRY_STORE(NSC - 1);
#undef CARRY_LOAD
#undef CARRY_STORE
}
__device__ __forceinline__ void scan_out_phase(const Frame& F, KP P, int j) {
    const int lane = F.lane, l15 = lane & 15, l4 = lane >> 4;
    const bf16_t* GE0 = (const bf16_t*)(P->ws + WS_AS0); const bf16_t* GE1 = (const bf16_t*)(P->ws + WS_AS1); const bf16_t* YE0 = (const bf16_t*)(P->ws + WS_ELOG0); const bf16_t* YE1 = (const bf16_t*)(P->ws + WS_ELOG1);
    const bf16_t* Vb = (const bf16_t*)(P->ws + WS_VV); const float* BON = (const float*)(P->ws + WS_BON);
    const bf16_t* GT = (const bf16_t*)(P->ws + WS_GATE); bf16_t* YG = (bf16_t*)(P->ws + WS_YG);
    for (int item = F.gw; item < NBATCH * NH * ((SEQ + CTXL) / 256) * 8; item += F.NGW) {
        const int hh = item & 15, oct = (item >> 4) & 7, b = (item >> 7) & 1, blk = item >> 8;
        const int sc0 = (blk * 256 + 32 * oct) / SCP, sc1 = blk == 0 ? 0 : (SEQ + CTXL - 1 - (blk - 1) * 256 - 32 * oct) / SCP;

        const bf16_t* s0 = (const bf16_t*)(P->ws + WS_SST) + ((size_t)(b * 16 + hh) * NSC + sc0) * 4096; const bf16_t* s1 = (const bf16_t*)(P->ws + WS_SST) + ((size_t)(32 + b * 16 + hh) * NSC + sc1) * 4096;
        bf16x8 sa0[4][2], sa1[4][2];
#pragma unroll
        for (int vt = 0; vt < 4; ++vt) { const int v = 32 * (vt >> 1) + 8 * (l15 >> 2) + 4 * (vt & 1) + (l15 & 3);
#pragma unroll
            for (int ks = 0; ks < 2; ++ks) { sa0[vt][ks] = *(const bf16x8*)(s0 + v * 64 + 32 * ks + 8 * l4); sa1[vt][ks] = *(const bf16x8*)(s1 + v * 64 + 32 * ks + 8 * l4); } }
        f32x4 lg4[4], lb4[4];
#pragma unroll
        for (int q = 0; q < 4; ++q) { const int c = hh * 64 + 32 * (q >> 1) + 8 * l4 + 4 * (q & 1); lg4[q] = *(const f32x4*)(P->in[I_LNG] + (size_t)j * D + c); lb4[q] = *(const f32x4*)(P->in[I_LNB] + (size_t)j * D + c); }
#pragma nounroll
        for (int ti = 0; ti < 2; ++ti) {
            const int tok = (2 * oct + ti) * 16 + l15; const int row = blk == 0 ? TL + b * CTXL + tok : b * SEQ + (blk - 1) * 256 + tok;
            const size_t o = (size_t)row * D + hh * 64;
            const bf16x8 g00 = *(const bf16x8*)(GE0 + o + 8 * l4), g01 = *(const bf16x8*)(GE0 + o + 32 + 8 * l4), g10 = *(const bf16x8*)(GE1 + o + 8 * l4), g11 = *(const bf16x8*)(GE1 + o + 32 + 8 * l4);
            u32x4 la[2], lc[2], lv[2], lgt[2];
#pragma unroll
            for (int h2 = 0; h2 < 2; ++h2) { const size_t oc = o + 32 * h2 + 8 * l4;
                la[h2] = *(const u32x4*)(YE0 + oc); lc[h2] = *(const u32x4*)(YE1 + oc); lv[h2] = *(const u32x4*)(Vb + oc); lgt[h2] = *(const u32x4*)(GT + oc); }
            const float bn = BON[(size_t)row * 16 + hh] + BON[((size_t)T + row) * 16 + hh];
            __builtin_amdgcn_sched_barrier(0);
            f32x4 y[4]; float s = 0.f; f32x4 vv[4], gg[4];
#pragma unroll
            for (int vt = 0; vt < 4; ++vt) { const int h2 = vt >> 1, hf = vt & 1;
                const unsigned ax = hf ? la[h2].z : la[h2].x, ay = hf ? la[h2].w : la[h2].y, cx = hf ? lc[h2].z : lc[h2].x, cy = hf ? lc[h2].w : lc[h2].y;
                const unsigned vx = hf ? lv[h2].z : lv[h2].x, vy = hf ? lv[h2].w : lv[h2].y, gx = hf ? lgt[h2].z : lgt[h2].x, gy = hf ? lgt[h2].w : lgt[h2].y;
                f32x4 acc = (f32x4){bf_lo(ax) + bf_lo(cx), bf_hi(ax) + bf_hi(cx), bf_lo(ay) + bf_lo(cy), bf_hi(ay) + bf_hi(cy)};
                acc = __builtin_amdgcn_mfma_f32_16x16x32_bf16(sa0[vt][0], g00, acc, 0, 0, 0); acc = __builtin_amdgcn_mfma_f32_16x16x32_bf16(sa0[vt][1], g01, acc, 0, 0, 0);
                acc = __builtin_amdgcn_mfma_f32_16x16x32_bf16(sa1[vt][0], g10, acc, 0, 0, 0); acc = __builtin_amdgcn_mfma_f32_16x16x32_bf16(sa1[vt][1], g11, acc, 0, 0, 0);
                y[vt] = acc; s += (acc[0] + acc[1]) + (acc[2] + acc[3]);
                vv[vt] = (f32x4){bf_lo(vx), bf_hi(vx), bf_lo(vy), bf_hi(vy)}; gg[vt] = (f32x4){bf_lo(gx), bf_hi(gx), bf_lo(gy), bf_hi(gy)}; }
            s += shx(s, 16, lane); s += shx(s, 32, lane);
            const float mean = s * (1.0f / 64.0f); float q = 0.f;
#pragma unroll
            for (int vt = 0; vt < 4; ++vt) { const f32x4 d = y[vt] - mean; q += (d[0] * d[0] + d[1] * d[1]) + (d[2] * d[2] + d[3] * d[3]); }
            q += shx(q, 16, lane); q += shx(q, 32, lane);
            const float rstd = rsqrtf(q * (1.0f / 64.0f) + 64e-5f);
#pragma unroll
            for (int h2 = 0; h2 < 2; ++h2) { const f32x4 o0 = (((y[2 * h2] - mean) * rstd) * lg4[2 * h2] + lb4[2 * h2] + vv[2 * h2] * bn) * gg[2 * h2], o1 = (((y[2 * h2 + 1] - mean) * rstd) * lg4[2 * h2 + 1] + lb4[2 * h2 + 1] + vv[2 * h2 + 1] * bn) * gg[2 * h2 + 1];
                u32x4 w; w.x = cvt_pk_bf16(o0[0], o0[1]); w.y = cvt_pk_bf16(o0[2], o0[3]); w.z = cvt_pk_bf16(o1[0], o1[1]); w.w = cvt_pk_bf16(o1[2], o1[3]); *(u32x4*)(YG + o + 32 * h2 + 8 * l4) = w; }
        }
    }
}
__device__ __forceinline__ bool in_range(int lo, int hi, int k) { asm volatile("" : "+s"(lo), "+s"(hi)); return lo <= k && k < hi; }
constexpr int NPH = 46;
template <unsigned KMASK> __global__ void __launch_bounds__(NTHR, 2) mega(Params Pv) {
    extern __shared__ __attribute__((aligned(16))) unsigned char lds_raw[];
    Frame F0; F0.lds = (LAS unsigned char*)lds_raw; F0.tid = threadIdx.x; F0.lane = F0.tid & 63; F0.wave = __builtin_amdgcn_readfirstlane(F0.tid >> 6);
    F0.G = gridDim.x; F0.gw = blockIdx.x * NWAVES + F0.wave; F0.NGW = F0.G * NWAVES;
    LAS unsigned* misc = (LAS unsigned*)(F0.lds + LDS_MISC);
    if (F0.tid < 128) misc[F0.tid] = 0u;
    __syncthreads();
    KP P0 = (KP)__builtin_amdgcn_kernarg_segment_ptr();
    constexpr bool ALL = (KMASK == 0x3ffffu);
    const int lo = ALL ? 0 : P0->ph_lo, hi = ALL ? NPH : P0->ph_hi;
    XcdBarrier bar; bar.bar = (unsigned*)(P0->ws + WS_CTL) + CW_BAR; bar.x = 0; bar.st = (volatile LAS unsigned*)(misc + 8);
    if (ALL || hi - lo > 1) bar = xcd_barrier_post((unsigned*)(P0->ws + WS_CTL) + CW_BAR, (volatile LAS unsigned*)(misc + 8));
#define IN(k) (ALL || in_range(lo, hi, (k)))
#define KIND(q) ((KMASK >> (q)) & 1u)
#define BAR_LEADER (wave_sgpr_now(F0.wave) == 0 && lane_id_now() == 0)
#define SEAM(k) do { if (IN(k) && IN((k) + 1)) { XcdBarrier b2_ = bar; unsigned* bb_ = bar.bar; unsigned bx_ = bar.x; asm volatile("" : "+s"(bb_), "+s"(bx_)); b2_.bar = bb_; b2_.x = bx_; xcd_barrier<false>(b2_, BAR_LEADER); } } while (0)
#define AMP_T0 const unsigned long long amp_t0 = AMP_MASK ? __builtin_amdgcn_s_memrealtime() : 0ull;
#define AMP_END(kind) do { if (AMP_MASK & (1u << (kind))) { const unsigned long long t1_ = __builtin_amdgcn_s_memrealtime(), dl_ = t1_ + AMP_F * (t1_ - amp_t0); while (__builtin_amdgcn_s_memrealtime() < dl_) __builtin_amdgcn_s_sleep(8); } } while (0)
#define PHASE_ENTRY AMP_T0 KP P = P0; asm volatile("" : "+s"(P)); unsigned char* ws = P->ws; unsigned* ctl = (unsigned*)(ws + WS_CTL); (void)ctl; \
    Frame F = F0; { int l_ = lane_id_now(), w_ = F0.wave; asm volatile("" : "+s"(w_)); F.lane = l_; F.wave = w_; F.tid = w_ * 64 + l_; F.gw = blockIdx.x * NWAVES + w_; }

    if constexpr (KIND(0)) if (IN(0)) { PHASE_ENTRY prologue_phase(F, P); AMP_END(0); }
    if (IN(0) && IN(1)) { XcdBarrier b2_ = bar; unsigned* bb_ = bar.bar; unsigned bx_ = bar.x; asm volatile("" : "+s"(bb_), "+s"(bx_)); b2_.bar = bb_; b2_.x = bx_; xcd_barrier<true>(b2_, BAR_LEADER); }
    for (int lp = 0; lp < 2; ++lp) {
        const int pb = 1 + 22 * lp, la = 2 * lp, lb = 2 * lp + 1;
        if constexpr (KIND(1)) if (IN(pb + 0)) { PHASE_ENTRY norm1_phase(F, P, la); AMP_END(1); }
        SEAM(pb + 0);
        if constexpr (KIND(2)) if (IN(pb + 1)) { PHASE_ENTRY
            __syncthreads(); set_desc(F.lds, F.tid, 0, ws + WS_HL, ws + WS_WIN + (size_t)lp * 4096 * D * 2, ws + WS_U, 16, 0, 0, ws + WS_V, P->in[I_GBIN] + (size_t)lp * 4096, ws + WS_STAT); __syncthreads();
            SchedMulti<D, D> S{F.lds, TL / 256, 16, 1};
            EpiGelu E{F.lds};
            pg8::gemm_phase<EpiGelu, SchedMulti<D, D>, false, D, D, D>(F.lds, S, E, F.tid);
            __syncthreads(); { int w_ = F0.wave; asm volatile("" : "+s"(w_)); tail_gelu(F0.lds, w_); }
            AMP_END(2); }
        SEAM(pb + 1);
        if constexpr (KIND(3)) if (IN(pb + 2)) { PHASE_ENTRY spatial_phase(F, P, lp); AMP_END(3); }
        SEAM(pb + 2);
        if constexpr (KIND(4)) if (IN(pb + 3)) { PHASE_ENTRY
            __syncthreads();
            { bf16_t* X = (bf16_t*)(ws + WS_X);
              set_desc(F.lds, F.tid, 0, ws + WS_U, ws + WS_WOUT + (size_t)lp * D * GWID * 2, X, 4, 0, 0, X, X + (size_t)TL * D, P->in[I_GBOUT] + (size_t)lp * D);
              set_desc(F.lds, F.tid, 1, nullptr, nullptr, nullptr, 0, 0, 0, (const float*)(ws + WS_MOD) + (size_t)la * 3 * 6 * D + 2 * D); }
            __syncthreads();
            SchedMulti<GWID, GWID> S{F.lds, TL / 256, 4, 1};
            EpiResid E{F.lds};
            pg8::gemm_phase<EpiResid, SchedMulti<GWID, GWID>, false, GWID, GWID, GWID>(F.lds, S, E, F.tid);
            __syncthreads(); { int w_ = F0.wave; asm volatile("" : "+s"(w_)); tail_resid<GWID>(F0.lds, w_); }
            AMP_END(4); }
        SEAM(pb + 3);
        if constexpr (KIND(5)) if (IN(pb + 4)) { PHASE_ENTRY norm2_phase(F, P, la); AMP_END(5); }
        SEAM(pb + 4);
        if constexpr (KIND(16)) if (IN(pb + 5)) { PHASE_ENTRY
            __syncthreads(); set_desc(F.lds, F.tid, 0, ws + WS_HL, ws + WS_WRT + (size_t)la * 256 * D * 2, nullptr, 1, 0, 0); __syncthreads();
            const int nun = (la == DEPTH - 1 ? TL : T) / 256;
            if ((int)blockIdx.x >= nun) moe_weights_phase(F, P, la, ((int)blockIdx.x - nun) * NWAVES + F.wave, (F.G - nun) * NWAVES, MOE_SPLIT, MOE_ITEMS);
            else { SchedMulti<D, D> S{F.lds, nun, 1, 1};
                EpiLogits E{(float*)(ws + WS_LG)};
                pg8::gemm_phase<EpiLogits, SchedMulti<D, D>, false, D, D, D>(F.lds, S, E, F.tid);
                if (F.G <= nun) { __syncthreads(); moe_weights_phase(F, P, la, F.gw, F.NGW, MOE_SPLIT, MOE_ITEMS); } }
            AMP_END(16); }
        SEAM(pb + 5);
        if constexpr (KIND(17)) if (IN(pb + 6)) { PHASE_ENTRY route_phase(F, P, la); AMP_END(17); }
        SEAM(pb + 6);
        if constexpr (KIND(6)) if (IN(pb + 7)) { PHASE_ENTRY
            moe_tables(F.lds, F.tid, ctl + CW_CNT + la * 64);
            SchedMoE<D, D, true> S{F.lds, (const char*)(ws + WS_HL), (const char*)(ws + WS_WGU), (const int*)(ws + WS_LIST)};
            EpiSiluGate E{(bf16_t*)(ws + WS_H)};
            pg8::gemm_phase<EpiSiluGate, SchedMoE<D, D, true>, true, D, D, D>(F.lds, S, E, F.tid);
            AMP_END(6); }
        SEAM(pb + 7);
        if constexpr (KIND(7)) if (IN(pb + 8)) { PHASE_ENTRY
            moe_tables(F.lds, F.tid, ctl + CW_CNT + la * 64);
            SchedMoE<EHID, EHID, false> S{F.lds, (const char*)(ws + WS_H), (const char*)(ws + WS_WD), (const int*)(ws + WS_LIST)};
            EpiScatter E{F.lds, (bf16_t*)(ws + WS_YB), (const int*)(ws + WS_LIST)};
            pg8::gemm_phase<EpiScatter, SchedMoE<EHID, EHID, false>, false, EHID, EHID, EHID>(F.lds, S, E, F.tid);
            AMP_END(7); }
        SEAM(pb + 8);
        if constexpr (KIND(1)) if (IN(pb + 9)) { PHASE_ENTRY norm1_phase(F, P, lb); AMP_END(1); }
        SEAM(pb + 9);
        if constexpr (KIND(8)) if (IN(pb + 10)) { PHASE_ENTRY mix_phase(F, P, lp); AMP_END(8); }
        SEAM(pb + 10);
        if constexpr (KIND(9)) if (IN(pb + 11)) { PHASE_ENTRY
            __syncthreads();
            set_desc(F.lds, F.tid, 0, ws + WS_XR, ws + WS_WR + (size_t)lp * D * D * 2, ws + WS_R, 4, D, 0);
            set_desc(F.lds, F.tid, 1, ws + WS_XK, ws + WS_WK + (size_t)lp * D * D * 2, ws + WS_K, 4, D, 0);
            set_desc(F.lds, F.tid, 2, ws + WS_XV, ws + WS_WV + (size_t)lp * D * D * 2, ws + WS_VV, 4, D, 0);
            set_desc(F.lds, F.tid, 3, ws + WS_XW, ws + WS_LW1 + (size_t)lp * 256 * D * 2, ws + WS_TW, 1, 256, 1);
            set_desc(F.lds, F.tid, 4, ws + WS_XA, ws + WS_LA1 + (size_t)lp * 256 * D * 2, ws + WS_TA, 1, 256, 0);
            set_desc(F.lds, F.tid, 5, ws + WS_XG, ws + WS_LG1 + (size_t)lp * 256 * D * 2, ws + WS_TG, 1, 256, 2);
            __syncthreads();
            SchedMulti<D, D> S{F.lds, T / 256, 15, 6};
            EpiAct E{F.lds};
            pg8::gemm_phase<EpiAct, SchedMulti<D, D>, false, D, D, D>(F.lds, S, E, F.tid);
            { const int rem = ((T / 256) * 15) % F.G;
              if (rem && (int)blockIdx.x >= rem) { __syncthreads(); moe_weights_phase(F, P, lb, ((int)blockIdx.x - rem) * NWAVES + F.wave, (F.G - rem) * NWAVES, 0, MOE_RKV); } }
            AMP_END(9); }
        SEAM(pb + 11);
        if constexpr (KIND(10)) if (IN(pb + 12)) { PHASE_ENTRY
            __syncthreads(); set_desc(F.lds, F.tid, 0, ws + WS_TG, ws + WS_G2P + (size_t)lp * D * 256 * 2, ws + WS_GATE, 4, D, 0); __syncthreads();
            SchedMulti<256, 256> S{F.lds, T / 256, 4, 1};
            EpiAct E{F.lds};
            pg8::gemm_phase<EpiAct, SchedMulti<256, 256>, false, 256, 256, 256>(F.lds, S, E, F.tid);
            AMP_END(10); }
        SEAM(pb + 12);
        if constexpr (KIND(11)) if (IN(pb + 13)) { PHASE_ENTRY scan_chunk_phase(F, P, lp); AMP_END(11); }
        SEAM(pb + 13);
        if constexpr (KIND(14)) if (IN(pb + 14)) { PHASE_ENTRY scan_carry_phase(F, P, lb); AMP_END(14); }
        SEAM(pb + 14);
        if constexpr (KIND(15)) if (IN(pb + 15)) { PHASE_ENTRY scan_out_phase(F, P, lp); AMP_END(15); }
        SEAM(pb + 15);
        if constexpr (KIND(4)) if (IN(pb + 16)) { PHASE_ENTRY
            __syncthreads();
            { bf16_t* X = (bf16_t*)(ws + WS_X);
              set_desc(F.lds, F.tid, 0, ws + WS_YG, ws + WS_WO + (size_t)lp * D * D * 2, X, 4, 0, 0, X, X + (size_t)TL * D, nullptr);
              set_desc(F.lds, F.tid, 1, nullptr, nullptr, nullptr, 0, 0, 0, (const float*)(ws + WS_MOD) + (size_t)lb * 3 * 6 * D + 2 * D); }
            __syncthreads();
            SchedMulti<D, D> S{F.lds, TL / 256, 4, 1};
            EpiResid E{F.lds};
            pg8::gemm_phase<EpiResid, SchedMulti<D, D>, false, D, D, D>(F.lds, S, E, F.tid);
            if (lb != DEPTH - 1) { __syncthreads(); { int w_ = F0.wave; asm volatile("" : "+s"(w_)); tail_resid<D>(F0.lds, w_); } }
            AMP_END(4); }
        SEAM(pb + 16);
        if constexpr (KIND(5)) if (IN(pb + 17)) { PHASE_ENTRY norm2_phase(F, P, lb); AMP_END(5); }
        SEAM(pb + 17);
        if constexpr (KIND(16)) if (IN(pb + 18)) { PHASE_ENTRY
            __syncthreads(); set_desc(F.lds, F.tid, 0, ws + WS_HL, ws + WS_WRT + (size_t)lb * 256 * D * 2, nullptr, 1, 0, 0); __syncthreads();
            const int nun = (lb == DEPTH - 1 ? TL : T) / 256;
            if ((int)blockIdx.x >= nun) moe_weights_phase(F, P, lb, ((int)blockIdx.x - nun) * NWAVES + F.wave, (F.G - nun) * NWAVES, MOE_SPLIT, MOE_ITEMS);
            else { SchedMulti<D, D> S{F.lds, nun, 1, 1};
                EpiLogits E{(float*)(ws + WS_LG)};
                pg8::gemm_phase<EpiLogits, SchedMulti<D, D>, false, D, D, D>(F.lds, S, E, F.tid);
                if (F.G <= nun) { __syncthreads(); moe_weights_phase(F, P, lb, F.gw, F.NGW, MOE_SPLIT, MOE_ITEMS); } }
            AMP_END(16); }
        SEAM(pb + 18);
        if constexpr (KIND(17)) if (IN(pb + 19)) { PHASE_ENTRY route_phase(F, P, lb); AMP_END(17); }
        SEAM(pb + 19);
        if constexpr (KIND(6)) if (IN(pb + 20)) { PHASE_ENTRY
            moe_tables(F.lds, F.tid, ctl + CW_CNT + lb * 64);
            SchedMoE<D, D, true> S{F.lds, (const char*)(ws + WS_HL), (const char*)(ws + WS_WGU), (const int*)(ws + WS_LIST)};
            EpiSiluGate E{(bf16_t*)(ws + WS_H)};
            pg8::gemm_phase<EpiSiluGate, SchedMoE<D, D, true>, true, D, D, D>(F.lds, S, E, F.tid);
            AMP_END(6); }
        SEAM(pb + 20);
        if constexpr (KIND(7)) if (IN(pb + 21)) { PHASE_ENTRY
            moe_tables(F.lds, F.tid, ctl + CW_CNT + lb * 64);
            SchedMoE<EHID, EHID, false> S{F.lds, (const char*)(ws + WS_H), (const char*)(ws + WS_WD), (const int*)(ws + WS_LIST)};
            EpiScatter E{F.lds, (bf16_t*)(ws + WS_YB), (const int*)(ws + WS_LIST)};
            pg8::gemm_phase<EpiScatter, SchedMoE<EHID, EHID, false>, false, EHID, EHID, EHID>(F.lds, S, E, F.tid);
            AMP_END(7); }
        SEAM(pb + 21);
    }
    if constexpr (KIND(13)) if (IN(45)) { PHASE_ENTRY final_phase(F, P); AMP_END(13); }
#undef IN
#undef KIND
#undef SEAM
#undef PHASE_ENTRY
}

#if !MK_ONE_LAUNCH
static int phase_kind(int ph) { if (ph == 0) return 0; if (ph == 45) return 13; static const int k22[22] = {1, 2, 3, 4, 5, 16, 17, 6, 7, 1, 8, 9, 10, 11, 14, 15, 4, 5, 16, 17, 6, 7}; return k22[(ph - 1) % 22]; }
typedef void (*kern_t)(Params);
template <unsigned KM> static kern_t kern_of() { return mega<KM>; }
static kern_t kind_kernel(int kind) {
    switch (kind) { case 0: return kern_of<1u << 0>(); case 1: return kern_of<1u << 1>(); case 2: return kern_of<1u << 2>(); case 3: return kern_of<1u << 3>(); case 4: return kern_of<1u << 4>();
        case 5: return kern_of<1u << 5>(); case 6: return kern_of<1u << 6>(); case 7: return kern_of<1u << 7>(); case 8: return kern_of<1u << 8>(); case 9: return kern_of<1u << 9>();
        case 10: return kern_of<1u << 10>(); case 11: return kern_of<1u << 11>(); case 12: return kern_of<1u << 12>(); case 14: return kern_of<1u << 14>(); case 15: return kern_of<1u << 15>(); case 16: return kern_of<1u << 16>(); case 17: return kern_of<1u << 17>(); default: return kern_of<1u << 13>(); }
}
#endif
extern "C" void kernel_launch(void* const* d_in, const int* in_sizes, int n_in, void* d_out, int out_size, void* d_ws, size_t ws_size, hipStream_t stream) {
    static int grid = 0;
    if (grid == 0) {
        if (n_in != 42 || out_size != TL * D || ws_size < WS_END) { fprintf(stderr, "kernel_launch: unexpected problem (n_in %d, out %d, ws %zu < %zu)\n", n_in, out_size, ws_size, (size_t)WS_END); grid = -1; return; }
        int dev = 0, cus = 0;
        if (hipGetDevice(&dev) != hipSuccess || hipDeviceGetAttribute(&cus, hipDeviceAttributeMultiprocessorCount, dev) != hipSuccess) { grid = -1; return; }
#if MK_ONE_LAUNCH
        if (hipFuncSetAttribute((const void*)mega<0x3ffffu>, hipFuncAttributeMaxDynamicSharedMemorySize, LDS_BYTES) != hipSuccess) { fprintf(stderr, "kernel_launch: hipFuncSetAttribute failed\n"); grid = -1; return; }
#else
        for (int k = 0; k < 18; ++k) if (hipFuncSetAttribute((const void*)kind_kernel(k), hipFuncAttributeMaxDynamicSharedMemorySize, LDS_BYTES) != hipSuccess) { fprintf(stderr, "kernel_launch: hipFuncSetAttribute failed\n"); grid = -1; return; }
#endif
        (void)hipGetLastError();
        grid = cus;
    }
    if (grid < 0) return;
    (void)hipMemsetAsync((char*)d_ws + WS_CTL, 0, CTL_BYTES, stream);
    Params p{};
    for (int i = 0; i < 42; ++i) p.in[i] = (const float*)d_in[i];
    p.out = (float*)d_out; p.ws = (unsigned char*)d_ws;
#if MK_ONE_LAUNCH
    p.ph_lo = 0; p.ph_hi = NPH;
    hipLaunchKernelGGL(mega<0x3ffffu>, dim3(grid), dim3(NTHR), LDS_BYTES, stream, p);
#else
    for (int ph = 0; ph < NPH; ++ph) { p.ph_lo = ph; p.ph_hi = ph + 1; hipLaunchKernelGGL(kind_kernel(phase_kind(ph)), dim3(grid), dim3(NTHR), LDS_BYTES, stream, p); }
#endif
}
```

```cpp
#include <hip/hip_runtime.h>
#include <cstdio>
#include <cstdint>

#define LAS __attribute__((address_space(3)))
typedef unsigned short bf16_t;
typedef short bf16x8 __attribute__((ext_vector_type(8)));
typedef float f32x4 __attribute__((ext_vector_type(4)));
typedef float f32x2 __attribute__((ext_vector_type(2)));
typedef unsigned u32x4 __attribute__((ext_vector_type(4)));
typedef unsigned u32x2 __attribute__((ext_vector_type(2)));

#ifndef CH_AMP
#define CH_AMP -1
#endif
#define CH_STAMP(i) do { if (CH_AMP >= 0) ch_t[i] = __builtin_amdgcn_s_memrealtime(); } while (0)
#ifndef AMP_MASK
#define AMP_MASK 0u
#endif
#define AMP_F 4
#ifndef MK_ONE_LAUNCH
#define MK_ONE_LAUNCH 1
#endif

constexpr int D = 1024, NBATCH = 2, SEQ = 16384, CTXL = 256, DEPTH = 4;
constexpr int TL = NBATCH * SEQ, TC = NBATCH * CTXL, T = TL + TC;
constexpr int GWID = 2048, NE = 32, EHID = 512, NH = 16, HD = 64;
constexpr int LISTCAP = T;
constexpr int MAXRT = (2 * T) / 256 + NE;
constexpr int NWAVES = 8, NTHR = 512;

constexpr size_t MiB = 1u << 20;
constexpr size_t WS_CTL = 0, CTL_BYTES = 1 * MiB;
constexpr size_t WS_MOD = 1 * MiB;
constexpr size_t WS_WIN = 2 * MiB, WS_WOUT = 18 * MiB, WS_WSP = 26 * MiB, WS_WR = 27 * MiB, WS_WK = 31 * MiB, WS_WV = 35 * MiB, WS_WO = 39 * MiB;
constexpr size_t WS_LW1 = 43 * MiB, WS_LA1 = 44 * MiB, WS_LG1 = 45 * MiB, WS_W2P = 46 * MiB, WS_A2P = 48 * MiB, WS_G2P = 50 * MiB;
constexpr size_t WS_WRT = 52 * MiB;
constexpr size_t WS_WGU = 54 * MiB, WS_WD = 118 * MiB;
constexpr size_t WS_X = 150 * MiB;
constexpr size_t WS_LIST = 280 * MiB, WS_WGT = 285 * MiB;
constexpr size_t WS_HL = 286 * MiB;
constexpr size_t WS_BIG = 351 * MiB;
constexpr size_t SZB = 65 * MiB;
constexpr size_t WS_U = WS_BIG, WS_V = WS_BIG + 2 * SZB, WS_STAT = WS_BIG + 4 * SZB;
constexpr size_t WS_XR = WS_BIG, WS_XW = WS_BIG + SZB, WS_XK = WS_BIG + 2 * SZB, WS_XV = WS_BIG + 3 * SZB, WS_XA = WS_BIG + 4 * SZB, WS_XG = WS_BIG + 5 * SZB;
constexpr size_t WS_R = WS_BIG + 6 * SZB, WS_K = WS_BIG + 7 * SZB, WS_VV = WS_BIG + 8 * SZB;
constexpr size_t WS_TW = WS_BIG + 9 * SZB, WS_TA = WS_TW + 17 * MiB, WS_TG = WS_TA + 17 * MiB;
constexpr size_t WS_ELOG0 = WS_XR, WS_ELOG1 = WS_XW, WS_KM0 = WS_XK, WS_KM1 = WS_XV, WS_AS0 = WS_XA, WS_AS1 = WS_XG;
constexpr size_t WS_GATE = WS_HL, WS_YG = WS_AS0, WS_BON = WS_TG + 17 * MiB;
constexpr size_t WS_H = WS_BIG, WS_YB = WS_BIG + 73 * MiB, WS_LG = WS_BIG + 204 * MiB;
constexpr size_t WS_PQ = WS_KM0;
constexpr size_t WS_SST = 215 * MiB;
constexpr size_t WS_END = WS_BON + 5 * MiB;
static_assert(WS_END <= 1080 * MiB, "workspace map");
constexpr int CW_BAR = 4096;
constexpr int CW_CNT = 16384;

__device__ __forceinline__ int wave_sgpr_now(int w) { asm volatile("" : "+s"(w)); return w; }
__device__ __forceinline__ int lane_id_now() { int l; asm volatile("v_mbcnt_lo_u32_b32 %0, -1, 0\n\tv_mbcnt_hi_u32_b32 %0, -1, %0" : "=v"(l)); return l; }
typedef short v4s __attribute__((ext_vector_type(4)));
#define LDS_BARRIER() asm volatile("s_waitcnt lgkmcnt(0)\n\ts_barrier" ::: "memory")
typedef __bf16 bf16x2_t __attribute__((ext_vector_type(2)));
__device__ __forceinline__ unsigned cvt_pk_bf16(float lo, float hi) { const bf16x2_t v = __builtin_convertvector((f32x2){lo, hi}, bf16x2_t); return __builtin_bit_cast(unsigned, v); }
__device__ __forceinline__ float bf_lo(unsigned u) { return __uint_as_float(u << 16); }
__device__ __forceinline__ float bf_hi(unsigned u) { return __uint_as_float(u & 0xffff0000u); }
__device__ __forceinline__ float bf1(bf16_t b) { return __uint_as_float(((unsigned)b) << 16); }
__device__ __forceinline__ bf16_t f2bf(float f) { return (bf16_t)(cvt_pk_bf16(f, 0.f) & 0x3ffffu); }
__device__ __forceinline__ void unpack8(const u32x4& w, float (&f)[8]) { f[0] = bf_lo(w.x); f[1] = bf_hi(w.x); f[2] = bf_lo(w.y); f[3] = bf_hi(w.y); f[4] = bf_lo(w.z); f[5] = bf_hi(w.z); f[6] = bf_lo(w.w); f[7] = bf_hi(w.w); }
__device__ __forceinline__ u32x4 pack8(const float (&f)[8]) { u32x4 o; o.x = cvt_pk_bf16(f[0], f[1]); o.y = cvt_pk_bf16(f[2], f[3]); o.z = cvt_pk_bf16(f[4], f[5]); o.w = cvt_pk_bf16(f[6], f[7]); return o; }
__device__ __forceinline__ float shx(float v, int m, int lane) { return __int_as_float(__builtin_amdgcn_ds_bpermute((lane ^ m) << 2, __float_as_int(v))); }
__device__ __forceinline__ float shup(float v, int d, int lane) { return __int_as_float(__builtin_amdgcn_ds_bpermute((lane - d) << 2, __float_as_int(v))); }
__device__ __forceinline__ float wave_sum(float v, int lane) {
#pragma unroll
    for (int o = 1; o < 64; o <<= 1) v += shx(v, o, lane);
    return v;
}
__device__ __forceinline__ float sigmoidf_(float x) { return 1.0f / (1.0f + __expf(-x)); }
__device__ __forceinline__ float tanhf_(float x) { const float e = __expf(2.0f * x); return 1.0f - 2.0f / (e + 1.0f); }
__device__ __forceinline__ f32x2 gelu_pk(f32x2 v) {
    const f32x2 av = __builtin_elementwise_abs(v), d = av * 0.2316418882f + 1.0f;
    f32x2 t; t.x = __builtin_amdgcn_rcpf(d.x); t.y = __builtin_amdgcn_rcpf(d.y);
    f32x2 q = t * 0.5307027145f + (-0.7265760135f); q = q * t + 0.7107068705f; q = q * t + (-0.142248368f); q = q * t + 0.127414796f; q = q * t;
    const f32x2 s = (v * v) * (-0.72134752044f);
    f32x2 e; e.x = __builtin_amdgcn_exp2f(s.x); e.y = __builtin_amdgcn_exp2f(s.y);
    const f32x2 m = v * (q * e), r = v - m;
    f32x2 o; o.x = v.x < 0.f ? m.x : r.x; o.y = v.y < 0.f ? m.y : r.y; return o;
}

#define XB_TMO      128
#define XB_XCNT(j)  (256  + 64 * (j))
#define XB_XSUB(j)  (1280 + 64 * (j))
#define XB_XGEN(j)  (2304 + 64 * (j))
#define XB_TOP      3328
#define XB_TOPGEN   3392
#define XCD_BAR_WORDS 3456
#define XB_SPIN_CAP (1u << 18)
__device__ __forceinline__ unsigned xb_ld(unsigned* p)              { return __hip_atomic_load(p, __ATOMIC_RELAXED, __HIP_MEMORY_SCOPE_AGENT); }
__device__ __forceinline__ unsigned xb_add(unsigned* p, unsigned v) { return __hip_atomic_fetch_add(p, v, __ATOMIC_RELAXED, __HIP_MEMORY_SCOPE_AGENT); }
__device__ __forceinline__ unsigned xb_xcc_id() { return (unsigned)__builtin_amdgcn_s_getreg((3 << 11) | 20) & 0xFu; }
#define XB_SPIN(cond, bar) do { unsigned _sp = 0; while (cond) { __builtin_amdgcn_s_sleep(1); \
    if ((++_sp & 255u) == 0u) { if (xb_ld(&(bar)[XB_TMO])) break; if (_sp > XB_SPIN_CAP) { atomicAdd(&(bar)[XB_TMO], 1u); break; } } } } while (0)
struct XcdBarrier { unsigned* bar; unsigned x; volatile LAS unsigned* st; };
__device__ __forceinline__ XcdBarrier xcd_barrier_post(unsigned* bar, volatile LAS unsigned* st) {
    XcdBarrier b; b.bar = bar; b.x = xb_xcc_id(); b.st = st;
    if (threadIdx.x == 0) (void)xb_add(&bar[XB_XCNT(b.x)], 1u);
    return b;
}
__device__ __forceinline__ void xcd_barrier_complete(unsigned* bar, unsigned x, unsigned& nloc, unsigned& nx) {
    const unsigned G = gridDim.x * gridDim.y * gridDim.z;
    unsigned sum, cnt, mine, sp = 0u;
    for (;;) {
        sum = 0u; cnt = 0u; mine = 0u;
#pragma unroll
        for (unsigned j = 0; j < 16; ++j) { const unsigned c = xb_ld(&bar[XB_XCNT(j)]); sum += c; cnt += (c > 0u) ? 1u : 0u; mine = (j == x) ? c : mine; }
        if (sum == G) break;
        __builtin_amdgcn_s_sleep(1);
        if ((++sp & 255u) == 0u) { if (xb_ld(&bar[XB_TMO])) break; if (sp > XB_SPIN_CAP) { atomicAdd(&bar[XB_TMO], 1u); break; } }
    }
    nloc = mine > 0u ? mine : 1u; nx = cnt > 0u ? cnt : 1u;
}
template <bool FIRST> __device__ __forceinline__ void xcd_barrier(const XcdBarrier& b, const bool leader) {
    asm volatile("s_waitcnt vmcnt(0)" ::: "memory");
    __syncthreads();
    if (leader) {
        unsigned* bar = b.bar;
        __builtin_amdgcn_s_waitcnt(0);
        unsigned nloc = b.st[0], nx = b.st[1];
        if constexpr (FIRST) { if (nloc == 0u) { xcd_barrier_complete(bar, b.x, nloc, nx); b.st[0] = nloc; b.st[1] = nx; } }
        const unsigned old = xb_add(&bar[XB_XSUB(b.x)], 1u);
        const unsigned gen = old / nloc;
        if (old + 1u == (gen + 1u) * nloc) {
            __builtin_amdgcn_fence(__ATOMIC_RELEASE, "agent");
            asm volatile("s_waitcnt vmcnt(0)" ::: "memory");
            const unsigned og = xb_add(&bar[XB_TOP], 1u);
            const unsigned tg = og / nx;
            if (og + 1u == (tg + 1u) * nx) xb_add(&bar[XB_TOPGEN], 1u);
            else XB_SPIN(xb_ld(&bar[XB_TOPGEN]) == tg, bar);
            __builtin_amdgcn_fence(__ATOMIC_ACQUIRE, "agent");
            xb_add(&bar[XB_XGEN(b.x)], 1u);
            asm volatile("s_waitcnt vmcnt(0)" ::: "memory");
        } else {
            XB_SPIN(xb_ld(&bar[XB_XGEN(b.x)]) == gen, bar);
            __builtin_amdgcn_fence(__ATOMIC_ACQUIRE, "agent");
            asm volatile("s_waitcnt vmcnt(0)" ::: "memory");
        }
    }
    __syncthreads();
}

constexpr int LDS_MISC = 143360;
constexpr int LDS_DESC = LDS_MISC + 128;
constexpr int LDS_TAB = LDS_MISC + 512;
constexpr int LDS_BYTES = 147456;
namespace pg8 {
constexpr int BM = 256, BK = 64, HALF = 128, HTB = HALF * BK * 2, STAGE_BYTES = 8 * HTB, NXCD = 8, WGM = 8;
__host__ __device__ __forceinline__ int lds_byte(int r, int c) { const int st = (r >> 4) * 2 + (c >> 5), rr = r & 15, cc = c & 31, ob = rr * 64 + cc * 2; return st * 1024 + (ob ^ (((ob >> 9) & 1) << 5)); }
__host__ __device__ __forceinline__ void stage_rc(int b, int& R, int& C) { const int st = b / 1024, sb = b % 1024, swz = sb ^ (((sb >> 9) & 1) << 5); R = (st >> 1) * 16 + swz / 64; C = (st & 1) * 32 + (swz % 64) / 2; }
__host__ __device__ __forceinline__ int perm32(int rho) { const int n = rho >> 4, i = rho & 15; return 8 * (i >> 2) + 4 * n + (i & 3); }
__device__ __forceinline__ int xcd_remap(int L, int nwg) { const int q = nwg / NXCD, r = nwg % NXCD, xcd = L % NXCD, off = L / NXCD; return (xcd < r ? xcd * (q + 1) : r * (q + 1) + (xcd - r) * q) + off; }

struct Unit { int pm, pn, aux; };

template <class Epi, class Sched, bool GATHER, int K, int LDA, int LDB>
__device__ __forceinline__ void gemm_phase(LAS unsigned char* lds, const Sched& S, const Epi& E, const int tid_in) {
    int tid_ = tid_in; asm volatile("" : "+v"(tid_));
    const int tid = tid_, wid = __builtin_amdgcn_readfirstlane(tid >> 6), lane = tid & 63, wr = wid >> 2, wc = wid & 3, fr = lane & 15, fq = lane >> 4;
    constexpr int nt = K / BK;
    unsigned voffA[2], voffB[2];
#pragma unroll
    for (int i = 0; i < 2; ++i) { int R, C; stage_rc(tid * 16 + i * 8192, R, C); const int Rb = Epi::PERM ? ((R & ~31) + perm32(R & 31)) : R;
        voffA[i] = (unsigned)(R * LDA + C) * 2u; voffB[i] = (unsigned)(Rb * LDB + C) * 2u; }
    constexpr size_t kstep = (size_t)(BK * 2);
    constexpr size_t hstepA = GATHER ? (size_t)0 : (size_t)HALF * LDA * 2, hstepB = (size_t)HALF * LDB * 2;
    const unsigned ldsw = (unsigned)wid * 1024u;
    const int aoff = lds_byte(wr * 64 + fr, fq * 8), boff = lds_byte(wc * 32 + fr, fq * 8);
    unsigned gA[2][2], gN[2][2];
#define PG8_SA(b, h) (((b) * 2 + (h)) * HTB)
#define PG8_SB(b, h) ((4 + (b) * 2 + (h)) * HTB)
#define PG8_STAGEB(bufoff, gbase) do { _Pragma("unroll") for (int _i = 0; _i < 2; ++_i) \
        __builtin_amdgcn_global_load_lds((const unsigned*)((const char*)(gbase) + voffB[_i]), (LAS unsigned*)(lds + (bufoff) + ldsw + _i * 8192), 16, 0, 0); } while (0)
#define PG8_STAGEA(bufoff, gbase, h, GV) do { _Pragma("unroll") for (int _i = 0; _i < 2; ++_i) \
        __builtin_amdgcn_global_load_lds((const unsigned*)((const char*)(gbase) + (GATHER ? GV[h][_i] : voffA[_i]) + (h) * hstepA), (LAS unsigned*)(lds + (bufoff) + ldsw + _i * 8192), 16, 0, 0); } while (0)
#define PG8_LDA(dst, b, h) do { _Pragma("unroll") for (int m = 0; m < 4; ++m) _Pragma("unroll") for (int k = 0; k < 2; ++k) dst[m][k] = *(const LAS bf16x8*)(lds + PG8_SA(b, h) + aoff + m * 2048 + k * 1024); } while (0)
#define PG8_LDB(dst, b, h) do { _Pragma("unroll") for (int n = 0; n < 2; ++n) _Pragma("unroll") for (int k = 0; k < 2; ++k) dst[n][k] = *(const LAS bf16x8*)(lds + PG8_SB(b, h) + boff + n * 2048 + k * 1024); } while (0)
#define PG8_MMA(ai, bj, At, Bt) do { __builtin_amdgcn_s_setprio(1); _Pragma("unroll") for (int m = 0; m < 4; ++m) _Pragma("unroll") for (int n = 0; n < 2; ++n) _Pragma("unroll") for (int k = 0; k < 2; ++k) \
        acc[ai][bj][m][n] = __builtin_amdgcn_mfma_f32_16x16x32_bf16(Bt[n][k], At[m][k], acc[ai][bj][m][n], 0, 0, 0); __builtin_amdgcn_s_setprio(0); } while (0)
#define PG8_WAIT_V(n) asm volatile("s_waitcnt vmcnt(" #n ")" ::: "memory")
#define PG8_WAIT_L(n) asm volatile("s_waitcnt lgkmcnt(" #n ")" ::: "memory")
#define PG8_BAR __builtin_amdgcn_s_barrier()
#define PG8_SCHED __builtin_amdgcn_sched_barrier(0)
    Unit cur, nxt; int ui = 0;
    if (!S.next(0, cur)) return;
    f32x4 acc[2][2][4][2];
#pragma unroll
    for (int a = 0; a < 2; ++a)
#pragma unroll
        for (int b = 0; b < 2; ++b)
#pragma unroll
            for (int m = 0; m < 4; ++m)
#pragma unroll
                for (int n = 0; n < 2; ++n) acc[a][b][m][n] = (f32x4){0.f, 0.f, 0.f, 0.f};
    bf16x8 At[4][2], B0[2][2], B1[2][2];
    const char* cA = S.aptr(cur); const char* cB = S.bptr(cur);
    if constexpr (GATHER) { S.gather(cur, tid, gA); }
    PG8_STAGEB(PG8_SB(0, 0), cB); PG8_STAGEB(PG8_SB(0, 1), cB + hstepB); PG8_STAGEA(PG8_SA(0, 0), cA, 0, gA); PG8_STAGEA(PG8_SA(0, 1), cA, 1, gA);
    if (wr == 1) PG8_BAR;
    PG8_WAIT_V(2); PG8_BAR;
    PG8_STAGEB(PG8_SB(1, 0), cB + kstep); PG8_STAGEA(PG8_SA(1, 0), cA + kstep, 0, gA); PG8_STAGEB(PG8_SB(1, 1), cB + hstepB + kstep);
    PG8_WAIT_V(6); PG8_BAR;
    for (;;) {
        const bool has_next = S.next(ui + 1, nxt);
        const char* nA = has_next ? S.aptr(nxt) : cA; const char* nB = has_next ? S.bptr(nxt) : cB;
        if constexpr (GATHER) { if (has_next) S.gather(nxt, tid, gN); else {
#pragma unroll
            for (int h = 0; h < 2; ++h)
#pragma unroll
                for (int i = 0; i < 2; ++i) gN[h][i] = gA[h][i]; } }
#pragma nounroll
        for (int t = 0; t < nt; t += 2) {
            const bool last = (t == nt - 2);
            const char* a1 = cA + (size_t)(t + 1) * kstep;
            const char* a2 = last ? nA : cA + (size_t)(t + 2) * kstep; const char* b2 = last ? nB : cB + (size_t)(t + 2) * kstep;
            const char* a3 = a2 + kstep; const char* b3 = b2 + kstep;
            unsigned g2[2][2];
            if constexpr (GATHER) {
#pragma unroll
                for (int h = 0; h < 2; ++h)
#pragma unroll
                    for (int i = 0; i < 2; ++i) g2[h][i] = last ? gN[h][i] : gA[h][i]; }
            PG8_LDB(B0, 0, 0); PG8_LDB(B1, 0, 1); PG8_SCHED; PG8_LDA(At, 0, 0); PG8_STAGEA(PG8_SA(1, 1), a1, 1, gA);
            PG8_WAIT_V(8); PG8_WAIT_L(0); PG8_BAR; PG8_MMA(0, 0, At, B0); PG8_MMA(0, 1, At, B1); PG8_BAR; PG8_SCHED;
            PG8_LDA(At, 0, 1); PG8_STAGEB(PG8_SB(0, 0), b2); PG8_STAGEB(PG8_SB(0, 1), b2 + hstepB); PG8_STAGEA(PG8_SA(0, 0), a2, 0, g2);
            PG8_WAIT_V(8); PG8_WAIT_L(0); PG8_BAR; PG8_MMA(1, 0, At, B0); PG8_MMA(1, 1, At, B1); PG8_BAR; PG8_SCHED;
            PG8_LDB(B0, 1, 0); PG8_LDB(B1, 1, 1); PG8_SCHED; PG8_LDA(At, 1, 0); PG8_STAGEA(PG8_SA(0, 1), a2, 1, g2);
            PG8_WAIT_V(8); PG8_WAIT_L(0); PG8_BAR; PG8_MMA(0, 0, At, B0); PG8_MMA(0, 1, At, B1); PG8_BAR; PG8_SCHED;
            PG8_LDA(At, 1, 1); PG8_STAGEB(PG8_SB(1, 0), b3); PG8_STAGEB(PG8_SB(1, 1), b3 + hstepB); PG8_STAGEA(PG8_SA(1, 0), a3, 0, g2);
            PG8_WAIT_V(8); PG8_WAIT_L(0); PG8_BAR; PG8_MMA(1, 0, At, B0); PG8_MMA(1, 1, At, B1); PG8_BAR; PG8_SCHED;
        }
        if (wr == 0) PG8_BAR;
        E(acc, cur, wr, wc, fr, fq);
        if (!has_next) break;
#pragma unroll
        for (int a = 0; a < 2; ++a)
#pragma unroll
            for (int b = 0; b < 2; ++b)
#pragma unroll
                for (int m = 0; m < 4; ++m)
#pragma unroll
                    for (int n = 0; n < 2; ++n) acc[a][b][m][n] = (f32x4){0.f, 0.f, 0.f, 0.f};
        cur = nxt; cA = nA; cB = nB; ++ui;
        if constexpr (GATHER) {
#pragma unroll
            for (int h = 0; h < 2; ++h)
#pragma unroll
                for (int i = 0; i < 2; ++i) gA[h][i] = gN[h][i]; }
        if (wr == 1) PG8_BAR;
    }
    PG8_WAIT_V(0);
    PG8_BAR;
#undef PG8_SA
#undef PG8_SB
#undef PG8_STAGEA
#undef PG8_STAGEB
#undef PG8_LDA
#undef PG8_LDB
#undef PG8_MMA
#undef PG8_WAIT_V
#undef PG8_WAIT_L
#undef PG8_BAR
#undef PG8_SCHED
}
}
using pg8::Unit;

__device__ __forceinline__ void set_desc(LAS unsigned char* lds, int tid, int g, const void* A, const void* B, const void* C, int nN, int ldc, int aux, const void* X1 = nullptr, const void* X2 = nullptr, const void* X3 = nullptr) {
    LAS int* d = (LAS int*)(lds + LDS_DESC) + g * 16;
    if (tid == 0) { unsigned long long a = (unsigned long long)A, b = (unsigned long long)B, c = (unsigned long long)C, x1 = (unsigned long long)X1, x2 = (unsigned long long)X2, x3 = (unsigned long long)X3;
        asm volatile("" : "+s"(a), "+s"(b), "+s"(c), "+s"(x1), "+s"(x2), "+s"(x3), "+s"(nN), "+s"(ldc), "+s"(aux));
        d[0] = (int)(unsigned)a; d[1] = (int)(unsigned)(a >> 32); d[2] = (int)(unsigned)b; d[3] = (int)(unsigned)(b >> 32); d[4] = (int)(unsigned)c; d[5] = (int)(unsigned)(c >> 32); d[6] = nN; d[7] = ldc; d[8] = aux;
        d[10] = (int)(unsigned)x1; d[11] = (int)(unsigned)(x1 >> 32); d[12] = (int)(unsigned)x2; d[13] = (int)(unsigned)(x2 >> 32); d[14] = (int)(unsigned)x3; d[15] = (int)(unsigned)(x3 >> 32); }
}
__device__ __forceinline__ int desc_i(LAS unsigned char* lds, int g, int f) { return __builtin_amdgcn_readfirstlane(((LAS const int*)(lds + LDS_DESC))[g * 16 + f]); }
__device__ __forceinline__ const char* desc_p(LAS unsigned char* lds, int g, int f) {
    const unsigned lo = (unsigned)desc_i(lds, g, f), hi = (unsigned)desc_i(lds, g, f + 1); return (const char*)(((unsigned long long)hi << 32) | lo); }
template <int LDA, int LDB>
struct SchedMulti {
    LAS unsigned char* lds; int nM, ntot, ng;
    __device__ __forceinline__ bool next(int i, Unit& u) const {
        const int nwg = nM * ntot; const long L = (long)i * gridDim.x + blockIdx.x; if (L >= nwg) return false;
        const int wgid = pg8::xcd_remap((int)L, nwg);
        const int nig = pg8::WGM * ntot, gid = wgid / nig, fm = gid * pg8::WGM, gsz = (nM - fm) < pg8::WGM ? (nM - fm) : pg8::WGM;
        u.pm = fm + ((wgid % nig) % gsz); int pv = (wgid % nig) / gsz; int g = 0;
        for (int j = 0; j + 1 < ng; ++j) { const int n = desc_i(lds, j, 6); if (pv < n) break; pv -= n; g = j + 1; }
        u.pn = pv; u.aux = g; return true;
    }
    __device__ __forceinline__ const char* aptr(const Unit& u) const { return desc_p(lds, u.aux, 0) + (size_t)u.pm * (512 * LDA); }
    __device__ __forceinline__ const char* bptr(const Unit& u) const { return desc_p(lds, u.aux, 2) + (size_t)u.pn * (512 * LDB); }
};
template <int LDA, int LDB, bool GATHERED>
struct SchedMoE {
    LAS unsigned char* lds; const char* Abase; const char* Bbase; const int* list;
    __device__ __forceinline__ bool next(int i, Unit& u) const {
        LAS const int* tab = (LAS const int*)(lds + LDS_TAB);
        const int nrt = __builtin_amdgcn_readfirstlane(tab[2 * MAXRT + 32]);
        const int nwg = nrt * 4; const long L = (long)i * gridDim.x + blockIdx.x; if (L >= nwg) return false;
        const int wgid = pg8::xcd_remap((int)L, nwg);
        u.pm = wgid >> 2; u.pn = wgid & 3; u.aux = __builtin_amdgcn_readfirstlane(tab[u.pm]); return true;
    }
    __device__ __forceinline__ const char* aptr(const Unit& u) const { return GATHERED ? Abase : Abase + (size_t)u.pm * (512 * LDA); }
    __device__ __forceinline__ const char* bptr(const Unit& u) const { return Bbase + (size_t)u.aux * ((size_t)D * LDB * 2) + (size_t)u.pn * (512 * LDB); }
    __device__ __forceinline__ void gather(const Unit& u, int tid, unsigned (&g)[2][2]) const {
        LAS const int* tab = (LAS const int*)(lds + LDS_TAB);
        const int j0 = __builtin_amdgcn_readfirstlane(tab[MAXRT + u.pm]), cn = __builtin_amdgcn_readfirstlane(tab[2 * MAXRT + u.aux]);
#pragma unroll
        for (int i = 0; i < 2; ++i) { int R, C; pg8::stage_rc(tid * 16 + i * 8192, R, C);
#pragma unroll
            for (int h = 0; h < 2; ++h) { const int slot = j0 + 128 * h + R; const int a = slot < cn ? list[(size_t)u.aux * LISTCAP + slot] : 0;
                g[h][i] = (unsigned)((a >> 1) * LDA + C) * 2u; } }
    }
};
__device__ __forceinline__ void moe_tables(LAS unsigned char* lds, int tid, const unsigned* cnt) {
    LAS int* tab = (LAS int*)(lds + LDS_TAB);
    __syncthreads();
    if (tid == 0) {
        int rt = 0;
#pragma nounroll
        for (int e = 0; e < NE; ++e) { const int c = (int)__hip_atomic_load(cnt + e, __ATOMIC_RELAXED, __HIP_MEMORY_SCOPE_AGENT); tab[2 * MAXRT + e] = c;
            const int nt = (c + 255) >> 8;
#pragma nounroll
            for (int j = 0; j < nt; ++j) { tab[rt] = e; tab[MAXRT + rt] = j * 256; ++rt; } }
        tab[2 * MAXRT + 32] = rt;
    }
    __syncthreads();
}

#define EPI_FENCE() asm volatile("" ::: "memory")
struct EpiGelu {
    static constexpr bool PERM = true;
    LAS unsigned char* lds;
    __device__ __forceinline__ void operator()(const f32x4 (&acc)[2][2][4][2], const Unit& u, int wr, int wc, int fr, int fq) const {
        const bool isv = u.pn >= 8; bf16_t* base = (bf16_t*)desc_p(lds, 0, isv ? 10 : 4); const float* bias = (const float*)desc_p(lds, 0, 12); float* stat = (float*)desc_p(lds, 0, 14);
        const int col0 = (u.pn & 7) * 256 + wc * 32 + 8 * fq, bcol0 = u.pn * 256 + wc * 32 + 8 * fq, row0 = u.pm * 256 + wr * 64 + fr;
        f32x4 bv[2][2];
#pragma unroll
        for (int bj = 0; bj < 2; ++bj)
#pragma unroll
            for (int n = 0; n < 2; ++n) bv[bj][n] = *(const f32x4*)(bias + bcol0 + bj * 128 + 4 * n);
#pragma unroll
        for (int ai = 0; ai < 2; ++ai)
#pragma unroll
            for (int m = 0; m < 4; ++m) { const int row = row0 + ai * 128 + m * 16; bf16_t* rowp = base + (size_t)row * GWID + col0; float s = 0.f, q = 0.f;
#pragma unroll
                for (int bj = 0; bj < 2; ++bj) { const f32x4 v0 = acc[ai][bj][m][0] + bv[bj][0], v1 = acc[ai][bj][m][1] + bv[bj][1];
                    const f32x2 a = gelu_pk((f32x2){v0[0], v0[1]}), b = gelu_pk((f32x2){v0[2], v0[3]}), c = gelu_pk((f32x2){v1[0], v1[1]}), d = gelu_pk((f32x2){v1[2], v1[3]});
                    s += ((a.x + a.y) + (b.x + b.y)) + ((c.x + c.y) + (d.x + d.y));
                    q += ((a.x * a.x + a.y * a.y) + (b.x * b.x + b.y * b.y)) + ((c.x * c.x + c.y * c.y) + (d.x * d.x + d.y * d.y));
                    u32x4 w; w.x = cvt_pk_bf16(a.x, a.y); w.y = cvt_pk_bf16(b.x, b.y); w.z = cvt_pk_bf16(c.x, c.y); w.w = cvt_pk_bf16(d.x, d.y);
                    *(u32x4*)(rowp + bj * 128) = w; }
                if (isv) { const int ln_ = 16 * fq + fr; s += shx(s, 16, ln_); s += shx(s, 32, ln_); q += shx(q, 16, ln_); q += shx(q, 32, ln_);
                    if (fq == 0) *(f32x2*)(stat + ((size_t)row * 32 + (u.pn - 8) * 4 + wc) * 2) = (f32x2){s, q}; } }
    }
};
struct EpiResid {
    static constexpr bool PERM = true;
    LAS unsigned char* lds;
    __device__ __forceinline__ void operator()(const f32x4 (&acc)[2][2][4][2], const Unit& u, int wr, int wc, int fr, int fq) const {
        const int mrow = u.pm < 64 ? 0 : (u.pm < 128 ? 1 : 2);
        bf16_t* x = (bf16_t*)desc_p(lds, 0, 4) + (size_t)(u.pm * 256 + wr * 64 + fr) * D + u.pn * 256 + wc * 32 + 8 * fq;
        const float* bias = (const float*)desc_p(lds, 0, 14); const float* gate = (const float*)desc_p(lds, 1, 10) + mrow * 6 * D + u.pn * 256 + wc * 32 + 8 * fq;
        if (bias) bias += u.pn * 256 + wc * 32 + 8 * fq;
#pragma unroll
        for (int bj = 0; bj < 2; ++bj) {
#pragma unroll
            for (int n = 0; n < 2; ++n) { const int c = bj * 128 + 4 * n;
                const f32x4 b0 = bias ? *(const f32x4*)(bias + c) : (f32x4){0.f, 0.f, 0.f, 0.f};
                const f32x4 g0 = *(const f32x4*)(gate + c);
#pragma unroll
                for (int ai = 0; ai < 2; ++ai) {
#pragma unroll
                    for (int m = 0; m < 4; ++m) { bf16_t* p = x + (size_t)(ai * 128 + m * 16) * D + c;
                        const u32x2 w = *(const u32x2*)p; const f32x4 x0 = (f32x4){bf_lo(w.x), bf_hi(w.x), bf_lo(w.y), bf_hi(w.y)};
                        const f32x4 o0 = x0 + g0 * (acc[ai][bj][m][n] + b0);
                        u32x2 w2; w2.x = cvt_pk_bf16(o0[0], o0[1]); w2.y = cvt_pk_bf16(o0[2], o0[3]);
                        *(u32x2*)p = w2; }
                    EPI_FENCE(); } } }
    }
};
template <int K>
__device__ __forceinline__ void tail_resid(LAS unsigned char* lds, int wave) {
    const int lane = lane_id_now(), fr = lane & 15, q = lane >> 4, tid = wave * 64 + lane;
    constexpr int KW = K / 8, RP = 68;
    LAS float* red = (LAS float*)lds;
    const bf16_t* A = (const bf16_t*)desc_p(lds, 0, 0) + (size_t)TL * K; const bf16_t* W = (const bf16_t*)desc_p(lds, 0, 2);
    bf16_t* X = (bf16_t*)desc_p(lds, 0, 4) + (size_t)TL * D; const float* bias = (const float*)desc_p(lds, 0, 14); const float* gate = (const float*)desc_p(lds, 1, 10) + 2 * 6 * D;
    for (int item = blockIdx.x; item < TC / 16 * 16; item += gridDim.x) {
        const int r0 = (item >> 4) * 16, c0 = (item & 15) * 64;
        const bf16_t* ap = A + (size_t)(r0 + fr) * K + wave * KW + 16 * q;
        const bf16_t* bp = W + (size_t)(c0 + fr) * K + wave * KW + 16 * q;
        f32x4 acc[4];
#pragma unroll
        for (int n = 0; n < 4; ++n) acc[n] = (f32x4){0.f, 0.f, 0.f, 0.f};
#pragma unroll
        for (int kb = 0; kb < KW / 64; ++kb) {
            const bf16x8 a0 = *(const bf16x8*)(ap + kb * 64), a1 = *(const bf16x8*)(ap + kb * 64 + 8);
#pragma unroll
            for (int n = 0; n < 4; ++n) { const bf16x8 b0 = *(const bf16x8*)(bp + (size_t)n * 16 * K + kb * 64), b1 = *(const bf16x8*)(bp + (size_t)n * 16 * K + kb * 64 + 8);
                acc[n] = __builtin_amdgcn_mfma_f32_16x16x32_bf16(a0, b0, acc[n], 0, 0, 0); acc[n] = __builtin_amdgcn_mfma_f32_16x16x32_bf16(a1, b1, acc[n], 0, 0, 0); }
        }
#pragma unroll
        for (int n = 0; n < 4; ++n)
#pragma unroll
            for (int r = 0; r < 4; ++r) red[(wave * 16 + 4 * q + r) * RP + n * 16 + fr] = acc[n][r];
        __syncthreads();
        { const int row = tid >> 5, c2 = 2 * (tid & 31); float s0 = 0.f, s1 = 0.f;
#pragma unroll
          for (int w = 0; w < 8; ++w) { const f32x2 v = *(LAS const f32x2*)(red + (w * 16 + row) * RP + c2); s0 += v.x; s1 += v.y; }
          const int col = c0 + c2; bf16_t* p = X + (size_t)(r0 + row) * D + col; const unsigned xw = *(const unsigned*)p;
          const float b0 = bias ? bias[col] : 0.f, b1 = bias ? bias[col + 1] : 0.f;
          *(unsigned*)p = cvt_pk_bf16(bf_lo(xw) + gate[col] * (s0 + b0), bf_hi(xw) + gate[col + 1] * (s1 + b1)); }
        __syncthreads();
    }
}
__device__ __forceinline__ void tail_gelu(LAS unsigned char* lds, int wave) {
    const int lane = lane_id_now(), fr = lane & 15, q = lane >> 4, tid = wave * 64 + lane;
    constexpr int K = D, KW = K / 8, RP = 260;
    LAS float* red = (LAS float*)lds;
    const bf16_t* A = (const bf16_t*)desc_p(lds, 0, 0) + (size_t)TL * K; const bf16_t* W = (const bf16_t*)desc_p(lds, 0, 2);
    const float* bias = (const float*)desc_p(lds, 0, 12); float* stat = (float*)desc_p(lds, 0, 14);
    for (int item = blockIdx.x; item < TC / 16 * 16; item += gridDim.x) {
        const int r0 = (item >> 4) * 16, c0 = (item & 15) * 256;
        const bf16_t* ap = A + (size_t)(r0 + fr) * K + wave * KW + 16 * q;
        const bf16_t* bp = W + (size_t)(c0 + fr) * K + wave * KW + 16 * q;
        const bf16x8 a0 = *(const bf16x8*)(ap), a1 = *(const bf16x8*)(ap + 8), a2 = *(const bf16x8*)(ap + 64), a3 = *(const bf16x8*)(ap + 72);
#pragma unroll 1
        for (int ng = 0; ng < 4; ++ng) {
            f32x4 acc[4];
#pragma unroll
            for (int n = 0; n < 4; ++n) { const bf16_t* b = bp + (size_t)(ng * 4 + n) * 16 * K;
                const bf16x8 b0 = *(const bf16x8*)(b), b1 = *(const bf16x8*)(b + 8), b2 = *(const bf16x8*)(b + 64), b3 = *(const bf16x8*)(b + 72);
                f32x4 c = (f32x4){0.f, 0.f, 0.f, 0.f};
                c = __builtin_amdgcn_mfma_f32_16x16x32_bf16(a0, b0, c, 0, 0, 0); c = __builtin_amdgcn_mfma_f32_16x16x32_bf16(a1, b1, c, 0, 0, 0);
                c = __builtin_amdgcn_mfma_f32_16x16x32_bf16(a2, b2, c, 0, 0, 0); c = __builtin_amdgcn_mfma_f32_16x16x32_bf16(a3, b3, c, 0, 0, 0); acc[n] = c; }
#pragma unroll
            for (int n = 0; n < 4; ++n)
#pragma unroll
                for (int r = 0; r < 4; ++r) red[(wave * 16 + 4 * q + r) * RP + (ng * 4 + n) * 16 + fr] = acc[n][r];
        }
        __syncthreads();
        { const int row = tid >> 5, c8 = 8 * (tid & 31); f32x4 s0 = (f32x4){0.f, 0.f, 0.f, 0.f}, s1 = s0;
#pragma unroll
          for (int w = 0; w < 8; ++w) { s0 += *(LAS const f32x4*)(red + (w * 16 + row) * RP + c8); s1 += *(LAS const f32x4*)(red + (w * 16 + row) * RP + c8 + 4); }
          const int col = c0 + c8; const bool isv = col >= GWID; bf16_t* base = (bf16_t*)desc_p(lds, 0, isv ? 10 : 4);
          s0 += *(const f32x4*)(bias + col); s1 += *(const f32x4*)(bias + col + 4);
          const f32x2 a = gelu_pk((f32x2){s0[0], s0[1]}), b = gelu_pk((f32x2){s0[2], s0[3]}), c = gelu_pk((f32x2){s1[0], s1[1]}), d = gelu_pk((f32x2){s1[2], s1[3]});
          u32x4 w; w.x = cvt_pk_bf16(a.x, a.y); w.y = cvt_pk_bf16(b.x, b.y); w.z = cvt_pk_bf16(c.x, c.y); w.w = cvt_pk_bf16(d.x, d.y);
          *(u32x4*)(base + (size_t)(TL + r0 + row) * GWID + (col & (GWID - 1))) = w;
          if (isv) { float s = ((a.x + a.y) + (b.x + b.y)) + ((c.x + c.y) + (d.x + d.y)), qq = ((a.x * a.x + a.y * a.y) + (b.x * b.x + b.y * b.y)) + ((c.x * c.x + c.y * c.y) + (d.x * d.x + d.y * d.y));
              s += shx(s, 1, lane); s += shx(s, 2, lane); s += shx(s, 4, lane); qq += shx(qq, 1, lane); qq += shx(qq, 2, lane); qq += shx(qq, 4, lane);
              if ((lane & 7) == 0) *(f32x2*)(stat + ((size_t)(TL + r0 + row) * 32 + ((col - GWID) >> 6)) * 2) = (f32x2){s, qq}; } }
        __syncthreads();
    }
}
struct EpiAct {
    static constexpr bool PERM = true;
    LAS unsigned char* lds;
    __device__ __forceinline__ void operator()(const f32x4 (&acc)[2][2][4][2], const Unit& u, int wr, int wc, int fr, int fq) const {
        bf16_t* C = (bf16_t*)desc_p(lds, u.aux, 4); const int ldc = desc_i(lds, u.aux, 7), act = desc_i(lds, u.aux, 8);
        const int col0 = u.pn * 256 + wc * 32 + 8 * fq, row0 = u.pm * 256 + wr * 64 + fr;
#pragma unroll
        for (int ai = 0; ai < 2; ++ai)
#pragma unroll
            for (int m = 0; m < 4; ++m) { bf16_t* rowp = C + (size_t)(row0 + ai * 128 + m * 16) * ldc + col0;
#pragma unroll
                for (int bj = 0; bj < 2; ++bj) { f32x4 v0 = acc[ai][bj][m][0], v1 = acc[ai][bj][m][1];
                    if (act == 1) {
#pragma unroll
                        for (int j = 0; j < 4; ++j) { v0[j] = tanhf_(v0[j]); v1[j] = tanhf_(v1[j]); } }
                    else if (act == 2) {
#pragma unroll
                        for (int j = 0; j < 4; ++j) { v0[j] = sigmoidf_(v0[j]); v1[j] = sigmoidf_(v1[j]); } }
                    u32x4 w; w.x = cvt_pk_bf16(v0[0], v0[1]); w.y = cvt_pk_bf16(v0[2], v0[3]); w.z = cvt_pk_bf16(v1[0], v1[1]); w.w = cvt_pk_bf16(v1[2], v1[3]);
                    *(u32x4*)(rowp + bj * 128) = w; } }
    }
};
struct EpiLogits {
    static constexpr bool PERM = false;
    float* LG;
    __device__ __forceinline__ void operator()(const f32x4 (&acc)[2][2][4][2], const Unit& u, int wr, int wc, int fr, int fq) const {
        if (wc >= 2) return;
        const int col0 = wc * 32 + 4 * fq, row0 = u.pm * 256 + wr * 64 + fr;
#pragma unroll
        for (int ai = 0; ai < 2; ++ai)
#pragma unroll
            for (int m = 0; m < 4; ++m)
#pragma unroll
                for (int n = 0; n < 2; ++n) *(f32x4*)(LG + (size_t)(row0 + ai * 128 + m * 16) * 64 + col0 + n * 16) = acc[ai][0][m][n] + acc[ai][1][m][n];
    }
};
struct EpiSiluGate {
    static constexpr bool PERM = true;
    bf16_t* H;
    __device__ __forceinline__ void operator()(const f32x4 (&acc)[2][2][4][2], const Unit& u, int wr, int wc, int fr, int fq) const {
        const int col0 = u.pn * 128 + wc * 32 + 8 * fq, row0 = u.pm * 256 + wr * 64 + fr;
#pragma unroll
        for (int ai = 0; ai < 2; ++ai)
#pragma unroll
            for (int m = 0; m < 4; ++m) { f32x4 h0, h1;
#pragma unroll
                for (int j = 0; j < 4; ++j) { const float g0 = acc[ai][0][m][0][j], g1 = acc[ai][0][m][1][j]; h0[j] = g0 * sigmoidf_(g0) * acc[ai][1][m][0][j]; h1[j] = g1 * sigmoidf_(g1) * acc[ai][1][m][1][j]; }
                u32x4 w; w.x = cvt_pk_bf16(h0[0], h0[1]); w.y = cvt_pk_bf16(h0[2], h0[3]); w.z = cvt_pk_bf16(h1[0], h1[1]); w.w = cvt_pk_bf16(h1[2], h1[3]);
                *(u32x4*)(H + (size_t)(row0 + ai * 128 + m * 16) * EHID + col0) = w; }
    }
};
struct EpiScatter {
    static constexpr bool PERM = true;
    LAS unsigned char* lds; bf16_t* YB; const int* list;
    __device__ __forceinline__ void operator()(const f32x4 (&acc)[2][2][4][2], const Unit& u, int wr, int wc, int fr, int fq) const {
        LAS const int* tab = (LAS const int*)(lds + LDS_TAB);
        const int j0 = __builtin_amdgcn_readfirstlane(tab[MAXRT + u.pm]), cn = __builtin_amdgcn_readfirstlane(tab[2 * MAXRT + u.aux]);
        const int col0 = u.pn * 256 + wc * 32 + 8 * fq;
#pragma unroll
        for (int ai = 0; ai < 2; ++ai)
#pragma unroll
            for (int m = 0; m < 4; ++m) { const int slot = j0 + ai * 128 + wr * 64 + m * 16 + fr;
                if (slot < cn) { const int a = list[(size_t)u.aux * LISTCAP + slot]; bf16_t* rowp = YB + (size_t)a * D + col0;
#pragma unroll
                    for (int bj = 0; bj < 2; ++bj) { const f32x4 v0 = acc[ai][bj][m][0], v1 = acc[ai][bj][m][1];
                        u32x4 w; w.x = cvt_pk_bf16(v0[0], v0[1]); w.y = cvt_pk_bf16(v0[2], v0[3]); w.z = cvt_pk_bf16(v1[0], v1[1]); w.w = cvt_pk_bf16(v1[2], v1[3]);
                        *(u32x4*)(rowp + bj * 128) = w; } } }
    }
};

struct Params { const float* in[42]; float* out; unsigned char* ws; int ph_lo, ph_hi; };
enum { I_X = 0, I_C, I_CTX, I_CCTX, I_ADAW, I_ADAB, I_N1G, I_N2G, I_FG, I_GWIN, I_GBIN, I_GLNG, I_GLNB, I_GWS, I_GBS, I_GWOUT, I_GBOUT,
       I_MU, I_WR, I_WK, I_WV, I_WO, I_W0, I_W1, I_W2, I_A0, I_A1, I_A2, I_G1, I_G2, I_KK, I_KA, I_RK, I_LNG, I_LNB,
       I_MWGRP, I_MBGRP, I_MWEXP, I_MBEXP, I_MWG, I_MWU, I_MWD };
struct Frame { LAS unsigned char* lds; int tid, lane, wave, G, gw, NGW; };
typedef const __attribute__((address_space(4))) Params* KP;

constexpr int TRP = 36, TR_SCR = 64 * TRP * 4;
__device__ __forceinline__ void tr_item(const float* W, int N, int kmax, bf16_t* WT, int ldk, int k0, int n0, int drow0, int dk0, LAS float* scr, int lane) {
    const int n4 = lane & 7, kr = lane >> 3; f32x4 v[8];
#pragma unroll
    for (int i = 0; i < 8; ++i) { const int k = k0 + 8 * i + kr; v[i] = k < kmax ? *(const f32x4*)(W + (size_t)k * N + n0 + 4 * n4) : (f32x4){0.f, 0.f, 0.f, 0.f}; }
#pragma unroll
    for (int i = 0; i < 8; ++i) *(LAS f32x4*)(scr + (8 * i + kr) * TRP + 4 * n4) = v[i];
    asm volatile("s_waitcnt lgkmcnt(0)" ::: "memory");
    const int c = lane & 7;
#pragma unroll
    for (int j = 0; j < 4; ++j) { const int n = (lane >> 3) + 8 * j; const LAS float* sp = scr + (8 * c) * TRP + n;
        u32x4 o; o.x = cvt_pk_bf16(sp[0 * TRP], sp[1 * TRP]); o.y = cvt_pk_bf16(sp[2 * TRP], sp[3 * TRP]); o.z = cvt_pk_bf16(sp[4 * TRP], sp[5 * TRP]); o.w = cvt_pk_bf16(sp[6 * TRP], sp[7 * TRP]);
        *(u32x4*)(WT + (size_t)(drow0 + n) * ldk + dk0 + k0 + 8 * c) = o; }
    asm volatile("s_waitcnt lgkmcnt(0)" ::: "memory");
}
constexpr int LDS_JOBS = 80 * 1024, MAXJOBS = 48;
__device__ __forceinline__ void add_job(LAS int* jobs, int& nj, int& nit, const float* src, int N, int kmax, int kpad, bf16_t* dst, int ldk, int drow0, int dk0) {
    LAS int* q = jobs + nj * 12; const unsigned long long a = (unsigned long long)src, d = (unsigned long long)dst;
    q[0] = (int)(unsigned)a; q[1] = (int)(unsigned)(a >> 32); q[2] = (int)(unsigned)d; q[3] = (int)(unsigned)(d >> 32); q[4] = N; q[5] = kmax; q[6] = kpad / 64; q[7] = ldk; q[8] = drow0; q[9] = dk0; q[10] = nit;
    nit += (kpad / 64) * (N / 32); ++nj;
}
__device__ __forceinline__ void zero_fill(const Frame& F, bf16_t* p, size_t nbytes) {
    u32x4* q = (u32x4*)p; const size_t n = nbytes / 16;
    for (size_t i = (size_t)blockIdx.x * NTHR + F.tid; i < n; i += (size_t)F.G * NTHR) q[i] = (u32x4){0u, 0u, 0u, 0u};
}

__device__ __forceinline__ void prologue_phase(const Frame& F, KP P) {
    unsigned char* ws = P->ws;
    {   float* MOD = (float*)(ws + WS_MOD); LAS float* part = (LAS float*)F.lds;
        const float* c = P->in[I_C]; const float* cc = P->in[I_CCTX];
        for (int item = blockIdx.x; item < DEPTH * 24; item += F.G) {
            const int layer = item / 24, col = (item % 24) * 256 + 4 * F.lane; const float* w = P->in[I_ADAW] + (size_t)layer * D * 6 * D + col;
            f32x4 a0 = (f32x4){0.f, 0.f, 0.f, 0.f}, a1 = a0, a2 = a0;
#pragma unroll 8
            for (int i = 0; i < 128; ++i) { const int d = F.wave + 8 * i; const f32x4 wv = *(const f32x4*)(w + (size_t)d * 6 * D);
                const float c0 = c[d], c1 = c[D + d], c2 = cc[d];
                a0 += wv * (c0 * sigmoidf_(c0)); a1 += wv * (c1 * sigmoidf_(c1)); a2 += wv * (c2 * sigmoidf_(c2)); }
            __syncthreads();
            *(LAS f32x4*)(part + (F.wave * 3 + 0) * 256 + 4 * F.lane) = a0; *(LAS f32x4*)(part + (F.wave * 3 + 1) * 256 + 4 * F.lane) = a1; *(LAS f32x4*)(part + (F.wave * 3 + 2) * 256 + 4 * F.lane) = a2;
            __syncthreads();
            if (F.wave < 3) { f32x4 sacc = (f32x4){0.f, 0.f, 0.f, 0.f};
#pragma unroll
                for (int w8 = 0; w8 < 8; ++w8) sacc += *(const LAS f32x4*)(part + (w8 * 3 + F.wave) * 256 + 4 * F.lane);
                *(f32x4*)(MOD + ((size_t)layer * 3 + F.wave) * 6 * D + col) = sacc + *(const f32x4*)(P->in[I_ADAB] + (size_t)layer * 6 * D + col); }
        }
    }
    LAS int* jobs = (LAS int*)(F.lds + LDS_JOBS); LAS int* jtot = jobs + MAXJOBS * 12;
    __syncthreads();
    if (F.tid == 0) { int nj = 0, nit = 0;
        for (int j = 0; j < 2; ++j) {
            add_job(jobs, nj, nit, P->in[I_GWIN] + (size_t)j * D * 4096, 4096, D, D, (bf16_t*)(ws + WS_WIN) + (size_t)j * 4096 * D, D, 0, 0);
            add_job(jobs, nj, nit, P->in[I_GWOUT] + (size_t)j * GWID * D, D, GWID, GWID, (bf16_t*)(ws + WS_WOUT) + (size_t)j * D * GWID, GWID, 0, 0);
            add_job(jobs, nj, nit, P->in[I_WR] + (size_t)j * D * D, D, D, D, (bf16_t*)(ws + WS_WR) + (size_t)j * D * D, D, 0, 0);
            add_job(jobs, nj, nit, P->in[I_WK] + (size_t)j * D * D, D, D, D, (bf16_t*)(ws + WS_WK) + (size_t)j * D * D, D, 0, 0);
            add_job(jobs, nj, nit, P->in[I_WV] + (size_t)j * D * D, D, D, D, (bf16_t*)(ws + WS_WV) + (size_t)j * D * D, D, 0, 0);
            add_job(jobs, nj, nit, P->in[I_WO] + (size_t)j * D * D, D, D, D, (bf16_t*)(ws + WS_WO) + (size_t)j * D * D, D, 0, 0);
            for (int z = 0; z < 2; ++z) {
                add_job(jobs, nj, nit, P->in[I_W1] + ((size_t)j * 2 + z) * D * 64, 64, D, D, (bf16_t*)(ws + WS_LW1) + (size_t)j * 256 * D, D, z * 64, 0);
                add_job(jobs, nj, nit, P->in[I_A1] + ((size_t)j * 2 + z) * D * 64, 64, D, D, (bf16_t*)(ws + WS_LA1) + (size_t)j * 256 * D, D, z * 64, 0);
                add_job(jobs, nj, nit, P->in[I_W2] + ((size_t)j * 2 + z) * 64 * D, D, 64, 64, (bf16_t*)(ws + WS_W2P) + ((size_t)j * 2 + z) * D * 256, 256, 0, z * 64);
                add_job(jobs, nj, nit, P->in[I_A2] + ((size_t)j * 2 + z) * 64 * D, D, 64, 64, (bf16_t*)(ws + WS_A2P) + ((size_t)j * 2 + z) * D * 256, 256, 0, z * 64); }
            add_job(jobs, nj, nit, P->in[I_G1] + (size_t)j * D * 160, 160, D, D, (bf16_t*)(ws + WS_LG1) + (size_t)j * 256 * D, D, 0, 0);
            add_job(jobs, nj, nit, P->in[I_G2] + (size_t)j * 160 * D, D, 160, 256, (bf16_t*)(ws + WS_G2P) + (size_t)j * D * 256, 256, 0, 0); }
        jtot[0] = nj; jtot[1] = nit; }
    __syncthreads();
    {   const int nj = jtot[0], nit = jtot[1]; LAS float* scr = (LAS float*)(F.lds + F.wave * TR_SCR);
        for (int it = F.gw; it < nit; it += F.NGW) {
            int jb = 0; for (int q = 1; q < nj; ++q) if (it >= jobs[q * 12 + 10]) jb = q;
            jb = __builtin_amdgcn_readfirstlane(jb); LAS const int* q = jobs + jb * 12;
            const float* src = (const float*)(((unsigned long long)(unsigned)q[1] << 32) | (unsigned)q[0]); bf16_t* dst = (bf16_t*)(((unsigned long long)(unsigned)q[3] << 32) | (unsigned)q[2]);
            const int N = q[4], nnb = N / 32, r = it - q[10], kb = r / nnb, nb = r % nnb;
            tr_item(src, N, q[5], dst, q[7], kb * 64, nb * 32, q[8] + nb * 32, q[9], scr, F.lane); }
    }
    for (int j = 0; j < 2; ++j) {
        bf16_t* lw1 = (bf16_t*)(ws + WS_LW1) + (size_t)j * 256 * D; bf16_t* la1 = (bf16_t*)(ws + WS_LA1) + (size_t)j * 256 * D; bf16_t* lg1 = (bf16_t*)(ws + WS_LG1) + (size_t)j * 256 * D;
        zero_fill(F, lw1 + 128 * D, (size_t)128 * D * 2); zero_fill(F, la1 + 128 * D, (size_t)128 * D * 2); zero_fill(F, lg1 + 160 * D, (size_t)96 * D * 2);
        for (int z = 0; z < 2; ++z) { bf16_t* w2p = (bf16_t*)(ws + WS_W2P) + ((size_t)j * 2 + z) * D * 256; bf16_t* a2p = (bf16_t*)(ws + WS_A2P) + ((size_t)j * 2 + z) * D * 256;
            for (int idx = blockIdx.x * NTHR + F.tid; idx < D * 32; idx += F.G * NTHR) { const int n = idx >> 5, ch = idx & 31;
                if ((ch >> 3) != z) { *(u32x4*)(w2p + (size_t)n * 256 + ch * 8) = (u32x4){0u, 0u, 0u, 0u}; *(u32x4*)(a2p + (size_t)n * 256 + ch * 8) = (u32x4){0u, 0u, 0u, 0u}; } } }
    }
    {   bf16_t* wrt = (bf16_t*)(ws + WS_WRT);
        for (int idx = blockIdx.x * NTHR + F.tid; idx < DEPTH * 256 * (D / 8); idx += F.G * NTHR) { const int k0 = (idx & 127) * 8, n = (idx >> 7) & 255, layer = idx >> 15;
            const int nn = n & 127; const bool lo = n >= 128; float w[8];
#pragma unroll
            for (int e = 0; e < 8; ++e) { float x = 0.f;
                if (nn < 4) x = P->in[I_MWGRP][((size_t)layer * D + k0 + e) * 4 + nn]; else if (nn < 36) x = P->in[I_MWEXP][((size_t)layer * D + k0 + e) * NE + nn - 4];
                const float hi = bf_lo(cvt_pk_bf16(x, 0.f)); w[e] = lo ? x - hi : x; }
            *(u32x4*)(wrt + ((size_t)layer * 256 + n) * D + k0) = pack8(w); } }
    {   const float* src = P->in[I_GWS]; bf16_t* dst = (bf16_t*)(ws + WS_WSP); const int n8 = 2 * 16 * 128 * 128 / 8;
        for (int i = blockIdx.x * NTHR + F.tid; i < n8; i += F.G * NTHR) { const f32x4 a = *(const f32x4*)(src + (size_t)i * 8), b = *(const f32x4*)(src + (size_t)i * 8 + 4);
            u32x4 o; o.x = cvt_pk_bf16(a[0], a[1]); o.y = cvt_pk_bf16(a[2], a[3]); o.z = cvt_pk_bf16(b[0], b[1]); o.w = cvt_pk_bf16(b[2], b[3]); *(u32x4*)(dst + (size_t)i * 8) = o; } }
}
struct MoeItem { const float* src; bf16_t* dst; int N, kmax, ldk, k0, n0, drow0; };
__device__ __forceinline__ MoeItem moe_item(KP P, unsigned char* ws, int layer, int it) {
    const int e = it / 768, r = it % 768, m = r >> 8, q = r & 255; const size_t so = ((size_t)layer * NE + e) * (size_t)D * EHID; MoeItem I;
    if (m < 2) { const int kb = q >> 4, n0 = (q & 15) * 32;
        I.src = (m == 0 ? P->in[I_MWG] : P->in[I_MWU]) + so; I.N = EHID; I.kmax = D; I.dst = (bf16_t*)(ws + WS_WGU) + (size_t)e * D * D; I.ldk = D; I.k0 = kb * 64; I.n0 = n0; I.drow0 = 256 * (n0 >> 7) + (n0 & 127) + (m == 1 ? 128 : 0); }
    else { const int kb = q >> 5, n0 = (q & 31) * 32;
        I.src = P->in[I_MWD] + so; I.N = D; I.kmax = EHID; I.dst = (bf16_t*)(ws + WS_WD) + (size_t)e * D * EHID; I.ldk = EHID; I.k0 = kb * 64; I.n0 = n0; I.drow0 = n0; }
    return I;
}
__device__ __forceinline__ void tr_load(const MoeItem& I, int lane, f32x4 (&v)[8]) {
    const int n4 = lane & 7, kr = lane >> 3;
#pragma unroll
    for (int i = 0; i < 8; ++i) v[i] = *(const f32x4*)(I.src + (size_t)(I.k0 + 8 * i + kr) * I.N + I.n0 + 4 * n4);
}
__device__ __forceinline__ void tr_store(const MoeItem& I, int lane, const f32x4 (&v)[8], LAS float* scr) {
    const int n4 = lane & 7, kr = lane >> 3;
#pragma unroll
    for (int i = 0; i < 8; ++i) *(LAS f32x4*)(scr + (8 * i + kr) * TRP + 4 * n4) = v[i];
    asm volatile("s_waitcnt lgkmcnt(0)" ::: "memory");
    const int c = lane & 7;
#pragma unroll
    for (int j = 0; j < 4; ++j) { const int n = (lane >> 3) + 8 * j; const LAS float* sp = scr + (8 * c) * TRP + n;
        u32x4 o; o.x = cvt_pk_bf16(sp[0 * TRP], sp[1 * TRP]); o.y = cvt_pk_bf16(sp[2 * TRP], sp[3 * TRP]); o.z = cvt_pk_bf16(sp[4 * TRP], sp[5 * TRP]); o.w = cvt_pk_bf16(sp[6 * TRP], sp[7 * TRP]);
        *(u32x4*)(I.dst + (size_t)(I.drow0 + n) * I.ldk + I.k0 + 8 * c) = o; }
    asm volatile("s_waitcnt lgkmcnt(0)" ::: "memory");
}
constexpr int MOE_ITEMS = NE * 768, MOE_SPLIT = 14336;
__device__ __forceinline__ void moe_weights_phase(const Frame& F, KP P, int layer, int vgw, int vngw, int it0, int it1) {
    unsigned char* ws = P->ws; LAS float* scr = (LAS float*)(F.lds + F.wave * TR_SCR);
    int it = it0 + vgw; f32x4 v[8], vn[8];
    if (it < it1) { const MoeItem I = moe_item(P, ws, layer, it); tr_load(I, F.lane, v); }
#pragma nounroll
    while (it < it1) { const int nx = it + vngw;
        if (nx < it1) { const MoeItem In = moe_item(P, ws, layer, nx); tr_load(In, F.lane, vn); }
        { const MoeItem I = moe_item(P, ws, layer, it); tr_store(I, F.lane, v, scr); }
#pragma unroll
        for (int i = 0; i < 8; ++i) v[i] = vn[i];
        it = nx; }
}

__device__ __forceinline__ void load_xrow(KP P, const Frame& F, int layer, int row, f32x4 (&v)[4]) {
    if (layer == 0) { const float* xr = row < TL ? P->in[I_X] + (size_t)row * D : P->in[I_CTX] + (size_t)(row - TL) * D;
#pragma unroll
        for (int j = 0; j < 4; ++j) v[j] = *(const f32x4*)(xr + 4 * F.lane + 256 * j); }
    else { const bf16_t* xr = (const bf16_t*)(P->ws + WS_X) + (size_t)row * D;
#pragma unroll
        for (int j = 0; j < 4; ++j) { const u32x2 w = *(const u32x2*)(xr + 4 * F.lane + 256 * j); v[j] = (f32x4){bf_lo(w.x), bf_hi(w.x), bf_lo(w.y), bf_hi(w.y)}; } }
}
__device__ __forceinline__ void load_combine(KP P, const Frame& F, int layer, int row, int m, bool combine, f32x4 (&v)[4]) {
    load_xrow(P, F, layer, row, v);
    if (combine) {
        const bf16_t* yb = (const bf16_t*)(P->ws + WS_YB); const float* wg = (const float*)(P->ws + WS_WGT);
        const float w0 = wg[2 * row], w1 = wg[2 * row + 1]; const float* g2 = (const float*)(P->ws + WS_MOD) + ((size_t)(layer - 1) * 3 + m) * 6 * D + 5 * D;
#pragma unroll
        for (int j = 0; j < 4; ++j) { const int col = 4 * F.lane + 256 * j; const u32x2 a = *(const u32x2*)(yb + (size_t)(2 * row) * D + col), b = *(const u32x2*)(yb + (size_t)(2 * row + 1) * D + col);
            const f32x4 g = *(const f32x4*)(g2 + col);
            v[j][0] += g[0] * (w0 * bf_lo(a.x) + w1 * bf_lo(b.x)); v[j][1] += g[1] * (w0 * bf_hi(a.x) + w1 * bf_hi(b.x));
            v[j][2] += g[2] * (w0 * bf_lo(a.y) + w1 * bf_lo(b.y)); v[j][3] += g[3] * (w0 * bf_hi(a.y) + w1 * bf_hi(b.y)); }
    }
}
__device__ __forceinline__ void norm1_phase(const Frame& F, KP P, int layer) {
    const bool combine = layer > 0; bf16_t* X = (bf16_t*)(P->ws + WS_X); bf16_t* HL = (bf16_t*)(P->ws + WS_HL);
    const float* g1 = P->in[I_N1G] + (size_t)layer * D;
    for (int row = F.gw; row < T; row += F.NGW) {
        const int m = row < TL ? (row >> 14) : 2; f32x4 v[4];
        load_combine(P, F, layer, row, m, combine, v);
        {
#pragma unroll
            for (int j = 0; j < 4; ++j) { u32x2 o; o.x = cvt_pk_bf16(v[j][0], v[j][1]); o.y = cvt_pk_bf16(v[j][2], v[j][3]); *(u32x2*)(X + (size_t)row * D + 4 * F.lane + 256 * j) = o;
                v[j] = (f32x4){bf_lo(o.x), bf_hi(o.x), bf_lo(o.y), bf_hi(o.y)}; } }
        float ss = 0.f;
#pragma unroll
        for (int j = 0; j < 4; ++j) ss += (v[j][0] * v[j][0] + v[j][1] * v[j][1]) + (v[j][2] * v[j][2] + v[j][3] * v[j][3]);
        const float rstd = rsqrtf(wave_sum(ss, F.lane) * (1.0f / D) + 1e-6f);
        const float* mod = (const float*)(P->ws + WS_MOD) + ((size_t)layer * 3 + m) * 6 * D;
#pragma unroll
        for (int j = 0; j < 4; ++j) { const int col = 4 * F.lane + 256 * j; const f32x4 g = *(const f32x4*)(g1 + col), sh = *(const f32x4*)(mod + col), sc = *(const f32x4*)(mod + D + col);
            const f32x4 h = (v[j] * rstd) * g * (sc + 1.0f) + sh;
            u32x2 o; o.x = cvt_pk_bf16(h[0], h[1]); o.y = cvt_pk_bf16(h[2], h[3]); *(u32x2*)(HL + (size_t)row * D + col) = o; }
    }
}
__device__ __forceinline__ void final_phase(const Frame& F, KP P) {
    const float* fg = P->in[I_FG];
    for (int row = F.gw; row < TL; row += F.NGW) {
        const int m = row >> 14; f32x4 v[4];
        load_combine(P, F, DEPTH, row, m, true, v);
        float ss = 0.f;
#pragma unroll
        for (int j = 0; j < 4; ++j) ss += (v[j][0] * v[j][0] + v[j][1] * v[j][1]) + (v[j][2] * v[j][2] + v[j][3] * v[j][3]);
        const float rstd = rsqrtf(wave_sum(ss, F.lane) * (1.0f / D) + 1e-6f);
#pragma unroll
        for (int j = 0; j < 4; ++j) { const int col = 4 * F.lane + 256 * j; *(f32x4*)(P->out + (size_t)row * D + col) = (v[j] * rstd) * *(const f32x4*)(fg + col); }
    }
}
__device__ __forceinline__ void norm2_phase(const Frame& F, KP P, int layer) {
    const int ntok = layer == DEPTH - 1 ? TL : T; bf16_t* HL2 = (bf16_t*)(P->ws + WS_HL); const float* g2n = P->in[I_N2G] + (size_t)layer * D;
    for (int row = F.gw; row < ntok; row += F.NGW) {
        const int m = row < TL ? (row >> 14) : 2; f32x4 v[4]; load_xrow(P, F, 1, row, v);
        float ss = 0.f;
#pragma unroll
        for (int j = 0; j < 4; ++j) ss += (v[j][0] * v[j][0] + v[j][1] * v[j][1]) + (v[j][2] * v[j][2] + v[j][3] * v[j][3]);
        const float rstd = rsqrtf(wave_sum(ss, F.lane) * (1.0f / D) + 1e-6f);
        const float* mod = (const float*)(P->ws + WS_MOD) + ((size_t)layer * 3 + m) * 6 * D;
#pragma unroll
        for (int j = 0; j < 4; ++j) { const int col = 4 * F.lane + 256 * j; const f32x4 g = *(const f32x4*)(g2n + col), sh = *(const f32x4*)(mod + 3 * D + col), sc = *(const f32x4*)(mod + 4 * D + col);
            const f32x4 h = (v[j] * rstd) * g * (sc + 1.0f) + sh;
            u32x2 o; o.x = cvt_pk_bf16(h[0], h[1]); o.y = cvt_pk_bf16(h[2], h[3]); *(u32x2*)(HL2 + (size_t)row * D + col) = o; }
    }
    if (!(layer & 1)) moe_weights_phase(F, P, layer, F.gw, F.NGW, 0, MOE_SPLIT);
}
__device__ __forceinline__ void route_phase(const Frame& F, KP P, int layer) {
    const int ntok = layer == DEPTH - 1 ? TL : T; const float* LG = (const float*)(P->ws + WS_LG);
    const float* bgrp = P->in[I_MBGRP] + layer * 4; const float* bexp = P->in[I_MBEXP] + layer * NE;
    unsigned* cnt = (unsigned*)(P->ws + WS_CTL) + CW_CNT + layer * 64; int* list = (int*)(P->ws + WS_LIST); float* wgt = (float*)(P->ws + WS_WGT);
    LAS unsigned* lcnt = (LAS unsigned*)F.lds; LAS unsigned* lbase = lcnt + 32;
    for (int r0 = blockIdx.x * NTHR; r0 < ntok; r0 += F.G * NTHR) {
        const int row = r0 + F.tid; const bool act = row < ntok;
        __syncthreads();
        if (F.tid < 32) lcnt[F.tid] = 0u;
        __syncthreads();
        int e0 = 0, e1 = 0; unsigned k0 = 0, k1 = 0;
        if (act) {
            const float* lg = LG + (size_t)row * 64; const f32x4 g4 = *(const f32x4*)lg;
            float ag[4];
#pragma unroll
            for (int i = 0; i < 4; ++i) ag[i] = g4[i] + bgrp[i];
            int grp = 0; float mx = ag[0];
#pragma unroll
            for (int i = 1; i < 4; ++i) if (ag[i] > mx) { mx = ag[i]; grp = i; }
            float den = 0.f;
#pragma unroll
            for (int i = 0; i < 4; ++i) den += __expf(ag[i] - mx);
            const float pg = 1.0f / den;
            const f32x4 e0v = *(const f32x4*)(lg + 4 + 8 * grp), e1v = *(const f32x4*)(lg + 8 + 8 * grp); const f32x4 b0v = *(const f32x4*)(bexp + 8 * grp), b1v = *(const f32x4*)(bexp + 8 * grp + 4);
            float el[8];
#pragma unroll
            for (int i = 0; i < 4; ++i) { el[i] = e0v[i] + b0v[i]; el[4 + i] = e1v[i] + b1v[i]; }
            int i0 = 0; float t0 = el[0];
#pragma unroll
            for (int i = 1; i < 8; ++i) if (el[i] > t0) { t0 = el[i]; i0 = i; }
            int i1 = -1; float t1 = -3.0e38f;
#pragma unroll
            for (int i = 0; i < 8; ++i) if (i != i0 && el[i] > t1) { t1 = el[i]; i1 = i; }
            const float p0 = 1.0f / (1.0f + __expf(t1 - t0));
            wgt[2 * row] = pg * p0; wgt[2 * row + 1] = pg * (1.0f - p0);
            e0 = grp * 8 + i0; e1 = grp * 8 + i1;
            k0 = atomicAdd((unsigned*)(lcnt + e0), 1u); k1 = atomicAdd((unsigned*)(lcnt + e1), 1u);
        }
        __syncthreads();
        if (F.tid < 32) { const unsigned c = lcnt[F.tid]; lbase[F.tid] = c ? atomicAdd(cnt + F.tid, c) : 0u; }
        __syncthreads();
        if (act) { list[(size_t)e0 * LISTCAP + lbase[e0] + k0] = 2 * row; list[(size_t)e1 * LISTCAP + lbase[e1] + k1] = 2 * row + 1; }
    }
}
__device__ __forceinline__ bf16x8 tr_frag136(const LAS bf16_t* M, int k0, int c0, int lane) {
    LAS bf16_t* p = (LAS bf16_t*)M + (k0 + 8 * (lane >> 4) + ((lane & 15) >> 2)) * 136 + c0 + 4 * (lane & 3);
    const v4s lo = __builtin_amdgcn_ds_read_tr16_b64_v4i16((LAS v4s*)p), hi = __builtin_amdgcn_ds_read_tr16_b64_v4i16((LAS v4s*)(p + 4 * 136));
    return (bf16x8){lo[0], lo[1], lo[2], lo[3], hi[0], hi[1], hi[2], hi[3]};
}
__device__ __forceinline__ bf16x8 tr_frag136p(const LAS bf16_t* M, int k0, int dt, int lane) {
    LAS bf16_t* p = (LAS bf16_t*)M + (k0 + 8 * (lane >> 4) + ((lane & 15) >> 2)) * 136 + 32 * (dt >> 1) + 8 * (lane & 3) + 4 * (dt & 1);
    const v4s lo = __builtin_amdgcn_ds_read_tr16_b64_v4i16((LAS v4s*)p), hi = __builtin_amdgcn_ds_read_tr16_b64_v4i16((LAS v4s*)(p + 4 * 136));
    return (bf16x8){lo[0], lo[1], lo[2], lo[3], hi[0], hi[1], hi[2], hi[3]};
}
__device__ __forceinline__ void spatial_phase(const Frame& F, KP P, int j) {
    bf16_t* U = (bf16_t*)(P->ws + WS_U); const bf16_t* V = (const bf16_t*)(P->ws + WS_V); const float* stat = (const float*)(P->ws + WS_STAT);
    const bf16_t* WSP = (const bf16_t*)(P->ws + WS_WSP) + (size_t)j * 16 * 128 * 128;
    const float* lng = P->in[I_GLNG] + (size_t)j * GWID; const float* lnb = P->in[I_GLNB] + (size_t)j * GWID; const float* bs = P->in[I_GBS] + (size_t)j * 16 * 128;
    LAS bf16_t* Wt = (LAS bf16_t*)F.lds; LAS bf16_t* Vn = Wt + 128 * 136;
    LAS float* mu = (LAS float*)(F.lds + 2 * 128 * 136 * 2); LAS float* rs = mu + 128;
    const int l15 = F.lane & 15, l4 = F.lane >> 4;
    constexpr int NUNIT = (T / 128) * 16;
    const int u0 = (int)((long)blockIdx.x * NUNIT / F.G), u1 = (int)((long)(blockIdx.x + 1) * NUNIT / F.G);
#define SP_LOAD(W_, V_, U_, t0_, g_) do { \
        _Pragma("unroll") for (int i = 0; i < 4; ++i) { const int idx = F.tid + NTHR * i, r = idx >> 4, seg = idx & 15; \
            W_[i] = *(const u32x4*)(WSP + ((size_t)(g_) * 128 + r) * 128 + seg * 8); V_[i] = *(const u32x4*)(V + (size_t)((t0_) + r) * GWID + (g_) * 128 + seg * 8); } \
        { const bf16_t* ur_ = U + (size_t)((t0_) + 16 * F.wave + l15) * GWID + (g_) * 128 + 8 * l4; \
          _Pragma("unroll") for (int e = 0; e < 4; ++e) U_[e] = *(const u32x4*)(ur_ + e * 32); } } while (0)
    u32x4 wv[4], vv[4], uu[4];
    if (u0 < u1) SP_LOAD(wv, vv, uu, (u0 >> 4) * 128, u0 & 15);
    int cprev = -1;
#pragma nounroll
    for (int u = u0; u < u1; ++u) { const int c = u >> 4, g = u & 15, t0 = c * 128;
        if (c != cprev) { cprev = c;
            if (F.tid < 128) { const int row = t0 + F.tid; float s = 0.f, q = 0.f;
#pragma unroll 8
                for (int i = 0; i < 32; ++i) { const f32x2 p = *(const f32x2*)(stat + ((size_t)row * 32 + i) * 2); s += p.x; q += p.y; }
                const float mean = s * (1.0f / GWID), var = q * (1.0f / GWID) - mean * mean; mu[F.tid] = mean; rs[F.tid] = rsqrtf(var + 1e-5f); } }
        LDS_BARRIER();
#pragma unroll
        for (int i = 0; i < 4; ++i) { const int idx = F.tid + NTHR * i, r = idx >> 4, seg = idx & 15, ch = g * 128 + seg * 8;
            *(LAS u32x4*)(Wt + r * 136 + seg * 8) = wv[i];
            float x[8], o[8]; unpack8(vv[i], x); const float m_ = mu[r], r_ = rs[r];
            const f32x4 g0 = *(const f32x4*)(lng + ch), g1 = *(const f32x4*)(lng + ch + 4), b0 = *(const f32x4*)(lnb + ch), b1 = *(const f32x4*)(lnb + ch + 4);
#pragma unroll
            for (int e = 0; e < 8; ++e) o[e] = (x[e] - m_) * r_ * (e < 4 ? g0[e & 3] : g1[e & 3]) + (e < 4 ? b0[e & 3] : b1[e & 3]);
            *(LAS u32x4*)(Vn + r * 136 + seg * 8) = pack8(o); }
        u32x4 wn[4], vn[4], un[4];
        if (u + 1 < u1) SP_LOAD(wn, vn, un, ((u + 1) >> 4) * 128, (u + 1) & 15);
        LDS_BARRIER();
        bf16x8 bw[4];
#pragma unroll
        for (int ks = 0; ks < 4; ++ks) bw[ks] = *(const LAS bf16x8*)(Wt + (16 * F.wave + l15) * 136 + ks * 32 + 8 * l4);
        const int p = 16 * F.wave + l15; const float bias = bs[g * 128 + p];
        bf16_t* urow = U + (size_t)(t0 + p) * GWID + g * 128 + 8 * l4;
#pragma unroll
        for (int e = 0; e < 4; ++e) { f32x4 a0 = (f32x4){0.f, 0.f, 0.f, 0.f}, a1 = a0;
#pragma unroll
            for (int ks = 0; ks < 4; ++ks) { const bf16x8 f0 = tr_frag136p(Vn, 32 * ks, 2 * e, F.lane), f1 = tr_frag136p(Vn, 32 * ks, 2 * e + 1, F.lane);
                a0 = __builtin_amdgcn_mfma_f32_16x16x32_bf16(f0, bw[ks], a0, 0, 0, 0); a1 = __builtin_amdgcn_mfma_f32_16x16x32_bf16(f1, bw[ks], a1, 0, 0, 0); }
            u32x4 o; o.x = cvt_pk_bf16(bf_lo(uu[e].x) * (a0[0] + bias), bf_hi(uu[e].x) * (a0[1] + bias)); o.y = cvt_pk_bf16(bf_lo(uu[e].y) * (a0[2] + bias), bf_hi(uu[e].y) * (a0[3] + bias));
            o.z = cvt_pk_bf16(bf_lo(uu[e].z) * (a1[0] + bias), bf_hi(uu[e].z) * (a1[1] + bias)); o.w = cvt_pk_bf16(bf_lo(uu[e].w) * (a1[2] + bias), bf_hi(uu[e].w) * (a1[3] + bias));
            *(u32x4*)(urow + e * 32) = o; }
        if (u + 1 < u1) {
#pragma unroll
            for (int i = 0; i < 4; ++i) { wv[i] = wn[i]; vv[i] = vn[i]; uu[i] = un[i]; } }
    }
#undef SP_LOAD
}

__device__ __forceinline__ void mix_phase(const Frame& F, KP P, int j) {
    const bf16_t* HL = (const bf16_t*)(P->ws + WS_HL); const float* mu = P->in[I_MU] + (size_t)j * 6 * D;
    bf16_t* outs[6] = {(bf16_t*)(P->ws + WS_XR), (bf16_t*)(P->ws + WS_XW), (bf16_t*)(P->ws + WS_XK), (bf16_t*)(P->ws + WS_XV), (bf16_t*)(P->ws + WS_XA), (bf16_t*)(P->ws + WS_XG)};
    f32x4 mr[2][6][2];
#pragma unroll
    for (int jj = 0; jj < 2; ++jj)
#pragma unroll
        for (int m = 0; m < 6; ++m) { const int col = 512 * jj + 8 * F.lane; mr[jj][m][0] = *(const f32x4*)(mu + (size_t)m * D + col); mr[jj][m][1] = *(const f32x4*)(mu + (size_t)m * D + col + 4); }
    for (int row = F.gw; row < T; row += F.NGW) {
        bool ok[2]; int src[2]; const bool hi = F.lane >= 32;
        if (row < TL) { const int n = row & (SEQ - 1), gc = n & 63, gr = n >> 6;
            ok[0] = hi ? gc < 63 : gc > 0; src[0] = hi ? row + 1 : row - 1; ok[1] = hi ? gr < 255 : gr > 0; src[1] = hi ? row + 64 : row - 64; }
        else { const int n = (row - TL) & (CTXL - 1); ok[0] = n > 0; src[0] = row - 1; ok[1] = n < CTXL - 1; src[1] = row + 1; }
#pragma unroll
        for (int jj = 0; jj < 2; ++jj) { const int col = 512 * jj + 8 * F.lane;
            const u32x4 h8 = *(const u32x4*)(HL + (size_t)row * D + col); u32x4 s8 = (u32x4){0u, 0u, 0u, 0u};
            if (ok[jj]) s8 = *(const u32x4*)(HL + (size_t)src[jj] * D + col);
            const unsigned hw[4] = {h8.x, h8.y, h8.z, h8.w}, sw[4] = {s8.x, s8.y, s8.z, s8.w}; float h[8], xx[8];
#pragma unroll
            for (int e = 0; e < 8; ++e) { h[e] = (e & 1) ? bf_hi(hw[e >> 1]) : bf_lo(hw[e >> 1]); const float s = (e & 1) ? bf_hi(sw[e >> 1]) : bf_lo(sw[e >> 1]); xx[e] = s - h[e]; }
#pragma unroll
            for (int m = 0; m < 6; ++m) { const f32x4 ma = mr[jj][m][0], mb = mr[jj][m][1];
                u32x4 o; o.x = cvt_pk_bf16(h[0] + xx[0] * ma[0], h[1] + xx[1] * ma[1]); o.y = cvt_pk_bf16(h[2] + xx[2] * ma[2], h[3] + xx[3] * ma[3]);
                o.z = cvt_pk_bf16(h[4] + xx[4] * mb[0], h[5] + xx[5] * mb[1]); o.w = cvt_pk_bf16(h[6] + xx[6] * mb[2], h[7] + xx[7] * mb[3]);
                *(u32x4*)(outs[m] + (size_t)row * D + col) = o; } }
    }
}

constexpr int NCH = 5, SCP = NCH * 64, NSC = (SEQ + CTXL) / SCP, NSCAN = 64, TP = 72, TILE_B = 64 * TP * 2;
static_assert(NSC * SCP == SEQ + CTXL, "super-chunks");
enum { T_AT = 0, T_RT, T_BT, T_KT, T_VM, T_NT, T_MT, T_NRT, T_MRT, T_APA, T_APB, T_TAA, T_TAB, T_PRB, T_QRB, T_NTILE };
constexpr int LDS_GL = T_NTILE * TILE_B, LDS_SEG = LDS_GL + 256;
static_assert(LDS_SEG + 2048 <= LDS_MISC, "scan LDS map");
__device__ __forceinline__ int scan_row(int z, int b, int p) {
    if (p < CTXL) return TL + b * CTXL + (z ? CTXL - 1 - p : p);
    const int q = p - CTXL; return b * SEQ + (z ? SEQ - 1 - q : q);
}
__device__ __forceinline__ LAS bf16_t* stile(LAS unsigned char* lds, int n) { return (LAS bf16_t*)(lds + n * TILE_B); }
__device__ __forceinline__ bf16x8 row_frag(const LAS bf16_t* M, int r0, int k0, int lane) { return *(const LAS bf16x8*)(M + (r0 + (lane & 15)) * TP + k0 + 8 * (lane >> 4)); }
__device__ __forceinline__ bf16x8 tr_frag(const LAS bf16_t* M, int k0, int c0, int lane) {
    LAS bf16_t* p = (LAS bf16_t*)M + (k0 + 8 * (lane >> 4) + ((lane & 15) >> 2)) * TP + c0 + 4 * (lane & 3);
    const v4s lo = __builtin_amdgcn_ds_read_tr16_b64_v4i16((LAS v4s*)p), hi = __builtin_amdgcn_ds_read_tr16_b64_v4i16((LAS v4s*)(p + 4 * TP));
    return (bf16x8){lo[0], lo[1], lo[2], lo[3], hi[0], hi[1], hi[2], hi[3]};
}
template <bool XT, bool YT>
__device__ __forceinline__ void mm64(const LAS bf16_t* X, const LAS bf16_t* Y, f32x4 (&acc)[2], int wq, int wh, int lane) {
#pragma unroll
    for (int ks = 0; ks < 2; ++ks) {
        const bf16x8 b = XT ? tr_frag(X, 32 * ks, 16 * wq, lane) : row_frag(X, 16 * wq, 32 * ks, lane);
#pragma unroll
        for (int q = 0; q < 2; ++q) { const int i0 = 16 * (2 * wh + q);
            const bf16x8 a = YT ? row_frag(Y, i0, 32 * ks, lane) : tr_frag(Y, 32 * ks, i0, lane);
            acc[q] = __builtin_amdgcn_mfma_f32_16x16x32_bf16(a, b, acc[q], 0, 0, 0); }
    }
}
__device__ __forceinline__ void st_tile(LAS bf16_t* Z, const f32x4 (&acc)[2], int wq, int wh, int lane) {
#pragma unroll
    for (int q = 0; q < 2; ++q) { u32x2 o; o.x = cvt_pk_bf16(acc[q][0], acc[q][1]); o.y = cvt_pk_bf16(acc[q][2], acc[q][3]);
        *(LAS u32x2*)(Z + (16 * wq + (lane & 15)) * TP + 16 * (2 * wh + q) + 4 * (lane >> 4)) = o; }
}
__device__ __forceinline__ void ld_tile(const LAS bf16_t* Z, f32x4 (&acc)[2], int wq, int wh, int lane) {
#pragma unroll
    for (int q = 0; q < 2; ++q) { const u32x2 o = *(const LAS u32x2*)(Z + (16 * wq + (lane & 15)) * TP + 16 * (2 * wh + q) + 4 * (lane >> 4));
        acc[q] = (f32x4){bf_lo(o.x), bf_hi(o.x), bf_lo(o.y), bf_hi(o.y)}; }
}
__device__ __forceinline__ f32x4 prod16(const LAS bf16_t* X, int xr, int xc, const LAS bf16_t* Y, int yr, int yc, f32x4 acc, int lane) {
    bf16x8 b = *(const LAS bf16x8*)(X + (xr + (lane & 15)) * TP + xc + 8 * (lane >> 4)); bf16x8 a = tr_frag(Y, yr, yc, lane);
    if ((lane >> 4) >= 2) { b = (bf16x8){0, 0, 0, 0, 0, 0, 0, 0}; a = (bf16x8){0, 0, 0, 0, 0, 0, 0, 0}; }
    return __builtin_amdgcn_mfma_f32_16x16x32_bf16(a, b, acc, 0, 0, 0);
}
__device__ __forceinline__ void st16(LAS bf16_t* Z, int zr, int zc, f32x4 acc, int lane) { u32x2 o; o.x = cvt_pk_bf16(acc[0], acc[1]); o.y = cvt_pk_bf16(acc[2], acc[3]); *(LAS u32x2*)(Z + (zr + (lane & 15)) * TP + zc + 4 * (lane >> 4)) = o; }
__device__ __forceinline__ f32x4 ld16(const LAS bf16_t* Z, int zr, int zc, int lane) { const u32x2 o = *(const LAS u32x2*)(Z + (zr + (lane & 15)) * TP + zc + 4 * (lane >> 4)); return (f32x4){bf_lo(o.x), bf_hi(o.x), bf_lo(o.y), bf_hi(o.y)}; }
struct ChunkRegs { u32x4 r, k, v, tw, ta; };
__device__ __forceinline__ void scan_load(KP P, const Frame& F, int item, int c4, ChunkRegs& R) {
    const int s = item & 63, sc = item >> 6, z = s >> 5, b = (s >> 4) & 1, hh = s & 15;
    const size_t row = (size_t)scan_row(z, b, sc * SCP + c4 * 64 + (F.tid >> 3)); const size_t o = row * D + hh * 64 + (F.tid & 7) * 8, o2 = row * 256 + z * 64 + (F.tid & 7) * 8;
    R.r = *(const u32x4*)((const bf16_t*)(P->ws + WS_R) + o); R.k = *(const u32x4*)((const bf16_t*)(P->ws + WS_K) + o); R.v = *(const u32x4*)((const bf16_t*)(P->ws + WS_VV) + o);
    R.tw = *(const u32x4*)((const bf16_t*)(P->ws + WS_TW) + o2); R.ta = *(const u32x4*)((const bf16_t*)(P->ws + WS_TA) + o2);
}
__device__ __forceinline__ void scan_chunk_phase(const Frame& F, KP P, int j) {
    LAS unsigned char* lds = F.lds;
    LAS bf16_t* At = stile(lds, T_AT); LAS bf16_t* Rt = stile(lds, T_RT); LAS bf16_t* Bt = stile(lds, T_BT); LAS bf16_t* Kt = stile(lds, T_KT); LAS bf16_t* Vm = stile(lds, T_VM);
    LAS bf16_t* NT = stile(lds, T_NT); LAS bf16_t* MT = stile(lds, T_MT); LAS bf16_t* NrT = stile(lds, T_NRT); LAS bf16_t* MrT = stile(lds, T_MRT);
    LAS bf16_t* ApA = stile(lds, T_APA); LAS bf16_t* ApB = stile(lds, T_APB); LAS bf16_t* TaA = stile(lds, T_TAA); LAS bf16_t* TaB = stile(lds, T_TAB);
    LAS bf16_t* PrB = stile(lds, T_PRB); LAS bf16_t* QrB = stile(lds, T_QRB);
    LAS float* gl = (LAS float*)(lds + LDS_GL); LAS float* seg = (LAS float*)(lds + LDS_SEG);
    const int lane = F.lane, wq = F.wave & 3, wh = F.wave >> 2, l15 = lane & 15, l4 = lane >> 4;
    const int pi = F.tid >> 3, kq = F.tid & 7;
    const int jrow = 16 * wq + l15;
    const int NITEM = NSCAN * NSC;
    int item = blockIdx.x; if (item >= NITEM) return;
    ChunkRegs cur, nxt; scan_load(P, F, item, 0, cur); nxt = cur;
    f32x4 Pr[2], Qr[2], aYp[2], aQp[2];
#pragma unroll
    for (int q = 0; q < 2; ++q) { Pr[q] = (f32x4){0.f, 0.f, 0.f, 0.f}; Qr[q] = Pr[q]; aYp[q] = Pr[q]; aQp[q] = Pr[q]; }
    bool pend = false; size_t orowp = 0; bf16_t* GEp = nullptr; bf16_t* YEp = nullptr; float* pqp = nullptr; bool lastp = false;
#define SCAN_STAGE_G() do { \
        f32x4 ge[2] = {(f32x4){0.f, 0.f, 0.f, 0.f}, (f32x4){0.f, 0.f, 0.f, 0.f}}; \
        mm64<false, true>(NT, PrB, ge, wq, wh, lane); mm64<false, true>(NT, QrB, aYp, wq, wh, lane); \
        f32x4 pn[2] = {(f32x4){0.f, 0.f, 0.f, 0.f}, (f32x4){0.f, 0.f, 0.f, 0.f}}; \
        mm64<false, false>(PrB, MT, pn, wq, wh, lane); mm64<false, false>(QrB, MT, aQp, wq, wh, lane); \
        _Pragma("unroll") for (int q = 0; q < 2; ++q) { const int i0 = 16 * (2 * wh + q) + 4 * l4; \
            u32x2 o; o.x = cvt_pk_bf16(ge[q][0], ge[q][1]); o.y = cvt_pk_bf16(ge[q][2], ge[q][3]); *(u32x2*)(GEp + orowp + i0) = o; \
            u32x2 y; y.x = cvt_pk_bf16(aYp[q][0], aYp[q][1]); y.y = cvt_pk_bf16(aYp[q][2], aYp[q][3]); *(u32x2*)(YEp + orowp + i0) = y; \
            Pr[q] = pn[q]; Qr[q] = aQp[q]; } \
        if (lastp) { const int ln_ = lane_id_now(), l15_ = ln_ & 15, l4_ = ln_ >> 4;   \
            float* pP_ = pqp + ((l15_ & 3) * 4 + (l15_ >> 2)) * 64 + wq * 16 + 8 * wh + l4_; float* pQ_ = pqp + 4096 + (wq * 16 + l4_) * 64 + 32 * wh + l15_; \
            _Pragma("unroll") for (int q = 0; q < 2; ++q)   \
            _Pragma("unroll") for (int r = 0; r < 4; ++r) { pP_[r * 1024 + 4 * q] = Pr[q][r]; pQ_[r * 256 + 16 * q] = Qr[q][r]; } } \
    } while (0)
    for (;;) {
        const int s = item & 63, sc = item >> 6, z = s >> 5, b = (s >> 4) & 1, hh = s & 15;
        const float* kkw = P->in[I_KK] + (size_t)j * D + hh * 64 + kq * 8; const float* kap = P->in[I_KA] + (size_t)j * D + hh * 64 + kq * 8; const float* rkp = P->in[I_RK] + (size_t)j * D + hh * 64 + kq * 8;
        const float* w0p = P->in[I_W0] + ((size_t)j * 2 + z) * D + hh * 64; const float* a0p = P->in[I_A0] + ((size_t)j * 2 + z) * D + hh * 64;
        float* bon = (float*)(P->ws + WS_BON) + (size_t)z * T * 16;
        const u32x4 w2r = *(const u32x4*)((const bf16_t*)(P->ws + WS_W2P) + (((size_t)j * 2 + z) * D + hh * 64 + pi) * 256 + z * 64 + kq * 8);
        const u32x4 a2r = *(const u32x4*)((const bf16_t*)(P->ws + WS_A2P) + (((size_t)j * 2 + z) * D + hh * 64 + pi) * 256 + z * 64 + kq * 8);
        bf16_t* GE = (bf16_t*)(P->ws + (z ? WS_AS1 : WS_AS0)); bf16_t* YE = (bf16_t*)(P->ws + (z ? WS_ELOG1 : WS_ELOG0));
        float* pq = (float*)(P->ws + WS_PQ) + ((size_t)(s * NSC + sc) * 2) * 4096;
#pragma nounroll
        for (int c4 = 0; c4 < NCH; ++c4) {
            unsigned long long ch_t[12]; ch_t[11] = CH_AMP >= 0 ? __builtin_amdgcn_s_memrealtime() : 0ull;
            *(LAS u32x4*)(ApA + pi * TP + kq * 8) = cur.tw; *(LAS u32x4*)(ApB + pi * TP + kq * 8) = cur.ta; *(LAS u32x4*)(NrT + pi * TP + kq * 8) = w2r; *(LAS u32x4*)(MrT + pi * TP + kq * 8) = a2r;
            LDS_BARRIER(); CH_STAMP(0);
            {   f32x4 lw[2] = {(f32x4){0.f, 0.f, 0.f, 0.f}, (f32x4){0.f, 0.f, 0.f, 0.f}}, la[2] = {(f32x4){0.f, 0.f, 0.f, 0.f}, (f32x4){0.f, 0.f, 0.f, 0.f}};
                mm64<false, true>(ApA, NrT, lw, wq, wh, lane); mm64<false, true>(ApB, MrT, la, wq, wh, lane);
#pragma unroll
                for (int q = 0; q < 2; ++q) { const int i0 = 16 * (2 * wh + q) + 4 * l4; const f32x4 w04 = *(const f32x4*)(w0p + i0), a04 = *(const f32x4*)(a0p + i0);
#pragma unroll
                    for (int r = 0; r < 4; ++r) { lw[q][r] = -0.60653065971f * sigmoidf_(w04[r] + lw[q][r]); la[q][r] = sigmoidf_(a04[r] + la[q][r]); } }
                st_tile(TaA, lw, wq, wh, lane); st_tile(TaB, la, wq, wh, lane); }
            LDS_BARRIER(); CH_STAMP(1);
            float r8[8], k8[8], e8[8], m8[8], a8[8], kk8[8], c8[8];
            { const u32x4 et = *(const LAS u32x4*)(TaA + pi * TP + kq * 8), at = *(const LAS u32x4*)(TaB + pi * TP + kq * 8); unpack8(cur.r, r8); unpack8(cur.k, k8); unpack8(et, e8); unpack8(at, a8); }
            {   const f32x4 ka0 = *(const f32x4*)(kap), ka1 = *(const f32x4*)(kap + 4), rk0 = *(const f32x4*)(rkp), rk1 = *(const f32x4*)(rkp + 4); float bp = 0.f;
#pragma unroll
                for (int e = 0; e < 8; ++e) { m8[e] = k8[e] * (1.0f + (a8[e] - 1.0f) * (e < 4 ? ka0[e & 3] : ka1[e & 3])); bp += r8[e] * (e < 4 ? rk0[e & 3] : rk1[e & 3]) * m8[e]; }
                bp += shx(bp, 1, lane); bp += shx(bp, 2, lane); bp += shx(bp, 4, lane);
                if (kq == 0) bon[(size_t)scan_row(z, b, sc * SCP + c4 * 64 + pi) * 16 + hh] = bp; }
            { const f32x4 w0 = *(const f32x4*)kkw, w1 = *(const f32x4*)(kkw + 4); float ss = 0.f;
#pragma unroll
              for (int e = 0; e < 8; ++e) { kk8[e] = k8[e] * (e < 4 ? w0[e & 3] : w1[e & 3]); ss += kk8[e] * kk8[e]; }
              ss += shx(ss, 1, lane); ss += shx(ss, 2, lane); ss += shx(ss, 4, lane);
              const float rn = rsqrtf(ss + 1e-12f);
#pragma unroll
              for (int e = 0; e < 8; ++e) { kk8[e] *= rn; c8[e] = e8[e]; } }
#pragma unroll
            for (int d = 8; d < 64; d <<= 1) {
#pragma unroll
                for (int e = 0; e < 8; ++e) { const float t = shup(c8[e], d, lane); c8[e] += lane >= d ? t : 0.f; } }
            if (lane >= 56) { *(LAS f32x4*)(seg + F.wave * 64 + kq * 8) = (f32x4){c8[0], c8[1], c8[2], c8[3]}; *(LAS f32x4*)(seg + F.wave * 64 + kq * 8 + 4) = (f32x4){c8[4], c8[5], c8[6], c8[7]}; }
            if (pend) { SCAN_STAGE_G(); pend = false; }
            LDS_BARRIER(); CH_STAMP(2);
            if (c4 > 0) { st_tile(PrB, Pr, wq, wh, lane); st_tile(QrB, Qr, wq, wh, lane); }
            { float cum[8];
#pragma unroll
              for (int e = 0; e < 8; ++e) cum[e] = c8[e];
              for (int w2 = 0; w2 < F.wave; ++w2) { const f32x4 o0 = *(const LAS f32x4*)(seg + w2 * 64 + kq * 8), o1 = *(const LAS f32x4*)(seg + w2 * 64 + kq * 8 + 4);
#pragma unroll
                  for (int e = 0; e < 8; ++e) cum[e] += e < 4 ? o0[e & 3] : o1[e & 3]; }
              float o[8];
#pragma unroll
              for (int e = 0; e < 8; ++e) o[e] = -kk8[e] * __expf(cum[e] - e8[e]);
              *(LAS u32x4*)(At + pi * TP + kq * 8) = pack8(o);
#pragma unroll
              for (int e = 0; e < 8; ++e) o[e] = r8[e] * __expf(cum[e]);
              *(LAS u32x4*)(Rt + pi * TP + kq * 8) = pack8(o);
              float en[8];
#pragma unroll
              for (int e = 0; e < 8; ++e) { en[e] = __expf(-cum[e]); o[e] = kk8[e] * a8[e] * en[e]; }
              *(LAS u32x4*)(Bt + pi * TP + kq * 8) = pack8(o);
#pragma unroll
              for (int e = 0; e < 8; ++e) o[e] = m8[e] * en[e];
              *(LAS u32x4*)(Kt + pi * TP + kq * 8) = pack8(o);
              *(LAS u32x4*)(Vm + pi * TP + kq * 8) = cur.v;
              if (pi == 63) {
#pragma unroll
                  for (int e = 0; e < 8; ++e) gl[kq * 8 + e] = __expf(cum[e]); } }
            { const int nitem = c4 < NCH - 1 ? item : item + (int)gridDim.x, nc4 = c4 < NCH - 1 ? c4 + 1 : 0; if (nitem < NITEM) scan_load(P, F, nitem, nc4, nxt); }
            LDS_BARRIER(); CH_STAMP(3);
            {   f32x4 aN[2], aM[2], aNr[2], aMr[2];
#pragma unroll
                for (int q = 0; q < 2; ++q) { aN[q] = (f32x4){0.f, 0.f, 0.f, 0.f}; aM[q] = aN[q]; aNr[q] = aN[q]; aMr[q] = aN[q]; }
                mm64<false, true>(At, Bt, aN, wq, wh, lane); mm64<false, true>(At, Kt, aM, wq, wh, lane); mm64<false, true>(Rt, Bt, aNr, wq, wh, lane); mm64<false, true>(Rt, Kt, aMr, wq, wh, lane);
                f32x4 aT[2];
#pragma unroll
                for (int q = 0; q < 2; ++q)
#pragma unroll
                    for (int r = 0; r < 4; ++r) { const int i = 16 * (2 * wh + q) + 4 * l4 + r; const bool lt = i < jrow, le = i <= jrow;
                        aN[q][r] = lt ? aN[q][r] : 0.f; aM[q][r] = lt ? aM[q][r] : 0.f; aNr[q][r] = le ? aNr[q][r] : 0.f; aMr[q][r] = le ? aMr[q][r] : 0.f; aT[q][r] = aN[q][r] + (i == jrow ? 1.f : 0.f); }
                st_tile(NT, aN, wq, wh, lane); st_tile(MT, aM, wq, wh, lane); st_tile(NrT, aNr, wq, wh, lane); st_tile(MrT, aMr, wq, wh, lane); st_tile(TaA, aT, wq, wh, lane);
            }
            LDS_BARRIER(); CH_STAMP(4);
            if (F.wave < 4) { const int o = 16 * F.wave, oc = 16 * ((F.wave + 1) & 3);
                f32x4 p = prod16(NT, o, o, NT, o, o, (f32x4){0.f, 0.f, 0.f, 0.f}, lane); st16(ApA, o, o, p, lane);
                f32x4 t = prod16(TaA, o, o, ApA, o, o, ld16(TaA, o, o, lane), lane); p = prod16(ApA, o, o, ApA, o, o, (f32x4){0.f, 0.f, 0.f, 0.f}, lane);
                st16(TaB, o, o, t, lane); st16(ApA, o, oc, p, lane);
                t = prod16(TaB, o, o, ApA, o, oc, ld16(TaB, o, o, lane), lane); p = prod16(ApA, o, oc, ApA, o, oc, (f32x4){0.f, 0.f, 0.f, 0.f}, lane);
                st16(TaA, o, o, t, lane); st16(ApA, o, o, p, lane);
                t = prod16(TaA, o, o, ApA, o, o, ld16(TaA, o, o, lane), lane); st16(TaB, o, o, t, lane);
#pragma unroll
                for (int jj = 1; jj < 4; ++jj) if (jj > F.wave) { u32x2 zz; asm volatile("v_mov_b32 %0, 0\n\tv_mov_b32 %1, 0" : "=v"(zz.x), "=v"(zz.y)); *(LAS u32x2*)(TaB + (o + l15) * TP + 16 * jj + 4 * l4) = zz; }
            } else { const int wq2 = F.wave - 4;
#pragma unroll
                for (int wh2 = 0; wh2 < 2; ++wh2) { f32x4 x[2] = {(f32x4){0.f, 0.f, 0.f, 0.f}, (f32x4){0.f, 0.f, 0.f, 0.f}}; mm64<true, true>(Vm, MT, x, wq2, wh2, lane); st_tile(ApB, x, wq2, wh2, lane); } }
            LDS_BARRIER(); CH_STAMP(5);
            if (F.wave < 3) { const int jj = F.wave;
#pragma unroll
                for (int i = 1; i < 4; ++i) if (i > jj) { f32x4 e = (f32x4){0.f, 0.f, 0.f, 0.f};
#pragma unroll
                    for (int m = 0; m < 3; ++m) if (m >= jj && m < i) e = prod16(NT, 16 * i, 16 * m, TaB, 16 * m, 16 * jj, e, lane);
                    st16(ApA, 16 * i, 16 * jj, e, lane);
                    st16(TaB, 16 * i, 16 * jj, prod16(TaB, 16 * i, 16 * i, ApA, 16 * i, 16 * jj, (f32x4){0.f, 0.f, 0.f, 0.f}, lane), lane); } }
            LDS_BARRIER(); CH_STAMP(6);
            {   f32x4 w[2] = {(f32x4){0.f, 0.f, 0.f, 0.f}, (f32x4){0.f, 0.f, 0.f, 0.f}}; mm64<true, true>(At, TaB, w, wq, wh, lane); st_tile(ApA, w, wq, wh, lane);
                f32x4 u[2] = {(f32x4){0.f, 0.f, 0.f, 0.f}, (f32x4){0.f, 0.f, 0.f, 0.f}}; mm64<false, true>(ApB, TaB, u, wq, wh, lane); st_tile(TaA, u, wq, wh, lane); }
            LDS_BARRIER(); CH_STAMP(7);
            f32x4 aP[2], aQ[2], aG[2], aY[2];
#pragma unroll
            for (int q = 0; q < 2; ++q) { aP[q] = (f32x4){0.f, 0.f, 0.f, 0.f}; aQ[q] = aP[q]; aG[q] = aP[q]; aY[q] = aP[q]; }
            mm64<false, false>(ApA, Bt, aP, wq, wh, lane);
            mm64<false, false>(TaA, Bt, aQ, wq, wh, lane); mm64<true, false>(Vm, Kt, aQ, wq, wh, lane);
            mm64<false, true>(NrT, ApA, aG, wq, wh, lane);
            mm64<false, true>(NrT, TaA, aY, wq, wh, lane); mm64<false, false>(MrT, Vm, aY, wq, wh, lane);
#pragma unroll
            for (int q = 0; q < 2; ++q) { const int i0 = 16 * (2 * wh + q) + 4 * l4; const f32x4 g4 = *(const LAS f32x4*)(gl + i0);
                const u32x2 rr = *(const LAS u32x2*)(Rt + jrow * TP + i0);
#pragma unroll
                for (int r = 0; r < 4; ++r) { aP[q][r] = (aP[q][r] + (i0 + r == jrow ? 1.f : 0.f)) * g4[r]; aQ[q][r] *= g4[r]; }
                aG[q][0] += bf_lo(rr.x); aG[q][1] += bf_hi(rr.x); aG[q][2] += bf_lo(rr.y); aG[q][3] += bf_hi(rr.y); }
            const size_t orow = (size_t)scan_row(z, b, sc * SCP + c4 * 64 + jrow) * D + hh * 64;
            if (c4 == 0) {
#pragma unroll
                for (int q = 0; q < 2; ++q) { const int i0 = 16 * (2 * wh + q) + 4 * l4;
                    u32x2 o; o.x = cvt_pk_bf16(aG[q][0], aG[q][1]); o.y = cvt_pk_bf16(aG[q][2], aG[q][3]); *(u32x2*)(GE + orow + i0) = o;
                    u32x2 y; y.x = cvt_pk_bf16(aY[q][0], aY[q][1]); y.y = cvt_pk_bf16(aY[q][2], aY[q][3]); *(u32x2*)(YE + orow + i0) = y;
                    Pr[q] = aP[q]; Qr[q] = aQ[q]; }
            } else {
                st_tile(NT, aG, wq, wh, lane); st_tile(MT, aP, wq, wh, lane);
#pragma unroll
                for (int q = 0; q < 2; ++q) { aYp[q] = aY[q]; aQp[q] = aQ[q]; }
                pend = true; orowp = orow; GEp = GE; YEp = YE; pqp = pq; lastp = c4 == NCH - 1;
            }
            cur = nxt;
            if (CH_AMP >= 0) { const unsigned long long d_ = CH_AMP == 0 ? ch_t[0] - ch_t[11] : ch_t[CH_AMP] - ch_t[CH_AMP - 1]; const unsigned long long dl_ = __builtin_amdgcn_s_memrealtime() + 4 * d_; while (__builtin_amdgcn_s_memrealtime() < dl_) __builtin_amdgcn_s_sleep(4); }
            LDS_BARRIER(); CH_STAMP(8);
        }
        item += gridDim.x; if (item >= NITEM) break;
    }
    if (pend) { SCAN_STAGE_G(); }
#undef SCAN_STAGE_G
}
__device__ __forceinline__ void scan_carry_phase(const Frame& F, KP P, int layer) {
    LAS unsigned* cbar = (LAS unsigned*)(F.lds + 8192);
    if (F.tid == 0) *cbar = 0u;
    __syncthreads();
    if (F.wave >= 4) { moe_weights_phase(F, P, layer, blockIdx.x * 4 + (F.wave - 4), gridDim.x * 4, 0, MOE_SPLIT); return; }
    if (blockIdx.x >= 4 * NSCAN) return;
    unsigned ctarget = 0u;
    const int s = blockIdx.x >> 2, vs = blockIdx.x & 3, lane = F.lane, l15 = lane & 15, l4 = lane >> 4, v = 16 * vs + l15, T2 = F.wave;
    const float* pq = (const float*)(P->ws + WS_PQ) + (size_t)s * NSC * 2 * 4096; bf16_t* sst = (bf16_t*)(P->ws + WS_SST) + (size_t)s * NSC * 4096;
    LAS f32x4* exch = (LAS f32x4*)F.lds;
    f32x4 S[4]; float ap[4][16], qp[4][4];
#pragma unroll
    for (int t = 0; t < 4; ++t) S[t] = (f32x4){0.f, 0.f, 0.f, 0.f};
#define CARRY_LOAD(slot, step) do { const float* Pm_ = pq + (size_t)(step) * 2 * 4096; \
        _Pragma("unroll") for (int t2i = 0; t2i < 4; ++t2i) _Pragma("unroll") for (int ri = 0; ri < 4; ++ri) ap[slot][t2i * 4 + ri] = Pm_[(T2 * 16 + t2i * 4 + ri) * 64 + lane];   \
        _Pragma("unroll") for (int r = 0; r < 4; ++r) qp[slot][r] = Pm_[4096 + ((vs * 4 + T2) * 4 + r) * 64 + lane];   } while (0)
#define CARRY_STORE(sc_) do { if (T2 == 0) { float o[16]; \
        _Pragma("unroll") for (int r = 0; r < 4; ++r) _Pragma("unroll") for (int t2 = 0; t2 < 4; ++t2) o[4 * r + t2] = S[t2][r]; \
        u32x4 w0, w1; w0.x = cvt_pk_bf16(o[0], o[1]); w0.y = cvt_pk_bf16(o[2], o[3]); w0.z = cvt_pk_bf16(o[4], o[5]); w0.w = cvt_pk_bf16(o[6], o[7]); \
        w1.x = cvt_pk_bf16(o[8], o[9]); w1.y = cvt_pk_bf16(o[10], o[11]); w1.z = cvt_pk_bf16(o[12], o[13]); w1.w = cvt_pk_bf16(o[14], o[15]); \
        *(u32x4*)(sst + (size_t)(sc_) * 4096 + v * 64 + 16 * l4) = w0; *(u32x4*)(sst + (size_t)(sc_) * 4096 + v * 64 + 16 * l4 + 8) = w1; } } while (0)
    if (T2 < 4) {
#pragma unroll
        for (int u = 0; u < 4; ++u) CARRY_LOAD(u, u);
    }
#pragma nounroll
    for (int sc0 = 0; sc0 < NSC - 1; sc0 += 4) {
#pragma unroll
        for (int u = 0; u < 4; ++u) { const int sc = sc0 + u; if (sc >= NSC - 1) break;
            CARRY_STORE(sc);
            if (T2 < 4) {
                f32x4 nw = (f32x4){qp[u][0], qp[u][1], qp[u][2], qp[u][3]};
#pragma unroll
                for (int t2i = 0; t2i < 4; ++t2i)
#pragma unroll
                    for (int ri = 0; ri < 4; ++ri) nw = __builtin_amdgcn_mfma_f32_16x16x4f32(ap[u][t2i * 4 + ri], S[t2i][ri], nw, 0, 0, 0);
                if (sc + 4 < NSC - 1) CARRY_LOAD(u, sc + 4);
                exch[((u & 1) * 4 + T2) * 64 + lane] = nw;
            }
            { asm volatile("s_waitcnt lgkmcnt(0)" ::: "memory"); if (lane == 0) __hip_atomic_fetch_add(cbar, 1u, __ATOMIC_RELAXED, __HIP_MEMORY_SCOPE_WORKGROUP); ctarget += 4u;
              for (int spin = 0; spin < (1 << 22); ++spin) { const unsigned c = __hip_atomic_load(cbar, __ATOMIC_RELAXED, __HIP_MEMORY_SCOPE_WORKGROUP); if ((int)(c - ctarget) >= 0) break; }
              asm volatile("" ::: "memory"); }
            if (T2 < 4) {
#pragma unroll
                for (int t = 0; t < 4; ++t) S[t] = exch[((u & 1) * 4 + t) * 64 + lane];
            }
        }
    }
    CARRY_STORE(NSC - 1);
#undef CARRY_LOAD
#undef CARRY_STORE
}
__device__ __forceinline__ void scan_out_phase(const Frame& F, KP P, int j) {
    const int lane = F.lane, l15 = lane & 15, l4 = lane >> 4;
    const bf16_t* GE0 = (const bf16_t*)(P->ws + WS_AS0); const bf16_t* GE1 = (const bf16_t*)(P->ws + WS_AS1); const bf16_t* YE0 = (const bf16_t*)(P->ws + WS_ELOG0); const bf16_t* YE1 = (const bf16_t*)(P->ws + WS_ELOG1);
    const bf16_t* Vb = (const bf16_t*)(P->ws + WS_VV); const float* BON = (const float*)(P->ws + WS_BON);
    const bf16_t* GT = (const bf16_t*)(P->ws + WS_GATE); bf16_t* YG = (bf16_t*)(P->ws + WS_YG);
    for (int item = F.gw; item < NBATCH * NH * ((SEQ + CTXL) / 256) * 8; item += F.NGW) {
        const int hh = item & 15, oct = (item >> 4) & 7, b = (item >> 7) & 1, blk = item >> 8;
        const int sc0 = (blk * 256 + 32 * oct) / SCP, sc1 = blk == 0 ? 0 : (SEQ + CTXL - 1 - (blk - 1) * 256 - 32 * oct) / SCP;

        const bf16_t* s0 = (const bf16_t*)(P->ws + WS_SST) + ((size_t)(b * 16 + hh) * NSC + sc0) * 4096; const bf16_t* s1 = (const bf16_t*)(P->ws + WS_SST) + ((size_t)(32 + b * 16 + hh) * NSC + sc1) * 4096;
        bf16x8 sa0[4][2], sa1[4][2];
#pragma unroll
        for (int vt = 0; vt < 4; ++vt) { const int v = 32 * (vt >> 1) + 8 * (l15 >> 2) + 4 * (vt & 1) + (l15 & 3);
#pragma unroll
            for (int ks = 0; ks < 2; ++ks) { sa0[vt][ks] = *(const bf16x8*)(s0 + v * 64 + 32 * ks + 8 * l4); sa1[vt][ks] = *(const bf16x8*)(s1 + v * 64 + 32 * ks + 8 * l4); } }
        f32x4 lg4[4], lb4[4];
#pragma unroll
        for (int q = 0; q < 4; ++q) { const int c = hh * 64 + 32 * (q >> 1) + 8 * l4 + 4 * (q & 1); lg4[q] = *(const f32x4*)(P->in[I_LNG] + (size_t)j * D + c); lb4[q] = *(const f32x4*)(P->in[I_LNB] + (size_t)j * D + c); }
#pragma nounroll
        for (int ti = 0; ti < 2; ++ti) {
            const int tok = (2 * oct + ti) * 16 + l15; const int row = blk == 0 ? TL + b * CTXL + tok : b * SEQ + (blk - 1) * 256 + tok;
            const size_t o = (size_t)row * D + hh * 64;
            const bf16x8 g00 = *(const bf16x8*)(GE0 + o + 8 * l4), g01 = *(const bf16x8*)(GE0 + o + 32 + 8 * l4), g10 = *(const bf16x8*)(GE1 + o + 8 * l4), g11 = *(const bf16x8*)(GE1 + o + 32 + 8 * l4);
            u32x4 la[2], lc[2], lv[2], lgt[2];
#pragma unroll
            for (int h2 = 0; h2 < 2; ++h2) { const size_t oc = o + 32 * h2 + 8 * l4;
                la[h2] = *(const u32x4*)(YE0 + oc); lc[h2] = *(const u32x4*)(YE1 + oc); lv[h2] = *(const u32x4*)(Vb + oc); lgt[h2] = *(const u32x4*)(GT + oc); }
            const float bn = BON[(size_t)row * 16 + hh] + BON[((size_t)T + row) * 16 + hh];
            __builtin_amdgcn_sched_barrier(0);
            f32x4 y[4]; float s = 0.f; f32x4 vv[4], gg[4];
#pragma unroll
            for (int vt = 0; vt < 4; ++vt) { const int h2 = vt >> 1, hf = vt & 1;
                const unsigned ax = hf ? la[h2].z : la[h2].x, ay = hf ? la[h2].w : la[h2].y, cx = hf ? lc[h2].z : lc[h2].x, cy = hf ? lc[h2].w : lc[h2].y;
                const unsigned vx = hf ? lv[h2].z : lv[h2].x, vy = hf ? lv[h2].w : lv[h2].y, gx = hf ? lgt[h2].z : lgt[h2].x, gy = hf ? lgt[h2].w : lgt[h2].y;
                f32x4 acc = (f32x4){bf_lo(ax) + bf_lo(cx), bf_hi(ax) + bf_hi(cx), bf_lo(ay) + bf_lo(cy), bf_hi(ay) + bf_hi(cy)};
                acc = __builtin_amdgcn_mfma_f32_16x16x32_bf16(sa0[vt][0], g00, acc, 0, 0, 0); acc = __builtin_amdgcn_mfma_f32_16x16x32_bf16(sa0[vt][1], g01, acc, 0, 0, 0);
                acc = __builtin_amdgcn_mfma_f32_16x16x32_bf16(sa1[vt][0], g10, acc, 0, 0, 0); acc = __builtin_amdgcn_mfma_f32_16x16x32_bf16(sa1[vt][1], g11, acc, 0, 0, 0);
                y[vt] = acc; s += (acc[0] + acc[1]) + (acc[2] + acc[3]);
                vv[vt] = (f32x4){bf_lo(vx), bf_hi(vx), bf_lo(vy), bf_hi(vy)}; gg[vt] = (f32x4){bf_lo(gx), bf_hi(gx), bf_lo(gy), bf_hi(gy)}; }
            s += shx(s, 16, lane); s += shx(s, 32, lane);
            const float mean = s * (1.0f / 64.0f); float q = 0.f;
#pragma unroll
            for (int vt = 0; vt < 4; ++vt) { const f32x4 d = y[vt] - mean; q += (d[0] * d[0] + d[1] * d[1]) + (d[2] * d[2] + d[3] * d[3]); }
            q += shx(q, 16, lane); q += shx(q, 32, lane);
            const float rstd = rsqrtf(q * (1.0f / 64.0f) + 64e-5f);
#pragma unroll
            for (int h2 = 0; h2 < 2; ++h2) { const f32x4 o0 = (((y[2 * h2] - mean) * rstd) * lg4[2 * h2] + lb4[2 * h2] + vv[2 * h2] * bn) * gg[2 * h2], o1 = (((y[2 * h2 + 1] - mean) * rstd) * lg4[2 * h2 + 1] + lb4[2 * h2 + 1] + vv[2 * h2 + 1] * bn) * gg[2 * h2 + 1];
                u32x4 w; w.x = cvt_pk_bf16(o0[0], o0[1]); w.y = cvt_pk_bf16(o0[2], o0[3]); w.z = cvt_pk_bf16(o1[0], o1[1]); w.w = cvt_pk_bf16(o1[2], o1[3]); *(u32x4*)(YG + o + 32 * h2 + 8 * l4) = w; }
        }
    }
}
__device__ __forceinline__ bool in_range(int lo, int hi, int k) { asm volatile("" : "+s"(lo), "+s"(hi)); return lo <= k && k < hi; }
constexpr int NPH = 46;
template <unsigned KMASK> __global__ void __launch_bounds__(NTHR, 2) mega(Params Pv) {
    extern __shared__ __attribute__((aligned(16))) unsigned char lds_raw[];
    Frame F0; F0.lds = (LAS unsigned char*)lds_raw; F0.tid = threadIdx.x; F0.lane = F0.tid & 63; F0.wave = __builtin_amdgcn_readfirstlane(F0.tid >> 6);
    F0.G = gridDim.x; F0.gw = blockIdx.x * NWAVES + F0.wave; F0.NGW = F0.G * NWAVES;
    LAS unsigned* misc = (LAS unsigned*)(F0.lds + LDS_MISC);
    if (F0.tid < 128) misc[F0.tid] = 0u;
    __syncthreads();
    KP P0 = (KP)__builtin_amdgcn_kernarg_segment_ptr();
    constexpr bool ALL = (KMASK == 0x3ffffu);
    const int lo = ALL ? 0 : P0->ph_lo, hi = ALL ? NPH : P0->ph_hi;
    XcdBarrier bar; bar.bar = (unsigned*)(P0->ws + WS_CTL) + CW_BAR; bar.x = 0; bar.st = (volatile LAS unsigned*)(misc + 8);
    if (ALL || hi - lo > 1) bar = xcd_barrier_post((unsigned*)(P0->ws + WS_CTL) + CW_BAR, (volatile LAS unsigned*)(misc + 8));
#define IN(k) (ALL || in_range(lo, hi, (k)))
#define KIND(q) ((KMASK >> (q)) & 1u)
#define BAR_LEADER (wave_sgpr_now(F0.wave) == 0 && lane_id_now() == 0)
#define SEAM(k) do { if (IN(k) && IN((k) + 1)) { XcdBarrier b2_ = bar; unsigned* bb_ = bar.bar; unsigned bx_ = bar.x; asm volatile("" : "+s"(bb_), "+s"(bx_)); b2_.bar = bb_; b2_.x = bx_; xcd_barrier<false>(b2_, BAR_LEADER); } } while (0)
#define AMP_T0 const unsigned long long amp_t0 = AMP_MASK ? __builtin_amdgcn_s_memrealtime() : 0ull;
#define AMP_END(kind) do { if (AMP_MASK & (1u << (kind))) { const unsigned long long t1_ = __builtin_amdgcn_s_memrealtime(), dl_ = t1_ + AMP_F * (t1_ - amp_t0); while (__builtin_amdgcn_s_memrealtime() < dl_) __builtin_amdgcn_s_sleep(8); } } while (0)
#define PHASE_ENTRY AMP_T0 KP P = P0; asm volatile("" : "+s"(P)); unsigned char* ws = P->ws; unsigned* ctl = (unsigned*)(ws + WS_CTL); (void)ctl; \
    Frame F = F0; { int l_ = lane_id_now(), w_ = F0.wave; asm volatile("" : "+s"(w_)); F.lane = l_; F.wave = w_; F.tid = w_ * 64 + l_; F.gw = blockIdx.x * NWAVES + w_; }

    if constexpr (KIND(0)) if (IN(0)) { PHASE_ENTRY prologue_phase(F, P); AMP_END(0); }
    if (IN(0) && IN(1)) { XcdBarrier b2_ = bar; unsigned* bb_ = bar.bar; unsigned bx_ = bar.x; asm volatile("" : "+s"(bb_), "+s"(bx_)); b2_.bar = bb_; b2_.x = bx_; xcd_barrier<true>(b2_, BAR_LEADER); }
    for (int lp = 0; lp < 2; ++lp) {
        const int pb = 1 + 22 * lp, la = 2 * lp, lb = 2 * lp + 1;
        if constexpr (KIND(1)) if (IN(pb + 0)) { PHASE_ENTRY norm1_phase(F, P, la); AMP_END(1); }
        SEAM(pb + 0);
        if constexpr (KIND(2)) if (IN(pb + 1)) { PHASE_ENTRY
            __syncthreads(); set_desc(F.lds, F.tid, 0, ws + WS_HL, ws + WS_WIN + (size_t)lp * 4096 * D * 2, ws + WS_U, 16, 0, 0, ws + WS_V, P->in[I_GBIN] + (size_t)lp * 4096, ws + WS_STAT); __syncthreads();
            SchedMulti<D, D> S{F.lds, TL / 256, 16, 1};
            EpiGelu E{F.lds};
            pg8::gemm_phase<EpiGelu, SchedMulti<D, D>, false, D, D, D>(F.lds, S, E, F.tid);
            __syncthreads(); { int w_ = F0.wave; asm volatile("" : "+s"(w_)); tail_gelu(F0.lds, w_); }
            AMP_END(2); }
        SEAM(pb + 1);
        if constexpr (KIND(3)) if (IN(pb + 2)) { PHASE_ENTRY spatial_phase(F, P, lp); AMP_END(3); }
        SEAM(pb + 2);
        if constexpr (KIND(4)) if (IN(pb + 3)) { PHASE_ENTRY
            __syncthreads();
            { bf16_t* X = (bf16_t*)(ws + WS_X);
              set_desc(F.lds, F.tid, 0, ws + WS_U, ws + WS_WOUT + (size_t)lp * D * GWID * 2, X, 4, 0, 0, X, X + (size_t)TL * D, P->in[I_GBOUT] + (size_t)lp * D);
              set_desc(F.lds, F.tid, 1, nullptr, nullptr, nullptr, 0, 0, 0, (const float*)(ws + WS_MOD) + (size_t)la * 3 * 6 * D + 2 * D); }
            __syncthreads();
            SchedMulti<GWID, GWID> S{F.lds, TL / 256, 4, 1};
            EpiResid E{F.lds};
            pg8::gemm_phase<EpiResid, SchedMulti<GWID, GWID>, false, GWID, GWID, GWID>(F.lds, S, E, F.tid);
            __syncthreads(); { int w_ = F0.wave; asm volatile("" : "+s"(w_)); tail_resid<GWID>(F0.lds, w_); }
            AMP_END(4); }
        SEAM(pb + 3);
        if constexpr (KIND(5)) if (IN(pb + 4)) { PHASE_ENTRY norm2_phase(F, P, la); AMP_END(5); }
        SEAM(pb + 4);
        if constexpr (KIND(16)) if (IN(pb + 5)) { PHASE_ENTRY
            __syncthreads(); set_desc(F.lds, F.tid, 0, ws + WS_HL, ws + WS_WRT + (size_t)la * 256 * D * 2, nullptr, 1, 0, 0); __syncthreads();
            const int nun = (la == DEPTH - 1 ? TL : T) / 256;
            if ((int)blockIdx.x >= nun) moe_weights_phase(F, P, la, ((int)blockIdx.x - nun) * NWAVES + F.wave, (F.G - nun) * NWAVES, MOE_SPLIT, MOE_ITEMS);
            else { SchedMulti<D, D> S{F.lds, nun, 1, 1};
                EpiLogits E{(float*)(ws + WS_LG)};
                pg8::gemm_phase<EpiLogits, SchedMulti<D, D>, false, D, D, D>(F.lds, S, E, F.tid);
                if (F.G <= nun) { __syncthreads(); moe_weights_phase(F, P, la, F.gw, F.NGW, MOE_SPLIT, MOE_ITEMS); } }
            AMP_END(16); }
        SEAM(pb + 5);
        if constexpr (KIND(17)) if (IN(pb + 6)) { PHASE_ENTRY route_phase(F, P, la); AMP_END(17); }
        SEAM(pb + 6);
        if constexpr (KIND(6)) if (IN(pb + 7)) { PHASE_ENTRY
            moe_tables(F.lds, F.tid, ctl + CW_CNT + la * 64);
            SchedMoE<D, D, true> S{F.lds, (const char*)(ws + WS_HL), (const char*)(ws + WS_WGU), (const int*)(ws + WS_LIST)};
            EpiSiluGate E{(bf16_t*)(ws + WS_H)};
            pg8::gemm_phase<EpiSiluGate, SchedMoE<D, D, true>, true, D, D, D>(F.lds, S, E, F.tid);
            AMP_END(6); }
        SEAM(pb + 7);
        if constexpr (KIND(7)) if (IN(pb + 8)) { PHASE_ENTRY
            moe_tables(F.lds, F.tid, ctl + CW_CNT + la * 64);
            SchedMoE<EHID, EHID, false> S{F.lds, (const char*)(ws + WS_H), (const char*)(ws + WS_WD), (const int*)(ws + WS_LIST)};
            EpiScatter E{F.lds, (bf16_t*)(ws + WS_YB), (const int*)(ws + WS_LIST)};
            pg8::gemm_phase<EpiScatter, SchedMoE<EHID, EHID, false>, false, EHID, EHID, EHID>(F.lds, S, E, F.tid);
            AMP_END(7); }
        SEAM(pb + 8);
        if constexpr (KIND(1)) if (IN(pb + 9)) { PHASE_ENTRY norm1_phase(F, P, lb); AMP_END(1); }
        SEAM(pb + 9);
        if constexpr (KIND(8)) if (IN(pb + 10)) { PHASE_ENTRY mix_phase(F, P, lp); AMP_END(8); }
        SEAM(pb + 10);
        if constexpr (KIND(9)) if (IN(pb + 11)) { PHASE_ENTRY
            __syncthreads();
            set_desc(F.lds, F.tid, 0, ws + WS_XR, ws + WS_WR + (size_t)lp * D * D * 2, ws + WS_R, 4, D, 0);
            set_desc(F.lds, F.tid, 1, ws + WS_XK, ws + WS_WK + (size_t)lp * D * D * 2, ws + WS_K, 4, D, 0);
            set_desc(F.lds, F.tid, 2, ws + WS_XV, ws + WS_WV + (size_t)lp * D * D * 2, ws + WS_VV, 4, D, 0);
            set_desc(F.lds, F.tid, 3, ws + WS_XW, ws + WS_LW1 + (size_t)lp * 256 * D * 2, ws + WS_TW, 1, 256, 1);
            set_desc(F.lds, F.tid, 4, ws + WS_XA, ws + WS_LA1 + (size_t)lp * 256 * D * 2, ws + WS_TA, 1, 256, 0);
            set_desc(F.lds, F.tid, 5, ws + WS_XG, ws + WS_LG1 + (size_t)lp * 256 * D * 2, ws + WS_TG, 1, 256, 2);
            __syncthreads();
            SchedMulti<D, D> S{F.lds, T / 256, 15, 6};
            EpiAct E{F.lds};
            pg8::gemm_phase<EpiAct, SchedMulti<D, D>, false, D, D, D>(F.lds, S, E, F.tid);
            AMP_END(9); }
        SEAM(pb + 11);
        if constexpr (KIND(10)) if (IN(pb + 12)) { PHASE_ENTRY
            __syncthreads(); set_desc(F.lds, F.tid, 0, ws + WS_TG, ws + WS_G2P + (size_t)lp * D * 256 * 2, ws + WS_GATE, 4, D, 0); __syncthreads();
            SchedMulti<256, 256> S{F.lds, T / 256, 4, 1};
            EpiAct E{F.lds};
            pg8::gemm_phase<EpiAct, SchedMulti<256, 256>, false, 256, 256, 256>(F.lds, S, E, F.tid);
            AMP_END(10); }
        SEAM(pb + 12);
        if constexpr (KIND(11)) if (IN(pb + 13)) { PHASE_ENTRY scan_chunk_phase(F, P, lp); AMP_END(11); }
        SEAM(pb + 13);
        if constexpr (KIND(14)) if (IN(pb + 14)) { PHASE_ENTRY scan_carry_phase(F, P, lb); AMP_END(14); }
        SEAM(pb + 14);
        if constexpr (KIND(15)) if (IN(pb + 15)) { PHASE_ENTRY scan_out_phase(F, P, lp); AMP_END(15); }
        SEAM(pb + 15);
        if constexpr (KIND(4)) if (IN(pb + 16)) { PHASE_ENTRY
            __syncthreads();
            { bf16_t* X = (bf16_t*)(ws + WS_X);
              set_desc(F.lds, F.tid, 0, ws + WS_YG, ws + WS_WO + (size_t)lp * D * D * 2, X, 4, 0, 0, X, X + (size_t)TL * D, nullptr);
              set_desc(F.lds, F.tid, 1, nullptr, nullptr, nullptr, 0, 0, 0, (const float*)(ws + WS_MOD) + (size_t)lb * 3 * 6 * D + 2 * D); }
            __syncthreads();
            SchedMulti<D, D> S{F.lds, TL / 256, 4, 1};
            EpiResid E{F.lds};
            pg8::gemm_phase<EpiResid, SchedMulti<D, D>, false, D, D, D>(F.lds, S, E, F.tid);
            if (lb != DEPTH - 1) { __syncthreads(); { int w_ = F0.wave; asm volatile("" : "+s"(w_)); tail_resid<D>(F0.lds, w_); } }
            AMP_END(4); }
        SEAM(pb + 16);
        if constexpr (KIND(5)) if (IN(pb + 17)) { PHASE_ENTRY norm2_phase(F, P, lb); AMP_END(5); }
        SEAM(pb + 17);
        if constexpr (KIND(16)) if (IN(pb + 18)) { PHASE_ENTRY
            __syncthreads(); set_desc(F.lds, F.tid, 0, ws + WS_HL, ws + WS_WRT + (size_t)lb * 256 * D * 2, nullptr, 1, 0, 0); __syncthreads();
            const int nun = (lb == DEPTH - 1 ? TL : T) / 256;
            if ((int)blockIdx.x >= nun) moe_weights_phase(F, P, lb, ((int)blockIdx.x - nun) * NWAVES + F.wave, (F.G - nun) * NWAVES, MOE_SPLIT, MOE_ITEMS);
            else { SchedMulti<D, D> S{F.lds, nun, 1, 1};
                EpiLogits E{(float*)(ws + WS_LG)};
                pg8::gemm_phase<EpiLogits, SchedMulti<D, D>, false, D, D, D>(F.lds, S, E, F.tid);
                if (F.G <= nun) { __syncthreads(); moe_weights_phase(F, P, lb, F.gw, F.NGW, MOE_SPLIT, MOE_ITEMS); } }
            AMP_END(16); }
        SEAM(pb + 18);
        if constexpr (KIND(17)) if (IN(pb + 19)) { PHASE_ENTRY route_phase(F, P, lb); AMP_END(17); }
        SEAM(pb + 19);
        if constexpr (KIND(6)) if (IN(pb + 20)) { PHASE_ENTRY
            moe_tables(F.lds, F.tid, ctl + CW_CNT + lb * 64);
            SchedMoE<D, D, true> S{F.lds, (const char*)(ws + WS_HL), (const char*)(ws + WS_WGU), (const int*)(ws + WS_LIST)};
            EpiSiluGate E{(bf16_t*)(ws + WS_H)};
            pg8::gemm_phase<EpiSiluGate, SchedMoE<D, D, true>, true, D, D, D>(F.lds, S, E, F.tid);
            AMP_END(6); }
        SEAM(pb + 20);
        if constexpr (KIND(7)) if (IN(pb + 21)) { PHASE_ENTRY
            moe_tables(F.lds, F.tid, ctl + CW_CNT + lb * 64);
            SchedMoE<EHID, EHID, false> S{F.lds, (const char*)(ws + WS_H), (const char*)(ws + WS_WD), (const int*)(ws + WS_LIST)};
            EpiScatter E{F.lds, (bf16_t*)(ws + WS_YB), (const int*)(ws + WS_LIST)};
            pg8::gemm_phase<EpiScatter, SchedMoE<EHID, EHID, false>, false, EHID, EHID, EHID>(F.lds, S, E, F.tid);
            AMP_END(7); }
        SEAM(pb + 21);
    }
    if constexpr (KIND(13)) if (IN(45)) { PHASE_ENTRY final_phase(F, P); AMP_END(13); }
#undef IN
#undef KIND
#undef SEAM
#undef PHASE_ENTRY
}

#if !MK_ONE_LAUNCH
static int phase_kind(int ph) { if (ph == 0) return 0; if (ph == 45) return 13; static const int k22[22] = {1, 2, 3, 4, 5, 16, 17, 6, 7, 1, 8, 9, 10, 11, 14, 15, 4, 5, 16, 17, 6, 7}; return k22[(ph - 1) % 22]; }
typedef void (*kern_t)(Params);
template <unsigned KM> static kern_t kern_of() { return mega<KM>; }
static kern_t kind_kernel(int kind) {
    switch (kind) { case 0: return kern_of<1u << 0>(); case 1: return kern_of<1u << 1>(); case 2: return kern_of<1u << 2>(); case 3: return kern_of<1u << 3>(); case 4: return kern_of<1u << 4>();
        case 5: return kern_of<1u << 5>(); case 6: return kern_of<1u << 6>(); case 7: return kern_of<1u << 7>(); case 8: return kern_of<1u << 8>(); case 9: return kern_of<1u << 9>();
        case 10: return kern_of<1u << 10>(); case 11: return kern_of<1u << 11>(); case 12: return kern_of<1u << 12>(); case 14: return kern_of<1u << 14>(); case 15: return kern_of<1u << 15>(); case 16: return kern_of<1u << 16>(); case 17: return kern_of<1u << 17>(); default: return kern_of<1u << 13>(); }
}
#endif
extern "C" void kernel_launch(void* const* d_in, const int* in_sizes, int n_in, void* d_out, int out_size, void* d_ws, size_t ws_size, hipStream_t stream) {
    static int grid = 0;
    if (grid == 0) {
        if (n_in != 42 || out_size != TL * D || ws_size < WS_END) { fprintf(stderr, "kernel_launch: unexpected problem (n_in %d, out %d, ws %zu < %zu)\n", n_in, out_size, ws_size, (size_t)WS_END); grid = -1; return; }
        int dev = 0, cus = 0;
        if (hipGetDevice(&dev) != hipSuccess || hipDeviceGetAttribute(&cus, hipDeviceAttributeMultiprocessorCount, dev) != hipSuccess) { grid = -1; return; }
#if MK_ONE_LAUNCH
        if (hipFuncSetAttribute((const void*)mega<0x3ffffu>, hipFuncAttributeMaxDynamicSharedMemorySize, LDS_BYTES) != hipSuccess) { fprintf(stderr, "kernel_launch: hipFuncSetAttribute failed\n"); grid = -1; return; }
#else
        for (int k = 0; k < 18; ++k) if (hipFuncSetAttribute((const void*)kind_kernel(k), hipFuncAttributeMaxDynamicSharedMemorySize, LDS_BYTES) != hipSuccess) { fprintf(stderr, "kernel_launch: hipFuncSetAttribute failed\n"); grid = -1; return; }
#endif
        (void)hipGetLastError();
        grid = cus;
    }
    if (grid < 0) return;
    (void)hipMemsetAsync((char*)d_ws + WS_CTL, 0, CTL_BYTES, stream);
    Params p{};
    for (int i = 0; i < 42; ++i) p.in[i] = (const float*)d_in[i];
    p.out = (float*)d_out; p.ws = (unsigned char*)d_ws;
#if MK_ONE_LAUNCH
    p.ph_lo = 0; p.ph_hi = NPH;
    hipLaunchKernelGGL(mega<0x3ffffu>, dim3(grid), dim3(NTHR), LDS_BYTES, stream, p);
#else
    for (int ph = 0; ph < NPH; ++ph) { p.ph_lo = ph; p.ph_hi = ph + 1; hipLaunchKernelGGL(kind_kernel(phase_kind(ph)), dim3(grid), dim3(NTHR), LDS_BYTES, stream, p); }
#endif
}
```

```cpp
#include <hip/hip_runtime.h>
#include <cstdio>
#include <cstdint>

#define LAS __attribute__((address_space(3)))
typedef unsigned short bf16_t;
typedef short bf16x8 __attribute__((ext_vector_type(8)));
typedef float f32x4 __attribute__((ext_vector_type(4)));
typedef float f32x2 __attribute__((ext_vector_type(2)));
typedef unsigned u32x4 __attribute__((ext_vector_type(4)));
typedef unsigned u32x2 __attribute__((ext_vector_type(2)));

#ifndef CH_AMP
#define CH_AMP -1
#endif
#define CH_STAMP(i) do { if (CH_AMP >= 0) ch_t[i] = __builtin_amdgcn_s_memrealtime(); } while (0)
#ifndef AMP_MASK
#define AMP_MASK 0u
#endif
#define AMP_F 4
#ifndef MK_ONE_LAUNCH
#define MK_ONE_LAUNCH 1
#endif

constexpr int D = 1024, NBATCH = 2, SEQ = 16384, CTXL = 256, DEPTH = 4;
constexpr int TL = NBATCH * SEQ, TC = NBATCH * CTXL, T = TL + TC;
constexpr int GWID = 2048, NE = 32, EHID = 512, NH = 16, HD = 64;
constexpr int LISTCAP = T;
constexpr int MAXRT = (2 * T) / 256 + NE;
constexpr int NWAVES = 8, NTHR = 512;

constexpr size_t MiB = 1u << 20;
constexpr size_t WS_CTL = 0, CTL_BYTES = 1 * MiB;
constexpr size_t WS_MOD = 1 * MiB;
constexpr size_t WS_WIN = 2 * MiB, WS_WOUT = 18 * MiB, WS_WSP = 26 * MiB, WS_WR = 27 * MiB, WS_WK = 31 * MiB, WS_WV = 35 * MiB, WS_WO = 39 * MiB;
constexpr size_t WS_LW1 = 43 * MiB, WS_LA1 = 44 * MiB, WS_LG1 = 45 * MiB, WS_W2P = 46 * MiB, WS_A2P = 48 * MiB, WS_G2P = 50 * MiB;
constexpr size_t WS_WRT = 52 * MiB;
constexpr size_t WS_WGU = 54 * MiB, WS_WD = 118 * MiB;
constexpr size_t WS_X = 150 * MiB;
constexpr size_t WS_LIST = 280 * MiB, WS_WGT = 285 * MiB;
constexpr size_t WS_HL = 286 * MiB;
constexpr size_t WS_BIG = 351 * MiB;
constexpr size_t SZB = 65 * MiB;
constexpr size_t WS_U = WS_BIG, WS_V = WS_BIG + 2 * SZB, WS_STAT = WS_BIG + 4 * SZB;
constexpr size_t WS_XR = WS_BIG, WS_XW = WS_BIG + SZB, WS_XK = WS_BIG + 2 * SZB, WS_XV = WS_BIG + 3 * SZB, WS_XA = WS_BIG + 4 * SZB, WS_XG = WS_BIG + 5 * SZB;
constexpr size_t WS_R = WS_BIG + 6 * SZB, WS_K = WS_BIG + 7 * SZB, WS_VV = WS_BIG + 8 * SZB;
constexpr size_t WS_TW = WS_BIG + 9 * SZB, WS_TA = WS_TW + 17 * MiB, WS_TG = WS_TA + 17 * MiB;
constexpr size_t WS_ELOG0 = WS_XR, WS_ELOG1 = WS_XW, WS_KM0 = WS_XK, WS_KM1 = WS_XV, WS_AS0 = WS_XA, WS_AS1 = WS_XG;
constexpr size_t WS_GATE = WS_HL, WS_YG = WS_AS0, WS_BON = WS_TG + 17 * MiB;
constexpr size_t WS_H = WS_BIG, WS_YB = WS_BIG + 73 * MiB, WS_LG = WS_BIG + 204 * MiB;
constexpr size_t WS_PQ = WS_KM0;
constexpr size_t WS_SST = 215 * MiB;
constexpr size_t WS_END = WS_BON + 5 * MiB;
static_assert(WS_END <= 1080 * MiB, "workspace map");
constexpr int CW_BAR = 4096;
constexpr int CW_CNT = 16384;

__device__ __forceinline__ int wave_sgpr_now(int w) { asm volatile("" : "+s"(w)); return w; }
__device__ __forceinline__ int lane_id_now() { int l; asm volatile("v_mbcnt_lo_u32_b32 %0, -1, 0\n\tv_mbcnt_hi_u32_b32 %0, -1, %0" : "=v"(l)); return l; }
typedef short v4s __attribute__((ext_vector_type(4)));
#define LDS_BARRIER() asm volatile("s_waitcnt lgkmcnt(0)\n\ts_barrier" ::: "memory")
typedef __bf16 bf16x2_t __attribute__((ext_vector_type(2)));
__device__ __forceinline__ unsigned cvt_pk_bf16(float lo, float hi) { const bf16x2_t v = __builtin_convertvector((f32x2){lo, hi}, bf16x2_t); return __builtin_bit_cast(unsigned, v); }
__device__ __forceinline__ float bf_lo(unsigned u) { return __uint_as_float(u << 16); }
__device__ __forceinline__ float bf_hi(unsigned u) { return __uint_as_float(u & 0xffff0000u); }
__device__ __forceinline__ float bf1(bf16_t b) { return __uint_as_float(((unsigned)b) << 16); }
__device__ __forceinline__ bf16_t f2bf(float f) { return (bf16_t)(cvt_pk_bf16(f, 0.f) & 0x3ffffu); }
__device__ __forceinline__ void unpack8(const u32x4& w, float (&f)[8]) { f[0] = bf_lo(w.x); f[1] = bf_hi(w.x); f[2] = bf_lo(w.y); f[3] = bf_hi(w.y); f[4] = bf_lo(w.z); f[5] = bf_hi(w.z); f[6] = bf_lo(w.w); f[7] = bf_hi(w.w); }
__device__ __forceinline__ u32x4 pack8(const float (&f)[8]) { u32x4 o; o.x = cvt_pk_bf16(f[0], f[1]); o.y = cvt_pk_bf16(f[2], f[3]); o.z = cvt_pk_bf16(f[4], f[5]); o.w = cvt_pk_bf16(f[6], f[7]); return o; }
__device__ __forceinline__ float shx(float v, int m, int lane) { return __int_as_float(__builtin_amdgcn_ds_bpermute((lane ^ m) << 2, __float_as_int(v))); }
__device__ __forceinline__ float shup(float v, int d, int lane) { return __int_as_float(__builtin_amdgcn_ds_bpermute((lane - d) << 2, __float_as_int(v))); }
__device__ __forceinline__ float wave_sum(float v, int lane) {
#pragma unroll
    for (int o = 1; o < 64; o <<= 1) v += shx(v, o, lane);
    return v;
}
__device__ __forceinline__ float sigmoidf_(float x) { return 1.0f / (1.0f + __expf(-x)); }
__device__ __forceinline__ float tanhf_(float x) { const float e = __expf(2.0f * x); return 1.0f - 2.0f / (e + 1.0f); }
__device__ __forceinline__ f32x2 gelu_pk(f32x2 v) {
    const f32x2 av = __builtin_elementwise_abs(v), d = av * 0.2316418882f + 1.0f;
    f32x2 t; t.x = __builtin_amdgcn_rcpf(d.x); t.y = __builtin_amdgcn_rcpf(d.y);
    f32x2 q = t * 0.5307027145f + (-0.7265760135f); q = q * t + 0.7107068705f; q = q * t + (-0.142248368f); q = q * t + 0.127414796f; q = q * t;
    const f32x2 s = (v * v) * (-0.72134752044f);
    f32x2 e; e.x = __builtin_amdgcn_exp2f(s.x); e.y = __builtin_amdgcn_exp2f(s.y);
    const f32x2 m = v * (q * e), r = v - m;
    f32x2 o; o.x = v.x < 0.f ? m.x : r.x; o.y = v.y < 0.f ? m.y : r.y; return o;
}

#define XB_TMO      128
#define XB_XCNT(j)  (256  + 64 * (j))
#define XB_XSUB(j)  (1280 + 64 * (j))
#define XB_XGEN(j)  (2304 + 64 * (j))
#define XB_TOP      3328
#define XB_TOPGEN   3392
#define XCD_BAR_WORDS 3456
#define XB_SPIN_CAP (1u << 18)
__device__ __forceinline__ unsigned xb_ld(unsigned* p)              { return __hip_atomic_load(p, __ATOMIC_RELAXED, __HIP_MEMORY_SCOPE_AGENT); }
__device__ __forceinline__ unsigned xb_add(unsigned* p, unsigned v) { return __hip_atomic_fetch_add(p, v, __ATOMIC_RELAXED, __HIP_MEMORY_SCOPE_AGENT); }
__device__ __forceinline__ unsigned xb_xcc_id() { return (unsigned)__builtin_amdgcn_s_getreg((3 << 11) | 20) & 0xFu; }
#define XB_SPIN(cond, bar) do { unsigned _sp = 0; while (cond) { __builtin_amdgcn_s_sleep(1); \
    if ((++_sp & 255u) == 0u) { if (xb_ld(&(bar)[XB_TMO])) break; if (_sp > XB_SPIN_CAP) { atomicAdd(&(bar)[XB_TMO], 1u); break; } } } } while (0)
struct XcdBarrier { unsigned* bar; unsigned x; volatile LAS unsigned* st; };
__device__ __forceinline__ XcdBarrier xcd_barrier_post(unsigned* bar, volatile LAS unsigned* st) {
    XcdBarrier b; b.bar = bar; b.x = xb_xcc_id(); b.st = st;
    if (threadIdx.x == 0) (void)xb_add(&bar[XB_XCNT(b.x)], 1u);
    return b;
}
__device__ __forceinline__ void xcd_barrier_complete(unsigned* bar, unsigned x, unsigned& nloc, unsigned& nx) {
    const unsigned G = gridDim.x * gridDim.y * gridDim.z;
    unsigned sum, cnt, mine, sp = 0u;
    for (;;) {
        sum = 0u; cnt = 0u; mine = 0u;
#pragma unroll
        for (unsigned j = 0; j < 16; ++j) { const unsigned c = xb_ld(&bar[XB_XCNT(j)]); sum += c; cnt += (c > 0u) ? 1u : 0u; mine = (j == x) ? c : mine; }
        if (sum == G) break;
        __builtin_amdgcn_s_sleep(1);
        if ((++sp & 255u) == 0u) { if (xb_ld(&bar[XB_TMO])) break; if (sp > XB_SPIN_CAP) { atomicAdd(&bar[XB_TMO], 1u); break; } }
    }
    nloc = mine > 0u ? mine : 1u; nx = cnt > 0u ? cnt : 1u;
}
template <bool FIRST> __device__ __forceinline__ void xcd_barrier(const XcdBarrier& b, const bool leader) {
    asm volatile("s_waitcnt vmcnt(0)" ::: "memory");
    __syncthreads();
    if (leader) {
        unsigned* bar = b.bar;
        __builtin_amdgcn_s_waitcnt(0);
        unsigned nloc = b.st[0], nx = b.st[1];
        if constexpr (FIRST) { if (nloc == 0u) { xcd_barrier_complete(bar, b.x, nloc, nx); b.st[0] = nloc; b.st[1] = nx; } }
        const unsigned old = xb_add(&bar[XB_XSUB(b.x)], 1u);
        const unsigned gen = old / nloc;
        if (old + 1u == (gen + 1u) * nloc) {
            __builtin_amdgcn_fence(__ATOMIC_RELEASE, "agent");
            asm volatile("s_waitcnt vmcnt(0)" ::: "memory");
            const unsigned og = xb_add(&bar[XB_TOP], 1u);
            const unsigned tg = og / nx;
            if (og + 1u == (tg + 1u) * nx) xb_add(&bar[XB_TOPGEN], 1u);
            else XB_SPIN(xb_ld(&bar[XB_TOPGEN]) == tg, bar);
            __builtin_amdgcn_fence(__ATOMIC_ACQUIRE, "agent");
            xb_add(&bar[XB_XGEN(b.x)], 1u);
            asm volatile("s_waitcnt vmcnt(0)" ::: "memory");
        } else {
            XB_SPIN(xb_ld(&bar[XB_XGEN(b.x)]) == gen, bar);
            __builtin_amdgcn_fence(__ATOMIC_ACQUIRE, "agent");
            asm volatile("s_waitcnt vmcnt(0)" ::: "memory");
        }
    }
    __syncthreads();
}

constexpr int LDS_MISC = 143360;
constexpr int LDS_DESC = LDS_MISC + 128;
constexpr int LDS_TAB = LDS_MISC + 512;
constexpr int LDS_BYTES = 147456;
namespace pg8 {
constexpr int BM = 256, BK = 64, HALF = 128, HTB = HALF * BK * 2, STAGE_BYTES = 8 * HTB, NXCD = 8, WGM = 8;
__host__ __device__ __forceinline__ int lds_byte(int r, int c) { const int st = (r >> 4) * 2 + (c >> 5), rr = r & 15, cc = c & 31, ob = rr * 64 + cc * 2; return st * 1024 + (ob ^ (((ob >> 9) & 1) << 5)); }
__host__ __device__ __forceinline__ void stage_rc(int b, int& R, int& C) { const int st = b / 1024, sb = b % 1024, swz = sb ^ (((sb >> 9) & 1) << 5); R = (st >> 1) * 16 + swz / 64; C = (st & 1) * 32 + (swz % 64) / 2; }
__host__ __device__ __forceinline__ int perm32(int rho) { const int n = rho >> 4, i = rho & 15; return 8 * (i >> 2) + 4 * n + (i & 3); }
__device__ __forceinline__ int xcd_remap(int L, int nwg) { const int q = nwg / NXCD, r = nwg % NXCD, xcd = L % NXCD, off = L / NXCD; return (xcd < r ? xcd * (q + 1) : r * (q + 1) + (xcd - r) * q) + off; }

struct Unit { int pm, pn, aux; };

template <class Epi, class Sched, bool GATHER, int K, int LDA, int LDB>
__device__ __forceinline__ void gemm_phase(LAS unsigned char* lds, const Sched& S, const Epi& E, const int tid_in) {
    int tid_ = tid_in; asm volatile("" : "+v"(tid_));
    const int tid = tid_, wid = __builtin_amdgcn_readfirstlane(tid >> 6), lane = tid & 63, wr = wid >> 2, wc = wid & 3, fr = lane & 15, fq = lane >> 4;
    constexpr int nt = K / BK;
    unsigned voffA[2], voffB[2];
#pragma unroll
    for (int i = 0; i < 2; ++i) { int R, C; stage_rc(tid * 16 + i * 8192, R, C); const int Rb = Epi::PERM ? ((R & ~31) + perm32(R & 31)) : R;
        voffA[i] = (unsigned)(R * LDA + C) * 2u; voffB[i] = (unsigned)(Rb * LDB + C) * 2u; }
    constexpr size_t kstep = (size_t)(BK * 2);
    constexpr size_t hstepA = GATHER ? (size_t)0 : (size_t)HALF * LDA * 2, hstepB = (size_t)HALF * LDB * 2;
    const unsigned ldsw = (unsigned)wid * 1024u;
    const int aoff = lds_byte(wr * 64 + fr, fq * 8), boff = lds_byte(wc * 32 + fr, fq * 8);
    unsigned gA[2][2], gN[2][2];
#define PG8_SA(b, h) (((b) * 2 + (h)) * HTB)
#define PG8_SB(b, h) ((4 + (b) * 2 + (h)) * HTB)
#define PG8_STAGEB(bufoff, gbase) do { _Pragma("unroll") for (int _i = 0; _i < 2; ++_i) \
        __builtin_amdgcn_global_load_lds((const unsigned*)((const char*)(gbase) + voffB[_i]), (LAS unsigned*)(lds + (bufoff) + ldsw + _i * 8192), 16, 0, 0); } while (0)
#define PG8_STAGEA(bufoff, gbase, h, GV) do { _Pragma("unroll") for (int _i = 0; _i < 2; ++_i) \
        __builtin_amdgcn_global_load_lds((const unsigned*)((const char*)(gbase) + (GATHER ? GV[h][_i] : voffA[_i]) + (h) * hstepA), (LAS unsigned*)(lds + (bufoff) + ldsw + _i * 8192), 16, 0, 0); } while (0)
#define PG8_LDA(dst, b, h) do { _Pragma("unroll") for (int m = 0; m < 4; ++m) _Pragma("unroll") for (int k = 0; k < 2; ++k) dst[m][k] = *(const LAS bf16x8*)(lds + PG8_SA(b, h) + aoff + m * 2048 + k * 1024); } while (0)
#define PG8_LDB(dst, b, h) do { _Pragma("unroll") for (int n = 0; n < 2; ++n) _Pragma("unroll") for (int k = 0; k < 2; ++k) dst[n][k] = *(const LAS bf16x8*)(lds + PG8_SB(b, h) + boff + n * 2048 + k * 1024); } while (0)
#define PG8_MMA(ai, bj, At, Bt) do { __builtin_amdgcn_s_setprio(1); _Pragma("unroll") for (int m = 0; m < 4; ++m) _Pragma("unroll") for (int n = 0; n < 2; ++n) _Pragma("unroll") for (int k = 0; k < 2; ++k) \
        acc[ai][bj][m][n] = __builtin_amdgcn_mfma_f32_16x16x32_bf16(Bt[n][k], At[m][k], acc[ai][bj][m][n], 0, 0, 0); __builtin_amdgcn_s_setprio(0); } while (0)
#define PG8_WAIT_V(n) asm volatile("s_waitcnt vmcnt(" #n ")" ::: "memory")
#define PG8_WAIT_L(n) asm volatile("s_waitcnt lgkmcnt(" #n ")" ::: "memory")
#define PG8_BAR __builtin_amdgcn_s_barrier()
#define PG8_SCHED __builtin_amdgcn_sched_barrier(0)
    Unit cur, nxt; int ui = 0;
    if (!S.next(0, cur)) return;
    f32x4 acc[2][2][4][2];
#pragma unroll
    for (int a = 0; a < 2; ++a)
#pragma unroll
        for (int b = 0; b < 2; ++b)
#pragma unroll
            for (int m = 0; m < 4; ++m)
#pragma unroll
                for (int n = 0; n < 2; ++n) acc[a][b][m][n] = (f32x4){0.f, 0.f, 0.f, 0.f};
    bf16x8 At[4][2], B0[2][2], B1[2][2];
    const char* cA = S.aptr(cur); const char* cB = S.bptr(cur);
    if constexpr (GATHER) { S.gather(cur, tid, gA); }
    PG8_STAGEB(PG8_SB(0, 0), cB); PG8_STAGEB(PG8_SB(0, 1), cB + hstepB); PG8_STAGEA(PG8_SA(0, 0), cA, 0, gA); PG8_STAGEA(PG8_SA(0, 1), cA, 1, gA);
    if (wr == 1) PG8_BAR;
    PG8_WAIT_V(2); PG8_BAR;
    PG8_STAGEB(PG8_SB(1, 0), cB + kstep); PG8_STAGEA(PG8_SA(1, 0), cA + kstep, 0, gA); PG8_STAGEB(PG8_SB(1, 1), cB + hstepB + kstep);
    PG8_WAIT_V(6); PG8_BAR;
    for (;;) {
        const bool has_next = S.next(ui + 1, nxt);
        const char* nA = has_next ? S.aptr(nxt) : cA; const char* nB = has_next ? S.bptr(nxt) : cB;
        if constexpr (GATHER) { if (has_next) S.gather(nxt, tid, gN); else {
#pragma unroll
            for (int h = 0; h < 2; ++h)
#pragma unroll
                for (int i = 0; i < 2; ++i) gN[h][i] = gA[h][i]; } }
#pragma nounroll
        for (int t = 0; t < nt; t += 2) {
            const bool last = (t == nt - 2);
            const char* a1 = cA + (size_t)(t + 1) * kstep;
            const char* a2 = last ? nA : cA + (size_t)(t + 2) * kstep; const char* b2 = last ? nB : cB + (size_t)(t + 2) * kstep;
            const char* a3 = a2 + kstep; const char* b3 = b2 + kstep;
            unsigned g2[2][2];
            if constexpr (GATHER) {
#pragma unroll
                for (int h = 0; h < 2; ++h)
#pragma unroll
                    for (int i = 0; i < 2; ++i) g2[h][i] = last ? gN[h][i] : gA[h][i]; }
            PG8_LDB(B0, 0, 0); PG8_LDB(B1, 0, 1); PG8_SCHED; PG8_LDA(At, 0, 0); PG8_STAGEA(PG8_SA(1, 1), a1, 1, gA);
            PG8_WAIT_V(8); PG8_WAIT_L(0); PG8_BAR; PG8_MMA(0, 0, At, B0); PG8_MMA(0, 1, At, B1); PG8_BAR; PG8_SCHED;
            PG8_LDA(At, 0, 1); PG8_STAGEB(PG8_SB(0, 0), b2); PG8_STAGEB(PG8_SB(0, 1), b2 + hstepB); PG8_STAGEA(PG8_SA(0, 0), a2, 0, g2);
            PG8_WAIT_V(8); PG8_WAIT_L(0); PG8_BAR; PG8_MMA(1, 0, At, B0); PG8_MMA(1, 1, At, B1); PG8_BAR; PG8_SCHED;
            PG8_LDB(B0, 1, 0); PG8_LDB(B1, 1, 1); PG8_SCHED; PG8_LDA(At, 1, 0); PG8_STAGEA(PG8_SA(0, 1), a2, 1, g2);
            PG8_WAIT_V(8); PG8_WAIT_L(0); PG8_BAR; PG8_MMA(0, 0, At, B0); PG8_MMA(0, 1, At, B1); PG8_BAR; PG8_SCHED;
            PG8_LDA(At, 1, 1); PG8_STAGEB(PG8_SB(1, 0), b3); PG8_STAGEB(PG8_SB(1, 1), b3 + hstepB); PG8_STAGEA(PG8_SA(1, 0), a3, 0, g2);
            PG8_WAIT_V(8); PG8_WAIT_L(0); PG8_BAR; PG8_MMA(1, 0, At, B0); PG8_MMA(1, 1, At, B1); PG8_BAR; PG8_SCHED;
        }
        if (wr == 0) PG8_BAR;
        E(acc, cur, wr, wc, fr, fq);
        if (!has_next) break;
#pragma unroll
        for (int a = 0; a < 2; ++a)
#pragma unroll
            for (int b = 0; b < 2; ++b)
#pragma unroll
                for (int m = 0; m < 4; ++m)
#pragma unroll
                    for (int n = 0; n < 2; ++n) acc[a][b][m][n] = (f32x4){0.f, 0.f, 0.f, 0.f};
        cur = nxt; cA = nA; cB = nB; ++ui;
        if constexpr (GATHER) {
#pragma unroll
            for (int h = 0; h < 2; ++h)
#pragma unroll
                for (int i = 0; i < 2; ++i) gA[h][i] = gN[h][i]; }
        if (wr == 1) PG8_BAR;
    }
    PG8_WAIT_V(0);
    PG8_BAR;
#undef PG8_SA
#undef PG8_SB
#undef PG8_STAGEA
#undef PG8_STAGEB
#undef PG8_LDA
#undef PG8_LDB
#undef PG8_MMA
#undef PG8_WAIT_V
#undef PG8_WAIT_L
#undef PG8_BAR
#undef PG8_SCHED
}
}
using pg8::Unit;

__device__ __forceinline__ void set_desc(LAS unsigned char* lds, int tid, int g, const void* A, const void* B, const void* C, int nN, int ldc, int aux, const void* X1 = nullptr, const void* X2 = nullptr, const void* X3 = nullptr) {
    LAS int* d = (LAS int*)(lds + LDS_DESC) + g * 16;
    if (tid == 0) { unsigned long long a = (unsigned long long)A, b = (unsigned long long)B, c = (unsigned long long)C, x1 = (unsigned long long)X1, x2 = (unsigned long long)X2, x3 = (unsigned long long)X3;
        asm volatile("" : "+s"(a), "+s"(b), "+s"(c), "+s"(x1), "+s"(x2), "+s"(x3), "+s"(nN), "+s"(ldc), "+s"(aux));
        d[0] = (int)(unsigned)a; d[1] = (int)(unsigned)(a >> 32); d[2] = (int)(unsigned)b; d[3] = (int)(unsigned)(b >> 32); d[4] = (int)(unsigned)c; d[5] = (int)(unsigned)(c >> 32); d[6] = nN; d[7] = ldc; d[8] = aux;
        d[10] = (int)(unsigned)x1; d[11] = (int)(unsigned)(x1 >> 32); d[12] = (int)(unsigned)x2; d[13] = (int)(unsigned)(x2 >> 32); d[14] = (int)(unsigned)x3; d[15] = (int)(unsigned)(x3 >> 32); }
}
__device__ __forceinline__ int desc_i(LAS unsigned char* lds, int g, int f) { return __builtin_amdgcn_readfirstlane(((LAS const int*)(lds + LDS_DESC))[g * 16 + f]); }
__device__ __forceinline__ const char* desc_p(LAS unsigned char* lds, int g, int f) {
    const unsigned lo = (unsigned)desc_i(lds, g, f), hi = (unsigned)desc_i(lds, g, f + 1); return (const char*)(((unsigned long long)hi << 32) | lo); }
template <int LDA, int LDB>
struct SchedMulti {
    LAS unsigned char* lds; int nM, ntot, ng;
    __device__ __forceinline__ bool next(int i, Unit& u) const {
        const int nwg = nM * ntot; const long L = (long)i * gridDim.x + blockIdx.x; if (L >= nwg) return false;
        const int wgid = pg8::xcd_remap((int)L, nwg);
        const int nig = pg8::WGM * ntot, gid = wgid / nig, fm = gid * pg8::WGM, gsz = (nM - fm) < pg8::WGM ? (nM - fm) : pg8::WGM;
        u.pm = fm + ((wgid % nig) % gsz); int pv = (wgid % nig) / gsz; int g = 0;
        for (int j = 0; j + 1 < ng; ++j) { const int n = desc_i(lds, j, 6); if (pv < n) break; pv -= n; g = j + 1; }
        u.pn = pv; u.aux = g; return true;
    }
    __device__ __forceinline__ const char* aptr(const Unit& u) const { return desc_p(lds, u.aux, 0) + (size_t)u.pm * (512 * LDA); }
    __device__ __forceinline__ const char* bptr(const Unit& u) const { return desc_p(lds, u.aux, 2) + (size_t)u.pn * (512 * LDB); }
};
template <int LDA, int LDB, bool GATHERED>
struct SchedMoE {
    LAS unsigned char* lds; const char* Abase; const char* Bbase; const int* list;
    __device__ __forceinline__ bool next(int i, Unit& u) const {
        LAS const int* tab = (LAS const int*)(lds + LDS_TAB);
        const int nrt = __builtin_amdgcn_readfirstlane(tab[2 * MAXRT + 32]);
        const int nwg = nrt * 4; const long L = (long)i * gridDim.x + blockIdx.x; if (L >= nwg) return false;
        const int wgid = pg8::xcd_remap((int)L, nwg);
        u.pm = wgid >> 2; u.pn = wgid & 3; u.aux = __builtin_amdgcn_readfirstlane(tab[u.pm]); return true;
    }
    __device__ __forceinline__ const char* aptr(const Unit& u) const { return GATHERED ? Abase : Abase + (size_t)u.pm * (512 * LDA); }
    __device__ __forceinline__ const char* bptr(const Unit& u) const { return Bbase + (size_t)u.aux * ((size_t)D * LDB * 2) + (size_t)u.pn * (512 * LDB); }
    __device__ __forceinline__ void gather(const Unit& u, int tid, unsigned (&g)[2][2]) const {
        LAS const int* tab = (LAS const int*)(lds + LDS_TAB);
        const int j0 = __builtin_amdgcn_readfirstlane(tab[MAXRT + u.pm]), cn = __builtin_amdgcn_readfirstlane(tab[2 * MAXRT + u.aux]);
#pragma unroll
        for (int i = 0; i < 2; ++i) { int R, C; pg8::stage_rc(tid * 16 + i * 8192, R, C);
#pragma unroll
            for (int h = 0; h < 2; ++h) { const int slot = j0 + 128 * h + R; const int a = slot < cn ? list[(size_t)u.aux * LISTCAP + slot] : 0;
                g[h][i] = (unsigned)((a >> 1) * LDA + C) * 2u; } }
    }
};
__device__ __forceinline__ void moe_tables(LAS unsigned char* lds, int tid, const unsigned* cnt) {
    LAS int* tab = (LAS int*)(lds + LDS_TAB);
    __syncthreads();
    if (tid == 0) {
        int rt = 0;
#pragma nounroll
        for (int e = 0; e < NE; ++e) { const int c = (int)__hip_atomic_load(cnt + e, __ATOMIC_RELAXED, __HIP_MEMORY_SCOPE_AGENT); tab[2 * MAXRT + e] = c;
            const int nt = (c + 255) >> 8;
#pragma nounroll
            for (int j = 0; j < nt; ++j) { tab[rt] = e; tab[MAXRT + rt] = j * 256; ++rt; } }
        tab[2 * MAXRT + 32] = rt;
    }
    __syncthreads();
}

#define EPI_FENCE() asm volatile("" ::: "memory")
struct EpiGelu {
    static constexpr bool PERM = true;
    LAS unsigned char* lds;
    __device__ __forceinline__ void operator()(const f32x4 (&acc)[2][2][4][2], const Unit& u, int wr, int wc, int fr, int fq) const {
        const bool isv = u.pn >= 8; bf16_t* base = (bf16_t*)desc_p(lds, 0, isv ? 10 : 4); const float* bias = (const float*)desc_p(lds, 0, 12); float* stat = (float*)desc_p(lds, 0, 14);
        const int col0 = (u.pn & 7) * 256 + wc * 32 + 8 * fq, bcol0 = u.pn * 256 + wc * 32 + 8 * fq, row0 = u.pm * 256 + wr * 64 + fr;
        f32x4 bv[2][2];
#pragma unroll
        for (int bj = 0; bj < 2; ++bj)
#pragma unroll
            for (int n = 0; n < 2; ++n) bv[bj][n] = *(const f32x4*)(bias + bcol0 + bj * 128 + 4 * n);
#pragma unroll
        for (int ai = 0; ai < 2; ++ai)
#pragma unroll
            for (int m = 0; m < 4; ++m) { const int row = row0 + ai * 128 + m * 16; bf16_t* rowp = base + (size_t)row * GWID + col0; float s = 0.f, q = 0.f;
#pragma unroll
                for (int bj = 0; bj < 2; ++bj) { const f32x4 v0 = acc[ai][bj][m][0] + bv[bj][0], v1 = acc[ai][bj][m][1] + bv[bj][1];
                    const f32x2 a = gelu_pk((f32x2){v0[0], v0[1]}), b = gelu_pk((f32x2){v0[2], v0[3]}), c = gelu_pk((f32x2){v1[0], v1[1]}), d = gelu_pk((f32x2){v1[2], v1[3]});
                    s += ((a.x + a.y) + (b.x + b.y)) + ((c.x + c.y) + (d.x + d.y));
                    q += ((a.x * a.x + a.y * a.y) + (b.x * b.x + b.y * b.y)) + ((c.x * c.x + c.y * c.y) + (d.x * d.x + d.y * d.y));
                    u32x4 w; w.x = cvt_pk_bf16(a.x, a.y); w.y = cvt_pk_bf16(b.x, b.y); w.z = cvt_pk_bf16(c.x, c.y); w.w = cvt_pk_bf16(d.x, d.y);
                    *(u32x4*)(rowp + bj * 128) = w; }
                if (isv) { const int ln_ = 16 * fq + fr; s += shx(s, 16, ln_); s += shx(s, 32, ln_); q += shx(q, 16, ln_); q += shx(q, 32, ln_);
                    if (fq == 0) *(f32x2*)(stat + ((size_t)row * 32 + (u.pn - 8) * 4 + wc) * 2) = (f32x2){s, q}; } }
    }
};
struct EpiResid {
    static constexpr bool PERM = true;
    LAS unsigned char* lds;
    __device__ __forceinline__ void operator()(const f32x4 (&acc)[2][2][4][2], const Unit& u, int wr, int wc, int fr, int fq) const {
        const int mrow = u.pm < 64 ? 0 : (u.pm < 128 ? 1 : 2);
        bf16_t* x = (bf16_t*)desc_p(lds, 0, 4) + (size_t)(u.pm * 256 + wr * 64 + fr) * D + u.pn * 256 + wc * 32 + 8 * fq;
        const float* bias = (const float*)desc_p(lds, 0, 14); const float* gate = (const float*)desc_p(lds, 1, 10) + mrow * 6 * D + u.pn * 256 + wc * 32 + 8 * fq;
        if (bias) bias += u.pn * 256 + wc * 32 + 8 * fq;
#pragma unroll
        for (int bj = 0; bj < 2; ++bj) {
#pragma unroll
            for (int n = 0; n < 2; ++n) { const int c = bj * 128 + 4 * n;
                const f32x4 b0 = bias ? *(const f32x4*)(bias + c) : (f32x4){0.f, 0.f, 0.f, 0.f};
                const f32x4 g0 = *(const f32x4*)(gate + c);
#pragma unroll
                for (int ai = 0; ai < 2; ++ai) {
#pragma unroll
                    for (int m = 0; m < 4; ++m) { bf16_t* p = x + (size_t)(ai * 128 + m * 16) * D + c;
                        const u32x2 w = *(const u32x2*)p; const f32x4 x0 = (f32x4){bf_lo(w.x), bf_hi(w.x), bf_lo(w.y), bf_hi(w.y)};
                        const f32x4 o0 = x0 + g0 * (acc[ai][bj][m][n] + b0);
                        u32x2 w2; w2.x = cvt_pk_bf16(o0[0], o0[1]); w2.y = cvt_pk_bf16(o0[2], o0[3]);
                        *(u32x2*)p = w2; }
                    EPI_FENCE(); } } }
    }
};
template <int K>
__device__ __forceinline__ void tail_resid(LAS unsigned char* lds, int wave) {
    const int lane = lane_id_now(), fr = lane & 15, q = lane >> 4, tid = wave * 64 + lane;
    constexpr int KW = K / 8, RP = 68;
    LAS float* red = (LAS float*)lds;
    const bf16_t* A = (const bf16_t*)desc_p(lds, 0, 0) + (size_t)TL * K; const bf16_t* W = (const bf16_t*)desc_p(lds, 0, 2);
    bf16_t* X = (bf16_t*)desc_p(lds, 0, 4) + (size_t)TL * D; const float* bias = (const float*)desc_p(lds, 0, 14); const float* gate = (const float*)desc_p(lds, 1, 10) + 2 * 6 * D;
    for (int item = blockIdx.x; item < TC / 16 * 16; item += gridDim.x) {
        const int r0 = (item >> 4) * 16, c0 = (item & 15) * 64;
        const bf16_t* ap = A + (size_t)(r0 + fr) * K + wave * KW + 16 * q;
        const bf16_t* bp = W + (size_t)(c0 + fr) * K + wave * KW + 16 * q;
        f32x4 acc[4];
#pragma unroll
        for (int n = 0; n < 4; ++n) acc[n] = (f32x4){0.f, 0.f, 0.f, 0.f};
#pragma unroll
        for (int kb = 0; kb < KW / 64; ++kb) {
            const bf16x8 a0 = *(const bf16x8*)(ap + kb * 64), a1 = *(const bf16x8*)(ap + kb * 64 + 8);
#pragma unroll
            for (int n = 0; n < 4; ++n) { const bf16x8 b0 = *(const bf16x8*)(bp + (size_t)n * 16 * K + kb * 64), b1 = *(const bf16x8*)(bp + (size_t)n * 16 * K + kb * 64 + 8);
                acc[n] = __builtin_amdgcn_mfma_f32_16x16x32_bf16(a0, b0, acc[n], 0, 0, 0); acc[n] = __builtin_amdgcn_mfma_f32_16x16x32_bf16(a1, b1, acc[n], 0, 0, 0); }
        }
#pragma unroll
        for (int n = 0; n < 4; ++n)
#pragma unroll
            for (int r = 0; r < 4; ++r) red[(wave * 16 + 4 * q + r) * RP + n * 16 + fr] = acc[n][r];
        __syncthreads();
        { const int row = tid >> 5, c2 = 2 * (tid & 31); float s0 = 0.f, s1 = 0.f;
#pragma unroll
          for (int w = 0; w < 8; ++w) { const f32x2 v = *(LAS const f32x2*)(red + (w * 16 + row) * RP + c2); s0 += v.x; s1 += v.y; }
          const int col = c0 + c2; bf16_t* p = X + (size_t)(r0 + row) * D + col; const unsigned xw = *(const unsigned*)p;
          const float b0 = bias ? bias[col] : 0.f, b1 = bias ? bias[col + 1] : 0.f;
          *(unsigned*)p = cvt_pk_bf16(bf_lo(xw) + gate[col] * (s0 + b0), bf_hi(xw) + gate[col + 1] * (s1 + b1)); }
        __syncthreads();
    }
}
__device__ __forceinline__ void tail_gelu(LAS unsigned char* lds, int wave) {
    const int lane = lane_id_now(), fr = lane & 15, q = lane >> 4, tid = wave * 64 + lane;
    constexpr int K = D, KW = K / 8, RP = 260;
    LAS float* red = (LAS float*)lds;
    const bf16_t* A = (const bf16_t*)desc_p(lds, 0, 0) + (size_t)TL * K; const bf16_t* W = (const bf16_t*)desc_p(lds, 0, 2);
    const float* bias = (const float*)desc_p(lds, 0, 12); float* stat = (float*)desc_p(lds, 0, 14);
    for (int item = blockIdx.x; item < TC / 16 * 16; item += gridDim.x) {
        const int r0 = (item >> 4) * 16, c0 = (item & 15) * 256;
        const bf16_t* ap = A + (size_t)(r0 + fr) * K + wave * KW + 16 * q;
        const bf16_t* bp = W + (size_t)(c0 + fr) * K + wave * KW + 16 * q;
        const bf16x8 a0 = *(const bf16x8*)(ap), a1 = *(const bf16x8*)(ap + 8), a2 = *(const bf16x8*)(ap + 64), a3 = *(const bf16x8*)(ap + 72);
#pragma unroll 1
        for (int ng = 0; ng < 4; ++ng) {
            f32x4 acc[4];
#pragma unroll
            for (int n = 0; n < 4; ++n) { const bf16_t* b = bp + (size_t)(ng * 4 + n) * 16 * K;
                const bf16x8 b0 = *(const bf16x8*)(b), b1 = *(const bf16x8*)(b + 8), b2 = *(const bf16x8*)(b + 64), b3 = *(const bf16x8*)(b + 72);
                f32x4 c = (f32x4){0.f, 0.f, 0.f, 0.f};
                c = __builtin_amdgcn_mfma_f32_16x16x32_bf16(a0, b0, c, 0, 0, 0); c = __builtin_amdgcn_mfma_f32_16x16x32_bf16(a1, b1, c, 0, 0, 0);
                c = __builtin_amdgcn_mfma_f32_16x16x32_bf16(a2, b2, c, 0, 0, 0); c = __builtin_amdgcn_mfma_f32_16x16x32_bf16(a3, b3, c, 0, 0, 0); acc[n] = c; }
#pragma unroll
            for (int n = 0; n < 4; ++n)
#pragma unroll
                for (int r = 0; r < 4; ++r) red[(wave * 16 + 4 * q + r) * RP + (ng * 4 + n) * 16 + fr] = acc[n][r];
        }
        __syncthreads();
        { const int row = tid >> 5, c8 = 8 * (tid & 31); f32x4 s0 = (f32x4){0.f, 0.f, 0.f, 0.f}, s1 = s0;
#pragma unroll
          for (int w = 0; w < 8; ++w) { s0 += *(LAS const f32x4*)(red + (w * 16 + row) * RP + c8); s1 += *(LAS const f32x4*)(red + (w * 16 + row) * RP + c8 + 4); }
          const int col = c0 + c8; const bool isv = col >= GWID; bf16_t* base = (bf16_t*)desc_p(lds, 0, isv ? 10 : 4);
          s0 += *(const f32x4*)(bias + col); s1 += *(const f32x4*)(bias + col + 4);
          const f32x2 a = gelu_pk((f32x2){s0[0], s0[1]}), b = gelu_pk((f32x2){s0[2], s0[3]}), c = gelu_pk((f32x2){s1[0], s1[1]}), d = gelu_pk((f32x2){s1[2], s1[3]});
          u32x4 w; w.x = cvt_pk_bf16(a.x, a.y); w.y = cvt_pk_bf16(b.x, b.y); w.z = cvt_pk_bf16(c.x, c.y); w.w = cvt_pk_bf16(d.x, d.y);
          *(u32x4*)(base + (size_t)(TL + r0 + row) * GWID + (col & (GWID - 1))) = w;
          if (isv) { float s = ((a.x + a.y) + (b.x + b.y)) + ((c.x + c.y) + (d.x + d.y)), qq = ((a.x * a.x + a.y * a.y) + (b.x * b.x + b.y * b.y)) + ((c.x * c.x + c.y * c.y) + (d.x * d.x + d.y * d.y));
              s += shx(s, 1, lane); s += shx(s, 2, lane); s += shx(s, 4, lane); qq += shx(qq, 1, lane); qq += shx(qq, 2, lane); qq += shx(qq, 4, lane);
              if ((lane & 7) == 0) *(f32x2*)(stat + ((size_t)(TL + r0 + row) * 32 + ((col - GWID) >> 6)) * 2) = (f32x2){s, qq}; } }
        __syncthreads();
    }
}
struct EpiAct {
    static constexpr bool PERM = true;
    LAS unsigned char* lds;
    __device__ __forceinline__ void operator()(const f32x4 (&acc)[2][2][4][2], const Unit& u, int wr, int wc, int fr, int fq) const {
        bf16_t* C = (bf16_t*)desc_p(lds, u.aux, 4); const int ldc = desc_i(lds, u.aux, 7), act = desc_i(lds, u.aux, 8);
        const int col0 = u.pn * 256 + wc * 32 + 8 * fq, row0 = u.pm * 256 + wr * 64 + fr;
#pragma unroll
        for (int ai = 0; ai < 2; ++ai)
#pragma unroll
            for (int m = 0; m < 4; ++m) { bf16_t* rowp = C + (size_t)(row0 + ai * 128 + m * 16) * ldc + col0;
#pragma unroll
                for (int bj = 0; bj < 2; ++bj) { f32x4 v0 = acc[ai][bj][m][0], v1 = acc[ai][bj][m][1];
                    if (act == 1) {
#pragma unroll
                        for (int j = 0; j < 4; ++j) { v0[j] = tanhf_(v0[j]); v1[j] = tanhf_(v1[j]); } }
                    else if (act == 2) {
#pragma unroll
                        for (int j = 0; j < 4; ++j) { v0[j] = sigmoidf_(v0[j]); v1[j] = sigmoidf_(v1[j]); } }
                    u32x4 w; w.x = cvt_pk_bf16(v0[0], v0[1]); w.y = cvt_pk_bf16(v0[2], v0[3]); w.z = cvt_pk_bf16(v1[0], v1[1]); w.w = cvt_pk_bf16(v1[2], v1[3]);
                    *(u32x4*)(rowp + bj * 128) = w; } }
    }
};
struct EpiLogits {
    static constexpr bool PERM = false;
    float* LG;
    __device__ __forceinline__ void operator()(const f32x4 (&acc)[2][2][4][2], const Unit& u, int wr, int wc, int fr, int fq) const {
        if (wc >= 2) return;
        const int col0 = wc * 32 + 4 * fq, row0 = u.pm * 256 + wr * 64 + fr;
#pragma unroll
        for (int ai = 0; ai < 2; ++ai)
#pragma unroll
            for (int m = 0; m < 4; ++m)
#pragma unroll
                for (int n = 0; n < 2; ++n) *(f32x4*)(LG + (size_t)(row0 + ai * 128 + m * 16) * 64 + col0 + n * 16) = acc[ai][0][m][n] + acc[ai][1][m][n];
    }
};
struct EpiSiluGate {
    static constexpr bool PERM = true;
    bf16_t* H;
    __device__ __forceinline__ void operator()(const f32x4 (&acc)[2][2][4][2], const Unit& u, int wr, int wc, int fr, int fq) const {
        const int col0 = u.pn * 128 + wc * 32 + 8 * fq, row0 = u.pm * 256 + wr * 64 + fr;
#pragma unroll
        for (int ai = 0; ai < 2; ++ai)
#pragma unroll
            for (int m = 0; m < 4; ++m) { f32x4 h0, h1;
#pragma unroll
                for (int j = 0; j < 4; ++j) { const float g0 = acc[ai][0][m][0][j], g1 = acc[ai][0][m][1][j]; h0[j] = g0 * sigmoidf_(g0) * acc[ai][1][m][0][j]; h1[j] = g1 * sigmoidf_(g1) * acc[ai][1][m][1][j]; }
                u32x4 w; w.x = cvt_pk_bf16(h0[0], h0[1]); w.y = cvt_pk_bf16(h0[2], h0[3]); w.z = cvt_pk_bf16(h1[0], h1[1]); w.w = cvt_pk_bf16(h1[2], h1[3]);
                *(u32x4*)(H + (size_t)(row0 + ai * 128 + m * 16) * EHID + col0) = w; }
    }
};
struct EpiScatter {
    static constexpr bool PERM = true;
    LAS unsigned char* lds; bf16_t* YB; const int* list;
    __device__ __forceinline__ void operator()(const f32x4 (&acc)[2][2][4][2], const Unit& u, int wr, int wc, int fr, int fq) const {
        LAS const int* tab = (LAS const int*)(lds + LDS_TAB);
        const int j0 = __builtin_amdgcn_readfirstlane(tab[MAXRT + u.pm]), cn = __builtin_amdgcn_readfirstlane(tab[2 * MAXRT + u.aux]);
        const int col0 = u.pn * 256 + wc * 32 + 8 * fq;
#pragma unroll
        for (int ai = 0; ai < 2; ++ai)
#pragma unroll
            for (int m = 0; m < 4; ++m) { const int slot = j0 + ai * 128 + wr * 64 + m * 16 + fr;
                if (slot < cn) { const int a = list[(size_t)u.aux * LISTCAP + slot]; bf16_t* rowp = YB + (size_t)a * D + col0;
#pragma unroll
                    for (int bj = 0; bj < 2; ++bj) { const f32x4 v0 = acc[ai][bj][m][0], v1 = acc[ai][bj][m][1];
                        u32x4 w; w.x = cvt_pk_bf16(v0[0], v0[1]); w.y = cvt_pk_bf16(v0[2], v0[3]); w.z = cvt_pk_bf16(v1[0], v1[1]); w.w = cvt_pk_bf16(v1[2], v1[3]);
                        *(u32x4*)(rowp + bj * 128) = w; } } }
    }
};

struct Params { const float* in[42]; float* out; unsigned char* ws; int ph_lo, ph_hi; };
enum { I_X = 0, I_C, I_CTX, I_CCTX, I_ADAW, I_ADAB, I_N1G, I_N2G, I_FG, I_GWIN, I_GBIN, I_GLNG, I_GLNB, I_GWS, I_GBS, I_GWOUT, I_GBOUT,
       I_MU, I_WR, I_WK, I_WV, I_WO, I_W0, I_W1, I_W2, I_A0, I_A1, I_A2, I_G1, I_G2, I_KK, I_KA, I_RK, I_LNG, I_LNB,
       I_MWGRP, I_MBGRP, I_MWEXP, I_MBEXP, I_MWG, I_MWU, I_MWD };
struct Frame { LAS unsigned char* lds; int tid, lane, wave, G, gw, NGW; };
typedef const __attribute__((address_space(4))) Params* KP;

constexpr int TRP = 36, TR_SCR = 64 * TRP * 4;
__device__ __forceinline__ void tr_item(const float* W, int N, int kmax, bf16_t* WT, int ldk, int k0, int n0, int drow0, int dk0, LAS float* scr, int lane) {
    const int n4 = lane & 7, kr = lane >> 3; f32x4 v[8];
#pragma unroll
    for (int i = 0; i < 8; ++i) { const int k = k0 + 8 * i + kr; v[i] = k < kmax ? *(const f32x4*)(W + (size_t)k * N + n0 + 4 * n4) : (f32x4){0.f, 0.f, 0.f, 0.f}; }
#pragma unroll
    for (int i = 0; i < 8; ++i) *(LAS f32x4*)(scr + (8 * i + kr) * TRP + 4 * n4) = v[i];
    asm volatile("s_waitcnt lgkmcnt(0)" ::: "memory");
    const int c = lane & 7;
#pragma unroll
    for (int j = 0; j < 4; ++j) { const int n = (lane >> 3) + 8 * j; const LAS float* sp = scr + (8 * c) * TRP + n;
        u32x4 o; o.x = cvt_pk_bf16(sp[0 * TRP], sp[1 * TRP]); o.y = cvt_pk_bf16(sp[2 * TRP], sp[3 * TRP]); o.z = cvt_pk_bf16(sp[4 * TRP], sp[5 * TRP]); o.w = cvt_pk_bf16(sp[6 * TRP], sp[7 * TRP]);
        *(u32x4*)(WT + (size_t)(drow0 + n) * ldk + dk0 + k0 + 8 * c) = o; }
    asm volatile("s_waitcnt lgkmcnt(0)" ::: "memory");
}
constexpr int LDS_JOBS = 80 * 1024, MAXJOBS = 48;
__device__ __forceinline__ void add_job(LAS int* jobs, int& nj, int& nit, const float* src, int N, int kmax, int kpad, bf16_t* dst, int ldk, int drow0, int dk0) {
    LAS int* q = jobs + nj * 12; const unsigned long long a = (unsigned long long)src, d = (unsigned long long)dst;
    q[0] = (int)(unsigned)a; q[1] = (int)(unsigned)(a >> 32); q[2] = (int)(unsigned)d; q[3] = (int)(unsigned)(d >> 32); q[4] = N; q[5] = kmax; q[6] = kpad / 64; q[7] = ldk; q[8] = drow0; q[9] = dk0; q[10] = nit;
    nit += (kpad / 64) * (N / 32); ++nj;
}
__device__ __forceinline__ void zero_fill(const Frame& F, bf16_t* p, size_t nbytes) {
    u32x4* q = (u32x4*)p; const size_t n = nbytes / 16;
    for (size_t i = (size_t)blockIdx.x * NTHR + F.tid; i < n; i += (size_t)F.G * NTHR) q[i] = (u32x4){0u, 0u, 0u, 0u};
}

__device__ __forceinline__ void prologue_phase(const Frame& F, KP P) {
    unsigned char* ws = P->ws;
    {   float* MOD = (float*)(ws + WS_MOD); LAS float* part = (LAS float*)F.lds;
        const float* c = P->in[I_C]; const float* cc = P->in[I_CCTX];
        for (int item = blockIdx.x; item < DEPTH * 24; item += F.G) {
            const int layer = item / 24, col = (item % 24) * 256 + 4 * F.lane; const float* w = P->in[I_ADAW] + (size_t)layer * D * 6 * D + col;
            f32x4 a0 = (f32x4){0.f, 0.f, 0.f, 0.f}, a1 = a0, a2 = a0;
#pragma unroll 8
            for (int i = 0; i < 128; ++i) { const int d = F.wave + 8 * i; const f32x4 wv = *(const f32x4*)(w + (size_t)d * 6 * D);
                const float c0 = c[d], c1 = c[D + d], c2 = cc[d];
                a0 += wv * (c0 * sigmoidf_(c0)); a1 += wv * (c1 * sigmoidf_(c1)); a2 += wv * (c2 * sigmoidf_(c2)); }
            __syncthreads();
            *(LAS f32x4*)(part + (F.wave * 3 + 0) * 256 + 4 * F.lane) = a0; *(LAS f32x4*)(part + (F.wave * 3 + 1) * 256 + 4 * F.lane) = a1; *(LAS f32x4*)(part + (F.wave * 3 + 2) * 256 + 4 * F.lane) = a2;
            __syncthreads();
            if (F.wave < 3) { f32x4 sacc = (f32x4){0.f, 0.f, 0.f, 0.f};
#pragma unroll
                for (int w8 = 0; w8 < 8; ++w8) sacc += *(const LAS f32x4*)(part + (w8 * 3 + F.wave) * 256 + 4 * F.lane);
                *(f32x4*)(MOD + ((size_t)layer * 3 + F.wave) * 6 * D + col) = sacc + *(const f32x4*)(P->in[I_ADAB] + (size_t)layer * 6 * D + col); }
        }
    }
    LAS int* jobs = (LAS int*)(F.lds + LDS_JOBS); LAS int* jtot = jobs + MAXJOBS * 12;
    __syncthreads();
    if (F.tid == 0) { int nj = 0, nit = 0;
        for (int j = 0; j < 2; ++j) {
            add_job(jobs, nj, nit, P->in[I_GWIN] + (size_t)j * D * 4096, 4096, D, D, (bf16_t*)(ws + WS_WIN) + (size_t)j * 4096 * D, D, 0, 0);
            add_job(jobs, nj, nit, P->in[I_GWOUT] + (size_t)j * GWID * D, D, GWID, GWID, (bf16_t*)(ws + WS_WOUT) + (size_t)j * D * GWID, GWID, 0, 0);
            add_job(jobs, nj, nit, P->in[I_WR] + (size_t)j * D * D, D, D, D, (bf16_t*)(ws + WS_WR) + (size_t)j * D * D, D, 0, 0);
            add_job(jobs, nj, nit, P->in[I_WK] + (size_t)j * D * D, D, D, D, (bf16_t*)(ws + WS_WK) + (size_t)j * D * D, D, 0, 0);
            add_job(jobs, nj, nit, P->in[I_WV] + (size_t)j * D * D, D, D, D, (bf16_t*)(ws + WS_WV) + (size_t)j * D * D, D, 0, 0);
            add_job(jobs, nj, nit, P->in[I_WO] + (size_t)j * D * D, D, D, D, (bf16_t*)(ws + WS_WO) + (size_t)j * D * D, D, 0, 0);
            for (int z = 0; z < 2; ++z) {
                add_job(jobs, nj, nit, P->in[I_W1] + ((size_t)j * 2 + z) * D * 64, 64, D, D, (bf16_t*)(ws + WS_LW1) + (size_t)j * 256 * D, D, z * 64, 0);
                add_job(jobs, nj, nit, P->in[I_A1] + ((size_t)j * 2 + z) * D * 64, 64, D, D, (bf16_t*)(ws + WS_LA1) + (size_t)j * 256 * D, D, z * 64, 0);
                add_job(jobs, nj, nit, P->in[I_W2] + ((size_t)j * 2 + z) * 64 * D, D, 64, 64, (bf16_t*)(ws + WS_W2P) + ((size_t)j * 2 + z) * D * 256, 256, 0, z * 64);
                add_job(jobs, nj, nit, P->in[I_A2] + ((size_t)j * 2 + z) * 64 * D, D, 64, 64, (bf16_t*)(ws + WS_A2P) + ((size_t)j * 2 + z) * D * 256, 256, 0, z * 64); }
            add_job(jobs, nj, nit, P->in[I_G1] + (size_t)j * D * 160, 160, D, D, (bf16_t*)(ws + WS_LG1) + (size_t)j * 256 * D, D, 0, 0);
            add_job(jobs, nj, nit, P->in[I_G2] + (size_t)j * 160 * D, D, 160, 256, (bf16_t*)(ws + WS_G2P) + (size_t)j * D * 256, 256, 0, 0); }
        jtot[0] = nj; jtot[1] = nit; }
    __syncthreads();
    {   const int nj = jtot[0], nit = jtot[1]; LAS float* scr = (LAS float*)(F.lds + F.wave * TR_SCR);
        for (int it = F.gw; it < nit; it += F.NGW) {
            int jb = 0; for (int q = 1; q < nj; ++q) if (it >= jobs[q * 12 + 10]) jb = q;
            jb = __builtin_amdgcn_readfirstlane(jb); LAS const int* q = jobs + jb * 12;
            const float* src = (const float*)(((unsigned long long)(unsigned)q[1] << 32) | (unsigned)q[0]); bf16_t* dst = (bf16_t*)(((unsigned long long)(unsigned)q[3] << 32) | (unsigned)q[2]);
            const int N = q[4], nnb = N / 32, r = it - q[10], kb = r / nnb, nb = r % nnb;
            tr_item(src, N, q[5], dst, q[7], kb * 64, nb * 32, q[8] + nb * 32, q[9], scr, F.lane); }
    }
    for (int j = 0; j < 2; ++j) {
        bf16_t* lw1 = (bf16_t*)(ws + WS_LW1) + (size_t)j * 256 * D; bf16_t* la1 = (bf16_t*)(ws + WS_LA1) + (size_t)j * 256 * D; bf16_t* lg1 = (bf16_t*)(ws + WS_LG1) + (size_t)j * 256 * D;
        zero_fill(F, lw1 + 128 * D, (size_t)128 * D * 2); zero_fill(F, la1 + 128 * D, (size_t)128 * D * 2); zero_fill(F, lg1 + 160 * D, (size_t)96 * D * 2);
        for (int z = 0; z < 2; ++z) { bf16_t* w2p = (bf16_t*)(ws + WS_W2P) + ((size_t)j * 2 + z) * D * 256; bf16_t* a2p = (bf16_t*)(ws + WS_A2P) + ((size_t)j * 2 + z) * D * 256;
            for (int idx = blockIdx.x * NTHR + F.tid; idx < D * 32; idx += F.G * NTHR) { const int n = idx >> 5, ch = idx & 31;
                if ((ch >> 3) != z) { *(u32x4*)(w2p + (size_t)n * 256 + ch * 8) = (u32x4){0u, 0u, 0u, 0u}; *(u32x4*)(a2p + (size_t)n * 256 + ch * 8) = (u32x4){0u, 0u, 0u, 0u}; } } }
    }
    {   bf16_t* wrt = (bf16_t*)(ws + WS_WRT);
        for (int idx = blockIdx.x * NTHR + F.tid; idx < DEPTH * 256 * (D / 8); idx += F.G * NTHR) { const int k0 = (idx & 127) * 8, n = (idx >> 7) & 255, layer = idx >> 15;
            const int nn = n & 127; const bool lo = n >= 128; float w[8];
#pragma unroll
            for (int e = 0; e < 8; ++e) { float x = 0.f;
                if (nn < 4) x = P->in[I_MWGRP][((size_t)layer * D + k0 + e) * 4 + nn]; else if (nn < 36) x = P->in[I_MWEXP][((size_t)layer * D + k0 + e) * NE + nn - 4];
                const float hi = bf_lo(cvt_pk_bf16(x, 0.f)); w[e] = lo ? x - hi : x; }
            *(u32x4*)(wrt + ((size_t)layer * 256 + n) * D + k0) = pack8(w); } }
    {   const float* src = P->in[I_GWS]; bf16_t* dst = (bf16_t*)(ws + WS_WSP); const int n8 = 2 * 16 * 128 * 128 / 8;
        for (int i = blockIdx.x * NTHR + F.tid; i < n8; i += F.G * NTHR) { const f32x4 a = *(const f32x4*)(src + (size_t)i * 8), b = *(const f32x4*)(src + (size_t)i * 8 + 4);
            u32x4 o; o.x = cvt_pk_bf16(a[0], a[1]); o.y = cvt_pk_bf16(a[2], a[3]); o.z = cvt_pk_bf16(b[0], b[1]); o.w = cvt_pk_bf16(b[2], b[3]); *(u32x4*)(dst + (size_t)i * 8) = o; } }
}
struct MoeItem { const float* src; bf16_t* dst; int N, kmax, ldk, k0, n0, drow0; };
__device__ __forceinline__ MoeItem moe_item(KP P, unsigned char* ws, int layer, int it) {
    const int e = it / 768, r = it % 768, m = r >> 8, q = r & 255; const size_t so = ((size_t)layer * NE + e) * (size_t)D * EHID; MoeItem I;
    if (m < 2) { const int kb = q >> 4, n0 = (q & 15) * 32;
        I.src = (m == 0 ? P->in[I_MWG] : P->in[I_MWU]) + so; I.N = EHID; I.kmax = D; I.dst = (bf16_t*)(ws + WS_WGU) + (size_t)e * D * D; I.ldk = D; I.k0 = kb * 64; I.n0 = n0; I.drow0 = 256 * (n0 >> 7) + (n0 & 127) + (m == 1 ? 128 : 0); }
    else { const int kb = q >> 5, n0 = (q & 31) * 32;
        I.src = P->in[I_MWD] + so; I.N = D; I.kmax = EHID; I.dst = (bf16_t*)(ws + WS_WD) + (size_t)e * D * EHID; I.ldk = EHID; I.k0 = kb * 64; I.n0 = n0; I.drow0 = n0; }
    return I;
}
__device__ __forceinline__ void tr_load(const MoeItem& I, int lane, f32x4 (&v)[8]) {
    const int n4 = lane & 7, kr = lane >> 3;
#pragma unroll
    for (int i = 0; i < 8; ++i) v[i] = *(const f32x4*)(I.src + (size_t)(I.k0 + 8 * i + kr) * I.N + I.n0 + 4 * n4);
}
__device__ __forceinline__ void tr_store(const MoeItem& I, int lane, const f32x4 (&v)[8], LAS float* scr) {
    const int n4 = lane & 7, kr = lane >> 3;
#pragma unroll
    for (int i = 0; i < 8; ++i) *(LAS f32x4*)(scr + (8 * i + kr) * TRP + 4 * n4) = v[i];
    asm volatile("s_waitcnt lgkmcnt(0)" ::: "memory");
    const int c = lane & 7;
#pragma unroll
    for (int j = 0; j < 4; ++j) { const int n = (lane >> 3) + 8 * j; const LAS float* sp = scr + (8 * c) * TRP + n;
        u32x4 o; o.x = cvt_pk_bf16(sp[0 * TRP], sp[1 * TRP]); o.y = cvt_pk_bf16(sp[2 * TRP], sp[3 * TRP]); o.z = cvt_pk_bf16(sp[4 * TRP], sp[5 * TRP]); o.w = cvt_pk_bf16(sp[6 * TRP], sp[7 * TRP]);
        *(u32x4*)(I.dst + (size_t)(I.drow0 + n) * I.ldk + I.k0 + 8 * c) = o; }
    asm volatile("s_waitcnt lgkmcnt(0)" ::: "memory");
}
constexpr int MOE_ITEMS = NE * 768, MOE_SPLIT = 14336;
__device__ __forceinline__ void moe_weights_phase(const Frame& F, KP P, int layer, int vgw, int vngw, int it0, int it1) {
    unsigned char* ws = P->ws; LAS float* scr = (LAS float*)(F.lds + F.wave * TR_SCR);
    int it = it0 + vgw; f32x4 v[8], vn[8];
    if (it < it1) { const MoeItem I = moe_item(P, ws, layer, it); tr_load(I, F.lane, v); }
#pragma nounroll
    while (it < it1) { const int nx = it + vngw;
        if (nx < it1) { const MoeItem In = moe_item(P, ws, layer, nx); tr_load(In, F.lane, vn); }
        { const MoeItem I = moe_item(P, ws, layer, it); tr_store(I, F.lane, v, scr); }
#pragma unroll
        for (int i = 0; i < 8; ++i) v[i] = vn[i];
        it = nx; }
}

__device__ __forceinline__ void load_xrow(KP P, const Frame& F, int layer, int row, f32x4 (&v)[4]) {
    if (layer == 0) { const float* xr = row < TL ? P->in[I_X] + (size_t)row * D : P->in[I_CTX] + (size_t)(row - TL) * D;
#pragma unroll
        for (int j = 0; j < 4; ++j) v[j] = *(const f32x4*)(xr + 4 * F.lane + 256 * j); }
    else { const bf16_t* xr = (const bf16_t*)(P->ws + WS_X) + (size_t)row * D;
#pragma unroll
        for (int j = 0; j < 4; ++j) { const u32x2 w = *(const u32x2*)(xr + 4 * F.lane + 256 * j); v[j] = (f32x4){bf_lo(w.x), bf_hi(w.x), bf_lo(w.y), bf_hi(w.y)}; } }
}
__device__ __forceinline__ void load_vec4(const float* p, int lane, f32x4 (&r)[4]) {
#pragma unroll
    for (int j = 0; j < 4; ++j) r[j] = *(const f32x4*)(p + 4 * lane + 256 * j);
}
__device__ __forceinline__ void load_combine(KP P, const Frame& F, int layer, int row, bool combine, const f32x4 (&g2r)[4], f32x4 (&v)[4]) {
    load_xrow(P, F, layer, row, v);
    if (combine) {
        const bf16_t* yb = (const bf16_t*)(P->ws + WS_YB); const float* wg = (const float*)(P->ws + WS_WGT);
        const float w0 = wg[2 * row], w1 = wg[2 * row + 1];
#pragma unroll
        for (int j = 0; j < 4; ++j) { const int col = 4 * F.lane + 256 * j; const u32x2 a = *(const u32x2*)(yb + (size_t)(2 * row) * D + col), b = *(const u32x2*)(yb + (size_t)(2 * row + 1) * D + col);
            const f32x4 g = g2r[j];
            v[j][0] += g[0] * (w0 * bf_lo(a.x) + w1 * bf_lo(b.x)); v[j][1] += g[1] * (w0 * bf_hi(a.x) + w1 * bf_hi(b.x));
            v[j][2] += g[2] * (w0 * bf_lo(a.y) + w1 * bf_lo(b.y)); v[j][3] += g[3] * (w0 * bf_hi(a.y) + w1 * bf_hi(b.y)); }
    }
}
__device__ __forceinline__ void norm1_phase(const Frame& F, KP P, int layer) {
    const bool combine = layer > 0; bf16_t* X = (bf16_t*)(P->ws + WS_X); bf16_t* HL = (bf16_t*)(P->ws + WS_HL);
    f32x4 g1r[4], shr[4], scr[4], g2r[4]; load_vec4(P->in[I_N1G] + (size_t)layer * D, F.lane, g1r); int mc = -1;
#pragma unroll
    for (int j = 0; j < 4; ++j) { shr[j] = (f32x4){0.f, 0.f, 0.f, 0.f}; scr[j] = shr[j]; g2r[j] = shr[j]; }
    for (int row = F.gw; row < T; row += F.NGW) {
        const int m = row < TL ? (row >> 14) : 2; f32x4 v[4];
        if (m != mc) { mc = m; const float* mod = (const float*)(P->ws + WS_MOD) + ((size_t)layer * 3 + m) * 6 * D; load_vec4(mod, F.lane, shr); load_vec4(mod + D, F.lane, scr);
            if (combine) load_vec4((const float*)(P->ws + WS_MOD) + ((size_t)(layer - 1) * 3 + m) * 6 * D + 5 * D, F.lane, g2r); }
        load_combine(P, F, layer, row, combine, g2r, v);
        {
#pragma unroll
            for (int j = 0; j < 4; ++j) { u32x2 o; o.x = cvt_pk_bf16(v[j][0], v[j][1]); o.y = cvt_pk_bf16(v[j][2], v[j][3]); *(u32x2*)(X + (size_t)row * D + 4 * F.lane + 256 * j) = o;
                v[j] = (f32x4){bf_lo(o.x), bf_hi(o.x), bf_lo(o.y), bf_hi(o.y)}; } }
        float ss = 0.f;
#pragma unroll
        for (int j = 0; j < 4; ++j) ss += (v[j][0] * v[j][0] + v[j][1] * v[j][1]) + (v[j][2] * v[j][2] + v[j][3] * v[j][3]);
        const float rstd = rsqrtf(wave_sum(ss, F.lane) * (1.0f / D) + 1e-6f);
#pragma unroll
        for (int j = 0; j < 4; ++j) { const int col = 4 * F.lane + 256 * j;
            const f32x4 h = (v[j] * rstd) * g1r[j] * (scr[j] + 1.0f) + shr[j];
            u32x2 o; o.x = cvt_pk_bf16(h[0], h[1]); o.y = cvt_pk_bf16(h[2], h[3]); *(u32x2*)(HL + (size_t)row * D + col) = o; }
    }
}
__device__ __forceinline__ void final_phase(const Frame& F, KP P) {
    f32x4 fgr[4], g2r[4]; load_vec4(P->in[I_FG], F.lane, fgr); int mc = -1;
#pragma unroll
    for (int j = 0; j < 4; ++j) g2r[j] = (f32x4){0.f, 0.f, 0.f, 0.f};
    for (int row = F.gw; row < TL; row += F.NGW) {
        const int m = row >> 14; f32x4 v[4];
        if (m != mc) { mc = m; load_vec4((const float*)(P->ws + WS_MOD) + ((size_t)(DEPTH - 1) * 3 + m) * 6 * D + 5 * D, F.lane, g2r); }
        load_combine(P, F, DEPTH, row, true, g2r, v);
        float ss = 0.f;
#pragma unroll
        for (int j = 0; j < 4; ++j) ss += (v[j][0] * v[j][0] + v[j][1] * v[j][1]) + (v[j][2] * v[j][2] + v[j][3] * v[j][3]);
        const float rstd = rsqrtf(wave_sum(ss, F.lane) * (1.0f / D) + 1e-6f);
#pragma unroll
        for (int j = 0; j < 4; ++j) { const int col = 4 * F.lane + 256 * j; *(f32x4*)(P->out + (size_t)row * D + col) = (v[j] * rstd) * fgr[j]; }
    }
}
__device__ __forceinline__ void norm2_phase(const Frame& F, KP P, int layer) {
    const int ntok = layer == DEPTH - 1 ? TL : T; bf16_t* HL2 = (bf16_t*)(P->ws + WS_HL);
    f32x4 gr[4], shr[4], scr[4]; load_vec4(P->in[I_N2G] + (size_t)layer * D, F.lane, gr); int mc = -1;
#pragma unroll
    for (int j = 0; j < 4; ++j) { shr[j] = (f32x4){0.f, 0.f, 0.f, 0.f}; scr[j] = shr[j]; }
    for (int row = F.gw; row < ntok; row += F.NGW) {
        const int m = row < TL ? (row >> 14) : 2; f32x4 v[4]; load_xrow(P, F, 1, row, v);
        if (m != mc) { mc = m; const float* mod = (const float*)(P->ws + WS_MOD) + ((size_t)layer * 3 + m) * 6 * D; load_vec4(mod + 3 * D, F.lane, shr); load_vec4(mod + 4 * D, F.lane, scr); }
        float ss = 0.f;
#pragma unroll
        for (int j = 0; j < 4; ++j) ss += (v[j][0] * v[j][0] + v[j][1] * v[j][1]) + (v[j][2] * v[j][2] + v[j][3] * v[j][3]);
        const float rstd = rsqrtf(wave_sum(ss, F.lane) * (1.0f / D) + 1e-6f);
#pragma unroll
        for (int j = 0; j < 4; ++j) { const int col = 4 * F.lane + 256 * j;
            const f32x4 h = (v[j] * rstd) * gr[j] * (scr[j] + 1.0f) + shr[j];
            u32x2 o; o.x = cvt_pk_bf16(h[0], h[1]); o.y = cvt_pk_bf16(h[2], h[3]); *(u32x2*)(HL2 + (size_t)row * D + col) = o; }
    }
    if (!(layer & 1)) moe_weights_phase(F, P, layer, F.gw, F.NGW, 0, MOE_SPLIT);
}
__device__ __forceinline__ void route_phase(const Frame& F, KP P, int layer) {
    const int ntok = layer == DEPTH - 1 ? TL : T; const float* LG = (const float*)(P->ws + WS_LG);
    const float* bgrp = P->in[I_MBGRP] + layer * 4; const float* bexp = P->in[I_MBEXP] + layer * NE;
    unsigned* cnt = (unsigned*)(P->ws + WS_CTL) + CW_CNT + layer * 64; int* list = (int*)(P->ws + WS_LIST); float* wgt = (float*)(P->ws + WS_WGT);
    LAS unsigned* lcnt = (LAS unsigned*)F.lds; LAS unsigned* lbase = lcnt + 32;
    for (int r0 = blockIdx.x * NTHR; r0 < ntok; r0 += F.G * NTHR) {
        const int row = r0 + F.tid; const bool act = row < ntok;
        __syncthreads();
        if (F.tid < 32) lcnt[F.tid] = 0u;
        __syncthreads();
        int e0 = 0, e1 = 0; unsigned k0 = 0, k1 = 0;
        if (act) {
            const float* lg = LG + (size_t)row * 64; const f32x4 g4 = *(const f32x4*)lg;
            float ag[4];
#pragma unroll
            for (int i = 0; i < 4; ++i) ag[i] = g4[i] + bgrp[i];
            int grp = 0; float mx = ag[0];
#pragma unroll
            for (int i = 1; i < 4; ++i) if (ag[i] > mx) { mx = ag[i]; grp = i; }
            float den = 0.f;
#pragma unroll
            for (int i = 0; i < 4; ++i) den += __expf(ag[i] - mx);
            const float pg = 1.0f / den;
            const f32x4 e0v = *(const f32x4*)(lg + 4 + 8 * grp), e1v = *(const f32x4*)(lg + 8 + 8 * grp); const f32x4 b0v = *(const f32x4*)(bexp + 8 * grp), b1v = *(const f32x4*)(bexp + 8 * grp + 4);
            float el[8];
#pragma unroll
            for (int i = 0; i < 4; ++i) { el[i] = e0v[i] + b0v[i]; el[4 + i] = e1v[i] + b1v[i]; }
            int i0 = 0; float t0 = el[0];
#pragma unroll
            for (int i = 1; i < 8; ++i) if (el[i] > t0) { t0 = el[i]; i0 = i; }
            int i1 = -1; float t1 = -3.0e38f;
#pragma unroll
            for (int i = 0; i < 8; ++i) if (i != i0 && el[i] > t1) { t1 = el[i]; i1 = i; }
            const float p0 = 1.0f / (1.0f + __expf(t1 - t0));
            wgt[2 * row] = pg * p0; wgt[2 * row + 1] = pg * (1.0f - p0);
            e0 = grp * 8 + i0; e1 = grp * 8 + i1;
            k0 = atomicAdd((unsigned*)(lcnt + e0), 1u); k1 = atomicAdd((unsigned*)(lcnt + e1), 1u);
        }
        __syncthreads();
        if (F.tid < 32) { const unsigned c = lcnt[F.tid]; lbase[F.tid] = c ? atomicAdd(cnt + F.tid, c) : 0u; }
        __syncthreads();
        if (act) { list[(size_t)e0 * LISTCAP + lbase[e0] + k0] = 2 * row; list[(size_t)e1 * LISTCAP + lbase[e1] + k1] = 2 * row + 1; }
    }
}
__device__ __forceinline__ bf16x8 tr_frag136(const LAS bf16_t* M, int k0, int c0, int lane) {
    LAS bf16_t* p = (LAS bf16_t*)M + (k0 + 8 * (lane >> 4) + ((lane & 15) >> 2)) * 136 + c0 + 4 * (lane & 3);
    const v4s lo = __builtin_amdgcn_ds_read_tr16_b64_v4i16((LAS v4s*)p), hi = __builtin_amdgcn_ds_read_tr16_b64_v4i16((LAS v4s*)(p + 4 * 136));
    return (bf16x8){lo[0], lo[1], lo[2], lo[3], hi[0], hi[1], hi[2], hi[3]};
}
__device__ __forceinline__ bf16x8 tr_frag136p(const LAS bf16_t* M, int k0, int dt, int lane) {
    LAS bf16_t* p = (LAS bf16_t*)M + (k0 + 8 * (lane >> 4) + ((lane & 15) >> 2)) * 136 + 32 * (dt >> 1) + 8 * (lane & 3) + 4 * (dt & 1);
    const v4s lo = __builtin_amdgcn_ds_read_tr16_b64_v4i16((LAS v4s*)p), hi = __builtin_amdgcn_ds_read_tr16_b64_v4i16((LAS v4s*)(p + 4 * 136));
    return (bf16x8){lo[0], lo[1], lo[2], lo[3], hi[0], hi[1], hi[2], hi[3]};
}
__device__ __forceinline__ void spatial_phase(const Frame& F, KP P, int j) {
    bf16_t* U = (bf16_t*)(P->ws + WS_U); const bf16_t* V = (const bf16_t*)(P->ws + WS_V); const float* stat = (const float*)(P->ws + WS_STAT);
    const bf16_t* WSP = (const bf16_t*)(P->ws + WS_WSP) + (size_t)j * 16 * 128 * 128;
    const float* lng = P->in[I_GLNG] + (size_t)j * GWID; const float* lnb = P->in[I_GLNB] + (size_t)j * GWID; const float* bs = P->in[I_GBS] + (size_t)j * 16 * 128;
    LAS bf16_t* Wt = (LAS bf16_t*)F.lds; LAS bf16_t* Vn = Wt + 128 * 136;
    LAS float* mu = (LAS float*)(F.lds + 2 * 128 * 136 * 2); LAS float* rs = mu + 128;
    const int l15 = F.lane & 15, l4 = F.lane >> 4;
    constexpr int NUNIT = (T / 128) * 16;
    const int u0 = (int)((long)blockIdx.x * NUNIT / F.G), u1 = (int)((long)(blockIdx.x + 1) * NUNIT / F.G);
#define SP_LOAD(W_, V_, U_, t0_, g_) do { \
        _Pragma("unroll") for (int i = 0; i < 4; ++i) { const int idx = F.tid + NTHR * i, r = idx >> 4, seg = idx & 15; \
            W_[i] = *(const u32x4*)(WSP + ((size_t)(g_) * 128 + r) * 128 + seg * 8); V_[i] = *(const u32x4*)(V + (size_t)((t0_) + r) * GWID + (g_) * 128 + seg * 8); } \
        { const bf16_t* ur_ = U + (size_t)((t0_) + 16 * F.wave + l15) * GWID + (g_) * 128 + 8 * l4; \
          _Pragma("unroll") for (int e = 0; e < 4; ++e) U_[e] = *(const u32x4*)(ur_ + e * 32); } } while (0)
    u32x4 wv[4], vv[4], uu[4];
    if (u0 < u1) SP_LOAD(wv, vv, uu, (u0 >> 4) * 128, u0 & 15);
    int cprev = -1;
#pragma nounroll
    for (int u = u0; u < u1; ++u) { const int c = u >> 4, g = u & 15, t0 = c * 128;
        if (c != cprev) { cprev = c;
            if (F.tid < 128) { const int row = t0 + F.tid; float s = 0.f, q = 0.f;
#pragma unroll 8
                for (int i = 0; i < 32; ++i) { const f32x2 p = *(const f32x2*)(stat + ((size_t)row * 32 + i) * 2); s += p.x; q += p.y; }
                const float mean = s * (1.0f / GWID), var = q * (1.0f / GWID) - mean * mean; mu[F.tid] = mean; rs[F.tid] = rsqrtf(var + 1e-5f); } }
        LDS_BARRIER();
#pragma unroll
        for (int i = 0; i < 4; ++i) { const int idx = F.tid + NTHR * i, r = idx >> 4, seg = idx & 15, ch = g * 128 + seg * 8;
            *(LAS u32x4*)(Wt + r * 136 + seg * 8) = wv[i];
            float x[8], o[8]; unpack8(vv[i], x); const float m_ = mu[r], r_ = rs[r];
            const f32x4 g0 = *(const f32x4*)(lng + ch), g1 = *(const f32x4*)(lng + ch + 4), b0 = *(const f32x4*)(lnb + ch), b1 = *(const f32x4*)(lnb + ch + 4);
#pragma unroll
            for (int e = 0; e < 8; ++e) o[e] = (x[e] - m_) * r_ * (e < 4 ? g0[e & 3] : g1[e & 3]) + (e < 4 ? b0[e & 3] : b1[e & 3]);
            *(LAS u32x4*)(Vn + r * 136 + seg * 8) = pack8(o); }
        u32x4 wn[4], vn[4], un[4];
        if (u + 1 < u1) SP_LOAD(wn, vn, un, ((u + 1) >> 4) * 128, (u + 1) & 15);
        LDS_BARRIER();
        bf16x8 bw[4];
#pragma unroll
        for (int ks = 0; ks < 4; ++ks) bw[ks] = *(const LAS bf16x8*)(Wt + (16 * F.wave + l15) * 136 + ks * 32 + 8 * l4);
        const int p = 16 * F.wave + l15; const float bias = bs[g * 128 + p];
        bf16_t* urow = U + (size_t)(t0 + p) * GWID + g * 128 + 8 * l4;
#pragma unroll
        for (int e = 0; e < 4; ++e) { f32x4 a0 = (f32x4){0.f, 0.f, 0.f, 0.f}, a1 = a0;
#pragma unroll
            for (int ks = 0; ks < 4; ++ks) { const bf16x8 f0 = tr_frag136p(Vn, 32 * ks, 2 * e, F.lane), f1 = tr_frag136p(Vn, 32 * ks, 2 * e + 1, F.lane);
                a0 = __builtin_amdgcn_mfma_f32_16x16x32_bf16(f0, bw[ks], a0, 0, 0, 0); a1 = __builtin_amdgcn_mfma_f32_16x16x32_bf16(f1, bw[ks], a1, 0, 0, 0); }
            u32x4 o; o.x = cvt_pk_bf16(bf_lo(uu[e].x) * (a0[0] + bias), bf_hi(uu[e].x) * (a0[1] + bias)); o.y = cvt_pk_bf16(bf_lo(uu[e].y) * (a0[2] + bias), bf_hi(uu[e].y) * (a0[3] + bias));
            o.z = cvt_pk_bf16(bf_lo(uu[e].z) * (a1[0] + bias), bf_hi(uu[e].z) * (a1[1] + bias)); o.w = cvt_pk_bf16(bf_lo(uu[e].w) * (a1[2] + bias), bf_hi(uu[e].w) * (a1[3] + bias));
            *(u32x4*)(urow + e * 32) = o; }
        if (u + 1 < u1) {
#pragma unroll
            for (int i = 0; i < 4; ++i) { wv[i] = wn[i]; vv[i] = vn[i]; uu[i] = un[i]; } }
    }
#undef SP_LOAD
}

__device__ __forceinline__ void mix_phase(const Frame& F, KP P, int j) {
    const bf16_t* HL = (const bf16_t*)(P->ws + WS_HL); const float* mu = P->in[I_MU] + (size_t)j * 6 * D;
    bf16_t* outs[6] = {(bf16_t*)(P->ws + WS_XR), (bf16_t*)(P->ws + WS_XW), (bf16_t*)(P->ws + WS_XK), (bf16_t*)(P->ws + WS_XV), (bf16_t*)(P->ws + WS_XA), (bf16_t*)(P->ws + WS_XG)};
    f32x4 mr[2][6][2];
#pragma unroll
    for (int jj = 0; jj < 2; ++jj)
#pragma unroll
        for (int m = 0; m < 6; ++m) { const int col = 512 * jj + 8 * F.lane; mr[jj][m][0] = *(const f32x4*)(mu + (size_t)m * D + col); mr[jj][m][1] = *(const f32x4*)(mu + (size_t)m * D + col + 4); }
    for (int row = F.gw; row < T; row += F.NGW) {
        bool ok[2]; int src[2]; const bool hi = F.lane >= 32;
        if (row < TL) { const int n = row & (SEQ - 1), gc = n & 63, gr = n >> 6;
            ok[0] = hi ? gc < 63 : gc > 0; src[0] = hi ? row + 1 : row - 1; ok[1] = hi ? gr < 255 : gr > 0; src[1] = hi ? row + 64 : row - 64; }
        else { const int n = (row - TL) & (CTXL - 1); ok[0] = n > 0; src[0] = row - 1; ok[1] = n < CTXL - 1; src[1] = row + 1; }
#pragma unroll
        for (int jj = 0; jj < 2; ++jj) { const int col = 512 * jj + 8 * F.lane;
            const u32x4 h8 = *(const u32x4*)(HL + (size_t)row * D + col); u32x4 s8 = (u32x4){0u, 0u, 0u, 0u};
            if (ok[jj]) s8 = *(const u32x4*)(HL + (size_t)src[jj] * D + col);
            const unsigned hw[4] = {h8.x, h8.y, h8.z, h8.w}, sw[4] = {s8.x, s8.y, s8.z, s8.w}; float h[8], xx[8];
#pragma unroll
            for (int e = 0; e < 8; ++e) { h[e] = (e & 1) ? bf_hi(hw[e >> 1]) : bf_lo(hw[e >> 1]); const float s = (e & 1) ? bf_hi(sw[e >> 1]) : bf_lo(sw[e >> 1]); xx[e] = s - h[e]; }
#pragma unroll
            for (int m = 0; m < 6; ++m) { const f32x4 ma = mr[jj][m][0], mb = mr[jj][m][1];
                u32x4 o; o.x = cvt_pk_bf16(h[0] + xx[0] * ma[0], h[1] + xx[1] * ma[1]); o.y = cvt_pk_bf16(h[2] + xx[2] * ma[2], h[3] + xx[3] * ma[3]);
                o.z = cvt_pk_bf16(h[4] + xx[4] * mb[0], h[5] + xx[5] * mb[1]); o.w = cvt_pk_bf16(h[6] + xx[6] * mb[2], h[7] + xx[7] * mb[3]);
                *(u32x4*)(outs[m] + (size_t)row * D + col) = o; } }
    }
}

constexpr int NCH = 5, SCP = NCH * 64, NSC = (SEQ + CTXL) / SCP, NSCAN = 64, TP = 72, TILE_B = 64 * TP * 2;
static_assert(NSC * SCP == SEQ + CTXL, "super-chunks");
enum { T_AT = 0, T_RT, T_BT, T_KT, T_VM, T_NT, T_MT, T_NRT, T_MRT, T_APA, T_APB, T_TAA, T_TAB, T_PRB, T_QRB, T_NTILE };
constexpr int LDS_GL = T_NTILE * TILE_B, LDS_SEG = LDS_GL + 256;
static_assert(LDS_SEG + 2048 <= LDS_MISC, "scan LDS map");
__device__ __forceinline__ int scan_row(int z, int b, int p) {
    if (p < CTXL) return TL + b * CTXL + (z ? CTXL - 1 - p : p);
    const int q = p - CTXL; return b * SEQ + (z ? SEQ - 1 - q : q);
}
__device__ __forceinline__ LAS bf16_t* stile(LAS unsigned char* lds, int n) { return (LAS bf16_t*)(lds + n * TILE_B); }
__device__ __forceinline__ bf16x8 row_frag(const LAS bf16_t* M, int r0, int k0, int lane) { return *(const LAS bf16x8*)(M + (r0 + (lane & 15)) * TP + k0 + 8 * (lane >> 4)); }
__device__ __forceinline__ bf16x8 tr_frag(const LAS bf16_t* M, int k0, int c0, int lane) {
    LAS bf16_t* p = (LAS bf16_t*)M + (k0 + 8 * (lane >> 4) + ((lane & 15) >> 2)) * TP + c0 + 4 * (lane & 3);
    const v4s lo = __builtin_amdgcn_ds_read_tr16_b64_v4i16((LAS v4s*)p), hi = __builtin_amdgcn_ds_read_tr16_b64_v4i16((LAS v4s*)(p + 4 * TP));
    return (bf16x8){lo[0], lo[1], lo[2], lo[3], hi[0], hi[1], hi[2], hi[3]};
}
template <bool XT, bool YT>
__device__ __forceinline__ void mm64(const LAS bf16_t* X, const LAS bf16_t* Y, f32x4 (&acc)[2], int wq, int wh, int lane) {
#pragma unroll
    for (int ks = 0; ks < 2; ++ks) {
        const bf16x8 b = XT ? tr_frag(X, 32 * ks, 16 * wq, lane) : row_frag(X, 16 * wq, 32 * ks, lane);
#pragma unroll
        for (int q = 0; q < 2; ++q) { const int i0 = 16 * (2 * wh + q);
            const bf16x8 a = YT ? row_frag(Y, i0, 32 * ks, lane) : tr_frag(Y, 32 * ks, i0, lane);
            acc[q] = __builtin_amdgcn_mfma_f32_16x16x32_bf16(a, b, acc[q], 0, 0, 0); }
    }
}
__device__ __forceinline__ void st_tile(LAS bf16_t* Z, const f32x4 (&acc)[2], int wq, int wh, int lane) {
#pragma unroll
    for (int q = 0; q < 2; ++q) { u32x2 o; o.x = cvt_pk_bf16(acc[q][0], acc[q][1]); o.y = cvt_pk_bf16(acc[q][2], acc[q][3]);
        *(LAS u32x2*)(Z + (16 * wq + (lane & 15)) * TP + 16 * (2 * wh + q) + 4 * (lane >> 4)) = o; }
}
__device__ __forceinline__ void ld_tile(const LAS bf16_t* Z, f32x4 (&acc)[2], int wq, int wh, int lane) {
#pragma unroll
    for (int q = 0; q < 2; ++q) { const u32x2 o = *(const LAS u32x2*)(Z + (16 * wq + (lane & 15)) * TP + 16 * (2 * wh + q) + 4 * (lane >> 4));
        acc[q] = (f32x4){bf_lo(o.x), bf_hi(o.x), bf_lo(o.y), bf_hi(o.y)}; }
}
__device__ __forceinline__ f32x4 prod16(const LAS bf16_t* X, int xr, int xc, const LAS bf16_t* Y, int yr, int yc, f32x4 acc, int lane) {
    bf16x8 b = *(const LAS bf16x8*)(X + (xr + (lane & 15)) * TP + xc + 8 * (lane >> 4)); bf16x8 a = tr_frag(Y, yr, yc, lane);
    if ((lane >> 4) >= 2) { b = (bf16x8){0, 0, 0, 0, 0, 0, 0, 0}; a = (bf16x8){0, 0, 0, 0, 0, 0, 0, 0}; }
    return __builtin_amdgcn_mfma_f32_16x16x32_bf16(a, b, acc, 0, 0, 0);
}
__device__ __forceinline__ void st16(LAS bf16_t* Z, int zr, int zc, f32x4 acc, int lane) { u32x2 o; o.x = cvt_pk_bf16(acc[0], acc[1]); o.y = cvt_pk_bf16(acc[2], acc[3]); *(LAS u32x2*)(Z + (zr + (lane & 15)) * TP + zc + 4 * (lane >> 4)) = o; }
__device__ __forceinline__ f32x4 ld16(const LAS bf16_t* Z, int zr, int zc, int lane) { const u32x2 o = *(const LAS u32x2*)(Z + (zr + (lane & 15)) * TP + zc + 4 * (lane >> 4)); return (f32x4){bf_lo(o.x), bf_hi(o.x), bf_lo(o.y), bf_hi(o.y)}; }
struct ChunkRegs { u32x4 r, k, v, tw, ta; };
__device__ __forceinline__ void scan_load(KP P, const Frame& F, int item, int c4, ChunkRegs& R) {
    const int s = item & 63, sc = item >> 6, z = s >> 5, b = (s >> 4) & 1, hh = s & 15;
    const size_t row = (size_t)scan_row(z, b, sc * SCP + c4 * 64 + (F.tid >> 3)); const size_t o = row * D + hh * 64 + (F.tid & 7) * 8, o2 = row * 256 + z * 64 + (F.tid & 7) * 8;
    R.r = *(const u32x4*)((const bf16_t*)(P->ws + WS_R) + o); R.k = *(const u32x4*)((const bf16_t*)(P->ws + WS_K) + o); R.v = *(const u32x4*)((const bf16_t*)(P->ws + WS_VV) + o);
    R.tw = *(const u32x4*)((const bf16_t*)(P->ws + WS_TW) + o2); R.ta = *(const u32x4*)((const bf16_t*)(P->ws + WS_TA) + o2);
}
__device__ __forceinline__ void scan_chunk_phase(const Frame& F, KP P, int j) {
    LAS unsigned char* lds = F.lds;
    LAS bf16_t* At = stile(lds, T_AT); LAS bf16_t* Rt = stile(lds, T_RT); LAS bf16_t* Bt = stile(lds, T_BT); LAS bf16_t* Kt = stile(lds, T_KT); LAS bf16_t* Vm = stile(lds, T_VM);
    LAS bf16_t* NT = stile(lds, T_NT); LAS bf16_t* MT = stile(lds, T_MT); LAS bf16_t* NrT = stile(lds, T_NRT); LAS bf16_t* MrT = stile(lds, T_MRT);
    LAS bf16_t* ApA = stile(lds, T_APA); LAS bf16_t* ApB = stile(lds, T_APB); LAS bf16_t* TaA = stile(lds, T_TAA); LAS bf16_t* TaB = stile(lds, T_TAB);
    LAS bf16_t* PrB = stile(lds, T_PRB); LAS bf16_t* QrB = stile(lds, T_QRB);
    LAS float* gl = (LAS float*)(lds + LDS_GL); LAS float* seg = (LAS float*)(lds + LDS_SEG);
    const int lane = F.lane, wq = F.wave & 3, wh = F.wave >> 2, l15 = lane & 15, l4 = lane >> 4;
    const int pi = F.tid >> 3, kq = F.tid & 7;
    const int jrow = 16 * wq + l15;
    const int NITEM = NSCAN * NSC;
    int item = blockIdx.x; if (item >= NITEM) return;
    ChunkRegs cur, nxt; scan_load(P, F, item, 0, cur); nxt = cur;
    f32x4 Pr[2], Qr[2], aYp[2], aQp[2];
#pragma unroll
    for (int q = 0; q < 2; ++q) { Pr[q] = (f32x4){0.f, 0.f, 0.f, 0.f}; Qr[q] = Pr[q]; aYp[q] = Pr[q]; aQp[q] = Pr[q]; }
    bool pend = false; size_t orowp = 0; bf16_t* GEp = nullptr; bf16_t* YEp = nullptr; float* pqp = nullptr; bool lastp = false;
#define SCAN_STAGE_G() do { \
        f32x4 ge[2] = {(f32x4){0.f, 0.f, 0.f, 0.f}, (f32x4){0.f, 0.f, 0.f, 0.f}}; \
        mm64<false, true>(NT, PrB, ge, wq, wh, lane); mm64<false, true>(NT, QrB, aYp, wq, wh, lane); \
        f32x4 pn[2] = {(f32x4){0.f, 0.f, 0.f, 0.f}, (f32x4){0.f, 0.f, 0.f, 0.f}}; \
        mm64<false, false>(PrB, MT, pn, wq, wh, lane); mm64<false, false>(QrB, MT, aQp, wq, wh, lane); \
        _Pragma("unroll") for (int q = 0; q < 2; ++q) { const int i0 = 16 * (2 * wh + q) + 4 * l4; \
            u32x2 o; o.x = cvt_pk_bf16(ge[q][0], ge[q][1]); o.y = cvt_pk_bf16(ge[q][2], ge[q][3]); *(u32x2*)(GEp + orowp + i0) = o; \
            u32x2 y; y.x = cvt_pk_bf16(aYp[q][0], aYp[q][1]); y.y = cvt_pk_bf16(aYp[q][2], aYp[q][3]); *(u32x2*)(YEp + orowp + i0) = y; \
            Pr[q] = pn[q]; Qr[q] = aQp[q]; } \
        if (lastp) { const int ln_ = lane_id_now(), l15_ = ln_ & 15, l4_ = ln_ >> 4;   \
            float* pP_ = pqp + ((l15_ & 3) * 4 + (l15_ >> 2)) * 64 + wq * 16 + 8 * wh + l4_; float* pQ_ = pqp + 4096 + (wq * 16 + l4_) * 64 + 32 * wh + l15_; \
            _Pragma("unroll") for (int q = 0; q < 2; ++q)   \
            _Pragma("unroll") for (int r = 0; r < 4; ++r) { pP_[r * 1024 + 4 * q] = Pr[q][r]; pQ_[r * 256 + 16 * q] = Qr[q][r]; } } \
    } while (0)
    for (;;) {
        const int s = item & 63, sc = item >> 6, z = s >> 5, b = (s >> 4) & 1, hh = s & 15;
        const float* kkw = P->in[I_KK] + (size_t)j * D + hh * 64 + kq * 8; const float* kap = P->in[I_KA] + (size_t)j * D + hh * 64 + kq * 8; const float* rkp = P->in[I_RK] + (size_t)j * D + hh * 64 + kq * 8;
        const float* w0p = P->in[I_W0] + ((size_t)j * 2 + z) * D + hh * 64; const float* a0p = P->in[I_A0] + ((size_t)j * 2 + z) * D + hh * 64;
        float* bon = (float*)(P->ws + WS_BON) + (size_t)z * T * 16;
        const u32x4 w2r = *(const u32x4*)((const bf16_t*)(P->ws + WS_W2P) + (((size_t)j * 2 + z) * D + hh * 64 + pi) * 256 + z * 64 + kq * 8);
        const u32x4 a2r = *(const u32x4*)((const bf16_t*)(P->ws + WS_A2P) + (((size_t)j * 2 + z) * D + hh * 64 + pi) * 256 + z * 64 + kq * 8);
        bf16_t* GE = (bf16_t*)(P->ws + (z ? WS_AS1 : WS_AS0)); bf16_t* YE = (bf16_t*)(P->ws + (z ? WS_ELOG1 : WS_ELOG0));
        float* pq = (float*)(P->ws + WS_PQ) + ((size_t)(s * NSC + sc) * 2) * 4096;
#pragma nounroll
        for (int c4 = 0; c4 < NCH; ++c4) {
            unsigned long long ch_t[12]; ch_t[11] = CH_AMP >= 0 ? __builtin_amdgcn_s_memrealtime() : 0ull;
            *(LAS u32x4*)(ApA + pi * TP + kq * 8) = cur.tw; *(LAS u32x4*)(ApB + pi * TP + kq * 8) = cur.ta; *(LAS u32x4*)(NrT + pi * TP + kq * 8) = w2r; *(LAS u32x4*)(MrT + pi * TP + kq * 8) = a2r;
            LDS_BARRIER(); CH_STAMP(0);
            {   f32x4 lw[2] = {(f32x4){0.f, 0.f, 0.f, 0.f}, (f32x4){0.f, 0.f, 0.f, 0.f}}, la[2] = {(f32x4){0.f, 0.f, 0.f, 0.f}, (f32x4){0.f, 0.f, 0.f, 0.f}};
                mm64<false, true>(ApA, NrT, lw, wq, wh, lane); mm64<false, true>(ApB, MrT, la, wq, wh, lane);
#pragma unroll
                for (int q = 0; q < 2; ++q) { const int i0 = 16 * (2 * wh + q) + 4 * l4; const f32x4 w04 = *(const f32x4*)(w0p + i0), a04 = *(const f32x4*)(a0p + i0);
#pragma unroll
                    for (int r = 0; r < 4; ++r) { lw[q][r] = -0.60653065971f * sigmoidf_(w04[r] + lw[q][r]); la[q][r] = sigmoidf_(a04[r] + la[q][r]); } }
                st_tile(TaA, lw, wq, wh, lane); st_tile(TaB, la, wq, wh, lane); }
            LDS_BARRIER(); CH_STAMP(1);
            float r8[8], k8[8], e8[8], m8[8], a8[8], kk8[8], c8[8];
            { const u32x4 et = *(const LAS u32x4*)(TaA + pi * TP + kq * 8), at = *(const LAS u32x4*)(TaB + pi * TP + kq * 8); unpack8(cur.r, r8); unpack8(cur.k, k8); unpack8(et, e8); unpack8(at, a8); }
            {   const f32x4 ka0 = *(const f32x4*)(kap), ka1 = *(const f32x4*)(kap + 4), rk0 = *(const f32x4*)(rkp), rk1 = *(const f32x4*)(rkp + 4); float bp = 0.f;
#pragma unroll
                for (int e = 0; e < 8; ++e) { m8[e] = k8[e] * (1.0f + (a8[e] - 1.0f) * (e < 4 ? ka0[e & 3] : ka1[e & 3])); bp += r8[e] * (e < 4 ? rk0[e & 3] : rk1[e & 3]) * m8[e]; }
                bp += shx(bp, 1, lane); bp += shx(bp, 2, lane); bp += shx(bp, 4, lane);
                if (kq == 0) bon[(size_t)scan_row(z, b, sc * SCP + c4 * 64 + pi) * 16 + hh] = bp; }
            { const f32x4 w0 = *(const f32x4*)kkw, w1 = *(const f32x4*)(kkw + 4); float ss = 0.f;
#pragma unroll
              for (int e = 0; e < 8; ++e) { kk8[e] = k8[e] * (e < 4 ? w0[e & 3] : w1[e & 3]); ss += kk8[e] * kk8[e]; }
              ss += shx(ss, 1, lane); ss += shx(ss, 2, lane); ss += shx(ss, 4, lane);
              const float rn = rsqrtf(ss + 1e-12f);
#pragma unroll
              for (int e = 0; e < 8; ++e) { kk8[e] *= rn; c8[e] = e8[e]; } }
#pragma unroll
            for (int d = 8; d < 64; d <<= 1) {
#pragma unroll
                for (int e = 0; e < 8; ++e) { const float t = shup(c8[e], d, lane); c8[e] += lane >= d ? t : 0.f; } }
            if (lane >= 56) { *(LAS f32x4*)(seg + F.wave * 64 + kq * 8) = (f32x4){c8[0], c8[1], c8[2], c8[3]}; *(LAS f32x4*)(seg + F.wave * 64 + kq * 8 + 4) = (f32x4){c8[4], c8[5], c8[6], c8[7]}; }
            if (pend) { SCAN_STAGE_G(); pend = false; }
            LDS_BARRIER(); CH_STAMP(2);
            if (c4 > 0) { st_tile(PrB, Pr, wq, wh, lane); st_tile(QrB, Qr, wq, wh, lane); }
            { float cum[8];
#pragma unroll
              for (int e = 0; e < 8; ++e) cum[e] = c8[e];
              for (int w2 = 0; w2 < F.wave; ++w2) { const f32x4 o0 = *(const LAS f32x4*)(seg + w2 * 64 + kq * 8), o1 = *(const LAS f32x4*)(seg + w2 * 64 + kq * 8 + 4);
#pragma unroll
                  for (int e = 0; e < 8; ++e) cum[e] += e < 4 ? o0[e & 3] : o1[e & 3]; }
              float o[8];
#pragma unroll
              for (int e = 0; e < 8; ++e) o[e] = -kk8[e] * __expf(cum[e] - e8[e]);
              *(LAS u32x4*)(At + pi * TP + kq * 8) = pack8(o);
#pragma unroll
              for (int e = 0; e < 8; ++e) o[e] = r8[e] * __expf(cum[e]);
              *(LAS u32x4*)(Rt + pi * TP + kq * 8) = pack8(o);
              float en[8];
#pragma unroll
              for (int e = 0; e < 8; ++e) { en[e] = __expf(-cum[e]); o[e] = kk8[e] * a8[e] * en[e]; }
              *(LAS u32x4*)(Bt + pi * TP + kq * 8) = pack8(o);
#pragma unroll
              for (int e = 0; e < 8; ++e) o[e] = m8[e] * en[e];
              *(LAS u32x4*)(Kt + pi * TP + kq * 8) = pack8(o);
              *(LAS u32x4*)(Vm + pi * TP + kq * 8) = cur.v;
              if (pi == 63) {
#pragma unroll
                  for (int e = 0; e < 8; ++e) gl[kq * 8 + e] = __expf(cum[e]); } }
            { const int nitem = c4 < NCH - 1 ? item : item + (int)gridDim.x, nc4 = c4 < NCH - 1 ? c4 + 1 : 0; if (nitem < NITEM) scan_load(P, F, nitem, nc4, nxt); }
            LDS_BARRIER(); CH_STAMP(3);
            {   f32x4 aN[2], aM[2], aNr[2], aMr[2];
#pragma unroll
                for (int q = 0; q < 2; ++q) { aN[q] = (f32x4){0.f, 0.f, 0.f, 0.f}; aM[q] = aN[q]; aNr[q] = aN[q]; aMr[q] = aN[q]; }
                mm64<false, true>(At, Bt, aN, wq, wh, lane); mm64<false, true>(At, Kt, aM, wq, wh, lane); mm64<false, true>(Rt, Bt, aNr, wq, wh, lane); mm64<false, true>(Rt, Kt, aMr, wq, wh, lane);
                f32x4 aT[2];
#pragma unroll
                for (int q = 0; q < 2; ++q)
#pragma unroll
                    for (int r = 0; r < 4; ++r) { const int i = 16 * (2 * wh + q) + 4 * l4 + r; const bool lt = i < jrow, le = i <= jrow;
                        aN[q][r] = lt ? aN[q][r] : 0.f; aM[q][r] = lt ? aM[q][r] : 0.f; aNr[q][r] = le ? aNr[q][r] : 0.f; aMr[q][r] = le ? aMr[q][r] : 0.f; aT[q][r] = aN[q][r] + (i == jrow ? 1.f : 0.f); }
                st_tile(NT, aN, wq, wh, lane); st_tile(MT, aM, wq, wh, lane); st_tile(NrT, aNr, wq, wh, lane); st_tile(MrT, aMr, wq, wh, lane); st_tile(TaA, aT, wq, wh, lane);
            }
            LDS_BARRIER(); CH_STAMP(4);
            if (F.wave < 4) { const int o = 16 * F.wave, oc = 16 * ((F.wave + 1) & 3);
                f32x4 p = prod16(NT, o, o, NT, o, o, (f32x4){0.f, 0.f, 0.f, 0.f}, lane); st16(ApA, o, o, p, lane);
                f32x4 t = prod16(TaA, o, o, ApA, o, o, ld16(TaA, o, o, lane), lane); p = prod16(ApA, o, o, ApA, o, o, (f32x4){0.f, 0.f, 0.f, 0.f}, lane);
                st16(TaB, o, o, t, lane); st16(ApA, o, oc, p, lane);
                t = prod16(TaB, o, o, ApA, o, oc, ld16(TaB, o, o, lane), lane); p = prod16(ApA, o, oc, ApA, o, oc, (f32x4){0.f, 0.f, 0.f, 0.f}, lane);
                st16(TaA, o, o, t, lane); st16(ApA, o, o, p, lane);
                t = prod16(TaA, o, o, ApA, o, o, ld16(TaA, o, o, lane), lane); st16(TaB, o, o, t, lane);
#pragma unroll
                for (int jj = 1; jj < 4; ++jj) if (jj > F.wave) { u32x2 zz; asm volatile("v_mov_b32 %0, 0\n\tv_mov_b32 %1, 0" : "=v"(zz.x), "=v"(zz.y)); *(LAS u32x2*)(TaB + (o + l15) * TP + 16 * jj + 4 * l4) = zz; }
            } else { const int wq2 = F.wave - 4;
#pragma unroll
                for (int wh2 = 0; wh2 < 2; ++wh2) { f32x4 x[2] = {(f32x4){0.f, 0.f, 0.f, 0.f}, (f32x4){0.f, 0.f, 0.f, 0.f}}; mm64<true, true>(Vm, MT, x, wq2, wh2, lane); st_tile(ApB, x, wq2, wh2, lane); } }
            LDS_BARRIER(); CH_STAMP(5);
            if (F.wave < 3) { const int jj = F.wave;
#pragma unroll
                for (int i = 1; i < 4; ++i) if (i > jj) { f32x4 e = (f32x4){0.f, 0.f, 0.f, 0.f};
#pragma unroll
                    for (int m = 0; m < 3; ++m) if (m >= jj && m < i) e = prod16(NT, 16 * i, 16 * m, TaB, 16 * m, 16 * jj, e, lane);
                    st16(ApA, 16 * i, 16 * jj, e, lane);
                    st16(TaB, 16 * i, 16 * jj, prod16(TaB, 16 * i, 16 * i, ApA, 16 * i, 16 * jj, (f32x4){0.f, 0.f, 0.f, 0.f}, lane), lane); } }
            LDS_BARRIER(); CH_STAMP(6);
            {   f32x4 w[2] = {(f32x4){0.f, 0.f, 0.f, 0.f}, (f32x4){0.f, 0.f, 0.f, 0.f}}; mm64<true, true>(At, TaB, w, wq, wh, lane); st_tile(ApA, w, wq, wh, lane);
                f32x4 u[2] = {(f32x4){0.f, 0.f, 0.f, 0.f}, (f32x4){0.f, 0.f, 0.f, 0.f}}; mm64<false, true>(ApB, TaB, u, wq, wh, lane); st_tile(TaA, u, wq, wh, lane); }
            LDS_BARRIER(); CH_STAMP(7);
            f32x4 aP[2], aQ[2], aG[2], aY[2];
#pragma unroll
            for (int q = 0; q < 2; ++q) { aP[q] = (f32x4){0.f, 0.f, 0.f, 0.f}; aQ[q] = aP[q]; aG[q] = aP[q]; aY[q] = aP[q]; }
            mm64<false, false>(ApA, Bt, aP, wq, wh, lane);
            mm64<false, false>(TaA, Bt, aQ, wq, wh, lane); mm64<true, false>(Vm, Kt, aQ, wq, wh, lane);
            mm64<false, true>(NrT, ApA, aG, wq, wh, lane);
            mm64<false, true>(NrT, TaA, aY, wq, wh, lane); mm64<false, false>(MrT, Vm, aY, wq, wh, lane);
#pragma unroll
            for (int q = 0; q < 2; ++q) { const int i0 = 16 * (2 * wh + q) + 4 * l4; const f32x4 g4 = *(const LAS f32x4*)(gl + i0);
                const u32x2 rr = *(const LAS u32x2*)(Rt + jrow * TP + i0);
#pragma unroll
                for (int r = 0; r < 4; ++r) { aP[q][r] = (aP[q][r] + (i0 + r == jrow ? 1.f : 0.f)) * g4[r]; aQ[q][r] *= g4[r]; }
                aG[q][0] += bf_lo(rr.x); aG[q][1] += bf_hi(rr.x); aG[q][2] += bf_lo(rr.y); aG[q][3] += bf_hi(rr.y); }
            const size_t orow = (size_t)scan_row(z, b, sc * SCP + c4 * 64 + jrow) * D + hh * 64;
            if (c4 == 0) {
#pragma unroll
                for (int q = 0; q < 2; ++q) { const int i0 = 16 * (2 * wh + q) + 4 * l4;
                    u32x2 o; o.x = cvt_pk_bf16(aG[q][0], aG[q][1]); o.y = cvt_pk_bf16(aG[q][2], aG[q][3]); *(u32x2*)(GE + orow + i0) = o;
                    u32x2 y; y.x = cvt_pk_bf16(aY[q][0], aY[q][1]); y.y = cvt_pk_bf16(aY[q][2], aY[q][3]); *(u32x2*)(YE + orow + i0) = y;
                    Pr[q] = aP[q]; Qr[q] = aQ[q]; }
            } else {
                st_tile(NT, aG, wq, wh, lane); st_tile(MT, aP, wq, wh, lane);
#pragma unroll
                for (int q = 0; q < 2; ++q) { aYp[q] = aY[q]; aQp[q] = aQ[q]; }
                pend = true; orowp = orow; GEp = GE; YEp = YE; pqp = pq; lastp = c4 == NCH - 1;
            }
            cur = nxt;
            if (CH_AMP >= 0) { const unsigned long long d_ = CH_AMP == 0 ? ch_t[0] - ch_t[11] : ch_t[CH_AMP] - ch_t[CH_AMP - 1]; const unsigned long long dl_ = __builtin_amdgcn_s_memrealtime() + 4 * d_; while (__builtin_amdgcn_s_memrealtime() < dl_) __builtin_amdgcn_s_sleep(4); }
            LDS_BARRIER(); CH_STAMP(8);
        }
        item += gridDim.x; if (item >= NITEM) break;
    }
    if (pend) { SCAN_STAGE_G(); }
#undef SCAN_STAGE_G
}
__device__ __forceinline__ void scan_carry_phase(const Frame& F, KP P, int layer) {
    LAS unsigned* cbar = (LAS unsigned*)(F.lds + 8192);
    if (F.tid == 0) *cbar = 0u;
    __syncthreads();
    if (F.wave >= 4) { moe_weights_phase(F, P, layer, blockIdx.x * 4 + (F.wave - 4), gridDim.x * 4, 0, MOE_SPLIT); return; }
    if (blockIdx.x >= 4 * NSCAN) return;
    unsigned ctarget = 0u;
    const int s = blockIdx.x >> 2, vs = blockIdx.x & 3, lane = F.lane, l15 = lane & 15, l4 = lane >> 4, v = 16 * vs + l15, T2 = F.wave;
    const float* pq = (const float*)(P->ws + WS_PQ) + (size_t)s * NSC * 2 * 4096; bf16_t* sst = (bf16_t*)(P->ws + WS_SST) + (size_t)s * NSC * 4096;
    LAS f32x4* exch = (LAS f32x4*)F.lds;
    f32x4 S[4]; float ap[4][16], qp[4][4];
#pragma unroll
    for (int t = 0; t < 4; ++t) S[t] = (f32x4){0.f, 0.f, 0.f, 0.f};
#define CARRY_LOAD(slot, step) do { const float* Pm_ = pq + (size_t)(step) * 2 * 4096; \
        _Pragma("unroll") for (int t2i = 0; t2i < 4; ++t2i) _Pragma("unroll") for (int ri = 0; ri < 4; ++ri) ap[slot][t2i * 4 + ri] = Pm_[(T2 * 16 + t2i * 4 + ri) * 64 + lane];   \
        _Pragma("unroll") for (int r = 0; r < 4; ++r) qp[slot][r] = Pm_[4096 + ((vs * 4 + T2) * 4 + r) * 64 + lane];   } while (0)
#define CARRY_STORE(sc_) do { if (T2 == 0) { float o[16]; \
        _Pragma("unroll") for (int r = 0; r < 4; ++r) _Pragma("unroll") for (int t2 = 0; t2 < 4; ++t2) o[4 * r + t2] = S[t2][r]; \
        u32x4 w0, w1; w0.x = cvt_pk_bf16(o[0], o[1]); w0.y = cvt_pk_bf16(o[2], o[3]); w0.z = cvt_pk_bf16(o[4], o[5]); w0.w = cvt_pk_bf16(o[6], o[7]); \
        w1.x = cvt_pk_bf16(o[8], o[9]); w1.y = cvt_pk_bf16(o[10], o[11]); w1.z = cvt_pk_bf16(o[12], o[13]); w1.w = cvt_pk_bf16(o[14], o[15]); \
        *(u32x4*)(sst + (size_t)(sc_) * 4096 + v * 64 + 16 * l4) = w0; *(u32x4*)(sst + (size_t)(sc_) * 4096 + v * 64 + 16 * l4 + 8) = w1; } } while (0)
    if (T2 < 4) {
#pragma unroll
        for (int u = 0; u < 4; ++u) CARRY_LOAD(u, u);
    }
#pragma nounroll
    for (int sc0 = 0; sc0 < NSC - 1; sc0 += 4) {
#pragma unroll
        for (int u = 0; u < 4; ++u) { const int sc = sc0 + u; if (sc >= NSC - 1) break;
            CARRY_STORE(sc);
            if (T2 < 4) {
                f32x4 nw = (f32x4){qp[u][0], qp[u][1], qp[u][2], qp[u][3]};
#pragma unroll
                for (int t2i = 0; t2i < 4; ++t2i)
#pragma unroll
                    for (int ri = 0; ri < 4; ++ri) nw = __builtin_amdgcn_mfma_f32_16x16x4f32(ap[u][t2i * 4 + ri], S[t2i][ri], nw, 0, 0, 0);
                if (sc + 4 < NSC - 1) CARRY_LOAD(u, sc + 4);
                exch[((u & 1) * 4 + T2) * 64 + lane] = nw;
            }
            { asm volatile("s_waitcnt lgkmcnt(0)" ::: "memory"); if (lane == 0) __hip_atomic_fetch_add(cbar, 1u, __ATOMIC_RELAXED, __HIP_MEMORY_SCOPE_WORKGROUP); ctarget += 4u;
              for (int spin = 0; spin < (1 << 22); ++spin) { const unsigned c = __hip_atomic_load(cbar, __ATOMIC_RELAXED, __HIP_MEMORY_SCOPE_WORKGROUP); if ((int)(c - ctarget) >= 0) break; }
              asm volatile("" ::: "memory"); }
            if (T2 < 4) {
#pragma unroll
                for (int t = 0; t < 4; ++t) S[t] = exch[((u & 1) * 4 + t) * 64 + lane];
            }
        }
    }
    CARRY_STORE(NSC - 1);
#undef CARRY_LOAD
#undef CARRY_STORE
}
__device__ __forceinline__ void scan_out_phase(const Frame& F, KP P, int j) {
    const int lane = F.lane, l15 = lane & 15, l4 = lane >> 4;
    const bf16_t* GE0 = (const bf16_t*)(P->ws + WS_AS0); const bf16_t* GE1 = (const bf16_t*)(P->ws + WS_AS1); const bf16_t* YE0 = (const bf16_t*)(P->ws + WS_ELOG0); const bf16_t* YE1 = (const bf16_t*)(P->ws + WS_ELOG1);
    const bf16_t* Vb = (const bf16_t*)(P->ws + WS_VV); const float* BON = (const float*)(P->ws + WS_BON);
    const bf16_t* GT = (const bf16_t*)(P->ws + WS_GATE); bf16_t* YG = (bf16_t*)(P->ws + WS_YG);
    for (int item = F.gw; item < NBATCH * NH * ((SEQ + CTXL) / 256) * 8; item += F.NGW) {
        const int hh = item & 15, oct = (item >> 4) & 7, b = (item >> 7) & 1, blk = item >> 8;
        const int sc0 = (blk * 256 + 32 * oct) / SCP, sc1 = blk == 0 ? 0 : (SEQ + CTXL - 1 - (blk - 1) * 256 - 32 * oct) / SCP;

        const bf16_t* s0 = (const bf16_t*)(P->ws + WS_SST) + ((size_t)(b * 16 + hh) * NSC + sc0) * 4096; const bf16_t* s1 = (const bf16_t*)(P->ws + WS_SST) + ((size_t)(32 + b * 16 + hh) * NSC + sc1) * 4096;
        bf16x8 sa0[4][2], sa1[4][2];
#pragma unroll
        for (int vt = 0; vt < 4; ++vt) { const int v = 32 * (vt >> 1) + 8 * (l15 >> 2) + 4 * (vt & 1) + (l15 & 3);
#pragma unroll
            for (int ks = 0; ks < 2; ++ks) { sa0[vt][ks] = *(const bf16x8*)(s0 + v * 64 + 32 * ks + 8 * l4); sa1[vt][ks] = *(const bf16x8*)(s1 + v * 64 + 32 * ks + 8 * l4); } }
        f32x4 lg4[4], lb4[4];
#pragma unroll
        for (int q = 0; q < 4; ++q) { const int c = hh * 64 + 32 * (q >> 1) + 8 * l4 + 4 * (q & 1); lg4[q] = *(const f32x4*)(P->in[I_LNG] + (size_t)j * D + c); lb4[q] = *(const f32x4*)(P->in[I_LNB] + (size_t)j * D + c); }
#pragma nounroll
        for (int ti = 0; ti < 2; ++ti) {
            const int tok = (2 * oct + ti) * 16 + l15; const int row = blk == 0 ? TL + b * CTXL + tok : b * SEQ + (blk - 1) * 256 + tok;
            const size_t o = (size_t)row * D + hh * 64;
            const bf16x8 g00 = *(const bf16x8*)(GE0 + o + 8 * l4), g01 = *(const bf16x8*)(GE0 + o + 32 + 8 * l4), g10 = *(const bf16x8*)(GE1 + o + 8 * l4), g11 = *(const bf16x8*)(GE1 + o + 32 + 8 * l4);
            u32x4 la[2], lc[2], lv[2], lgt[2];
#pragma unroll
            for (int h2 = 0; h2 < 2; ++h2) { const size_t oc = o + 32 * h2 + 8 * l4;
                la[h2] = *(const u32x4*)(YE0 + oc); lc[h2] = *(const u32x4*)(YE1 + oc); lv[h2] = *(const u32x4*)(Vb + oc); lgt[h2] = *(const u32x4*)(GT + oc); }
            const float bn = BON[(size_t)row * 16 + hh] + BON[((size_t)T + row) * 16 + hh];
            __builtin_amdgcn_sched_barrier(0);
            f32x4 y[4]; float s = 0.f; f32x4 vv[4], gg[4];
#pragma unroll
            for (int vt = 0; vt < 4; ++vt) { const int h2 = vt >> 1, hf = vt & 1;
                const unsigned ax = hf ? la[h2].z : la[h2].x, ay = hf ? la[h2].w : la[h2].y, cx = hf ? lc[h2].z : lc[h2].x, cy = hf ? lc[h2].w : lc[h2].y;
                const unsigned vx = hf ? lv[h2].z : lv[h2].x, vy = hf ? lv[h2].w : lv[h2].y, gx = hf ? lgt[h2].z : lgt[h2].x, gy = hf ? lgt[h2].w : lgt[h2].y;
                f32x4 acc = (f32x4){bf_lo(ax) + bf_lo(cx), bf_hi(ax) + bf_hi(cx), bf_lo(ay) + bf_lo(cy), bf_hi(ay) + bf_hi(cy)};
                acc = __builtin_amdgcn_mfma_f32_16x16x32_bf16(sa0[vt][0], g00, acc, 0, 0, 0); acc = __builtin_amdgcn_mfma_f32_16x16x32_bf16(sa0[vt][1], g01, acc, 0, 0, 0);
                acc = __builtin_amdgcn_mfma_f32_16x16x32_bf16(sa1[vt][0], g10, acc, 0, 0, 0); acc = __builtin_amdgcn_mfma_f32_16x16x32_bf16(sa1[vt][1], g11, acc, 0, 0, 0);
                y[vt] = acc; s += (acc[0] + acc[1]) + (acc[2] + acc[3]);
                vv[vt] = (f32x4){bf_lo(vx), bf_hi(vx), bf_lo(vy), bf_hi(vy)}; gg[vt] = (f32x4){bf_lo(gx), bf_hi(gx), bf_lo(gy), bf_hi(gy)}; }
            s += shx(s, 16, lane); s += shx(s, 32, lane);
            const float mean = s * (1.0f / 64.0f); float q = 0.f;
#pragma unroll
            for (int vt = 0; vt < 4; ++vt) { const f32x4 d = y[vt] - mean; q += (d[0] * d[0] + d[1] * d[1]) + (d[2] * d[2] + d[3] * d[3]); }
            q += shx(q, 16, lane); q += shx(q, 32, lane);
            const float rstd = rsqrtf(q * (1.0f / 64.0f) + 64e-5f);
#pragma unroll
            for (int h2 = 0; h2 < 2; ++h2) { const f32x4 o0 = (((y[2 * h2] - mean) * rstd) * lg4[2 * h2] + lb4[2 * h2] + vv[2 * h2] * bn) * gg[2 * h2], o1 = (((y[2 * h2 + 1] - mean) * rstd) * lg4[2 * h2 + 1] + lb4[2 * h2 + 1] + vv[2 * h2 + 1] * bn) * gg[2 * h2 + 1];
                u32x4 w; w.x = cvt_pk_bf16(o0[0], o0[1]); w.y = cvt_pk_bf16(o0[2], o0[3]); w.z = cvt_pk_bf16(o1[0], o1[1]); w.w = cvt_pk_bf16(o1[2], o1[3]); *(u32x4*)(YG + o + 32 * h2 + 8 * l4) = w; }
        }
    }
}
__device__ __forceinline__ bool in_range(int lo, int hi, int k) { asm volatile("" : "+s"(lo), "+s"(hi)); return lo <= k && k < hi; }
constexpr int NPH = 46;
template <unsigned KMASK> __global__ void __launch_bounds__(NTHR, 2) mega(Params Pv) {
    extern __shared__ __attribute__((aligned(16))) unsigned char lds_raw[];
    Frame F0; F0.lds = (LAS unsigned char*)lds_raw; F0.tid = threadIdx.x; F0.lane = F0.tid & 63; F0.wave = __builtin_amdgcn_readfirstlane(F0.tid >> 6);
    F0.G = gridDim.x; F0.gw = blockIdx.x * NWAVES + F0.wave; F0.NGW = F0.G * NWAVES;
    LAS unsigned* misc = (LAS unsigned*)(F0.lds + LDS_MISC);
    if (F0.tid < 128) misc[F0.tid] = 0u;
    __syncthreads();
    KP P0 = (KP)__builtin_amdgcn_kernarg_segment_ptr();
    constexpr bool ALL = (KMASK == 0x3ffffu);
    const int lo = ALL ? 0 : P0->ph_lo, hi = ALL ? NPH : P0->ph_hi;
    XcdBarrier bar; bar.bar = (unsigned*)(P0->ws + WS_CTL) + CW_BAR; bar.x = 0; bar.st = (volatile LAS unsigned*)(misc + 8);
    if (ALL || hi - lo > 1) bar = xcd_barrier_post((unsigned*)(P0->ws + WS_CTL) + CW_BAR, (volatile LAS unsigned*)(misc + 8));
#define IN(k) (ALL || in_range(lo, hi, (k)))
#define KIND(q) ((KMASK >> (q)) & 1u)
#define BAR_LEADER (wave_sgpr_now(F0.wave) == 0 && lane_id_now() == 0)
#define SEAM(k) do { if (IN(k) && IN((k) + 1)) { XcdBarrier b2_ = bar; unsigned* bb_ = bar.bar; unsigned bx_ = bar.x; asm volatile("" : "+s"(bb_), "+s"(bx_)); b2_.bar = bb_; b2_.x = bx_; xcd_barrier<false>(b2_, BAR_LEADER); } } while (0)
#define AMP_T0 const unsigned long long amp_t0 = AMP_MASK ? __builtin_amdgcn_s_memrealtime() : 0ull;
#define AMP_END(kind) do { if (AMP_MASK & (1u << (kind))) { const unsigned long long t1_ = __builtin_amdgcn_s_memrealtime(), dl_ = t1_ + AMP_F * (t1_ - amp_t0); while (__builtin_amdgcn_s_memrealtime() < dl_) __builtin_amdgcn_s_sleep(8); } } while (0)
#define PHASE_ENTRY AMP_T0 KP P = P0; asm volatile("" : "+s"(P)); unsigned char* ws = P->ws; unsigned* ctl = (unsigned*)(ws + WS_CTL); (void)ctl; \
    Frame F = F0; { int l_ = lane_id_now(), w_ = F0.wave; asm volatile("" : "+s"(w_)); F.lane = l_; F.wave = w_; F.tid = w_ * 64 + l_; F.gw = blockIdx.x * NWAVES + w_; }

    if constexpr (KIND(0)) if (IN(0)) { PHASE_ENTRY prologue_phase(F, P); AMP_END(0); }
    if (IN(0) && IN(1)) { XcdBarrier b2_ = bar; unsigned* bb_ = bar.bar; unsigned bx_ = bar.x; asm volatile("" : "+s"(bb_), "+s"(bx_)); b2_.bar = bb_; b2_.x = bx_; xcd_barrier<true>(b2_, BAR_LEADER); }
    for (int lp = 0; lp < 2; ++lp) {
        const int pb = 1 + 22 * lp, la = 2 * lp, lb = 2 * lp + 1;
        if constexpr (KIND(1)) if (IN(pb + 0)) { PHASE_ENTRY norm1_phase(F, P, la); AMP_END(1); }
        SEAM(pb + 0);
        if constexpr (KIND(2)) if (IN(pb + 1)) { PHASE_ENTRY
            __syncthreads(); set_desc(F.lds, F.tid, 0, ws + WS_HL, ws + WS_WIN + (size_t)lp * 4096 * D * 2, ws + WS_U, 16, 0, 0, ws + WS_V, P->in[I_GBIN] + (size_t)lp * 4096, ws + WS_STAT); __syncthreads();
            SchedMulti<D, D> S{F.lds, TL / 256, 16, 1};
            EpiGelu E{F.lds};
            pg8::gemm_phase<EpiGelu, SchedMulti<D, D>, false, D, D, D>(F.lds, S, E, F.tid);
            __syncthreads(); { int w_ = F0.wave; asm volatile("" : "+s"(w_)); tail_gelu(F0.lds, w_); }
            AMP_END(2); }
        SEAM(pb + 1);
        if constexpr (KIND(3)) if (IN(pb + 2)) { PHASE_ENTRY spatial_phase(F, P, lp); AMP_END(3); }
        SEAM(pb + 2);
        if constexpr (KIND(4)) if (IN(pb + 3)) { PHASE_ENTRY
            __syncthreads();
            { bf16_t* X = (bf16_t*)(ws + WS_X);
              set_desc(F.lds, F.tid, 0, ws + WS_U, ws + WS_WOUT + (size_t)lp * D * GWID * 2, X, 4, 0, 0, X, X + (size_t)TL * D, P->in[I_GBOUT] + (size_t)lp * D);
              set_desc(F.lds, F.tid, 1, nullptr, nullptr, nullptr, 0, 0, 0, (const float*)(ws + WS_MOD) + (size_t)la * 3 * 6 * D + 2 * D); }
            __syncthreads();
            SchedMulti<GWID, GWID> S{F.lds, TL / 256, 4, 1};
            EpiResid E{F.lds};
            pg8::gemm_phase<EpiResid, SchedMulti<GWID, GWID>, false, GWID, GWID, GWID>(F.lds, S, E, F.tid);
            __syncthreads(); { int w_ = F0.wave; asm volatile("" : "+s"(w_)); tail_resid<GWID>(F0.lds, w_); }
            AMP_END(4); }
        SEAM(pb + 3);
        if constexpr (KIND(5)) if (IN(pb + 4)) { PHASE_ENTRY norm2_phase(F, P, la); AMP_END(5); }
        SEAM(pb + 4);
        if constexpr (KIND(16)) if (IN(pb + 5)) { PHASE_ENTRY
            __syncthreads(); set_desc(F.lds, F.tid, 0, ws + WS_HL, ws + WS_WRT + (size_t)la * 256 * D * 2, nullptr, 1, 0, 0); __syncthreads();
            const int nun = (la == DEPTH - 1 ? TL : T) / 256;
            if ((int)blockIdx.x >= nun) moe_weights_phase(F, P, la, ((int)blockIdx.x - nun) * NWAVES + F.wave, (F.G - nun) * NWAVES, MOE_SPLIT, MOE_ITEMS);
            else { SchedMulti<D, D> S{F.lds, nun, 1, 1};
                EpiLogits E{(float*)(ws + WS_LG)};
                pg8::gemm_phase<EpiLogits, SchedMulti<D, D>, false, D, D, D>(F.lds, S, E, F.tid);
                if (F.G <= nun) { __syncthreads(); moe_weights_phase(F, P, la, F.gw, F.NGW, MOE_SPLIT, MOE_ITEMS); } }
            AMP_END(16); }
        SEAM(pb + 5);
        if constexpr (KIND(17)) if (IN(pb + 6)) { PHASE_ENTRY route_phase(F, P, la); AMP_END(17); }
        SEAM(pb + 6);
        if constexpr (KIND(6)) if (IN(pb + 7)) { PHASE_ENTRY
            moe_tables(F.lds, F.tid, ctl + CW_CNT + la * 64);
            SchedMoE<D, D, true> S{F.lds, (const char*)(ws + WS_HL), (const char*)(ws + WS_WGU), (const int*)(ws + WS_LIST)};
            EpiSiluGate E{(bf16_t*)(ws + WS_H)};
            pg8::gemm_phase<EpiSiluGate, SchedMoE<D, D, true>, true, D, D, D>(F.lds, S, E, F.tid);
            AMP_END(6); }
        SEAM(pb + 7);
        if constexpr (KIND(7)) if (IN(pb + 8)) { PHASE_ENTRY
            moe_tables(F.lds, F.tid, ctl + CW_CNT + la * 64);
            SchedMoE<EHID, EHID, false> S{F.lds, (const char*)(ws + WS_H), (const char*)(ws + WS_WD), (const int*)(ws + WS_LIST)};
            EpiScatter E{F.lds, (bf16_t*)(ws + WS_YB), (const int*)(ws + WS_LIST)};
            pg8::gemm_phase<EpiScatter, SchedMoE<EHID, EHID, false>, false, EHID, EHID, EHID>(F.lds, S, E, F.tid);
            AMP_END(7); }
        SEAM(pb + 8);
        if constexpr (KIND(1)) if (IN(pb + 9)) { PHASE_ENTRY norm1_phase(F, P, lb); AMP_END(1); }
        SEAM(pb + 9);
        if constexpr (KIND(8)) if (IN(pb + 10)) { PHASE_ENTRY mix_phase(F, P, lp); AMP_END(8); }
        SEAM(pb + 10);
        if constexpr (KIND(9)) if (IN(pb + 11)) { PHASE_ENTRY
            __syncthreads();
            set_desc(F.lds, F.tid, 0, ws + WS_XR, ws + WS_WR + (size_t)lp * D * D * 2, ws + WS_R, 4, D, 0);
            set_desc(F.lds, F.tid, 1, ws + WS_XK, ws + WS_WK + (size_t)lp * D * D * 2, ws + WS_K, 4, D, 0);
            set_desc(F.lds, F.tid, 2, ws + WS_XV, ws + WS_WV + (size_t)lp * D * D * 2, ws + WS_VV, 4, D, 0);
            set_desc(F.lds, F.tid, 3, ws + WS_XW, ws + WS_LW1 + (size_t)lp * 256 * D * 2, ws + WS_TW, 1, 256, 1);
            set_desc(F.lds, F.tid, 4, ws + WS_XA, ws + WS_LA1 + (size_t)lp * 256 * D * 2, ws + WS_TA, 1, 256, 0);
            set_desc(F.lds, F.tid, 5, ws + WS_XG, ws + WS_LG1 + (size_t)lp * 256 * D * 2, ws + WS_TG, 1, 256, 2);
            __syncthreads();
            SchedMulti<D, D> S{F.lds, T / 256, 15, 6};
            EpiAct E{F.lds};
            pg8::gemm_phase<EpiAct, SchedMulti<D, D>, false, D, D, D>(F.lds, S, E, F.tid);
            AMP_END(9); }
        SEAM(pb + 11);
        if constexpr (KIND(10)) if (IN(pb + 12)) { PHASE_ENTRY
            __syncthreads(); set_desc(F.lds, F.tid, 0, ws + WS_TG, ws + WS_G2P + (size_t)lp * D * 256 * 2, ws + WS_GATE, 4, D, 0); __syncthreads();
            SchedMulti<256, 256> S{F.lds, T / 256, 4, 1};
            EpiAct E{F.lds};
            pg8::gemm_phase<EpiAct, SchedMulti<256, 256>, false, 256, 256, 256>(F.lds, S, E, F.tid);
            AMP_END(10); }
        SEAM(pb + 12);
        if constexpr (KIND(11)) if (IN(pb + 13)) { PHASE_ENTRY scan_chunk_phase(F, P, lp); AMP_END(11); }
        SEAM(pb + 13);
        if constexpr (KIND(14)) if (IN(pb + 14)) { PHASE_ENTRY scan_carry_phase(F, P, lb); AMP_END(14); }
        SEAM(pb + 14);
        if constexpr (KIND(15)) if (IN(pb + 15)) { PHASE_ENTRY scan_out_phase(F, P, lp); AMP_END(15); }
        SEAM(pb + 15);
        if constexpr (KIND(4)) if (IN(pb + 16)) { PHASE_ENTRY
            __syncthreads();
            { bf16_t* X = (bf16_t*)(ws + WS_X);
              set_desc(F.lds, F.tid, 0, ws + WS_YG, ws + WS_WO + (size_t)lp * D * D * 2, X, 4, 0, 0, X, X + (size_t)TL * D, nullptr);
              set_desc(F.lds, F.tid, 1, nullptr, nullptr, nullptr, 0, 0, 0, (const float*)(ws + WS_MOD) + (size_t)lb * 3 * 6 * D + 2 * D); }
            __syncthreads();
            SchedMulti<D, D> S{F.lds, TL / 256, 4, 1};
            EpiResid E{F.lds};
            pg8::gemm_phase<EpiResid, SchedMulti<D, D>, false, D, D, D>(F.lds, S, E, F.tid);
            if (lb != DEPTH - 1) { __syncthreads(); { int w_ = F0.wave; asm volatile("" : "+s"(w_)); tail_resid<D>(F0.lds, w_); } }
            AMP_END(4); }
        SEAM(pb + 16);
        if constexpr (KIND(5)) if (IN(pb + 17)) { PHASE_ENTRY norm2_phase(F, P, lb); AMP_END(5); }
        SEAM(pb + 17);
        if constexpr (KIND(16)) if (IN(pb + 18)) { PHASE_ENTRY
            __syncthreads(); set_desc(F.lds, F.tid, 0, ws + WS_HL, ws + WS_WRT + (size_t)lb * 256 * D * 2, nullptr, 1, 0, 0); __syncthreads();
            const int nun = (lb == DEPTH - 1 ? TL : T) / 256;
            if ((int)blockIdx.x >= nun) moe_weights_phase(F, P, lb, ((int)blockIdx.x - nun) * NWAVES + F.wave, (F.G - nun) * NWAVES, MOE_SPLIT, MOE_ITEMS);
            else { SchedMulti<D, D> S{F.lds, nun, 1, 1};
                EpiLogits E{(float*)(ws + WS_LG)};
                pg8::gemm_phase<EpiLogits, SchedMulti<D, D>, false, D, D, D>(F.lds, S, E, F.tid);
                if (F.G <= nun) { __syncthreads(); moe_weights_phase(F, P, lb, F.gw, F.NGW, MOE_SPLIT, MOE_ITEMS); } }
            AMP_END(16); }
        SEAM(pb + 18);
        if constexpr (KIND(17)) if (IN(pb + 19)) { PHASE_ENTRY route_phase(F, P, lb); AMP_END(17); }
        SEAM(pb + 19);
        if constexpr (KIND(6)) if (IN(pb + 20)) { PHASE_ENTRY
            moe_tables(F.lds, F.tid, ctl + CW_CNT + lb * 64);
            SchedMoE<D, D, true> S{F.lds, (const char*)(ws + WS_HL), (const char*)(ws + WS_WGU), (const int*)(ws + WS_LIST)};
            EpiSiluGate E{(bf16_t*)(ws + WS_H)};
            pg8::gemm_phase<EpiSiluGate, SchedMoE<D, D, true>, true, D, D, D>(F.lds, S, E, F.tid);
            AMP_END(6); }
        SEAM(pb + 20);
        if constexpr (KIND(7)) if (IN(pb + 21)) { PHASE_ENTRY
            moe_tables(F.lds, F.tid, ctl + CW_CNT + lb * 64);
            SchedMoE<EHID, EHID, false> S{F.lds, (const char*)(ws + WS_H), (const char*)(ws + WS_WD), (const int*)(ws + WS_LIST)};
            EpiScatter E{F.lds, (bf16_t*)(ws + WS_YB), (const int*)(ws + WS_LIST)};
            pg8::gemm_phase<EpiScatter, SchedMoE<EHID, EHID, false>, false, EHID, EHID, EHID>(F.lds, S, E, F.tid);
            AMP_END(7); }
        SEAM(pb + 21);
    }
    if constexpr (KIND(13)) if (IN(45)) { PHASE_ENTRY final_phase(F, P); AMP_END(13); }
#undef IN
#undef KIND
#undef SEAM
#undef PHASE_ENTRY
}

#if !MK_ONE_LAUNCH
static int phase_kind(int ph) { if (ph == 0) return 0; if (ph == 45) return 13; static const int k22[22] = {1, 2, 3, 4, 5, 16, 17, 6, 7, 1, 8, 9, 10, 11, 14, 15, 4, 5, 16, 17, 6, 7}; return k22[(ph - 1) % 22]; }
typedef void (*kern_t)(Params);
template <unsigned KM> static kern_t kern_of() { return mega<KM>; }
static kern_t kind_kernel(int kind) {
    switch (kind) { case 0: return kern_of<1u << 0>(); case 1: return kern_of<1u << 1>(); case 2: return kern_of<1u << 2>(); case 3: return kern_of<1u << 3>(); case 4: return kern_of<1u << 4>();
        case 5: return kern_of<1u << 5>(); case 6: return kern_of<1u << 6>(); case 7: return kern_of<1u << 7>(); case 8: return kern_of<1u << 8>(); case 9: return kern_of<1u << 9>();
        case 10: return kern_of<1u << 10>(); case 11: return kern_of<1u << 11>(); case 12: return kern_of<1u << 12>(); case 14: return kern_of<1u << 14>(); case 15: return kern_of<1u << 15>(); case 16: return kern_of<1u << 16>(); case 17: return kern_of<1u << 17>(); default: return kern_of<1u << 13>(); }
}
#endif
extern "C" void kernel_launch(void* const* d_in, const int* in_sizes, int n_in, void* d_out, int out_size, void* d_ws, size_t ws_size, hipStream_t stream) {
    static int grid = 0;
    if (grid == 0) {
        if (n_in != 42 || out_size != TL * D || ws_size < WS_END) { fprintf(stderr, "kernel_launch: unexpected problem (n_in %d, out %d, ws %zu < %zu)\n", n_in, out_size, ws_size, (size_t)WS_END); grid = -1; return; }
        int dev = 0, cus = 0;
        if (hipGetDevice(&dev) != hipSuccess || hipDeviceGetAttribute(&cus, hipDeviceAttributeMultiprocessorCount, dev) != hipSuccess) { grid = -1; return; }
#if MK_ONE_LAUNCH
        if (hipFuncSetAttribute((const void*)mega<0x3ffffu>, hipFuncAttributeMaxDynamicSharedMemorySize, LDS_BYTES) != hipSuccess) { fprintf(stderr, "kernel_launch: hipFuncSetAttribute failed\n"); grid = -1; return; }
#else
        for (int k = 0; k < 18; ++k) if (hipFuncSetAttribute((const void*)kind_kernel(k), hipFuncAttributeMaxDynamicSharedMemorySize, LDS_BYTES) != hipSuccess) { fprintf(stderr, "kernel_launch: hipFuncSetAttribute failed\n"); grid = -1; return; }
#endif
        (void)hipGetLastError();
        grid = cus;
    }
    if (grid < 0) return;
    (void)hipMemsetAsync((char*)d_ws + WS_CTL, 0, CTL_BYTES, stream);
    Params p{};
    for (int i = 0; i < 42; ++i) p.in[i] = (const float*)d_in[i];
    p.out = (float*)d_out; p.ws = (unsigned char*)d_ws;
#if MK_ONE_LAUNCH
    p.ph_lo = 0; p.ph_hi = NPH;
    hipLaunchKernelGGL(mega<0x3ffffu>, dim3(grid), dim3(NTHR), LDS_BYTES, stream, p);
#else
    for (int ph = 0; ph < NPH; ++ph) { p.ph_lo = ph; p.ph_hi = ph + 1; hipLaunchKernelGGL(kind_kernel(phase_kind(ph)), dim3(grid), dim3(NTHR), LDS_BYTES, stream, p); }
#endif
}
```

```cpp
#include <hip/hip_runtime.h>
#include <cstdio>
#include <cstdint>

#define LAS __attribute__((address_space(3)))
typedef unsigned short bf16_t;
typedef short bf16x8 __attribute__((ext_vector_type(8)));
typedef float f32x4 __attribute__((ext_vector_type(4)));
typedef float f32x2 __attribute__((ext_vector_type(2)));
typedef unsigned u32x4 __attribute__((ext_vector_type(4)));
typedef unsigned u32x2 __attribute__((ext_vector_type(2)));

#ifndef CH_AMP
#define CH_AMP -1
#endif
#define CH_STAMP(i) do { if (CH_AMP >= 0) ch_t[i] = __builtin_amdgcn_s_memrealtime(); } while (0)
#ifndef AMP_MASK
#define AMP_MASK 0u
#endif
#define AMP_F 4
#ifndef MK_ONE_LAUNCH
#define MK_ONE_LAUNCH 1
#endif

constexpr int D = 1024, NBATCH = 2, SEQ = 16384, CTXL = 256, DEPTH = 4;
constexpr int TL = NBATCH * SEQ, TC = NBATCH * CTXL, T = TL + TC;
constexpr int GWID = 2048, NE = 32, EHID = 512, NH = 16, HD = 64;
constexpr int LISTCAP = T;
constexpr int MAXRT = (2 * T) / 256 + NE;
constexpr int NWAVES = 8, NTHR = 512;

constexpr size_t MiB = 1u << 20;
constexpr size_t WS_CTL = 0, CTL_BYTES = 1 * MiB;
constexpr size_t WS_MOD = 1 * MiB;
constexpr size_t WS_WIN = 2 * MiB, WS_WOUT = 18 * MiB, WS_WSP = 26 * MiB, WS_WR = 27 * MiB, WS_WK = 31 * MiB, WS_WV = 35 * MiB, WS_WO = 39 * MiB;
constexpr size_t WS_LW1 = 43 * MiB, WS_LA1 = 44 * MiB, WS_LG1 = 45 * MiB, WS_W2P = 46 * MiB, WS_A2P = 48 * MiB, WS_G2P = 50 * MiB;
constexpr size_t WS_WRT = 52 * MiB;
constexpr size_t WS_WGU = 54 * MiB, WS_WD = 118 * MiB;
constexpr size_t WS_X = 150 * MiB;
constexpr size_t WS_LIST = 280 * MiB, WS_WGT = 285 * MiB;
constexpr size_t WS_HL = 286 * MiB;
constexpr size_t WS_BIG = 351 * MiB;
constexpr size_t SZB = 65 * MiB;
constexpr size_t WS_U = WS_BIG, WS_V = WS_BIG + 2 * SZB, WS_STAT = WS_BIG + 4 * SZB;
constexpr size_t WS_XR = WS_BIG, WS_XW = WS_BIG + SZB, WS_XK = WS_BIG + 2 * SZB, WS_XV = WS_BIG + 3 * SZB, WS_XA = WS_BIG + 4 * SZB, WS_XG = WS_BIG + 5 * SZB;
constexpr size_t WS_R = WS_BIG + 6 * SZB, WS_K = WS_BIG + 7 * SZB, WS_VV = WS_BIG + 8 * SZB;
constexpr size_t WS_TW = WS_BIG + 9 * SZB, WS_TA = WS_TW + 17 * MiB, WS_TG = WS_TA + 17 * MiB;
constexpr size_t WS_ELOG0 = WS_XR, WS_ELOG1 = WS_XW, WS_KM0 = WS_XK, WS_KM1 = WS_XV, WS_AS0 = WS_XA, WS_AS1 = WS_XG;
constexpr size_t WS_GATE = WS_HL, WS_YG = WS_AS0, WS_BON = WS_TG + 17 * MiB;
constexpr size_t WS_H = WS_BIG, WS_YB = WS_BIG + 73 * MiB, WS_LG = WS_BIG + 204 * MiB;
constexpr size_t WS_PQ = WS_KM0;
constexpr size_t WS_SST = 215 * MiB;
constexpr size_t WS_END = WS_BON + 5 * MiB;
static_assert(WS_END <= 1080 * MiB, "workspace map");
constexpr int CW_BAR = 4096;
constexpr int CW_CNT = 16384;

__device__ __forceinline__ int wave_sgpr_now(int w) { asm volatile("" : "+s"(w)); return w; }
__device__ __forceinline__ int lane_id_now() { int l; asm volatile("v_mbcnt_lo_u32_b32 %0, -1, 0\n\tv_mbcnt_hi_u32_b32 %0, -1, %0" : "=v"(l)); return l; }
typedef short v4s __attribute__((ext_vector_type(4)));
#define LDS_BARRIER() asm volatile("s_waitcnt lgkmcnt(0)\n\ts_barrier" ::: "memory")
typedef __bf16 bf16x2_t __attribute__((ext_vector_type(2)));
__device__ __forceinline__ unsigned cvt_pk_bf16(float lo, float hi) { const bf16x2_t v = __builtin_convertvector((f32x2){lo, hi}, bf16x2_t); return __builtin_bit_cast(unsigned, v); }
__device__ __forceinline__ float bf_lo(unsigned u) { return __uint_as_float(u << 16); }
__device__ __forceinline__ float bf_hi(unsigned u) { return __uint_as_float(u & 0xffff0000u); }
__device__ __forceinline__ float bf1(bf16_t b) { return __uint_as_float(((unsigned)b) << 16); }
__device__ __forceinline__ bf16_t f2bf(float f) { return (bf16_t)(cvt_pk_bf16(f, 0.f) & 0x3ffffu); }
__device__ __forceinline__ void unpack8(const u32x4& w, float (&f)[8]) { f[0] = bf_lo(w.x); f[1] = bf_hi(w.x); f[2] = bf_lo(w.y); f[3] = bf_hi(w.y); f[4] = bf_lo(w.z); f[5] = bf_hi(w.z); f[6] = bf_lo(w.w); f[7] = bf_hi(w.w); }
__device__ __forceinline__ u32x4 pack8(const float (&f)[8]) { u32x4 o; o.x = cvt_pk_bf16(f[0], f[1]); o.y = cvt_pk_bf16(f[2], f[3]); o.z = cvt_pk_bf16(f[4], f[5]); o.w = cvt_pk_bf16(f[6], f[7]); return o; }
__device__ __forceinline__ float shx(float v, int m, int lane) { return __int_as_float(__builtin_amdgcn_ds_bpermute((lane ^ m) << 2, __float_as_int(v))); }
__device__ __forceinline__ float shup(float v, int d, int lane) { return __int_as_float(__builtin_amdgcn_ds_bpermute((lane - d) << 2, __float_as_int(v))); }
__device__ __forceinline__ float wave_sum(float v, int lane) {
#pragma unroll
    for (int o = 1; o < 64; o <<= 1) v += shx(v, o, lane);
    return v;
}
__device__ __forceinline__ float sigmoidf_(float x) { return 1.0f / (1.0f + __expf(-x)); }
__device__ __forceinline__ float tanhf_(float x) { const float e = __expf(2.0f * x); return 1.0f - 2.0f / (e + 1.0f); }
__device__ __forceinline__ f32x2 gelu_pk(f32x2 v) {
    const f32x2 av = __builtin_elementwise_abs(v), d = av * 0.2316418882f + 1.0f;
    f32x2 t; t.x = __builtin_amdgcn_rcpf(d.x); t.y = __builtin_amdgcn_rcpf(d.y);
    f32x2 q = t * 0.5307027145f + (-0.7265760135f); q = q * t + 0.7107068705f; q = q * t + (-0.142248368f); q = q * t + 0.127414796f; q = q * t;
    const f32x2 s = (v * v) * (-0.72134752044f);
    f32x2 e; e.x = __builtin_amdgcn_exp2f(s.x); e.y = __builtin_amdgcn_exp2f(s.y);
    const f32x2 m = v * (q * e), r = v - m;
    f32x2 o; o.x = v.x < 0.f ? m.x : r.x; o.y = v.y < 0.f ? m.y : r.y; return o;
}

#define XB_TMO      128
#define XB_XCNT(j)  (256  + 64 * (j))
#define XB_XSUB(j)  (1280 + 64 * (j))
#define XB_XGEN(j)  (2304 + 64 * (j))
#define XB_TOP      3328
#define XB_TOPGEN   3392
#define XCD_BAR_WORDS 3456
#define XB_SPIN_CAP (1u << 18)
__device__ __forceinline__ unsigned xb_ld(unsigned* p)              { return __hip_atomic_load(p, __ATOMIC_RELAXED, __HIP_MEMORY_SCOPE_AGENT); }
__device__ __forceinline__ unsigned xb_add(unsigned* p, unsigned v) { return __hip_atomic_fetch_add(p, v, __ATOMIC_RELAXED, __HIP_MEMORY_SCOPE_AGENT); }
__device__ __forceinline__ unsigned xb_xcc_id() { return (unsigned)__builtin_amdgcn_s_getreg((3 << 11) | 20) & 0xFu; }
#define XB_SPIN(cond, bar) do { unsigned _sp = 0; while (cond) { __builtin_amdgcn_s_sleep(1); \
    if ((++_sp & 255u) == 0u) { if (xb_ld(&(bar)[XB_TMO])) break; if (_sp > XB_SPIN_CAP) { atomicAdd(&(bar)[XB_TMO], 1u); break; } } } } while (0)
struct XcdBarrier { unsigned* bar; unsigned x; volatile LAS unsigned* st; };
__device__ __forceinline__ XcdBarrier xcd_barrier_post(unsigned* bar, volatile LAS unsigned* st) {
    XcdBarrier b; b.bar = bar; b.x = xb_xcc_id(); b.st = st;
    if (threadIdx.x == 0) (void)xb_add(&bar[XB_XCNT(b.x)], 1u);
    return b;
}
__device__ __forceinline__ void xcd_barrier_complete(unsigned* bar, unsigned x, unsigned& nloc, unsigned& nx) {
    const unsigned G = gridDim.x * gridDim.y * gridDim.z;
    unsigned sum, cnt, mine, sp = 0u;
    for (;;) {
        sum = 0u; cnt = 0u; mine = 0u;
#pragma unroll
        for (unsigned j = 0; j < 16; ++j) { const unsigned c = xb_ld(&bar[XB_XCNT(j)]); sum += c; cnt += (c > 0u) ? 1u : 0u; mine = (j == x) ? c : mine; }
        if (sum == G) break;
        __builtin_amdgcn_s_sleep(1);
        if ((++sp & 255u) == 0u) { if (xb_ld(&bar[XB_TMO])) break; if (sp > XB_SPIN_CAP) { atomicAdd(&bar[XB_TMO], 1u); break; } }
    }
    nloc = mine > 0u ? mine : 1u; nx = cnt > 0u ? cnt : 1u;
}
template <bool FIRST> __device__ __forceinline__ void xcd_barrier(const XcdBarrier& b, const bool leader) {
    asm volatile("s_waitcnt vmcnt(0)" ::: "memory");
    __syncthreads();
    if (leader) {
        unsigned* bar = b.bar;
        __builtin_amdgcn_s_waitcnt(0);
        unsigned nloc = b.st[0], nx = b.st[1];
        if constexpr (FIRST) { if (nloc == 0u) { xcd_barrier_complete(bar, b.x, nloc, nx); b.st[0] = nloc; b.st[1] = nx; } }
        const unsigned old = xb_add(&bar[XB_XSUB(b.x)], 1u);
        const unsigned gen = old / nloc;
        if (old + 1u == (gen + 1u) * nloc) {
            __builtin_amdgcn_fence(__ATOMIC_RELEASE, "agent");
            asm volatile("s_waitcnt vmcnt(0)" ::: "memory");
            const unsigned og = xb_add(&bar[XB_TOP], 1u);
            const unsigned tg = og / nx;
            if (og + 1u == (tg + 1u) * nx) xb_add(&bar[XB_TOPGEN], 1u);
            else XB_SPIN(xb_ld(&bar[XB_TOPGEN]) == tg, bar);
            __builtin_amdgcn_fence(__ATOMIC_ACQUIRE, "agent");
            xb_add(&bar[XB_XGEN(b.x)], 1u);
            asm volatile("s_waitcnt vmcnt(0)" ::: "memory");
        } else {
            XB_SPIN(xb_ld(&bar[XB_XGEN(b.x)]) == gen, bar);
            __builtin_amdgcn_fence(__ATOMIC_ACQUIRE, "agent");
            asm volatile("s_waitcnt vmcnt(0)" ::: "memory");
        }
    }
    __syncthreads();
}

constexpr int LDS_MISC = 143360;
constexpr int LDS_DESC = LDS_MISC + 128;
constexpr int LDS_TAB = LDS_MISC + 512;
constexpr int LDS_BYTES = 147456;
namespace pg8 {
constexpr int BM = 256, BK = 64, HALF = 128, HTB = HALF * BK * 2, STAGE_BYTES = 8 * HTB, NXCD = 8, WGM = 8;
__host__ __device__ __forceinline__ int lds_byte(int r, int c) { const int st = (r >> 4) * 2 + (c >> 5), rr = r & 15, cc = c & 31, ob = rr * 64 + cc * 2; return st * 1024 + (ob ^ (((ob >> 9) & 1) << 5)); }
__host__ __device__ __forceinline__ void stage_rc(int b, int& R, int& C) { const int st = b / 1024, sb = b % 1024, swz = sb ^ (((sb >> 9) & 1) << 5); R = (st >> 1) * 16 + swz / 64; C = (st & 1) * 32 + (swz % 64) / 2; }
__host__ __device__ __forceinline__ int perm32(int rho) { const int n = rho >> 4, i = rho & 15; return 8 * (i >> 2) + 4 * n + (i & 3); }
__device__ __forceinline__ int xcd_remap(int L, int nwg) { const int q = nwg / NXCD, r = nwg % NXCD, xcd = L % NXCD, off = L / NXCD; return (xcd < r ? xcd * (q + 1) : r * (q + 1) + (xcd - r) * q) + off; }

struct Unit { int pm, pn, aux; };

template <class Epi, class Sched, bool GATHER, int K, int LDA, int LDB>
__device__ __forceinline__ void gemm_phase(LAS unsigned char* lds, const Sched& S, const Epi& E, const int tid_in) {
    int tid_ = tid_in; asm volatile("" : "+v"(tid_));
    const int tid = tid_, wid = __builtin_amdgcn_readfirstlane(tid >> 6), lane = tid & 63, wr = wid >> 2, wc = wid & 3, fr = lane & 15, fq = lane >> 4;
    constexpr int nt = K / BK;
    unsigned voffA[2], voffB[2];
#pragma unroll
    for (int i = 0; i < 2; ++i) { int R, C; stage_rc(tid * 16 + i * 8192, R, C); const int Rb = Epi::PERM ? ((R & ~31) + perm32(R & 31)) : R;
        voffA[i] = (unsigned)(R * LDA + C) * 2u; voffB[i] = (unsigned)(Rb * LDB + C) * 2u; }
    constexpr size_t kstep = (size_t)(BK * 2);
    constexpr size_t hstepA = GATHER ? (size_t)0 : (size_t)HALF * LDA * 2, hstepB = (size_t)HALF * LDB * 2;
    const unsigned ldsw = (unsigned)wid * 1024u;
    const int aoff = lds_byte(wr * 64 + fr, fq * 8), boff = lds_byte(wc * 32 + fr, fq * 8);
    unsigned gA[2][2], gN[2][2];
#define PG8_SA(b, h) (((b) * 2 + (h)) * HTB)
#define PG8_SB(b, h) ((4 + (b) * 2 + (h)) * HTB)
#define PG8_STAGEB(bufoff, gbase) do { _Pragma("unroll") for (int _i = 0; _i < 2; ++_i) \
        __builtin_amdgcn_global_load_lds((const unsigned*)((const char*)(gbase) + voffB[_i]), (LAS unsigned*)(lds + (bufoff) + ldsw + _i * 8192), 16, 0, 0); } while (0)
#define PG8_STAGEA(bufoff, gbase, h, GV) do { _Pragma("unroll") for (int _i = 0; _i < 2; ++_i) \
        __builtin_amdgcn_global_load_lds((const unsigned*)((const char*)(gbase) + (GATHER ? GV[h][_i] : voffA[_i]) + (h) * hstepA), (LAS unsigned*)(lds + (bufoff) + ldsw + _i * 8192), 16, 0, 0); } while (0)
#define PG8_LDA(dst, b, h) do { _Pragma("unroll") for (int m = 0; m < 4; ++m) _Pragma("unroll") for (int k = 0; k < 2; ++k) dst[m][k] = *(const LAS bf16x8*)(lds + PG8_SA(b, h) + aoff + m * 2048 + k * 1024); } while (0)
#define PG8_LDB(dst, b, h) do { _Pragma("unroll") for (int n = 0; n < 2; ++n) _Pragma("unroll") for (int k = 0; k < 2; ++k) dst[n][k] = *(const LAS bf16x8*)(lds + PG8_SB(b, h) + boff + n * 2048 + k * 1024); } while (0)
#define PG8_MMA(ai, bj, At, Bt) do { __builtin_amdgcn_s_setprio(1); _Pragma("unroll") for (int m = 0; m < 4; ++m) _Pragma("unroll") for (int n = 0; n < 2; ++n) _Pragma("unroll") for (int k = 0; k < 2; ++k) \
        acc[ai][bj][m][n] = __builtin_amdgcn_mfma_f32_16x16x32_bf16(Bt[n][k], At[m][k], acc[ai][bj][m][n], 0, 0, 0); __builtin_amdgcn_s_setprio(0); } while (0)
#define PG8_WAIT_V(n) asm volatile("s_waitcnt vmcnt(" #n ")" ::: "memory")
#define PG8_WAIT_L(n) asm volatile("s_waitcnt lgkmcnt(" #n ")" ::: "memory")
#define PG8_BAR __builtin_amdgcn_s_barrier()
#define PG8_SCHED __builtin_amdgcn_sched_barrier(0)
    Unit cur, nxt; int ui = 0;
    if (!S.next(0, cur)) return;
    f32x4 acc[2][2][4][2];
#pragma unroll
    for (int a = 0; a < 2; ++a)
#pragma unroll
        for (int b = 0; b < 2; ++b)
#pragma unroll
            for (int m = 0; m < 4; ++m)
#pragma unroll
                for (int n = 0; n < 2; ++n) acc[a][b][m][n] = (f32x4){0.f, 0.f, 0.f, 0.f};
    bf16x8 At[4][2], B0[2][2], B1[2][2];
    const char* cA = S.aptr(cur); const char* cB = S.bptr(cur);
    if constexpr (GATHER) { S.gather(cur, tid, gA); }
    PG8_STAGEB(PG8_SB(0, 0), cB); PG8_STAGEB(PG8_SB(0, 1), cB + hstepB); PG8_STAGEA(PG8_SA(0, 0), cA, 0, gA); PG8_STAGEA(PG8_SA(0, 1), cA, 1, gA);
    if (wr == 1) PG8_BAR;
    PG8_WAIT_V(2); PG8_BAR;
    PG8_STAGEB(PG8_SB(1, 0), cB + kstep); PG8_STAGEA(PG8_SA(1, 0), cA + kstep, 0, gA); PG8_STAGEB(PG8_SB(1, 1), cB + hstepB + kstep);
    PG8_WAIT_V(6); PG8_BAR;
    for (;;) {
        const bool has_next = S.next(ui + 1, nxt);
        const char* nA = has_next ? S.aptr(nxt) : cA; const char* nB = has_next ? S.bptr(nxt) : cB;
        if constexpr (GATHER) { if (has_next) S.gather(nxt, tid, gN); else {
#pragma unroll
            for (int h = 0; h < 2; ++h)
#pragma unroll
                for (int i = 0; i < 2; ++i) gN[h][i] = gA[h][i]; } }
#pragma nounroll
        for (int t = 0; t < nt; t += 2) {
            const bool last = (t == nt - 2);
            const char* a1 = cA + (size_t)(t + 1) * kstep;
            const char* a2 = last ? nA : cA + (size_t)(t + 2) * kstep; const char* b2 = last ? nB : cB + (size_t)(t + 2) * kstep;
            const char* a3 = a2 + kstep; const char* b3 = b2 + kstep;
            unsigned g2[2][2];
            if constexpr (GATHER) {
#pragma unroll
                for (int h = 0; h < 2; ++h)
#pragma unroll
                    for (int i = 0; i < 2; ++i) g2[h][i] = last ? gN[h][i] : gA[h][i]; }
            PG8_LDB(B0, 0, 0); PG8_LDB(B1, 0, 1); PG8_SCHED; PG8_LDA(At, 0, 0); PG8_STAGEA(PG8_SA(1, 1), a1, 1, gA);
            PG8_WAIT_V(8); PG8_WAIT_L(0); PG8_BAR; PG8_MMA(0, 0, At, B0); PG8_MMA(0, 1, At, B1); PG8_BAR; PG8_SCHED;
            PG8_LDA(At, 0, 1); PG8_STAGEB(PG8_SB(0, 0), b2); PG8_STAGEB(PG8_SB(0, 1), b2 + hstepB); PG8_STAGEA(PG8_SA(0, 0), a2, 0, g2);
            PG8_WAIT_V(8); PG8_WAIT_L(0); PG8_BAR; PG8_MMA(1, 0, At, B0); PG8_MMA(1, 1, At, B1); PG8_BAR; PG8_SCHED;
            PG8_LDB(B0, 1, 0); PG8_LDB(B1, 1, 1); PG8_SCHED; PG8_LDA(At, 1, 0); PG8_STAGEA(PG8_SA(0, 1), a2, 1, g2);
            PG8_WAIT_V(8); PG8_WAIT_L(0); PG8_BAR; PG8_MMA(0, 0, At, B0); PG8_MMA(0, 1, At, B1); PG8_BAR; PG8_SCHED;
            PG8_LDA(At, 1, 1); PG8_STAGEB(PG8_SB(1, 0), b3); PG8_STAGEB(PG8_SB(1, 1), b3 + hstepB); PG8_STAGEA(PG8_SA(1, 0), a3, 0, g2);
            PG8_WAIT_V(8); PG8_WAIT_L(0); PG8_BAR; PG8_MMA(1, 0, At, B0); PG8_MMA(1, 1, At, B1); PG8_BAR; PG8_SCHED;
        }
        if (wr == 0) PG8_BAR;
        E(acc, cur, wr, wc, fr, fq);
        if (!has_next) break;
#pragma unroll
        for (int a = 0; a < 2; ++a)
#pragma unroll
            for (int b = 0; b < 2; ++b)
#pragma unroll
                for (int m = 0; m < 4; ++m)
#pragma unroll
                    for (int n = 0; n < 2; ++n) acc[a][b][m][n] = (f32x4){0.f, 0.f, 0.f, 0.f};
        cur = nxt; cA = nA; cB = nB; ++ui;
        if constexpr (GATHER) {
#pragma unroll
            for (int h = 0; h < 2; ++h)
#pragma unroll
                for (int i = 0; i < 2; ++i) gA[h][i] = gN[h][i]; }
        if (wr == 1) PG8_BAR;
    }
    PG8_WAIT_V(0);
    PG8_BAR;
#undef PG8_SA
#undef PG8_SB
#undef PG8_STAGEA
#undef PG8_STAGEB
#undef PG8_LDA
#undef PG8_LDB
#undef PG8_MMA
#undef PG8_WAIT_V
#undef PG8_WAIT_L
#undef PG8_BAR
#undef PG8_SCHED
}
}
using pg8::Unit;

__device__ __forceinline__ void set_desc(LAS unsigned char* lds, int tid, int g, const void* A, const void* B, const void* C, int nN, int ldc, int aux, const void* X1 = nullptr, const void* X2 = nullptr, const void* X3 = nullptr) {
    LAS int* d = (LAS int*)(lds + LDS_DESC) + g * 16;
    if (tid == 0) { unsigned long long a = (unsigned long long)A, b = (unsigned long long)B, c = (unsigned long long)C, x1 = (unsigned long long)X1, x2 = (unsigned long long)X2, x3 = (unsigned long long)X3;
        asm volatile("" : "+s"(a), "+s"(b), "+s"(c), "+s"(x1), "+s"(x2), "+s"(x3), "+s"(nN), "+s"(ldc), "+s"(aux));
        d[0] = (int)(unsigned)a; d[1] = (int)(unsigned)(a >> 32); d[2] = (int)(unsigned)b; d[3] = (int)(unsigned)(b >> 32); d[4] = (int)(unsigned)c; d[5] = (int)(unsigned)(c >> 32); d[6] = nN; d[7] = ldc; d[8] = aux;
        d[10] = (int)(unsigned)x1; d[11] = (int)(unsigned)(x1 >> 32); d[12] = (int)(unsigned)x2; d[13] = (int)(unsigned)(x2 >> 32); d[14] = (int)(unsigned)x3; d[15] = (int)(unsigned)(x3 >> 32); }
}
__device__ __forceinline__ int desc_i(LAS unsigned char* lds, int g, int f) { return __builtin_amdgcn_readfirstlane(((LAS const int*)(lds + LDS_DESC))[g * 16 + f]); }
__device__ __forceinline__ const char* desc_p(LAS unsigned char* lds, int g, int f) {
    const unsigned lo = (unsigned)desc_i(lds, g, f), hi = (unsigned)desc_i(lds, g, f + 1); return (const char*)(((unsigned long long)hi << 32) | lo); }
template <int LDA, int LDB>
struct SchedMulti {
    LAS unsigned char* lds; int nM, ntot, ng;
    __device__ __forceinline__ bool next(int i, Unit& u) const {
        const int nwg = nM * ntot; const long L = (long)i * gridDim.x + blockIdx.x; if (L >= nwg) return false;
        const int wgid = pg8::xcd_remap((int)L, nwg);
        const int nig = pg8::WGM * ntot, gid = wgid / nig, fm = gid * pg8::WGM, gsz = (nM - fm) < pg8::WGM ? (nM - fm) : pg8::WGM;
        u.pm = fm + ((wgid % nig) % gsz); int pv = (wgid % nig) / gsz; int g = 0;
        for (int j = 0; j + 1 < ng; ++j) { const int n = desc_i(lds, j, 6); if (pv < n) break; pv -= n; g = j + 1; }
        u.pn = pv; u.aux = g; return true;
    }
    __device__ __forceinline__ const char* aptr(const Unit& u) const { return desc_p(lds, u.aux, 0) + (size_t)u.pm * (512 * LDA); }
    __device__ __forceinline__ const char* bptr(const Unit& u) const { return desc_p(lds, u.aux, 2) + (size_t)u.pn * (512 * LDB); }
};
template <int LDA, int LDB, bool GATHERED>
struct SchedMoE {
    LAS unsigned char* lds; const char* Abase; const char* Bbase; const int* list;
    __device__ __forceinline__ bool next(int i, Unit& u) const {
        LAS const int* tab = (LAS const int*)(lds + LDS_TAB);
        const int nrt = __builtin_amdgcn_readfirstlane(tab[2 * MAXRT + 32]);
        const int nwg = nrt * 4; const long L = (long)i * gridDim.x + blockIdx.x; if (L >= nwg) return false;
        const int wgid = pg8::xcd_remap((int)L, nwg);
        u.pm = wgid >> 2; u.pn = wgid & 3; u.aux = __builtin_amdgcn_readfirstlane(tab[u.pm]); return true;
    }
    __device__ __forceinline__ const char* aptr(const Unit& u) const { return GATHERED ? Abase : Abase + (size_t)u.pm * (512 * LDA); }
    __device__ __forceinline__ const char* bptr(const Unit& u) const { return Bbase + (size_t)u.aux * ((size_t)D * LDB * 2) + (size_t)u.pn * (512 * LDB); }
    __device__ __forceinline__ void gather(const Unit& u, int tid, unsigned (&g)[2][2]) const {
        LAS const int* tab = (LAS const int*)(lds + LDS_TAB);
        const int j0 = __builtin_amdgcn_readfirstlane(tab[MAXRT + u.pm]), cn = __builtin_amdgcn_readfirstlane(tab[2 * MAXRT + u.aux]);
#pragma unroll
        for (int i = 0; i < 2; ++i) { int R, C; pg8::stage_rc(tid * 16 + i * 8192, R, C);
#pragma unroll
            for (int h = 0; h < 2; ++h) { const int slot = j0 + 128 * h + R; const int a = slot < cn ? list[(size_t)u.aux * LISTCAP + slot] : 0;
                g[h][i] = (unsigned)((a >> 1) * LDA + C) * 2u; } }
    }
};
__device__ __forceinline__ void moe_tables(LAS unsigned char* lds, int tid, const unsigned* cnt) {
    LAS int* tab = (LAS int*)(lds + LDS_TAB);
    __syncthreads();
    if (tid < 64) {
        const int e = tid & 31; const bool act = tid < NE;
        const int c = act ? (int)__hip_atomic_load(cnt + e, __ATOMIC_RELAXED, __HIP_MEMORY_SCOPE_AGENT) : 0;
        const int nt = (c + 255) >> 8; int incl = nt;
#pragma unroll
        for (int d = 1; d < 32; d <<= 1) { const int t = __builtin_amdgcn_ds_bpermute((tid >= d ? tid - d : tid) << 2, incl); if (tid >= d) incl += t; }
        if (act) { const int start = incl - nt; tab[2 * MAXRT + e] = c;
#pragma nounroll
            for (int j = 0; j < nt; ++j) { tab[start + j] = e; tab[MAXRT + start + j] = j * 256; }
            if (tid == NE - 1) tab[2 * MAXRT + 32] = incl; }
    }
    __syncthreads();
}

#define EPI_FENCE() asm volatile("" ::: "memory")
struct EpiGelu {
    static constexpr bool PERM = true;
    LAS unsigned char* lds;
    __device__ __forceinline__ void operator()(const f32x4 (&acc)[2][2][4][2], const Unit& u, int wr, int wc, int fr, int fq) const {
        const bool isv = u.pn >= 8; bf16_t* base = (bf16_t*)desc_p(lds, 0, isv ? 10 : 4); const float* bias = (const float*)desc_p(lds, 0, 12); float* stat = (float*)desc_p(lds, 0, 14);
        const int col0 = (u.pn & 7) * 256 + wc * 32 + 8 * fq, bcol0 = u.pn * 256 + wc * 32 + 8 * fq, row0 = u.pm * 256 + wr * 64 + fr;
        f32x4 bv[2][2];
#pragma unroll
        for (int bj = 0; bj < 2; ++bj)
#pragma unroll
            for (int n = 0; n < 2; ++n) bv[bj][n] = *(const f32x4*)(bias + bcol0 + bj * 128 + 4 * n);
#pragma unroll
        for (int ai = 0; ai < 2; ++ai)
#pragma unroll
            for (int m = 0; m < 4; ++m) { const int row = row0 + ai * 128 + m * 16; bf16_t* rowp = base + (size_t)row * GWID + col0; float s = 0.f, q = 0.f;
#pragma unroll
                for (int bj = 0; bj < 2; ++bj) { const f32x4 v0 = acc[ai][bj][m][0] + bv[bj][0], v1 = acc[ai][bj][m][1] + bv[bj][1];
                    const f32x2 a = gelu_pk((f32x2){v0[0], v0[1]}), b = gelu_pk((f32x2){v0[2], v0[3]}), c = gelu_pk((f32x2){v1[0], v1[1]}), d = gelu_pk((f32x2){v1[2], v1[3]});
                    s += ((a.x + a.y) + (b.x + b.y)) + ((c.x + c.y) + (d.x + d.y));
                    q += ((a.x * a.x + a.y * a.y) + (b.x * b.x + b.y * b.y)) + ((c.x * c.x + c.y * c.y) + (d.x * d.x + d.y * d.y));
                    u32x4 w; w.x = cvt_pk_bf16(a.x, a.y); w.y = cvt_pk_bf16(b.x, b.y); w.z = cvt_pk_bf16(c.x, c.y); w.w = cvt_pk_bf16(d.x, d.y);
                    *(u32x4*)(rowp + bj * 128) = w; }
                if (isv) { const int ln_ = 16 * fq + fr; s += shx(s, 16, ln_); s += shx(s, 32, ln_); q += shx(q, 16, ln_); q += shx(q, 32, ln_);
                    if (fq == 0) *(f32x2*)(stat + ((size_t)row * 32 + (u.pn - 8) * 4 + wc) * 2) = (f32x2){s, q}; } }
    }
};
struct EpiResid {
    static constexpr bool PERM = true;
    LAS unsigned char* lds;
    __device__ __forceinline__ void operator()(const f32x4 (&acc)[2][2][4][2], const Unit& u, int wr, int wc, int fr, int fq) const {
        const int mrow = u.pm < 64 ? 0 : (u.pm < 128 ? 1 : 2);
        bf16_t* x = (bf16_t*)desc_p(lds, 0, 4) + (size_t)(u.pm * 256 + wr * 64 + fr) * D + u.pn * 256 + wc * 32 + 8 * fq;
        const float* bias = (const float*)desc_p(lds, 0, 14); const float* gate = (const float*)desc_p(lds, 1, 10) + mrow * 6 * D + u.pn * 256 + wc * 32 + 8 * fq;
        if (bias) bias += u.pn * 256 + wc * 32 + 8 * fq;
#pragma unroll
        for (int bj = 0; bj < 2; ++bj) {
#pragma unroll
            for (int n = 0; n < 2; ++n) { const int c = bj * 128 + 4 * n;
                const f32x4 b0 = bias ? *(const f32x4*)(bias + c) : (f32x4){0.f, 0.f, 0.f, 0.f};
                const f32x4 g0 = *(const f32x4*)(gate + c);
#pragma unroll
                for (int ai = 0; ai < 2; ++ai) {
#pragma unroll
                    for (int m = 0; m < 4; ++m) { bf16_t* p = x + (size_t)(ai * 128 + m * 16) * D + c;
                        const u32x2 w = *(const u32x2*)p; const f32x4 x0 = (f32x4){bf_lo(w.x), bf_hi(w.x), bf_lo(w.y), bf_hi(w.y)};
                        const f32x4 o0 = x0 + g0 * (acc[ai][bj][m][n] + b0);
                        u32x2 w2; w2.x = cvt_pk_bf16(o0[0], o0[1]); w2.y = cvt_pk_bf16(o0[2], o0[3]);
                        *(u32x2*)p = w2; }
                    EPI_FENCE(); } } }
    }
};
template <int K>
__device__ __forceinline__ void tail_resid(LAS unsigned char* lds, int wave) {
    const int lane = lane_id_now(), fr = lane & 15, q = lane >> 4, tid = wave * 64 + lane;
    constexpr int KW = K / 8, RP = 68;
    LAS float* red = (LAS float*)lds;
    const bf16_t* A = (const bf16_t*)desc_p(lds, 0, 0) + (size_t)TL * K; const bf16_t* W = (const bf16_t*)desc_p(lds, 0, 2);
    bf16_t* X = (bf16_t*)desc_p(lds, 0, 4) + (size_t)TL * D; const float* bias = (const float*)desc_p(lds, 0, 14); const float* gate = (const float*)desc_p(lds, 1, 10) + 2 * 6 * D;
    for (int item = blockIdx.x; item < TC / 16 * 16; item += gridDim.x) {
        const int r0 = (item >> 4) * 16, c0 = (item & 15) * 64;
        const bf16_t* ap = A + (size_t)(r0 + fr) * K + wave * KW + 16 * q;
        const bf16_t* bp = W + (size_t)(c0 + fr) * K + wave * KW + 16 * q;
        f32x4 acc[4];
#pragma unroll
        for (int n = 0; n < 4; ++n) acc[n] = (f32x4){0.f, 0.f, 0.f, 0.f};
#pragma unroll
        for (int kb = 0; kb < KW / 64; ++kb) {
            const bf16x8 a0 = *(const bf16x8*)(ap + kb * 64), a1 = *(const bf16x8*)(ap + kb * 64 + 8);
#pragma unroll
            for (int n = 0; n < 4; ++n) { const bf16x8 b0 = *(const bf16x8*)(bp + (size_t)n * 16 * K + kb * 64), b1 = *(const bf16x8*)(bp + (size_t)n * 16 * K + kb * 64 + 8);
                acc[n] = __builtin_amdgcn_mfma_f32_16x16x32_bf16(a0, b0, acc[n], 0, 0, 0); acc[n] = __builtin_amdgcn_mfma_f32_16x16x32_bf16(a1, b1, acc[n], 0, 0, 0); }
        }
#pragma unroll
        for (int n = 0; n < 4; ++n)
#pragma unroll
            for (int r = 0; r < 4; ++r) red[(wave * 16 + 4 * q + r) * RP + n * 16 + fr] = acc[n][r];
        __syncthreads();
        { const int row = tid >> 5, c2 = 2 * (tid & 31); float s0 = 0.f, s1 = 0.f;
#pragma unroll
          for (int w = 0; w < 8; ++w) { const f32x2 v = *(LAS const f32x2*)(red + (w * 16 + row) * RP + c2); s0 += v.x; s1 += v.y; }
          const int col = c0 + c2; bf16_t* p = X + (size_t)(r0 + row) * D + col; const unsigned xw = *(const unsigned*)p;
          const float b0 = bias ? bias[col] : 0.f, b1 = bias ? bias[col + 1] : 0.f;
          *(unsigned*)p = cvt_pk_bf16(bf_lo(xw) + gate[col] * (s0 + b0), bf_hi(xw) + gate[col + 1] * (s1 + b1)); }
        __syncthreads();
    }
}
__device__ __forceinline__ void tail_gelu(LAS unsigned char* lds, int wave) {
    const int lane = lane_id_now(), fr = lane & 15, q = lane >> 4, tid = wave * 64 + lane;
    constexpr int K = D, KW = K / 8, RP = 260;
    LAS float* red = (LAS float*)lds;
    const bf16_t* A = (const bf16_t*)desc_p(lds, 0, 0) + (size_t)TL * K; const bf16_t* W = (const bf16_t*)desc_p(lds, 0, 2);
    const float* bias = (const float*)desc_p(lds, 0, 12); float* stat = (float*)desc_p(lds, 0, 14);
    for (int item = blockIdx.x; item < TC / 16 * 16; item += gridDim.x) {
        const int r0 = (item >> 4) * 16, c0 = (item & 15) * 256;
        const bf16_t* ap = A + (size_t)(r0 + fr) * K + wave * KW + 16 * q;
        const bf16_t* bp = W + (size_t)(c0 + fr) * K + wave * KW + 16 * q;
        const bf16x8 a0 = *(const bf16x8*)(ap), a1 = *(const bf16x8*)(ap + 8), a2 = *(const bf16x8*)(ap + 64), a3 = *(const bf16x8*)(ap + 72);
#pragma unroll 1
        for (int ng = 0; ng < 4; ++ng) {
            f32x4 acc[4];
#pragma unroll
            for (int n = 0; n < 4; ++n) { const bf16_t* b = bp + (size_t)(ng * 4 + n) * 16 * K;
                const bf16x8 b0 = *(const bf16x8*)(b), b1 = *(const bf16x8*)(b + 8), b2 = *(const bf16x8*)(b + 64), b3 = *(const bf16x8*)(b + 72);
                f32x4 c = (f32x4){0.f, 0.f, 0.f, 0.f};
                c = __builtin_amdgcn_mfma_f32_16x16x32_bf16(a0, b0, c, 0, 0, 0); c = __builtin_amdgcn_mfma_f32_16x16x32_bf16(a1, b1, c, 0, 0, 0);
                c = __builtin_amdgcn_mfma_f32_16x16x32_bf16(a2, b2, c, 0, 0, 0); c = __builtin_amdgcn_mfma_f32_16x16x32_bf16(a3, b3, c, 0, 0, 0); acc[n] = c; }
#pragma unroll
            for (int n = 0; n < 4; ++n)
#pragma unroll
                for (int r = 0; r < 4; ++r) red[(wave * 16 + 4 * q + r) * RP + (ng * 4 + n) * 16 + fr] = acc[n][r];
        }
        __syncthreads();
        { const int row = tid >> 5, c8 = 8 * (tid & 31); f32x4 s0 = (f32x4){0.f, 0.f, 0.f, 0.f}, s1 = s0;
#pragma unroll
          for (int w = 0; w < 8; ++w) { s0 += *(LAS const f32x4*)(red + (w * 16 + row) * RP + c8); s1 += *(LAS const f32x4*)(red + (w * 16 + row) * RP + c8 + 4); }
          const int col = c0 + c8; const bool isv = col >= GWID; bf16_t* base = (bf16_t*)desc_p(lds, 0, isv ? 10 : 4);
          s0 += *(const f32x4*)(bias + col); s1 += *(const f32x4*)(bias + col + 4);
          const f32x2 a = gelu_pk((f32x2){s0[0], s0[1]}), b = gelu_pk((f32x2){s0[2], s0[3]}), c = gelu_pk((f32x2){s1[0], s1[1]}), d = gelu_pk((f32x2){s1[2], s1[3]});
          u32x4 w; w.x = cvt_pk_bf16(a.x, a.y); w.y = cvt_pk_bf16(b.x, b.y); w.z = cvt_pk_bf16(c.x, c.y); w.w = cvt_pk_bf16(d.x, d.y);
          *(u32x4*)(base + (size_t)(TL + r0 + row) * GWID + (col & (GWID - 1))) = w;
          if (isv) { float s = ((a.x + a.y) + (b.x + b.y)) + ((c.x + c.y) + (d.x + d.y)), qq = ((a.x * a.x + a.y * a.y) + (b.x * b.x + b.y * b.y)) + ((c.x * c.x + c.y * c.y) + (d.x * d.x + d.y * d.y));
              s += shx(s, 1, lane); s += shx(s, 2, lane); s += shx(s, 4, lane); qq += shx(qq, 1, lane); qq += shx(qq, 2, lane); qq += shx(qq, 4, lane);
              if ((lane & 7) == 0) *(f32x2*)(stat + ((size_t)(TL + r0 + row) * 32 + ((col - GWID) >> 6)) * 2) = (f32x2){s, qq}; } }
        __syncthreads();
    }
}
struct EpiAct {
    static constexpr bool PERM = true;
    LAS unsigned char* lds;
    __device__ __forceinline__ void operator()(const f32x4 (&acc)[2][2][4][2], const Unit& u, int wr, int wc, int fr, int fq) const {
        bf16_t* C = (bf16_t*)desc_p(lds, u.aux, 4); const int ldc = desc_i(lds, u.aux, 7), act = desc_i(lds, u.aux, 8);
        const int col0 = u.pn * 256 + wc * 32 + 8 * fq, row0 = u.pm * 256 + wr * 64 + fr;
#pragma unroll
        for (int ai = 0; ai < 2; ++ai)
#pragma unroll
            for (int m = 0; m < 4; ++m) { bf16_t* rowp = C + (size_t)(row0 + ai * 128 + m * 16) * ldc + col0;
#pragma unroll
                for (int bj = 0; bj < 2; ++bj) { f32x4 v0 = acc[ai][bj][m][0], v1 = acc[ai][bj][m][1];
                    if (act == 1) {
#pragma unroll
                        for (int j = 0; j < 4; ++j) { v0[j] = tanhf_(v0[j]); v1[j] = tanhf_(v1[j]); } }
                    else if (act == 2) {
#pragma unroll
                        for (int j = 0; j < 4; ++j) { v0[j] = sigmoidf_(v0[j]); v1[j] = sigmoidf_(v1[j]); } }
                    u32x4 w; w.x = cvt_pk_bf16(v0[0], v0[1]); w.y = cvt_pk_bf16(v0[2], v0[3]); w.z = cvt_pk_bf16(v1[0], v1[1]); w.w = cvt_pk_bf16(v1[2], v1[3]);
                    *(u32x4*)(rowp + bj * 128) = w; } }
    }
};
struct EpiLogits {
    static constexpr bool PERM = false;
    float* LG;
    __device__ __forceinline__ void operator()(const f32x4 (&acc)[2][2][4][2], const Unit& u, int wr, int wc, int fr, int fq) const {
        if (wc >= 2) return;
        const int col0 = wc * 32 + 4 * fq, row0 = u.pm * 256 + wr * 64 + fr;
#pragma unroll
        for (int ai = 0; ai < 2; ++ai)
#pragma unroll
            for (int m = 0; m < 4; ++m)
#pragma unroll
                for (int n = 0; n < 2; ++n) *(f32x4*)(LG + (size_t)(row0 + ai * 128 + m * 16) * 64 + col0 + n * 16) = acc[ai][0][m][n] + acc[ai][1][m][n];
    }
};
struct EpiSiluGate {
    static constexpr bool PERM = true;
    bf16_t* H;
    __device__ __forceinline__ void operator()(const f32x4 (&acc)[2][2][4][2], const Unit& u, int wr, int wc, int fr, int fq) const {
        const int col0 = u.pn * 128 + wc * 32 + 8 * fq, row0 = u.pm * 256 + wr * 64 + fr;
#pragma unroll
        for (int ai = 0; ai < 2; ++ai)
#pragma unroll
            for (int m = 0; m < 4; ++m) { f32x4 h0, h1;
#pragma unroll
                for (int j = 0; j < 4; ++j) { const float g0 = acc[ai][0][m][0][j], g1 = acc[ai][0][m][1][j]; h0[j] = g0 * sigmoidf_(g0) * acc[ai][1][m][0][j]; h1[j] = g1 * sigmoidf_(g1) * acc[ai][1][m][1][j]; }
                u32x4 w; w.x = cvt_pk_bf16(h0[0], h0[1]); w.y = cvt_pk_bf16(h0[2], h0[3]); w.z = cvt_pk_bf16(h1[0], h1[1]); w.w = cvt_pk_bf16(h1[2], h1[3]);
                *(u32x4*)(H + (size_t)(row0 + ai * 128 + m * 16) * EHID + col0) = w; }
    }
};
struct EpiScatter {
    static constexpr bool PERM = true;
    LAS unsigned char* lds; bf16_t* YB; const int* list;
    __device__ __forceinline__ void operator()(const f32x4 (&acc)[2][2][4][2], const Unit& u, int wr, int wc, int fr, int fq) const {
        LAS const int* tab = (LAS const int*)(lds + LDS_TAB);
        const int j0 = __builtin_amdgcn_readfirstlane(tab[MAXRT + u.pm]), cn = __builtin_amdgcn_readfirstlane(tab[2 * MAXRT + u.aux]);
        const int col0 = u.pn * 256 + wc * 32 + 8 * fq;
#pragma unroll
        for (int ai = 0; ai < 2; ++ai)
#pragma unroll
            for (int m = 0; m < 4; ++m) { const int slot = j0 + ai * 128 + wr * 64 + m * 16 + fr;
                if (slot < cn) { const int a = list[(size_t)u.aux * LISTCAP + slot]; bf16_t* rowp = YB + (size_t)a * D + col0;
#pragma unroll
                    for (int bj = 0; bj < 2; ++bj) { const f32x4 v0 = acc[ai][bj][m][0], v1 = acc[ai][bj][m][1];
                        u32x4 w; w.x = cvt_pk_bf16(v0[0], v0[1]); w.y = cvt_pk_bf16(v0[2], v0[3]); w.z = cvt_pk_bf16(v1[0], v1[1]); w.w = cvt_pk_bf16(v1[2], v1[3]);
                        *(u32x4*)(rowp + bj * 128) = w; } } }
    }
};

struct Params { const float* in[42]; float* out; unsigned char* ws; int ph_lo, ph_hi; };
enum { I_X = 0, I_C, I_CTX, I_CCTX, I_ADAW, I_ADAB, I_N1G, I_N2G, I_FG, I_GWIN, I_GBIN, I_GLNG, I_GLNB, I_GWS, I_GBS, I_GWOUT, I_GBOUT,
       I_MU, I_WR, I_WK, I_WV, I_WO, I_W0, I_W1, I_W2, I_A0, I_A1, I_A2, I_G1, I_G2, I_KK, I_KA, I_RK, I_LNG, I_LNB,
       I_MWGRP, I_MBGRP, I_MWEXP, I_MBEXP, I_MWG, I_MWU, I_MWD };
struct Frame { LAS unsigned char* lds; int tid, lane, wave, G, gw, NGW; };
typedef const __attribute__((address_space(4))) Params* KP;

constexpr int TRP = 36, TR_SCR = 64 * TRP * 4;
__device__ __forceinline__ void tr_item(const float* W, int N, int kmax, bf16_t* WT, int ldk, int k0, int n0, int drow0, int dk0, LAS float* scr, int lane) {
    const int n4 = lane & 7, kr = lane >> 3; f32x4 v[8];
#pragma unroll
    for (int i = 0; i < 8; ++i) { const int k = k0 + 8 * i + kr; v[i] = k < kmax ? *(const f32x4*)(W + (size_t)k * N + n0 + 4 * n4) : (f32x4){0.f, 0.f, 0.f, 0.f}; }
#pragma unroll
    for (int i = 0; i < 8; ++i) *(LAS f32x4*)(scr + (8 * i + kr) * TRP + 4 * n4) = v[i];
    asm volatile("s_waitcnt lgkmcnt(0)" ::: "memory");
    const int c = lane & 7;
#pragma unroll
    for (int j = 0; j < 4; ++j) { const int n = (lane >> 3) + 8 * j; const LAS float* sp = scr + (8 * c) * TRP + n;
        u32x4 o; o.x = cvt_pk_bf16(sp[0 * TRP], sp[1 * TRP]); o.y = cvt_pk_bf16(sp[2 * TRP], sp[3 * TRP]); o.z = cvt_pk_bf16(sp[4 * TRP], sp[5 * TRP]); o.w = cvt_pk_bf16(sp[6 * TRP], sp[7 * TRP]);
        *(u32x4*)(WT + (size_t)(drow0 + n) * ldk + dk0 + k0 + 8 * c) = o; }
    asm volatile("s_waitcnt lgkmcnt(0)" ::: "memory");
}
constexpr int LDS_JOBS = 80 * 1024, MAXJOBS = 48;
__device__ __forceinline__ void add_job(LAS int* jobs, int& nj, int& nit, const float* src, int N, int kmax, int kpad, bf16_t* dst, int ldk, int drow0, int dk0) {
    LAS int* q = jobs + nj * 12; const unsigned long long a = (unsigned long long)src, d = (unsigned long long)dst;
    q[0] = (int)(unsigned)a; q[1] = (int)(unsigned)(a >> 32); q[2] = (int)(unsigned)d; q[3] = (int)(unsigned)(d >> 32); q[4] = N; q[5] = kmax; q[6] = kpad / 64; q[7] = ldk; q[8] = drow0; q[9] = dk0; q[10] = nit;
    nit += (kpad / 64) * (N / 32); ++nj;
}
__device__ __forceinline__ void zero_fill(const Frame& F, bf16_t* p, size_t nbytes) {
    u32x4* q = (u32x4*)p; const size_t n = nbytes / 16;
    for (size_t i = (size_t)blockIdx.x * NTHR + F.tid; i < n; i += (size_t)F.G * NTHR) q[i] = (u32x4){0u, 0u, 0u, 0u};
}

__device__ __forceinline__ void prologue_phase(const Frame& F, KP P) {
    unsigned char* ws = P->ws;
    {   float* MOD = (float*)(ws + WS_MOD); LAS float* part = (LAS float*)F.lds;
        const float* c = P->in[I_C]; const float* cc = P->in[I_CCTX];
        for (int item = blockIdx.x; item < DEPTH * 24; item += F.G) {
            const int layer = item / 24, col = (item % 24) * 256 + 4 * F.lane; const float* w = P->in[I_ADAW] + (size_t)layer * D * 6 * D + col;
            f32x4 a0 = (f32x4){0.f, 0.f, 0.f, 0.f}, a1 = a0, a2 = a0;
#pragma unroll 8
            for (int i = 0; i < 128; ++i) { const int d = F.wave + 8 * i; const f32x4 wv = *(const f32x4*)(w + (size_t)d * 6 * D);
                const float c0 = c[d], c1 = c[D + d], c2 = cc[d];
                a0 += wv * (c0 * sigmoidf_(c0)); a1 += wv * (c1 * sigmoidf_(c1)); a2 += wv * (c2 * sigmoidf_(c2)); }
            __syncthreads();
            *(LAS f32x4*)(part + (F.wave * 3 + 0) * 256 + 4 * F.lane) = a0; *(LAS f32x4*)(part + (F.wave * 3 + 1) * 256 + 4 * F.lane) = a1; *(LAS f32x4*)(part + (F.wave * 3 + 2) * 256 + 4 * F.lane) = a2;
            __syncthreads();
            if (F.wave < 3) { f32x4 sacc = (f32x4){0.f, 0.f, 0.f, 0.f};
#pragma unroll
                for (int w8 = 0; w8 < 8; ++w8) sacc += *(const LAS f32x4*)(part + (w8 * 3 + F.wave) * 256 + 4 * F.lane);
                *(f32x4*)(MOD + ((size_t)layer * 3 + F.wave) * 6 * D + col) = sacc + *(const f32x4*)(P->in[I_ADAB] + (size_t)layer * 6 * D + col); }
        }
    }
    LAS int* jobs = (LAS int*)(F.lds + LDS_JOBS); LAS int* jtot = jobs + MAXJOBS * 12;
    __syncthreads();
    if (F.tid == 0) { int nj = 0, nit = 0;
        for (int j = 0; j < 2; ++j) {
            add_job(jobs, nj, nit, P->in[I_GWIN] + (size_t)j * D * 4096, 4096, D, D, (bf16_t*)(ws + WS_WIN) + (size_t)j * 4096 * D, D, 0, 0);
            add_job(jobs, nj, nit, P->in[I_GWOUT] + (size_t)j * GWID * D, D, GWID, GWID, (bf16_t*)(ws + WS_WOUT) + (size_t)j * D * GWID, GWID, 0, 0);
            add_job(jobs, nj, nit, P->in[I_WR] + (size_t)j * D * D, D, D, D, (bf16_t*)(ws + WS_WR) + (size_t)j * D * D, D, 0, 0);
            add_job(jobs, nj, nit, P->in[I_WK] + (size_t)j * D * D, D, D, D, (bf16_t*)(ws + WS_WK) + (size_t)j * D * D, D, 0, 0);
            add_job(jobs, nj, nit, P->in[I_WV] + (size_t)j * D * D, D, D, D, (bf16_t*)(ws + WS_WV) + (size_t)j * D * D, D, 0, 0);
            add_job(jobs, nj, nit, P->in[I_WO] + (size_t)j * D * D, D, D, D, (bf16_t*)(ws + WS_WO) + (size_t)j * D * D, D, 0, 0);
            for (int z = 0; z < 2; ++z) {
                add_job(jobs, nj, nit, P->in[I_W1] + ((size_t)j * 2 + z) * D * 64, 64, D, D, (bf16_t*)(ws + WS_LW1) + (size_t)j * 256 * D, D, z * 64, 0);
                add_job(jobs, nj, nit, P->in[I_A1] + ((size_t)j * 2 + z) * D * 64, 64, D, D, (bf16_t*)(ws + WS_LA1) + (size_t)j * 256 * D, D, z * 64, 0);
                add_job(jobs, nj, nit, P->in[I_W2] + ((size_t)j * 2 + z) * 64 * D, D, 64, 64, (bf16_t*)(ws + WS_W2P) + ((size_t)j * 2 + z) * D * 256, 256, 0, z * 64);
                add_job(jobs, nj, nit, P->in[I_A2] + ((size_t)j * 2 + z) * 64 * D, D, 64, 64, (bf16_t*)(ws + WS_A2P) + ((size_t)j * 2 + z) * D * 256, 256, 0, z * 64); }
            add_job(jobs, nj, nit, P->in[I_G1] + (size_t)j * D * 160, 160, D, D, (bf16_t*)(ws + WS_LG1) + (size_t)j * 256 * D, D, 0, 0);
            add_job(jobs, nj, nit, P->in[I_G2] + (size_t)j * 160 * D, D, 160, 256, (bf16_t*)(ws + WS_G2P) + (size_t)j * D * 256, 256, 0, 0); }
        jtot[0] = nj; jtot[1] = nit; }
    __syncthreads();
    {   const int nj = jtot[0], nit = jtot[1]; LAS float* scr = (LAS float*)(F.lds + F.wave * TR_SCR);
        for (int it = F.gw; it < nit; it += F.NGW) {
            int jb = 0; for (int q = 1; q < nj; ++q) if (it >= jobs[q * 12 + 10]) jb = q;
            jb = __builtin_amdgcn_readfirstlane(jb); LAS const int* q = jobs + jb * 12;
            const float* src = (const float*)(((unsigned long long)(unsigned)q[1] << 32) | (unsigned)q[0]); bf16_t* dst = (bf16_t*)(((unsigned long long)(unsigned)q[3] << 32) | (unsigned)q[2]);
            const int N = q[4], nnb = N / 32, r = it - q[10], kb = r / nnb, nb = r % nnb;
            tr_item(src, N, q[5], dst, q[7], kb * 64, nb * 32, q[8] + nb * 32, q[9], scr, F.lane); }
    }
    for (int j = 0; j < 2; ++j) {
        bf16_t* lw1 = (bf16_t*)(ws + WS_LW1) + (size_t)j * 256 * D; bf16_t* la1 = (bf16_t*)(ws + WS_LA1) + (size_t)j * 256 * D; bf16_t* lg1 = (bf16_t*)(ws + WS_LG1) + (size_t)j * 256 * D;
        zero_fill(F, lw1 + 128 * D, (size_t)128 * D * 2); zero_fill(F, la1 + 128 * D, (size_t)128 * D * 2); zero_fill(F, lg1 + 160 * D, (size_t)96 * D * 2);
        for (int z = 0; z < 2; ++z) { bf16_t* w2p = (bf16_t*)(ws + WS_W2P) + ((size_t)j * 2 + z) * D * 256; bf16_t* a2p = (bf16_t*)(ws + WS_A2P) + ((size_t)j * 2 + z) * D * 256;
            for (int idx = blockIdx.x * NTHR + F.tid; idx < D * 32; idx += F.G * NTHR) { const int n = idx >> 5, ch = idx & 31;
                if ((ch >> 3) != z) { *(u32x4*)(w2p + (size_t)n * 256 + ch * 8) = (u32x4){0u, 0u, 0u, 0u}; *(u32x4*)(a2p + (size_t)n * 256 + ch * 8) = (u32x4){0u, 0u, 0u, 0u}; } } }
    }
    {   bf16_t* wrt = (bf16_t*)(ws + WS_WRT);
        for (int idx = blockIdx.x * NTHR + F.tid; idx < DEPTH * 256 * (D / 8); idx += F.G * NTHR) { const int k0 = (idx & 127) * 8, n = (idx >> 7) & 255, layer = idx >> 15;
            const int nn = n & 127; const bool lo = n >= 128; float w[8];
#pragma unroll
            for (int e = 0; e < 8; ++e) { float x = 0.f;
                if (nn < 4) x = P->in[I_MWGRP][((size_t)layer * D + k0 + e) * 4 + nn]; else if (nn < 36) x = P->in[I_MWEXP][((size_t)layer * D + k0 + e) * NE + nn - 4];
                const float hi = bf_lo(cvt_pk_bf16(x, 0.f)); w[e] = lo ? x - hi : x; }
            *(u32x4*)(wrt + ((size_t)layer * 256 + n) * D + k0) = pack8(w); } }
    {   const float* src = P->in[I_GWS]; bf16_t* dst = (bf16_t*)(ws + WS_WSP); const int n8 = 2 * 16 * 128 * 128 / 8;
        for (int i = blockIdx.x * NTHR + F.tid; i < n8; i += F.G * NTHR) { const f32x4 a = *(const f32x4*)(src + (size_t)i * 8), b = *(const f32x4*)(src + (size_t)i * 8 + 4);
            u32x4 o; o.x = cvt_pk_bf16(a[0], a[1]); o.y = cvt_pk_bf16(a[2], a[3]); o.z = cvt_pk_bf16(b[0], b[1]); o.w = cvt_pk_bf16(b[2], b[3]); *(u32x4*)(dst + (size_t)i * 8) = o; } }
}
struct MoeItem { const float* src; bf16_t* dst; int N, kmax, ldk, k0, n0, drow0; };
__device__ __forceinline__ MoeItem moe_item(KP P, unsigned char* ws, int layer, int it) {
    const int e = it / 768, r = it % 768, m = r >> 8, q = r & 255; const size_t so = ((size_t)layer * NE + e) * (size_t)D * EHID; MoeItem I;
    if (m < 2) { const int kb = q >> 4, n0 = (q & 15) * 32;
        I.src = (m == 0 ? P->in[I_MWG] : P->in[I_MWU]) + so; I.N = EHID; I.kmax = D; I.dst = (bf16_t*)(ws + WS_WGU) + (size_t)e * D * D; I.ldk = D; I.k0 = kb * 64; I.n0 = n0; I.drow0 = 256 * (n0 >> 7) + (n0 & 127) + (m == 1 ? 128 : 0); }
    else { const int kb = q >> 5, n0 = (q & 31) * 32;
        I.src = P->in[I_MWD] + so; I.N = D; I.kmax = EHID; I.dst = (bf16_t*)(ws + WS_WD) + (size_t)e * D * EHID; I.ldk = EHID; I.k0 = kb * 64; I.n0 = n0; I.drow0 = n0; }
    return I;
}
__device__ __forceinline__ void tr_load(const MoeItem& I, int lane, f32x4 (&v)[8]) {
    const int n4 = lane & 7, kr = lane >> 3;
#pragma unroll
    for (int i = 0; i < 8; ++i) v[i] = *(const f32x4*)(I.src + (size_t)(I.k0 + 8 * i + kr) * I.N + I.n0 + 4 * n4);
}
__device__ __forceinline__ void tr_store(const MoeItem& I, int lane, const f32x4 (&v)[8], LAS float* scr) {
    const int n4 = lane & 7, kr = lane >> 3;
#pragma unroll
    for (int i = 0; i < 8; ++i) *(LAS f32x4*)(scr + (8 * i + kr) * TRP + 4 * n4) = v[i];
    asm volatile("s_waitcnt lgkmcnt(0)" ::: "memory");
    const int c = lane & 7;
#pragma unroll
    for (int j = 0; j < 4; ++j) { const int n = (lane >> 3) + 8 * j; const LAS float* sp = scr + (8 * c) * TRP + n;
        u32x4 o; o.x = cvt_pk_bf16(sp[0 * TRP], sp[1 * TRP]); o.y = cvt_pk_bf16(sp[2 * TRP], sp[3 * TRP]); o.z = cvt_pk_bf16(sp[4 * TRP], sp[5 * TRP]); o.w = cvt_pk_bf16(sp[6 * TRP], sp[7 * TRP]);
        *(u32x4*)(I.dst + (size_t)(I.drow0 + n) * I.ldk + I.k0 + 8 * c) = o; }
    asm volatile("s_waitcnt lgkmcnt(0)" ::: "memory");
}
constexpr int MOE_ITEMS = NE * 768, MOE_SPLIT = 14336;
__device__ __forceinline__ void moe_weights_phase(const Frame& F, KP P, int layer, int vgw, int vngw, int it0, int it1) {
    unsigned char* ws = P->ws; LAS float* scr = (LAS float*)(F.lds + F.wave * TR_SCR);
    int it = it0 + vgw; f32x4 v[8], vn[8];
    if (it < it1) { const MoeItem I = moe_item(P, ws, layer, it); tr_load(I, F.lane, v); }
#pragma nounroll
    while (it < it1) { const int nx = it + vngw;
        if (nx < it1) { const MoeItem In = moe_item(P, ws, layer, nx); tr_load(In, F.lane, vn); }
        { const MoeItem I = moe_item(P, ws, layer, it); tr_store(I, F.lane, v, scr); }
#pragma unroll
        for (int i = 0; i < 8; ++i) v[i] = vn[i];
        it = nx; }
}

__device__ __forceinline__ void load_xrow(KP P, const Frame& F, int layer, int row, f32x4 (&v)[4]) {
    if (layer == 0) { const float* xr = row < TL ? P->in[I_X] + (size_t)row * D : P->in[I_CTX] + (size_t)(row - TL) * D;
#pragma unroll
        for (int j = 0; j < 4; ++j) v[j] = *(const f32x4*)(xr + 4 * F.lane + 256 * j); }
    else { const bf16_t* xr = (const bf16_t*)(P->ws + WS_X) + (size_t)row * D;
#pragma unroll
        for (int j = 0; j < 4; ++j) { const u32x2 w = *(const u32x2*)(xr + 4 * F.lane + 256 * j); v[j] = (f32x4){bf_lo(w.x), bf_hi(w.x), bf_lo(w.y), bf_hi(w.y)}; } }
}
__device__ __forceinline__ void load_vec4(const float* p, int lane, f32x4 (&r)[4]) {
#pragma unroll
    for (int j = 0; j < 4; ++j) r[j] = *(const f32x4*)(p + 4 * lane + 256 * j);
}
__device__ __forceinline__ void load_combine(KP P, const Frame& F, int layer, int row, bool combine, const f32x4 (&g2r)[4], f32x4 (&v)[4]) {
    load_xrow(P, F, layer, row, v);
    if (combine) {
        const bf16_t* yb = (const bf16_t*)(P->ws + WS_YB); const float* wg = (const float*)(P->ws + WS_WGT);
        const float w0 = wg[2 * row], w1 = wg[2 * row + 1];
#pragma unroll
        for (int j = 0; j < 4; ++j) { const int col = 4 * F.lane + 256 * j; const u32x2 a = *(const u32x2*)(yb + (size_t)(2 * row) * D + col), b = *(const u32x2*)(yb + (size_t)(2 * row + 1) * D + col);
            const f32x4 g = g2r[j];
            v[j][0] += g[0] * (w0 * bf_lo(a.x) + w1 * bf_lo(b.x)); v[j][1] += g[1] * (w0 * bf_hi(a.x) + w1 * bf_hi(b.x));
            v[j][2] += g[2] * (w0 * bf_lo(a.y) + w1 * bf_lo(b.y)); v[j][3] += g[3] * (w0 * bf_hi(a.y) + w1 * bf_hi(b.y)); }
    }
}
__device__ __forceinline__ void norm1_phase(const Frame& F, KP P, int layer) {
    const bool combine = layer > 0; bf16_t* X = (bf16_t*)(P->ws + WS_X); bf16_t* HL = (bf16_t*)(P->ws + WS_HL);
    f32x4 g1r[4], shr[4], scr[4], g2r[4]; load_vec4(P->in[I_N1G] + (size_t)layer * D, F.lane, g1r); int mc = -1;
#pragma unroll
    for (int j = 0; j < 4; ++j) { shr[j] = (f32x4){0.f, 0.f, 0.f, 0.f}; scr[j] = shr[j]; g2r[j] = shr[j]; }
    for (int row = F.gw; row < T; row += F.NGW) {
        const int m = row < TL ? (row >> 14) : 2; f32x4 v[4];
        if (m != mc) { mc = m; const float* mod = (const float*)(P->ws + WS_MOD) + ((size_t)layer * 3 + m) * 6 * D; load_vec4(mod, F.lane, shr); load_vec4(mod + D, F.lane, scr);
            if (combine) load_vec4((const float*)(P->ws + WS_MOD) + ((size_t)(layer - 1) * 3 + m) * 6 * D + 5 * D, F.lane, g2r); }
        load_combine(P, F, layer, row, combine, g2r, v);
        {
#pragma unroll
            for (int j = 0; j < 4; ++j) { u32x2 o; o.x = cvt_pk_bf16(v[j][0], v[j][1]); o.y = cvt_pk_bf16(v[j][2], v[j][3]); *(u32x2*)(X + (size_t)row * D + 4 * F.lane + 256 * j) = o;
                v[j] = (f32x4){bf_lo(o.x), bf_hi(o.x), bf_lo(o.y), bf_hi(o.y)}; } }
        float ss = 0.f;
#pragma unroll
        for (int j = 0; j < 4; ++j) ss += (v[j][0] * v[j][0] + v[j][1] * v[j][1]) + (v[j][2] * v[j][2] + v[j][3] * v[j][3]);
        const float rstd = rsqrtf(wave_sum(ss, F.lane) * (1.0f / D) + 1e-6f);
#pragma unroll
        for (int j = 0; j < 4; ++j) { const int col = 4 * F.lane + 256 * j;
            const f32x4 h = (v[j] * rstd) * g1r[j] * (scr[j] + 1.0f) + shr[j];
            u32x2 o; o.x = cvt_pk_bf16(h[0], h[1]); o.y = cvt_pk_bf16(h[2], h[3]); *(u32x2*)(HL + (size_t)row * D + col) = o; }
    }
}
__device__ __forceinline__ void final_phase(const Frame& F, KP P) {
    f32x4 fgr[4], g2r[4]; load_vec4(P->in[I_FG], F.lane, fgr); int mc = -1;
#pragma unroll
    for (int j = 0; j < 4; ++j) g2r[j] = (f32x4){0.f, 0.f, 0.f, 0.f};
    for (int row = F.gw; row < TL; row += F.NGW) {
        const int m = row >> 14; f32x4 v[4];
        if (m != mc) { mc = m; load_vec4((const float*)(P->ws + WS_MOD) + ((size_t)(DEPTH - 1) * 3 + m) * 6 * D + 5 * D, F.lane, g2r); }
        load_combine(P, F, DEPTH, row, true, g2r, v);
        float ss = 0.f;
#pragma unroll
        for (int j = 0; j < 4; ++j) ss += (v[j][0] * v[j][0] + v[j][1] * v[j][1]) + (v[j][2] * v[j][2] + v[j][3] * v[j][3]);
        const float rstd = rsqrtf(wave_sum(ss, F.lane) * (1.0f / D) + 1e-6f);
#pragma unroll
        for (int j = 0; j < 4; ++j) { const int col = 4 * F.lane + 256 * j; *(f32x4*)(P->out + (size_t)row * D + col) = (v[j] * rstd) * fgr[j]; }
    }
}
__device__ __forceinline__ void norm2_phase(const Frame& F, KP P, int layer) {
    const int ntok = layer == DEPTH - 1 ? TL : T; bf16_t* HL2 = (bf16_t*)(P->ws + WS_HL);
    f32x4 gr[4], shr[4], scr[4]; load_vec4(P->in[I_N2G] + (size_t)layer * D, F.lane, gr); int mc = -1;
#pragma unroll
    for (int j = 0; j < 4; ++j) { shr[j] = (f32x4){0.f, 0.f, 0.f, 0.f}; scr[j] = shr[j]; }
    for (int row = F.gw; row < ntok; row += F.NGW) {
        const int m = row < TL ? (row >> 14) : 2; f32x4 v[4]; load_xrow(P, F, 1, row, v);
        if (m != mc) { mc = m; const float* mod = (const float*)(P->ws + WS_MOD) + ((size_t)layer * 3 + m) * 6 * D; load_vec4(mod + 3 * D, F.lane, shr); load_vec4(mod + 4 * D, F.lane, scr); }
        float ss = 0.f;
#pragma unroll
        for (int j = 0; j < 4; ++j) ss += (v[j][0] * v[j][0] + v[j][1] * v[j][1]) + (v[j][2] * v[j][2] + v[j][3] * v[j][3]);
        const float rstd = rsqrtf(wave_sum(ss, F.lane) * (1.0f / D) + 1e-6f);
#pragma unroll
        for (int j = 0; j < 4; ++j) { const int col = 4 * F.lane + 256 * j;
            const f32x4 h = (v[j] * rstd) * gr[j] * (scr[j] + 1.0f) + shr[j];
            u32x2 o; o.x = cvt_pk_bf16(h[0], h[1]); o.y = cvt_pk_bf16(h[2], h[3]); *(u32x2*)(HL2 + (size_t)row * D + col) = o; }
    }
    if (!(layer & 1)) moe_weights_phase(F, P, layer, F.gw, F.NGW, 0, MOE_SPLIT);
}
__device__ __forceinline__ void route_phase(const Frame& F, KP P, int layer) {
    const int ntok = layer == DEPTH - 1 ? TL : T; const float* LG = (const float*)(P->ws + WS_LG);
    const float* bgrp = P->in[I_MBGRP] + layer * 4; const float* bexp = P->in[I_MBEXP] + layer * NE;
    unsigned* cnt = (unsigned*)(P->ws + WS_CTL) + CW_CNT + layer * 64; int* list = (int*)(P->ws + WS_LIST); float* wgt = (float*)(P->ws + WS_WGT);
    LAS unsigned* lcnt = (LAS unsigned*)F.lds; LAS unsigned* lbase = lcnt + 32;
    for (int r0 = blockIdx.x * NTHR; r0 < ntok; r0 += F.G * NTHR) {
        const int row = r0 + F.tid; const bool act = row < ntok;
        __syncthreads();
        if (F.tid < 32) lcnt[F.tid] = 0u;
        __syncthreads();
        int e0 = 0, e1 = 0; unsigned k0 = 0, k1 = 0;
        if (act) {
            const float* lg = LG + (size_t)row * 64; const f32x4 g4 = *(const f32x4*)lg;
            float ag[4];
#pragma unroll
            for (int i = 0; i < 4; ++i) ag[i] = g4[i] + bgrp[i];
            int grp = 0; float mx = ag[0];
#pragma unroll
            for (int i = 1; i < 4; ++i) if (ag[i] > mx) { mx = ag[i]; grp = i; }
            float den = 0.f;
#pragma unroll
            for (int i = 0; i < 4; ++i) den += __expf(ag[i] - mx);
            const float pg = 1.0f / den;
            const f32x4 e0v = *(const f32x4*)(lg + 4 + 8 * grp), e1v = *(const f32x4*)(lg + 8 + 8 * grp); const f32x4 b0v = *(const f32x4*)(bexp + 8 * grp), b1v = *(const f32x4*)(bexp + 8 * grp + 4);
            float el[8];
#pragma unroll
            for (int i = 0; i < 4; ++i) { el[i] = e0v[i] + b0v[i]; el[4 + i] = e1v[i] + b1v[i]; }
            int i0 = 0; float t0 = el[0];
#pragma unroll
            for (int i = 1; i < 8; ++i) if (el[i] > t0) { t0 = el[i]; i0 = i; }
            int i1 = -1; float t1 = -3.0e38f;
#pragma unroll
            for (int i = 0; i < 8; ++i) if (i != i0 && el[i] > t1) { t1 = el[i]; i1 = i; }
            const float p0 = 1.0f / (1.0f + __expf(t1 - t0));
            wgt[2 * row] = pg * p0; wgt[2 * row + 1] = pg * (1.0f - p0);
            e0 = grp * 8 + i0; e1 = grp * 8 + i1;
            k0 = atomicAdd((unsigned*)(lcnt + e0), 1u); k1 = atomicAdd((unsigned*)(lcnt + e1), 1u);
        }
        __syncthreads();
        if (F.tid < 32) { const unsigned c = lcnt[F.tid]; lbase[F.tid] = c ? atomicAdd(cnt + F.tid, c) : 0u; }
        __syncthreads();
        if (act) { list[(size_t)e0 * LISTCAP + lbase[e0] + k0] = 2 * row; list[(size_t)e1 * LISTCAP + lbase[e1] + k1] = 2 * row + 1; }
    }
}
__device__ __forceinline__ bf16x8 tr_frag136(const LAS bf16_t* M, int k0, int c0, int lane) {
    LAS bf16_t* p = (LAS bf16_t*)M + (k0 + 8 * (lane >> 4) + ((lane & 15) >> 2)) * 136 + c0 + 4 * (lane & 3);
    const v4s lo = __builtin_amdgcn_ds_read_tr16_b64_v4i16((LAS v4s*)p), hi = __builtin_amdgcn_ds_read_tr16_b64_v4i16((LAS v4s*)(p + 4 * 136));
    return (bf16x8){lo[0], lo[1], lo[2], lo[3], hi[0], hi[1], hi[2], hi[3]};
}
__device__ __forceinline__ bf16x8 tr_frag136p(const LAS bf16_t* M, int k0, int dt, int lane) {
    LAS bf16_t* p = (LAS bf16_t*)M + (k0 + 8 * (lane >> 4) + ((lane & 15) >> 2)) * 136 + 32 * (dt >> 1) + 8 * (lane & 3) + 4 * (dt & 1);
    const v4s lo = __builtin_amdgcn_ds_read_tr16_b64_v4i16((LAS v4s*)p), hi = __builtin_amdgcn_ds_read_tr16_b64_v4i16((LAS v4s*)(p + 4 * 136));
    return (bf16x8){lo[0], lo[1], lo[2], lo[3], hi[0], hi[1], hi[2], hi[3]};
}
__device__ __forceinline__ void spatial_phase(const Frame& F, KP P, int j) {
    bf16_t* U = (bf16_t*)(P->ws + WS_U); const bf16_t* V = (const bf16_t*)(P->ws + WS_V); const float* stat = (const float*)(P->ws + WS_STAT);
    const bf16_t* WSP = (const bf16_t*)(P->ws + WS_WSP) + (size_t)j * 16 * 128 * 128;
    const float* lng = P->in[I_GLNG] + (size_t)j * GWID; const float* lnb = P->in[I_GLNB] + (size_t)j * GWID; const float* bs = P->in[I_GBS] + (size_t)j * 16 * 128;
    LAS bf16_t* Wt = (LAS bf16_t*)F.lds; LAS bf16_t* Vn = Wt + 128 * 136;
    LAS float* mu = (LAS float*)(F.lds + 2 * 128 * 136 * 2); LAS float* rs = mu + 128;
    const int l15 = F.lane & 15, l4 = F.lane >> 4;
    constexpr int NUNIT = (T / 128) * 16;
    const int u0 = (int)((long)blockIdx.x * NUNIT / F.G), u1 = (int)((long)(blockIdx.x + 1) * NUNIT / F.G);
#define SP_LOAD(W_, V_, U_, t0_, g_) do { \
        _Pragma("unroll") for (int i = 0; i < 4; ++i) { const int idx = F.tid + NTHR * i, r = idx >> 4, seg = idx & 15; \
            W_[i] = *(const u32x4*)(WSP + ((size_t)(g_) * 128 + r) * 128 + seg * 8); V_[i] = *(const u32x4*)(V + (size_t)((t0_) + r) * GWID + (g_) * 128 + seg * 8); } \
        { const bf16_t* ur_ = U + (size_t)((t0_) + 16 * F.wave + l15) * GWID + (g_) * 128 + 8 * l4; \
          _Pragma("unroll") for (int e = 0; e < 4; ++e) U_[e] = *(const u32x4*)(ur_ + e * 32); } } while (0)
    u32x4 wv[4], vv[4], uu[4];
    if (u0 < u1) SP_LOAD(wv, vv, uu, (u0 >> 4) * 128, u0 & 15);
    int cprev = -1;
#pragma nounroll
    for (int u = u0; u < u1; ++u) { const int c = u >> 4, g = u & 15, t0 = c * 128;
        if (c != cprev) { cprev = c;
            if (F.tid < 128) { const int row = t0 + F.tid; float s = 0.f, q = 0.f;
#pragma unroll 8
                for (int i = 0; i < 32; ++i) { const f32x2 p = *(const f32x2*)(stat + ((size_t)row * 32 + i) * 2); s += p.x; q += p.y; }
                const float mean = s * (1.0f / GWID), var = q * (1.0f / GWID) - mean * mean; mu[F.tid] = mean; rs[F.tid] = rsqrtf(var + 1e-5f); } }
        LDS_BARRIER();
#pragma unroll
        for (int i = 0; i < 4; ++i) { const int idx = F.tid + NTHR * i, r = idx >> 4, seg = idx & 15, ch = g * 128 + seg * 8;
            *(LAS u32x4*)(Wt + r * 136 + seg * 8) = wv[i];
            float x[8], o[8]; unpack8(vv[i], x); const float m_ = mu[r], r_ = rs[r];
            const f32x4 g0 = *(const f32x4*)(lng + ch), g1 = *(const f32x4*)(lng + ch + 4), b0 = *(const f32x4*)(lnb + ch), b1 = *(const f32x4*)(lnb + ch + 4);
#pragma unroll
            for (int e = 0; e < 8; ++e) o[e] = (x[e] - m_) * r_ * (e < 4 ? g0[e & 3] : g1[e & 3]) + (e < 4 ? b0[e & 3] : b1[e & 3]);
            *(LAS u32x4*)(Vn + r * 136 + seg * 8) = pack8(o); }
        u32x4 wn[4], vn[4], un[4];
        if (u + 1 < u1) SP_LOAD(wn, vn, un, ((u + 1) >> 4) * 128, (u + 1) & 15);
        LDS_BARRIER();
        bf16x8 bw[4];
#pragma unroll
        for (int ks = 0; ks < 4; ++ks) bw[ks] = *(const LAS bf16x8*)(Wt + (16 * F.wave + l15) * 136 + ks * 32 + 8 * l4);
        const int p = 16 * F.wave + l15; const float bias = bs[g * 128 + p];
        bf16_t* urow = U + (size_t)(t0 + p) * GWID + g * 128 + 8 * l4;
#pragma unroll
        for (int e = 0; e < 4; ++e) { f32x4 a0 = (f32x4){0.f, 0.f, 0.f, 0.f}, a1 = a0;
#pragma unroll
            for (int ks = 0; ks < 4; ++ks) { const bf16x8 f0 = tr_frag136p(Vn, 32 * ks, 2 * e, F.lane), f1 = tr_frag136p(Vn, 32 * ks, 2 * e + 1, F.lane);
                a0 = __builtin_amdgcn_mfma_f32_16x16x32_bf16(f0, bw[ks], a0, 0, 0, 0); a1 = __builtin_amdgcn_mfma_f32_16x16x32_bf16(f1, bw[ks], a1, 0, 0, 0); }
            u32x4 o; o.x = cvt_pk_bf16(bf_lo(uu[e].x) * (a0[0] + bias), bf_hi(uu[e].x) * (a0[1] + bias)); o.y = cvt_pk_bf16(bf_lo(uu[e].y) * (a0[2] + bias), bf_hi(uu[e].y) * (a0[3] + bias));
            o.z = cvt_pk_bf16(bf_lo(uu[e].z) * (a1[0] + bias), bf_hi(uu[e].z) * (a1[1] + bias)); o.w = cvt_pk_bf16(bf_lo(uu[e].w) * (a1[2] + bias), bf_hi(uu[e].w) * (a1[3] + bias));
            *(u32x4*)(urow + e * 32) = o; }
        if (u + 1 < u1) {
#pragma unroll
            for (int i = 0; i < 4; ++i) { wv[i] = wn[i]; vv[i] = vn[i]; uu[i] = un[i]; } }
    }
#undef SP_LOAD
}

__device__ __forceinline__ void mix_phase(const Frame& F, KP P, int j) {
    const bf16_t* HL = (const bf16_t*)(P->ws + WS_HL); const float* mu = P->in[I_MU] + (size_t)j * 6 * D;
    bf16_t* outs[6] = {(bf16_t*)(P->ws + WS_XR), (bf16_t*)(P->ws + WS_XW), (bf16_t*)(P->ws + WS_XK), (bf16_t*)(P->ws + WS_XV), (bf16_t*)(P->ws + WS_XA), (bf16_t*)(P->ws + WS_XG)};
    f32x4 mr[2][6][2];
#pragma unroll
    for (int jj = 0; jj < 2; ++jj)
#pragma unroll
        for (int m = 0; m < 6; ++m) { const int col = 512 * jj + 8 * F.lane; mr[jj][m][0] = *(const f32x4*)(mu + (size_t)m * D + col); mr[jj][m][1] = *(const f32x4*)(mu + (size_t)m * D + col + 4); }
    for (int row = F.gw; row < T; row += F.NGW) {
        bool ok[2]; int src[2]; const bool hi = F.lane >= 32;
        if (row < TL) { const int n = row & (SEQ - 1), gc = n & 63, gr = n >> 6;
            ok[0] = hi ? gc < 63 : gc > 0; src[0] = hi ? row + 1 : row - 1; ok[1] = hi ? gr < 255 : gr > 0; src[1] = hi ? row + 64 : row - 64; }
        else { const int n = (row - TL) & (CTXL - 1); ok[0] = n > 0; src[0] = row - 1; ok[1] = n < CTXL - 1; src[1] = row + 1; }
#pragma unroll
        for (int jj = 0; jj < 2; ++jj) { const int col = 512 * jj + 8 * F.lane;
            const u32x4 h8 = *(const u32x4*)(HL + (size_t)row * D + col); u32x4 s8 = (u32x4){0u, 0u, 0u, 0u};
            if (ok[jj]) s8 = *(const u32x4*)(HL + (size_t)src[jj] * D + col);
            const unsigned hw[4] = {h8.x, h8.y, h8.z, h8.w}, sw[4] = {s8.x, s8.y, s8.z, s8.w}; float h[8], xx[8];
#pragma unroll
            for (int e = 0; e < 8; ++e) { h[e] = (e & 1) ? bf_hi(hw[e >> 1]) : bf_lo(hw[e >> 1]); const float s = (e & 1) ? bf_hi(sw[e >> 1]) : bf_lo(sw[e >> 1]); xx[e] = s - h[e]; }
#pragma unroll
            for (int m = 0; m < 6; ++m) { const f32x4 ma = mr[jj][m][0], mb = mr[jj][m][1];
                u32x4 o; o.x = cvt_pk_bf16(h[0] + xx[0] * ma[0], h[1] + xx[1] * ma[1]); o.y = cvt_pk_bf16(h[2] + xx[2] * ma[2], h[3] + xx[3] * ma[3]);
                o.z = cvt_pk_bf16(h[4] + xx[4] * mb[0], h[5] + xx[5] * mb[1]); o.w = cvt_pk_bf16(h[6] + xx[6] * mb[2], h[7] + xx[7] * mb[3]);
                *(u32x4*)(outs[m] + (size_t)row * D + col) = o; } }
    }
}

constexpr int NCH = 5, SCP = NCH * 64, NSC = (SEQ + CTXL) / SCP, NSCAN = 64, TP = 72, TILE_B = 64 * TP * 2;
static_assert(NSC * SCP == SEQ + CTXL, "super-chunks");
enum { T_AT = 0, T_RT, T_BT, T_KT, T_VM, T_NT, T_MT, T_NRT, T_MRT, T_APA, T_APB, T_TAA, T_TAB, T_PRB, T_QRB, T_NTILE };
constexpr int LDS_GL = T_NTILE * TILE_B, LDS_SEG = LDS_GL + 256;
static_assert(LDS_SEG + 2048 <= LDS_MISC, "scan LDS map");
__device__ __forceinline__ int scan_row(int z, int b, int p) {
    if (p < CTXL) return TL + b * CTXL + (z ? CTXL - 1 - p : p);
    const int q = p - CTXL; return b * SEQ + (z ? SEQ - 1 - q : q);
}
__device__ __forceinline__ LAS bf16_t* stile(LAS unsigned char* lds, int n) { return (LAS bf16_t*)(lds + n * TILE_B); }
__device__ __forceinline__ bf16x8 row_frag(const LAS bf16_t* M, int r0, int k0, int lane) { return *(const LAS bf16x8*)(M + (r0 + (lane & 15)) * TP + k0 + 8 * (lane >> 4)); }
__device__ __forceinline__ bf16x8 tr_frag(const LAS bf16_t* M, int k0, int c0, int lane) {
    LAS bf16_t* p = (LAS bf16_t*)M + (k0 + 8 * (lane >> 4) + ((lane & 15) >> 2)) * TP + c0 + 4 * (lane & 3);
    const v4s lo = __builtin_amdgcn_ds_read_tr16_b64_v4i16((LAS v4s*)p), hi = __builtin_amdgcn_ds_read_tr16_b64_v4i16((LAS v4s*)(p + 4 * TP));
    return (bf16x8){lo[0], lo[1], lo[2], lo[3], hi[0], hi[1], hi[2], hi[3]};
}
template <bool XT, bool YT>
__device__ __forceinline__ void mm64(const LAS bf16_t* X, const LAS bf16_t* Y, f32x4 (&acc)[2], int wq, int wh, int lane) {
#pragma unroll
    for (int ks = 0; ks < 2; ++ks) {
        const bf16x8 b = XT ? tr_frag(X, 32 * ks, 16 * wq, lane) : row_frag(X, 16 * wq, 32 * ks, lane);
#pragma unroll
        for (int q = 0; q < 2; ++q) { const int i0 = 16 * (2 * wh + q);
            const bf16x8 a = YT ? row_frag(Y, i0, 32 * ks, lane) : tr_frag(Y, 32 * ks, i0, lane);
            acc[q] = __builtin_amdgcn_mfma_f32_16x16x32_bf16(a, b, acc[q], 0, 0, 0); }
    }
}
__device__ __forceinline__ void st_tile(LAS bf16_t* Z, const f32x4 (&acc)[2], int wq, int wh, int lane) {
#pragma unroll
    for (int q = 0; q < 2; ++q) { u32x2 o; o.x = cvt_pk_bf16(acc[q][0], acc[q][1]); o.y = cvt_pk_bf16(acc[q][2], acc[q][3]);
        *(LAS u32x2*)(Z + (16 * wq + (lane & 15)) * TP + 16 * (2 * wh + q) + 4 * (lane >> 4)) = o; }
}
__device__ __forceinline__ void ld_tile(const LAS bf16_t* Z, f32x4 (&acc)[2], int wq, int wh, int lane) {
#pragma unroll
    for (int q = 0; q < 2; ++q) { const u32x2 o = *(const LAS u32x2*)(Z + (16 * wq + (lane & 15)) * TP + 16 * (2 * wh + q) + 4 * (lane >> 4));
        acc[q] = (f32x4){bf_lo(o.x), bf_hi(o.x), bf_lo(o.y), bf_hi(o.y)}; }
}
__device__ __forceinline__ f32x4 prod16(const LAS bf16_t* X, int xr, int xc, const LAS bf16_t* Y, int yr, int yc, f32x4 acc, int lane) {
    bf16x8 b = *(const LAS bf16x8*)(X + (xr + (lane & 15)) * TP + xc + 8 * (lane >> 4)); bf16x8 a = tr_frag(Y, yr, yc, lane);
    if ((lane >> 4) >= 2) { b = (bf16x8){0, 0, 0, 0, 0, 0, 0, 0}; a = (bf16x8){0, 0, 0, 0, 0, 0, 0, 0}; }
    return __builtin_amdgcn_mfma_f32_16x16x32_bf16(a, b, acc, 0, 0, 0);
}
__device__ __forceinline__ void st16(LAS bf16_t* Z, int zr, int zc, f32x4 acc, int lane) { u32x2 o; o.x = cvt_pk_bf16(acc[0], acc[1]); o.y = cvt_pk_bf16(acc[2], acc[3]); *(LAS u32x2*)(Z + (zr + (lane & 15)) * TP + zc + 4 * (lane >> 4)) = o; }
__device__ __forceinline__ f32x4 ld16(const LAS bf16_t* Z, int zr, int zc, int lane) { const u32x2 o = *(const LAS u32x2*)(Z + (zr + (lane & 15)) * TP + zc + 4 * (lane >> 4)); return (f32x4){bf_lo(o.x), bf_hi(o.x), bf_lo(o.y), bf_hi(o.y)}; }
struct ChunkRegs { u32x4 r, k, v, tw, ta; };
__device__ __forceinline__ void scan_load(KP P, const Frame& F, int item, int c4, ChunkRegs& R) {
    const int s = item & 63, sc = item >> 6, z = s >> 5, b = (s >> 4) & 1, hh = s & 15;
    const size_t row = (size_t)scan_row(z, b, sc * SCP + c4 * 64 + (F.tid >> 3)); const size_t o = row * D + hh * 64 + (F.tid & 7) * 8, o2 = row * 256 + z * 64 + (F.tid & 7) * 8;
    R.r = *(const u32x4*)((const bf16_t*)(P->ws + WS_R) + o); R.k = *(const u32x4*)((const bf16_t*)(P->ws + WS_K) + o); R.v = *(const u32x4*)((const bf16_t*)(P->ws + WS_VV) + o);
    R.tw = *(const u32x4*)((const bf16_t*)(P->ws + WS_TW) + o2); R.ta = *(const u32x4*)((const bf16_t*)(P->ws + WS_TA) + o2);
}
__device__ __forceinline__ void scan_chunk_phase(const Frame& F, KP P, int j) {
    LAS unsigned char* lds = F.lds;
    LAS bf16_t* At = stile(lds, T_AT); LAS bf16_t* Rt = stile(lds, T_RT); LAS bf16_t* Bt = stile(lds, T_BT); LAS bf16_t* Kt = stile(lds, T_KT); LAS bf16_t* Vm = stile(lds, T_VM);
    LAS bf16_t* NT = stile(lds, T_NT); LAS bf16_t* MT = stile(lds, T_MT); LAS bf16_t* NrT = stile(lds, T_NRT); LAS bf16_t* MrT = stile(lds, T_MRT);
    LAS bf16_t* ApA = stile(lds, T_APA); LAS bf16_t* ApB = stile(lds, T_APB); LAS bf16_t* TaA = stile(lds, T_TAA); LAS bf16_t* TaB = stile(lds, T_TAB);
    LAS bf16_t* PrB = stile(lds, T_PRB); LAS bf16_t* QrB = stile(lds, T_QRB);
    LAS float* gl = (LAS float*)(lds + LDS_GL); LAS float* seg = (LAS float*)(lds + LDS_SEG);
    const int lane = F.lane, wq = F.wave & 3, wh = F.wave >> 2, l15 = lane & 15, l4 = lane >> 4;
    const int pi = F.tid >> 3, kq = F.tid & 7;
    const int jrow = 16 * wq + l15;
    const int NITEM = NSCAN * NSC;
    int item = blockIdx.x; if (item >= NITEM) return;
    ChunkRegs cur, nxt; scan_load(P, F, item, 0, cur); nxt = cur;
    f32x4 Pr[2], Qr[2], aYp[2], aQp[2];
#pragma unroll
    for (int q = 0; q < 2; ++q) { Pr[q] = (f32x4){0.f, 0.f, 0.f, 0.f}; Qr[q] = Pr[q]; aYp[q] = Pr[q]; aQp[q] = Pr[q]; }
    bool pend = false; size_t orowp = 0; bf16_t* GEp = nullptr; bf16_t* YEp = nullptr; float* pqp = nullptr; bool lastp = false;
#define SCAN_STAGE_G() do { \
        f32x4 ge[2] = {(f32x4){0.f, 0.f, 0.f, 0.f}, (f32x4){0.f, 0.f, 0.f, 0.f}}; \
        mm64<false, true>(NT, PrB, ge, wq, wh, lane); mm64<false, true>(NT, QrB, aYp, wq, wh, lane); \
        f32x4 pn[2] = {(f32x4){0.f, 0.f, 0.f, 0.f}, (f32x4){0.f, 0.f, 0.f, 0.f}}; \
        mm64<false, false>(PrB, MT, pn, wq, wh, lane); mm64<false, false>(QrB, MT, aQp, wq, wh, lane); \
        _Pragma("unroll") for (int q = 0; q < 2; ++q) { const int i0 = 16 * (2 * wh + q) + 4 * l4; \
            u32x2 o; o.x = cvt_pk_bf16(ge[q][0], ge[q][1]); o.y = cvt_pk_bf16(ge[q][2], ge[q][3]); *(u32x2*)(GEp + orowp + i0) = o; \
            u32x2 y; y.x = cvt_pk_bf16(aYp[q][0], aYp[q][1]); y.y = cvt_pk_bf16(aYp[q][2], aYp[q][3]); *(u32x2*)(YEp + orowp + i0) = y; \
            Pr[q] = pn[q]; Qr[q] = aQp[q]; } \
        if (lastp) { const int ln_ = lane_id_now(), l15_ = ln_ & 15, l4_ = ln_ >> 4;   \
            float* pP_ = pqp + ((l15_ & 3) * 4 + (l15_ >> 2)) * 64 + wq * 16 + 8 * wh + l4_; float* pQ_ = pqp + 4096 + (wq * 16 + l4_) * 64 + 32 * wh + l15_; \
            _Pragma("unroll") for (int q = 0; q < 2; ++q)   \
            _Pragma("unroll") for (int r = 0; r < 4; ++r) { pP_[r * 1024 + 4 * q] = Pr[q][r]; pQ_[r * 256 + 16 * q] = Qr[q][r]; } } \
    } while (0)
    for (;;) {
        const int s = item & 63, sc = item >> 6, z = s >> 5, b = (s >> 4) & 1, hh = s & 15;
        const float* kkw = P->in[I_KK] + (size_t)j * D + hh * 64 + kq * 8; const float* kap = P->in[I_KA] + (size_t)j * D + hh * 64 + kq * 8; const float* rkp = P->in[I_RK] + (size_t)j * D + hh * 64 + kq * 8;
        const float* w0p = P->in[I_W0] + ((size_t)j * 2 + z) * D + hh * 64; const float* a0p = P->in[I_A0] + ((size_t)j * 2 + z) * D + hh * 64;
        float* bon = (float*)(P->ws + WS_BON) + (size_t)z * T * 16;
        const u32x4 w2r = *(const u32x4*)((const bf16_t*)(P->ws + WS_W2P) + (((size_t)j * 2 + z) * D + hh * 64 + pi) * 256 + z * 64 + kq * 8);
        const u32x4 a2r = *(const u32x4*)((const bf16_t*)(P->ws + WS_A2P) + (((size_t)j * 2 + z) * D + hh * 64 + pi) * 256 + z * 64 + kq * 8);
        bf16_t* GE = (bf16_t*)(P->ws + (z ? WS_AS1 : WS_AS0)); bf16_t* YE = (bf16_t*)(P->ws + (z ? WS_ELOG1 : WS_ELOG0));
        float* pq = (float*)(P->ws + WS_PQ) + ((size_t)(s * NSC + sc) * 2) * 4096;
#pragma nounroll
        for (int c4 = 0; c4 < NCH; ++c4) {
            unsigned long long ch_t[12]; ch_t[11] = CH_AMP >= 0 ? __builtin_amdgcn_s_memrealtime() : 0ull;
            *(LAS u32x4*)(ApA + pi * TP + kq * 8) = cur.tw; *(LAS u32x4*)(ApB + pi * TP + kq * 8) = cur.ta; *(LAS u32x4*)(NrT + pi * TP + kq * 8) = w2r; *(LAS u32x4*)(MrT + pi * TP + kq * 8) = a2r;
            LDS_BARRIER(); CH_STAMP(0);
            {   f32x4 lw[2] = {(f32x4){0.f, 0.f, 0.f, 0.f}, (f32x4){0.f, 0.f, 0.f, 0.f}}, la[2] = {(f32x4){0.f, 0.f, 0.f, 0.f}, (f32x4){0.f, 0.f, 0.f, 0.f}};
                mm64<false, true>(ApA, NrT, lw, wq, wh, lane); mm64<false, true>(ApB, MrT, la, wq, wh, lane);
#pragma unroll
                for (int q = 0; q < 2; ++q) { const int i0 = 16 * (2 * wh + q) + 4 * l4; const f32x4 w04 = *(const f32x4*)(w0p + i0), a04 = *(const f32x4*)(a0p + i0);
#pragma unroll
                    for (int r = 0; r < 4; ++r) { lw[q][r] = -0.60653065971f * sigmoidf_(w04[r] + lw[q][r]); la[q][r] = sigmoidf_(a04[r] + la[q][r]); } }
                st_tile(TaA, lw, wq, wh, lane); st_tile(TaB, la, wq, wh, lane); }
            LDS_BARRIER(); CH_STAMP(1);
            float r8[8], k8[8], e8[8], m8[8], a8[8], kk8[8], c8[8];
            { const u32x4 et = *(const LAS u32x4*)(TaA + pi * TP + kq * 8), at = *(const LAS u32x4*)(TaB + pi * TP + kq * 8); unpack8(cur.r, r8); unpack8(cur.k, k8); unpack8(et, e8); unpack8(at, a8); }
            {   const f32x4 ka0 = *(const f32x4*)(kap), ka1 = *(const f32x4*)(kap + 4), rk0 = *(const f32x4*)(rkp), rk1 = *(const f32x4*)(rkp + 4); float bp = 0.f;
#pragma unroll
                for (int e = 0; e < 8; ++e) { m8[e] = k8[e] * (1.0f + (a8[e] - 1.0f) * (e < 4 ? ka0[e & 3] : ka1[e & 3])); bp += r8[e] * (e < 4 ? rk0[e & 3] : rk1[e & 3]) * m8[e]; }
                bp += shx(bp, 1, lane); bp += shx(bp, 2, lane); bp += shx(bp, 4, lane);
                if (kq == 0) bon[(size_t)scan_row(z, b, sc * SCP + c4 * 64 + pi) * 16 + hh] = bp; }
            { const f32x4 w0 = *(const f32x4*)kkw, w1 = *(const f32x4*)(kkw + 4); float ss = 0.f;
#pragma unroll
              for (int e = 0; e < 8; ++e) { kk8[e] = k8[e] * (e < 4 ? w0[e & 3] : w1[e & 3]); ss += kk8[e] * kk8[e]; }
              ss += shx(ss, 1, lane); ss += shx(ss, 2, lane); ss += shx(ss, 4, lane);
              const float rn = rsqrtf(ss + 1e-12f);
#pragma unroll
              for (int e = 0; e < 8; ++e) { kk8[e] *= rn; c8[e] = e8[e]; } }
#pragma unroll
            for (int d = 8; d < 64; d <<= 1) {
#pragma unroll
                for (int e = 0; e < 8; ++e) { const float t = shup(c8[e], d, lane); c8[e] += lane >= d ? t : 0.f; } }
            if (lane >= 56) { *(LAS f32x4*)(seg + F.wave * 64 + kq * 8) = (f32x4){c8[0], c8[1], c8[2], c8[3]}; *(LAS f32x4*)(seg + F.wave * 64 + kq * 8 + 4) = (f32x4){c8[4], c8[5], c8[6], c8[7]}; }
            if (pend) { SCAN_STAGE_G(); pend = false; }
            LDS_BARRIER(); CH_STAMP(2);
            if (c4 > 0) { st_tile(PrB, Pr, wq, wh, lane); st_tile(QrB, Qr, wq, wh, lane); }
            { float cum[8];
#pragma unroll
              for (int e = 0; e < 8; ++e) cum[e] = c8[e];
              for (int w2 = 0; w2 < F.wave; ++w2) { const f32x4 o0 = *(const LAS f32x4*)(seg + w2 * 64 + kq * 8), o1 = *(const LAS f32x4*)(seg + w2 * 64 + kq * 8 + 4);
#pragma unroll
                  for (int e = 0; e < 8; ++e) cum[e] += e < 4 ? o0[e & 3] : o1[e & 3]; }
              float o[8];
#pragma unroll
              for (int e = 0; e < 8; ++e) o[e] = -kk8[e] * __expf(cum[e] - e8[e]);
              *(LAS u32x4*)(At + pi * TP + kq * 8) = pack8(o);
#pragma unroll
              for (int e = 0; e < 8; ++e) o[e] = r8[e] * __expf(cum[e]);
              *(LAS u32x4*)(Rt + pi * TP + kq * 8) = pack8(o);
              float en[8];
#pragma unroll
              for (int e = 0; e < 8; ++e) { en[e] = __expf(-cum[e]); o[e] = kk8[e] * a8[e] * en[e]; }
              *(LAS u32x4*)(Bt + pi * TP + kq * 8) = pack8(o);
#pragma unroll
              for (int e = 0; e < 8; ++e) o[e] = m8[e] * en[e];
              *(LAS u32x4*)(Kt + pi * TP + kq * 8) = pack8(o);
              *(LAS u32x4*)(Vm + pi * TP + kq * 8) = cur.v;
              if (pi == 63) {
#pragma unroll
                  for (int e = 0; e < 8; ++e) gl[kq * 8 + e] = __expf(cum[e]); } }
            { const int nitem = c4 < NCH - 1 ? item : item + (int)gridDim.x, nc4 = c4 < NCH - 1 ? c4 + 1 : 0; if (nitem < NITEM) scan_load(P, F, nitem, nc4, nxt); }
            LDS_BARRIER(); CH_STAMP(3);
            {   f32x4 aN[2], aM[2], aNr[2], aMr[2];
#pragma unroll
                for (int q = 0; q < 2; ++q) { aN[q] = (f32x4){0.f, 0.f, 0.f, 0.f}; aM[q] = aN[q]; aNr[q] = aN[q]; aMr[q] = aN[q]; }
                mm64<false, true>(At, Bt, aN, wq, wh, lane); mm64<false, true>(At, Kt, aM, wq, wh, lane); mm64<false, true>(Rt, Bt, aNr, wq, wh, lane); mm64<false, true>(Rt, Kt, aMr, wq, wh, lane);
                f32x4 aT[2];
#pragma unroll
                for (int q = 0; q < 2; ++q)
#pragma unroll
                    for (int r = 0; r < 4; ++r) { const int i = 16 * (2 * wh + q) + 4 * l4 + r; const bool lt = i < jrow, le = i <= jrow;
                        aN[q][r] = lt ? aN[q][r] : 0.f; aM[q][r] = lt ? aM[q][r] : 0.f; aNr[q][r] = le ? aNr[q][r] : 0.f; aMr[q][r] = le ? aMr[q][r] : 0.f; aT[q][r] = aN[q][r] + (i == jrow ? 1.f : 0.f); }
                st_tile(NT, aN, wq, wh, lane); st_tile(MT, aM, wq, wh, lane); st_tile(NrT, aNr, wq, wh, lane); st_tile(MrT, aMr, wq, wh, lane); st_tile(TaA, aT, wq, wh, lane);
            }
            LDS_BARRIER(); CH_STAMP(4);
            if (F.wave < 4) { const int o = 16 * F.wave, oc = 16 * ((F.wave + 1) & 3);
                f32x4 p = prod16(NT, o, o, NT, o, o, (f32x4){0.f, 0.f, 0.f, 0.f}, lane); st16(ApA, o, o, p, lane);
                f32x4 t = prod16(TaA, o, o, ApA, o, o, ld16(TaA, o, o, lane), lane); p = prod16(ApA, o, o, ApA, o, o, (f32x4){0.f, 0.f, 0.f, 0.f}, lane);
                st16(TaB, o, o, t, lane); st16(ApA, o, oc, p, lane);
                t = prod16(TaB, o, o, ApA, o, oc, ld16(TaB, o, o, lane), lane); p = prod16(ApA, o, oc, ApA, o, oc, (f32x4){0.f, 0.f, 0.f, 0.f}, lane);
                st16(TaA, o, o, t, lane); st16(ApA, o, o, p, lane);
                t = prod16(TaA, o, o, ApA, o, o, ld16(TaA, o, o, lane), lane); st16(TaB, o, o, t, lane);
#pragma unroll
                for (int jj = 1; jj < 4; ++jj) if (jj > F.wave) { u32x2 zz; asm volatile("v_mov_b32 %0, 0\n\tv_mov_b32 %1, 0" : "=v"(zz.x), "=v"(zz.y)); *(LAS u32x2*)(TaB + (o + l15) * TP + 16 * jj + 4 * l4) = zz; }
            } else { const int wq2 = F.wave - 4;
#pragma unroll
                for (int wh2 = 0; wh2 < 2; ++wh2) { f32x4 x[2] = {(f32x4){0.f, 0.f, 0.f, 0.f}, (f32x4){0.f, 0.f, 0.f, 0.f}}; mm64<true, true>(Vm, MT, x, wq2, wh2, lane); st_tile(ApB, x, wq2, wh2, lane); } }
            LDS_BARRIER(); CH_STAMP(5);
            if (F.wave < 3) { const int jj = F.wave;
#pragma unroll
                for (int i = 1; i < 4; ++i) if (i > jj) { f32x4 e = (f32x4){0.f, 0.f, 0.f, 0.f};
#pragma unroll
                    for (int m = 0; m < 3; ++m) if (m >= jj && m < i) e = prod16(NT, 16 * i, 16 * m, TaB, 16 * m, 16 * jj, e, lane);
                    st16(ApA, 16 * i, 16 * jj, e, lane);
                    st16(TaB, 16 * i, 16 * jj, prod16(TaB, 16 * i, 16 * i, ApA, 16 * i, 16 * jj, (f32x4){0.f, 0.f, 0.f, 0.f}, lane), lane); } }
            LDS_BARRIER(); CH_STAMP(6);
            {   f32x4 w[2] = {(f32x4){0.f, 0.f, 0.f, 0.f}, (f32x4){0.f, 0.f, 0.f, 0.f}}; mm64<true, true>(At, TaB, w, wq, wh, lane); st_tile(ApA, w, wq, wh, lane);
                f32x4 u[2] = {(f32x4){0.f, 0.f, 0.f, 0.f}, (f32x4){0.f, 0.f, 0.f, 0.f}}; mm64<false, true>(ApB, TaB, u, wq, wh, lane); st_tile(TaA, u, wq, wh, lane); }
            LDS_BARRIER(); CH_STAMP(7);
            f32x4 aP[2], aQ[2], aG[2], aY[2];
#pragma unroll
            for (int q = 0; q < 2; ++q) { aP[q] = (f32x4){0.f, 0.f, 0.f, 0.f}; aQ[q] = aP[q]; aG[q] = aP[q]; aY[q] = aP[q]; }
            mm64<false, false>(ApA, Bt, aP, wq, wh, lane);
            mm64<false, false>(TaA, Bt, aQ, wq, wh, lane); mm64<true, false>(Vm, Kt, aQ, wq, wh, lane);
            mm64<false, true>(NrT, ApA, aG, wq, wh, lane);
            mm64<false, true>(NrT, TaA, aY, wq, wh, lane); mm64<false, false>(MrT, Vm, aY, wq, wh, lane);
#pragma unroll
            for (int q = 0; q < 2; ++q) { const int i0 = 16 * (2 * wh + q) + 4 * l4; const f32x4 g4 = *(const LAS f32x4*)(gl + i0);
                const u32x2 rr = *(const LAS u32x2*)(Rt + jrow * TP + i0);
#pragma unroll
                for (int r = 0; r < 4; ++r) { aP[q][r] = (aP[q][r] + (i0 + r == jrow ? 1.f : 0.f)) * g4[r]; aQ[q][r] *= g4[r]; }
                aG[q][0] += bf_lo(rr.x); aG[q][1] += bf_hi(rr.x); aG[q][2] += bf_lo(rr.y); aG[q][3] += bf_hi(rr.y); }
            const size_t orow = (size_t)scan_row(z, b, sc * SCP + c4 * 64 + jrow) * D + hh * 64;
            if (c4 == 0) {
#pragma unroll
                for (int q = 0; q < 2; ++q) { const int i0 = 16 * (2 * wh + q) + 4 * l4;
                    u32x2 o; o.x = cvt_pk_bf16(aG[q][0], aG[q][1]); o.y = cvt_pk_bf16(aG[q][2], aG[q][3]); *(u32x2*)(GE + orow + i0) = o;
                    u32x2 y; y.x = cvt_pk_bf16(aY[q][0], aY[q][1]); y.y = cvt_pk_bf16(aY[q][2], aY[q][3]); *(u32x2*)(YE + orow + i0) = y;
                    Pr[q] = aP[q]; Qr[q] = aQ[q]; }
            } else {
                st_tile(NT, aG, wq, wh, lane); st_tile(MT, aP, wq, wh, lane);
#pragma unroll
                for (int q = 0; q < 2; ++q) { aYp[q] = aY[q]; aQp[q] = aQ[q]; }
                pend = true; orowp = orow; GEp = GE; YEp = YE; pqp = pq; lastp = c4 == NCH - 1;
            }
            cur = nxt;
            if (CH_AMP >= 0) { const unsigned long long d_ = CH_AMP == 0 ? ch_t[0] - ch_t[11] : ch_t[CH_AMP] - ch_t[CH_AMP - 1]; const unsigned long long dl_ = __builtin_amdgcn_s_memrealtime() + 4 * d_; while (__builtin_amdgcn_s_memrealtime() < dl_) __builtin_amdgcn_s_sleep(4); }
            LDS_BARRIER(); CH_STAMP(8);
        }
        item += gridDim.x; if (item >= NITEM) break;
    }
    if (pend) { SCAN_STAGE_G(); }
#undef SCAN_STAGE_G
}
__device__ __forceinline__ void scan_carry_phase(const Frame& F, KP P, int layer) {
    LAS unsigned* cbar = (LAS unsigned*)(F.lds + 8192);
    if (F.tid == 0) *cbar = 0u;
    __syncthreads();
    if (F.wave >= 4) { moe_weights_phase(F, P, layer, blockIdx.x * 4 + (F.wave - 4), gridDim.x * 4, 0, MOE_SPLIT); return; }
    if (blockIdx.x >= 4 * NSCAN) return;
    unsigned ctarget = 0u;
    const int s = blockIdx.x >> 2, vs = blockIdx.x & 3, lane = F.lane, l15 = lane & 15, l4 = lane >> 4, v = 16 * vs + l15, T2 = F.wave;
    const float* pq = (const float*)(P->ws + WS_PQ) + (size_t)s * NSC * 2 * 4096; bf16_t* sst = (bf16_t*)(P->ws + WS_SST) + (size_t)s * NSC * 4096;
    LAS f32x4* exch = (LAS f32x4*)F.lds;
    f32x4 S[4]; float ap[4][16], qp[4][4];
#pragma unroll
    for (int t = 0; t < 4; ++t) S[t] = (f32x4){0.f, 0.f, 0.f, 0.f};
#define CARRY_LOAD(slot, step) do { const float* Pm_ = pq + (size_t)(step) * 2 * 4096; \
        _Pragma("unroll") for (int t2i = 0; t2i < 4; ++t2i) _Pragma("unroll") for (int ri = 0; ri < 4; ++ri) ap[slot][t2i * 4 + ri] = Pm_[(T2 * 16 + t2i * 4 + ri) * 64 + lane];   \
        _Pragma("unroll") for (int r = 0; r < 4; ++r) qp[slot][r] = Pm_[4096 + ((vs * 4 + T2) * 4 + r) * 64 + lane];   } while (0)
#define CARRY_STORE(sc_) do { if (T2 == 0) { float o[16]; \
        _Pragma("unroll") for (int r = 0; r < 4; ++r) _Pragma("unroll") for (int t2 = 0; t2 < 4; ++t2) o[4 * r + t2] = S[t2][r]; \
        u32x4 w0, w1; w0.x = cvt_pk_bf16(o[0], o[1]); w0.y = cvt_pk_bf16(o[2], o[3]); w0.z = cvt_pk_bf16(o[4], o[5]); w0.w = cvt_pk_bf16(o[6], o[7]); \
        w1.x = cvt_pk_bf16(o[8], o[9]); w1.y = cvt_pk_bf16(o[10], o[11]); w1.z = cvt_pk_bf16(o[12], o[13]); w1.w = cvt_pk_bf16(o[14], o[15]); \
        *(u32x4*)(sst + (size_t)(sc_) * 4096 + v * 64 + 16 * l4) = w0; *(u32x4*)(sst + (size_t)(sc_) * 4096 + v * 64 + 16 * l4 + 8) = w1; } } while (0)
    if (T2 < 4) {
#pragma unroll
        for (int u = 0; u < 4; ++u) CARRY_LOAD(u, u);
    }
#pragma nounroll
    for (int sc0 = 0; sc0 < NSC - 1; sc0 += 4) {
#pragma unroll
        for (int u = 0; u < 4; ++u) { const int sc = sc0 + u; if (sc >= NSC - 1) break;
            CARRY_STORE(sc);
            if (T2 < 4) {
                f32x4 nw = (f32x4){qp[u][0], qp[u][1], qp[u][2], qp[u][3]};
#pragma unroll
                for (int t2i = 0; t2i < 4; ++t2i)
#pragma unroll
                    for (int ri = 0; ri < 4; ++ri) nw = __builtin_amdgcn_mfma_f32_16x16x4f32(ap[u][t2i * 4 + ri], S[t2i][ri], nw, 0, 0, 0);
                if (sc + 4 < NSC - 1) CARRY_LOAD(u, sc + 4);
                exch[((u & 1) * 4 + T2) * 64 + lane] = nw;
            }
            { asm volatile("s_waitcnt lgkmcnt(0)" ::: "memory"); if (lane == 0) __hip_atomic_fetch_add(cbar, 1u, __ATOMIC_RELAXED, __HIP_MEMORY_SCOPE_WORKGROUP); ctarget += 4u;
              for (int spin = 0; spin < (1 << 22); ++spin) { const unsigned c = __hip_atomic_load(cbar, __ATOMIC_RELAXED, __HIP_MEMORY_SCOPE_WORKGROUP); if ((int)(c - ctarget) >= 0) break; }
              asm volatile("" ::: "memory"); }
            if (T2 < 4) {
#pragma unroll
                for (int t = 0; t < 4; ++t) S[t] = exch[((u & 1) * 4 + t) * 64 + lane];
            }
        }
    }
    CARRY_STORE(NSC - 1);
#undef CARRY_LOAD
#undef CARRY_STORE
}
__device__ __forceinline__ void scan_out_phase(const Frame& F, KP P, int j) {
    const int lane = F.lane, l15 = lane & 15, l4 = lane >> 4;
    const bf16_t* GE0 = (const bf16_t*)(P->ws + WS_AS0); const bf16_t* GE1 = (const bf16_t*)(P->ws + WS_AS1); const bf16_t* YE0 = (const bf16_t*)(P->ws + WS_ELOG0); const bf16_t* YE1 = (const bf16_t*)(P->ws + WS_ELOG1);
    const bf16_t* Vb = (const bf16_t*)(P->ws + WS_VV); const float* BON = (const float*)(P->ws + WS_BON);
    const bf16_t* GT = (const bf16_t*)(P->ws + WS_GATE); bf16_t* YG = (bf16_t*)(P->ws + WS_YG);
    for (int item = F.gw; item < NBATCH * NH * ((SEQ + CTXL) / 256) * 8; item += F.NGW) {
        const int hh = item & 15, oct = (item >> 4) & 7, b = (item >> 7) & 1, blk = item >> 8;
        const int sc0 = (blk * 256 + 32 * oct) / SCP, sc1 = blk == 0 ? 0 : (SEQ + CTXL - 1 - (blk - 1) * 256 - 32 * oct) / SCP;

        const bf16_t* s0 = (const bf16_t*)(P->ws + WS_SST) + ((size_t)(b * 16 + hh) * NSC + sc0) * 4096; const bf16_t* s1 = (const bf16_t*)(P->ws + WS_SST) + ((size_t)(32 + b * 16 + hh) * NSC + sc1) * 4096;
        bf16x8 sa0[4][2], sa1[4][2];
#pragma unroll
        for (int vt = 0; vt < 4; ++vt) { const int v = 32 * (vt >> 1) + 8 * (l15 >> 2) + 4 * (vt & 1) + (l15 & 3);
#pragma unroll
            for (int ks = 0; ks < 2; ++ks) { sa0[vt][ks] = *(const bf16x8*)(s0 + v * 64 + 32 * ks + 8 * l4); sa1[vt][ks] = *(const bf16x8*)(s1 + v * 64 + 32 * ks + 8 * l4); } }
        f32x4 lg4[4], lb4[4];
#pragma unroll
        for (int q = 0; q < 4; ++q) { const int c = hh * 64 + 32 * (q >> 1) + 8 * l4 + 4 * (q & 1); lg4[q] = *(const f32x4*)(P->in[I_LNG] + (size_t)j * D + c); lb4[q] = *(const f32x4*)(P->in[I_LNB] + (size_t)j * D + c); }
#pragma nounroll
        for (int ti = 0; ti < 2; ++ti) {
            const int tok = (2 * oct + ti) * 16 + l15; const int row = blk == 0 ? TL + b * CTXL + tok : b * SEQ + (blk - 1) * 256 + tok;
            const size_t o = (size_t)row * D + hh * 64;
            const bf16x8 g00 = *(const bf16x8*)(GE0 + o + 8 * l4), g01 = *(const bf16x8*)(GE0 + o + 32 + 8 * l4), g10 = *(const bf16x8*)(GE1 + o + 8 * l4), g11 = *(const bf16x8*)(GE1 + o + 32 + 8 * l4);
            u32x4 la[2], lc[2], lv[2], lgt[2];
#pragma unroll
            for (int h2 = 0; h2 < 2; ++h2) { const size_t oc = o + 32 * h2 + 8 * l4;
                la[h2] = *(const u32x4*)(YE0 + oc); lc[h2] = *(const u32x4*)(YE1 + oc); lv[h2] = *(const u32x4*)(Vb + oc); lgt[h2] = *(const u32x4*)(GT + oc); }
            const float bn = BON[(size_t)row * 16 + hh] + BON[((size_t)T + row) * 16 + hh];
            __builtin_amdgcn_sched_barrier(0);
            f32x4 y[4]; float s = 0.f; f32x4 vv[4], gg[4];
#pragma unroll
            for (int vt = 0; vt < 4; ++vt) { const int h2 = vt >> 1, hf = vt & 1;
                const unsigned ax = hf ? la[h2].z : la[h2].x, ay = hf ? la[h2].w : la[h2].y, cx = hf ? lc[h2].z : lc[h2].x, cy = hf ? lc[h2].w : lc[h2].y;
                const unsigned vx = hf ? lv[h2].z : lv[h2].x, vy = hf ? lv[h2].w : lv[h2].y, gx = hf ? lgt[h2].z : lgt[h2].x, gy = hf ? lgt[h2].w : lgt[h2].y;
                f32x4 acc = (f32x4){bf_lo(ax) + bf_lo(cx), bf_hi(ax) + bf_hi(cx), bf_lo(ay) + bf_lo(cy), bf_hi(ay) + bf_hi(cy)};
                acc = __builtin_amdgcn_mfma_f32_16x16x32_bf16(sa0[vt][0], g00, acc, 0, 0, 0); acc = __builtin_amdgcn_mfma_f32_16x16x32_bf16(sa0[vt][1], g01, acc, 0, 0, 0);
                acc = __builtin_amdgcn_mfma_f32_16x16x32_bf16(sa1[vt][0], g10, acc, 0, 0, 0); acc = __builtin_amdgcn_mfma_f32_16x16x32_bf16(sa1[vt][1], g11, acc, 0, 0, 0);
                y[vt] = acc; s += (acc[0] + acc[1]) + (acc[2] + acc[3]);
                vv[vt] = (f32x4){bf_lo(vx), bf_hi(vx), bf_lo(vy), bf_hi(vy)}; gg[vt] = (f32x4){bf_lo(gx), bf_hi(gx), bf_lo(gy), bf_hi(gy)}; }
            s += shx(s, 16, lane); s += shx(s, 32, lane);
            const float mean = s * (1.0f / 64.0f); float q = 0.f;
#pragma unroll
            for (int vt = 0; vt < 4; ++vt) { const f32x4 d = y[vt] - mean; q += (d[0] * d[0] + d[1] * d[1]) + (d[2] * d[2] + d[3] * d[3]); }
            q += shx(q, 16, lane); q += shx(q, 32, lane);
            const float rstd = rsqrtf(q * (1.0f / 64.0f) + 64e-5f);
#pragma unroll
            for (int h2 = 0; h2 < 2; ++h2) { const f32x4 o0 = (((y[2 * h2] - mean) * rstd) * lg4[2 * h2] + lb4[2 * h2] + vv[2 * h2] * bn) * gg[2 * h2], o1 = (((y[2 * h2 + 1] - mean) * rstd) * lg4[2 * h2 + 1] + lb4[2 * h2 + 1] + vv[2 * h2 + 1] * bn) * gg[2 * h2 + 1];
                u32x4 w; w.x = cvt_pk_bf16(o0[0], o0[1]); w.y = cvt_pk_bf16(o0[2], o0[3]); w.z = cvt_pk_bf16(o1[0], o1[1]); w.w = cvt_pk_bf16(o1[2], o1[3]); *(u32x4*)(YG + o + 32 * h2 + 8 * l4) = w; }
        }
    }
}
__device__ __forceinline__ bool in_range(int lo, int hi, int k) { asm volatile("" : "+s"(lo), "+s"(hi)); return lo <= k && k < hi; }
constexpr int NPH = 46;
template <unsigned KMASK> __global__ void __launch_bounds__(NTHR, 2) mega(Params Pv) {
    extern __shared__ __attribute__((aligned(16))) unsigned char lds_raw[];
    Frame F0; F0.lds = (LAS unsigned char*)lds_raw; F0.tid = threadIdx.x; F0.lane = F0.tid & 63; F0.wave = __builtin_amdgcn_readfirstlane(F0.tid >> 6);
    F0.G = gridDim.x; F0.gw = blockIdx.x * NWAVES + F0.wave; F0.NGW = F0.G * NWAVES;
    LAS unsigned* misc = (LAS unsigned*)(F0.lds + LDS_MISC);
    if (F0.tid < 128) misc[F0.tid] = 0u;
    __syncthreads();
    KP P0 = (KP)__builtin_amdgcn_kernarg_segment_ptr();
    constexpr bool ALL = (KMASK == 0x3ffffu);
    const int lo = ALL ? 0 : P0->ph_lo, hi = ALL ? NPH : P0->ph_hi;
    XcdBarrier bar; bar.bar = (unsigned*)(P0->ws + WS_CTL) + CW_BAR; bar.x = 0; bar.st = (volatile LAS unsigned*)(misc + 8);
    if (ALL || hi - lo > 1) bar = xcd_barrier_post((unsigned*)(P0->ws + WS_CTL) + CW_BAR, (volatile LAS unsigned*)(misc + 8));
#define IN(k) (ALL || in_range(lo, hi, (k)))
#define KIND(q) ((KMASK >> (q)) & 1u)
#define BAR_LEADER (wave_sgpr_now(F0.wave) == 0 && lane_id_now() == 0)
#define SEAM(k) do { if (IN(k) && IN((k) + 1)) { XcdBarrier b2_ = bar; unsigned* bb_ = bar.bar; unsigned bx_ = bar.x; asm volatile("" : "+s"(bb_), "+s"(bx_)); b2_.bar = bb_; b2_.x = bx_; xcd_barrier<false>(b2_, BAR_LEADER); } } while (0)
#define AMP_T0 const unsigned long long amp_t0 = AMP_MASK ? __builtin_amdgcn_s_memrealtime() : 0ull;
#define AMP_END(kind) do { if (AMP_MASK & (1u << (kind))) { const unsigned long long t1_ = __builtin_amdgcn_s_memrealtime(), dl_ = t1_ + AMP_F * (t1_ - amp_t0); while (__builtin_amdgcn_s_memrealtime() < dl_) __builtin_amdgcn_s_sleep(8); } } while (0)
#define PHASE_ENTRY AMP_T0 KP P = P0; asm volatile("" : "+s"(P)); unsigned char* ws = P->ws; unsigned* ctl = (unsigned*)(ws + WS_CTL); (void)ctl; \
    Frame F = F0; { int l_ = lane_id_now(), w_ = F0.wave; asm volatile("" : "+s"(w_)); F.lane = l_; F.wave = w_; F.tid = w_ * 64 + l_; F.gw = blockIdx.x * NWAVES + w_; }

    if constexpr (KIND(0)) if (IN(0)) { PHASE_ENTRY prologue_phase(F, P); AMP_END(0); }
    if (IN(0) && IN(1)) { XcdBarrier b2_ = bar; unsigned* bb_ = bar.bar; unsigned bx_ = bar.x; asm volatile("" : "+s"(bb_), "+s"(bx_)); b2_.bar = bb_; b2_.x = bx_; xcd_barrier<true>(b2_, BAR_LEADER); }
    for (int lp = 0; lp < 2; ++lp) {
        const int pb = 1 + 22 * lp, la = 2 * lp, lb = 2 * lp + 1;
        if constexpr (KIND(1)) if (IN(pb + 0)) { PHASE_ENTRY norm1_phase(F, P, la); AMP_END(1); }
        SEAM(pb + 0);
        if constexpr (KIND(2)) if (IN(pb + 1)) { PHASE_ENTRY
            __syncthreads(); set_desc(F.lds, F.tid, 0, ws + WS_HL, ws + WS_WIN + (size_t)lp * 4096 * D * 2, ws + WS_U, 16, 0, 0, ws + WS_V, P->in[I_GBIN] + (size_t)lp * 4096, ws + WS_STAT); __syncthreads();
            SchedMulti<D, D> S{F.lds, TL / 256, 16, 1};
            EpiGelu E{F.lds};
            pg8::gemm_phase<EpiGelu, SchedMulti<D, D>, false, D, D, D>(F.lds, S, E, F.tid);
            __syncthreads(); { int w_ = F0.wave; asm volatile("" : "+s"(w_)); tail_gelu(F0.lds, w_); }
            AMP_END(2); }
        SEAM(pb + 1);
        if constexpr (KIND(3)) if (IN(pb + 2)) { PHASE_ENTRY spatial_phase(F, P, lp); AMP_END(3); }
        SEAM(pb + 2);
        if constexpr (KIND(4)) if (IN(pb + 3)) { PHASE_ENTRY
            __syncthreads();
            { bf16_t* X = (bf16_t*)(ws + WS_X);
              set_desc(F.lds, F.tid, 0, ws + WS_U, ws + WS_WOUT + (size_t)lp * D * GWID * 2, X, 4, 0, 0, X, X + (size_t)TL * D, P->in[I_GBOUT] + (size_t)lp * D);
              set_desc(F.lds, F.tid, 1, nullptr, nullptr, nullptr, 0, 0, 0, (const float*)(ws + WS_MOD) + (size_t)la * 3 * 6 * D + 2 * D); }
            __syncthreads();
            SchedMulti<GWID, GWID> S{F.lds, TL / 256, 4, 1};
            EpiResid E{F.lds};
            pg8::gemm_phase<EpiResid, SchedMulti<GWID, GWID>, false, GWID, GWID, GWID>(F.lds, S, E, F.tid);
            __syncthreads(); { int w_ = F0.wave; asm volatile("" : "+s"(w_)); tail_resid<GWID>(F0.lds, w_); }
            AMP_END(4); }
        SEAM(pb + 3);
        if constexpr (KIND(5)) if (IN(pb + 4)) { PHASE_ENTRY norm2_phase(F, P, la); AMP_END(5); }
        SEAM(pb + 4);
        if constexpr (KIND(16)) if (IN(pb + 5)) { PHASE_ENTRY
            __syncthreads(); set_desc(F.lds, F.tid, 0, ws + WS_HL, ws + WS_WRT + (size_t)la * 256 * D * 2, nullptr, 1, 0, 0); __syncthreads();
            const int nun = (la == DEPTH - 1 ? TL : T) / 256;
            if ((int)blockIdx.x >= nun) moe_weights_phase(F, P, la, ((int)blockIdx.x - nun) * NWAVES + F.wave, (F.G - nun) * NWAVES, MOE_SPLIT, MOE_ITEMS);
            else { SchedMulti<D, D> S{F.lds, nun, 1, 1};
                EpiLogits E{(float*)(ws + WS_LG)};
                pg8::gemm_phase<EpiLogits, SchedMulti<D, D>, false, D, D, D>(F.lds, S, E, F.tid);
                if (F.G <= nun) { __syncthreads(); moe_weights_phase(F, P, la, F.gw, F.NGW, MOE_SPLIT, MOE_ITEMS); } }
            AMP_END(16); }
        SEAM(pb + 5);
        if constexpr (KIND(17)) if (IN(pb + 6)) { PHASE_ENTRY route_phase(F, P, la); AMP_END(17); }
        SEAM(pb + 6);
        if constexpr (KIND(6)) if (IN(pb + 7)) { PHASE_ENTRY
            moe_tables(F.lds, F.tid, ctl + CW_CNT + la * 64);
            SchedMoE<D, D, true> S{F.lds, (const char*)(ws + WS_HL), (const char*)(ws + WS_WGU), (const int*)(ws + WS_LIST)};
            EpiSiluGate E{(bf16_t*)(ws + WS_H)};
            pg8::gemm_phase<EpiSiluGate, SchedMoE<D, D, true>, true, D, D, D>(F.lds, S, E, F.tid);
            AMP_END(6); }
        SEAM(pb + 7);
        if constexpr (KIND(7)) if (IN(pb + 8)) { PHASE_ENTRY
            moe_tables(F.lds, F.tid, ctl + CW_CNT + la * 64);
            SchedMoE<EHID, EHID, false> S{F.lds, (const char*)(ws + WS_H), (const char*)(ws + WS_WD), (const int*)(ws + WS_LIST)};
            EpiScatter E{F.lds, (bf16_t*)(ws + WS_YB), (const int*)(ws + WS_LIST)};
            pg8::gemm_phase<EpiScatter, SchedMoE<EHID, EHID, false>, false, EHID, EHID, EHID>(F.lds, S, E, F.tid);
            AMP_END(7); }
        SEAM(pb + 8);
        if constexpr (KIND(1)) if (IN(pb + 9)) { PHASE_ENTRY norm1_phase(F, P, lb); AMP_END(1); }
        SEAM(pb + 9);
        if constexpr (KIND(8)) if (IN(pb + 10)) { PHASE_ENTRY mix_phase(F, P, lp); AMP_END(8); }
        SEAM(pb + 10);
        if constexpr (KIND(9)) if (IN(pb + 11)) { PHASE_ENTRY
            __syncthreads();
            set_desc(F.lds, F.tid, 0, ws + WS_XR, ws + WS_WR + (size_t)lp * D * D * 2, ws + WS_R, 4, D, 0);
            set_desc(F.lds, F.tid, 1, ws + WS_XK, ws + WS_WK + (size_t)lp * D * D * 2, ws + WS_K, 4, D, 0);
            set_desc(F.lds, F.tid, 2, ws + WS_XV, ws + WS_WV + (size_t)lp * D * D * 2, ws + WS_VV, 4, D, 0);
            set_desc(F.lds, F.tid, 3, ws + WS_XW, ws + WS_LW1 + (size_t)lp * 256 * D * 2, ws + WS_TW, 1, 256, 1);
            set_desc(F.lds, F.tid, 4, ws + WS_XA, ws + WS_LA1 + (size_t)lp * 256 * D * 2, ws + WS_TA, 1, 256, 0);
            set_desc(F.lds, F.tid, 5, ws + WS_XG, ws + WS_LG1 + (size_t)lp * 256 * D * 2, ws + WS_TG, 1, 256, 2);
            __syncthreads();
            SchedMulti<D, D> S{F.lds, T / 256, 15, 6};
            EpiAct E{F.lds};
            pg8::gemm_phase<EpiAct, SchedMulti<D, D>, false, D, D, D>(F.lds, S, E, F.tid);
            AMP_END(9); }
        SEAM(pb + 11);
        if constexpr (KIND(10)) if (IN(pb + 12)) { PHASE_ENTRY
            __syncthreads(); set_desc(F.lds, F.tid, 0, ws + WS_TG, ws + WS_G2P + (size_t)lp * D * 256 * 2, ws + WS_GATE, 4, D, 0); __syncthreads();
            SchedMulti<256, 256> S{F.lds, T / 256, 4, 1};
            EpiAct E{F.lds};
            pg8::gemm_phase<EpiAct, SchedMulti<256, 256>, false, 256, 256, 256>(F.lds, S, E, F.tid);
            AMP_END(10); }
        SEAM(pb + 12);
        if constexpr (KIND(11)) if (IN(pb + 13)) { PHASE_ENTRY scan_chunk_phase(F, P, lp); AMP_END(11); }
        SEAM(pb + 13);
        if constexpr (KIND(14)) if (IN(pb + 14)) { PHASE_ENTRY scan_carry_phase(F, P, lb); AMP_END(14); }
        SEAM(pb + 14);
        if constexpr (KIND(15)) if (IN(pb + 15)) { PHASE_ENTRY scan_out_phase(F, P, lp); AMP_END(15); }
        SEAM(pb + 15);
        if constexpr (KIND(4)) if (IN(pb + 16)) { PHASE_ENTRY
            __syncthreads();
            { bf16_t* X = (bf16_t*)(ws + WS_X);
              set_desc(F.lds, F.tid, 0, ws + WS_YG, ws + WS_WO + (size_t)lp * D * D * 2, X, 4, 0, 0, X, X + (size_t)TL * D, nullptr);
              set_desc(F.lds, F.tid, 1, nullptr, nullptr, nullptr, 0, 0, 0, (const float*)(ws + WS_MOD) + (size_t)lb * 3 * 6 * D + 2 * D); }
            __syncthreads();
            SchedMulti<D, D> S{F.lds, TL / 256, 4, 1};
            EpiResid E{F.lds};
            pg8::gemm_phase<EpiResid, SchedMulti<D, D>, false, D, D, D>(F.lds, S, E, F.tid);
            if (lb != DEPTH - 1) { __syncthreads(); { int w_ = F0.wave; asm volatile("" : "+s"(w_)); tail_resid<D>(F0.lds, w_); } }
            AMP_END(4); }
        SEAM(pb + 16);
        if constexpr (KIND(5)) if (IN(pb + 17)) { PHASE_ENTRY norm2_phase(F, P, lb); AMP_END(5); }
        SEAM(pb + 17);
        if constexpr (KIND(16)) if (IN(pb + 18)) { PHASE_ENTRY
            __syncthreads(); set_desc(F.lds, F.tid, 0, ws + WS_HL, ws + WS_WRT + (size_t)lb * 256 * D * 2, nullptr, 1, 0, 0); __syncthreads();
            const int nun = (lb == DEPTH - 1 ? TL : T) / 256;
            if ((int)blockIdx.x >= nun) moe_weights_phase(F, P, lb, ((int)blockIdx.x - nun) * NWAVES + F.wave, (F.G - nun) * NWAVES, MOE_SPLIT, MOE_ITEMS);
            else { SchedMulti<D, D> S{F.lds, nun, 1, 1};
                EpiLogits E{(float*)(ws + WS_LG)};
                pg8::gemm_phase<EpiLogits, SchedMulti<D, D>, false, D, D, D>(F.lds, S, E, F.tid);
                if (F.G <= nun) { __syncthreads(); moe_weights_phase(F, P, lb, F.gw, F.NGW, MOE_SPLIT, MOE_ITEMS); } }
            AMP_END(16); }
        SEAM(pb + 18);
        if constexpr (KIND(17)) if (IN(pb + 19)) { PHASE_ENTRY route_phase(F, P, lb); AMP_END(17); }
        SEAM(pb + 19);
        if constexpr (KIND(6)) if (IN(pb + 20)) { PHASE_ENTRY
            moe_tables(F.lds, F.tid, ctl + CW_CNT + lb * 64);
            SchedMoE<D, D, true> S{F.lds, (const char*)(ws + WS_HL), (const char*)(ws + WS_WGU), (const int*)(ws + WS_LIST)};
            EpiSiluGate E{(bf16_t*)(ws + WS_H)};
            pg8::gemm_phase<EpiSiluGate, SchedMoE<D, D, true>, true, D, D, D>(F.lds, S, E, F.tid);
            AMP_END(6); }
        SEAM(pb + 20);
        if constexpr (KIND(7)) if (IN(pb + 21)) { PHASE_ENTRY
            moe_tables(F.lds, F.tid, ctl + CW_CNT + lb * 64);
            SchedMoE<EHID, EHID, false> S{F.lds, (const char*)(ws + WS_H), (const char*)(ws + WS_WD), (const int*)(ws + WS_LIST)};
            EpiScatter E{F.lds, (bf16_t*)(ws + WS_YB), (const int*)(ws + WS_LIST)};
            pg8::gemm_phase<EpiScatter, SchedMoE<EHID, EHID, false>, false, EHID, EHID, EHID>(F.lds, S, E, F.tid);
            AMP_END(7); }
        SEAM(pb + 21);
    }
    if constexpr (KIND(13)) if (IN(45)) { PHASE_ENTRY final_phase(F, P); AMP_END(13); }
#undef IN
#undef KIND
#undef SEAM
#undef PHASE_ENTRY
}

#if !MK_ONE_LAUNCH
static int phase_kind(int ph) { if (ph == 0) return 0; if (ph == 45) return 13; static const int k22[22] = {1, 2, 3, 4, 5, 16, 17, 6, 7, 1, 8, 9, 10, 11, 14, 15, 4, 5, 16, 17, 6, 7}; return k22[(ph - 1) % 22]; }
typedef void (*kern_t)(Params);
template <unsigned KM> static kern_t kern_of() { return mega<KM>; }
static kern_t kind_kernel(int kind) {
    switch (kind) { case 0: return kern_of<1u << 0>(); case 1: return kern_of<1u << 1>(); case 2: return kern_of<1u << 2>(); case 3: return kern_of<1u << 3>(); case 4: return kern_of<1u << 4>();
        case 5: return kern_of<1u << 5>(); case 6: return kern_of<1u << 6>(); case 7: return kern_of<1u << 7>(); case 8: return kern_of<1u << 8>(); case 9: return kern_of<1u << 9>();
        case 10: return kern_of<1u << 10>(); case 11: return kern_of<1u << 11>(); case 12: return kern_of<1u << 12>(); case 14: return kern_of<1u << 14>(); case 15: return kern_of<1u << 15>(); case 16: return kern_of<1u << 16>(); case 17: return kern_of<1u << 17>(); default: return kern_of<1u << 13>(); }
}
#endif
extern "C" void kernel_launch(void* const* d_in, const int* in_sizes, int n_in, void* d_out, int out_size, void* d_ws, size_t ws_size, hipStream_t stream) {
    static int grid = 0;
    if (grid == 0) {
        if (n_in != 42 || out_size != TL * D || ws_size < WS_END) { fprintf(stderr, "kernel_launch: unexpected problem (n_in %d, out %d, ws %zu < %zu)\n", n_in, out_size, ws_size, (size_t)WS_END); grid = -1; return; }
        int dev = 0, cus = 0;
        if (hipGetDevice(&dev) != hipSuccess || hipDeviceGetAttribute(&cus, hipDeviceAttributeMultiprocessorCount, dev) != hipSuccess) { grid = -1; return; }
#if MK_ONE_LAUNCH
        if (hipFuncSetAttribute((const void*)mega<0x3ffffu>, hipFuncAttributeMaxDynamicSharedMemorySize, LDS_BYTES) != hipSuccess) { fprintf(stderr, "kernel_launch: hipFuncSetAttribute failed\n"); grid = -1; return; }
#else
        for (int k = 0; k < 18; ++k) if (hipFuncSetAttribute((const void*)kind_kernel(k), hipFuncAttributeMaxDynamicSharedMemorySize, LDS_BYTES) != hipSuccess) { fprintf(stderr, "kernel_launch: hipFuncSetAttribute failed\n"); grid = -1; return; }
#endif
        (void)hipGetLastError();
        grid = cus;
    }
    if (grid < 0) return;
    (void)hipMemsetAsync((char*)d_ws + WS_CTL, 0, CTL_BYTES, stream);
    Params p{};
    for (int i = 0; i < 42; ++i) p.in[i] = (const float*)d_in[i];
    p.out = (float*)d_out; p.ws = (unsigned char*)d_ws;
#if MK_ONE_LAUNCH
    p.ph_lo = 0; p.ph_hi = NPH;
    hipLaunchKernelGGL(mega<0x3ffffu>, dim3(grid), dim3(NTHR), LDS_BYTES, stream, p);
#else
    for (int ph = 0; ph < NPH; ++ph) { p.ph_lo = ph; p.ph_hi = ph + 1; hipLaunchKernelGGL(kind_kernel(phase_kind(ph)), dim3(grid), dim3(NTHR), LDS_BYTES, stream, p); }
#endif
}
```

```cpp
#include <hip/hip_runtime.h>
#include <cstdio>
#include <cstdint>

#define LAS __attribute__((address_space(3)))
typedef unsigned short bf16_t;
typedef short bf16x8 __attribute__((ext_vector_type(8)));
typedef float f32x4 __attribute__((ext_vector_type(4)));
typedef float f32x2 __attribute__((ext_vector_type(2)));
typedef unsigned u32x4 __attribute__((ext_vector_type(4)));
typedef unsigned u32x2 __attribute__((ext_vector_type(2)));

#ifndef CH_AMP
#define CH_AMP -1
#endif
#define CH_STAMP(i) do { if (CH_AMP >= 0) ch_t[i] = __builtin_amdgcn_s_memrealtime(); } while (0)
#ifndef AMP_MASK
#define AMP_MASK 0u
#endif
#define AMP_F 4
#ifndef MK_ONE_LAUNCH
#define MK_ONE_LAUNCH 1
#endif

constexpr int D = 1024, NBATCH = 2, SEQ = 16384, CTXL = 256, DEPTH = 4;
constexpr int TL = NBATCH * SEQ, TC = NBATCH * CTXL, T = TL + TC;
constexpr int GWID = 2048, NE = 32, EHID = 512, NH = 16, HD = 64;
constexpr int LISTCAP = T;
constexpr int MAXRT = (2 * T) / 256 + NE;
constexpr int NWAVES = 8, NTHR = 512;

constexpr size_t MiB = 1u << 20;
constexpr size_t WS_CTL = 0, CTL_BYTES = 1 * MiB;
constexpr size_t WS_MOD = 1 * MiB;
constexpr size_t WS_WIN = 2 * MiB, WS_WOUT = 18 * MiB, WS_WSP = 26 * MiB, WS_WR = 27 * MiB, WS_WK = 31 * MiB, WS_WV = 35 * MiB, WS_WO = 39 * MiB;
constexpr size_t WS_LW1 = 43 * MiB, WS_LA1 = 44 * MiB, WS_LG1 = 45 * MiB, WS_W2P = 46 * MiB, WS_A2P = 48 * MiB, WS_G2P = 50 * MiB;
constexpr size_t WS_WRT = 52 * MiB;
constexpr size_t WS_WGU = 54 * MiB, WS_WD = 118 * MiB;
constexpr size_t WS_X = 150 * MiB;
constexpr size_t WS_LIST = 280 * MiB, WS_WGT = 285 * MiB;
constexpr size_t WS_HL = 286 * MiB;
constexpr size_t WS_BIG = 351 * MiB;
constexpr size_t SZB = 65 * MiB;
constexpr size_t WS_U = WS_BIG, WS_V = WS_BIG + 2 * SZB, WS_STAT = WS_BIG + 4 * SZB;
constexpr size_t WS_XR = WS_BIG, WS_XW = WS_BIG + SZB, WS_XK = WS_BIG + 2 * SZB, WS_XV = WS_BIG + 3 * SZB, WS_XA = WS_BIG + 4 * SZB, WS_XG = WS_BIG + 5 * SZB;
constexpr size_t WS_R = WS_BIG + 6 * SZB, WS_K = WS_BIG + 7 * SZB, WS_VV = WS_BIG + 8 * SZB;
constexpr size_t WS_TW = WS_BIG + 9 * SZB, WS_TA = WS_TW + 17 * MiB, WS_TG = WS_TA + 17 * MiB;
constexpr size_t WS_ELOG0 = WS_XR, WS_ELOG1 = WS_XW, WS_KM0 = WS_XK, WS_KM1 = WS_XV, WS_AS0 = WS_XA, WS_AS1 = WS_XG;
constexpr size_t WS_GATE = WS_HL, WS_YG = WS_AS0, WS_BON = WS_TG + 17 * MiB;
constexpr size_t WS_H = WS_BIG, WS_YB = WS_BIG + 73 * MiB, WS_LG = WS_BIG + 204 * MiB;
constexpr size_t WS_PQ = WS_KM0;
constexpr size_t WS_SST = 215 * MiB;
constexpr size_t WS_END = WS_BON + 5 * MiB;
static_assert(WS_END <= 1080 * MiB, "workspace map");
constexpr int CW_BAR = 4096;
constexpr int CW_CNT = 16384;

__device__ __forceinline__ int wave_sgpr_now(int w) { asm volatile("" : "+s"(w)); return w; }
__device__ __forceinline__ int lane_id_now() { int l; asm volatile("v_mbcnt_lo_u32_b32 %0, -1, 0\n\tv_mbcnt_hi_u32_b32 %0, -1, %0" : "=v"(l)); return l; }
typedef short v4s __attribute__((ext_vector_type(4)));
#define LDS_BARRIER() asm volatile("s_waitcnt lgkmcnt(0)\n\ts_barrier" ::: "memory")
typedef __bf16 bf16x2_t __attribute__((ext_vector_type(2)));
__device__ __forceinline__ unsigned cvt_pk_bf16(float lo, float hi) { const bf16x2_t v = __builtin_convertvector((f32x2){lo, hi}, bf16x2_t); return __builtin_bit_cast(unsigned, v); }
__device__ __forceinline__ float bf_lo(unsigned u) { return __uint_as_float(u << 16); }
__device__ __forceinline__ float bf_hi(unsigned u) { return __uint_as_float(u & 0xffff0000u); }
__device__ __forceinline__ float bf1(bf16_t b) { return __uint_as_float(((unsigned)b) << 16); }
__device__ __forceinline__ bf16_t f2bf(float f) { return (bf16_t)(cvt_pk_bf16(f, 0.f) & 0x3ffffu); }
__device__ __forceinline__ void unpack8(const u32x4& w, float (&f)[8]) { f[0] = bf_lo(w.x); f[1] = bf_hi(w.x); f[2] = bf_lo(w.y); f[3] = bf_hi(w.y); f[4] = bf_lo(w.z); f[5] = bf_hi(w.z); f[6] = bf_lo(w.w); f[7] = bf_hi(w.w); }
__device__ __forceinline__ u32x4 pack8(const float (&f)[8]) { u32x4 o; o.x = cvt_pk_bf16(f[0], f[1]); o.y = cvt_pk_bf16(f[2], f[3]); o.z = cvt_pk_bf16(f[4], f[5]); o.w = cvt_pk_bf16(f[6], f[7]); return o; }
__device__ __forceinline__ float shx(float v, int m, int lane) { return __int_as_float(__builtin_amdgcn_ds_bpermute((lane ^ m) << 2, __float_as_int(v))); }
__device__ __forceinline__ float shup(float v, int d, int lane) { return __int_as_float(__builtin_amdgcn_ds_bpermute((lane - d) << 2, __float_as_int(v))); }
__device__ __forceinline__ float wave_sum(float v, int lane) {
#pragma unroll
    for (int o = 1; o < 64; o <<= 1) v += shx(v, o, lane);
    return v;
}
__device__ __forceinline__ float sigmoidf_(float x) { return 1.0f / (1.0f + __expf(-x)); }
__device__ __forceinline__ float tanhf_(float x) { const float e = __expf(2.0f * x); return 1.0f - 2.0f / (e + 1.0f); }
__device__ __forceinline__ f32x2 gelu_pk(f32x2 v) {
    const f32x2 av = __builtin_elementwise_abs(v), d = av * 0.2316418882f + 1.0f;
    f32x2 t; t.x = __builtin_amdgcn_rcpf(d.x); t.y = __builtin_amdgcn_rcpf(d.y);
    f32x2 q = t * 0.5307027145f + (-0.7265760135f); q = q * t + 0.7107068705f; q = q * t + (-0.142248368f); q = q * t + 0.127414796f; q = q * t;
    const f32x2 s = (v * v) * (-0.72134752044f);
    f32x2 e; e.x = __builtin_amdgcn_exp2f(s.x); e.y = __builtin_amdgcn_exp2f(s.y);
    const f32x2 m = v * (q * e), r = v - m;
    f32x2 o; o.x = v.x < 0.f ? m.x : r.x; o.y = v.y < 0.f ? m.y : r.y; return o;
}

#define XB_TMO      128
#define XB_XCNT(j)  (256  + 64 * (j))
#define XB_XSUB(j)  (1280 + 64 * (j))
#define XB_XGEN(j)  (2304 + 64 * (j))
#define XB_TOP      3328
#define XB_TOPGEN   3392
#define XCD_BAR_WORDS 3456
#define XB_SPIN_CAP (1u << 18)
__device__ __forceinline__ unsigned xb_ld(unsigned* p)              { return __hip_atomic_load(p, __ATOMIC_RELAXED, __HIP_MEMORY_SCOPE_AGENT); }
__device__ __forceinline__ unsigned xb_add(unsigned* p, unsigned v) { return __hip_atomic_fetch_add(p, v, __ATOMIC_RELAXED, __HIP_MEMORY_SCOPE_AGENT); }
__device__ __forceinline__ unsigned xb_xcc_id() { return (unsigned)__builtin_amdgcn_s_getreg((3 << 11) | 20) & 0xFu; }
#define XB_SPIN(cond, bar) do { unsigned _sp = 0; while (cond) { __builtin_amdgcn_s_sleep(1); \
    if ((++_sp & 255u) == 0u) { if (xb_ld(&(bar)[XB_TMO])) break; if (_sp > XB_SPIN_CAP) { atomicAdd(&(bar)[XB_TMO], 1u); break; } } } } while (0)
struct XcdBarrier { unsigned* bar; unsigned x; volatile LAS unsigned* st; };
__device__ __forceinline__ XcdBarrier xcd_barrier_post(unsigned* bar, volatile LAS unsigned* st) {
    XcdBarrier b; b.bar = bar; b.x = xb_xcc_id(); b.st = st;
    if (threadIdx.x == 0) (void)xb_add(&bar[XB_XCNT(b.x)], 1u);
    return b;
}
__device__ __forceinline__ void xcd_barrier_complete(unsigned* bar, unsigned x, unsigned& nloc, unsigned& nx) {
    const unsigned G = gridDim.x * gridDim.y * gridDim.z;
    unsigned sum, cnt, mine, sp = 0u;
    for (;;) {
        sum = 0u; cnt = 0u; mine = 0u;
#pragma unroll
        for (unsigned j = 0; j < 16; ++j) { const unsigned c = xb_ld(&bar[XB_XCNT(j)]); sum += c; cnt += (c > 0u) ? 1u : 0u; mine = (j == x) ? c : mine; }
        if (sum == G) break;
        __builtin_amdgcn_s_sleep(1);
        if ((++sp & 255u) == 0u) { if (xb_ld(&bar[XB_TMO])) break; if (sp > XB_SPIN_CAP) { atomicAdd(&bar[XB_TMO], 1u); break; } }
    }
    nloc = mine > 0u ? mine : 1u; nx = cnt > 0u ? cnt : 1u;
}
template <bool FIRST> __device__ __forceinline__ void xcd_barrier(const XcdBarrier& b, const bool leader) {
    asm volatile("s_waitcnt vmcnt(0)" ::: "memory");
    __syncthreads();
    if (leader) {
        unsigned* bar = b.bar;
        __builtin_amdgcn_s_waitcnt(0);
        unsigned nloc = b.st[0], nx = b.st[1];
        if constexpr (FIRST) { if (nloc == 0u) { xcd_barrier_complete(bar, b.x, nloc, nx); b.st[0] = nloc; b.st[1] = nx; } }
        const unsigned old = xb_add(&bar[XB_XSUB(b.x)], 1u);
        const unsigned gen = old / nloc;
        if (old + 1u == (gen + 1u) * nloc) {
            __builtin_amdgcn_fence(__ATOMIC_RELEASE, "agent");
            asm volatile("s_waitcnt vmcnt(0)" ::: "memory");
            const unsigned og = xb_add(&bar[XB_TOP], 1u);
            const unsigned tg = og / nx;
            if (og + 1u == (tg + 1u) * nx) xb_add(&bar[XB_TOPGEN], 1u);
            else XB_SPIN(xb_ld(&bar[XB_TOPGEN]) == tg, bar);
            __builtin_amdgcn_fence(__ATOMIC_ACQUIRE, "agent");
            xb_add(&bar[XB_XGEN(b.x)], 1u);
            asm volatile("s_waitcnt vmcnt(0)" ::: "memory");
        } else {
            XB_SPIN(xb_ld(&bar[XB_XGEN(b.x)]) == gen, bar);
            __builtin_amdgcn_fence(__ATOMIC_ACQUIRE, "agent");
            asm volatile("s_waitcnt vmcnt(0)" ::: "memory");
        }
    }
    __syncthreads();
}

constexpr int LDS_MISC = 143360;
constexpr int LDS_DESC = LDS_MISC + 128;
constexpr int LDS_TAB = LDS_MISC + 512;
constexpr int LDS_BYTES = 147456;
namespace pg8 {
constexpr int BM = 256, BK = 64, HALF = 128, HTB = HALF * BK * 2, STAGE_BYTES = 8 * HTB, NXCD = 8, WGM = 8;
__host__ __device__ __forceinline__ int lds_byte(int r, int c) { const int st = (r >> 4) * 2 + (c >> 5), rr = r & 15, cc = c & 31, ob = rr * 64 + cc * 2; return st * 1024 + (ob ^ (((ob >> 9) & 1) << 5)); }
__host__ __device__ __forceinline__ void stage_rc(int b, int& R, int& C) { const int st = b / 1024, sb = b % 1024, swz = sb ^ (((sb >> 9) & 1) << 5); R = (st >> 1) * 16 + swz / 64; C = (st & 1) * 32 + (swz % 64) / 2; }
__host__ __device__ __forceinline__ int perm32(int rho) { const int n = rho >> 4, i = rho & 15; return 8 * (i >> 2) + 4 * n + (i & 3); }
__device__ __forceinline__ int xcd_remap(int L, int nwg) { const int q = nwg / NXCD, r = nwg % NXCD, xcd = L % NXCD, off = L / NXCD; return (xcd < r ? xcd * (q + 1) : r * (q + 1) + (xcd - r) * q) + off; }

struct Unit { int pm, pn, aux; };

template <class Epi, class Sched, bool GATHER, int K, int LDA, int LDB>
__device__ __forceinline__ void gemm_phase(LAS unsigned char* lds, const Sched& S, const Epi& E, const int tid_in) {
    int tid_ = tid_in; asm volatile("" : "+v"(tid_));
    const int tid = tid_, wid = __builtin_amdgcn_readfirstlane(tid >> 6), lane = tid & 63, wr = wid >> 2, wc = wid & 3, fr = lane & 15, fq = lane >> 4;
    constexpr int nt = K / BK;
    unsigned voffA[2], voffB[2];
#pragma unroll
    for (int i = 0; i < 2; ++i) { int R, C; stage_rc(tid * 16 + i * 8192, R, C); const int Rb = Epi::PERM ? ((R & ~31) + perm32(R & 31)) : R;
        voffA[i] = (unsigned)(R * LDA + C) * 2u; voffB[i] = (unsigned)(Rb * LDB + C) * 2u; }
    constexpr size_t kstep = (size_t)(BK * 2);
    constexpr size_t hstepA = GATHER ? (size_t)0 : (size_t)HALF * LDA * 2, hstepB = (size_t)HALF * LDB * 2;
    const unsigned ldsw = (unsigned)wid * 1024u;
    const int aoff = lds_byte(wr * 64 + fr, fq * 8), boff = lds_byte(wc * 32 + fr, fq * 8);
    unsigned gA[2][2], gN[2][2];
#define PG8_SA(b, h) (((b) * 2 + (h)) * HTB)
#define PG8_SB(b, h) ((4 + (b) * 2 + (h)) * HTB)
#define PG8_STAGEB(bufoff, gbase) do { _Pragma("unroll") for (int _i = 0; _i < 2; ++_i) \
        __builtin_amdgcn_global_load_lds((const unsigned*)((const char*)(gbase) + voffB[_i]), (LAS unsigned*)(lds + (bufoff) + ldsw + _i * 8192), 16, 0, 0); } while (0)
#define PG8_STAGEA(bufoff, gbase, h, GV) do { _Pragma("unroll") for (int _i = 0; _i < 2; ++_i) \
        __builtin_amdgcn_global_load_lds((const unsigned*)((const char*)(gbase) + (GATHER ? GV[h][_i] : voffA[_i]) + (h) * hstepA), (LAS unsigned*)(lds + (bufoff) + ldsw + _i * 8192), 16, 0, 0); } while (0)
#define PG8_LDA(dst, b, h) do { _Pragma("unroll") for (int m = 0; m < 4; ++m) _Pragma("unroll") for (int k = 0; k < 2; ++k) dst[m][k] = *(const LAS bf16x8*)(lds + PG8_SA(b, h) + aoff + m * 2048 + k * 1024); } while (0)
#define PG8_LDB(dst, b, h) do { _Pragma("unroll") for (int n = 0; n < 2; ++n) _Pragma("unroll") for (int k = 0; k < 2; ++k) dst[n][k] = *(const LAS bf16x8*)(lds + PG8_SB(b, h) + boff + n * 2048 + k * 1024); } while (0)
#define PG8_MMA(ai, bj, At, Bt) do { __builtin_amdgcn_s_setprio(1); _Pragma("unroll") for (int m = 0; m < 4; ++m) _Pragma("unroll") for (int n = 0; n < 2; ++n) _Pragma("unroll") for (int k = 0; k < 2; ++k) \
        acc[ai][bj][m][n] = __builtin_amdgcn_mfma_f32_16x16x32_bf16(Bt[n][k], At[m][k], acc[ai][bj][m][n], 0, 0, 0); __builtin_amdgcn_s_setprio(0); } while (0)
#define PG8_WAIT_V(n) asm volatile("s_waitcnt vmcnt(" #n ")" ::: "memory")
#define PG8_WAIT_L(n) asm volatile("s_waitcnt lgkmcnt(" #n ")" ::: "memory")
#define PG8_BAR __builtin_amdgcn_s_barrier()
#define PG8_SCHED __builtin_amdgcn_sched_barrier(0)
    Unit cur, nxt; int ui = 0;
    if (!S.next(0, cur)) return;
    f32x4 acc[2][2][4][2];
#pragma unroll
    for (int a = 0; a < 2; ++a)
#pragma unroll
        for (int b = 0; b < 2; ++b)
#pragma unroll
            for (int m = 0; m < 4; ++m)
#pragma unroll
                for (int n = 0; n < 2; ++n) acc[a][b][m][n] = (f32x4){0.f, 0.f, 0.f, 0.f};
    bf16x8 At[4][2], B0[2][2], B1[2][2];
    const char* cA = S.aptr(cur); const char* cB = S.bptr(cur);
    if constexpr (GATHER) { S.gather(cur, tid, gA); }
    PG8_STAGEB(PG8_SB(0, 0), cB); PG8_STAGEB(PG8_SB(0, 1), cB + hstepB); PG8_STAGEA(PG8_SA(0, 0), cA, 0, gA); PG8_STAGEA(PG8_SA(0, 1), cA, 1, gA);
    if (wr == 1) PG8_BAR;
    PG8_WAIT_V(2); PG8_BAR;
    PG8_STAGEB(PG8_SB(1, 0), cB + kstep); PG8_STAGEA(PG8_SA(1, 0), cA + kstep, 0, gA); PG8_STAGEB(PG8_SB(1, 1), cB + hstepB + kstep);
    PG8_WAIT_V(6); PG8_BAR;
    for (;;) {
        const bool has_next = S.next(ui + 1, nxt);
        const char* nA = has_next ? S.aptr(nxt) : cA; const char* nB = has_next ? S.bptr(nxt) : cB;
        if constexpr (GATHER) { if (has_next) S.gather(nxt, tid, gN); else {
#pragma unroll
            for (int h = 0; h < 2; ++h)
#pragma unroll
                for (int i = 0; i < 2; ++i) gN[h][i] = gA[h][i]; } }
#pragma nounroll
        for (int t = 0; t < nt; t += 2) {
            const bool last = (t == nt - 2);
            const char* a1 = cA + (size_t)(t + 1) * kstep;
            const char* a2 = last ? nA : cA + (size_t)(t + 2) * kstep; const char* b2 = last ? nB : cB + (size_t)(t + 2) * kstep;
            const char* a3 = a2 + kstep; const char* b3 = b2 + kstep;
            unsigned g2[2][2];
            if constexpr (GATHER) {
#pragma unroll
                for (int h = 0; h < 2; ++h)
#pragma unroll
                    for (int i = 0; i < 2; ++i) g2[h][i] = last ? gN[h][i] : gA[h][i]; }
            PG8_LDB(B0, 0, 0); PG8_LDB(B1, 0, 1); PG8_SCHED; PG8_LDA(At, 0, 0); PG8_STAGEA(PG8_SA(1, 1), a1, 1, gA);
            PG8_WAIT_V(8); PG8_WAIT_L(0); PG8_BAR; PG8_MMA(0, 0, At, B0); PG8_MMA(0, 1, At, B1); PG8_BAR; PG8_SCHED;
            PG8_LDA(At, 0, 1); PG8_STAGEB(PG8_SB(0, 0), b2); PG8_STAGEB(PG8_SB(0, 1), b2 + hstepB); PG8_STAGEA(PG8_SA(0, 0), a2, 0, g2);
            PG8_WAIT_V(8); PG8_WAIT_L(0); PG8_BAR; PG8_MMA(1, 0, At, B0); PG8_MMA(1, 1, At, B1); PG8_BAR; PG8_SCHED;
            PG8_LDB(B0, 1, 0); PG8_LDB(B1, 1, 1); PG8_SCHED; PG8_LDA(At, 1, 0); PG8_STAGEA(PG8_SA(0, 1), a2, 1, g2);
            PG8_WAIT_V(8); PG8_WAIT_L(0); PG8_BAR; PG8_MMA(0, 0, At, B0); PG8_MMA(0, 1, At, B1); PG8_BAR; PG8_SCHED;
            PG8_LDA(At, 1, 1); PG8_STAGEB(PG8_SB(1, 0), b3); PG8_STAGEB(PG8_SB(1, 1), b3 + hstepB); PG8_STAGEA(PG8_SA(1, 0), a3, 0, g2);
            PG8_WAIT_V(8); PG8_WAIT_L(0); PG8_BAR; PG8_MMA(1, 0, At, B0); PG8_MMA(1, 1, At, B1); PG8_BAR; PG8_SCHED;
        }
        if (wr == 0) PG8_BAR;
        E(acc, cur, wr, wc, fr, fq);
        if (!has_next) break;
#pragma unroll
        for (int a = 0; a < 2; ++a)
#pragma unroll
            for (int b = 0; b < 2; ++b)
#pragma unroll
                for (int m = 0; m < 4; ++m)
#pragma unroll
                    for (int n = 0; n < 2; ++n) acc[a][b][m][n] = (f32x4){0.f, 0.f, 0.f, 0.f};
        cur = nxt; cA = nA; cB = nB; ++ui;
        if constexpr (GATHER) {
#pragma unroll
            for (int h = 0; h < 2; ++h)
#pragma unroll
                for (int i = 0; i < 2; ++i) gA[h][i] = gN[h][i]; }
        if (wr == 1) PG8_BAR;
    }
    PG8_WAIT_V(0);
    PG8_BAR;
#undef PG8_SA
#undef PG8_SB
#undef PG8_STAGEA
#undef PG8_STAGEB
#undef PG8_LDA
#undef PG8_LDB
#undef PG8_MMA
#undef PG8_WAIT_V
#undef PG8_WAIT_L
#undef PG8_BAR
#undef PG8_SCHED
}
}
using pg8::Unit;

__device__ __forceinline__ void set_desc(LAS unsigned char* lds, int tid, int g, const void* A, const void* B, const void* C, int nN, int ldc, int aux, const void* X1 = nullptr, const void* X2 = nullptr, const void* X3 = nullptr) {
    LAS int* d = (LAS int*)(lds + LDS_DESC) + g * 16;
    if (tid == 0) { unsigned long long a = (unsigned long long)A, b = (unsigned long long)B, c = (unsigned long long)C, x1 = (unsigned long long)X1, x2 = (unsigned long long)X2, x3 = (unsigned long long)X3;
        asm volatile("" : "+s"(a), "+s"(b), "+s"(c), "+s"(x1), "+s"(x2), "+s"(x3), "+s"(nN), "+s"(ldc), "+s"(aux));
        d[0] = (int)(unsigned)a; d[1] = (int)(unsigned)(a >> 32); d[2] = (int)(unsigned)b; d[3] = (int)(unsigned)(b >> 32); d[4] = (int)(unsigned)c; d[5] = (int)(unsigned)(c >> 32); d[6] = nN; d[7] = ldc; d[8] = aux;
        d[10] = (int)(unsigned)x1; d[11] = (int)(unsigned)(x1 >> 32); d[12] = (int)(unsigned)x2; d[13] = (int)(unsigned)(x2 >> 32); d[14] = (int)(unsigned)x3; d[15] = (int)(unsigned)(x3 >> 32); }
}
__device__ __forceinline__ int desc_i(LAS unsigned char* lds, int g, int f) { return __builtin_amdgcn_readfirstlane(((LAS const int*)(lds + LDS_DESC))[g * 16 + f]); }
__device__ __forceinline__ const char* desc_p(LAS unsigned char* lds, int g, int f) {
    const unsigned lo = (unsigned)desc_i(lds, g, f), hi = (unsigned)desc_i(lds, g, f + 1); return (const char*)(((unsigned long long)hi << 32) | lo); }
template <int LDA, int LDB>
struct SchedMulti {
    LAS unsigned char* lds; int nM, ntot, ng;
    __device__ __forceinline__ bool next(int i, Unit& u) const {
        const int nwg = nM * ntot; const long L = (long)i * gridDim.x + blockIdx.x; if (L >= nwg) return false;
        const int wgid = pg8::xcd_remap((int)L, nwg);
        const int nig = pg8::WGM * ntot, gid = wgid / nig, fm = gid * pg8::WGM, gsz = (nM - fm) < pg8::WGM ? (nM - fm) : pg8::WGM;
        u.pm = fm + ((wgid % nig) % gsz); int pv = (wgid % nig) / gsz; int g = 0;
        for (int j = 0; j + 1 < ng; ++j) { const int n = desc_i(lds, j, 6); if (pv < n) break; pv -= n; g = j + 1; }
        u.pn = pv; u.aux = g; return true;
    }
    __device__ __forceinline__ const char* aptr(const Unit& u) const { return desc_p(lds, u.aux, 0) + (size_t)u.pm * (512 * LDA); }
    __device__ __forceinline__ const char* bptr(const Unit& u) const { return desc_p(lds, u.aux, 2) + (size_t)u.pn * (512 * LDB); }
};
template <int LDA, int LDB, bool GATHERED>
struct SchedMoE {
    LAS unsigned char* lds; const char* Abase; const char* Bbase; const int* list;
    __device__ __forceinline__ bool next(int i, Unit& u) const {
        LAS const int* tab = (LAS const int*)(lds + LDS_TAB);
        const int nrt = __builtin_amdgcn_readfirstlane(tab[2 * MAXRT + 32]);
        const int nwg = nrt * 4; const long L = (long)i * gridDim.x + blockIdx.x; if (L >= nwg) return false;
        const int wgid = pg8::xcd_remap((int)L, nwg);
        u.pm = wgid >> 2; u.pn = wgid & 3; u.aux = __builtin_amdgcn_readfirstlane(tab[u.pm]); return true;
    }
    __device__ __forceinline__ const char* aptr(const Unit& u) const { return GATHERED ? Abase : Abase + (size_t)u.pm * (512 * LDA); }
    __device__ __forceinline__ const char* bptr(const Unit& u) const { return Bbase + (size_t)u.aux * ((size_t)D * LDB * 2) + (size_t)u.pn * (512 * LDB); }
    __device__ __forceinline__ void gather(const Unit& u, int tid, unsigned (&g)[2][2]) const {
        LAS const int* tab = (LAS const int*)(lds + LDS_TAB);
        const int j0 = __builtin_amdgcn_readfirstlane(tab[MAXRT + u.pm]), cn = __builtin_amdgcn_readfirstlane(tab[2 * MAXRT + u.aux]);
#pragma unroll
        for (int i = 0; i < 2; ++i) { int R, C; pg8::stage_rc(tid * 16 + i * 8192, R, C);
#pragma unroll
            for (int h = 0; h < 2; ++h) { const int slot = j0 + 128 * h + R; const int a = slot < cn ? list[(size_t)u.aux * LISTCAP + slot] : 0;
                g[h][i] = (unsigned)((a >> 1) * LDA + C) * 2u; } }
    }
};
__device__ __forceinline__ void moe_tables(LAS unsigned char* lds, int tid, const unsigned* cnt) {
    LAS int* tab = (LAS int*)(lds + LDS_TAB);
    __syncthreads();
    if (tid < 64) {
        const int e = tid & 31; const bool act = tid < NE;
        const int c = act ? (int)__hip_atomic_load(cnt + e, __ATOMIC_RELAXED, __HIP_MEMORY_SCOPE_AGENT) : 0;
        const int nt = (c + 255) >> 8; int incl = nt;
#pragma unroll
        for (int d = 1; d < 32; d <<= 1) { const int t = __builtin_amdgcn_ds_bpermute((tid >= d ? tid - d : tid) << 2, incl); if (tid >= d) incl += t; }
        if (act) { const int start = incl - nt; tab[2 * MAXRT + e] = c;
#pragma nounroll
            for (int j = 0; j < nt; ++j) { tab[start + j] = e; tab[MAXRT + start + j] = j * 256; }
            if (tid == NE - 1) tab[2 * MAXRT + 32] = incl; }
    }
    __syncthreads();
}

#define EPI_FENCE() asm volatile("" ::: "memory")
struct EpiGelu {
    static constexpr bool PERM = true;
    LAS unsigned char* lds;
    __device__ __forceinline__ void operator()(const f32x4 (&acc)[2][2][4][2], const Unit& u, int wr, int wc, int fr, int fq) const {
        const bool isv = u.pn >= 8; bf16_t* base = (bf16_t*)desc_p(lds, 0, isv ? 10 : 4); const float* bias = (const float*)desc_p(lds, 0, 12); float* stat = (float*)desc_p(lds, 0, 14);
        const int col0 = (u.pn & 7) * 256 + wc * 32 + 8 * fq, bcol0 = u.pn * 256 + wc * 32 + 8 * fq, row0 = u.pm * 256 + wr * 64 + fr;
        f32x4 bv[2][2];
#pragma unroll
        for (int bj = 0; bj < 2; ++bj)
#pragma unroll
            for (int n = 0; n < 2; ++n) bv[bj][n] = *(const f32x4*)(bias + bcol0 + bj * 128 + 4 * n);
#pragma unroll
        for (int ai = 0; ai < 2; ++ai)
#pragma unroll
            for (int m = 0; m < 4; ++m) { const int row = row0 + ai * 128 + m * 16; bf16_t* rowp = base + (size_t)row * GWID + col0; float s = 0.f, q = 0.f;
#pragma unroll
                for (int bj = 0; bj < 2; ++bj) { const f32x4 v0 = acc[ai][bj][m][0] + bv[bj][0], v1 = acc[ai][bj][m][1] + bv[bj][1];
                    const f32x2 a = gelu_pk((f32x2){v0[0], v0[1]}), b = gelu_pk((f32x2){v0[2], v0[3]}), c = gelu_pk((f32x2){v1[0], v1[1]}), d = gelu_pk((f32x2){v1[2], v1[3]});
                    s += ((a.x + a.y) + (b.x + b.y)) + ((c.x + c.y) + (d.x + d.y));
                    q += ((a.x * a.x + a.y * a.y) + (b.x * b.x + b.y * b.y)) + ((c.x * c.x + c.y * c.y) + (d.x * d.x + d.y * d.y));
                    u32x4 w; w.x = cvt_pk_bf16(a.x, a.y); w.y = cvt_pk_bf16(b.x, b.y); w.z = cvt_pk_bf16(c.x, c.y); w.w = cvt_pk_bf16(d.x, d.y);
                    *(u32x4*)(rowp + bj * 128) = w; }
                if (isv) { const int ln_ = 16 * fq + fr; s += shx(s, 16, ln_); s += shx(s, 32, ln_); q += shx(q, 16, ln_); q += shx(q, 32, ln_);
                    if (fq == 0) *(f32x2*)(stat + ((size_t)row * 32 + (u.pn - 8) * 4 + wc) * 2) = (f32x2){s, q}; } }
    }
};
struct EpiResid {
    static constexpr bool PERM = true;
    LAS unsigned char* lds;
    __device__ __forceinline__ void operator()(const f32x4 (&acc)[2][2][4][2], const Unit& u, int wr, int wc, int fr, int fq) const {
        const int mrow = u.pm < 64 ? 0 : (u.pm < 128 ? 1 : 2);
        bf16_t* x = (bf16_t*)desc_p(lds, 0, 4) + (size_t)(u.pm * 256 + wr * 64 + fr) * D + u.pn * 256 + wc * 32 + 8 * fq;
        const float* bias = (const float*)desc_p(lds, 0, 14); const float* gate = (const float*)desc_p(lds, 1, 10) + mrow * 6 * D + u.pn * 256 + wc * 32 + 8 * fq;
        if (bias) bias += u.pn * 256 + wc * 32 + 8 * fq;
#pragma unroll
        for (int bj = 0; bj < 2; ++bj) { const int c = bj * 128;
            const f32x4 b0 = bias ? *(const f32x4*)(bias + c) : (f32x4){0.f, 0.f, 0.f, 0.f}, b1 = bias ? *(const f32x4*)(bias + c + 4) : (f32x4){0.f, 0.f, 0.f, 0.f};
            const f32x4 g0 = *(const f32x4*)(gate + c), g1 = *(const f32x4*)(gate + c + 4);
            u32x4 xw[2][4];
#pragma unroll
            for (int ai = 0; ai < 2; ++ai)
#pragma unroll
                for (int m = 0; m < 4; ++m) xw[ai][m] = *(const u32x4*)(x + (size_t)(ai * 128 + m * 16) * D + c);
#pragma unroll
            for (int ai = 0; ai < 2; ++ai) {
#pragma unroll
                for (int m = 0; m < 4; ++m) { const u32x4 w = xw[ai][m];
                    const f32x4 o0 = (f32x4){bf_lo(w.x), bf_hi(w.x), bf_lo(w.y), bf_hi(w.y)} + g0 * (acc[ai][bj][m][0] + b0), o1 = (f32x4){bf_lo(w.z), bf_hi(w.z), bf_lo(w.w), bf_hi(w.w)} + g1 * (acc[ai][bj][m][1] + b1);
                    u32x4 w2; w2.x = cvt_pk_bf16(o0[0], o0[1]); w2.y = cvt_pk_bf16(o0[2], o0[3]); w2.z = cvt_pk_bf16(o1[0], o1[1]); w2.w = cvt_pk_bf16(o1[2], o1[3]);
                    *(u32x4*)(x + (size_t)(ai * 128 + m * 16) * D + c) = w2; }
                EPI_FENCE(); } }
    }
};
template <int K>
__device__ __forceinline__ void tail_resid(LAS unsigned char* lds, int wave) {
    const int lane = lane_id_now(), fr = lane & 15, q = lane >> 4, tid = wave * 64 + lane;
    constexpr int KW = K / 8, RP = 68;
    LAS float* red = (LAS float*)lds;
    const bf16_t* A = (const bf16_t*)desc_p(lds, 0, 0) + (size_t)TL * K; const bf16_t* W = (const bf16_t*)desc_p(lds, 0, 2);
    bf16_t* X = (bf16_t*)desc_p(lds, 0, 4) + (size_t)TL * D; const float* bias = (const float*)desc_p(lds, 0, 14); const float* gate = (const float*)desc_p(lds, 1, 10) + 2 * 6 * D;
    for (int item = blockIdx.x; item < TC / 16 * 16; item += gridDim.x) {
        const int r0 = (item >> 4) * 16, c0 = (item & 15) * 64;
        const bf16_t* ap = A + (size_t)(r0 + fr) * K + wave * KW + 16 * q;
        const bf16_t* bp = W + (size_t)(c0 + fr) * K + wave * KW + 16 * q;
        f32x4 acc[4];
#pragma unroll
        for (int n = 0; n < 4; ++n) acc[n] = (f32x4){0.f, 0.f, 0.f, 0.f};
#pragma unroll
        for (int kb = 0; kb < KW / 64; ++kb) {
            const bf16x8 a0 = *(const bf16x8*)(ap + kb * 64), a1 = *(const bf16x8*)(ap + kb * 64 + 8);
#pragma unroll
            for (int n = 0; n < 4; ++n) { const bf16x8 b0 = *(const bf16x8*)(bp + (size_t)n * 16 * K + kb * 64), b1 = *(const bf16x8*)(bp + (size_t)n * 16 * K + kb * 64 + 8);
                acc[n] = __builtin_amdgcn_mfma_f32_16x16x32_bf16(a0, b0, acc[n], 0, 0, 0); acc[n] = __builtin_amdgcn_mfma_f32_16x16x32_bf16(a1, b1, acc[n], 0, 0, 0); }
        }
#pragma unroll
        for (int n = 0; n < 4; ++n)
#pragma unroll
            for (int r = 0; r < 4; ++r) red[(wave * 16 + 4 * q + r) * RP + n * 16 + fr] = acc[n][r];
        __syncthreads();
        { const int row = tid >> 5, c2 = 2 * (tid & 31); float s0 = 0.f, s1 = 0.f;
#pragma unroll
          for (int w = 0; w < 8; ++w) { const f32x2 v = *(LAS const f32x2*)(red + (w * 16 + row) * RP + c2); s0 += v.x; s1 += v.y; }
          const int col = c0 + c2; bf16_t* p = X + (size_t)(r0 + row) * D + col; const unsigned xw = *(const unsigned*)p;
          const float b0 = bias ? bias[col] : 0.f, b1 = bias ? bias[col + 1] : 0.f;
          *(unsigned*)p = cvt_pk_bf16(bf_lo(xw) + gate[col] * (s0 + b0), bf_hi(xw) + gate[col + 1] * (s1 + b1)); }
        __syncthreads();
    }
}
__device__ __forceinline__ void tail_gelu(LAS unsigned char* lds, int wave) {
    const int lane = lane_id_now(), fr = lane & 15, q = lane >> 4, tid = wave * 64 + lane;
    constexpr int K = D, KW = K / 8, RP = 260;
    LAS float* red = (LAS float*)lds;
    const bf16_t* A = (const bf16_t*)desc_p(lds, 0, 0) + (size_t)TL * K; const bf16_t* W = (const bf16_t*)desc_p(lds, 0, 2);
    const float* bias = (const float*)desc_p(lds, 0, 12); float* stat = (float*)desc_p(lds, 0, 14);
    for (int item = blockIdx.x; item < TC / 16 * 16; item += gridDim.x) {
        const int r0 = (item >> 4) * 16, c0 = (item & 15) * 256;
        const bf16_t* ap = A + (size_t)(r0 + fr) * K + wave * KW + 16 * q;
        const bf16_t* bp = W + (size_t)(c0 + fr) * K + wave * KW + 16 * q;
        const bf16x8 a0 = *(const bf16x8*)(ap), a1 = *(const bf16x8*)(ap + 8), a2 = *(const bf16x8*)(ap + 64), a3 = *(const bf16x8*)(ap + 72);
#pragma unroll 1
        for (int ng = 0; ng < 4; ++ng) {
            f32x4 acc[4];
#pragma unroll
            for (int n = 0; n < 4; ++n) { const bf16_t* b = bp + (size_t)(ng * 4 + n) * 16 * K;
                const bf16x8 b0 = *(const bf16x8*)(b), b1 = *(const bf16x8*)(b + 8), b2 = *(const bf16x8*)(b + 64), b3 = *(const bf16x8*)(b + 72);
                f32x4 c = (f32x4){0.f, 0.f, 0.f, 0.f};
                c = __builtin_amdgcn_mfma_f32_16x16x32_bf16(a0, b0, c, 0, 0, 0); c = __builtin_amdgcn_mfma_f32_16x16x32_bf16(a1, b1, c, 0, 0, 0);
                c = __builtin_amdgcn_mfma_f32_16x16x32_bf16(a2, b2, c, 0, 0, 0); c = __builtin_amdgcn_mfma_f32_16x16x32_bf16(a3, b3, c, 0, 0, 0); acc[n] = c; }
#pragma unroll
            for (int n = 0; n < 4; ++n)
#pragma unroll
                for (int r = 0; r < 4; ++r) red[(wave * 16 + 4 * q + r) * RP + (ng * 4 + n) * 16 + fr] = acc[n][r];
        }
        __syncthreads();
        { const int row = tid >> 5, c8 = 8 * (tid & 31); f32x4 s0 = (f32x4){0.f, 0.f, 0.f, 0.f}, s1 = s0;
#pragma unroll
          for (int w = 0; w < 8; ++w) { s0 += *(LAS const f32x4*)(red + (w * 16 + row) * RP + c8); s1 += *(LAS const f32x4*)(red + (w * 16 + row) * RP + c8 + 4); }
          const int col = c0 + c8; const bool isv = col >= GWID; bf16_t* base = (bf16_t*)desc_p(lds, 0, isv ? 10 : 4);
          s0 += *(const f32x4*)(bias + col); s1 += *(const f32x4*)(bias + col + 4);
          const f32x2 a = gelu_pk((f32x2){s0[0], s0[1]}), b = gelu_pk((f32x2){s0[2], s0[3]}), c = gelu_pk((f32x2){s1[0], s1[1]}), d = gelu_pk((f32x2){s1[2], s1[3]});
          u32x4 w; w.x = cvt_pk_bf16(a.x, a.y); w.y = cvt_pk_bf16(b.x, b.y); w.z = cvt_pk_bf16(c.x, c.y); w.w = cvt_pk_bf16(d.x, d.y);
          *(u32x4*)(base + (size_t)(TL + r0 + row) * GWID + (col & (GWID - 1))) = w;
          if (isv) { float s = ((a.x + a.y) + (b.x + b.y)) + ((c.x + c.y) + (d.x + d.y)), qq = ((a.x * a.x + a.y * a.y) + (b.x * b.x + b.y * b.y)) + ((c.x * c.x + c.y * c.y) + (d.x * d.x + d.y * d.y));
              s += shx(s, 1, lane); s += shx(s, 2, lane); s += shx(s, 4, lane); qq += shx(qq, 1, lane); qq += shx(qq, 2, lane); qq += shx(qq, 4, lane);
              if ((lane & 7) == 0) *(f32x2*)(stat + ((size_t)(TL + r0 + row) * 32 + ((col - GWID) >> 6)) * 2) = (f32x2){s, qq}; } }
        __syncthreads();
    }
}
struct EpiAct {
    static constexpr bool PERM = true;
    LAS unsigned char* lds;
    __device__ __forceinline__ void operator()(const f32x4 (&acc)[2][2][4][2], const Unit& u, int wr, int wc, int fr, int fq) const {
        bf16_t* C = (bf16_t*)desc_p(lds, u.aux, 4); const int ldc = desc_i(lds, u.aux, 7), act = desc_i(lds, u.aux, 8);
        const int col0 = u.pn * 256 + wc * 32 + 8 * fq, row0 = u.pm * 256 + wr * 64 + fr;
#pragma unroll
        for (int ai = 0; ai < 2; ++ai)
#pragma unroll
            for (int m = 0; m < 4; ++m) { bf16_t* rowp = C + (size_t)(row0 + ai * 128 + m * 16) * ldc + col0;
#pragma unroll
                for (int bj = 0; bj < 2; ++bj) { f32x4 v0 = acc[ai][bj][m][0], v1 = acc[ai][bj][m][1];
                    if (act == 1) {
#pragma unroll
                        for (int j = 0; j < 4; ++j) { v0[j] = tanhf_(v0[j]); v1[j] = tanhf_(v1[j]); } }
                    else if (act == 2) {
#pragma unroll
                        for (int j = 0; j < 4; ++j) { v0[j] = sigmoidf_(v0[j]); v1[j] = sigmoidf_(v1[j]); } }
                    u32x4 w; w.x = cvt_pk_bf16(v0[0], v0[1]); w.y = cvt_pk_bf16(v0[2], v0[3]); w.z = cvt_pk_bf16(v1[0], v1[1]); w.w = cvt_pk_bf16(v1[2], v1[3]);
                    *(u32x4*)(rowp + bj * 128) = w; } }
    }
};
struct EpiLogits {
    static constexpr bool PERM = false;
    float* LG;
    __device__ __forceinline__ void operator()(const f32x4 (&acc)[2][2][4][2], const Unit& u, int wr, int wc, int fr, int fq) const {
        if (wc >= 2) return;
        const int col0 = wc * 32 + 4 * fq, row0 = u.pm * 256 + wr * 64 + fr;
#pragma unroll
        for (int ai = 0; ai < 2; ++ai)
#pragma unroll
            for (int m = 0; m < 4; ++m)
#pragma unroll
                for (int n = 0; n < 2; ++n) *(f32x4*)(LG + (size_t)(row0 + ai * 128 + m * 16) * 64 + col0 + n * 16) = acc[ai][0][m][n] + acc[ai][1][m][n];
    }
};
struct EpiSiluGate {
    static constexpr bool PERM = true;
    bf16_t* H;
    __device__ __forceinline__ void operator()(const f32x4 (&acc)[2][2][4][2], const Unit& u, int wr, int wc, int fr, int fq) const {
        const int col0 = u.pn * 128 + wc * 32 + 8 * fq, row0 = u.pm * 256 + wr * 64 + fr;
#pragma unroll
        for (int ai = 0; ai < 2; ++ai)
#pragma unroll
            for (int m = 0; m < 4; ++m) { f32x4 h0, h1;
#pragma unroll
                for (int j = 0; j < 4; ++j) { const float g0 = acc[ai][0][m][0][j], g1 = acc[ai][0][m][1][j]; h0[j] = g0 * sigmoidf_(g0) * acc[ai][1][m][0][j]; h1[j] = g1 * sigmoidf_(g1) * acc[ai][1][m][1][j]; }
                u32x4 w; w.x = cvt_pk_bf16(h0[0], h0[1]); w.y = cvt_pk_bf16(h0[2], h0[3]); w.z = cvt_pk_bf16(h1[0], h1[1]); w.w = cvt_pk_bf16(h1[2], h1[3]);
                *(u32x4*)(H + (size_t)(row0 + ai * 128 + m * 16) * EHID + col0) = w; }
    }
};
struct EpiScatter {
    static constexpr bool PERM = true;
    LAS unsigned char* lds; bf16_t* YB; const int* list;
    __device__ __forceinline__ void operator()(const f32x4 (&acc)[2][2][4][2], const Unit& u, int wr, int wc, int fr, int fq) const {
        LAS const int* tab = (LAS const int*)(lds + LDS_TAB);
        const int j0 = __builtin_amdgcn_readfirstlane(tab[MAXRT + u.pm]), cn = __builtin_amdgcn_readfirstlane(tab[2 * MAXRT + u.aux]);
        const int col0 = u.pn * 256 + wc * 32 + 8 * fq;
        int aid[2][4];
#pragma unroll
        for (int ai = 0; ai < 2; ++ai)
#pragma unroll
            for (int m = 0; m < 4; ++m) { const int slot = j0 + ai * 128 + wr * 64 + m * 16 + fr; aid[ai][m] = slot < cn ? list[(size_t)u.aux * LISTCAP + slot] : -1; }
#pragma unroll
        for (int ai = 0; ai < 2; ++ai)
#pragma unroll
            for (int m = 0; m < 4; ++m) { const int a = aid[ai][m];
                if (a >= 0) { bf16_t* rowp = YB + (size_t)a * D + col0;
#pragma unroll
                    for (int bj = 0; bj < 2; ++bj) { const f32x4 v0 = acc[ai][bj][m][0], v1 = acc[ai][bj][m][1];
                        u32x4 w; w.x = cvt_pk_bf16(v0[0], v0[1]); w.y = cvt_pk_bf16(v0[2], v0[3]); w.z = cvt_pk_bf16(v1[0], v1[1]); w.w = cvt_pk_bf16(v1[2], v1[3]);
                        *(u32x4*)(rowp + bj * 128) = w; } } }
    }
};

struct Params { const float* in[42]; float* out; unsigned char* ws; int ph_lo, ph_hi; };
enum { I_X = 0, I_C, I_CTX, I_CCTX, I_ADAW, I_ADAB, I_N1G, I_N2G, I_FG, I_GWIN, I_GBIN, I_GLNG, I_GLNB, I_GWS, I_GBS, I_GWOUT, I_GBOUT,
       I_MU, I_WR, I_WK, I_WV, I_WO, I_W0, I_W1, I_W2, I_A0, I_A1, I_A2, I_G1, I_G2, I_KK, I_KA, I_RK, I_LNG, I_LNB,
       I_MWGRP, I_MBGRP, I_MWEXP, I_MBEXP, I_MWG, I_MWU, I_MWD };
struct Frame { LAS unsigned char* lds; int tid, lane, wave, G, gw, NGW; };
typedef const __attribute__((address_space(4))) Params* KP;

constexpr int TRP = 36, TR_SCR = 64 * TRP * 4;
__device__ __forceinline__ void tr_item(const float* W, int N, int kmax, bf16_t* WT, int ldk, int k0, int n0, int drow0, int dk0, LAS float* scr, int lane) {
    const int n4 = lane & 7, kr = lane >> 3; f32x4 v[8];
#pragma unroll
    for (int i = 0; i < 8; ++i) { const int k = k0 + 8 * i + kr; v[i] = k < kmax ? *(const f32x4*)(W + (size_t)k * N + n0 + 4 * n4) : (f32x4){0.f, 0.f, 0.f, 0.f}; }
#pragma unroll
    for (int i = 0; i < 8; ++i) *(LAS f32x4*)(scr + (8 * i + kr) * TRP + 4 * n4) = v[i];
    asm volatile("s_waitcnt lgkmcnt(0)" ::: "memory");
    const int c = lane & 7;
#pragma unroll
    for (int j = 0; j < 4; ++j) { const int n = (lane >> 3) + 8 * j; const LAS float* sp = scr + (8 * c) * TRP + n;
        u32x4 o; o.x = cvt_pk_bf16(sp[0 * TRP], sp[1 * TRP]); o.y = cvt_pk_bf16(sp[2 * TRP], sp[3 * TRP]); o.z = cvt_pk_bf16(sp[4 * TRP], sp[5 * TRP]); o.w = cvt_pk_bf16(sp[6 * TRP], sp[7 * TRP]);
        *(u32x4*)(WT + (size_t)(drow0 + n) * ldk + dk0 + k0 + 8 * c) = o; }
    asm volatile("s_waitcnt lgkmcnt(0)" ::: "memory");
}
constexpr int LDS_JOBS = 80 * 1024, MAXJOBS = 48;
__device__ __forceinline__ void add_job(LAS int* jobs, int& nj, int& nit, const float* src, int N, int kmax, int kpad, bf16_t* dst, int ldk, int drow0, int dk0) {
    LAS int* q = jobs + nj * 12; const unsigned long long a = (unsigned long long)src, d = (unsigned long long)dst;
    q[0] = (int)(unsigned)a; q[1] = (int)(unsigned)(a >> 32); q[2] = (int)(unsigned)d; q[3] = (int)(unsigned)(d >> 32); q[4] = N; q[5] = kmax; q[6] = kpad / 64; q[7] = ldk; q[8] = drow0; q[9] = dk0; q[10] = nit;
    nit += (kpad / 64) * (N / 32); ++nj;
}
__device__ __forceinline__ void zero_fill(const Frame& F, bf16_t* p, size_t nbytes) {
    u32x4* q = (u32x4*)p; const size_t n = nbytes / 16;
    for (size_t i = (size_t)blockIdx.x * NTHR + F.tid; i < n; i += (size_t)F.G * NTHR) q[i] = (u32x4){0u, 0u, 0u, 0u};
}

__device__ __forceinline__ void prologue_phase(const Frame& F, KP P) {
    unsigned char* ws = P->ws;
    {   float* MOD = (float*)(ws + WS_MOD); LAS float* part = (LAS float*)F.lds;
        const float* c = P->in[I_C]; const float* cc = P->in[I_CCTX];
        for (int item = blockIdx.x; item < DEPTH * 24; item += F.G) {
            const int layer = item / 24, col = (item % 24) * 256 + 4 * F.lane; const float* w = P->in[I_ADAW] + (size_t)layer * D * 6 * D + col;
            f32x4 a0 = (f32x4){0.f, 0.f, 0.f, 0.f}, a1 = a0, a2 = a0;
#pragma unroll 8
            for (int i = 0; i < 128; ++i) { const int d = F.wave + 8 * i; const f32x4 wv = *(const f32x4*)(w + (size_t)d * 6 * D);
                const float c0 = c[d], c1 = c[D + d], c2 = cc[d];
                a0 += wv * (c0 * sigmoidf_(c0)); a1 += wv * (c1 * sigmoidf_(c1)); a2 += wv * (c2 * sigmoidf_(c2)); }
            __syncthreads();
            *(LAS f32x4*)(part + (F.wave * 3 + 0) * 256 + 4 * F.lane) = a0; *(LAS f32x4*)(part + (F.wave * 3 + 1) * 256 + 4 * F.lane) = a1; *(LAS f32x4*)(part + (F.wave * 3 + 2) * 256 + 4 * F.lane) = a2;
            __syncthreads();
            if (F.wave < 3) { f32x4 sacc = (f32x4){0.f, 0.f, 0.f, 0.f};
#pragma unroll
                for (int w8 = 0; w8 < 8; ++w8) sacc += *(const LAS f32x4*)(part + (w8 * 3 + F.wave) * 256 + 4 * F.lane);
                *(f32x4*)(MOD + ((size_t)layer * 3 + F.wave) * 6 * D + col) = sacc + *(const f32x4*)(P->in[I_ADAB] + (size_t)layer * 6 * D + col); }
        }
    }
    LAS int* jobs = (LAS int*)(F.lds + LDS_JOBS); LAS int* jtot = jobs + MAXJOBS * 12;
    __syncthreads();
    if (F.tid == 0) { int nj = 0, nit = 0;
        for (int j = 0; j < 2; ++j) {
            add_job(jobs, nj, nit, P->in[I_GWIN] + (size_t)j * D * 4096, 4096, D, D, (bf16_t*)(ws + WS_WIN) + (size_t)j * 4096 * D, D, 0, 0);
            add_job(jobs, nj, nit, P->in[I_GWOUT] + (size_t)j * GWID * D, D, GWID, GWID, (bf16_t*)(ws + WS_WOUT) + (size_t)j * D * GWID, GWID, 0, 0);
            add_job(jobs, nj, nit, P->in[I_WR] + (size_t)j * D * D, D, D, D, (bf16_t*)(ws + WS_WR) + (size_t)j * D * D, D, 0, 0);
            add_job(jobs, nj, nit, P->in[I_WK] + (size_t)j * D * D, D, D, D, (bf16_t*)(ws + WS_WK) + (size_t)j * D * D, D, 0, 0);
            add_job(jobs, nj, nit, P->in[I_WV] + (size_t)j * D * D, D, D, D, (bf16_t*)(ws + WS_WV) + (size_t)j * D * D, D, 0, 0);
            add_job(jobs, nj, nit, P->in[I_WO] + (size_t)j * D * D, D, D, D, (bf16_t*)(ws + WS_WO) + (size_t)j * D * D, D, 0, 0);
            for (int z = 0; z < 2; ++z) {
                add_job(jobs, nj, nit, P->in[I_W1] + ((size_t)j * 2 + z) * D * 64, 64, D, D, (bf16_t*)(ws + WS_LW1) + (size_t)j * 256 * D, D, z * 64, 0);
                add_job(jobs, nj, nit, P->in[I_A1] + ((size_t)j * 2 + z) * D * 64, 64, D, D, (bf16_t*)(ws + WS_LA1) + (size_t)j * 256 * D, D, z * 64, 0);
                add_job(jobs, nj, nit, P->in[I_W2] + ((size_t)j * 2 + z) * 64 * D, D, 64, 64, (bf16_t*)(ws + WS_W2P) + ((size_t)j * 2 + z) * D * 256, 256, 0, z * 64);
                add_job(jobs, nj, nit, P->in[I_A2] + ((size_t)j * 2 + z) * 64 * D, D, 64, 64, (bf16_t*)(ws + WS_A2P) + ((size_t)j * 2 + z) * D * 256, 256, 0, z * 64); }
            add_job(jobs, nj, nit, P->in[I_G1] + (size_t)j * D * 160, 160, D, D, (bf16_t*)(ws + WS_LG1) + (size_t)j * 256 * D, D, 0, 0);
            add_job(jobs, nj, nit, P->in[I_G2] + (size_t)j * 160 * D, D, 160, 256, (bf16_t*)(ws + WS_G2P) + (size_t)j * D * 256, 256, 0, 0); }
        jtot[0] = nj; jtot[1] = nit; }
    __syncthreads();
    {   const int nj = jtot[0], nit = jtot[1]; LAS float* scr = (LAS float*)(F.lds + F.wave * TR_SCR);
        for (int it = F.gw; it < nit; it += F.NGW) {
            int jb = 0; for (int q = 1; q < nj; ++q) if (it >= jobs[q * 12 + 10]) jb = q;
            jb = __builtin_amdgcn_readfirstlane(jb); LAS const int* q = jobs + jb * 12;
            const float* src = (const float*)(((unsigned long long)(unsigned)q[1] << 32) | (unsigned)q[0]); bf16_t* dst = (bf16_t*)(((unsigned long long)(unsigned)q[3] << 32) | (unsigned)q[2]);
            const int N = q[4], nnb = N / 32, r = it - q[10], kb = r / nnb, nb = r % nnb;
            tr_item(src, N, q[5], dst, q[7], kb * 64, nb * 32, q[8] + nb * 32, q[9], scr, F.lane); }
    }
    for (int j = 0; j < 2; ++j) {
        bf16_t* lw1 = (bf16_t*)(ws + WS_LW1) + (size_t)j * 256 * D; bf16_t* la1 = (bf16_t*)(ws + WS_LA1) + (size_t)j * 256 * D; bf16_t* lg1 = (bf16_t*)(ws + WS_LG1) + (size_t)j * 256 * D;
        zero_fill(F, lw1 + 128 * D, (size_t)128 * D * 2); zero_fill(F, la1 + 128 * D, (size_t)128 * D * 2); zero_fill(F, lg1 + 160 * D, (size_t)96 * D * 2);
        for (int z = 0; z < 2; ++z) { bf16_t* w2p = (bf16_t*)(ws + WS_W2P) + ((size_t)j * 2 + z) * D * 256; bf16_t* a2p = (bf16_t*)(ws + WS_A2P) + ((size_t)j * 2 + z) * D * 256;
            for (int idx = blockIdx.x * NTHR + F.tid; idx < D * 32; idx += F.G * NTHR) { const int n = idx >> 5, ch = idx & 31;
                if ((ch >> 3) != z) { *(u32x4*)(w2p + (size_t)n * 256 + ch * 8) = (u32x4){0u, 0u, 0u, 0u}; *(u32x4*)(a2p + (size_t)n * 256 + ch * 8) = (u32x4){0u, 0u, 0u, 0u}; } } }
    }
    {   bf16_t* wrt = (bf16_t*)(ws + WS_WRT);
        for (int idx = blockIdx.x * NTHR + F.tid; idx < DEPTH * 256 * (D / 8); idx += F.G * NTHR) { const int k0 = (idx & 127) * 8, n = (idx >> 7) & 255, layer = idx >> 15;
            const int nn = n & 127; const bool lo = n >= 128; float w[8];
#pragma unroll
            for (int e = 0; e < 8; ++e) { float x = 0.f;
                if (nn < 4) x = P->in[I_MWGRP][((size_t)layer * D + k0 + e) * 4 + nn]; else if (nn < 36) x = P->in[I_MWEXP][((size_t)layer * D + k0 + e) * NE + nn - 4];
                const float hi = bf_lo(cvt_pk_bf16(x, 0.f)); w[e] = lo ? x - hi : x; }
            *(u32x4*)(wrt + ((size_t)layer * 256 + n) * D + k0) = pack8(w); } }
    {   const float* src = P->in[I_GWS]; bf16_t* dst = (bf16_t*)(ws + WS_WSP); const int n8 = 2 * 16 * 128 * 128 / 8;
        for (int i = blockIdx.x * NTHR + F.tid; i < n8; i += F.G * NTHR) { const f32x4 a = *(const f32x4*)(src + (size_t)i * 8), b = *(const f32x4*)(src + (size_t)i * 8 + 4);
            u32x4 o; o.x = cvt_pk_bf16(a[0], a[1]); o.y = cvt_pk_bf16(a[2], a[3]); o.z = cvt_pk_bf16(b[0], b[1]); o.w = cvt_pk_bf16(b[2], b[3]); *(u32x4*)(dst + (size_t)i * 8) = o; } }
}
struct MoeItem { const float* src; bf16_t* dst; int N, kmax, ldk, k0, n0, drow0; };
__device__ __forceinline__ MoeItem moe_item(KP P, unsigned char* ws, int layer, int it) {
    const int e = it / 768, r = it % 768, m = r >> 8, q = r & 255; const size_t so = ((size_t)layer * NE + e) * (size_t)D * EHID; MoeItem I;
    if (m < 2) { const int kb = q >> 4, n0 = (q & 15) * 32;
        I.src = (m == 0 ? P->in[I_MWG] : P->in[I_MWU]) + so; I.N = EHID; I.kmax = D; I.dst = (bf16_t*)(ws + WS_WGU) + (size_t)e * D * D; I.ldk = D; I.k0 = kb * 64; I.n0 = n0; I.drow0 = 256 * (n0 >> 7) + (n0 & 127) + (m == 1 ? 128 : 0); }
    else { const int kb = q >> 5, n0 = (q & 31) * 32;
        I.src = P->in[I_MWD] + so; I.N = D; I.kmax = EHID; I.dst = (bf16_t*)(ws + WS_WD) + (size_t)e * D * EHID; I.ldk = EHID; I.k0 = kb * 64; I.n0 = n0; I.drow0 = n0; }
    return I;
}
__device__ __forceinline__ void tr_load(const MoeItem& I, int lane, f32x4 (&v)[8]) {
    const int n4 = lane & 7, kr = lane >> 3;
#pragma unroll
    for (int i = 0; i < 8; ++i) v[i] = *(const f32x4*)(I.src + (size_t)(I.k0 + 8 * i + kr) * I.N + I.n0 + 4 * n4);
}
__device__ __forceinline__ void tr_store(const MoeItem& I, int lane, const f32x4 (&v)[8], LAS float* scr) {
    const int n4 = lane & 7, kr = lane >> 3;
#pragma unroll
    for (int i = 0; i < 8; ++i) *(LAS f32x4*)(scr + (8 * i + kr) * TRP + 4 * n4) = v[i];
    asm volatile("s_waitcnt lgkmcnt(0)" ::: "memory");
    const int c = lane & 7;
#pragma unroll
    for (int j = 0; j < 4; ++j) { const int n = (lane >> 3) + 8 * j; const LAS float* sp = scr + (8 * c) * TRP + n;
        u32x4 o; o.x = cvt_pk_bf16(sp[0 * TRP], sp[1 * TRP]); o.y = cvt_pk_bf16(sp[2 * TRP], sp[3 * TRP]); o.z = cvt_pk_bf16(sp[4 * TRP], sp[5 * TRP]); o.w = cvt_pk_bf16(sp[6 * TRP], sp[7 * TRP]);
        *(u32x4*)(I.dst + (size_t)(I.drow0 + n) * I.ldk + I.k0 + 8 * c) = o; }
    asm volatile("s_waitcnt lgkmcnt(0)" ::: "memory");
}
constexpr int MOE_ITEMS = NE * 768, MOE_SPLIT = 14336;
__device__ __forceinline__ void moe_weights_phase(const Frame& F, KP P, int layer, int vgw, int vngw, int it0, int it1) {
    unsigned char* ws = P->ws; LAS float* scr = (LAS float*)(F.lds + F.wave * TR_SCR);
    int it = it0 + vgw; f32x4 v[8], vn[8];
    if (it < it1) { const MoeItem I = moe_item(P, ws, layer, it); tr_load(I, F.lane, v); }
#pragma nounroll
    while (it < it1) { const int nx = it + vngw;
        if (nx < it1) { const MoeItem In = moe_item(P, ws, layer, nx); tr_load(In, F.lane, vn); }
        { const MoeItem I = moe_item(P, ws, layer, it); tr_store(I, F.lane, v, scr); }
#pragma unroll
        for (int i = 0; i < 8; ++i) v[i] = vn[i];
        it = nx; }
}

__device__ __forceinline__ void load_xrow(KP P, const Frame& F, int layer, int row, f32x4 (&v)[4]) {
    if (layer == 0) { const float* xr = row < TL ? P->in[I_X] + (size_t)row * D : P->in[I_CTX] + (size_t)(row - TL) * D;
#pragma unroll
        for (int j = 0; j < 4; ++j) v[j] = *(const f32x4*)(xr + 4 * F.lane + 256 * j); }
    else { const bf16_t* xr = (const bf16_t*)(P->ws + WS_X) + (size_t)row * D;
#pragma unroll
        for (int j = 0; j < 4; ++j) { const u32x2 w = *(const u32x2*)(xr + 4 * F.lane + 256 * j); v[j] = (f32x4){bf_lo(w.x), bf_hi(w.x), bf_lo(w.y), bf_hi(w.y)}; } }
}
__device__ __forceinline__ void load_vec4(const float* p, int lane, f32x4 (&r)[4]) {
#pragma unroll
    for (int j = 0; j < 4; ++j) r[j] = *(const f32x4*)(p + 4 * lane + 256 * j);
}
__device__ __forceinline__ void load_combine(KP P, const Frame& F, int layer, int row, bool combine, const f32x4 (&g2r)[4], f32x4 (&v)[4]) {
    load_xrow(P, F, layer, row, v);
    if (combine) {
        const bf16_t* yb = (const bf16_t*)(P->ws + WS_YB); const float* wg = (const float*)(P->ws + WS_WGT);
        const float w0 = wg[2 * row], w1 = wg[2 * row + 1];
#pragma unroll
        for (int j = 0; j < 4; ++j) { const int col = 4 * F.lane + 256 * j; const u32x2 a = *(const u32x2*)(yb + (size_t)(2 * row) * D + col), b = *(const u32x2*)(yb + (size_t)(2 * row + 1) * D + col);
            const f32x4 g = g2r[j];
            v[j][0] += g[0] * (w0 * bf_lo(a.x) + w1 * bf_lo(b.x)); v[j][1] += g[1] * (w0 * bf_hi(a.x) + w1 * bf_hi(b.x));
            v[j][2] += g[2] * (w0 * bf_lo(a.y) + w1 * bf_lo(b.y)); v[j][3] += g[3] * (w0 * bf_hi(a.y) + w1 * bf_hi(b.y)); }
    }
}
__device__ __forceinline__ void norm1_phase(const Frame& F, KP P, int layer) {
    const bool combine = layer > 0; bf16_t* X = (bf16_t*)(P->ws + WS_X); bf16_t* HL = (bf16_t*)(P->ws + WS_HL);
    f32x4 g1r[4], shr[4], scr[4], g2r[4]; load_vec4(P->in[I_N1G] + (size_t)layer * D, F.lane, g1r); int mc = -1;
#pragma unroll
    for (int j = 0; j < 4; ++j) { shr[j] = (f32x4){0.f, 0.f, 0.f, 0.f}; scr[j] = shr[j]; g2r[j] = shr[j]; }
    for (int row = F.gw; row < T; row += F.NGW) {
        const int m = row < TL ? (row >> 14) : 2; f32x4 v[4];
        if (m != mc) { mc = m; const float* mod = (const float*)(P->ws + WS_MOD) + ((size_t)layer * 3 + m) * 6 * D; load_vec4(mod, F.lane, shr); load_vec4(mod + D, F.lane, scr);
            if (combine) load_vec4((const float*)(P->ws + WS_MOD) + ((size_t)(layer - 1) * 3 + m) * 6 * D + 5 * D, F.lane, g2r); }
        load_combine(P, F, layer, row, combine, g2r, v);
        {
#pragma unroll
            for (int j = 0; j < 4; ++j) { u32x2 o; o.x = cvt_pk_bf16(v[j][0], v[j][1]); o.y = cvt_pk_bf16(v[j][2], v[j][3]); *(u32x2*)(X + (size_t)row * D + 4 * F.lane + 256 * j) = o;
                v[j] = (f32x4){bf_lo(o.x), bf_hi(o.x), bf_lo(o.y), bf_hi(o.y)}; } }
        float ss = 0.f;
#pragma unroll
        for (int j = 0; j < 4; ++j) ss += (v[j][0] * v[j][0] + v[j][1] * v[j][1]) + (v[j][2] * v[j][2] + v[j][3] * v[j][3]);
        const float rstd = rsqrtf(wave_sum(ss, F.lane) * (1.0f / D) + 1e-6f);
#pragma unroll
        for (int j = 0; j < 4; ++j) { const int col = 4 * F.lane + 256 * j;
            const f32x4 h = (v[j] * rstd) * g1r[j] * (scr[j] + 1.0f) + shr[j];
            u32x2 o; o.x = cvt_pk_bf16(h[0], h[1]); o.y = cvt_pk_bf16(h[2], h[3]); *(u32x2*)(HL + (size_t)row * D + col) = o; }
    }
}
__device__ __forceinline__ void final_phase(const Frame& F, KP P) {
    f32x4 fgr[4], g2r[4]; load_vec4(P->in[I_FG], F.lane, fgr); int mc = -1;
#pragma unroll
    for (int j = 0; j < 4; ++j) g2r[j] = (f32x4){0.f, 0.f, 0.f, 0.f};
    for (int row = F.gw; row < TL; row += F.NGW) {
        const int m = row >> 14; f32x4 v[4];
        if (m != mc) { mc = m; load_vec4((const float*)(P->ws + WS_MOD) + ((size_t)(DEPTH - 1) * 3 + m) * 6 * D + 5 * D, F.lane, g2r); }
        load_combine(P, F, DEPTH, row, true, g2r, v);
        float ss = 0.f;
#pragma unroll
        for (int j = 0; j < 4; ++j) ss += (v[j][0] * v[j][0] + v[j][1] * v[j][1]) + (v[j][2] * v[j][2] + v[j][3] * v[j][3]);
        const float rstd = rsqrtf(wave_sum(ss, F.lane) * (1.0f / D) + 1e-6f);
#pragma unroll
        for (int j = 0; j < 4; ++j) { const int col = 4 * F.lane + 256 * j; *(f32x4*)(P->out + (size_t)row * D + col) = (v[j] * rstd) * fgr[j]; }
    }
}
__device__ __forceinline__ void norm2_phase(const Frame& F, KP P, int layer) {
    const int ntok = layer == DEPTH - 1 ? TL : T; bf16_t* HL2 = (bf16_t*)(P->ws + WS_HL);
    f32x4 gr[4], shr[4], scr[4]; load_vec4(P->in[I_N2G] + (size_t)layer * D, F.lane, gr); int mc = -1;
#pragma unroll
    for (int j = 0; j < 4; ++j) { shr[j] = (f32x4){0.f, 0.f, 0.f, 0.f}; scr[j] = shr[j]; }
    for (int row = F.gw; row < ntok; row += F.NGW) {
        const int m = row < TL ? (row >> 14) : 2; f32x4 v[4]; load_xrow(P, F, 1, row, v);
        if (m != mc) { mc = m; const float* mod = (const float*)(P->ws + WS_MOD) + ((size_t)layer * 3 + m) * 6 * D; load_vec4(mod + 3 * D, F.lane, shr); load_vec4(mod + 4 * D, F.lane, scr); }
        float ss = 0.f;
#pragma unroll
        for (int j = 0; j < 4; ++j) ss += (v[j][0] * v[j][0] + v[j][1] * v[j][1]) + (v[j][2] * v[j][2] + v[j][3] * v[j][3]);
        const float rstd = rsqrtf(wave_sum(ss, F.lane) * (1.0f / D) + 1e-6f);
#pragma unroll
        for (int j = 0; j < 4; ++j) { const int col = 4 * F.lane + 256 * j;
            const f32x4 h = (v[j] * rstd) * gr[j] * (scr[j] + 1.0f) + shr[j];
            u32x2 o; o.x = cvt_pk_bf16(h[0], h[1]); o.y = cvt_pk_bf16(h[2], h[3]); *(u32x2*)(HL2 + (size_t)row * D + col) = o; }
    }
    if (!(layer & 1)) moe_weights_phase(F, P, layer, F.gw, F.NGW, 0, MOE_SPLIT);
}
__device__ __forceinline__ void route_phase(const Frame& F, KP P, int layer) {
    const int ntok = layer == DEPTH - 1 ? TL : T; const float* LG = (const float*)(P->ws + WS_LG);
    const float* bgrp = P->in[I_MBGRP] + layer * 4; const float* bexp = P->in[I_MBEXP] + layer * NE;
    unsigned* cnt = (unsigned*)(P->ws + WS_CTL) + CW_CNT + layer * 64; int* list = (int*)(P->ws + WS_LIST); float* wgt = (float*)(P->ws + WS_WGT);
    LAS unsigned* lcnt = (LAS unsigned*)F.lds; LAS unsigned* lbase = lcnt + 32;
    for (int r0 = blockIdx.x * NTHR; r0 < ntok; r0 += F.G * NTHR) {
        const int row = r0 + F.tid; const bool act = row < ntok;
        __syncthreads();
        if (F.tid < 32) lcnt[F.tid] = 0u;
        __syncthreads();
        int e0 = 0, e1 = 0; unsigned k0 = 0, k1 = 0;
        if (act) {
            const float* lg = LG + (size_t)row * 64; const f32x4 g4 = *(const f32x4*)lg;
            float ag[4];
#pragma unroll
            for (int i = 0; i < 4; ++i) ag[i] = g4[i] + bgrp[i];
            int grp = 0; float mx = ag[0];
#pragma unroll
            for (int i = 1; i < 4; ++i) if (ag[i] > mx) { mx = ag[i]; grp = i; }
            float den = 0.f;
#pragma unroll
            for (int i = 0; i < 4; ++i) den += __expf(ag[i] - mx);
            const float pg = 1.0f / den;
            const f32x4 e0v = *(const f32x4*)(lg + 4 + 8 * grp), e1v = *(const f32x4*)(lg + 8 + 8 * grp); const f32x4 b0v = *(const f32x4*)(bexp + 8 * grp), b1v = *(const f32x4*)(bexp + 8 * grp + 4);
            float el[8];
#pragma unroll
            for (int i = 0; i < 4; ++i) { el[i] = e0v[i] + b0v[i]; el[4 + i] = e1v[i] + b1v[i]; }
            int i0 = 0; float t0 = el[0];
#pragma unroll
            for (int i = 1; i < 8; ++i) if (el[i] > t0) { t0 = el[i]; i0 = i; }
            int i1 = -1; float t1 = -3.0e38f;
#pragma unroll
            for (int i = 0; i < 8; ++i) if (i != i0 && el[i] > t1) { t1 = el[i]; i1 = i; }
            const float p0 = 1.0f / (1.0f + __expf(t1 - t0));
            wgt[2 * row] = pg * p0; wgt[2 * row + 1] = pg * (1.0f - p0);
            e0 = grp * 8 + i0; e1 = grp * 8 + i1;
            k0 = atomicAdd((unsigned*)(lcnt + e0), 1u); k1 = atomicAdd((unsigned*)(lcnt + e1), 1u);
        }
        __syncthreads();
        if (F.tid < 32) { const unsigned c = lcnt[F.tid]; lbase[F.tid] = c ? atomicAdd(cnt + F.tid, c) : 0u; }
        __syncthreads();
        if (act) { list[(size_t)e0 * LISTCAP + lbase[e0] + k0] = 2 * row; list[(size_t)e1 * LISTCAP + lbase[e1] + k1] = 2 * row + 1; }
    }
}
__device__ __forceinline__ bf16x8 tr_frag136(const LAS bf16_t* M, int k0, int c0, int lane) {
    LAS bf16_t* p = (LAS bf16_t*)M + (k0 + 8 * (lane >> 4) + ((lane & 15) >> 2)) * 136 + c0 + 4 * (lane & 3);
    const v4s lo = __builtin_amdgcn_ds_read_tr16_b64_v4i16((LAS v4s*)p), hi = __builtin_amdgcn_ds_read_tr16_b64_v4i16((LAS v4s*)(p + 4 * 136));
    return (bf16x8){lo[0], lo[1], lo[2], lo[3], hi[0], hi[1], hi[2], hi[3]};
}
__device__ __forceinline__ bf16x8 tr_frag136p(const LAS bf16_t* M, int k0, int dt, int lane) {
    LAS bf16_t* p = (LAS bf16_t*)M + (k0 + 8 * (lane >> 4) + ((lane & 15) >> 2)) * 136 + 32 * (dt >> 1) + 8 * (lane & 3) + 4 * (dt & 1);
    const v4s lo = __builtin_amdgcn_ds_read_tr16_b64_v4i16((LAS v4s*)p), hi = __builtin_amdgcn_ds_read_tr16_b64_v4i16((LAS v4s*)(p + 4 * 136));
    return (bf16x8){lo[0], lo[1], lo[2], lo[3], hi[0], hi[1], hi[2], hi[3]};
}
__device__ __forceinline__ void spatial_phase(const Frame& F, KP P, int j) {
    bf16_t* U = (bf16_t*)(P->ws + WS_U); const bf16_t* V = (const bf16_t*)(P->ws + WS_V); const float* stat = (const float*)(P->ws + WS_STAT);
    const bf16_t* WSP = (const bf16_t*)(P->ws + WS_WSP) + (size_t)j * 16 * 128 * 128;
    const float* lng = P->in[I_GLNG] + (size_t)j * GWID; const float* lnb = P->in[I_GLNB] + (size_t)j * GWID; const float* bs = P->in[I_GBS] + (size_t)j * 16 * 128;
    LAS bf16_t* Wt = (LAS bf16_t*)F.lds; LAS bf16_t* Vn = Wt + 128 * 136;
    LAS float* mu = (LAS float*)(F.lds + 2 * 128 * 136 * 2); LAS float* rs = mu + 128;
    const int l15 = F.lane & 15, l4 = F.lane >> 4;
    constexpr int NUNIT = (T / 128) * 16;
    const int u0 = (int)((long)blockIdx.x * NUNIT / F.G), u1 = (int)((long)(blockIdx.x + 1) * NUNIT / F.G);
#define SP_LOAD(W_, V_, U_, t0_, g_) do { \
        _Pragma("unroll") for (int i = 0; i < 4; ++i) { const int idx = F.tid + NTHR * i, r = idx >> 4, seg = idx & 15; \
            W_[i] = *(const u32x4*)(WSP + ((size_t)(g_) * 128 + r) * 128 + seg * 8); V_[i] = *(const u32x4*)(V + (size_t)((t0_) + r) * GWID + (g_) * 128 + seg * 8); } \
        { const bf16_t* ur_ = U + (size_t)((t0_) + 16 * F.wave + l15) * GWID + (g_) * 128 + 8 * l4; \
          _Pragma("unroll") for (int e = 0; e < 4; ++e) U_[e] = *(const u32x4*)(ur_ + e * 32); } } while (0)
    u32x4 wv[4], vv[4], uu[4];
    if (u0 < u1) SP_LOAD(wv, vv, uu, (u0 >> 4) * 128, u0 & 15);
    int cprev = -1;
#pragma nounroll
    for (int u = u0; u < u1; ++u) { const int c = u >> 4, g = u & 15, t0 = c * 128;
        if (c != cprev) { cprev = c;
            if (F.tid < 128) { const int row = t0 + F.tid; float s = 0.f, q = 0.f;
#pragma unroll 8
                for (int i = 0; i < 32; ++i) { const f32x2 p = *(const f32x2*)(stat + ((size_t)row * 32 + i) * 2); s += p.x; q += p.y; }
                const float mean = s * (1.0f / GWID), var = q * (1.0f / GWID) - mean * mean; mu[F.tid] = mean; rs[F.tid] = rsqrtf(var + 1e-5f); } }
        LDS_BARRIER();
#pragma unroll
        for (int i = 0; i < 4; ++i) { const int idx = F.tid + NTHR * i, r = idx >> 4, seg = idx & 15, ch = g * 128 + seg * 8;
            *(LAS u32x4*)(Wt + r * 136 + seg * 8) = wv[i];
            float x[8], o[8]; unpack8(vv[i], x); const float m_ = mu[r], r_ = rs[r];
            const f32x4 g0 = *(const f32x4*)(lng + ch), g1 = *(const f32x4*)(lng + ch + 4), b0 = *(const f32x4*)(lnb + ch), b1 = *(const f32x4*)(lnb + ch + 4);
#pragma unroll
            for (int e = 0; e < 8; ++e) o[e] = (x[e] - m_) * r_ * (e < 4 ? g0[e & 3] : g1[e & 3]) + (e < 4 ? b0[e & 3] : b1[e & 3]);
            *(LAS u32x4*)(Vn + r * 136 + seg * 8) = pack8(o); }
        u32x4 wn[4], vn[4], un[4];
        if (u + 1 < u1) SP_LOAD(wn, vn, un, ((u + 1) >> 4) * 128, (u + 1) & 15);
        LDS_BARRIER();
        bf16x8 bw[4];
#pragma unroll
        for (int ks = 0; ks < 4; ++ks) bw[ks] = *(const LAS bf16x8*)(Wt + (16 * F.wave + l15) * 136 + ks * 32 + 8 * l4);
        const int p = 16 * F.wave + l15; const float bias = bs[g * 128 + p];
        bf16_t* urow = U + (size_t)(t0 + p) * GWID + g * 128 + 8 * l4;
#pragma unroll
        for (int e = 0; e < 4; ++e) { f32x4 a0 = (f32x4){0.f, 0.f, 0.f, 0.f}, a1 = a0;
#pragma unroll
            for (int ks = 0; ks < 4; ++ks) { const bf16x8 f0 = tr_frag136p(Vn, 32 * ks, 2 * e, F.lane), f1 = tr_frag136p(Vn, 32 * ks, 2 * e + 1, F.lane);
                a0 = __builtin_amdgcn_mfma_f32_16x16x32_bf16(f0, bw[ks], a0, 0, 0, 0); a1 = __builtin_amdgcn_mfma_f32_16x16x32_bf16(f1, bw[ks], a1, 0, 0, 0); }
            u32x4 o; o.x = cvt_pk_bf16(bf_lo(uu[e].x) * (a0[0] + bias), bf_hi(uu[e].x) * (a0[1] + bias)); o.y = cvt_pk_bf16(bf_lo(uu[e].y) * (a0[2] + bias), bf_hi(uu[e].y) * (a0[3] + bias));
            o.z = cvt_pk_bf16(bf_lo(uu[e].z) * (a1[0] + bias), bf_hi(uu[e].z) * (a1[1] + bias)); o.w = cvt_pk_bf16(bf_lo(uu[e].w) * (a1[2] + bias), bf_hi(uu[e].w) * (a1[3] + bias));
            *(u32x4*)(urow + e * 32) = o; }
        if (u + 1 < u1) {
#pragma unroll
            for (int i = 0; i < 4; ++i) { wv[i] = wn[i]; vv[i] = vn[i]; uu[i] = un[i]; } }
    }
#undef SP_LOAD
}

__device__ __forceinline__ void mix_phase(const Frame& F, KP P, int j) {
    const bf16_t* HL = (const bf16_t*)(P->ws + WS_HL); const float* mu = P->in[I_MU] + (size_t)j * 6 * D;
    bf16_t* outs[6] = {(bf16_t*)(P->ws + WS_XR), (bf16_t*)(P->ws + WS_XW), (bf16_t*)(P->ws + WS_XK), (bf16_t*)(P->ws + WS_XV), (bf16_t*)(P->ws + WS_XA), (bf16_t*)(P->ws + WS_XG)};
    f32x4 mr[2][6][2];
#pragma unroll
    for (int jj = 0; jj < 2; ++jj)
#pragma unroll
        for (int m = 0; m < 6; ++m) { const int col = 512 * jj + 8 * F.lane; mr[jj][m][0] = *(const f32x4*)(mu + (size_t)m * D + col); mr[jj][m][1] = *(const f32x4*)(mu + (size_t)m * D + col + 4); }
    for (int row = F.gw; row < T; row += F.NGW) {
        bool ok[2]; int src[2]; const bool hi = F.lane >= 32;
        if (row < TL) { const int n = row & (SEQ - 1), gc = n & 63, gr = n >> 6;
            ok[0] = hi ? gc < 63 : gc > 0; src[0] = hi ? row + 1 : row - 1; ok[1] = hi ? gr < 255 : gr > 0; src[1] = hi ? row + 64 : row - 64; }
        else { const int n = (row - TL) & (CTXL - 1); ok[0] = n > 0; src[0] = row - 1; ok[1] = n < CTXL - 1; src[1] = row + 1; }
#pragma unroll
        for (int jj = 0; jj < 2; ++jj) { const int col = 512 * jj + 8 * F.lane;
            const u32x4 h8 = *(const u32x4*)(HL + (size_t)row * D + col); u32x4 s8 = (u32x4){0u, 0u, 0u, 0u};
            if (ok[jj]) s8 = *(const u32x4*)(HL + (size_t)src[jj] * D + col);
            const unsigned hw[4] = {h8.x, h8.y, h8.z, h8.w}, sw[4] = {s8.x, s8.y, s8.z, s8.w}; float h[8], xx[8];
#pragma unroll
            for (int e = 0; e < 8; ++e) { h[e] = (e & 1) ? bf_hi(hw[e >> 1]) : bf_lo(hw[e >> 1]); const float s = (e & 1) ? bf_hi(sw[e >> 1]) : bf_lo(sw[e >> 1]); xx[e] = s - h[e]; }
#pragma unroll
            for (int m = 0; m < 6; ++m) { const f32x4 ma = mr[jj][m][0], mb = mr[jj][m][1];
                u32x4 o; o.x = cvt_pk_bf16(h[0] + xx[0] * ma[0], h[1] + xx[1] * ma[1]); o.y = cvt_pk_bf16(h[2] + xx[2] * ma[2], h[3] + xx[3] * ma[3]);
                o.z = cvt_pk_bf16(h[4] + xx[4] * mb[0], h[5] + xx[5] * mb[1]); o.w = cvt_pk_bf16(h[6] + xx[6] * mb[2], h[7] + xx[7] * mb[3]);
                *(u32x4*)(outs[m] + (size_t)row * D + col) = o; } }
    }
}

constexpr int NCH = 5, SCP = NCH * 64, NSC = (SEQ + CTXL) / SCP, NSCAN = 64, TP = 72, TILE_B = 64 * TP * 2;
static_assert(NSC * SCP == SEQ + CTXL, "super-chunks");
enum { T_AT = 0, T_RT, T_BT, T_KT, T_VM, T_NT, T_MT, T_NRT, T_MRT, T_APA, T_APB, T_TAA, T_TAB, T_PRB, T_QRB, T_NTILE };
constexpr int LDS_GL = T_NTILE * TILE_B, LDS_SEG = LDS_GL + 256;
static_assert(LDS_SEG + 2048 <= LDS_MISC, "scan LDS map");
__device__ __forceinline__ int scan_row(int z, int b, int p) {
    if (p < CTXL) return TL + b * CTXL + (z ? CTXL - 1 - p : p);
    const int q = p - CTXL; return b * SEQ + (z ? SEQ - 1 - q : q);
}
__device__ __forceinline__ LAS bf16_t* stile(LAS unsigned char* lds, int n) { return (LAS bf16_t*)(lds + n * TILE_B); }
__device__ __forceinline__ bf16x8 row_frag(const LAS bf16_t* M, int r0, int k0, int lane) { return *(const LAS bf16x8*)(M + (r0 + (lane & 15)) * TP + k0 + 8 * (lane >> 4)); }
__device__ __forceinline__ bf16x8 tr_frag(const LAS bf16_t* M, int k0, int c0, int lane) {
    LAS bf16_t* p = (LAS bf16_t*)M + (k0 + 8 * (lane >> 4) + ((lane & 15) >> 2)) * TP + c0 + 4 * (lane & 3);
    const v4s lo = __builtin_amdgcn_ds_read_tr16_b64_v4i16((LAS v4s*)p), hi = __builtin_amdgcn_ds_read_tr16_b64_v4i16((LAS v4s*)(p + 4 * TP));
    return (bf16x8){lo[0], lo[1], lo[2], lo[3], hi[0], hi[1], hi[2], hi[3]};
}
template <bool XT, bool YT>
__device__ __forceinline__ void mm64(const LAS bf16_t* X, const LAS bf16_t* Y, f32x4 (&acc)[2], int wq, int wh, int lane) {
#pragma unroll
    for (int ks = 0; ks < 2; ++ks) {
        const bf16x8 b = XT ? tr_frag(X, 32 * ks, 16 * wq, lane) : row_frag(X, 16 * wq, 32 * ks, lane);
#pragma unroll
        for (int q = 0; q < 2; ++q) { const int i0 = 16 * (2 * wh + q);
            const bf16x8 a = YT ? row_frag(Y, i0, 32 * ks, lane) : tr_frag(Y, 32 * ks, i0, lane);
            acc[q] = __builtin_amdgcn_mfma_f32_16x16x32_bf16(a, b, acc[q], 0, 0, 0); }
    }
}
__device__ __forceinline__ void st_tile(LAS bf16_t* Z, const f32x4 (&acc)[2], int wq, int wh, int lane) {
#pragma unroll
    for (int q = 0; q < 2; ++q) { u32x2 o; o.x = cvt_pk_bf16(acc[q][0], acc[q][1]); o.y = cvt_pk_bf16(acc[q][2], acc[q][3]);
        *(LAS u32x2*)(Z + (16 * wq + (lane & 15)) * TP + 16 * (2 * wh + q) + 4 * (lane >> 4)) = o; }
}
__device__ __forceinline__ void ld_tile(const LAS bf16_t* Z, f32x4 (&acc)[2], int wq, int wh, int lane) {
#pragma unroll
    for (int q = 0; q < 2; ++q) { const u32x2 o = *(const LAS u32x2*)(Z + (16 * wq + (lane & 15)) * TP + 16 * (2 * wh + q) + 4 * (lane >> 4));
        acc[q] = (f32x4){bf_lo(o.x), bf_hi(o.x), bf_lo(o.y), bf_hi(o.y)}; }
}
__device__ __forceinline__ f32x4 prod16(const LAS bf16_t* X, int xr, int xc, const LAS bf16_t* Y, int yr, int yc, f32x4 acc, int lane) {
    bf16x8 b = *(const LAS bf16x8*)(X + (xr + (lane & 15)) * TP + xc + 8 * (lane >> 4)); bf16x8 a = tr_frag(Y, yr, yc, lane);
    if ((lane >> 4) >= 2) { b = (bf16x8){0, 0, 0, 0, 0, 0, 0, 0}; a = (bf16x8){0, 0, 0, 0, 0, 0, 0, 0}; }
    return __builtin_amdgcn_mfma_f32_16x16x32_bf16(a, b, acc, 0, 0, 0);
}
__device__ __forceinline__ void st16(LAS bf16_t* Z, int zr, int zc, f32x4 acc, int lane) { u32x2 o; o.x = cvt_pk_bf16(acc[0], acc[1]); o.y = cvt_pk_bf16(acc[2], acc[3]); *(LAS u32x2*)(Z + (zr + (lane & 15)) * TP + zc + 4 * (lane >> 4)) = o; }
__device__ __forceinline__ f32x4 ld16(const LAS bf16_t* Z, int zr, int zc, int lane) { const u32x2 o = *(const LAS u32x2*)(Z + (zr + (lane & 15)) * TP + zc + 4 * (lane >> 4)); return (f32x4){bf_lo(o.x), bf_hi(o.x), bf_lo(o.y), bf_hi(o.y)}; }
struct ChunkRegs { u32x4 r, k, v, tw, ta; };
__device__ __forceinline__ void scan_load(KP P, const Frame& F, int item, int c4, ChunkRegs& R) {
    const int s = item & 63, sc = item >> 6, z = s >> 5, b = (s >> 4) & 1, hh = s & 15;
    const size_t row = (size_t)scan_row(z, b, sc * SCP + c4 * 64 + (F.tid >> 3)); const size_t o = row * D + hh * 64 + (F.tid & 7) * 8, o2 = row * 256 + z * 64 + (F.tid & 7) * 8;
    R.r = *(const u32x4*)((const bf16_t*)(P->ws + WS_R) + o); R.k = *(const u32x4*)((const bf16_t*)(P->ws + WS_K) + o); R.v = *(const u32x4*)((const bf16_t*)(P->ws + WS_VV) + o);
    R.tw = *(const u32x4*)((const bf16_t*)(P->ws + WS_TW) + o2); R.ta = *(const u32x4*)((const bf16_t*)(P->ws + WS_TA) + o2);
}
__device__ __forceinline__ void scan_chunk_phase(const Frame& F, KP P, int j) {
    LAS unsigned char* lds = F.lds;
    LAS bf16_t* At = stile(lds, T_AT); LAS bf16_t* Rt = stile(lds, T_RT); LAS bf16_t* Bt = stile(lds, T_BT); LAS bf16_t* Kt = stile(lds, T_KT); LAS bf16_t* Vm = stile(lds, T_VM);
    LAS bf16_t* NT = stile(lds, T_NT); LAS bf16_t* MT = stile(lds, T_MT); LAS bf16_t* NrT = stile(lds, T_NRT); LAS bf16_t* MrT = stile(lds, T_MRT);
    LAS bf16_t* ApA = stile(lds, T_APA); LAS bf16_t* ApB = stile(lds, T_APB); LAS bf16_t* TaA = stile(lds, T_TAA); LAS bf16_t* TaB = stile(lds, T_TAB);
    LAS bf16_t* PrB = stile(lds, T_PRB); LAS bf16_t* QrB = stile(lds, T_QRB);
    LAS float* gl = (LAS float*)(lds + LDS_GL); LAS float* seg = (LAS float*)(lds + LDS_SEG);
    const int lane = F.lane, wq = F.wave & 3, wh = F.wave >> 2, l15 = lane & 15, l4 = lane >> 4;
    const int pi = F.tid >> 3, kq = F.tid & 7;
    const int jrow = 16 * wq + l15;
    const int NITEM = NSCAN * NSC;
    int item = blockIdx.x; if (item >= NITEM) return;
    ChunkRegs cur, nxt; scan_load(P, F, item, 0, cur); nxt = cur;
    f32x4 Pr[2], Qr[2], aYp[2], aQp[2];
#pragma unroll
    for (int q = 0; q < 2; ++q) { Pr[q] = (f32x4){0.f, 0.f, 0.f, 0.f}; Qr[q] = Pr[q]; aYp[q] = Pr[q]; aQp[q] = Pr[q]; }
    bool pend = false; size_t orowp = 0; bf16_t* GEp = nullptr; bf16_t* YEp = nullptr; float* pqp = nullptr; bool lastp = false;
#define SCAN_STAGE_G() do { \
        f32x4 ge[2] = {(f32x4){0.f, 0.f, 0.f, 0.f}, (f32x4){0.f, 0.f, 0.f, 0.f}}; \
        mm64<false, true>(NT, PrB, ge, wq, wh, lane); mm64<false, true>(NT, QrB, aYp, wq, wh, lane); \
        f32x4 pn[2] = {(f32x4){0.f, 0.f, 0.f, 0.f}, (f32x4){0.f, 0.f, 0.f, 0.f}}; \
        mm64<false, false>(PrB, MT, pn, wq, wh, lane); mm64<false, false>(QrB, MT, aQp, wq, wh, lane); \
        _Pragma("unroll") for (int q = 0; q < 2; ++q) { const int i0 = 16 * (2 * wh + q) + 4 * l4; \
            u32x2 o; o.x = cvt_pk_bf16(ge[q][0], ge[q][1]); o.y = cvt_pk_bf16(ge[q][2], ge[q][3]); *(u32x2*)(GEp + orowp + i0) = o; \
            u32x2 y; y.x = cvt_pk_bf16(aYp[q][0], aYp[q][1]); y.y = cvt_pk_bf16(aYp[q][2], aYp[q][3]); *(u32x2*)(YEp + orowp + i0) = y; \
            Pr[q] = pn[q]; Qr[q] = aQp[q]; } \
        if (lastp) { const int ln_ = lane_id_now(), l15_ = ln_ & 15, l4_ = ln_ >> 4;   \
            float* pP_ = pqp + ((l15_ & 3) * 4 + (l15_ >> 2)) * 64 + wq * 16 + 8 * wh + l4_; float* pQ_ = pqp + 4096 + (wq * 16 + l4_) * 64 + 32 * wh + l15_; \
            _Pragma("unroll") for (int q = 0; q < 2; ++q)   \
            _Pragma("unroll") for (int r = 0; r < 4; ++r) { pP_[r * 1024 + 4 * q] = Pr[q][r]; pQ_[r * 256 + 16 * q] = Qr[q][r]; } } \
    } while (0)
    for (;;) {
        const int s = item & 63, sc = item >> 6, z = s >> 5, b = (s >> 4) & 1, hh = s & 15;
        const float* kkw = P->in[I_KK] + (size_t)j * D + hh * 64 + kq * 8; const float* kap = P->in[I_KA] + (size_t)j * D + hh * 64 + kq * 8; const float* rkp = P->in[I_RK] + (size_t)j * D + hh * 64 + kq * 8;
        const float* w0p = P->in[I_W0] + ((size_t)j * 2 + z) * D + hh * 64; const float* a0p = P->in[I_A0] + ((size_t)j * 2 + z) * D + hh * 64;
        float* bon = (float*)(P->ws + WS_BON) + (size_t)z * T * 16;
        const u32x4 w2r = *(const u32x4*)((const bf16_t*)(P->ws + WS_W2P) + (((size_t)j * 2 + z) * D + hh * 64 + pi) * 256 + z * 64 + kq * 8);
        const u32x4 a2r = *(const u32x4*)((const bf16_t*)(P->ws + WS_A2P) + (((size_t)j * 2 + z) * D + hh * 64 + pi) * 256 + z * 64 + kq * 8);
        bf16_t* GE = (bf16_t*)(P->ws + (z ? WS_AS1 : WS_AS0)); bf16_t* YE = (bf16_t*)(P->ws + (z ? WS_ELOG1 : WS_ELOG0));
        float* pq = (float*)(P->ws + WS_PQ) + ((size_t)(s * NSC + sc) * 2) * 4096;
#pragma nounroll
        for (int c4 = 0; c4 < NCH; ++c4) {
            unsigned long long ch_t[12]; ch_t[11] = CH_AMP >= 0 ? __builtin_amdgcn_s_memrealtime() : 0ull;
            *(LAS u32x4*)(ApA + pi * TP + kq * 8) = cur.tw; *(LAS u32x4*)(ApB + pi * TP + kq * 8) = cur.ta; *(LAS u32x4*)(NrT + pi * TP + kq * 8) = w2r; *(LAS u32x4*)(MrT + pi * TP + kq * 8) = a2r;
            LDS_BARRIER(); CH_STAMP(0);
            {   f32x4 lw[2] = {(f32x4){0.f, 0.f, 0.f, 0.f}, (f32x4){0.f, 0.f, 0.f, 0.f}}, la[2] = {(f32x4){0.f, 0.f, 0.f, 0.f}, (f32x4){0.f, 0.f, 0.f, 0.f}};
                mm64<false, true>(ApA, NrT, lw, wq, wh, lane); mm64<false, true>(ApB, MrT, la, wq, wh, lane);
#pragma unroll
                for (int q = 0; q < 2; ++q) { const int i0 = 16 * (2 * wh + q) + 4 * l4; const f32x4 w04 = *(const f32x4*)(w0p + i0), a04 = *(const f32x4*)(a0p + i0);
#pragma unroll
                    for (int r = 0; r < 4; ++r) { lw[q][r] = -0.60653065971f * sigmoidf_(w04[r] + lw[q][r]); la[q][r] = sigmoidf_(a04[r] + la[q][r]); } }
                st_tile(TaA, lw, wq, wh, lane); st_tile(TaB, la, wq, wh, lane); }
            LDS_BARRIER(); CH_STAMP(1);
            float r8[8], k8[8], e8[8], m8[8], a8[8], kk8[8], c8[8];
            { const u32x4 et = *(const LAS u32x4*)(TaA + pi * TP + kq * 8), at = *(const LAS u32x4*)(TaB + pi * TP + kq * 8); unpack8(cur.r, r8); unpack8(cur.k, k8); unpack8(et, e8); unpack8(at, a8); }
            {   const f32x4 ka0 = *(const f32x4*)(kap), ka1 = *(const f32x4*)(kap + 4), rk0 = *(const f32x4*)(rkp), rk1 = *(const f32x4*)(rkp + 4); float bp = 0.f;
#pragma unroll
                for (int e = 0; e < 8; ++e) { m8[e] = k8[e] * (1.0f + (a8[e] - 1.0f) * (e < 4 ? ka0[e & 3] : ka1[e & 3])); bp += r8[e] * (e < 4 ? rk0[e & 3] : rk1[e & 3]) * m8[e]; }
                bp += shx(bp, 1, lane); bp += shx(bp, 2, lane); bp += shx(bp, 4, lane);
                if (kq == 0) bon[(size_t)scan_row(z, b, sc * SCP + c4 * 64 + pi) * 16 + hh] = bp; }
            { const f32x4 w0 = *(const f32x4*)kkw, w1 = *(const f32x4*)(kkw + 4); float ss = 0.f;
#pragma unroll
              for (int e = 0; e < 8; ++e) { kk8[e] = k8[e] * (e < 4 ? w0[e & 3] : w1[e & 3]); ss += kk8[e] * kk8[e]; }
              ss += shx(ss, 1, lane); ss += shx(ss, 2, lane); ss += shx(ss, 4, lane);
              const float rn = rsqrtf(ss + 1e-12f);
#pragma unroll
              for (int e = 0; e < 8; ++e) { kk8[e] *= rn; c8[e] = e8[e]; } }
#pragma unroll
            for (int d = 8; d < 64; d <<= 1) {
#pragma unroll
                for (int e = 0; e < 8; ++e) { const float t = shup(c8[e], d, lane); c8[e] += lane >= d ? t : 0.f; } }
            if (lane >= 56) { *(LAS f32x4*)(seg + F.wave * 64 + kq * 8) = (f32x4){c8[0], c8[1], c8[2], c8[3]}; *(LAS f32x4*)(seg + F.wave * 64 + kq * 8 + 4) = (f32x4){c8[4], c8[5], c8[6], c8[7]}; }
            if (pend) { SCAN_STAGE_G(); pend = false; }
            LDS_BARRIER(); CH_STAMP(2);
            if (c4 > 0) { st_tile(PrB, Pr, wq, wh, lane); st_tile(QrB, Qr, wq, wh, lane); }
            { float cum[8];
#pragma unroll
              for (int e = 0; e < 8; ++e) cum[e] = c8[e];
              for (int w2 = 0; w2 < F.wave; ++w2) { const f32x4 o0 = *(const LAS f32x4*)(seg + w2 * 64 + kq * 8), o1 = *(const LAS f32x4*)(seg + w2 * 64 + kq * 8 + 4);
#pragma unroll
                  for (int e = 0; e < 8; ++e) cum[e] += e < 4 ? o0[e & 3] : o1[e & 3]; }
              float o[8];
#pragma unroll
              for (int e = 0; e < 8; ++e) o[e] = -kk8[e] * __expf(cum[e] - e8[e]);
              *(LAS u32x4*)(At + pi * TP + kq * 8) = pack8(o);
#pragma unroll
              for (int e = 0; e < 8; ++e) o[e] = r8[e] * __expf(cum[e]);
              *(LAS u32x4*)(Rt + pi * TP + kq * 8) = pack8(o);
              float en[8];
#pragma unroll
              for (int e = 0; e < 8; ++e) { en[e] = __expf(-cum[e]); o[e] = kk8[e] * a8[e] * en[e]; }
              *(LAS u32x4*)(Bt + pi * TP + kq * 8) = pack8(o);
#pragma unroll
              for (int e = 0; e < 8; ++e) o[e] = m8[e] * en[e];
              *(LAS u32x4*)(Kt + pi * TP + kq * 8) = pack8(o);
              *(LAS u32x4*)(Vm + pi * TP + kq * 8) = cur.v;
              if (pi == 63) {
#pragma unroll
                  for (int e = 0; e < 8; ++e) gl[kq * 8 + e] = __expf(cum[e]); } }
            { const int nitem = c4 < NCH - 1 ? item : item + (int)gridDim.x, nc4 = c4 < NCH - 1 ? c4 + 1 : 0; if (nitem < NITEM) scan_load(P, F, nitem, nc4, nxt); }
            LDS_BARRIER(); CH_STAMP(3);
            {   f32x4 aN[2], aM[2], aNr[2], aMr[2];
#pragma unroll
                for (int q = 0; q < 2; ++q) { aN[q] = (f32x4){0.f, 0.f, 0.f, 0.f}; aM[q] = aN[q]; aNr[q] = aN[q]; aMr[q] = aN[q]; }
                mm64<false, true>(At, Bt, aN, wq, wh, lane); mm64<false, true>(At, Kt, aM, wq, wh, lane); mm64<false, true>(Rt, Bt, aNr, wq, wh, lane); mm64<false, true>(Rt, Kt, aMr, wq, wh, lane);
                f32x4 aT[2];
#pragma unroll
                for (int q = 0; q < 2; ++q)
#pragma unroll
                    for (int r = 0; r < 4; ++r) { const int i = 16 * (2 * wh + q) + 4 * l4 + r; const bool lt = i < jrow, le = i <= jrow;
                        aN[q][r] = lt ? aN[q][r] : 0.f; aM[q][r] = lt ? aM[q][r] : 0.f; aNr[q][r] = le ? aNr[q][r] : 0.f; aMr[q][r] = le ? aMr[q][r] : 0.f; aT[q][r] = aN[q][r] + (i == jrow ? 1.f : 0.f); }
                st_tile(NT, aN, wq, wh, lane); st_tile(MT, aM, wq, wh, lane); st_tile(NrT, aNr, wq, wh, lane); st_tile(MrT, aMr, wq, wh, lane); st_tile(TaA, aT, wq, wh, lane);
            }
            LDS_BARRIER(); CH_STAMP(4);
            if (F.wave < 4) { const int o = 16 * F.wave, oc = 16 * ((F.wave + 1) & 3);
                f32x4 p = prod16(NT, o, o, NT, o, o, (f32x4){0.f, 0.f, 0.f, 0.f}, lane); st16(ApA, o, o, p, lane);
                f32x4 t = prod16(TaA, o, o, ApA, o, o, ld16(TaA, o, o, lane), lane); p = prod16(ApA, o, o, ApA, o, o, (f32x4){0.f, 0.f, 0.f, 0.f}, lane);
                st16(TaB, o, o, t, lane); st16(ApA, o, oc, p, lane);
                t = prod16(TaB, o, o, ApA, o, oc, ld16(TaB, o, o, lane), lane); p = prod16(ApA, o, oc, ApA, o, oc, (f32x4){0.f, 0.f, 0.f, 0.f}, lane);
                st16(TaA, o, o, t, lane); st16(ApA, o, o, p, lane);
                t = prod16(TaA, o, o, ApA, o, o, ld16(TaA, o, o, lane), lane); st16(TaB, o, o, t, lane);
#pragma unroll
                for (int jj = 1; jj < 4; ++jj) if (jj > F.wave) { u32x2 zz; asm volatile("v_mov_b32 %0, 0\n\tv_mov_b32 %1, 0" : "=v"(zz.x), "=v"(zz.y)); *(LAS u32x2*)(TaB + (o + l15) * TP + 16 * jj + 4 * l4) = zz; }
            } else { const int wq2 = F.wave - 4;
#pragma unroll
                for (int wh2 = 0; wh2 < 2; ++wh2) { f32x4 x[2] = {(f32x4){0.f, 0.f, 0.f, 0.f}, (f32x4){0.f, 0.f, 0.f, 0.f}}; mm64<true, true>(Vm, MT, x, wq2, wh2, lane); st_tile(ApB, x, wq2, wh2, lane); } }
            LDS_BARRIER(); CH_STAMP(5);
            if (F.wave < 3) { const int jj = F.wave;
#pragma unroll
                for (int i = 1; i < 4; ++i) if (i > jj) { f32x4 e = (f32x4){0.f, 0.f, 0.f, 0.f};
#pragma unroll
                    for (int m = 0; m < 3; ++m) if (m >= jj && m < i) e = prod16(NT, 16 * i, 16 * m, TaB, 16 * m, 16 * jj, e, lane);
                    st16(ApA, 16 * i, 16 * jj, e, lane);
                    st16(TaB, 16 * i, 16 * jj, prod16(TaB, 16 * i, 16 * i, ApA, 16 * i, 16 * jj, (f32x4){0.f, 0.f, 0.f, 0.f}, lane), lane); } }
            LDS_BARRIER(); CH_STAMP(6);
            {   f32x4 w[2] = {(f32x4){0.f, 0.f, 0.f, 0.f}, (f32x4){0.f, 0.f, 0.f, 0.f}}; mm64<true, true>(At, TaB, w, wq, wh, lane); st_tile(ApA, w, wq, wh, lane);
                f32x4 u[2] = {(f32x4){0.f, 0.f, 0.f, 0.f}, (f32x4){0.f, 0.f, 0.f, 0.f}}; mm64<false, true>(ApB, TaB, u, wq, wh, lane); st_tile(TaA, u, wq, wh, lane); }
            LDS_BARRIER(); CH_STAMP(7);
            f32x4 aP[2], aQ[2], aG[2], aY[2];
#pragma unroll
            for (int q = 0; q < 2; ++q) { aP[q] = (f32x4){0.f, 0.f, 0.f, 0.f}; aQ[q] = aP[q]; aG[q] = aP[q]; aY[q] = aP[q]; }
            mm64<false, false>(ApA, Bt, aP, wq, wh, lane);
            mm64<false, false>(TaA, Bt, aQ, wq, wh, lane); mm64<true, false>(Vm, Kt, aQ, wq, wh, lane);
            mm64<false, true>(NrT, ApA, aG, wq, wh, lane);
            mm64<false, true>(NrT, TaA, aY, wq, wh, lane); mm64<false, false>(MrT, Vm, aY, wq, wh, lane);
#pragma unroll
            for (int q = 0; q < 2; ++q) { const int i0 = 16 * (2 * wh + q) + 4 * l4; const f32x4 g4 = *(const LAS f32x4*)(gl + i0);
                const u32x2 rr = *(const LAS u32x2*)(Rt + jrow * TP + i0);
#pragma unroll
                for (int r = 0; r < 4; ++r) { aP[q][r] = (aP[q][r] + (i0 + r == jrow ? 1.f : 0.f)) * g4[r]; aQ[q][r] *= g4[r]; }
                aG[q][0] += bf_lo(rr.x); aG[q][1] += bf_hi(rr.x); aG[q][2] += bf_lo(rr.y); aG[q][3] += bf_hi(rr.y); }
            const size_t orow = (size_t)scan_row(z, b, sc * SCP + c4 * 64 + jrow) * D + hh * 64;
            if (c4 == 0) {
#pragma unroll
                for (int q = 0; q < 2; ++q) { const int i0 = 16 * (2 * wh + q) + 4 * l4;
                    u32x2 o; o.x = cvt_pk_bf16(aG[q][0], aG[q][1]); o.y = cvt_pk_bf16(aG[q][2], aG[q][3]); *(u32x2*)(GE + orow + i0) = o;
                    u32x2 y; y.x = cvt_pk_bf16(aY[q][0], aY[q][1]); y.y = cvt_pk_bf16(aY[q][2], aY[q][3]); *(u32x2*)(YE + orow + i0) = y;
                    Pr[q] = aP[q]; Qr[q] = aQ[q]; }
            } else {
                st_tile(NT, aG, wq, wh, lane); st_tile(MT, aP, wq, wh, lane);
#pragma unroll
                for (int q = 0; q < 2; ++q) { aYp[q] = aY[q]; aQp[q] = aQ[q]; }
                pend = true; orowp = orow; GEp = GE; YEp = YE; pqp = pq; lastp = c4 == NCH - 1;
            }
            cur = nxt;
            if (CH_AMP >= 0) { const unsigned long long d_ = CH_AMP == 0 ? ch_t[0] - ch_t[11] : ch_t[CH_AMP] - ch_t[CH_AMP - 1]; const unsigned long long dl_ = __builtin_amdgcn_s_memrealtime() + 4 * d_; while (__builtin_amdgcn_s_memrealtime() < dl_) __builtin_amdgcn_s_sleep(4); }
            LDS_BARRIER(); CH_STAMP(8);
        }
        item += gridDim.x; if (item >= NITEM) break;
    }
    if (pend) { SCAN_STAGE_G(); }
#undef SCAN_STAGE_G
}
__device__ __forceinline__ void scan_carry_phase(const Frame& F, KP P, int layer) {
    LAS unsigned* cbar = (LAS unsigned*)(F.lds + 8192);
    if (F.tid == 0) *cbar = 0u;
    __syncthreads();
    if (F.wave >= 4) { moe_weights_phase(F, P, layer, blockIdx.x * 4 + (F.wave - 4), gridDim.x * 4, 0, MOE_SPLIT); return; }
    if (blockIdx.x >= 4 * NSCAN) return;
    unsigned ctarget = 0u;
    const int s = blockIdx.x >> 2, vs = blockIdx.x & 3, lane = F.lane, l15 = lane & 15, l4 = lane >> 4, v = 16 * vs + l15, T2 = F.wave;
    const float* pq = (const float*)(P->ws + WS_PQ) + (size_t)s * NSC * 2 * 4096; bf16_t* sst = (bf16_t*)(P->ws + WS_SST) + (size_t)s * NSC * 4096;
    LAS f32x4* exch = (LAS f32x4*)F.lds;
    f32x4 S[4]; float ap[4][16], qp[4][4];
#pragma unroll
    for (int t = 0; t < 4; ++t) S[t] = (f32x4){0.f, 0.f, 0.f, 0.f};
#define CARRY_LOAD(slot, step) do { const float* Pm_ = pq + (size_t)(step) * 2 * 4096; \
        _Pragma("unroll") for (int t2i = 0; t2i < 4; ++t2i) _Pragma("unroll") for (int ri = 0; ri < 4; ++ri) ap[slot][t2i * 4 + ri] = Pm_[(T2 * 16 + t2i * 4 + ri) * 64 + lane];   \
        _Pragma("unroll") for (int r = 0; r < 4; ++r) qp[slot][r] = Pm_[4096 + ((vs * 4 + T2) * 4 + r) * 64 + lane];   } while (0)
#define CARRY_STORE(sc_) do { if (T2 == 0) { float o[16]; \
        _Pragma("unroll") for (int r = 0; r < 4; ++r) _Pragma("unroll") for (int t2 = 0; t2 < 4; ++t2) o[4 * r + t2] = S[t2][r]; \
        u32x4 w0, w1; w0.x = cvt_pk_bf16(o[0], o[1]); w0.y = cvt_pk_bf16(o[2], o[3]); w0.z = cvt_pk_bf16(o[4], o[5]); w0.w = cvt_pk_bf16(o[6], o[7]); \
        w1.x = cvt_pk_bf16(o[8], o[9]); w1.y = cvt_pk_bf16(o[10], o[11]); w1.z = cvt_pk_bf16(o[12], o[13]); w1.w = cvt_pk_bf16(o[14], o[15]); \
        *(u32x4*)(sst + (size_t)(sc_) * 4096 + v * 64 + 16 * l4) = w0; *(u32x4*)(sst + (size_t)(sc_) * 4096 + v * 64 + 16 * l4 + 8) = w1; } } while (0)
    if (T2 < 4) {
#pragma unroll
        for (int u = 0; u < 4; ++u) CARRY_LOAD(u, u);
    }
#pragma nounroll
    for (int sc0 = 0; sc0 < NSC - 1; sc0 += 4) {
#pragma unroll
        for (int u = 0; u < 4; ++u) { const int sc = sc0 + u; if (sc >= NSC - 1) break;
            CARRY_STORE(sc);
            if (T2 < 4) {
                f32x4 nw = (f32x4){qp[u][0], qp[u][1], qp[u][2], qp[u][3]};
#pragma unroll
                for (int t2i = 0; t2i < 4; ++t2i)
#pragma unroll
                    for (int ri = 0; ri < 4; ++ri) nw = __builtin_amdgcn_mfma_f32_16x16x4f32(ap[u][t2i * 4 + ri], S[t2i][ri], nw, 0, 0, 0);
                if (sc + 4 < NSC - 1) CARRY_LOAD(u, sc + 4);
                exch[((u & 1) * 4 + T2) * 64 + lane] = nw;
            }
            { asm volatile("s_waitcnt lgkmcnt(0)" ::: "memory"); if (lane == 0) __hip_atomic_fetch_add(cbar, 1u, __ATOMIC_RELAXED, __HIP_MEMORY_SCOPE_WORKGROUP); ctarget += 4u;
              for (int spin = 0; spin < (1 << 22); ++spin) { const unsigned c = __hip_atomic_load(cbar, __ATOMIC_RELAXED, __HIP_MEMORY_SCOPE_WORKGROUP); if ((int)(c - ctarget) >= 0) break; }
              asm volatile("" ::: "memory"); }
            if (T2 < 4) {
#pragma unroll
                for (int t = 0; t < 4; ++t) S[t] = exch[((u & 1) * 4 + t) * 64 + lane];
            }
        }
    }
    CARRY_STORE(NSC - 1);
#undef CARRY_LOAD
#undef CARRY_STORE
}
__device__ __forceinline__ void scan_out_phase(const Frame& F, KP P, int j) {
    const int lane = F.lane, l15 = lane & 15, l4 = lane >> 4;
    const bf16_t* GE0 = (const bf16_t*)(P->ws + WS_AS0); const bf16_t* GE1 = (const bf16_t*)(P->ws + WS_AS1); const bf16_t* YE0 = (const bf16_t*)(P->ws + WS_ELOG0); const bf16_t* YE1 = (const bf16_t*)(P->ws + WS_ELOG1);
    const bf16_t* Vb = (const bf16_t*)(P->ws + WS_VV); const float* BON = (const float*)(P->ws + WS_BON);
    const bf16_t* GT = (const bf16_t*)(P->ws + WS_GATE); bf16_t* YG = (bf16_t*)(P->ws + WS_YG);
    for (int item = F.gw; item < NBATCH * NH * ((SEQ + CTXL) / 256) * 8; item += F.NGW) {
        const int hh = item & 15, oct = (item >> 4) & 7, b = (item >> 7) & 1, blk = item >> 8;
        const int sc0 = (blk * 256 + 32 * oct) / SCP, sc1 = blk == 0 ? 0 : (SEQ + CTXL - 1 - (blk - 1) * 256 - 32 * oct) / SCP;

        const bf16_t* s0 = (const bf16_t*)(P->ws + WS_SST) + ((size_t)(b * 16 + hh) * NSC + sc0) * 4096; const bf16_t* s1 = (const bf16_t*)(P->ws + WS_SST) + ((size_t)(32 + b * 16 + hh) * NSC + sc1) * 4096;
        bf16x8 sa0[4][2], sa1[4][2];
#pragma unroll
        for (int vt = 0; vt < 4; ++vt) { const int v = 32 * (vt >> 1) + 8 * (l15 >> 2) + 4 * (vt & 1) + (l15 & 3);
#pragma unroll
            for (int ks = 0; ks < 2; ++ks) { sa0[vt][ks] = *(const bf16x8*)(s0 + v * 64 + 32 * ks + 8 * l4); sa1[vt][ks] = *(const bf16x8*)(s1 + v * 64 + 32 * ks + 8 * l4); } }
        f32x4 lg4[4], lb4[4];
#pragma unroll
        for (int q = 0; q < 4; ++q) { const int c = hh * 64 + 32 * (q >> 1) + 8 * l4 + 4 * (q & 1); lg4[q] = *(const f32x4*)(P->in[I_LNG] + (size_t)j * D + c); lb4[q] = *(const f32x4*)(P->in[I_LNB] + (size_t)j * D + c); }
#pragma nounroll
        for (int ti = 0; ti < 2; ++ti) {
            const int tok = (2 * oct + ti) * 16 + l15; const int row = blk == 0 ? TL + b * CTXL + tok : b * SEQ + (blk - 1) * 256 + tok;
            const size_t o = (size_t)row * D + hh * 64;
            const bf16x8 g00 = *(const bf16x8*)(GE0 + o + 8 * l4), g01 = *(const bf16x8*)(GE0 + o + 32 + 8 * l4), g10 = *(const bf16x8*)(GE1 + o + 8 * l4), g11 = *(const bf16x8*)(GE1 + o + 32 + 8 * l4);
            u32x4 la[2], lc[2], lv[2], lgt[2];
#pragma unroll
            for (int h2 = 0; h2 < 2; ++h2) { const size_t oc = o + 32 * h2 + 8 * l4;
                la[h2] = *(const u32x4*)(YE0 + oc); lc[h2] = *(const u32x4*)(YE1 + oc); lv[h2] = *(const u32x4*)(Vb + oc); lgt[h2] = *(const u32x4*)(GT + oc); }
            const float bn = BON[(size_t)row * 16 + hh] + BON[((size_t)T + row) * 16 + hh];
            __builtin_amdgcn_sched_barrier(0);
            f32x4 y[4]; float s = 0.f; f32x4 vv[4], gg[4];
#pragma unroll
            for (int vt = 0; vt < 4; ++vt) { const int h2 = vt >> 1, hf = vt & 1;
                const unsigned ax = hf ? la[h2].z : la[h2].x, ay = hf ? la[h2].w : la[h2].y, cx = hf ? lc[h2].z : lc[h2].x, cy = hf ? lc[h2].w : lc[h2].y;
                const unsigned vx = hf ? lv[h2].z : lv[h2].x, vy = hf ? lv[h2].w : lv[h2].y, gx = hf ? lgt[h2].z : lgt[h2].x, gy = hf ? lgt[h2].w : lgt[h2].y;
                f32x4 acc = (f32x4){bf_lo(ax) + bf_lo(cx), bf_hi(ax) + bf_hi(cx), bf_lo(ay) + bf_lo(cy), bf_hi(ay) + bf_hi(cy)};
                acc = __builtin_amdgcn_mfma_f32_16x16x32_bf16(sa0[vt][0], g00, acc, 0, 0, 0); acc = __builtin_amdgcn_mfma_f32_16x16x32_bf16(sa0[vt][1], g01, acc, 0, 0, 0);
                acc = __builtin_amdgcn_mfma_f32_16x16x32_bf16(sa1[vt][0], g10, acc, 0, 0, 0); acc = __builtin_amdgcn_mfma_f32_16x16x32_bf16(sa1[vt][1], g11, acc, 0, 0, 0);
                y[vt] = acc; s += (acc[0] + acc[1]) + (acc[2] + acc[3]);
                vv[vt] = (f32x4){bf_lo(vx), bf_hi(vx), bf_lo(vy), bf_hi(vy)}; gg[vt] = (f32x4){bf_lo(gx), bf_hi(gx), bf_lo(gy), bf_hi(gy)}; }
            s += shx(s, 16, lane); s += shx(s, 32, lane);
            const float mean = s * (1.0f / 64.0f); float q = 0.f;
#pragma unroll
            for (int vt = 0; vt < 4; ++vt) { const f32x4 d = y[vt] - mean; q += (d[0] * d[0] + d[1] * d[1]) + (d[2] * d[2] + d[3] * d[3]); }
            q += shx(q, 16, lane); q += shx(q, 32, lane);
            const float rstd = rsqrtf(q * (1.0f / 64.0f) + 64e-5f);
#pragma unroll
            for (int h2 = 0; h2 < 2; ++h2) { const f32x4 o0 = (((y[2 * h2] - mean) * rstd) * lg4[2 * h2] + lb4[2 * h2] + vv[2 * h2] * bn) * gg[2 * h2], o1 = (((y[2 * h2 + 1] - mean) * rstd) * lg4[2 * h2 + 1] + lb4[2 * h2 + 1] + vv[2 * h2 + 1] * bn) * gg[2 * h2 + 1];
                u32x4 w; w.x = cvt_pk_bf16(o0[0], o0[1]); w.y = cvt_pk_bf16(o0[2], o0[3]); w.z = cvt_pk_bf16(o1[0], o1[1]); w.w = cvt_pk_bf16(o1[2], o1[3]); *(u32x4*)(YG + o + 32 * h2 + 8 * l4) = w; }
        }
    }
}
__device__ __forceinline__ bool in_range(int lo, int hi, int k) { asm volatile("" : "+s"(lo), "+s"(hi)); return lo <= k && k < hi; }
constexpr int NPH = 46;
template <unsigned KMASK> __global__ void __launch_bounds__(NTHR, 2) mega(Params Pv) {
    extern __shared__ __attribute__((aligned(16))) unsigned char lds_raw[];
    Frame F0; F0.lds = (LAS unsigned char*)lds_raw; F0.tid = threadIdx.x; F0.lane = F0.tid & 63; F0.wave = __builtin_amdgcn_readfirstlane(F0.tid >> 6);
    F0.G = gridDim.x; F0.gw = blockIdx.x * NWAVES + F0.wave; F0.NGW = F0.G * NWAVES;
    LAS unsigned* misc = (LAS unsigned*)(F0.lds + LDS_MISC);
    if (F0.tid < 128) misc[F0.tid] = 0u;
    __syncthreads();
    KP P0 = (KP)__builtin_amdgcn_kernarg_segment_ptr();
    constexpr bool ALL = (KMASK == 0x3ffffu);
    const int lo = ALL ? 0 : P0->ph_lo, hi = ALL ? NPH : P0->ph_hi;
    XcdBarrier bar; bar.bar = (unsigned*)(P0->ws + WS_CTL) + CW_BAR; bar.x = 0; bar.st = (volatile LAS unsigned*)(misc + 8);
    if (ALL || hi - lo > 1) bar = xcd_barrier_post((unsigned*)(P0->ws + WS_CTL) + CW_BAR, (volatile LAS unsigned*)(misc + 8));
#define IN(k) (ALL || in_range(lo, hi, (k)))
#define KIND(q) ((KMASK >> (q)) & 1u)
#define BAR_LEADER (wave_sgpr_now(F0.wave) == 0 && lane_id_now() == 0)
#define SEAM(k) do { if (IN(k) && IN((k) + 1)) { XcdBarrier b2_ = bar; unsigned* bb_ = bar.bar; unsigned bx_ = bar.x; asm volatile("" : "+s"(bb_), "+s"(bx_)); b2_.bar = bb_; b2_.x = bx_; xcd_barrier<false>(b2_, BAR_LEADER); } } while (0)
#define AMP_T0 const unsigned long long amp_t0 = AMP_MASK ? __builtin_amdgcn_s_memrealtime() : 0ull;
#define AMP_END(kind) do { if (AMP_MASK & (1u << (kind))) { const unsigned long long t1_ = __builtin_amdgcn_s_memrealtime(), dl_ = t1_ + AMP_F * (t1_ - amp_t0); while (__builtin_amdgcn_s_memrealtime() < dl_) __builtin_amdgcn_s_sleep(8); } } while (0)
#define PHASE_ENTRY AMP_T0 KP P = P0; asm volatile("" : "+s"(P)); unsigned char* ws = P->ws; unsigned* ctl = (unsigned*)(ws + WS_CTL); (void)ctl; \
    Frame F = F0; { int l_ = lane_id_now(), w_ = F0.wave; asm volatile("" : "+s"(w_)); F.lane = l_; F.wave = w_; F.tid = w_ * 64 + l_; F.gw = blockIdx.x * NWAVES + w_; }

    if constexpr (KIND(0)) if (IN(0)) { PHASE_ENTRY prologue_phase(F, P); AMP_END(0); }
    if (IN(0) && IN(1)) { XcdBarrier b2_ = bar; unsigned* bb_ = bar.bar; unsigned bx_ = bar.x; asm volatile("" : "+s"(bb_), "+s"(bx_)); b2_.bar = bb_; b2_.x = bx_; xcd_barrier<true>(b2_, BAR_LEADER); }
    for (int lp = 0; lp < 2; ++lp) {
        const int pb = 1 + 22 * lp, la = 2 * lp, lb = 2 * lp + 1;
        if constexpr (KIND(1)) if (IN(pb + 0)) { PHASE_ENTRY norm1_phase(F, P, la); AMP_END(1); }
        SEAM(pb + 0);
        if constexpr (KIND(2)) if (IN(pb + 1)) { PHASE_ENTRY
            __syncthreads(); set_desc(F.lds, F.tid, 0, ws + WS_HL, ws + WS_WIN + (size_t)lp * 4096 * D * 2, ws + WS_U, 16, 0, 0, ws + WS_V, P->in[I_GBIN] + (size_t)lp * 4096, ws + WS_STAT); __syncthreads();
            SchedMulti<D, D> S{F.lds, TL / 256, 16, 1};
            EpiGelu E{F.lds};
            pg8::gemm_phase<EpiGelu, SchedMulti<D, D>, false, D, D, D>(F.lds, S, E, F.tid);
            __syncthreads(); { int w_ = F0.wave; asm volatile("" : "+s"(w_)); tail_gelu(F0.lds, w_); }
            AMP_END(2); }
        SEAM(pb + 1);
        if constexpr (KIND(3)) if (IN(pb + 2)) { PHASE_ENTRY spatial_phase(F, P, lp); AMP_END(3); }
        SEAM(pb + 2);
        if constexpr (KIND(4)) if (IN(pb + 3)) { PHASE_ENTRY
            __syncthreads();
            { bf16_t* X = (bf16_t*)(ws + WS_X);
              set_desc(F.lds, F.tid, 0, ws + WS_U, ws + WS_WOUT + (size_t)lp * D * GWID * 2, X, 4, 0, 0, X, X + (size_t)TL * D, P->in[I_GBOUT] + (size_t)lp * D);
              set_desc(F.lds, F.tid, 1, nullptr, nullptr, nullptr, 0, 0, 0, (const float*)(ws + WS_MOD) + (size_t)la * 3 * 6 * D + 2 * D); }
            __syncthreads();
            SchedMulti<GWID, GWID> S{F.lds, TL / 256, 4, 1};
            EpiResid E{F.lds};
            pg8::gemm_phase<EpiResid, SchedMulti<GWID, GWID>, false, GWID, GWID, GWID>(F.lds, S, E, F.tid);
            __syncthreads(); { int w_ = F0.wave; asm volatile("" : "+s"(w_)); tail_resid<GWID>(F0.lds, w_); }
            AMP_END(4); }
        SEAM(pb + 3);
        if constexpr (KIND(5)) if (IN(pb + 4)) { PHASE_ENTRY norm2_phase(F, P, la); AMP_END(5); }
        SEAM(pb + 4);
        if constexpr (KIND(16)) if (IN(pb + 5)) { PHASE_ENTRY
            __syncthreads(); set_desc(F.lds, F.tid, 0, ws + WS_HL, ws + WS_WRT + (size_t)la * 256 * D * 2, nullptr, 1, 0, 0); __syncthreads();
            const int nun = (la == DEPTH - 1 ? TL : T) / 256;
            if ((int)blockIdx.x >= nun) moe_weights_phase(F, P, la, ((int)blockIdx.x - nun) * NWAVES + F.wave, (F.G - nun) * NWAVES, MOE_SPLIT, MOE_ITEMS);
            else { SchedMulti<D, D> S{F.lds, nun, 1, 1};
                EpiLogits E{(float*)(ws + WS_LG)};
                pg8::gemm_phase<EpiLogits, SchedMulti<D, D>, false, D, D, D>(F.lds, S, E, F.tid);
                if (F.G <= nun) { __syncthreads(); moe_weights_phase(F, P, la, F.gw, F.NGW, MOE_SPLIT, MOE_ITEMS); } }
            AMP_END(16); }
        SEAM(pb + 5);
        if constexpr (KIND(17)) if (IN(pb + 6)) { PHASE_ENTRY route_phase(F, P, la); AMP_END(17); }
        SEAM(pb + 6);
        if constexpr (KIND(6)) if (IN(pb + 7)) { PHASE_ENTRY
            moe_tables(F.lds, F.tid, ctl + CW_CNT + la * 64);
            SchedMoE<D, D, true> S{F.lds, (const char*)(ws + WS_HL), (const char*)(ws + WS_WGU), (const int*)(ws + WS_LIST)};
            EpiSiluGate E{(bf16_t*)(ws + WS_H)};
            pg8::gemm_phase<EpiSiluGate, SchedMoE<D, D, true>, true, D, D, D>(F.lds, S, E, F.tid);
            AMP_END(6); }
        SEAM(pb + 7);
        if constexpr (KIND(7)) if (IN(pb + 8)) { PHASE_ENTRY
            moe_tables(F.lds, F.tid, ctl + CW_CNT + la * 64);
            SchedMoE<EHID, EHID, false> S{F.lds, (const char*)(ws + WS_H), (const char*)(ws + WS_WD), (const int*)(ws + WS_LIST)};
            EpiScatter E{F.lds, (bf16_t*)(ws + WS_YB), (const int*)(ws + WS_LIST)};
            pg8::gemm_phase<EpiScatter, SchedMoE<EHID, EHID, false>, false, EHID, EHID, EHID>(F.lds, S, E, F.tid);
            AMP_END(7); }
        SEAM(pb + 8);
        if constexpr (KIND(1)) if (IN(pb + 9)) { PHASE_ENTRY norm1_phase(F, P, lb); AMP_END(1); }
        SEAM(pb + 9);
        if constexpr (KIND(8)) if (IN(pb + 10)) { PHASE_ENTRY mix_phase(F, P, lp); AMP_END(8); }
        SEAM(pb + 10);
        if constexpr (KIND(9)) if (IN(pb + 11)) { PHASE_ENTRY
            __syncthreads();
            set_desc(F.lds, F.tid, 0, ws + WS_XR, ws + WS_WR + (size_t)lp * D * D * 2, ws + WS_R, 4, D, 0);
            set_desc(F.lds, F.tid, 1, ws + WS_XK, ws + WS_WK + (size_t)lp * D * D * 2, ws + WS_K, 4, D, 0);
            set_desc(F.lds, F.tid, 2, ws + WS_XV, ws + WS_WV + (size_t)lp * D * D * 2, ws + WS_VV, 4, D, 0);
            set_desc(F.lds, F.tid, 3, ws + WS_XW, ws + WS_LW1 + (size_t)lp * 256 * D * 2, ws + WS_TW, 1, 256, 1);
            set_desc(F.lds, F.tid, 4, ws + WS_XA, ws + WS_LA1 + (size_t)lp * 256 * D * 2, ws + WS_TA, 1, 256, 0);
            set_desc(F.lds, F.tid, 5, ws + WS_XG, ws + WS_LG1 + (size_t)lp * 256 * D * 2, ws + WS_TG, 1, 256, 2);
            __syncthreads();
            SchedMulti<D, D> S{F.lds, T / 256, 15, 6};
            EpiAct E{F.lds};
            pg8::gemm_phase<EpiAct, SchedMulti<D, D>, false, D, D, D>(F.lds, S, E, F.tid);
            AMP_END(9); }
        SEAM(pb + 11);
        if constexpr (KIND(10)) if (IN(pb + 12)) { PHASE_ENTRY
            __syncthreads(); set_desc(F.lds, F.tid, 0, ws + WS_TG, ws + WS_G2P + (size_t)lp * D * 256 * 2, ws + WS_GATE, 4, D, 0); __syncthreads();
            SchedMulti<256, 256> S{F.lds, T / 256, 4, 1};
            EpiAct E{F.lds};
            pg8::gemm_phase<EpiAct, SchedMulti<256, 256>, false, 256, 256, 256>(F.lds, S, E, F.tid);
            AMP_END(10); }
        SEAM(pb + 12);
        if constexpr (KIND(11)) if (IN(pb + 13)) { PHASE_ENTRY scan_chunk_phase(F, P, lp); AMP_END(11); }
        SEAM(pb + 13);
        if constexpr (KIND(14)) if (IN(pb + 14)) { PHASE_ENTRY scan_carry_phase(F, P, lb); AMP_END(14); }
        SEAM(pb + 14);
        if constexpr (KIND(15)) if (IN(pb + 15)) { PHASE_ENTRY scan_out_phase(F, P, lp); AMP_END(15); }
        SEAM(pb + 15);
        if constexpr (KIND(4)) if (IN(pb + 16)) { PHASE_ENTRY
            __syncthreads();
            { bf16_t* X = (bf16_t*)(ws + WS_X);
              set_desc(F.lds, F.tid, 0, ws + WS_YG, ws + WS_WO + (size_t)lp * D * D * 2, X, 4, 0, 0, X, X + (size_t)TL * D, nullptr);
              set_desc(F.lds, F.tid, 1, nullptr, nullptr, nullptr, 0, 0, 0, (const float*)(ws + WS_MOD) + (size_t)lb * 3 * 6 * D + 2 * D); }
            __syncthreads();
            SchedMulti<D, D> S{F.lds, TL / 256, 4, 1};
            EpiResid E{F.lds};
            pg8::gemm_phase<EpiResid, SchedMulti<D, D>, false, D, D, D>(F.lds, S, E, F.tid);
            if (lb != DEPTH - 1) { __syncthreads(); { int w_ = F0.wave; asm volatile("" : "+s"(w_)); tail_resid<D>(F0.lds, w_); } }
            AMP_END(4); }
        SEAM(pb + 16);
        if constexpr (KIND(5)) if (IN(pb + 17)) { PHASE_ENTRY norm2_phase(F, P, lb); AMP_END(5); }
        SEAM(pb + 17);
        if constexpr (KIND(16)) if (IN(pb + 18)) { PHASE_ENTRY
            __syncthreads(); set_desc(F.lds, F.tid, 0, ws + WS_HL, ws + WS_WRT + (size_t)lb * 256 * D * 2, nullptr, 1, 0, 0); __syncthreads();
            const int nun = (lb == DEPTH - 1 ? TL : T) / 256;
            if ((int)blockIdx.x >= nun) moe_weights_phase(F, P, lb, ((int)blockIdx.x - nun) * NWAVES + F.wave, (F.G - nun) * NWAVES, MOE_SPLIT, MOE_ITEMS);
            else { SchedMulti<D, D> S{F.lds, nun, 1, 1};
                EpiLogits E{(float*)(ws + WS_LG)};
                pg8::gemm_phase<EpiLogits, SchedMulti<D, D>, false, D, D, D>(F.lds, S, E, F.tid);
                if (F.G <= nun) { __syncthreads(); moe_weights_phase(F, P, lb, F.gw, F.NGW, MOE_SPLIT, MOE_ITEMS); } }
            AMP_END(16); }
        SEAM(pb + 18);
        if constexpr (KIND(17)) if (IN(pb + 19)) { PHASE_ENTRY route_phase(F, P, lb); AMP_END(17); }
        SEAM(pb + 19);
        if constexpr (KIND(6)) if (IN(pb + 20)) { PHASE_ENTRY
            moe_tables(F.lds, F.tid, ctl + CW_CNT + lb * 64);
            SchedMoE<D, D, true> S{F.lds, (const char*)(ws + WS_HL), (const char*)(ws + WS_WGU), (const int*)(ws + WS_LIST)};
            EpiSiluGate E{(bf16_t*)(ws + WS_H)};
            pg8::gemm_phase<EpiSiluGate, SchedMoE<D, D, true>, true, D, D, D>(F.lds, S, E, F.tid);
            AMP_END(6); }
        SEAM(pb + 20);
        if constexpr (KIND(7)) if (IN(pb + 21)) { PHASE_ENTRY
            moe_tables(F.lds, F.tid, ctl + CW_CNT + lb * 64);
            SchedMoE<EHID, EHID, false> S{F.lds, (const char*)(ws + WS_H), (const char*)(ws + WS_WD), (const int*)(ws + WS_LIST)};
            EpiScatter E{F.lds, (bf16_t*)(ws + WS_YB), (const int*)(ws + WS_LIST)};
            pg8::gemm_phase<EpiScatter, SchedMoE<EHID, EHID, false>, false, EHID, EHID, EHID>(F.lds, S, E, F.tid);
            AMP_END(7); }
        SEAM(pb + 21);
    }
    if constexpr (KIND(13)) if (IN(45)) { PHASE_ENTRY final_phase(F, P); AMP_END(13); }
#undef IN
#undef KIND
#undef SEAM
#undef PHASE_ENTRY
}

#if !MK_ONE_LAUNCH
static int phase_kind(int ph) { if (ph == 0) return 0; if (ph == 45) return 13; static const int k22[22] = {1, 2, 3, 4, 5, 16, 17, 6, 7, 1, 8, 9, 10, 11, 14, 15, 4, 5, 16, 17, 6, 7}; return k22[(ph - 1) % 22]; }
typedef void (*kern_t)(Params);
template <unsigned KM> static kern_t kern_of() { return mega<KM>; }
static kern_t kind_kernel(int kind) {
    switch (kind) { case 0: return kern_of<1u << 0>(); case 1: return kern_of<1u << 1>(); case 2: return kern_of<1u << 2>(); case 3: return kern_of<1u << 3>(); case 4: return kern_of<1u << 4>();
        case 5: return kern_of<1u << 5>(); case 6: return kern_of<1u << 6>(); case 7: return kern_of<1u << 7>(); case 8: return kern_of<1u << 8>(); case 9: return kern_of<1u << 9>();
        case 10: return kern_of<1u << 10>(); case 11: return kern_of<1u << 11>(); case 12: return kern_of<1u << 12>(); case 14: return kern_of<1u << 14>(); case 15: return kern_of<1u << 15>(); case 16: return kern_of<1u << 16>(); case 17: return kern_of<1u << 17>(); default: return kern_of<1u << 13>(); }
}
#endif
extern "C" void kernel_launch(void* const* d_in, const int* in_sizes, int n_in, void* d_out, int out_size, void* d_ws, size_t ws_size, hipStream_t stream) {
    static int grid = 0;
    if (grid == 0) {
        if (n_in != 42 || out_size != TL * D || ws_size < WS_END) { fprintf(stderr, "kernel_launch: unexpected problem (n_in %d, out %d, ws %zu < %zu)\n", n_in, out_size, ws_size, (size_t)WS_END); grid = -1; return; }
        int dev = 0, cus = 0;
        if (hipGetDevice(&dev) != hipSuccess || hipDeviceGetAttribute(&cus, hipDeviceAttributeMultiprocessorCount, dev) != hipSuccess) { grid = -1; return; }
#if MK_ONE_LAUNCH
        if (hipFuncSetAttribute((const void*)mega<0x3ffffu>, hipFuncAttributeMaxDynamicSharedMemorySize, LDS_BYTES) != hipSuccess) { fprintf(stderr, "kernel_launch: hipFuncSetAttribute failed\n"); grid = -1; return; }
#else
        for (int k = 0; k < 18; ++k) if (hipFuncSetAttribute((const void*)kind_kernel(k), hipFuncAttributeMaxDynamicSharedMemorySize, LDS_BYTES) != hipSuccess) { fprintf(stderr, "kernel_launch: hipFuncSetAttribute failed\n"); grid = -1; return; }
#endif
        (void)hipGetLastError();
        grid = cus;
    }
    if (grid < 0) return;
    (void)hipMemsetAsync((char*)d_ws + WS_CTL, 0, CTL_BYTES, stream);
    Params p{};
    for (int i = 0; i < 42; ++i) p.in[i] = (const float*)d_in[i];
    p.out = (float*)d_out; p.ws = (unsigned char*)d_ws;
#if MK_ONE_LAUNCH
    p.ph_lo = 0; p.ph_hi = NPH;
    hipLaunchKernelGGL(mega<0x3ffffu>, dim3(grid), dim3(NTHR), LDS_BYTES, stream, p);
#else
    for (int ph = 0; ph < NPH; ++ph) { p.ph_lo = ph; p.ph_hi = ph + 1; hipLaunchKernelGGL(kind_kernel(phase_kind(ph)), dim3(grid), dim3(NTHR), LDS_BYTES, stream, p); }
#endif
}
```

```cpp
#include <hip/hip_runtime.h>
#include <cstdio>
#include <cstdint>

#define LAS __attribute__((address_space(3)))
typedef unsigned short bf16_t;
typedef short bf16x8 __attribute__((ext_vector_type(8)));
typedef float f32x4 __attribute__((ext_vector_type(4)));
typedef float f32x2 __attribute__((ext_vector_type(2)));
typedef unsigned u32x4 __attribute__((ext_vector_type(4)));
typedef unsigned u32x2 __attribute__((ext_vector_type(2)));

#ifndef CH_AMP
#define CH_AMP -1
#endif
#define CH_STAMP(i) do { if (CH_AMP >= 0) ch_t[i] = __builtin_amdgcn_s_memrealtime(); } while (0)
#ifndef AMP_MASK
#define AMP_MASK 0u
#endif
#define AMP_F 4
#ifndef MK_ONE_LAUNCH
#define MK_ONE_LAUNCH 1
#endif

constexpr int D = 1024, NBATCH = 2, SEQ = 16384, CTXL = 256, DEPTH = 4;
constexpr int TL = NBATCH * SEQ, TC = NBATCH * CTXL, T = TL + TC;
constexpr int GWID = 2048, NE = 32, EHID = 512, NH = 16, HD = 64;
constexpr int LISTCAP = T;
constexpr int MAXRT = (2 * T) / 256 + NE;
constexpr int NWAVES = 8, NTHR = 512;

constexpr size_t MiB = 1u << 20;
constexpr size_t WS_CTL = 0, CTL_BYTES = 1 * MiB;
constexpr size_t WS_MOD = 1 * MiB;
constexpr size_t WS_WIN = 2 * MiB, WS_WOUT = 18 * MiB, WS_WSP = 26 * MiB, WS_WR = 27 * MiB, WS_WK = 31 * MiB, WS_WV = 35 * MiB, WS_WO = 39 * MiB;
constexpr size_t WS_LW1 = 43 * MiB, WS_LA1 = 44 * MiB, WS_LG1 = 45 * MiB, WS_W2P = 46 * MiB, WS_A2P = 48 * MiB, WS_G2P = 50 * MiB;
constexpr size_t WS_WRT = 52 * MiB;
constexpr size_t WS_WGU = 54 * MiB, WS_WD = 118 * MiB;
constexpr size_t WS_X = 150 * MiB;
constexpr size_t WS_LIST = 280 * MiB, WS_WGT = 285 * MiB;
constexpr size_t WS_HL = 286 * MiB;
constexpr size_t WS_BIG = 351 * MiB;
constexpr size_t SZB = 65 * MiB;
constexpr size_t WS_U = WS_BIG, WS_V = WS_BIG + 2 * SZB, WS_STAT = WS_BIG + 4 * SZB;
constexpr size_t WS_XR = WS_BIG, WS_XW = WS_BIG + SZB, WS_XK = WS_BIG + 2 * SZB, WS_XV = WS_BIG + 3 * SZB, WS_XA = WS_BIG + 4 * SZB, WS_XG = WS_BIG + 5 * SZB;
constexpr size_t WS_R = WS_BIG + 6 * SZB, WS_K = WS_BIG + 7 * SZB, WS_VV = WS_BIG + 8 * SZB;
constexpr size_t WS_TW = WS_BIG + 9 * SZB, WS_TA = WS_TW + 17 * MiB, WS_TG = WS_TA + 17 * MiB;
constexpr size_t WS_ELOG0 = WS_XR, WS_ELOG1 = WS_XW, WS_KM0 = WS_XK, WS_KM1 = WS_XV, WS_AS0 = WS_XA, WS_AS1 = WS_XG;
constexpr size_t WS_GATE = WS_HL, WS_YG = WS_AS0, WS_BON = WS_TG + 17 * MiB;
constexpr size_t WS_H = WS_BIG, WS_YB = WS_BIG + 73 * MiB, WS_LG = WS_BIG + 204 * MiB;
constexpr size_t WS_PQ = WS_KM0;
constexpr size_t WS_SST = 215 * MiB;
constexpr size_t WS_END = WS_BON + 5 * MiB;
static_assert(WS_END <= 1080 * MiB, "workspace map");
constexpr int CW_BAR = 4096;
constexpr int CW_CNT = 16384;

__device__ __forceinline__ int wave_sgpr_now(int w) { asm volatile("" : "+s"(w)); return w; }
__device__ __forceinline__ int lane_id_now() { int l; asm volatile("v_mbcnt_lo_u32_b32 %0, -1, 0\n\tv_mbcnt_hi_u32_b32 %0, -1, %0" : "=v"(l)); return l; }
typedef short v4s __attribute__((ext_vector_type(4)));
#define LDS_BARRIER() asm volatile("s_waitcnt lgkmcnt(0)\n\ts_barrier" ::: "memory")
typedef __bf16 bf16x2_t __attribute__((ext_vector_type(2)));
__device__ __forceinline__ unsigned cvt_pk_bf16(float lo, float hi) { const bf16x2_t v = __builtin_convertvector((f32x2){lo, hi}, bf16x2_t); return __builtin_bit_cast(unsigned, v); }
__device__ __forceinline__ float bf_lo(unsigned u) { return __uint_as_float(u << 16); }
__device__ __forceinline__ float bf_hi(unsigned u) { return __uint_as_float(u & 0xffff0000u); }
__device__ __forceinline__ float bf1(bf16_t b) { return __uint_as_float(((unsigned)b) << 16); }
__device__ __forceinline__ bf16_t f2bf(float f) { return (bf16_t)(cvt_pk_bf16(f, 0.f) & 0x3ffffu); }
__device__ __forceinline__ void unpack8(const u32x4& w, float (&f)[8]) { f[0] = bf_lo(w.x); f[1] = bf_hi(w.x); f[2] = bf_lo(w.y); f[3] = bf_hi(w.y); f[4] = bf_lo(w.z); f[5] = bf_hi(w.z); f[6] = bf_lo(w.w); f[7] = bf_hi(w.w); }
__device__ __forceinline__ u32x4 pack8(const float (&f)[8]) { u32x4 o; o.x = cvt_pk_bf16(f[0], f[1]); o.y = cvt_pk_bf16(f[2], f[3]); o.z = cvt_pk_bf16(f[4], f[5]); o.w = cvt_pk_bf16(f[6], f[7]); return o; }
__device__ __forceinline__ float shx(float v, int m, int lane) { return __int_as_float(__builtin_amdgcn_ds_bpermute((lane ^ m) << 2, __float_as_int(v))); }
__device__ __forceinline__ float shup(float v, int d, int lane) { return __int_as_float(__builtin_amdgcn_ds_bpermute((lane - d) << 2, __float_as_int(v))); }
__device__ __forceinline__ float wave_sum(float v, int lane) {
#pragma unroll
    for (int o = 1; o < 64; o <<= 1) v += shx(v, o, lane);
    return v;
}
__device__ __forceinline__ float sigmoidf_(float x) { return 1.0f / (1.0f + __expf(-x)); }
__device__ __forceinline__ float tanhf_(float x) { const float e = __expf(2.0f * x); return 1.0f - 2.0f / (e + 1.0f); }
__device__ __forceinline__ f32x2 gelu_pk(f32x2 v) {
    const f32x2 av = __builtin_elementwise_abs(v), d = av * 0.2316418882f + 1.0f;
    f32x2 t; t.x = __builtin_amdgcn_rcpf(d.x); t.y = __builtin_amdgcn_rcpf(d.y);
    f32x2 q = t * 0.5307027145f + (-0.7265760135f); q = q * t + 0.7107068705f; q = q * t + (-0.142248368f); q = q * t + 0.127414796f; q = q * t;
    const f32x2 s = (v * v) * (-0.72134752044f);
    f32x2 e; e.x = __builtin_amdgcn_exp2f(s.x); e.y = __builtin_amdgcn_exp2f(s.y);
    const f32x2 m = v * (q * e), r = v - m;
    f32x2 o; o.x = v.x < 0.f ? m.x : r.x; o.y = v.y < 0.f ? m.y : r.y; return o;
}

#define XB_TMO      128
#define XB_XCNT(j)  (256  + 64 * (j))
#define XB_XSUB(j)  (1280 + 64 * (j))
#define XB_XGEN(j)  (2304 + 64 * (j))
#define XB_TOP      3328
#define XB_TOPGEN   3392
#define XCD_BAR_WORDS 3456
#define XB_SPIN_CAP (1u << 18)
__device__ __forceinline__ unsigned xb_ld(unsigned* p)              { return __hip_atomic_load(p, __ATOMIC_RELAXED, __HIP_MEMORY_SCOPE_AGENT); }
__device__ __forceinline__ unsigned xb_add(unsigned* p, unsigned v) { return __hip_atomic_fetch_add(p, v, __ATOMIC_RELAXED, __HIP_MEMORY_SCOPE_AGENT); }
__device__ __forceinline__ unsigned xb_xcc_id() { return (unsigned)__builtin_amdgcn_s_getreg((3 << 11) | 20) & 0xFu; }
#define XB_SPIN(cond, bar) do { unsigned _sp = 0; while (cond) { __builtin_amdgcn_s_sleep(1); \
    if ((++_sp & 255u) == 0u) { if (xb_ld(&(bar)[XB_TMO])) break; if (_sp > XB_SPIN_CAP) { atomicAdd(&(bar)[XB_TMO], 1u); break; } } } } while (0)
struct XcdBarrier { unsigned* bar; unsigned x; volatile LAS unsigned* st; };
__device__ __forceinline__ XcdBarrier xcd_barrier_post(unsigned* bar, volatile LAS unsigned* st) {
    XcdBarrier b; b.bar = bar; b.x = xb_xcc_id(); b.st = st;
    if (threadIdx.x == 0) (void)xb_add(&bar[XB_XCNT(b.x)], 1u);
    return b;
}
__device__ __forceinline__ void xcd_barrier_complete(unsigned* bar, unsigned x, unsigned& nloc, unsigned& nx) {
    const unsigned G = gridDim.x * gridDim.y * gridDim.z;
    unsigned sum, cnt, mine, sp = 0u;
    for (;;) {
        sum = 0u; cnt = 0u; mine = 0u;
#pragma unroll
        for (unsigned j = 0; j < 16; ++j) { const unsigned c = xb_ld(&bar[XB_XCNT(j)]); sum += c; cnt += (c > 0u) ? 1u : 0u; mine = (j == x) ? c : mine; }
        if (sum == G) break;
        __builtin_amdgcn_s_sleep(1);
        if ((++sp & 255u) == 0u) { if (xb_ld(&bar[XB_TMO])) break; if (sp > XB_SPIN_CAP) { atomicAdd(&bar[XB_TMO], 1u); break; } }
    }
    nloc = mine > 0u ? mine : 1u; nx = cnt > 0u ? cnt : 1u;
}
template <bool FIRST> __device__ __forceinline__ void xcd_barrier(const XcdBarrier& b, const bool leader) {
    asm volatile("s_waitcnt vmcnt(0)" ::: "memory");
    __syncthreads();
    if (leader) {
        unsigned* bar = b.bar;
        __builtin_amdgcn_s_waitcnt(0);
        unsigned nloc = b.st[0], nx = b.st[1];
        if constexpr (FIRST) { if (nloc == 0u) { xcd_barrier_complete(bar, b.x, nloc, nx); b.st[0] = nloc; b.st[1] = nx; } }
        const unsigned old = xb_add(&bar[XB_XSUB(b.x)], 1u);
        const unsigned gen = old / nloc;
        if (old + 1u == (gen + 1u) * nloc) {
            __builtin_amdgcn_fence(__ATOMIC_RELEASE, "agent");
            asm volatile("s_waitcnt vmcnt(0)" ::: "memory");
            const unsigned og = xb_add(&bar[XB_TOP], 1u);
            const unsigned tg = og / nx;
            if (og + 1u == (tg + 1u) * nx) xb_add(&bar[XB_TOPGEN], 1u);
            else XB_SPIN(xb_ld(&bar[XB_TOPGEN]) == tg, bar);
            __builtin_amdgcn_fence(__ATOMIC_ACQUIRE, "agent");
            xb_add(&bar[XB_XGEN(b.x)], 1u);
            asm volatile("s_waitcnt vmcnt(0)" ::: "memory");
        } else {
            XB_SPIN(xb_ld(&bar[XB_XGEN(b.x)]) == gen, bar);
            __builtin_amdgcn_fence(__ATOMIC_ACQUIRE, "agent");
            asm volatile("s_waitcnt vmcnt(0)" ::: "memory");
        }
    }
    __syncthreads();
}

constexpr int LDS_MISC = 143360;
constexpr int LDS_DESC = LDS_MISC + 128;
constexpr int LDS_TAB = LDS_MISC + 512;
constexpr int LDS_BYTES = 147456;
namespace pg8 {
constexpr int BM = 256, BK = 64, HALF = 128, HTB = HALF * BK * 2, STAGE_BYTES = 8 * HTB, NXCD = 8, WGM = 8;
__host__ __device__ __forceinline__ int lds_byte(int r, int c) { const int st = (r >> 4) * 2 + (c >> 5), rr = r & 15, cc = c & 31, ob = rr * 64 + cc * 2; return st * 1024 + (ob ^ (((ob >> 9) & 1) << 5)); }
__host__ __device__ __forceinline__ void stage_rc(int b, int& R, int& C) { const int st = b / 1024, sb = b % 1024, swz = sb ^ (((sb >> 9) & 1) << 5); R = (st >> 1) * 16 + swz / 64; C = (st & 1) * 32 + (swz % 64) / 2; }
__host__ __device__ __forceinline__ int perm32(int rho) { const int n = rho >> 4, i = rho & 15; return 8 * (i >> 2) + 4 * n + (i & 3); }
__device__ __forceinline__ int xcd_remap(int L, int nwg) { const int q = nwg / NXCD, r = nwg % NXCD, xcd = L % NXCD, off = L / NXCD; return (xcd < r ? xcd * (q + 1) : r * (q + 1) + (xcd - r) * q) + off; }

struct Unit { int pm, pn, aux; };

template <class Epi, class Sched, bool GATHER, int K, int LDA, int LDB>
__device__ __forceinline__ void gemm_phase(LAS unsigned char* lds, const Sched& S, const Epi& E, const int tid_in) {
    int tid_ = tid_in; asm volatile("" : "+v"(tid_));
    const int tid = tid_, wid = __builtin_amdgcn_readfirstlane(tid >> 6), lane = tid & 63, wr = wid >> 2, wc = wid & 3, fr = lane & 15, fq = lane >> 4;
    constexpr int nt = K / BK;
    unsigned voffA[2], voffB[2];
#pragma unroll
    for (int i = 0; i < 2; ++i) { int R, C; stage_rc(tid * 16 + i * 8192, R, C); const int Rb = Epi::PERM ? ((R & ~31) + perm32(R & 31)) : R;
        voffA[i] = (unsigned)(R * LDA + C) * 2u; voffB[i] = (unsigned)(Rb * LDB + C) * 2u; }
    constexpr size_t kstep = (size_t)(BK * 2);
    constexpr size_t hstepA = GATHER ? (size_t)0 : (size_t)HALF * LDA * 2, hstepB = (size_t)HALF * LDB * 2;
    const unsigned ldsw = (unsigned)wid * 1024u;
    const int aoff = lds_byte(wr * 64 + fr, fq * 8), boff = lds_byte(wc * 32 + fr, fq * 8);
    unsigned gA[2][2], gN[2][2];
#define PG8_SA(b, h) (((b) * 2 + (h)) * HTB)
#define PG8_SB(b, h) ((4 + (b) * 2 + (h)) * HTB)
#define PG8_STAGEB(bufoff, gbase) do { _Pragma("unroll") for (int _i = 0; _i < 2; ++_i) \
        __builtin_amdgcn_global_load_lds((const unsigned*)((const char*)(gbase) + voffB[_i]), (LAS unsigned*)(lds + (bufoff) + ldsw + _i * 8192), 16, 0, 0); } while (0)
#define PG8_STAGEA(bufoff, gbase, h, GV) do { _Pragma("unroll") for (int _i = 0; _i < 2; ++_i) \
        __builtin_amdgcn_global_load_lds((const unsigned*)((const char*)(gbase) + (GATHER ? GV[h][_i] : voffA[_i]) + (h) * hstepA), (LAS unsigned*)(lds + (bufoff) + ldsw + _i * 8192), 16, 0, 0); } while (0)
#define PG8_LDA(dst, b, h) do { _Pragma("unroll") for (int m = 0; m < 4; ++m) _Pragma("unroll") for (int k = 0; k < 2; ++k) dst[m][k] = *(const LAS bf16x8*)(lds + PG8_SA(b, h) + aoff + m * 2048 + k * 1024); } while (0)
#define PG8_LDB(dst, b, h) do { _Pragma("unroll") for (int n = 0; n < 2; ++n) _Pragma("unroll") for (int k = 0; k < 2; ++k) dst[n][k] = *(const LAS bf16x8*)(lds + PG8_SB(b, h) + boff + n * 2048 + k * 1024); } while (0)
#define PG8_MMA(ai, bj, At, Bt) do { __builtin_amdgcn_s_setprio(1); _Pragma("unroll") for (int m = 0; m < 4; ++m) _Pragma("unroll") for (int n = 0; n < 2; ++n) _Pragma("unroll") for (int k = 0; k < 2; ++k) \
        acc[ai][bj][m][n] = __builtin_amdgcn_mfma_f32_16x16x32_bf16(Bt[n][k], At[m][k], acc[ai][bj][m][n], 0, 0, 0); __builtin_amdgcn_s_setprio(0); } while (0)
#define PG8_WAIT_V(n) asm volatile("s_waitcnt vmcnt(" #n ")" ::: "memory")
#define PG8_WAIT_L(n) asm volatile("s_waitcnt lgkmcnt(" #n ")" ::: "memory")
#define PG8_BAR __builtin_amdgcn_s_barrier()
#define PG8_SCHED __builtin_amdgcn_sched_barrier(0)
    Unit cur, nxt; int ui = 0;
    if (!S.next(0, cur)) return;
    f32x4 acc[2][2][4][2];
#pragma unroll
    for (int a = 0; a < 2; ++a)
#pragma unroll
        for (int b = 0; b < 2; ++b)
#pragma unroll
            for (int m = 0; m < 4; ++m)
#pragma unroll
                for (int n = 0; n < 2; ++n) acc[a][b][m][n] = (f32x4){0.f, 0.f, 0.f, 0.f};
    bf16x8 At[4][2], B0[2][2], B1[2][2];
    const char* cA = S.aptr(cur); const char* cB = S.bptr(cur);
    if constexpr (GATHER) { S.gather(cur, tid, gA); }
    PG8_STAGEB(PG8_SB(0, 0), cB); PG8_STAGEB(PG8_SB(0, 1), cB + hstepB); PG8_STAGEA(PG8_SA(0, 0), cA, 0, gA); PG8_STAGEA(PG8_SA(0, 1), cA, 1, gA);
    if (wr == 1) PG8_BAR;
    PG8_WAIT_V(2); PG8_BAR;
    PG8_STAGEB(PG8_SB(1, 0), cB + kstep); PG8_STAGEA(PG8_SA(1, 0), cA + kstep, 0, gA); PG8_STAGEB(PG8_SB(1, 1), cB + hstepB + kstep);
    PG8_WAIT_V(6); PG8_BAR;
    for (;;) {
        const bool has_next = S.next(ui + 1, nxt);
        const char* nA = has_next ? S.aptr(nxt) : cA; const char* nB = has_next ? S.bptr(nxt) : cB;
        if constexpr (GATHER) { if (has_next) S.gather(nxt, tid, gN); else {
#pragma unroll
            for (int h = 0; h < 2; ++h)
#pragma unroll
                for (int i = 0; i < 2; ++i) gN[h][i] = gA[h][i]; } }
#pragma nounroll
        for (int t = 0; t < nt; t += 2) {
            const bool last = (t == nt - 2);
            const char* a1 = cA + (size_t)(t + 1) * kstep;
            const char* a2 = last ? nA : cA + (size_t)(t + 2) * kstep; const char* b2 = last ? nB : cB + (size_t)(t + 2) * kstep;
            const char* a3 = a2 + kstep; const char* b3 = b2 + kstep;
            unsigned g2[2][2];
            if constexpr (GATHER) {
#pragma unroll
                for (int h = 0; h < 2; ++h)
#pragma unroll
                    for (int i = 0; i < 2; ++i) g2[h][i] = last ? gN[h][i] : gA[h][i]; }
            PG8_LDB(B0, 0, 0); PG8_LDB(B1, 0, 1); PG8_SCHED; PG8_LDA(At, 0, 0); PG8_STAGEA(PG8_SA(1, 1), a1, 1, gA);
            PG8_WAIT_V(8); PG8_WAIT_L(0); PG8_BAR; PG8_MMA(0, 0, At, B0); PG8_MMA(0, 1, At, B1); PG8_BAR; PG8_SCHED;
            PG8_LDA(At, 0, 1); PG8_STAGEB(PG8_SB(0, 0), b2); PG8_STAGEB(PG8_SB(0, 1), b2 + hstepB); PG8_STAGEA(PG8_SA(0, 0), a2, 0, g2);
            PG8_WAIT_V(8); PG8_WAIT_L(0); PG8_BAR; PG8_MMA(1, 0, At, B0); PG8_MMA(1, 1, At, B1); PG8_BAR; PG8_SCHED;
            PG8_LDB(B0, 1, 0); PG8_LDB(B1, 1, 1); PG8_SCHED; PG8_LDA(At, 1, 0); PG8_STAGEA(PG8_SA(0, 1), a2, 1, g2);
            PG8_WAIT_V(8); PG8_WAIT_L(0); PG8_BAR; PG8_MMA(0, 0, At, B0); PG8_MMA(0, 1, At, B1); PG8_BAR; PG8_SCHED;
            PG8_LDA(At, 1, 1); PG8_STAGEB(PG8_SB(1, 0), b3); PG8_STAGEB(PG8_SB(1, 1), b3 + hstepB); PG8_STAGEA(PG8_SA(1, 0), a3, 0, g2);
            PG8_WAIT_V(8); PG8_WAIT_L(0); PG8_BAR; PG8_MMA(1, 0, At, B0); PG8_MMA(1, 1, At, B1); PG8_BAR; PG8_SCHED;
        }
        if (wr == 0) PG8_BAR;
        E(acc, cur, wr, wc, fr, fq);
        if (!has_next) break;
#pragma unroll
        for (int a = 0; a < 2; ++a)
#pragma unroll
            for (int b = 0; b < 2; ++b)
#pragma unroll
                for (int m = 0; m < 4; ++m)
#pragma unroll
                    for (int n = 0; n < 2; ++n) acc[a][b][m][n] = (f32x4){0.f, 0.f, 0.f, 0.f};
        cur = nxt; cA = nA; cB = nB; ++ui;
        if constexpr (GATHER) {
#pragma unroll
            for (int h = 0; h < 2; ++h)
#pragma unroll
                for (int i = 0; i < 2; ++i) gA[h][i] = gN[h][i]; }
        if (wr == 1) PG8_BAR;
    }
    PG8_WAIT_V(0);
    PG8_BAR;
#undef PG8_SA
#undef PG8_SB
#undef PG8_STAGEA
#undef PG8_STAGEB
#undef PG8_LDA
#undef PG8_LDB
#undef PG8_MMA
#undef PG8_WAIT_V
#undef PG8_WAIT_L
#undef PG8_BAR
#undef PG8_SCHED
}
}
using pg8::Unit;

__device__ __forceinline__ void set_desc(LAS unsigned char* lds, int tid, int g, const void* A, const void* B, const void* C, int nN, int ldc, int aux, const void* X1 = nullptr, const void* X2 = nullptr, const void* X3 = nullptr) {
    LAS int* d = (LAS int*)(lds + LDS_DESC) + g * 16;
    if (tid == 0) { unsigned long long a = (unsigned long long)A, b = (unsigned long long)B, c = (unsigned long long)C, x1 = (unsigned long long)X1, x2 = (unsigned long long)X2, x3 = (unsigned long long)X3;
        asm volatile("" : "+s"(a), "+s"(b), "+s"(c), "+s"(x1), "+s"(x2), "+s"(x3), "+s"(nN), "+s"(ldc), "+s"(aux));
        d[0] = (int)(unsigned)a; d[1] = (int)(unsigned)(a >> 32); d[2] = (int)(unsigned)b; d[3] = (int)(unsigned)(b >> 32); d[4] = (int)(unsigned)c; d[5] = (int)(unsigned)(c >> 32); d[6] = nN; d[7] = ldc; d[8] = aux;
        d[10] = (int)(unsigned)x1; d[11] = (int)(unsigned)(x1 >> 32); d[12] = (int)(unsigned)x2; d[13] = (int)(unsigned)(x2 >> 32); d[14] = (int)(unsigned)x3; d[15] = (int)(unsigned)(x3 >> 32); }
}
__device__ __forceinline__ int desc_i(LAS unsigned char* lds, int g, int f) { return __builtin_amdgcn_readfirstlane(((LAS const int*)(lds + LDS_DESC))[g * 16 + f]); }
__device__ __forceinline__ const char* desc_p(LAS unsigned char* lds, int g, int f) {
    const unsigned lo = (unsigned)desc_i(lds, g, f), hi = (unsigned)desc_i(lds, g, f + 1); return (const char*)(((unsigned long long)hi << 32) | lo); }
template <int LDA, int LDB>
struct SchedMulti {
    LAS unsigned char* lds; int nM, ntot, ng;
    __device__ __forceinline__ bool next(int i, Unit& u) const {
        const int nwg = nM * ntot; const long L = (long)i * gridDim.x + blockIdx.x; if (L >= nwg) return false;
        const int wgid = pg8::xcd_remap((int)L, nwg);
        const int nig = pg8::WGM * ntot, gid = wgid / nig, fm = gid * pg8::WGM, gsz = (nM - fm) < pg8::WGM ? (nM - fm) : pg8::WGM;
        u.pm = fm + ((wgid % nig) % gsz); int pv = (wgid % nig) / gsz; int g = 0;
        for (int j = 0; j + 1 < ng; ++j) { const int n = desc_i(lds, j, 6); if (pv < n) break; pv -= n; g = j + 1; }
        u.pn = pv; u.aux = g; return true;
    }
    __device__ __forceinline__ const char* aptr(const Unit& u) const { return desc_p(lds, u.aux, 0) + (size_t)u.pm * (512 * LDA); }
    __device__ __forceinline__ const char* bptr(const Unit& u) const { return desc_p(lds, u.aux, 2) + (size_t)u.pn * (512 * LDB); }
};
template <int LDA, int LDB, bool GATHERED>
struct SchedMoE {
    LAS unsigned char* lds; const char* Abase; const char* Bbase; const int* list;
    __device__ __forceinline__ bool next(int i, Unit& u) const {
        LAS const int* tab = (LAS const int*)(lds + LDS_TAB);
        const int nrt = __builtin_amdgcn_readfirstlane(tab[2 * MAXRT + 32]);
        const int nwg = nrt * 4; const long L = (long)i * gridDim.x + blockIdx.x; if (L >= nwg) return false;
        const int wgid = pg8::xcd_remap((int)L, nwg);
        u.pm = wgid >> 2; u.pn = wgid & 3; u.aux = __builtin_amdgcn_readfirstlane(tab[u.pm]); return true;
    }
    __device__ __forceinline__ const char* aptr(const Unit& u) const { return GATHERED ? Abase : Abase + (size_t)u.pm * (512 * LDA); }
    __device__ __forceinline__ const char* bptr(const Unit& u) const { return Bbase + (size_t)u.aux * ((size_t)D * LDB * 2) + (size_t)u.pn * (512 * LDB); }
    __device__ __forceinline__ void gather(const Unit& u, int tid, unsigned (&g)[2][2]) const {
        LAS const int* tab = (LAS const int*)(lds + LDS_TAB);
        const int j0 = __builtin_amdgcn_readfirstlane(tab[MAXRT + u.pm]), cn = __builtin_amdgcn_readfirstlane(tab[2 * MAXRT + u.aux]);
#pragma unroll
        for (int i = 0; i < 2; ++i) { int R, C; pg8::stage_rc(tid * 16 + i * 8192, R, C);
#pragma unroll
            for (int h = 0; h < 2; ++h) { const int slot = j0 + 128 * h + R; const int a = slot < cn ? list[(size_t)u.aux * LISTCAP + slot] : 0;
                g[h][i] = (unsigned)((a >> 1) * LDA + C) * 2u; } }
    }
};
__device__ __forceinline__ void moe_tables(LAS unsigned char* lds, int tid, const unsigned* cnt) {
    LAS int* tab = (LAS int*)(lds + LDS_TAB);
    __syncthreads();
    if (tid < 64) {
        const int e = tid & 31; const bool act = tid < NE;
        const int c = act ? (int)__hip_atomic_load(cnt + e, __ATOMIC_RELAXED, __HIP_MEMORY_SCOPE_AGENT) : 0;
        const int nt = (c + 255) >> 8; int incl = nt;
#pragma unroll
        for (int d = 1; d < 32; d <<= 1) { const int t = __builtin_amdgcn_ds_bpermute((tid >= d ? tid - d : tid) << 2, incl); if (tid >= d) incl += t; }
        if (act) { const int start = incl - nt; tab[2 * MAXRT + e] = c;
#pragma nounroll
            for (int j = 0; j < nt; ++j) { tab[start + j] = e; tab[MAXRT + start + j] = j * 256; }
            if (tid == NE - 1) tab[2 * MAXRT + 32] = incl; }
    }
    __syncthreads();
}

#define EPI_FENCE() asm volatile("" ::: "memory")
struct EpiGelu {
    static constexpr bool PERM = true;
    LAS unsigned char* lds;
    __device__ __forceinline__ void operator()(const f32x4 (&acc)[2][2][4][2], const Unit& u, int wr, int wc, int fr, int fq) const {
        const bool isv = u.pn >= 8; bf16_t* base = (bf16_t*)desc_p(lds, 0, isv ? 10 : 4); const float* bias = (const float*)desc_p(lds, 0, 12); float* stat = (float*)desc_p(lds, 0, 14);
        const int col0 = (u.pn & 7) * 256 + wc * 32 + 8 * fq, bcol0 = u.pn * 256 + wc * 32 + 8 * fq, row0 = u.pm * 256 + wr * 64 + fr;
        f32x4 bv[2][2];
#pragma unroll
        for (int bj = 0; bj < 2; ++bj)
#pragma unroll
            for (int n = 0; n < 2; ++n) bv[bj][n] = *(const f32x4*)(bias + bcol0 + bj * 128 + 4 * n);
#pragma unroll
        for (int ai = 0; ai < 2; ++ai)
#pragma unroll
            for (int m = 0; m < 4; ++m) { const int row = row0 + ai * 128 + m * 16; bf16_t* rowp = base + (size_t)row * GWID + col0; float s = 0.f, q = 0.f;
#pragma unroll
                for (int bj = 0; bj < 2; ++bj) { const f32x4 v0 = acc[ai][bj][m][0] + bv[bj][0], v1 = acc[ai][bj][m][1] + bv[bj][1];
                    const f32x2 a = gelu_pk((f32x2){v0[0], v0[1]}), b = gelu_pk((f32x2){v0[2], v0[3]}), c = gelu_pk((f32x2){v1[0], v1[1]}), d = gelu_pk((f32x2){v1[2], v1[3]});
                    s += ((a.x + a.y) + (b.x + b.y)) + ((c.x + c.y) + (d.x + d.y));
                    q += ((a.x * a.x + a.y * a.y) + (b.x * b.x + b.y * b.y)) + ((c.x * c.x + c.y * c.y) + (d.x * d.x + d.y * d.y));
                    u32x4 w; w.x = cvt_pk_bf16(a.x, a.y); w.y = cvt_pk_bf16(b.x, b.y); w.z = cvt_pk_bf16(c.x, c.y); w.w = cvt_pk_bf16(d.x, d.y);
                    *(u32x4*)(rowp + bj * 128) = w; }
                if (isv) { const int ln_ = 16 * fq + fr; s += shx(s, 16, ln_); s += shx(s, 32, ln_); q += shx(q, 16, ln_); q += shx(q, 32, ln_);
                    if (fq == 0) *(f32x2*)(stat + ((size_t)row * 32 + (u.pn - 8) * 4 + wc) * 2) = (f32x2){s, q}; } }
    }
};
struct EpiResid {
    static constexpr bool PERM = true;
    LAS unsigned char* lds;
    __device__ __forceinline__ void operator()(const f32x4 (&acc)[2][2][4][2], const Unit& u, int wr, int wc, int fr, int fq) const {
        const int mrow = u.pm < 64 ? 0 : (u.pm < 128 ? 1 : 2);
        bf16_t* x = (bf16_t*)desc_p(lds, 0, 4) + (size_t)(u.pm * 256 + wr * 64 + fr) * D + u.pn * 256 + wc * 32 + 8 * fq;
        const float* bias = (const float*)desc_p(lds, 0, 14); const float* gate = (const float*)desc_p(lds, 1, 10) + mrow * 6 * D + u.pn * 256 + wc * 32 + 8 * fq;
        if (bias) bias += u.pn * 256 + wc * 32 + 8 * fq;
#pragma unroll
        for (int bj = 0; bj < 2; ++bj) { const int c = bj * 128;
            const f32x4 b0 = bias ? *(const f32x4*)(bias + c) : (f32x4){0.f, 0.f, 0.f, 0.f}, b1 = bias ? *(const f32x4*)(bias + c + 4) : (f32x4){0.f, 0.f, 0.f, 0.f};
            const f32x4 g0 = *(const f32x4*)(gate + c), g1 = *(const f32x4*)(gate + c + 4);
            u32x4 xw[2][4];
#pragma unroll
            for (int ai = 0; ai < 2; ++ai)
#pragma unroll
                for (int m = 0; m < 4; ++m) xw[ai][m] = *(const u32x4*)(x + (size_t)(ai * 128 + m * 16) * D + c);
#pragma unroll
            for (int ai = 0; ai < 2; ++ai) {
#pragma unroll
                for (int m = 0; m < 4; ++m) { const u32x4 w = xw[ai][m];
                    const f32x4 o0 = (f32x4){bf_lo(w.x), bf_hi(w.x), bf_lo(w.y), bf_hi(w.y)} + g0 * (acc[ai][bj][m][0] + b0), o1 = (f32x4){bf_lo(w.z), bf_hi(w.z), bf_lo(w.w), bf_hi(w.w)} + g1 * (acc[ai][bj][m][1] + b1);
                    u32x4 w2; w2.x = cvt_pk_bf16(o0[0], o0[1]); w2.y = cvt_pk_bf16(o0[2], o0[3]); w2.z = cvt_pk_bf16(o1[0], o1[1]); w2.w = cvt_pk_bf16(o1[2], o1[3]);
                    *(u32x4*)(x + (size_t)(ai * 128 + m * 16) * D + c) = w2; }
                EPI_FENCE(); } }
    }
};
template <int K>
__device__ __forceinline__ void tail_resid(LAS unsigned char* lds, int wave) {
    const int lane = lane_id_now(), fr = lane & 15, q = lane >> 4, tid = wave * 64 + lane;
    constexpr int KW = K / 8, RP = 68;
    LAS float* red = (LAS float*)lds;
    const bf16_t* A = (const bf16_t*)desc_p(lds, 0, 0) + (size_t)TL * K; const bf16_t* W = (const bf16_t*)desc_p(lds, 0, 2);
    bf16_t* X = (bf16_t*)desc_p(lds, 0, 4) + (size_t)TL * D; const float* bias = (const float*)desc_p(lds, 0, 14); const float* gate = (const float*)desc_p(lds, 1, 10) + 2 * 6 * D;
    for (int item = blockIdx.x; item < TC / 16 * 16; item += gridDim.x) {
        const int r0 = (item >> 4) * 16, c0 = (item & 15) * 64;
        const bf16_t* ap = A + (size_t)(r0 + fr) * K + wave * KW + 16 * q;
        const bf16_t* bp = W + (size_t)(c0 + fr) * K + wave * KW + 16 * q;
        f32x4 acc[4];
#pragma unroll
        for (int n = 0; n < 4; ++n) acc[n] = (f32x4){0.f, 0.f, 0.f, 0.f};
#pragma unroll
        for (int kb = 0; kb < KW / 64; ++kb) {
            const bf16x8 a0 = *(const bf16x8*)(ap + kb * 64), a1 = *(const bf16x8*)(ap + kb * 64 + 8);
#pragma unroll
            for (int n = 0; n < 4; ++n) { const bf16x8 b0 = *(const bf16x8*)(bp + (size_t)n * 16 * K + kb * 64), b1 = *(const bf16x8*)(bp + (size_t)n * 16 * K + kb * 64 + 8);
                acc[n] = __builtin_amdgcn_mfma_f32_16x16x32_bf16(a0, b0, acc[n], 0, 0, 0); acc[n] = __builtin_amdgcn_mfma_f32_16x16x32_bf16(a1, b1, acc[n], 0, 0, 0); }
        }
#pragma unroll
        for (int n = 0; n < 4; ++n)
#pragma unroll
            for (int r = 0; r < 4; ++r) red[(wave * 16 + 4 * q + r) * RP + n * 16 + fr] = acc[n][r];
        __syncthreads();
        { const int row = tid >> 5, c2 = 2 * (tid & 31); float s0 = 0.f, s1 = 0.f;
#pragma unroll
          for (int w = 0; w < 8; ++w) { const f32x2 v = *(LAS const f32x2*)(red + (w * 16 + row) * RP + c2); s0 += v.x; s1 += v.y; }
          const int col = c0 + c2; bf16_t* p = X + (size_t)(r0 + row) * D + col; const unsigned xw = *(const unsigned*)p;
          const float b0 = bias ? bias[col] : 0.f, b1 = bias ? bias[col + 1] : 0.f;
          *(unsigned*)p = cvt_pk_bf16(bf_lo(xw) + gate[col] * (s0 + b0), bf_hi(xw) + gate[col + 1] * (s1 + b1)); }
        __syncthreads();
    }
}
__device__ __forceinline__ void tail_gelu(LAS unsigned char* lds, int wave) {
    const int lane = lane_id_now(), fr = lane & 15, q = lane >> 4, tid = wave * 64 + lane;
    constexpr int K = D, KW = K / 8, RP = 260;
    LAS float* red = (LAS float*)lds;
    const bf16_t* A = (const bf16_t*)desc_p(lds, 0, 0) + (size_t)TL * K; const bf16_t* W = (const bf16_t*)desc_p(lds, 0, 2);
    const float* bias = (const float*)desc_p(lds, 0, 12); float* stat = (float*)desc_p(lds, 0, 14);
    for (int item = blockIdx.x; item < TC / 16 * 16; item += gridDim.x) {
        const int r0 = (item >> 4) * 16, c0 = (item & 15) * 256;
        const bf16_t* ap = A + (size_t)(r0 + fr) * K + wave * KW + 16 * q;
        const bf16_t* bp = W + (size_t)(c0 + fr) * K + wave * KW + 16 * q;
        const bf16x8 a0 = *(const bf16x8*)(ap), a1 = *(const bf16x8*)(ap + 8), a2 = *(const bf16x8*)(ap + 64), a3 = *(const bf16x8*)(ap + 72);
#pragma unroll 1
        for (int ng = 0; ng < 4; ++ng) {
            f32x4 acc[4];
#pragma unroll
            for (int n = 0; n < 4; ++n) { const bf16_t* b = bp + (size_t)(ng * 4 + n) * 16 * K;
                const bf16x8 b0 = *(const bf16x8*)(b), b1 = *(const bf16x8*)(b + 8), b2 = *(const bf16x8*)(b + 64), b3 = *(const bf16x8*)(b + 72);
                f32x4 c = (f32x4){0.f, 0.f, 0.f, 0.f};
                c = __builtin_amdgcn_mfma_f32_16x16x32_bf16(a0, b0, c, 0, 0, 0); c = __builtin_amdgcn_mfma_f32_16x16x32_bf16(a1, b1, c, 0, 0, 0);
                c = __builtin_amdgcn_mfma_f32_16x16x32_bf16(a2, b2, c, 0, 0, 0); c = __builtin_amdgcn_mfma_f32_16x16x32_bf16(a3, b3, c, 0, 0, 0); acc[n] = c; }
#pragma unroll
            for (int n = 0; n < 4; ++n)
#pragma unroll
                for (int r = 0; r < 4; ++r) red[(wave * 16 + 4 * q + r) * RP + (ng * 4 + n) * 16 + fr] = acc[n][r];
        }
        __syncthreads();
        { const int row = tid >> 5, c8 = 8 * (tid & 31); f32x4 s0 = (f32x4){0.f, 0.f, 0.f, 0.f}, s1 = s0;
#pragma unroll
          for (int w = 0; w < 8; ++w) { s0 += *(LAS const f32x4*)(red + (w * 16 + row) * RP + c8); s1 += *(LAS const f32x4*)(red + (w * 16 + row) * RP + c8 + 4); }
          const int col = c0 + c8; const bool isv = col >= GWID; bf16_t* base = (bf16_t*)desc_p(lds, 0, isv ? 10 : 4);
          s0 += *(const f32x4*)(bias + col); s1 += *(const f32x4*)(bias + col + 4);
          const f32x2 a = gelu_pk((f32x2){s0[0], s0[1]}), b = gelu_pk((f32x2){s0[2], s0[3]}), c = gelu_pk((f32x2){s1[0], s1[1]}), d = gelu_pk((f32x2){s1[2], s1[3]});
          u32x4 w; w.x = cvt_pk_bf16(a.x, a.y); w.y = cvt_pk_bf16(b.x, b.y); w.z = cvt_pk_bf16(c.x, c.y); w.w = cvt_pk_bf16(d.x, d.y);
          *(u32x4*)(base + (size_t)(TL + r0 + row) * GWID + (col & (GWID - 1))) = w;
          if (isv) { float s = ((a.x + a.y) + (b.x + b.y)) + ((c.x + c.y) + (d.x + d.y)), qq = ((a.x * a.x + a.y * a.y) + (b.x * b.x + b.y * b.y)) + ((c.x * c.x + c.y * c.y) + (d.x * d.x + d.y * d.y));
              s += shx(s, 1, lane); s += shx(s, 2, lane); s += shx(s, 4, lane); qq += shx(qq, 1, lane); qq += shx(qq, 2, lane); qq += shx(qq, 4, lane);
              if ((lane & 7) == 0) *(f32x2*)(stat + ((size_t)(TL + r0 + row) * 32 + ((col - GWID) >> 6)) * 2) = (f32x2){s, qq}; } }
        __syncthreads();
    }
}
struct EpiAct {
    static constexpr bool PERM = true;
    LAS unsigned char* lds;
    __device__ __forceinline__ void operator()(const f32x4 (&acc)[2][2][4][2], const Unit& u, int wr, int wc, int fr, int fq) const {
        bf16_t* C = (bf16_t*)desc_p(lds, u.aux, 4); const int ldc = desc_i(lds, u.aux, 7), act = desc_i(lds, u.aux, 8);
        const int col0 = u.pn * 256 + wc * 32 + 8 * fq, row0 = u.pm * 256 + wr * 64 + fr;
#pragma unroll
        for (int ai = 0; ai < 2; ++ai)
#pragma unroll
            for (int m = 0; m < 4; ++m) { bf16_t* rowp = C + (size_t)(row0 + ai * 128 + m * 16) * ldc + col0;
#pragma unroll
                for (int bj = 0; bj < 2; ++bj) { f32x4 v0 = acc[ai][bj][m][0], v1 = acc[ai][bj][m][1];
                    if (act == 1) {
#pragma unroll
                        for (int j = 0; j < 4; ++j) { v0[j] = tanhf_(v0[j]); v1[j] = tanhf_(v1[j]); } }
                    else if (act == 2) {
#pragma unroll
                        for (int j = 0; j < 4; ++j) { v0[j] = sigmoidf_(v0[j]); v1[j] = sigmoidf_(v1[j]); } }
                    u32x4 w; w.x = cvt_pk_bf16(v0[0], v0[1]); w.y = cvt_pk_bf16(v0[2], v0[3]); w.z = cvt_pk_bf16(v1[0], v1[1]); w.w = cvt_pk_bf16(v1[2], v1[3]);
                    *(u32x4*)(rowp + bj * 128) = w; } }
    }
};
struct EpiLogits {
    static constexpr bool PERM = false;
    float* LG;
    __device__ __forceinline__ void operator()(const f32x4 (&acc)[2][2][4][2], const Unit& u, int wr, int wc, int fr, int fq) const {
        if (wc >= 2) return;
        const int col0 = wc * 32 + 4 * fq, row0 = u.pm * 256 + wr * 64 + fr;
#pragma unroll
        for (int ai = 0; ai < 2; ++ai)
#pragma unroll
            for (int m = 0; m < 4; ++m)
#pragma unroll
                for (int n = 0; n < 2; ++n) *(f32x4*)(LG + (size_t)(row0 + ai * 128 + m * 16) * 64 + col0 + n * 16) = acc[ai][0][m][n] + acc[ai][1][m][n];
    }
};
struct EpiSiluGate {
    static constexpr bool PERM = true;
    bf16_t* H;
    __device__ __forceinline__ void operator()(const f32x4 (&acc)[2][2][4][2], const Unit& u, int wr, int wc, int fr, int fq) const {
        const int col0 = u.pn * 128 + wc * 32 + 8 * fq, row0 = u.pm * 256 + wr * 64 + fr;
#pragma unroll
        for (int ai = 0; ai < 2; ++ai)
#pragma unroll
            for (int m = 0; m < 4; ++m) { f32x4 h0, h1;
#pragma unroll
                for (int j = 0; j < 4; ++j) { const float g0 = acc[ai][0][m][0][j], g1 = acc[ai][0][m][1][j]; h0[j] = g0 * sigmoidf_(g0) * acc[ai][1][m][0][j]; h1[j] = g1 * sigmoidf_(g1) * acc[ai][1][m][1][j]; }
                u32x4 w; w.x = cvt_pk_bf16(h0[0], h0[1]); w.y = cvt_pk_bf16(h0[2], h0[3]); w.z = cvt_pk_bf16(h1[0], h1[1]); w.w = cvt_pk_bf16(h1[2], h1[3]);
                *(u32x4*)(H + (size_t)(row0 + ai * 128 + m * 16) * EHID + col0) = w; }
    }
};
struct EpiScatter {
    static constexpr bool PERM = true;
    LAS unsigned char* lds; bf16_t* YB; const int* list;
    __device__ __forceinline__ void operator()(const f32x4 (&acc)[2][2][4][2], const Unit& u, int wr, int wc, int fr, int fq) const {
        LAS const int* tab = (LAS const int*)(lds + LDS_TAB);
        const int j0 = __builtin_amdgcn_readfirstlane(tab[MAXRT + u.pm]), cn = __builtin_amdgcn_readfirstlane(tab[2 * MAXRT + u.aux]);
        const int col0 = u.pn * 256 + wc * 32 + 8 * fq;
        int aid[2][4];
#pragma unroll
        for (int ai = 0; ai < 2; ++ai)
#pragma unroll
            for (int m = 0; m < 4; ++m) { const int slot = j0 + ai * 128 + wr * 64 + m * 16 + fr; aid[ai][m] = slot < cn ? list[(size_t)u.aux * LISTCAP + slot] : -1; }
#pragma unroll
        for (int ai = 0; ai < 2; ++ai)
#pragma unroll
            for (int m = 0; m < 4; ++m) { const int a = aid[ai][m];
                if (a >= 0) { bf16_t* rowp = YB + (size_t)a * D + col0;
#pragma unroll
                    for (int bj = 0; bj < 2; ++bj) { const f32x4 v0 = acc[ai][bj][m][0], v1 = acc[ai][bj][m][1];
                        u32x4 w; w.x = cvt_pk_bf16(v0[0], v0[1]); w.y = cvt_pk_bf16(v0[2], v0[3]); w.z = cvt_pk_bf16(v1[0], v1[1]); w.w = cvt_pk_bf16(v1[2], v1[3]);
                        *(u32x4*)(rowp + bj * 128) = w; } } }
    }
};

struct Params { const float* in[42]; float* out; unsigned char* ws; int ph_lo, ph_hi; };
enum { I_X = 0, I_C, I_CTX, I_CCTX, I_ADAW, I_ADAB, I_N1G, I_N2G, I_FG, I_GWIN, I_GBIN, I_GLNG, I_GLNB, I_GWS, I_GBS, I_GWOUT, I_GBOUT,
       I_MU, I_WR, I_WK, I_WV, I_WO, I_W0, I_W1, I_W2, I_A0, I_A1, I_A2, I_G1, I_G2, I_KK, I_KA, I_RK, I_LNG, I_LNB,
       I_MWGRP, I_MBGRP, I_MWEXP, I_MBEXP, I_MWG, I_MWU, I_MWD };
struct Frame { LAS unsigned char* lds; int tid, lane, wave, G, gw, NGW; };
typedef const __attribute__((address_space(4))) Params* KP;

constexpr int TRP = 36, TR_SCR = 64 * TRP * 4;
__device__ __forceinline__ void tr_item(const float* W, int N, int kmax, bf16_t* WT, int ldk, int k0, int n0, int drow0, int dk0, LAS float* scr, int lane) {
    const int n4 = lane & 7, kr = lane >> 3; f32x4 v[8];
#pragma unroll
    for (int i = 0; i < 8; ++i) { const int k = k0 + 8 * i + kr; v[i] = k < kmax ? *(const f32x4*)(W + (size_t)k * N + n0 + 4 * n4) : (f32x4){0.f, 0.f, 0.f, 0.f}; }
#pragma unroll
    for (int i = 0; i < 8; ++i) *(LAS f32x4*)(scr + (8 * i + kr) * TRP + 4 * n4) = v[i];
    asm volatile("s_waitcnt lgkmcnt(0)" ::: "memory");
    const int c = lane & 7;
#pragma unroll
    for (int j = 0; j < 4; ++j) { const int n = (lane >> 3) + 8 * j; const LAS float* sp = scr + (8 * c) * TRP + n;
        u32x4 o; o.x = cvt_pk_bf16(sp[0 * TRP], sp[1 * TRP]); o.y = cvt_pk_bf16(sp[2 * TRP], sp[3 * TRP]); o.z = cvt_pk_bf16(sp[4 * TRP], sp[5 * TRP]); o.w = cvt_pk_bf16(sp[6 * TRP], sp[7 * TRP]);
        *(u32x4*)(WT + (size_t)(drow0 + n) * ldk + dk0 + k0 + 8 * c) = o; }
    asm volatile("s_waitcnt lgkmcnt(0)" ::: "memory");
}
constexpr int LDS_JOBS = 80 * 1024, MAXJOBS = 48;
__device__ __forceinline__ void add_job(LAS int* jobs, int& nj, int& nit, const float* src, int N, int kmax, int kpad, bf16_t* dst, int ldk, int drow0, int dk0) {
    LAS int* q = jobs + nj * 12; const unsigned long long a = (unsigned long long)src, d = (unsigned long long)dst;
    q[0] = (int)(unsigned)a; q[1] = (int)(unsigned)(a >> 32); q[2] = (int)(unsigned)d; q[3] = (int)(unsigned)(d >> 32); q[4] = N; q[5] = kmax; q[6] = kpad / 64; q[7] = ldk; q[8] = drow0; q[9] = dk0; q[10] = nit;
    nit += (kpad / 64) * (N / 32); ++nj;
}
__device__ __forceinline__ void zero_fill(const Frame& F, bf16_t* p, size_t nbytes) {
    u32x4* q = (u32x4*)p; const size_t n = nbytes / 16;
    for (size_t i = (size_t)blockIdx.x * NTHR + F.tid; i < n; i += (size_t)F.G * NTHR) q[i] = (u32x4){0u, 0u, 0u, 0u};
}

__device__ __forceinline__ void prologue_phase(const Frame& F, KP P) {
    unsigned char* ws = P->ws;
    {   float* MOD = (float*)(ws + WS_MOD); LAS float* part = (LAS float*)F.lds;
        const float* c = P->in[I_C]; const float* cc = P->in[I_CCTX];
        for (int item = blockIdx.x; item < DEPTH * 24; item += F.G) {
            const int layer = item / 24, col = (item % 24) * 256 + 4 * F.lane; const float* w = P->in[I_ADAW] + (size_t)layer * D * 6 * D + col;
            f32x4 a0 = (f32x4){0.f, 0.f, 0.f, 0.f}, a1 = a0, a2 = a0;
#pragma unroll 8
            for (int i = 0; i < 128; ++i) { const int d = F.wave + 8 * i; const f32x4 wv = *(const f32x4*)(w + (size_t)d * 6 * D);
                const float c0 = c[d], c1 = c[D + d], c2 = cc[d];
                a0 += wv * (c0 * sigmoidf_(c0)); a1 += wv * (c1 * sigmoidf_(c1)); a2 += wv * (c2 * sigmoidf_(c2)); }
            __syncthreads();
            *(LAS f32x4*)(part + (F.wave * 3 + 0) * 256 + 4 * F.lane) = a0; *(LAS f32x4*)(part + (F.wave * 3 + 1) * 256 + 4 * F.lane) = a1; *(LAS f32x4*)(part + (F.wave * 3 + 2) * 256 + 4 * F.lane) = a2;
            __syncthreads();
            if (F.wave < 3) { f32x4 sacc = (f32x4){0.f, 0.f, 0.f, 0.f};
#pragma unroll
                for (int w8 = 0; w8 < 8; ++w8) sacc += *(const LAS f32x4*)(part + (w8 * 3 + F.wave) * 256 + 4 * F.lane);
                *(f32x4*)(MOD + ((size_t)layer * 3 + F.wave) * 6 * D + col) = sacc + *(const f32x4*)(P->in[I_ADAB] + (size_t)layer * 6 * D + col); }
        }
    }
    LAS int* jobs = (LAS int*)(F.lds + LDS_JOBS); LAS int* jtot = jobs + MAXJOBS * 12;
    __syncthreads();
    if (F.tid == 0) { int nj = 0, nit = 0;
        for (int j = 0; j < 2; ++j) {
            add_job(jobs, nj, nit, P->in[I_GWIN] + (size_t)j * D * 4096, 4096, D, D, (bf16_t*)(ws + WS_WIN) + (size_t)j * 4096 * D, D, 0, 0);
            add_job(jobs, nj, nit, P->in[I_GWOUT] + (size_t)j * GWID * D, D, GWID, GWID, (bf16_t*)(ws + WS_WOUT) + (size_t)j * D * GWID, GWID, 0, 0);
            add_job(jobs, nj, nit, P->in[I_WR] + (size_t)j * D * D, D, D, D, (bf16_t*)(ws + WS_WR) + (size_t)j * D * D, D, 0, 0);
            add_job(jobs, nj, nit, P->in[I_WK] + (size_t)j * D * D, D, D, D, (bf16_t*)(ws + WS_WK) + (size_t)j * D * D, D, 0, 0);
            add_job(jobs, nj, nit, P->in[I_WV] + (size_t)j * D * D, D, D, D, (bf16_t*)(ws + WS_WV) + (size_t)j * D * D, D, 0, 0);
            add_job(jobs, nj, nit, P->in[I_WO] + (size_t)j * D * D, D, D, D, (bf16_t*)(ws + WS_WO) + (size_t)j * D * D, D, 0, 0);
            for (int z = 0; z < 2; ++z) {
                add_job(jobs, nj, nit, P->in[I_W1] + ((size_t)j * 2 + z) * D * 64, 64, D, D, (bf16_t*)(ws + WS_LW1) + (size_t)j * 256 * D, D, z * 64, 0);
                add_job(jobs, nj, nit, P->in[I_A1] + ((size_t)j * 2 + z) * D * 64, 64, D, D, (bf16_t*)(ws + WS_LA1) + (size_t)j * 256 * D, D, z * 64, 0);
                add_job(jobs, nj, nit, P->in[I_W2] + ((size_t)j * 2 + z) * 64 * D, D, 64, 64, (bf16_t*)(ws + WS_W2P) + ((size_t)j * 2 + z) * D * 256, 256, 0, z * 64);
                add_job(jobs, nj, nit, P->in[I_A2] + ((size_t)j * 2 + z) * 64 * D, D, 64, 64, (bf16_t*)(ws + WS_A2P) + ((size_t)j * 2 + z) * D * 256, 256, 0, z * 64); }
            add_job(jobs, nj, nit, P->in[I_G1] + (size_t)j * D * 160, 160, D, D, (bf16_t*)(ws + WS_LG1) + (size_t)j * 256 * D, D, 0, 0);
            add_job(jobs, nj, nit, P->in[I_G2] + (size_t)j * 160 * D, D, 160, 256, (bf16_t*)(ws + WS_G2P) + (size_t)j * D * 256, 256, 0, 0); }
        jtot[0] = nj; jtot[1] = nit; }
    __syncthreads();
    {   const int nj = jtot[0], nit = jtot[1]; LAS float* scr = (LAS float*)(F.lds + F.wave * TR_SCR);
        for (int it = F.gw; it < nit; it += F.NGW) {
            int jb = 0; for (int q = 1; q < nj; ++q) if (it >= jobs[q * 12 + 10]) jb = q;
            jb = __builtin_amdgcn_readfirstlane(jb); LAS const int* q = jobs + jb * 12;
            const float* src = (const float*)(((unsigned long long)(unsigned)q[1] << 32) | (unsigned)q[0]); bf16_t* dst = (bf16_t*)(((unsigned long long)(unsigned)q[3] << 32) | (unsigned)q[2]);
            const int N = q[4], nnb = N / 32, r = it - q[10], kb = r / nnb, nb = r % nnb;
            tr_item(src, N, q[5], dst, q[7], kb * 64, nb * 32, q[8] + nb * 32, q[9], scr, F.lane); }
    }
    for (int j = 0; j < 2; ++j) {
        bf16_t* lw1 = (bf16_t*)(ws + WS_LW1) + (size_t)j * 256 * D; bf16_t* la1 = (bf16_t*)(ws + WS_LA1) + (size_t)j * 256 * D; bf16_t* lg1 = (bf16_t*)(ws + WS_LG1) + (size_t)j * 256 * D;
        zero_fill(F, lw1 + 128 * D, (size_t)128 * D * 2); zero_fill(F, la1 + 128 * D, (size_t)128 * D * 2); zero_fill(F, lg1 + 160 * D, (size_t)96 * D * 2);
        for (int z = 0; z < 2; ++z) { bf16_t* w2p = (bf16_t*)(ws + WS_W2P) + ((size_t)j * 2 + z) * D * 256; bf16_t* a2p = (bf16_t*)(ws + WS_A2P) + ((size_t)j * 2 + z) * D * 256;
            for (int idx = blockIdx.x * NTHR + F.tid; idx < D * 32; idx += F.G * NTHR) { const int n = idx >> 5, ch = idx & 31;
                if ((ch >> 3) != z) { *(u32x4*)(w2p + (size_t)n * 256 + ch * 8) = (u32x4){0u, 0u, 0u, 0u}; *(u32x4*)(a2p + (size_t)n * 256 + ch * 8) = (u32x4){0u, 0u, 0u, 0u}; } } }
    }
    {   bf16_t* wrt = (bf16_t*)(ws + WS_WRT);
        for (int idx = blockIdx.x * NTHR + F.tid; idx < DEPTH * 256 * (D / 8); idx += F.G * NTHR) { const int k0 = (idx & 127) * 8, n = (idx >> 7) & 255, layer = idx >> 15;
            const int nn = n & 127; const bool lo = n >= 128; float w[8];
#pragma unroll
            for (int e = 0; e < 8; ++e) { float x = 0.f;
                if (nn < 4) x = P->in[I_MWGRP][((size_t)layer * D + k0 + e) * 4 + nn]; else if (nn < 36) x = P->in[I_MWEXP][((size_t)layer * D + k0 + e) * NE + nn - 4];
                const float hi = bf_lo(cvt_pk_bf16(x, 0.f)); w[e] = lo ? x - hi : x; }
            *(u32x4*)(wrt + ((size_t)layer * 256 + n) * D + k0) = pack8(w); } }
    {   const float* src = P->in[I_GWS]; bf16_t* dst = (bf16_t*)(ws + WS_WSP); const int n8 = 2 * 16 * 128 * 128 / 8;
        for (int i = blockIdx.x * NTHR + F.tid; i < n8; i += F.G * NTHR) { const f32x4 a = *(const f32x4*)(src + (size_t)i * 8), b = *(const f32x4*)(src + (size_t)i * 8 + 4);
            u32x4 o; o.x = cvt_pk_bf16(a[0], a[1]); o.y = cvt_pk_bf16(a[2], a[3]); o.z = cvt_pk_bf16(b[0], b[1]); o.w = cvt_pk_bf16(b[2], b[3]); *(u32x4*)(dst + (size_t)i * 8) = o; } }
}
struct MoeItem { const float* src; bf16_t* dst; int N, kmax, ldk, k0, n0, drow0; };
__device__ __forceinline__ MoeItem moe_item(KP P, unsigned char* ws, int layer, int it) {
    const int e = it / 768, r = it % 768, m = r >> 8, q = r & 255; const size_t so = ((size_t)layer * NE + e) * (size_t)D * EHID; MoeItem I;
    if (m < 2) { const int kb = q >> 4, n0 = (q & 15) * 32;
        I.src = (m == 0 ? P->in[I_MWG] : P->in[I_MWU]) + so; I.N = EHID; I.kmax = D; I.dst = (bf16_t*)(ws + WS_WGU) + (size_t)e * D * D; I.ldk = D; I.k0 = kb * 64; I.n0 = n0; I.drow0 = 256 * (n0 >> 7) + (n0 & 127) + (m == 1 ? 128 : 0); }
    else { const int kb = q >> 5, n0 = (q & 31) * 32;
        I.src = P->in[I_MWD] + so; I.N = D; I.kmax = EHID; I.dst = (bf16_t*)(ws + WS_WD) + (size_t)e * D * EHID; I.ldk = EHID; I.k0 = kb * 64; I.n0 = n0; I.drow0 = n0; }
    return I;
}
__device__ __forceinline__ void tr_load(const MoeItem& I, int lane, f32x4 (&v)[8]) {
    const int n4 = lane & 7, kr = lane >> 3;
#pragma unroll
    for (int i = 0; i < 8; ++i) v[i] = *(const f32x4*)(I.src + (size_t)(I.k0 + 8 * i + kr) * I.N + I.n0 + 4 * n4);
}
__device__ __forceinline__ void tr_store(const MoeItem& I, int lane, const f32x4 (&v)[8], LAS float* scr) {
    const int n4 = lane & 7, kr = lane >> 3;
#pragma unroll
    for (int i = 0; i < 8; ++i) *(LAS f32x4*)(scr + (8 * i + kr) * TRP + 4 * n4) = v[i];
    asm volatile("s_waitcnt lgkmcnt(0)" ::: "memory");
    const int c = lane & 7;
#pragma unroll
    for (int j = 0; j < 4; ++j) { const int n = (lane >> 3) + 8 * j; const LAS float* sp = scr + (8 * c) * TRP + n;
        u32x4 o; o.x = cvt_pk_bf16(sp[0 * TRP], sp[1 * TRP]); o.y = cvt_pk_bf16(sp[2 * TRP], sp[3 * TRP]); o.z = cvt_pk_bf16(sp[4 * TRP], sp[5 * TRP]); o.w = cvt_pk_bf16(sp[6 * TRP], sp[7 * TRP]);
        *(u32x4*)(I.dst + (size_t)(I.drow0 + n) * I.ldk + I.k0 + 8 * c) = o; }
    asm volatile("s_waitcnt lgkmcnt(0)" ::: "memory");
}
constexpr int MOE_ITEMS = NE * 768, MOE_SPLIT = 14336;
__device__ __forceinline__ void moe_weights_phase(const Frame& F, KP P, int layer, int vgw, int vngw, int it0, int it1) {
    unsigned char* ws = P->ws; LAS float* scr = (LAS float*)(F.lds + F.wave * TR_SCR);
    int it = it0 + vgw; f32x4 v[8], vn[8];
    if (it < it1) { const MoeItem I = moe_item(P, ws, layer, it); tr_load(I, F.lane, v); }
#pragma nounroll
    while (it < it1) { const int nx = it + vngw;
        if (nx < it1) { const MoeItem In = moe_item(P, ws, layer, nx); tr_load(In, F.lane, vn); }
        { const MoeItem I = moe_item(P, ws, layer, it); tr_store(I, F.lane, v, scr); }
#pragma unroll
        for (int i = 0; i < 8; ++i) v[i] = vn[i];
        it = nx; }
}

__device__ __forceinline__ void load_xrow(KP P, const Frame& F, int layer, int row, f32x4 (&v)[4]) {
    if (layer == 0) { const float* xr = row < TL ? P->in[I_X] + (size_t)row * D : P->in[I_CTX] + (size_t)(row - TL) * D;
#pragma unroll
        for (int j = 0; j < 4; ++j) v[j] = *(const f32x4*)(xr + 4 * F.lane + 256 * j); }
    else { const bf16_t* xr = (const bf16_t*)(P->ws + WS_X) + (size_t)row * D;
#pragma unroll
        for (int j = 0; j < 4; ++j) { const u32x2 w = *(const u32x2*)(xr + 4 * F.lane + 256 * j); v[j] = (f32x4){bf_lo(w.x), bf_hi(w.x), bf_lo(w.y), bf_hi(w.y)}; } }
}
__device__ __forceinline__ void load_vec4(const float* p, int lane, f32x4 (&r)[4]) {
#pragma unroll
    for (int j = 0; j < 4; ++j) r[j] = *(const f32x4*)(p + 4 * lane + 256 * j);
}
__device__ __forceinline__ void load_combine(KP P, const Frame& F, int layer, int row, bool combine, const f32x4 (&g2r)[4], f32x4 (&v)[4]) {
    load_xrow(P, F, layer, row, v);
    if (combine) {
        const bf16_t* yb = (const bf16_t*)(P->ws + WS_YB); const float* wg = (const float*)(P->ws + WS_WGT);
        const float w0 = wg[2 * row], w1 = wg[2 * row + 1];
#pragma unroll
        for (int j = 0; j < 4; ++j) { const int col = 4 * F.lane + 256 * j; const u32x2 a = *(const u32x2*)(yb + (size_t)(2 * row) * D + col), b = *(const u32x2*)(yb + (size_t)(2 * row + 1) * D + col);
            const f32x4 g = g2r[j];
            v[j][0] += g[0] * (w0 * bf_lo(a.x) + w1 * bf_lo(b.x)); v[j][1] += g[1] * (w0 * bf_hi(a.x) + w1 * bf_hi(b.x));
            v[j][2] += g[2] * (w0 * bf_lo(a.y) + w1 * bf_lo(b.y)); v[j][3] += g[3] * (w0 * bf_hi(a.y) + w1 * bf_hi(b.y)); }
    }
}
__device__ __forceinline__ void norm1_phase(const Frame& F, KP P, int layer) {
    const bool combine = layer > 0; bf16_t* X = (bf16_t*)(P->ws + WS_X); bf16_t* HL = (bf16_t*)(P->ws + WS_HL);
    f32x4 g1r[4], shr[4], scr[4], g2r[4]; load_vec4(P->in[I_N1G] + (size_t)layer * D, F.lane, g1r); int mc = -1;
#pragma unroll
    for (int j = 0; j < 4; ++j) { shr[j] = (f32x4){0.f, 0.f, 0.f, 0.f}; scr[j] = shr[j]; g2r[j] = shr[j]; }
    for (int row = F.gw; row < T; row += F.NGW) {
        const int m = row < TL ? (row >> 14) : 2; f32x4 v[4];
        if (m != mc) { mc = m; const float* mod = (const float*)(P->ws + WS_MOD) + ((size_t)layer * 3 + m) * 6 * D; load_vec4(mod, F.lane, shr); load_vec4(mod + D, F.lane, scr);
            if (combine) load_vec4((const float*)(P->ws + WS_MOD) + ((size_t)(layer - 1) * 3 + m) * 6 * D + 5 * D, F.lane, g2r); }
        load_combine(P, F, layer, row, combine, g2r, v);
        {
#pragma unroll
            for (int j = 0; j < 4; ++j) { u32x2 o; o.x = cvt_pk_bf16(v[j][0], v[j][1]); o.y = cvt_pk_bf16(v[j][2], v[j][3]); *(u32x2*)(X + (size_t)row * D + 4 * F.lane + 256 * j) = o;
                v[j] = (f32x4){bf_lo(o.x), bf_hi(o.x), bf_lo(o.y), bf_hi(o.y)}; } }
        float ss = 0.f;
#pragma unroll
        for (int j = 0; j < 4; ++j) ss += (v[j][0] * v[j][0] + v[j][1] * v[j][1]) + (v[j][2] * v[j][2] + v[j][3] * v[j][3]);
        const float rstd = rsqrtf(wave_sum(ss, F.lane) * (1.0f / D) + 1e-6f);
#pragma unroll
        for (int j = 0; j < 4; ++j) { const int col = 4 * F.lane + 256 * j;
            const f32x4 h = (v[j] * rstd) * g1r[j] * (scr[j] + 1.0f) + shr[j];
            u32x2 o; o.x = cvt_pk_bf16(h[0], h[1]); o.y = cvt_pk_bf16(h[2], h[3]); *(u32x2*)(HL + (size_t)row * D + col) = o; }
    }
}
__device__ __forceinline__ void final_phase(const Frame& F, KP P) {
    f32x4 fgr[4], g2r[4]; load_vec4(P->in[I_FG], F.lane, fgr); int mc = -1;
#pragma unroll
    for (int j = 0; j < 4; ++j) g2r[j] = (f32x4){0.f, 0.f, 0.f, 0.f};
    for (int row = F.gw; row < TL; row += F.NGW) {
        const int m = row >> 14; f32x4 v[4];
        if (m != mc) { mc = m; load_vec4((const float*)(P->ws + WS_MOD) + ((size_t)(DEPTH - 1) * 3 + m) * 6 * D + 5 * D, F.lane, g2r); }
        load_combine(P, F, DEPTH, row, true, g2r, v);
        float ss = 0.f;
#pragma unroll
        for (int j = 0; j < 4; ++j) ss += (v[j][0] * v[j][0] + v[j][1] * v[j][1]) + (v[j][2] * v[j][2] + v[j][3] * v[j][3]);
        const float rstd = rsqrtf(wave_sum(ss, F.lane) * (1.0f / D) + 1e-6f);
#pragma unroll
        for (int j = 0; j < 4; ++j) { const int col = 4 * F.lane + 256 * j; *(f32x4*)(P->out + (size_t)row * D + col) = (v[j] * rstd) * fgr[j]; }
    }
}
__device__ __forceinline__ void norm2_phase(const Frame& F, KP P, int layer) {
    const int ntok = layer == DEPTH - 1 ? TL : T; bf16_t* HL2 = (bf16_t*)(P->ws + WS_HL);
    f32x4 gr[4], shr[4], scr[4]; load_vec4(P->in[I_N2G] + (size_t)layer * D, F.lane, gr); int mc = -1;
#pragma unroll
    for (int j = 0; j < 4; ++j) { shr[j] = (f32x4){0.f, 0.f, 0.f, 0.f}; scr[j] = shr[j]; }
    for (int row = F.gw; row < ntok; row += F.NGW) {
        const int m = row < TL ? (row >> 14) : 2; f32x4 v[4]; load_xrow(P, F, 1, row, v);
        if (m != mc) { mc = m; const float* mod = (const float*)(P->ws + WS_MOD) + ((size_t)layer * 3 + m) * 6 * D; load_vec4(mod + 3 * D, F.lane, shr); load_vec4(mod + 4 * D, F.lane, scr); }
        float ss = 0.f;
#pragma unroll
        for (int j = 0; j < 4; ++j) ss += (v[j][0] * v[j][0] + v[j][1] * v[j][1]) + (v[j][2] * v[j][2] + v[j][3] * v[j][3]);
        const float rstd = rsqrtf(wave_sum(ss, F.lane) * (1.0f / D) + 1e-6f);
#pragma unroll
        for (int j = 0; j < 4; ++j) { const int col = 4 * F.lane + 256 * j;
            const f32x4 h = (v[j] * rstd) * gr[j] * (scr[j] + 1.0f) + shr[j];
            u32x2 o; o.x = cvt_pk_bf16(h[0], h[1]); o.y = cvt_pk_bf16(h[2], h[3]); *(u32x2*)(HL2 + (size_t)row * D + col) = o; }
    }
    if (!(layer & 1)) moe_weights_phase(F, P, layer, F.gw, F.NGW, 0, MOE_SPLIT);
}
__device__ __forceinline__ void route_phase(const Frame& F, KP P, int layer) {
    const int ntok = layer == DEPTH - 1 ? TL : T; const float* LG = (const float*)(P->ws + WS_LG);
    const float* bgrp = P->in[I_MBGRP] + layer * 4; const float* bexp = P->in[I_MBEXP] + layer * NE;
    unsigned* cnt = (unsigned*)(P->ws + WS_CTL) + CW_CNT + layer * 64; int* list = (int*)(P->ws + WS_LIST); float* wgt = (float*)(P->ws + WS_WGT);
    LAS unsigned* lcnt = (LAS unsigned*)F.lds; LAS unsigned* lbase = lcnt + 32;
    for (int r0 = blockIdx.x * NTHR; r0 < ntok; r0 += F.G * NTHR) {
        const int row = r0 + F.tid; const bool act = row < ntok;
        __syncthreads();
        if (F.tid < 32) lcnt[F.tid] = 0u;
        __syncthreads();
        int e0 = 0, e1 = 0; unsigned k0 = 0, k1 = 0;
        if (act) {
            const float* lg = LG + (size_t)row * 64; const f32x4 g4 = *(const f32x4*)lg;
            float ag[4];
#pragma unroll
            for (int i = 0; i < 4; ++i) ag[i] = g4[i] + bgrp[i];
            int grp = 0; float mx = ag[0];
#pragma unroll
            for (int i = 1; i < 4; ++i) if (ag[i] > mx) { mx = ag[i]; grp = i; }
            float den = 0.f;
#pragma unroll
            for (int i = 0; i < 4; ++i) den += __expf(ag[i] - mx);
            const float pg = 1.0f / den;
            const f32x4 e0v = *(const f32x4*)(lg + 4 + 8 * grp), e1v = *(const f32x4*)(lg + 8 + 8 * grp); const f32x4 b0v = *(const f32x4*)(bexp + 8 * grp), b1v = *(const f32x4*)(bexp + 8 * grp + 4);
            float el[8];
#pragma unroll
            for (int i = 0; i < 4; ++i) { el[i] = e0v[i] + b0v[i]; el[4 + i] = e1v[i] + b1v[i]; }
            int i0 = 0; float t0 = el[0];
#pragma unroll
            for (int i = 1; i < 8; ++i) if (el[i] > t0) { t0 = el[i]; i0 = i; }
            int i1 = -1; float t1 = -3.0e38f;
#pragma unroll
            for (int i = 0; i < 8; ++i) if (i != i0 && el[i] > t1) { t1 = el[i]; i1 = i; }
            const float p0 = 1.0f / (1.0f + __expf(t1 - t0));
            wgt[2 * row] = pg * p0; wgt[2 * row + 1] = pg * (1.0f - p0);
            e0 = grp * 8 + i0; e1 = grp * 8 + i1;
            k0 = atomicAdd((unsigned*)(lcnt + e0), 1u); k1 = atomicAdd((unsigned*)(lcnt + e1), 1u);
        }
        __syncthreads();
        if (F.tid < 32) { const unsigned c = lcnt[F.tid]; lbase[F.tid] = c ? atomicAdd(cnt + F.tid, c) : 0u; }
        __syncthreads();
        if (act) { list[(size_t)e0 * LISTCAP + lbase[e0] + k0] = 2 * row; list[(size_t)e1 * LISTCAP + lbase[e1] + k1] = 2 * row + 1; }
    }
}
__device__ __forceinline__ bf16x8 tr_frag136(const LAS bf16_t* M, int k0, int c0, int lane) {
    LAS bf16_t* p = (LAS bf16_t*)M + (k0 + 8 * (lane >> 4) + ((lane & 15) >> 2)) * 136 + c0 + 4 * (lane & 3);
    const v4s lo = __builtin_amdgcn_ds_read_tr16_b64_v4i16((LAS v4s*)p), hi = __builtin_amdgcn_ds_read_tr16_b64_v4i16((LAS v4s*)(p + 4 * 136));
    return (bf16x8){lo[0], lo[1], lo[2], lo[3], hi[0], hi[1], hi[2], hi[3]};
}
__device__ __forceinline__ bf16x8 tr_frag136p(const LAS bf16_t* M, int k0, int dt, int lane) {
    LAS bf16_t* p = (LAS bf16_t*)M + (k0 + 8 * (lane >> 4) + ((lane & 15) >> 2)) * 136 + 32 * (dt >> 1) + 8 * (lane & 3) + 4 * (dt & 1);
    const v4s lo = __builtin_amdgcn_ds_read_tr16_b64_v4i16((LAS v4s*)p), hi = __builtin_amdgcn_ds_read_tr16_b64_v4i16((LAS v4s*)(p + 4 * 136));
    return (bf16x8){lo[0], lo[1], lo[2], lo[3], hi[0], hi[1], hi[2], hi[3]};
}
__device__ __forceinline__ void spatial_phase(const Frame& F, KP P, int j) {
    bf16_t* U = (bf16_t*)(P->ws + WS_U); const bf16_t* V = (const bf16_t*)(P->ws + WS_V); const float* stat = (const float*)(P->ws + WS_STAT);
    const bf16_t* WSP = (const bf16_t*)(P->ws + WS_WSP) + (size_t)j * 16 * 128 * 128;
    const float* lng = P->in[I_GLNG] + (size_t)j * GWID; const float* lnb = P->in[I_GLNB] + (size_t)j * GWID; const float* bs = P->in[I_GBS] + (size_t)j * 16 * 128;
    LAS bf16_t* Wt = (LAS bf16_t*)F.lds; LAS bf16_t* Vn = Wt + 128 * 136;
    LAS float* mu = (LAS float*)(F.lds + 2 * 128 * 136 * 2); LAS float* rs = mu + 128;
    const int l15 = F.lane & 15, l4 = F.lane >> 4;
    constexpr int NUNIT = (T / 128) * 16;
    const int u0 = (int)((long)blockIdx.x * NUNIT / F.G), u1 = (int)((long)(blockIdx.x + 1) * NUNIT / F.G);
#define SP_LOAD(W_, V_, U_, t0_, g_) do { \
        _Pragma("unroll") for (int i = 0; i < 4; ++i) { const int idx = F.tid + NTHR * i, r = idx >> 4, seg = idx & 15; \
            W_[i] = *(const u32x4*)(WSP + ((size_t)(g_) * 128 + r) * 128 + seg * 8); V_[i] = *(const u32x4*)(V + (size_t)((t0_) + r) * GWID + (g_) * 128 + seg * 8); } \
        { const bf16_t* ur_ = U + (size_t)((t0_) + 16 * F.wave + l15) * GWID + (g_) * 128 + 8 * l4; \
          _Pragma("unroll") for (int e = 0; e < 4; ++e) U_[e] = *(const u32x4*)(ur_ + e * 32); } } while (0)
    u32x4 wv[4], vv[4], uu[4];
    if (u0 < u1) SP_LOAD(wv, vv, uu, (u0 >> 4) * 128, u0 & 15);
    int cprev = -1;
#pragma nounroll
    for (int u = u0; u < u1; ++u) { const int c = u >> 4, g = u & 15, t0 = c * 128;
        if (c != cprev) { cprev = c;
            if (F.tid < 128) { const int row = t0 + F.tid; float s = 0.f, q = 0.f;
#pragma unroll
                for (int i = 0; i < 16; ++i) { const f32x4 p = *(const f32x4*)(stat + ((size_t)row * 32 + 2 * i) * 2); s += p[0] + p[2]; q += p[1] + p[3]; }
                const float mean = s * (1.0f / GWID), var = q * (1.0f / GWID) - mean * mean; mu[F.tid] = mean; rs[F.tid] = rsqrtf(var + 1e-5f); } }
        LDS_BARRIER();
#pragma unroll
        for (int i = 0; i < 4; ++i) { const int idx = F.tid + NTHR * i, r = idx >> 4, seg = idx & 15, ch = g * 128 + seg * 8;
            *(LAS u32x4*)(Wt + r * 136 + seg * 8) = wv[i];
            float x[8], o[8]; unpack8(vv[i], x); const float m_ = mu[r], r_ = rs[r];
            const f32x4 g0 = *(const f32x4*)(lng + ch), g1 = *(const f32x4*)(lng + ch + 4), b0 = *(const f32x4*)(lnb + ch), b1 = *(const f32x4*)(lnb + ch + 4);
#pragma unroll
            for (int e = 0; e < 8; ++e) o[e] = (x[e] - m_) * r_ * (e < 4 ? g0[e & 3] : g1[e & 3]) + (e < 4 ? b0[e & 3] : b1[e & 3]);
            *(LAS u32x4*)(Vn + r * 136 + seg * 8) = pack8(o); }
        u32x4 wn[4], vn[4], un[4];
        if (u + 1 < u1) SP_LOAD(wn, vn, un, ((u + 1) >> 4) * 128, (u + 1) & 15);
        LDS_BARRIER();
        bf16x8 bw[4];
#pragma unroll
        for (int ks = 0; ks < 4; ++ks) bw[ks] = *(const LAS bf16x8*)(Wt + (16 * F.wave + l15) * 136 + ks * 32 + 8 * l4);
        const int p = 16 * F.wave + l15; const float bias = bs[g * 128 + p];
        bf16_t* urow = U + (size_t)(t0 + p) * GWID + g * 128 + 8 * l4;
#pragma unroll
        for (int e = 0; e < 4; ++e) { f32x4 a0 = (f32x4){0.f, 0.f, 0.f, 0.f}, a1 = a0;
#pragma unroll
            for (int ks = 0; ks < 4; ++ks) { const bf16x8 f0 = tr_frag136p(Vn, 32 * ks, 2 * e, F.lane), f1 = tr_frag136p(Vn, 32 * ks, 2 * e + 1, F.lane);
                a0 = __builtin_amdgcn_mfma_f32_16x16x32_bf16(f0, bw[ks], a0, 0, 0, 0); a1 = __builtin_amdgcn_mfma_f32_16x16x32_bf16(f1, bw[ks], a1, 0, 0, 0); }
            u32x4 o; o.x = cvt_pk_bf16(bf_lo(uu[e].x) * (a0[0] + bias), bf_hi(uu[e].x) * (a0[1] + bias)); o.y = cvt_pk_bf16(bf_lo(uu[e].y) * (a0[2] + bias), bf_hi(uu[e].y) * (a0[3] + bias));
            o.z = cvt_pk_bf16(bf_lo(uu[e].z) * (a1[0] + bias), bf_hi(uu[e].z) * (a1[1] + bias)); o.w = cvt_pk_bf16(bf_lo(uu[e].w) * (a1[2] + bias), bf_hi(uu[e].w) * (a1[3] + bias));
            *(u32x4*)(urow + e * 32) = o; }
        if (u + 1 < u1) {
#pragma unroll
            for (int i = 0; i < 4; ++i) { wv[i] = wn[i]; vv[i] = vn[i]; uu[i] = un[i]; } }
    }
#undef SP_LOAD
}

__device__ __forceinline__ void mix_phase(const Frame& F, KP P, int j) {
    const bf16_t* HL = (const bf16_t*)(P->ws + WS_HL); const float* mu = P->in[I_MU] + (size_t)j * 6 * D;
    bf16_t* outs[6] = {(bf16_t*)(P->ws + WS_XR), (bf16_t*)(P->ws + WS_XW), (bf16_t*)(P->ws + WS_XK), (bf16_t*)(P->ws + WS_XV), (bf16_t*)(P->ws + WS_XA), (bf16_t*)(P->ws + WS_XG)};
    f32x4 mr[2][6][2];
#pragma unroll
    for (int jj = 0; jj < 2; ++jj)
#pragma unroll
        for (int m = 0; m < 6; ++m) { const int col = 512 * jj + 8 * F.lane; mr[jj][m][0] = *(const f32x4*)(mu + (size_t)m * D + col); mr[jj][m][1] = *(const f32x4*)(mu + (size_t)m * D + col + 4); }
    for (int row = F.gw; row < T; row += F.NGW) {
        bool ok[2]; int src[2]; const bool hi = F.lane >= 32;
        if (row < TL) { const int n = row & (SEQ - 1), gc = n & 63, gr = n >> 6;
            ok[0] = hi ? gc < 63 : gc > 0; src[0] = hi ? row + 1 : row - 1; ok[1] = hi ? gr < 255 : gr > 0; src[1] = hi ? row + 64 : row - 64; }
        else { const int n = (row - TL) & (CTXL - 1); ok[0] = n > 0; src[0] = row - 1; ok[1] = n < CTXL - 1; src[1] = row + 1; }
#pragma unroll
        for (int jj = 0; jj < 2; ++jj) { const int col = 512 * jj + 8 * F.lane;
            const u32x4 h8 = *(const u32x4*)(HL + (size_t)row * D + col); u32x4 s8 = (u32x4){0u, 0u, 0u, 0u};
            if (ok[jj]) s8 = *(const u32x4*)(HL + (size_t)src[jj] * D + col);
            const unsigned hw[4] = {h8.x, h8.y, h8.z, h8.w}, sw[4] = {s8.x, s8.y, s8.z, s8.w}; float h[8], xx[8];
#pragma unroll
            for (int e = 0; e < 8; ++e) { h[e] = (e & 1) ? bf_hi(hw[e >> 1]) : bf_lo(hw[e >> 1]); const float s = (e & 1) ? bf_hi(sw[e >> 1]) : bf_lo(sw[e >> 1]); xx[e] = s - h[e]; }
#pragma unroll
            for (int m = 0; m < 6; ++m) { const f32x4 ma = mr[jj][m][0], mb = mr[jj][m][1];
                u32x4 o; o.x = cvt_pk_bf16(h[0] + xx[0] * ma[0], h[1] + xx[1] * ma[1]); o.y = cvt_pk_bf16(h[2] + xx[2] * ma[2], h[3] + xx[3] * ma[3]);
                o.z = cvt_pk_bf16(h[4] + xx[4] * mb[0], h[5] + xx[5] * mb[1]); o.w = cvt_pk_bf16(h[6] + xx[6] * mb[2], h[7] + xx[7] * mb[3]);
                *(u32x4*)(outs[m] + (size_t)row * D + col) = o; } }
    }
}

constexpr int NCH = 5, SCP = NCH * 64, NSC = (SEQ + CTXL) / SCP, NSCAN = 64, TP = 72, TILE_B = 64 * TP * 2;
static_assert(NSC * SCP == SEQ + CTXL, "super-chunks");
enum { T_AT = 0, T_RT, T_BT, T_KT, T_VM, T_NT, T_MT, T_NRT, T_MRT, T_APA, T_APB, T_TAA, T_TAB, T_PRB, T_QRB, T_NTILE };
constexpr int LDS_GL = T_NTILE * TILE_B, LDS_SEG = LDS_GL + 256;
static_assert(LDS_SEG + 2048 <= LDS_MISC, "scan LDS map");
__device__ __forceinline__ int scan_row(int z, int b, int p) {
    if (p < CTXL) return TL + b * CTXL + (z ? CTXL - 1 - p : p);
    const int q = p - CTXL; return b * SEQ + (z ? SEQ - 1 - q : q);
}
__device__ __forceinline__ LAS bf16_t* stile(LAS unsigned char* lds, int n) { return (LAS bf16_t*)(lds + n * TILE_B); }
__device__ __forceinline__ bf16x8 row_frag(const LAS bf16_t* M, int r0, int k0, int lane) { return *(const LAS bf16x8*)(M + (r0 + (lane & 15)) * TP + k0 + 8 * (lane >> 4)); }
__device__ __forceinline__ bf16x8 tr_frag(const LAS bf16_t* M, int k0, int c0, int lane) {
    LAS bf16_t* p = (LAS bf16_t*)M + (k0 + 8 * (lane >> 4) + ((lane & 15) >> 2)) * TP + c0 + 4 * (lane & 3);
    const v4s lo = __builtin_amdgcn_ds_read_tr16_b64_v4i16((LAS v4s*)p), hi = __builtin_amdgcn_ds_read_tr16_b64_v4i16((LAS v4s*)(p + 4 * TP));
    return (bf16x8){lo[0], lo[1], lo[2], lo[3], hi[0], hi[1], hi[2], hi[3]};
}
template <bool XT, bool YT>
__device__ __forceinline__ void mm64(const LAS bf16_t* X, const LAS bf16_t* Y, f32x4 (&acc)[2], int wq, int wh, int lane) {
#pragma unroll
    for (int ks = 0; ks < 2; ++ks) {
        const bf16x8 b = XT ? tr_frag(X, 32 * ks, 16 * wq, lane) : row_frag(X, 16 * wq, 32 * ks, lane);
#pragma unroll
        for (int q = 0; q < 2; ++q) { const int i0 = 16 * (2 * wh + q);
            const bf16x8 a = YT ? row_frag(Y, i0, 32 * ks, lane) : tr_frag(Y, 32 * ks, i0, lane);
            acc[q] = __builtin_amdgcn_mfma_f32_16x16x32_bf16(a, b, acc[q], 0, 0, 0); }
    }
}
__device__ __forceinline__ void st_tile(LAS bf16_t* Z, const f32x4 (&acc)[2], int wq, int wh, int lane) {
#pragma unroll
    for (int q = 0; q < 2; ++q) { u32x2 o; o.x = cvt_pk_bf16(acc[q][0], acc[q][1]); o.y = cvt_pk_bf16(acc[q][2], acc[q][3]);
        *(LAS u32x2*)(Z + (16 * wq + (lane & 15)) * TP + 16 * (2 * wh + q) + 4 * (lane >> 4)) = o; }
}
__device__ __forceinline__ void ld_tile(const LAS bf16_t* Z, f32x4 (&acc)[2], int wq, int wh, int lane) {
#pragma unroll
    for (int q = 0; q < 2; ++q) { const u32x2 o = *(const LAS u32x2*)(Z + (16 * wq + (lane & 15)) * TP + 16 * (2 * wh + q) + 4 * (lane >> 4));
        acc[q] = (f32x4){bf_lo(o.x), bf_hi(o.x), bf_lo(o.y), bf_hi(o.y)}; }
}
__device__ __forceinline__ f32x4 prod16(const LAS bf16_t* X, int xr, int xc, const LAS bf16_t* Y, int yr, int yc, f32x4 acc, int lane) {
    bf16x8 b = *(const LAS bf16x8*)(X + (xr + (lane & 15)) * TP + xc + 8 * (lane >> 4)); bf16x8 a = tr_frag(Y, yr, yc, lane);
    if ((lane >> 4) >= 2) { b = (bf16x8){0, 0, 0, 0, 0, 0, 0, 0}; a = (bf16x8){0, 0, 0, 0, 0, 0, 0, 0}; }
    return __builtin_amdgcn_mfma_f32_16x16x32_bf16(a, b, acc, 0, 0, 0);
}
__device__ __forceinline__ void st16(LAS bf16_t* Z, int zr, int zc, f32x4 acc, int lane) { u32x2 o; o.x = cvt_pk_bf16(acc[0], acc[1]); o.y = cvt_pk_bf16(acc[2], acc[3]); *(LAS u32x2*)(Z + (zr + (lane & 15)) * TP + zc + 4 * (lane >> 4)) = o; }
__device__ __forceinline__ f32x4 ld16(const LAS bf16_t* Z, int zr, int zc, int lane) { const u32x2 o = *(const LAS u32x2*)(Z + (zr + (lane & 15)) * TP + zc + 4 * (lane >> 4)); return (f32x4){bf_lo(o.x), bf_hi(o.x), bf_lo(o.y), bf_hi(o.y)}; }
struct ChunkRegs { u32x4 r, k, v, tw, ta; };
__device__ __forceinline__ void scan_load(KP P, const Frame& F, int item, int c4, ChunkRegs& R) {
    const int s = item & 63, sc = item >> 6, z = s >> 5, b = (s >> 4) & 1, hh = s & 15;
    const size_t row = (size_t)scan_row(z, b, sc * SCP + c4 * 64 + (F.tid >> 3)); const size_t o = row * D + hh * 64 + (F.tid & 7) * 8, o2 = row * 256 + z * 64 + (F.tid & 7) * 8;
    R.r = *(const u32x4*)((const bf16_t*)(P->ws + WS_R) + o); R.k = *(const u32x4*)((const bf16_t*)(P->ws + WS_K) + o); R.v = *(const u32x4*)((const bf16_t*)(P->ws + WS_VV) + o);
    R.tw = *(const u32x4*)((const bf16_t*)(P->ws + WS_TW) + o2); R.ta = *(const u32x4*)((const bf16_t*)(P->ws + WS_TA) + o2);
}
__device__ __forceinline__ void scan_chunk_phase(const Frame& F, KP P, int j) {
    LAS unsigned char* lds = F.lds;
    LAS bf16_t* At = stile(lds, T_AT); LAS bf16_t* Rt = stile(lds, T_RT); LAS bf16_t* Bt = stile(lds, T_BT); LAS bf16_t* Kt = stile(lds, T_KT); LAS bf16_t* Vm = stile(lds, T_VM);
    LAS bf16_t* NT = stile(lds, T_NT); LAS bf16_t* MT = stile(lds, T_MT); LAS bf16_t* NrT = stile(lds, T_NRT); LAS bf16_t* MrT = stile(lds, T_MRT);
    LAS bf16_t* ApA = stile(lds, T_APA); LAS bf16_t* ApB = stile(lds, T_APB); LAS bf16_t* TaA = stile(lds, T_TAA); LAS bf16_t* TaB = stile(lds, T_TAB);
    LAS bf16_t* PrB = stile(lds, T_PRB); LAS bf16_t* QrB = stile(lds, T_QRB);
    LAS float* gl = (LAS float*)(lds + LDS_GL); LAS float* seg = (LAS float*)(lds + LDS_SEG);
    const int lane = F.lane, wq = F.wave & 3, wh = F.wave >> 2, l15 = lane & 15, l4 = lane >> 4;
    const int pi = F.tid >> 3, kq = F.tid & 7;
    const int jrow = 16 * wq + l15;
    const int NITEM = NSCAN * NSC;
    int item = blockIdx.x; if (item >= NITEM) return;
    ChunkRegs cur, nxt; scan_load(P, F, item, 0, cur); nxt = cur;
    f32x4 Pr[2], Qr[2], aYp[2], aQp[2];
#pragma unroll
    for (int q = 0; q < 2; ++q) { Pr[q] = (f32x4){0.f, 0.f, 0.f, 0.f}; Qr[q] = Pr[q]; aYp[q] = Pr[q]; aQp[q] = Pr[q]; }
    bool pend = false; size_t orowp = 0; bf16_t* GEp = nullptr; bf16_t* YEp = nullptr; float* pqp = nullptr; bool lastp = false;
#define SCAN_STAGE_G() do { \
        f32x4 ge[2] = {(f32x4){0.f, 0.f, 0.f, 0.f}, (f32x4){0.f, 0.f, 0.f, 0.f}}; \
        mm64<false, true>(NT, PrB, ge, wq, wh, lane); mm64<false, true>(NT, QrB, aYp, wq, wh, lane); \
        f32x4 pn[2] = {(f32x4){0.f, 0.f, 0.f, 0.f}, (f32x4){0.f, 0.f, 0.f, 0.f}}; \
        mm64<false, false>(PrB, MT, pn, wq, wh, lane); mm64<false, false>(QrB, MT, aQp, wq, wh, lane); \
        _Pragma("unroll") for (int q = 0; q < 2; ++q) { const int i0 = 16 * (2 * wh + q) + 4 * l4; \
            u32x2 o; o.x = cvt_pk_bf16(ge[q][0], ge[q][1]); o.y = cvt_pk_bf16(ge[q][2], ge[q][3]); *(u32x2*)(GEp + orowp + i0) = o; \
            u32x2 y; y.x = cvt_pk_bf16(aYp[q][0], aYp[q][1]); y.y = cvt_pk_bf16(aYp[q][2], aYp[q][3]); *(u32x2*)(YEp + orowp + i0) = y; \
            Pr[q] = pn[q]; Qr[q] = aQp[q]; } \
        if (lastp) { const int ln_ = lane_id_now(), l15_ = ln_ & 15, l4_ = ln_ >> 4;   \
            float* pP_ = pqp + ((l15_ & 3) * 4 + (l15_ >> 2)) * 64 + wq * 16 + 8 * wh + l4_; float* pQ_ = pqp + 4096 + (wq * 16 + l4_) * 64 + 32 * wh + l15_; \
            _Pragma("unroll") for (int q = 0; q < 2; ++q)   \
            _Pragma("unroll") for (int r = 0; r < 4; ++r) { pP_[r * 1024 + 4 * q] = Pr[q][r]; pQ_[r * 256 + 16 * q] = Qr[q][r]; } } \
    } while (0)
    u32x4 w2r = (u32x4){0u, 0u, 0u, 0u}, a2r = w2r; int sprev = -1;
    for (;;) {
        const int s = item & 63, sc = item >> 6, z = s >> 5, b = (s >> 4) & 1, hh = s & 15;
        const float* kkw = P->in[I_KK] + (size_t)j * D + hh * 64 + kq * 8; const float* kap = P->in[I_KA] + (size_t)j * D + hh * 64 + kq * 8; const float* rkp = P->in[I_RK] + (size_t)j * D + hh * 64 + kq * 8;
        const float* w0p = P->in[I_W0] + ((size_t)j * 2 + z) * D + hh * 64; const float* a0p = P->in[I_A0] + ((size_t)j * 2 + z) * D + hh * 64;
        float* bon = (float*)(P->ws + WS_BON) + (size_t)z * T * 16;
        if (s != sprev) { sprev = s;
            w2r = *(const u32x4*)((const bf16_t*)(P->ws + WS_W2P) + (((size_t)j * 2 + z) * D + hh * 64 + pi) * 256 + z * 64 + kq * 8);
            a2r = *(const u32x4*)((const bf16_t*)(P->ws + WS_A2P) + (((size_t)j * 2 + z) * D + hh * 64 + pi) * 256 + z * 64 + kq * 8); }
        bf16_t* GE = (bf16_t*)(P->ws + (z ? WS_AS1 : WS_AS0)); bf16_t* YE = (bf16_t*)(P->ws + (z ? WS_ELOG1 : WS_ELOG0));
        float* pq = (float*)(P->ws + WS_PQ) + ((size_t)(s * NSC + sc) * 2) * 4096;
#pragma nounroll
        for (int c4 = 0; c4 < NCH; ++c4) {
            unsigned long long ch_t[12]; ch_t[11] = CH_AMP >= 0 ? __builtin_amdgcn_s_memrealtime() : 0ull;
            *(LAS u32x4*)(ApA + pi * TP + kq * 8) = cur.tw; *(LAS u32x4*)(ApB + pi * TP + kq * 8) = cur.ta; *(LAS u32x4*)(NrT + pi * TP + kq * 8) = w2r; *(LAS u32x4*)(MrT + pi * TP + kq * 8) = a2r;
            LDS_BARRIER(); CH_STAMP(0);
            {   f32x4 lw[2] = {(f32x4){0.f, 0.f, 0.f, 0.f}, (f32x4){0.f, 0.f, 0.f, 0.f}}, la[2] = {(f32x4){0.f, 0.f, 0.f, 0.f}, (f32x4){0.f, 0.f, 0.f, 0.f}};
                mm64<false, true>(ApA, NrT, lw, wq, wh, lane); mm64<false, true>(ApB, MrT, la, wq, wh, lane);
#pragma unroll
                for (int q = 0; q < 2; ++q) { const int i0 = 16 * (2 * wh + q) + 4 * l4; const f32x4 w04 = *(const f32x4*)(w0p + i0), a04 = *(const f32x4*)(a0p + i0);
#pragma unroll
                    for (int r = 0; r < 4; ++r) { lw[q][r] = -0.60653065971f * sigmoidf_(w04[r] + lw[q][r]); la[q][r] = sigmoidf_(a04[r] + la[q][r]); } }
                st_tile(TaA, lw, wq, wh, lane); st_tile(TaB, la, wq, wh, lane); }
            LDS_BARRIER(); CH_STAMP(1);
            float r8[8], k8[8], e8[8], m8[8], a8[8], kk8[8], c8[8];
            { const u32x4 et = *(const LAS u32x4*)(TaA + pi * TP + kq * 8), at = *(const LAS u32x4*)(TaB + pi * TP + kq * 8); unpack8(cur.r, r8); unpack8(cur.k, k8); unpack8(et, e8); unpack8(at, a8); }
            {   const f32x4 ka0 = *(const f32x4*)(kap), ka1 = *(const f32x4*)(kap + 4), rk0 = *(const f32x4*)(rkp), rk1 = *(const f32x4*)(rkp + 4); float bp = 0.f;
#pragma unroll
                for (int e = 0; e < 8; ++e) { m8[e] = k8[e] * (1.0f + (a8[e] - 1.0f) * (e < 4 ? ka0[e & 3] : ka1[e & 3])); bp += r8[e] * (e < 4 ? rk0[e & 3] : rk1[e & 3]) * m8[e]; }
                bp += shx(bp, 1, lane); bp += shx(bp, 2, lane); bp += shx(bp, 4, lane);
                if (kq == 0) bon[(size_t)scan_row(z, b, sc * SCP + c4 * 64 + pi) * 16 + hh] = bp; }
            { const f32x4 w0 = *(const f32x4*)kkw, w1 = *(const f32x4*)(kkw + 4); float ss = 0.f;
#pragma unroll
              for (int e = 0; e < 8; ++e) { kk8[e] = k8[e] * (e < 4 ? w0[e & 3] : w1[e & 3]); ss += kk8[e] * kk8[e]; }
              ss += shx(ss, 1, lane); ss += shx(ss, 2, lane); ss += shx(ss, 4, lane);
              const float rn = rsqrtf(ss + 1e-12f);
#pragma unroll
              for (int e = 0; e < 8; ++e) { kk8[e] *= rn; c8[e] = e8[e]; } }
#pragma unroll
            for (int d = 8; d < 64; d <<= 1) {
#pragma unroll
                for (int e = 0; e < 8; ++e) { const float t = shup(c8[e], d, lane); c8[e] += lane >= d ? t : 0.f; } }
            if (lane >= 56) { *(LAS f32x4*)(seg + F.wave * 64 + kq * 8) = (f32x4){c8[0], c8[1], c8[2], c8[3]}; *(LAS f32x4*)(seg + F.wave * 64 + kq * 8 + 4) = (f32x4){c8[4], c8[5], c8[6], c8[7]}; }
            if (pend) { SCAN_STAGE_G(); pend = false; }
            LDS_BARRIER(); CH_STAMP(2);
            if (c4 > 0) { st_tile(PrB, Pr, wq, wh, lane); st_tile(QrB, Qr, wq, wh, lane); }
            { float cum[8];
#pragma unroll
              for (int e = 0; e < 8; ++e) cum[e] = c8[e];
              for (int w2 = 0; w2 < F.wave; ++w2) { const f32x4 o0 = *(const LAS f32x4*)(seg + w2 * 64 + kq * 8), o1 = *(const LAS f32x4*)(seg + w2 * 64 + kq * 8 + 4);
#pragma unroll
                  for (int e = 0; e < 8; ++e) cum[e] += e < 4 ? o0[e & 3] : o1[e & 3]; }
              float o[8];
#pragma unroll
              for (int e = 0; e < 8; ++e) o[e] = -kk8[e] * __expf(cum[e] - e8[e]);
              *(LAS u32x4*)(At + pi * TP + kq * 8) = pack8(o);
#pragma unroll
              for (int e = 0; e < 8; ++e) o[e] = r8[e] * __expf(cum[e]);
              *(LAS u32x4*)(Rt + pi * TP + kq * 8) = pack8(o);
              float en[8];
#pragma unroll
              for (int e = 0; e < 8; ++e) { en[e] = __expf(-cum[e]); o[e] = kk8[e] * a8[e] * en[e]; }
              *(LAS u32x4*)(Bt + pi * TP + kq * 8) = pack8(o);
#pragma unroll
              for (int e = 0; e < 8; ++e) o[e] = m8[e] * en[e];
              *(LAS u32x4*)(Kt + pi * TP + kq * 8) = pack8(o);
              *(LAS u32x4*)(Vm + pi * TP + kq * 8) = cur.v;
              if (pi == 63) {
#pragma unroll
                  for (int e = 0; e < 8; ++e) gl[kq * 8 + e] = __expf(cum[e]); } }
            { const int nitem = c4 < NCH - 1 ? item : item + (int)gridDim.x, nc4 = c4 < NCH - 1 ? c4 + 1 : 0; if (nitem < NITEM) scan_load(P, F, nitem, nc4, nxt); }
            LDS_BARRIER(); CH_STAMP(3);
            {   f32x4 aN[2], aM[2], aNr[2], aMr[2];
#pragma unroll
                for (int q = 0; q < 2; ++q) { aN[q] = (f32x4){0.f, 0.f, 0.f, 0.f}; aM[q] = aN[q]; aNr[q] = aN[q]; aMr[q] = aN[q]; }
                mm64<false, true>(At, Bt, aN, wq, wh, lane); mm64<false, true>(At, Kt, aM, wq, wh, lane); mm64<false, true>(Rt, Bt, aNr, wq, wh, lane); mm64<false, true>(Rt, Kt, aMr, wq, wh, lane);
                f32x4 aT[2];
#pragma unroll
                for (int q = 0; q < 2; ++q)
#pragma unroll
                    for (int r = 0; r < 4; ++r) { const int i = 16 * (2 * wh + q) + 4 * l4 + r; const bool lt = i < jrow, le = i <= jrow;
                        aN[q][r] = lt ? aN[q][r] : 0.f; aM[q][r] = lt ? aM[q][r] : 0.f; aNr[q][r] = le ? aNr[q][r] : 0.f; aMr[q][r] = le ? aMr[q][r] : 0.f; aT[q][r] = aN[q][r] + (i == jrow ? 1.f : 0.f); }
                st_tile(NT, aN, wq, wh, lane); st_tile(MT, aM, wq, wh, lane); st_tile(NrT, aNr, wq, wh, lane); st_tile(MrT, aMr, wq, wh, lane); st_tile(TaA, aT, wq, wh, lane);
            }
            LDS_BARRIER(); CH_STAMP(4);
            if (F.wave < 4) { const int o = 16 * F.wave, oc = 16 * ((F.wave + 1) & 3);
                f32x4 p = prod16(NT, o, o, NT, o, o, (f32x4){0.f, 0.f, 0.f, 0.f}, lane); st16(ApA, o, o, p, lane);
                f32x4 t = prod16(TaA, o, o, ApA, o, o, ld16(TaA, o, o, lane), lane); p = prod16(ApA, o, o, ApA, o, o, (f32x4){0.f, 0.f, 0.f, 0.f}, lane);
                st16(TaB, o, o, t, lane); st16(ApA, o, oc, p, lane);
                t = prod16(TaB, o, o, ApA, o, oc, ld16(TaB, o, o, lane), lane); p = prod16(ApA, o, oc, ApA, o, oc, (f32x4){0.f, 0.f, 0.f, 0.f}, lane);
                st16(TaA, o, o, t, lane); st16(ApA, o, o, p, lane);
                t = prod16(TaA, o, o, ApA, o, o, ld16(TaA, o, o, lane), lane); st16(TaB, o, o, t, lane);
#pragma unroll
                for (int jj = 1; jj < 4; ++jj) if (jj > F.wave) { u32x2 zz; asm volatile("v_mov_b32 %0, 0\n\tv_mov_b32 %1, 0" : "=v"(zz.x), "=v"(zz.y)); *(LAS u32x2*)(TaB + (o + l15) * TP + 16 * jj + 4 * l4) = zz; }
            } else { const int wq2 = F.wave - 4;
#pragma unroll
                for (int wh2 = 0; wh2 < 2; ++wh2) { f32x4 x[2] = {(f32x4){0.f, 0.f, 0.f, 0.f}, (f32x4){0.f, 0.f, 0.f, 0.f}}; mm64<true, true>(Vm, MT, x, wq2, wh2, lane); st_tile(ApB, x, wq2, wh2, lane); } }
            LDS_BARRIER(); CH_STAMP(5);
            if (F.wave < 3) { const int jj = F.wave;
#pragma unroll
                for (int i = 1; i < 4; ++i) if (i > jj) { f32x4 e = (f32x4){0.f, 0.f, 0.f, 0.f};
#pragma unroll
                    for (int m = 0; m < 3; ++m) if (m >= jj && m < i) e = prod16(NT, 16 * i, 16 * m, TaB, 16 * m, 16 * jj, e, lane);
                    st16(ApA, 16 * i, 16 * jj, e, lane);
                    st16(TaB, 16 * i, 16 * jj, prod16(TaB, 16 * i, 16 * i, ApA, 16 * i, 16 * jj, (f32x4){0.f, 0.f, 0.f, 0.f}, lane), lane); } }
            LDS_BARRIER(); CH_STAMP(6);
            {   f32x4 w[2] = {(f32x4){0.f, 0.f, 0.f, 0.f}, (f32x4){0.f, 0.f, 0.f, 0.f}}; mm64<true, true>(At, TaB, w, wq, wh, lane); st_tile(ApA, w, wq, wh, lane);
                f32x4 u[2] = {(f32x4){0.f, 0.f, 0.f, 0.f}, (f32x4){0.f, 0.f, 0.f, 0.f}}; mm64<false, true>(ApB, TaB, u, wq, wh, lane); st_tile(TaA, u, wq, wh, lane); }
            LDS_BARRIER(); CH_STAMP(7);
            f32x4 aP[2], aQ[2], aG[2], aY[2];
#pragma unroll
            for (int q = 0; q < 2; ++q) { aP[q] = (f32x4){0.f, 0.f, 0.f, 0.f}; aQ[q] = aP[q]; aG[q] = aP[q]; aY[q] = aP[q]; }
            mm64<false, false>(ApA, Bt, aP, wq, wh, lane);
            mm64<false, false>(TaA, Bt, aQ, wq, wh, lane); mm64<true, false>(Vm, Kt, aQ, wq, wh, lane);
            mm64<false, true>(NrT, ApA, aG, wq, wh, lane);
            mm64<false, true>(NrT, TaA, aY, wq, wh, lane); mm64<false, false>(MrT, Vm, aY, wq, wh, lane);
#pragma unroll
            for (int q = 0; q < 2; ++q) { const int i0 = 16 * (2 * wh + q) + 4 * l4; const f32x4 g4 = *(const LAS f32x4*)(gl + i0);
                const u32x2 rr = *(const LAS u32x2*)(Rt + jrow * TP + i0);
#pragma unroll
                for (int r = 0; r < 4; ++r) { aP[q][r] = (aP[q][r] + (i0 + r == jrow ? 1.f : 0.f)) * g4[r]; aQ[q][r] *= g4[r]; }
                aG[q][0] += bf_lo(rr.x); aG[q][1] += bf_hi(rr.x); aG[q][2] += bf_lo(rr.y); aG[q][3] += bf_hi(rr.y); }
            const size_t orow = (size_t)scan_row(z, b, sc * SCP + c4 * 64 + jrow) * D + hh * 64;
            if (c4 == 0) {
#pragma unroll
                for (int q = 0; q < 2; ++q) { const int i0 = 16 * (2 * wh + q) + 4 * l4;
                    u32x2 o; o.x = cvt_pk_bf16(aG[q][0], aG[q][1]); o.y = cvt_pk_bf16(aG[q][2], aG[q][3]); *(u32x2*)(GE + orow + i0) = o;
                    u32x2 y; y.x = cvt_pk_bf16(aY[q][0], aY[q][1]); y.y = cvt_pk_bf16(aY[q][2], aY[q][3]); *(u32x2*)(YE + orow + i0) = y;
                    Pr[q] = aP[q]; Qr[q] = aQ[q]; }
            } else {
                st_tile(NT, aG, wq, wh, lane); st_tile(MT, aP, wq, wh, lane);
#pragma unroll
                for (int q = 0; q < 2; ++q) { aYp[q] = aY[q]; aQp[q] = aQ[q]; }
                pend = true; orowp = orow; GEp = GE; YEp = YE; pqp = pq; lastp = c4 == NCH - 1;
            }
            cur = nxt;
            if (CH_AMP >= 0) { const unsigned long long d_ = CH_AMP == 0 ? ch_t[0] - ch_t[11] : ch_t[CH_AMP] - ch_t[CH_AMP - 1]; const unsigned long long dl_ = __builtin_amdgcn_s_memrealtime() + 4 * d_; while (__builtin_amdgcn_s_memrealtime() < dl_) __builtin_amdgcn_s_sleep(4); }
            LDS_BARRIER(); CH_STAMP(8);
        }
        item += gridDim.x; if (item >= NITEM) break;
    }
    if (pend) { SCAN_STAGE_G(); }
#undef SCAN_STAGE_G
}
__device__ __forceinline__ void scan_carry_phase(const Frame& F, KP P, int layer) {
    LAS unsigned* cbar = (LAS unsigned*)(F.lds + 8192);
    if (F.tid == 0) *cbar = 0u;
    __syncthreads();
    if (F.wave >= 4) { moe_weights_phase(F, P, layer, blockIdx.x * 4 + (F.wave - 4), gridDim.x * 4, 0, MOE_SPLIT); return; }
    if (blockIdx.x >= 4 * NSCAN) return;
    unsigned ctarget = 0u;
    const int s = blockIdx.x >> 2, vs = blockIdx.x & 3, lane = F.lane, l15 = lane & 15, l4 = lane >> 4, v = 16 * vs + l15, T2 = F.wave;
    const float* pq = (const float*)(P->ws + WS_PQ) + (size_t)s * NSC * 2 * 4096; bf16_t* sst = (bf16_t*)(P->ws + WS_SST) + (size_t)s * NSC * 4096;
    LAS f32x4* exch = (LAS f32x4*)F.lds;
    f32x4 S[4]; float ap[4][16], qp[4][4];
#pragma unroll
    for (int t = 0; t < 4; ++t) S[t] = (f32x4){0.f, 0.f, 0.f, 0.f};
#define CARRY_LOAD(slot, step) do { const float* Pm_ = pq + (size_t)(step) * 2 * 4096; \
        _Pragma("unroll") for (int t2i = 0; t2i < 4; ++t2i) _Pragma("unroll") for (int ri = 0; ri < 4; ++ri) ap[slot][t2i * 4 + ri] = Pm_[(T2 * 16 + t2i * 4 + ri) * 64 + lane];   \
        _Pragma("unroll") for (int r = 0; r < 4; ++r) qp[slot][r] = Pm_[4096 + ((vs * 4 + T2) * 4 + r) * 64 + lane];   } while (0)
#define CARRY_STORE(sc_) do { if (T2 == 0) { float o[16]; \
        _Pragma("unroll") for (int r = 0; r < 4; ++r) _Pragma("unroll") for (int t2 = 0; t2 < 4; ++t2) o[4 * r + t2] = S[t2][r]; \
        u32x4 w0, w1; w0.x = cvt_pk_bf16(o[0], o[1]); w0.y = cvt_pk_bf16(o[2], o[3]); w0.z = cvt_pk_bf16(o[4], o[5]); w0.w = cvt_pk_bf16(o[6], o[7]); \
        w1.x = cvt_pk_bf16(o[8], o[9]); w1.y = cvt_pk_bf16(o[10], o[11]); w1.z = cvt_pk_bf16(o[12], o[13]); w1.w = cvt_pk_bf16(o[14], o[15]); \
        *(u32x4*)(sst + (size_t)(sc_) * 4096 + v * 64 + 16 * l4) = w0; *(u32x4*)(sst + (size_t)(sc_) * 4096 + v * 64 + 16 * l4 + 8) = w1; } } while (0)
    if (T2 < 4) {
#pragma unroll
        for (int u = 0; u < 4; ++u) CARRY_LOAD(u, u);
    }
#pragma nounroll
    for (int sc0 = 0; sc0 < NSC - 1; sc0 += 4) {
#pragma unroll
        for (int u = 0; u < 4; ++u) { const int sc = sc0 + u; if (sc >= NSC - 1) break;
            CARRY_STORE(sc);
            if (T2 < 4) {
                f32x4 nw = (f32x4){qp[u][0], qp[u][1], qp[u][2], qp[u][3]};
#pragma unroll
                for (int t2i = 0; t2i < 4; ++t2i)
#pragma unroll
                    for (int ri = 0; ri < 4; ++ri) nw = __builtin_amdgcn_mfma_f32_16x16x4f32(ap[u][t2i * 4 + ri], S[t2i][ri], nw, 0, 0, 0);
                if (sc + 4 < NSC - 1) CARRY_LOAD(u, sc + 4);
                exch[((u & 1) * 4 + T2) * 64 + lane] = nw;
            }
            { asm volatile("s_waitcnt lgkmcnt(0)" ::: "memory"); if (lane == 0) __hip_atomic_fetch_add(cbar, 1u, __ATOMIC_RELAXED, __HIP_MEMORY_SCOPE_WORKGROUP); ctarget += 4u;
              for (int spin = 0; spin < (1 << 22); ++spin) { const unsigned c = __hip_atomic_load(cbar, __ATOMIC_RELAXED, __HIP_MEMORY_SCOPE_WORKGROUP); if ((int)(c - ctarget) >= 0) break; }
              asm volatile("" ::: "memory"); }
            if (T2 < 4) {
#pragma unroll
                for (int t = 0; t < 4; ++t) S[t] = exch[((u & 1) * 4 + t) * 64 + lane];
            }
        }
    }
    CARRY_STORE(NSC - 1);
#undef CARRY_LOAD
#undef CARRY_STORE
}
__device__ __forceinline__ void scan_out_phase(const Frame& F, KP P, int j) {
    const int lane = F.lane, l15 = lane & 15, l4 = lane >> 4;
    const bf16_t* GE0 = (const bf16_t*)(P->ws + WS_AS0); const bf16_t* GE1 = (const bf16_t*)(P->ws + WS_AS1); const bf16_t* YE0 = (const bf16_t*)(P->ws + WS_ELOG0); const bf16_t* YE1 = (const bf16_t*)(P->ws + WS_ELOG1);
    const bf16_t* Vb = (const bf16_t*)(P->ws + WS_VV); const float* BON = (const float*)(P->ws + WS_BON);
    const bf16_t* GT = (const bf16_t*)(P->ws + WS_GATE); bf16_t* YG = (bf16_t*)(P->ws + WS_YG);
    for (int item = F.gw; item < NBATCH * NH * ((SEQ + CTXL) / 256) * 8; item += F.NGW) {
        const int hh = item & 15, oct = (item >> 4) & 7, b = (item >> 7) & 1, blk = item >> 8;
        const int sc0 = (blk * 256 + 32 * oct) / SCP, sc1 = blk == 0 ? 0 : (SEQ + CTXL - 1 - (blk - 1) * 256 - 32 * oct) / SCP;

        const bf16_t* s0 = (const bf16_t*)(P->ws + WS_SST) + ((size_t)(b * 16 + hh) * NSC + sc0) * 4096; const bf16_t* s1 = (const bf16_t*)(P->ws + WS_SST) + ((size_t)(32 + b * 16 + hh) * NSC + sc1) * 4096;
        bf16x8 sa0[4][2], sa1[4][2];
#pragma unroll
        for (int vt = 0; vt < 4; ++vt) { const int v = 32 * (vt >> 1) + 8 * (l15 >> 2) + 4 * (vt & 1) + (l15 & 3);
#pragma unroll
            for (int ks = 0; ks < 2; ++ks) { sa0[vt][ks] = *(const bf16x8*)(s0 + v * 64 + 32 * ks + 8 * l4); sa1[vt][ks] = *(const bf16x8*)(s1 + v * 64 + 32 * ks + 8 * l4); } }
        f32x4 lg4[4], lb4[4];
#pragma unroll
        for (int q = 0; q < 4; ++q) { const int c = hh * 64 + 32 * (q >> 1) + 8 * l4 + 4 * (q & 1); lg4[q] = *(const f32x4*)(P->in[I_LNG] + (size_t)j * D + c); lb4[q] = *(const f32x4*)(P->in[I_LNB] + (size_t)j * D + c); }
#pragma nounroll
        for (int ti = 0; ti < 2; ++ti) {
            const int tok = (2 * oct + ti) * 16 + l15; const int row = blk == 0 ? TL + b * CTXL + tok : b * SEQ + (blk - 1) * 256 + tok;
            const size_t o = (size_t)row * D + hh * 64;
            const bf16x8 g00 = *(const bf16x8*)(GE0 + o + 8 * l4), g01 = *(const bf16x8*)(GE0 + o + 32 + 8 * l4), g10 = *(const bf16x8*)(GE1 + o + 8 * l4), g11 = *(const bf16x8*)(GE1 + o + 32 + 8 * l4);
            u32x4 la[2], lc[2], lv[2], lgt[2];
#pragma unroll
            for (int h2 = 0; h2 < 2; ++h2) { const size_t oc = o + 32 * h2 + 8 * l4;
                la[h2] = *(const u32x4*)(YE0 + oc); lc[h2] = *(const u32x4*)(YE1 + oc); lv[h2] = *(const u32x4*)(Vb + oc); lgt[h2] = *(const u32x4*)(GT + oc); }
            const float bn = BON[(size_t)row * 16 + hh] + BON[((size_t)T + row) * 16 + hh];
            __builtin_amdgcn_sched_barrier(0);
            f32x4 y[4]; float s = 0.f; f32x4 vv[4], gg[4];
#pragma unroll
            for (int vt = 0; vt < 4; ++vt) { const int h2 = vt >> 1, hf = vt & 1;
                const unsigned ax = hf ? la[h2].z : la[h2].x, ay = hf ? la[h2].w : la[h2].y, cx = hf ? lc[h2].z : lc[h2].x, cy = hf ? lc[h2].w : lc[h2].y;
                const unsigned vx = hf ? lv[h2].z : lv[h2].x, vy = hf ? lv[h2].w : lv[h2].y, gx = hf ? lgt[h2].z : lgt[h2].x, gy = hf ? lgt[h2].w : lgt[h2].y;
                f32x4 acc = (f32x4){bf_lo(ax) + bf_lo(cx), bf_hi(ax) + bf_hi(cx), bf_lo(ay) + bf_lo(cy), bf_hi(ay) + bf_hi(cy)};
                acc = __builtin_amdgcn_mfma_f32_16x16x32_bf16(sa0[vt][0], g00, acc, 0, 0, 0); acc = __builtin_amdgcn_mfma_f32_16x16x32_bf16(sa0[vt][1], g01, acc, 0, 0, 0);
                acc = __builtin_amdgcn_mfma_f32_16x16x32_bf16(sa1[vt][0], g10, acc, 0, 0, 0); acc = __builtin_amdgcn_mfma_f32_16x16x32_bf16(sa1[vt][1], g11, acc, 0, 0, 0);
                y[vt] = acc; s += (acc[0] + acc[1]) + (acc[2] + acc[3]);
                vv[vt] = (f32x4){bf_lo(vx), bf_hi(vx), bf_lo(vy), bf_hi(vy)}; gg[vt] = (f32x4){bf_lo(gx), bf_hi(gx), bf_lo(gy), bf_hi(gy)}; }
            s += shx(s, 16, lane); s += shx(s, 32, lane);
            const float mean = s * (1.0f / 64.0f); float q = 0.f;
#pragma unroll
            for (int vt = 0; vt < 4; ++vt) { const f32x4 d = y[vt] - mean; q += (d[0] * d[0] + d[1] * d[1]) + (d[2] * d[2] + d[3] * d[3]); }
            q += shx(q, 16, lane); q += shx(q, 32, lane);
            const float rstd = rsqrtf(q * (1.0f / 64.0f) + 64e-5f);
#pragma unroll
            for (int h2 = 0; h2 < 2; ++h2) { const f32x4 o0 = (((y[2 * h2] - mean) * rstd) * lg4[2 * h2] + lb4[2 * h2] + vv[2 * h2] * bn) * gg[2 * h2], o1 = (((y[2 * h2 + 1] - mean) * rstd) * lg4[2 * h2 + 1] + lb4[2 * h2 + 1] + vv[2 * h2 + 1] * bn) * gg[2 * h2 + 1];
                u32x4 w; w.x = cvt_pk_bf16(o0[0], o0[1]); w.y = cvt_pk_bf16(o0[2], o0[3]); w.z = cvt_pk_bf16(o1[0], o1[1]); w.w = cvt_pk_bf16(o1[2], o1[3]); *(u32x4*)(YG + o + 32 * h2 + 8 * l4) = w; }
        }
    }
}
__device__ __forceinline__ bool in_range(int lo, int hi, int k) { asm volatile("" : "+s"(lo), "+s"(hi)); return lo <= k && k < hi; }
constexpr int NPH = 46;
template <unsigned KMASK> __global__ void __launch_bounds__(NTHR, 2) mega(Params Pv) {
    extern __shared__ __attribute__((aligned(16))) unsigned char lds_raw[];
    Frame F0; F0.lds = (LAS unsigned char*)lds_raw; F0.tid = threadIdx.x; F0.lane = F0.tid & 63; F0.wave = __builtin_amdgcn_readfirstlane(F0.tid >> 6);
    F0.G = gridDim.x; F0.gw = blockIdx.x * NWAVES + F0.wave; F0.NGW = F0.G * NWAVES;
    LAS unsigned* misc = (LAS unsigned*)(F0.lds + LDS_MISC);
    if (F0.tid < 128) misc[F0.tid] = 0u;
    __syncthreads();
    KP P0 = (KP)__builtin_amdgcn_kernarg_segment_ptr();
    constexpr bool ALL = (KMASK == 0x3ffffu);
    const int lo = ALL ? 0 : P0->ph_lo, hi = ALL ? NPH : P0->ph_hi;
    XcdBarrier bar; bar.bar = (unsigned*)(P0->ws + WS_CTL) + CW_BAR; bar.x = 0; bar.st = (volatile LAS unsigned*)(misc + 8);
    if (ALL || hi - lo > 1) bar = xcd_barrier_post((unsigned*)(P0->ws + WS_CTL) + CW_BAR, (volatile LAS unsigned*)(misc + 8));
#define IN(k) (ALL || in_range(lo, hi, (k)))
#define KIND(q) ((KMASK >> (q)) & 1u)
#define BAR_LEADER (wave_sgpr_now(F0.wave) == 0 && lane_id_now() == 0)
#define SEAM(k) do { if (IN(k) && IN((k) + 1)) { XcdBarrier b2_ = bar; unsigned* bb_ = bar.bar; unsigned bx_ = bar.x; asm volatile("" : "+s"(bb_), "+s"(bx_)); b2_.bar = bb_; b2_.x = bx_; xcd_barrier<false>(b2_, BAR_LEADER); } } while (0)
#define AMP_T0 const unsigned long long amp_t0 = AMP_MASK ? __builtin_amdgcn_s_memrealtime() : 0ull;
#define AMP_END(kind) do { if (AMP_MASK & (1u << (kind))) { const unsigned long long t1_ = __builtin_amdgcn_s_memrealtime(), dl_ = t1_ + AMP_F * (t1_ - amp_t0); while (__builtin_amdgcn_s_memrealtime() < dl_) __builtin_amdgcn_s_sleep(8); } } while (0)
#define PHASE_ENTRY AMP_T0 KP P = P0; asm volatile("" : "+s"(P)); unsigned char* ws = P->ws; unsigned* ctl = (unsigned*)(ws + WS_CTL); (void)ctl; \
    Frame F = F0; { int l_ = lane_id_now(), w_ = F0.wave; asm volatile("" : "+s"(w_)); F.lane = l_; F.wave = w_; F.tid = w_ * 64 + l_; F.gw = blockIdx.x * NWAVES + w_; }

    if constexpr (KIND(0)) if (IN(0)) { PHASE_ENTRY prologue_phase(F, P); AMP_END(0); }
    if (IN(0) && IN(1)) { XcdBarrier b2_ = bar; unsigned* bb_ = bar.bar; unsigned bx_ = bar.x; asm volatile("" : "+s"(bb_), "+s"(bx_)); b2_.bar = bb_; b2_.x = bx_; xcd_barrier<true>(b2_, BAR_LEADER); }
    for (int lp = 0; lp < 2; ++lp) {
        const int pb = 1 + 22 * lp, la = 2 * lp, lb = 2 * lp + 1;
        if constexpr (KIND(1)) if (IN(pb + 0)) { PHASE_ENTRY norm1_phase(F, P, la); AMP_END(1); }
        SEAM(pb + 0);
        if constexpr (KIND(2)) if (IN(pb + 1)) { PHASE_ENTRY
            __syncthreads(); set_desc(F.lds, F.tid, 0, ws + WS_HL, ws + WS_WIN + (size_t)lp * 4096 * D * 2, ws + WS_U, 16, 0, 0, ws + WS_V, P->in[I_GBIN] + (size_t)lp * 4096, ws + WS_STAT); __syncthreads();
            SchedMulti<D, D> S{F.lds, TL / 256, 16, 1};
            EpiGelu E{F.lds};
            pg8::gemm_phase<EpiGelu, SchedMulti<D, D>, false, D, D, D>(F.lds, S, E, F.tid);
            __syncthreads(); { int w_ = F0.wave; asm volatile("" : "+s"(w_)); tail_gelu(F0.lds, w_); }
            AMP_END(2); }
        SEAM(pb + 1);
        if constexpr (KIND(3)) if (IN(pb + 2)) { PHASE_ENTRY spatial_phase(F, P, lp); AMP_END(3); }
        SEAM(pb + 2);
        if constexpr (KIND(4)) if (IN(pb + 3)) { PHASE_ENTRY
            __syncthreads();
            { bf16_t* X = (bf16_t*)(ws + WS_X);
              set_desc(F.lds, F.tid, 0, ws + WS_U, ws + WS_WOUT + (size_t)lp * D * GWID * 2, X, 4, 0, 0, X, X + (size_t)TL * D, P->in[I_GBOUT] + (size_t)lp * D);
              set_desc(F.lds, F.tid, 1, nullptr, nullptr, nullptr, 0, 0, 0, (const float*)(ws + WS_MOD) + (size_t)la * 3 * 6 * D + 2 * D); }
            __syncthreads();
            SchedMulti<GWID, GWID> S{F.lds, TL / 256, 4, 1};
            EpiResid E{F.lds};
            pg8::gemm_phase<EpiResid, SchedMulti<GWID, GWID>, false, GWID, GWID, GWID>(F.lds, S, E, F.tid);
            __syncthreads(); { int w_ = F0.wave; asm volatile("" : "+s"(w_)); tail_resid<GWID>(F0.lds, w_); }
            AMP_END(4); }
        SEAM(pb + 3);
        if constexpr (KIND(5)) if (IN(pb + 4)) { PHASE_ENTRY norm2_phase(F, P, la); AMP_END(5); }
        SEAM(pb + 4);
        if constexpr (KIND(16)) if (IN(pb + 5)) { PHASE_ENTRY
            __syncthreads(); set_desc(F.lds, F.tid, 0, ws + WS_HL, ws + WS_WRT + (size_t)la * 256 * D * 2, nullptr, 1, 0, 0); __syncthreads();
            const int nun = (la == DEPTH - 1 ? TL : T) / 256;
            if ((int)blockIdx.x >= nun) moe_weights_phase(F, P, la, ((int)blockIdx.x - nun) * NWAVES + F.wave, (F.G - nun) * NWAVES, MOE_SPLIT, MOE_ITEMS);
            else { SchedMulti<D, D> S{F.lds, nun, 1, 1};
                EpiLogits E{(float*)(ws + WS_LG)};
                pg8::gemm_phase<EpiLogits, SchedMulti<D, D>, false, D, D, D>(F.lds, S, E, F.tid);
                if (F.G <= nun) { __syncthreads(); moe_weights_phase(F, P, la, F.gw, F.NGW, MOE_SPLIT, MOE_ITEMS); } }
            AMP_END(16); }
        SEAM(pb + 5);
        if constexpr (KIND(17)) if (IN(pb + 6)) { PHASE_ENTRY route_phase(F, P, la); AMP_END(17); }
        SEAM(pb + 6);
        if constexpr (KIND(6)) if (IN(pb + 7)) { PHASE_ENTRY
            moe_tables(F.lds, F.tid, ctl + CW_CNT + la * 64);
            SchedMoE<D, D, true> S{F.lds, (const char*)(ws + WS_HL), (const char*)(ws + WS_WGU), (const int*)(ws + WS_LIST)};
            EpiSiluGate E{(bf16_t*)(ws + WS_H)};
            pg8::gemm_phase<EpiSiluGate, SchedMoE<D, D, true>, true, D, D, D>(F.lds, S, E, F.tid);
            AMP_END(6); }
        SEAM(pb + 7);
        if constexpr (KIND(7)) if (IN(pb + 8)) { PHASE_ENTRY
            moe_tables(F.lds, F.tid, ctl + CW_CNT + la * 64);
            SchedMoE<EHID, EHID, false> S{F.lds, (const char*)(ws + WS_H), (const char*)(ws + WS_WD), (const int*)(ws + WS_LIST)};
            EpiScatter E{F.lds, (bf16_t*)(ws + WS_YB), (const int*)(ws + WS_LIST)};
            pg8::gemm_phase<EpiScatter, SchedMoE<EHID, EHID, false>, false, EHID, EHID, EHID>(F.lds, S, E, F.tid);
            AMP_END(7); }
        SEAM(pb + 8);
        if constexpr (KIND(1)) if (IN(pb + 9)) { PHASE_ENTRY norm1_phase(F, P, lb); AMP_END(1); }
        SEAM(pb + 9);
        if constexpr (KIND(8)) if (IN(pb + 10)) { PHASE_ENTRY mix_phase(F, P, lp); AMP_END(8); }
        SEAM(pb + 10);
        if constexpr (KIND(9)) if (IN(pb + 11)) { PHASE_ENTRY
            __syncthreads();
            set_desc(F.lds, F.tid, 0, ws + WS_XR, ws + WS_WR + (size_t)lp * D * D * 2, ws + WS_R, 4, D, 0);
            set_desc(F.lds, F.tid, 1, ws + WS_XK, ws + WS_WK + (size_t)lp * D * D * 2, ws + WS_K, 4, D, 0);
            set_desc(F.lds, F.tid, 2, ws + WS_XV, ws + WS_WV + (size_t)lp * D * D * 2, ws + WS_VV, 4, D, 0);
            set_desc(F.lds, F.tid, 3, ws + WS_XW, ws + WS_LW1 + (size_t)lp * 256 * D * 2, ws + WS_TW, 1, 256, 1);
            set_desc(F.lds, F.tid, 4, ws + WS_XA, ws + WS_LA1 + (size_t)lp * 256 * D * 2, ws + WS_TA, 1, 256, 0);
            set_desc(F.lds, F.tid, 5, ws + WS_XG, ws + WS_LG1 + (size_t)lp * 256 * D * 2, ws + WS_TG, 1, 256, 2);
            __syncthreads();
            SchedMulti<D, D> S{F.lds, T / 256, 15, 6};
            EpiAct E{F.lds};
            pg8::gemm_phase<EpiAct, SchedMulti<D, D>, false, D, D, D>(F.lds, S, E, F.tid);
            AMP_END(9); }
        SEAM(pb + 11);
        if constexpr (KIND(10)) if (IN(pb + 12)) { PHASE_ENTRY
            __syncthreads(); set_desc(F.lds, F.tid, 0, ws + WS_TG, ws + WS_G2P + (size_t)lp * D * 256 * 2, ws + WS_GATE, 4, D, 0); __syncthreads();
            SchedMulti<256, 256> S{F.lds, T / 256, 4, 1};
            EpiAct E{F.lds};
            pg8::gemm_phase<EpiAct, SchedMulti<256, 256>, false, 256, 256, 256>(F.lds, S, E, F.tid);
            AMP_END(10); }
        SEAM(pb + 12);
        if constexpr (KIND(11)) if (IN(pb + 13)) { PHASE_ENTRY scan_chunk_phase(F, P, lp); AMP_END(11); }
        SEAM(pb + 13);
        if constexpr (KIND(14)) if (IN(pb + 14)) { PHASE_ENTRY scan_carry_phase(F, P, lb); AMP_END(14); }
        SEAM(pb + 14);
        if constexpr (KIND(15)) if (IN(pb + 15)) { PHASE_ENTRY scan_out_phase(F, P, lp); AMP_END(15); }
        SEAM(pb + 15);
        if constexpr (KIND(4)) if (IN(pb + 16)) { PHASE_ENTRY
            __syncthreads();
            { bf16_t* X = (bf16_t*)(ws + WS_X);
              set_desc(F.lds, F.tid, 0, ws + WS_YG, ws + WS_WO + (size_t)lp * D * D * 2, X, 4, 0, 0, X, X + (size_t)TL * D, nullptr);
              set_desc(F.lds, F.tid, 1, nullptr, nullptr, nullptr, 0, 0, 0, (const float*)(ws + WS_MOD) + (size_t)lb * 3 * 6 * D + 2 * D); }
            __syncthreads();
            SchedMulti<D, D> S{F.lds, TL / 256, 4, 1};
            EpiResid E{F.lds};
            pg8::gemm_phase<EpiResid, SchedMulti<D, D>, false, D, D, D>(F.lds, S, E, F.tid);
            if (lb != DEPTH - 1) { __syncthreads(); { int w_ = F0.wave; asm volatile("" : "+s"(w_)); tail_resid<D>(F0.lds, w_); } }
            AMP_END(4); }
        SEAM(pb + 16);
        if constexpr (KIND(5)) if (IN(pb + 17)) { PHASE_ENTRY norm2_phase(F, P, lb); AMP_END(5); }
        SEAM(pb + 17);
        if constexpr (KIND(16)) if (IN(pb + 18)) { PHASE_ENTRY
            __syncthreads(); set_desc(F.lds, F.tid, 0, ws + WS_HL, ws + WS_WRT + (size_t)lb * 256 * D * 2, nullptr, 1, 0, 0); __syncthreads();
            const int nun = (lb == DEPTH - 1 ? TL : T) / 256;
            if ((int)blockIdx.x >= nun) moe_weights_phase(F, P, lb, ((int)blockIdx.x - nun) * NWAVES + F.wave, (F.G - nun) * NWAVES, MOE_SPLIT, MOE_ITEMS);
            else { SchedMulti<D, D> S{F.lds, nun, 1, 1};
                EpiLogits E{(float*)(ws + WS_LG)};
                pg8::gemm_phase<EpiLogits, SchedMulti<D, D>, false, D, D, D>(F.lds, S, E, F.tid);
                if (F.G <= nun) { __syncthreads(); moe_weights_phase(F, P, lb, F.gw, F.NGW, MOE_SPLIT, MOE_ITEMS); } }
            AMP_END(16); }
        SEAM(pb + 18);
        if constexpr (KIND(17)) if (IN(pb + 19)) { PHASE_ENTRY route_phase(F, P, lb); AMP_END(17); }
        SEAM(pb + 19);
        if constexpr (KIND(6)) if (IN(pb + 20)) { PHASE_ENTRY
            moe_tables(F.lds, F.tid, ctl + CW_CNT + lb * 64);
            SchedMoE<D, D, true> S{F.lds, (const char*)(ws + WS_HL), (const char*)(ws + WS_WGU), (const int*)(ws + WS_LIST)};
            EpiSiluGate E{(bf16_t*)(ws + WS_H)};
            pg8::gemm_phase<EpiSiluGate, SchedMoE<D, D, true>, true, D, D, D>(F.lds, S, E, F.tid);
            AMP_END(6); }
        SEAM(pb + 20);
        if constexpr (KIND(7)) if (IN(pb + 21)) { PHASE_ENTRY
            moe_tables(F.lds, F.tid, ctl + CW_CNT + lb * 64);
            SchedMoE<EHID, EHID, false> S{F.lds, (const char*)(ws + WS_H), (const char*)(ws + WS_WD), (const int*)(ws + WS_LIST)};
            EpiScatter E{F.lds, (bf16_t*)(ws + WS_YB), (const int*)(ws + WS_LIST)};
            pg8::gemm_phase<EpiScatter, SchedMoE<EHID, EHID, false>, false, EHID, EHID, EHID>(F.lds, S, E, F.tid);
            AMP_END(7); }
        SEAM(pb + 21);
    }
    if constexpr (KIND(13)) if (IN(45)) { PHASE_ENTRY final_phase(F, P); AMP_END(13); }
#undef IN
#undef KIND
#undef SEAM
#undef PHASE_ENTRY
}

#if !MK_ONE_LAUNCH
static int phase_kind(int ph) { if (ph == 0) return 0; if (ph == 45) return 13; static const int k22[22] = {1, 2, 3, 4, 5, 16, 17, 6, 7, 1, 8, 9, 10, 11, 14, 15, 4, 5, 16, 17, 6, 7}; return k22[(ph - 1) % 22]; }
typedef void (*kern_t)(Params);
template <unsigned KM> static kern_t kern_of() { return mega<KM>; }
static kern_t kind_kernel(int kind) {
    switch (kind) { case 0: return kern_of<1u << 0>(); case 1: return kern_of<1u << 1>(); case 2: return kern_of<1u << 2>(); case 3: return kern_of<1u << 3>(); case 4: return kern_of<1u << 4>();
        case 5: return kern_of<1u << 5>(); case 6: return kern_of<1u << 6>(); case 7: return kern_of<1u << 7>(); case 8: return kern_of<1u << 8>(); case 9: return kern_of<1u << 9>();
        case 10: return kern_of<1u << 10>(); case 11: return kern_of<1u << 11>(); case 12: return kern_of<1u << 12>(); case 14: return kern_of<1u << 14>(); case 15: return kern_of<1u << 15>(); case 16: return kern_of<1u << 16>(); case 17: return kern_of<1u << 17>(); default: return kern_of<1u << 13>(); }
}
#endif
extern "C" void kernel_launch(void* const* d_in, const int* in_sizes, int n_in, void* d_out, int out_size, void* d_ws, size_t ws_size, hipStream_t stream) {
    static int grid = 0;
    if (grid == 0) {
        if (n_in != 42 || out_size != TL * D || ws_size < WS_END) { fprintf(stderr, "kernel_launch: unexpected problem (n_in %d, out %d, ws %zu < %zu)\n", n_in, out_size, ws_size, (size_t)WS_END); grid = -1; return; }
        int dev = 0, cus = 0;
        if (hipGetDevice(&dev) != hipSuccess || hipDeviceGetAttribute(&cus, hipDeviceAttributeMultiprocessorCount, dev) != hipSuccess) { grid = -1; return; }
#if MK_ONE_LAUNCH
        if (hipFuncSetAttribute((const void*)mega<0x3ffffu>, hipFuncAttributeMaxDynamicSharedMemorySize, LDS_BYTES) != hipSuccess) { fprintf(stderr, "kernel_launch: hipFuncSetAttribute failed\n"); grid = -1; return; }
#else
        for (int k = 0; k < 18; ++k) if (hipFuncSetAttribute((const void*)kind_kernel(k), hipFuncAttributeMaxDynamicSharedMemorySize, LDS_BYTES) != hipSuccess) { fprintf(stderr, "kernel_launch: hipFuncSetAttribute failed\n"); grid = -1; return; }
#endif
        (void)hipGetLastError();
        grid = cus;
    }
    if (grid < 0) return;
    (void)hipMemsetAsync((char*)d_ws + WS_CTL, 0, CTL_BYTES, stream);
    Params p{};
    for (int i = 0; i < 42; ++i) p.in[i] = (const float*)d_in[i];
    p.out = (float*)d_out; p.ws = (unsigned char*)d_ws;
#if MK_ONE_LAUNCH
    p.ph_lo = 0; p.ph_hi = NPH;
    hipLaunchKernelGGL(mega<0x3ffffu>, dim3(grid), dim3(NTHR), LDS_BYTES, stream, p);
#else
    for (int ph = 0; ph < NPH; ++ph) { p.ph_lo = ph; p.ph_hi = ph + 1; hipLaunchKernelGGL(kind_kernel(phase_kind(ph)), dim3(grid), dim3(NTHR), LDS_BYTES, stream, p); }
#endif
}
```

```cpp
#include <hip/hip_runtime.h>
#include <cstdio>
#include <cstdint>

#define LAS __attribute__((address_space(3)))
typedef unsigned short bf16_t;
typedef short bf16x8 __attribute__((ext_vector_type(8)));
typedef float f32x4 __attribute__((ext_vector_type(4)));
typedef float f32x2 __attribute__((ext_vector_type(2)));
typedef unsigned u32x4 __attribute__((ext_vector_type(4)));
typedef unsigned u32x2 __attribute__((ext_vector_type(2)));

#ifndef CH_AMP
#define CH_AMP -1
#endif
#define CH_STAMP(i) do { if (CH_AMP >= 0) ch_t[i] = __builtin_amdgcn_s_memrealtime(); } while (0)
#ifndef AMP_MASK
#define AMP_MASK 0u
#endif
#define AMP_F 4
#ifndef MK_ONE_LAUNCH
#define MK_ONE_LAUNCH 1
#endif

constexpr int D = 1024, NBATCH = 2, SEQ = 16384, CTXL = 256, DEPTH = 4;
constexpr int TL = NBATCH * SEQ, TC = NBATCH * CTXL, T = TL + TC;
constexpr int GWID = 2048, NE = 32, EHID = 512, NH = 16, HD = 64;
constexpr int LISTCAP = T;
constexpr int MAXRT = (2 * T) / 256 + NE;
constexpr int NWAVES = 8, NTHR = 512;

constexpr size_t MiB = 1u << 20;
constexpr size_t WS_CTL = 0, CTL_BYTES = 1 * MiB;
constexpr size_t WS_MOD = 1 * MiB;
constexpr size_t WS_WIN = 2 * MiB, WS_WOUT = 18 * MiB, WS_WSP = 26 * MiB, WS_WR = 27 * MiB, WS_WK = 31 * MiB, WS_WV = 35 * MiB, WS_WO = 39 * MiB;
constexpr size_t WS_LW1 = 43 * MiB, WS_LA1 = 44 * MiB, WS_LG1 = 45 * MiB, WS_W2P = 46 * MiB, WS_A2P = 48 * MiB, WS_G2P = 50 * MiB;
constexpr size_t WS_WRT = 52 * MiB;
constexpr size_t WS_WGU = 54 * MiB, WS_WD = 118 * MiB;
constexpr size_t WS_X = 150 * MiB;
constexpr size_t WS_LIST = 280 * MiB, WS_WGT = 285 * MiB;
constexpr size_t WS_HL = 286 * MiB;
constexpr size_t WS_BIG = 351 * MiB;
constexpr size_t SZB = 65 * MiB;
constexpr size_t WS_U = WS_BIG, WS_V = WS_BIG + 2 * SZB, WS_STAT = WS_BIG + 4 * SZB;
constexpr size_t WS_XR = WS_BIG, WS_XW = WS_BIG + SZB, WS_XK = WS_BIG + 2 * SZB, WS_XV = WS_BIG + 3 * SZB, WS_XA = WS_BIG + 4 * SZB, WS_XG = WS_BIG + 5 * SZB;
constexpr size_t WS_R = WS_BIG + 6 * SZB, WS_K = WS_BIG + 7 * SZB, WS_VV = WS_BIG + 8 * SZB;
constexpr size_t WS_TW = WS_BIG + 9 * SZB, WS_TA = WS_TW + 17 * MiB, WS_TG = WS_TA + 17 * MiB;
constexpr size_t WS_ELOG0 = WS_XR, WS_ELOG1 = WS_XW, WS_KM0 = WS_XK, WS_KM1 = WS_XV, WS_AS0 = WS_XA, WS_AS1 = WS_XG;
constexpr size_t WS_GATE = WS_HL, WS_YG = WS_AS0, WS_BON = WS_TG + 17 * MiB;
constexpr size_t WS_H = WS_BIG, WS_YB = WS_BIG + 73 * MiB, WS_LG = WS_BIG + 204 * MiB;
constexpr size_t WS_PQ = WS_KM0;
constexpr size_t WS_SST = 215 * MiB;
constexpr size_t WS_END = WS_BON + 5 * MiB;
static_assert(WS_END <= 1080 * MiB, "workspace map");
constexpr int CW_BAR = 4096;
constexpr int CW_CNT = 16384;

__device__ __forceinline__ int wave_sgpr_now(int w) { asm volatile("" : "+s"(w)); return w; }
__device__ __forceinline__ int lane_id_now() { int l; asm volatile("v_mbcnt_lo_u32_b32 %0, -1, 0\n\tv_mbcnt_hi_u32_b32 %0, -1, %0" : "=v"(l)); return l; }
typedef short v4s __attribute__((ext_vector_type(4)));
#define LDS_BARRIER() asm volatile("s_waitcnt lgkmcnt(0)\n\ts_barrier" ::: "memory")
typedef __bf16 bf16x2_t __attribute__((ext_vector_type(2)));
__device__ __forceinline__ unsigned cvt_pk_bf16(float lo, float hi) { const bf16x2_t v = __builtin_convertvector((f32x2){lo, hi}, bf16x2_t); return __builtin_bit_cast(unsigned, v); }
__device__ __forceinline__ float bf_lo(unsigned u) { return __uint_as_float(u << 16); }
__device__ __forceinline__ float bf_hi(unsigned u) { return __uint_as_float(u & 0xffff0000u); }
__device__ __forceinline__ float bf1(bf16_t b) { return __uint_as_float(((unsigned)b) << 16); }
__device__ __forceinline__ bf16_t f2bf(float f) { return (bf16_t)(cvt_pk_bf16(f, 0.f) & 0x3ffffu); }
__device__ __forceinline__ void unpack8(const u32x4& w, float (&f)[8]) { f[0] = bf_lo(w.x); f[1] = bf_hi(w.x); f[2] = bf_lo(w.y); f[3] = bf_hi(w.y); f[4] = bf_lo(w.z); f[5] = bf_hi(w.z); f[6] = bf_lo(w.w); f[7] = bf_hi(w.w); }
__device__ __forceinline__ u32x4 pack8(const float (&f)[8]) { u32x4 o; o.x = cvt_pk_bf16(f[0], f[1]); o.y = cvt_pk_bf16(f[2], f[3]); o.z = cvt_pk_bf16(f[4], f[5]); o.w = cvt_pk_bf16(f[6], f[7]); return o; }
__device__ __forceinline__ float shx(float v, int m, int lane) { return __int_as_float(__builtin_amdgcn_ds_bpermute((lane ^ m) << 2, __float_as_int(v))); }
__device__ __forceinline__ float shup(float v, int d, int lane) { return __int_as_float(__builtin_amdgcn_ds_bpermute((lane - d) << 2, __float_as_int(v))); }
__device__ __forceinline__ float wave_sum(float v, int lane) {
#pragma unroll
    for (int o = 1; o < 64; o <<= 1) v += shx(v, o, lane);
    return v;
}
__device__ __forceinline__ float sigmoidf_(float x) { return 1.0f / (1.0f + __expf(-x)); }
__device__ __forceinline__ float tanhf_(float x) { const float e = __expf(2.0f * x); return 1.0f - 2.0f / (e + 1.0f); }
__device__ __forceinline__ f32x2 gelu_pk(f32x2 v) {
    const f32x2 av = __builtin_elementwise_abs(v), d = av * 0.2316418882f + 1.0f;
    f32x2 t; t.x = __builtin_amdgcn_rcpf(d.x); t.y = __builtin_amdgcn_rcpf(d.y);
    f32x2 q = t * 0.5307027145f + (-0.7265760135f); q = q * t + 0.7107068705f; q = q * t + (-0.142248368f); q = q * t + 0.127414796f; q = q * t;
    const f32x2 s = (v * v) * (-0.72134752044f);
    f32x2 e; e.x = __builtin_amdgcn_exp2f(s.x); e.y = __builtin_amdgcn_exp2f(s.y);
    const f32x2 m = v * (q * e), r = v - m;
    f32x2 o; o.x = v.x < 0.f ? m.x : r.x; o.y = v.y < 0.f ? m.y : r.y; return o;
}

#define XB_TMO      128
#define XB_XCNT(j)  (256  + 64 * (j))
#define XB_XSUB(j)  (1280 + 64 * (j))
#define XB_XGEN(j)  (2304 + 64 * (j))
#define XB_TOP      3328
#define XB_TOPGEN   3392
#define XCD_BAR_WORDS 3456
#define XB_SPIN_CAP (1u << 18)
__device__ __forceinline__ unsigned xb_ld(unsigned* p)              { return __hip_atomic_load(p, __ATOMIC_RELAXED, __HIP_MEMORY_SCOPE_AGENT); }
__device__ __forceinline__ unsigned xb_add(unsigned* p, unsigned v) { return __hip_atomic_fetch_add(p, v, __ATOMIC_RELAXED, __HIP_MEMORY_SCOPE_AGENT); }
__device__ __forceinline__ unsigned xb_xcc_id() { return (unsigned)__builtin_amdgcn_s_getreg((3 << 11) | 20) & 0xFu; }
#define XB_SPIN(cond, bar) do { unsigned _sp = 0; while (cond) { __builtin_amdgcn_s_sleep(1); \
    if ((++_sp & 255u) == 0u) { if (xb_ld(&(bar)[XB_TMO])) break; if (_sp > XB_SPIN_CAP) { atomicAdd(&(bar)[XB_TMO], 1u); break; } } } } while (0)
struct XcdBarrier { unsigned* bar; unsigned x; volatile LAS unsigned* st; };
__device__ __forceinline__ XcdBarrier xcd_barrier_post(unsigned* bar, volatile LAS unsigned* st) {
    XcdBarrier b; b.bar = bar; b.x = xb_xcc_id(); b.st = st;
    if (threadIdx.x == 0) (void)xb_add(&bar[XB_XCNT(b.x)], 1u);
    return b;
}
__device__ __forceinline__ void xcd_barrier_complete(unsigned* bar, unsigned x, unsigned& nloc, unsigned& nx) {
    const unsigned G = gridDim.x * gridDim.y * gridDim.z;
    unsigned sum, cnt, mine, sp = 0u;
    for (;;) {
        sum = 0u; cnt = 0u; mine = 0u;
#pragma unroll
        for (unsigned j = 0; j < 16; ++j) { const unsigned c = xb_ld(&bar[XB_XCNT(j)]); sum += c; cnt += (c > 0u) ? 1u : 0u; mine = (j == x) ? c : mine; }
        if (sum == G) break;
        __builtin_amdgcn_s_sleep(1);
        if ((++sp & 255u) == 0u) { if (xb_ld(&bar[XB_TMO])) break; if (sp > XB_SPIN_CAP) { atomicAdd(&bar[XB_TMO], 1u); break; } }
    }
    nloc = mine > 0u ? mine : 1u; nx = cnt > 0u ? cnt : 1u;
}
template <bool FIRST> __device__ __forceinline__ void xcd_barrier(const XcdBarrier& b, const bool leader) {
    asm volatile("s_waitcnt vmcnt(0)" ::: "memory");
    __syncthreads();
    if (leader) {
        unsigned* bar = b.bar;
        __builtin_amdgcn_s_waitcnt(0);
        unsigned nloc = b.st[0], nx = b.st[1];
        if constexpr (FIRST) { if (nloc == 0u) { xcd_barrier_complete(bar, b.x, nloc, nx); b.st[0] = nloc; b.st[1] = nx; } }
        const unsigned old = xb_add(&bar[XB_XSUB(b.x)], 1u);
        const unsigned gen = old / nloc;
        if (old + 1u == (gen + 1u) * nloc) {
            __builtin_amdgcn_fence(__ATOMIC_RELEASE, "agent");
            asm volatile("s_waitcnt vmcnt(0)" ::: "memory");
            const unsigned og = xb_add(&bar[XB_TOP], 1u);
            const unsigned tg = og / nx;
            if (og + 1u == (tg + 1u) * nx) xb_add(&bar[XB_TOPGEN], 1u);
            else XB_SPIN(xb_ld(&bar[XB_TOPGEN]) == tg, bar);
            __builtin_amdgcn_fence(__ATOMIC_ACQUIRE, "agent");
            xb_add(&bar[XB_XGEN(b.x)], 1u);
            asm volatile("s_waitcnt vmcnt(0)" ::: "memory");
        } else {
            XB_SPIN(xb_ld(&bar[XB_XGEN(b.x)]) == gen, bar);
            __builtin_amdgcn_fence(__ATOMIC_ACQUIRE, "agent");
            asm volatile("s_waitcnt vmcnt(0)" ::: "memory");
        }
    }
    __syncthreads();
}

constexpr int LDS_MISC = 143360;
constexpr int LDS_DESC = LDS_MISC + 128;
constexpr int LDS_TAB = LDS_MISC + 512;
constexpr int LDS_BYTES = 147456;
namespace pg8 {
constexpr int BM = 256, BK = 64, HALF = 128, HTB = HALF * BK * 2, STAGE_BYTES = 8 * HTB, NXCD = 8, WGM = 8;
__host__ __device__ __forceinline__ int lds_byte(int r, int c) { const int st = (r >> 4) * 2 + (c >> 5), rr = r & 15, cc = c & 31, ob = rr * 64 + cc * 2; return st * 1024 + (ob ^ (((ob >> 9) & 1) << 5)); }
__host__ __device__ __forceinline__ void stage_rc(int b, int& R, int& C) { const int st = b / 1024, sb = b % 1024, swz = sb ^ (((sb >> 9) & 1) << 5); R = (st >> 1) * 16 + swz / 64; C = (st & 1) * 32 + (swz % 64) / 2; }
__host__ __device__ __forceinline__ int perm32(int rho) { const int n = rho >> 4, i = rho & 15; return 8 * (i >> 2) + 4 * n + (i & 3); }
__device__ __forceinline__ int xcd_remap(int L, int nwg) { const int q = nwg / NXCD, r = nwg % NXCD, xcd = L % NXCD, off = L / NXCD; return (xcd < r ? xcd * (q + 1) : r * (q + 1) + (xcd - r) * q) + off; }

struct Unit { int pm, pn, aux; };

template <class Epi, class Sched, bool GATHER, int K, int LDA, int LDB>
__device__ __forceinline__ void gemm_phase(LAS unsigned char* lds, const Sched& S, const Epi& E, const int tid_in) {
    int tid_ = tid_in; asm volatile("" : "+v"(tid_));
    const int tid = tid_, wid = __builtin_amdgcn_readfirstlane(tid >> 6), lane = tid & 63, wr = wid >> 2, wc = wid & 3, fr = lane & 15, fq = lane >> 4;
    constexpr int nt = K / BK;
    unsigned voffA[2], voffB[2];
#pragma unroll
    for (int i = 0; i < 2; ++i) { int R, C; stage_rc(tid * 16 + i * 8192, R, C); const int Rb = Epi::PERM ? ((R & ~31) + perm32(R & 31)) : R;
        voffA[i] = (unsigned)(R * LDA + C) * 2u; voffB[i] = (unsigned)(Rb * LDB + C) * 2u; }
    constexpr size_t kstep = (size_t)(BK * 2);
    constexpr size_t hstepA = GATHER ? (size_t)0 : (size_t)HALF * LDA * 2, hstepB = (size_t)HALF * LDB * 2;
    const unsigned ldsw = (unsigned)wid * 1024u;
    const int aoff = lds_byte(wr * 64 + fr, fq * 8), boff = lds_byte(wc * 32 + fr, fq * 8);
    unsigned gA[2][2], gN[2][2];
#define PG8_SA(b, h) (((b) * 2 + (h)) * HTB)
#define PG8_SB(b, h) ((4 + (b) * 2 + (h)) * HTB)
#define PG8_STAGEB(bufoff, gbase) do { _Pragma("unroll") for (int _i = 0; _i < 2; ++_i) \
        __builtin_amdgcn_global_load_lds((const unsigned*)((const char*)(gbase) + voffB[_i]), (LAS unsigned*)(lds + (bufoff) + ldsw + _i * 8192), 16, 0, 0); } while (0)
#define PG8_STAGEA(bufoff, gbase, h, GV) do { _Pragma("unroll") for (int _i = 0; _i < 2; ++_i) \
        __builtin_amdgcn_global_load_lds((const unsigned*)((const char*)(gbase) + (GATHER ? GV[h][_i] : voffA[_i]) + (h) * hstepA), (LAS unsigned*)(lds + (bufoff) + ldsw + _i * 8192), 16, 0, 0); } while (0)
#define PG8_LDA(dst, b, h) do { _Pragma("unroll") for (int m = 0; m < 4; ++m) _Pragma("unroll") for (int k = 0; k < 2; ++k) dst[m][k] = *(const LAS bf16x8*)(lds + PG8_SA(b, h) + aoff + m * 2048 + k * 1024); } while (0)
#define PG8_LDB(dst, b, h) do { _Pragma("unroll") for (int n = 0; n < 2; ++n) _Pragma("unroll") for (int k = 0; k < 2; ++k) dst[n][k] = *(const LAS bf16x8*)(lds + PG8_SB(b, h) + boff + n * 2048 + k * 1024); } while (0)
#define PG8_MMA(ai, bj, At, Bt) do { __builtin_amdgcn_s_setprio(1); _Pragma("unroll") for (int m = 0; m < 4; ++m) _Pragma("unroll") for (int n = 0; n < 2; ++n) _Pragma("unroll") for (int k = 0; k < 2; ++k) \
        acc[ai][bj][m][n] = __builtin_amdgcn_mfma_f32_16x16x32_bf16(Bt[n][k], At[m][k], acc[ai][bj][m][n], 0, 0, 0); __builtin_amdgcn_s_setprio(0); } while (0)
#define PG8_WAIT_V(n) asm volatile("s_waitcnt vmcnt(" #n ")" ::: "memory")
#define PG8_WAIT_L(n) asm volatile("s_waitcnt lgkmcnt(" #n ")" ::: "memory")
#define PG8_BAR __builtin_amdgcn_s_barrier()
#define PG8_SCHED __builtin_amdgcn_sched_barrier(0)
    Unit cur, nxt; int ui = 0;
    if (!S.next(0, cur)) return;
    f32x4 acc[2][2][4][2];
#pragma unroll
    for (int a = 0; a < 2; ++a)
#pragma unroll
        for (int b = 0; b < 2; ++b)
#pragma unroll
            for (int m = 0; m < 4; ++m)
#pragma unroll
                for (int n = 0; n < 2; ++n) acc[a][b][m][n] = (f32x4){0.f, 0.f, 0.f, 0.f};
    bf16x8 At[4][2], B0[2][2], B1[2][2];
    const char* cA = S.aptr(cur); const char* cB = S.bptr(cur);
    if constexpr (GATHER) { S.gather(cur, tid, gA); }
    PG8_STAGEB(PG8_SB(0, 0), cB); PG8_STAGEB(PG8_SB(0, 1), cB + hstepB); PG8_STAGEA(PG8_SA(0, 0), cA, 0, gA); PG8_STAGEA(PG8_SA(0, 1), cA, 1, gA);
    if (wr == 1) PG8_BAR;
    PG8_WAIT_V(2); PG8_BAR;
    PG8_STAGEB(PG8_SB(1, 0), cB + kstep); PG8_STAGEA(PG8_SA(1, 0), cA + kstep, 0, gA); PG8_STAGEB(PG8_SB(1, 1), cB + hstepB + kstep);
    PG8_WAIT_V(6); PG8_BAR;
    for (;;) {
        const bool has_next = S.next(ui + 1, nxt);
        const char* nA = has_next ? S.aptr(nxt) : cA; const char* nB = has_next ? S.bptr(nxt) : cB;
        if constexpr (GATHER) { if (has_next) S.gather(nxt, tid, gN); else {
#pragma unroll
            for (int h = 0; h < 2; ++h)
#pragma unroll
                for (int i = 0; i < 2; ++i) gN[h][i] = gA[h][i]; } }
#pragma nounroll
        for (int t = 0; t < nt; t += 2) {
            const bool last = (t == nt - 2);
            const char* a1 = cA + (size_t)(t + 1) * kstep;
            const char* a2 = last ? nA : cA + (size_t)(t + 2) * kstep; const char* b2 = last ? nB : cB + (size_t)(t + 2) * kstep;
            const char* a3 = a2 + kstep; const char* b3 = b2 + kstep;
            unsigned g2[2][2];
            if constexpr (GATHER) {
#pragma unroll
                for (int h = 0; h < 2; ++h)
#pragma unroll
                    for (int i = 0; i < 2; ++i) g2[h][i] = last ? gN[h][i] : gA[h][i]; }
            PG8_LDB(B0, 0, 0); PG8_LDB(B1, 0, 1); PG8_SCHED; PG8_LDA(At, 0, 0); PG8_STAGEA(PG8_SA(1, 1), a1, 1, gA);
            PG8_WAIT_V(8); PG8_WAIT_L(0); PG8_BAR; PG8_MMA(0, 0, At, B0); PG8_MMA(0, 1, At, B1); PG8_BAR; PG8_SCHED;
            PG8_LDA(At, 0, 1); PG8_STAGEB(PG8_SB(0, 0), b2); PG8_STAGEB(PG8_SB(0, 1), b2 + hstepB); PG8_STAGEA(PG8_SA(0, 0), a2, 0, g2);
            PG8_WAIT_V(8); PG8_WAIT_L(0); PG8_BAR; PG8_MMA(1, 0, At, B0); PG8_MMA(1, 1, At, B1); PG8_BAR; PG8_SCHED;
            PG8_LDB(B0, 1, 0); PG8_LDB(B1, 1, 1); PG8_SCHED; PG8_LDA(At, 1, 0); PG8_STAGEA(PG8_SA(0, 1), a2, 1, g2);
            PG8_WAIT_V(8); PG8_WAIT_L(0); PG8_BAR; PG8_MMA(0, 0, At, B0); PG8_MMA(0, 1, At, B1); PG8_BAR; PG8_SCHED;
            PG8_LDA(At, 1, 1); PG8_STAGEB(PG8_SB(1, 0), b3); PG8_STAGEB(PG8_SB(1, 1), b3 + hstepB); PG8_STAGEA(PG8_SA(1, 0), a3, 0, g2);
            PG8_WAIT_V(8); PG8_WAIT_L(0); PG8_BAR; PG8_MMA(1, 0, At, B0); PG8_MMA(1, 1, At, B1); PG8_BAR; PG8_SCHED;
        }
        if (wr == 0) PG8_BAR;
        E(acc, cur, wr, wc, fr, fq);
        if (!has_next) break;
#pragma unroll
        for (int a = 0; a < 2; ++a)
#pragma unroll
            for (int b = 0; b < 2; ++b)
#pragma unroll
                for (int m = 0; m < 4; ++m)
#pragma unroll
                    for (int n = 0; n < 2; ++n) acc[a][b][m][n] = (f32x4){0.f, 0.f, 0.f, 0.f};
        cur = nxt; cA = nA; cB = nB; ++ui;
        if constexpr (GATHER) {
#pragma unroll
            for (int h = 0; h < 2; ++h)
#pragma unroll
                for (int i = 0; i < 2; ++i) gA[h][i] = gN[h][i]; }
        if (wr == 1) PG8_BAR;
    }
    PG8_WAIT_V(0);
    PG8_BAR;
#undef PG8_SA
#undef PG8_SB
#undef PG8_STAGEA
#undef PG8_STAGEB
#undef PG8_LDA
#undef PG8_LDB
#undef PG8_MMA
#undef PG8_WAIT_V
#undef PG8_WAIT_L
#undef PG8_BAR
#undef PG8_SCHED
}
}
using pg8::Unit;

__device__ __forceinline__ void set_desc(LAS unsigned char* lds, int tid, int g, const void* A, const void* B, const void* C, int nN, int ldc, int aux, const void* X1 = nullptr, const void* X2 = nullptr, const void* X3 = nullptr) {
    LAS int* d = (LAS int*)(lds + LDS_DESC) + g * 16;
    if (tid == 0) { unsigned long long a = (unsigned long long)A, b = (unsigned long long)B, c = (unsigned long long)C, x1 = (unsigned long long)X1, x2 = (unsigned long long)X2, x3 = (unsigned long long)X3;
        asm volatile("" : "+s"(a), "+s"(b), "+s"(c), "+s"(x1), "+s"(x2), "+s"(x3), "+s"(nN), "+s"(ldc), "+s"(aux));
        d[0] = (int)(unsigned)a; d[1] = (int)(unsigned)(a >> 32); d[2] = (int)(unsigned)b; d[3] = (int)(unsigned)(b >> 32); d[4] = (int)(unsigned)c; d[5] = (int)(unsigned)(c >> 32); d[6] = nN; d[7] = ldc; d[8] = aux;
        d[10] = (int)(unsigned)x1; d[11] = (int)(unsigned)(x1 >> 32); d[12] = (int)(unsigned)x2; d[13] = (int)(unsigned)(x2 >> 32); d[14] = (int)(unsigned)x3; d[15] = (int)(unsigned)(x3 >> 32); }
}
__device__ __forceinline__ int desc_i(LAS unsigned char* lds, int g, int f) { return __builtin_amdgcn_readfirstlane(((LAS const int*)(lds + LDS_DESC))[g * 16 + f]); }
__device__ __forceinline__ const char* desc_p(LAS unsigned char* lds, int g, int f) {
    const unsigned lo = (unsigned)desc_i(lds, g, f), hi = (unsigned)desc_i(lds, g, f + 1); return (const char*)(((unsigned long long)hi << 32) | lo); }
template <int LDA, int LDB>
struct SchedMulti {
    LAS unsigned char* lds; int nM, ntot, ng;
    __device__ __forceinline__ bool next(int i, Unit& u) const {
        const int nwg = nM * ntot; const long L = (long)i * gridDim.x + blockIdx.x; if (L >= nwg) return false;
        const int wgid = pg8::xcd_remap((int)L, nwg);
        const int nig = pg8::WGM * ntot, gid = wgid / nig, fm = gid * pg8::WGM, gsz = (nM - fm) < pg8::WGM ? (nM - fm) : pg8::WGM;
        u.pm = fm + ((wgid % nig) % gsz); int pv = (wgid % nig) / gsz; int g = 0;
        for (int j = 0; j + 1 < ng; ++j) { const int n = desc_i(lds, j, 6); if (pv < n) break; pv -= n; g = j + 1; }
        u.pn = pv; u.aux = g; return true;
    }
    __device__ __forceinline__ const char* aptr(const Unit& u) const { return desc_p(lds, u.aux, 0) + (size_t)u.pm * (512 * LDA); }
    __device__ __forceinline__ const char* bptr(const Unit& u) const { return desc_p(lds, u.aux, 2) + (size_t)u.pn * (512 * LDB); }
};
template <int LDA, int LDB, bool GATHERED>
struct SchedMoE {
    LAS unsigned char* lds; const char* Abase; const char* Bbase; const int* list;
    __device__ __forceinline__ bool next(int i, Unit& u) const {
        LAS const int* tab = (LAS const int*)(lds + LDS_TAB);
        const int nrt = __builtin_amdgcn_readfirstlane(tab[2 * MAXRT + 32]);
        const int nwg = nrt * 4; const long L = (long)i * gridDim.x + blockIdx.x; if (L >= nwg) return false;
        const int wgid = pg8::xcd_remap((int)L, nwg);
        u.pm = wgid >> 2; u.pn = wgid & 3; u.aux = __builtin_amdgcn_readfirstlane(tab[u.pm]); return true;
    }
    __device__ __forceinline__ const char* aptr(const Unit& u) const { return GATHERED ? Abase : Abase + (size_t)u.pm * (512 * LDA); }
    __device__ __forceinline__ const char* bptr(const Unit& u) const { return Bbase + (size_t)u.aux * ((size_t)D * LDB * 2) + (size_t)u.pn * (512 * LDB); }
    __device__ __forceinline__ void gather(const Unit& u, int tid, unsigned (&g)[2][2]) const {
        LAS const int* tab = (LAS const int*)(lds + LDS_TAB);
        const int j0 = __builtin_amdgcn_readfirstlane(tab[MAXRT + u.pm]), cn = __builtin_amdgcn_readfirstlane(tab[2 * MAXRT + u.aux]);
#pragma unroll
        for (int i = 0; i < 2; ++i) { int R, C; pg8::stage_rc(tid * 16 + i * 8192, R, C);
#pragma unroll
            for (int h = 0; h < 2; ++h) { const int slot = j0 + 128 * h + R; const int a = slot < cn ? list[(size_t)u.aux * LISTCAP + slot] : 0;
                g[h][i] = (unsigned)((a >> 1) * LDA + C) * 2u; } }
    }
};
__device__ __forceinline__ void moe_tables(LAS unsigned char* lds, int tid, const unsigned* cnt) {
    LAS int* tab = (LAS int*)(lds + LDS_TAB);
    __syncthreads();
    if (tid < 64) {
        const int e = tid & 31; const bool act = tid < NE;
        const int c = act ? (int)__hip_atomic_load(cnt + e, __ATOMIC_RELAXED, __HIP_MEMORY_SCOPE_AGENT) : 0;
        const int nt = (c + 255) >> 8; int incl = nt;
#pragma unroll
        for (int d = 1; d < 32; d <<= 1) { const int t = __builtin_amdgcn_ds_bpermute((tid >= d ? tid - d : tid) << 2, incl); if (tid >= d) incl += t; }
        if (act) { const int start = incl - nt; tab[2 * MAXRT + e] = c;
#pragma nounroll
            for (int j = 0; j < nt; ++j) { tab[start + j] = e; tab[MAXRT + start + j] = j * 256; }
            if (tid == NE - 1) tab[2 * MAXRT + 32] = incl; }
    }
    __syncthreads();
}

#define EPI_FENCE() asm volatile("" ::: "memory")
struct EpiGelu {
    static constexpr bool PERM = true;
    LAS unsigned char* lds;
    __device__ __forceinline__ void operator()(const f32x4 (&acc)[2][2][4][2], const Unit& u, int wr, int wc, int fr, int fq) const {
        const bool isv = u.pn >= 8; bf16_t* base = (bf16_t*)desc_p(lds, 0, isv ? 10 : 4); const float* bias = (const float*)desc_p(lds, 0, 12); float* stat = (float*)desc_p(lds, 0, 14);
        const int col0 = (u.pn & 7) * 256 + wc * 32 + 8 * fq, bcol0 = u.pn * 256 + wc * 32 + 8 * fq, row0 = u.pm * 256 + wr * 64 + fr;
        f32x4 bv[2][2];
#pragma unroll
        for (int bj = 0; bj < 2; ++bj)
#pragma unroll
            for (int n = 0; n < 2; ++n) bv[bj][n] = *(const f32x4*)(bias + bcol0 + bj * 128 + 4 * n);
#pragma unroll
        for (int ai = 0; ai < 2; ++ai)
#pragma unroll
            for (int m = 0; m < 4; ++m) { const int row = row0 + ai * 128 + m * 16; bf16_t* rowp = base + (size_t)row * GWID + col0; float s = 0.f, q = 0.f;
#pragma unroll
                for (int bj = 0; bj < 2; ++bj) { const f32x4 v0 = acc[ai][bj][m][0] + bv[bj][0], v1 = acc[ai][bj][m][1] + bv[bj][1];
                    const f32x2 a = gelu_pk((f32x2){v0[0], v0[1]}), b = gelu_pk((f32x2){v0[2], v0[3]}), c = gelu_pk((f32x2){v1[0], v1[1]}), d = gelu_pk((f32x2){v1[2], v1[3]});
                    s += ((a.x + a.y) + (b.x + b.y)) + ((c.x + c.y) + (d.x + d.y));
                    q += ((a.x * a.x + a.y * a.y) + (b.x * b.x + b.y * b.y)) + ((c.x * c.x + c.y * c.y) + (d.x * d.x + d.y * d.y));
                    u32x4 w; w.x = cvt_pk_bf16(a.x, a.y); w.y = cvt_pk_bf16(b.x, b.y); w.z = cvt_pk_bf16(c.x, c.y); w.w = cvt_pk_bf16(d.x, d.y);
                    *(u32x4*)(rowp + bj * 128) = w; }
                if (isv) { const int ln_ = 16 * fq + fr; s += shx(s, 16, ln_); s += shx(s, 32, ln_); q += shx(q, 16, ln_); q += shx(q, 32, ln_);
                    if (fq == 0) *(f32x2*)(stat + ((size_t)row * 32 + (u.pn - 8) * 4 + wc) * 2) = (f32x2){s, q}; } }
    }
};
struct EpiResid {
    static constexpr bool PERM = true;
    LAS unsigned char* lds;
    __device__ __forceinline__ void operator()(const f32x4 (&acc)[2][2][4][2], const Unit& u, int wr, int wc, int fr, int fq) const {
        const int mrow = u.pm < 64 ? 0 : (u.pm < 128 ? 1 : 2);
        bf16_t* x = (bf16_t*)desc_p(lds, 0, 4) + (size_t)(u.pm * 256 + wr * 64 + fr) * D + u.pn * 256 + wc * 32 + 8 * fq;
        const float* bias = (const float*)desc_p(lds, 0, 14); const float* gate = (const float*)desc_p(lds, 1, 10) + mrow * 6 * D + u.pn * 256 + wc * 32 + 8 * fq;
        if (bias) bias += u.pn * 256 + wc * 32 + 8 * fq;
#pragma unroll
        for (int bj = 0; bj < 2; ++bj) { const int c = bj * 128;
            const f32x4 b0 = bias ? *(const f32x4*)(bias + c) : (f32x4){0.f, 0.f, 0.f, 0.f}, b1 = bias ? *(const f32x4*)(bias + c + 4) : (f32x4){0.f, 0.f, 0.f, 0.f};
            const f32x4 g0 = *(const f32x4*)(gate + c), g1 = *(const f32x4*)(gate + c + 4);
            u32x4 xw[2][4];
#pragma unroll
            for (int ai = 0; ai < 2; ++ai)
#pragma unroll
                for (int m = 0; m < 4; ++m) xw[ai][m] = *(const u32x4*)(x + (size_t)(ai * 128 + m * 16) * D + c);
#pragma unroll
            for (int ai = 0; ai < 2; ++ai) {
#pragma unroll
                for (int m = 0; m < 4; ++m) { const u32x4 w = xw[ai][m];
                    const f32x4 o0 = (f32x4){bf_lo(w.x), bf_hi(w.x), bf_lo(w.y), bf_hi(w.y)} + g0 * (acc[ai][bj][m][0] + b0), o1 = (f32x4){bf_lo(w.z), bf_hi(w.z), bf_lo(w.w), bf_hi(w.w)} + g1 * (acc[ai][bj][m][1] + b1);
                    u32x4 w2; w2.x = cvt_pk_bf16(o0[0], o0[1]); w2.y = cvt_pk_bf16(o0[2], o0[3]); w2.z = cvt_pk_bf16(o1[0], o1[1]); w2.w = cvt_pk_bf16(o1[2], o1[3]);
                    *(u32x4*)(x + (size_t)(ai * 128 + m * 16) * D + c) = w2; }
                EPI_FENCE(); } }
    }
};
template <int K>
__device__ __forceinline__ void tail_resid(LAS unsigned char* lds, int wave) {
    const int lane = lane_id_now(), fr = lane & 15, q = lane >> 4, tid = wave * 64 + lane;
    constexpr int KW = K / 8, RP = 68;
    LAS float* red = (LAS float*)lds;
    const bf16_t* A = (const bf16_t*)desc_p(lds, 0, 0) + (size_t)TL * K; const bf16_t* W = (const bf16_t*)desc_p(lds, 0, 2);
    bf16_t* X = (bf16_t*)desc_p(lds, 0, 4) + (size_t)TL * D; const float* bias = (const float*)desc_p(lds, 0, 14); const float* gate = (const float*)desc_p(lds, 1, 10) + 2 * 6 * D;
    for (int item = blockIdx.x; item < TC / 16 * 16; item += gridDim.x) {
        const int r0 = (item >> 4) * 16, c0 = (item & 15) * 64;
        const bf16_t* ap = A + (size_t)(r0 + fr) * K + wave * KW + 16 * q;
        const bf16_t* bp = W + (size_t)(c0 + fr) * K + wave * KW + 16 * q;
        f32x4 acc[4];
#pragma unroll
        for (int n = 0; n < 4; ++n) acc[n] = (f32x4){0.f, 0.f, 0.f, 0.f};
#pragma unroll
        for (int kb = 0; kb < KW / 64; ++kb) {
            const bf16x8 a0 = *(const bf16x8*)(ap + kb * 64), a1 = *(const bf16x8*)(ap + kb * 64 + 8);
#pragma unroll
            for (int n = 0; n < 4; ++n) { const bf16x8 b0 = *(const bf16x8*)(bp + (size_t)n * 16 * K + kb * 64), b1 = *(const bf16x8*)(bp + (size_t)n * 16 * K + kb * 64 + 8);
                acc[n] = __builtin_amdgcn_mfma_f32_16x16x32_bf16(a0, b0, acc[n], 0, 0, 0); acc[n] = __builtin_amdgcn_mfma_f32_16x16x32_bf16(a1, b1, acc[n], 0, 0, 0); }
        }
#pragma unroll
        for (int n = 0; n < 4; ++n)
#pragma unroll
            for (int r = 0; r < 4; ++r) red[(wave * 16 + 4 * q + r) * RP + n * 16 + fr] = acc[n][r];
        __syncthreads();
        { const int row = tid >> 5, c2 = 2 * (tid & 31); float s0 = 0.f, s1 = 0.f;
#pragma unroll
          for (int w = 0; w < 8; ++w) { const f32x2 v = *(LAS const f32x2*)(red + (w * 16 + row) * RP + c2); s0 += v.x; s1 += v.y; }
          const int col = c0 + c2; bf16_t* p = X + (size_t)(r0 + row) * D + col; const unsigned xw = *(const unsigned*)p;
          const float b0 = bias ? bias[col] : 0.f, b1 = bias ? bias[col + 1] : 0.f;
          *(unsigned*)p = cvt_pk_bf16(bf_lo(xw) + gate[col] * (s0 + b0), bf_hi(xw) + gate[col + 1] * (s1 + b1)); }
        __syncthreads();
    }
}
__device__ __forceinline__ void tail_gelu(LAS unsigned char* lds, int wave) {
    const int lane = lane_id_now(), fr = lane & 15, q = lane >> 4, tid = wave * 64 + lane;
    constexpr int K = D, KW = K / 8, RP = 260;
    LAS float* red = (LAS float*)lds;
    const bf16_t* A = (const bf16_t*)desc_p(lds, 0, 0) + (size_t)TL * K; const bf16_t* W = (const bf16_t*)desc_p(lds, 0, 2);
    const float* bias = (const float*)desc_p(lds, 0, 12); float* stat = (float*)desc_p(lds, 0, 14);
    for (int item = blockIdx.x; item < TC / 16 * 16; item += gridDim.x) {
        const int r0 = (item >> 4) * 16, c0 = (item & 15) * 256;
        const bf16_t* ap = A + (size_t)(r0 + fr) * K + wave * KW + 16 * q;
        const bf16_t* bp = W + (size_t)(c0 + fr) * K + wave * KW + 16 * q;
        const bf16x8 a0 = *(const bf16x8*)(ap), a1 = *(const bf16x8*)(ap + 8), a2 = *(const bf16x8*)(ap + 64), a3 = *(const bf16x8*)(ap + 72);
#pragma unroll 1
        for (int ng = 0; ng < 4; ++ng) {
            f32x4 acc[4];
#pragma unroll
            for (int n = 0; n < 4; ++n) { const bf16_t* b = bp + (size_t)(ng * 4 + n) * 16 * K;
                const bf16x8 b0 = *(const bf16x8*)(b), b1 = *(const bf16x8*)(b + 8), b2 = *(const bf16x8*)(b + 64), b3 = *(const bf16x8*)(b + 72);
                f32x4 c = (f32x4){0.f, 0.f, 0.f, 0.f};
                c = __builtin_amdgcn_mfma_f32_16x16x32_bf16(a0, b0, c, 0, 0, 0); c = __builtin_amdgcn_mfma_f32_16x16x32_bf16(a1, b1, c, 0, 0, 0);
                c = __builtin_amdgcn_mfma_f32_16x16x32_bf16(a2, b2, c, 0, 0, 0); c = __builtin_amdgcn_mfma_f32_16x16x32_bf16(a3, b3, c, 0, 0, 0); acc[n] = c; }
#pragma unroll
            for (int n = 0; n < 4; ++n)
#pragma unroll
                for (int r = 0; r < 4; ++r) red[(wave * 16 + 4 * q + r) * RP + (ng * 4 + n) * 16 + fr] = acc[n][r];
        }
        __syncthreads();
        { const int row = tid >> 5, c8 = 8 * (tid & 31); f32x4 s0 = (f32x4){0.f, 0.f, 0.f, 0.f}, s1 = s0;
#pragma unroll
          for (int w = 0; w < 8; ++w) { s0 += *(LAS const f32x4*)(red + (w * 16 + row) * RP + c8); s1 += *(LAS const f32x4*)(red + (w * 16 + row) * RP + c8 + 4); }
          const int col = c0 + c8; const bool isv = col >= GWID; bf16_t* base = (bf16_t*)desc_p(lds, 0, isv ? 10 : 4);
          s0 += *(const f32x4*)(bias + col); s1 += *(const f32x4*)(bias + col + 4);
          const f32x2 a = gelu_pk((f32x2){s0[0], s0[1]}), b = gelu_pk((f32x2){s0[2], s0[3]}), c = gelu_pk((f32x2){s1[0], s1[1]}), d = gelu_pk((f32x2){s1[2], s1[3]});
          u32x4 w; w.x = cvt_pk_bf16(a.x, a.y); w.y = cvt_pk_bf16(b.x, b.y); w.z = cvt_pk_bf16(c.x, c.y); w.w = cvt_pk_bf16(d.x, d.y);
          *(u32x4*)(base + (size_t)(TL + r0 + row) * GWID + (col & (GWID - 1))) = w;
          if (isv) { float s = ((a.x + a.y) + (b.x + b.y)) + ((c.x + c.y) + (d.x + d.y)), qq = ((a.x * a.x + a.y * a.y) + (b.x * b.x + b.y * b.y)) + ((c.x * c.x + c.y * c.y) + (d.x * d.x + d.y * d.y));
              s += shx(s, 1, lane); s += shx(s, 2, lane); s += shx(s, 4, lane); qq += shx(qq, 1, lane); qq += shx(qq, 2, lane); qq += shx(qq, 4, lane);
              if ((lane & 7) == 0) *(f32x2*)(stat + ((size_t)(TL + r0 + row) * 32 + ((col - GWID) >> 6)) * 2) = (f32x2){s, qq}; } }
        __syncthreads();
    }
}
struct EpiAct {
    static constexpr bool PERM = true;
    LAS unsigned char* lds;
    __device__ __forceinline__ void operator()(const f32x4 (&acc)[2][2][4][2], const Unit& u, int wr, int wc, int fr, int fq) const {
        bf16_t* C = (bf16_t*)desc_p(lds, u.aux, 4); const int ldc = desc_i(lds, u.aux, 7), act = desc_i(lds, u.aux, 8);
        const int col0 = u.pn * 256 + wc * 32 + 8 * fq, row0 = u.pm * 256 + wr * 64 + fr;
#pragma unroll
        for (int ai = 0; ai < 2; ++ai)
#pragma unroll
            for (int m = 0; m < 4; ++m) { bf16_t* rowp = C + (size_t)(row0 + ai * 128 + m * 16) * ldc + col0;
#pragma unroll
                for (int bj = 0; bj < 2; ++bj) { f32x4 v0 = acc[ai][bj][m][0], v1 = acc[ai][bj][m][1];
                    if (act == 1) {
#pragma unroll
                        for (int j = 0; j < 4; ++j) { v0[j] = tanhf_(v0[j]); v1[j] = tanhf_(v1[j]); } }
                    else if (act == 2) {
#pragma unroll
                        for (int j = 0; j < 4; ++j) { v0[j] = sigmoidf_(v0[j]); v1[j] = sigmoidf_(v1[j]); } }
                    u32x4 w; w.x = cvt_pk_bf16(v0[0], v0[1]); w.y = cvt_pk_bf16(v0[2], v0[3]); w.z = cvt_pk_bf16(v1[0], v1[1]); w.w = cvt_pk_bf16(v1[2], v1[3]);
                    *(u32x4*)(rowp + bj * 128) = w; } }
    }
};
struct EpiLogits {
    static constexpr bool PERM = false;
    float* LG;
    __device__ __forceinline__ void operator()(const f32x4 (&acc)[2][2][4][2], const Unit& u, int wr, int wc, int fr, int fq) const {
        if (wc >= 2) return;
        const int col0 = wc * 32 + 4 * fq, row0 = u.pm * 256 + wr * 64 + fr;
#pragma unroll
        for (int ai = 0; ai < 2; ++ai)
#pragma unroll
            for (int m = 0; m < 4; ++m)
#pragma unroll
                for (int n = 0; n < 2; ++n) *(f32x4*)(LG + (size_t)(row0 + ai * 128 + m * 16) * 64 + col0 + n * 16) = acc[ai][0][m][n] + acc[ai][1][m][n];
    }
};
struct EpiSiluGate {
    static constexpr bool PERM = true;
    bf16_t* H;
    __device__ __forceinline__ void operator()(const f32x4 (&acc)[2][2][4][2], const Unit& u, int wr, int wc, int fr, int fq) const {
        const int col0 = u.pn * 128 + wc * 32 + 8 * fq, row0 = u.pm * 256 + wr * 64 + fr;
#pragma unroll
        for (int ai = 0; ai < 2; ++ai)
#pragma unroll
            for (int m = 0; m < 4; ++m) { f32x4 h0, h1;
#pragma unroll
                for (int j = 0; j < 4; ++j) { const float g0 = acc[ai][0][m][0][j], g1 = acc[ai][0][m][1][j]; h0[j] = g0 * sigmoidf_(g0) * acc[ai][1][m][0][j]; h1[j] = g1 * sigmoidf_(g1) * acc[ai][1][m][1][j]; }
                u32x4 w; w.x = cvt_pk_bf16(h0[0], h0[1]); w.y = cvt_pk_bf16(h0[2], h0[3]); w.z = cvt_pk_bf16(h1[0], h1[1]); w.w = cvt_pk_bf16(h1[2], h1[3]);
                *(u32x4*)(H + (size_t)(row0 + ai * 128 + m * 16) * EHID + col0) = w; }
    }
};
struct EpiScatter {
    static constexpr bool PERM = true;
    LAS unsigned char* lds; bf16_t* YB; const int* list;
    __device__ __forceinline__ void operator()(const f32x4 (&acc)[2][2][4][2], const Unit& u, int wr, int wc, int fr, int fq) const {
        LAS const int* tab = (LAS const int*)(lds + LDS_TAB);
        const int j0 = __builtin_amdgcn_readfirstlane(tab[MAXRT + u.pm]), cn = __builtin_amdgcn_readfirstlane(tab[2 * MAXRT + u.aux]);
        const int col0 = u.pn * 256 + wc * 32 + 8 * fq;
        int aid[2][4];
#pragma unroll
        for (int ai = 0; ai < 2; ++ai)
#pragma unroll
            for (int m = 0; m < 4; ++m) { const int slot = j0 + ai * 128 + wr * 64 + m * 16 + fr; aid[ai][m] = slot < cn ? list[(size_t)u.aux * LISTCAP + slot] : -1; }
#pragma unroll
        for (int ai = 0; ai < 2; ++ai)
#pragma unroll
            for (int m = 0; m < 4; ++m) { const int a = aid[ai][m];
                if (a >= 0) { bf16_t* rowp = YB + (size_t)a * D + col0;
#pragma unroll
                    for (int bj = 0; bj < 2; ++bj) { const f32x4 v0 = acc[ai][bj][m][0], v1 = acc[ai][bj][m][1];
                        u32x4 w; w.x = cvt_pk_bf16(v0[0], v0[1]); w.y = cvt_pk_bf16(v0[2], v0[3]); w.z = cvt_pk_bf16(v1[0], v1[1]); w.w = cvt_pk_bf16(v1[2], v1[3]);
                        *(u32x4*)(rowp + bj * 128) = w; } } }
    }
};

struct Params { const float* in[42]; float* out; unsigned char* ws; int ph_lo, ph_hi; };
enum { I_X = 0, I_C, I_CTX, I_CCTX, I_ADAW, I_ADAB, I_N1G, I_N2G, I_FG, I_GWIN, I_GBIN, I_GLNG, I_GLNB, I_GWS, I_GBS, I_GWOUT, I_GBOUT,
       I_MU, I_WR, I_WK, I_WV, I_WO, I_W0, I_W1, I_W2, I_A0, I_A1, I_A2, I_G1, I_G2, I_KK, I_KA, I_RK, I_LNG, I_LNB,
       I_MWGRP, I_MBGRP, I_MWEXP, I_MBEXP, I_MWG, I_MWU, I_MWD };
struct Frame { LAS unsigned char* lds; int tid, lane, wave, G, gw, NGW; };
typedef const __attribute__((address_space(4))) Params* KP;

constexpr int TRP = 36, TR_SCR = 64 * TRP * 4;
__device__ __forceinline__ void tr_item(const float* W, int N, int kmax, bf16_t* WT, int ldk, int k0, int n0, int drow0, int dk0, LAS float* scr, int lane) {
    const int n4 = lane & 7, kr = lane >> 3; f32x4 v[8];
#pragma unroll
    for (int i = 0; i < 8; ++i) { const int k = k0 + 8 * i + kr; v[i] = k < kmax ? *(const f32x4*)(W + (size_t)k * N + n0 + 4 * n4) : (f32x4){0.f, 0.f, 0.f, 0.f}; }
#pragma unroll
    for (int i = 0; i < 8; ++i) *(LAS f32x4*)(scr + (8 * i + kr) * TRP + 4 * n4) = v[i];
    asm volatile("s_waitcnt lgkmcnt(0)" ::: "memory");
    const int c = lane & 7;
#pragma unroll
    for (int j = 0; j < 4; ++j) { const int n = (lane >> 3) + 8 * j; const LAS float* sp = scr + (8 * c) * TRP + n;
        u32x4 o; o.x = cvt_pk_bf16(sp[0 * TRP], sp[1 * TRP]); o.y = cvt_pk_bf16(sp[2 * TRP], sp[3 * TRP]); o.z = cvt_pk_bf16(sp[4 * TRP], sp[5 * TRP]); o.w = cvt_pk_bf16(sp[6 * TRP], sp[7 * TRP]);
        *(u32x4*)(WT + (size_t)(drow0 + n) * ldk + dk0 + k0 + 8 * c) = o; }
    asm volatile("s_waitcnt lgkmcnt(0)" ::: "memory");
}
constexpr int LDS_JOBS = 80 * 1024, MAXJOBS = 48;
__device__ __forceinline__ void add_job(LAS int* jobs, int& nj, int& nit, const float* src, int N, int kmax, int kpad, bf16_t* dst, int ldk, int drow0, int dk0) {
    LAS int* q = jobs + nj * 12; const unsigned long long a = (unsigned long long)src, d = (unsigned long long)dst;
    q[0] = (int)(unsigned)a; q[1] = (int)(unsigned)(a >> 32); q[2] = (int)(unsigned)d; q[3] = (int)(unsigned)(d >> 32); q[4] = N; q[5] = kmax; q[6] = kpad / 64; q[7] = ldk; q[8] = drow0; q[9] = dk0; q[10] = nit;
    nit += (kpad / 64) * (N / 32); ++nj;
}
__device__ __forceinline__ void zero_fill(const Frame& F, bf16_t* p, size_t nbytes) {
    u32x4* q = (u32x4*)p; const size_t n = nbytes / 16;
    for (size_t i = (size_t)blockIdx.x * NTHR + F.tid; i < n; i += (size_t)F.G * NTHR) q[i] = (u32x4){0u, 0u, 0u, 0u};
}

__device__ __forceinline__ void prologue_phase(const Frame& F, KP P) {
    unsigned char* ws = P->ws;
    {   float* MOD = (float*)(ws + WS_MOD); LAS float* part = (LAS float*)F.lds;
        const float* c = P->in[I_C]; const float* cc = P->in[I_CCTX];
        for (int item = blockIdx.x; item < DEPTH * 24; item += F.G) {
            const int layer = item / 24, col = (item % 24) * 256 + 4 * F.lane; const float* w = P->in[I_ADAW] + (size_t)layer * D * 6 * D + col;
            f32x4 a0 = (f32x4){0.f, 0.f, 0.f, 0.f}, a1 = a0, a2 = a0;
#pragma unroll 8
            for (int i = 0; i < 128; ++i) { const int d = F.wave + 8 * i; const f32x4 wv = *(const f32x4*)(w + (size_t)d * 6 * D);
                const float c0 = c[d], c1 = c[D + d], c2 = cc[d];
                a0 += wv * (c0 * sigmoidf_(c0)); a1 += wv * (c1 * sigmoidf_(c1)); a2 += wv * (c2 * sigmoidf_(c2)); }
            __syncthreads();
            *(LAS f32x4*)(part + (F.wave * 3 + 0) * 256 + 4 * F.lane) = a0; *(LAS f32x4*)(part + (F.wave * 3 + 1) * 256 + 4 * F.lane) = a1; *(LAS f32x4*)(part + (F.wave * 3 + 2) * 256 + 4 * F.lane) = a2;
            __syncthreads();
            if (F.wave < 3) { f32x4 sacc = (f32x4){0.f, 0.f, 0.f, 0.f};
#pragma unroll
                for (int w8 = 0; w8 < 8; ++w8) sacc += *(const LAS f32x4*)(part + (w8 * 3 + F.wave) * 256 + 4 * F.lane);
                *(f32x4*)(MOD + ((size_t)layer * 3 + F.wave) * 6 * D + col) = sacc + *(const f32x4*)(P->in[I_ADAB] + (size_t)layer * 6 * D + col); }
        }
    }
    LAS int* jobs = (LAS int*)(F.lds + LDS_JOBS); LAS int* jtot = jobs + MAXJOBS * 12;
    __syncthreads();
    if (F.tid == 0) { int nj = 0, nit = 0;
        for (int j = 0; j < 2; ++j) {
            add_job(jobs, nj, nit, P->in[I_GWIN] + (size_t)j * D * 4096, 4096, D, D, (bf16_t*)(ws + WS_WIN) + (size_t)j * 4096 * D, D, 0, 0);
            add_job(jobs, nj, nit, P->in[I_GWOUT] + (size_t)j * GWID * D, D, GWID, GWID, (bf16_t*)(ws + WS_WOUT) + (size_t)j * D * GWID, GWID, 0, 0);
            add_job(jobs, nj, nit, P->in[I_WR] + (size_t)j * D * D, D, D, D, (bf16_t*)(ws + WS_WR) + (size_t)j * D * D, D, 0, 0);
            add_job(jobs, nj, nit, P->in[I_WK] + (size_t)j * D * D, D, D, D, (bf16_t*)(ws + WS_WK) + (size_t)j * D * D, D, 0, 0);
            add_job(jobs, nj, nit, P->in[I_WV] + (size_t)j * D * D, D, D, D, (bf16_t*)(ws + WS_WV) + (size_t)j * D * D, D, 0, 0);
            add_job(jobs, nj, nit, P->in[I_WO] + (size_t)j * D * D, D, D, D, (bf16_t*)(ws + WS_WO) + (size_t)j * D * D, D, 0, 0);
            for (int z = 0; z < 2; ++z) {
                add_job(jobs, nj, nit, P->in[I_W1] + ((size_t)j * 2 + z) * D * 64, 64, D, D, (bf16_t*)(ws + WS_LW1) + (size_t)j * 256 * D, D, z * 64, 0);
                add_job(jobs, nj, nit, P->in[I_A1] + ((size_t)j * 2 + z) * D * 64, 64, D, D, (bf16_t*)(ws + WS_LA1) + (size_t)j * 256 * D, D, z * 64, 0);
                add_job(jobs, nj, nit, P->in[I_W2] + ((size_t)j * 2 + z) * 64 * D, D, 64, 64, (bf16_t*)(ws + WS_W2P) + ((size_t)j * 2 + z) * D * 256, 256, 0, z * 64);
                add_job(jobs, nj, nit, P->in[I_A2] + ((size_t)j * 2 + z) * 64 * D, D, 64, 64, (bf16_t*)(ws + WS_A2P) + ((size_t)j * 2 + z) * D * 256, 256, 0, z * 64); }
            add_job(jobs, nj, nit, P->in[I_G1] + (size_t)j * D * 160, 160, D, D, (bf16_t*)(ws + WS_LG1) + (size_t)j * 256 * D, D, 0, 0);
            add_job(jobs, nj, nit, P->in[I_G2] + (size_t)j * 160 * D, D, 160, 256, (bf16_t*)(ws + WS_G2P) + (size_t)j * D * 256, 256, 0, 0); }
        jtot[0] = nj; jtot[1] = nit; }
    __syncthreads();
    {   const int nj = jtot[0], nit = jtot[1]; LAS float* scr = (LAS float*)(F.lds + F.wave * TR_SCR);
        for (int it = F.gw; it < nit; it += F.NGW) {
            int jb = 0; for (int q = 1; q < nj; ++q) if (it >= jobs[q * 12 + 10]) jb = q;
            jb = __builtin_amdgcn_readfirstlane(jb); LAS const int* q = jobs + jb * 12;
            const float* src = (const float*)(((unsigned long long)(unsigned)q[1] << 32) | (unsigned)q[0]); bf16_t* dst = (bf16_t*)(((unsigned long long)(unsigned)q[3] << 32) | (unsigned)q[2]);
            const int N = q[4], nnb = N / 32, r = it - q[10], kb = r / nnb, nb = r % nnb;
            tr_item(src, N, q[5], dst, q[7], kb * 64, nb * 32, q[8] + nb * 32, q[9], scr, F.lane); }
    }
    for (int j = 0; j < 2; ++j) {
        bf16_t* lw1 = (bf16_t*)(ws + WS_LW1) + (size_t)j * 256 * D; bf16_t* la1 = (bf16_t*)(ws + WS_LA1) + (size_t)j * 256 * D; bf16_t* lg1 = (bf16_t*)(ws + WS_LG1) + (size_t)j * 256 * D;
        zero_fill(F, lw1 + 128 * D, (size_t)128 * D * 2); zero_fill(F, la1 + 128 * D, (size_t)128 * D * 2); zero_fill(F, lg1 + 160 * D, (size_t)96 * D * 2);
        for (int z = 0; z < 2; ++z) { bf16_t* w2p = (bf16_t*)(ws + WS_W2P) + ((size_t)j * 2 + z) * D * 256; bf16_t* a2p = (bf16_t*)(ws + WS_A2P) + ((size_t)j * 2 + z) * D * 256;
            for (int idx = blockIdx.x * NTHR + F.tid; idx < D * 32; idx += F.G * NTHR) { const int n = idx >> 5, ch = idx & 31;
                if ((ch >> 3) != z) { *(u32x4*)(w2p + (size_t)n * 256 + ch * 8) = (u32x4){0u, 0u, 0u, 0u}; *(u32x4*)(a2p + (size_t)n * 256 + ch * 8) = (u32x4){0u, 0u, 0u, 0u}; } } }
    }
    {   bf16_t* wrt = (bf16_t*)(ws + WS_WRT);
        for (int idx = blockIdx.x * NTHR + F.tid; idx < DEPTH * 256 * (D / 8); idx += F.G * NTHR) { const int k0 = (idx & 127) * 8, n = (idx >> 7) & 255, layer = idx >> 15;
            const int nn = n & 127; const bool lo = n >= 128; float w[8];
#pragma unroll
            for (int e = 0; e < 8; ++e) { float x = 0.f;
                if (nn < 4) x = P->in[I_MWGRP][((size_t)layer * D + k0 + e) * 4 + nn]; else if (nn < 36) x = P->in[I_MWEXP][((size_t)layer * D + k0 + e) * NE + nn - 4];
                const float hi = bf_lo(cvt_pk_bf16(x, 0.f)); w[e] = lo ? x - hi : x; }
            *(u32x4*)(wrt + ((size_t)layer * 256 + n) * D + k0) = pack8(w); } }
    {   const float* src = P->in[I_GWS]; bf16_t* dst = (bf16_t*)(ws + WS_WSP); const int n8 = 2 * 16 * 128 * 128 / 8;
        for (int i = blockIdx.x * NTHR + F.tid; i < n8; i += F.G * NTHR) { const f32x4 a = *(const f32x4*)(src + (size_t)i * 8), b = *(const f32x4*)(src + (size_t)i * 8 + 4);
            u32x4 o; o.x = cvt_pk_bf16(a[0], a[1]); o.y = cvt_pk_bf16(a[2], a[3]); o.z = cvt_pk_bf16(b[0], b[1]); o.w = cvt_pk_bf16(b[2], b[3]); *(u32x4*)(dst + (size_t)i * 8) = o; } }
}
struct MoeItem { const float* src; bf16_t* dst; int N, kmax, ldk, k0, n0, drow0; };
__device__ __forceinline__ MoeItem moe_item(KP P, unsigned char* ws, int layer, int it) {
    const int e = it / 768, r = it % 768, m = r >> 8, q = r & 255; const size_t so = ((size_t)layer * NE + e) * (size_t)D * EHID; MoeItem I;
    if (m < 2) { const int kb = q >> 4, n0 = (q & 15) * 32;
        I.src = (m == 0 ? P->in[I_MWG] : P->in[I_MWU]) + so; I.N = EHID; I.kmax = D; I.dst = (bf16_t*)(ws + WS_WGU) + (size_t)e * D * D; I.ldk = D; I.k0 = kb * 64; I.n0 = n0; I.drow0 = 256 * (n0 >> 7) + (n0 & 127) + (m == 1 ? 128 : 0); }
    else { const int kb = q >> 5, n0 = (q & 31) * 32;
        I.src = P->in[I_MWD] + so; I.N = D; I.kmax = EHID; I.dst = (bf16_t*)(ws + WS_WD) + (size_t)e * D * EHID; I.ldk = EHID; I.k0 = kb * 64; I.n0 = n0; I.drow0 = n0; }
    return I;
}
__device__ __forceinline__ void tr_load(const MoeItem& I, int lane, f32x4 (&v)[8]) {
    const int n4 = lane & 7, kr = lane >> 3;
#pragma unroll
    for (int i = 0; i < 8; ++i) v[i] = *(const f32x4*)(I.src + (size_t)(I.k0 + 8 * i + kr) * I.N + I.n0 + 4 * n4);
}
__device__ __forceinline__ void tr_store(const MoeItem& I, int lane, const f32x4 (&v)[8], LAS float* scr) {
    const int n4 = lane & 7, kr = lane >> 3;
#pragma unroll
    for (int i = 0; i < 8; ++i) *(LAS f32x4*)(scr + (8 * i + kr) * TRP + 4 * n4) = v[i];
    asm volatile("s_waitcnt lgkmcnt(0)" ::: "memory");
    const int c = lane & 7;
#pragma unroll
    for (int j = 0; j < 4; ++j) { const int n = (lane >> 3) + 8 * j; const LAS float* sp = scr + (8 * c) * TRP + n;
        u32x4 o; o.x = cvt_pk_bf16(sp[0 * TRP], sp[1 * TRP]); o.y = cvt_pk_bf16(sp[2 * TRP], sp[3 * TRP]); o.z = cvt_pk_bf16(sp[4 * TRP], sp[5 * TRP]); o.w = cvt_pk_bf16(sp[6 * TRP], sp[7 * TRP]);
        *(u32x4*)(I.dst + (size_t)(I.drow0 + n) * I.ldk + I.k0 + 8 * c) = o; }
    asm volatile("s_waitcnt lgkmcnt(0)" ::: "memory");
}
constexpr int MOE_ITEMS = NE * 768, MOE_SPLIT = 14336;
__device__ __forceinline__ void moe_weights_phase(const Frame& F, KP P, int layer, int vgw, int vngw, int it0, int it1) {
    unsigned char* ws = P->ws; LAS float* scr = (LAS float*)(F.lds + F.wave * TR_SCR);
    int it = it0 + vgw; f32x4 v[8], vn[8];
    if (it < it1) { const MoeItem I = moe_item(P, ws, layer, it); tr_load(I, F.lane, v); }
#pragma nounroll
    while (it < it1) { const int nx = it + vngw;
        if (nx < it1) { const MoeItem In = moe_item(P, ws, layer, nx); tr_load(In, F.lane, vn); }
        { const MoeItem I = moe_item(P, ws, layer, it); tr_store(I, F.lane, v, scr); }
#pragma unroll
        for (int i = 0; i < 8; ++i) v[i] = vn[i];
        it = nx; }
}

__device__ __forceinline__ void load_xrow(KP P, const Frame& F, int layer, int row, f32x4 (&v)[4]) {
    if (layer == 0) { const float* xr = row < TL ? P->in[I_X] + (size_t)row * D : P->in[I_CTX] + (size_t)(row - TL) * D;
#pragma unroll
        for (int j = 0; j < 4; ++j) v[j] = *(const f32x4*)(xr + 4 * F.lane + 256 * j); }
    else { const bf16_t* xr = (const bf16_t*)(P->ws + WS_X) + (size_t)row * D;
#pragma unroll
        for (int j = 0; j < 4; ++j) { const u32x2 w = *(const u32x2*)(xr + 4 * F.lane + 256 * j); v[j] = (f32x4){bf_lo(w.x), bf_hi(w.x), bf_lo(w.y), bf_hi(w.y)}; } }
}
__device__ __forceinline__ void load_vec4(const float* p, int lane, f32x4 (&r)[4]) {
#pragma unroll
    for (int j = 0; j < 4; ++j) r[j] = *(const f32x4*)(p + 4 * lane + 256 * j);
}
__device__ __forceinline__ void load_combine(KP P, const Frame& F, int layer, int row, bool combine, const f32x4 (&g2r)[4], f32x4 (&v)[4]) {
    load_xrow(P, F, layer, row, v);
    if (combine) {
        const bf16_t* yb = (const bf16_t*)(P->ws + WS_YB); const float* wg = (const float*)(P->ws + WS_WGT);
        const float w0 = wg[2 * row], w1 = wg[2 * row + 1];
#pragma unroll
        for (int j = 0; j < 4; ++j) { const int col = 4 * F.lane + 256 * j; const u32x2 a = *(const u32x2*)(yb + (size_t)(2 * row) * D + col), b = *(const u32x2*)(yb + (size_t)(2 * row + 1) * D + col);
            const f32x4 g = g2r[j];
            v[j][0] += g[0] * (w0 * bf_lo(a.x) + w1 * bf_lo(b.x)); v[j][1] += g[1] * (w0 * bf_hi(a.x) + w1 * bf_hi(b.x));
            v[j][2] += g[2] * (w0 * bf_lo(a.y) + w1 * bf_lo(b.y)); v[j][3] += g[3] * (w0 * bf_hi(a.y) + w1 * bf_hi(b.y)); }
    }
}
__device__ __forceinline__ void norm1_phase(const Frame& F, KP P, int layer) {
    const bool combine = layer > 0; bf16_t* X = (bf16_t*)(P->ws + WS_X); bf16_t* HL = (bf16_t*)(P->ws + WS_HL);
    f32x4 g1r[4], shr[4], scr[4], g2r[4]; load_vec4(P->in[I_N1G] + (size_t)layer * D, F.lane, g1r); int mc = -1;
#pragma unroll
    for (int j = 0; j < 4; ++j) { shr[j] = (f32x4){0.f, 0.f, 0.f, 0.f}; scr[j] = shr[j]; g2r[j] = shr[j]; }
    for (int row = F.gw; row < T; row += F.NGW) {
        const int m = row < TL ? (row >> 14) : 2; f32x4 v[4];
        if (m != mc) { mc = m; const float* mod = (const float*)(P->ws + WS_MOD) + ((size_t)layer * 3 + m) * 6 * D; load_vec4(mod, F.lane, shr); load_vec4(mod + D, F.lane, scr);
            if (combine) load_vec4((const float*)(P->ws + WS_MOD) + ((size_t)(layer - 1) * 3 + m) * 6 * D + 5 * D, F.lane, g2r); }
        load_combine(P, F, layer, row, combine, g2r, v);
        {
#pragma unroll
            for (int j = 0; j < 4; ++j) { u32x2 o; o.x = cvt_pk_bf16(v[j][0], v[j][1]); o.y = cvt_pk_bf16(v[j][2], v[j][3]); *(u32x2*)(X + (size_t)row * D + 4 * F.lane + 256 * j) = o;
                v[j] = (f32x4){bf_lo(o.x), bf_hi(o.x), bf_lo(o.y), bf_hi(o.y)}; } }
        float ss = 0.f;
#pragma unroll
        for (int j = 0; j < 4; ++j) ss += (v[j][0] * v[j][0] + v[j][1] * v[j][1]) + (v[j][2] * v[j][2] + v[j][3] * v[j][3]);
        const float rstd = rsqrtf(wave_sum(ss, F.lane) * (1.0f / D) + 1e-6f);
#pragma unroll
        for (int j = 0; j < 4; ++j) { const int col = 4 * F.lane + 256 * j;
            const f32x4 h = (v[j] * rstd) * g1r[j] * (scr[j] + 1.0f) + shr[j];
            u32x2 o; o.x = cvt_pk_bf16(h[0], h[1]); o.y = cvt_pk_bf16(h[2], h[3]); *(u32x2*)(HL + (size_t)row * D + col) = o; }
    }
}
__device__ __forceinline__ void final_phase(const Frame& F, KP P) {
    f32x4 fgr[4], g2r[4]; load_vec4(P->in[I_FG], F.lane, fgr); int mc = -1;
#pragma unroll
    for (int j = 0; j < 4; ++j) g2r[j] = (f32x4){0.f, 0.f, 0.f, 0.f};
    for (int row = F.gw; row < TL; row += F.NGW) {
        const int m = row >> 14; f32x4 v[4];
        if (m != mc) { mc = m; load_vec4((const float*)(P->ws + WS_MOD) + ((size_t)(DEPTH - 1) * 3 + m) * 6 * D + 5 * D, F.lane, g2r); }
        load_combine(P, F, DEPTH, row, true, g2r, v);
        float ss = 0.f;
#pragma unroll
        for (int j = 0; j < 4; ++j) ss += (v[j][0] * v[j][0] + v[j][1] * v[j][1]) + (v[j][2] * v[j][2] + v[j][3] * v[j][3]);
        const float rstd = rsqrtf(wave_sum(ss, F.lane) * (1.0f / D) + 1e-6f);
#pragma unroll
        for (int j = 0; j < 4; ++j) { const int col = 4 * F.lane + 256 * j; *(f32x4*)(P->out + (size_t)row * D + col) = (v[j] * rstd) * fgr[j]; }
    }
}
__device__ __forceinline__ void norm2_phase(const Frame& F, KP P, int layer) {
    const int ntok = layer == DEPTH - 1 ? TL : T; bf16_t* HL2 = (bf16_t*)(P->ws + WS_HL);
    f32x4 gr[4], shr[4], scr[4]; load_vec4(P->in[I_N2G] + (size_t)layer * D, F.lane, gr); int mc = -1;
#pragma unroll
    for (int j = 0; j < 4; ++j) { shr[j] = (f32x4){0.f, 0.f, 0.f, 0.f}; scr[j] = shr[j]; }
    for (int row = F.gw; row < ntok; row += F.NGW) {
        const int m = row < TL ? (row >> 14) : 2; f32x4 v[4]; load_xrow(P, F, 1, row, v);
        if (m != mc) { mc = m; const float* mod = (const float*)(P->ws + WS_MOD) + ((size_t)layer * 3 + m) * 6 * D; load_vec4(mod + 3 * D, F.lane, shr); load_vec4(mod + 4 * D, F.lane, scr); }
        float ss = 0.f;
#pragma unroll
        for (int j = 0; j < 4; ++j) ss += (v[j][0] * v[j][0] + v[j][1] * v[j][1]) + (v[j][2] * v[j][2] + v[j][3] * v[j][3]);
        const float rstd = rsqrtf(wave_sum(ss, F.lane) * (1.0f / D) + 1e-6f);
#pragma unroll
        for (int j = 0; j < 4; ++j) { const int col = 4 * F.lane + 256 * j;
            const f32x4 h = (v[j] * rstd) * gr[j] * (scr[j] + 1.0f) + shr[j];
            u32x2 o; o.x = cvt_pk_bf16(h[0], h[1]); o.y = cvt_pk_bf16(h[2], h[3]); *(u32x2*)(HL2 + (size_t)row * D + col) = o; }
    }
    if (!(layer & 1)) moe_weights_phase(F, P, layer, F.gw, F.NGW, 0, MOE_SPLIT);
}
__device__ __forceinline__ void route_phase(const Frame& F, KP P, int layer) {
    const int ntok = layer == DEPTH - 1 ? TL : T; const float* LG = (const float*)(P->ws + WS_LG);
    const float* bgrp = P->in[I_MBGRP] + layer * 4; const float* bexp = P->in[I_MBEXP] + layer * NE;
    unsigned* cnt = (unsigned*)(P->ws + WS_CTL) + CW_CNT + layer * 64; int* list = (int*)(P->ws + WS_LIST); float* wgt = (float*)(P->ws + WS_WGT);
    LAS unsigned* lcnt = (LAS unsigned*)F.lds; LAS unsigned* lbase = lcnt + 32;
    for (int r0 = blockIdx.x * NTHR; r0 < ntok; r0 += F.G * NTHR) {
        const int row = r0 + F.tid; const bool act = row < ntok;
        __syncthreads();
        if (F.tid < 32) lcnt[F.tid] = 0u;
        __syncthreads();
        int e0 = 0, e1 = 0; unsigned k0 = 0, k1 = 0;
        if (act) {
            const float* lg = LG + (size_t)row * 64; const f32x4 g4 = *(const f32x4*)lg;
            float ag[4];
#pragma unroll
            for (int i = 0; i < 4; ++i) ag[i] = g4[i] + bgrp[i];
            int grp = 0; float mx = ag[0];
#pragma unroll
            for (int i = 1; i < 4; ++i) if (ag[i] > mx) { mx = ag[i]; grp = i; }
            float den = 0.f;
#pragma unroll
            for (int i = 0; i < 4; ++i) den += __expf(ag[i] - mx);
            const float pg = 1.0f / den;
            const f32x4 e0v = *(const f32x4*)(lg + 4 + 8 * grp), e1v = *(const f32x4*)(lg + 8 + 8 * grp); const f32x4 b0v = *(const f32x4*)(bexp + 8 * grp), b1v = *(const f32x4*)(bexp + 8 * grp + 4);
            float el[8];
#pragma unroll
            for (int i = 0; i < 4; ++i) { el[i] = e0v[i] + b0v[i]; el[4 + i] = e1v[i] + b1v[i]; }
            int i0 = 0; float t0 = el[0];
#pragma unroll
            for (int i = 1; i < 8; ++i) if (el[i] > t0) { t0 = el[i]; i0 = i; }
            int i1 = -1; float t1 = -3.0e38f;
#pragma unroll
            for (int i = 0; i < 8; ++i) if (i != i0 && el[i] > t1) { t1 = el[i]; i1 = i; }
            const float p0 = 1.0f / (1.0f + __expf(t1 - t0));
            wgt[2 * row] = pg * p0; wgt[2 * row + 1] = pg * (1.0f - p0);
            e0 = grp * 8 + i0; e1 = grp * 8 + i1;
            k0 = atomicAdd((unsigned*)(lcnt + e0), 1u); k1 = atomicAdd((unsigned*)(lcnt + e1), 1u);
        }
        __syncthreads();
        if (F.tid < 32) { const unsigned c = lcnt[F.tid]; lbase[F.tid] = c ? atomicAdd(cnt + F.tid, c) : 0u; }
        __syncthreads();
        if (act) { list[(size_t)e0 * LISTCAP + lbase[e0] + k0] = 2 * row; list[(size_t)e1 * LISTCAP + lbase[e1] + k1] = 2 * row + 1; }
    }
}
__device__ __forceinline__ bf16x8 tr_frag136(const LAS bf16_t* M, int k0, int c0, int lane) {
    LAS bf16_t* p = (LAS bf16_t*)M + (k0 + 8 * (lane >> 4) + ((lane & 15) >> 2)) * 136 + c0 + 4 * (lane & 3);
    const v4s lo = __builtin_amdgcn_ds_read_tr16_b64_v4i16((LAS v4s*)p), hi = __builtin_amdgcn_ds_read_tr16_b64_v4i16((LAS v4s*)(p + 4 * 136));
    return (bf16x8){lo[0], lo[1], lo[2], lo[3], hi[0], hi[1], hi[2], hi[3]};
}
__device__ __forceinline__ bf16x8 tr_frag136p(const LAS bf16_t* M, int k0, int dt, int lane) {
    LAS bf16_t* p = (LAS bf16_t*)M + (k0 + 8 * (lane >> 4) + ((lane & 15) >> 2)) * 136 + 32 * (dt >> 1) + 8 * (lane & 3) + 4 * (dt & 1);
    const v4s lo = __builtin_amdgcn_ds_read_tr16_b64_v4i16((LAS v4s*)p), hi = __builtin_amdgcn_ds_read_tr16_b64_v4i16((LAS v4s*)(p + 4 * 136));
    return (bf16x8){lo[0], lo[1], lo[2], lo[3], hi[0], hi[1], hi[2], hi[3]};
}
__device__ __forceinline__ void spatial_phase(const Frame& F, KP P, int j) {
    bf16_t* U = (bf16_t*)(P->ws + WS_U); const bf16_t* V = (const bf16_t*)(P->ws + WS_V); const float* stat = (const float*)(P->ws + WS_STAT);
    const bf16_t* WSP = (const bf16_t*)(P->ws + WS_WSP) + (size_t)j * 16 * 128 * 128;
    const float* lng = P->in[I_GLNG] + (size_t)j * GWID; const float* lnb = P->in[I_GLNB] + (size_t)j * GWID; const float* bs = P->in[I_GBS] + (size_t)j * 16 * 128;
    LAS bf16_t* Wt = (LAS bf16_t*)F.lds; LAS bf16_t* Vn = Wt + 128 * 136;
    LAS float* mu = (LAS float*)(F.lds + 2 * 128 * 136 * 2); LAS float* rs = mu + 128;
    const int l15 = F.lane & 15, l4 = F.lane >> 4;
    constexpr int NUNIT = (T / 128) * 16;
    const int u0 = (int)((long)blockIdx.x * NUNIT / F.G), u1 = (int)((long)(blockIdx.x + 1) * NUNIT / F.G);
#define SP_LOAD(W_, V_, U_, t0_, g_) do { \
        _Pragma("unroll") for (int i = 0; i < 4; ++i) { const int idx = F.tid + NTHR * i, r = idx >> 4, seg = idx & 15; \
            W_[i] = *(const u32x4*)(WSP + ((size_t)(g_) * 128 + r) * 128 + seg * 8); V_[i] = *(const u32x4*)(V + (size_t)((t0_) + r) * GWID + (g_) * 128 + seg * 8); } \
        { const bf16_t* ur_ = U + (size_t)((t0_) + 16 * F.wave + l15) * GWID + (g_) * 128 + 8 * l4; \
          _Pragma("unroll") for (int e = 0; e < 4; ++e) U_[e] = *(const u32x4*)(ur_ + e * 32); } } while (0)
    u32x4 wv[4], vv[4], uu[4];
    if (u0 < u1) SP_LOAD(wv, vv, uu, (u0 >> 4) * 128, u0 & 15);
    int cprev = -1;
#pragma nounroll
    for (int u = u0; u < u1; ++u) { const int c = u >> 4, g = u & 15, t0 = c * 128;
        if (c != cprev) { cprev = c;
            if (F.tid < 128) { const int row = t0 + F.tid; float s = 0.f, q = 0.f;
#pragma unroll
                for (int i = 0; i < 16; ++i) { const f32x4 p = *(const f32x4*)(stat + ((size_t)row * 32 + 2 * i) * 2); s += p[0] + p[2]; q += p[1] + p[3]; }
                const float mean = s * (1.0f / GWID), var = q * (1.0f / GWID) - mean * mean; mu[F.tid] = mean; rs[F.tid] = rsqrtf(var + 1e-5f); } }
        LDS_BARRIER();
#pragma unroll
        for (int i = 0; i < 4; ++i) { const int idx = F.tid + NTHR * i, r = idx >> 4, seg = idx & 15, ch = g * 128 + seg * 8;
            *(LAS u32x4*)(Wt + r * 136 + seg * 8) = wv[i];
            float x[8], o[8]; unpack8(vv[i], x); const float m_ = mu[r], r_ = rs[r];
            const f32x4 g0 = *(const f32x4*)(lng + ch), g1 = *(const f32x4*)(lng + ch + 4), b0 = *(const f32x4*)(lnb + ch), b1 = *(const f32x4*)(lnb + ch + 4);
#pragma unroll
            for (int e = 0; e < 8; ++e) o[e] = (x[e] - m_) * r_ * (e < 4 ? g0[e & 3] : g1[e & 3]) + (e < 4 ? b0[e & 3] : b1[e & 3]);
            *(LAS u32x4*)(Vn + r * 136 + seg * 8) = pack8(o); }
        u32x4 wn[4], vn[4], un[4];
        if (u + 1 < u1) SP_LOAD(wn, vn, un, ((u + 1) >> 4) * 128, (u + 1) & 15);
        LDS_BARRIER();
        bf16x8 bw[4];
#pragma unroll
        for (int ks = 0; ks < 4; ++ks) bw[ks] = *(const LAS bf16x8*)(Wt + (16 * F.wave + l15) * 136 + ks * 32 + 8 * l4);
        const int p = 16 * F.wave + l15; const float bias = bs[g * 128 + p];
        bf16_t* urow = U + (size_t)(t0 + p) * GWID + g * 128 + 8 * l4;
#pragma unroll
        for (int e = 0; e < 4; ++e) { f32x4 a0 = (f32x4){0.f, 0.f, 0.f, 0.f}, a1 = a0;
#pragma unroll
            for (int ks = 0; ks < 4; ++ks) { const bf16x8 f0 = tr_frag136p(Vn, 32 * ks, 2 * e, F.lane), f1 = tr_frag136p(Vn, 32 * ks, 2 * e + 1, F.lane);
                a0 = __builtin_amdgcn_mfma_f32_16x16x32_bf16(f0, bw[ks], a0, 0, 0, 0); a1 = __builtin_amdgcn_mfma_f32_16x16x32_bf16(f1, bw[ks], a1, 0, 0, 0); }
            u32x4 o; o.x = cvt_pk_bf16(bf_lo(uu[e].x) * (a0[0] + bias), bf_hi(uu[e].x) * (a0[1] + bias)); o.y = cvt_pk_bf16(bf_lo(uu[e].y) * (a0[2] + bias), bf_hi(uu[e].y) * (a0[3] + bias));
            o.z = cvt_pk_bf16(bf_lo(uu[e].z) * (a1[0] + bias), bf_hi(uu[e].z) * (a1[1] + bias)); o.w = cvt_pk_bf16(bf_lo(uu[e].w) * (a1[2] + bias), bf_hi(uu[e].w) * (a1[3] + bias));
            *(u32x4*)(urow + e * 32) = o; }
        if (u + 1 < u1) {
#pragma unroll
            for (int i = 0; i < 4; ++i) { wv[i] = wn[i]; vv[i] = vn[i]; uu[i] = un[i]; } }
    }
#undef SP_LOAD
}

__device__ __forceinline__ void mix_phase(const Frame& F, KP P, int j) {
    const bf16_t* HL = (const bf16_t*)(P->ws + WS_HL); const float* mu = P->in[I_MU] + (size_t)j * 6 * D;
    bf16_t* outs[6] = {(bf16_t*)(P->ws + WS_XR), (bf16_t*)(P->ws + WS_XW), (bf16_t*)(P->ws + WS_XK), (bf16_t*)(P->ws + WS_XV), (bf16_t*)(P->ws + WS_XA), (bf16_t*)(P->ws + WS_XG)};
    f32x4 mr[2][6][2];
#pragma unroll
    for (int jj = 0; jj < 2; ++jj)
#pragma unroll
        for (int m = 0; m < 6; ++m) { const int col = 512 * jj + 8 * F.lane; mr[jj][m][0] = *(const f32x4*)(mu + (size_t)m * D + col); mr[jj][m][1] = *(const f32x4*)(mu + (size_t)m * D + col + 4); }
    for (int row = F.gw; row < T; row += F.NGW) {
        bool ok[2]; int src[2]; const bool hi = F.lane >= 32;
        if (row < TL) { const int n = row & (SEQ - 1), gc = n & 63, gr = n >> 6;
            ok[0] = hi ? gc < 63 : gc > 0; src[0] = hi ? row + 1 : row - 1; ok[1] = hi ? gr < 255 : gr > 0; src[1] = hi ? row + 64 : row - 64; }
        else { const int n = (row - TL) & (CTXL - 1); ok[0] = n > 0; src[0] = row - 1; ok[1] = n < CTXL - 1; src[1] = row + 1; }
#pragma unroll
        for (int jj = 0; jj < 2; ++jj) { const int col = 512 * jj + 8 * F.lane;
            const u32x4 h8 = *(const u32x4*)(HL + (size_t)row * D + col); u32x4 s8 = (u32x4){0u, 0u, 0u, 0u};
            if (ok[jj]) s8 = *(const u32x4*)(HL + (size_t)src[jj] * D + col);
            const unsigned hw[4] = {h8.x, h8.y, h8.z, h8.w}, sw[4] = {s8.x, s8.y, s8.z, s8.w}; float h[8], xx[8];
#pragma unroll
            for (int e = 0; e < 8; ++e) { h[e] = (e & 1) ? bf_hi(hw[e >> 1]) : bf_lo(hw[e >> 1]); const float s = (e & 1) ? bf_hi(sw[e >> 1]) : bf_lo(sw[e >> 1]); xx[e] = s - h[e]; }
#pragma unroll
            for (int m = 0; m < 6; ++m) { const f32x4 ma = mr[jj][m][0], mb = mr[jj][m][1];
                u32x4 o; o.x = cvt_pk_bf16(h[0] + xx[0] * ma[0], h[1] + xx[1] * ma[1]); o.y = cvt_pk_bf16(h[2] + xx[2] * ma[2], h[3] + xx[3] * ma[3]);
                o.z = cvt_pk_bf16(h[4] + xx[4] * mb[0], h[5] + xx[5] * mb[1]); o.w = cvt_pk_bf16(h[6] + xx[6] * mb[2], h[7] + xx[7] * mb[3]);
                *(u32x4*)(outs[m] + (size_t)row * D + col) = o; } }
    }
}

constexpr int NCH = 5, SCP = NCH * 64, NSC = (SEQ + CTXL) / SCP, NSCAN = 64, TP = 72, TILE_B = 64 * TP * 2;
static_assert(NSC * SCP == SEQ + CTXL, "super-chunks");
enum { T_AT = 0, T_RT, T_BT, T_KT, T_VM, T_NT, T_MT, T_NRT, T_MRT, T_APA, T_APB, T_TAA, T_TAB, T_PRB, T_QRB, T_NTILE };
constexpr int LDS_GL = T_NTILE * TILE_B, LDS_SEG = LDS_GL + 256;
static_assert(LDS_SEG + 2048 <= LDS_MISC, "scan LDS map");
__device__ __forceinline__ int scan_row(int z, int b, int p) {
    if (p < CTXL) return TL + b * CTXL + (z ? CTXL - 1 - p : p);
    const int q = p - CTXL; return b * SEQ + (z ? SEQ - 1 - q : q);
}
__device__ __forceinline__ LAS bf16_t* stile(LAS unsigned char* lds, int n) { return (LAS bf16_t*)(lds + n * TILE_B); }
__device__ __forceinline__ bf16x8 row_frag(const LAS bf16_t* M, int r0, int k0, int lane) { return *(const LAS bf16x8*)(M + (r0 + (lane & 15)) * TP + k0 + 8 * (lane >> 4)); }
__device__ __forceinline__ bf16x8 tr_frag(const LAS bf16_t* M, int k0, int c0, int lane) {
    LAS bf16_t* p = (LAS bf16_t*)M + (k0 + 8 * (lane >> 4) + ((lane & 15) >> 2)) * TP + c0 + 4 * (lane & 3);
    const v4s lo = __builtin_amdgcn_ds_read_tr16_b64_v4i16((LAS v4s*)p), hi = __builtin_amdgcn_ds_read_tr16_b64_v4i16((LAS v4s*)(p + 4 * TP));
    return (bf16x8){lo[0], lo[1], lo[2], lo[3], hi[0], hi[1], hi[2], hi[3]};
}
template <bool XT, bool YT>
__device__ __forceinline__ void mm64(const LAS bf16_t* X, const LAS bf16_t* Y, f32x4 (&acc)[2], int wq, int wh, int lane) {
#pragma unroll
    for (int ks = 0; ks < 2; ++ks) {
        const bf16x8 b = XT ? tr_frag(X, 32 * ks, 16 * wq, lane) : row_frag(X, 16 * wq, 32 * ks, lane);
#pragma unroll
        for (int q = 0; q < 2; ++q) { const int i0 = 16 * (2 * wh + q);
            const bf16x8 a = YT ? row_frag(Y, i0, 32 * ks, lane) : tr_frag(Y, 32 * ks, i0, lane);
            acc[q] = __builtin_amdgcn_mfma_f32_16x16x32_bf16(a, b, acc[q], 0, 0, 0); }
    }
}
__device__ __forceinline__ void st_tile(LAS bf16_t* Z, const f32x4 (&acc)[2], int wq, int wh, int lane) {
#pragma unroll
    for (int q = 0; q < 2; ++q) { u32x2 o; o.x = cvt_pk_bf16(acc[q][0], acc[q][1]); o.y = cvt_pk_bf16(acc[q][2], acc[q][3]);
        *(LAS u32x2*)(Z + (16 * wq + (lane & 15)) * TP + 16 * (2 * wh + q) + 4 * (lane >> 4)) = o; }
}
__device__ __forceinline__ void ld_tile(const LAS bf16_t* Z, f32x4 (&acc)[2], int wq, int wh, int lane) {
#pragma unroll
    for (int q = 0; q < 2; ++q) { const u32x2 o = *(const LAS u32x2*)(Z + (16 * wq + (lane & 15)) * TP + 16 * (2 * wh + q) + 4 * (lane >> 4));
        acc[q] = (f32x4){bf_lo(o.x), bf_hi(o.x), bf_lo(o.y), bf_hi(o.y)}; }
}
__device__ __forceinline__ f32x4 prod16(const LAS bf16_t* X, int xr, int xc, const LAS bf16_t* Y, int yr, int yc, f32x4 acc, int lane) {
    bf16x8 b = *(const LAS bf16x8*)(X + (xr + (lane & 15)) * TP + xc + 8 * (lane >> 4)); bf16x8 a = tr_frag(Y, yr, yc, lane);
    if ((lane >> 4) >= 2) { b = (bf16x8){0, 0, 0, 0, 0, 0, 0, 0}; a = (bf16x8){0, 0, 0, 0, 0, 0, 0, 0}; }
    return __builtin_amdgcn_mfma_f32_16x16x32_bf16(a, b, acc, 0, 0, 0);
}
__device__ __forceinline__ void st16(LAS bf16_t* Z, int zr, int zc, f32x4 acc, int lane) { u32x2 o; o.x = cvt_pk_bf16(acc[0], acc[1]); o.y = cvt_pk_bf16(acc[2], acc[3]); *(LAS u32x2*)(Z + (zr + (lane & 15)) * TP + zc + 4 * (lane >> 4)) = o; }
__device__ __forceinline__ f32x4 ld16(const LAS bf16_t* Z, int zr, int zc, int lane) { const u32x2 o = *(const LAS u32x2*)(Z + (zr + (lane & 15)) * TP + zc + 4 * (lane >> 4)); return (f32x4){bf_lo(o.x), bf_hi(o.x), bf_lo(o.y), bf_hi(o.y)}; }
struct ChunkRegs { u32x4 r, k, v, tw, ta; };
__device__ __forceinline__ void scan_load(KP P, const Frame& F, int item, int c4, ChunkRegs& R) {
    const int s = item & 63, sc = item >> 6, z = s >> 5, b = (s >> 4) & 1, hh = s & 15;
    const size_t row = (size_t)scan_row(z, b, sc * SCP + c4 * 64 + (F.tid >> 3)); const size_t o = row * D + hh * 64 + (F.tid & 7) * 8, o2 = row * 256 + z * 64 + (F.tid & 7) * 8;
    R.r = *(const u32x4*)((const bf16_t*)(P->ws + WS_R) + o); R.k = *(const u32x4*)((const bf16_t*)(P->ws + WS_K) + o); R.v = *(const u32x4*)((const bf16_t*)(P->ws + WS_VV) + o);
    R.tw = *(const u32x4*)((const bf16_t*)(P->ws + WS_TW) + o2); R.ta = *(const u32x4*)((const bf16_t*)(P->ws + WS_TA) + o2);
}
__device__ __forceinline__ void scan_chunk_phase(const Frame& F, KP P, int j) {
    LAS unsigned char* lds = F.lds;
    LAS bf16_t* At = stile(lds, T_AT); LAS bf16_t* Rt = stile(lds, T_RT); LAS bf16_t* Bt = stile(lds, T_BT); LAS bf16_t* Kt = stile(lds, T_KT); LAS bf16_t* Vm = stile(lds, T_VM);
    LAS bf16_t* NT = stile(lds, T_NT); LAS bf16_t* MT = stile(lds, T_MT); LAS bf16_t* NrT = stile(lds, T_NRT); LAS bf16_t* MrT = stile(lds, T_MRT);
    LAS bf16_t* ApA = stile(lds, T_APA); LAS bf16_t* ApB = stile(lds, T_APB); LAS bf16_t* TaA = stile(lds, T_TAA); LAS bf16_t* TaB = stile(lds, T_TAB);
    LAS bf16_t* PrB = stile(lds, T_PRB); LAS bf16_t* QrB = stile(lds, T_QRB);
    LAS float* gl = (LAS float*)(lds + LDS_GL); LAS float* seg = (LAS float*)(lds + LDS_SEG);
    const int lane = F.lane, wq = F.wave & 3, wh = F.wave >> 2, l15 = lane & 15, l4 = lane >> 4;
    const int pi = F.tid >> 3, kq = F.tid & 7;
    const int jrow = 16 * wq + l15;
    const int NITEM = NSCAN * NSC;
    int item = blockIdx.x; if (item >= NITEM) return;
    ChunkRegs cur, nxt; scan_load(P, F, item, 0, cur); nxt = cur;
    f32x4 Pr[2], Qr[2], aYp[2], aQp[2];
#pragma unroll
    for (int q = 0; q < 2; ++q) { Pr[q] = (f32x4){0.f, 0.f, 0.f, 0.f}; Qr[q] = Pr[q]; aYp[q] = Pr[q]; aQp[q] = Pr[q]; }
    bool pend = false; size_t orowp = 0; bf16_t* GEp = nullptr; bf16_t* YEp = nullptr; float* pqp = nullptr; bool lastp = false;
#define SCAN_STAGE_G() do { \
        f32x4 ge[2] = {(f32x4){0.f, 0.f, 0.f, 0.f}, (f32x4){0.f, 0.f, 0.f, 0.f}}; \
        mm64<false, true>(NT, PrB, ge, wq, wh, lane); mm64<false, true>(NT, QrB, aYp, wq, wh, lane); \
        f32x4 pn[2] = {(f32x4){0.f, 0.f, 0.f, 0.f}, (f32x4){0.f, 0.f, 0.f, 0.f}}; \
        mm64<false, false>(PrB, MT, pn, wq, wh, lane); mm64<false, false>(QrB, MT, aQp, wq, wh, lane); \
        _Pragma("unroll") for (int q = 0; q < 2; ++q) { const int i0 = 16 * (2 * wh + q) + 4 * l4; \
            u32x2 o; o.x = cvt_pk_bf16(ge[q][0], ge[q][1]); o.y = cvt_pk_bf16(ge[q][2], ge[q][3]); *(u32x2*)(GEp + orowp + i0) = o; \
            u32x2 y; y.x = cvt_pk_bf16(aYp[q][0], aYp[q][1]); y.y = cvt_pk_bf16(aYp[q][2], aYp[q][3]); *(u32x2*)(YEp + orowp + i0) = y; \
            Pr[q] = pn[q]; Qr[q] = aQp[q]; } \
        if (lastp) { const int ln_ = lane_id_now(), l15_ = ln_ & 15, l4_ = ln_ >> 4;   \
            float* pP_ = pqp + ((l15_ & 3) * 4 + (l15_ >> 2)) * 64 + wq * 16 + 8 * wh + l4_; float* pQ_ = pqp + 4096 + (wq * 16 + l4_) * 64 + 32 * wh + l15_; \
            _Pragma("unroll") for (int q = 0; q < 2; ++q)   \
            _Pragma("unroll") for (int r = 0; r < 4; ++r) { pP_[r * 1024 + 4 * q] = Pr[q][r]; pQ_[r * 256 + 16 * q] = Qr[q][r]; } } \
    } while (0)
    u32x4 w2r = (u32x4){0u, 0u, 0u, 0u}, a2r = w2r; int sprev = -1;
    for (;;) {
        const int s = item & 63, sc = item >> 6, z = s >> 5, b = (s >> 4) & 1, hh = s & 15;
        const float* kkw = P->in[I_KK] + (size_t)j * D + hh * 64 + kq * 8; const float* kap = P->in[I_KA] + (size_t)j * D + hh * 64 + kq * 8; const float* rkp = P->in[I_RK] + (size_t)j * D + hh * 64 + kq * 8;
        const float* w0p = P->in[I_W0] + ((size_t)j * 2 + z) * D + hh * 64; const float* a0p = P->in[I_A0] + ((size_t)j * 2 + z) * D + hh * 64;
        float* bon = (float*)(P->ws + WS_BON) + (size_t)z * T * 16;
        if (s != sprev) { sprev = s;
            w2r = *(const u32x4*)((const bf16_t*)(P->ws + WS_W2P) + (((size_t)j * 2 + z) * D + hh * 64 + pi) * 256 + z * 64 + kq * 8);
            a2r = *(const u32x4*)((const bf16_t*)(P->ws + WS_A2P) + (((size_t)j * 2 + z) * D + hh * 64 + pi) * 256 + z * 64 + kq * 8); }
        bf16_t* GE = (bf16_t*)(P->ws + (z ? WS_AS1 : WS_AS0)); bf16_t* YE = (bf16_t*)(P->ws + (z ? WS_ELOG1 : WS_ELOG0));
        float* pq = (float*)(P->ws + WS_PQ) + ((size_t)(s * NSC + sc) * 2) * 4096;
#pragma nounroll
        for (int c4 = 0; c4 < NCH; ++c4) {
            unsigned long long ch_t[12]; ch_t[11] = CH_AMP >= 0 ? __builtin_amdgcn_s_memrealtime() : 0ull;
            *(LAS u32x4*)(ApA + pi * TP + kq * 8) = cur.tw; *(LAS u32x4*)(ApB + pi * TP + kq * 8) = cur.ta; *(LAS u32x4*)(NrT + pi * TP + kq * 8) = w2r; *(LAS u32x4*)(MrT + pi * TP + kq * 8) = a2r;
            LDS_BARRIER(); CH_STAMP(0);
            {   f32x4 lw[2] = {(f32x4){0.f, 0.f, 0.f, 0.f}, (f32x4){0.f, 0.f, 0.f, 0.f}}, la[2] = {(f32x4){0.f, 0.f, 0.f, 0.f}, (f32x4){0.f, 0.f, 0.f, 0.f}};
                mm64<false, true>(ApA, NrT, lw, wq, wh, lane); mm64<false, true>(ApB, MrT, la, wq, wh, lane);
#pragma unroll
                for (int q = 0; q < 2; ++q) { const int i0 = 16 * (2 * wh + q) + 4 * l4; const f32x4 w04 = *(const f32x4*)(w0p + i0), a04 = *(const f32x4*)(a0p + i0);
#pragma unroll
                    for (int r = 0; r < 4; ++r) { lw[q][r] = -0.60653065971f * sigmoidf_(w04[r] + lw[q][r]); la[q][r] = sigmoidf_(a04[r] + la[q][r]); } }
                st_tile(TaA, lw, wq, wh, lane); st_tile(TaB, la, wq, wh, lane); }
            LDS_BARRIER(); CH_STAMP(1);
            float r8[8], k8[8], e8[8], m8[8], a8[8], kk8[8], c8[8];
            { const u32x4 et = *(const LAS u32x4*)(TaA + pi * TP + kq * 8), at = *(const LAS u32x4*)(TaB + pi * TP + kq * 8); unpack8(cur.r, r8); unpack8(cur.k, k8); unpack8(et, e8); unpack8(at, a8); }
            {   const f32x4 ka0 = *(const f32x4*)(kap), ka1 = *(const f32x4*)(kap + 4), rk0 = *(const f32x4*)(rkp), rk1 = *(const f32x4*)(rkp + 4); float bp = 0.f;
#pragma unroll
                for (int e = 0; e < 8; ++e) { m8[e] = k8[e] * (1.0f + (a8[e] - 1.0f) * (e < 4 ? ka0[e & 3] : ka1[e & 3])); bp += r8[e] * (e < 4 ? rk0[e & 3] : rk1[e & 3]) * m8[e]; }
                bp += shx(bp, 1, lane); bp += shx(bp, 2, lane); bp += shx(bp, 4, lane);
                if (kq == 0) bon[(size_t)scan_row(z, b, sc * SCP + c4 * 64 + pi) * 16 + hh] = bp; }
            { const f32x4 w0 = *(const f32x4*)kkw, w1 = *(const f32x4*)(kkw + 4); float ss = 0.f;
#pragma unroll
              for (int e = 0; e < 8; ++e) { kk8[e] = k8[e] * (e < 4 ? w0[e & 3] : w1[e & 3]); ss += kk8[e] * kk8[e]; }
              ss += shx(ss, 1, lane); ss += shx(ss, 2, lane); ss += shx(ss, 4, lane);
              const float rn = rsqrtf(ss + 1e-12f);
#pragma unroll
              for (int e = 0; e < 8; ++e) { kk8[e] *= rn; c8[e] = e8[e]; } }
#pragma unroll
            for (int d = 8; d < 64; d <<= 1) {
#pragma unroll
                for (int e = 0; e < 8; ++e) { const float t = shup(c8[e], d, lane); c8[e] += lane >= d ? t : 0.f; } }
            if (lane >= 56) { *(LAS f32x4*)(seg + F.wave * 64 + kq * 8) = (f32x4){c8[0], c8[1], c8[2], c8[3]}; *(LAS f32x4*)(seg + F.wave * 64 + kq * 8 + 4) = (f32x4){c8[4], c8[5], c8[6], c8[7]}; }
            if (pend) { SCAN_STAGE_G(); pend = false; }
            LDS_BARRIER(); CH_STAMP(2);
            if (c4 > 0) { st_tile(PrB, Pr, wq, wh, lane); st_tile(QrB, Qr, wq, wh, lane); }
            { float cum[8];
#pragma unroll
              for (int e = 0; e < 8; ++e) cum[e] = c8[e];
              for (int w2 = 0; w2 < F.wave; ++w2) { const f32x4 o0 = *(const LAS f32x4*)(seg + w2 * 64 + kq * 8), o1 = *(const LAS f32x4*)(seg + w2 * 64 + kq * 8 + 4);
#pragma unroll
                  for (int e = 0; e < 8; ++e) cum[e] += e < 4 ? o0[e & 3] : o1[e & 3]; }
              float o[8];
#pragma unroll
              for (int e = 0; e < 8; ++e) o[e] = -kk8[e] * __expf(cum[e] - e8[e]);
              *(LAS u32x4*)(At + pi * TP + kq * 8) = pack8(o);
#pragma unroll
              for (int e = 0; e < 8; ++e) o[e] = r8[e] * __expf(cum[e]);
              *(LAS u32x4*)(Rt + pi * TP + kq * 8) = pack8(o);
              float en[8];
#pragma unroll
              for (int e = 0; e < 8; ++e) { en[e] = __expf(-cum[e]); o[e] = kk8[e] * a8[e] * en[e]; }
              *(LAS u32x4*)(Bt + pi * TP + kq * 8) = pack8(o);
#pragma unroll
              for (int e = 0; e < 8; ++e) o[e] = m8[e] * en[e];
              *(LAS u32x4*)(Kt + pi * TP + kq * 8) = pack8(o);
              *(LAS u32x4*)(Vm + pi * TP + kq * 8) = cur.v;
              if (pi == 63) {
#pragma unroll
                  for (int e = 0; e < 8; ++e) gl[kq * 8 + e] = __expf(cum[e]); } }
            { const int nitem = c4 < NCH - 1 ? item : item + (int)gridDim.x, nc4 = c4 < NCH - 1 ? c4 + 1 : 0; if (nitem < NITEM) scan_load(P, F, nitem, nc4, nxt); }
            LDS_BARRIER(); CH_STAMP(3);
            {   f32x4 aN[2], aM[2], aNr[2], aMr[2];
#pragma unroll
                for (int q = 0; q < 2; ++q) { aN[q] = (f32x4){0.f, 0.f, 0.f, 0.f}; aM[q] = aN[q]; aNr[q] = aN[q]; aMr[q] = aN[q]; }
                mm64<false, true>(At, Bt, aN, wq, wh, lane); mm64<false, true>(At, Kt, aM, wq, wh, lane); mm64<false, true>(Rt, Bt, aNr, wq, wh, lane); mm64<false, true>(Rt, Kt, aMr, wq, wh, lane);
                f32x4 aT[2];
#pragma unroll
                for (int q = 0; q < 2; ++q)
#pragma unroll
                    for (int r = 0; r < 4; ++r) { const int i = 16 * (2 * wh + q) + 4 * l4 + r; const bool lt = i < jrow, le = i <= jrow;
                        aN[q][r] = lt ? aN[q][r] : 0.f; aM[q][r] = lt ? aM[q][r] : 0.f; aNr[q][r] = le ? aNr[q][r] : 0.f; aMr[q][r] = le ? aMr[q][r] : 0.f; aT[q][r] = aN[q][r] + (i == jrow ? 1.f : 0.f); }
                st_tile(NT, aN, wq, wh, lane); st_tile(MT, aM, wq, wh, lane); st_tile(NrT, aNr, wq, wh, lane); st_tile(MrT, aMr, wq, wh, lane); st_tile(TaA, aT, wq, wh, lane);
            }
            LDS_BARRIER(); CH_STAMP(4);
            if (F.wave < 4) { const int o = 16 * F.wave, oc = 16 * ((F.wave + 1) & 3);
                f32x4 p = prod16(NT, o, o, NT, o, o, (f32x4){0.f, 0.f, 0.f, 0.f}, lane); st16(ApA, o, o, p, lane);
                f32x4 t = prod16(TaA, o, o, ApA, o, o, ld16(TaA, o, o, lane), lane); p = prod16(ApA, o, o, ApA, o, o, (f32x4){0.f, 0.f, 0.f, 0.f}, lane);
                st16(TaB, o, o, t, lane); st16(ApA, o, oc, p, lane);
                t = prod16(TaB, o, o, ApA, o, oc, ld16(TaB, o, o, lane), lane); p = prod16(ApA, o, oc, ApA, o, oc, (f32x4){0.f, 0.f, 0.f, 0.f}, lane);
                st16(TaA, o, o, t, lane); st16(ApA, o, o, p, lane);
                t = prod16(TaA, o, o, ApA, o, o, ld16(TaA, o, o, lane), lane); st16(TaB, o, o, t, lane);
#pragma unroll
                for (int jj = 1; jj < 4; ++jj) if (jj > F.wave) { u32x2 zz; asm volatile("v_mov_b32 %0, 0\n\tv_mov_b32 %1, 0" : "=v"(zz.x), "=v"(zz.y)); *(LAS u32x2*)(TaB + (o + l15) * TP + 16 * jj + 4 * l4) = zz; }
            } else { const int wq2 = F.wave - 4;
#pragma unroll
                for (int wh2 = 0; wh2 < 2; ++wh2) { f32x4 x[2] = {(f32x4){0.f, 0.f, 0.f, 0.f}, (f32x4){0.f, 0.f, 0.f, 0.f}}; mm64<true, true>(Vm, MT, x, wq2, wh2, lane); st_tile(ApB, x, wq2, wh2, lane); } }
            LDS_BARRIER(); CH_STAMP(5);
            if (F.wave < 3) { const int jj = F.wave;
#pragma unroll
                for (int i = 1; i < 4; ++i) if (i > jj) { f32x4 e = (f32x4){0.f, 0.f, 0.f, 0.f};
#pragma unroll
                    for (int m = 0; m < 3; ++m) if (m >= jj && m < i) e = prod16(NT, 16 * i, 16 * m, TaB, 16 * m, 16 * jj, e, lane);
                    st16(ApA, 16 * i, 16 * jj, e, lane);
                    st16(TaB, 16 * i, 16 * jj, prod16(TaB, 16 * i, 16 * i, ApA, 16 * i, 16 * jj, (f32x4){0.f, 0.f, 0.f, 0.f}, lane), lane); } }
            LDS_BARRIER(); CH_STAMP(6);
            {   f32x4 w[2] = {(f32x4){0.f, 0.f, 0.f, 0.f}, (f32x4){0.f, 0.f, 0.f, 0.f}}; mm64<true, true>(At, TaB, w, wq, wh, lane); st_tile(ApA, w, wq, wh, lane);
                f32x4 u[2] = {(f32x4){0.f, 0.f, 0.f, 0.f}, (f32x4){0.f, 0.f, 0.f, 0.f}}; mm64<false, true>(ApB, TaB, u, wq, wh, lane); st_tile(TaA, u, wq, wh, lane); }
            LDS_BARRIER(); CH_STAMP(7);
            f32x4 aP[2], aQ[2], aG[2], aY[2];
#pragma unroll
            for (int q = 0; q < 2; ++q) { aP[q] = (f32x4){0.f, 0.f, 0.f, 0.f}; aQ[q] = aP[q]; aG[q] = aP[q]; aY[q] = aP[q]; }
            mm64<false, false>(ApA, Bt, aP, wq, wh, lane);
            mm64<false, false>(TaA, Bt, aQ, wq, wh, lane); mm64<true, false>(Vm, Kt, aQ, wq, wh, lane);
            mm64<false, true>(NrT, ApA, aG, wq, wh, lane);
            mm64<false, true>(NrT, TaA, aY, wq, wh, lane); mm64<false, false>(MrT, Vm, aY, wq, wh, lane);
#pragma unroll
            for (int q = 0; q < 2; ++q) { const int i0 = 16 * (2 * wh + q) + 4 * l4; const f32x4 g4 = *(const LAS f32x4*)(gl + i0);
                const u32x2 rr = *(const LAS u32x2*)(Rt + jrow * TP + i0);
#pragma unroll
                for (int r = 0; r < 4; ++r) { aP[q][r] = (aP[q][r] + (i0 + r == jrow ? 1.f : 0.f)) * g4[r]; aQ[q][r] *= g4[r]; }
                aG[q][0] += bf_lo(rr.x); aG[q][1] += bf_hi(rr.x); aG[q][2] += bf_lo(rr.y); aG[q][3] += bf_hi(rr.y); }
            const size_t orow = (size_t)scan_row(z, b, sc * SCP + c4 * 64 + jrow) * D + hh * 64;
            if (c4 == 0) {
#pragma unroll
                for (int q = 0; q < 2; ++q) { const int i0 = 16 * (2 * wh + q) + 4 * l4;
                    u32x2 o; o.x = cvt_pk_bf16(aG[q][0], aG[q][1]); o.y = cvt_pk_bf16(aG[q][2], aG[q][3]); *(u32x2*)(GE + orow + i0) = o;
                    u32x2 y; y.x = cvt_pk_bf16(aY[q][0], aY[q][1]); y.y = cvt_pk_bf16(aY[q][2], aY[q][3]); *(u32x2*)(YE + orow + i0) = y;
                    Pr[q] = aP[q]; Qr[q] = aQ[q]; }
            } else {
                st_tile(NT, aG, wq, wh, lane); st_tile(MT, aP, wq, wh, lane);
#pragma unroll
                for (int q = 0; q < 2; ++q) { aYp[q] = aY[q]; aQp[q] = aQ[q]; }
                pend = true; orowp = orow; GEp = GE; YEp = YE; pqp = pq; lastp = c4 == NCH - 1;
            }
            cur = nxt;
            if (CH_AMP >= 0) { const unsigned long long d_ = CH_AMP == 0 ? ch_t[0] - ch_t[11] : ch_t[CH_AMP] - ch_t[CH_AMP - 1]; const unsigned long long dl_ = __builtin_amdgcn_s_memrealtime() + 4 * d_; while (__builtin_amdgcn_s_memrealtime() < dl_) __builtin_amdgcn_s_sleep(4); }
            LDS_BARRIER(); CH_STAMP(8);
        }
        item += gridDim.x; if (item >= NITEM) break;
    }
    if (pend) { SCAN_STAGE_G(); }
#undef SCAN_STAGE_G
}
__device__ __forceinline__ void scan_carry_phase(const Frame& F, KP P, int layer) {
    LAS unsigned* cbar = (LAS unsigned*)(F.lds + 8192);
    if (F.tid == 0) *cbar = 0u;
    __syncthreads();
    if (F.wave >= 4) { moe_weights_phase(F, P, layer, blockIdx.x * 4 + (F.wave - 4), gridDim.x * 4, 0, MOE_SPLIT); return; }
    if (blockIdx.x >= 4 * NSCAN) return;
    unsigned ctarget = 0u;
    const int s = blockIdx.x >> 2, vs = blockIdx.x & 3, lane = F.lane, l15 = lane & 15, l4 = lane >> 4, v = 16 * vs + l15, T2 = F.wave;
    const float* pq = (const float*)(P->ws + WS_PQ) + (size_t)s * NSC * 2 * 4096; bf16_t* sst = (bf16_t*)(P->ws + WS_SST) + (size_t)s * NSC * 4096;
    LAS f32x4* exch = (LAS f32x4*)F.lds;
    f32x4 S[4]; float ap[4][16], qp[4][4];
#pragma unroll
    for (int t = 0; t < 4; ++t) S[t] = (f32x4){0.f, 0.f, 0.f, 0.f};
#define CARRY_LOAD(slot, step) do { const float* Pm_ = pq + (size_t)(step) * 2 * 4096; \
        _Pragma("unroll") for (int t2i = 0; t2i < 4; ++t2i) _Pragma("unroll") for (int ri = 0; ri < 4; ++ri) ap[slot][t2i * 4 + ri] = Pm_[(T2 * 16 + t2i * 4 + ri) * 64 + lane];   \
        _Pragma("unroll") for (int r = 0; r < 4; ++r) qp[slot][r] = Pm_[4096 + ((vs * 4 + T2) * 4 + r) * 64 + lane];   } while (0)
#define CARRY_STORE(sc_) do { if (T2 == 0) { float o[16]; \
        _Pragma("unroll") for (int r = 0; r < 4; ++r) _Pragma("unroll") for (int t2 = 0; t2 < 4; ++t2) o[4 * r + t2] = S[t2][r]; \
        u32x4 w0, w1; w0.x = cvt_pk_bf16(o[0], o[1]); w0.y = cvt_pk_bf16(o[2], o[3]); w0.z = cvt_pk_bf16(o[4], o[5]); w0.w = cvt_pk_bf16(o[6], o[7]); \
        w1.x = cvt_pk_bf16(o[8], o[9]); w1.y = cvt_pk_bf16(o[10], o[11]); w1.z = cvt_pk_bf16(o[12], o[13]); w1.w = cvt_pk_bf16(o[14], o[15]); \
        *(u32x4*)(sst + (size_t)(sc_) * 4096 + v * 64 + 16 * l4) = w0; *(u32x4*)(sst + (size_t)(sc_) * 4096 + v * 64 + 16 * l4 + 8) = w1; } } while (0)
    if (T2 < 4) {
#pragma unroll
        for (int u = 0; u < 4; ++u) CARRY_LOAD(u, u);
    }
#pragma nounroll
    for (int sc0 = 0; sc0 < NSC - 1; sc0 += 4) {
#pragma unroll
        for (int u = 0; u < 4; ++u) { const int sc = sc0 + u; if (sc >= NSC - 1) break;
            CARRY_STORE(sc);
            if (T2 < 4) {
                f32x4 nw = (f32x4){qp[u][0], qp[u][1], qp[u][2], qp[u][3]};
#pragma unroll
                for (int t2i = 0; t2i < 4; ++t2i)
#pragma unroll
                    for (int ri = 0; ri < 4; ++ri) nw = __builtin_amdgcn_mfma_f32_16x16x4f32(ap[u][t2i * 4 + ri], S[t2i][ri], nw, 0, 0, 0);
                if (sc + 4 < NSC - 1) CARRY_LOAD(u, sc + 4);
                exch[((u & 1) * 4 + T2) * 64 + lane] = nw;
            }
            { asm volatile("s_waitcnt lgkmcnt(0)" ::: "memory"); if (lane == 0) __hip_atomic_fetch_add(cbar, 1u, __ATOMIC_RELAXED, __HIP_MEMORY_SCOPE_WORKGROUP); ctarget += 4u;
              for (int spin = 0; spin < (1 << 22); ++spin) { const unsigned c = __hip_atomic_load(cbar, __ATOMIC_RELAXED, __HIP_MEMORY_SCOPE_WORKGROUP); if ((int)(c - ctarget) >= 0) break; }
              asm volatile("" ::: "memory"); }
            if (T2 < 4) {
#pragma unroll
                for (int t = 0; t < 4; ++t) S[t] = exch[((u & 1) * 4 + t) * 64 + lane];
            }
        }
    }
    CARRY_STORE(NSC - 1);
#undef CARRY_LOAD
#undef CARRY_STORE
}
__device__ __forceinline__ void scan_out_phase(const Frame& F, KP P, int j) {
    const int lane = F.lane, l15 = lane & 15, l4 = lane >> 4;
    const bf16_t* GE0 = (const bf16_t*)(P->ws + WS_AS0); const bf16_t* GE1 = (const bf16_t*)(P->ws + WS_AS1); const bf16_t* YE0 = (const bf16_t*)(P->ws + WS_ELOG0); const bf16_t* YE1 = (const bf16_t*)(P->ws + WS_ELOG1);
    const bf16_t* Vb = (const bf16_t*)(P->ws + WS_VV); const float* BON = (const float*)(P->ws + WS_BON);
    const bf16_t* GT = (const bf16_t*)(P->ws + WS_GATE); bf16_t* YG = (bf16_t*)(P->ws + WS_YG);
    for (int item = F.gw; item < NBATCH * NH * ((SEQ + CTXL) / 256) * 8; item += F.NGW) {
        const int hh = item & 15, oct = (item >> 4) & 7, b = (item >> 7) & 1, blk = item >> 8;
        const int sc0 = (blk * 256 + 32 * oct) / SCP, sc1 = blk == 0 ? 0 : (SEQ + CTXL - 1 - (blk - 1) * 256 - 32 * oct) / SCP;

        const bf16_t* s0 = (const bf16_t*)(P->ws + WS_SST) + ((size_t)(b * 16 + hh) * NSC + sc0) * 4096; const bf16_t* s1 = (const bf16_t*)(P->ws + WS_SST) + ((size_t)(32 + b * 16 + hh) * NSC + sc1) * 4096;
        bf16x8 sa0[4][2], sa1[4][2];
#pragma unroll
        for (int vt = 0; vt < 4; ++vt) { const int v = 32 * (vt >> 1) + 8 * (l15 >> 2) + 4 * (vt & 1) + (l15 & 3);
#pragma unroll
            for (int ks = 0; ks < 2; ++ks) { sa0[vt][ks] = *(const bf16x8*)(s0 + v * 64 + 32 * ks + 8 * l4); sa1[vt][ks] = *(const bf16x8*)(s1 + v * 64 + 32 * ks + 8 * l4); } }
        f32x4 lg4[4], lb4[4];
#pragma unroll
        for (int q = 0; q < 4; ++q) { const int c = hh * 64 + 32 * (q >> 1) + 8 * l4 + 4 * (q & 1); lg4[q] = *(const f32x4*)(P->in[I_LNG] + (size_t)j * D + c); lb4[q] = *(const f32x4*)(P->in[I_LNB] + (size_t)j * D + c); }
#pragma nounroll
        for (int ti = 0; ti < 2; ++ti) {
            const int tok = (2 * oct + ti) * 16 + l15; const int row = blk == 0 ? TL + b * CTXL + tok : b * SEQ + (blk - 1) * 256 + tok;
            const size_t o = (size_t)row * D + hh * 64;
            const bf16x8 g00 = *(const bf16x8*)(GE0 + o + 8 * l4), g01 = *(const bf16x8*)(GE0 + o + 32 + 8 * l4), g10 = *(const bf16x8*)(GE1 + o + 8 * l4), g11 = *(const bf16x8*)(GE1 + o + 32 + 8 * l4);
            u32x4 la[2], lc[2], lv[2], lgt[2];
#pragma unroll
            for (int h2 = 0; h2 < 2; ++h2) { const size_t oc = o + 32 * h2 + 8 * l4;
                la[h2] = *(const u32x4*)(YE0 + oc); lc[h2] = *(const u32x4*)(YE1 + oc); lv[h2] = *(const u32x4*)(Vb + oc); lgt[h2] = *(const u32x4*)(GT + oc); }
            const float bn = BON[(size_t)row * 16 + hh] + BON[((size_t)T + row) * 16 + hh];
            __builtin_amdgcn_sched_barrier(0);
            f32x4 y[4]; float s = 0.f; f32x4 vv[4], gg[4];
#pragma unroll
            for (int vt = 0; vt < 4; ++vt) { const int h2 = vt >> 1, hf = vt & 1;
                const unsigned ax = hf ? la[h2].z : la[h2].x, ay = hf ? la[h2].w : la[h2].y, cx = hf ? lc[h2].z : lc[h2].x, cy = hf ? lc[h2].w : lc[h2].y;
                const unsigned vx = hf ? lv[h2].z : lv[h2].x, vy = hf ? lv[h2].w : lv[h2].y, gx = hf ? lgt[h2].z : lgt[h2].x, gy = hf ? lgt[h2].w : lgt[h2].y;
                f32x4 acc = (f32x4){bf_lo(ax) + bf_lo(cx), bf_hi(ax) + bf_hi(cx), bf_lo(ay) + bf_lo(cy), bf_hi(ay) + bf_hi(cy)};
                acc = __builtin_amdgcn_mfma_f32_16x16x32_bf16(sa0[vt][0], g00, acc, 0, 0, 0); acc = __builtin_amdgcn_mfma_f32_16x16x32_bf16(sa0[vt][1], g01, acc, 0, 0, 0);
                acc = __builtin_amdgcn_mfma_f32_16x16x32_bf16(sa1[vt][0], g10, acc, 0, 0, 0); acc = __builtin_amdgcn_mfma_f32_16x16x32_bf16(sa1[vt][1], g11, acc, 0, 0, 0);
                y[vt] = acc; s += (acc[0] + acc[1]) + (acc[2] + acc[3]);
                vv[vt] = (f32x4){bf_lo(vx), bf_hi(vx), bf_lo(vy), bf_hi(vy)}; gg[vt] = (f32x4){bf_lo(gx), bf_hi(gx), bf_lo(gy), bf_hi(gy)}; }
            s += shx(s, 16, lane); s += shx(s, 32, lane);
            const float mean = s * (1.0f / 64.0f); float q = 0.f;
#pragma unroll
            for (int vt = 0; vt < 4; ++vt) { const f32x4 d = y[vt] - mean; q += (d[0] * d[0] + d[1] * d[1]) + (d[2] * d[2] + d[3] * d[3]); }
            q += shx(q, 16, lane); q += shx(q, 32, lane);
            const float rstd = rsqrtf(q * (1.0f / 64.0f) + 64e-5f);
#pragma unroll
            for (int h2 = 0; h2 < 2; ++h2) { const f32x4 o0 = (((y[2 * h2] - mean) * rstd) * lg4[2 * h2] + lb4[2 * h2] + vv[2 * h2] * bn) * gg[2 * h2], o1 = (((y[2 * h2 + 1] - mean) * rstd) * lg4[2 * h2 + 1] + lb4[2 * h2 + 1] + vv[2 * h2 + 1] * bn) * gg[2 * h2 + 1];
                u32x4 w; w.x = cvt_pk_bf16(o0[0], o0[1]); w.y = cvt_pk_bf16(o0[2], o0[3]); w.z = cvt_pk_bf16(o1[0], o1[1]); w.w = cvt_pk_bf16(o1[2], o1[3]); *(u32x4*)(YG + o + 32 * h2 + 8 * l4) = w; }
        }
    }
}
__device__ __forceinline__ bool in_range(int lo, int hi, int k) { asm volatile("" : "+s"(lo), "+s"(hi)); return lo <= k && k < hi; }
constexpr int NPH = 46;
template <unsigned KMASK> __global__ void __launch_bounds__(NTHR, 2) mega(Params Pv) {
    extern __shared__ __attribute__((aligned(16))) unsigned char lds_raw[];
    Frame F0; F0.lds = (LAS unsigned char*)lds_raw; F0.tid = threadIdx.x; F0.lane = F0.tid & 63; F0.wave = __builtin_amdgcn_readfirstlane(F0.tid >> 6);
    F0.G = gridDim.x; F0.gw = blockIdx.x * NWAVES + F0.wave; F0.NGW = F0.G * NWAVES;
    LAS unsigned* misc = (LAS unsigned*)(F0.lds + LDS_MISC);
    if (F0.tid < 128) misc[F0.tid] = 0u;
    __syncthreads();
    KP P0 = (KP)__builtin_amdgcn_kernarg_segment_ptr();
    constexpr bool ALL = (KMASK == 0x3ffffu);
    const int lo = ALL ? 0 : P0->ph_lo, hi = ALL ? NPH : P0->ph_hi;
    XcdBarrier bar; bar.bar = (unsigned*)(P0->ws + WS_CTL) + CW_BAR; bar.x = 0; bar.st = (volatile LAS unsigned*)(misc + 8);
    if (ALL || hi - lo > 1) bar = xcd_barrier_post((unsigned*)(P0->ws + WS_CTL) + CW_BAR, (volatile LAS unsigned*)(misc + 8));
#define IN(k) (ALL || in_range(lo, hi, (k)))
#define KIND(q) ((KMASK >> (q)) & 1u)
#define BAR_LEADER (wave_sgpr_now(F0.wave) == 0 && lane_id_now() == 0)
#define SEAM(k) do { if (IN(k) && IN((k) + 1)) { XcdBarrier b2_ = bar; unsigned* bb_ = bar.bar; unsigned bx_ = bar.x; asm volatile("" : "+s"(bb_), "+s"(bx_)); b2_.bar = bb_; b2_.x = bx_; xcd_barrier<false>(b2_, BAR_LEADER); } } while (0)
#define AMP_T0 const unsigned long long amp_t0 = AMP_MASK ? __builtin_amdgcn_s_memrealtime() : 0ull;
#define AMP_END(kind) do { if (AMP_MASK & (1u << (kind))) { const unsigned long long t1_ = __builtin_amdgcn_s_memrealtime(), dl_ = t1_ + AMP_F * (t1_ - amp_t0); while (__builtin_amdgcn_s_memrealtime() < dl_) __builtin_amdgcn_s_sleep(8); } } while (0)
#define PHASE_ENTRY AMP_T0 KP P = P0; asm volatile("" : "+s"(P)); unsigned char* ws = P->ws; unsigned* ctl = (unsigned*)(ws + WS_CTL); (void)ctl; \
    Frame F = F0; { int l_ = lane_id_now(), w_ = F0.wave; asm volatile("" : "+s"(w_)); F.lane = l_; F.wave = w_; F.tid = w_ * 64 + l_; F.gw = blockIdx.x * NWAVES + w_; }

    if constexpr (KIND(0)) if (IN(0)) { PHASE_ENTRY prologue_phase(F, P); AMP_END(0); }
    if (IN(0) && IN(1)) { XcdBarrier b2_ = bar; unsigned* bb_ = bar.bar; unsigned bx_ = bar.x; asm volatile("" : "+s"(bb_), "+s"(bx_)); b2_.bar = bb_; b2_.x = bx_; xcd_barrier<true>(b2_, BAR_LEADER); }
    for (int lp = 0; lp < 2; ++lp) {
        const int pb = 1 + 22 * lp, la = 2 * lp, lb = 2 * lp + 1;
        if constexpr (KIND(1)) if (IN(pb + 0)) { PHASE_ENTRY norm1_phase(F, P, la); AMP_END(1); }
        SEAM(pb + 0);
        if constexpr (KIND(2)) if (IN(pb + 1)) { PHASE_ENTRY
            __syncthreads(); set_desc(F.lds, F.tid, 0, ws + WS_HL, ws + WS_WIN + (size_t)lp * 4096 * D * 2, ws + WS_U, 16, 0, 0, ws + WS_V, P->in[I_GBIN] + (size_t)lp * 4096, ws + WS_STAT); __syncthreads();
            SchedMulti<D, D> S{F.lds, TL / 256, 16, 1};
            EpiGelu E{F.lds};
            pg8::gemm_phase<EpiGelu, SchedMulti<D, D>, false, D, D, D>(F.lds, S, E, F.tid);
            __syncthreads(); { int w_ = F0.wave; asm volatile("" : "+s"(w_)); tail_gelu(F0.lds, w_); }
            AMP_END(2); }
        SEAM(pb + 1);
        if constexpr (KIND(3)) if (IN(pb + 2)) { PHASE_ENTRY spatial_phase(F, P, lp); AMP_END(3); }
        SEAM(pb + 2);
        if constexpr (KIND(4)) if (IN(pb + 3)) { PHASE_ENTRY
            __syncthreads();
            { bf16_t* X = (bf16_t*)(ws + WS_X);
              set_desc(F.lds, F.tid, 0, ws + WS_U, ws + WS_WOUT + (size_t)lp * D * GWID * 2, X, 4, 0, 0, X, X + (size_t)TL * D, P->in[I_GBOUT] + (size_t)lp * D);
              set_desc(F.lds, F.tid, 1, nullptr, nullptr, nullptr, 0, 0, 0, (const float*)(ws + WS_MOD) + (size_t)la * 3 * 6 * D + 2 * D); }
            __syncthreads();
            SchedMulti<GWID, GWID> S{F.lds, TL / 256, 4, 1};
            EpiResid E{F.lds};
            pg8::gemm_phase<EpiResid, SchedMulti<GWID, GWID>, false, GWID, GWID, GWID>(F.lds, S, E, F.tid);
            __syncthreads(); { int w_ = F0.wave; asm volatile("" : "+s"(w_)); tail_resid<GWID>(F0.lds, w_); }
            AMP_END(4); }
        SEAM(pb + 3);
        if constexpr (KIND(5)) if (IN(pb + 4)) { PHASE_ENTRY norm2_phase(F, P, la); AMP_END(5); }
        SEAM(pb + 4);
        if constexpr (KIND(16)) if (IN(pb + 5)) { PHASE_ENTRY
            __syncthreads(); set_desc(F.lds, F.tid, 0, ws + WS_HL, ws + WS_WRT + (size_t)la * 256 * D * 2, nullptr, 1, 0, 0); __syncthreads();
            const int nun = (la == DEPTH - 1 ? TL : T) / 256;
            if ((int)blockIdx.x >= nun) moe_weights_phase(F, P, la, ((int)blockIdx.x - nun) * NWAVES + F.wave, (F.G - nun) * NWAVES, MOE_SPLIT, MOE_ITEMS);
            else { SchedMulti<D, D> S{F.lds, nun, 1, 1};
                EpiLogits E{(float*)(ws + WS_LG)};
                pg8::gemm_phase<EpiLogits, SchedMulti<D, D>, false, D, D, D>(F.lds, S, E, F.tid);
                if (F.G <= nun) { __syncthreads(); moe_weights_phase(F, P, la, F.gw, F.NGW, MOE_SPLIT, MOE_ITEMS); } }
            AMP_END(16); }
        SEAM(pb + 5);
        if constexpr (KIND(17)) if (IN(pb + 6)) { PHASE_ENTRY route_phase(F, P, la); AMP_END(17); }
        SEAM(pb + 6);
        if constexpr (KIND(6)) if (IN(pb + 7)) { PHASE_ENTRY
            moe_tables(F.lds, F.tid, ctl + CW_CNT + la * 64);
            SchedMoE<D, D, true> S{F.lds, (const char*)(ws + WS_HL), (const char*)(ws + WS_WGU), (const int*)(ws + WS_LIST)};
            EpiSiluGate E{(bf16_t*)(ws + WS_H)};
            pg8::gemm_phase<EpiSiluGate, SchedMoE<D, D, true>, true, D, D, D>(F.lds, S, E, F.tid);
            AMP_END(6); }
        SEAM(pb + 7);
        if constexpr (KIND(7)) if (IN(pb + 8)) { PHASE_ENTRY
            moe_tables(F.lds, F.tid, ctl + CW_CNT + la * 64);
            SchedMoE<EHID, EHID, false> S{F.lds, (const char*)(ws + WS_H), (const char*)(ws + WS_WD), (const int*)(ws + WS_LIST)};
            EpiScatter E{F.lds, (bf16_t*)(ws + WS_YB), (const int*)(ws + WS_LIST)};
            pg8::gemm_phase<EpiScatter, SchedMoE<EHID, EHID, false>, false, EHID, EHID, EHID>(F.lds, S, E, F.tid);
            AMP_END(7); }
        SEAM(pb + 8);
        if constexpr (KIND(1)) if (IN(pb + 9)) { PHASE_ENTRY norm1_phase(F, P, lb); AMP_END(1); }
        SEAM(pb + 9);
        if constexpr (KIND(8)) if (IN(pb + 10)) { PHASE_ENTRY mix_phase(F, P, lp); AMP_END(8); }
        SEAM(pb + 10);
        if constexpr (KIND(9)) if (IN(pb + 11)) { PHASE_ENTRY
            __syncthreads();
            set_desc(F.lds, F.tid, 0, ws + WS_XR, ws + WS_WR + (size_t)lp * D * D * 2, ws + WS_R, 4, D, 0);
            set_desc(F.lds, F.tid, 1, ws + WS_XK, ws + WS_WK + (size_t)lp * D * D * 2, ws + WS_K, 4, D, 0);
            set_desc(F.lds, F.tid, 2, ws + WS_XV, ws + WS_WV + (size_t)lp * D * D * 2, ws + WS_VV, 4, D, 0);
            set_desc(F.lds, F.tid, 3, ws + WS_XW, ws + WS_LW1 + (size_t)lp * 256 * D * 2, ws + WS_TW, 1, 256, 1);
            set_desc(F.lds, F.tid, 4, ws + WS_XA, ws + WS_LA1 + (size_t)lp * 256 * D * 2, ws + WS_TA, 1, 256, 0);
            set_desc(F.lds, F.tid, 5, ws + WS_XG, ws + WS_LG1 + (size_t)lp * 256 * D * 2, ws + WS_TG, 1, 256, 2);
            __syncthreads();
            SchedMulti<D, D> S{F.lds, T / 256, 15, 6};
            EpiAct E{F.lds};
            pg8::gemm_phase<EpiAct, SchedMulti<D, D>, false, D, D, D>(F.lds, S, E, F.tid);
            AMP_END(9); }
        SEAM(pb + 11);
        if constexpr (KIND(10)) if (IN(pb + 12)) { PHASE_ENTRY
            __syncthreads(); set_desc(F.lds, F.tid, 0, ws + WS_TG, ws + WS_G2P + (size_t)lp * D * 256 * 2, ws + WS_GATE, 4, D, 0); __syncthreads();
            SchedMulti<256, 256> S{F.lds, T / 256, 4, 1};
            EpiAct E{F.lds};
            pg8::gemm_phase<EpiAct, SchedMulti<256, 256>, false, 256, 256, 256>(F.lds, S, E, F.tid);
            AMP_END(10); }
        __syncthreads();
        if constexpr (KIND(11)) if (IN(pb + 13)) { PHASE_ENTRY scan_chunk_phase(F, P, lp); AMP_END(11); }
        SEAM(pb + 13);
        if constexpr (KIND(14)) if (IN(pb + 14)) { PHASE_ENTRY scan_carry_phase(F, P, lb); AMP_END(14); }
        SEAM(pb + 14);
        if constexpr (KIND(15)) if (IN(pb + 15)) { PHASE_ENTRY scan_out_phase(F, P, lp); AMP_END(15); }
        SEAM(pb + 15);
        if constexpr (KIND(4)) if (IN(pb + 16)) { PHASE_ENTRY
            __syncthreads();
            { bf16_t* X = (bf16_t*)(ws + WS_X);
              set_desc(F.lds, F.tid, 0, ws + WS_YG, ws + WS_WO + (size_t)lp * D * D * 2, X, 4, 0, 0, X, X + (size_t)TL * D, nullptr);
              set_desc(F.lds, F.tid, 1, nullptr, nullptr, nullptr, 0, 0, 0, (const float*)(ws + WS_MOD) + (size_t)lb * 3 * 6 * D + 2 * D); }
            __syncthreads();
            SchedMulti<D, D> S{F.lds, TL / 256, 4, 1};
            EpiResid E{F.lds};
            pg8::gemm_phase<EpiResid, SchedMulti<D, D>, false, D, D, D>(F.lds, S, E, F.tid);
            if (lb != DEPTH - 1) { __syncthreads(); { int w_ = F0.wave; asm volatile("" : "+s"(w_)); tail_resid<D>(F0.lds, w_); } }
            AMP_END(4); }
        SEAM(pb + 16);
        if constexpr (KIND(5)) if (IN(pb + 17)) { PHASE_ENTRY norm2_phase(F, P, lb); AMP_END(5); }
        SEAM(pb + 17);
        if constexpr (KIND(16)) if (IN(pb + 18)) { PHASE_ENTRY
            __syncthreads(); set_desc(F.lds, F.tid, 0, ws + WS_HL, ws + WS_WRT + (size_t)lb * 256 * D * 2, nullptr, 1, 0, 0); __syncthreads();
            const int nun = (lb == DEPTH - 1 ? TL : T) / 256;
            if ((int)blockIdx.x >= nun) moe_weights_phase(F, P, lb, ((int)blockIdx.x - nun) * NWAVES + F.wave, (F.G - nun) * NWAVES, MOE_SPLIT, MOE_ITEMS);
            else { SchedMulti<D, D> S{F.lds, nun, 1, 1};
                EpiLogits E{(float*)(ws + WS_LG)};
                pg8::gemm_phase<EpiLogits, SchedMulti<D, D>, false, D, D, D>(F.lds, S, E, F.tid);
                if (F.G <= nun) { __syncthreads(); moe_weights_phase(F, P, lb, F.gw, F.NGW, MOE_SPLIT, MOE_ITEMS); } }
            AMP_END(16); }
        SEAM(pb + 18);
        if constexpr (KIND(17)) if (IN(pb + 19)) { PHASE_ENTRY route_phase(F, P, lb); AMP_END(17); }
        SEAM(pb + 19);
        if constexpr (KIND(6)) if (IN(pb + 20)) { PHASE_ENTRY
            moe_tables(F.lds, F.tid, ctl + CW_CNT + lb * 64);
            SchedMoE<D, D, true> S{F.lds, (const char*)(ws + WS_HL), (const char*)(ws + WS_WGU), (const int*)(ws + WS_LIST)};
            EpiSiluGate E{(bf16_t*)(ws + WS_H)};
            pg8::gemm_phase<EpiSiluGate, SchedMoE<D, D, true>, true, D, D, D>(F.lds, S, E, F.tid);
            AMP_END(6); }
        SEAM(pb + 20);
        if constexpr (KIND(7)) if (IN(pb + 21)) { PHASE_ENTRY
            moe_tables(F.lds, F.tid, ctl + CW_CNT + lb * 64);
            SchedMoE<EHID, EHID, false> S{F.lds, (const char*)(ws + WS_H), (const char*)(ws + WS_WD), (const int*)(ws + WS_LIST)};
            EpiScatter E{F.lds, (bf16_t*)(ws + WS_YB), (const int*)(ws + WS_LIST)};
            pg8::gemm_phase<EpiScatter, SchedMoE<EHID, EHID, false>, false, EHID, EHID, EHID>(F.lds, S, E, F.tid);
            AMP_END(7); }
        SEAM(pb + 21);
    }
    if constexpr (KIND(13)) if (IN(45)) { PHASE_ENTRY final_phase(F, P); AMP_END(13); }
#undef IN
#undef KIND
#undef SEAM
#undef PHASE_ENTRY
}

#if !MK_ONE_LAUNCH
static int phase_kind(int ph) { if (ph == 0) return 0; if (ph == 45) return 13; static const int k22[22] = {1, 2, 3, 4, 5, 16, 17, 6, 7, 1, 8, 9, 10, 11, 14, 15, 4, 5, 16, 17, 6, 7}; return k22[(ph - 1) % 22]; }
typedef void (*kern_t)(Params);
template <unsigned KM> static kern_t kern_of() { return mega<KM>; }
static kern_t kind_kernel(int kind) {
    switch (kind) { case 0: return kern_of<1u << 0>(); case 1: return kern_of<1u << 1>(); case 2: return kern_of<1u << 2>(); case 3: return kern_of<1u << 3>(); case 4: return kern_of<1u << 4>();
        case 5: return kern_of<1u << 5>(); case 6: return kern_of<1u << 6>(); case 7: return kern_of<1u << 7>(); case 8: return kern_of<1u << 8>(); case 9: return kern_of<1u << 9>();
        case 10: return kern_of<1u << 10>(); case 11: return kern_of<1u << 11>(); case 12: return kern_of<1u << 12>(); case 14: return kern_of<1u << 14>(); case 15: return kern_of<1u << 15>(); case 16: return kern_of<1u << 16>(); case 17: return kern_of<1u << 17>(); default: return kern_of<1u << 13>(); }
}
#endif
extern "C" void kernel_launch(void* const* d_in, const int* in_sizes, int n_in, void* d_out, int out_size, void* d_ws, size_t ws_size, hipStream_t stream) {
    static int grid = 0;
    if (grid == 0) {
        if (n_in != 42 || out_size != TL * D || ws_size < WS_END) { fprintf(stderr, "kernel_launch: unexpected problem (n_in %d, out %d, ws %zu < %zu)\n", n_in, out_size, ws_size, (size_t)WS_END); grid = -1; return; }
        int dev = 0, cus = 0;
        if (hipGetDevice(&dev) != hipSuccess || hipDeviceGetAttribute(&cus, hipDeviceAttributeMultiprocessorCount, dev) != hipSuccess) { grid = -1; return; }
#if MK_ONE_LAUNCH
        if (hipFuncSetAttribute((const void*)mega<0x3ffffu>, hipFuncAttributeMaxDynamicSharedMemorySize, LDS_BYTES) != hipSuccess) { fprintf(stderr, "kernel_launch: hipFuncSetAttribute failed\n"); grid = -1; return; }
#else
        for (int k = 0; k < 18; ++k) if (hipFuncSetAttribute((const void*)kind_kernel(k), hipFuncAttributeMaxDynamicSharedMemorySize, LDS_BYTES) != hipSuccess) { fprintf(stderr, "kernel_launch: hipFuncSetAttribute failed\n"); grid = -1; return; }
#endif
        (void)hipGetLastError();
        grid = cus;
    }
    if (grid < 0) return;
    (void)hipMemsetAsync((char*)d_ws + WS_CTL, 0, CTL_BYTES, stream);
    Params p{};
    for (int i = 0; i < 42; ++i) p.in[i] = (const float*)d_in[i];
    p.out = (float*)d_out; p.ws = (unsigned char*)d_ws;
#if MK_ONE_LAUNCH
    p.ph_lo = 0; p.ph_hi = NPH;
    hipLaunchKernelGGL(mega<0x3ffffu>, dim3(grid), dim3(NTHR), LDS_BYTES, stream, p);
#else
    for (int ph = 0; ph < NPH; ++ph) { p.ph_lo = ph; p.ph_hi = ph + 1; hipLaunchKernelGGL(kind_kernel(phase_kind(ph)), dim3(grid), dim3(NTHR), LDS_BYTES, stream, p); }
#endif
}
```

```cpp
#include <hip/hip_runtime.h>
#include <cstdio>
#include <cstdint>

#define LAS __attribute__((address_space(3)))
typedef unsigned short bf16_t;
typedef short bf16x8 __attribute__((ext_vector_type(8)));
typedef float f32x4 __attribute__((ext_vector_type(4)));
typedef float f32x2 __attribute__((ext_vector_type(2)));
typedef unsigned u32x4 __attribute__((ext_vector_type(4)));
typedef unsigned u32x2 __attribute__((ext_vector_type(2)));

#ifndef CH_AMP
#define CH_AMP -1
#endif
#define CH_STAMP(i) do { if (CH_AMP >= 0) ch_t[i] = __builtin_amdgcn_s_memrealtime(); } while (0)
#ifndef AMP_MASK
#define AMP_MASK 0u
#endif
#define AMP_F 4
#ifndef MK_ONE_LAUNCH
#define MK_ONE_LAUNCH 1
#endif

constexpr int D = 1024, NBATCH = 2, SEQ = 16384, CTXL = 256, DEPTH = 4;
constexpr int TL = NBATCH * SEQ, TC = NBATCH * CTXL, T = TL + TC;
constexpr int GWID = 2048, NE = 32, EHID = 512, NH = 16, HD = 64;
constexpr int LISTCAP = T;
constexpr int MAXRT = (2 * T) / 256 + NE;
constexpr int NWAVES = 8, NTHR = 512;

constexpr size_t MiB = 1u << 20;
constexpr size_t WS_CTL = 0, CTL_BYTES = 1 * MiB;
constexpr size_t WS_MOD = 1 * MiB;
constexpr size_t WS_WIN = 2 * MiB, WS_WOUT = 18 * MiB, WS_WSP = 26 * MiB, WS_WR = 27 * MiB, WS_WK = 31 * MiB, WS_WV = 35 * MiB, WS_WO = 39 * MiB;
constexpr size_t WS_LW1 = 43 * MiB, WS_LA1 = 44 * MiB, WS_LG1 = 45 * MiB, WS_W2P = 46 * MiB, WS_A2P = 48 * MiB, WS_G2P = 50 * MiB;
constexpr size_t WS_WRT = 52 * MiB;
constexpr size_t WS_WGU = 54 * MiB, WS_WD = 118 * MiB;
constexpr size_t WS_X = 150 * MiB;
constexpr size_t WS_LIST = 280 * MiB, WS_WGT = 285 * MiB;
constexpr size_t WS_HL = 286 * MiB;
constexpr size_t WS_BIG = 351 * MiB;
constexpr size_t SZB = 65 * MiB;
constexpr size_t WS_U = WS_BIG, WS_V = WS_BIG + 2 * SZB, WS_STAT = WS_BIG + 4 * SZB;
constexpr size_t WS_XR = WS_BIG, WS_XW = WS_BIG + SZB, WS_XK = WS_BIG + 2 * SZB, WS_XV = WS_BIG + 3 * SZB, WS_XA = WS_BIG + 4 * SZB, WS_XG = WS_BIG + 5 * SZB;
constexpr size_t WS_R = WS_BIG + 6 * SZB, WS_K = WS_BIG + 7 * SZB, WS_VV = WS_BIG + 8 * SZB;
constexpr size_t WS_TW = WS_BIG + 9 * SZB, WS_TA = WS_TW + 17 * MiB, WS_TG = WS_TA + 17 * MiB;
constexpr size_t WS_ELOG0 = WS_XR, WS_ELOG1 = WS_XW, WS_KM0 = WS_XK, WS_KM1 = WS_XV, WS_AS0 = WS_XA, WS_AS1 = WS_XG;
constexpr size_t WS_GATE = WS_HL, WS_YG = WS_AS0, WS_BON = WS_TG + 17 * MiB;
constexpr size_t WS_H = WS_BIG, WS_YB = WS_BIG + 73 * MiB, WS_LG = WS_BIG + 204 * MiB;
constexpr size_t WS_PQ = WS_KM0;
constexpr size_t WS_SST = 215 * MiB;
constexpr size_t WS_END = WS_BON + 5 * MiB;
static_assert(WS_END <= 1080 * MiB, "workspace map");
constexpr int CW_BAR = 4096;
constexpr int CW_CNT = 16384;

__device__ __forceinline__ int wave_sgpr_now(int w) { asm volatile("" : "+s"(w)); return w; }
__device__ __forceinline__ int lane_id_now() { int l; asm volatile("v_mbcnt_lo_u32_b32 %0, -1, 0\n\tv_mbcnt_hi_u32_b32 %0, -1, %0" : "=v"(l)); return l; }
typedef short v4s __attribute__((ext_vector_type(4)));
#define LDS_BARRIER() asm volatile("s_waitcnt lgkmcnt(0)\n\ts_barrier" ::: "memory")
typedef __bf16 bf16x2_t __attribute__((ext_vector_type(2)));
__device__ __forceinline__ unsigned cvt_pk_bf16(float lo, float hi) { const bf16x2_t v = __builtin_convertvector((f32x2){lo, hi}, bf16x2_t); return __builtin_bit_cast(unsigned, v); }
__device__ __forceinline__ float bf_lo(unsigned u) { return __uint_as_float(u << 16); }
__device__ __forceinline__ float bf_hi(unsigned u) { return __uint_as_float(u & 0xffff0000u); }
__device__ __forceinline__ float bf1(bf16_t b) { return __uint_as_float(((unsigned)b) << 16); }
__device__ __forceinline__ bf16_t f2bf(float f) { return (bf16_t)(cvt_pk_bf16(f, 0.f) & 0x3ffffu); }
__device__ __forceinline__ void unpack8(const u32x4& w, float (&f)[8]) { f[0] = bf_lo(w.x); f[1] = bf_hi(w.x); f[2] = bf_lo(w.y); f[3] = bf_hi(w.y); f[4] = bf_lo(w.z); f[5] = bf_hi(w.z); f[6] = bf_lo(w.w); f[7] = bf_hi(w.w); }
__device__ __forceinline__ u32x4 pack8(const float (&f)[8]) { u32x4 o; o.x = cvt_pk_bf16(f[0], f[1]); o.y = cvt_pk_bf16(f[2], f[3]); o.z = cvt_pk_bf16(f[4], f[5]); o.w = cvt_pk_bf16(f[6], f[7]); return o; }
__device__ __forceinline__ float shx(float v, int m, int lane) { return __int_as_float(__builtin_amdgcn_ds_bpermute((lane ^ m) << 2, __float_as_int(v))); }
__device__ __forceinline__ float shup(float v, int d, int lane) { return __int_as_float(__builtin_amdgcn_ds_bpermute((lane - d) << 2, __float_as_int(v))); }
__device__ __forceinline__ float wave_sum(float v, int lane) {
#pragma unroll
    for (int o = 1; o < 64; o <<= 1) v += shx(v, o, lane);
    return v;
}
__device__ __forceinline__ float sigmoidf_(float x) { return 1.0f / (1.0f + __expf(-x)); }
__device__ __forceinline__ float tanhf_(float x) { const float e = __expf(2.0f * x); return 1.0f - 2.0f / (e + 1.0f); }
__device__ __forceinline__ f32x2 gelu_pk(f32x2 v) {
    const f32x2 av = __builtin_elementwise_abs(v), d = av * 0.2316418882f + 1.0f;
    f32x2 t; t.x = __builtin_amdgcn_rcpf(d.x); t.y = __builtin_amdgcn_rcpf(d.y);
    f32x2 q = t * 0.5307027145f + (-0.7265760135f); q = q * t + 0.7107068705f; q = q * t + (-0.142248368f); q = q * t + 0.127414796f; q = q * t;
    const f32x2 s = (v * v) * (-0.72134752044f);
    f32x2 e; e.x = __builtin_amdgcn_exp2f(s.x); e.y = __builtin_amdgcn_exp2f(s.y);
    const f32x2 m = v * (q * e), r = v - m;
    f32x2 o; o.x = v.x < 0.f ? m.x : r.x; o.y = v.y < 0.f ? m.y : r.y; return o;
}

#define XB_TMO      128
#define XB_XCNT(j)  (256  + 64 * (j))
#define XB_XSUB(j)  (1280 + 64 * (j))
#define XB_XGEN(j)  (2304 + 64 * (j))
#define XB_TOP      3328
#define XB_TOPGEN   3392
#define XCD_BAR_WORDS 3456
#define XB_SPIN_CAP (1u << 18)
__device__ __forceinline__ unsigned xb_ld(unsigned* p)              { return __hip_atomic_load(p, __ATOMIC_RELAXED, __HIP_MEMORY_SCOPE_AGENT); }
__device__ __forceinline__ unsigned xb_add(unsigned* p, unsigned v) { return __hip_atomic_fetch_add(p, v, __ATOMIC_RELAXED, __HIP_MEMORY_SCOPE_AGENT); }
__device__ __forceinline__ unsigned xb_xcc_id() { return (unsigned)__builtin_amdgcn_s_getreg((3 << 11) | 20) & 0xFu; }
#define XB_SPIN(cond, bar) do { unsigned _sp = 0; while (cond) { __builtin_amdgcn_s_sleep(1); \
    if ((++_sp & 255u) == 0u) { if (xb_ld(&(bar)[XB_TMO])) break; if (_sp > XB_SPIN_CAP) { atomicAdd(&(bar)[XB_TMO], 1u); break; } } } } while (0)
struct XcdBarrier { unsigned* bar; unsigned x; volatile LAS unsigned* st; };
__device__ __forceinline__ XcdBarrier xcd_barrier_post(unsigned* bar, volatile LAS unsigned* st) {
    XcdBarrier b; b.bar = bar; b.x = xb_xcc_id(); b.st = st;
    if (threadIdx.x == 0) (void)xb_add(&bar[XB_XCNT(b.x)], 1u);
    return b;
}
__device__ __forceinline__ void xcd_barrier_complete(unsigned* bar, unsigned x, unsigned& nloc, unsigned& nx) {
    const unsigned G = gridDim.x * gridDim.y * gridDim.z;
    unsigned sum, cnt, mine, sp = 0u;
    for (;;) {
        sum = 0u; cnt = 0u; mine = 0u;
#pragma unroll
        for (unsigned j = 0; j < 16; ++j) { const unsigned c = xb_ld(&bar[XB_XCNT(j)]); sum += c; cnt += (c > 0u) ? 1u : 0u; mine = (j == x) ? c : mine; }
        if (sum == G) break;
        __builtin_amdgcn_s_sleep(1);
        if ((++sp & 255u) == 0u) { if (xb_ld(&bar[XB_TMO])) break; if (sp > XB_SPIN_CAP) { atomicAdd(&bar[XB_TMO], 1u); break; } }
    }
    nloc = mine > 0u ? mine : 1u; nx = cnt > 0u ? cnt : 1u;
}
template <bool FIRST> __device__ __forceinline__ void xcd_barrier(const XcdBarrier& b, const bool leader) {
    asm volatile("s_waitcnt vmcnt(0)" ::: "memory");
    __syncthreads();
    if (leader) {
        unsigned* bar = b.bar;
        __builtin_amdgcn_s_waitcnt(0);
        unsigned nloc = b.st[0], nx = b.st[1];
        if constexpr (FIRST) { if (nloc == 0u) { xcd_barrier_complete(bar, b.x, nloc, nx); b.st[0] = nloc; b.st[1] = nx; } }
        const unsigned old = xb_add(&bar[XB_XSUB(b.x)], 1u);
        const unsigned gen = old / nloc;
        if (old + 1u == (gen + 1u) * nloc) {
            __builtin_amdgcn_fence(__ATOMIC_RELEASE, "agent");
            asm volatile("s_waitcnt vmcnt(0)" ::: "memory");
            const unsigned og = xb_add(&bar[XB_TOP], 1u);
            const unsigned tg = og / nx;
            if (og + 1u == (tg + 1u) * nx) xb_add(&bar[XB_TOPGEN], 1u);
            else XB_SPIN(xb_ld(&bar[XB_TOPGEN]) == tg, bar);
            __builtin_amdgcn_fence(__ATOMIC_ACQUIRE, "agent");
            xb_add(&bar[XB_XGEN(b.x)], 1u);
            asm volatile("s_waitcnt vmcnt(0)" ::: "memory");
        } else {
            XB_SPIN(xb_ld(&bar[XB_XGEN(b.x)]) == gen, bar);
            __builtin_amdgcn_fence(__ATOMIC_ACQUIRE, "agent");
            asm volatile("s_waitcnt vmcnt(0)" ::: "memory");
        }
    }
    __syncthreads();
}

constexpr int LDS_MISC = 143360;
constexpr int LDS_DESC = LDS_MISC + 128;
constexpr int LDS_TAB = LDS_MISC + 512;
constexpr int LDS_BYTES = 147456;
namespace pg8 {
constexpr int BM = 256, BK = 64, HALF = 128, HTB = HALF * BK * 2, STAGE_BYTES = 8 * HTB, NXCD = 8, WGM = 8;
__host__ __device__ __forceinline__ int lds_byte(int r, int c) { const int st = (r >> 4) * 2 + (c >> 5), rr = r & 15, cc = c & 31, ob = rr * 64 + cc * 2; return st * 1024 + (ob ^ (((ob >> 9) & 1) << 5)); }
__host__ __device__ __forceinline__ void stage_rc(int b, int& R, int& C) { const int st = b / 1024, sb = b % 1024, swz = sb ^ (((sb >> 9) & 1) << 5); R = (st >> 1) * 16 + swz / 64; C = (st & 1) * 32 + (swz % 64) / 2; }
__host__ __device__ __forceinline__ int perm32(int rho) { const int n = rho >> 4, i = rho & 15; return 8 * (i >> 2) + 4 * n + (i & 3); }
__device__ __forceinline__ int xcd_remap(int L, int nwg) { const int q = nwg / NXCD, r = nwg % NXCD, xcd = L % NXCD, off = L / NXCD; return (xcd < r ? xcd * (q + 1) : r * (q + 1) + (xcd - r) * q) + off; }

struct Unit { int pm, pn, aux; };

template <class Epi, class Sched, bool GATHER, int K, int LDA, int LDB>
__device__ __forceinline__ void gemm_phase(LAS unsigned char* lds, const Sched& S, const Epi& E, const int tid_in) {
    int tid_ = tid_in; asm volatile("" : "+v"(tid_));
    const int tid = tid_, wid = __builtin_amdgcn_readfirstlane(tid >> 6), lane = tid & 63, wr = wid >> 2, wc = wid & 3, fr = lane & 15, fq = lane >> 4;
    constexpr int nt = K / BK;
    unsigned voffA[2], voffB[2];
#pragma unroll
    for (int i = 0; i < 2; ++i) { int R, C; stage_rc(tid * 16 + i * 8192, R, C); const int Rb = Epi::PERM ? ((R & ~31) + perm32(R & 31)) : R;
        voffA[i] = (unsigned)(R * LDA + C) * 2u; voffB[i] = (unsigned)(Rb * LDB + C) * 2u; }
    constexpr size_t kstep = (size_t)(BK * 2);
    constexpr size_t hstepA = GATHER ? (size_t)0 : (size_t)HALF * LDA * 2, hstepB = (size_t)HALF * LDB * 2;
    const unsigned ldsw = (unsigned)wid * 1024u;
    const int aoff = lds_byte(wr * 64 + fr, fq * 8), boff = lds_byte(wc * 32 + fr, fq * 8);
    unsigned gA[2][2], gN[2][2];
#define PG8_SA(b, h) (((b) * 2 + (h)) * HTB)
#define PG8_SB(b, h) ((4 + (b) * 2 + (h)) * HTB)
#define PG8_STAGEB(bufoff, gbase) do { _Pragma("unroll") for (int _i = 0; _i < 2; ++_i) \
        __builtin_amdgcn_global_load_lds((const unsigned*)((const char*)(gbase) + voffB[_i]), (LAS unsigned*)(lds + (bufoff) + ldsw + _i * 8192), 16, 0, 0); } while (0)
#define PG8_STAGEA(bufoff, gbase, h, GV) do { _Pragma("unroll") for (int _i = 0; _i < 2; ++_i) \
        __builtin_amdgcn_global_load_lds((const unsigned*)((const char*)(gbase) + (GATHER ? GV[h][_i] : voffA[_i]) + (h) * hstepA), (LAS unsigned*)(lds + (bufoff) + ldsw + _i * 8192), 16, 0, 0); } while (0)
#define PG8_LDA(dst, b, h) do { _Pragma("unroll") for (int m = 0; m < 4; ++m) _Pragma("unroll") for (int k = 0; k < 2; ++k) dst[m][k] = *(const LAS bf16x8*)(lds + PG8_SA(b, h) + aoff + m * 2048 + k * 1024); } while (0)
#define PG8_LDB(dst, b, h) do { _Pragma("unroll") for (int n = 0; n < 2; ++n) _Pragma("unroll") for (int k = 0; k < 2; ++k) dst[n][k] = *(const LAS bf16x8*)(lds + PG8_SB(b, h) + boff + n * 2048 + k * 1024); } while (0)
#define PG8_MMA(ai, bj, At, Bt) do { __builtin_amdgcn_s_setprio(1); _Pragma("unroll") for (int m = 0; m < 4; ++m) _Pragma("unroll") for (int n = 0; n < 2; ++n) _Pragma("unroll") for (int k = 0; k < 2; ++k) \
        acc[ai][bj][m][n] = __builtin_amdgcn_mfma_f32_16x16x32_bf16(Bt[n][k], At[m][k], acc[ai][bj][m][n], 0, 0, 0); __builtin_amdgcn_s_setprio(0); } while (0)
#define PG8_WAIT_V(n) asm volatile("s_waitcnt vmcnt(" #n ")" ::: "memory")
#define PG8_WAIT_L(n) asm volatile("s_waitcnt lgkmcnt(" #n ")" ::: "memory")
#define PG8_BAR __builtin_amdgcn_s_barrier()
#define PG8_SCHED __builtin_amdgcn_sched_barrier(0)
    Unit cur, nxt; int ui = 0;
    if (!S.next(0, cur)) return;
    f32x4 acc[2][2][4][2];
#pragma unroll
    for (int a = 0; a < 2; ++a)
#pragma unroll
        for (int b = 0; b < 2; ++b)
#pragma unroll
            for (int m = 0; m < 4; ++m)
#pragma unroll
                for (int n = 0; n < 2; ++n) acc[a][b][m][n] = (f32x4){0.f, 0.f, 0.f, 0.f};
    bf16x8 At[4][2], B0[2][2], B1[2][2];
    const char* cA = S.aptr(cur); const char* cB = S.bptr(cur);
    if constexpr (GATHER) { S.gather(cur, tid, gA); }
    PG8_STAGEB(PG8_SB(0, 0), cB); PG8_STAGEB(PG8_SB(0, 1), cB + hstepB); PG8_STAGEA(PG8_SA(0, 0), cA, 0, gA); PG8_STAGEA(PG8_SA(0, 1), cA, 1, gA);
    if (wr == 1) PG8_BAR;
    PG8_WAIT_V(2); PG8_BAR;
    PG8_STAGEB(PG8_SB(1, 0), cB + kstep); PG8_STAGEA(PG8_SA(1, 0), cA + kstep, 0, gA); PG8_STAGEB(PG8_SB(1, 1), cB + hstepB + kstep);
    PG8_WAIT_V(6); PG8_BAR;
    for (;;) {
        const bool has_next = S.next(ui + 1, nxt);
        const char* nA = has_next ? S.aptr(nxt) : cA; const char* nB = has_next ? S.bptr(nxt) : cB;
        if constexpr (GATHER) { if (has_next) S.gather(nxt, tid, gN); else {
#pragma unroll
            for (int h = 0; h < 2; ++h)
#pragma unroll
                for (int i = 0; i < 2; ++i) gN[h][i] = gA[h][i]; } }
#pragma nounroll
        for (int t = 0; t < nt; t += 2) {
            const bool last = (t == nt - 2);
            const char* a1 = cA + (size_t)(t + 1) * kstep;
            const char* a2 = last ? nA : cA + (size_t)(t + 2) * kstep; const char* b2 = last ? nB : cB + (size_t)(t + 2) * kstep;
            const char* a3 = a2 + kstep; const char* b3 = b2 + kstep;
            unsigned g2[2][2];
            if constexpr (GATHER) {
#pragma unroll
                for (int h = 0; h < 2; ++h)
#pragma unroll
                    for (int i = 0; i < 2; ++i) g2[h][i] = last ? gN[h][i] : gA[h][i]; }
            PG8_LDB(B0, 0, 0); PG8_LDB(B1, 0, 1); PG8_SCHED; PG8_LDA(At, 0, 0); PG8_STAGEA(PG8_SA(1, 1), a1, 1, gA);
            PG8_WAIT_V(8); PG8_WAIT_L(0); PG8_BAR; PG8_MMA(0, 0, At, B0); PG8_MMA(0, 1, At, B1); PG8_BAR; PG8_SCHED;
            PG8_LDA(At, 0, 1); PG8_STAGEB(PG8_SB(0, 0), b2); PG8_STAGEB(PG8_SB(0, 1), b2 + hstepB); PG8_STAGEA(PG8_SA(0, 0), a2, 0, g2);
            PG8_WAIT_V(8); PG8_WAIT_L(0); PG8_BAR; PG8_MMA(1, 0, At, B0); PG8_MMA(1, 1, At, B1); PG8_BAR; PG8_SCHED;
            PG8_LDB(B0, 1, 0); PG8_LDB(B1, 1, 1); PG8_SCHED; PG8_LDA(At, 1, 0); PG8_STAGEA(PG8_SA(0, 1), a2, 1, g2);
            PG8_WAIT_V(8); PG8_WAIT_L(0); PG8_BAR; PG8_MMA(0, 0, At, B0); PG8_MMA(0, 1, At, B1); PG8_BAR; PG8_SCHED;
            PG8_LDA(At, 1, 1); PG8_STAGEB(PG8_SB(1, 0), b3); PG8_STAGEB(PG8_SB(1, 1), b3 + hstepB); PG8_STAGEA(PG8_SA(1, 0), a3, 0, g2);
            PG8_WAIT_V(8); PG8_WAIT_L(0); PG8_BAR; PG8_MMA(1, 0, At, B0); PG8_MMA(1, 1, At, B1); PG8_BAR; PG8_SCHED;
        }
        if (wr == 0) PG8_BAR;
        E(acc, cur, wr, wc, fr, fq);
        if (!has_next) break;
#pragma unroll
        for (int a = 0; a < 2; ++a)
#pragma unroll
            for (int b = 0; b < 2; ++b)
#pragma unroll
                for (int m = 0; m < 4; ++m)
#pragma unroll
                    for (int n = 0; n < 2; ++n) acc[a][b][m][n] = (f32x4){0.f, 0.f, 0.f, 0.f};
        cur = nxt; cA = nA; cB = nB; ++ui;
        if constexpr (GATHER) {
#pragma unroll
            for (int h = 0; h < 2; ++h)
#pragma unroll
                for (int i = 0; i < 2; ++i) gA[h][i] = gN[h][i]; }
        if (wr == 1) PG8_BAR;
    }
    PG8_WAIT_V(0);
    PG8_BAR;
#undef PG8_SA
#undef PG8_SB
#undef PG8_STAGEA
#undef PG8_STAGEB
#undef PG8_LDA
#undef PG8_LDB
#undef PG8_MMA
#undef PG8_WAIT_V
#undef PG8_WAIT_L
#undef PG8_BAR
#undef PG8_SCHED
}
}
using pg8::Unit;

__device__ __forceinline__ void set_desc(LAS unsigned char* lds, int tid, int g, const void* A, const void* B, const void* C, int nN, int ldc, int aux, const void* X1 = nullptr, const void* X2 = nullptr, const void* X3 = nullptr) {
    LAS int* d = (LAS int*)(lds + LDS_DESC) + g * 16;
    if (tid == 0) { unsigned long long a = (unsigned long long)A, b = (unsigned long long)B, c = (unsigned long long)C, x1 = (unsigned long long)X1, x2 = (unsigned long long)X2, x3 = (unsigned long long)X3;
        asm volatile("" : "+s"(a), "+s"(b), "+s"(c), "+s"(x1), "+s"(x2), "+s"(x3), "+s"(nN), "+s"(ldc), "+s"(aux));
        d[0] = (int)(unsigned)a; d[1] = (int)(unsigned)(a >> 32); d[2] = (int)(unsigned)b; d[3] = (int)(unsigned)(b >> 32); d[4] = (int)(unsigned)c; d[5] = (int)(unsigned)(c >> 32); d[6] = nN; d[7] = ldc; d[8] = aux;
        d[10] = (int)(unsigned)x1; d[11] = (int)(unsigned)(x1 >> 32); d[12] = (int)(unsigned)x2; d[13] = (int)(unsigned)(x2 >> 32); d[14] = (int)(unsigned)x3; d[15] = (int)(unsigned)(x3 >> 32); }
}
__device__ __forceinline__ int desc_i(LAS unsigned char* lds, int g, int f) { return __builtin_amdgcn_readfirstlane(((LAS const int*)(lds + LDS_DESC))[g * 16 + f]); }
__device__ __forceinline__ const char* desc_p(LAS unsigned char* lds, int g, int f) {
    const unsigned lo = (unsigned)desc_i(lds, g, f), hi = (unsigned)desc_i(lds, g, f + 1); return (const char*)(((unsigned long long)hi << 32) | lo); }
template <int LDA, int LDB>
struct SchedMulti {
    LAS unsigned char* lds; int nM, ntot, ng;
    __device__ __forceinline__ bool next(int i, Unit& u) const {
        const int nwg = nM * ntot; const long L = (long)i * gridDim.x + blockIdx.x; if (L >= nwg) return false;
        const int wgid = pg8::xcd_remap((int)L, nwg);
        const int nig = pg8::WGM * ntot, gid = wgid / nig, fm = gid * pg8::WGM, gsz = (nM - fm) < pg8::WGM ? (nM - fm) : pg8::WGM;
        u.pm = fm + ((wgid % nig) % gsz); int pv = (wgid % nig) / gsz; int g = 0;
        for (int j = 0; j + 1 < ng; ++j) { const int n = desc_i(lds, j, 6); if (pv < n) break; pv -= n; g = j + 1; }
        u.pn = pv; u.aux = g; return true;
    }
    __device__ __forceinline__ const char* aptr(const Unit& u) const { return desc_p(lds, u.aux, 0) + (size_t)u.pm * (512 * LDA); }
    __device__ __forceinline__ const char* bptr(const Unit& u) const { return desc_p(lds, u.aux, 2) + (size_t)u.pn * (512 * LDB); }
};
template <int LDA, int LDB, bool GATHERED>
struct SchedMoE {
    LAS unsigned char* lds; const char* Abase; const char* Bbase; const int* list;
    __device__ __forceinline__ bool next(int i, Unit& u) const {
        LAS const int* tab = (LAS const int*)(lds + LDS_TAB);
        const int nrt = __builtin_amdgcn_readfirstlane(tab[2 * MAXRT + 32]);
        const int nwg = nrt * 4; const long L = (long)i * gridDim.x + blockIdx.x; if (L >= nwg) return false;
        const int wgid = pg8::xcd_remap((int)L, nwg);
        u.pm = wgid >> 2; u.pn = wgid & 3; u.aux = __builtin_amdgcn_readfirstlane(tab[u.pm]); return true;
    }
    __device__ __forceinline__ const char* aptr(const Unit& u) const { return GATHERED ? Abase : Abase + (size_t)u.pm * (512 * LDA); }
    __device__ __forceinline__ const char* bptr(const Unit& u) const { return Bbase + (size_t)u.aux * ((size_t)D * LDB * 2) + (size_t)u.pn * (512 * LDB); }
    __device__ __forceinline__ void gather(const Unit& u, int tid, unsigned (&g)[2][2]) const {
        LAS const int* tab = (LAS const int*)(lds + LDS_TAB);
        const int j0 = __builtin_amdgcn_readfirstlane(tab[MAXRT + u.pm]), cn = __builtin_amdgcn_readfirstlane(tab[2 * MAXRT + u.aux]);
#pragma unroll
        for (int i = 0; i < 2; ++i) { int R, C; pg8::stage_rc(tid * 16 + i * 8192, R, C);
#pragma unroll
            for (int h = 0; h < 2; ++h) { const int slot = j0 + 128 * h + R; const int a = slot < cn ? list[(size_t)u.aux * LISTCAP + slot] : 0;
                g[h][i] = (unsigned)((a >> 1) * LDA + C) * 2u; } }
    }
};
__device__ __forceinline__ void moe_tables(LAS unsigned char* lds, int tid, const unsigned* cnt) {
    LAS int* tab = (LAS int*)(lds + LDS_TAB);
    __syncthreads();
    if (tid < 64) {
        const int e = tid & 31; const bool act = tid < NE;
        const int c = act ? (int)__hip_atomic_load(cnt + e, __ATOMIC_RELAXED, __HIP_MEMORY_SCOPE_AGENT) : 0;
        const int nt = (c + 255) >> 8; int incl = nt;
#pragma unroll
        for (int d = 1; d < 32; d <<= 1) { const int t = __builtin_amdgcn_ds_bpermute((tid >= d ? tid - d : tid) << 2, incl); if (tid >= d) incl += t; }
        if (act) { const int start = incl - nt; tab[2 * MAXRT + e] = c;
#pragma nounroll
            for (int j = 0; j < nt; ++j) { tab[start + j] = e; tab[MAXRT + start + j] = j * 256; }
            if (tid == NE - 1) tab[2 * MAXRT + 32] = incl; }
    }
    __syncthreads();
}

#define EPI_FENCE() asm volatile("" ::: "memory")
struct EpiGelu {
    static constexpr bool PERM = true;
    LAS unsigned char* lds;
    __device__ __forceinline__ void operator()(const f32x4 (&acc)[2][2][4][2], const Unit& u, int wr, int wc, int fr, int fq) const {
        const bool isv = u.pn >= 8; bf16_t* base = (bf16_t*)desc_p(lds, 0, isv ? 10 : 4); const float* bias = (const float*)desc_p(lds, 0, 12); float* stat = (float*)desc_p(lds, 0, 14);
        const int col0 = (u.pn & 7) * 256 + wc * 32 + 8 * fq, bcol0 = u.pn * 256 + wc * 32 + 8 * fq, row0 = u.pm * 256 + wr * 64 + fr;
        f32x4 bv[2][2];
#pragma unroll
        for (int bj = 0; bj < 2; ++bj)
#pragma unroll
            for (int n = 0; n < 2; ++n) bv[bj][n] = *(const f32x4*)(bias + bcol0 + bj * 128 + 4 * n);
#pragma unroll
        for (int ai = 0; ai < 2; ++ai)
#pragma unroll
            for (int m = 0; m < 4; ++m) { const int row = row0 + ai * 128 + m * 16; bf16_t* rowp = base + (size_t)row * GWID + col0; float s = 0.f, q = 0.f;
#pragma unroll
                for (int bj = 0; bj < 2; ++bj) { const f32x4 v0 = acc[ai][bj][m][0] + bv[bj][0], v1 = acc[ai][bj][m][1] + bv[bj][1];
                    const f32x2 a = gelu_pk((f32x2){v0[0], v0[1]}), b = gelu_pk((f32x2){v0[2], v0[3]}), c = gelu_pk((f32x2){v1[0], v1[1]}), d = gelu_pk((f32x2){v1[2], v1[3]});
                    s += ((a.x + a.y) + (b.x + b.y)) + ((c.x + c.y) + (d.x + d.y));
                    q += ((a.x * a.x + a.y * a.y) + (b.x * b.x + b.y * b.y)) + ((c.x * c.x + c.y * c.y) + (d.x * d.x + d.y * d.y));
                    u32x4 w; w.x = cvt_pk_bf16(a.x, a.y); w.y = cvt_pk_bf16(b.x, b.y); w.z = cvt_pk_bf16(c.x, c.y); w.w = cvt_pk_bf16(d.x, d.y);
                    *(u32x4*)(rowp + bj * 128) = w; }
                if (isv) { const int ln_ = 16 * fq + fr; s += shx(s, 16, ln_); s += shx(s, 32, ln_); q += shx(q, 16, ln_); q += shx(q, 32, ln_);
                    if (fq == 0) *(f32x2*)(stat + ((size_t)row * 32 + (u.pn - 8) * 4 + wc) * 2) = (f32x2){s, q}; } }
    }
};
struct EpiResid {
    static constexpr bool PERM = true;
    LAS unsigned char* lds;
    __device__ __forceinline__ void operator()(const f32x4 (&acc)[2][2][4][2], const Unit& u, int wr, int wc, int fr, int fq) const {
        const int mrow = u.pm < 64 ? 0 : (u.pm < 128 ? 1 : 2);
        bf16_t* x = (bf16_t*)desc_p(lds, 0, 4) + (size_t)(u.pm * 256 + wr * 64 + fr) * D + u.pn * 256 + wc * 32 + 8 * fq;
        const float* bias = (const float*)desc_p(lds, 0, 14); const float* gate = (const float*)desc_p(lds, 1, 10) + mrow * 6 * D + u.pn * 256 + wc * 32 + 8 * fq;
        if (bias) bias += u.pn * 256 + wc * 32 + 8 * fq;
#pragma unroll
        for (int bj = 0; bj < 2; ++bj) { const int c = bj * 128;
            const f32x4 b0 = bias ? *(const f32x4*)(bias + c) : (f32x4){0.f, 0.f, 0.f, 0.f}, b1 = bias ? *(const f32x4*)(bias + c + 4) : (f32x4){0.f, 0.f, 0.f, 0.f};
            const f32x4 g0 = *(const f32x4*)(gate + c), g1 = *(const f32x4*)(gate + c + 4);
            u32x4 xw[2][4];
#pragma unroll
            for (int ai = 0; ai < 2; ++ai)
#pragma unroll
                for (int m = 0; m < 4; ++m) xw[ai][m] = *(const u32x4*)(x + (size_t)(ai * 128 + m * 16) * D + c);
#pragma unroll
            for (int ai = 0; ai < 2; ++ai) {
#pragma unroll
                for (int m = 0; m < 4; ++m) { const u32x4 w = xw[ai][m];
                    const f32x4 o0 = (f32x4){bf_lo(w.x), bf_hi(w.x), bf_lo(w.y), bf_hi(w.y)} + g0 * (acc[ai][bj][m][0] + b0), o1 = (f32x4){bf_lo(w.z), bf_hi(w.z), bf_lo(w.w), bf_hi(w.w)} + g1 * (acc[ai][bj][m][1] + b1);
                    u32x4 w2; w2.x = cvt_pk_bf16(o0[0], o0[1]); w2.y = cvt_pk_bf16(o0[2], o0[3]); w2.z = cvt_pk_bf16(o1[0], o1[1]); w2.w = cvt_pk_bf16(o1[2], o1[3]);
                    *(u32x4*)(x + (size_t)(ai * 128 + m * 16) * D + c) = w2; }
                EPI_FENCE(); } }
    }
};
template <int K>
__device__ __forceinline__ void tail_resid(LAS unsigned char* lds, int wave) {
    const int lane = lane_id_now(), fr = lane & 15, q = lane >> 4, tid = wave * 64 + lane;
    constexpr int KW = K / 8, RP = 68;
    LAS float* red = (LAS float*)lds;
    const bf16_t* A = (const bf16_t*)desc_p(lds, 0, 0) + (size_t)TL * K; const bf16_t* W = (const bf16_t*)desc_p(lds, 0, 2);
    bf16_t* X = (bf16_t*)desc_p(lds, 0, 4) + (size_t)TL * D; const float* bias = (const float*)desc_p(lds, 0, 14); const float* gate = (const float*)desc_p(lds, 1, 10) + 2 * 6 * D;
    for (int item = blockIdx.x; item < TC / 16 * 16; item += gridDim.x) {
        const int r0 = (item >> 4) * 16, c0 = (item & 15) * 64;
        const bf16_t* ap = A + (size_t)(r0 + fr) * K + wave * KW + 16 * q;
        const bf16_t* bp = W + (size_t)(c0 + fr) * K + wave * KW + 16 * q;
        const int erow = tid >> 5, ec2 = 2 * (tid & 31), ecol = c0 + ec2; bf16_t* ep = X + (size_t)(r0 + erow) * D + ecol;
        const unsigned exw = *(const unsigned*)ep; const float eb0 = bias ? bias[ecol] : 0.f, eb1 = bias ? bias[ecol + 1] : 0.f, eg0 = gate[ecol], eg1 = gate[ecol + 1];
        f32x4 acc[4];
#pragma unroll
        for (int n = 0; n < 4; ++n) acc[n] = (f32x4){0.f, 0.f, 0.f, 0.f};
#pragma unroll
        for (int kb = 0; kb < KW / 64; ++kb) {
            const bf16x8 a0 = *(const bf16x8*)(ap + kb * 64), a1 = *(const bf16x8*)(ap + kb * 64 + 8);
#pragma unroll
            for (int n = 0; n < 4; ++n) { const bf16x8 b0 = *(const bf16x8*)(bp + (size_t)n * 16 * K + kb * 64), b1 = *(const bf16x8*)(bp + (size_t)n * 16 * K + kb * 64 + 8);
                acc[n] = __builtin_amdgcn_mfma_f32_16x16x32_bf16(a0, b0, acc[n], 0, 0, 0); acc[n] = __builtin_amdgcn_mfma_f32_16x16x32_bf16(a1, b1, acc[n], 0, 0, 0); }
        }
#pragma unroll
        for (int n = 0; n < 4; ++n)
#pragma unroll
            for (int r = 0; r < 4; ++r) red[(wave * 16 + 4 * q + r) * RP + n * 16 + fr] = acc[n][r];
        __syncthreads();
        { float s0 = 0.f, s1 = 0.f;
#pragma unroll
          for (int w = 0; w < 8; ++w) { const f32x2 v = *(LAS const f32x2*)(red + (w * 16 + erow) * RP + ec2); s0 += v.x; s1 += v.y; }
          *(unsigned*)ep = cvt_pk_bf16(bf_lo(exw) + eg0 * (s0 + eb0), bf_hi(exw) + eg1 * (s1 + eb1)); }
        __syncthreads();
    }
}
__device__ __forceinline__ void tail_gelu(LAS unsigned char* lds, int wave) {
    const int lane = lane_id_now(), fr = lane & 15, q = lane >> 4, tid = wave * 64 + lane;
    constexpr int K = D, KW = K / 8, RP = 260;
    LAS float* red = (LAS float*)lds;
    const bf16_t* A = (const bf16_t*)desc_p(lds, 0, 0) + (size_t)TL * K; const bf16_t* W = (const bf16_t*)desc_p(lds, 0, 2);
    const float* bias = (const float*)desc_p(lds, 0, 12); float* stat = (float*)desc_p(lds, 0, 14);
    for (int item = blockIdx.x; item < TC / 16 * 16; item += gridDim.x) {
        const int r0 = (item >> 4) * 16, c0 = (item & 15) * 256;
        const bf16_t* ap = A + (size_t)(r0 + fr) * K + wave * KW + 16 * q;
        const bf16_t* bp = W + (size_t)(c0 + fr) * K + wave * KW + 16 * q;
        const bf16x8 a0 = *(const bf16x8*)(ap), a1 = *(const bf16x8*)(ap + 8), a2 = *(const bf16x8*)(ap + 64), a3 = *(const bf16x8*)(ap + 72);
#pragma unroll 1
        for (int ng = 0; ng < 4; ++ng) {
            f32x4 acc[4];
#pragma unroll
            for (int n = 0; n < 4; ++n) { const bf16_t* b = bp + (size_t)(ng * 4 + n) * 16 * K;
                const bf16x8 b0 = *(const bf16x8*)(b), b1 = *(const bf16x8*)(b + 8), b2 = *(const bf16x8*)(b + 64), b3 = *(const bf16x8*)(b + 72);
                f32x4 c = (f32x4){0.f, 0.f, 0.f, 0.f};
                c = __builtin_amdgcn_mfma_f32_16x16x32_bf16(a0, b0, c, 0, 0, 0); c = __builtin_amdgcn_mfma_f32_16x16x32_bf16(a1, b1, c, 0, 0, 0);
                c = __builtin_amdgcn_mfma_f32_16x16x32_bf16(a2, b2, c, 0, 0, 0); c = __builtin_amdgcn_mfma_f32_16x16x32_bf16(a3, b3, c, 0, 0, 0); acc[n] = c; }
#pragma unroll
            for (int n = 0; n < 4; ++n)
#pragma unroll
                for (int r = 0; r < 4; ++r) red[(wave * 16 + 4 * q + r) * RP + (ng * 4 + n) * 16 + fr] = acc[n][r];
        }
        __syncthreads();
        { const int row = tid >> 5, c8 = 8 * (tid & 31); f32x4 s0 = (f32x4){0.f, 0.f, 0.f, 0.f}, s1 = s0;
#pragma unroll
          for (int w = 0; w < 8; ++w) { s0 += *(LAS const f32x4*)(red + (w * 16 + row) * RP + c8); s1 += *(LAS const f32x4*)(red + (w * 16 + row) * RP + c8 + 4); }
          const int col = c0 + c8; const bool isv = col >= GWID; bf16_t* base = (bf16_t*)desc_p(lds, 0, isv ? 10 : 4);
          s0 += *(const f32x4*)(bias + col); s1 += *(const f32x4*)(bias + col + 4);
          const f32x2 a = gelu_pk((f32x2){s0[0], s0[1]}), b = gelu_pk((f32x2){s0[2], s0[3]}), c = gelu_pk((f32x2){s1[0], s1[1]}), d = gelu_pk((f32x2){s1[2], s1[3]});
          u32x4 w; w.x = cvt_pk_bf16(a.x, a.y); w.y = cvt_pk_bf16(b.x, b.y); w.z = cvt_pk_bf16(c.x, c.y); w.w = cvt_pk_bf16(d.x, d.y);
          *(u32x4*)(base + (size_t)(TL + r0 + row) * GWID + (col & (GWID - 1))) = w;
          if (isv) { float s = ((a.x + a.y) + (b.x + b.y)) + ((c.x + c.y) + (d.x + d.y)), qq = ((a.x * a.x + a.y * a.y) + (b.x * b.x + b.y * b.y)) + ((c.x * c.x + c.y * c.y) + (d.x * d.x + d.y * d.y));
              s += shx(s, 1, lane); s += shx(s, 2, lane); s += shx(s, 4, lane); qq += shx(qq, 1, lane); qq += shx(qq, 2, lane); qq += shx(qq, 4, lane);
              if ((lane & 7) == 0) *(f32x2*)(stat + ((size_t)(TL + r0 + row) * 32 + ((col - GWID) >> 6)) * 2) = (f32x2){s, qq}; } }
        __syncthreads();
    }
}
struct EpiAct {
    static constexpr bool PERM = true;
    LAS unsigned char* lds;
    __device__ __forceinline__ void operator()(const f32x4 (&acc)[2][2][4][2], const Unit& u, int wr, int wc, int fr, int fq) const {
        bf16_t* C = (bf16_t*)desc_p(lds, u.aux, 4); const int ldc = desc_i(lds, u.aux, 7), act = desc_i(lds, u.aux, 8);
        const int col0 = u.pn * 256 + wc * 32 + 8 * fq, row0 = u.pm * 256 + wr * 64 + fr;
#pragma unroll
        for (int ai = 0; ai < 2; ++ai)
#pragma unroll
            for (int m = 0; m < 4; ++m) { bf16_t* rowp = C + (size_t)(row0 + ai * 128 + m * 16) * ldc + col0;
#pragma unroll
                for (int bj = 0; bj < 2; ++bj) { f32x4 v0 = acc[ai][bj][m][0], v1 = acc[ai][bj][m][1];
                    if (act == 1) {
#pragma unroll
                        for (int j = 0; j < 4; ++j) { v0[j] = tanhf_(v0[j]); v1[j] = tanhf_(v1[j]); } }
                    else if (act == 2) {
#pragma unroll
                        for (int j = 0; j < 4; ++j) { v0[j] = sigmoidf_(v0[j]); v1[j] = sigmoidf_(v1[j]); } }
                    u32x4 w; w.x = cvt_pk_bf16(v0[0], v0[1]); w.y = cvt_pk_bf16(v0[2], v0[3]); w.z = cvt_pk_bf16(v1[0], v1[1]); w.w = cvt_pk_bf16(v1[2], v1[3]);
                    *(u32x4*)(rowp + bj * 128) = w; } }
    }
};
struct EpiLogits {
    static constexpr bool PERM = false;
    float* LG;
    __device__ __forceinline__ void operator()(const f32x4 (&acc)[2][2][4][2], const Unit& u, int wr, int wc, int fr, int fq) const {
        if (wc >= 2) return;
        const int col0 = wc * 32 + 4 * fq, row0 = u.pm * 256 + wr * 64 + fr;
#pragma unroll
        for (int ai = 0; ai < 2; ++ai)
#pragma unroll
            for (int m = 0; m < 4; ++m)
#pragma unroll
                for (int n = 0; n < 2; ++n) *(f32x4*)(LG + (size_t)(row0 + ai * 128 + m * 16) * 64 + col0 + n * 16) = acc[ai][0][m][n] + acc[ai][1][m][n];
    }
};
struct EpiSiluGate {
    static constexpr bool PERM = true;
    bf16_t* H;
    __device__ __forceinline__ void operator()(const f32x4 (&acc)[2][2][4][2], const Unit& u, int wr, int wc, int fr, int fq) const {
        const int col0 = u.pn * 128 + wc * 32 + 8 * fq, row0 = u.pm * 256 + wr * 64 + fr;
#pragma unroll
        for (int ai = 0; ai < 2; ++ai)
#pragma unroll
            for (int m = 0; m < 4; ++m) { f32x4 h0, h1;
#pragma unroll
                for (int j = 0; j < 4; ++j) { const float g0 = acc[ai][0][m][0][j], g1 = acc[ai][0][m][1][j]; h0[j] = g0 * sigmoidf_(g0) * acc[ai][1][m][0][j]; h1[j] = g1 * sigmoidf_(g1) * acc[ai][1][m][1][j]; }
                u32x4 w; w.x = cvt_pk_bf16(h0[0], h0[1]); w.y = cvt_pk_bf16(h0[2], h0[3]); w.z = cvt_pk_bf16(h1[0], h1[1]); w.w = cvt_pk_bf16(h1[2], h1[3]);
                *(u32x4*)(H + (size_t)(row0 + ai * 128 + m * 16) * EHID + col0) = w; }
    }
};
struct EpiScatter {
    static constexpr bool PERM = true;
    LAS unsigned char* lds; bf16_t* YB; const int* list;
    __device__ __forceinline__ void operator()(const f32x4 (&acc)[2][2][4][2], const Unit& u, int wr, int wc, int fr, int fq) const {
        LAS const int* tab = (LAS const int*)(lds + LDS_TAB);
        const int j0 = __builtin_amdgcn_readfirstlane(tab[MAXRT + u.pm]), cn = __builtin_amdgcn_readfirstlane(tab[2 * MAXRT + u.aux]);
        const int col0 = u.pn * 256 + wc * 32 + 8 * fq;
        int aid[2][4];
#pragma unroll
        for (int ai = 0; ai < 2; ++ai)
#pragma unroll
            for (int m = 0; m < 4; ++m) { const int slot = j0 + ai * 128 + wr * 64 + m * 16 + fr; aid[ai][m] = slot < cn ? list[(size_t)u.aux * LISTCAP + slot] : -1; }
#pragma unroll
        for (int ai = 0; ai < 2; ++ai)
#pragma unroll
            for (int m = 0; m < 4; ++m) { const int a = aid[ai][m];
                if (a >= 0) { bf16_t* rowp = YB + (size_t)a * D + col0;
#pragma unroll
                    for (int bj = 0; bj < 2; ++bj) { const f32x4 v0 = acc[ai][bj][m][0], v1 = acc[ai][bj][m][1];
                        u32x4 w; w.x = cvt_pk_bf16(v0[0], v0[1]); w.y = cvt_pk_bf16(v0[2], v0[3]); w.z = cvt_pk_bf16(v1[0], v1[1]); w.w = cvt_pk_bf16(v1[2], v1[3]);
                        *(u32x4*)(rowp + bj * 128) = w; } } }
    }
};

struct Params { const float* in[42]; float* out; unsigned char* ws; int ph_lo, ph_hi; };
enum { I_X = 0, I_C, I_CTX, I_CCTX, I_ADAW, I_ADAB, I_N1G, I_N2G, I_FG, I_GWIN, I_GBIN, I_GLNG, I_GLNB, I_GWS, I_GBS, I_GWOUT, I_GBOUT,
       I_MU, I_WR, I_WK, I_WV, I_WO, I_W0, I_W1, I_W2, I_A0, I_A1, I_A2, I_G1, I_G2, I_KK, I_KA, I_RK, I_LNG, I_LNB,
       I_MWGRP, I_MBGRP, I_MWEXP, I_MBEXP, I_MWG, I_MWU, I_MWD };
struct Frame { LAS unsigned char* lds; int tid, lane, wave, G, gw, NGW; };
typedef const __attribute__((address_space(4))) Params* KP;

constexpr int TRP = 36, TR_SCR = 64 * TRP * 4;
__device__ __forceinline__ void tr_item(const float* W, int N, int kmax, bf16_t* WT, int ldk, int k0, int n0, int drow0, int dk0, LAS float* scr, int lane) {
    const int n4 = lane & 7, kr = lane >> 3; f32x4 v[8];
#pragma unroll
    for (int i = 0; i < 8; ++i) { const int k = k0 + 8 * i + kr; v[i] = k < kmax ? *(const f32x4*)(W + (size_t)k * N + n0 + 4 * n4) : (f32x4){0.f, 0.f, 0.f, 0.f}; }
#pragma unroll
    for (int i = 0; i < 8; ++i) *(LAS f32x4*)(scr + (8 * i + kr) * TRP + 4 * n4) = v[i];
    asm volatile("s_waitcnt lgkmcnt(0)" ::: "memory");
    const int c = lane & 7;
#pragma unroll
    for (int j = 0; j < 4; ++j) { const int n = (lane >> 3) + 8 * j; const LAS float* sp = scr + (8 * c) * TRP + n;
        u32x4 o; o.x = cvt_pk_bf16(sp[0 * TRP], sp[1 * TRP]); o.y = cvt_pk_bf16(sp[2 * TRP], sp[3 * TRP]); o.z = cvt_pk_bf16(sp[4 * TRP], sp[5 * TRP]); o.w = cvt_pk_bf16(sp[6 * TRP], sp[7 * TRP]);
        *(u32x4*)(WT + (size_t)(drow0 + n) * ldk + dk0 + k0 + 8 * c) = o; }
    asm volatile("s_waitcnt lgkmcnt(0)" ::: "memory");
}
constexpr int LDS_JOBS = 80 * 1024, MAXJOBS = 48;
__device__ __forceinline__ void add_job(LAS int* jobs, int& nj, int& nit, const float* src, int N, int kmax, int kpad, bf16_t* dst, int ldk, int drow0, int dk0) {
    LAS int* q = jobs + nj * 12; const unsigned long long a = (unsigned long long)src, d = (unsigned long long)dst;
    q[0] = (int)(unsigned)a; q[1] = (int)(unsigned)(a >> 32); q[2] = (int)(unsigned)d; q[3] = (int)(unsigned)(d >> 32); q[4] = N; q[5] = kmax; q[6] = kpad / 64; q[7] = ldk; q[8] = drow0; q[9] = dk0; q[10] = nit;
    nit += (kpad / 64) * (N / 32); ++nj;
}
__device__ __forceinline__ void zero_fill(const Frame& F, bf16_t* p, size_t nbytes) {
    u32x4* q = (u32x4*)p; const size_t n = nbytes / 16;
    for (size_t i = (size_t)blockIdx.x * NTHR + F.tid; i < n; i += (size_t)F.G * NTHR) q[i] = (u32x4){0u, 0u, 0u, 0u};
}

__device__ __forceinline__ void prologue_phase(const Frame& F, KP P) {
    unsigned char* ws = P->ws;
    {   float* MOD = (float*)(ws + WS_MOD); LAS float* part = (LAS float*)F.lds;
        const float* c = P->in[I_C]; const float* cc = P->in[I_CCTX];
        for (int item = blockIdx.x; item < DEPTH * 24; item += F.G) {
            const int layer = item / 24, col = (item % 24) * 256 + 4 * F.lane; const float* w = P->in[I_ADAW] + (size_t)layer * D * 6 * D + col;
            f32x4 a0 = (f32x4){0.f, 0.f, 0.f, 0.f}, a1 = a0, a2 = a0;
#pragma unroll 8
            for (int i = 0; i < 128; ++i) { const int d = F.wave + 8 * i; const f32x4 wv = *(const f32x4*)(w + (size_t)d * 6 * D);
                const float c0 = c[d], c1 = c[D + d], c2 = cc[d];
                a0 += wv * (c0 * sigmoidf_(c0)); a1 += wv * (c1 * sigmoidf_(c1)); a2 += wv * (c2 * sigmoidf_(c2)); }
            __syncthreads();
            *(LAS f32x4*)(part + (F.wave * 3 + 0) * 256 + 4 * F.lane) = a0; *(LAS f32x4*)(part + (F.wave * 3 + 1) * 256 + 4 * F.lane) = a1; *(LAS f32x4*)(part + (F.wave * 3 + 2) * 256 + 4 * F.lane) = a2;
            __syncthreads();
            if (F.wave < 3) { f32x4 sacc = (f32x4){0.f, 0.f, 0.f, 0.f};
#pragma unroll
                for (int w8 = 0; w8 < 8; ++w8) sacc += *(const LAS f32x4*)(part + (w8 * 3 + F.wave) * 256 + 4 * F.lane);
                *(f32x4*)(MOD + ((size_t)layer * 3 + F.wave) * 6 * D + col) = sacc + *(const f32x4*)(P->in[I_ADAB] + (size_t)layer * 6 * D + col); }
        }
    }
    LAS int* jobs = (LAS int*)(F.lds + LDS_JOBS); LAS int* jtot = jobs + MAXJOBS * 12;
    __syncthreads();
    if (F.tid == 0) { int nj = 0, nit = 0;
        for (int j = 0; j < 2; ++j) {
            add_job(jobs, nj, nit, P->in[I_GWIN] + (size_t)j * D * 4096, 4096, D, D, (bf16_t*)(ws + WS_WIN) + (size_t)j * 4096 * D, D, 0, 0);
            add_job(jobs, nj, nit, P->in[I_GWOUT] + (size_t)j * GWID * D, D, GWID, GWID, (bf16_t*)(ws + WS_WOUT) + (size_t)j * D * GWID, GWID, 0, 0);
            add_job(jobs, nj, nit, P->in[I_WR] + (size_t)j * D * D, D, D, D, (bf16_t*)(ws + WS_WR) + (size_t)j * D * D, D, 0, 0);
            add_job(jobs, nj, nit, P->in[I_WK] + (size_t)j * D * D, D, D, D, (bf16_t*)(ws + WS_WK) + (size_t)j * D * D, D, 0, 0);
            add_job(jobs, nj, nit, P->in[I_WV] + (size_t)j * D * D, D, D, D, (bf16_t*)(ws + WS_WV) + (size_t)j * D * D, D, 0, 0);
            add_job(jobs, nj, nit, P->in[I_WO] + (size_t)j * D * D, D, D, D, (bf16_t*)(ws + WS_WO) + (size_t)j * D * D, D, 0, 0);
            for (int z = 0; z < 2; ++z) {
                add_job(jobs, nj, nit, P->in[I_W1] + ((size_t)j * 2 + z) * D * 64, 64, D, D, (bf16_t*)(ws + WS_LW1) + (size_t)j * 256 * D, D, z * 64, 0);
                add_job(jobs, nj, nit, P->in[I_A1] + ((size_t)j * 2 + z) * D * 64, 64, D, D, (bf16_t*)(ws + WS_LA1) + (size_t)j * 256 * D, D, z * 64, 0);
                add_job(jobs, nj, nit, P->in[I_W2] + ((size_t)j * 2 + z) * 64 * D, D, 64, 64, (bf16_t*)(ws + WS_W2P) + ((size_t)j * 2 + z) * D * 256, 256, 0, z * 64);
                add_job(jobs, nj, nit, P->in[I_A2] + ((size_t)j * 2 + z) * 64 * D, D, 64, 64, (bf16_t*)(ws + WS_A2P) + ((size_t)j * 2 + z) * D * 256, 256, 0, z * 64); }
            add_job(jobs, nj, nit, P->in[I_G1] + (size_t)j * D * 160, 160, D, D, (bf16_t*)(ws + WS_LG1) + (size_t)j * 256 * D, D, 0, 0);
            add_job(jobs, nj, nit, P->in[I_G2] + (size_t)j * 160 * D, D, 160, 256, (bf16_t*)(ws + WS_G2P) + (size_t)j * D * 256, 256, 0, 0); }
        jtot[0] = nj; jtot[1] = nit; }
    __syncthreads();
    {   const int nj = jtot[0], nit = jtot[1]; LAS float* scr = (LAS float*)(F.lds + F.wave * TR_SCR);
        for (int it = F.gw; it < nit; it += F.NGW) {
            int jb = 0; for (int q = 1; q < nj; ++q) if (it >= jobs[q * 12 + 10]) jb = q;
            jb = __builtin_amdgcn_readfirstlane(jb); LAS const int* q = jobs + jb * 12;
            const float* src = (const float*)(((unsigned long long)(unsigned)q[1] << 32) | (unsigned)q[0]); bf16_t* dst = (bf16_t*)(((unsigned long long)(unsigned)q[3] << 32) | (unsigned)q[2]);
            const int N = q[4], nnb = N / 32, r = it - q[10], kb = r / nnb, nb = r % nnb;
            tr_item(src, N, q[5], dst, q[7], kb * 64, nb * 32, q[8] + nb * 32, q[9], scr, F.lane); }
    }
    for (int j = 0; j < 2; ++j) {
        bf16_t* lw1 = (bf16_t*)(ws + WS_LW1) + (size_t)j * 256 * D; bf16_t* la1 = (bf16_t*)(ws + WS_LA1) + (size_t)j * 256 * D; bf16_t* lg1 = (bf16_t*)(ws + WS_LG1) + (size_t)j * 256 * D;
        zero_fill(F, lw1 + 128 * D, (size_t)128 * D * 2); zero_fill(F, la1 + 128 * D, (size_t)128 * D * 2); zero_fill(F, lg1 + 160 * D, (size_t)96 * D * 2);
        for (int z = 0; z < 2; ++z) { bf16_t* w2p = (bf16_t*)(ws + WS_W2P) + ((size_t)j * 2 + z) * D * 256; bf16_t* a2p = (bf16_t*)(ws + WS_A2P) + ((size_t)j * 2 + z) * D * 256;
            for (int idx = blockIdx.x * NTHR + F.tid; idx < D * 32; idx += F.G * NTHR) { const int n = idx >> 5, ch = idx & 31;
                if ((ch >> 3) != z) { *(u32x4*)(w2p + (size_t)n * 256 + ch * 8) = (u32x4){0u, 0u, 0u, 0u}; *(u32x4*)(a2p + (size_t)n * 256 + ch * 8) = (u32x4){0u, 0u, 0u, 0u}; } } }
    }
    {   bf16_t* wrt = (bf16_t*)(ws + WS_WRT);
        for (int idx = blockIdx.x * NTHR + F.tid; idx < DEPTH * 256 * (D / 8); idx += F.G * NTHR) { const int k0 = (idx & 127) * 8, n = (idx >> 7) & 255, layer = idx >> 15;
            const int nn = n & 127; const bool lo = n >= 128; float w[8];
#pragma unroll
            for (int e = 0; e < 8; ++e) { float x = 0.f;
                if (nn < 4) x = P->in[I_MWGRP][((size_t)layer * D + k0 + e) * 4 + nn]; else if (nn < 36) x = P->in[I_MWEXP][((size_t)layer * D + k0 + e) * NE + nn - 4];
                const float hi = bf_lo(cvt_pk_bf16(x, 0.f)); w[e] = lo ? x - hi : x; }
            *(u32x4*)(wrt + ((size_t)layer * 256 + n) * D + k0) = pack8(w); } }
    {   const float* src = P->in[I_GWS]; bf16_t* dst = (bf16_t*)(ws + WS_WSP); const int n8 = 2 * 16 * 128 * 128 / 8;
        for (int i = blockIdx.x * NTHR + F.tid; i < n8; i += F.G * NTHR) { const f32x4 a = *(const f32x4*)(src + (size_t)i * 8), b = *(const f32x4*)(src + (size_t)i * 8 + 4);
            u32x4 o; o.x = cvt_pk_bf16(a[0], a[1]); o.y = cvt_pk_bf16(a[2], a[3]); o.z = cvt_pk_bf16(b[0], b[1]); o.w = cvt_pk_bf16(b[2], b[3]); *(u32x4*)(dst + (size_t)i * 8) = o; } }
}
struct MoeItem { const float* src; bf16_t* dst; int N, kmax, ldk, k0, n0, drow0; };
__device__ __forceinline__ MoeItem moe_item(KP P, unsigned char* ws, int layer, int it) {
    const int e = it / 768, r = it % 768, m = r >> 8, q = r & 255; const size_t so = ((size_t)layer * NE + e) * (size_t)D * EHID; MoeItem I;
    if (m < 2) { const int kb = q >> 4, n0 = (q & 15) * 32;
        I.src = (m == 0 ? P->in[I_MWG] : P->in[I_MWU]) + so; I.N = EHID; I.kmax = D; I.dst = (bf16_t*)(ws + WS_WGU) + (size_t)e * D * D; I.ldk = D; I.k0 = kb * 64; I.n0 = n0; I.drow0 = 256 * (n0 >> 7) + (n0 & 127) + (m == 1 ? 128 : 0); }
    else { const int kb = q >> 5, n0 = (q & 31) * 32;
        I.src = P->in[I_MWD] + so; I.N = D; I.kmax = EHID; I.dst = (bf16_t*)(ws + WS_WD) + (size_t)e * D * EHID; I.ldk = EHID; I.k0 = kb * 64; I.n0 = n0; I.drow0 = n0; }
    return I;
}
__device__ __forceinline__ void tr_load(const MoeItem& I, int lane, f32x4 (&v)[8]) {
    const int n4 = lane & 7, kr = lane >> 3;
#pragma unroll
    for (int i = 0; i < 8; ++i) v[i] = *(const f32x4*)(I.src + (size_t)(I.k0 + 8 * i + kr) * I.N + I.n0 + 4 * n4);
}
__device__ __forceinline__ void tr_store(const MoeItem& I, int lane, const f32x4 (&v)[8], LAS float* scr) {
    const int n4 = lane & 7, kr = lane >> 3;
#pragma unroll
    for (int i = 0; i < 8; ++i) *(LAS f32x4*)(scr + (8 * i + kr) * TRP + 4 * n4) = v[i];
    asm volatile("s_waitcnt lgkmcnt(0)" ::: "memory");
    const int c = lane & 7;
#pragma unroll
    for (int j = 0; j < 4; ++j) { const int n = (lane >> 3) + 8 * j; const LAS float* sp = scr + (8 * c) * TRP + n;
        u32x4 o; o.x = cvt_pk_bf16(sp[0 * TRP], sp[1 * TRP]); o.y = cvt_pk_bf16(sp[2 * TRP], sp[3 * TRP]); o.z = cvt_pk_bf16(sp[4 * TRP], sp[5 * TRP]); o.w = cvt_pk_bf16(sp[6 * TRP], sp[7 * TRP]);
        *(u32x4*)(I.dst + (size_t)(I.drow0 + n) * I.ldk + I.k0 + 8 * c) = o; }
    asm volatile("s_waitcnt lgkmcnt(0)" ::: "memory");
}
constexpr int MOE_ITEMS = NE * 768, MOE_SPLIT = 14336;
__device__ __forceinline__ void moe_weights_phase(const Frame& F, KP P, int layer, int vgw, int vngw, int it0, int it1) {
    unsigned char* ws = P->ws; LAS float* scr = (LAS float*)(F.lds + F.wave * TR_SCR);
    int it = it0 + vgw; f32x4 v[8], vn[8];
    if (it < it1) { const MoeItem I = moe_item(P, ws, layer, it); tr_load(I, F.lane, v); }
#pragma nounroll
    while (it < it1) { const int nx = it + vngw;
        if (nx < it1) { const MoeItem In = moe_item(P, ws, layer, nx); tr_load(In, F.lane, vn); }
        { const MoeItem I = moe_item(P, ws, layer, it); tr_store(I, F.lane, v, scr); }
#pragma unroll
        for (int i = 0; i < 8; ++i) v[i] = vn[i];
        it = nx; }
}

__device__ __forceinline__ void load_xrow(KP P, const Frame& F, int layer, int row, f32x4 (&v)[4]) {
    if (layer == 0) { const float* xr = row < TL ? P->in[I_X] + (size_t)row * D : P->in[I_CTX] + (size_t)(row - TL) * D;
#pragma unroll
        for (int j = 0; j < 4; ++j) v[j] = *(const f32x4*)(xr + 4 * F.lane + 256 * j); }
    else { const bf16_t* xr = (const bf16_t*)(P->ws + WS_X) + (size_t)row * D;
#pragma unroll
        for (int j = 0; j < 4; ++j) { const u32x2 w = *(const u32x2*)(xr + 4 * F.lane + 256 * j); v[j] = (f32x4){bf_lo(w.x), bf_hi(w.x), bf_lo(w.y), bf_hi(w.y)}; } }
}
__device__ __forceinline__ void load_vec4(const float* p, int lane, f32x4 (&r)[4]) {
#pragma unroll
    for (int j = 0; j < 4; ++j) r[j] = *(const f32x4*)(p + 4 * lane + 256 * j);
}
__device__ __forceinline__ void load_combine(KP P, const Frame& F, int layer, int row, bool combine, const f32x4 (&g2r)[4], f32x4 (&v)[4]) {
    load_xrow(P, F, layer, row, v);
    if (combine) {
        const bf16_t* yb = (const bf16_t*)(P->ws + WS_YB); const float* wg = (const float*)(P->ws + WS_WGT);
        const float w0 = wg[2 * row], w1 = wg[2 * row + 1];
#pragma unroll
        for (int j = 0; j < 4; ++j) { const int col = 4 * F.lane + 256 * j; const u32x2 a = *(const u32x2*)(yb + (size_t)(2 * row) * D + col), b = *(const u32x2*)(yb + (size_t)(2 * row + 1) * D + col);
            const f32x4 g = g2r[j];
            v[j][0] += g[0] * (w0 * bf_lo(a.x) + w1 * bf_lo(b.x)); v[j][1] += g[1] * (w0 * bf_hi(a.x) + w1 * bf_hi(b.x));
            v[j][2] += g[2] * (w0 * bf_lo(a.y) + w1 * bf_lo(b.y)); v[j][3] += g[3] * (w0 * bf_hi(a.y) + w1 * bf_hi(b.y)); }
    }
}
__device__ __forceinline__ void norm1_phase(const Frame& F, KP P, int layer) {
    const bool combine = layer > 0; bf16_t* X = (bf16_t*)(P->ws + WS_X); bf16_t* HL = (bf16_t*)(P->ws + WS_HL);
    f32x4 g1r[4], shr[4], scr[4], g2r[4]; load_vec4(P->in[I_N1G] + (size_t)layer * D, F.lane, g1r); int mc = -1;
#pragma unroll
    for (int j = 0; j < 4; ++j) { shr[j] = (f32x4){0.f, 0.f, 0.f, 0.f}; scr[j] = shr[j]; g2r[j] = shr[j]; }
    for (int row = F.gw; row < T; row += F.NGW) {
        const int m = row < TL ? (row >> 14) : 2; f32x4 v[4];
        if (m != mc) { mc = m; const float* mod = (const float*)(P->ws + WS_MOD) + ((size_t)layer * 3 + m) * 6 * D; load_vec4(mod, F.lane, shr); load_vec4(mod + D, F.lane, scr);
            if (combine) load_vec4((const float*)(P->ws + WS_MOD) + ((size_t)(layer - 1) * 3 + m) * 6 * D + 5 * D, F.lane, g2r); }
        load_combine(P, F, layer, row, combine, g2r, v);
        {
#pragma unroll
            for (int j = 0; j < 4; ++j) { u32x2 o; o.x = cvt_pk_bf16(v[j][0], v[j][1]); o.y = cvt_pk_bf16(v[j][2], v[j][3]); *(u32x2*)(X + (size_t)row * D + 4 * F.lane + 256 * j) = o;
                v[j] = (f32x4){bf_lo(o.x), bf_hi(o.x), bf_lo(o.y), bf_hi(o.y)}; } }
        float ss = 0.f;
#pragma unroll
        for (int j = 0; j < 4; ++j) ss += (v[j][0] * v[j][0] + v[j][1] * v[j][1]) + (v[j][2] * v[j][2] + v[j][3] * v[j][3]);
        const float rstd = rsqrtf(wave_sum(ss, F.lane) * (1.0f / D) + 1e-6f);
#pragma unroll
        for (int j = 0; j < 4; ++j) { const int col = 4 * F.lane + 256 * j;
            const f32x4 h = (v[j] * rstd) * g1r[j] * (scr[j] + 1.0f) + shr[j];
            u32x2 o; o.x = cvt_pk_bf16(h[0], h[1]); o.y = cvt_pk_bf16(h[2], h[3]); *(u32x2*)(HL + (size_t)row * D + col) = o; }
    }
}
__device__ __forceinline__ void final_phase(const Frame& F, KP P) {
    f32x4 fgr[4], g2r[4]; load_vec4(P->in[I_FG], F.lane, fgr); int mc = -1;
#pragma unroll
    for (int j = 0; j < 4; ++j) g2r[j] = (f32x4){0.f, 0.f, 0.f, 0.f};
    for (int row = F.gw; row < TL; row += F.NGW) {
        const int m = row >> 14; f32x4 v[4];
        if (m != mc) { mc = m; load_vec4((const float*)(P->ws + WS_MOD) + ((size_t)(DEPTH - 1) * 3 + m) * 6 * D + 5 * D, F.lane, g2r); }
        load_combine(P, F, DEPTH, row, true, g2r, v);
        float ss = 0.f;
#pragma unroll
        for (int j = 0; j < 4; ++j) ss += (v[j][0] * v[j][0] + v[j][1] * v[j][1]) + (v[j][2] * v[j][2] + v[j][3] * v[j][3]);
        const float rstd = rsqrtf(wave_sum(ss, F.lane) * (1.0f / D) + 1e-6f);
#pragma unroll
        for (int j = 0; j < 4; ++j) { const int col = 4 * F.lane + 256 * j; *(f32x4*)(P->out + (size_t)row * D + col) = (v[j] * rstd) * fgr[j]; }
    }
}
__device__ __forceinline__ void norm2_phase(const Frame& F, KP P, int layer) {
    const int ntok = layer == DEPTH - 1 ? TL : T; bf16_t* HL2 = (bf16_t*)(P->ws + WS_HL);
    f32x4 gr[4], shr[4], scr[4]; load_vec4(P->in[I_N2G] + (size_t)layer * D, F.lane, gr); int mc = -1;
#pragma unroll
    for (int j = 0; j < 4; ++j) { shr[j] = (f32x4){0.f, 0.f, 0.f, 0.f}; scr[j] = shr[j]; }
    for (int row = F.gw; row < ntok; row += F.NGW) {
        const int m = row < TL ? (row >> 14) : 2; f32x4 v[4]; load_xrow(P, F, 1, row, v);
        if (m != mc) { mc = m; const float* mod = (const float*)(P->ws + WS_MOD) + ((size_t)layer * 3 + m) * 6 * D; load_vec4(mod + 3 * D, F.lane, shr); load_vec4(mod + 4 * D, F.lane, scr); }
        float ss = 0.f;
#pragma unroll
        for (int j = 0; j < 4; ++j) ss += (v[j][0] * v[j][0] + v[j][1] * v[j][1]) + (v[j][2] * v[j][2] + v[j][3] * v[j][3]);
        const float rstd = rsqrtf(wave_sum(ss, F.lane) * (1.0f / D) + 1e-6f);
#pragma unroll
        for (int j = 0; j < 4; ++j) { const int col = 4 * F.lane + 256 * j;
            const f32x4 h = (v[j] * rstd) * gr[j] * (scr[j] + 1.0f) + shr[j];
            u32x2 o; o.x = cvt_pk_bf16(h[0], h[1]); o.y = cvt_pk_bf16(h[2], h[3]); *(u32x2*)(HL2 + (size_t)row * D + col) = o; }
    }
    if (!(layer & 1)) moe_weights_phase(F, P, layer, F.gw, F.NGW, 0, MOE_SPLIT);
}
__device__ __forceinline__ void route_phase(const Frame& F, KP P, int layer) {
    const int ntok = layer == DEPTH - 1 ? TL : T; const float* LG = (const float*)(P->ws + WS_LG);
    const float* bgrp = P->in[I_MBGRP] + layer * 4; const float* bexp = P->in[I_MBEXP] + layer * NE;
    unsigned* cnt = (unsigned*)(P->ws + WS_CTL) + CW_CNT + layer * 64; int* list = (int*)(P->ws + WS_LIST); float* wgt = (float*)(P->ws + WS_WGT);
    LAS unsigned* lcnt = (LAS unsigned*)F.lds; LAS unsigned* lbase = lcnt + 32;
    for (int r0 = blockIdx.x * NTHR; r0 < ntok; r0 += F.G * NTHR) {
        const int row = r0 + F.tid; const bool act = row < ntok;
        __syncthreads();
        if (F.tid < 32) lcnt[F.tid] = 0u;
        __syncthreads();
        int e0 = 0, e1 = 0; unsigned k0 = 0, k1 = 0;
        if (act) {
            const float* lg = LG + (size_t)row * 64; const f32x4 g4 = *(const f32x4*)lg;
            float ag[4];
#pragma unroll
            for (int i = 0; i < 4; ++i) ag[i] = g4[i] + bgrp[i];
            int grp = 0; float mx = ag[0];
#pragma unroll
            for (int i = 1; i < 4; ++i) if (ag[i] > mx) { mx = ag[i]; grp = i; }
            float den = 0.f;
#pragma unroll
            for (int i = 0; i < 4; ++i) den += __expf(ag[i] - mx);
            const float pg = 1.0f / den;
            const f32x4 e0v = *(const f32x4*)(lg + 4 + 8 * grp), e1v = *(const f32x4*)(lg + 8 + 8 * grp); const f32x4 b0v = *(const f32x4*)(bexp + 8 * grp), b1v = *(const f32x4*)(bexp + 8 * grp + 4);
            float el[8];
#pragma unroll
            for (int i = 0; i < 4; ++i) { el[i] = e0v[i] + b0v[i]; el[4 + i] = e1v[i] + b1v[i]; }
            int i0 = 0; float t0 = el[0];
#pragma unroll
            for (int i = 1; i < 8; ++i) if (el[i] > t0) { t0 = el[i]; i0 = i; }
            int i1 = -1; float t1 = -3.0e38f;
#pragma unroll
            for (int i = 0; i < 8; ++i) if (i != i0 && el[i] > t1) { t1 = el[i]; i1 = i; }
            const float p0 = 1.0f / (1.0f + __expf(t1 - t0));
            wgt[2 * row] = pg * p0; wgt[2 * row + 1] = pg * (1.0f - p0);
            e0 = grp * 8 + i0; e1 = grp * 8 + i1;
            k0 = atomicAdd((unsigned*)(lcnt + e0), 1u); k1 = atomicAdd((unsigned*)(lcnt + e1), 1u);
        }
        __syncthreads();
        if (F.tid < 32) { const unsigned c = lcnt[F.tid]; lbase[F.tid] = c ? atomicAdd(cnt + F.tid, c) : 0u; }
        __syncthreads();
        if (act) { list[(size_t)e0 * LISTCAP + lbase[e0] + k0] = 2 * row; list[(size_t)e1 * LISTCAP + lbase[e1] + k1] = 2 * row + 1; }
    }
}
__device__ __forceinline__ bf16x8 tr_frag136(const LAS bf16_t* M, int k0, int c0, int lane) {
    LAS bf16_t* p = (LAS bf16_t*)M + (k0 + 8 * (lane >> 4) + ((lane & 15) >> 2)) * 136 + c0 + 4 * (lane & 3);
    const v4s lo = __builtin_amdgcn_ds_read_tr16_b64_v4i16((LAS v4s*)p), hi = __builtin_amdgcn_ds_read_tr16_b64_v4i16((LAS v4s*)(p + 4 * 136));
    return (bf16x8){lo[0], lo[1], lo[2], lo[3], hi[0], hi[1], hi[2], hi[3]};
}
__device__ __forceinline__ bf16x8 tr_frag136p(const LAS bf16_t* M, int k0, int dt, int lane) {
    LAS bf16_t* p = (LAS bf16_t*)M + (k0 + 8 * (lane >> 4) + ((lane & 15) >> 2)) * 136 + 32 * (dt >> 1) + 8 * (lane & 3) + 4 * (dt & 1);
    const v4s lo = __builtin_amdgcn_ds_read_tr16_b64_v4i16((LAS v4s*)p), hi = __builtin_amdgcn_ds_read_tr16_b64_v4i16((LAS v4s*)(p + 4 * 136));
    return (bf16x8){lo[0], lo[1], lo[2], lo[3], hi[0], hi[1], hi[2], hi[3]};
}
__device__ __forceinline__ void spatial_phase(const Frame& F, KP P, int j) {
    bf16_t* U = (bf16_t*)(P->ws + WS_U); const bf16_t* V = (const bf16_t*)(P->ws + WS_V); const float* stat = (const float*)(P->ws + WS_STAT);
    const bf16_t* WSP = (const bf16_t*)(P->ws + WS_WSP) + (size_t)j * 16 * 128 * 128;
    const float* lng = P->in[I_GLNG] + (size_t)j * GWID; const float* lnb = P->in[I_GLNB] + (size_t)j * GWID; const float* bs = P->in[I_GBS] + (size_t)j * 16 * 128;
    LAS bf16_t* Wt = (LAS bf16_t*)F.lds; LAS bf16_t* Vn = Wt + 128 * 136;
    LAS float* mu = (LAS float*)(F.lds + 2 * 128 * 136 * 2); LAS float* rs = mu + 128;
    const int l15 = F.lane & 15, l4 = F.lane >> 4;
    constexpr int NUNIT = (T / 128) * 16;
    const int u0 = (int)((long)blockIdx.x * NUNIT / F.G), u1 = (int)((long)(blockIdx.x + 1) * NUNIT / F.G);
#define SP_LOAD(W_, V_, U_, t0_, g_) do { \
        _Pragma("unroll") for (int i = 0; i < 4; ++i) { const int idx = F.tid + NTHR * i, r = idx >> 4, seg = idx & 15; \
            W_[i] = *(const u32x4*)(WSP + ((size_t)(g_) * 128 + r) * 128 + seg * 8); V_[i] = *(const u32x4*)(V + (size_t)((t0_) + r) * GWID + (g_) * 128 + seg * 8); } \
        { const bf16_t* ur_ = U + (size_t)((t0_) + 16 * F.wave + l15) * GWID + (g_) * 128 + 8 * l4; \
          _Pragma("unroll") for (int e = 0; e < 4; ++e) U_[e] = *(const u32x4*)(ur_ + e * 32); } } while (0)
    u32x4 wv[4], vv[4], uu[4];
    if (u0 < u1) SP_LOAD(wv, vv, uu, (u0 >> 4) * 128, u0 & 15);
    int cprev = -1;
#pragma nounroll
    for (int u = u0; u < u1; ++u) { const int c = u >> 4, g = u & 15, t0 = c * 128;
        if (c != cprev) { cprev = c;
            if (F.tid < 128) { const int row = t0 + F.tid; float s = 0.f, q = 0.f;
#pragma unroll
                for (int i = 0; i < 16; ++i) { const f32x4 p = *(const f32x4*)(stat + ((size_t)row * 32 + 2 * i) * 2); s += p[0] + p[2]; q += p[1] + p[3]; }
                const float mean = s * (1.0f / GWID), var = q * (1.0f / GWID) - mean * mean; mu[F.tid] = mean; rs[F.tid] = rsqrtf(var + 1e-5f); } }
        LDS_BARRIER();
#pragma unroll
        for (int i = 0; i < 4; ++i) { const int idx = F.tid + NTHR * i, r = idx >> 4, seg = idx & 15, ch = g * 128 + seg * 8;
            *(LAS u32x4*)(Wt + r * 136 + seg * 8) = wv[i];
            float x[8], o[8]; unpack8(vv[i], x); const float m_ = mu[r], r_ = rs[r];
            const f32x4 g0 = *(const f32x4*)(lng + ch), g1 = *(const f32x4*)(lng + ch + 4), b0 = *(const f32x4*)(lnb + ch), b1 = *(const f32x4*)(lnb + ch + 4);
#pragma unroll
            for (int e = 0; e < 8; ++e) o[e] = (x[e] - m_) * r_ * (e < 4 ? g0[e & 3] : g1[e & 3]) + (e < 4 ? b0[e & 3] : b1[e & 3]);
            *(LAS u32x4*)(Vn + r * 136 + seg * 8) = pack8(o); }
        u32x4 wn[4], vn[4], un[4];
        if (u + 1 < u1) SP_LOAD(wn, vn, un, ((u + 1) >> 4) * 128, (u + 1) & 15);
        LDS_BARRIER();
        bf16x8 bw[4];
#pragma unroll
        for (int ks = 0; ks < 4; ++ks) bw[ks] = *(const LAS bf16x8*)(Wt + (16 * F.wave + l15) * 136 + ks * 32 + 8 * l4);
        const int p = 16 * F.wave + l15; const float bias = bs[g * 128 + p];
        bf16_t* urow = U + (size_t)(t0 + p) * GWID + g * 128 + 8 * l4;
#pragma unroll
        for (int e = 0; e < 4; ++e) { f32x4 a0 = (f32x4){0.f, 0.f, 0.f, 0.f}, a1 = a0;
#pragma unroll
            for (int ks = 0; ks < 4; ++ks) { const bf16x8 f0 = tr_frag136p(Vn, 32 * ks, 2 * e, F.lane), f1 = tr_frag136p(Vn, 32 * ks, 2 * e + 1, F.lane);
                a0 = __builtin_amdgcn_mfma_f32_16x16x32_bf16(f0, bw[ks], a0, 0, 0, 0); a1 = __builtin_amdgcn_mfma_f32_16x16x32_bf16(f1, bw[ks], a1, 0, 0, 0); }
            u32x4 o; o.x = cvt_pk_bf16(bf_lo(uu[e].x) * (a0[0] + bias), bf_hi(uu[e].x) * (a0[1] + bias)); o.y = cvt_pk_bf16(bf_lo(uu[e].y) * (a0[2] + bias), bf_hi(uu[e].y) * (a0[3] + bias));
            o.z = cvt_pk_bf16(bf_lo(uu[e].z) * (a1[0] + bias), bf_hi(uu[e].z) * (a1[1] + bias)); o.w = cvt_pk_bf16(bf_lo(uu[e].w) * (a1[2] + bias), bf_hi(uu[e].w) * (a1[3] + bias));
            *(u32x4*)(urow + e * 32) = o; }
        if (u + 1 < u1) {
#pragma unroll
            for (int i = 0; i < 4; ++i) { wv[i] = wn[i]; vv[i] = vn[i]; uu[i] = un[i]; } }
    }
#undef SP_LOAD
}

__device__ __forceinline__ void mix_phase(const Frame& F, KP P, int j) {
    const bf16_t* HL = (const bf16_t*)(P->ws + WS_HL); const float* mu = P->in[I_MU] + (size_t)j * 6 * D;
    bf16_t* outs[6] = {(bf16_t*)(P->ws + WS_XR), (bf16_t*)(P->ws + WS_XW), (bf16_t*)(P->ws + WS_XK), (bf16_t*)(P->ws + WS_XV), (bf16_t*)(P->ws + WS_XA), (bf16_t*)(P->ws + WS_XG)};
    f32x4 mr[2][6][2];
#pragma unroll
    for (int jj = 0; jj < 2; ++jj)
#pragma unroll
        for (int m = 0; m < 6; ++m) { const int col = 512 * jj + 8 * F.lane; mr[jj][m][0] = *(const f32x4*)(mu + (size_t)m * D + col); mr[jj][m][1] = *(const f32x4*)(mu + (size_t)m * D + col + 4); }
    for (int row = F.gw; row < T; row += F.NGW) {
        bool ok[2]; int src[2]; const bool hi = F.lane >= 32;
        if (row < TL) { const int n = row & (SEQ - 1), gc = n & 63, gr = n >> 6;
            ok[0] = hi ? gc < 63 : gc > 0; src[0] = hi ? row + 1 : row - 1; ok[1] = hi ? gr < 255 : gr > 0; src[1] = hi ? row + 64 : row - 64; }
        else { const int n = (row - TL) & (CTXL - 1); ok[0] = n > 0; src[0] = row - 1; ok[1] = n < CTXL - 1; src[1] = row + 1; }
#pragma unroll
        for (int jj = 0; jj < 2; ++jj) { const int col = 512 * jj + 8 * F.lane;
            const u32x4 h8 = *(const u32x4*)(HL + (size_t)row * D + col); u32x4 s8 = (u32x4){0u, 0u, 0u, 0u};
            if (ok[jj]) s8 = *(const u32x4*)(HL + (size_t)src[jj] * D + col);
            const unsigned hw[4] = {h8.x, h8.y, h8.z, h8.w}, sw[4] = {s8.x, s8.y, s8.z, s8.w}; float h[8], xx[8];
#pragma unroll
            for (int e = 0; e < 8; ++e) { h[e] = (e & 1) ? bf_hi(hw[e >> 1]) : bf_lo(hw[e >> 1]); const float s = (e & 1) ? bf_hi(sw[e >> 1]) : bf_lo(sw[e >> 1]); xx[e] = s - h[e]; }
#pragma unroll
            for (int m = 0; m < 6; ++m) { const f32x4 ma = mr[jj][m][0], mb = mr[jj][m][1];
                u32x4 o; o.x = cvt_pk_bf16(h[0] + xx[0] * ma[0], h[1] + xx[1] * ma[1]); o.y = cvt_pk_bf16(h[2] + xx[2] * ma[2], h[3] + xx[3] * ma[3]);
                o.z = cvt_pk_bf16(h[4] + xx[4] * mb[0], h[5] + xx[5] * mb[1]); o.w = cvt_pk_bf16(h[6] + xx[6] * mb[2], h[7] + xx[7] * mb[3]);
                *(u32x4*)(outs[m] + (size_t)row * D + col) = o; } }
    }
}

constexpr int NCH = 5, SCP = NCH * 64, NSC = (SEQ + CTXL) / SCP, NSCAN = 64, TP = 72, TILE_B = 64 * TP * 2;
static_assert(NSC * SCP == SEQ + CTXL, "super-chunks");
enum { T_AT = 0, T_RT, T_BT, T_KT, T_VM, T_NT, T_MT, T_NRT, T_MRT, T_APA, T_APB, T_TAA, T_TAB, T_PRB, T_QRB, T_NTILE };
constexpr int LDS_GL = T_NTILE * TILE_B, LDS_SEG = LDS_GL + 256;
static_assert(LDS_SEG + 2048 <= LDS_MISC, "scan LDS map");
__device__ __forceinline__ int scan_row(int z, int b, int p) {
    if (p < CTXL) return TL + b * CTXL + (z ? CTXL - 1 - p : p);
    const int q = p - CTXL; return b * SEQ + (z ? SEQ - 1 - q : q);
}
__device__ __forceinline__ LAS bf16_t* stile(LAS unsigned char* lds, int n) { return (LAS bf16_t*)(lds + n * TILE_B); }
__device__ __forceinline__ bf16x8 row_frag(const LAS bf16_t* M, int r0, int k0, int lane) { return *(const LAS bf16x8*)(M + (r0 + (lane & 15)) * TP + k0 + 8 * (lane >> 4)); }
__device__ __forceinline__ bf16x8 tr_frag(const LAS bf16_t* M, int k0, int c0, int lane) {
    LAS bf16_t* p = (LAS bf16_t*)M + (k0 + 8 * (lane >> 4) + ((lane & 15) >> 2)) * TP + c0 + 4 * (lane & 3);
    const v4s lo = __builtin_amdgcn_ds_read_tr16_b64_v4i16((LAS v4s*)p), hi = __builtin_amdgcn_ds_read_tr16_b64_v4i16((LAS v4s*)(p + 4 * TP));
    return (bf16x8){lo[0], lo[1], lo[2], lo[3], hi[0], hi[1], hi[2], hi[3]};
}
template <bool XT, bool YT>
__device__ __forceinline__ void mm64(const LAS bf16_t* X, const LAS bf16_t* Y, f32x4 (&acc)[2], int wq, int wh, int lane) {
#pragma unroll
    for (int ks = 0; ks < 2; ++ks) {
        const bf16x8 b = XT ? tr_frag(X, 32 * ks, 16 * wq, lane) : row_frag(X, 16 * wq, 32 * ks, lane);
#pragma unroll
        for (int q = 0; q < 2; ++q) { const int i0 = 16 * (2 * wh + q);
            const bf16x8 a = YT ? row_frag(Y, i0, 32 * ks, lane) : tr_frag(Y, 32 * ks, i0, lane);
            acc[q] = __builtin_amdgcn_mfma_f32_16x16x32_bf16(a, b, acc[q], 0, 0, 0); }
    }
}
__device__ __forceinline__ void st_tile(LAS bf16_t* Z, const f32x4 (&acc)[2], int wq, int wh, int lane) {
#pragma unroll
    for (int q = 0; q < 2; ++q) { u32x2 o; o.x = cvt_pk_bf16(acc[q][0], acc[q][1]); o.y = cvt_pk_bf16(acc[q][2], acc[q][3]);
        *(LAS u32x2*)(Z + (16 * wq + (lane & 15)) * TP + 16 * (2 * wh + q) + 4 * (lane >> 4)) = o; }
}
__device__ __forceinline__ void ld_tile(const LAS bf16_t* Z, f32x4 (&acc)[2], int wq, int wh, int lane) {
#pragma unroll
    for (int q = 0; q < 2; ++q) { const u32x2 o = *(const LAS u32x2*)(Z + (16 * wq + (lane & 15)) * TP + 16 * (2 * wh + q) + 4 * (lane >> 4));
        acc[q] = (f32x4){bf_lo(o.x), bf_hi(o.x), bf_lo(o.y), bf_hi(o.y)}; }
}
__device__ __forceinline__ f32x4 prod16(const LAS bf16_t* X, int xr, int xc, const LAS bf16_t* Y, int yr, int yc, f32x4 acc, int lane) {
    bf16x8 b = *(const LAS bf16x8*)(X + (xr + (lane & 15)) * TP + xc + 8 * (lane >> 4)); bf16x8 a = tr_frag(Y, yr, yc, lane);
    if ((lane >> 4) >= 2) { b = (bf16x8){0, 0, 0, 0, 0, 0, 0, 0}; a = (bf16x8){0, 0, 0, 0, 0, 0, 0, 0}; }
    return __builtin_amdgcn_mfma_f32_16x16x32_bf16(a, b, acc, 0, 0, 0);
}
__device__ __forceinline__ void st16(LAS bf16_t* Z, int zr, int zc, f32x4 acc, int lane) { u32x2 o; o.x = cvt_pk_bf16(acc[0], acc[1]); o.y = cvt_pk_bf16(acc[2], acc[3]); *(LAS u32x2*)(Z + (zr + (lane & 15)) * TP + zc + 4 * (lane >> 4)) = o; }
__device__ __forceinline__ f32x4 ld16(const LAS bf16_t* Z, int zr, int zc, int lane) { const u32x2 o = *(const LAS u32x2*)(Z + (zr + (lane & 15)) * TP + zc + 4 * (lane >> 4)); return (f32x4){bf_lo(o.x), bf_hi(o.x), bf_lo(o.y), bf_hi(o.y)}; }
struct ChunkRegs { u32x4 r, k, v, tw, ta; };
__device__ __forceinline__ void scan_load(KP P, const Frame& F, int item, int c4, ChunkRegs& R) {
    const int s = item & 63, sc = item >> 6, z = s >> 5, b = (s >> 4) & 1, hh = s & 15;
    const size_t row = (size_t)scan_row(z, b, sc * SCP + c4 * 64 + (F.tid >> 3)); const size_t o = row * D + hh * 64 + (F.tid & 7) * 8, o2 = row * 256 + z * 64 + (F.tid & 7) * 8;
    R.r = *(const u32x4*)((const bf16_t*)(P->ws + WS_R) + o); R.k = *(const u32x4*)((const bf16_t*)(P->ws + WS_K) + o); R.v = *(const u32x4*)((const bf16_t*)(P->ws + WS_VV) + o);
    R.tw = *(const u32x4*)((const bf16_t*)(P->ws + WS_TW) + o2); R.ta = *(const u32x4*)((const bf16_t*)(P->ws + WS_TA) + o2);
}
__device__ __forceinline__ void scan_chunk_phase(const Frame& F, KP P, int j) {
    LAS unsigned char* lds = F.lds;
    LAS bf16_t* At = stile(lds, T_AT); LAS bf16_t* Rt = stile(lds, T_RT); LAS bf16_t* Bt = stile(lds, T_BT); LAS bf16_t* Kt = stile(lds, T_KT); LAS bf16_t* Vm = stile(lds, T_VM);
    LAS bf16_t* NT = stile(lds, T_NT); LAS bf16_t* MT = stile(lds, T_MT); LAS bf16_t* NrT = stile(lds, T_NRT); LAS bf16_t* MrT = stile(lds, T_MRT);
    LAS bf16_t* ApA = stile(lds, T_APA); LAS bf16_t* ApB = stile(lds, T_APB); LAS bf16_t* TaA = stile(lds, T_TAA); LAS bf16_t* TaB = stile(lds, T_TAB);
    LAS bf16_t* PrB = stile(lds, T_PRB); LAS bf16_t* QrB = stile(lds, T_QRB);
    LAS float* gl = (LAS float*)(lds + LDS_GL); LAS float* seg = (LAS float*)(lds + LDS_SEG);
    const int lane = F.lane, wq = F.wave & 3, wh = F.wave >> 2, l15 = lane & 15, l4 = lane >> 4;
    const int pi = F.tid >> 3, kq = F.tid & 7;
    const int jrow = 16 * wq + l15;
    const int NITEM = NSCAN * NSC;
    int item = blockIdx.x; if (item >= NITEM) return;
    ChunkRegs cur, nxt; scan_load(P, F, item, 0, cur); nxt = cur;
    f32x4 Pr[2], Qr[2], aYp[2], aQp[2];
#pragma unroll
    for (int q = 0; q < 2; ++q) { Pr[q] = (f32x4){0.f, 0.f, 0.f, 0.f}; Qr[q] = Pr[q]; aYp[q] = Pr[q]; aQp[q] = Pr[q]; }
    bool pend = false; size_t orowp = 0; bf16_t* GEp = nullptr; bf16_t* YEp = nullptr; float* pqp = nullptr; bool lastp = false;
#define SCAN_STAGE_G() do { \
        f32x4 ge[2] = {(f32x4){0.f, 0.f, 0.f, 0.f}, (f32x4){0.f, 0.f, 0.f, 0.f}}; \
        mm64<false, true>(NT, PrB, ge, wq, wh, lane); mm64<false, true>(NT, QrB, aYp, wq, wh, lane); \
        f32x4 pn[2] = {(f32x4){0.f, 0.f, 0.f, 0.f}, (f32x4){0.f, 0.f, 0.f, 0.f}}; \
        mm64<false, false>(PrB, MT, pn, wq, wh, lane); mm64<false, false>(QrB, MT, aQp, wq, wh, lane); \
        _Pragma("unroll") for (int q = 0; q < 2; ++q) { const int i0 = 16 * (2 * wh + q) + 4 * l4; \
            u32x2 o; o.x = cvt_pk_bf16(ge[q][0], ge[q][1]); o.y = cvt_pk_bf16(ge[q][2], ge[q][3]); *(u32x2*)(GEp + orowp + i0) = o; \
            u32x2 y; y.x = cvt_pk_bf16(aYp[q][0], aYp[q][1]); y.y = cvt_pk_bf16(aYp[q][2], aYp[q][3]); *(u32x2*)(YEp + orowp + i0) = y; \
            Pr[q] = pn[q]; Qr[q] = aQp[q]; } \
        if (lastp) { const int ln_ = lane_id_now(), l15_ = ln_ & 15, l4_ = ln_ >> 4;   \
            float* pP_ = pqp + ((l15_ & 3) * 4 + (l15_ >> 2)) * 64 + wq * 16 + 8 * wh + l4_; float* pQ_ = pqp + 4096 + (wq * 16 + l4_) * 64 + 32 * wh + l15_; \
            _Pragma("unroll") for (int q = 0; q < 2; ++q)   \
            _Pragma("unroll") for (int r = 0; r < 4; ++r) { pP_[r * 1024 + 4 * q] = Pr[q][r]; pQ_[r * 256 + 16 * q] = Qr[q][r]; } } \
    } while (0)
    u32x4 w2r = (u32x4){0u, 0u, 0u, 0u}, a2r = w2r; int sprev = -1;
    for (;;) {
        const int s = item & 63, sc = item >> 6, z = s >> 5, b = (s >> 4) & 1, hh = s & 15;
        const float* kkw = P->in[I_KK] + (size_t)j * D + hh * 64 + kq * 8; const float* kap = P->in[I_KA] + (size_t)j * D + hh * 64 + kq * 8; const float* rkp = P->in[I_RK] + (size_t)j * D + hh * 64 + kq * 8;
        const float* w0p = P->in[I_W0] + ((size_t)j * 2 + z) * D + hh * 64; const float* a0p = P->in[I_A0] + ((size_t)j * 2 + z) * D + hh * 64;
        float* bon = (float*)(P->ws + WS_BON) + (size_t)z * T * 16;
        if (s != sprev) { sprev = s;
            w2r = *(const u32x4*)((const bf16_t*)(P->ws + WS_W2P) + (((size_t)j * 2 + z) * D + hh * 64 + pi) * 256 + z * 64 + kq * 8);
            a2r = *(const u32x4*)((const bf16_t*)(P->ws + WS_A2P) + (((size_t)j * 2 + z) * D + hh * 64 + pi) * 256 + z * 64 + kq * 8); }
        bf16_t* GE = (bf16_t*)(P->ws + (z ? WS_AS1 : WS_AS0)); bf16_t* YE = (bf16_t*)(P->ws + (z ? WS_ELOG1 : WS_ELOG0));
        float* pq = (float*)(P->ws + WS_PQ) + ((size_t)(s * NSC + sc) * 2) * 4096;
#pragma nounroll
        for (int c4 = 0; c4 < NCH; ++c4) {
            unsigned long long ch_t[12]; ch_t[11] = CH_AMP >= 0 ? __builtin_amdgcn_s_memrealtime() : 0ull;
            *(LAS u32x4*)(ApA + pi * TP + kq * 8) = cur.tw; *(LAS u32x4*)(ApB + pi * TP + kq * 8) = cur.ta; *(LAS u32x4*)(NrT + pi * TP + kq * 8) = w2r; *(LAS u32x4*)(MrT + pi * TP + kq * 8) = a2r;
            LDS_BARRIER(); CH_STAMP(0);
            {   f32x4 lw[2] = {(f32x4){0.f, 0.f, 0.f, 0.f}, (f32x4){0.f, 0.f, 0.f, 0.f}}, la[2] = {(f32x4){0.f, 0.f, 0.f, 0.f}, (f32x4){0.f, 0.f, 0.f, 0.f}};
                mm64<false, true>(ApA, NrT, lw, wq, wh, lane); mm64<false, true>(ApB, MrT, la, wq, wh, lane);
#pragma unroll
                for (int q = 0; q < 2; ++q) { const int i0 = 16 * (2 * wh + q) + 4 * l4; const f32x4 w04 = *(const f32x4*)(w0p + i0), a04 = *(const f32x4*)(a0p + i0);
#pragma unroll
                    for (int r = 0; r < 4; ++r) { lw[q][r] = -0.60653065971f * sigmoidf_(w04[r] + lw[q][r]); la[q][r] = sigmoidf_(a04[r] + la[q][r]); } }
                st_tile(TaA, lw, wq, wh, lane); st_tile(TaB, la, wq, wh, lane); }
            LDS_BARRIER(); CH_STAMP(1);
            float r8[8], k8[8], e8[8], m8[8], a8[8], kk8[8], c8[8];
            { const u32x4 et = *(const LAS u32x4*)(TaA + pi * TP + kq * 8), at = *(const LAS u32x4*)(TaB + pi * TP + kq * 8); unpack8(cur.r, r8); unpack8(cur.k, k8); unpack8(et, e8); unpack8(at, a8); }
            {   const f32x4 ka0 = *(const f32x4*)(kap), ka1 = *(const f32x4*)(kap + 4), rk0 = *(const f32x4*)(rkp), rk1 = *(const f32x4*)(rkp + 4); float bp = 0.f;
#pragma unroll
                for (int e = 0; e < 8; ++e) { m8[e] = k8[e] * (1.0f + (a8[e] - 1.0f) * (e < 4 ? ka0[e & 3] : ka1[e & 3])); bp += r8[e] * (e < 4 ? rk0[e & 3] : rk1[e & 3]) * m8[e]; }
                bp += shx(bp, 1, lane); bp += shx(bp, 2, lane); bp += shx(bp, 4, lane);
                if (kq == 0) bon[(size_t)scan_row(z, b, sc * SCP + c4 * 64 + pi) * 16 + hh] = bp; }
            { const f32x4 w0 = *(const f32x4*)kkw, w1 = *(const f32x4*)(kkw + 4); float ss = 0.f;
#pragma unroll
              for (int e = 0; e < 8; ++e) { kk8[e] = k8[e] * (e < 4 ? w0[e & 3] : w1[e & 3]); ss += kk8[e] * kk8[e]; }
              ss += shx(ss, 1, lane); ss += shx(ss, 2, lane); ss += shx(ss, 4, lane);
              const float rn = rsqrtf(ss + 1e-12f);
#pragma unroll
              for (int e = 0; e < 8; ++e) { kk8[e] *= rn; c8[e] = e8[e]; } }
#pragma unroll
            for (int d = 8; d < 64; d <<= 1) {
#pragma unroll
                for (int e = 0; e < 8; ++e) { const float t = shup(c8[e], d, lane); c8[e] += lane >= d ? t : 0.f; } }
            if (lane >= 56) { *(LAS f32x4*)(seg + F.wave * 64 + kq * 8) = (f32x4){c8[0], c8[1], c8[2], c8[3]}; *(LAS f32x4*)(seg + F.wave * 64 + kq * 8 + 4) = (f32x4){c8[4], c8[5], c8[6], c8[7]}; }
            if (pend) { SCAN_STAGE_G(); pend = false; }
            LDS_BARRIER(); CH_STAMP(2);
            if (c4 > 0) { st_tile(PrB, Pr, wq, wh, lane); st_tile(QrB, Qr, wq, wh, lane); }
            { float cum[8];
#pragma unroll
              for (int e = 0; e < 8; ++e) cum[e] = c8[e];
              for (int w2 = 0; w2 < F.wave; ++w2) { const f32x4 o0 = *(const LAS f32x4*)(seg + w2 * 64 + kq * 8), o1 = *(const LAS f32x4*)(seg + w2 * 64 + kq * 8 + 4);
#pragma unroll
                  for (int e = 0; e < 8; ++e) cum[e] += e < 4 ? o0[e & 3] : o1[e & 3]; }
              float o[8];
#pragma unroll
              for (int e = 0; e < 8; ++e) o[e] = -kk8[e] * __expf(cum[e] - e8[e]);
              *(LAS u32x4*)(At + pi * TP + kq * 8) = pack8(o);
#pragma unroll
              for (int e = 0; e < 8; ++e) o[e] = r8[e] * __expf(cum[e]);
              *(LAS u32x4*)(Rt + pi * TP + kq * 8) = pack8(o);
              float en[8];
#pragma unroll
              for (int e = 0; e < 8; ++e) { en[e] = __expf(-cum[e]); o[e] = kk8[e] * a8[e] * en[e]; }
              *(LAS u32x4*)(Bt + pi * TP + kq * 8) = pack8(o);
#pragma unroll
              for (int e = 0; e < 8; ++e) o[e] = m8[e] * en[e];
              *(LAS u32x4*)(Kt + pi * TP + kq * 8) = pack8(o);
              *(LAS u32x4*)(Vm + pi * TP + kq * 8) = cur.v;
              if (pi == 63) {
#pragma unroll
                  for (int e = 0; e < 8; ++e) gl[kq * 8 + e] = __expf(cum[e]); } }
            { const int nitem = c4 < NCH - 1 ? item : item + (int)gridDim.x, nc4 = c4 < NCH - 1 ? c4 + 1 : 0; if (nitem < NITEM) scan_load(P, F, nitem, nc4, nxt); }
            LDS_BARRIER(); CH_STAMP(3);
            {   f32x4 aN[2], aM[2], aNr[2], aMr[2];
#pragma unroll
                for (int q = 0; q < 2; ++q) { aN[q] = (f32x4){0.f, 0.f, 0.f, 0.f}; aM[q] = aN[q]; aNr[q] = aN[q]; aMr[q] = aN[q]; }
                mm64<false, true>(At, Bt, aN, wq, wh, lane); mm64<false, true>(At, Kt, aM, wq, wh, lane); mm64<false, true>(Rt, Bt, aNr, wq, wh, lane); mm64<false, true>(Rt, Kt, aMr, wq, wh, lane);
                f32x4 aT[2];
#pragma unroll
                for (int q = 0; q < 2; ++q)
#pragma unroll
                    for (int r = 0; r < 4; ++r) { const int i = 16 * (2 * wh + q) + 4 * l4 + r; const bool lt = i < jrow, le = i <= jrow;
                        aN[q][r] = lt ? aN[q][r] : 0.f; aM[q][r] = lt ? aM[q][r] : 0.f; aNr[q][r] = le ? aNr[q][r] : 0.f; aMr[q][r] = le ? aMr[q][r] : 0.f; aT[q][r] = aN[q][r] + (i == jrow ? 1.f : 0.f); }
                st_tile(NT, aN, wq, wh, lane); st_tile(MT, aM, wq, wh, lane); st_tile(NrT, aNr, wq, wh, lane); st_tile(MrT, aMr, wq, wh, lane); st_tile(TaA, aT, wq, wh, lane);
            }
            LDS_BARRIER(); CH_STAMP(4);
            if (F.wave < 4) { const int o = 16 * F.wave, oc = 16 * ((F.wave + 1) & 3);
                f32x4 p = prod16(NT, o, o, NT, o, o, (f32x4){0.f, 0.f, 0.f, 0.f}, lane); st16(ApA, o, o, p, lane);
                f32x4 t = prod16(TaA, o, o, ApA, o, o, ld16(TaA, o, o, lane), lane); p = prod16(ApA, o, o, ApA, o, o, (f32x4){0.f, 0.f, 0.f, 0.f}, lane);
                st16(TaB, o, o, t, lane); st16(ApA, o, oc, p, lane);
                t = prod16(TaB, o, o, ApA, o, oc, ld16(TaB, o, o, lane), lane); p = prod16(ApA, o, oc, ApA, o, oc, (f32x4){0.f, 0.f, 0.f, 0.f}, lane);
                st16(TaA, o, o, t, lane); st16(ApA, o, o, p, lane);
                t = prod16(TaA, o, o, ApA, o, o, ld16(TaA, o, o, lane), lane); st16(TaB, o, o, t, lane);
#pragma unroll
                for (int jj = 1; jj < 4; ++jj) if (jj > F.wave) { u32x2 zz; asm volatile("v_mov_b32 %0, 0\n\tv_mov_b32 %1, 0" : "=v"(zz.x), "=v"(zz.y)); *(LAS u32x2*)(TaB + (o + l15) * TP + 16 * jj + 4 * l4) = zz; }
            } else { const int wq2 = F.wave - 4;
#pragma unroll
                for (int wh2 = 0; wh2 < 2; ++wh2) { f32x4 x[2] = {(f32x4){0.f, 0.f, 0.f, 0.f}, (f32x4){0.f, 0.f, 0.f, 0.f}}; mm64<true, true>(Vm, MT, x, wq2, wh2, lane); st_tile(ApB, x, wq2, wh2, lane); } }
            LDS_BARRIER(); CH_STAMP(5);
            if (F.wave < 3) { const int jj = F.wave;
#pragma unroll
                for (int i = 1; i < 4; ++i) if (i > jj) { f32x4 e = (f32x4){0.f, 0.f, 0.f, 0.f};
#pragma unroll
                    for (int m = 0; m < 3; ++m) if (m >= jj && m < i) e = prod16(NT, 16 * i, 16 * m, TaB, 16 * m, 16 * jj, e, lane);
                    st16(ApA, 16 * i, 16 * jj, e, lane);
                    st16(TaB, 16 * i, 16 * jj, prod16(TaB, 16 * i, 16 * i, ApA, 16 * i, 16 * jj, (f32x4){0.f, 0.f, 0.f, 0.f}, lane), lane); } }
            LDS_BARRIER(); CH_STAMP(6);
            {   f32x4 w[2] = {(f32x4){0.f, 0.f, 0.f, 0.f}, (f32x4){0.f, 0.f, 0.f, 0.f}}; mm64<true, true>(At, TaB, w, wq, wh, lane); st_tile(ApA, w, wq, wh, lane);
                f32x4 u[2] = {(f32x4){0.f, 0.f, 0.f, 0.f}, (f32x4){0.f, 0.f, 0.f, 0.f}}; mm64<false, true>(ApB, TaB, u, wq, wh, lane); st_tile(TaA, u, wq, wh, lane); }
            LDS_BARRIER(); CH_STAMP(7);
            f32x4 aP[2], aQ[2], aG[2], aY[2];
#pragma unroll
            for (int q = 0; q < 2; ++q) { aP[q] = (f32x4){0.f, 0.f, 0.f, 0.f}; aQ[q] = aP[q]; aG[q] = aP[q]; aY[q] = aP[q]; }
            mm64<false, false>(ApA, Bt, aP, wq, wh, lane);
            mm64<false, false>(TaA, Bt, aQ, wq, wh, lane); mm64<true, false>(Vm, Kt, aQ, wq, wh, lane);
            mm64<false, true>(NrT, ApA, aG, wq, wh, lane);
            mm64<false, true>(NrT, TaA, aY, wq, wh, lane); mm64<false, false>(MrT, Vm, aY, wq, wh, lane);
#pragma unroll
            for (int q = 0; q < 2; ++q) { const int i0 = 16 * (2 * wh + q) + 4 * l4; const f32x4 g4 = *(const LAS f32x4*)(gl + i0);
                const u32x2 rr = *(const LAS u32x2*)(Rt + jrow * TP + i0);
#pragma unroll
                for (int r = 0; r < 4; ++r) { aP[q][r] = (aP[q][r] + (i0 + r == jrow ? 1.f : 0.f)) * g4[r]; aQ[q][r] *= g4[r]; }
                aG[q][0] += bf_lo(rr.x); aG[q][1] += bf_hi(rr.x); aG[q][2] += bf_lo(rr.y); aG[q][3] += bf_hi(rr.y); }
            const size_t orow = (size_t)scan_row(z, b, sc * SCP + c4 * 64 + jrow) * D + hh * 64;
            if (c4 == 0) {
#pragma unroll
                for (int q = 0; q < 2; ++q) { const int i0 = 16 * (2 * wh + q) + 4 * l4;
                    u32x2 o; o.x = cvt_pk_bf16(aG[q][0], aG[q][1]); o.y = cvt_pk_bf16(aG[q][2], aG[q][3]); *(u32x2*)(GE + orow + i0) = o;
                    u32x2 y; y.x = cvt_pk_bf16(aY[q][0], aY[q][1]); y.y = cvt_pk_bf16(aY[q][2], aY[q][3]); *(u32x2*)(YE + orow + i0) = y;
                    Pr[q] = aP[q]; Qr[q] = aQ[q]; }
            } else {
                st_tile(NT, aG, wq, wh, lane); st_tile(MT, aP, wq, wh, lane);
#pragma unroll
                for (int q = 0; q < 2; ++q) { aYp[q] = aY[q]; aQp[q] = aQ[q]; }
                pend = true; orowp = orow; GEp = GE; YEp = YE; pqp = pq; lastp = c4 == NCH - 1;
            }
            cur = nxt;
            if (CH_AMP >= 0) { const unsigned long long d_ = CH_AMP == 0 ? ch_t[0] - ch_t[11] : ch_t[CH_AMP] - ch_t[CH_AMP - 1]; const unsigned long long dl_ = __builtin_amdgcn_s_memrealtime() + 4 * d_; while (__builtin_amdgcn_s_memrealtime() < dl_) __builtin_amdgcn_s_sleep(4); }
            LDS_BARRIER(); CH_STAMP(8);
        }
        item += gridDim.x; if (item >= NITEM) break;
    }
    if (pend) { SCAN_STAGE_G(); }
#undef SCAN_STAGE_G
}
__device__ __forceinline__ void scan_carry_phase(const Frame& F, KP P, int layer) {
    LAS unsigned* cbar = (LAS unsigned*)(F.lds + 8192);
    if (F.tid == 0) *cbar = 0u;
    __syncthreads();
    if (F.wave >= 4) { moe_weights_phase(F, P, layer, blockIdx.x * 4 + (F.wave - 4), gridDim.x * 4, 0, MOE_SPLIT); return; }
    if (blockIdx.x >= 4 * NSCAN) return;
    unsigned ctarget = 0u;
    const int s = blockIdx.x >> 2, vs = blockIdx.x & 3, lane = F.lane, l15 = lane & 15, l4 = lane >> 4, v = 16 * vs + l15, T2 = F.wave;
    const float* pq = (const float*)(P->ws + WS_PQ) + (size_t)s * NSC * 2 * 4096; bf16_t* sst = (bf16_t*)(P->ws + WS_SST) + (size_t)s * NSC * 4096;
    LAS f32x4* exch = (LAS f32x4*)F.lds;
    f32x4 S[4]; float ap[4][16], qp[4][4];
#pragma unroll
    for (int t = 0; t < 4; ++t) S[t] = (f32x4){0.f, 0.f, 0.f, 0.f};
#define CARRY_LOAD(slot, step) do { const float* Pm_ = pq + (size_t)(step) * 2 * 4096; \
        _Pragma("unroll") for (int t2i = 0; t2i < 4; ++t2i) _Pragma("unroll") for (int ri = 0; ri < 4; ++ri) ap[slot][t2i * 4 + ri] = Pm_[(T2 * 16 + t2i * 4 + ri) * 64 + lane];   \
        _Pragma("unroll") for (int r = 0; r < 4; ++r) qp[slot][r] = Pm_[4096 + ((vs * 4 + T2) * 4 + r) * 64 + lane];   } while (0)
#define CARRY_STORE(sc_) do { if (T2 == 0) { float o[16]; \
        _Pragma("unroll") for (int r = 0; r < 4; ++r) _Pragma("unroll") for (int t2 = 0; t2 < 4; ++t2) o[4 * r + t2] = S[t2][r]; \
        u32x4 w0, w1; w0.x = cvt_pk_bf16(o[0], o[1]); w0.y = cvt_pk_bf16(o[2], o[3]); w0.z = cvt_pk_bf16(o[4], o[5]); w0.w = cvt_pk_bf16(o[6], o[7]); \
        w1.x = cvt_pk_bf16(o[8], o[9]); w1.y = cvt_pk_bf16(o[10], o[11]); w1.z = cvt_pk_bf16(o[12], o[13]); w1.w = cvt_pk_bf16(o[14], o[15]); \
        *(u32x4*)(sst + (size_t)(sc_) * 4096 + v * 64 + 16 * l4) = w0; *(u32x4*)(sst + (size_t)(sc_) * 4096 + v * 64 + 16 * l4 + 8) = w1; } } while (0)
    if (T2 < 4) {
#pragma unroll
        for (int u = 0; u < 4; ++u) CARRY_LOAD(u, u);
    }
#pragma nounroll
    for (int sc0 = 0; sc0 < NSC - 1; sc0 += 4) {
#pragma unroll
        for (int u = 0; u < 4; ++u) { const int sc = sc0 + u; if (sc >= NSC - 1) break;
            CARRY_STORE(sc);
            if (T2 < 4) {
                f32x4 nw = (f32x4){qp[u][0], qp[u][1], qp[u][2], qp[u][3]};
#pragma unroll
                for (int t2i = 0; t2i < 4; ++t2i)
#pragma unroll
                    for (int ri = 0; ri < 4; ++ri) nw = __builtin_amdgcn_mfma_f32_16x16x4f32(ap[u][t2i * 4 + ri], S[t2i][ri], nw, 0, 0, 0);
                if (sc + 4 < NSC - 1) CARRY_LOAD(u, sc + 4);
                exch[((u & 1) * 4 + T2) * 64 + lane] = nw;
            }
            { asm volatile("s_waitcnt lgkmcnt(0)" ::: "memory"); if (lane == 0) __hip_atomic_fetch_add(cbar, 1u, __ATOMIC_RELAXED, __HIP_MEMORY_SCOPE_WORKGROUP); ctarget += 4u;
              for (int spin = 0; spin < (1 << 22); ++spin) { const unsigned c = __hip_atomic_load(cbar, __ATOMIC_RELAXED, __HIP_MEMORY_SCOPE_WORKGROUP); if ((int)(c - ctarget) >= 0) break; }
              asm volatile("" ::: "memory"); }
            if (T2 < 4) {
#pragma unroll
                for (int t = 0; t < 4; ++t) S[t] = exch[((u & 1) * 4 + t) * 64 + lane];
            }
        }
    }
    CARRY_STORE(NSC - 1);
#undef CARRY_LOAD
#undef CARRY_STORE
}
__device__ __forceinline__ void scan_out_phase(const Frame& F, KP P, int j) {
    const int lane = F.lane, l15 = lane & 15, l4 = lane >> 4;
    const bf16_t* GE0 = (const bf16_t*)(P->ws + WS_AS0); const bf16_t* GE1 = (const bf16_t*)(P->ws + WS_AS1); const bf16_t* YE0 = (const bf16_t*)(P->ws + WS_ELOG0); const bf16_t* YE1 = (const bf16_t*)(P->ws + WS_ELOG1);
    const bf16_t* Vb = (const bf16_t*)(P->ws + WS_VV); const float* BON = (const float*)(P->ws + WS_BON);
    const bf16_t* GT = (const bf16_t*)(P->ws + WS_GATE); bf16_t* YG = (bf16_t*)(P->ws + WS_YG);
    for (int item = F.gw; item < NBATCH * NH * ((SEQ + CTXL) / 256) * 8; item += F.NGW) {
        const int hh = item & 15, oct = (item >> 4) & 7, b = (item >> 7) & 1, blk = item >> 8;
        const int sc0 = (blk * 256 + 32 * oct) / SCP, sc1 = blk == 0 ? 0 : (SEQ + CTXL - 1 - (blk - 1) * 256 - 32 * oct) / SCP;

        const bf16_t* s0 = (const bf16_t*)(P->ws + WS_SST) + ((size_t)(b * 16 + hh) * NSC + sc0) * 4096; const bf16_t* s1 = (const bf16_t*)(P->ws + WS_SST) + ((size_t)(32 + b * 16 + hh) * NSC + sc1) * 4096;
        bf16x8 sa0[4][2], sa1[4][2];
#pragma unroll
        for (int vt = 0; vt < 4; ++vt) { const int v = 32 * (vt >> 1) + 8 * (l15 >> 2) + 4 * (vt & 1) + (l15 & 3);
#pragma unroll
            for (int ks = 0; ks < 2; ++ks) { sa0[vt][ks] = *(const bf16x8*)(s0 + v * 64 + 32 * ks + 8 * l4); sa1[vt][ks] = *(const bf16x8*)(s1 + v * 64 + 32 * ks + 8 * l4); } }
        f32x4 lg4[4], lb4[4];
#pragma unroll
        for (int q = 0; q < 4; ++q) { const int c = hh * 64 + 32 * (q >> 1) + 8 * l4 + 4 * (q & 1); lg4[q] = *(const f32x4*)(P->in[I_LNG] + (size_t)j * D + c); lb4[q] = *(const f32x4*)(P->in[I_LNB] + (size_t)j * D + c); }
#pragma nounroll
        for (int ti = 0; ti < 2; ++ti) {
            const int tok = (2 * oct + ti) * 16 + l15; const int row = blk == 0 ? TL + b * CTXL + tok : b * SEQ + (blk - 1) * 256 + tok;
            const size_t o = (size_t)row * D + hh * 64;
            const bf16x8 g00 = *(const bf16x8*)(GE0 + o + 8 * l4), g01 = *(const bf16x8*)(GE0 + o + 32 + 8 * l4), g10 = *(const bf16x8*)(GE1 + o + 8 * l4), g11 = *(const bf16x8*)(GE1 + o + 32 + 8 * l4);
            u32x4 la[2], lc[2], lv[2], lgt[2];
#pragma unroll
            for (int h2 = 0; h2 < 2; ++h2) { const size_t oc = o + 32 * h2 + 8 * l4;
                la[h2] = *(const u32x4*)(YE0 + oc); lc[h2] = *(const u32x4*)(YE1 + oc); lv[h2] = *(const u32x4*)(Vb + oc); lgt[h2] = *(const u32x4*)(GT + oc); }
            const float bn = BON[(size_t)row * 16 + hh] + BON[((size_t)T + row) * 16 + hh];
            __builtin_amdgcn_sched_barrier(0);
            f32x4 y[4]; float s = 0.f; f32x4 vv[4], gg[4];
#pragma unroll
            for (int vt = 0; vt < 4; ++vt) { const int h2 = vt >> 1, hf = vt & 1;
                const unsigned ax = hf ? la[h2].z : la[h2].x, ay = hf ? la[h2].w : la[h2].y, cx = hf ? lc[h2].z : lc[h2].x, cy = hf ? lc[h2].w : lc[h2].y;
                const unsigned vx = hf ? lv[h2].z : lv[h2].x, vy = hf ? lv[h2].w : lv[h2].y, gx = hf ? lgt[h2].z : lgt[h2].x, gy = hf ? lgt[h2].w : lgt[h2].y;
                f32x4 acc = (f32x4){bf_lo(ax) + bf_lo(cx), bf_hi(ax) + bf_hi(cx), bf_lo(ay) + bf_lo(cy), bf_hi(ay) + bf_hi(cy)};
                acc = __builtin_amdgcn_mfma_f32_16x16x32_bf16(sa0[vt][0], g00, acc, 0, 0, 0); acc = __builtin_amdgcn_mfma_f32_16x16x32_bf16(sa0[vt][1], g01, acc, 0, 0, 0);
                acc = __builtin_amdgcn_mfma_f32_16x16x32_bf16(sa1[vt][0], g10, acc, 0, 0, 0); acc = __builtin_amdgcn_mfma_f32_16x16x32_bf16(sa1[vt][1], g11, acc, 0, 0, 0);
                y[vt] = acc; s += (acc[0] + acc[1]) + (acc[2] + acc[3]);
                vv[vt] = (f32x4){bf_lo(vx), bf_hi(vx), bf_lo(vy), bf_hi(vy)}; gg[vt] = (f32x4){bf_lo(gx), bf_hi(gx), bf_lo(gy), bf_hi(gy)}; }
            s += shx(s, 16, lane); s += shx(s, 32, lane);
            const float mean = s * (1.0f / 64.0f); float q = 0.f;
#pragma unroll
            for (int vt = 0; vt < 4; ++vt) { const f32x4 d = y[vt] - mean; q += (d[0] * d[0] + d[1] * d[1]) + (d[2] * d[2] + d[3] * d[3]); }
            q += shx(q, 16, lane); q += shx(q, 32, lane);
            const float rstd = rsqrtf(q * (1.0f / 64.0f) + 64e-5f);
#pragma unroll
            for (int h2 = 0; h2 < 2; ++h2) { const f32x4 o0 = (((y[2 * h2] - mean) * rstd) * lg4[2 * h2] + lb4[2 * h2] + vv[2 * h2] * bn) * gg[2 * h2], o1 = (((y[2 * h2 + 1] - mean) * rstd) * lg4[2 * h2 + 1] + lb4[2 * h2 + 1] + vv[2 * h2 + 1] * bn) * gg[2 * h2 + 1];
                u32x4 w; w.x = cvt_pk_bf16(o0[0], o0[1]); w.y = cvt_pk_bf16(o0[2], o0[3]); w.z = cvt_pk_bf16(o1[0], o1[1]); w.w = cvt_pk_bf16(o1[2], o1[3]); *(u32x4*)(YG + o + 32 * h2 + 8 * l4) = w; }
        }
    }
}
__device__ __forceinline__ bool in_range(int lo, int hi, int k) { asm volatile("" : "+s"(lo), "+s"(hi)); return lo <= k && k < hi; }
constexpr int NPH = 46;
template <unsigned KMASK> __global__ void __launch_bounds__(NTHR, 2) mega(Params Pv) {
    extern __shared__ __attribute__((aligned(16))) unsigned char lds_raw[];
    Frame F0; F0.lds = (LAS unsigned char*)lds_raw; F0.tid = threadIdx.x; F0.lane = F0.tid & 63; F0.wave = __builtin_amdgcn_readfirstlane(F0.tid >> 6);
    F0.G = gridDim.x; F0.gw = blockIdx.x * NWAVES + F0.wave; F0.NGW = F0.G * NWAVES;
    LAS unsigned* misc = (LAS unsigned*)(F0.lds + LDS_MISC);
    if (F0.tid < 128) misc[F0.tid] = 0u;
    __syncthreads();
    KP P0 = (KP)__builtin_amdgcn_kernarg_segment_ptr();
    constexpr bool ALL = (KMASK == 0x3ffffu);
    const int lo = ALL ? 0 : P0->ph_lo, hi = ALL ? NPH : P0->ph_hi;
    XcdBarrier bar; bar.bar = (unsigned*)(P0->ws + WS_CTL) + CW_BAR; bar.x = 0; bar.st = (volatile LAS unsigned*)(misc + 8);
    if (ALL || hi - lo > 1) bar = xcd_barrier_post((unsigned*)(P0->ws + WS_CTL) + CW_BAR, (volatile LAS unsigned*)(misc + 8));
#define IN(k) (ALL || in_range(lo, hi, (k)))
#define KIND(q) ((KMASK >> (q)) & 1u)
#define BAR_LEADER (wave_sgpr_now(F0.wave) == 0 && lane_id_now() == 0)
#define SEAM(k) do { if (IN(k) && IN((k) + 1)) { XcdBarrier b2_ = bar; unsigned* bb_ = bar.bar; unsigned bx_ = bar.x; asm volatile("" : "+s"(bb_), "+s"(bx_)); b2_.bar = bb_; b2_.x = bx_; xcd_barrier<false>(b2_, BAR_LEADER); } } while (0)
#define AMP_T0 const unsigned long long amp_t0 = AMP_MASK ? __builtin_amdgcn_s_memrealtime() : 0ull;
#define AMP_END(kind) do { if (AMP_MASK & (1u << (kind))) { const unsigned long long t1_ = __builtin_amdgcn_s_memrealtime(), dl_ = t1_ + AMP_F * (t1_ - amp_t0); while (__builtin_amdgcn_s_memrealtime() < dl_) __builtin_amdgcn_s_sleep(8); } } while (0)
#define PHASE_ENTRY AMP_T0 KP P = P0; asm volatile("" : "+s"(P)); unsigned char* ws = P->ws; unsigned* ctl = (unsigned*)(ws + WS_CTL); (void)ctl; \
    Frame F = F0; { int l_ = lane_id_now(), w_ = F0.wave; asm volatile("" : "+s"(w_)); F.lane = l_; F.wave = w_; F.tid = w_ * 64 + l_; F.gw = blockIdx.x * NWAVES + w_; }

    if constexpr (KIND(0)) if (IN(0)) { PHASE_ENTRY prologue_phase(F, P); AMP_END(0); }
    if (IN(0) && IN(1)) { XcdBarrier b2_ = bar; unsigned* bb_ = bar.bar; unsigned bx_ = bar.x; asm volatile("" : "+s"(bb_), "+s"(bx_)); b2_.bar = bb_; b2_.x = bx_; xcd_barrier<true>(b2_, BAR_LEADER); }
    for (int lp = 0; lp < 2; ++lp) {
        const int pb = 1 + 22 * lp, la = 2 * lp, lb = 2 * lp + 1;
        if constexpr (KIND(1)) if (IN(pb + 0)) { PHASE_ENTRY norm1_phase(F, P, la); AMP_END(1); }
        SEAM(pb + 0);
        if constexpr (KIND(2)) if (IN(pb + 1)) { PHASE_ENTRY
            __syncthreads(); set_desc(F.lds, F.tid, 0, ws + WS_HL, ws + WS_WIN + (size_t)lp * 4096 * D * 2, ws + WS_U, 16, 0, 0, ws + WS_V, P->in[I_GBIN] + (size_t)lp * 4096, ws + WS_STAT); __syncthreads();
            SchedMulti<D, D> S{F.lds, TL / 256, 16, 1};
            EpiGelu E{F.lds};
            pg8::gemm_phase<EpiGelu, SchedMulti<D, D>, false, D, D, D>(F.lds, S, E, F.tid);
            __syncthreads(); { int w_ = F0.wave; asm volatile("" : "+s"(w_)); tail_gelu(F0.lds, w_); }
            AMP_END(2); }
        SEAM(pb + 1);
        if constexpr (KIND(3)) if (IN(pb + 2)) { PHASE_ENTRY spatial_phase(F, P, lp); AMP_END(3); }
        SEAM(pb + 2);
        if constexpr (KIND(4)) if (IN(pb + 3)) { PHASE_ENTRY
            __syncthreads();
            { bf16_t* X = (bf16_t*)(ws + WS_X);
              set_desc(F.lds, F.tid, 0, ws + WS_U, ws + WS_WOUT + (size_t)lp * D * GWID * 2, X, 4, 0, 0, X, X + (size_t)TL * D, P->in[I_GBOUT] + (size_t)lp * D);
              set_desc(F.lds, F.tid, 1, nullptr, nullptr, nullptr, 0, 0, 0, (const float*)(ws + WS_MOD) + (size_t)la * 3 * 6 * D + 2 * D); }
            __syncthreads();
            SchedMulti<GWID, GWID> S{F.lds, TL / 256, 4, 1};
            EpiResid E{F.lds};
            pg8::gemm_phase<EpiResid, SchedMulti<GWID, GWID>, false, GWID, GWID, GWID>(F.lds, S, E, F.tid);
            __syncthreads(); { int w_ = F0.wave; asm volatile("" : "+s"(w_)); tail_resid<GWID>(F0.lds, w_); }
            AMP_END(4); }
        SEAM(pb + 3);
        if constexpr (KIND(5)) if (IN(pb + 4)) { PHASE_ENTRY norm2_phase(F, P, la); AMP_END(5); }
        SEAM(pb + 4);
        if constexpr (KIND(16)) if (IN(pb + 5)) { PHASE_ENTRY
            __syncthreads(); set_desc(F.lds, F.tid, 0, ws + WS_HL, ws + WS_WRT + (size_t)la * 256 * D * 2, nullptr, 1, 0, 0); __syncthreads();
            const int nun = (la == DEPTH - 1 ? TL : T) / 256;
            if ((int)blockIdx.x >= nun) moe_weights_phase(F, P, la, ((int)blockIdx.x - nun) * NWAVES + F.wave, (F.G - nun) * NWAVES, MOE_SPLIT, MOE_ITEMS);
            else { SchedMulti<D, D> S{F.lds, nun, 1, 1};
                EpiLogits E{(float*)(ws + WS_LG)};
                pg8::gemm_phase<EpiLogits, SchedMulti<D, D>, false, D, D, D>(F.lds, S, E, F.tid);
                if (F.G <= nun) { __syncthreads(); moe_weights_phase(F, P, la, F.gw, F.NGW, MOE_SPLIT, MOE_ITEMS); } }
            AMP_END(16); }
        SEAM(pb + 5);
        if constexpr (KIND(17)) if (IN(pb + 6)) { PHASE_ENTRY route_phase(F, P, la); AMP_END(17); }
        SEAM(pb + 6);
        if constexpr (KIND(6)) if (IN(pb + 7)) { PHASE_ENTRY
            moe_tables(F.lds, F.tid, ctl + CW_CNT + la * 64);
            SchedMoE<D, D, true> S{F.lds, (const char*)(ws + WS_HL), (const char*)(ws + WS_WGU), (const int*)(ws + WS_LIST)};
            EpiSiluGate E{(bf16_t*)(ws + WS_H)};
            pg8::gemm_phase<EpiSiluGate, SchedMoE<D, D, true>, true, D, D, D>(F.lds, S, E, F.tid);
            AMP_END(6); }
        SEAM(pb + 7);
        if constexpr (KIND(7)) if (IN(pb + 8)) { PHASE_ENTRY
            moe_tables(F.lds, F.tid, ctl + CW_CNT + la * 64);
            SchedMoE<EHID, EHID, false> S{F.lds, (const char*)(ws + WS_H), (const char*)(ws + WS_WD), (const int*)(ws + WS_LIST)};
            EpiScatter E{F.lds, (bf16_t*)(ws + WS_YB), (const int*)(ws + WS_LIST)};
            pg8::gemm_phase<EpiScatter, SchedMoE<EHID, EHID, false>, false, EHID, EHID, EHID>(F.lds, S, E, F.tid);
            AMP_END(7); }
        SEAM(pb + 8);
        if constexpr (KIND(1)) if (IN(pb + 9)) { PHASE_ENTRY norm1_phase(F, P, lb); AMP_END(1); }
        SEAM(pb + 9);
        if constexpr (KIND(8)) if (IN(pb + 10)) { PHASE_ENTRY mix_phase(F, P, lp); AMP_END(8); }
        SEAM(pb + 10);
        if constexpr (KIND(9)) if (IN(pb + 11)) { PHASE_ENTRY
            __syncthreads();
            set_desc(F.lds, F.tid, 0, ws + WS_XR, ws + WS_WR + (size_t)lp * D * D * 2, ws + WS_R, 4, D, 0);
            set_desc(F.lds, F.tid, 1, ws + WS_XK, ws + WS_WK + (size_t)lp * D * D * 2, ws + WS_K, 4, D, 0);
            set_desc(F.lds, F.tid, 2, ws + WS_XV, ws + WS_WV + (size_t)lp * D * D * 2, ws + WS_VV, 4, D, 0);
            set_desc(F.lds, F.tid, 3, ws + WS_XW, ws + WS_LW1 + (size_t)lp * 256 * D * 2, ws + WS_TW, 1, 256, 1);
            set_desc(F.lds, F.tid, 4, ws + WS_XA, ws + WS_LA1 + (size_t)lp * 256 * D * 2, ws + WS_TA, 1, 256, 0);
            set_desc(F.lds, F.tid, 5, ws + WS_XG, ws + WS_LG1 + (size_t)lp * 256 * D * 2, ws + WS_TG, 1, 256, 2);
            __syncthreads();
            SchedMulti<D, D> S{F.lds, T / 256, 15, 6};
            EpiAct E{F.lds};
            pg8::gemm_phase<EpiAct, SchedMulti<D, D>, false, D, D, D>(F.lds, S, E, F.tid);
            AMP_END(9); }
        SEAM(pb + 11);
        if constexpr (KIND(10)) if (IN(pb + 12)) { PHASE_ENTRY
            __syncthreads(); set_desc(F.lds, F.tid, 0, ws + WS_TG, ws + WS_G2P + (size_t)lp * D * 256 * 2, ws + WS_GATE, 4, D, 0); __syncthreads();
            SchedMulti<256, 256> S{F.lds, T / 256, 4, 1};
            EpiAct E{F.lds};
            pg8::gemm_phase<EpiAct, SchedMulti<256, 256>, false, 256, 256, 256>(F.lds, S, E, F.tid);
            AMP_END(10); }
        __syncthreads();
        if constexpr (KIND(11)) if (IN(pb + 13)) { PHASE_ENTRY scan_chunk_phase(F, P, lp); AMP_END(11); }
        SEAM(pb + 13);
        if constexpr (KIND(14)) if (IN(pb + 14)) { PHASE_ENTRY scan_carry_phase(F, P, lb); AMP_END(14); }
        SEAM(pb + 14);
        if constexpr (KIND(15)) if (IN(pb + 15)) { PHASE_ENTRY scan_out_phase(F, P, lp); AMP_END(15); }
        SEAM(pb + 15);
        if constexpr (KIND(4)) if (IN(pb + 16)) { PHASE_ENTRY
            __syncthreads();
            { bf16_t* X = (bf16_t*)(ws + WS_X);
              set_desc(F.lds, F.tid, 0, ws + WS_YG, ws + WS_WO + (size_t)lp * D * D * 2, X, 4, 0, 0, X, X + (size_t)TL * D, nullptr);
              set_desc(F.lds, F.tid, 1, nullptr, nullptr, nullptr, 0, 0, 0, (const float*)(ws + WS_MOD) + (size_t)lb * 3 * 6 * D + 2 * D); }
            __syncthreads();
            SchedMulti<D, D> S{F.lds, TL / 256, 4, 1};
            EpiResid E{F.lds};
            pg8::gemm_phase<EpiResid, SchedMulti<D, D>, false, D, D, D>(F.lds, S, E, F.tid);
            if (lb != DEPTH - 1) { __syncthreads(); { int w_ = F0.wave; asm volatile("" : "+s"(w_)); tail_resid<D>(F0.lds, w_); } }
            AMP_END(4); }
        SEAM(pb + 16);
        if constexpr (KIND(5)) if (IN(pb + 17)) { PHASE_ENTRY norm2_phase(F, P, lb); AMP_END(5); }
        SEAM(pb + 17);
        if constexpr (KIND(16)) if (IN(pb + 18)) { PHASE_ENTRY
            __syncthreads(); set_desc(F.lds, F.tid, 0, ws + WS_HL, ws + WS_WRT + (size_t)lb * 256 * D * 2, nullptr, 1, 0, 0); __syncthreads();
            const int nun = (lb == DEPTH - 1 ? TL : T) / 256;
            if ((int)blockIdx.x >= nun) moe_weights_phase(F, P, lb, ((int)blockIdx.x - nun) * NWAVES + F.wave, (F.G - nun) * NWAVES, MOE_SPLIT, MOE_ITEMS);
            else { SchedMulti<D, D> S{F.lds, nun, 1, 1};
                EpiLogits E{(float*)(ws + WS_LG)};
                pg8::gemm_phase<EpiLogits, SchedMulti<D, D>, false, D, D, D>(F.lds, S, E, F.tid);
                if (F.G <= nun) { __syncthreads(); moe_weights_phase(F, P, lb, F.gw, F.NGW, MOE_SPLIT, MOE_ITEMS); } }
            AMP_END(16); }
        SEAM(pb + 18);
        if constexpr (KIND(17)) if (IN(pb + 19)) { PHASE_ENTRY route_phase(F, P, lb); AMP_END(17); }
        SEAM(pb + 19);
        if constexpr (KIND(6)) if (IN(pb + 20)) { PHASE_ENTRY
            moe_tables(F.lds, F.tid, ctl + CW_CNT + lb * 64);
            SchedMoE<D, D, true> S{F.lds, (const char*)(ws + WS_HL), (const char*)(ws + WS_WGU), (const int*)(ws + WS_LIST)};
            EpiSiluGate E{(bf16_t*)(ws + WS_H)};
            pg8::gemm_phase<EpiSiluGate, SchedMoE<D, D, true>, true, D, D, D>(F.lds, S, E, F.tid);
            AMP_END(6); }
        SEAM(pb + 20);
        if constexpr (KIND(7)) if (IN(pb + 21)) { PHASE_ENTRY
            moe_tables(F.lds, F.tid, ctl + CW_CNT + lb * 64);
            SchedMoE<EHID, EHID, false> S{F.lds, (const char*)(ws + WS_H), (const char*)(ws + WS_WD), (const int*)(ws + WS_LIST)};
            EpiScatter E{F.lds, (bf16_t*)(ws + WS_YB), (const int*)(ws + WS_LIST)};
            pg8::gemm_phase<EpiScatter, SchedMoE<EHID, EHID, false>, false, EHID, EHID, EHID>(F.lds, S, E, F.tid);
            AMP_END(7); }
        SEAM(pb + 21);
    }
    if constexpr (KIND(13)) if (IN(45)) { PHASE_ENTRY final_phase(F, P); AMP_END(13); }
#undef IN
#undef KIND
#undef SEAM
#undef PHASE_ENTRY
}

#if !MK_ONE_LAUNCH
static int phase_kind(int ph) { if (ph == 0) return 0; if (ph == 45) return 13; static const int k22[22] = {1, 2, 3, 4, 5, 16, 17, 6, 7, 1, 8, 9, 10, 11, 14, 15, 4, 5, 16, 17, 6, 7}; return k22[(ph - 1) % 22]; }
typedef void (*kern_t)(Params);
template <unsigned KM> static kern_t kern_of() { return mega<KM>; }
static kern_t kind_kernel(int kind) {
    switch (kind) { case 0: return kern_of<1u << 0>(); case 1: return kern_of<1u << 1>(); case 2: return kern_of<1u << 2>(); case 3: return kern_of<1u << 3>(); case 4: return kern_of<1u << 4>();
        case 5: return kern_of<1u << 5>(); case 6: return kern_of<1u << 6>(); case 7: return kern_of<1u << 7>(); case 8: return kern_of<1u << 8>(); case 9: return kern_of<1u << 9>();
        case 10: return kern_of<1u << 10>(); case 11: return kern_of<1u << 11>(); case 12: return kern_of<1u << 12>(); case 14: return kern_of<1u << 14>(); case 15: return kern_of<1u << 15>(); case 16: return kern_of<1u << 16>(); case 17: return kern_of<1u << 17>(); default: return kern_of<1u << 13>(); }
}
#endif
extern "C" void kernel_launch(void* const* d_in, const int* in_sizes, int n_in, void* d_out, int out_size, void* d_ws, size_t ws_size, hipStream_t stream) {
    static int grid = 0;
    if (grid == 0) {
        if (n_in != 42 || out_size != TL * D || ws_size < WS_END) { fprintf(stderr, "kernel_launch: unexpected problem (n_in %d, out %d, ws %zu < %zu)\n", n_in, out_size, ws_size, (size_t)WS_END); grid = -1; return; }
        int dev = 0, cus = 0;
        if (hipGetDevice(&dev) != hipSuccess || hipDeviceGetAttribute(&cus, hipDeviceAttributeMultiprocessorCount, dev) != hipSuccess) { grid = -1; return; }
#if MK_ONE_LAUNCH
        if (hipFuncSetAttribute((const void*)mega<0x3ffffu>, hipFuncAttributeMaxDynamicSharedMemorySize, LDS_BYTES) != hipSuccess) { fprintf(stderr, "kernel_launch: hipFuncSetAttribute failed\n"); grid = -1; return; }
#else
        for (int k = 0; k < 18; ++k) if (hipFuncSetAttribute((const void*)kind_kernel(k), hipFuncAttributeMaxDynamicSharedMemorySize, LDS_BYTES) != hipSuccess) { fprintf(stderr, "kernel_launch: hipFuncSetAttribute failed\n"); grid = -1; return; }
#endif
        (void)hipGetLastError();
        grid = cus;
    }
    if (grid < 0) return;
    (void)hipMemsetAsync((char*)d_ws + WS_CTL, 0, CTL_BYTES, stream);
    Params p{};
    for (int i = 0; i < 42; ++i) p.in[i] = (const float*)d_in[i];
    p.out = (float*)d_out; p.ws = (unsigned char*)d_ws;
#if MK_ONE_LAUNCH
    p.ph_lo = 0; p.ph_hi = NPH;
    hipLaunchKernelGGL(mega<0x3ffffu>, dim3(grid), dim3(NTHR), LDS_BYTES, stream, p);
#else
    for (int ph = 0; ph < NPH; ++ph) { p.ph_lo = ph; p.ph_hi = ph + 1; hipLaunchKernelGGL(kind_kernel(phase_kind(ph)), dim3(grid), dim3(NTHR), LDS_BYTES, stream, p); }
#endif
}
```

```cpp
#include <hip/hip_runtime.h>
#include <cstdio>
#include <cstdint>

#define LAS __attribute__((address_space(3)))
typedef unsigned short bf16_t;
typedef short bf16x8 __attribute__((ext_vector_type(8)));
typedef float f32x4 __attribute__((ext_vector_type(4)));
typedef float f32x2 __attribute__((ext_vector_type(2)));
typedef unsigned u32x4 __attribute__((ext_vector_type(4)));
typedef unsigned u32x2 __attribute__((ext_vector_type(2)));

#ifndef CH_AMP
#define CH_AMP -1
#endif
#define CH_STAMP(i) do { if (CH_AMP >= 0) ch_t[i] = __builtin_amdgcn_s_memrealtime(); } while (0)
#ifndef AMP_MASK
#define AMP_MASK 0u
#endif
#define AMP_F 4
#ifndef MK_ONE_LAUNCH
#define MK_ONE_LAUNCH 1
#endif

constexpr int D = 1024, NBATCH = 2, SEQ = 16384, CTXL = 256, DEPTH = 4;
constexpr int TL = NBATCH * SEQ, TC = NBATCH * CTXL, T = TL + TC;
constexpr int GWID = 2048, NE = 32, EHID = 512, NH = 16, HD = 64;
constexpr int LISTCAP = T;
constexpr int MAXRT = (2 * T) / 256 + NE;
constexpr int NWAVES = 8, NTHR = 512;

constexpr size_t MiB = 1u << 20;
constexpr size_t WS_CTL = 0, CTL_BYTES = 1 * MiB;
constexpr size_t WS_MOD = 1 * MiB;
constexpr size_t WS_WIN = 2 * MiB, WS_WOUT = 18 * MiB, WS_WSP = 26 * MiB, WS_WR = 27 * MiB, WS_WK = 31 * MiB, WS_WV = 35 * MiB, WS_WO = 39 * MiB;
constexpr size_t WS_LW1 = 43 * MiB, WS_LA1 = 44 * MiB, WS_LG1 = 45 * MiB, WS_W2P = 46 * MiB, WS_A2P = 48 * MiB, WS_G2P = 50 * MiB;
constexpr size_t WS_WRT = 52 * MiB;
constexpr size_t WS_WGU = 54 * MiB, WS_WD = 118 * MiB;
constexpr size_t WS_X = 150 * MiB;
constexpr size_t WS_LIST = 280 * MiB, WS_WGT = 285 * MiB;
constexpr size_t WS_HL = 286 * MiB;
constexpr size_t WS_BIG = 351 * MiB;
constexpr size_t SZB = 65 * MiB;
constexpr size_t WS_U = WS_BIG, WS_V = WS_BIG + 2 * SZB, WS_STAT = WS_BIG + 4 * SZB;
constexpr size_t WS_XR = WS_BIG, WS_XW = WS_BIG + SZB, WS_XK = WS_BIG + 2 * SZB, WS_XV = WS_BIG + 3 * SZB, WS_XA = WS_BIG + 4 * SZB, WS_XG = WS_BIG + 5 * SZB;
constexpr size_t WS_R = WS_BIG + 6 * SZB, WS_K = WS_BIG + 7 * SZB, WS_VV = WS_BIG + 8 * SZB;
constexpr size_t WS_TW = WS_BIG + 9 * SZB, WS_TA = WS_TW + 17 * MiB, WS_TG = WS_TA + 17 * MiB;
constexpr size_t WS_ELOG0 = WS_XR, WS_ELOG1 = WS_XW, WS_KM0 = WS_XK, WS_KM1 = WS_XV, WS_AS0 = WS_XA, WS_AS1 = WS_XG;
constexpr size_t WS_GATE = WS_HL, WS_YG = WS_AS0, WS_BON = WS_TG + 17 * MiB;
constexpr size_t WS_H = WS_BIG, WS_YB = WS_BIG + 73 * MiB, WS_LG = WS_BIG + 204 * MiB;
constexpr size_t WS_PQ = WS_KM0;
constexpr size_t WS_SST = 215 * MiB;
constexpr size_t WS_END = WS_BON + 5 * MiB;
static_assert(WS_END <= 1080 * MiB, "workspace map");
constexpr int CW_BAR = 4096;
constexpr int CW_CNT = 16384;

__device__ __forceinline__ int wave_sgpr_now(int w) { asm volatile("" : "+s"(w)); return w; }
__device__ __forceinline__ int lane_id_now() { int l; asm volatile("v_mbcnt_lo_u32_b32 %0, -1, 0\n\tv_mbcnt_hi_u32_b32 %0, -1, %0" : "=v"(l)); return l; }
typedef short v4s __attribute__((ext_vector_type(4)));
#define LDS_BARRIER() asm volatile("s_waitcnt lgkmcnt(0)\n\ts_barrier" ::: "memory")
typedef __bf16 bf16x2_t __attribute__((ext_vector_type(2)));
__device__ __forceinline__ unsigned cvt_pk_bf16(float lo, float hi) { const bf16x2_t v = __builtin_convertvector((f32x2){lo, hi}, bf16x2_t); return __builtin_bit_cast(unsigned, v); }
__device__ __forceinline__ float bf_lo(unsigned u) { return __uint_as_float(u << 16); }
__device__ __forceinline__ float bf_hi(unsigned u) { return __uint_as_float(u & 0xffff0000u); }
__device__ __forceinline__ float bf1(bf16_t b) { return __uint_as_float(((unsigned)b) << 16); }
__device__ __forceinline__ bf16_t f2bf(float f) { return (bf16_t)(cvt_pk_bf16(f, 0.f) & 0x3ffffu); }
__device__ __forceinline__ void unpack8(const u32x4& w, float (&f)[8]) { f[0] = bf_lo(w.x); f[1] = bf_hi(w.x); f[2] = bf_lo(w.y); f[3] = bf_hi(w.y); f[4] = bf_lo(w.z); f[5] = bf_hi(w.z); f[6] = bf_lo(w.w); f[7] = bf_hi(w.w); }
__device__ __forceinline__ u32x4 pack8(const float (&f)[8]) { u32x4 o; o.x = cvt_pk_bf16(f[0], f[1]); o.y = cvt_pk_bf16(f[2], f[3]); o.z = cvt_pk_bf16(f[4], f[5]); o.w = cvt_pk_bf16(f[6], f[7]); return o; }
__device__ __forceinline__ float shx(float v, int m, int lane) { return __int_as_float(__builtin_amdgcn_ds_bpermute((lane ^ m) << 2, __float_as_int(v))); }
__device__ __forceinline__ float shup(float v, int d, int lane) { return __int_as_float(__builtin_amdgcn_ds_bpermute((lane - d) << 2, __float_as_int(v))); }
__device__ __forceinline__ float wave_sum(float v, int lane) {
#pragma unroll
    for (int o = 1; o < 64; o <<= 1) v += shx(v, o, lane);
    return v;
}
__device__ __forceinline__ float sigmoidf_(float x) { return __builtin_amdgcn_rcpf(1.0f + __expf(-x)); }
__device__ __forceinline__ float tanhf_(float x) { const float e = __expf(2.0f * x); return 1.0f - 2.0f * __builtin_amdgcn_rcpf(e + 1.0f); }
__device__ __forceinline__ f32x2 gelu_pk(f32x2 v) {
    const f32x2 av = __builtin_elementwise_abs(v), d = av * 0.2316418882f + 1.0f;
    f32x2 t; t.x = __builtin_amdgcn_rcpf(d.x); t.y = __builtin_amdgcn_rcpf(d.y);
    f32x2 q = t * 0.5307027145f + (-0.7265760135f); q = q * t + 0.7107068705f; q = q * t + (-0.142248368f); q = q * t + 0.127414796f; q = q * t;
    const f32x2 s = (v * v) * (-0.72134752044f);
    f32x2 e; e.x = __builtin_amdgcn_exp2f(s.x); e.y = __builtin_amdgcn_exp2f(s.y);
    const f32x2 m = v * (q * e), r = v - m;
    f32x2 o; o.x = v.x < 0.f ? m.x : r.x; o.y = v.y < 0.f ? m.y : r.y; return o;
}

#define XB_TMO      128
#define XB_XCNT(j)  (256  + 64 * (j))
#define XB_XSUB(j)  (1280 + 64 * (j))
#define XB_XGEN(j)  (2304 + 64 * (j))
#define XB_TOP      3328
#define XB_TOPGEN   3392
#define XCD_BAR_WORDS 3456
#define XB_SPIN_CAP (1u << 18)
__device__ __forceinline__ unsigned xb_ld(unsigned* p)              { return __hip_atomic_load(p, __ATOMIC_RELAXED, __HIP_MEMORY_SCOPE_AGENT); }
__device__ __forceinline__ unsigned xb_add(unsigned* p, unsigned v) { return __hip_atomic_fetch_add(p, v, __ATOMIC_RELAXED, __HIP_MEMORY_SCOPE_AGENT); }
__device__ __forceinline__ unsigned xb_xcc_id() { return (unsigned)__builtin_amdgcn_s_getreg((3 << 11) | 20) & 0xFu; }
#define XB_SPIN(cond, bar) do { unsigned _sp = 0; while (cond) { __builtin_amdgcn_s_sleep(1); \
    if ((++_sp & 255u) == 0u) { if (xb_ld(&(bar)[XB_TMO])) break; if (_sp > XB_SPIN_CAP) { atomicAdd(&(bar)[XB_TMO], 1u); break; } } } } while (0)
struct XcdBarrier { unsigned* bar; unsigned x; volatile LAS unsigned* st; };
__device__ __forceinline__ XcdBarrier xcd_barrier_post(unsigned* bar, volatile LAS unsigned* st) {
    XcdBarrier b; b.bar = bar; b.x = xb_xcc_id(); b.st = st;
    if (threadIdx.x == 0) (void)xb_add(&bar[XB_XCNT(b.x)], 1u);
    return b;
}
__device__ __forceinline__ void xcd_barrier_complete(unsigned* bar, unsigned x, unsigned& nloc, unsigned& nx) {
    const unsigned G = gridDim.x * gridDim.y * gridDim.z;
    unsigned sum, cnt, mine, sp = 0u;
    for (;;) {
        sum = 0u; cnt = 0u; mine = 0u;
#pragma unroll
        for (unsigned j = 0; j < 16; ++j) { const unsigned c = xb_ld(&bar[XB_XCNT(j)]); sum += c; cnt += (c > 0u) ? 1u : 0u; mine = (j == x) ? c : mine; }
        if (sum == G) break;
        __builtin_amdgcn_s_sleep(1);
        if ((++sp & 255u) == 0u) { if (xb_ld(&bar[XB_TMO])) break; if (sp > XB_SPIN_CAP) { atomicAdd(&bar[XB_TMO], 1u); break; } }
    }
    nloc = mine > 0u ? mine : 1u; nx = cnt > 0u ? cnt : 1u;
}
template <bool FIRST> __device__ __forceinline__ void xcd_barrier(const XcdBarrier& b, const bool leader) {
    asm volatile("s_waitcnt vmcnt(0)" ::: "memory");
    __syncthreads();
    if (leader) {
        unsigned* bar = b.bar;
        __builtin_amdgcn_s_waitcnt(0);
        unsigned nloc = b.st[0], nx = b.st[1];
        if constexpr (FIRST) { if (nloc == 0u) { xcd_barrier_complete(bar, b.x, nloc, nx); b.st[0] = nloc; b.st[1] = nx; } }
        const unsigned old = xb_add(&bar[XB_XSUB(b.x)], 1u);
        const unsigned gen = old / nloc;
        if (old + 1u == (gen + 1u) * nloc) {
            __builtin_amdgcn_fence(__ATOMIC_RELEASE, "agent");
            asm volatile("s_waitcnt vmcnt(0)" ::: "memory");
            const unsigned og = xb_add(&bar[XB_TOP], 1u);
            const unsigned tg = og / nx;
            if (og + 1u == (tg + 1u) * nx) xb_add(&bar[XB_TOPGEN], 1u);
            else XB_SPIN(xb_ld(&bar[XB_TOPGEN]) == tg, bar);
            __builtin_amdgcn_fence(__ATOMIC_ACQUIRE, "agent");
            xb_add(&bar[XB_XGEN(b.x)], 1u);
            asm volatile("s_waitcnt vmcnt(0)" ::: "memory");
        } else {
            XB_SPIN(xb_ld(&bar[XB_XGEN(b.x)]) == gen, bar);
            __builtin_amdgcn_fence(__ATOMIC_ACQUIRE, "agent");
            asm volatile("s_waitcnt vmcnt(0)" ::: "memory");
        }
    }
    __syncthreads();
}

constexpr int LDS_MISC = 143360;
constexpr int LDS_DESC = LDS_MISC + 128;
constexpr int LDS_TAB = LDS_MISC + 512;
constexpr int LDS_BYTES = 147456;
namespace pg8 {
constexpr int BM = 256, BK = 64, HALF = 128, HTB = HALF * BK * 2, STAGE_BYTES = 8 * HTB, NXCD = 8, WGM = 8;
__host__ __device__ __forceinline__ int lds_byte(int r, int c) { const int st = (r >> 4) * 2 + (c >> 5), rr = r & 15, cc = c & 31, ob = rr * 64 + cc * 2; return st * 1024 + (ob ^ (((ob >> 9) & 1) << 5)); }
__host__ __device__ __forceinline__ void stage_rc(int b, int& R, int& C) { const int st = b / 1024, sb = b % 1024, swz = sb ^ (((sb >> 9) & 1) << 5); R = (st >> 1) * 16 + swz / 64; C = (st & 1) * 32 + (swz % 64) / 2; }
__host__ __device__ __forceinline__ int perm32(int rho) { const int n = rho >> 4, i = rho & 15; return 8 * (i >> 2) + 4 * n + (i & 3); }
__device__ __forceinline__ int xcd_remap(int L, int nwg) { const int q = nwg / NXCD, r = nwg % NXCD, xcd = L % NXCD, off = L / NXCD; return (xcd < r ? xcd * (q + 1) : r * (q + 1) + (xcd - r) * q) + off; }

struct Unit { int pm, pn, aux; };

template <class Epi, class Sched, bool GATHER, int K, int LDA, int LDB>
__device__ __forceinline__ void gemm_phase(LAS unsigned char* lds, const Sched& S, const Epi& E, const int tid_in) {
    int tid_ = tid_in; asm volatile("" : "+v"(tid_));
    const int tid = tid_, wid = __builtin_amdgcn_readfirstlane(tid >> 6), lane = tid & 63, wr = wid >> 2, wc = wid & 3, fr = lane & 15, fq = lane >> 4;
    constexpr int nt = K / BK;
    unsigned voffA[2], voffB[2];
#pragma unroll
    for (int i = 0; i < 2; ++i) { int R, C; stage_rc(tid * 16 + i * 8192, R, C); const int Rb = Epi::PERM ? ((R & ~31) + perm32(R & 31)) : R;
        voffA[i] = (unsigned)(R * LDA + C) * 2u; voffB[i] = (unsigned)(Rb * LDB + C) * 2u; }
    constexpr size_t kstep = (size_t)(BK * 2);
    constexpr size_t hstepA = GATHER ? (size_t)0 : (size_t)HALF * LDA * 2, hstepB = (size_t)HALF * LDB * 2;
    const unsigned ldsw = (unsigned)wid * 1024u;
    const int aoff = lds_byte(wr * 64 + fr, fq * 8), boff = lds_byte(wc * 32 + fr, fq * 8);
    unsigned gA[2][2], gN[2][2];
#define PG8_SA(b, h) (((b) * 2 + (h)) * HTB)
#define PG8_SB(b, h) ((4 + (b) * 2 + (h)) * HTB)
#define PG8_STAGEB(bufoff, gbase) do { _Pragma("unroll") for (int _i = 0; _i < 2; ++_i) \
        __builtin_amdgcn_global_load_lds((const unsigned*)((const char*)(gbase) + voffB[_i]), (LAS unsigned*)(lds + (bufoff) + ldsw + _i * 8192), 16, 0, 0); } while (0)
#define PG8_STAGEA(bufoff, gbase, h, GV) do { _Pragma("unroll") for (int _i = 0; _i < 2; ++_i) \
        __builtin_amdgcn_global_load_lds((const unsigned*)((const char*)(gbase) + (GATHER ? GV[h][_i] : voffA[_i]) + (h) * hstepA), (LAS unsigned*)(lds + (bufoff) + ldsw + _i * 8192), 16, 0, 0); } while (0)
#define PG8_LDA(dst, b, h) do { _Pragma("unroll") for (int m = 0; m < 4; ++m) _Pragma("unroll") for (int k = 0; k < 2; ++k) dst[m][k] = *(const LAS bf16x8*)(lds + PG8_SA(b, h) + aoff + m * 2048 + k * 1024); } while (0)
#define PG8_LDB(dst, b, h) do { _Pragma("unroll") for (int n = 0; n < 2; ++n) _Pragma("unroll") for (int k = 0; k < 2; ++k) dst[n][k] = *(const LAS bf16x8*)(lds + PG8_SB(b, h) + boff + n * 2048 + k * 1024); } while (0)
#define PG8_MMA(ai, bj, At, Bt) do { __builtin_amdgcn_s_setprio(1); _Pragma("unroll") for (int m = 0; m < 4; ++m) _Pragma("unroll") for (int n = 0; n < 2; ++n) _Pragma("unroll") for (int k = 0; k < 2; ++k) \
        acc[ai][bj][m][n] = __builtin_amdgcn_mfma_f32_16x16x32_bf16(Bt[n][k], At[m][k], acc[ai][bj][m][n], 0, 0, 0); __builtin_amdgcn_s_setprio(0); } while (0)
#define PG8_WAIT_V(n) asm volatile("s_waitcnt vmcnt(" #n ")" ::: "memory")
#define PG8_WAIT_L(n) asm volatile("s_waitcnt lgkmcnt(" #n ")" ::: "memory")
#define PG8_BAR __builtin_amdgcn_s_barrier()
#define PG8_SCHED __builtin_amdgcn_sched_barrier(0)
    Unit cur, nxt; int ui = 0;
    if (!S.next(0, cur)) return;
    f32x4 acc[2][2][4][2];
#pragma unroll
    for (int a = 0; a < 2; ++a)
#pragma unroll
        for (int b = 0; b < 2; ++b)
#pragma unroll
            for (int m = 0; m < 4; ++m)
#pragma unroll
                for (int n = 0; n < 2; ++n) acc[a][b][m][n] = (f32x4){0.f, 0.f, 0.f, 0.f};
    bf16x8 At[4][2], B0[2][2], B1[2][2];
    const char* cA = S.aptr(cur); const char* cB = S.bptr(cur);
    if constexpr (GATHER) { S.gather(cur, tid, gA); }
    PG8_STAGEB(PG8_SB(0, 0), cB); PG8_STAGEB(PG8_SB(0, 1), cB + hstepB); PG8_STAGEA(PG8_SA(0, 0), cA, 0, gA); PG8_STAGEA(PG8_SA(0, 1), cA, 1, gA);
    if (wr == 1) PG8_BAR;
    PG8_WAIT_V(2); PG8_BAR;
    PG8_STAGEB(PG8_SB(1, 0), cB + kstep); PG8_STAGEA(PG8_SA(1, 0), cA + kstep, 0, gA); PG8_STAGEB(PG8_SB(1, 1), cB + hstepB + kstep);
    PG8_WAIT_V(6); PG8_BAR;
    for (;;) {
        const bool has_next = S.next(ui + 1, nxt);
        const char* nA = has_next ? S.aptr(nxt) : cA; const char* nB = has_next ? S.bptr(nxt) : cB;
        if constexpr (GATHER) { if (has_next) S.gather(nxt, tid, gN); else {
#pragma unroll
            for (int h = 0; h < 2; ++h)
#pragma unroll
                for (int i = 0; i < 2; ++i) gN[h][i] = gA[h][i]; } }
#pragma nounroll
        for (int t = 0; t < nt; t += 2) {
            const bool last = (t == nt - 2);
            const char* a1 = cA + (size_t)(t + 1) * kstep;
            const char* a2 = last ? nA : cA + (size_t)(t + 2) * kstep; const char* b2 = last ? nB : cB + (size_t)(t + 2) * kstep;
            const char* a3 = a2 + kstep; const char* b3 = b2 + kstep;
            unsigned g2[2][2];
            if constexpr (GATHER) {
#pragma unroll
                for (int h = 0; h < 2; ++h)
#pragma unroll
                    for (int i = 0; i < 2; ++i) g2[h][i] = last ? gN[h][i] : gA[h][i]; }
            PG8_LDB(B0, 0, 0); PG8_LDB(B1, 0, 1); PG8_SCHED; PG8_LDA(At, 0, 0); PG8_STAGEA(PG8_SA(1, 1), a1, 1, gA);
            PG8_WAIT_V(8); PG8_WAIT_L(0); PG8_BAR; PG8_MMA(0, 0, At, B0); PG8_MMA(0, 1, At, B1); PG8_BAR; PG8_SCHED;
            PG8_LDA(At, 0, 1); PG8_STAGEB(PG8_SB(0, 0), b2); PG8_STAGEB(PG8_SB(0, 1), b2 + hstepB); PG8_STAGEA(PG8_SA(0, 0), a2, 0, g2);
            PG8_WAIT_V(8); PG8_WAIT_L(0); PG8_BAR; PG8_MMA(1, 0, At, B0); PG8_MMA(1, 1, At, B1); PG8_BAR; PG8_SCHED;
            PG8_LDB(B0, 1, 0); PG8_LDB(B1, 1, 1); PG8_SCHED; PG8_LDA(At, 1, 0); PG8_STAGEA(PG8_SA(0, 1), a2, 1, g2);
            PG8_WAIT_V(8); PG8_WAIT_L(0); PG8_BAR; PG8_MMA(0, 0, At, B0); PG8_MMA(0, 1, At, B1); PG8_BAR; PG8_SCHED;
            PG8_LDA(At, 1, 1); PG8_STAGEB(PG8_SB(1, 0), b3); PG8_STAGEB(PG8_SB(1, 1), b3 + hstepB); PG8_STAGEA(PG8_SA(1, 0), a3, 0, g2);
            PG8_WAIT_V(8); PG8_WAIT_L(0); PG8_BAR; PG8_MMA(1, 0, At, B0); PG8_MMA(1, 1, At, B1); PG8_BAR; PG8_SCHED;
        }
        if (wr == 0) PG8_BAR;
        E(acc, cur, wr, wc, fr, fq);
        if (!has_next) break;
#pragma unroll
        for (int a = 0; a < 2; ++a)
#pragma unroll
            for (int b = 0; b < 2; ++b)
#pragma unroll
                for (int m = 0; m < 4; ++m)
#pragma unroll
                    for (int n = 0; n < 2; ++n) acc[a][b][m][n] = (f32x4){0.f, 0.f, 0.f, 0.f};
        cur = nxt; cA = nA; cB = nB; ++ui;
        if constexpr (GATHER) {
#pragma unroll
            for (int h = 0; h < 2; ++h)
#pragma unroll
                for (int i = 0; i < 2; ++i) gA[h][i] = gN[h][i]; }
        if (wr == 1) PG8_BAR;
    }
    PG8_WAIT_V(0);
    PG8_BAR;
#undef PG8_SA
#undef PG8_SB
#undef PG8_STAGEA
#undef PG8_STAGEB
#undef PG8_LDA
#undef PG8_LDB
#undef PG8_MMA
#undef PG8_WAIT_V
#undef PG8_WAIT_L
#undef PG8_BAR
#undef PG8_SCHED
}
}
using pg8::Unit;

__device__ __forceinline__ void set_desc(LAS unsigned char* lds, int tid, int g, const void* A, const void* B, const void* C, int nN, int ldc, int aux, const void* X1 = nullptr, const void* X2 = nullptr, const void* X3 = nullptr) {
    LAS int* d = (LAS int*)(lds + LDS_DESC) + g * 16;
    if (tid == 0) { unsigned long long a = (unsigned long long)A, b = (unsigned long long)B, c = (unsigned long long)C, x1 = (unsigned long long)X1, x2 = (unsigned long long)X2, x3 = (unsigned long long)X3;
        asm volatile("" : "+s"(a), "+s"(b), "+s"(c), "+s"(x1), "+s"(x2), "+s"(x3), "+s"(nN), "+s"(ldc), "+s"(aux));
        d[0] = (int)(unsigned)a; d[1] = (int)(unsigned)(a >> 32); d[2] = (int)(unsigned)b; d[3] = (int)(unsigned)(b >> 32); d[4] = (int)(unsigned)c; d[5] = (int)(unsigned)(c >> 32); d[6] = nN; d[7] = ldc; d[8] = aux;
        d[10] = (int)(unsigned)x1; d[11] = (int)(unsigned)(x1 >> 32); d[12] = (int)(unsigned)x2; d[13] = (int)(unsigned)(x2 >> 32); d[14] = (int)(unsigned)x3; d[15] = (int)(unsigned)(x3 >> 32); }
}
__device__ __forceinline__ int desc_i(LAS unsigned char* lds, int g, int f) { return __builtin_amdgcn_readfirstlane(((LAS const int*)(lds + LDS_DESC))[g * 16 + f]); }
__device__ __forceinline__ const char* desc_p(LAS unsigned char* lds, int g, int f) {
    const unsigned lo = (unsigned)desc_i(lds, g, f), hi = (unsigned)desc_i(lds, g, f + 1); return (const char*)(((unsigned long long)hi << 32) | lo); }
template <int LDA, int LDB>
struct SchedMulti {
    LAS unsigned char* lds; int nM, ntot, ng;
    __device__ __forceinline__ bool next(int i, Unit& u) const {
        const int nwg = nM * ntot; const long L = (long)i * gridDim.x + blockIdx.x; if (L >= nwg) return false;
        const int wgid = pg8::xcd_remap((int)L, nwg);
        const int nig = pg8::WGM * ntot, gid = wgid / nig, fm = gid * pg8::WGM, gsz = (nM - fm) < pg8::WGM ? (nM - fm) : pg8::WGM;
        u.pm = fm + ((wgid % nig) % gsz); int pv = (wgid % nig) / gsz; int g = 0;
        for (int j = 0; j + 1 < ng; ++j) { const int n = desc_i(lds, j, 6); if (pv < n) break; pv -= n; g = j + 1; }
        u.pn = pv; u.aux = g; return true;
    }
    __device__ __forceinline__ const char* aptr(const Unit& u) const { return desc_p(lds, u.aux, 0) + (size_t)u.pm * (512 * LDA); }
    __device__ __forceinline__ const char* bptr(const Unit& u) const { return desc_p(lds, u.aux, 2) + (size_t)u.pn * (512 * LDB); }
};
template <int LDA, int LDB, bool GATHERED>
struct SchedMoE {
    LAS unsigned char* lds; const char* Abase; const char* Bbase; const int* list;
    __device__ __forceinline__ bool next(int i, Unit& u) const {
        LAS const int* tab = (LAS const int*)(lds + LDS_TAB);
        const int nrt = __builtin_amdgcn_readfirstlane(tab[2 * MAXRT + 32]);
        const int nwg = nrt * 4; const long L = (long)i * gridDim.x + blockIdx.x; if (L >= nwg) return false;
        const int wgid = pg8::xcd_remap((int)L, nwg);
        u.pm = wgid >> 2; u.pn = wgid & 3; u.aux = __builtin_amdgcn_readfirstlane(tab[u.pm]); return true;
    }
    __device__ __forceinline__ const char* aptr(const Unit& u) const { return GATHERED ? Abase : Abase + (size_t)u.pm * (512 * LDA); }
    __device__ __forceinline__ const char* bptr(const Unit& u) const { return Bbase + (size_t)u.aux * ((size_t)D * LDB * 2) + (size_t)u.pn * (512 * LDB); }
    __device__ __forceinline__ void gather(const Unit& u, int tid, unsigned (&g)[2][2]) const {
        LAS const int* tab = (LAS const int*)(lds + LDS_TAB);
        const int j0 = __builtin_amdgcn_readfirstlane(tab[MAXRT + u.pm]), cn = __builtin_amdgcn_readfirstlane(tab[2 * MAXRT + u.aux]);
#pragma unroll
        for (int i = 0; i < 2; ++i) { int R, C; pg8::stage_rc(tid * 16 + i * 8192, R, C);
#pragma unroll
            for (int h = 0; h < 2; ++h) { const int slot = j0 + 128 * h + R; const int a = slot < cn ? list[(size_t)u.aux * LISTCAP + slot] : 0;
                g[h][i] = (unsigned)((a >> 1) * LDA + C) * 2u; } }
    }
};
__device__ __forceinline__ void moe_tables(LAS unsigned char* lds, int tid, const unsigned* cnt) {
    LAS int* tab = (LAS int*)(lds + LDS_TAB);
    __syncthreads();
    if (tid < 64) {
        const int e = tid & 31; const bool act = tid < NE;
        const int c = act ? (int)__hip_atomic_load(cnt + e, __ATOMIC_RELAXED, __HIP_MEMORY_SCOPE_AGENT) : 0;
        const int nt = (c + 255) >> 8; int incl = nt;
#pragma unroll
        for (int d = 1; d < 32; d <<= 1) { const int t = __builtin_amdgcn_ds_bpermute((tid >= d ? tid - d : tid) << 2, incl); if (tid >= d) incl += t; }
        if (act) { const int start = incl - nt; tab[2 * MAXRT + e] = c;
#pragma nounroll
            for (int j = 0; j < nt; ++j) { tab[start + j] = e; tab[MAXRT + start + j] = j * 256; }
            if (tid == NE - 1) tab[2 * MAXRT + 32] = incl; }
    }
    __syncthreads();
}

#define EPI_FENCE() asm volatile("" ::: "memory")
struct EpiGelu {
    static constexpr bool PERM = true;
    LAS unsigned char* lds;
    __device__ __forceinline__ void operator()(const f32x4 (&acc)[2][2][4][2], const Unit& u, int wr, int wc, int fr, int fq) const {
        const bool isv = u.pn >= 8; bf16_t* base = (bf16_t*)desc_p(lds, 0, isv ? 10 : 4); const float* bias = (const float*)desc_p(lds, 0, 12); float* stat = (float*)desc_p(lds, 0, 14);
        const int col0 = (u.pn & 7) * 256 + wc * 32 + 8 * fq, bcol0 = u.pn * 256 + wc * 32 + 8 * fq, row0 = u.pm * 256 + wr * 64 + fr;
        f32x4 bv[2][2];
#pragma unroll
        for (int bj = 0; bj < 2; ++bj)
#pragma unroll
            for (int n = 0; n < 2; ++n) bv[bj][n] = *(const f32x4*)(bias + bcol0 + bj * 128 + 4 * n);
#pragma unroll
        for (int ai = 0; ai < 2; ++ai)
#pragma unroll
            for (int m = 0; m < 4; ++m) { const int row = row0 + ai * 128 + m * 16; bf16_t* rowp = base + (size_t)row * GWID + col0; float s = 0.f, q = 0.f;
#pragma unroll
                for (int bj = 0; bj < 2; ++bj) { const f32x4 v0 = acc[ai][bj][m][0] + bv[bj][0], v1 = acc[ai][bj][m][1] + bv[bj][1];
                    const f32x2 a = gelu_pk((f32x2){v0[0], v0[1]}), b = gelu_pk((f32x2){v0[2], v0[3]}), c = gelu_pk((f32x2){v1[0], v1[1]}), d = gelu_pk((f32x2){v1[2], v1[3]});
                    s += ((a.x + a.y) + (b.x + b.y)) + ((c.x + c.y) + (d.x + d.y));
                    q += ((a.x * a.x + a.y * a.y) + (b.x * b.x + b.y * b.y)) + ((c.x * c.x + c.y * c.y) + (d.x * d.x + d.y * d.y));
                    u32x4 w; w.x = cvt_pk_bf16(a.x, a.y); w.y = cvt_pk_bf16(b.x, b.y); w.z = cvt_pk_bf16(c.x, c.y); w.w = cvt_pk_bf16(d.x, d.y);
                    *(u32x4*)(rowp + bj * 128) = w; }
                if (isv) { const int ln_ = 16 * fq + fr; s += shx(s, 16, ln_); s += shx(s, 32, ln_); q += shx(q, 16, ln_); q += shx(q, 32, ln_);
                    if (fq == 0) *(f32x2*)(stat + ((size_t)row * 32 + (u.pn - 8) * 4 + wc) * 2) = (f32x2){s, q}; } }
    }
};
struct EpiResid {
    static constexpr bool PERM = true;
    LAS unsigned char* lds;
    __device__ __forceinline__ void operator()(const f32x4 (&acc)[2][2][4][2], const Unit& u, int wr, int wc, int fr, int fq) const {
        const int mrow = u.pm < 64 ? 0 : (u.pm < 128 ? 1 : 2);
        bf16_t* x = (bf16_t*)desc_p(lds, 0, 4) + (size_t)(u.pm * 256 + wr * 64 + fr) * D + u.pn * 256 + wc * 32 + 8 * fq;
        const float* bias = (const float*)desc_p(lds, 0, 14); const float* gate = (const float*)desc_p(lds, 1, 10) + mrow * 6 * D + u.pn * 256 + wc * 32 + 8 * fq;
        if (bias) bias += u.pn * 256 + wc * 32 + 8 * fq;
#pragma unroll
        for (int bj = 0; bj < 2; ++bj) { const int c = bj * 128;
            const f32x4 b0 = bias ? *(const f32x4*)(bias + c) : (f32x4){0.f, 0.f, 0.f, 0.f}, b1 = bias ? *(const f32x4*)(bias + c + 4) : (f32x4){0.f, 0.f, 0.f, 0.f};
            const f32x4 g0 = *(const f32x4*)(gate + c), g1 = *(const f32x4*)(gate + c + 4);
            u32x4 xw[2][4];
#pragma unroll
            for (int ai = 0; ai < 2; ++ai)
#pragma unroll
                for (int m = 0; m < 4; ++m) xw[ai][m] = *(const u32x4*)(x + (size_t)(ai * 128 + m * 16) * D + c);
#pragma unroll
            for (int ai = 0; ai < 2; ++ai) {
#pragma unroll
                for (int m = 0; m < 4; ++m) { const u32x4 w = xw[ai][m];
                    const f32x4 o0 = (f32x4){bf_lo(w.x), bf_hi(w.x), bf_lo(w.y), bf_hi(w.y)} + g0 * (acc[ai][bj][m][0] + b0), o1 = (f32x4){bf_lo(w.z), bf_hi(w.z), bf_lo(w.w), bf_hi(w.w)} + g1 * (acc[ai][bj][m][1] + b1);
                    u32x4 w2; w2.x = cvt_pk_bf16(o0[0], o0[1]); w2.y = cvt_pk_bf16(o0[2], o0[3]); w2.z = cvt_pk_bf16(o1[0], o1[1]); w2.w = cvt_pk_bf16(o1[2], o1[3]);
                    *(u32x4*)(x + (size_t)(ai * 128 + m * 16) * D + c) = w2; }
                EPI_FENCE(); } }
    }
};
template <int K>
__device__ __forceinline__ void tail_resid(LAS unsigned char* lds, int wave) {
    const int lane = lane_id_now(), fr = lane & 15, q = lane >> 4, tid = wave * 64 + lane;
    constexpr int KW = K / 8, RP = 68;
    LAS float* red = (LAS float*)lds;
    const bf16_t* A = (const bf16_t*)desc_p(lds, 0, 0) + (size_t)TL * K; const bf16_t* W = (const bf16_t*)desc_p(lds, 0, 2);
    bf16_t* X = (bf16_t*)desc_p(lds, 0, 4) + (size_t)TL * D; const float* bias = (const float*)desc_p(lds, 0, 14); const float* gate = (const float*)desc_p(lds, 1, 10) + 2 * 6 * D;
    for (int item = blockIdx.x; item < TC / 32 * 16; item += gridDim.x) {
        const int r0 = (item >> 4) * 32, c0 = (item & 15) * 64;
        const bf16_t* ap = A + (size_t)(r0 + fr) * K + wave * KW + 16 * q;
        const bf16_t* bp = W + (size_t)(c0 + fr) * K + wave * KW + 16 * q;
        const int erow = tid >> 4, ec4 = 4 * (tid & 15), ecol = c0 + ec4; bf16_t* ep = X + (size_t)(r0 + erow) * D + ecol;
        const u32x2 exw = *(const u32x2*)ep; const f32x4 eb = bias ? *(const f32x4*)(bias + ecol) : (f32x4){0.f, 0.f, 0.f, 0.f}, eg = *(const f32x4*)(gate + ecol);
        f32x4 acc[2][4];
#pragma unroll
        for (int v = 0; v < 2; ++v)
#pragma unroll
            for (int n = 0; n < 4; ++n) acc[v][n] = (f32x4){0.f, 0.f, 0.f, 0.f};
#pragma unroll
        for (int kb = 0; kb < KW / 64; ++kb) {
            const bf16x8 a00 = *(const bf16x8*)(ap + kb * 64), a01 = *(const bf16x8*)(ap + kb * 64 + 8), a10 = *(const bf16x8*)(ap + (size_t)16 * K + kb * 64), a11 = *(const bf16x8*)(ap + (size_t)16 * K + kb * 64 + 8);
#pragma unroll
            for (int n = 0; n < 4; ++n) { const bf16x8 b0 = *(const bf16x8*)(bp + (size_t)n * 16 * K + kb * 64), b1 = *(const bf16x8*)(bp + (size_t)n * 16 * K + kb * 64 + 8);
                acc[0][n] = __builtin_amdgcn_mfma_f32_16x16x32_bf16(a00, b0, acc[0][n], 0, 0, 0); acc[0][n] = __builtin_amdgcn_mfma_f32_16x16x32_bf16(a01, b1, acc[0][n], 0, 0, 0);
                acc[1][n] = __builtin_amdgcn_mfma_f32_16x16x32_bf16(a10, b0, acc[1][n], 0, 0, 0); acc[1][n] = __builtin_amdgcn_mfma_f32_16x16x32_bf16(a11, b1, acc[1][n], 0, 0, 0); }
        }
#pragma unroll
        for (int v = 0; v < 2; ++v)
#pragma unroll
            for (int n = 0; n < 4; ++n)
#pragma unroll
                for (int r = 0; r < 4; ++r) red[(wave * 32 + 16 * v + 4 * q + r) * RP + n * 16 + fr] = acc[v][n][r];
        __syncthreads();
        { f32x4 sm = (f32x4){0.f, 0.f, 0.f, 0.f};
#pragma unroll
          for (int w = 0; w < 8; ++w) sm += *(LAS const f32x4*)(red + (w * 32 + erow) * RP + ec4);
          const f32x4 o = (f32x4){bf_lo(exw.x), bf_hi(exw.x), bf_lo(exw.y), bf_hi(exw.y)} + eg * (sm + eb);
          u32x2 w2; w2.x = cvt_pk_bf16(o[0], o[1]); w2.y = cvt_pk_bf16(o[2], o[3]); *(u32x2*)ep = w2; }
        __syncthreads();
    }
}
__device__ __forceinline__ void tail_gelu(LAS unsigned char* lds, int wave) {
    const int lane = lane_id_now(), fr = lane & 15, q = lane >> 4, tid = wave * 64 + lane;
    constexpr int K = D, KW = K / 8, RP = 260;
    LAS float* red = (LAS float*)lds;
    const bf16_t* A = (const bf16_t*)desc_p(lds, 0, 0) + (size_t)TL * K; const bf16_t* W = (const bf16_t*)desc_p(lds, 0, 2);
    const float* bias = (const float*)desc_p(lds, 0, 12); float* stat = (float*)desc_p(lds, 0, 14);
    for (int item = blockIdx.x; item < TC / 16 * 16; item += gridDim.x) {
        const int r0 = (item >> 4) * 16, c0 = (item & 15) * 256;
        const bf16_t* ap = A + (size_t)(r0 + fr) * K + wave * KW + 16 * q;
        const bf16_t* bp = W + (size_t)(c0 + fr) * K + wave * KW + 16 * q;
        const bf16x8 a0 = *(const bf16x8*)(ap), a1 = *(const bf16x8*)(ap + 8), a2 = *(const bf16x8*)(ap + 64), a3 = *(const bf16x8*)(ap + 72);
#pragma unroll 1
        for (int ng = 0; ng < 4; ++ng) {
            f32x4 acc[4];
#pragma unroll
            for (int n = 0; n < 4; ++n) { const bf16_t* b = bp + (size_t)(ng * 4 + n) * 16 * K;
                const bf16x8 b0 = *(const bf16x8*)(b), b1 = *(const bf16x8*)(b + 8), b2 = *(const bf16x8*)(b + 64), b3 = *(const bf16x8*)(b + 72);
                f32x4 c = (f32x4){0.f, 0.f, 0.f, 0.f};
                c = __builtin_amdgcn_mfma_f32_16x16x32_bf16(a0, b0, c, 0, 0, 0); c = __builtin_amdgcn_mfma_f32_16x16x32_bf16(a1, b1, c, 0, 0, 0);
                c = __builtin_amdgcn_mfma_f32_16x16x32_bf16(a2, b2, c, 0, 0, 0); c = __builtin_amdgcn_mfma_f32_16x16x32_bf16(a3, b3, c, 0, 0, 0); acc[n] = c; }
#pragma unroll
            for (int n = 0; n < 4; ++n)
#pragma unroll
                for (int r = 0; r < 4; ++r) red[(wave * 16 + 4 * q + r) * RP + (ng * 4 + n) * 16 + fr] = acc[n][r];
        }
        __syncthreads();
        { const int row = tid >> 5, c8 = 8 * (tid & 31); f32x4 s0 = (f32x4){0.f, 0.f, 0.f, 0.f}, s1 = s0;
#pragma unroll
          for (int w = 0; w < 8; ++w) { s0 += *(LAS const f32x4*)(red + (w * 16 + row) * RP + c8); s1 += *(LAS const f32x4*)(red + (w * 16 + row) * RP + c8 + 4); }
          const int col = c0 + c8; const bool isv = col >= GWID; bf16_t* base = (bf16_t*)desc_p(lds, 0, isv ? 10 : 4);
          s0 += *(const f32x4*)(bias + col); s1 += *(const f32x4*)(bias + col + 4);
          const f32x2 a = gelu_pk((f32x2){s0[0], s0[1]}), b = gelu_pk((f32x2){s0[2], s0[3]}), c = gelu_pk((f32x2){s1[0], s1[1]}), d = gelu_pk((f32x2){s1[2], s1[3]});
          u32x4 w; w.x = cvt_pk_bf16(a.x, a.y); w.y = cvt_pk_bf16(b.x, b.y); w.z = cvt_pk_bf16(c.x, c.y); w.w = cvt_pk_bf16(d.x, d.y);
          *(u32x4*)(base + (size_t)(TL + r0 + row) * GWID + (col & (GWID - 1))) = w;
          if (isv) { float s = ((a.x + a.y) + (b.x + b.y)) + ((c.x + c.y) + (d.x + d.y)), qq = ((a.x * a.x + a.y * a.y) + (b.x * b.x + b.y * b.y)) + ((c.x * c.x + c.y * c.y) + (d.x * d.x + d.y * d.y));
              s += shx(s, 1, lane); s += shx(s, 2, lane); s += shx(s, 4, lane); qq += shx(qq, 1, lane); qq += shx(qq, 2, lane); qq += shx(qq, 4, lane);
              if ((lane & 7) == 0) *(f32x2*)(stat + ((size_t)(TL + r0 + row) * 32 + ((col - GWID) >> 6)) * 2) = (f32x2){s, qq}; } }
        __syncthreads();
    }
}
struct EpiAct {
    static constexpr bool PERM = true;
    LAS unsigned char* lds;
    __device__ __forceinline__ void operator()(const f32x4 (&acc)[2][2][4][2], const Unit& u, int wr, int wc, int fr, int fq) const {
        bf16_t* C = (bf16_t*)desc_p(lds, u.aux, 4); const int ldc = desc_i(lds, u.aux, 7), act = desc_i(lds, u.aux, 8);
        const int col0 = u.pn * 256 + wc * 32 + 8 * fq, row0 = u.pm * 256 + wr * 64 + fr;
#pragma unroll
        for (int ai = 0; ai < 2; ++ai)
#pragma unroll
            for (int m = 0; m < 4; ++m) { bf16_t* rowp = C + (size_t)(row0 + ai * 128 + m * 16) * ldc + col0;
#pragma unroll
                for (int bj = 0; bj < 2; ++bj) { f32x4 v0 = acc[ai][bj][m][0], v1 = acc[ai][bj][m][1];
                    if (act == 1) {
#pragma unroll
                        for (int j = 0; j < 4; ++j) { v0[j] = tanhf_(v0[j]); v1[j] = tanhf_(v1[j]); } }
                    else if (act == 2) {
#pragma unroll
                        for (int j = 0; j < 4; ++j) { v0[j] = sigmoidf_(v0[j]); v1[j] = sigmoidf_(v1[j]); } }
                    u32x4 w; w.x = cvt_pk_bf16(v0[0], v0[1]); w.y = cvt_pk_bf16(v0[2], v0[3]); w.z = cvt_pk_bf16(v1[0], v1[1]); w.w = cvt_pk_bf16(v1[2], v1[3]);
                    *(u32x4*)(rowp + bj * 128) = w; } }
    }
};
struct EpiLogits {
    static constexpr bool PERM = false;
    float* LG;
    __device__ __forceinline__ void operator()(const f32x4 (&acc)[2][2][4][2], const Unit& u, int wr, int wc, int fr, int fq) const {
        if (wc >= 2) return;
        const int col0 = wc * 32 + 4 * fq, row0 = u.pm * 256 + wr * 64 + fr;
#pragma unroll
        for (int ai = 0; ai < 2; ++ai)
#pragma unroll
            for (int m = 0; m < 4; ++m)
#pragma unroll
                for (int n = 0; n < 2; ++n) *(f32x4*)(LG + (size_t)(row0 + ai * 128 + m * 16) * 64 + col0 + n * 16) = acc[ai][0][m][n] + acc[ai][1][m][n];
    }
};
struct EpiSiluGate {
    static constexpr bool PERM = true;
    bf16_t* H;
    __device__ __forceinline__ void operator()(const f32x4 (&acc)[2][2][4][2], const Unit& u, int wr, int wc, int fr, int fq) const {
        const int col0 = u.pn * 128 + wc * 32 + 8 * fq, row0 = u.pm * 256 + wr * 64 + fr;
#pragma unroll
        for (int ai = 0; ai < 2; ++ai)
#pragma unroll
            for (int m = 0; m < 4; ++m) { f32x4 h0, h1;
#pragma unroll
                for (int j = 0; j < 4; ++j) { const float g0 = acc[ai][0][m][0][j], g1 = acc[ai][0][m][1][j]; h0[j] = g0 * sigmoidf_(g0) * acc[ai][1][m][0][j]; h1[j] = g1 * sigmoidf_(g1) * acc[ai][1][m][1][j]; }
                u32x4 w; w.x = cvt_pk_bf16(h0[0], h0[1]); w.y = cvt_pk_bf16(h0[2], h0[3]); w.z = cvt_pk_bf16(h1[0], h1[1]); w.w = cvt_pk_bf16(h1[2], h1[3]);
                *(u32x4*)(H + (size_t)(row0 + ai * 128 + m * 16) * EHID + col0) = w; }
    }
};
struct EpiScatter {
    static constexpr bool PERM = true;
    LAS unsigned char* lds; bf16_t* YB; const int* list;
    __device__ __forceinline__ void operator()(const f32x4 (&acc)[2][2][4][2], const Unit& u, int wr, int wc, int fr, int fq) const {
        LAS const int* tab = (LAS const int*)(lds + LDS_TAB);
        const int j0 = __builtin_amdgcn_readfirstlane(tab[MAXRT + u.pm]), cn = __builtin_amdgcn_readfirstlane(tab[2 * MAXRT + u.aux]);
        const int col0 = u.pn * 256 + wc * 32 + 8 * fq;
        int aid[2][4];
#pragma unroll
        for (int ai = 0; ai < 2; ++ai)
#pragma unroll
            for (int m = 0; m < 4; ++m) { const int slot = j0 + ai * 128 + wr * 64 + m * 16 + fr; aid[ai][m] = slot < cn ? list[(size_t)u.aux * LISTCAP + slot] : -1; }
#pragma unroll
        for (int ai = 0; ai < 2; ++ai)
#pragma unroll
            for (int m = 0; m < 4; ++m) { const int a = aid[ai][m];
                if (a >= 0) { bf16_t* rowp = YB + (size_t)a * D + col0;
#pragma unroll
                    for (int bj = 0; bj < 2; ++bj) { const f32x4 v0 = acc[ai][bj][m][0], v1 = acc[ai][bj][m][1];
                        u32x4 w; w.x = cvt_pk_bf16(v0[0], v0[1]); w.y = cvt_pk_bf16(v0[2], v0[3]); w.z = cvt_pk_bf16(v1[0], v1[1]); w.w = cvt_pk_bf16(v1[2], v1[3]);
                        *(u32x4*)(rowp + bj * 128) = w; } } }
    }
};

struct Params { const float* in[42]; float* out; unsigned char* ws; int ph_lo, ph_hi; };
enum { I_X = 0, I_C, I_CTX, I_CCTX, I_ADAW, I_ADAB, I_N1G, I_N2G, I_FG, I_GWIN, I_GBIN, I_GLNG, I_GLNB, I_GWS, I_GBS, I_GWOUT, I_GBOUT,
       I_MU, I_WR, I_WK, I_WV, I_WO, I_W0, I_W1, I_W2, I_A0, I_A1, I_A2, I_G1, I_G2, I_KK, I_KA, I_RK, I_LNG, I_LNB,
       I_MWGRP, I_MBGRP, I_MWEXP, I_MBEXP, I_MWG, I_MWU, I_MWD };
struct Frame { LAS unsigned char* lds; int tid, lane, wave, G, gw, NGW; };
typedef const __attribute__((address_space(4))) Params* KP;

constexpr int TRP = 36, TR_SCR = 64 * TRP * 4;
__device__ __forceinline__ void tr_item(const float* W, int N, int kmax, bf16_t* WT, int ldk, int k0, int n0, int drow0, int dk0, LAS float* scr, int lane) {
    const int n4 = lane & 7, kr = lane >> 3; f32x4 v[8];
#pragma unroll
    for (int i = 0; i < 8; ++i) { const int k = k0 + 8 * i + kr; v[i] = k < kmax ? *(const f32x4*)(W + (size_t)k * N + n0 + 4 * n4) : (f32x4){0.f, 0.f, 0.f, 0.f}; }
#pragma unroll
    for (int i = 0; i < 8; ++i) *(LAS f32x4*)(scr + (8 * i + kr) * TRP + 4 * n4) = v[i];
    asm volatile("s_waitcnt lgkmcnt(0)" ::: "memory");
    const int c = lane & 7;
#pragma unroll
    for (int j = 0; j < 4; ++j) { const int n = (lane >> 3) + 8 * j; const LAS float* sp = scr + (8 * c) * TRP + n;
        u32x4 o; o.x = cvt_pk_bf16(sp[0 * TRP], sp[1 * TRP]); o.y = cvt_pk_bf16(sp[2 * TRP], sp[3 * TRP]); o.z = cvt_pk_bf16(sp[4 * TRP], sp[5 * TRP]); o.w = cvt_pk_bf16(sp[6 * TRP], sp[7 * TRP]);
        *(u32x4*)(WT + (size_t)(drow0 + n) * ldk + dk0 + k0 + 8 * c) = o; }
    asm volatile("s_waitcnt lgkmcnt(0)" ::: "memory");
}
constexpr int LDS_JOBS = 80 * 1024, MAXJOBS = 48;
__device__ __forceinline__ void add_job(LAS int* jobs, int& nj, int& nit, const float* src, int N, int kmax, int kpad, bf16_t* dst, int ldk, int drow0, int dk0) {
    LAS int* q = jobs + nj * 12; const unsigned long long a = (unsigned long long)src, d = (unsigned long long)dst;
    q[0] = (int)(unsigned)a; q[1] = (int)(unsigned)(a >> 32); q[2] = (int)(unsigned)d; q[3] = (int)(unsigned)(d >> 32); q[4] = N; q[5] = kmax; q[6] = kpad / 64; q[7] = ldk; q[8] = drow0; q[9] = dk0; q[10] = nit;
    nit += (kpad / 64) * (N / 32); ++nj;
}
__device__ __forceinline__ void zero_fill(const Frame& F, bf16_t* p, size_t nbytes) {
    u32x4* q = (u32x4*)p; const size_t n = nbytes / 16;
    for (size_t i = (size_t)blockIdx.x * NTHR + F.tid; i < n; i += (size_t)F.G * NTHR) q[i] = (u32x4){0u, 0u, 0u, 0u};
}

__device__ __forceinline__ void prologue_phase(const Frame& F, KP P) {
    unsigned char* ws = P->ws;
    {   float* MOD = (float*)(ws + WS_MOD); LAS float* part = (LAS float*)F.lds;
        const float* c = P->in[I_C]; const float* cc = P->in[I_CCTX];
        for (int item = blockIdx.x; item < DEPTH * 24; item += F.G) {
            const int layer = item / 24, col = (item % 24) * 256 + 4 * F.lane; const float* w = P->in[I_ADAW] + (size_t)layer * D * 6 * D + col;
            f32x4 a0 = (f32x4){0.f, 0.f, 0.f, 0.f}, a1 = a0, a2 = a0;
#pragma unroll 8
            for (int i = 0; i < 128; ++i) { const int d = F.wave + 8 * i; const f32x4 wv = *(const f32x4*)(w + (size_t)d * 6 * D);
                const float c0 = c[d], c1 = c[D + d], c2 = cc[d];
                a0 += wv * (c0 * sigmoidf_(c0)); a1 += wv * (c1 * sigmoidf_(c1)); a2 += wv * (c2 * sigmoidf_(c2)); }
            __syncthreads();
            *(LAS f32x4*)(part + (F.wave * 3 + 0) * 256 + 4 * F.lane) = a0; *(LAS f32x4*)(part + (F.wave * 3 + 1) * 256 + 4 * F.lane) = a1; *(LAS f32x4*)(part + (F.wave * 3 + 2) * 256 + 4 * F.lane) = a2;
            __syncthreads();
            if (F.wave < 3) { f32x4 sacc = (f32x4){0.f, 0.f, 0.f, 0.f};
#pragma unroll
                for (int w8 = 0; w8 < 8; ++w8) sacc += *(const LAS f32x4*)(part + (w8 * 3 + F.wave) * 256 + 4 * F.lane);
                *(f32x4*)(MOD + ((size_t)layer * 3 + F.wave) * 6 * D + col) = sacc + *(const f32x4*)(P->in[I_ADAB] + (size_t)layer * 6 * D + col); }
        }
    }
    LAS int* jobs = (LAS int*)(F.lds + LDS_JOBS); LAS int* jtot = jobs + MAXJOBS * 12;
    __syncthreads();
    if (F.tid == 0) { int nj = 0, nit = 0;
        for (int j = 0; j < 2; ++j) {
            add_job(jobs, nj, nit, P->in[I_GWIN] + (size_t)j * D * 4096, 4096, D, D, (bf16_t*)(ws + WS_WIN) + (size_t)j * 4096 * D, D, 0, 0);
            add_job(jobs, nj, nit, P->in[I_GWOUT] + (size_t)j * GWID * D, D, GWID, GWID, (bf16_t*)(ws + WS_WOUT) + (size_t)j * D * GWID, GWID, 0, 0);
            add_job(jobs, nj, nit, P->in[I_WR] + (size_t)j * D * D, D, D, D, (bf16_t*)(ws + WS_WR) + (size_t)j * D * D, D, 0, 0);
            add_job(jobs, nj, nit, P->in[I_WK] + (size_t)j * D * D, D, D, D, (bf16_t*)(ws + WS_WK) + (size_t)j * D * D, D, 0, 0);
            add_job(jobs, nj, nit, P->in[I_WV] + (size_t)j * D * D, D, D, D, (bf16_t*)(ws + WS_WV) + (size_t)j * D * D, D, 0, 0);
            add_job(jobs, nj, nit, P->in[I_WO] + (size_t)j * D * D, D, D, D, (bf16_t*)(ws + WS_WO) + (size_t)j * D * D, D, 0, 0);
            for (int z = 0; z < 2; ++z) {
                add_job(jobs, nj, nit, P->in[I_W1] + ((size_t)j * 2 + z) * D * 64, 64, D, D, (bf16_t*)(ws + WS_LW1) + (size_t)j * 256 * D, D, z * 64, 0);
                add_job(jobs, nj, nit, P->in[I_A1] + ((size_t)j * 2 + z) * D * 64, 64, D, D, (bf16_t*)(ws + WS_LA1) + (size_t)j * 256 * D, D, z * 64, 0);
                add_job(jobs, nj, nit, P->in[I_W2] + ((size_t)j * 2 + z) * 64 * D, D, 64, 64, (bf16_t*)(ws + WS_W2P) + ((size_t)j * 2 + z) * D * 256, 256, 0, z * 64);
                add_job(jobs, nj, nit, P->in[I_A2] + ((size_t)j * 2 + z) * 64 * D, D, 64, 64, (bf16_t*)(ws + WS_A2P) + ((size_t)j * 2 + z) * D * 256, 256, 0, z * 64); }
            add_job(jobs, nj, nit, P->in[I_G1] + (size_t)j * D * 160, 160, D, D, (bf16_t*)(ws + WS_LG1) + (size_t)j * 256 * D, D, 0, 0);
            add_job(jobs, nj, nit, P->in[I_G2] + (size_t)j * 160 * D, D, 160, 256, (bf16_t*)(ws + WS_G2P) + (size_t)j * D * 256, 256, 0, 0); }
        jtot[0] = nj; jtot[1] = nit; }
    __syncthreads();
    {   const int nj = jtot[0], nit = jtot[1]; LAS float* scr = (LAS float*)(F.lds + F.wave * TR_SCR);
        for (int it = F.gw; it < nit; it += F.NGW) {
            int jb = 0; for (int q = 1; q < nj; ++q) if (it >= jobs[q * 12 + 10]) jb = q;
            jb = __builtin_amdgcn_readfirstlane(jb); LAS const int* q = jobs + jb * 12;
            const float* src = (const float*)(((unsigned long long)(unsigned)q[1] << 32) | (unsigned)q[0]); bf16_t* dst = (bf16_t*)(((unsigned long long)(unsigned)q[3] << 32) | (unsigned)q[2]);
            const int N = q[4], nnb = N / 32, r = it - q[10], kb = r / nnb, nb = r % nnb;
            tr_item(src, N, q[5], dst, q[7], kb * 64, nb * 32, q[8] + nb * 32, q[9], scr, F.lane); }
    }
    for (int j = 0; j < 2; ++j) {
        bf16_t* lw1 = (bf16_t*)(ws + WS_LW1) + (size_t)j * 256 * D; bf16_t* la1 = (bf16_t*)(ws + WS_LA1) + (size_t)j * 256 * D; bf16_t* lg1 = (bf16_t*)(ws + WS_LG1) + (size_t)j * 256 * D;
        zero_fill(F, lw1 + 128 * D, (size_t)128 * D * 2); zero_fill(F, la1 + 128 * D, (size_t)128 * D * 2); zero_fill(F, lg1 + 160 * D, (size_t)96 * D * 2);
        for (int z = 0; z < 2; ++z) { bf16_t* w2p = (bf16_t*)(ws + WS_W2P) + ((size_t)j * 2 + z) * D * 256; bf16_t* a2p = (bf16_t*)(ws + WS_A2P) + ((size_t)j * 2 + z) * D * 256;
            for (int idx = blockIdx.x * NTHR + F.tid; idx < D * 32; idx += F.G * NTHR) { const int n = idx >> 5, ch = idx & 31;
                if ((ch >> 3) != z) { *(u32x4*)(w2p + (size_t)n * 256 + ch * 8) = (u32x4){0u, 0u, 0u, 0u}; *(u32x4*)(a2p + (size_t)n * 256 + ch * 8) = (u32x4){0u, 0u, 0u, 0u}; } } }
    }
    {   bf16_t* wrt = (bf16_t*)(ws + WS_WRT);
        for (int idx = blockIdx.x * NTHR + F.tid; idx < DEPTH * 256 * (D / 8); idx += F.G * NTHR) { const int k0 = (idx & 127) * 8, n = (idx >> 7) & 255, layer = idx >> 15;
            const int nn = n & 127; const bool lo = n >= 128; float w[8];
#pragma unroll
            for (int e = 0; e < 8; ++e) { float x = 0.f;
                if (nn < 4) x = P->in[I_MWGRP][((size_t)layer * D + k0 + e) * 4 + nn]; else if (nn < 36) x = P->in[I_MWEXP][((size_t)layer * D + k0 + e) * NE + nn - 4];
                const float hi = bf_lo(cvt_pk_bf16(x, 0.f)); w[e] = lo ? x - hi : x; }
            *(u32x4*)(wrt + ((size_t)layer * 256 + n) * D + k0) = pack8(w); } }
    {   const float* src = P->in[I_GWS]; bf16_t* dst = (bf16_t*)(ws + WS_WSP); const int n8 = 2 * 16 * 128 * 128 / 8;
        for (int i = blockIdx.x * NTHR + F.tid; i < n8; i += F.G * NTHR) { const f32x4 a = *(const f32x4*)(src + (size_t)i * 8), b = *(const f32x4*)(src + (size_t)i * 8 + 4);
            u32x4 o; o.x = cvt_pk_bf16(a[0], a[1]); o.y = cvt_pk_bf16(a[2], a[3]); o.z = cvt_pk_bf16(b[0], b[1]); o.w = cvt_pk_bf16(b[2], b[3]); *(u32x4*)(dst + (size_t)i * 8) = o; } }
}
struct MoeItem { const float* src; bf16_t* dst; int N, kmax, ldk, k0, n0, drow0; };
__device__ __forceinline__ MoeItem moe_item(KP P, unsigned char* ws, int layer, int it) {
    const int e = it / 768, r = it % 768, m = r >> 8, q = r & 255; const size_t so = ((size_t)layer * NE + e) * (size_t)D * EHID; MoeItem I;
    if (m < 2) { const int kb = q >> 4, n0 = (q & 15) * 32;
        I.src = (m == 0 ? P->in[I_MWG] : P->in[I_MWU]) + so; I.N = EHID; I.kmax = D; I.dst = (bf16_t*)(ws + WS_WGU) + (size_t)e * D * D; I.ldk = D; I.k0 = kb * 64; I.n0 = n0; I.drow0 = 256 * (n0 >> 7) + (n0 & 127) + (m == 1 ? 128 : 0); }
    else { const int kb = q >> 5, n0 = (q & 31) * 32;
        I.src = P->in[I_MWD] + so; I.N = D; I.kmax = EHID; I.dst = (bf16_t*)(ws + WS_WD) + (size_t)e * D * EHID; I.ldk = EHID; I.k0 = kb * 64; I.n0 = n0; I.drow0 = n0; }
    return I;
}
__device__ __forceinline__ void tr_load(const MoeItem& I, int lane, f32x4 (&v)[8]) {
    const int n4 = lane & 7, kr = lane >> 3;
#pragma unroll
    for (int i = 0; i < 8; ++i) v[i] = *(const f32x4*)(I.src + (size_t)(I.k0 + 8 * i + kr) * I.N + I.n0 + 4 * n4);
}
__device__ __forceinline__ void tr_store(const MoeItem& I, int lane, const f32x4 (&v)[8], LAS float* scr) {
    const int n4 = lane & 7, kr = lane >> 3;
#pragma unroll
    for (int i = 0; i < 8; ++i) *(LAS f32x4*)(scr + (8 * i + kr) * TRP + 4 * n4) = v[i];
    asm volatile("s_waitcnt lgkmcnt(0)" ::: "memory");
    const int c = lane & 7;
#pragma unroll
    for (int j = 0; j < 4; ++j) { const int n = (lane >> 3) + 8 * j; const LAS float* sp = scr + (8 * c) * TRP + n;
        u32x4 o; o.x = cvt_pk_bf16(sp[0 * TRP], sp[1 * TRP]); o.y = cvt_pk_bf16(sp[2 * TRP], sp[3 * TRP]); o.z = cvt_pk_bf16(sp[4 * TRP], sp[5 * TRP]); o.w = cvt_pk_bf16(sp[6 * TRP], sp[7 * TRP]);
        *(u32x4*)(I.dst + (size_t)(I.drow0 + n) * I.ldk + I.k0 + 8 * c) = o; }
    asm volatile("s_waitcnt lgkmcnt(0)" ::: "memory");
}
constexpr int MOE_ITEMS = NE * 768, MOE_SPLIT = 9216;
__device__ __forceinline__ void moe_weights_phase(const Frame& F, KP P, int layer, int vgw, int vngw, int it0, int it1) {
    unsigned char* ws = P->ws; LAS float* scr = (LAS float*)(F.lds + F.wave * TR_SCR);
    int it = it0 + vgw; f32x4 v[8], vn[8];
    if (it < it1) { const MoeItem I = moe_item(P, ws, layer, it); tr_load(I, F.lane, v); }
#pragma nounroll
    while (it < it1) { const int nx = it + vngw;
        if (nx < it1) { const MoeItem In = moe_item(P, ws, layer, nx); tr_load(In, F.lane, vn); }
        { const MoeItem I = moe_item(P, ws, layer, it); tr_store(I, F.lane, v, scr); }
#pragma unroll
        for (int i = 0; i < 8; ++i) v[i] = vn[i];
        it = nx; }
}

__device__ __forceinline__ void load_xrow(KP P, const Frame& F, int layer, int row, f32x4 (&v)[4]) {
    if (layer == 0) { const float* xr = row < TL ? P->in[I_X] + (size_t)row * D : P->in[I_CTX] + (size_t)(row - TL) * D;
#pragma unroll
        for (int j = 0; j < 4; ++j) v[j] = *(const f32x4*)(xr + 4 * F.lane + 256 * j); }
    else { const bf16_t* xr = (const bf16_t*)(P->ws + WS_X) + (size_t)row * D;
#pragma unroll
        for (int j = 0; j < 4; ++j) { const u32x2 w = *(const u32x2*)(xr + 4 * F.lane + 256 * j); v[j] = (f32x4){bf_lo(w.x), bf_hi(w.x), bf_lo(w.y), bf_hi(w.y)}; } }
}
__device__ __forceinline__ void load_vec4(const float* p, int lane, f32x4 (&r)[4]) {
#pragma unroll
    for (int j = 0; j < 4; ++j) r[j] = *(const f32x4*)(p + 4 * lane + 256 * j);
}
__device__ __forceinline__ void load_combine(KP P, const Frame& F, int layer, int row, bool combine, const f32x4 (&g2r)[4], f32x4 (&v)[4]) {
    load_xrow(P, F, layer, row, v);
    if (combine) {
        const bf16_t* yb = (const bf16_t*)(P->ws + WS_YB); const float* wg = (const float*)(P->ws + WS_WGT);
        const float w0 = wg[2 * row], w1 = wg[2 * row + 1];
#pragma unroll
        for (int j = 0; j < 4; ++j) { const int col = 4 * F.lane + 256 * j; const u32x2 a = *(const u32x2*)(yb + (size_t)(2 * row) * D + col), b = *(const u32x2*)(yb + (size_t)(2 * row + 1) * D + col);
            const f32x4 g = g2r[j];
            v[j][0] += g[0] * (w0 * bf_lo(a.x) + w1 * bf_lo(b.x)); v[j][1] += g[1] * (w0 * bf_hi(a.x) + w1 * bf_hi(b.x));
            v[j][2] += g[2] * (w0 * bf_lo(a.y) + w1 * bf_lo(b.y)); v[j][3] += g[3] * (w0 * bf_hi(a.y) + w1 * bf_hi(b.y)); }
    }
}
__device__ __forceinline__ void norm1_phase(const Frame& F, KP P, int layer) {
    const bool combine = layer > 0; bf16_t* X = (bf16_t*)(P->ws + WS_X); bf16_t* HL = (bf16_t*)(P->ws + WS_HL);
    f32x4 g1r[4], shr[4], scr[4], g2r[4]; load_vec4(P->in[I_N1G] + (size_t)layer * D, F.lane, g1r); int mc = -1;
#pragma unroll
    for (int j = 0; j < 4; ++j) { shr[j] = (f32x4){0.f, 0.f, 0.f, 0.f}; scr[j] = shr[j]; g2r[j] = shr[j]; }
    for (int row = F.gw; row < T; row += F.NGW) {
        const int m = row < TL ? (row >> 14) : 2; f32x4 v[4];
        if (m != mc) { mc = m; const float* mod = (const float*)(P->ws + WS_MOD) + ((size_t)layer * 3 + m) * 6 * D; load_vec4(mod, F.lane, shr); load_vec4(mod + D, F.lane, scr);
            if (combine) load_vec4((const float*)(P->ws + WS_MOD) + ((size_t)(layer - 1) * 3 + m) * 6 * D + 5 * D, F.lane, g2r); }
        load_combine(P, F, layer, row, combine, g2r, v);
        {
#pragma unroll
            for (int j = 0; j < 4; ++j) { u32x2 o; o.x = cvt_pk_bf16(v[j][0], v[j][1]); o.y = cvt_pk_bf16(v[j][2], v[j][3]); *(u32x2*)(X + (size_t)row * D + 4 * F.lane + 256 * j) = o;
                v[j] = (f32x4){bf_lo(o.x), bf_hi(o.x), bf_lo(o.y), bf_hi(o.y)}; } }
        float ss = 0.f;
#pragma unroll
        for (int j = 0; j < 4; ++j) ss += (v[j][0] * v[j][0] + v[j][1] * v[j][1]) + (v[j][2] * v[j][2] + v[j][3] * v[j][3]);
        const float rstd = rsqrtf(wave_sum(ss, F.lane) * (1.0f / D) + 1e-6f);
#pragma unroll
        for (int j = 0; j < 4; ++j) { const int col = 4 * F.lane + 256 * j;
            const f32x4 h = (v[j] * rstd) * g1r[j] * (scr[j] + 1.0f) + shr[j];
            u32x2 o; o.x = cvt_pk_bf16(h[0], h[1]); o.y = cvt_pk_bf16(h[2], h[3]); *(u32x2*)(HL + (size_t)row * D + col) = o; }
    }
}
__device__ __forceinline__ void final_phase(const Frame& F, KP P) {
    f32x4 fgr[4], g2r[4]; load_vec4(P->in[I_FG], F.lane, fgr); int mc = -1;
#pragma unroll
    for (int j = 0; j < 4; ++j) g2r[j] = (f32x4){0.f, 0.f, 0.f, 0.f};
    for (int row = F.gw; row < TL; row += F.NGW) {
        const int m = row >> 14; f32x4 v[4];
        if (m != mc) { mc = m; load_vec4((const float*)(P->ws + WS_MOD) + ((size_t)(DEPTH - 1) * 3 + m) * 6 * D + 5 * D, F.lane, g2r); }
        load_combine(P, F, DEPTH, row, true, g2r, v);
        float ss = 0.f;
#pragma unroll
        for (int j = 0; j < 4; ++j) ss += (v[j][0] * v[j][0] + v[j][1] * v[j][1]) + (v[j][2] * v[j][2] + v[j][3] * v[j][3]);
        const float rstd = rsqrtf(wave_sum(ss, F.lane) * (1.0f / D) + 1e-6f);
#pragma unroll
        for (int j = 0; j < 4; ++j) { const int col = 4 * F.lane + 256 * j; *(f32x4*)(P->out + (size_t)row * D + col) = (v[j] * rstd) * fgr[j]; }
    }
}
__device__ __forceinline__ void norm2_phase(const Frame& F, KP P, int layer) {
    const int ntok = layer == DEPTH - 1 ? TL : T; bf16_t* HL2 = (bf16_t*)(P->ws + WS_HL);
    f32x4 gr[4], shr[4], scr[4]; load_vec4(P->in[I_N2G] + (size_t)layer * D, F.lane, gr); int mc = -1;
#pragma unroll
    for (int j = 0; j < 4; ++j) { shr[j] = (f32x4){0.f, 0.f, 0.f, 0.f}; scr[j] = shr[j]; }
    for (int row = F.gw; row < ntok; row += F.NGW) {
        const int m = row < TL ? (row >> 14) : 2; f32x4 v[4]; load_xrow(P, F, 1, row, v);
        if (m != mc) { mc = m; const float* mod = (const float*)(P->ws + WS_MOD) + ((size_t)layer * 3 + m) * 6 * D; load_vec4(mod + 3 * D, F.lane, shr); load_vec4(mod + 4 * D, F.lane, scr); }
        float ss = 0.f;
#pragma unroll
        for (int j = 0; j < 4; ++j) ss += (v[j][0] * v[j][0] + v[j][1] * v[j][1]) + (v[j][2] * v[j][2] + v[j][3] * v[j][3]);
        const float rstd = rsqrtf(wave_sum(ss, F.lane) * (1.0f / D) + 1e-6f);
#pragma unroll
        for (int j = 0; j < 4; ++j) { const int col = 4 * F.lane + 256 * j;
            const f32x4 h = (v[j] * rstd) * gr[j] * (scr[j] + 1.0f) + shr[j];
            u32x2 o; o.x = cvt_pk_bf16(h[0], h[1]); o.y = cvt_pk_bf16(h[2], h[3]); *(u32x2*)(HL2 + (size_t)row * D + col) = o; }
    }
    if (!(layer & 1)) moe_weights_phase(F, P, layer, F.gw, F.NGW, 0, MOE_SPLIT);
}
__device__ __forceinline__ void route_rows(const Frame& F, KP P, int layer, int row0) {
    const int ntok = layer == DEPTH - 1 ? TL : T; const float* LG = (const float*)(P->ws + WS_LG);
    const float* bgrp = P->in[I_MBGRP] + layer * 4; const float* bexp = P->in[I_MBEXP] + layer * NE;
    unsigned* cnt = (unsigned*)(P->ws + WS_CTL) + CW_CNT + layer * 64; int* list = (int*)(P->ws + WS_LIST); float* wgt = (float*)(P->ws + WS_WGT);
    LAS unsigned* lcnt = (LAS unsigned*)F.lds; LAS unsigned* lbase = lcnt + 32;
    {
        const int row = row0 + F.tid; const bool act = F.tid < 256 && row < ntok;
        __syncthreads();
        if (F.tid < 32) lcnt[F.tid] = 0u;
        __syncthreads();
        int e0 = 0, e1 = 0; unsigned k0 = 0, k1 = 0;
        if (act) {
            const float* lg = LG + (size_t)row * 64; const f32x4 g4 = *(const f32x4*)lg;
            float ag[4];
#pragma unroll
            for (int i = 0; i < 4; ++i) ag[i] = g4[i] + bgrp[i];
            int grp = 0; float mx = ag[0];
#pragma unroll
            for (int i = 1; i < 4; ++i) if (ag[i] > mx) { mx = ag[i]; grp = i; }
            float den = 0.f;
#pragma unroll
            for (int i = 0; i < 4; ++i) den += __expf(ag[i] - mx);
            const float pg = 1.0f / den;
            const f32x4 e0v = *(const f32x4*)(lg + 4 + 8 * grp), e1v = *(const f32x4*)(lg + 8 + 8 * grp); const f32x4 b0v = *(const f32x4*)(bexp + 8 * grp), b1v = *(const f32x4*)(bexp + 8 * grp + 4);
            float el[8];
#pragma unroll
            for (int i = 0; i < 4; ++i) { el[i] = e0v[i] + b0v[i]; el[4 + i] = e1v[i] + b1v[i]; }
            int i0 = 0; float t0 = el[0];
#pragma unroll
            for (int i = 1; i < 8; ++i) if (el[i] > t0) { t0 = el[i]; i0 = i; }
            int i1 = -1; float t1 = -3.0e38f;
#pragma unroll
            for (int i = 0; i < 8; ++i) if (i != i0 && el[i] > t1) { t1 = el[i]; i1 = i; }
            const float p0 = 1.0f / (1.0f + __expf(t1 - t0));
            wgt[2 * row] = pg * p0; wgt[2 * row + 1] = pg * (1.0f - p0);
            e0 = grp * 8 + i0; e1 = grp * 8 + i1;
            k0 = atomicAdd((unsigned*)(lcnt + e0), 1u); k1 = atomicAdd((unsigned*)(lcnt + e1), 1u);
        }
        __syncthreads();
        if (F.tid < 32) { const unsigned c = lcnt[F.tid]; lbase[F.tid] = c ? atomicAdd(cnt + F.tid, c) : 0u; }
        __syncthreads();
        if (act) { list[(size_t)e0 * LISTCAP + lbase[e0] + k0] = 2 * row; list[(size_t)e1 * LISTCAP + lbase[e1] + k1] = 2 * row + 1; }
    }
}
__device__ __forceinline__ bf16x8 tr_frag136(const LAS bf16_t* M, int k0, int c0, int lane) {
    LAS bf16_t* p = (LAS bf16_t*)M + (k0 + 8 * (lane >> 4) + ((lane & 15) >> 2)) * 136 + c0 + 4 * (lane & 3);
    const v4s lo = __builtin_amdgcn_ds_read_tr16_b64_v4i16((LAS v4s*)p), hi = __builtin_amdgcn_ds_read_tr16_b64_v4i16((LAS v4s*)(p + 4 * 136));
    return (bf16x8){lo[0], lo[1], lo[2], lo[3], hi[0], hi[1], hi[2], hi[3]};
}
__device__ __forceinline__ bf16x8 tr_frag136p(const LAS bf16_t* M, int k0, int dt, int lane) {
    LAS bf16_t* p = (LAS bf16_t*)M + (k0 + 8 * (lane >> 4) + ((lane & 15) >> 2)) * 136 + 32 * (dt >> 1) + 8 * (lane & 3) + 4 * (dt & 1);
    const v4s lo = __builtin_amdgcn_ds_read_tr16_b64_v4i16((LAS v4s*)p), hi = __builtin_amdgcn_ds_read_tr16_b64_v4i16((LAS v4s*)(p + 4 * 136));
    return (bf16x8){lo[0], lo[1], lo[2], lo[3], hi[0], hi[1], hi[2], hi[3]};
}
__device__ __forceinline__ void spatial_phase(const Frame& F, KP P, int j) {
    bf16_t* U = (bf16_t*)(P->ws + WS_U); const bf16_t* V = (const bf16_t*)(P->ws + WS_V); const float* stat = (const float*)(P->ws + WS_STAT);
    const bf16_t* WSP = (const bf16_t*)(P->ws + WS_WSP) + (size_t)j * 16 * 128 * 128;
    const float* lng = P->in[I_GLNG] + (size_t)j * GWID; const float* lnb = P->in[I_GLNB] + (size_t)j * GWID; const float* bs = P->in[I_GBS] + (size_t)j * 16 * 128;
    LAS bf16_t* Wt = (LAS bf16_t*)F.lds; LAS bf16_t* Vn = Wt + 128 * 136;
    LAS float* mu = (LAS float*)(F.lds + 2 * 128 * 136 * 2); LAS float* rs = mu + 128;
    const int l15 = F.lane & 15, l4 = F.lane >> 4;
    constexpr int NUNIT = (T / 128) * 16;
    const int u0 = (int)((long)blockIdx.x * NUNIT / F.G), u1 = (int)((long)(blockIdx.x + 1) * NUNIT / F.G);
#define SP_LOAD(W_, V_, U_, t0_, g_) do { \
        _Pragma("unroll") for (int i = 0; i < 4; ++i) { const int idx = F.tid + NTHR * i, r = idx >> 4, seg = idx & 15; \
            W_[i] = *(const u32x4*)(WSP + ((size_t)(g_) * 128 + r) * 128 + seg * 8); V_[i] = *(const u32x4*)(V + (size_t)((t0_) + r) * GWID + (g_) * 128 + seg * 8); } \
        { const bf16_t* ur_ = U + (size_t)((t0_) + 16 * F.wave + l15) * GWID + (g_) * 128 + 8 * l4; \
          _Pragma("unroll") for (int e = 0; e < 4; ++e) U_[e] = *(const u32x4*)(ur_ + e * 32); } } while (0)
    u32x4 wv[4], vv[4], uu[4];
    if (u0 < u1) SP_LOAD(wv, vv, uu, (u0 >> 4) * 128, u0 & 15);
    int cprev = -1;
#pragma nounroll
    for (int u = u0; u < u1; ++u) { const int c = u >> 4, g = u & 15, t0 = c * 128;
        if (c != cprev) { cprev = c;
            if (F.tid < 128) { const int row = t0 + F.tid; float s = 0.f, q = 0.f;
#pragma unroll
                for (int i = 0; i < 16; ++i) { const f32x4 p = *(const f32x4*)(stat + ((size_t)row * 32 + 2 * i) * 2); s += p[0] + p[2]; q += p[1] + p[3]; }
                const float mean = s * (1.0f / GWID), var = q * (1.0f / GWID) - mean * mean; mu[F.tid] = mean; rs[F.tid] = rsqrtf(var + 1e-5f); } }
        LDS_BARRIER();
#pragma unroll
        for (int i = 0; i < 4; ++i) { const int idx = F.tid + NTHR * i, r = idx >> 4, seg = idx & 15, ch = g * 128 + seg * 8;
            *(LAS u32x4*)(Wt + r * 136 + seg * 8) = wv[i];
            float x[8], o[8]; unpack8(vv[i], x); const float m_ = mu[r], r_ = rs[r];
            const f32x4 g0 = *(const f32x4*)(lng + ch), g1 = *(const f32x4*)(lng + ch + 4), b0 = *(const f32x4*)(lnb + ch), b1 = *(const f32x4*)(lnb + ch + 4);
#pragma unroll
            for (int e = 0; e < 8; ++e) o[e] = (x[e] - m_) * r_ * (e < 4 ? g0[e & 3] : g1[e & 3]) + (e < 4 ? b0[e & 3] : b1[e & 3]);
            *(LAS u32x4*)(Vn + r * 136 + seg * 8) = pack8(o); }
        u32x4 wn[4], vn[4], un[4];
        if (u + 1 < u1) SP_LOAD(wn, vn, un, ((u + 1) >> 4) * 128, (u + 1) & 15);
        LDS_BARRIER();
        bf16x8 bw[4];
#pragma unroll
        for (int ks = 0; ks < 4; ++ks) bw[ks] = *(const LAS bf16x8*)(Wt + (16 * F.wave + l15) * 136 + ks * 32 + 8 * l4);
        const int p = 16 * F.wave + l15; const float bias = bs[g * 128 + p];
        bf16_t* urow = U + (size_t)(t0 + p) * GWID + g * 128 + 8 * l4;
#pragma unroll
        for (int e = 0; e < 4; ++e) { f32x4 a0 = (f32x4){0.f, 0.f, 0.f, 0.f}, a1 = a0;
#pragma unroll
            for (int ks = 0; ks < 4; ++ks) { const bf16x8 f0 = tr_frag136p(Vn, 32 * ks, 2 * e, F.lane), f1 = tr_frag136p(Vn, 32 * ks, 2 * e + 1, F.lane);
                a0 = __builtin_amdgcn_mfma_f32_16x16x32_bf16(f0, bw[ks], a0, 0, 0, 0); a1 = __builtin_amdgcn_mfma_f32_16x16x32_bf16(f1, bw[ks], a1, 0, 0, 0); }
            u32x4 o; o.x = cvt_pk_bf16(bf_lo(uu[e].x) * (a0[0] + bias), bf_hi(uu[e].x) * (a0[1] + bias)); o.y = cvt_pk_bf16(bf_lo(uu[e].y) * (a0[2] + bias), bf_hi(uu[e].y) * (a0[3] + bias));
            o.z = cvt_pk_bf16(bf_lo(uu[e].z) * (a1[0] + bias), bf_hi(uu[e].z) * (a1[1] + bias)); o.w = cvt_pk_bf16(bf_lo(uu[e].w) * (a1[2] + bias), bf_hi(uu[e].w) * (a1[3] + bias));
            *(u32x4*)(urow + e * 32) = o; }
        if (u + 1 < u1) {
#pragma unroll
            for (int i = 0; i < 4; ++i) { wv[i] = wn[i]; vv[i] = vn[i]; uu[i] = un[i]; } }
    }
#undef SP_LOAD
}

__device__ __forceinline__ void mix_phase(const Frame& F, KP P, int j) {
    const bf16_t* HL = (const bf16_t*)(P->ws + WS_HL); const float* mu = P->in[I_MU] + (size_t)j * 6 * D;
    bf16_t* outs[6] = {(bf16_t*)(P->ws + WS_XR), (bf16_t*)(P->ws + WS_XW), (bf16_t*)(P->ws + WS_XK), (bf16_t*)(P->ws + WS_XV), (bf16_t*)(P->ws + WS_XA), (bf16_t*)(P->ws + WS_XG)};
    f32x4 mr[2][6][2];
#pragma unroll
    for (int jj = 0; jj < 2; ++jj)
#pragma unroll
        for (int m = 0; m < 6; ++m) { const int col = 512 * jj + 8 * F.lane; mr[jj][m][0] = *(const f32x4*)(mu + (size_t)m * D + col); mr[jj][m][1] = *(const f32x4*)(mu + (size_t)m * D + col + 4); }
    for (int row = F.gw; row < T; row += F.NGW) {
        bool ok[2]; int src[2]; const bool hi = F.lane >= 32;
        if (row < TL) { const int n = row & (SEQ - 1), gc = n & 63, gr = n >> 6;
            ok[0] = hi ? gc < 63 : gc > 0; src[0] = hi ? row + 1 : row - 1; ok[1] = hi ? gr < 255 : gr > 0; src[1] = hi ? row + 64 : row - 64; }
        else { const int n = (row - TL) & (CTXL - 1); ok[0] = n > 0; src[0] = row - 1; ok[1] = n < CTXL - 1; src[1] = row + 1; }
#pragma unroll
        for (int jj = 0; jj < 2; ++jj) { const int col = 512 * jj + 8 * F.lane;
            const u32x4 h8 = *(const u32x4*)(HL + (size_t)row * D + col); u32x4 s8 = (u32x4){0u, 0u, 0u, 0u};
            if (ok[jj]) s8 = *(const u32x4*)(HL + (size_t)src[jj] * D + col);
            const unsigned hw[4] = {h8.x, h8.y, h8.z, h8.w}, sw[4] = {s8.x, s8.y, s8.z, s8.w}; float h[8], xx[8];
#pragma unroll
            for (int e = 0; e < 8; ++e) { h[e] = (e & 1) ? bf_hi(hw[e >> 1]) : bf_lo(hw[e >> 1]); const float s = (e & 1) ? bf_hi(sw[e >> 1]) : bf_lo(sw[e >> 1]); xx[e] = s - h[e]; }
#pragma unroll
            for (int m = 0; m < 6; ++m) { const f32x4 ma = mr[jj][m][0], mb = mr[jj][m][1];
                u32x4 o; o.x = cvt_pk_bf16(h[0] + xx[0] * ma[0], h[1] + xx[1] * ma[1]); o.y = cvt_pk_bf16(h[2] + xx[2] * ma[2], h[3] + xx[3] * ma[3]);
                o.z = cvt_pk_bf16(h[4] + xx[4] * mb[0], h[5] + xx[5] * mb[1]); o.w = cvt_pk_bf16(h[6] + xx[6] * mb[2], h[7] + xx[7] * mb[3]);
                *(u32x4*)(outs[m] + (size_t)row * D + col) = o; } }
    }
}

constexpr int NCH = 5, SCP = NCH * 64, NSC = (SEQ + CTXL) / SCP, NSCAN = 64, TP = 72, TILE_B = 64 * TP * 2;
static_assert(NSC * SCP == SEQ + CTXL, "super-chunks");
enum { T_AT = 0, T_RT, T_BT, T_KT, T_VM, T_NT, T_MT, T_NRT, T_MRT, T_APA, T_APB, T_TAA, T_TAB, T_PRB, T_QRB, T_NTILE };
constexpr int LDS_GL = T_NTILE * TILE_B, LDS_SEG = LDS_GL + 256;
static_assert(LDS_SEG + 2048 <= LDS_MISC, "scan LDS map");
__device__ __forceinline__ int scan_row(int z, int b, int p) {
    if (p < CTXL) return TL + b * CTXL + (z ? CTXL - 1 - p : p);
    const int q = p - CTXL; return b * SEQ + (z ? SEQ - 1 - q : q);
}
__device__ __forceinline__ LAS bf16_t* stile(LAS unsigned char* lds, int n) { return (LAS bf16_t*)(lds + n * TILE_B); }
__device__ __forceinline__ bf16x8 row_frag(const LAS bf16_t* M, int r0, int k0, int lane) { return *(const LAS bf16x8*)(M + (r0 + (lane & 15)) * TP + k0 + 8 * (lane >> 4)); }
__device__ __forceinline__ bf16x8 tr_frag(const LAS bf16_t* M, int k0, int c0, int lane) {
    LAS bf16_t* p = (LAS bf16_t*)M + (k0 + 8 * (lane >> 4) + ((lane & 15) >> 2)) * TP + c0 + 4 * (lane & 3);
    const v4s lo = __builtin_amdgcn_ds_read_tr16_b64_v4i16((LAS v4s*)p), hi = __builtin_amdgcn_ds_read_tr16_b64_v4i16((LAS v4s*)(p + 4 * TP));
    return (bf16x8){lo[0], lo[1], lo[2], lo[3], hi[0], hi[1], hi[2], hi[3]};
}
template <bool XT, bool YT>
__device__ __forceinline__ void mm64(const LAS bf16_t* X, const LAS bf16_t* Y, f32x4 (&acc)[2], int wq, int wh, int lane) {
#pragma unroll
    for (int ks = 0; ks < 2; ++ks) {
        const bf16x8 b = XT ? tr_frag(X, 32 * ks, 16 * wq, lane) : row_frag(X, 16 * wq, 32 * ks, lane);
#pragma unroll
        for (int q = 0; q < 2; ++q) { const int i0 = 16 * (2 * wh + q);
            const bf16x8 a = YT ? row_frag(Y, i0, 32 * ks, lane) : tr_frag(Y, 32 * ks, i0, lane);
            acc[q] = __builtin_amdgcn_mfma_f32_16x16x32_bf16(a, b, acc[q], 0, 0, 0); }
    }
}
__device__ __forceinline__ void st_tile(LAS bf16_t* Z, const f32x4 (&acc)[2], int wq, int wh, int lane) {
#pragma unroll
    for (int q = 0; q < 2; ++q) { u32x2 o; o.x = cvt_pk_bf16(acc[q][0], acc[q][1]); o.y = cvt_pk_bf16(acc[q][2], acc[q][3]);
        *(LAS u32x2*)(Z + (16 * wq + (lane & 15)) * TP + 16 * (2 * wh + q) + 4 * (lane >> 4)) = o; }
}
__device__ __forceinline__ void ld_tile(const LAS bf16_t* Z, f32x4 (&acc)[2], int wq, int wh, int lane) {
#pragma unroll
    for (int q = 0; q < 2; ++q) { const u32x2 o = *(const LAS u32x2*)(Z + (16 * wq + (lane & 15)) * TP + 16 * (2 * wh + q) + 4 * (lane >> 4));
        acc[q] = (f32x4){bf_lo(o.x), bf_hi(o.x), bf_lo(o.y), bf_hi(o.y)}; }
}
__device__ __forceinline__ f32x4 prod16(const LAS bf16_t* X, int xr, int xc, const LAS bf16_t* Y, int yr, int yc, f32x4 acc, int lane) {
    bf16x8 b = *(const LAS bf16x8*)(X + (xr + (lane & 15)) * TP + xc + 8 * (lane >> 4)); bf16x8 a = tr_frag(Y, yr, yc, lane);
    if ((lane >> 4) >= 2) { b = (bf16x8){0, 0, 0, 0, 0, 0, 0, 0}; a = (bf16x8){0, 0, 0, 0, 0, 0, 0, 0}; }
    return __builtin_amdgcn_mfma_f32_16x16x32_bf16(a, b, acc, 0, 0, 0);
}
__device__ __forceinline__ void st16(LAS bf16_t* Z, int zr, int zc, f32x4 acc, int lane) { u32x2 o; o.x = cvt_pk_bf16(acc[0], acc[1]); o.y = cvt_pk_bf16(acc[2], acc[3]); *(LAS u32x2*)(Z + (zr + (lane & 15)) * TP + zc + 4 * (lane >> 4)) = o; }
__device__ __forceinline__ f32x4 ld16(const LAS bf16_t* Z, int zr, int zc, int lane) { const u32x2 o = *(const LAS u32x2*)(Z + (zr + (lane & 15)) * TP + zc + 4 * (lane >> 4)); return (f32x4){bf_lo(o.x), bf_hi(o.x), bf_lo(o.y), bf_hi(o.y)}; }
struct ChunkRegs { u32x4 r, k, v, tw, ta; };
__device__ __forceinline__ void scan_load(KP P, const Frame& F, int item, int c4, ChunkRegs& R) {
    const int s = item & 63, sc = item >> 6, z = s >> 5, b = (s >> 4) & 1, hh = s & 15;
    const size_t row = (size_t)scan_row(z, b, sc * SCP + c4 * 64 + (F.tid >> 3)); const size_t o = row * D + hh * 64 + (F.tid & 7) * 8, o2 = row * 256 + z * 64 + (F.tid & 7) * 8;
    R.r = *(const u32x4*)((const bf16_t*)(P->ws + WS_R) + o); R.k = *(const u32x4*)((const bf16_t*)(P->ws + WS_K) + o); R.v = *(const u32x4*)((const bf16_t*)(P->ws + WS_VV) + o);
    R.tw = *(const u32x4*)((const bf16_t*)(P->ws + WS_TW) + o2); R.ta = *(const u32x4*)((const bf16_t*)(P->ws + WS_TA) + o2);
}
__device__ __forceinline__ void scan_chunk_phase(const Frame& F, KP P, int j) {
    LAS unsigned char* lds = F.lds;
    LAS bf16_t* At = stile(lds, T_AT); LAS bf16_t* Rt = stile(lds, T_RT); LAS bf16_t* Bt = stile(lds, T_BT); LAS bf16_t* Kt = stile(lds, T_KT); LAS bf16_t* Vm = stile(lds, T_VM);
    LAS bf16_t* NT = stile(lds, T_NT); LAS bf16_t* MT = stile(lds, T_MT); LAS bf16_t* NrT = stile(lds, T_NRT); LAS bf16_t* MrT = stile(lds, T_MRT);
    LAS bf16_t* ApA = stile(lds, T_APA); LAS bf16_t* ApB = stile(lds, T_APB); LAS bf16_t* TaA = stile(lds, T_TAA); LAS bf16_t* TaB = stile(lds, T_TAB);
    LAS bf16_t* PrB = stile(lds, T_PRB); LAS bf16_t* QrB = stile(lds, T_QRB);
    LAS float* gl = (LAS float*)(lds + LDS_GL); LAS float* seg = (LAS float*)(lds + LDS_SEG);
    const int lane = F.lane, wq = F.wave & 3, wh = F.wave >> 2, l15 = lane & 15, l4 = lane >> 4;
    const int pi = F.tid >> 3, kq = F.tid & 7;
    const int jrow = 16 * wq + l15;
    const int NITEM = NSCAN * NSC;
    int item = blockIdx.x; if (item >= NITEM) return;
    ChunkRegs cur, nxt; scan_load(P, F, item, 0, cur); nxt = cur;
    f32x4 Pr[2], Qr[2], aYp[2], aQp[2];
#pragma unroll
    for (int q = 0; q < 2; ++q) { Pr[q] = (f32x4){0.f, 0.f, 0.f, 0.f}; Qr[q] = Pr[q]; aYp[q] = Pr[q]; aQp[q] = Pr[q]; }
    bool pend = false; size_t orowp = 0; bf16_t* GEp = nullptr; bf16_t* YEp = nullptr; float* pqp = nullptr; bool lastp = false;
#define SCAN_STAGE_G() do { \
        f32x4 ge[2] = {(f32x4){0.f, 0.f, 0.f, 0.f}, (f32x4){0.f, 0.f, 0.f, 0.f}}; \
        mm64<false, true>(NT, PrB, ge, wq, wh, lane); mm64<false, true>(NT, QrB, aYp, wq, wh, lane); \
        f32x4 pn[2] = {(f32x4){0.f, 0.f, 0.f, 0.f}, (f32x4){0.f, 0.f, 0.f, 0.f}}; \
        mm64<false, false>(PrB, MT, pn, wq, wh, lane); mm64<false, false>(QrB, MT, aQp, wq, wh, lane); \
        _Pragma("unroll") for (int q = 0; q < 2; ++q) { const int i0 = 16 * (2 * wh + q) + 4 * l4; \
            u32x2 o; o.x = cvt_pk_bf16(ge[q][0], ge[q][1]); o.y = cvt_pk_bf16(ge[q][2], ge[q][3]); *(u32x2*)(GEp + orowp + i0) = o; \
            u32x2 y; y.x = cvt_pk_bf16(aYp[q][0], aYp[q][1]); y.y = cvt_pk_bf16(aYp[q][2], aYp[q][3]); *(u32x2*)(YEp + orowp + i0) = y; \
            Pr[q] = pn[q]; Qr[q] = aQp[q]; } \
        if (lastp) { const int ln_ = lane_id_now(), l15_ = ln_ & 15, l4_ = ln_ >> 4;   \
            float* pP_ = pqp + ((l15_ & 3) * 4 + (l15_ >> 2)) * 64 + wq * 16 + 8 * wh + l4_; float* pQ_ = pqp + 4096 + (wq * 16 + l4_) * 64 + 32 * wh + l15_; \
            _Pragma("unroll") for (int q = 0; q < 2; ++q)   \
            _Pragma("unroll") for (int r = 0; r < 4; ++r) { pP_[r * 1024 + 4 * q] = Pr[q][r]; pQ_[r * 256 + 16 * q] = Qr[q][r]; } } \
    } while (0)
    u32x4 w2r = (u32x4){0u, 0u, 0u, 0u}, a2r = w2r; int sprev = -1;
    for (;;) {
        const int s = item & 63, sc = item >> 6, z = s >> 5, b = (s >> 4) & 1, hh = s & 15;
        const float* kkw = P->in[I_KK] + (size_t)j * D + hh * 64 + kq * 8; const float* kap = P->in[I_KA] + (size_t)j * D + hh * 64 + kq * 8; const float* rkp = P->in[I_RK] + (size_t)j * D + hh * 64 + kq * 8;
        const float* w0p = P->in[I_W0] + ((size_t)j * 2 + z) * D + hh * 64; const float* a0p = P->in[I_A0] + ((size_t)j * 2 + z) * D + hh * 64;
        float* bon = (float*)(P->ws + WS_BON) + (size_t)z * T * 16;
        if (s != sprev) { sprev = s;
            w2r = *(const u32x4*)((const bf16_t*)(P->ws + WS_W2P) + (((size_t)j * 2 + z) * D + hh * 64 + pi) * 256 + z * 64 + kq * 8);
            a2r = *(const u32x4*)((const bf16_t*)(P->ws + WS_A2P) + (((size_t)j * 2 + z) * D + hh * 64 + pi) * 256 + z * 64 + kq * 8); }
        bf16_t* GE = (bf16_t*)(P->ws + (z ? WS_AS1 : WS_AS0)); bf16_t* YE = (bf16_t*)(P->ws + (z ? WS_ELOG1 : WS_ELOG0));
        float* pq = (float*)(P->ws + WS_PQ) + ((size_t)(s * NSC + sc) * 2) * 4096;
#pragma nounroll
        for (int c4 = 0; c4 < NCH; ++c4) {
            unsigned long long ch_t[12]; ch_t[11] = CH_AMP >= 0 ? __builtin_amdgcn_s_memrealtime() : 0ull;
            *(LAS u32x4*)(ApA + pi * TP + kq * 8) = cur.tw; *(LAS u32x4*)(ApB + pi * TP + kq * 8) = cur.ta; *(LAS u32x4*)(NrT + pi * TP + kq * 8) = w2r; *(LAS u32x4*)(MrT + pi * TP + kq * 8) = a2r;
            LDS_BARRIER(); CH_STAMP(0);
            {   f32x4 lw[2] = {(f32x4){0.f, 0.f, 0.f, 0.f}, (f32x4){0.f, 0.f, 0.f, 0.f}}, la[2] = {(f32x4){0.f, 0.f, 0.f, 0.f}, (f32x4){0.f, 0.f, 0.f, 0.f}};
                mm64<false, true>(ApA, NrT, lw, wq, wh, lane); mm64<false, true>(ApB, MrT, la, wq, wh, lane);
#pragma unroll
                for (int q = 0; q < 2; ++q) { const int i0 = 16 * (2 * wh + q) + 4 * l4; const f32x4 w04 = *(const f32x4*)(w0p + i0), a04 = *(const f32x4*)(a0p + i0);
#pragma unroll
                    for (int r = 0; r < 4; ++r) { lw[q][r] = -0.60653065971f * sigmoidf_(w04[r] + lw[q][r]); la[q][r] = sigmoidf_(a04[r] + la[q][r]); } }
                st_tile(TaA, lw, wq, wh, lane); st_tile(TaB, la, wq, wh, lane); }
            LDS_BARRIER(); CH_STAMP(1);
            float r8[8], k8[8], e8[8], m8[8], a8[8], kk8[8], c8[8];
            { const u32x4 et = *(const LAS u32x4*)(TaA + pi * TP + kq * 8), at = *(const LAS u32x4*)(TaB + pi * TP + kq * 8); unpack8(cur.r, r8); unpack8(cur.k, k8); unpack8(et, e8); unpack8(at, a8); }
            {   const f32x4 ka0 = *(const f32x4*)(kap), ka1 = *(const f32x4*)(kap + 4), rk0 = *(const f32x4*)(rkp), rk1 = *(const f32x4*)(rkp + 4); float bp = 0.f;
#pragma unroll
                for (int e = 0; e < 8; ++e) { m8[e] = k8[e] * (1.0f + (a8[e] - 1.0f) * (e < 4 ? ka0[e & 3] : ka1[e & 3])); bp += r8[e] * (e < 4 ? rk0[e & 3] : rk1[e & 3]) * m8[e]; }
                bp += shx(bp, 1, lane); bp += shx(bp, 2, lane); bp += shx(bp, 4, lane);
                if (kq == 0) bon[(size_t)scan_row(z, b, sc * SCP + c4 * 64 + pi) * 16 + hh] = bp; }
            { const f32x4 w0 = *(const f32x4*)kkw, w1 = *(const f32x4*)(kkw + 4); float ss = 0.f;
#pragma unroll
              for (int e = 0; e < 8; ++e) { kk8[e] = k8[e] * (e < 4 ? w0[e & 3] : w1[e & 3]); ss += kk8[e] * kk8[e]; }
              ss += shx(ss, 1, lane); ss += shx(ss, 2, lane); ss += shx(ss, 4, lane);
              const float rn = rsqrtf(ss + 1e-12f);
#pragma unroll
              for (int e = 0; e < 8; ++e) { kk8[e] *= rn; c8[e] = e8[e]; } }
#pragma unroll
            for (int d = 8; d < 64; d <<= 1) {
#pragma unroll
                for (int e = 0; e < 8; ++e) { const float t = shup(c8[e], d, lane); c8[e] += lane >= d ? t : 0.f; } }
            if (lane >= 56) { *(LAS f32x4*)(seg + F.wave * 64 + kq * 8) = (f32x4){c8[0], c8[1], c8[2], c8[3]}; *(LAS f32x4*)(seg + F.wave * 64 + kq * 8 + 4) = (f32x4){c8[4], c8[5], c8[6], c8[7]}; }
            if (pend) { SCAN_STAGE_G(); pend = false; }
            LDS_BARRIER(); CH_STAMP(2);
            if (c4 > 0) { st_tile(PrB, Pr, wq, wh, lane); st_tile(QrB, Qr, wq, wh, lane); }
            { float cum[8];
#pragma unroll
              for (int e = 0; e < 8; ++e) cum[e] = c8[e];
              for (int w2 = 0; w2 < F.wave; ++w2) { const f32x4 o0 = *(const LAS f32x4*)(seg + w2 * 64 + kq * 8), o1 = *(const LAS f32x4*)(seg + w2 * 64 + kq * 8 + 4);
#pragma unroll
                  for (int e = 0; e < 8; ++e) cum[e] += e < 4 ? o0[e & 3] : o1[e & 3]; }
              float o[8];
#pragma unroll
              for (int e = 0; e < 8; ++e) o[e] = -kk8[e] * __expf(cum[e] - e8[e]);
              *(LAS u32x4*)(At + pi * TP + kq * 8) = pack8(o);
#pragma unroll
              for (int e = 0; e < 8; ++e) o[e] = r8[e] * __expf(cum[e]);
              *(LAS u32x4*)(Rt + pi * TP + kq * 8) = pack8(o);
              float en[8];
#pragma unroll
              for (int e = 0; e < 8; ++e) { en[e] = __expf(-cum[e]); o[e] = kk8[e] * a8[e] * en[e]; }
              *(LAS u32x4*)(Bt + pi * TP + kq * 8) = pack8(o);
#pragma unroll
              for (int e = 0; e < 8; ++e) o[e] = m8[e] * en[e];
              *(LAS u32x4*)(Kt + pi * TP + kq * 8) = pack8(o);
              *(LAS u32x4*)(Vm + pi * TP + kq * 8) = cur.v;
              if (pi == 63) {
#pragma unroll
                  for (int e = 0; e < 8; ++e) gl[kq * 8 + e] = __expf(cum[e]); } }
            { const int nitem = c4 < NCH - 1 ? item : item + (int)gridDim.x, nc4 = c4 < NCH - 1 ? c4 + 1 : 0; if (nitem < NITEM) scan_load(P, F, nitem, nc4, nxt); }
            LDS_BARRIER(); CH_STAMP(3);
            {   f32x4 aN[2], aM[2], aNr[2], aMr[2];
#pragma unroll
                for (int q = 0; q < 2; ++q) { aN[q] = (f32x4){0.f, 0.f, 0.f, 0.f}; aM[q] = aN[q]; aNr[q] = aN[q]; aMr[q] = aN[q]; }
                mm64<false, true>(At, Bt, aN, wq, wh, lane); mm64<false, true>(At, Kt, aM, wq, wh, lane); mm64<false, true>(Rt, Bt, aNr, wq, wh, lane); mm64<false, true>(Rt, Kt, aMr, wq, wh, lane);
                f32x4 aT[2];
#pragma unroll
                for (int q = 0; q < 2; ++q)
#pragma unroll
                    for (int r = 0; r < 4; ++r) { const int i = 16 * (2 * wh + q) + 4 * l4 + r; const bool lt = i < jrow, le = i <= jrow;
                        aN[q][r] = lt ? aN[q][r] : 0.f; aM[q][r] = lt ? aM[q][r] : 0.f; aNr[q][r] = le ? aNr[q][r] : 0.f; aMr[q][r] = le ? aMr[q][r] : 0.f; aT[q][r] = aN[q][r] + (i == jrow ? 1.f : 0.f); }
                st_tile(NT, aN, wq, wh, lane); st_tile(MT, aM, wq, wh, lane); st_tile(NrT, aNr, wq, wh, lane); st_tile(MrT, aMr, wq, wh, lane); st_tile(TaA, aT, wq, wh, lane);
            }
            LDS_BARRIER(); CH_STAMP(4);
            if (F.wave < 4) { const int o = 16 * F.wave, oc = 16 * ((F.wave + 1) & 3);
                f32x4 p = prod16(NT, o, o, NT, o, o, (f32x4){0.f, 0.f, 0.f, 0.f}, lane); st16(ApA, o, o, p, lane);
                f32x4 t = prod16(TaA, o, o, ApA, o, o, ld16(TaA, o, o, lane), lane); p = prod16(ApA, o, o, ApA, o, o, (f32x4){0.f, 0.f, 0.f, 0.f}, lane);
                st16(TaB, o, o, t, lane); st16(ApA, o, oc, p, lane);
                t = prod16(TaB, o, o, ApA, o, oc, ld16(TaB, o, o, lane), lane); p = prod16(ApA, o, oc, ApA, o, oc, (f32x4){0.f, 0.f, 0.f, 0.f}, lane);
                st16(TaA, o, o, t, lane); st16(ApA, o, o, p, lane);
                t = prod16(TaA, o, o, ApA, o, o, ld16(TaA, o, o, lane), lane); st16(TaB, o, o, t, lane);
#pragma unroll
                for (int jj = 1; jj < 4; ++jj) if (jj > F.wave) { u32x2 zz; asm volatile("v_mov_b32 %0, 0\n\tv_mov_b32 %1, 0" : "=v"(zz.x), "=v"(zz.y)); *(LAS u32x2*)(TaB + (o + l15) * TP + 16 * jj + 4 * l4) = zz; }
            } else { const int wq2 = F.wave - 4;
#pragma unroll
                for (int wh2 = 0; wh2 < 2; ++wh2) { f32x4 x[2] = {(f32x4){0.f, 0.f, 0.f, 0.f}, (f32x4){0.f, 0.f, 0.f, 0.f}}; mm64<true, true>(Vm, MT, x, wq2, wh2, lane); st_tile(ApB, x, wq2, wh2, lane); } }
            LDS_BARRIER(); CH_STAMP(5);
            if (F.wave < 3) { const int jj = F.wave;
#pragma unroll
                for (int i = 1; i < 4; ++i) if (i > jj) { f32x4 e = (f32x4){0.f, 0.f, 0.f, 0.f};
#pragma unroll
                    for (int m = 0; m < 3; ++m) if (m >= jj && m < i) e = prod16(NT, 16 * i, 16 * m, TaB, 16 * m, 16 * jj, e, lane);
                    st16(ApA, 16 * i, 16 * jj, e, lane);
                    st16(TaB, 16 * i, 16 * jj, prod16(TaB, 16 * i, 16 * i, ApA, 16 * i, 16 * jj, (f32x4){0.f, 0.f, 0.f, 0.f}, lane), lane); } }
            LDS_BARRIER(); CH_STAMP(6);
            {   f32x4 w[2] = {(f32x4){0.f, 0.f, 0.f, 0.f}, (f32x4){0.f, 0.f, 0.f, 0.f}}; mm64<true, true>(At, TaB, w, wq, wh, lane); st_tile(ApA, w, wq, wh, lane);
                f32x4 u[2] = {(f32x4){0.f, 0.f, 0.f, 0.f}, (f32x4){0.f, 0.f, 0.f, 0.f}}; mm64<false, true>(ApB, TaB, u, wq, wh, lane); st_tile(TaA, u, wq, wh, lane); }
            LDS_BARRIER(); CH_STAMP(7);
            f32x4 aP[2], aQ[2], aG[2], aY[2];
#pragma unroll
            for (int q = 0; q < 2; ++q) { aP[q] = (f32x4){0.f, 0.f, 0.f, 0.f}; aQ[q] = aP[q]; aG[q] = aP[q]; aY[q] = aP[q]; }
            mm64<false, false>(ApA, Bt, aP, wq, wh, lane);
            mm64<false, false>(TaA, Bt, aQ, wq, wh, lane); mm64<true, false>(Vm, Kt, aQ, wq, wh, lane);
            mm64<false, true>(NrT, ApA, aG, wq, wh, lane);
            mm64<false, true>(NrT, TaA, aY, wq, wh, lane); mm64<false, false>(MrT, Vm, aY, wq, wh, lane);
#pragma unroll
            for (int q = 0; q < 2; ++q) { const int i0 = 16 * (2 * wh + q) + 4 * l4; const f32x4 g4 = *(const LAS f32x4*)(gl + i0);
                const u32x2 rr = *(const LAS u32x2*)(Rt + jrow * TP + i0);
#pragma unroll
                for (int r = 0; r < 4; ++r) { aP[q][r] = (aP[q][r] + (i0 + r == jrow ? 1.f : 0.f)) * g4[r]; aQ[q][r] *= g4[r]; }
                aG[q][0] += bf_lo(rr.x); aG[q][1] += bf_hi(rr.x); aG[q][2] += bf_lo(rr.y); aG[q][3] += bf_hi(rr.y); }
            const size_t orow = (size_t)scan_row(z, b, sc * SCP + c4 * 64 + jrow) * D + hh * 64;
            if (c4 == 0) {
#pragma unroll
                for (int q = 0; q < 2; ++q) { const int i0 = 16 * (2 * wh + q) + 4 * l4;
                    u32x2 o; o.x = cvt_pk_bf16(aG[q][0], aG[q][1]); o.y = cvt_pk_bf16(aG[q][2], aG[q][3]); *(u32x2*)(GE + orow + i0) = o;
                    u32x2 y; y.x = cvt_pk_bf16(aY[q][0], aY[q][1]); y.y = cvt_pk_bf16(aY[q][2], aY[q][3]); *(u32x2*)(YE + orow + i0) = y;
                    Pr[q] = aP[q]; Qr[q] = aQ[q]; }
            } else {
                st_tile(NT, aG, wq, wh, lane); st_tile(MT, aP, wq, wh, lane);
#pragma unroll
                for (int q = 0; q < 2; ++q) { aYp[q] = aY[q]; aQp[q] = aQ[q]; }
                pend = true; orowp = orow; GEp = GE; YEp = YE; pqp = pq; lastp = c4 == NCH - 1;
            }
            cur = nxt;
            if (CH_AMP >= 0) { const unsigned long long d_ = CH_AMP == 0 ? ch_t[0] - ch_t[11] : ch_t[CH_AMP] - ch_t[CH_AMP - 1]; const unsigned long long dl_ = __builtin_amdgcn_s_memrealtime() + 4 * d_; while (__builtin_amdgcn_s_memrealtime() < dl_) __builtin_amdgcn_s_sleep(4); }
            LDS_BARRIER(); CH_STAMP(8);
        }
        item += gridDim.x; if (item >= NITEM) break;
    }
    if (pend) { SCAN_STAGE_G(); }
#undef SCAN_STAGE_G
}
__device__ __forceinline__ void scan_carry_phase(const Frame& F, KP P, int layer) {
    LAS unsigned* cbar = (LAS unsigned*)(F.lds + 8192);
    if (F.tid == 0) *cbar = 0u;
    __syncthreads();
    if (F.wave >= 4) { moe_weights_phase(F, P, layer, blockIdx.x * 4 + (F.wave - 4), gridDim.x * 4, 0, MOE_SPLIT); return; }
    if (blockIdx.x >= 4 * NSCAN) return;
    unsigned ctarget = 0u;
    const int s = blockIdx.x >> 2, vs = blockIdx.x & 3, lane = F.lane, l15 = lane & 15, l4 = lane >> 4, v = 16 * vs + l15, T2 = F.wave;
    const float* pq = (const float*)(P->ws + WS_PQ) + (size_t)s * NSC * 2 * 4096; bf16_t* sst = (bf16_t*)(P->ws + WS_SST) + (size_t)s * NSC * 4096;
    LAS f32x4* exch = (LAS f32x4*)F.lds;
    f32x4 S[4]; float ap[4][16], qp[4][4];
#pragma unroll
    for (int t = 0; t < 4; ++t) S[t] = (f32x4){0.f, 0.f, 0.f, 0.f};
#define CARRY_LOAD(slot, step) do { const float* Pm_ = pq + (size_t)(step) * 2 * 4096; \
        _Pragma("unroll") for (int t2i = 0; t2i < 4; ++t2i) _Pragma("unroll") for (int ri = 0; ri < 4; ++ri) ap[slot][t2i * 4 + ri] = Pm_[(T2 * 16 + t2i * 4 + ri) * 64 + lane];   \
        _Pragma("unroll") for (int r = 0; r < 4; ++r) qp[slot][r] = Pm_[4096 + ((vs * 4 + T2) * 4 + r) * 64 + lane];   } while (0)
#define CARRY_STORE(sc_) do { if (T2 == 0) { float o[16]; \
        _Pragma("unroll") for (int r = 0; r < 4; ++r) _Pragma("unroll") for (int t2 = 0; t2 < 4; ++t2) o[4 * r + t2] = S[t2][r]; \
        u32x4 w0, w1; w0.x = cvt_pk_bf16(o[0], o[1]); w0.y = cvt_pk_bf16(o[2], o[3]); w0.z = cvt_pk_bf16(o[4], o[5]); w0.w = cvt_pk_bf16(o[6], o[7]); \
        w1.x = cvt_pk_bf16(o[8], o[9]); w1.y = cvt_pk_bf16(o[10], o[11]); w1.z = cvt_pk_bf16(o[12], o[13]); w1.w = cvt_pk_bf16(o[14], o[15]); \
        *(u32x4*)(sst + (size_t)(sc_) * 4096 + v * 64 + 16 * l4) = w0; *(u32x4*)(sst + (size_t)(sc_) * 4096 + v * 64 + 16 * l4 + 8) = w1; } } while (0)
    if (T2 < 4) {
#pragma unroll
        for (int u = 0; u < 4; ++u) CARRY_LOAD(u, u);
    }
#pragma nounroll
    for (int sc0 = 0; sc0 < NSC - 1; sc0 += 4) {
#pragma unroll
        for (int u = 0; u < 4; ++u) { const int sc = sc0 + u; if (sc >= NSC - 1) break;
            CARRY_STORE(sc);
            if (T2 < 4) {
                f32x4 nw = (f32x4){qp[u][0], qp[u][1], qp[u][2], qp[u][3]};
#pragma unroll
                for (int t2i = 0; t2i < 4; ++t2i)
#pragma unroll
                    for (int ri = 0; ri < 4; ++ri) nw = __builtin_amdgcn_mfma_f32_16x16x4f32(ap[u][t2i * 4 + ri], S[t2i][ri], nw, 0, 0, 0);
                if (sc + 4 < NSC - 1) CARRY_LOAD(u, sc + 4);
                exch[((u & 1) * 4 + T2) * 64 + lane] = nw;
            }
            { asm volatile("s_waitcnt lgkmcnt(0)" ::: "memory"); if (lane == 0) __hip_atomic_fetch_add(cbar, 1u, __ATOMIC_RELAXED, __HIP_MEMORY_SCOPE_WORKGROUP); ctarget += 4u;
              for (int spin = 0; spin < (1 << 22); ++spin) { const unsigned c = __hip_atomic_load(cbar, __ATOMIC_RELAXED, __HIP_MEMORY_SCOPE_WORKGROUP); if ((int)(c - ctarget) >= 0) break; }
              asm volatile("" ::: "memory"); }
            if (T2 < 4) {
#pragma unroll
                for (int t = 0; t < 4; ++t) S[t] = exch[((u & 1) * 4 + t) * 64 + lane];
            }
        }
    }
    CARRY_STORE(NSC - 1);
#undef CARRY_LOAD
#undef CARRY_STORE
}
__device__ __forceinline__ void scan_out_phase(const Frame& F, KP P, int j) {
    const int lane = F.lane, l15 = lane & 15, l4 = lane >> 4;
    const bf16_t* GE0 = (const bf16_t*)(P->ws + WS_AS0); const bf16_t* GE1 = (const bf16_t*)(P->ws + WS_AS1); const bf16_t* YE0 = (const bf16_t*)(P->ws + WS_ELOG0); const bf16_t* YE1 = (const bf16_t*)(P->ws + WS_ELOG1);
    const bf16_t* Vb = (const bf16_t*)(P->ws + WS_VV); const float* BON = (const float*)(P->ws + WS_BON);
    const bf16_t* GT = (const bf16_t*)(P->ws + WS_GATE); bf16_t* YG = (bf16_t*)(P->ws + WS_YG);
    for (int item = F.gw; item < NBATCH * NH * ((SEQ + CTXL) / 256) * 8; item += F.NGW) {
        const int hh = item & 15, oct = (item >> 4) & 7, b = (item >> 7) & 1, blk = item >> 8;
        const int sc0 = (blk * 256 + 32 * oct) / SCP, sc1 = blk == 0 ? 0 : (SEQ + CTXL - 1 - (blk - 1) * 256 - 32 * oct) / SCP;

        const bf16_t* s0 = (const bf16_t*)(P->ws + WS_SST) + ((size_t)(b * 16 + hh) * NSC + sc0) * 4096; const bf16_t* s1 = (const bf16_t*)(P->ws + WS_SST) + ((size_t)(32 + b * 16 + hh) * NSC + sc1) * 4096;
        bf16x8 sa0[4][2], sa1[4][2];
#pragma unroll
        for (int vt = 0; vt < 4; ++vt) { const int v = 32 * (vt >> 1) + 8 * (l15 >> 2) + 4 * (vt & 1) + (l15 & 3);
#pragma unroll
            for (int ks = 0; ks < 2; ++ks) { sa0[vt][ks] = *(const bf16x8*)(s0 + v * 64 + 32 * ks + 8 * l4); sa1[vt][ks] = *(const bf16x8*)(s1 + v * 64 + 32 * ks + 8 * l4); } }
        f32x4 lg4[4], lb4[4];
#pragma unroll
        for (int q = 0; q < 4; ++q) { const int c = hh * 64 + 32 * (q >> 1) + 8 * l4 + 4 * (q & 1); lg4[q] = *(const f32x4*)(P->in[I_LNG] + (size_t)j * D + c); lb4[q] = *(const f32x4*)(P->in[I_LNB] + (size_t)j * D + c); }
#pragma nounroll
        for (int ti = 0; ti < 2; ++ti) {
            const int tok = (2 * oct + ti) * 16 + l15; const int row = blk == 0 ? TL + b * CTXL + tok : b * SEQ + (blk - 1) * 256 + tok;
            const size_t o = (size_t)row * D + hh * 64;
            const bf16x8 g00 = *(const bf16x8*)(GE0 + o + 8 * l4), g01 = *(const bf16x8*)(GE0 + o + 32 + 8 * l4), g10 = *(const bf16x8*)(GE1 + o + 8 * l4), g11 = *(const bf16x8*)(GE1 + o + 32 + 8 * l4);
            u32x4 la[2], lc[2], lv[2], lgt[2];
#pragma unroll
            for (int h2 = 0; h2 < 2; ++h2) { const size_t oc = o + 32 * h2 + 8 * l4;
                la[h2] = *(const u32x4*)(YE0 + oc); lc[h2] = *(const u32x4*)(YE1 + oc); lv[h2] = *(const u32x4*)(Vb + oc); lgt[h2] = *(const u32x4*)(GT + oc); }
            const float bn = BON[(size_t)row * 16 + hh] + BON[((size_t)T + row) * 16 + hh];
            __builtin_amdgcn_sched_barrier(0);
            f32x4 y[4]; float s = 0.f; f32x4 vv[4], gg[4];
#pragma unroll
            for (int vt = 0; vt < 4; ++vt) { const int h2 = vt >> 1, hf = vt & 1;
                const unsigned ax = hf ? la[h2].z : la[h2].x, ay = hf ? la[h2].w : la[h2].y, cx = hf ? lc[h2].z : lc[h2].x, cy = hf ? lc[h2].w : lc[h2].y;
                const unsigned vx = hf ? lv[h2].z : lv[h2].x, vy = hf ? lv[h2].w : lv[h2].y, gx = hf ? lgt[h2].z : lgt[h2].x, gy = hf ? lgt[h2].w : lgt[h2].y;
                f32x4 acc = (f32x4){bf_lo(ax) + bf_lo(cx), bf_hi(ax) + bf_hi(cx), bf_lo(ay) + bf_lo(cy), bf_hi(ay) + bf_hi(cy)};
                acc = __builtin_amdgcn_mfma_f32_16x16x32_bf16(sa0[vt][0], g00, acc, 0, 0, 0); acc = __builtin_amdgcn_mfma_f32_16x16x32_bf16(sa0[vt][1], g01, acc, 0, 0, 0);
                acc = __builtin_amdgcn_mfma_f32_16x16x32_bf16(sa1[vt][0], g10, acc, 0, 0, 0); acc = __builtin_amdgcn_mfma_f32_16x16x32_bf16(sa1[vt][1], g11, acc, 0, 0, 0);
                y[vt] = acc; s += (acc[0] + acc[1]) + (acc[2] + acc[3]);
                vv[vt] = (f32x4){bf_lo(vx), bf_hi(vx), bf_lo(vy), bf_hi(vy)}; gg[vt] = (f32x4){bf_lo(gx), bf_hi(gx), bf_lo(gy), bf_hi(gy)}; }
            s += shx(s, 16, lane); s += shx(s, 32, lane);
            const float mean = s * (1.0f / 64.0f); float q = 0.f;
#pragma unroll
            for (int vt = 0; vt < 4; ++vt) { const f32x4 d = y[vt] - mean; q += (d[0] * d[0] + d[1] * d[1]) + (d[2] * d[2] + d[3] * d[3]); }
            q += shx(q, 16, lane); q += shx(q, 32, lane);
            const float rstd = rsqrtf(q * (1.0f / 64.0f) + 64e-5f);
#pragma unroll
            for (int h2 = 0; h2 < 2; ++h2) { const f32x4 o0 = (((y[2 * h2] - mean) * rstd) * lg4[2 * h2] + lb4[2 * h2] + vv[2 * h2] * bn) * gg[2 * h2], o1 = (((y[2 * h2 + 1] - mean) * rstd) * lg4[2 * h2 + 1] + lb4[2 * h2 + 1] + vv[2 * h2 + 1] * bn) * gg[2 * h2 + 1];
                u32x4 w; w.x = cvt_pk_bf16(o0[0], o0[1]); w.y = cvt_pk_bf16(o0[2], o0[3]); w.z = cvt_pk_bf16(o1[0], o1[1]); w.w = cvt_pk_bf16(o1[2], o1[3]); *(u32x4*)(YG + o + 32 * h2 + 8 * l4) = w; }
        }
    }
}
__device__ __forceinline__ bool in_range(int lo, int hi, int k) { asm volatile("" : "+s"(lo), "+s"(hi)); return lo <= k && k < hi; }
constexpr int NPH = 46;
template <unsigned KMASK> __global__ void __launch_bounds__(NTHR, 2) mega(Params Pv) {
    extern __shared__ __attribute__((aligned(16))) unsigned char lds_raw[];
    Frame F0; F0.lds = (LAS unsigned char*)lds_raw; F0.tid = threadIdx.x; F0.lane = F0.tid & 63; F0.wave = __builtin_amdgcn_readfirstlane(F0.tid >> 6);
    F0.G = gridDim.x; F0.gw = blockIdx.x * NWAVES + F0.wave; F0.NGW = F0.G * NWAVES;
    LAS unsigned* misc = (LAS unsigned*)(F0.lds + LDS_MISC);
    if (F0.tid < 128) misc[F0.tid] = 0u;
    __syncthreads();
    KP P0 = (KP)__builtin_amdgcn_kernarg_segment_ptr();
    constexpr bool ALL = (KMASK == 0x3ffffu);
    const int lo = ALL ? 0 : P0->ph_lo, hi = ALL ? NPH : P0->ph_hi;
    XcdBarrier bar; bar.bar = (unsigned*)(P0->ws + WS_CTL) + CW_BAR; bar.x = 0; bar.st = (volatile LAS unsigned*)(misc + 8);
    if (ALL || hi - lo > 1) bar = xcd_barrier_post((unsigned*)(P0->ws + WS_CTL) + CW_BAR, (volatile LAS unsigned*)(misc + 8));
#define IN(k) (ALL || in_range(lo, hi, (k)))
#define KIND(q) ((KMASK >> (q)) & 1u)
#define BAR_LEADER (wave_sgpr_now(F0.wave) == 0 && lane_id_now() == 0)
#define SEAM(k) do { if (IN(k) && IN((k) + 1)) { XcdBarrier b2_ = bar; unsigned* bb_ = bar.bar; unsigned bx_ = bar.x; asm volatile("" : "+s"(bb_), "+s"(bx_)); b2_.bar = bb_; b2_.x = bx_; xcd_barrier<false>(b2_, BAR_LEADER); } } while (0)
#define AMP_T0 const unsigned long long amp_t0 = AMP_MASK ? __builtin_amdgcn_s_memrealtime() : 0ull;
#define AMP_END(kind) do { if (AMP_MASK & (1u << (kind))) { const unsigned long long t1_ = __builtin_amdgcn_s_memrealtime(), dl_ = t1_ + AMP_F * (t1_ - amp_t0); while (__builtin_amdgcn_s_memrealtime() < dl_) __builtin_amdgcn_s_sleep(8); } } while (0)
#define PHASE_ENTRY AMP_T0 KP P = P0; asm volatile("" : "+s"(P)); unsigned char* ws = P->ws; unsigned* ctl = (unsigned*)(ws + WS_CTL); (void)ctl; \
    Frame F = F0; { int l_ = lane_id_now(), w_ = F0.wave; asm volatile("" : "+s"(w_)); F.lane = l_; F.wave = w_; F.tid = w_ * 64 + l_; F.gw = blockIdx.x * NWAVES + w_; }

    if constexpr (KIND(0)) if (IN(0)) { PHASE_ENTRY prologue_phase(F, P); AMP_END(0); }
    if (IN(0) && IN(1)) { XcdBarrier b2_ = bar; unsigned* bb_ = bar.bar; unsigned bx_ = bar.x; asm volatile("" : "+s"(bb_), "+s"(bx_)); b2_.bar = bb_; b2_.x = bx_; xcd_barrier<true>(b2_, BAR_LEADER); }
    for (int lp = 0; lp < 2; ++lp) {
        const int pb = 1 + 22 * lp, la = 2 * lp, lb = 2 * lp + 1;
        if constexpr (KIND(1)) if (IN(pb + 0)) { PHASE_ENTRY norm1_phase(F, P, la); AMP_END(1); }
        SEAM(pb + 0);
        if constexpr (KIND(2)) if (IN(pb + 1)) { PHASE_ENTRY
            __syncthreads(); set_desc(F.lds, F.tid, 0, ws + WS_HL, ws + WS_WIN + (size_t)lp * 4096 * D * 2, ws + WS_U, 16, 0, 0, ws + WS_V, P->in[I_GBIN] + (size_t)lp * 4096, ws + WS_STAT); __syncthreads();
            SchedMulti<D, D> S{F.lds, TL / 256, 16, 1};
            EpiGelu E{F.lds};
            pg8::gemm_phase<EpiGelu, SchedMulti<D, D>, false, D, D, D>(F.lds, S, E, F.tid);
            __syncthreads(); { int w_ = F0.wave; asm volatile("" : "+s"(w_)); tail_gelu(F0.lds, w_); }
            AMP_END(2); }
        SEAM(pb + 1);
        if constexpr (KIND(3)) if (IN(pb + 2)) { PHASE_ENTRY spatial_phase(F, P, lp); AMP_END(3); }
        SEAM(pb + 2);
        if constexpr (KIND(4)) if (IN(pb + 3)) { PHASE_ENTRY
            __syncthreads();
            { bf16_t* X = (bf16_t*)(ws + WS_X);
              set_desc(F.lds, F.tid, 0, ws + WS_U, ws + WS_WOUT + (size_t)lp * D * GWID * 2, X, 4, 0, 0, X, X + (size_t)TL * D, P->in[I_GBOUT] + (size_t)lp * D);
              set_desc(F.lds, F.tid, 1, nullptr, nullptr, nullptr, 0, 0, 0, (const float*)(ws + WS_MOD) + (size_t)la * 3 * 6 * D + 2 * D); }
            __syncthreads();
            SchedMulti<GWID, GWID> S{F.lds, TL / 256, 4, 1};
            EpiResid E{F.lds};
            pg8::gemm_phase<EpiResid, SchedMulti<GWID, GWID>, false, GWID, GWID, GWID>(F.lds, S, E, F.tid);
            __syncthreads(); { int w_ = F0.wave; asm volatile("" : "+s"(w_)); tail_resid<GWID>(F0.lds, w_); }
            AMP_END(4); }
        SEAM(pb + 3);
        if constexpr (KIND(5)) if (IN(pb + 4)) { PHASE_ENTRY norm2_phase(F, P, la); AMP_END(5); }
        SEAM(pb + 4);
        if constexpr (KIND(16)) if (IN(pb + 5)) { PHASE_ENTRY
            __syncthreads(); set_desc(F.lds, F.tid, 0, ws + WS_HL, ws + WS_WRT + (size_t)la * 256 * D * 2, nullptr, 1, 0, 0); __syncthreads();
            const int nun = (la == DEPTH - 1 ? TL : T) / 256;
            if ((int)blockIdx.x >= nun) moe_weights_phase(F, P, la, ((int)blockIdx.x - nun) * NWAVES + F.wave, (F.G - nun) * NWAVES, MOE_SPLIT, MOE_ITEMS);
            else { SchedMulti<D, D> S{F.lds, nun, 1, 1};
                EpiLogits E{(float*)(ws + WS_LG)};
                pg8::gemm_phase<EpiLogits, SchedMulti<D, D>, false, D, D, D>(F.lds, S, E, F.tid);
                __syncthreads();
                { Unit uu_; for (int i = 0; S.next(i, uu_); ++i) route_rows(F, P, la, uu_.pm * 256); }
                if (F.G <= nun) { __syncthreads(); moe_weights_phase(F, P, la, F.gw, F.NGW, MOE_SPLIT, MOE_ITEMS); } }
            AMP_END(16); }
        SEAM(pb + 6);
        if constexpr (KIND(6)) if (IN(pb + 7)) { PHASE_ENTRY
            moe_tables(F.lds, F.tid, ctl + CW_CNT + la * 64);
            SchedMoE<D, D, true> S{F.lds, (const char*)(ws + WS_HL), (const char*)(ws + WS_WGU), (const int*)(ws + WS_LIST)};
            EpiSiluGate E{(bf16_t*)(ws + WS_H)};
            pg8::gemm_phase<EpiSiluGate, SchedMoE<D, D, true>, true, D, D, D>(F.lds, S, E, F.tid);
            AMP_END(6); }
        SEAM(pb + 7);
        if constexpr (KIND(7)) if (IN(pb + 8)) { PHASE_ENTRY
            moe_tables(F.lds, F.tid, ctl + CW_CNT + la * 64);
            SchedMoE<EHID, EHID, false> S{F.lds, (const char*)(ws + WS_H), (const char*)(ws + WS_WD), (const int*)(ws + WS_LIST)};
            EpiScatter E{F.lds, (bf16_t*)(ws + WS_YB), (const int*)(ws + WS_LIST)};
            pg8::gemm_phase<EpiScatter, SchedMoE<EHID, EHID, false>, false, EHID, EHID, EHID>(F.lds, S, E, F.tid);
            AMP_END(7); }
        SEAM(pb + 8);
        if constexpr (KIND(1)) if (IN(pb + 9)) { PHASE_ENTRY norm1_phase(F, P, lb); AMP_END(1); }
        SEAM(pb + 9);
        if constexpr (KIND(8)) if (IN(pb + 10)) { PHASE_ENTRY mix_phase(F, P, lp); AMP_END(8); }
        SEAM(pb + 10);
        if constexpr (KIND(9)) if (IN(pb + 11)) { PHASE_ENTRY
            __syncthreads();
            set_desc(F.lds, F.tid, 0, ws + WS_XR, ws + WS_WR + (size_t)lp * D * D * 2, ws + WS_R, 4, D, 0);
            set_desc(F.lds, F.tid, 1, ws + WS_XK, ws + WS_WK + (size_t)lp * D * D * 2, ws + WS_K, 4, D, 0);
            set_desc(F.lds, F.tid, 2, ws + WS_XV, ws + WS_WV + (size_t)lp * D * D * 2, ws + WS_VV, 4, D, 0);
            set_desc(F.lds, F.tid, 3, ws + WS_XW, ws + WS_LW1 + (size_t)lp * 256 * D * 2, ws + WS_TW, 1, 256, 1);
            set_desc(F.lds, F.tid, 4, ws + WS_XA, ws + WS_LA1 + (size_t)lp * 256 * D * 2, ws + WS_TA, 1, 256, 0);
            set_desc(F.lds, F.tid, 5, ws + WS_XG, ws + WS_LG1 + (size_t)lp * 256 * D * 2, ws + WS_TG, 1, 256, 2);
            __syncthreads();
            SchedMulti<D, D> S{F.lds, T / 256, 15, 6};
            EpiAct E{F.lds};
            pg8::gemm_phase<EpiAct, SchedMulti<D, D>, false, D, D, D>(F.lds, S, E, F.tid);
            AMP_END(9); }
        SEAM(pb + 11);
        if constexpr (KIND(10)) if (IN(pb + 12)) { PHASE_ENTRY
            __syncthreads(); set_desc(F.lds, F.tid, 0, ws + WS_TG, ws + WS_G2P + (size_t)lp * D * 256 * 2, ws + WS_GATE, 4, D, 0); __syncthreads();
            SchedMulti<256, 256> S{F.lds, T / 256, 4, 1};
            EpiAct E{F.lds};
            pg8::gemm_phase<EpiAct, SchedMulti<256, 256>, false, 256, 256, 256>(F.lds, S, E, F.tid);
            AMP_END(10); }
        __syncthreads();
        if constexpr (KIND(11)) if (IN(pb + 13)) { PHASE_ENTRY scan_chunk_phase(F, P, lp); AMP_END(11); }
        SEAM(pb + 13);
        if constexpr (KIND(14)) if (IN(pb + 14)) { PHASE_ENTRY scan_carry_phase(F, P, lb); AMP_END(14); }
        SEAM(pb + 14);
        if constexpr (KIND(15)) if (IN(pb + 15)) { PHASE_ENTRY scan_out_phase(F, P, lp); AMP_END(15); }
        SEAM(pb + 15);
        if constexpr (KIND(4)) if (IN(pb + 16)) { PHASE_ENTRY
            __syncthreads();
            { bf16_t* X = (bf16_t*)(ws + WS_X);
              set_desc(F.lds, F.tid, 0, ws + WS_YG, ws + WS_WO + (size_t)lp * D * D * 2, X, 4, 0, 0, X, X + (size_t)TL * D, nullptr);
              set_desc(F.lds, F.tid, 1, nullptr, nullptr, nullptr, 0, 0, 0, (const float*)(ws + WS_MOD) + (size_t)lb * 3 * 6 * D + 2 * D); }
            __syncthreads();
            SchedMulti<D, D> S{F.lds, TL / 256, 4, 1};
            EpiResid E{F.lds};
            pg8::gemm_phase<EpiResid, SchedMulti<D, D>, false, D, D, D>(F.lds, S, E, F.tid);
            if (lb != DEPTH - 1) { __syncthreads(); { int w_ = F0.wave; asm volatile("" : "+s"(w_)); tail_resid<D>(F0.lds, w_); } }
            AMP_END(4); }
        SEAM(pb + 16);
        if constexpr (KIND(5)) if (IN(pb + 17)) { PHASE_ENTRY norm2_phase(F, P, lb); AMP_END(5); }
        SEAM(pb + 17);
        if constexpr (KIND(16)) if (IN(pb + 18)) { PHASE_ENTRY
            __syncthreads(); set_desc(F.lds, F.tid, 0, ws + WS_HL, ws + WS_WRT + (size_t)lb * 256 * D * 2, nullptr, 1, 0, 0); __syncthreads();
            const int nun = (lb == DEPTH - 1 ? TL : T) / 256;
            if ((int)blockIdx.x >= nun) moe_weights_phase(F, P, lb, ((int)blockIdx.x - nun) * NWAVES + F.wave, (F.G - nun) * NWAVES, MOE_SPLIT, MOE_ITEMS);
            else { SchedMulti<D, D> S{F.lds, nun, 1, 1};
                EpiLogits E{(float*)(ws + WS_LG)};
                pg8::gemm_phase<EpiLogits, SchedMulti<D, D>, false, D, D, D>(F.lds, S, E, F.tid);
                __syncthreads();
                { Unit uu_; for (int i = 0; S.next(i, uu_); ++i) route_rows(F, P, lb, uu_.pm * 256); }
                if (F.G <= nun) { __syncthreads(); moe_weights_phase(F, P, lb, F.gw, F.NGW, MOE_SPLIT, MOE_ITEMS); } }
            AMP_END(16); }
        SEAM(pb + 19);
        if constexpr (KIND(6)) if (IN(pb + 20)) { PHASE_ENTRY
            moe_tables(F.lds, F.tid, ctl + CW_CNT + lb * 64);
            SchedMoE<D, D, true> S{F.lds, (const char*)(ws + WS_HL), (const char*)(ws + WS_WGU), (const int*)(ws + WS_LIST)};
            EpiSiluGate E{(bf16_t*)(ws + WS_H)};
            pg8::gemm_phase<EpiSiluGate, SchedMoE<D, D, true>, true, D, D, D>(F.lds, S, E, F.tid);
            AMP_END(6); }
        SEAM(pb + 20);
        if constexpr (KIND(7)) if (IN(pb + 21)) { PHASE_ENTRY
            moe_tables(F.lds, F.tid, ctl + CW_CNT + lb * 64);
            SchedMoE<EHID, EHID, false> S{F.lds, (const char*)(ws + WS_H), (const char*)(ws + WS_WD), (const int*)(ws + WS_LIST)};
            EpiScatter E{F.lds, (bf16_t*)(ws + WS_YB), (const int*)(ws + WS_LIST)};
            pg8::gemm_phase<EpiScatter, SchedMoE<EHID, EHID, false>, false, EHID, EHID, EHID>(F.lds, S, E, F.tid);
            AMP_END(7); }
        SEAM(pb + 21);
    }
    if constexpr (KIND(13)) if (IN(45)) { PHASE_ENTRY final_phase(F, P); AMP_END(13); }
#undef IN
#undef KIND
#undef SEAM
#undef PHASE_ENTRY
}

#if !MK_ONE_LAUNCH
static int phase_kind(int ph) { if (ph == 0) return 0; if (ph == 45) return 13; static const int k22[22] = {1, 2, 3, 4, 5, 16, 17, 6, 7, 1, 8, 9, 10, 11, 14, 15, 4, 5, 16, 17, 6, 7}; return k22[(ph - 1) % 22]; }
typedef void (*kern_t)(Params);
template <unsigned KM> static kern_t kern_of() { return mega<KM>; }
static kern_t kind_kernel(int kind) {
    switch (kind) { case 0: return kern_of<1u << 0>(); case 1: return kern_of<1u << 1>(); case 2: return kern_of<1u << 2>(); case 3: return kern_of<1u << 3>(); case 4: return kern_of<1u << 4>();
        case 5: return kern_of<1u << 5>(); case 6: return kern_of<1u << 6>(); case 7: return kern_of<1u << 7>(); case 8: return kern_of<1u << 8>(); case 9: return kern_of<1u << 9>();
        case 10: return kern_of<1u << 10>(); case 11: return kern_of<1u << 11>(); case 12: return kern_of<1u << 12>(); case 14: return kern_of<1u << 14>(); case 15: return kern_of<1u << 15>(); case 16: return kern_of<1u << 16>(); case 17: return kern_of<1u << 17>(); default: return kern_of<1u << 13>(); }
}
#endif
extern "C" void kernel_launch(void* const* d_in, const int* in_sizes, int n_in, void* d_out, int out_size, void* d_ws, size_t ws_size, hipStream_t stream) {
    static int grid = 0;
    if (grid == 0) {
        if (n_in != 42 || out_size != TL * D || ws_size < WS_END) { fprintf(stderr, "kernel_launch: unexpected problem (n_in %d, out %d, ws %zu < %zu)\n", n_in, out_size, ws_size, (size_t)WS_END); grid = -1; return; }
        int dev = 0, cus = 0;
        if (hipGetDevice(&dev) != hipSuccess || hipDeviceGetAttribute(&cus, hipDeviceAttributeMultiprocessorCount, dev) != hipSuccess) { grid = -1; return; }
#if MK_ONE_LAUNCH
        if (hipFuncSetAttribute((const void*)mega<0x3ffffu>, hipFuncAttributeMaxDynamicSharedMemorySize, LDS_BYTES) != hipSuccess) { fprintf(stderr, "kernel_launch: hipFuncSetAttribute failed\n"); grid = -1; return; }
#else
        for (int k = 0; k < 18; ++k) if (hipFuncSetAttribute((const void*)kind_kernel(k), hipFuncAttributeMaxDynamicSharedMemorySize, LDS_BYTES) != hipSuccess) { fprintf(stderr, "kernel_launch: hipFuncSetAttribute failed\n"); grid = -1; return; }
#endif
        (void)hipGetLastError();
        grid = cus;
    }
    if (grid < 0) return;
    (void)hipMemsetAsync((char*)d_ws + WS_CTL, 0, CTL_BYTES, stream);
    Params p{};
    for (int i = 0; i < 42; ++i) p.in[i] = (const float*)d_in[i];
    p.out = (float*)d_out; p.ws = (unsigned char*)d_ws;
#if MK_ONE_LAUNCH
    p.ph_lo = 0; p.ph_hi = NPH;
    hipLaunchKernelGGL(mega<0x3ffffu>, dim3(grid), dim3(NTHR), LDS_BYTES, stream, p);
#else
    for (int ph = 0; ph < NPH; ++ph) { p.ph_lo = ph; p.ph_hi = ph + 1; hipLaunchKernelGGL(kind_kernel(phase_kind(ph)), dim3(grid), dim3(NTHR), LDS_BYTES, stream, p); }
#endif
}
```
